# Optimizing an MI355X kernel written in HIP

```python
import math
import jax, jax.numpy as jnp
from jax import lax
import numpy as np

D_MODEL = 1024
BATCH = 4
SEQ = 8192
DEPTH = 2

GRID_W = 64
HEAD_DIM = 64
NA_HEADS = 6
NA_WIN_H = 8
NA_WIN_W = 16
NA_W = NA_HEADS * HEAD_DIM
GQA_HEADS = 6
GQA_KV_HEADS = 2
GQA_QW = GQA_HEADS * HEAD_DIM
GQA_KVW = GQA_KV_HEADS * HEAD_DIM
MLA_HEADS = 4
MLA_Q_RANK = 384
MLA_KV_RANK = 256
MLA_NOPE = 64
MLA_ROPE = 32
MLA_V = 64
MLA_QK = MLA_NOPE + MLA_ROPE
MLA_W = MLA_HEADS * MLA_V
ROPE_THETA = 10000.0
Q_BLOCK = 128
N_BRANCH = 3
N_EXPERTS = 32
TOP_K = 4
D_EXPERT = 1024
SWIGLU_LIMIT = 7.0
SWIGLU_ALPHA = 1.702
MOE_BLOCK = 512
LN_EPS = 1e-5
RMS_EPS = 1e-6
DN_ALPHA = (2.0 * DEPTH) ** 0.25
DN_BETA = (8.0 * DEPTH) ** -0.25
NEG_INF = -1e30

SPLIT_WIDTHS = [NA_W, NA_W, NA_W, GQA_QW, GQA_KVW, GQA_KVW,
                MLA_Q_RANK, MLA_KV_RANK, MLA_ROPE, N_BRANCH * D_MODEL]
SPLIT_POINTS = [int(v) for v in np.cumsum(SPLIT_WIDTHS)[:-1]]
D_IN = int(sum(SPLIT_WIDTHS))

kernel_name = "hybrid_na_gqa_mla_moe_encoder"


def layer_norm(x, g, b):
    xf = x.astype(jnp.float32)
    mu = jnp.mean(xf, -1, keepdims=True)
    var = jnp.mean(jnp.square(xf - mu), -1, keepdims=True)
    y = (xf - mu) * lax.rsqrt(var + LN_EPS)
    return (y * g.astype(jnp.float32) + b.astype(jnp.float32)).astype(x.dtype)


def rms_norm(x, g):
    xf = x.astype(jnp.float32)
    y = xf * lax.rsqrt(jnp.mean(xf * xf, -1, keepdims=True) + RMS_EPS)
    return (y * g.astype(jnp.float32)).astype(x.dtype)


def axial_rope(seq_len, dim):
    quarter = dim // 4
    inv = ROPE_THETA ** (-jnp.arange(quarter, dtype=jnp.float32) / quarter)
    t = jnp.arange(seq_len)
    row = (t // GRID_W).astype(jnp.float32)
    col = (t % GRID_W).astype(jnp.float32)
    ang = jnp.concatenate([row[:, None] * inv, col[:, None] * inv], -1)
    return jnp.cos(ang), jnp.sin(ang)


def apply_rope(x, cos, sin):
    half = x.shape[-1] // 2
    xf = x.astype(jnp.float32)
    x1, x2 = xf[..., :half], xf[..., half:]
    c, s = cos[:, None, :], sin[:, None, :]
    return jnp.concatenate([x1 * c - x2 * s, x1 * s + x2 * c], -1).astype(x.dtype)


def blocked_attention(q, k, v, scale):
    B, S, H, dq = q.shape
    G = k.shape[2]
    rep = H // G
    nb = S // Q_BLOCK
    qb = jnp.moveaxis(q.reshape(B, nb, Q_BLOCK, G, rep, dq), 1, 0)

    def one_block(qblk):
        s = jnp.einsum('bqgrd,bkgd->bgrqk', qblk, k,
                       preferred_element_type=jnp.float32) * scale
        p = jax.nn.softmax(s, axis=-1)
        return jnp.einsum('bgrqk,bkgd->bqgrd', p.astype(v.dtype), v)

    out = lax.map(one_block, qb)
    return jnp.moveaxis(out, 0, 1).reshape(B, S, H, v.shape[-1])


def neighbourhood_attention(q, k, v, rpb):
    B, S, H, d = q.shape
    R = S // GRID_W
    kh = min(NA_WIN_H, R)
    kw = NA_WIN_W
    rows = jnp.arange(R)
    cols = jnp.arange(GRID_W)
    r0 = jnp.clip(rows - kh // 2, 0, R - kh)
    c0 = jnp.clip(cols - kw // 2, 0, GRID_W - kw)
    row_idx = r0[:, None] + jnp.arange(kh)[None, :]
    qg = q.reshape(B, R, GRID_W, H, d)
    kg = k.reshape(B, R, GRID_W, H, d)[:, row_idx]
    vg = v.reshape(B, R, GRID_W, H, d)[:, row_idx]
    s = jnp.einsum('brqhd,brikhd->brhqik', qg, kg,
                   preferred_element_type=jnp.float32) * (d ** -0.5)
    idx_r = row_idx - rows[:, None] + (NA_WIN_H - 1)
    dc = cols[None, :] - cols[:, None]
    idx_c = jnp.clip(dc + (NA_WIN_W - 1), 0, 2 * NA_WIN_W - 2)
    bias = rpb[:, idx_r][..., idx_c]
    bias = bias.transpose(1, 0, 3, 2, 4).astype(jnp.float32)
    in_win = (cols[None, :] >= c0[:, None]) & (cols[None, :] < c0[:, None] + kw)
    s = jnp.where(in_win[:, None, :], s + bias[None], NEG_INF)
    p = jax.nn.softmax(s.reshape(B, R, H, GRID_W, kh * GRID_W), axis=-1).reshape(s.shape)
    out = jnp.einsum('brhqik,brikhd->brqhd', p.astype(v.dtype), vg)
    return out.reshape(B, S, H, d)


def moe_ffn(x, w_router, b_router, w_gate_up, b_gate_up, w_down, b_down):
    B, S, D = x.shape
    T = B * S
    TK = T * TOP_K
    xt = x.reshape(T, D)
    logits = jnp.dot(xt, w_router, preferred_element_type=jnp.float32) + b_router.astype(jnp.float32)
    top_val, top_idx = lax.top_k(logits, TOP_K)
    gate = jax.nn.softmax(top_val, axis=-1)
    flat_e = top_idx.reshape(-1).astype(jnp.int32)
    order = jnp.argsort(flat_e)
    e_sorted = flat_e[order]
    counts = jnp.bincount(flat_e, length=N_EXPERTS).astype(jnp.int32)
    padded = ((counts + MOE_BLOCK - 1) // MOE_BLOCK) * MOE_BLOCK
    cum_padded = jnp.cumsum(padded)
    starts_sorted = jnp.cumsum(counts) - counts
    starts_padded = cum_padded - padded
    rank = jnp.arange(TK, dtype=jnp.int32) - starts_sorted[e_sorted]
    dest = starts_padded[e_sorted] + rank
    n_blocks = TK // MOE_BLOCK + N_EXPERTS
    P = n_blocks * MOE_BLOCK
    slot_token = jnp.full((P,), T, jnp.int32).at[dest].set((order // TOP_K).astype(jnp.int32))
    slot_gate = jnp.zeros((P,), jnp.float32).at[dest].set(gate.reshape(-1)[order])
    block_start = jnp.arange(n_blocks, dtype=jnp.int32) * MOE_BLOCK
    block_expert = jnp.minimum(jnp.searchsorted(cum_padded, block_start, side='right'),
                               N_EXPERTS - 1).astype(jnp.int32)
    xpad = jnp.concatenate([xt, jnp.zeros((1, D), xt.dtype)], 0)
    xb = xpad[slot_token].reshape(n_blocks, MOE_BLOCK, D)

    def expert_block(args):
        xblk, e = args
        h = jnp.dot(xblk, w_gate_up[e]) + b_gate_up[e]
        g, u = h[:, :D_EXPERT], h[:, D_EXPERT:]
        g = jnp.minimum(g, SWIGLU_LIMIT)
        u = jnp.clip(u, -SWIGLU_LIMIT, SWIGLU_LIMIT)
        a = g * jax.nn.sigmoid(SWIGLU_ALPHA * g) * (u + 1.0)
        return jnp.dot(a, w_down[e]) + b_down[e]

    yb = lax.map(expert_block, (xb, block_expert))
    y = yb.reshape(P, D).astype(jnp.float32) * slot_gate[:, None]
    out = jnp.zeros((T + 1, D), jnp.float32).at[slot_token].add(y)[:T]
    return out.reshape(B, S, D).astype(x.dtype)


def hybrid_layer(x, cos64, sin64, cos32, sin32, w_in, na_rpb, gqa_q_norm, gqa_k_norm,
                 mla_q_norm, mla_kv_norm, w_uq, w_ukv, w_branch_a, w_branch_b, w_branch_c,
                 w_out, ln1_g, ln1_b, w_router, b_router, w_gate_up, b_gate_up,
                 w_down, b_down, ln2_g, ln2_b):
    B, S, D = x.shape
    h = x @ w_in
    (na_q, na_k, na_v, g_q, g_k, g_v, c_q, c_kv, k_rope, gates) = jnp.split(h, SPLIT_POINTS, axis=-1)

    hd = (B, S, NA_HEADS, HEAD_DIM)
    y_a = neighbourhood_attention(na_q.reshape(hd), na_k.reshape(hd), na_v.reshape(hd), na_rpb)
    y_a = y_a.reshape(B, S, NA_W) @ w_branch_a

    q_b = rms_norm(g_q.reshape(B, S, GQA_HEADS, HEAD_DIM), gqa_q_norm)
    k_b = rms_norm(g_k.reshape(B, S, GQA_KV_HEADS, HEAD_DIM), gqa_k_norm)
    q_b = apply_rope(q_b, cos64, sin64)
    k_b = apply_rope(k_b, cos64, sin64)
    v_b = g_v.reshape(B, S, GQA_KV_HEADS, HEAD_DIM)
    y_b = blocked_attention(q_b, k_b, v_b, HEAD_DIM ** -0.5)
    y_b = y_b.reshape(B, S, GQA_QW) @ w_branch_b

    q_c = (rms_norm(c_q, mla_q_norm) @ w_uq).reshape(B, S, MLA_HEADS, MLA_QK)
    q_nope, q_rope = q_c[..., :MLA_NOPE], apply_rope(q_c[..., MLA_NOPE:], cos32, sin32)
    kv_c = (rms_norm(c_kv, mla_kv_norm) @ w_ukv).reshape(B, S, MLA_HEADS, MLA_NOPE + MLA_V)
    k_nope, v_c = kv_c[..., :MLA_NOPE], kv_c[..., MLA_NOPE:]
    k_r = apply_rope(k_rope.reshape(B, S, 1, MLA_ROPE), cos32, sin32)
    q_full = jnp.concatenate([q_nope, q_rope], -1)
    k_full = jnp.concatenate([k_nope, jnp.broadcast_to(k_r, (B, S, MLA_HEADS, MLA_ROPE))], -1)
    y_c = blocked_attention(q_full, k_full, v_c, MLA_QK ** -0.5)
    y_c = y_c.reshape(B, S, MLA_W) @ w_branch_c

    g = jax.nn.sigmoid(gates.astype(jnp.float32)).reshape(B, S, N_BRANCH, D).astype(x.dtype)
    mixed = g[:, :, 0] * y_a + g[:, :, 1] * y_b + g[:, :, 2] * y_c
    x = layer_norm(DN_ALPHA * x + mixed @ w_out, ln1_g, ln1_b)

    f = moe_ffn(x, w_router, b_router, w_gate_up, b_gate_up, w_down, b_down)
    return layer_norm(DN_ALPHA * x + f, ln2_g, ln2_b)


def setup_inputs(seed: int = 0) -> dict:
    key = jax.random.key(seed)
    ks = jax.random.split(key, 28)
    L, D, E, F = DEPTH, D_MODEL, N_EXPERTS, D_EXPERT

    def nrm(k, shape, scale):
        return jax.random.normal(k, shape, jnp.float32) * scale

    return {
        "x": nrm(ks[0], (BATCH, SEQ, D), 1.0),
        "w_in": nrm(ks[1], (L, D, D_IN), D ** -0.5),
        "na_rpb": nrm(ks[2], (L, NA_HEADS, 2 * NA_WIN_H - 1, 2 * NA_WIN_W - 1), 0.1),
        "gqa_q_norm": 1.0 + nrm(ks[3], (L, HEAD_DIM), 0.02),
        "gqa_k_norm": 1.0 + nrm(ks[4], (L, HEAD_DIM), 0.02),
        "mla_q_norm": 1.0 + nrm(ks[5], (L, MLA_Q_RANK), 0.02),
        "mla_kv_norm": 1.0 + nrm(ks[6], (L, MLA_KV_RANK), 0.02),
        "w_uq": nrm(ks[7], (L, MLA_Q_RANK, MLA_HEADS * MLA_QK), MLA_Q_RANK ** -0.5),
        "w_ukv": nrm(ks[8], (L, MLA_KV_RANK, MLA_HEADS * (MLA_NOPE + MLA_V)), MLA_KV_RANK ** -0.5),
        "w_branch_a": nrm(ks[9], (L, NA_W, D), NA_W ** -0.5),
        "w_branch_b": nrm(ks[10], (L, GQA_QW, D), GQA_QW ** -0.5),
        "w_branch_c": nrm(ks[11], (L, MLA_W, D), MLA_W ** -0.5),
        "w_out": nrm(ks[12], (L, D, D), DN_BETA * D ** -0.5),
        "ln1_g": 1.0 + nrm(ks[13], (L, D), 0.02),
        "ln1_b": nrm(ks[14], (L, D), 0.02),
        "w_router": nrm(ks[15], (L, D, E), D ** -0.5),
        "b_router": nrm(ks[16], (L, E), 0.01),
        "w_gate_up": nrm(ks[17], (L, E, D, 2 * F), D ** -0.5),
        "b_gate_up": nrm(ks[18], (L, E, 2 * F), 0.01),
        "w_down": nrm(ks[19], (L, E, F, D), DN_BETA * F ** -0.5),
        "b_down": nrm(ks[20], (L, E, D), 0.01),
        "ln2_g": 1.0 + nrm(ks[21], (L, D), 0.02),
        "ln2_b": nrm(ks[22], (L, D), 0.02),
    }


def reference(x, w_in, na_rpb, gqa_q_norm, gqa_k_norm, mla_q_norm, mla_kv_norm, w_uq, w_ukv,
              w_branch_a, w_branch_b, w_branch_c, w_out, ln1_g, ln1_b, w_router, b_router,
              w_gate_up, b_gate_up, w_down, b_down, ln2_g, ln2_b):
    S = x.shape[1]
    cos64, sin64 = axial_rope(S, HEAD_DIM)
    cos32, sin32 = axial_rope(S, MLA_ROPE)
    for l in range(DEPTH):
        x = hybrid_layer(x, cos64, sin64, cos32, sin32, w_in[l], na_rpb[l], gqa_q_norm[l],
                         gqa_k_norm[l], mla_q_norm[l], mla_kv_norm[l], w_uq[l], w_ukv[l],
                         w_branch_a[l], w_branch_b[l], w_branch_c[l], w_out[l], ln1_g[l],
                         ln1_b[l], w_router[l], b_router[l], w_gate_up[l], b_gate_up[l],
                         w_down[l], b_down[l], ln2_g[l], ln2_b[l])
    return x
```

```cpp
#define MK_DEBUG 0
#define MK_ONE_LAUNCH 1
#include <hip/hip_runtime.h>
#include <hip/hip_bf16.h>
#include <cstdio>
#include <cstdint>
namespace pg8 {
#define PG8_LAS __attribute__((address_space(3)))
typedef unsigned short bf16_t;
typedef short bf16x8 __attribute__((ext_vector_type(8)));
typedef float f32x4 __attribute__((ext_vector_type(4)));
typedef unsigned u32x4 __attribute__((ext_vector_type(4)));
constexpr int BM = 256, BK = 64, HALF = 128, HTB = HALF * BK * 2  , STAGE_BYTES = 8 * HTB, NXCD = 8, WGM = 8;

__host__ __device__ __forceinline__ int lds_byte(int r, int c) { const int st = (r >> 4) * 2 + (c >> 5), rr = r & 15, cc = c & 31, ob = rr * 64 + cc * 2; return st * 1024 + (ob ^ (((ob >> 9) & 1) << 5)); }
__host__ __device__ __forceinline__ void stage_rc(int b, int& R, int& C) { const int st = b / 1024, sb = b % 1024, swz = sb ^ (((sb >> 9) & 1) << 5); R = (st >> 1) * 16 + swz / 64; C = (st & 1) * 32 + (swz % 64) / 2; }
__host__ __device__ __forceinline__ int perm32(int rho) { const int n = rho >> 4, i = rho & 15; return 8 * (i >> 2) + 4 * n + (i & 3); }

struct Unit { int pm, pn, e; };
struct Gemm { const bf16_t* A; const bf16_t* Bt; int M, N, K; size_t bstride; };

struct StaticOrder {
    int nM, nN, nwg, G, c;
    __host__ __device__ void init(int M, int N, int G_, int c_) { nM = M / BM; nN = N / BM; nwg = nM * nN; G = G_; c = c_; }
    __host__ __device__ bool next(int i, Unit& u) const {
        const long L = (long)i * G + c; if (L >= nwg) return false;
        int wgid = (int)L; { const int q = nwg / NXCD, r = nwg % NXCD, xcd = wgid % NXCD, off = wgid / NXCD; wgid = (xcd < r ? xcd * (q + 1) : r * (q + 1) + (xcd - r) * q) + off; }
        const int nig = WGM * nN, gid = wgid / nig, fm = gid * WGM, gsz = (nM - fm) < WGM ? (nM - fm) : WGM;
        u.pm = fm + ((wgid % nig) % gsz); u.pn = (wgid % nig) / gsz; u.e = 0; return true;
    }
    __device__ __forceinline__ void a_ready(const Unit&) const {}
    __device__ __forceinline__ void done(const Unit&) const {}
};

__device__ __forceinline__ unsigned cvt_pk_bf16(float lo, float hi) { unsigned r; asm volatile("v_cvt_pk_bf16_f32 %0, %1, %2" : "=v"(r) : "v"(lo), "v"(hi)); return r; }
typedef float f32x2 __attribute__((ext_vector_type(2)));


__device__ __forceinline__ float bf_lo(unsigned w) { return __uint_as_float(w << 16); }
__device__ __forceinline__ float bf_hi(unsigned w) { return __uint_as_float(w & 0xffff0000u); }
__device__ __forceinline__ float sigmoidf_(float z) { return __builtin_amdgcn_rcpf(1.0f + __builtin_amdgcn_exp2f(-1.4426950408889634f * z)); }
__device__ __forceinline__ u32x4 pack8(const f32x4& v0, const f32x4& v1) { u32x4 w; w.x = cvt_pk_bf16(v0[0], v0[1]); w.y = cvt_pk_bf16(v0[2], v0[3]); w.z = cvt_pk_bf16(v1[0], v1[1]); w.w = cvt_pk_bf16(v1[2], v1[3]); return w; }

struct EpiStore {
    static constexpr bool PERM = true, AFTER_DRAIN = false;
    bf16_t* O; int ldc; int nvalid;
    __device__ __forceinline__ void operator()(const f32x4 (&acc)[2][2][4][2], const Unit& u, int wr, int wc, int fr, int fq) const {
        const int row0 = u.pm * BM + wr * 64 + fr, col0 = u.pn * BM + wc * 32 + 8 * fq;
#pragma unroll
        for (int ai = 0; ai < 2; ++ai)
#pragma unroll
            for (int m = 0; m < 4; ++m) { bf16_t* rowp = O + (size_t)(row0 + ai * HALF + m * 16) * ldc + col0;
#pragma unroll
                for (int bj = 0; bj < 2; ++bj) { if (col0 + bj * HALF < nvalid) *(u32x4*)(rowp + bj * HALF) = pack8(acc[ai][bj][m][0], acc[ai][bj][m][1]); } }
    }
};
template <int MODE> struct EpiGate {
    static constexpr bool PERM = true, AFTER_DRAIN = false;
    const bf16_t* gate; int ldg; float* mix; bf16_t* mixed;
    __device__ __forceinline__ void operator()(const f32x4 (&acc)[2][2][4][2], const Unit& u, int wr, int wc, int fr, int fq) const {
        const int row0 = u.pm * BM + wr * 64 + fr, col0 = u.pn * BM + wc * 32 + 8 * fq;
#pragma unroll
        for (int ai = 0; ai < 2; ++ai)
#pragma unroll
            for (int m = 0; m < 4; ++m) { const size_t row = (size_t)(row0 + ai * HALF + m * 16);
#pragma unroll
                for (int bj = 0; bj < 2; ++bj) { const int col = col0 + bj * HALF;
                    const u32x4 gw = *(const u32x4*)(gate + row * ldg + col);
                    f32x4 g0 = {sigmoidf_(bf_lo(gw.x)), sigmoidf_(bf_hi(gw.x)), sigmoidf_(bf_lo(gw.y)), sigmoidf_(bf_hi(gw.y))};
                    f32x4 g1 = {sigmoidf_(bf_lo(gw.z)), sigmoidf_(bf_hi(gw.z)), sigmoidf_(bf_lo(gw.w)), sigmoidf_(bf_hi(gw.w))};
                    f32x4 v0 = g0 * acc[ai][bj][m][0], v1 = g1 * acc[ai][bj][m][1];
                    float* mp = mix + row * 1024 + col;
                    if (MODE >= 1) { v0 += *(const f32x4*)mp; v1 += *(const f32x4*)(mp + 4); }
                    if (MODE <= 1) { *(f32x4*)mp = v0; *(f32x4*)(mp + 4) = v1; }
                    else *(u32x4*)(mixed + row * 1024 + col) = pack8(v0, v1); } }
    }
};
struct EpiResid {
    static constexpr bool PERM = true, AFTER_DRAIN = false;
    const float* x; float* pre; float alpha;
    __device__ __forceinline__ void operator()(const f32x4 (&acc)[2][2][4][2], const Unit& u, int wr, int wc, int fr, int fq) const {
        const int row0 = u.pm * BM + wr * 64 + fr, col0 = u.pn * BM + wc * 32 + 8 * fq;
#pragma unroll
        for (int ai = 0; ai < 2; ++ai)
#pragma unroll
            for (int m = 0; m < 4; ++m) { const size_t row = (size_t)(row0 + ai * HALF + m * 16);
#pragma unroll
                for (int bj = 0; bj < 2; ++bj) { const size_t off = row * 1024 + col0 + bj * HALF;
                    const f32x4 x0 = *(const f32x4*)(x + off), x1 = *(const f32x4*)(x + off + 4);
                    *(f32x4*)(pre + off) = x0 * alpha + acc[ai][bj][m][0]; *(f32x4*)(pre + off + 4) = x1 * alpha + acc[ai][bj][m][1]; } }
    }
};
struct EpiSwiglu {
    static constexpr bool PERM = true, AFTER_DRAIN = false;
    bf16_t* a; const float* bias;
    __device__ __forceinline__ void operator()(const f32x4 (&acc)[2][2][4][2], const Unit& u, int wr, int wc, int fr, int fq) const {
        const int row0 = u.pm * BM + wr * 64 + fr, j0 = wc * 32 + 8 * fq, oc = u.pn * HALF + j0;
        const float* bg = bias + (size_t)u.e * 2048 + oc; const float* bu = bg + 1024;
        const f32x4 bg0 = *(const f32x4*)bg, bg1 = *(const f32x4*)(bg + 4), bu0 = *(const f32x4*)bu, bu1 = *(const f32x4*)(bu + 4);
#pragma unroll
        for (int ai = 0; ai < 2; ++ai)
#pragma unroll
            for (int m = 0; m < 4; ++m) { const size_t row = (size_t)(row0 + ai * HALF + m * 16);
                f32x4 g[2] = {acc[ai][0][m][0] + bg0, acc[ai][0][m][1] + bg1}, uu[2] = {acc[ai][1][m][0] + bu0, acc[ai][1][m][1] + bu1}, r[2];
#pragma unroll
                for (int n = 0; n < 2; ++n)
#pragma unroll
                    for (int q = 0; q < 4; ++q) { const float gg = fminf(g[n][q], 7.0f), uc = fminf(fmaxf(uu[n][q], -7.0f), 7.0f);
                        r[n][q] = gg * sigmoidf_(1.702f * gg) * (uc + 1.0f); }
                *(u32x4*)(a + row * 1024 + oc) = pack8(r[0], r[1]); }
    }
};
struct EpiDown {
    static constexpr bool PERM = true, AFTER_DRAIN = false;
    bf16_t* y; const float* bias; const float* sgate;
    __device__ __forceinline__ void operator()(const f32x4 (&acc)[2][2][4][2], const Unit& u, int wr, int wc, int fr, int fq) const {
        const int row0 = u.pm * BM + wr * 64 + fr, col0 = u.pn * BM + wc * 32 + 8 * fq;
        f32x4 bv[2][2];
#pragma unroll
        for (int bj = 0; bj < 2; ++bj)
#pragma unroll
            for (int n = 0; n < 2; ++n) bv[bj][n] = *(const f32x4*)(bias + (size_t)u.e * 1024 + col0 + bj * HALF + 4 * n);
#pragma unroll
        for (int ai = 0; ai < 2; ++ai)
#pragma unroll
            for (int m = 0; m < 4; ++m) { const size_t row = (size_t)(row0 + ai * HALF + m * 16); const float gt = sgate[row];
#pragma unroll
                for (int bj = 0; bj < 2; ++bj) { const f32x4 v0 = (acc[ai][bj][m][0] + bv[bj][0]) * gt, v1 = (acc[ai][bj][m][1] + bv[bj][1]) * gt;
                    *(u32x4*)(y + row * 1024 + col0 + bj * HALF) = pack8(v0, v1); } }
    }
};
struct MoeOrder {
    int nN, nunits, G, c; const PG8_LAS int* tile_e;
    __device__ __forceinline__ bool next(int i, Unit& u) const {
        const long L = (long)i * G + c; if (L >= nunits) return false;
        const int tile = (int)L / nN; u.pm = tile; u.pn = (int)L % nN; u.e = __builtin_amdgcn_readfirstlane(tile_e[tile]); return true;
    }
    __device__ __forceinline__ void a_ready(const Unit&) const {}
    __device__ __forceinline__ void done(const Unit&) const {}
};

template <class Epi, class Sched, bool ALIGN_EPI = false, bool SP2 = false>
__device__ __forceinline__ void gemm_phase(PG8_LAS unsigned char* lds, const Gemm g, const Sched& S, const Epi& E, const int tid) {
    const int wid = __builtin_amdgcn_readfirstlane(tid >> 6), lane = tid & 63, wr = wid >> 2, wc = wid & 3, fr = lane & 15, fq = lane >> 4;
    const int K = g.K, nt = K / BK;
    unsigned voffA[2], voffB[2];
#pragma unroll
    for (int i = 0; i < 2; ++i) { int R, C; stage_rc(tid * 16 + i * 8192, R, C); const int Rb = Epi::PERM ? ((R & ~31) + perm32(R & 31)) : R;
        voffA[i] = (unsigned)(R * K + C) * 2u; voffB[i] = (unsigned)(Rb * K + C) * 2u; }
    const size_t kstep = (size_t)(BK * 2);
    const size_t hstep = (size_t)HALF * K * 2;
    const size_t tstep = 2 * hstep;
    const unsigned ldsw = (unsigned)wid * 1024u;
    const int aoff = lds_byte(wr * 64 + fr, fq * 8), boff = lds_byte(wc * 32 + fr, fq * 8);
#define PG8_SA(b, h) (((b) * 2 + (h)) * HTB)
#define PG8_SB(b, h) ((4 + (b) * 2 + (h)) * HTB)
#define PG8_STAGE(bufoff, gbase, voff) do { _Pragma("unroll") for (int _i = 0; _i < 2; ++_i) \
        __builtin_amdgcn_global_load_lds((const unsigned*)((const char*)(gbase) + (voff)[_i]), (PG8_LAS unsigned*)(lds + (bufoff) + ldsw + _i * 8192), 16, 0, 0); } while (0)
#define PG8_LDA(dst, b, h) do { _Pragma("unroll") for (int m = 0; m < 4; ++m) _Pragma("unroll") for (int k = 0; k < 2; ++k) dst[m][k] = *(const PG8_LAS bf16x8*)(lds + PG8_SA(b, h) + aoff + m * 2048 + k * 1024); } while (0)
#define PG8_LDB(dst, b, h) do { _Pragma("unroll") for (int n = 0; n < 2; ++n) _Pragma("unroll") for (int k = 0; k < 2; ++k) dst[n][k] = *(const PG8_LAS bf16x8*)(lds + PG8_SB(b, h) + boff + n * 2048 + k * 1024); } while (0)
#define PG8_MMA(ai, bj, At, Bt) do { __builtin_amdgcn_s_setprio(1); _Pragma("unroll") for (int m = 0; m < 4; ++m) _Pragma("unroll") for (int n = 0; n < 2; ++n) _Pragma("unroll") for (int k = 0; k < 2; ++k) \
        acc[ai][bj][m][n] = __builtin_amdgcn_mfma_f32_16x16x32_bf16(Bt[n][k], At[m][k], acc[ai][bj][m][n], 0, 0, 0); __builtin_amdgcn_s_setprio(0); } while (0)
#define PG8_WAIT_V(n) asm volatile("s_waitcnt vmcnt(" #n ")" ::: "memory")
#define PG8_WAIT_L(n) asm volatile("s_waitcnt lgkmcnt(" #n ")" ::: "memory")
#define PG8_BAR __builtin_amdgcn_s_barrier()
#define PG8_SCHED __builtin_amdgcn_sched_barrier(0)
    Unit cur, nxt; int ui = 0;
    if (!S.next(0, cur)) return;
    f32x4 acc[2][2][4][2];
#pragma unroll
    for (int a = 0; a < 2; ++a)
#pragma unroll
        for (int b = 0; b < 2; ++b)
#pragma unroll
            for (int m = 0; m < 4; ++m)
#pragma unroll
                for (int n = 0; n < 2; ++n) acc[a][b][m][n] = (f32x4){0.f, 0.f, 0.f, 0.f};
    bf16x8 At[4][2], B0[2][2], B1[2][2];
    const char* cA = (const char*)g.A + (size_t)cur.pm * tstep; const char* cB = (const char*)g.Bt + (size_t)cur.pn * tstep + (size_t)cur.e * g.bstride;
    S.a_ready(cur);
    if constexpr (SP2) {
        PG8_STAGE(PG8_SB(0, 0), cB, voffB); PG8_STAGE(PG8_SB(0, 1), cB + hstep, voffB); PG8_STAGE(PG8_SA(0, 0), cA, voffA); PG8_STAGE(PG8_SA(0, 1), cA + hstep, voffA);
        if (wr == 1) PG8_BAR;
        PG8_WAIT_V(2); PG8_BAR;
        PG8_STAGE(PG8_SB(1, 0), cB + kstep, voffB); PG8_STAGE(PG8_SA(1, 0), cA + kstep, voffA); PG8_STAGE(PG8_SB(1, 1), cB + hstep + kstep, voffB);
        PG8_WAIT_V(6); PG8_BAR;
    } else {
        PG8_STAGE(PG8_SB(0, 0), cB, voffB); PG8_STAGE(PG8_SA(0, 0), cA, voffA); PG8_STAGE(PG8_SB(0, 1), cB + hstep, voffB); PG8_STAGE(PG8_SA(0, 1), cA + hstep, voffA);
        if (wr == 1) PG8_BAR;
        PG8_WAIT_V(4); PG8_BAR;
        PG8_STAGE(PG8_SB(1, 0), cB + kstep, voffB); PG8_STAGE(PG8_SA(1, 0), cA + kstep, voffA); PG8_STAGE(PG8_SB(1, 1), cB + hstep + kstep, voffB);
        PG8_WAIT_V(6); PG8_BAR;
    }
    for (;;) {
        const bool has_next = S.next(ui + 1, nxt);
        const char* nA = has_next ? (const char*)g.A + (size_t)nxt.pm * tstep : cA; const char* nB = has_next ? (const char*)g.Bt + (size_t)nxt.pn * tstep + (size_t)nxt.e * g.bstride : cB;
        for (int t = 0; t < nt; t += 2) {
            const bool last = (t == nt - 2);
            const char* a1 = cA + (size_t)(t + 1) * kstep;
            const char* a2 = last ? nA : cA + (size_t)(t + 2) * kstep; const char* b2 = last ? nB : cB + (size_t)(t + 2) * kstep;
            const char* a3 = a2 + kstep; const char* b3 = b2 + kstep;
            if (last && has_next) S.a_ready(nxt);
            if constexpr (SP2) {
            PG8_LDB(B0, 0, 0); PG8_LDB(B1, 0, 1); PG8_SCHED; PG8_LDA(At, 0, 0); PG8_STAGE(PG8_SA(1, 1), a1 + hstep, voffA);
            PG8_WAIT_V(8); PG8_WAIT_L(0); PG8_BAR; PG8_MMA(0, 0, At, B0); PG8_MMA(0, 1, At, B1); PG8_BAR; PG8_SCHED;
            PG8_LDA(At, 0, 1); PG8_STAGE(PG8_SB(0, 0), b2, voffB); PG8_STAGE(PG8_SB(0, 1), b2 + hstep, voffB); PG8_STAGE(PG8_SA(0, 0), a2, voffA);
            PG8_WAIT_V(8); PG8_WAIT_L(0); PG8_BAR; PG8_MMA(1, 0, At, B0); PG8_MMA(1, 1, At, B1); PG8_BAR; PG8_SCHED;
            PG8_LDB(B0, 1, 0); PG8_LDB(B1, 1, 1); PG8_SCHED; PG8_LDA(At, 1, 0); PG8_STAGE(PG8_SA(0, 1), a2 + hstep, voffA);
            PG8_WAIT_V(8); PG8_WAIT_L(0); PG8_BAR; PG8_MMA(0, 0, At, B0); PG8_MMA(0, 1, At, B1); PG8_BAR; PG8_SCHED;
            PG8_LDA(At, 1, 1); PG8_STAGE(PG8_SB(1, 0), b3, voffB); PG8_STAGE(PG8_SB(1, 1), b3 + hstep, voffB); PG8_STAGE(PG8_SA(1, 0), a3, voffA);
            PG8_WAIT_V(8); PG8_WAIT_L(0); PG8_BAR; PG8_MMA(1, 0, At, B0); PG8_MMA(1, 1, At, B1); PG8_BAR; PG8_SCHED;
            } else {
            PG8_LDB(B0, 0, 0); PG8_SCHED; PG8_LDA(At, 0, 0); PG8_STAGE(PG8_SA(1, 1), a1 + hstep, voffA);
            PG8_WAIT_L(8); PG8_BAR; PG8_WAIT_L(0); PG8_MMA(0, 0, At, B0); PG8_BAR; PG8_SCHED;
            PG8_LDB(B1, 0, 1); PG8_STAGE(PG8_SB(0, 0), b2, voffB);
            PG8_BAR; PG8_WAIT_L(0); PG8_MMA(0, 1, At, B1); PG8_BAR;
            PG8_LDA(At, 0, 1); PG8_STAGE(PG8_SA(0, 0), a2, voffA);
            PG8_BAR; PG8_WAIT_L(0); PG8_MMA(1, 0, At, B0); PG8_BAR; PG8_SCHED;
            PG8_STAGE(PG8_SB(0, 1), b2 + hstep, voffB);
            PG8_WAIT_V(6); PG8_BAR; PG8_MMA(1, 1, At, B1); PG8_BAR;
            PG8_LDB(B0, 1, 0); PG8_SCHED; PG8_LDA(At, 1, 0); PG8_STAGE(PG8_SA(0, 1), a2 + hstep, voffA);
            PG8_WAIT_L(8); PG8_BAR; PG8_WAIT_L(0); PG8_MMA(0, 0, At, B0); PG8_BAR; PG8_SCHED;
            PG8_LDB(B1, 1, 1); PG8_STAGE(PG8_SB(1, 0), b3, voffB);
            PG8_BAR; PG8_WAIT_L(0); PG8_MMA(0, 1, At, B1); PG8_BAR;
            PG8_LDA(At, 1, 1); PG8_STAGE(PG8_SA(1, 0), a3, voffA);
            PG8_BAR; PG8_WAIT_L(0); PG8_MMA(1, 0, At, B0); PG8_BAR; PG8_SCHED;
            PG8_STAGE(PG8_SB(1, 1), b3 + hstep, voffB);
            PG8_WAIT_V(6); PG8_BAR; PG8_MMA(1, 1, At, B1); PG8_BAR;
            }
        }
        if constexpr (ALIGN_EPI) { if (wr == 0) PG8_BAR; }
        if constexpr (!Epi::AFTER_DRAIN) { E(acc, cur, wr, wc, fr, fq); S.done(cur); }
        if (!has_next) break;
#pragma unroll
        for (int a = 0; a < 2; ++a)
#pragma unroll
            for (int b = 0; b < 2; ++b)
#pragma unroll
                for (int m = 0; m < 4; ++m)
#pragma unroll
                    for (int n = 0; n < 2; ++n) acc[a][b][m][n] = (f32x4){0.f, 0.f, 0.f, 0.f};
        cur = nxt; cA = nA; cB = nB; ++ui;
        if constexpr (ALIGN_EPI) { if (wr == 1) PG8_BAR; }
    }
    PG8_WAIT_V(0);
    if constexpr (!ALIGN_EPI) { if (wr == 0) PG8_BAR; }
    PG8_BAR;
    if constexpr (Epi::AFTER_DRAIN) { E.fused(acc, cur, wr, wc, fr, fq, lds, wid, lane); S.done(cur); }
#undef PG8_SA
#undef PG8_SB
#undef PG8_STAGE
#undef PG8_LDA
#undef PG8_LDB
#undef PG8_MMA
#undef PG8_WAIT_V
#undef PG8_WAIT_L
#undef PG8_BAR
#undef PG8_SCHED
}
}


namespace att {
typedef unsigned short bf16_t;
typedef short bf16x8 __attribute__((ext_vector_type(8)));
typedef short s16x4 __attribute__((ext_vector_type(4)));
typedef float f32x16 __attribute__((ext_vector_type(16)));
typedef unsigned u32x4 __attribute__((ext_vector_type(4)));
#define ALAS __attribute__((address_space(3)))
typedef ALAS unsigned char* ALAS_PTR;
#define ASBAR() __builtin_amdgcn_sched_barrier(0)
constexpr int QBLK = 32, KVBLK = 64;
constexpr float THR2 = 11.0f;
constexpr float LOG2E = 1.4426950408889634f, INV2PI = 0.15915494309189535f, LOG2_THETA = 13.287712379549449f;
constexpr int OFF_V = 0, VBUF = 8192, OFF_K = 16384, KBUF_MAX = 13312, OFF_WS = OFF_K + 2 * KBUF_MAX  , OFF_BIAS = OFF_WS + 2048  , ATT_LDS = OFF_BIAS + 2048;
__device__ __forceinline__ int crow(int r, int hi) { return (r & 3) + 8 * (r >> 2) + 4 * hi; }
__device__ __forceinline__ unsigned cvtpk(float lo, float hi) { unsigned r; asm volatile("v_cvt_pk_bf16_f32 %0, %1, %2" : "=v"(r) : "v"(lo), "v"(hi)); return r; }
__device__ __forceinline__ float bf2f(short s) { return __uint_as_float(((unsigned)(unsigned short)s) << 16); }
__device__ __forceinline__ short f2bf_s(float f) { return (short)(cvtpk(f, 0.f) & 0xffffu); }

struct UnitP {
    const bf16_t* Q; int ldq;
    const bf16_t* K0; int ldk0;
    const bf16_t* K1; int ldk1;
    const bf16_t* V; int ldv;
    bf16_t* O; int ldo;
    int nt;
    int grow0;
    const float* gain;
    int kr0;
};

template <int OFF> __device__ __forceinline__ s16x4 tr_read(int vb) { s16x4 r; asm volatile("ds_read_b64_tr_b16 %0, %1 offset:%2" : "=&v"(r) : "v"(vb), "i"(OFF) : "memory"); return r; }
template <int D0> __device__ __forceinline__ void pv_one(f32x16& od, int vb, bf16x8 pa0, bf16x8 pa1, bf16x8 pa2, bf16x8 pa3) {
    const s16x4 l0 = tr_read<D0 * 4096 + 0>(vb), h0 = tr_read<D0 * 4096 + 512>(vb), l1 = tr_read<D0 * 4096 + 1024>(vb), h1 = tr_read<D0 * 4096 + 1536>(vb);
    const s16x4 l2 = tr_read<D0 * 4096 + 2048>(vb), h2 = tr_read<D0 * 4096 + 2560>(vb), l3 = tr_read<D0 * 4096 + 3072>(vb), h3 = tr_read<D0 * 4096 + 3584>(vb);
    asm volatile("s_waitcnt lgkmcnt(0)" ::: "memory"); ASBAR();
#define ATT_PK(L, H) (bf16x8){L[0], L[1], L[2], L[3], H[0], H[1], H[2], H[3]}
    od = __builtin_amdgcn_mfma_f32_32x32x16_bf16(pa0, ATT_PK(l0, h0), od, 0, 0, 0);
    od = __builtin_amdgcn_mfma_f32_32x32x16_bf16(pa1, ATT_PK(l1, h1), od, 0, 0, 0);
    od = __builtin_amdgcn_mfma_f32_32x32x16_bf16(pa2, ATT_PK(l2, h2), od, 0, 0, 0);
    od = __builtin_amdgcn_mfma_f32_32x32x16_bf16(pa3, ATT_PK(l3, h3), od, 0, 0, 0);
#undef ATT_PK
}
template <int DQK> __device__ __forceinline__ void qkt(f32x16& p0, f32x16& p1, const ALAS unsigned char* Ks, const bf16x8* qr, int r32, int hi) {
    constexpr int KST = DQK * 2 + 16;
    p0 = f32x16{}; p1 = f32x16{};
#pragma unroll
    for (int d0 = 0; d0 < DQK / 16; ++d0) { const int cb = (2 * d0 + hi) * 16;
        const bf16x8 b0 = *(const ALAS bf16x8*)(Ks + r32 * KST + cb);
        const bf16x8 b1 = *(const ALAS bf16x8*)(Ks + (32 + r32) * KST + cb);
        p0 = __builtin_amdgcn_mfma_f32_32x32x16_bf16(b0, qr[d0], p0, 0, 0, 0);
        p1 = __builtin_amdgcn_mfma_f32_32x32x16_bf16(b1, qr[d0], p1, 0, 0, 0); }
}
__device__ __forceinline__ void na_mask(f32x16& p0, f32x16& p1, const ALAS float* btab, int kr, int rq, int qc, int hi) {
    int r0 = rq - 4; r0 = r0 < 0 ? 0 : (r0 > 120 ? 120 : r0);
    const bool rowok = (kr >= r0) && (kr < r0 + 8);
    int c0 = qc - 8; c0 = c0 < 0 ? 0 : (c0 > 48 ? 48 : c0);
    int dr = kr - rq + 7; dr = dr < 0 ? 0 : (dr > 14 ? 14 : dr);
    const ALAS float* brow = btab + dr * 31;
#pragma unroll
    for (int r = 0; r < 16; ++r) {
        const int ka = crow(r, hi), kb = 32 + ka;
        int ia = ka - qc + 15; ia = ia < 0 ? 0 : (ia > 30 ? 30 : ia);
        int ib = kb - qc + 15; ib = ib < 0 ? 0 : (ib > 30 ? 30 : ib);
        const bool oka = rowok && (ka >= c0) && (ka < c0 + 16), okb = rowok && (kb >= c0) && (kb < c0 + 16);
        p0[r] = oka ? p0[r] + brow[ia] : -1e30f;
        p1[r] = okb ? p1[r] + brow[ib] : -1e30f;
    }
}
__device__ __forceinline__ void partialSM(f32x16& p0, f32x16& p1, float& m_reg, float& alpha) {
    float pmax = p0[0];
#pragma unroll
    for (int r = 1; r < 16; ++r) pmax = fmaxf(pmax, p0[r]);
#pragma unroll
    for (int r = 0; r < 16; ++r) pmax = fmaxf(pmax, p1[r]);
    { auto rr = __builtin_amdgcn_permlane32_swap(__float_as_uint(pmax), __float_as_uint(pmax), false, false);
      pmax = fmaxf(__uint_as_float(rr[0]), __uint_as_float(rr[1])); }
    float mn;
    if (__builtin_expect(__all(pmax - m_reg <= THR2), 1)) { mn = m_reg; alpha = 1.f; }
    else { mn = fmaxf(m_reg, pmax); alpha = __builtin_amdgcn_exp2f(m_reg - mn); m_reg = mn; }
#pragma unroll
    for (int r = 0; r < 16; ++r) { p0[r] = p0[r] - mn; p1[r] = p1[r] - mn; }
#pragma unroll
    for (int r = 0; r < 16; ++r) p0[r] = __builtin_amdgcn_exp2f(p0[r]);
}
__device__ __forceinline__ void finishSM(f32x16& p0, f32x16& p1, float alpha, float& l_reg, bf16x8& pa0, bf16x8& pa1, bf16x8& pa2, bf16x8& pa3) {
#pragma unroll
    for (int r = 0; r < 16; ++r) p1[r] = __builtin_amdgcn_exp2f(p1[r]);
    float ps = 0.f;
#pragma unroll
    for (int r = 0; r < 16; ++r) ps += p0[r];
#pragma unroll
    for (int r = 0; r < 16; ++r) ps += p1[r];
    { auto rr = __builtin_amdgcn_permlane32_swap(__float_as_uint(ps), __float_as_uint(ps), false, false);
      ps = __uint_as_float(rr[0]) + __uint_as_float(rr[1]); }
    l_reg = l_reg * alpha + ps;
    u32x4 w;
    w = (u32x4){cvtpk(p0[0], p0[1]), cvtpk(p0[2], p0[3]), cvtpk(p0[4], p0[5]), cvtpk(p0[6], p0[7])}; pa0 = __builtin_bit_cast(bf16x8, w);
    w = (u32x4){cvtpk(p0[8], p0[9]), cvtpk(p0[10], p0[11]), cvtpk(p0[12], p0[13]), cvtpk(p0[14], p0[15])}; pa1 = __builtin_bit_cast(bf16x8, w);
    w = (u32x4){cvtpk(p1[0], p1[1]), cvtpk(p1[2], p1[3]), cvtpk(p1[4], p1[5]), cvtpk(p1[6], p1[7])}; pa2 = __builtin_bit_cast(bf16x8, w);
    w = (u32x4){cvtpk(p1[8], p1[9]), cvtpk(p1[10], p1[11]), cvtpk(p1[12], p1[13]), cvtpk(p1[14], p1[15])}; pa3 = __builtin_bit_cast(bf16x8, w);
}

template <int DQK, int MODE>
__device__ __forceinline__ void attn_unit(const UnitP& u, ALAS unsigned char* lds, const int tid) {
    constexpr int ND = DQK / 16, KST = DQK * 2 + 16, KBUF = 64 * KST;
    static_assert(KBUF <= KBUF_MAX, "K buffer");
    const int wid = __builtin_amdgcn_readfirstlane(tid >> 6), lane = tid & 63, r32 = lane & 31, hi = lane >> 5;
    ALAS unsigned char* V_lds = lds + OFF_V; ALAS unsigned char* K_lds = lds + OFF_K;
    ALAS float* ws = (ALAS float*)(lds + OFF_WS) + wid * 64; ALAS float* li_l = ws; ALAS float* al_l = ws + 32;
    const ALAS float* btab = (const ALAS float*)(lds + OFF_BIAS);
    float m_reg = -1e30f, l_reg = 0.f; f32x16 o[2]; o[0] = f32x16{}; o[1] = f32x16{}; bf16x8 qr[ND];
    const int grow = u.grow0 + (wid >> 1), gcol = (wid & 1) * 32 + r32;
    {
        const bf16_t* Qw = u.Q + (size_t)(wid * QBLK + r32) * u.ldq + hi * 8;
#pragma unroll
        for (int d0 = 0; d0 < ND; ++d0) qr[d0] = *(const bf16x8*)(Qw + d0 * 16);
        if constexpr (MODE == 0) {
            float x[4][8]; float ssq = 0.f;
#pragma unroll
            for (int d0 = 0; d0 < 4; ++d0)
#pragma unroll
                for (int j = 0; j < 8; ++j) { x[d0][j] = bf2f(qr[d0][j]); ssq += x[d0][j] * x[d0][j]; }
            ssq += __shfl_xor(ssq, 32);
            const float rstd = 1.0f / sqrtf(ssq * (1.0f / 64.0f) + 1e-6f);
#pragma unroll
            for (int d0 = 0; d0 < 4; ++d0)
#pragma unroll
                for (int j = 0; j < 8; ++j) x[d0][j] = x[d0][j] * rstd * u.gain[16 * d0 + 8 * hi + j];
#pragma unroll
            for (int d0 = 0; d0 < 2; ++d0)
#pragma unroll
                for (int j = 0; j < 8; ++j) { const float inv = exp2f(-(float)(8 * hi + j) * (LOG2_THETA / 16.0f));
                    const float ang = (float)(d0 == 0 ? grow : gcol) * inv * INV2PI; const float c = __builtin_amdgcn_cosf(ang), s = __builtin_amdgcn_sinf(ang);
                    const float y1 = x[d0][j], y2 = x[d0 + 2][j]; x[d0][j] = y1 * c - y2 * s; x[d0 + 2][j] = y1 * s + y2 * c; }
            constexpr float C2 = 0.125f * LOG2E;
#pragma unroll
            for (int d0 = 0; d0 < 4; ++d0) { u32x4 w = {cvtpk(x[d0][0] * C2, x[d0][1] * C2), cvtpk(x[d0][2] * C2, x[d0][3] * C2), cvtpk(x[d0][4] * C2, x[d0][5] * C2), cvtpk(x[d0][6] * C2, x[d0][7] * C2)};
                qr[d0] = __builtin_bit_cast(bf16x8, w); }
        }
        if constexpr (MODE == 1) {
            float y1[8], y2[8];
#pragma unroll
            for (int j = 0; j < 8; ++j) { const float inv = exp2f(-(float)j * (LOG2_THETA / 8.0f));
                const float ang = (float)(hi == 0 ? grow : gcol) * inv * INV2PI; const float c = __builtin_amdgcn_cosf(ang), s = __builtin_amdgcn_sinf(ang);
                const float a = bf2f(qr[4][j]), b = bf2f(qr[5][j]); y1[j] = a * c - b * s; y2[j] = a * s + b * c; }
            u32x4 w = {cvtpk(y1[0], y1[1]), cvtpk(y1[2], y1[3]), cvtpk(y1[4], y1[5]), cvtpk(y1[6], y1[7])}; qr[4] = __builtin_bit_cast(bf16x8, w);
            w = (u32x4){cvtpk(y2[0], y2[1]), cvtpk(y2[2], y2[3]), cvtpk(y2[4], y2[5]), cvtpk(y2[6], y2[7])}; qr[5] = __builtin_bit_cast(bf16x8, w);
        }
    }
    const int sk = tid >> 3, sc = tid & 7;
    const bf16_t* vsrc = u.V + (size_t)sk * u.ldv + sc * 8; const bf16_t* ksrc = u.K0 + (size_t)sk * u.ldk0 + sc * 8;
    const int vst = (sc >> 2) * 4096 + sk * 64 + (sc & 3) * 16, kst = sk * KST + sc * 16;
    const int sk2 = (tid & 255) >> 2, sc2 = tid & 3;
    const bf16_t* k2src = (DQK == 96) ? u.K1 + (size_t)sk2 * u.ldk1 + sc2 * 8 : nullptr;
    const int k2st = sk2 * KST + (8 + sc2) * 16;
    const int vb0 = (int)(unsigned)(size_t)V_lds + ((lane >> 4) & 1) * 32 + (lane & 3) * 8 + (4 * hi + ((lane & 15) >> 2)) * 64;
    struct { bf16x8 v, k, k2; } sr_[2];
#define ATT_SLOAD(i, k0) do { sr_[i].v = *(const bf16x8*)(vsrc + (size_t)(k0) * u.ldv); sr_[i].k = *(const bf16x8*)(ksrc + (size_t)(k0) * u.ldk0); \
        if constexpr (DQK == 96) sr_[i].k2 = *(const bf16x8*)(k2src + (size_t)(k0) * u.ldk1); } while (0)
#define ATT_SWRITE(b, i) do { *(ALAS bf16x8*)(V_lds + (b) * VBUF + vst) = sr_[i].v; *(ALAS bf16x8*)(K_lds + (b) * KBUF + kst) = sr_[i].k; \
        if constexpr (DQK == 96) *(ALAS bf16x8*)(K_lds + (b) * KBUF + k2st) = sr_[i].k2; } while (0)
#define ATT_SWAIT() do { if constexpr (DQK == 96) asm volatile("s_waitcnt vmcnt(3)" ::: "memory"); else asm volatile("s_waitcnt vmcnt(2)" ::: "memory"); } while (0)
#define ATT_RESC(a) do { if (__any((a) < 1.f)) { if (hi == 0) al_l[r32] = (a); asm volatile("s_waitcnt lgkmcnt(0)" ::: "memory"); \
        _Pragma("unroll") for (int d = 0; d < 2; ++d) _Pragma("unroll") for (int r = 0; r < 16; ++r) o[d][r] *= al_l[crow(r, hi)]; } } while (0)
#define ATT_MASK(P0, P1, j) do { if constexpr (MODE == 2) na_mask(P0, P1, btab, u.kr0 + (j), grow, gcol, hi); } while (0)
    f32x16 pA0, pA1, pB0, pB1; float alA, alB; bf16x8 pa0, pa1, pa2, pa3; const int NT = u.nt;
    constexpr int SE = 0, SO = 1;
    ATT_SLOAD(SE, 0); asm volatile("s_waitcnt vmcnt(0)" ::: "memory"); ATT_SWRITE(0, SE); __syncthreads();
    qkt<DQK>(pA0, pA1, K_lds, qr, r32, hi); ATT_MASK(pA0, pA1, 0); partialSM(pA0, pA1, m_reg, alA);
    ATT_SLOAD(SO, KVBLK); if (2 < NT) ATT_SLOAD(SE, 2 * KVBLK);
    ATT_SWAIT(); ATT_SWRITE(1, SO); __syncthreads();
    for (int j = 1; j + 1 < NT; j += 2) {
        ASBAR(); qkt<DQK>(pB0, pB1, K_lds + KBUF, qr, r32, hi); ATT_MASK(pB0, pB1, j);
        finishSM(pA0, pA1, alA, l_reg, pa0, pa1, pa2, pa3); ASBAR();
        ATT_SLOAD(SO, (j + 2) * KVBLK); ASBAR();
        pv_one<0>(o[0], vb0, pa0, pa1, pa2, pa3); pv_one<1>(o[1], vb0, pa0, pa1, pa2, pa3); partialSM(pB0, pB1, m_reg, alB);
        __syncthreads(); ATT_SWAIT(); ATT_SWRITE(0, SE);
        ATT_RESC(alB); __syncthreads();
        ASBAR(); qkt<DQK>(pA0, pA1, K_lds, qr, r32, hi); ATT_MASK(pA0, pA1, j + 1);
        finishSM(pB0, pB1, alB, l_reg, pa0, pa1, pa2, pa3); ASBAR();
        if (j + 3 < NT) ATT_SLOAD(SE, (j + 3) * KVBLK); ASBAR();
        pv_one<0>(o[0], vb0 + VBUF, pa0, pa1, pa2, pa3); pv_one<1>(o[1], vb0 + VBUF, pa0, pa1, pa2, pa3); partialSM(pA0, pA1, m_reg, alA);
        __syncthreads(); ATT_SWAIT(); ATT_SWRITE(1, SO);
        ATT_RESC(alA); __syncthreads();
    }
    ASBAR(); qkt<DQK>(pB0, pB1, K_lds + KBUF, qr, r32, hi); ATT_MASK(pB0, pB1, NT - 1);
    finishSM(pA0, pA1, alA, l_reg, pa0, pa1, pa2, pa3); ASBAR();
    pv_one<0>(o[0], vb0, pa0, pa1, pa2, pa3); pv_one<1>(o[1], vb0, pa0, pa1, pa2, pa3); partialSM(pB0, pB1, m_reg, alB);
    __syncthreads(); ATT_RESC(alB);
    finishSM(pB0, pB1, alB, l_reg, pa0, pa1, pa2, pa3); ASBAR();
    pv_one<0>(o[0], vb0 + VBUF, pa0, pa1, pa2, pa3); pv_one<1>(o[1], vb0 + VBUF, pa0, pa1, pa2, pa3);
    if (hi == 0) li_l[r32] = l_reg; asm volatile("s_waitcnt lgkmcnt(0)" ::: "memory");
    bf16_t* Ow = u.O + (size_t)(wid * QBLK) * u.ldo;
#pragma unroll
    for (int r = 0; r < 16; ++r) { const int orow = crow(r, hi); const float rl = __builtin_amdgcn_rcpf(li_l[orow]);
#pragma unroll
        for (int d0 = 0; d0 < 2; ++d0) Ow[(size_t)orow * u.ldo + d0 * 32 + r32] = (bf16_t)f2bf_s(o[d0][r] * rl); }
    __syncthreads();
#undef ATT_SLOAD
#undef ATT_SWRITE
#undef ATT_SWAIT
#undef ATT_RESC
#undef ATT_MASK
}
}


constexpr int NWAVES = 8;
#ifndef MK_DEBUG
#define MK_DEBUG 0
#endif
#ifndef MK_DBG_IGNORE
#define MK_DBG_IGNORE 0
#endif
#ifndef MK_ONE_LAUNCH
#define MK_ONE_LAUNCH 0
#endif
constexpr int NB = 4, SEQ = 8192, T = NB * SEQ, D = 1024, DEPTH = 2, GW = 64;
constexpr int DIN = 5536, DINP = 5632;
constexpr int H_NAQ = 0, H_NAK = 384, H_NAV = 768, H_GQ = 1152, H_GK = 1536, H_GV = 1664, H_CQ = 1792, H_CKV = 2176, H_KR = 2432, H_GATE = 2464;
constexpr int NE = 32, TOPK = 4, FF = 1024, TK = T * TOPK;
constexpr int PSLOTS = TK + NE * 256;
constexpr int MAXTILES = PSLOTS / 256;
constexpr int LCAP = T;
constexpr float LN_EPS = 1e-5f, RMS_EPS = 1e-6f, DN_ALPHA = 1.4142135623730951f;
constexpr float LOG2E_F = 1.4426950408889634f;
constexpr int PPL = 11, NPH = 1 + DEPTH * PPL;

constexpr size_t MiB = 1u << 20;
constexpr size_t WS_CTL = 0, CTL_ZERO_BYTES = 1 * MiB;
constexpr size_t WB_IN = 0, WB_UQ = WB_IN + (size_t)DINP * 1024 * 2, WB_UKV = WB_UQ + (size_t)512 * 384 * 2, WB_BA = WB_UKV + (size_t)512 * 256 * 2,
                 WB_BB = WB_BA + (size_t)1024 * 384 * 2, WB_BC = WB_BB + (size_t)1024 * 384 * 2, WB_OUT = WB_BC + (size_t)1024 * 256 * 2,
                 WB_GU = WB_OUT + (size_t)1024 * 1024 * 2, WB_DN = WB_GU + (size_t)NE * 2048 * 1024 * 2, WB_LAYER = WB_DN + (size_t)NE * 1024 * 1024 * 2;
static_assert(WB_LAYER % 256 == 0, "weight block alignment");
constexpr size_t WS_W = 2 * MiB;
constexpr size_t WS_H = WS_W + 2 * WB_LAYER;
constexpr size_t SZ_H = (size_t)T * DINP * 2;
constexpr size_t WS_A2 = WS_H + SZ_H;
constexpr size_t A2_MIX = 0, A2_MIXED = A2_MIX + (size_t)T * 1024 * 4, A2_YA = A2_MIXED + (size_t)T * 1024 * 2, A2_YB = A2_YA + (size_t)T * 384 * 2,
                 A2_YC = A2_YB + (size_t)T * 384 * 2, A2_QC = A2_YC + (size_t)T * 256 * 2, A2_KVC = A2_QC + (size_t)T * 384 * 2, A2_KB = A2_KVC + (size_t)T * 512 * 2,
                 A2_CQN = A2_KB + (size_t)T * 128 * 2, A2_CKVN = A2_CQN + (size_t)T * 384 * 2, A2_KR = A2_CKVN + (size_t)T * 256 * 2, SZ_A2 = A2_KR + (size_t)T * 32 * 2;
static_assert(SZ_A2 >= (size_t)PSLOTS * 1024 * 2 && SZ_H >= (size_t)PSLOTS * 1024 * 2, "overlays fit");
constexpr size_t WS_X2 = WS_A2 + SZ_A2;
constexpr size_t WS_XB = WS_X2 + (size_t)T * D * 4;
constexpr size_t WS_X1 = WS_XB + (size_t)T * D * 2;
constexpr size_t WS_X1B = WS_X1 + (size_t)T * D * 4;
constexpr size_t WS_LT = WS_X1B + (size_t)T * D * 2;
constexpr size_t WS_LG = WS_LT + (size_t)NE * LCAP * 4;
constexpr size_t WS_TE = WS_LG + (size_t)NE * LCAP * 4;
constexpr size_t WS_TR = WS_TE + (size_t)T * 4 * 4;
constexpr size_t WS_SG = WS_TR + (size_t)T * 4 * 4;
constexpr size_t WS_END = WS_SG + (size_t)PSLOTS * 4;
constexpr int CW_BAR = 4096;
constexpr int CW_CNT = 16384;

constexpr int RING_BYTES = 131072, LDSCTL_OFF = RING_BYTES, MISC_OFF = LDSCTL_OFF + 64;
constexpr int TBL_OFF = LDSCTL_OFF + 256;
constexpr int TBL_START = TBL_OFF, TBL_TILEE = TBL_OFF + 512, TBL_RS = TBL_TILEE + 2304;
constexpr int LDS_BYTES = 147456;
static_assert(TBL_RS + 512 * 12 + 256 <= LDS_BYTES, "LDS map");

#define GAS __attribute__((address_space(1)))
#define LAS __attribute__((address_space(3)))
typedef unsigned short bf16;
typedef unsigned v4u __attribute__((ext_vector_type(4)));
typedef float f32x4 __attribute__((ext_vector_type(4)));
typedef GAS unsigned gu32;
#define RLX_AGENT __ATOMIC_RELAXED, __HIP_MEMORY_SCOPE_AGENT
#define LDS_WAIT() asm volatile("s_waitcnt lgkmcnt(0)" ::: "memory")
#define VM_WAIT() asm volatile("s_waitcnt vmcnt(0)" ::: "memory")
__device__ __forceinline__ unsigned f2bf(float f) { unsigned u = __builtin_bit_cast(unsigned, f); return (u + 0x7fffu + ((u >> 16) & 1u)) >> 16; }
__device__ __forceinline__ unsigned pk2(float lo, float hi) { return f2bf(lo) | (f2bf(hi) << 16); }
__device__ __forceinline__ float bflo(unsigned w) { return __uint_as_float(w << 16); }
__device__ __forceinline__ float bfhi(unsigned w) { return __uint_as_float(w & 0xffff0000u); }

#define XB_TMO      128
#define XB_XCNT(j)  (256  + 64 * (j))
#define XB_XSUB(j)  (1280 + 64 * (j))
#define XB_XGEN(j)  (2304 + 64 * (j))
#define XB_TOP      3328
#define XB_TOPGEN   3392
#define XCD_BAR_WORDS 3456
#define XB_SPIN_CAP (1u << 18)

__device__ __forceinline__ unsigned xb_ld(unsigned* p)              { return __hip_atomic_load(p, __ATOMIC_RELAXED, __HIP_MEMORY_SCOPE_AGENT); }
__device__ __forceinline__ unsigned xb_add(unsigned* p, unsigned v) { return __hip_atomic_fetch_add(p, v, __ATOMIC_RELAXED, __HIP_MEMORY_SCOPE_AGENT); }
__device__ __forceinline__ unsigned xb_xcc_id() { return (unsigned)__builtin_amdgcn_s_getreg((3 << 11) | 20) & 0xFu; }
#define XB_SPIN(cond, bar) do { unsigned _sp = 0; while (cond) { __builtin_amdgcn_s_sleep(1); \
    if ((++_sp & 255u) == 0u) { if (xb_ld(&(bar)[XB_TMO])) break; if (_sp > XB_SPIN_CAP) { atomicAdd(&(bar)[XB_TMO], 1u); break; } } } } while (0)

struct XcdBarrier {
    unsigned* bar; unsigned x;
    volatile LAS unsigned* st;
};

__device__ __forceinline__ XcdBarrier xcd_barrier_post(unsigned* bar, volatile LAS unsigned* st) {
    XcdBarrier b; b.bar = bar; b.x = xb_xcc_id(); b.st = st;
    if (threadIdx.x == 0) (void)xb_add(&bar[XB_XCNT(b.x)], 1u);
    return b;
}
__device__ __forceinline__ void xcd_barrier_complete(unsigned* bar, unsigned x, unsigned& nloc, unsigned& nx) {
    const unsigned G = gridDim.x * gridDim.y * gridDim.z;
    unsigned sum, cnt, mine, sp = 0u;
    for (;;) {
        sum = 0u; cnt = 0u; mine = 0u;
#pragma unroll
        for (unsigned j = 0; j < 16; ++j) { const unsigned c = xb_ld(&bar[XB_XCNT(j)]); sum += c; cnt += (c > 0u) ? 1u : 0u; mine = (j == x) ? c : mine; }
        if (sum == G) break;
        __builtin_amdgcn_s_sleep(1);
        if ((++sp & 255u) == 0u) { if (xb_ld(&bar[XB_TMO])) break; if (sp > XB_SPIN_CAP) { atomicAdd(&bar[XB_TMO], 1u); break; } }
    }
    nloc = mine > 0u ? mine : 1u; nx = cnt > 0u ? cnt : 1u;
}

__device__ __forceinline__ void xcd_barrier(const XcdBarrier& b) {
    asm volatile("s_waitcnt vmcnt(0)" ::: "memory");
    __syncthreads();
    if (threadIdx.x == 0) {
        unsigned* bar = b.bar;
        __builtin_amdgcn_s_waitcnt(0);
        unsigned nloc = b.st[0], nx = b.st[1];
        if (nloc == 0u) { xcd_barrier_complete(bar, b.x, nloc, nx); b.st[0] = nloc; b.st[1] = nx; }
        const unsigned old = xb_add(&bar[XB_XSUB(b.x)], 1u);
        const unsigned gen = old / nloc;
        if (old + 1u == (gen + 1u) * nloc) {
            __builtin_amdgcn_fence(__ATOMIC_RELEASE, "agent");
            asm volatile("s_waitcnt vmcnt(0)" ::: "memory");
            const unsigned og = xb_add(&bar[XB_TOP], 1u);
            const unsigned tg = og / nx;
            if (og + 1u == (tg + 1u) * nx) xb_add(&bar[XB_TOPGEN], 1u);
            else XB_SPIN(xb_ld(&bar[XB_TOPGEN]) == tg, bar);
            __builtin_amdgcn_fence(__ATOMIC_ACQUIRE, "agent");
            xb_add(&bar[XB_XGEN(b.x)], 1u);
            asm volatile("s_waitcnt vmcnt(0)" ::: "memory");
        } else {
            XB_SPIN(xb_ld(&bar[XB_XGEN(b.x)]) == gen, bar);
            __builtin_amdgcn_fence(__ATOMIC_ACQUIRE, "agent");
            asm volatile("s_waitcnt vmcnt(0)" ::: "memory");
        }
    }
    __syncthreads();
}


struct Frame {
    LAS unsigned char* lds;
    gu32* ctl;
    int tid, lane, wave;
    int vcu, G, bx;
    unsigned char* ws;
    float* out;
};
__device__ __forceinline__ const float* in_ptr(int i) {
    const void* base = (const void*)__builtin_amdgcn_kernarg_segment_ptr(); const GAS float* p;
    asm volatile("s_load_dwordx2 %0, %1, %2\n\ts_waitcnt lgkmcnt(0)" : "=s"(p) : "s"(base), "i"(i * 8) : "memory"); return (const float*)p;
}
#define INP(i) in_ptr(i)
template <int SITE> __device__ __forceinline__ Frame mkframe(LAS unsigned char* lds_in, unsigned char* ws_in, float* out_in, int wave_id, int bx0, int G0) {
    Frame F; int lane_;
    asm volatile("v_mbcnt_lo_u32_b32 %0, -1, 0\n\tv_mbcnt_hi_u32_b32 %0, -1, %0 ; site %1" : "=v"(lane_) : "n"(SITE));
    int bx = bx0, G = G0, wv = wave_id; asm volatile("; site %3" : "+s"(bx), "+s"(G), "+s"(wv) : "n"(SITE));
    GAS unsigned char* wsg = (GAS unsigned char*)ws_in; asm volatile("; site %1" : "+s"(wsg) : "n"(SITE)); unsigned char* ws = (unsigned char*)wsg;
    LAS unsigned char* l3 = lds_in; asm volatile("; site %1" : "+s"(l3) : "n"(SITE));
    const int tid = wv * 64 + lane_;
    F.lds = l3; F.tid = tid; F.lane = lane_; F.wave = wv;
    F.G = G; F.bx = bx; F.vcu = (G % 8 == 0) ? (bx % 8) * (G / 8) + bx / 8 : bx;
    F.ws = ws; F.ctl = (gu32*)(wsg + WS_CTL); F.out = out_in; return F;
}
__device__ __forceinline__ float wave_sum(float v) {
#pragma unroll
    for (int o = 1; o < 64; o <<= 1) v += __shfl_xor(v, o);
    return v;
}
__device__ __forceinline__ void tr_item(const float* W, int ldw, int K, int k0, int src_n0, bf16* WT, int dst_n0, float scale, LAS float* scr, int lane) {
#pragma unroll 8
    for (int i = 0; i < 32; ++i) { const int kk = 2 * i + (lane >> 5); scr[kk * 33 + (lane & 31)] = W[(size_t)(k0 + kk) * ldw + src_n0 + (lane & 31)]; }
    LDS_WAIT(); asm volatile("" ::: "memory");
    const int c = lane & 7;
#pragma unroll
    for (int j = 0; j < 4; ++j) { const int n = (lane >> 3) + 8 * j; const LAS float* s = scr + (8 * c) * 33 + n;
        v4u o; o.x = pk2(s[0 * 33] * scale, s[1 * 33] * scale); o.y = pk2(s[2 * 33] * scale, s[3 * 33] * scale); o.z = pk2(s[4 * 33] * scale, s[5 * 33] * scale); o.w = pk2(s[6 * 33] * scale, s[7 * 33] * scale);
        *(GAS v4u*)(WT + (size_t)(dst_n0 + n) * K + k0 + 8 * c) = o; }
    LDS_WAIT(); asm volatile("" ::: "memory");
}
template <int KIND> __device__ __forceinline__ void conv_matrix(Frame& F, const float* W, int K, int N, bf16* WT, float s, int gw, int NGW, LAS float* scr) {
    const int nnb = N / 32, nkb = K / 64, nit = nnb * nkb;
    for (int it = gw; it < nit; it += NGW) {
        const int kb = it / nnb, nb = it % nnb; const int dst_n0 = 32 * nb; int src_n0 = dst_n0; float sc = s;
        if (KIND == 1) sc = (dst_n0 < 384) ? s : 1.0f;
        if (KIND == 2) { const int p = dst_n0 >> 8, j = dst_n0 & 255; src_n0 = (j < 128) ? (128 * p + j) : (1024 + 128 * p + (j - 128)); }
        tr_item(W, N, K, 64 * kb, src_n0, WT, dst_n0, sc, scr, F.lane);
    }
}
__device__ __forceinline__ void zero_rows(bf16* WT, int K, int n_lo, int n_hi, int gtid, int nthr) {
    const size_t n16 = (size_t)(n_hi - n_lo) * K / 8; GAS v4u* p = (GAS v4u*)(WT + (size_t)n_lo * K);
    for (size_t i = gtid; i < n16; i += nthr) p[i] = (v4u){0u, 0u, 0u, 0u};
}
__device__ __forceinline__ void p_prologue(Frame& F) {
    LAS float* scr = (LAS float*)(F.lds + F.wave * 16384);
    const int gw0 = F.vcu * NWAVES + F.wave, NGW = F.G * NWAVES, gtid = F.bx * (NWAVES * 64) + F.tid, nthr = F.G * NWAVES * 64;
    for (int l = 0; l < DEPTH; ++l) {
        unsigned char* wb = F.ws + WS_W + (size_t)l * WB_LAYER;
        int gw = gw0;
#define ROT(n) do { gw = (gw + NGW - ((n) % NGW)) % NGW; } while (0)
        conv_matrix<1>(F, INP(1) + (size_t)l * 1024 * DIN, 1024, DIN, (bf16*)(wb + WB_IN), 0.125f * LOG2E_F, gw, NGW, scr); ROT(16 * 173);
        zero_rows((bf16*)(wb + WB_IN), 1024, DIN, DINP, gtid, nthr);
        conv_matrix<0>(F, INP(7) + (size_t)l * 384 * 384, 384, 384, (bf16*)(wb + WB_UQ), 0.10206207261596577f * LOG2E_F, gw, NGW, scr); ROT(72);
        zero_rows((bf16*)(wb + WB_UQ), 384, 384, 512, gtid, nthr);
        conv_matrix<0>(F, INP(8) + (size_t)l * 256 * 512, 256, 512, (bf16*)(wb + WB_UKV), 1.0f, gw, NGW, scr); ROT(64);
        conv_matrix<0>(F, INP(9) + (size_t)l * 384 * 1024, 384, 1024, (bf16*)(wb + WB_BA), 1.0f, gw, NGW, scr); ROT(192);
        conv_matrix<0>(F, INP(10) + (size_t)l * 384 * 1024, 384, 1024, (bf16*)(wb + WB_BB), 1.0f, gw, NGW, scr); ROT(192);
        conv_matrix<0>(F, INP(11) + (size_t)l * 256 * 1024, 256, 1024, (bf16*)(wb + WB_BC), 1.0f, gw, NGW, scr); ROT(128);
        conv_matrix<0>(F, INP(12) + (size_t)l * 1024 * 1024, 1024, 1024, (bf16*)(wb + WB_OUT), 1.0f, gw, NGW, scr); ROT(512);
        for (int e = 0; e < NE; ++e) {
            conv_matrix<2>(F, INP(17) + ((size_t)l * NE + e) * 1024 * 2048, 1024, 2048, (bf16*)(wb + WB_GU) + (size_t)e * 2048 * 1024, 1.0f, gw, NGW, scr);
            conv_matrix<0>(F, INP(19) + ((size_t)l * NE + e) * 1024 * 1024, 1024, 1024, (bf16*)(wb + WB_DN) + (size_t)e * 1024 * 1024, 1.0f, gw, NGW, scr);
        }
#undef ROT
    }
    { const GAS f32x4* xs = (const GAS f32x4*)INP(0); GAS v4u* xd = (GAS v4u*)(F.ws + WS_XB);
      for (size_t i = gtid; i < (size_t)T * D / 8; i += nthr) { const f32x4 a = xs[2 * i], b = xs[2 * i + 1]; xd[i] = (v4u){pk2(a.x, a.y), pk2(a.z, a.w), pk2(b.x, b.y), pk2(b.z, b.w)}; } }
}

__device__ __forceinline__ void p_prep(Frame& F, int l) {
    const bf16* hb = (const bf16*)(F.ws + WS_H); unsigned char* a2 = F.ws + WS_A2;
    bf16* kB = (bf16*)(a2 + A2_KB); bf16* cqn = (bf16*)(a2 + A2_CQN); bf16* ckvn = (bf16*)(a2 + A2_CKVN); bf16* kr = (bf16*)(a2 + A2_KR);
    const float* gk = INP(4) + l * 64; const float* gq = INP(5) + l * 384; const float* gkv = INP(6) + l * 256;
    const int lane = F.lane, gw = F.vcu * NWAVES + F.wave, NGW = F.G * NWAVES;
    for (int t = gw; t < T; t += NGW) {
        const bf16* hr = hb + (size_t)t * DINP; const int s = t & (SEQ - 1); const float prow = (float)(s >> 6), pcol = (float)(s & 63);
        {   float x[8]; float ssq = 0.f; const int cc = lane & 7;
            if (lane < 16) { const v4u w = *(const GAS v4u*)(hr + H_GK + lane * 8); x[0] = bflo(w.x); x[1] = bfhi(w.x); x[2] = bflo(w.y); x[3] = bfhi(w.y); x[4] = bflo(w.z); x[5] = bfhi(w.z); x[6] = bflo(w.w); x[7] = bfhi(w.w); }
            else {
#pragma unroll
                for (int j = 0; j < 8; ++j) x[j] = 0.f; }
#pragma unroll
            for (int j = 0; j < 8; ++j) ssq += x[j] * x[j];
            ssq += __shfl_xor(ssq, 1); ssq += __shfl_xor(ssq, 2); ssq += __shfl_xor(ssq, 4);
            const float rstd = 1.0f / sqrtf(ssq * (1.0f / 64.0f) + RMS_EPS);
            float y[8], o[8];
#pragma unroll
            for (int j = 0; j < 8; ++j) y[j] = x[j] * rstd * gk[(cc * 8 + j) & 63];
#pragma unroll
            for (int j = 0; j < 8; ++j) { const float other = __shfl_xor(y[j], 4); const int i = 8 * (cc & 3) + j;
                const float inv = exp2f(-(float)(i & 15) * (att::LOG2_THETA / 16.0f)); const float ang = ((i < 16) ? prow : pcol) * inv * att::INV2PI;
                const float c = __builtin_amdgcn_cosf(ang), sn = __builtin_amdgcn_sinf(ang);
                o[j] = (cc < 4) ? (y[j] * c - other * sn) : (other * sn + y[j] * c); }
            if (lane < 16) *(GAS v4u*)(kB + (size_t)t * 128 + lane * 8) = (v4u){pk2(o[0], o[1]), pk2(o[2], o[3]), pk2(o[4], o[5]), pk2(o[6], o[7])};
        }
        {   float x[8]; float ssq = 0.f;
            if (lane < 48) { const v4u w = *(const GAS v4u*)(hr + H_CQ + lane * 8); x[0] = bflo(w.x); x[1] = bfhi(w.x); x[2] = bflo(w.y); x[3] = bfhi(w.y); x[4] = bflo(w.z); x[5] = bfhi(w.z); x[6] = bflo(w.w); x[7] = bfhi(w.w); }
            else {
#pragma unroll
                for (int j = 0; j < 8; ++j) x[j] = 0.f; }
#pragma unroll
            for (int j = 0; j < 8; ++j) ssq += x[j] * x[j];
            ssq = wave_sum(ssq); const float rstd = 1.0f / sqrtf(ssq * (1.0f / 384.0f) + RMS_EPS);
            if (lane < 48) { float y[8];
#pragma unroll
                for (int j = 0; j < 8; ++j) y[j] = x[j] * rstd * gq[lane * 8 + j];
                *(GAS v4u*)(cqn + (size_t)t * 384 + lane * 8) = (v4u){pk2(y[0], y[1]), pk2(y[2], y[3]), pk2(y[4], y[5]), pk2(y[6], y[7])}; }
        }
        {   float x[8]; float ssq = 0.f;
            if (lane < 32) { const v4u w = *(const GAS v4u*)(hr + H_CKV + lane * 8); x[0] = bflo(w.x); x[1] = bfhi(w.x); x[2] = bflo(w.y); x[3] = bfhi(w.y); x[4] = bflo(w.z); x[5] = bfhi(w.z); x[6] = bflo(w.w); x[7] = bfhi(w.w); }
            else {
#pragma unroll
                for (int j = 0; j < 8; ++j) x[j] = 0.f; }
#pragma unroll
            for (int j = 0; j < 8; ++j) ssq += x[j] * x[j];
            ssq = wave_sum(ssq); const float rstd = 1.0f / sqrtf(ssq * (1.0f / 256.0f) + RMS_EPS);
            if (lane < 32) { float y[8];
#pragma unroll
                for (int j = 0; j < 8; ++j) y[j] = x[j] * rstd * gkv[lane * 8 + j];
                *(GAS v4u*)(ckvn + (size_t)t * 256 + lane * 8) = (v4u){pk2(y[0], y[1]), pk2(y[2], y[3]), pk2(y[4], y[5]), pk2(y[6], y[7])}; }
        }
        {   float x[8]; const int cc = lane & 3;
            if (lane < 4) { const v4u w = *(const GAS v4u*)(hr + H_KR + lane * 8); x[0] = bflo(w.x); x[1] = bfhi(w.x); x[2] = bflo(w.y); x[3] = bfhi(w.y); x[4] = bflo(w.z); x[5] = bfhi(w.z); x[6] = bflo(w.w); x[7] = bfhi(w.w); }
            else {
#pragma unroll
                for (int j = 0; j < 8; ++j) x[j] = 0.f; }
            float o[8];
#pragma unroll
            for (int j = 0; j < 8; ++j) { const float other = __shfl_xor(x[j], 2);
                const float inv = exp2f(-(float)j * (att::LOG2_THETA / 8.0f)); const float ang = (((cc & 1) == 0) ? prow : pcol) * inv * att::INV2PI;
                const float c = __builtin_amdgcn_cosf(ang), sn = __builtin_amdgcn_sinf(ang);
                o[j] = (cc < 2) ? (x[j] * c - other * sn) : (other * sn + x[j] * c); }
            if (lane < 4) *(GAS v4u*)(kr + (size_t)t * 32 + lane * 8) = (v4u){pk2(o[0], o[1]), pk2(o[2], o[3]), pk2(o[4], o[5]), pk2(o[6], o[7])};
        }
    }
}


__device__ __forceinline__ int build_tables(Frame& F, int l) {
    LAS int* st = (LAS int*)(F.lds + TBL_START); LAS int* cn = st + 33; LAS int* te = (LAS int*)(F.lds + TBL_TILEE);
    __syncthreads();
    if (F.tid < NE) cn[F.tid] = (int)__hip_atomic_load(F.ctl + CW_CNT + 64 * l + F.tid, RLX_AGENT);
    __syncthreads();
    if (F.tid == 0) { int s = 0; for (int e = 0; e < NE; ++e) { st[e] = s; s += ((cn[e] + 255) >> 8) << 8; } st[NE] = s; }
    __syncthreads();
    const int total = st[NE];
    for (int tile = F.tid; tile < (total >> 8); tile += NWAVES * 64) { int e = 0; for (int k = 1; k < NE; ++k) e += (tile * 256 >= st[k]) ? 1 : 0; te[tile] = e; }
    __syncthreads();
    return total;
}

__device__ __forceinline__ void p_ln1_router(Frame& F, int l) {
    float* x1 = (float*)(F.ws + WS_X1); bf16* x1b = (bf16*)(F.ws + WS_X1B);
    int* list_t = (int*)(F.ws + WS_LT); float* list_g = (float*)(F.ws + WS_LG); int* tok_e = (int*)(F.ws + WS_TE); int* tok_r = (int*)(F.ws + WS_TR);
    const float* wr = INP(15) + (size_t)l * 1024 * NE; const float* br = INP(16) + l * NE;
    const int lane = F.lane, tid = F.tid;
    LAS unsigned char* wl = F.lds;
    LAS int* sel_e = (LAS int*)(F.lds + TBL_RS); LAS float* sel_g = (LAS float*)(sel_e + 512); LAS int* sel_r = sel_e + 1024; LAS int* hist = sel_e + 1536; LAS int* base = hist + 32;
    __syncthreads();
    for (int idx = tid; idx < 1024 * 8; idx += NWAVES * 64) { const int k = idx >> 3, c = idx & 7, kp = (k & 3) * 256 + (k >> 2), cp = c ^ ((kp >> 1) & 7);
        *(LAS f32x4*)(wl + (kp * 8 + cp) * 16) = *(const GAS f32x4*)(wr + (size_t)k * NE + c * 4); }
    f32x4 lg[4], lb[4];
#pragma unroll
    for (int j = 0; j < 4; ++j) { lg[j] = ((const GAS f32x4*)(INP(13) + l * D))[64 * j + lane]; lb[j] = ((const GAS f32x4*)(INP(14) + l * D))[64 * j + lane]; }
    const float bias_e = br[(lane >> 1) & 31];
    const int sw = (lane >> 1) & 7;
    __syncthreads();
    for (int tile = F.bx; tile < T / 128; tile += F.G) {
        if (tid < 32) hist[tid] = 0;
        __syncthreads();
        for (int it = 0; it < 16; ++it) {
            const int tl = F.wave * 16 + it, t = tile * 128 + tl;
            GAS f32x4* xr = (GAS f32x4*)(x1 + (size_t)t * D) + lane;
            f32x4 v[4]; float s = 0.f;
#pragma unroll
            for (int j = 0; j < 4; ++j) { v[j] = xr[64 * j]; s += (v[j].x + v[j].y) + (v[j].z + v[j].w); }
            const float mean = wave_sum(s) * (1.f / D); float s2 = 0.f;
#pragma unroll
            for (int j = 0; j < 4; ++j) { v[j] = v[j] - mean; s2 += (v[j].x * v[j].x + v[j].y * v[j].y) + (v[j].z * v[j].z + v[j].w * v[j].w); }
            const float rstd = 1.f / sqrtf(wave_sum(s2) * (1.f / D) + LN_EPS);
            GAS unsigned long long* o8 = (GAS unsigned long long*)(x1b + (size_t)t * D) + lane;
#pragma unroll
            for (int j = 0; j < 4; ++j) { v[j] = v[j] * rstd * lg[j] + lb[j]; xr[64 * j] = v[j];
                o8[64 * j] = (unsigned long long)pk2(v[j].x, v[j].y) | ((unsigned long long)pk2(v[j].z, v[j].w) << 32); }
            float acc[32];
#pragma unroll
            for (int e = 0; e < 32; ++e) acc[e] = 0.f;
#pragma unroll
            for (int j = 0; j < 4; ++j)
#pragma unroll
                for (int i = 0; i < 4; ++i) { const float xv = v[j][i]; const int kp = i * 256 + 64 * j + lane;
#pragma unroll
                    for (int c = 0; c < 8; ++c) { const f32x4 w = *(const LAS f32x4*)(wl + (kp * 8 + (c ^ sw)) * 16);
                        acc[4 * c + 0] += xv * w.x; acc[4 * c + 1] += xv * w.y; acc[4 * c + 2] += xv * w.z; acc[4 * c + 3] += xv * w.w; } }
            float a16[16], a8[8], a4[4], a2[2], a1;
            { const bool b = (lane & 32) != 0;
#pragma unroll
              for (int i = 0; i < 16; ++i) { const float send = b ? acc[i] : acc[16 + i]; const float keep = b ? acc[16 + i] : acc[i]; a16[i] = keep + __shfl_xor(send, 32); } }
            { const bool b = (lane & 16) != 0;
#pragma unroll
              for (int i = 0; i < 8; ++i) { const float send = b ? a16[i] : a16[8 + i]; const float keep = b ? a16[8 + i] : a16[i]; a8[i] = keep + __shfl_xor(send, 16); } }
            { const bool b = (lane & 8) != 0;
#pragma unroll
              for (int i = 0; i < 4; ++i) { const float send = b ? a8[i] : a8[4 + i]; const float keep = b ? a8[4 + i] : a8[i]; a4[i] = keep + __shfl_xor(send, 8); } }
            { const bool b = (lane & 4) != 0;
#pragma unroll
              for (int i = 0; i < 2; ++i) { const float send = b ? a4[i] : a4[2 + i]; const float keep = b ? a4[2 + i] : a4[i]; a2[i] = keep + __shfl_xor(send, 4); } }
            { const bool b = (lane & 2) != 0; const float send = b ? a2[0] : a2[1]; const float keep = b ? a2[1] : a2[0]; a1 = keep + __shfl_xor(send, 2); }
            a1 += __shfl_xor(a1, 1);
            float val = a1 + bias_e; const int my_e = (lane >> 1) & 31;
            float sv[4]; int se[4];
#pragma unroll
            for (int r = 0; r < 4; ++r) { float bv = val; int be = my_e;
#pragma unroll
                for (int o = 2; o < 64; o <<= 1) { const float ov = __shfl_xor(bv, o); const int oe = __shfl_xor(be, o); if (ov > bv || (ov == bv && oe < be)) { bv = ov; be = oe; } }
                sv[r] = bv; se[r] = be; if (my_e == be) val = -INFINITY; }
            const float e1 = __expf(sv[1] - sv[0]), e2 = __expf(sv[2] - sv[0]), e3 = __expf(sv[3] - sv[0]); const float rs = 1.0f / (1.0f + e1 + e2 + e3);
            if (lane < 4) { const int ee = lane == 0 ? se[0] : lane == 1 ? se[1] : lane == 2 ? se[2] : se[3]; const float gg = (lane == 0 ? 1.0f : lane == 1 ? e1 : lane == 2 ? e2 : e3) * rs;
                const int a = tl * 4 + lane; sel_e[a] = ee; sel_g[a] = gg; sel_r[a] = __hip_atomic_fetch_add(&hist[ee], 1, __ATOMIC_RELAXED, __HIP_MEMORY_SCOPE_WORKGROUP); }
        }
        __syncthreads();
        if (tid < 32) base[tid] = (int)__hip_atomic_fetch_add(F.ctl + CW_CNT + 64 * l + tid, (unsigned)hist[tid], RLX_AGENT);
        __syncthreads();
        { const int a = tid, e = sel_e[a], rank = base[e] + sel_r[a], t = tile * 128 + (a >> 2);
          list_t[(size_t)e * LCAP + rank] = t; list_g[(size_t)e * LCAP + rank] = sel_g[a]; tok_e[t * 4 + (a & 3)] = e; tok_r[t * 4 + (a & 3)] = rank; }
        __syncthreads();
    }
}

__device__ __forceinline__ void p_gather(Frame& F, int l) {
    const int total = build_tables(F, l);
    LAS int* st = (LAS int*)(F.lds + TBL_START); LAS int* cn = st + 33;
    const bf16* x1b = (const bf16*)(F.ws + WS_X1B); bf16* xg = (bf16*)(F.ws + WS_H); float* sg = (float*)(F.ws + WS_SG);
    const int* list_t = (const int*)(F.ws + WS_LT); const float* list_g = (const float*)(F.ws + WS_LG);
    const int lane = F.lane, gw = F.vcu * NWAVES + F.wave, NGW = F.G * NWAVES;
    for (int s = gw; s < total; s += NGW) {
        const bool pr = (lane < NE) && (s >= st[lane & 31]);
        const int e = __popcll(__ballot(pr)) - 1; const int r = s - st[e];
        GAS v4u* dst = (GAS v4u*)(xg + (size_t)s * D);
        if (r < cn[e]) { const int t = list_t[(size_t)e * LCAP + r]; const GAS v4u* src = (const GAS v4u*)(x1b + (size_t)t * D);
            dst[lane] = src[lane]; dst[64 + lane] = src[64 + lane]; if (lane == 0) sg[s] = list_g[(size_t)e * LCAP + r]; }
        else { unsigned zz = 0u; asm volatile("" : "+v"(zz)); const v4u z4 = {zz, zz, zz, zz}; dst[lane] = z4; dst[64 + lane] = z4; if (lane == 0) sg[s] = 0.f; }
    }
}

__device__ __forceinline__ void p_ln2(Frame& F, int l, float* dst) {
    (void)build_tables(F, l);
    LAS int* st = (LAS int*)(F.lds + TBL_START);
    const float* x1 = (const float*)(F.ws + WS_X1); const bf16* yb = (const bf16*)(F.ws + WS_H); bf16* xb = (bf16*)(F.ws + WS_XB);
    const int* tok_e = (const int*)(F.ws + WS_TE); const int* tok_r = (const int*)(F.ws + WS_TR);
    const int lane = F.lane, gw = F.vcu * NWAVES + F.wave, NGW = F.G * NWAVES;
    f32x4 lg[4], lb[4];
#pragma unroll
    for (int j = 0; j < 4; ++j) { lg[j] = ((const GAS f32x4*)(INP(21) + l * D))[64 * j + lane]; lb[j] = ((const GAS f32x4*)(INP(22) + l * D))[64 * j + lane]; }
    float dmult = 1.0f;
#if MK_DEBUG
    if (l == DEPTH - 1) { const unsigned mask = __hip_atomic_load(F.ctl + 20000, RLX_AGENT) & ~(unsigned)(MK_DBG_IGNORE); if (mask) dmult = 1.0f + (float)(__ffs((int)mask) - 1); }
#endif
    for (int t = gw; t < T; t += NGW) {
        const GAS f32x4* xr = (const GAS f32x4*)(x1 + (size_t)t * D) + lane;
        f32x4 v[4];
#pragma unroll
        for (int j = 0; j < 4; ++j) v[j] = xr[64 * j] * DN_ALPHA;
#pragma unroll
        for (int k = 0; k < 4; ++k) { const int slot = st[tok_e[t * 4 + k]] + tok_r[t * 4 + k];
            const GAS unsigned long long* yr = (const GAS unsigned long long*)(yb + (size_t)slot * D) + lane;
#pragma unroll
            for (int j = 0; j < 4; ++j) { const unsigned long long w = yr[64 * j]; const unsigned lo = (unsigned)w, hi = (unsigned)(w >> 32);
                v[j].x += bflo(lo); v[j].y += bfhi(lo); v[j].z += bflo(hi); v[j].w += bfhi(hi); } }
        float s = 0.f;
#pragma unroll
        for (int j = 0; j < 4; ++j) s += (v[j].x + v[j].y) + (v[j].z + v[j].w);
        const float mean = wave_sum(s) * (1.f / D); float s2 = 0.f;
#pragma unroll
        for (int j = 0; j < 4; ++j) { v[j] = v[j] - mean; s2 += (v[j].x * v[j].x + v[j].y * v[j].y) + (v[j].z * v[j].z + v[j].w * v[j].w); }
        const float rstd = 1.f / sqrtf(wave_sum(s2) * (1.f / D) + LN_EPS);
        GAS f32x4* orow = (GAS f32x4*)(dst + (size_t)t * D) + lane; GAS unsigned long long* o8 = (GAS unsigned long long*)(xb + (size_t)t * D) + lane;
#pragma unroll
        for (int j = 0; j < 4; ++j) { v[j] = v[j] * rstd * lg[j] + lb[j]; orow[64 * j] = v[j] * dmult;
            o8[64 * j] = (unsigned long long)pk2(v[j].x, v[j].y) | ((unsigned long long)pk2(v[j].z, v[j].w) << 32); }
    }
}

__device__ __forceinline__ void p_attention(Frame& F, int l) {
    const bf16* hb = (const bf16*)(F.ws + WS_H); unsigned char* a2 = F.ws + WS_A2;
    const bf16* kB = (const bf16*)(a2 + A2_KB); const bf16* kr = (const bf16*)(a2 + A2_KR); const bf16* qc = (const bf16*)(a2 + A2_QC); const bf16* kvc = (const bf16*)(a2 + A2_KVC);
    bf16* ya = (bf16*)(a2 + A2_YA); bf16* yb = (bf16*)(a2 + A2_YB); bf16* yc = (bf16*)(a2 + A2_YC);
    att::ALAS_PTR lds = (att::ALAS_PTR)F.lds;
    __syncthreads();
    for (int idx = F.vcu; idx < 768; idx += F.G) {
        const int qi = idx >> 8, rem = idx & 255, bk = rem >> 5, qb = rem & 31, b = bk >> 1, kvh = bk & 1, head = kvh * 3 + qi;
        att::UnitP u; const size_t tb = (size_t)b * SEQ, tq = tb + (size_t)qb * 256;
        u.Q = hb + tq * DINP + H_GQ + head * 64; u.ldq = DINP; u.K0 = kB + tb * 128 + kvh * 64; u.ldk0 = 128; u.K1 = nullptr; u.ldk1 = 0;
        u.V = hb + tb * DINP + H_GV + kvh * 64; u.ldv = DINP; u.O = yb + tq * 384 + head * 64; u.ldo = 384; u.nt = SEQ / 64; u.grow0 = qb * 4; u.gain = INP(3) + l * 64; u.kr0 = 0;
        att::attn_unit<64, 0>(u, lds, F.tid);
    }
    for (int idx = F.vcu; idx < 512; idx += F.G) {
        const int rnd = idx >> 8, rem = idx & 255, p = (rem >> 5) * 2 + rnd, qb = rem & 31, b = p >> 2, h = p & 3;
        att::UnitP u; const size_t tb = (size_t)b * SEQ, tq = tb + (size_t)qb * 256;
        u.Q = qc + tq * 384 + h * 96; u.ldq = 384; u.K0 = kvc + tb * 512 + h * 128; u.ldk0 = 512; u.K1 = kr + tb * 32; u.ldk1 = 32;
        u.V = kvc + tb * 512 + h * 128 + 64; u.ldv = 512; u.O = yc + tq * 256 + h * 64; u.ldo = 256; u.nt = SEQ / 64; u.grow0 = qb * 4; u.gain = nullptr; u.kr0 = 0;
        att::attn_unit<96, 1>(u, lds, F.tid);
    }
    for (int idx = F.vcu; idx < 768; idx += F.G) {
        const int b = idx / 192, rem = idx % 192, h = rem >> 5, rg = rem & 31, R0 = rg * 4;
        int r_lo = R0 - 4; r_lo = r_lo < 0 ? 0 : (r_lo > 120 ? 120 : r_lo);
        int r_hi = R0 - 1; r_hi = (r_hi < 0 ? 0 : (r_hi > 120 ? 120 : r_hi)) + 8;
        if ((r_hi - r_lo) & 1) { if (r_hi < 128) ++r_hi; else --r_lo; }
        {
            LAS float* bt = (LAS float*)(F.lds + att::OFF_BIAS); const float* rp = INP(2) + ((size_t)l * 6 + h) * 465;
            if (F.tid < 465) bt[F.tid] = rp[F.tid] * LOG2E_F; }
        att::UnitP u; const size_t tb = (size_t)b * SEQ, tq = tb + (size_t)R0 * 64, tk = tb + (size_t)r_lo * 64;
        u.Q = hb + tq * DINP + H_NAQ + h * 64; u.ldq = DINP; u.K0 = hb + tk * DINP + H_NAK + h * 64; u.ldk0 = DINP; u.K1 = nullptr; u.ldk1 = 0;
        u.V = hb + tk * DINP + H_NAV + h * 64; u.ldv = DINP; u.O = ya + tq * 384 + h * 64; u.ldo = 384; u.nt = r_hi - r_lo; u.grow0 = R0; u.gain = nullptr; u.kr0 = r_lo;
        att::attn_unit<64, 2>(u, lds, F.tid);
    }
}


struct Args { const float* in[23]; float* out; unsigned char* ws; int ph_lo, ph_hi, use_bar, pad; };
__global__ void __launch_bounds__(NWAVES * 64, 2) mk_fwd(Args args) {
    extern __shared__ __attribute__((aligned(16))) unsigned char lds[];
    const int wave_id = __builtin_amdgcn_readfirstlane((int)threadIdx.x >> 6), bx0 = blockIdx.x, G0 = gridDim.x;
    {   LAS unsigned* z = (LAS unsigned*)((LAS unsigned char*)lds + LDSCTL_OFF); for (int u = threadIdx.x; u < (LDS_BYTES - LDSCTL_OFF) / 4; u += NWAVES * 64) z[u] = 0u; }
    __syncthreads();
    XcdBarrier bar; bar.bar = (unsigned*)(args.ws + WS_CTL) + CW_BAR; bar.x = 0; bar.st = nullptr;
    if (args.use_bar) bar = xcd_barrier_post((unsigned*)(args.ws + WS_CTL) + CW_BAR, (volatile LAS unsigned*)((LAS unsigned char*)lds + MISC_OFF));
    const int lo = args.ph_lo, hi = args.ph_hi;
#define IN(k) (lo <= (k) && (k) < hi)
#define SEAM(k) do { if (IN(k) && IN((k) + 1)) { XcdBarrier b_ = bar; { GAS unsigned* bb_ = (GAS unsigned*)b_.bar; asm volatile("; seam %1" : "+s"(bb_) : "n"(__COUNTER__)); b_.bar = (unsigned*)bb_; } xcd_barrier(b_); } } while (0)
#define FRAME() Frame F = mkframe<__COUNTER__>((LAS unsigned char*)lds, args.ws, args.out, wave_id, bx0, G0); unsigned char* ws = F.ws; unsigned char* a2 = ws + WS_A2; unsigned char* wb = ws + WS_W + (size_t)l * WB_LAYER; (void)a2; (void)wb

    if (IN(0)) { Frame F = mkframe<__COUNTER__>((LAS unsigned char*)lds, args.ws, args.out, wave_id, bx0, G0); p_prologue(F); } SEAM(0);

    for (int l = 0; l < DEPTH; ++l) {
        const int pb = 1 + l * PPL;
        if (IN(pb + 0)) { FRAME();
            pg8::Gemm g{(const bf16*)(ws + WS_XB), (const bf16*)(wb + WB_IN), T, DINP, 1024, 0}; pg8::StaticOrder S; S.init(T, DINP, F.G, F.bx);
            pg8::EpiStore E{(bf16*)(ws + WS_H), DINP, DINP};
            pg8::gemm_phase<pg8::EpiStore, pg8::StaticOrder, true, true>(F.lds, g, S, E, F.tid);
        } SEAM(pb + 0);
        if (IN(pb + 1)) { FRAME(); p_prep(F, l); } SEAM(pb + 1);
        if (IN(pb + 2)) {
            { FRAME(); pg8::Gemm g{(const bf16*)(a2 + A2_CQN), (const bf16*)(wb + WB_UQ), T, 512, 384, 0}; pg8::StaticOrder S; S.init(T, 512, F.G, F.bx);
              pg8::EpiStore E{(bf16*)(a2 + A2_QC), 384, 384};
              pg8::gemm_phase<pg8::EpiStore, pg8::StaticOrder, true, true>(F.lds, g, S, E, F.tid); }
            { FRAME(); pg8::Gemm g{(const bf16*)(a2 + A2_CKVN), (const bf16*)(wb + WB_UKV), T, 512, 256, 0}; pg8::StaticOrder S; S.init(T, 512, F.G, F.bx);
              pg8::EpiStore E{(bf16*)(a2 + A2_KVC), 512, 512};
              pg8::gemm_phase<pg8::EpiStore, pg8::StaticOrder, true, true>(F.lds, g, S, E, F.tid); }
        } SEAM(pb + 2);
        if (IN(pb + 3)) { FRAME(); p_attention(F, l); } SEAM(pb + 3);
        if (IN(pb + 4)) {
#define EFRAME() FRAME(); bf16* hb = (bf16*)(ws + WS_H); float* mix = (float*)(a2 + A2_MIX); bf16* mixed = (bf16*)(a2 + A2_MIXED); pg8::StaticOrder S; S.init(T, 1024, F.G, F.bx)
            { EFRAME(); pg8::Gemm g{(const bf16*)(a2 + A2_YA), (const bf16*)(wb + WB_BA), T, 1024, 384, 0}; pg8::EpiGate<0> E{hb + H_GATE, DINP, mix, mixed};
              pg8::gemm_phase<pg8::EpiGate<0>, pg8::StaticOrder, true, true>(F.lds, g, S, E, F.tid); }
            { EFRAME(); pg8::Gemm g{(const bf16*)(a2 + A2_YB), (const bf16*)(wb + WB_BB), T, 1024, 384, 0}; pg8::EpiGate<1> E{hb + H_GATE + 1024, DINP, mix, mixed};
              pg8::gemm_phase<pg8::EpiGate<1>, pg8::StaticOrder, true, true>(F.lds, g, S, E, F.tid); }
            { EFRAME(); pg8::Gemm g{(const bf16*)(a2 + A2_YC), (const bf16*)(wb + WB_BC), T, 1024, 256, 0}; pg8::EpiGate<2> E{hb + H_GATE + 2048, DINP, mix, mixed};
              pg8::gemm_phase<pg8::EpiGate<2>, pg8::StaticOrder, true, true>(F.lds, g, S, E, F.tid); }
        } SEAM(pb + 4);
        if (IN(pb + 5)) { FRAME(); const float* xcur = (l == 0) ? INP(0) : (const float*)(ws + WS_X2);
            pg8::Gemm g{(const bf16*)(a2 + A2_MIXED), (const bf16*)(wb + WB_OUT), T, 1024, 1024, 0}; pg8::StaticOrder S; S.init(T, 1024, F.G, F.bx);
            pg8::EpiResid E{xcur, (float*)(ws + WS_X1), DN_ALPHA};
            pg8::gemm_phase<pg8::EpiResid, pg8::StaticOrder, true, true>(F.lds, g, S, E, F.tid);
        } SEAM(pb + 5);
        if (IN(pb + 6)) { FRAME(); p_ln1_router(F, l); } SEAM(pb + 6);
        if (IN(pb + 7)) { FRAME(); p_gather(F, l); } SEAM(pb + 7);
        if (IN(pb + 8)) { FRAME();
            const int total = build_tables(F, l);
            pg8::Gemm g{(const bf16*)(ws + WS_H), (const bf16*)(wb + WB_GU), total, 2048, 1024, (size_t)2048 * 1024 * 2};
            pg8::MoeOrder S{8, (total >> 8) * 8, F.G, F.vcu, (const LAS int*)(F.lds + TBL_TILEE)};
            pg8::EpiSwiglu E{(bf16*)(ws + WS_A2), INP(18) + (size_t)l * NE * 2048};
            pg8::gemm_phase<pg8::EpiSwiglu, pg8::MoeOrder, true, true>(F.lds, g, S, E, F.tid);
        } SEAM(pb + 8);
        if (IN(pb + 9)) { FRAME();
            const int total = build_tables(F, l);
            pg8::Gemm g{(const bf16*)(ws + WS_A2), (const bf16*)(wb + WB_DN), total, 1024, 1024, (size_t)1024 * 1024 * 2};
            pg8::MoeOrder S{4, (total >> 8) * 4, F.G, F.vcu, (const LAS int*)(F.lds + TBL_TILEE)};
            pg8::EpiDown E{(bf16*)(ws + WS_H), INP(20) + (size_t)l * NE * 1024, (const float*)(ws + WS_SG)};
            pg8::gemm_phase<pg8::EpiDown, pg8::MoeOrder, true, true>(F.lds, g, S, E, F.tid);
        } SEAM(pb + 9);
        if (IN(pb + 10)) { FRAME(); p_ln2(F, l, (l == DEPTH - 1) ? F.out : (float*)(ws + WS_X2)); }
        if (l + 1 < DEPTH) SEAM(pb + 10);
    }
#undef IN
#undef SEAM
}


#if MK_DEBUG
constexpr int CW_DBG = 20000;
__device__ __forceinline__ float bfr(float f) { return __uint_as_float(f2bf(f) << 16); }
__device__ __forceinline__ float bfv(const bf16* p) { return __uint_as_float(((unsigned)*p) << 16); }
__device__ __forceinline__ unsigned hsh(unsigned x) { x ^= x >> 16; x *= 0x7feb352du; x ^= x >> 15; x *= 0x846ca68bu; x ^= x >> 16; return x; }
__device__ __forceinline__ bool close_(float got, float ref, float rel, float abs_) { return fabsf(got - ref) <= rel * fabsf(ref) + abs_; }
__device__ __forceinline__ void ropecs(int i, int quarter, int s, float& c, float& sn) {
    const float pos = (i < quarter) ? (float)(s >> 6) : (float)(s & 63); const int m = (i < quarter) ? i : i - quarter;
    const float inv = exp2f(-(float)m / (float)quarter * 13.287712379549449f); const float ang = pos * inv * 0.15915494309189535f; c = __builtin_amdgcn_cosf(ang); sn = __builtin_amdgcn_sinf(ang);
}
#define DBG_FAIL(bit) atomicOr((unsigned*)(ws + WS_CTL) + CW_DBG, 1u << (bit))
template <int stage> __global__ void __launch_bounds__(256) dbg_kernel(Args args) {
    unsigned char* ws = args.ws; const int l = 0;
    const int gid = blockIdx.x * 256 + threadIdx.x;
    const bf16* hb = (const bf16*)(ws + WS_H); unsigned char* a2 = ws + WS_A2; unsigned char* wb = ws + WS_W + (size_t)l * WB_LAYER;
    const bf16* kB = (const bf16*)(a2 + A2_KB); const bf16* cqn = (const bf16*)(a2 + A2_CQN); const bf16* ckvn = (const bf16*)(a2 + A2_CKVN); const bf16* kr = (const bf16*)(a2 + A2_KR);
    const bf16* qc = (const bf16*)(a2 + A2_QC); const bf16* kvc = (const bf16*)(a2 + A2_KVC);
    const bf16* ya = (const bf16*)(a2 + A2_YA); const bf16* yb = (const bf16*)(a2 + A2_YB); const bf16* yc = (const bf16*)(a2 + A2_YC);
    const unsigned h1 = hsh(gid * 2654435761u + 12345u + stage * 977u), h2 = hsh(h1 + 0x9e3779b9u);
    const int t = h1 % T, s = t & (SEQ - 1), b = t / SEQ;
    if (stage == 0) {
        const int n = h2 % DIN; const float* x = args.in[0] + (size_t)t * D; const float* W = args.in[1];
        const float sc = (n < 384) ? 0.125f * LOG2E_F : 1.0f; float r = 0.f;
        for (int k = 0; k < 1024; ++k) r += bfr(x[k]) * bfr(W[(size_t)k * DIN + n] * sc);
        if (!close_(bfv(hb + (size_t)t * DINP + n), r, 0.02f, 0.02f)) DBG_FAIL(1);
    }
    if (stage == 1) {
        const bf16* hr = hb + (size_t)t * DINP;
        {   const int d = h2 % 128, head = d >> 6, dd = d & 63; float ssq = 0.f;
            for (int k = 0; k < 64; ++k) { const float v = bfv(hr + H_GK + head * 64 + k); ssq += v * v; }
            const float rstd = 1.0f / sqrtf(ssq / 64.0f + RMS_EPS); const float* g = args.in[4];
            const int i = dd & 31; const float y1 = bfv(hr + H_GK + head * 64 + i) * rstd * g[i], y2 = bfv(hr + H_GK + head * 64 + i + 32) * rstd * g[i + 32];
            float c, sn; ropecs(i, 16, s, c, sn); const float ref = (dd < 32) ? (y1 * c - y2 * sn) : (y1 * sn + y2 * c);
            if (!close_(bfv(kB + (size_t)t * 128 + d), ref, 0.02f, 0.01f)) DBG_FAIL(2); }
        {   const int d = h2 % 384; float ssq = 0.f; for (int k = 0; k < 384; ++k) { const float v = bfv(hr + H_CQ + k); ssq += v * v; }
            const float ref = bfv(hr + H_CQ + d) / sqrtf(ssq / 384.0f + RMS_EPS) * args.in[5][d];
            if (!close_(bfv(cqn + (size_t)t * 384 + d), ref, 0.02f, 0.01f)) DBG_FAIL(3); }
        {   const int d = h2 % 256; float ssq = 0.f; for (int k = 0; k < 256; ++k) { const float v = bfv(hr + H_CKV + k); ssq += v * v; }
            const float ref = bfv(hr + H_CKV + d) / sqrtf(ssq / 256.0f + RMS_EPS) * args.in[6][d];
            if (!close_(bfv(ckvn + (size_t)t * 256 + d), ref, 0.02f, 0.01f)) DBG_FAIL(4); }
        {   const int d = h2 % 32, i = d & 15; const float x1 = bfv(hr + H_KR + i), x2 = bfv(hr + H_KR + i + 16); float c, sn; ropecs(i, 8, s, c, sn);
            const float ref = (d < 16) ? (x1 * c - x2 * sn) : (x1 * sn + x2 * c);
            if (!close_(bfv(kr + (size_t)t * 32 + d), ref, 0.02f, 0.01f)) DBG_FAIL(5); }
    }
    if (stage == 2) {
        {   const int n = h2 % 384; float r = 0.f; const float sc = 0.10206207261596577f * LOG2E_F;
            for (int k = 0; k < 384; ++k) r += bfv(cqn + (size_t)t * 384 + k) * bfr(args.in[7][(size_t)k * 384 + n] * sc);
            if (!close_(bfv(qc + (size_t)t * 384 + n), r, 0.02f, 0.01f)) DBG_FAIL(6); }
        {   const int n = h2 % 512; float r = 0.f;
            for (int k = 0; k < 256; ++k) r += bfv(ckvn + (size_t)t * 256 + k) * bfr(args.in[8][(size_t)k * 512 + n]);
            if (!close_(bfv(kvc + (size_t)t * 512 + n), r, 0.02f, 0.02f)) DBG_FAIL(7); }
    }
    if (stage == 3) {
        const int gr = s >> 6, gc = s & 63;
        if (gid < 1024) {
            const int h = h2 % 6, dofs = ((h2 >> 8) & 1) * 32; float q[64], o[32];
            _Pragma("unroll") for (int d = 0; d < 64; ++d) { q[d] = bfv(hb + (size_t)t * DINP + H_NAQ + h * 64 + d); }
            _Pragma("unroll") for (int d = 0; d < 32; ++d) o[d] = 0.f;
            int r0 = gr - 4; r0 = r0 < 0 ? 0 : (r0 > 120 ? 120 : r0); int c0 = gc - 8; c0 = c0 < 0 ? 0 : (c0 > 48 ? 48 : c0);
            const float* rp = args.in[2] + (size_t)h * 465; float m = -1e30f, lsum = 0.f;
            for (int pass = 0; pass < 2; ++pass)
                for (int i = 0; i < 8; ++i) for (int j = 0; j < 16; ++j) { const int kr_ = r0 + i, kc = c0 + j; const size_t kt = (size_t)b * SEQ + kr_ * 64 + kc;
                    float sc = 0.f; _Pragma("unroll") for (int d = 0; d < 64; ++d) sc += q[d] * bfv(hb + kt * DINP + H_NAK + h * 64 + d);
                    sc += rp[(kr_ - gr + 7) * 31 + (kc - gc + 15)] * LOG2E_F;
                    if (pass == 0) m = fmaxf(m, sc); else { const float p = exp2f(sc - m); lsum += p; _Pragma("unroll") for (int d = 0; d < 32; ++d) o[d] += p * bfv(hb + kt * DINP + H_NAV + h * 64 + dofs + d); } }
            bool bad = false; _Pragma("unroll") for (int d = 0; d < 32; ++d) bad |= !close_(bfv(ya + (size_t)t * 384 + h * 64 + dofs + d), o[d] / lsum, 0.03f, 0.01f);
            if (bad) DBG_FAIL(8);
        } else if (gid < 1024 + 128) {
            const int head = h2 % 6, kvh = head / 3, dofs = ((h2 >> 8) & 1) * 32; float q[64], o[32]; float ssq = 0.f;
            _Pragma("unroll") for (int d = 0; d < 64; ++d) { q[d] = bfv(hb + (size_t)t * DINP + H_GQ + head * 64 + d); ssq += q[d] * q[d]; }
            _Pragma("unroll") for (int d = 0; d < 32; ++d) o[d] = 0.f;
            const float rstd = 1.0f / sqrtf(ssq / 64.0f + RMS_EPS);
            _Pragma("unroll") for (int d = 0; d < 64; ++d) q[d] = q[d] * rstd * args.in[3][d];
            _Pragma("unroll") for (int i = 0; i < 32; ++i) { float c, sn; ropecs(i, 16, s, c, sn); const float y1 = q[i], y2 = q[i + 32]; q[i] = y1 * c - y2 * sn; q[i + 32] = y1 * sn + y2 * c; }
            _Pragma("unroll") for (int d = 0; d < 64; ++d) q[d] = bfr(q[d] * 0.125f * LOG2E_F);
            float m = -1e30f, lsum = 0.f;
            for (int key = 0; key < SEQ; ++key) { const size_t kt = (size_t)b * SEQ + key; float sc = 0.f;
                _Pragma("unroll") for (int d = 0; d < 64; ++d) sc += q[d] * bfv(kB + kt * 128 + kvh * 64 + d);
                const float mn = fmaxf(m, sc), al = exp2f(m - mn), p = exp2f(sc - mn); m = mn; lsum = lsum * al + p;
                _Pragma("unroll") for (int d = 0; d < 32; ++d) o[d] = o[d] * al + p * bfv(hb + kt * DINP + H_GV + kvh * 64 + dofs + d); }
            bool bad = false; _Pragma("unroll") for (int d = 0; d < 32; ++d) bad |= !close_(bfv(yb + (size_t)t * 384 + head * 64 + dofs + d), o[d] / lsum, 0.03f, 0.003f);
            if (bad) DBG_FAIL(9);
        } else if (gid < 1024 + 256) {
            const int h = h2 % 4, dofs = ((h2 >> 8) & 1) * 32; float q[96], o[32];
            _Pragma("unroll") for (int d = 0; d < 96; ++d) q[d] = bfv(qc + (size_t)t * 384 + h * 96 + d);
            _Pragma("unroll") for (int i = 0; i < 16; ++i) { float c, sn; ropecs(i, 8, s, c, sn); const float y1 = q[64 + i], y2 = q[80 + i]; q[64 + i] = bfr(y1 * c - y2 * sn); q[80 + i] = bfr(y1 * sn + y2 * c); }
            _Pragma("unroll") for (int d = 0; d < 32; ++d) o[d] = 0.f;
            float m = -1e30f, lsum = 0.f;
            for (int key = 0; key < SEQ; ++key) { const size_t kt = (size_t)b * SEQ + key; float sc = 0.f;
                _Pragma("unroll") for (int d = 0; d < 64; ++d) sc += q[d] * bfv(kvc + kt * 512 + h * 128 + d);
                _Pragma("unroll") for (int d = 0; d < 32; ++d) sc += q[64 + d] * bfv(kr + kt * 32 + d);
                const float mn = fmaxf(m, sc), al = exp2f(m - mn), p = exp2f(sc - mn); m = mn; lsum = lsum * al + p;
                _Pragma("unroll") for (int d = 0; d < 32; ++d) o[d] = o[d] * al + p * bfv(kvc + kt * 512 + h * 128 + 64 + dofs + d); }
            bool bad = false; _Pragma("unroll") for (int d = 0; d < 32; ++d) bad |= !close_(bfv(yc + (size_t)t * 256 + h * 64 + dofs + d), o[d] / lsum, 0.03f, 0.003f);
            if (bad) DBG_FAIL(10);
        }
    }
    if (stage == 4) {
        const int n = h2 % 1024; float r = 0.f;
        { float a = 0.f; for (int k = 0; k < 384; ++k) a += bfv(ya + (size_t)t * 384 + k) * bfr(args.in[9][(size_t)k * 1024 + n]); r += a / (1.0f + expf(-bfv(hb + (size_t)t * DINP + H_GATE + n))); }
        { float a = 0.f; for (int k = 0; k < 384; ++k) a += bfv(yb + (size_t)t * 384 + k) * bfr(args.in[10][(size_t)k * 1024 + n]); r += a / (1.0f + expf(-bfv(hb + (size_t)t * DINP + H_GATE + 1024 + n))); }
        { float a = 0.f; for (int k = 0; k < 256; ++k) a += bfv(yc + (size_t)t * 256 + k) * bfr(args.in[11][(size_t)k * 1024 + n]); r += a / (1.0f + expf(-bfv(hb + (size_t)t * DINP + H_GATE + 2048 + n))); }
        if (!close_(bfv((const bf16*)(a2 + A2_MIXED) + (size_t)t * 1024 + n), r, 0.02f, 0.003f)) DBG_FAIL(11);
    }
    if (stage == 5) {
        const int n = h2 % 1024; float r = 0.f; const bf16* mx = (const bf16*)(a2 + A2_MIXED) + (size_t)t * 1024;
        for (int k = 0; k < 1024; ++k) r += bfv(mx + k) * bfr(args.in[12][(size_t)k * 1024 + n]);
        r += DN_ALPHA * args.in[0][(size_t)t * D + n];
        if (!close_(((const float*)(ws + WS_X1))[(size_t)t * D + n], r, 0.005f, 0.003f)) DBG_FAIL(12);
    }
    if (stage == 6) {
        const float* x1 = (const float*)(ws + WS_X1) + (size_t)t * D; const int* tok_e = (const int*)(ws + WS_TE); const int* tok_r = (const int*)(ws + WS_TR);
        const int* list_t = (const int*)(ws + WS_LT); const float* list_g = (const float*)(ws + WS_LG);
        float lg[32]; _Pragma("unroll") for (int e = 0; e < 32; ++e) lg[e] = args.in[16][e];
        for (int k = 0; k < 1024; ++k) { const float xv = x1[k]; _Pragma("unroll") for (int e = 0; e < 32; ++e) lg[e] += xv * args.in[15][(size_t)k * 32 + e]; }
        int se[4]; float sv[4]; unsigned used = 0;
        _Pragma("unroll") for (int r = 0; r < 4; ++r) { int be = -1; float bv = -INFINITY; _Pragma("unroll") for (int e = 0; e < 32; ++e) if (!((used >> e) & 1) && lg[e] > bv) { bv = lg[e]; be = e; } se[r] = be; sv[r] = bv; used |= 1u << be; }
        float fifth = -INFINITY; _Pragma("unroll") for (int e = 0; e < 32; ++e) if (!((used >> e) & 1)) fifth = fmaxf(fifth, lg[e]);
        const bool neartie = (sv[3] - fifth) < 2e-3f || (sv[0] - sv[1]) < 2e-3f || (sv[1] - sv[2]) < 2e-3f || (sv[2] - sv[3]) < 2e-3f;
        float den = 0.f; _Pragma("unroll") for (int r = 0; r < 4; ++r) den += expf(sv[r] - sv[0]);
        bool bad = false, badg = false;
        if (!neartie) _Pragma("unroll") for (int r = 0; r < 4; ++r) { const int e = tok_e[t * 4 + r], rk = tok_r[t * 4 + r]; if (e != se[r]) { bad = true; continue; }
            if (rk < 0 || rk >= LCAP || list_t[(size_t)e * LCAP + rk] != t) badg = true; else if (!close_(list_g[(size_t)e * LCAP + rk], expf(sv[r] - sv[0]) / den, 0.01f, 1e-4f)) badg = true; }
        if (bad) DBG_FAIL(13); if (badg) DBG_FAIL(14);
        { float sm = 0.f, sq = 0.f; for (int k = 0; k < 1024; ++k) { const float z = (x1[k] - args.in[14][k]) / args.in[13][k]; sm += z; sq += z * z; }
          if (fabsf(sm / 1024.f) > 2e-3f || fabsf(sq / 1024.f - 1.0f) > 1e-2f) DBG_FAIL(19); }
    }
    if (stage >= 7 && stage <= 10) {
        __shared__ int st[33], cn[32];
        if (threadIdx.x == 0) { int a = 0; for (int e2 = 0; e2 < 32; ++e2) { cn[e2] = (int)((const unsigned*)(ws + WS_CTL))[CW_CNT + 64 * l + e2]; st[e2] = a; a += ((cn[e2] + 255) >> 8) << 8; } st[32] = a; }
        __syncthreads();
        const int total = st[32]; const int sl = h1 % total; int e = 0; for (int k = 1; k < 32; ++k) if (sl >= st[k]) e = k; const int r = sl - st[e];
        const int* list_t = (const int*)(ws + WS_LT); const float* list_g = (const float*)(ws + WS_LG); const float* sg = (const float*)(ws + WS_SG);
        if (stage == 7) {
            int sum = 0; for (int k = 0; k < 32; ++k) sum += cn[k]; if (sum != TK) DBG_FAIL(15);
            const bf16* xg = (const bf16*)(ws + WS_H) + (size_t)sl * D; const int c = h2 % 1024;
            if (r < cn[e]) { const int tt = list_t[(size_t)e * LCAP + r]; if (tt < 0 || tt >= T) DBG_FAIL(15); else { if (xg[c] != ((const bf16*)(ws + WS_X1B))[(size_t)tt * D + c]) DBG_FAIL(15); if (sg[sl] != list_g[(size_t)e * LCAP + r]) DBG_FAIL(15); } }
            else { if (xg[c] != 0 || sg[sl] != 0.f) DBG_FAIL(15); }
        }
        if (stage == 8 && r < cn[e]) {
            const bf16* xg = (const bf16*)(ws + WS_H) + (size_t)sl * D; const int f = h2 % 1024; const float* W = args.in[17] + (size_t)e * 1024 * 2048;
            float g = args.in[18][e * 2048 + f], u = args.in[18][e * 2048 + 1024 + f];
            for (int k = 0; k < 1024; ++k) { const float xv = bfv(xg + k); g += xv * bfr(W[(size_t)k * 2048 + f]); u += xv * bfr(W[(size_t)k * 2048 + 1024 + f]); }
            g = fminf(g, 7.0f); u = fminf(fmaxf(u, -7.0f), 7.0f); const float ref = g / (1.0f + expf(-1.702f * g)) * (u + 1.0f);
            if (!close_(bfv((const bf16*)(ws + WS_A2) + (size_t)sl * 1024 + f), ref, 0.03f, 0.02f)) DBG_FAIL(16);
        }
        if (stage == 9 && r < cn[e]) {
            const bf16* ab = (const bf16*)(ws + WS_A2) + (size_t)sl * 1024; const int n = h2 % 1024; const float* W = args.in[19] + (size_t)e * 1024 * 1024;
            float y = args.in[20][e * 1024 + n]; for (int k = 0; k < 1024; ++k) y += bfv(ab + k) * bfr(W[(size_t)k * 1024 + n]);
            y *= sg[sl];
            if (!close_(bfv((const bf16*)(ws + WS_H) + (size_t)sl * 1024 + n), y, 0.03f, 0.005f)) DBG_FAIL(17);
        }
        if (stage == 10) {
            const float* x1 = (const float*)(ws + WS_X1) + (size_t)t * D; const int* tok_e = (const int*)(ws + WS_TE); const int* tok_r = (const int*)(ws + WS_TR);
            const bf16* ybf = (const bf16*)(ws + WS_H); float sm = 0.f, sq = 0.f; const int n = h2 % 1024; float vn = 0.f;
            for (int k = 0; k < 1024; ++k) { float v = DN_ALPHA * x1[k]; for (int q = 0; q < 4; ++q) v += bfv(ybf + (size_t)(st[tok_e[t * 4 + q]] + tok_r[t * 4 + q]) * D + k); sm += v; sq += v * v; if (k == n) vn = v; }
            const float mean = sm / 1024.f, var = sq / 1024.f - mean * mean; const float ref = (vn - mean) / sqrtf(var + LN_EPS) * args.in[21][n] + args.in[22][n];
            if (!close_(((const float*)(ws + WS_X2))[(size_t)t * D + n], ref, 0.005f, 0.003f)) DBG_FAIL(18);
        }
    }
}
static void dbg_launch(int stage, const Args& a, hipStream_t stream) {
    switch (stage) {
#define DBGL(k) case k: hipLaunchKernelGGL(dbg_kernel<k>, dim3(8), dim3(256), 0, stream, a); break;
        DBGL(0) DBGL(1) DBGL(2) DBGL(3) DBGL(4) DBGL(5) DBGL(6) DBGL(7) DBGL(8) DBGL(9) DBGL(10)
#undef DBGL
    }
}
#endif

extern "C" void kernel_launch(void* const* d_in, const int* in_sizes, int n_in, void* d_out, int out_size, void* d_ws, size_t ws_size, hipStream_t stream) {
    static int grid = 0;
    if (grid == 0) {
        if (n_in != 23 || in_sizes[0] != T * D || out_size != T * D || ws_size < WS_END) { fprintf(stderr, "kernel_launch: unexpected shapes / workspace (%d inputs, ws %zu, need %zu)\n", n_in, ws_size, (size_t)WS_END); grid = -1; return; }
        int dev = 0, cus = 0, per_cu = 0;
        if (hipGetDevice(&dev) != hipSuccess || hipDeviceGetAttribute(&cus, hipDeviceAttributeMultiprocessorCount, dev) != hipSuccess) { grid = -1; return; }
        if (hipFuncSetAttribute((const void*)mk_fwd, hipFuncAttributeMaxDynamicSharedMemorySize, LDS_BYTES) != hipSuccess) { fprintf(stderr, "kernel_launch: hipFuncSetAttribute failed\n"); grid = -1; return; }
        if (hipOccupancyMaxActiveBlocksPerMultiprocessor(&per_cu, (const void*)mk_fwd, NWAVES * 64, LDS_BYTES) != hipSuccess || per_cu < 1) { fprintf(stderr, "kernel_launch: occupancy query reports %d\n", per_cu); }
        (void)hipGetLastError();
        grid = cus;
    }
    if (grid < 0) return;
    if (hipMemsetAsync((char*)d_ws + WS_CTL, 0, CTL_ZERO_BYTES, stream) != hipSuccess) return;
    Args a{};
    for (int i = 0; i < 23; ++i) a.in[i] = (const float*)d_in[i];
    a.out = (float*)d_out; a.ws = (unsigned char*)d_ws; a.pad = 0;
#if MK_ONE_LAUNCH
    a.ph_lo = 0; a.ph_hi = NPH; a.use_bar = 1;
    hipLaunchKernelGGL(mk_fwd, dim3(grid), dim3(NWAVES * 64), LDS_BYTES, stream, a);
#else
    for (int p = 0; p < NPH; ++p) { a.ph_lo = p; a.ph_hi = p + 1; a.use_bar = 0; hipLaunchKernelGGL(mk_fwd, dim3(grid), dim3(NWAVES * 64), LDS_BYTES, stream, a);
#if MK_DEBUG
        if (p >= 1 && p <= PPL) dbg_launch(p - 1, a, stream);
#endif
    }
#endif
    const hipError_t le = hipPeekAtLastError();
    if (le != hipSuccess) fprintf(stderr, "kernel_launch: launch failed: %s\n", hipGetErrorName(le));
}
```

```cpp
#define MK_DEBUG 0
#define MK_ONE_LAUNCH 1
#include <hip/hip_runtime.h>
#include <hip/hip_bf16.h>
#include <cstdio>
#include <cstdint>
namespace pg8 {
#define PG8_LAS __attribute__((address_space(3)))
typedef unsigned short bf16_t;
typedef short bf16x8 __attribute__((ext_vector_type(8)));
typedef float f32x4 __attribute__((ext_vector_type(4)));
typedef unsigned u32x4 __attribute__((ext_vector_type(4)));
constexpr int BM = 256, BK = 64, HALF = 128, HTB = HALF * BK * 2  , STAGE_BYTES = 8 * HTB, NXCD = 8, WGM = 8;

__host__ __device__ __forceinline__ int lds_byte(int r, int c) { const int st = (r >> 4) * 2 + (c >> 5), rr = r & 15, cc = c & 31, ob = rr * 64 + cc * 2; return st * 1024 + (ob ^ (((ob >> 9) & 1) << 5)); }
__host__ __device__ __forceinline__ void stage_rc(int b, int& R, int& C) { const int st = b / 1024, sb = b % 1024, swz = sb ^ (((sb >> 9) & 1) << 5); R = (st >> 1) * 16 + swz / 64; C = (st & 1) * 32 + (swz % 64) / 2; }
__host__ __device__ __forceinline__ int perm32(int rho) { const int n = rho >> 4, i = rho & 15; return 8 * (i >> 2) + 4 * n + (i & 3); }

struct Unit { int pm, pn, e; };
struct Gemm { const bf16_t* A; const bf16_t* Bt; int M, N, K; size_t bstride; };

struct StaticOrder {
    int nM, nN, nwg, G, c;
    __host__ __device__ void init(int M, int N, int G_, int c_) { nM = M / BM; nN = N / BM; nwg = nM * nN; G = G_; c = c_; }
    __host__ __device__ bool next(int i, Unit& u) const {
        const long L = (long)i * G + c; if (L >= nwg) return false;
        int wgid = (int)L; { const int q = nwg / NXCD, r = nwg % NXCD, xcd = wgid % NXCD, off = wgid / NXCD; wgid = (xcd < r ? xcd * (q + 1) : r * (q + 1) + (xcd - r) * q) + off; }
        const int nig = WGM * nN, gid = wgid / nig, fm = gid * WGM, gsz = (nM - fm) < WGM ? (nM - fm) : WGM;
        u.pm = fm + ((wgid % nig) % gsz); u.pn = (wgid % nig) / gsz; u.e = 0; return true;
    }
    __device__ __forceinline__ void a_ready(const Unit&) const {}
    __device__ __forceinline__ void done(const Unit&) const {}
};

__device__ __forceinline__ unsigned cvt_pk_bf16(float lo, float hi) { unsigned r; asm volatile("v_cvt_pk_bf16_f32 %0, %1, %2" : "=v"(r) : "v"(lo), "v"(hi)); return r; }
typedef float f32x2 __attribute__((ext_vector_type(2)));


__device__ __forceinline__ float bf_lo(unsigned w) { return __uint_as_float(w << 16); }
__device__ __forceinline__ float bf_hi(unsigned w) { return __uint_as_float(w & 0xffff0000u); }
__device__ __forceinline__ float sigmoidf_(float z) { return __builtin_amdgcn_rcpf(1.0f + __builtin_amdgcn_exp2f(-1.4426950408889634f * z)); }
__device__ __forceinline__ u32x4 pack8(const f32x4& v0, const f32x4& v1) { u32x4 w; w.x = cvt_pk_bf16(v0[0], v0[1]); w.y = cvt_pk_bf16(v0[2], v0[3]); w.z = cvt_pk_bf16(v1[0], v1[1]); w.w = cvt_pk_bf16(v1[2], v1[3]); return w; }

struct EpiStore {
    static constexpr bool PERM = true, AFTER_DRAIN = false;
    bf16_t* O; int ldc; int nvalid;
    __device__ __forceinline__ void operator()(const f32x4 (&acc)[2][2][4][2], const Unit& u, int wr, int wc, int fr, int fq) const {
        const int row0 = u.pm * BM + wr * 64 + fr, col0 = u.pn * BM + wc * 32 + 8 * fq;
#pragma unroll
        for (int ai = 0; ai < 2; ++ai)
#pragma unroll
            for (int m = 0; m < 4; ++m) { bf16_t* rowp = O + (size_t)(row0 + ai * HALF + m * 16) * ldc + col0;
#pragma unroll
                for (int bj = 0; bj < 2; ++bj) { if (col0 + bj * HALF < nvalid) *(u32x4*)(rowp + bj * HALF) = pack8(acc[ai][bj][m][0], acc[ai][bj][m][1]); } }
    }
};
template <int MODE> struct EpiGate {
    static constexpr bool PERM = true, AFTER_DRAIN = false;
    const bf16_t* gate; int ldg; float* mix; bf16_t* mixed;
    __device__ __forceinline__ void operator()(const f32x4 (&acc)[2][2][4][2], const Unit& u, int wr, int wc, int fr, int fq) const {
        const int row0 = u.pm * BM + wr * 64 + fr, col0 = u.pn * BM + wc * 32 + 8 * fq;
#pragma unroll
        for (int ai = 0; ai < 2; ++ai)
#pragma unroll
            for (int m = 0; m < 4; ++m) { const size_t row = (size_t)(row0 + ai * HALF + m * 16);
#pragma unroll
                for (int bj = 0; bj < 2; ++bj) { const int col = col0 + bj * HALF;
                    const u32x4 gw = *(const u32x4*)(gate + row * ldg + col);
                    f32x4 g0 = {sigmoidf_(bf_lo(gw.x)), sigmoidf_(bf_hi(gw.x)), sigmoidf_(bf_lo(gw.y)), sigmoidf_(bf_hi(gw.y))};
                    f32x4 g1 = {sigmoidf_(bf_lo(gw.z)), sigmoidf_(bf_hi(gw.z)), sigmoidf_(bf_lo(gw.w)), sigmoidf_(bf_hi(gw.w))};
                    f32x4 v0 = g0 * acc[ai][bj][m][0], v1 = g1 * acc[ai][bj][m][1];
                    float* mp = mix + row * 1024 + col;
                    if (MODE >= 1) { v0 += *(const f32x4*)mp; v1 += *(const f32x4*)(mp + 4); }
                    if (MODE <= 1) { *(f32x4*)mp = v0; *(f32x4*)(mp + 4) = v1; }
                    else *(u32x4*)(mixed + row * 1024 + col) = pack8(v0, v1); } }
    }
};
struct EpiResid {
    static constexpr bool PERM = true, AFTER_DRAIN = false;
    const float* x; float* pre; float alpha;
    __device__ __forceinline__ void operator()(const f32x4 (&acc)[2][2][4][2], const Unit& u, int wr, int wc, int fr, int fq) const {
        const int row0 = u.pm * BM + wr * 64 + fr, col0 = u.pn * BM + wc * 32 + 8 * fq;
#pragma unroll
        for (int ai = 0; ai < 2; ++ai)
#pragma unroll
            for (int m = 0; m < 4; ++m) { const size_t row = (size_t)(row0 + ai * HALF + m * 16);
#pragma unroll
                for (int bj = 0; bj < 2; ++bj) { const size_t off = row * 1024 + col0 + bj * HALF;
                    const f32x4 x0 = *(const f32x4*)(x + off), x1 = *(const f32x4*)(x + off + 4);
                    *(f32x4*)(pre + off) = x0 * alpha + acc[ai][bj][m][0]; *(f32x4*)(pre + off + 4) = x1 * alpha + acc[ai][bj][m][1]; } }
    }
};
struct EpiSwiglu {
    static constexpr bool PERM = true, AFTER_DRAIN = false;
    bf16_t* a; const float* bias;
    __device__ __forceinline__ void operator()(const f32x4 (&acc)[2][2][4][2], const Unit& u, int wr, int wc, int fr, int fq) const {
        const int row0 = u.pm * BM + wr * 64 + fr, j0 = wc * 32 + 8 * fq, oc = u.pn * HALF + j0;
        const float* bg = bias + (size_t)u.e * 2048 + oc; const float* bu = bg + 1024;
        const f32x4 bg0 = *(const f32x4*)bg, bg1 = *(const f32x4*)(bg + 4), bu0 = *(const f32x4*)bu, bu1 = *(const f32x4*)(bu + 4);
#pragma unroll
        for (int ai = 0; ai < 2; ++ai)
#pragma unroll
            for (int m = 0; m < 4; ++m) { const size_t row = (size_t)(row0 + ai * HALF + m * 16);
                f32x4 g[2] = {acc[ai][0][m][0] + bg0, acc[ai][0][m][1] + bg1}, uu[2] = {acc[ai][1][m][0] + bu0, acc[ai][1][m][1] + bu1}, r[2];
#pragma unroll
                for (int n = 0; n < 2; ++n)
#pragma unroll
                    for (int q = 0; q < 4; ++q) { const float gg = fminf(g[n][q], 7.0f), uc = fminf(fmaxf(uu[n][q], -7.0f), 7.0f);
                        r[n][q] = gg * sigmoidf_(1.702f * gg) * (uc + 1.0f); }
                *(u32x4*)(a + row * 1024 + oc) = pack8(r[0], r[1]); }
    }
};
struct EpiDown {
    static constexpr bool PERM = true, AFTER_DRAIN = false;
    bf16_t* y; const float* bias; const float* list_g; const PG8_LAS int* st; const PG8_LAS int* cn; int lcap;
    __device__ __forceinline__ void operator()(const f32x4 (&acc)[2][2][4][2], const Unit& u, int wr, int wc, int fr, int fq) const {
        const int row0 = u.pm * BM + wr * 64 + fr, col0 = u.pn * BM + wc * 32 + 8 * fq;
        const int st_e = st[u.e], cn_e = cn[u.e];
        f32x4 bv[2][2];
#pragma unroll
        for (int bj = 0; bj < 2; ++bj)
#pragma unroll
            for (int n = 0; n < 2; ++n) bv[bj][n] = *(const f32x4*)(bias + (size_t)u.e * 1024 + col0 + bj * HALF + 4 * n);
#pragma unroll
        for (int ai = 0; ai < 2; ++ai)
#pragma unroll
            for (int m = 0; m < 4; ++m) { const size_t row = (size_t)(row0 + ai * HALF + m * 16); const int rank = (int)row - st_e;
                const float gt = rank < cn_e ? list_g[(size_t)u.e * lcap + rank] : 0.f;
#pragma unroll
                for (int bj = 0; bj < 2; ++bj) { const f32x4 v0 = (acc[ai][bj][m][0] + bv[bj][0]) * gt, v1 = (acc[ai][bj][m][1] + bv[bj][1]) * gt;
                    *(u32x4*)(y + row * 1024 + col0 + bj * HALF) = pack8(v0, v1); } }
    }
};
struct MoeGather {
    const int* list_t; const PG8_LAS int* st; const PG8_LAS int* cn; int lcap;
    __device__ __forceinline__ int row(const Unit& u, int r) const { int rank = u.pm * BM + r - st[u.e]; const int c = cn[u.e]; rank = rank < c ? rank : c - 1; return list_t[(size_t)u.e * lcap + rank]; }
};
struct MoeOrder {
    int nN, nunits, G, c; const PG8_LAS int* tile_e;
    __device__ __forceinline__ bool next(int i, Unit& u) const {
        const long L = (long)i * G + c; if (L >= nunits) return false;
        const int tile = (int)L / nN; u.pm = tile; u.pn = (int)L % nN; u.e = __builtin_amdgcn_readfirstlane(tile_e[tile]); return true;
    }
    __device__ __forceinline__ void a_ready(const Unit&) const {}
    __device__ __forceinline__ void done(const Unit&) const {}
};

struct NoGather { };
template <class Epi, class Sched, bool ALIGN_EPI = false, bool SP2 = false, bool GATHER = false, class GS = NoGather>
__device__ __forceinline__ void gemm_phase(PG8_LAS unsigned char* lds, const Gemm g, const Sched& S, const Epi& E, const int tid, const GS gs = GS()) {
    const int wid = __builtin_amdgcn_readfirstlane(tid >> 6), lane = tid & 63, wr = wid >> 2, wc = wid & 3, fr = lane & 15, fq = lane >> 4;
    const int K = g.K, nt = K / BK;
    unsigned voffA[2], voffB[2];
#pragma unroll
    for (int i = 0; i < 2; ++i) { int R, C; stage_rc(tid * 16 + i * 8192, R, C); const int Rb = Epi::PERM ? ((R & ~31) + perm32(R & 31)) : R;
        voffA[i] = (unsigned)(R * K + C) * 2u; voffB[i] = (unsigned)(Rb * K + C) * 2u; }
    unsigned vc0[2], vc1[2], vn0[2], vn1[2];
#define PG8_GROWS(u_, o0, o1) do { _Pragma("unroll") for (int i_ = 0; i_ < 2; ++i_) { int R_, C_; stage_rc(tid * 16 + i_ * 8192, R_, C_); \
        o0[i_] = (unsigned)gs.row((u_), R_) * (unsigned)(K * 2) + (unsigned)(C_ * 2); o1[i_] = (unsigned)gs.row((u_), HALF + R_) * (unsigned)(K * 2) + (unsigned)(C_ * 2); } } while (0)
    const size_t kstep = (size_t)(BK * 2);
    const size_t hstep = (size_t)HALF * K * 2;
    const size_t tstep = 2 * hstep;
    const unsigned ldsw = (unsigned)wid * 1024u;
    const int aoff = lds_byte(wr * 64 + fr, fq * 8), boff = lds_byte(wc * 32 + fr, fq * 8);
#define PG8_SA(b, h) (((b) * 2 + (h)) * HTB)
#define PG8_SB(b, h) ((4 + (b) * 2 + (h)) * HTB)
#define PG8_STAGE(bufoff, gbase, voff) do { _Pragma("unroll") for (int _i = 0; _i < 2; ++_i) \
        __builtin_amdgcn_global_load_lds((const unsigned*)((const char*)(gbase) + (voff)[_i]), (PG8_LAS unsigned*)(lds + (bufoff) + ldsw + _i * 8192), 16, 0, 0); } while (0)
#define PG8_LDA(dst, b, h) do { _Pragma("unroll") for (int m = 0; m < 4; ++m) _Pragma("unroll") for (int k = 0; k < 2; ++k) dst[m][k] = *(const PG8_LAS bf16x8*)(lds + PG8_SA(b, h) + aoff + m * 2048 + k * 1024); } while (0)
#define PG8_LDB(dst, b, h) do { _Pragma("unroll") for (int n = 0; n < 2; ++n) _Pragma("unroll") for (int k = 0; k < 2; ++k) dst[n][k] = *(const PG8_LAS bf16x8*)(lds + PG8_SB(b, h) + boff + n * 2048 + k * 1024); } while (0)
#define PG8_MMA(ai, bj, At, Bt) do { __builtin_amdgcn_s_setprio(1); _Pragma("unroll") for (int m = 0; m < 4; ++m) _Pragma("unroll") for (int n = 0; n < 2; ++n) _Pragma("unroll") for (int k = 0; k < 2; ++k) \
        acc[ai][bj][m][n] = __builtin_amdgcn_mfma_f32_16x16x32_bf16(Bt[n][k], At[m][k], acc[ai][bj][m][n], 0, 0, 0); __builtin_amdgcn_s_setprio(0); } while (0)
#define PG8_WAIT_V(n) asm volatile("s_waitcnt vmcnt(" #n ")" ::: "memory")
#define PG8_WAIT_L(n) asm volatile("s_waitcnt lgkmcnt(" #n ")" ::: "memory")
#define PG8_BAR __builtin_amdgcn_s_barrier()
#define PG8_SCHED __builtin_amdgcn_sched_barrier(0)
    Unit cur, nxt; int ui = 0;
    if (!S.next(0, cur)) return;
    f32x4 acc[2][2][4][2];
#pragma unroll
    for (int a = 0; a < 2; ++a)
#pragma unroll
        for (int b = 0; b < 2; ++b)
#pragma unroll
            for (int m = 0; m < 4; ++m)
#pragma unroll
                for (int n = 0; n < 2; ++n) acc[a][b][m][n] = (f32x4){0.f, 0.f, 0.f, 0.f};
    bf16x8 At[4][2], B0[2][2], B1[2][2];
    const char* cA = GATHER ? (const char*)g.A : (const char*)g.A + (size_t)cur.pm * tstep;
    if constexpr (GATHER) { PG8_GROWS(cur, vc0, vc1); } else { _Pragma("unroll") for (int i = 0; i < 2; ++i) { vc0[i] = voffA[i]; vc1[i] = voffA[i] + (unsigned)hstep; } }
#pragma unroll
    for (int i = 0; i < 2; ++i) { vn0[i] = vc0[i]; vn1[i] = vc1[i]; }
    const char* cB = (const char*)g.Bt + (size_t)cur.pn * tstep + (size_t)cur.e * g.bstride;
    S.a_ready(cur);
    if constexpr (SP2) {
        PG8_STAGE(PG8_SB(0, 0), cB, voffB); PG8_STAGE(PG8_SB(0, 1), cB + hstep, voffB); PG8_STAGE(PG8_SA(0, 0), cA, vc0); PG8_STAGE(PG8_SA(0, 1), cA, vc1);
        if (wr == 1) PG8_BAR;
        PG8_WAIT_V(2); PG8_BAR;
        PG8_STAGE(PG8_SB(1, 0), cB + kstep, voffB); PG8_STAGE(PG8_SA(1, 0), cA + kstep, vc0); PG8_STAGE(PG8_SB(1, 1), cB + hstep + kstep, voffB);
        PG8_WAIT_V(6); PG8_BAR;
    } else {
        PG8_STAGE(PG8_SB(0, 0), cB, voffB); PG8_STAGE(PG8_SA(0, 0), cA, vc0); PG8_STAGE(PG8_SB(0, 1), cB + hstep, voffB); PG8_STAGE(PG8_SA(0, 1), cA, vc1);
        if (wr == 1) PG8_BAR;
        PG8_WAIT_V(4); PG8_BAR;
        PG8_STAGE(PG8_SB(1, 0), cB + kstep, voffB); PG8_STAGE(PG8_SA(1, 0), cA + kstep, vc0); PG8_STAGE(PG8_SB(1, 1), cB + hstep + kstep, voffB);
        PG8_WAIT_V(6); PG8_BAR;
    }
    for (;;) {
        const bool has_next = S.next(ui + 1, nxt);
        const char* nA = GATHER ? cA : (has_next ? (const char*)g.A + (size_t)nxt.pm * tstep : cA);
        if constexpr (GATHER) { if (has_next) { PG8_GROWS(nxt, vn0, vn1); } } const char* nB = has_next ? (const char*)g.Bt + (size_t)nxt.pn * tstep + (size_t)nxt.e * g.bstride : cB;
        for (int t = 0; t < nt; t += 2) {
            const bool last = (t == nt - 2);
            const char* a1 = cA + (size_t)(t + 1) * kstep;
            const char* a2 = last ? nA : cA + (size_t)(t + 2) * kstep; const char* b2 = last ? nB : cB + (size_t)(t + 2) * kstep;
            const char* a3 = a2 + kstep; const char* b3 = b2 + kstep;
            unsigned vs0[2], vs1[2];
#pragma unroll
            for (int i = 0; i < 2; ++i) { vs0[i] = (GATHER && last) ? vn0[i] : vc0[i]; vs1[i] = (GATHER && last) ? vn1[i] : vc1[i]; }
            if (last && has_next) S.a_ready(nxt);
            if constexpr (SP2) {
            PG8_LDB(B0, 0, 0); PG8_LDB(B1, 0, 1); PG8_SCHED; PG8_LDA(At, 0, 0); PG8_STAGE(PG8_SA(1, 1), a1, vc1);
            PG8_WAIT_V(8); PG8_WAIT_L(0); PG8_BAR; PG8_MMA(0, 0, At, B0); PG8_MMA(0, 1, At, B1); PG8_BAR; PG8_SCHED;
            PG8_LDA(At, 0, 1); PG8_STAGE(PG8_SB(0, 0), b2, voffB); PG8_STAGE(PG8_SB(0, 1), b2 + hstep, voffB); PG8_STAGE(PG8_SA(0, 0), a2, vs0);
            PG8_WAIT_V(8); PG8_WAIT_L(0); PG8_BAR; PG8_MMA(1, 0, At, B0); PG8_MMA(1, 1, At, B1); PG8_BAR; PG8_SCHED;
            PG8_LDB(B0, 1, 0); PG8_LDB(B1, 1, 1); PG8_SCHED; PG8_LDA(At, 1, 0); PG8_STAGE(PG8_SA(0, 1), a2, vs1);
            PG8_WAIT_V(8); PG8_WAIT_L(0); PG8_BAR; PG8_MMA(0, 0, At, B0); PG8_MMA(0, 1, At, B1); PG8_BAR; PG8_SCHED;
            PG8_LDA(At, 1, 1); PG8_STAGE(PG8_SB(1, 0), b3, voffB); PG8_STAGE(PG8_SB(1, 1), b3 + hstep, voffB); PG8_STAGE(PG8_SA(1, 0), a3, vs0);
            PG8_WAIT_V(8); PG8_WAIT_L(0); PG8_BAR; PG8_MMA(1, 0, At, B0); PG8_MMA(1, 1, At, B1); PG8_BAR; PG8_SCHED;
            } else {
            PG8_LDB(B0, 0, 0); PG8_SCHED; PG8_LDA(At, 0, 0); PG8_STAGE(PG8_SA(1, 1), a1, vc1);
            PG8_WAIT_L(8); PG8_BAR; PG8_WAIT_L(0); PG8_MMA(0, 0, At, B0); PG8_BAR; PG8_SCHED;
            PG8_LDB(B1, 0, 1); PG8_STAGE(PG8_SB(0, 0), b2, voffB);
            PG8_BAR; PG8_WAIT_L(0); PG8_MMA(0, 1, At, B1); PG8_BAR;
            PG8_LDA(At, 0, 1); PG8_STAGE(PG8_SA(0, 0), a2, vs0);
            PG8_BAR; PG8_WAIT_L(0); PG8_MMA(1, 0, At, B0); PG8_BAR; PG8_SCHED;
            PG8_STAGE(PG8_SB(0, 1), b2 + hstep, voffB);
            PG8_WAIT_V(6); PG8_BAR; PG8_MMA(1, 1, At, B1); PG8_BAR;
            PG8_LDB(B0, 1, 0); PG8_SCHED; PG8_LDA(At, 1, 0); PG8_STAGE(PG8_SA(0, 1), a2, vs1);
            PG8_WAIT_L(8); PG8_BAR; PG8_WAIT_L(0); PG8_MMA(0, 0, At, B0); PG8_BAR; PG8_SCHED;
            PG8_LDB(B1, 1, 1); PG8_STAGE(PG8_SB(1, 0), b3, voffB);
            PG8_BAR; PG8_WAIT_L(0); PG8_MMA(0, 1, At, B1); PG8_BAR;
            PG8_LDA(At, 1, 1); PG8_STAGE(PG8_SA(1, 0), a3, vs0);
            PG8_BAR; PG8_WAIT_L(0); PG8_MMA(1, 0, At, B0); PG8_BAR; PG8_SCHED;
            PG8_STAGE(PG8_SB(1, 1), b3 + hstep, voffB);
            PG8_WAIT_V(6); PG8_BAR; PG8_MMA(1, 1, At, B1); PG8_BAR;
            }
        }
        if constexpr (ALIGN_EPI) { if (wr == 0) PG8_BAR; }
        if constexpr (!Epi::AFTER_DRAIN) { E(acc, cur, wr, wc, fr, fq); S.done(cur); }
        if (!has_next) break;
#pragma unroll
        for (int a = 0; a < 2; ++a)
#pragma unroll
            for (int b = 0; b < 2; ++b)
#pragma unroll
                for (int m = 0; m < 4; ++m)
#pragma unroll
                    for (int n = 0; n < 2; ++n) acc[a][b][m][n] = (f32x4){0.f, 0.f, 0.f, 0.f};
        cur = nxt; cA = nA; cB = nB; ++ui;
        if constexpr (GATHER) { _Pragma("unroll") for (int i = 0; i < 2; ++i) { vc0[i] = vn0[i]; vc1[i] = vn1[i]; } }
        if constexpr (ALIGN_EPI) { if (wr == 1) PG8_BAR; }
    }
    PG8_WAIT_V(0);
    if constexpr (!ALIGN_EPI) { if (wr == 0) PG8_BAR; }
    PG8_BAR;
    if constexpr (Epi::AFTER_DRAIN) { E.fused(acc, cur, wr, wc, fr, fq, lds, wid, lane); S.done(cur); }
#undef PG8_GROWS
#undef PG8_SA
#undef PG8_SB
#undef PG8_STAGE
#undef PG8_LDA
#undef PG8_LDB
#undef PG8_MMA
#undef PG8_WAIT_V
#undef PG8_WAIT_L
#undef PG8_BAR
#undef PG8_SCHED
}
}


namespace att {
typedef unsigned short bf16_t;
typedef short bf16x8 __attribute__((ext_vector_type(8)));
typedef short s16x4 __attribute__((ext_vector_type(4)));
typedef float f32x16 __attribute__((ext_vector_type(16)));
typedef unsigned u32x4 __attribute__((ext_vector_type(4)));
#define ALAS __attribute__((address_space(3)))
typedef ALAS unsigned char* ALAS_PTR;
#define ASBAR() __builtin_amdgcn_sched_barrier(0)
constexpr int QBLK = 32, KVBLK = 64;
constexpr float THR2 = 11.0f;
constexpr float LOG2E = 1.4426950408889634f, INV2PI = 0.15915494309189535f, LOG2_THETA = 13.287712379549449f;
constexpr int OFF_V = 0, VBUF = 8192, OFF_K = 16384, KBUF_MAX = 13312, OFF_WS = OFF_K + 2 * KBUF_MAX  , OFF_BIAS = OFF_WS + 2048  , ATT_LDS = OFF_BIAS + 2048;
__device__ __forceinline__ int crow(int r, int hi) { return (r & 3) + 8 * (r >> 2) + 4 * hi; }
__device__ __forceinline__ unsigned cvtpk(float lo, float hi) { unsigned r; asm volatile("v_cvt_pk_bf16_f32 %0, %1, %2" : "=v"(r) : "v"(lo), "v"(hi)); return r; }
__device__ __forceinline__ float bf2f(short s) { return __uint_as_float(((unsigned)(unsigned short)s) << 16); }
__device__ __forceinline__ short f2bf_s(float f) { return (short)(cvtpk(f, 0.f) & 0xffffu); }

struct UnitP {
    const bf16_t* Q; int ldq;
    const bf16_t* K0; int ldk0;
    const bf16_t* K1; int ldk1;
    const bf16_t* V; int ldv;
    bf16_t* O; int ldo;
    int nt;
    int grow0;
    const float* gain;
    int kr0;
    float cref;
};

typedef short v4i16_t __attribute__((ext_vector_type(4)));
__device__ __forceinline__ s16x4 vtr(const ALAS unsigned char* p) { return __builtin_bit_cast(s16x4, __builtin_amdgcn_ds_read_tr16_b64_v4i16((ALAS v4i16_t*)p)); }
__device__ __forceinline__ void pv_all(f32x16& o0, f32x16& o1, f32x16& lacc, const ALAS unsigned char* vp, bf16x8 pa0, bf16x8 pa1, bf16x8 pa2, bf16x8 pa3) {
    const bf16x8 ones = {(short)0x3F80, (short)0x3F80, (short)0x3F80, (short)0x3F80, (short)0x3F80, (short)0x3F80, (short)0x3F80, (short)0x3F80};
#define ATT_PK(L, H) (bf16x8){L[0], L[1], L[2], L[3], H[0], H[1], H[2], H[3]}
#define ATT_STEP(KS, PA) { const s16x4 l0 = vtr(vp + (KS) * 1024), h0 = vtr(vp + (KS) * 1024 + 512), l1 = vtr(vp + 4096 + (KS) * 1024), h1 = vtr(vp + 4096 + (KS) * 1024 + 512); \
        o0 = __builtin_amdgcn_mfma_f32_32x32x16_bf16(PA, ATT_PK(l0, h0), o0, 0, 0, 0); o1 = __builtin_amdgcn_mfma_f32_32x32x16_bf16(PA, ATT_PK(l1, h1), o1, 0, 0, 0); \
        lacc = __builtin_amdgcn_mfma_f32_32x32x16_bf16(PA, ones, lacc, 0, 0, 0); }
    ATT_STEP(0, pa0) ATT_STEP(1, pa1) ATT_STEP(2, pa2) ATT_STEP(3, pa3)
#undef ATT_STEP
#undef ATT_PK
}
template <int DQK> __device__ __forceinline__ void qkt(f32x16& p0, f32x16& p1, const ALAS unsigned char* Ks, const bf16x8* qr, const f32x16& cinit, int r32, int hi) {
    constexpr int KST = DQK * 2 + 16;
#pragma unroll
    for (int d0 = 0; d0 < DQK / 16; ++d0) { const int cb = (2 * d0 + hi) * 16;
        const bf16x8 b0 = *(const ALAS bf16x8*)(Ks + r32 * KST + cb);
        const bf16x8 b1 = *(const ALAS bf16x8*)(Ks + (32 + r32) * KST + cb);
        if (d0 == 0) { p0 = __builtin_amdgcn_mfma_f32_32x32x16_bf16(b0, qr[0], cinit, 0, 0, 0); p1 = __builtin_amdgcn_mfma_f32_32x32x16_bf16(b1, qr[0], cinit, 0, 0, 0); }
        else { p0 = __builtin_amdgcn_mfma_f32_32x32x16_bf16(b0, qr[d0], p0, 0, 0, 0); p1 = __builtin_amdgcn_mfma_f32_32x32x16_bf16(b1, qr[d0], p1, 0, 0, 0); } }
}
__device__ __forceinline__ void na_mask(f32x16& p0, f32x16& p1, const ALAS float* btab, int kr, int rq, int qc_in, int hi_in) {
    int qc = qc_in, hi = hi_in; asm volatile("" : "+v"(qc), "+v"(hi));
    int r0 = rq - 4; r0 = r0 < 0 ? 0 : (r0 > 120 ? 120 : r0);
    const bool rowok = (kr >= r0) && (kr < r0 + 8);
    int c0 = qc - 8; c0 = c0 < 0 ? 0 : (c0 > 48 ? 48 : c0);
    int dr = kr - rq + 7; dr = dr < 0 ? 0 : (dr > 14 ? 14 : dr);
    const ALAS float* brow = btab + dr * 31;
#pragma unroll
    for (int r = 0; r < 16; ++r) {
        const int ka = crow(r, hi), kb = 32 + ka;
        int ia = ka - qc + 15; ia = ia < 0 ? 0 : (ia > 30 ? 30 : ia);
        int ib = kb - qc + 15; ib = ib < 0 ? 0 : (ib > 30 ? 30 : ib);
        const bool oka = rowok && (ka >= c0) && (ka < c0 + 16), okb = rowok && (kb >= c0) && (kb < c0 + 16);
        p0[r] = oka ? p0[r] + brow[ia] : -1e30f;
        p1[r] = okb ? p1[r] + brow[ib] : -1e30f;
    }
}
__device__ __forceinline__ void lazySM(f32x16& p0, f32x16& p1, float& m_reg, bool& moved, float& alpha) {
    float pmax = p0[0];
#pragma unroll
    for (int r = 1; r < 16; ++r) pmax = fmaxf(pmax, p0[r]);
#pragma unroll
    for (int r = 0; r < 16; ++r) pmax = fmaxf(pmax, p1[r]);
    { auto rr = __builtin_amdgcn_permlane32_swap(__float_as_uint(pmax), __float_as_uint(pmax), false, false);
      pmax = fmaxf(__uint_as_float(rr[0]), __uint_as_float(rr[1])); }
    if (__builtin_expect(__all(pmax <= THR2), 1)) { alpha = 1.f; }
    else { const float dl = fmaxf(pmax, 0.f); m_reg += dl; alpha = __builtin_amdgcn_exp2f(-dl);
#pragma unroll
        for (int r = 0; r < 16; ++r) { p0[r] -= dl; p1[r] -= dl; }
        moved = true; }
#pragma unroll
    for (int r = 0; r < 16; ++r) p0[r] = __builtin_amdgcn_exp2f(p0[r]);
}
__device__ __forceinline__ void fixedSM(f32x16& p0) {
#pragma unroll
    for (int r = 0; r < 16; ++r) p0[r] = __builtin_amdgcn_exp2f(p0[r]);
}
__device__ __forceinline__ void finishSM(f32x16& p0, f32x16& p1, bf16x8& pa0, bf16x8& pa1, bf16x8& pa2, bf16x8& pa3) {
#pragma unroll
    for (int r = 0; r < 16; ++r) p1[r] = __builtin_amdgcn_exp2f(p1[r]);
    u32x4 w;
    w = (u32x4){cvtpk(p0[0], p0[1]), cvtpk(p0[2], p0[3]), cvtpk(p0[4], p0[5]), cvtpk(p0[6], p0[7])}; pa0 = __builtin_bit_cast(bf16x8, w);
    w = (u32x4){cvtpk(p0[8], p0[9]), cvtpk(p0[10], p0[11]), cvtpk(p0[12], p0[13]), cvtpk(p0[14], p0[15])}; pa1 = __builtin_bit_cast(bf16x8, w);
    w = (u32x4){cvtpk(p1[0], p1[1]), cvtpk(p1[2], p1[3]), cvtpk(p1[4], p1[5]), cvtpk(p1[6], p1[7])}; pa2 = __builtin_bit_cast(bf16x8, w);
    w = (u32x4){cvtpk(p1[8], p1[9]), cvtpk(p1[10], p1[11]), cvtpk(p1[12], p1[13]), cvtpk(p1[14], p1[15])}; pa3 = __builtin_bit_cast(bf16x8, w);
}
template <int DQK, int MODE>
__device__ __forceinline__ void attn_unit(const UnitP& u, ALAS unsigned char* lds, const int tid) {
    constexpr int ND = DQK / 16, KST = DQK * 2 + 16, KBUF = 64 * KST;
    static_assert(KBUF <= KBUF_MAX, "K buffer");
    const int wid = __builtin_amdgcn_readfirstlane(tid >> 6), lane = tid & 63, r32 = lane & 31, hi = lane >> 5;
    ALAS unsigned char* V_lds = lds + OFF_V; ALAS unsigned char* K_lds = lds + OFF_K;
    ALAS float* ws = (ALAS float*)(lds + OFF_WS) + wid * 64; ALAS float* al_l = ws + 32;
    const ALAS float* btab = (const ALAS float*)(lds + OFF_BIAS);
    float m_reg = 0.f; f32x16 o[2], lacc; o[0] = f32x16{}; o[1] = f32x16{}; lacc = f32x16{}; bf16x8 qr[ND];
    bool moved = false;
    const int grow = u.grow0 + (wid >> 1), gcol = (wid & 1) * 32 + r32;
    {
        const bf16_t* Qw = u.Q + (size_t)(wid * QBLK + r32) * u.ldq + hi * 8;
#pragma unroll
        for (int d0 = 0; d0 < ND; ++d0) qr[d0] = *(const bf16x8*)(Qw + d0 * 16);
        if constexpr (MODE == 0 || MODE == 3) {
            float x[4][8]; float ssq = 0.f;
#pragma unroll
            for (int d0 = 0; d0 < 4; ++d0)
#pragma unroll
                for (int j = 0; j < 8; ++j) { x[d0][j] = bf2f(qr[d0][j]); ssq += x[d0][j] * x[d0][j]; }
            { auto rr_ = __builtin_amdgcn_permlane32_swap(__float_as_uint(ssq), __float_as_uint(ssq), false, false); ssq = __uint_as_float(rr_[0]) + __uint_as_float(rr_[1]); }
            const float rstd = 1.0f / sqrtf(ssq * (1.0f / 64.0f) + 1e-6f);
#pragma unroll
            for (int d0 = 0; d0 < 4; ++d0)
#pragma unroll
                for (int j = 0; j < 8; ++j) x[d0][j] = x[d0][j] * rstd * u.gain[16 * d0 + 8 * hi + j];
#pragma unroll
            for (int d0 = 0; d0 < 2; ++d0)
#pragma unroll
                for (int j = 0; j < 8; ++j) { const float inv = exp2f(-(float)(8 * hi + j) * (LOG2_THETA / 16.0f));
                    const float ang = (float)(d0 == 0 ? grow : gcol) * inv * INV2PI; const float c = __builtin_amdgcn_cosf(ang), s = __builtin_amdgcn_sinf(ang);
                    const float y1 = x[d0][j], y2 = x[d0 + 2][j]; x[d0][j] = y1 * c - y2 * s; x[d0 + 2][j] = y1 * s + y2 * c; }
            constexpr float C2 = 0.125f * LOG2E;
#pragma unroll
            for (int d0 = 0; d0 < 4; ++d0) { u32x4 w = {cvtpk(x[d0][0] * C2, x[d0][1] * C2), cvtpk(x[d0][2] * C2, x[d0][3] * C2), cvtpk(x[d0][4] * C2, x[d0][5] * C2), cvtpk(x[d0][6] * C2, x[d0][7] * C2)};
                qr[d0] = __builtin_bit_cast(bf16x8, w); }
        }
        if constexpr (MODE == 1) {
            float y1[8], y2[8];
#pragma unroll
            for (int j = 0; j < 8; ++j) { const float inv = exp2f(-(float)j * (LOG2_THETA / 8.0f));
                const float ang = (float)(hi == 0 ? grow : gcol) * inv * INV2PI; const float c = __builtin_amdgcn_cosf(ang), s = __builtin_amdgcn_sinf(ang);
                const float a = bf2f(qr[4][j]), b = bf2f(qr[5][j]); y1[j] = a * c - b * s; y2[j] = a * s + b * c; }
            u32x4 w = {cvtpk(y1[0], y1[1]), cvtpk(y1[2], y1[3]), cvtpk(y1[4], y1[5]), cvtpk(y1[6], y1[7])}; qr[4] = __builtin_bit_cast(bf16x8, w);
            w = (u32x4){cvtpk(y2[0], y2[1]), cvtpk(y2[2], y2[3]), cvtpk(y2[4], y2[5]), cvtpk(y2[6], y2[7])}; qr[5] = __builtin_bit_cast(bf16x8, w);
        }
    }
    const int sk = tid >> 3, sc = tid & 7;
    const bf16_t* vsrc = u.V + (size_t)sk * u.ldv + sc * 8; const bf16_t* ksrc = u.K0 + (size_t)sk * u.ldk0 + sc * 8;
    const int vst = (sc >> 2) * 4096 + sk * 64 + (sc & 3) * 16, kst = sk * KST + sc * 16;
    const int sk2 = (tid & 255) >> 2, sc2 = tid & 3;
    const bf16_t* k2src = (DQK == 96) ? u.K1 + (size_t)sk2 * u.ldk1 + sc2 * 8 : nullptr;
    const int k2st = sk2 * KST + (8 + sc2) * 16;
    const ALAS unsigned char* vb0 = V_lds + ((lane >> 4) & 1) * 32 + (lane & 3) * 8 + (4 * hi + ((lane & 15) >> 2)) * 64;
    struct { bf16x8 v, k, k2; } sr_[2];
#define ATT_SLOAD(i, k0) do { sr_[i].v = *(const bf16x8*)(vsrc + (size_t)(k0) * u.ldv); sr_[i].k = *(const bf16x8*)(ksrc + (size_t)(k0) * u.ldk0); \
        if constexpr (DQK == 96) sr_[i].k2 = *(const bf16x8*)(k2src + (size_t)(k0) * u.ldk1); } while (0)
#define ATT_SWRITE(b, i) do { *(ALAS bf16x8*)(V_lds + (b) * VBUF + vst) = sr_[i].v; *(ALAS bf16x8*)(K_lds + (b) * KBUF + kst) = sr_[i].k; \
        if constexpr (DQK == 96) *(ALAS bf16x8*)(K_lds + (b) * KBUF + k2st) = sr_[i].k2; } while (0)
#define ATT_SWAIT() do { if constexpr (DQK == 96) asm volatile("s_waitcnt vmcnt(3)" ::: "memory"); else asm volatile("s_waitcnt vmcnt(2)" ::: "memory"); } while (0)
#define ATT_RESC(a) do { if constexpr (MODE != 0) { if (__any((a) < 1.f)) { if (hi == 0) al_l[r32] = (a); asm volatile("s_waitcnt lgkmcnt(0)" ::: "memory"); \
        _Pragma("unroll") for (int r = 0; r < 16; ++r) { const float f_ = al_l[crow(r, hi)]; o[0][r] *= f_; o[1][r] *= f_; lacc[r] *= f_; } } } } while (0)
#define ATT_SM(P0, P1, AL) do { if constexpr (MODE == 0) { fixedSM(P0); AL = 1.f; } else lazySM(P0, P1, m_reg, moved, AL); } while (0)
#define ATT_QKT(P0, P1, KS) do { if (MODE != 0 && moved) { f32x16 ng_; _Pragma("unroll") for (int r_ = 0; r_ < 16; ++r_) ng_[r_] = -m_reg; qkt<DQK>(P0, P1, KS, qr, ng_, r32, hi); } \
        else { const f32x16 z_ = f32x16{}; qkt<DQK>(P0, P1, KS, qr, z_, r32, hi); } } while (0)
#define ATT_PV(VB) pv_all(o[0], o[1], lacc, (VB), pa0, pa1, pa2, pa3)
#define ATT_MASK(P0, P1, j) do { if constexpr (MODE == 2) na_mask(P0, P1, btab, u.kr0 + (j), grow, gcol, hi); } while (0)
    f32x16 pA0, pA1, pB0, pB1; float alA, alB; bf16x8 pa0, pa1, pa2, pa3; const int NT = u.nt;
    constexpr int SE = 0, SO = 1;
    ATT_SLOAD(SE, 0); asm volatile("s_waitcnt vmcnt(0)" ::: "memory"); ATT_SWRITE(0, SE); __syncthreads();
    ATT_QKT(pA0, pA1, K_lds); ATT_MASK(pA0, pA1, 0); ATT_SM(pA0, pA1, alA);
    ATT_SLOAD(SO, KVBLK); if (2 < NT) ATT_SLOAD(SE, 2 * KVBLK);
    ATT_SWAIT(); ATT_SWRITE(1, SO); __syncthreads();
    for (int j = 1; j + 1 < NT; j += 2) {
        ASBAR(); ATT_QKT(pB0, pB1, K_lds + KBUF); ATT_MASK(pB0, pB1, j);
        finishSM(pA0, pA1, pa0, pa1, pa2, pa3); ASBAR();
        ATT_SLOAD(SO, (j + 2) * KVBLK); ASBAR();
        ATT_PV(vb0); ATT_SM(pB0, pB1, alB);
        __syncthreads(); ATT_SWAIT(); ATT_SWRITE(0, SE);
        ATT_RESC(alB); __syncthreads();
        ASBAR(); ATT_QKT(pA0, pA1, K_lds); ATT_MASK(pA0, pA1, j + 1);
        finishSM(pB0, pB1, pa0, pa1, pa2, pa3); ASBAR();
        if (j + 3 < NT) ATT_SLOAD(SE, (j + 3) * KVBLK); ASBAR();
        ATT_PV(vb0 + VBUF); ATT_SM(pA0, pA1, alA);
        __syncthreads(); ATT_SWAIT(); ATT_SWRITE(1, SO);
        ATT_RESC(alA); __syncthreads();
    }
    ASBAR(); ATT_QKT(pB0, pB1, K_lds + KBUF); ATT_MASK(pB0, pB1, NT - 1);
    finishSM(pA0, pA1, pa0, pa1, pa2, pa3); ASBAR();
    ATT_PV(vb0); ATT_SM(pB0, pB1, alB);
    __syncthreads(); ATT_RESC(alB);
    finishSM(pB0, pB1, pa0, pa1, pa2, pa3); ASBAR();
    ATT_PV(vb0 + VBUF);
    bf16_t* Ow = u.O + (size_t)(wid * QBLK) * u.ldo;
#pragma unroll
    for (int r = 0; r < 16; ++r) { const int orow = crow(r, hi); const float rl = __builtin_amdgcn_rcpf(lacc[r]);
#pragma unroll
        for (int d0 = 0; d0 < 2; ++d0) Ow[(size_t)orow * u.ldo + d0 * 32 + r32] = (bf16_t)f2bf_s(o[d0][r] * rl); }
    __syncthreads();
#undef ATT_SLOAD
#undef ATT_SWRITE
#undef ATT_SWAIT
#undef ATT_RESC
#undef ATT_SM
#undef ATT_QKT
#undef ATT_PV
#undef ATT_MASK
}
}


constexpr int NWAVES = 8;
#ifndef MK_DEBUG
#define MK_DEBUG 0
#endif
#ifndef MK_DBG_IGNORE
#define MK_DBG_IGNORE 0
#endif
#ifndef MK_ONE_LAUNCH
#define MK_ONE_LAUNCH 0
#endif
#ifndef REP_P
#define REP_P 1
#endif
#ifndef REP_A
#define REP_A 1
#endif
#ifndef REP_B
#define REP_B 1
#endif
#ifndef REP_C
#define REP_C 1
#endif
#ifndef REP_DG
#define REP_DG 1
#endif
#ifndef REP_DM
#define REP_DM 1
#endif
#ifndef REP_DN
#define REP_DN 1
#endif
#ifndef REP_E
#define REP_E 1
#endif
#ifndef REP_F
#define REP_F 1
#endif
#ifndef REP_H
#define REP_H 1
#endif
#ifndef REP_I
#define REP_I 1
#endif
#ifndef REP_J
#define REP_J 1
#endif
#ifndef REP_K
#define REP_K 1
#endif
constexpr int NB = 4, SEQ = 8192, T = NB * SEQ, D = 1024, DEPTH = 2, GW = 64;
constexpr int DIN = 5536, DINP = 5632;
constexpr int H_NAQ = 0, H_NAK = 384, H_NAV = 768, H_GQ = 1152, H_GK = 1536, H_GV = 1664, H_CQ = 1792, H_CKV = 2176, H_KR = 2432, H_GATE = 2464;
constexpr int NE = 32, TOPK = 4, FF = 1024, TK = T * TOPK;
constexpr int PSLOTS = TK + NE * 256;
constexpr int MAXTILES = PSLOTS / 256;
constexpr int LCAP = T;
constexpr float LN_EPS = 1e-5f, RMS_EPS = 1e-6f, DN_ALPHA = 1.4142135623730951f;
constexpr float LOG2E_F = 1.4426950408889634f;
constexpr int PPL = 10, NPH = 1 + DEPTH * PPL;

constexpr size_t MiB = 1u << 20;
constexpr size_t WS_CTL = 0, CTL_ZERO_BYTES = 1 * MiB;
constexpr size_t WB_IN = 0, WB_UQ = WB_IN + (size_t)DINP * 1024 * 2, WB_UKV = WB_UQ + (size_t)512 * 384 * 2, WB_BA = WB_UKV + (size_t)512 * 256 * 2,
                 WB_BB = WB_BA + (size_t)1024 * 384 * 2, WB_BC = WB_BB + (size_t)1024 * 384 * 2, WB_OUT = WB_BC + (size_t)1024 * 256 * 2,
                 WB_GU = WB_OUT + (size_t)1024 * 1024 * 2, WB_DN = WB_GU + (size_t)NE * 2048 * 1024 * 2, WB_LAYER = WB_DN + (size_t)NE * 1024 * 1024 * 2;
static_assert(WB_LAYER % 256 == 0, "weight block alignment");
constexpr size_t WS_W = 2 * MiB;
constexpr size_t WS_H = WS_W + 2 * WB_LAYER;
constexpr size_t SZ_H = (size_t)T * DINP * 2;
constexpr size_t WS_A2 = WS_H + SZ_H;
constexpr size_t A2_MIX = 0, A2_MIXED = A2_MIX + (size_t)T * 1024 * 4, A2_YA = A2_MIXED + (size_t)T * 1024 * 2, A2_YB = A2_YA + (size_t)T * 384 * 2,
                 A2_YC = A2_YB + (size_t)T * 384 * 2, A2_QC = A2_YC + (size_t)T * 256 * 2, A2_KVC = A2_QC + (size_t)T * 384 * 2, A2_KB = A2_KVC + (size_t)T * 512 * 2,
                 A2_CQN = A2_KB + (size_t)T * 128 * 2, A2_CKVN = A2_CQN + (size_t)T * 384 * 2, A2_KR = A2_CKVN + (size_t)T * 256 * 2, SZ_A2 = A2_KR + (size_t)T * 32 * 2;
static_assert(SZ_A2 >= (size_t)PSLOTS * 1024 * 2 && SZ_H >= (size_t)PSLOTS * 1024 * 2, "overlays fit");
constexpr size_t WS_X2 = WS_A2 + SZ_A2;
constexpr size_t WS_XB = WS_X2 + (size_t)T * D * 4;
constexpr size_t WS_X1 = WS_XB + (size_t)T * D * 2;
constexpr size_t WS_X1B = WS_X1 + (size_t)T * D * 4;
constexpr size_t WS_LT = WS_X1B + (size_t)T * D * 2;
constexpr size_t WS_LG = WS_LT + (size_t)NE * LCAP * 4;
constexpr size_t WS_TE = WS_LG + (size_t)NE * LCAP * 4;
constexpr size_t WS_TR = WS_TE + (size_t)T * 4 * 4;
constexpr size_t WS_SG = WS_TR + (size_t)T * 4 * 4;
constexpr size_t WS_END = WS_SG + (size_t)PSLOTS * 4;
constexpr int CW_BAR = 4096;
constexpr int CW_CNT = 16384;

constexpr int RING_BYTES = 131072, LDSCTL_OFF = 139264, MISC_OFF = LDSCTL_OFF + 64;
constexpr int TBL_OFF = LDSCTL_OFF + 256;
constexpr int TBL_START = TBL_OFF, TBL_TILEE = TBL_OFF + 512, TBL_RS = TBL_TILEE + 2304;
constexpr int LDS_BYTES = 155648;
static_assert(TBL_RS + 512 * 12 + 256 <= LDS_BYTES, "LDS map");

#define GAS __attribute__((address_space(1)))
#define LAS __attribute__((address_space(3)))
typedef unsigned short bf16;
typedef unsigned v4u __attribute__((ext_vector_type(4)));
typedef float f32x4 __attribute__((ext_vector_type(4)));
typedef GAS unsigned gu32;
#define RLX_AGENT __ATOMIC_RELAXED, __HIP_MEMORY_SCOPE_AGENT
#define LDS_WAIT() asm volatile("s_waitcnt lgkmcnt(0)" ::: "memory")
#define VM_WAIT() asm volatile("s_waitcnt vmcnt(0)" ::: "memory")
__device__ __forceinline__ unsigned f2bf(float f) { unsigned u = __builtin_bit_cast(unsigned, f); return (u + 0x7fffu + ((u >> 16) & 1u)) >> 16; }
__device__ __forceinline__ unsigned pk2(float lo, float hi) { unsigned r; asm("v_cvt_pk_bf16_f32 %0, %1, %2" : "=v"(r) : "v"(lo), "v"(hi)); return r; }
__device__ __forceinline__ float bflo(unsigned w) { return __uint_as_float(w << 16); }
__device__ __forceinline__ float bfhi(unsigned w) { return __uint_as_float(w & 0xffff0000u); }

template <int O> __device__ __forceinline__ float shx(float v, int lane) { return __int_as_float(__builtin_amdgcn_ds_bpermute((lane ^ O) << 2, __float_as_int(v))); }
template <int O> __device__ __forceinline__ int shxi(int v, int lane) { return __builtin_amdgcn_ds_bpermute((lane ^ O) << 2, v); }

#define XB_TMO      128
#define XB_XCNT(j)  (256  + 64 * (j))
#define XB_XSUB(j)  (1280 + 64 * (j))
#define XB_XGEN(j)  (2304 + 64 * (j))
#define XB_TOP      3328
#define XB_TOPGEN   3392
#define XCD_BAR_WORDS 3456
#define XB_SPIN_CAP (1u << 18)

__device__ __forceinline__ unsigned xb_ld(unsigned* p)              { return __hip_atomic_load(p, __ATOMIC_RELAXED, __HIP_MEMORY_SCOPE_AGENT); }
__device__ __forceinline__ unsigned xb_add(unsigned* p, unsigned v) { return __hip_atomic_fetch_add(p, v, __ATOMIC_RELAXED, __HIP_MEMORY_SCOPE_AGENT); }
__device__ __forceinline__ unsigned xb_xcc_id() { return (unsigned)__builtin_amdgcn_s_getreg((3 << 11) | 20) & 0xFu; }
#define XB_SPIN(cond, bar) do { unsigned _sp = 0; while (cond) { __builtin_amdgcn_s_sleep(1); \
    if ((++_sp & 255u) == 0u) { if (xb_ld(&(bar)[XB_TMO])) break; if (_sp > XB_SPIN_CAP) { atomicAdd(&(bar)[XB_TMO], 1u); break; } } } } while (0)

struct XcdBarrier {
    unsigned* bar; unsigned x;
    volatile LAS unsigned* st;
};

__device__ __forceinline__ XcdBarrier xcd_barrier_post(unsigned* bar, volatile LAS unsigned* st) {
    XcdBarrier b; b.bar = bar; b.x = xb_xcc_id(); b.st = st;
    if (threadIdx.x == 0) (void)xb_add(&bar[XB_XCNT(b.x)], 1u);
    return b;
}
__device__ __forceinline__ void xcd_barrier_complete(unsigned* bar, unsigned x, unsigned& nloc, unsigned& nx) {
    const unsigned G = gridDim.x * gridDim.y * gridDim.z;
    unsigned sum, cnt, mine, sp = 0u;
    for (;;) {
        sum = 0u; cnt = 0u; mine = 0u;
#pragma unroll
        for (unsigned j = 0; j < 16; ++j) { const unsigned c = xb_ld(&bar[XB_XCNT(j)]); sum += c; cnt += (c > 0u) ? 1u : 0u; mine = (j == x) ? c : mine; }
        if (sum == G) break;
        __builtin_amdgcn_s_sleep(1);
        if ((++sp & 255u) == 0u) { if (xb_ld(&bar[XB_TMO])) break; if (sp > XB_SPIN_CAP) { atomicAdd(&bar[XB_TMO], 1u); break; } }
    }
    nloc = mine > 0u ? mine : 1u; nx = cnt > 0u ? cnt : 1u;
}

__device__ __forceinline__ void xcd_barrier(const XcdBarrier& b) {
    asm volatile("s_waitcnt vmcnt(0)" ::: "memory");
    __syncthreads();
    if (threadIdx.x == 0) {
        unsigned* bar = b.bar;
        __builtin_amdgcn_s_waitcnt(0);
        unsigned nloc = b.st[0], nx = b.st[1];
        if (nloc == 0u) { xcd_barrier_complete(bar, b.x, nloc, nx); b.st[0] = nloc; b.st[1] = nx; }
        const unsigned old = xb_add(&bar[XB_XSUB(b.x)], 1u);
        const unsigned gen = old / nloc;
        if (old + 1u == (gen + 1u) * nloc) {
            __builtin_amdgcn_fence(__ATOMIC_RELEASE, "agent");
            asm volatile("s_waitcnt vmcnt(0)" ::: "memory");
            const unsigned og = xb_add(&bar[XB_TOP], 1u);
            const unsigned tg = og / nx;
            if (og + 1u == (tg + 1u) * nx) xb_add(&bar[XB_TOPGEN], 1u);
            else XB_SPIN(xb_ld(&bar[XB_TOPGEN]) == tg, bar);
            __builtin_amdgcn_fence(__ATOMIC_ACQUIRE, "agent");
            xb_add(&bar[XB_XGEN(b.x)], 1u);
            asm volatile("s_waitcnt vmcnt(0)" ::: "memory");
        } else {
            XB_SPIN(xb_ld(&bar[XB_XGEN(b.x)]) == gen, bar);
            __builtin_amdgcn_fence(__ATOMIC_ACQUIRE, "agent");
            asm volatile("s_waitcnt vmcnt(0)" ::: "memory");
        }
    }
    __syncthreads();
}


struct Frame {
    LAS unsigned char* lds;
    gu32* ctl;
    int tid, lane, wave;
    int vcu, G, bx;
    unsigned char* ws;
    float* out;
};
__device__ __forceinline__ const float* in_ptr(int i) {
    const void* base = (const void*)__builtin_amdgcn_kernarg_segment_ptr(); const GAS float* p;
    asm volatile("s_load_dwordx2 %0, %1, %2\n\ts_waitcnt lgkmcnt(0)" : "=s"(p) : "s"(base), "i"(i * 8) : "memory"); return (const float*)p;
}
#define INP(i) in_ptr(i)
template <int SITE> __device__ __forceinline__ Frame mkframe(LAS unsigned char* lds_in, unsigned char* ws_in, float* out_in, int wave_id, int bx0, int G0) {
    Frame F; int lane_;
    asm volatile("v_mbcnt_lo_u32_b32 %0, -1, 0\n\tv_mbcnt_hi_u32_b32 %0, -1, %0 ; site %1" : "=v"(lane_) : "n"(SITE));
    int bx = bx0, G = G0, wv = wave_id; asm volatile("; site %3" : "+s"(bx), "+s"(G), "+s"(wv) : "n"(SITE));
    GAS unsigned char* wsg = (GAS unsigned char*)ws_in; asm volatile("; site %1" : "+s"(wsg) : "n"(SITE)); unsigned char* ws = (unsigned char*)wsg;
    LAS unsigned char* l3 = lds_in; asm volatile("; site %1" : "+s"(l3) : "n"(SITE));
    const int tid = wv * 64 + lane_;
    F.lds = l3; F.tid = tid; F.lane = lane_; F.wave = wv;
    F.G = G; F.bx = bx; F.vcu = (G % 8 == 0) ? (bx % 8) * (G / 8) + bx / 8 : bx;
    F.ws = ws; F.ctl = (gu32*)(wsg + WS_CTL); F.out = out_in; return F;
}
__device__ __forceinline__ float wave_sum(float v, int lane) {
    v += shx<1>(v, lane); v += shx<2>(v, lane); v += shx<4>(v, lane); v += shx<8>(v, lane); v += shx<16>(v, lane); v += shx<32>(v, lane);
    return v;
}
__device__ __forceinline__ void tr_item(const float* W, int ldw, int K, int k0, int src_n0, bf16* WT, int dst_n0, float scale, LAS float* scr, int lane) {
    float v[32];
#pragma unroll
    for (int i = 0; i < 32; ++i) v[i] = W[(size_t)(k0 + 2 * i + (lane >> 5)) * ldw + src_n0 + (lane & 31)];
#pragma unroll
    for (int i = 0; i < 32; ++i) scr[(2 * i + (lane >> 5)) * 33 + (lane & 31)] = v[i];
    LDS_WAIT(); asm volatile("" ::: "memory");
    const int c = lane & 7;
#pragma unroll
    for (int j = 0; j < 4; ++j) { const int n = (lane >> 3) + 8 * j; const LAS float* s = scr + (8 * c) * 33 + n;
        v4u o; o.x = pk2(s[0 * 33] * scale, s[1 * 33] * scale); o.y = pk2(s[2 * 33] * scale, s[3 * 33] * scale); o.z = pk2(s[4 * 33] * scale, s[5 * 33] * scale); o.w = pk2(s[6 * 33] * scale, s[7 * 33] * scale);
        *(GAS v4u*)(WT + (size_t)(dst_n0 + n) * K + k0 + 8 * c) = o; }
    LDS_WAIT(); asm volatile("" ::: "memory");
}
template <int KIND> __device__ __forceinline__ void conv_matrix(Frame& F, const float* W, int K, int N, bf16* WT, float s, int gw, int NGW, LAS float* scr) {
    const int nnb = N / 32, nkb = K / 64, nit = nnb * nkb;
    for (int it = gw; it < nit; it += NGW) {
        const int kb = it / nnb, nb = it % nnb; const int dst_n0 = 32 * nb; int src_n0 = dst_n0; float sc = s;
        if (KIND == 1) sc = (dst_n0 < 384) ? s : 1.0f;
        if (KIND == 2) { const int p = dst_n0 >> 8, j = dst_n0 & 255; src_n0 = (j < 128) ? (128 * p + j) : (1024 + 128 * p + (j - 128)); }
        tr_item(W, N, K, 64 * kb, src_n0, WT, dst_n0, sc, scr, F.lane);
    }
}
__device__ __forceinline__ void zero_rows(bf16* WT, int K, int n_lo, int n_hi, int gtid, int nthr) {
    const size_t n16 = (size_t)(n_hi - n_lo) * K / 8; GAS v4u* p = (GAS v4u*)(WT + (size_t)n_lo * K);
    for (size_t i = gtid; i < n16; i += nthr) p[i] = (v4u){0u, 0u, 0u, 0u};
}
__device__ __forceinline__ void p_prologue(Frame& F) {
    LAS float* scr = (LAS float*)(F.lds + F.wave * 16384);
    const int gw0 = F.vcu * NWAVES + F.wave, NGW = F.G * NWAVES, gtid = F.bx * (NWAVES * 64) + F.tid, nthr = F.G * NWAVES * 64;
    for (int l = 0; l < DEPTH; ++l) {
        unsigned char* wb = F.ws + WS_W + (size_t)l * WB_LAYER;
        int gw = gw0;
#define ROT(n) do { gw = (gw + NGW - ((n) % NGW)) % NGW; } while (0)
        conv_matrix<1>(F, INP(1) + (size_t)l * 1024 * DIN, 1024, DIN, (bf16*)(wb + WB_IN), 0.125f * LOG2E_F, gw, NGW, scr); ROT(16 * 173);
        zero_rows((bf16*)(wb + WB_IN), 1024, DIN, DINP, gtid, nthr);
        conv_matrix<0>(F, INP(7) + (size_t)l * 384 * 384, 384, 384, (bf16*)(wb + WB_UQ), 0.10206207261596577f * LOG2E_F, gw, NGW, scr); ROT(72);
        zero_rows((bf16*)(wb + WB_UQ), 384, 384, 512, gtid, nthr);
        conv_matrix<0>(F, INP(8) + (size_t)l * 256 * 512, 256, 512, (bf16*)(wb + WB_UKV), 1.0f, gw, NGW, scr); ROT(64);
        conv_matrix<0>(F, INP(9) + (size_t)l * 384 * 1024, 384, 1024, (bf16*)(wb + WB_BA), 1.0f, gw, NGW, scr); ROT(192);
        conv_matrix<0>(F, INP(10) + (size_t)l * 384 * 1024, 384, 1024, (bf16*)(wb + WB_BB), 1.0f, gw, NGW, scr); ROT(192);
        conv_matrix<0>(F, INP(11) + (size_t)l * 256 * 1024, 256, 1024, (bf16*)(wb + WB_BC), 1.0f, gw, NGW, scr); ROT(64);
        conv_matrix<0>(F, INP(12) + (size_t)l * 1024 * 1024, 1024, 1024, (bf16*)(wb + WB_OUT), 1.0f, gw, NGW, scr); ROT(512);
        for (int e = 0; e < NE; ++e) {
            conv_matrix<2>(F, INP(17) + ((size_t)l * NE + e) * 1024 * 2048, 1024, 2048, (bf16*)(wb + WB_GU) + (size_t)e * 2048 * 1024, 1.0f, gw, NGW, scr);
            conv_matrix<0>(F, INP(19) + ((size_t)l * NE + e) * 1024 * 1024, 1024, 1024, (bf16*)(wb + WB_DN) + (size_t)e * 1024 * 1024, 1.0f, gw, NGW, scr);
        }
#undef ROT
    }
    { const GAS f32x4* xs = (const GAS f32x4*)INP(0); GAS v4u* xd = (GAS v4u*)(F.ws + WS_XB);
      for (size_t i = gtid; i < (size_t)T * D / 8; i += nthr) { const f32x4 a = xs[2 * i], b = xs[2 * i + 1]; xd[i] = (v4u){pk2(a.x, a.y), pk2(a.z, a.w), pk2(b.x, b.y), pk2(b.z, b.w)}; } }
}

__device__ __forceinline__ void p_prep(Frame& F, int l) {
    const bf16* hb = (const bf16*)(F.ws + WS_H); unsigned char* a2 = F.ws + WS_A2;
    bf16* kB = (bf16*)(a2 + A2_KB); bf16* cqn = (bf16*)(a2 + A2_CQN); bf16* ckvn = (bf16*)(a2 + A2_CKVN); bf16* kr = (bf16*)(a2 + A2_KR);
    const float* gk = INP(4) + l * 64; const float* gq = INP(5) + l * 384; const float* gkv = INP(6) + l * 256;
    const int lane = F.lane, gw = F.vcu * NWAVES + F.wave, NGW = F.G * NWAVES;
    for (int t = gw; t < T; t += NGW) {
        const bf16* hr = hb + (size_t)t * DINP; const int s = t & (SEQ - 1); const float prow = (float)(s >> 6), pcol = (float)(s & 63);
        {   float x[8]; float ssq = 0.f; const int cc = lane & 7;
            if (lane < 16) { const v4u w = *(const GAS v4u*)(hr + H_GK + lane * 8); x[0] = bflo(w.x); x[1] = bfhi(w.x); x[2] = bflo(w.y); x[3] = bfhi(w.y); x[4] = bflo(w.z); x[5] = bfhi(w.z); x[6] = bflo(w.w); x[7] = bfhi(w.w); }
            else {
#pragma unroll
                for (int j = 0; j < 8; ++j) x[j] = 0.f; }
#pragma unroll
            for (int j = 0; j < 8; ++j) ssq += x[j] * x[j];
            ssq += shx<1>(ssq, lane); ssq += shx<2>(ssq, lane); ssq += shx<4>(ssq, lane);
            const float rstd = 1.0f / sqrtf(ssq * (1.0f / 64.0f) + RMS_EPS);
            float y[8], o[8];
#pragma unroll
            for (int j = 0; j < 8; ++j) y[j] = x[j] * rstd * gk[(cc * 8 + j) & 63];
#pragma unroll
            for (int j = 0; j < 8; ++j) { const float other = shx<4>(y[j], lane); const int i = 8 * (cc & 3) + j;
                const float inv = exp2f(-(float)(i & 15) * (att::LOG2_THETA / 16.0f)); const float ang = ((i < 16) ? prow : pcol) * inv * att::INV2PI;
                const float c = __builtin_amdgcn_cosf(ang), sn = __builtin_amdgcn_sinf(ang);
                o[j] = (cc < 4) ? (y[j] * c - other * sn) : (other * sn + y[j] * c); }
            if (lane < 16) *(GAS v4u*)(kB + (size_t)t * 128 + lane * 8) = (v4u){pk2(o[0], o[1]), pk2(o[2], o[3]), pk2(o[4], o[5]), pk2(o[6], o[7])};
        }
        {   float x[8]; float ssq = 0.f;
            if (lane < 48) { const v4u w = *(const GAS v4u*)(hr + H_CQ + lane * 8); x[0] = bflo(w.x); x[1] = bfhi(w.x); x[2] = bflo(w.y); x[3] = bfhi(w.y); x[4] = bflo(w.z); x[5] = bfhi(w.z); x[6] = bflo(w.w); x[7] = bfhi(w.w); }
            else {
#pragma unroll
                for (int j = 0; j < 8; ++j) x[j] = 0.f; }
#pragma unroll
            for (int j = 0; j < 8; ++j) ssq += x[j] * x[j];
            ssq = wave_sum(ssq, lane); const float rstd = 1.0f / sqrtf(ssq * (1.0f / 384.0f) + RMS_EPS);
            if (lane < 48) { float y[8];
#pragma unroll
                for (int j = 0; j < 8; ++j) y[j] = x[j] * rstd * gq[lane * 8 + j];
                *(GAS v4u*)(cqn + (size_t)t * 384 + lane * 8) = (v4u){pk2(y[0], y[1]), pk2(y[2], y[3]), pk2(y[4], y[5]), pk2(y[6], y[7])}; }
        }
        {   float x[8]; float ssq = 0.f;
            if (lane < 32) { const v4u w = *(const GAS v4u*)(hr + H_CKV + lane * 8); x[0] = bflo(w.x); x[1] = bfhi(w.x); x[2] = bflo(w.y); x[3] = bfhi(w.y); x[4] = bflo(w.z); x[5] = bfhi(w.z); x[6] = bflo(w.w); x[7] = bfhi(w.w); }
            else {
#pragma unroll
                for (int j = 0; j < 8; ++j) x[j] = 0.f; }
#pragma unroll
            for (int j = 0; j < 8; ++j) ssq += x[j] * x[j];
            ssq = wave_sum(ssq, lane); const float rstd = 1.0f / sqrtf(ssq * (1.0f / 256.0f) + RMS_EPS);
            if (lane < 32) { float y[8];
#pragma unroll
                for (int j = 0; j < 8; ++j) y[j] = x[j] * rstd * gkv[lane * 8 + j];
                *(GAS v4u*)(ckvn + (size_t)t * 256 + lane * 8) = (v4u){pk2(y[0], y[1]), pk2(y[2], y[3]), pk2(y[4], y[5]), pk2(y[6], y[7])}; }
        }
        {   float x[8]; const int cc = lane & 3;
            if (lane < 4) { const v4u w = *(const GAS v4u*)(hr + H_KR + lane * 8); x[0] = bflo(w.x); x[1] = bfhi(w.x); x[2] = bflo(w.y); x[3] = bfhi(w.y); x[4] = bflo(w.z); x[5] = bfhi(w.z); x[6] = bflo(w.w); x[7] = bfhi(w.w); }
            else {
#pragma unroll
                for (int j = 0; j < 8; ++j) x[j] = 0.f; }
            float o[8];
#pragma unroll
            for (int j = 0; j < 8; ++j) { const float other = shx<2>(x[j], lane);
                const float inv = exp2f(-(float)j * (att::LOG2_THETA / 8.0f)); const float ang = (((cc & 1) == 0) ? prow : pcol) * inv * att::INV2PI;
                const float c = __builtin_amdgcn_cosf(ang), sn = __builtin_amdgcn_sinf(ang);
                o[j] = (cc < 2) ? (x[j] * c - other * sn) : (other * sn + x[j] * c); }
            if (lane < 4) *(GAS v4u*)(kr + (size_t)t * 32 + lane * 8) = (v4u){pk2(o[0], o[1]), pk2(o[2], o[3]), pk2(o[4], o[5]), pk2(o[6], o[7])};
        }
    }
}


__device__ __forceinline__ int build_tables(Frame& F, int l) {
    LAS int* st = (LAS int*)(F.lds + TBL_START); LAS int* cn = st + 33; LAS int* te = (LAS int*)(F.lds + TBL_TILEE);
    __syncthreads();
    if (F.tid < NE) cn[F.tid] = (int)__hip_atomic_load(F.ctl + CW_CNT + 64 * l + F.tid, RLX_AGENT);
    __syncthreads();
    if (F.tid == 0) { int s = 0; for (int e = 0; e < NE; ++e) { st[e] = s; s += ((cn[e] + 255) >> 8) << 8; } st[NE] = s; }
    __syncthreads();
    const int total = st[NE];
    for (int tile = F.tid; tile < (total >> 8); tile += NWAVES * 64) { int e = 0; for (int k = 1; k < NE; ++k) e += (tile * 256 >= st[k]) ? 1 : 0; te[tile] = e; }
    __syncthreads();
    return total;
}

__device__ __forceinline__ void p_ln1_router(Frame& F, int l) {
    float* x1 = (float*)(F.ws + WS_X1); bf16* x1b = (bf16*)(F.ws + WS_X1B);
    int* list_t = (int*)(F.ws + WS_LT); float* list_g = (float*)(F.ws + WS_LG); int* tok_e = (int*)(F.ws + WS_TE); int* tok_r = (int*)(F.ws + WS_TR);
    const float* wr = INP(15) + (size_t)l * 1024 * NE; const float* br = INP(16) + l * NE;
    const int lane0 = F.lane, tid = F.tid;
    LAS unsigned char* wl = F.lds;
    LAS int* sel_e = (LAS int*)(F.lds + TBL_RS); LAS float* sel_g = (LAS float*)(sel_e + 512); LAS int* sel_r = sel_e + 1024; LAS int* hist = sel_e + 1536; LAS int* base = hist + 32;
    __syncthreads();
    for (int idx = tid; idx < 1024 * 8; idx += NWAVES * 64) { const int k = idx >> 3, c = idx & 7, kp = (k & 3) * 256 + (k >> 2), cp = c ^ ((kp >> 1) & 7);
        *(LAS f32x4*)(wl + (kp * 8 + cp) * 16) = *(const GAS f32x4*)(wr + (size_t)k * NE + c * 4); }
    __syncthreads();
    for (int tile = F.bx; tile < T / 128; tile += F.G) {
        if (tid < 32) hist[tid] = 0;
        __syncthreads();
        for (int it = 0; it < 16; ++it) {
            int lane = lane0; asm volatile("" : "+v"(lane));
            const int sw = (lane >> 1) & 7; const float bias_e = br[(lane >> 1) & 31];
            const GAS f32x4* lgp = (const GAS f32x4*)(INP(13) + l * D) + lane; const GAS f32x4* lbp = (const GAS f32x4*)(INP(14) + l * D) + lane;
            const int tl = F.wave * 16 + it, t = tile * 128 + tl;
            GAS f32x4* xr = (GAS f32x4*)(x1 + (size_t)t * D) + lane;
            f32x4 v[4]; float s = 0.f;
#pragma unroll
            for (int j = 0; j < 4; ++j) { v[j] = xr[64 * j]; s += (v[j].x + v[j].y) + (v[j].z + v[j].w); }
            const float mean = wave_sum(s, lane) * (1.f / D); float s2 = 0.f;
#pragma unroll
            for (int j = 0; j < 4; ++j) { v[j] = v[j] - mean; s2 += (v[j].x * v[j].x + v[j].y * v[j].y) + (v[j].z * v[j].z + v[j].w * v[j].w); }
            const float rstd = 1.f / sqrtf(wave_sum(s2, lane) * (1.f / D) + LN_EPS);
            GAS unsigned long long* o8 = (GAS unsigned long long*)(x1b + (size_t)t * D) + lane;
#pragma unroll
            for (int j = 0; j < 4; ++j) { v[j] = v[j] * rstd * lgp[64 * j] + lbp[64 * j]; xr[64 * j] = v[j];
                o8[64 * j] = (unsigned long long)pk2(v[j].x, v[j].y) | ((unsigned long long)pk2(v[j].z, v[j].w) << 32); }
            float acc[32];
#pragma unroll
            for (int c = 0; c < 8; ++c) {
                int basec = lane * 128 + ((c ^ sw) << 4); asm volatile("" : "+v"(basec));
                const LAS unsigned char* wp = wl + basec;
                float a0 = 0.f, a1_ = 0.f, a2_ = 0.f, a3 = 0.f;
#pragma unroll
                for (int i = 0; i < 4; ++i)
#pragma unroll
                    for (int j = 0; j < 4; ++j) { const f32x4 w = *(const LAS f32x4*)(wp + (i * 256 + 64 * j) * 128); const float xv = v[j][i];
                        a0 += xv * w.x; a1_ += xv * w.y; a2_ += xv * w.z; a3 += xv * w.w; }
                acc[4 * c + 0] = a0; acc[4 * c + 1] = a1_; acc[4 * c + 2] = a2_; acc[4 * c + 3] = a3;
            }
            float a16[16], a8[8], a4[4], a2[2], a1;
            { const bool b = (lane & 32) != 0;
#pragma unroll
              for (int i = 0; i < 16; ++i) { const float send = b ? acc[i] : acc[16 + i]; const float keep = b ? acc[16 + i] : acc[i]; a16[i] = keep + shx<32>(send, lane); } }
            { const bool b = (lane & 16) != 0;
#pragma unroll
              for (int i = 0; i < 8; ++i) { const float send = b ? a16[i] : a16[8 + i]; const float keep = b ? a16[8 + i] : a16[i]; a8[i] = keep + shx<16>(send, lane); } }
            { const bool b = (lane & 8) != 0;
#pragma unroll
              for (int i = 0; i < 4; ++i) { const float send = b ? a8[i] : a8[4 + i]; const float keep = b ? a8[4 + i] : a8[i]; a4[i] = keep + shx<8>(send, lane); } }
            { const bool b = (lane & 4) != 0;
#pragma unroll
              for (int i = 0; i < 2; ++i) { const float send = b ? a4[i] : a4[2 + i]; const float keep = b ? a4[2 + i] : a4[i]; a2[i] = keep + shx<4>(send, lane); } }
            { const bool b = (lane & 2) != 0; const float send = b ? a2[0] : a2[1]; const float keep = b ? a2[1] : a2[0]; a1 = keep + shx<2>(send, lane); }
            a1 += shx<1>(a1, lane);
            float val = a1 + bias_e; const int my_e = (lane >> 1) & 31;
            float sv[4]; int se[4];
#pragma unroll
            for (int r = 0; r < 4; ++r) { float bv = val; int be = my_e;
#define TOPK_STEP(O) { const float ov = shx<O>(bv, lane); const int oe = shxi<O>(be, lane); if (ov > bv || (ov == bv && oe < be)) { bv = ov; be = oe; } }
                TOPK_STEP(2) TOPK_STEP(4) TOPK_STEP(8) TOPK_STEP(16) TOPK_STEP(32)
#undef TOPK_STEP
                sv[r] = bv; se[r] = be; if (my_e == be) val = -INFINITY; }
            const float e1 = __expf(sv[1] - sv[0]), e2 = __expf(sv[2] - sv[0]), e3 = __expf(sv[3] - sv[0]); const float rs = 1.0f / (1.0f + e1 + e2 + e3);
            if (lane < 4) { const int ee = lane == 0 ? se[0] : lane == 1 ? se[1] : lane == 2 ? se[2] : se[3]; const float gg = (lane == 0 ? 1.0f : lane == 1 ? e1 : lane == 2 ? e2 : e3) * rs;
                const int a = tl * 4 + lane; sel_e[a] = ee; sel_g[a] = gg; sel_r[a] = __hip_atomic_fetch_add(&hist[ee], 1, __ATOMIC_RELAXED, __HIP_MEMORY_SCOPE_WORKGROUP); }
        }
        __syncthreads();
        if (tid < 32) base[tid] = (int)__hip_atomic_fetch_add(F.ctl + CW_CNT + 64 * l + tid, (unsigned)hist[tid], RLX_AGENT);
        __syncthreads();
        { const int a = tid, e = sel_e[a], rank = base[e] + sel_r[a], t = tile * 128 + (a >> 2);
          list_t[(size_t)e * LCAP + rank] = t; list_g[(size_t)e * LCAP + rank] = sel_g[a]; tok_e[t * 4 + (a & 3)] = e; tok_r[t * 4 + (a & 3)] = rank; }
        __syncthreads();
    }
}

__device__ __forceinline__ void p_gather(Frame& F, int l) {
    const int total = build_tables(F, l);
    LAS int* st = (LAS int*)(F.lds + TBL_START); LAS int* cn = st + 33;
    const bf16* x1b = (const bf16*)(F.ws + WS_X1B); bf16* xg = (bf16*)(F.ws + WS_H); float* sg = (float*)(F.ws + WS_SG);
    const int* list_t = (const int*)(F.ws + WS_LT); const float* list_g = (const float*)(F.ws + WS_LG);
    const int lane = F.lane, gw = F.vcu * NWAVES + F.wave, NGW = F.G * NWAVES;
    for (int s = gw; s < total; s += NGW) {
        const bool pr = (lane < NE) && (s >= st[lane & 31]);
        const int e = __popcll(__ballot(pr)) - 1; const int r = s - st[e];
        GAS v4u* dst = (GAS v4u*)(xg + (size_t)s * D);
        if (r < cn[e]) { const int t = list_t[(size_t)e * LCAP + r]; const GAS v4u* src = (const GAS v4u*)(x1b + (size_t)t * D);
            dst[lane] = src[lane]; dst[64 + lane] = src[64 + lane]; if (lane == 0) sg[s] = list_g[(size_t)e * LCAP + r]; }
        else { unsigned zz = 0u; asm volatile("" : "+v"(zz)); const v4u z4 = {zz, zz, zz, zz}; dst[lane] = z4; dst[64 + lane] = z4; if (lane == 0) sg[s] = 0.f; }
    }
}

__device__ __forceinline__ void p_ln2(Frame& F, int l, float* dst) {
    (void)build_tables(F, l);
    LAS int* st = (LAS int*)(F.lds + TBL_START);
    const float* x1 = (const float*)(F.ws + WS_X1); const bf16* yb = (const bf16*)(F.ws + WS_H); bf16* xb = (bf16*)(F.ws + WS_XB);
    const int* tok_e = (const int*)(F.ws + WS_TE); const int* tok_r = (const int*)(F.ws + WS_TR);
    const int lane = F.lane, gw = F.vcu * NWAVES + F.wave, NGW = F.G * NWAVES;
    f32x4 lg[4], lb[4];
#pragma unroll
    for (int j = 0; j < 4; ++j) { lg[j] = ((const GAS f32x4*)(INP(21) + l * D))[64 * j + lane]; lb[j] = ((const GAS f32x4*)(INP(22) + l * D))[64 * j + lane]; }
    float dmult = 1.0f;
#if MK_DEBUG
    if (l == DEPTH - 1) { const unsigned mask = __hip_atomic_load(F.ctl + 20000, RLX_AGENT) & ~(unsigned)(MK_DBG_IGNORE); if (mask) dmult = 1.0f + (float)(__ffs((int)mask) - 1); }
#endif
    for (int t = gw; t < T; t += NGW) {
        const GAS f32x4* xr = (const GAS f32x4*)(x1 + (size_t)t * D) + lane;
        f32x4 v[4];
#pragma unroll
        for (int j = 0; j < 4; ++j) v[j] = xr[64 * j] * DN_ALPHA;
#pragma unroll
        for (int k = 0; k < 4; ++k) { const int slot = st[tok_e[t * 4 + k]] + tok_r[t * 4 + k];
            const GAS unsigned long long* yr = (const GAS unsigned long long*)(yb + (size_t)slot * D) + lane;
#pragma unroll
            for (int j = 0; j < 4; ++j) { const unsigned long long w = yr[64 * j]; const unsigned lo = (unsigned)w, hi = (unsigned)(w >> 32);
                v[j].x += bflo(lo); v[j].y += bfhi(lo); v[j].z += bflo(hi); v[j].w += bfhi(hi); } }
        float s = 0.f;
#pragma unroll
        for (int j = 0; j < 4; ++j) s += (v[j].x + v[j].y) + (v[j].z + v[j].w);
        const float mean = wave_sum(s, lane) * (1.f / D); float s2 = 0.f;
#pragma unroll
        for (int j = 0; j < 4; ++j) { v[j] = v[j] - mean; s2 += (v[j].x * v[j].x + v[j].y * v[j].y) + (v[j].z * v[j].z + v[j].w * v[j].w); }
        const float rstd = 1.f / sqrtf(wave_sum(s2, lane) * (1.f / D) + LN_EPS);
        GAS f32x4* orow = (GAS f32x4*)(dst + (size_t)t * D) + lane; GAS unsigned long long* o8 = (GAS unsigned long long*)(xb + (size_t)t * D) + lane;
#pragma unroll
        for (int j = 0; j < 4; ++j) { v[j] = v[j] * rstd * lg[j] + lb[j]; orow[64 * j] = v[j] * dmult;
            o8[64 * j] = (unsigned long long)pk2(v[j].x, v[j].y) | ((unsigned long long)pk2(v[j].z, v[j].w) << 32); }
    }
}

template <int WHICH> __device__ __forceinline__ void p_attention(Frame& F, int l) {
    const bf16* hb = (const bf16*)(F.ws + WS_H); unsigned char* a2 = F.ws + WS_A2;
    const bf16* kB = (const bf16*)(a2 + A2_KB); const bf16* kr = (const bf16*)(a2 + A2_KR); const bf16* qc = (const bf16*)(a2 + A2_QC); const bf16* kvc = (const bf16*)(a2 + A2_KVC);
    bf16* ya = (bf16*)(a2 + A2_YA); bf16* yb = (bf16*)(a2 + A2_YB); bf16* yc = (bf16*)(a2 + A2_YC);
    att::ALAS_PTR lds = (att::ALAS_PTR)F.lds;
    __syncthreads();
    if (WHICH == 0) {
        float mq = fabsf((INP(3) + l * 64)[F.lane]), mk = fabsf((INP(4) + l * 64)[F.lane]);
#define MX_STEP(O) { mq = fmaxf(mq, shx<O>(mq, F.lane)); mk = fmaxf(mk, shx<O>(mk, F.lane)); }
        MX_STEP(1) MX_STEP(2) MX_STEP(4) MX_STEP(8) MX_STEP(16) MX_STEP(32)
#undef MX_STEP
        const float cref = __int_as_float(__builtin_amdgcn_readfirstlane(__float_as_int(8.0f * LOG2E_F * 1.03f * mq * mk)));
        const bool fixed_ok = cref < 60.0f;
        for (int idx = F.vcu; idx < 768; idx += F.G) {
            const int qi = idx >> 8, rem = idx & 255, bk = rem >> 5, qb = rem & 31, b = bk >> 1, kvh = bk & 1, head = kvh * 3 + qi;
            att::UnitP u; const size_t tb = (size_t)b * SEQ, tq = tb + (size_t)qb * 256;
            u.Q = hb + tq * DINP + H_GQ + head * 64; u.ldq = DINP; u.K0 = kB + tb * 128 + kvh * 64; u.ldk0 = 128; u.K1 = nullptr; u.ldk1 = 0;
            u.V = hb + tb * DINP + H_GV + kvh * 64; u.ldv = DINP; u.O = yb + tq * 384 + head * 64; u.ldo = 384; u.nt = SEQ / 64; u.grow0 = qb * 4; u.gain = INP(3) + l * 64; u.kr0 = 0; u.cref = cref;
            if (fixed_ok) att::attn_unit<64, 0>(u, lds, F.tid); else att::attn_unit<64, 3>(u, lds, F.tid);
        }
    }
    if (WHICH == 1) for (int idx = F.vcu; idx < 512; idx += F.G) {
        const int rnd = idx >> 8, rem = idx & 255, p = (rem >> 5) * 2 + rnd, qb = rem & 31, b = p >> 2, h = p & 3;
        att::UnitP u; const size_t tb = (size_t)b * SEQ, tq = tb + (size_t)qb * 256;
        u.Q = qc + tq * 384 + h * 96; u.ldq = 384; u.K0 = kvc + tb * 512 + h * 128; u.ldk0 = 512; u.K1 = kr + tb * 32; u.ldk1 = 32;
        u.V = kvc + tb * 512 + h * 128 + 64; u.ldv = 512; u.O = yc + tq * 256 + h * 64; u.ldo = 256; u.nt = SEQ / 64; u.grow0 = qb * 4; u.gain = nullptr; u.kr0 = 0; u.cref = 0.f;
        att::attn_unit<96, 1>(u, lds, F.tid);
    }
    if (WHICH == 2) for (int idx = F.vcu; idx < 768; idx += F.G) {
        const int b = idx / 192, rem = idx % 192, h = rem >> 5, rg = rem & 31, R0 = rg * 4;
        int r_lo = R0 - 4; r_lo = r_lo < 0 ? 0 : (r_lo > 120 ? 120 : r_lo);
        int r_hi = R0 - 1; r_hi = (r_hi < 0 ? 0 : (r_hi > 120 ? 120 : r_hi)) + 8;
        if ((r_hi - r_lo) & 1) { if (r_hi < 128) ++r_hi; else --r_lo; }
        {
            LAS float* bt = (LAS float*)(F.lds + att::OFF_BIAS); const float* rp = INP(2) + ((size_t)l * 6 + h) * 465;
            if (F.tid < 465) bt[F.tid] = rp[F.tid] * LOG2E_F; }
        att::UnitP u; const size_t tb = (size_t)b * SEQ, tq = tb + (size_t)R0 * 64, tk = tb + (size_t)r_lo * 64;
        u.Q = hb + tq * DINP + H_NAQ + h * 64; u.ldq = DINP; u.K0 = hb + tk * DINP + H_NAK + h * 64; u.ldk0 = DINP; u.K1 = nullptr; u.ldk1 = 0;
        u.V = hb + tk * DINP + H_NAV + h * 64; u.ldv = DINP; u.O = ya + tq * 384 + h * 64; u.ldo = 384; u.nt = r_hi - r_lo; u.grow0 = R0; u.gain = nullptr; u.kr0 = r_lo; u.cref = 0.f;
        att::attn_unit<64, 2>(u, lds, F.tid);
    }
}


struct Args { const float* in[23]; float* out; unsigned char* ws; int ph_lo, ph_hi, use_bar, pad; };
__global__ void __launch_bounds__(NWAVES * 64, 2) mk_fwd(Args args) {
    extern __shared__ __attribute__((aligned(16))) unsigned char lds[];
    const int wave_id = __builtin_amdgcn_readfirstlane((int)threadIdx.x >> 6), bx0 = blockIdx.x, G0 = gridDim.x;
    {   LAS unsigned* z = (LAS unsigned*)((LAS unsigned char*)lds + LDSCTL_OFF); for (int u = threadIdx.x; u < (LDS_BYTES - LDSCTL_OFF) / 4; u += NWAVES * 64) z[u] = 0u; }
    __syncthreads();
    XcdBarrier bar; bar.bar = (unsigned*)(args.ws + WS_CTL) + CW_BAR; bar.x = 0; bar.st = nullptr;
    if (args.use_bar) bar = xcd_barrier_post((unsigned*)(args.ws + WS_CTL) + CW_BAR, (volatile LAS unsigned*)((LAS unsigned char*)lds + MISC_OFF));
    const int lo = args.ph_lo, hi = args.ph_hi;
#define IN(k) (lo <= (k) && (k) < hi)
#define REPEAT(n) for (int rep_ = 0; rep_ < (n); ++rep_)
#define RSEAM(n) do { if (rep_ + 1 < (n)) { XcdBarrier b_ = bar; { GAS unsigned* bb_ = (GAS unsigned*)b_.bar; asm volatile("; rseam %1" : "+s"(bb_) : "n"(__COUNTER__)); b_.bar = (unsigned*)bb_; } xcd_barrier(b_); } } while (0)
#define SEAM(k) do { if (IN(k) && IN((k) + 1)) { XcdBarrier b_ = bar; { GAS unsigned* bb_ = (GAS unsigned*)b_.bar; asm volatile("; seam %1" : "+s"(bb_) : "n"(__COUNTER__)); b_.bar = (unsigned*)bb_; } xcd_barrier(b_); } } while (0)
#define FRAME() Frame F = mkframe<__COUNTER__>((LAS unsigned char*)lds, args.ws, args.out, wave_id, bx0, G0); unsigned char* ws = F.ws; unsigned char* a2 = ws + WS_A2; unsigned char* wb = ws + WS_W + (size_t)l * WB_LAYER; (void)a2; (void)wb

    if (IN(0)) REPEAT(REP_P) { Frame F = mkframe<__COUNTER__>((LAS unsigned char*)lds, args.ws, args.out, wave_id, bx0, G0); p_prologue(F); RSEAM(REP_P); } SEAM(0);

    for (int l = 0; l < DEPTH; ++l) {
        const int pb = 1 + l * PPL;
        if (IN(pb + 0)) REPEAT(REP_A) { FRAME();
            pg8::Gemm g{(const bf16*)(ws + WS_XB), (const bf16*)(wb + WB_IN), T, DINP, 1024, 0}; pg8::StaticOrder S; S.init(T, DINP, F.G, F.bx);
            pg8::EpiStore E{(bf16*)(ws + WS_H), DINP, DINP};
            pg8::gemm_phase<pg8::EpiStore, pg8::StaticOrder, true, true>(F.lds, g, S, E, F.tid); RSEAM(REP_A);
        } SEAM(pb + 0);
        if (IN(pb + 1)) REPEAT(REP_B) { FRAME(); p_prep(F, l); RSEAM(REP_B); } SEAM(pb + 1);
        if (IN(pb + 2)) REPEAT(REP_C) {
            { FRAME(); pg8::Gemm g{(const bf16*)(a2 + A2_CQN), (const bf16*)(wb + WB_UQ), T, 512, 384, 0}; pg8::StaticOrder S; S.init(T, 512, F.G, F.bx);
              pg8::EpiStore E{(bf16*)(a2 + A2_QC), 384, 384};
              pg8::gemm_phase<pg8::EpiStore, pg8::StaticOrder, true, true>(F.lds, g, S, E, F.tid); }
            { FRAME(); pg8::Gemm g{(const bf16*)(a2 + A2_CKVN), (const bf16*)(wb + WB_UKV), T, 512, 256, 0}; pg8::StaticOrder S; S.init(T, 512, F.G, F.bx);
              pg8::EpiStore E{(bf16*)(a2 + A2_KVC), 512, 512};
              pg8::gemm_phase<pg8::EpiStore, pg8::StaticOrder, true, true>(F.lds, g, S, E, F.tid); }
            RSEAM(REP_C);
        } SEAM(pb + 2);
        if (IN(pb + 3)) { REPEAT(REP_DG) { FRAME(); p_attention<0>(F, l); RSEAM(REP_DG); } REPEAT(REP_DM) { FRAME(); p_attention<1>(F, l); RSEAM(REP_DM); } REPEAT(REP_DN) { FRAME(); p_attention<2>(F, l); RSEAM(REP_DN); } } SEAM(pb + 3);
        if (IN(pb + 4)) REPEAT(REP_E) {
#define EFRAME() FRAME(); bf16* hb = (bf16*)(ws + WS_H); float* mix = (float*)(a2 + A2_MIX); bf16* mixed = (bf16*)(a2 + A2_MIXED); pg8::StaticOrder S; S.init(T, 1024, F.G, F.bx)
            { EFRAME(); pg8::Gemm g{(const bf16*)(a2 + A2_YA), (const bf16*)(wb + WB_BA), T, 1024, 384, 0}; pg8::EpiGate<0> E{hb + H_GATE, DINP, mix, mixed};
              pg8::gemm_phase<pg8::EpiGate<0>, pg8::StaticOrder, true, true>(F.lds, g, S, E, F.tid); }
            { EFRAME(); pg8::Gemm g{(const bf16*)(a2 + A2_YB), (const bf16*)(wb + WB_BB), T, 1024, 384, 0}; pg8::EpiGate<1> E{hb + H_GATE + 1024, DINP, mix, mixed};
              pg8::gemm_phase<pg8::EpiGate<1>, pg8::StaticOrder, true, true>(F.lds, g, S, E, F.tid); }
            { EFRAME(); pg8::Gemm g{(const bf16*)(a2 + A2_YC), (const bf16*)(wb + WB_BC), T, 1024, 256, 0}; pg8::EpiGate<2> E{hb + H_GATE + 2048, DINP, mix, mixed};
              pg8::gemm_phase<pg8::EpiGate<2>, pg8::StaticOrder, true, true>(F.lds, g, S, E, F.tid); }
            RSEAM(REP_E);
        } SEAM(pb + 4);
        if (IN(pb + 5)) REPEAT(REP_F) { FRAME(); const float* xcur = (l == 0) ? INP(0) : (const float*)(ws + WS_X2);
            pg8::Gemm g{(const bf16*)(a2 + A2_MIXED), (const bf16*)(wb + WB_OUT), T, 1024, 1024, 0}; pg8::StaticOrder S; S.init(T, 1024, F.G, F.bx);
            pg8::EpiResid E{xcur, (float*)(ws + WS_X1), DN_ALPHA};
            pg8::gemm_phase<pg8::EpiResid, pg8::StaticOrder, true, true>(F.lds, g, S, E, F.tid); RSEAM(REP_F);
        } SEAM(pb + 5);
        if (IN(pb + 6)) { FRAME(); p_ln1_router(F, l); } SEAM(pb + 6);
        if (IN(pb + 7)) REPEAT(REP_I) { FRAME();
            const int total = build_tables(F, l);
            pg8::Gemm g{(const bf16*)(ws + WS_X1B), (const bf16*)(wb + WB_GU), total, 2048, 1024, (size_t)2048 * 1024 * 2};
            pg8::MoeGather gs{(const int*)(ws + WS_LT), (const LAS int*)(F.lds + TBL_START), (const LAS int*)(F.lds + TBL_START) + 33, LCAP};
            pg8::MoeOrder S{8, (total >> 8) * 8, F.G, F.vcu, (const LAS int*)(F.lds + TBL_TILEE)};
            pg8::EpiSwiglu E{(bf16*)(ws + WS_A2), INP(18) + (size_t)l * NE * 2048};
            pg8::gemm_phase<pg8::EpiSwiglu, pg8::MoeOrder, true, true, true, pg8::MoeGather>(F.lds, g, S, E, F.tid, gs); RSEAM(REP_I);
        } SEAM(pb + 7);
        if (IN(pb + 8)) REPEAT(REP_J) { FRAME();
            const int total = build_tables(F, l);
            pg8::Gemm g{(const bf16*)(ws + WS_A2), (const bf16*)(wb + WB_DN), total, 1024, 1024, (size_t)1024 * 1024 * 2};
            pg8::MoeOrder S{4, (total >> 8) * 4, F.G, F.vcu, (const LAS int*)(F.lds + TBL_TILEE)};
            pg8::EpiDown E{(bf16*)(ws + WS_H), INP(20) + (size_t)l * NE * 1024, (const float*)(ws + WS_LG), (const LAS int*)(F.lds + TBL_START), (const LAS int*)(F.lds + TBL_START) + 33, LCAP};
            pg8::gemm_phase<pg8::EpiDown, pg8::MoeOrder, true, true>(F.lds, g, S, E, F.tid); RSEAM(REP_J);
        } SEAM(pb + 8);
        if (IN(pb + 9)) REPEAT(REP_K) { FRAME(); RSEAM(REP_K); p_ln2(F, l, (l == DEPTH - 1) ? F.out : (float*)(ws + WS_X2)); }
        if (l + 1 < DEPTH) SEAM(pb + 9);
    }
#undef IN
#undef SEAM
}


#if MK_DEBUG
constexpr int CW_DBG = 20000;
__device__ __forceinline__ float bfr(float f) { return __uint_as_float(f2bf(f) << 16); }
__device__ __forceinline__ float bfv(const bf16* p) { return __uint_as_float(((unsigned)*p) << 16); }
__device__ __forceinline__ unsigned hsh(unsigned x) { x ^= x >> 16; x *= 0x7feb352du; x ^= x >> 15; x *= 0x846ca68bu; x ^= x >> 16; return x; }
__device__ __forceinline__ bool close_(float got, float ref, float rel, float abs_) { return fabsf(got - ref) <= rel * fabsf(ref) + abs_; }
__device__ __forceinline__ void ropecs(int i, int quarter, int s, float& c, float& sn) {
    const float pos = (i < quarter) ? (float)(s >> 6) : (float)(s & 63); const int m = (i < quarter) ? i : i - quarter;
    const float inv = exp2f(-(float)m / (float)quarter * 13.287712379549449f); const float ang = pos * inv * 0.15915494309189535f; c = __builtin_amdgcn_cosf(ang); sn = __builtin_amdgcn_sinf(ang);
}
#define DBG_FAIL(bit) atomicOr((unsigned*)(ws + WS_CTL) + CW_DBG, 1u << (bit))
template <int stage> __global__ void __launch_bounds__(256) dbg_kernel(Args args) {
    unsigned char* ws = args.ws; const int l = 0;
    const int gid = blockIdx.x * 256 + threadIdx.x;
    const bf16* hb = (const bf16*)(ws + WS_H); unsigned char* a2 = ws + WS_A2; unsigned char* wb = ws + WS_W + (size_t)l * WB_LAYER;
    const bf16* kB = (const bf16*)(a2 + A2_KB); const bf16* cqn = (const bf16*)(a2 + A2_CQN); const bf16* ckvn = (const bf16*)(a2 + A2_CKVN); const bf16* kr = (const bf16*)(a2 + A2_KR);
    const bf16* qc = (const bf16*)(a2 + A2_QC); const bf16* kvc = (const bf16*)(a2 + A2_KVC);
    const bf16* ya = (const bf16*)(a2 + A2_YA); const bf16* yb = (const bf16*)(a2 + A2_YB); const bf16* yc = (const bf16*)(a2 + A2_YC);
    const unsigned h1 = hsh(gid * 2654435761u + 12345u + stage * 977u), h2 = hsh(h1 + 0x9e3779b9u);
    const int t = h1 % T, s = t & (SEQ - 1), b = t / SEQ;
    if (stage == 0) {
        const int n = h2 % DIN; const float* x = args.in[0] + (size_t)t * D; const float* W = args.in[1];
        const float sc = (n < 384) ? 0.125f * LOG2E_F : 1.0f; float r = 0.f;
        for (int k = 0; k < 1024; ++k) r += bfr(x[k]) * bfr(W[(size_t)k * DIN + n] * sc);
        if (!close_(bfv(hb + (size_t)t * DINP + n), r, 0.02f, 0.02f)) DBG_FAIL(1);
    }
    if (stage == 1) {
        const bf16* hr = hb + (size_t)t * DINP;
        {   const int d = h2 % 128, head = d >> 6, dd = d & 63; float ssq = 0.f;
            for (int k = 0; k < 64; ++k) { const float v = bfv(hr + H_GK + head * 64 + k); ssq += v * v; }
            const float rstd = 1.0f / sqrtf(ssq / 64.0f + RMS_EPS); const float* g = args.in[4];
            const int i = dd & 31; const float y1 = bfv(hr + H_GK + head * 64 + i) * rstd * g[i], y2 = bfv(hr + H_GK + head * 64 + i + 32) * rstd * g[i + 32];
            float c, sn; ropecs(i, 16, s, c, sn); const float ref = (dd < 32) ? (y1 * c - y2 * sn) : (y1 * sn + y2 * c);
            if (!close_(bfv(kB + (size_t)t * 128 + d), ref, 0.02f, 0.01f)) DBG_FAIL(2); }
        {   const int d = h2 % 384; float ssq = 0.f; for (int k = 0; k < 384; ++k) { const float v = bfv(hr + H_CQ + k); ssq += v * v; }
            const float ref = bfv(hr + H_CQ + d) / sqrtf(ssq / 384.0f + RMS_EPS) * args.in[5][d];
            if (!close_(bfv(cqn + (size_t)t * 384 + d), ref, 0.02f, 0.01f)) DBG_FAIL(3); }
        {   const int d = h2 % 256; float ssq = 0.f; for (int k = 0; k < 256; ++k) { const float v = bfv(hr + H_CKV + k); ssq += v * v; }
            const float ref = bfv(hr + H_CKV + d) / sqrtf(ssq / 256.0f + RMS_EPS) * args.in[6][d];
            if (!close_(bfv(ckvn + (size_t)t * 256 + d), ref, 0.02f, 0.01f)) DBG_FAIL(4); }
        {   const int d = h2 % 32, i = d & 15; const float x1 = bfv(hr + H_KR + i), x2 = bfv(hr + H_KR + i + 16); float c, sn; ropecs(i, 8, s, c, sn);
            const float ref = (d < 16) ? (x1 * c - x2 * sn) : (x1 * sn + x2 * c);
            if (!close_(bfv(kr + (size_t)t * 32 + d), ref, 0.02f, 0.01f)) DBG_FAIL(5); }
    }
    if (stage == 2) {
        {   const int n = h2 % 384; float r = 0.f; const float sc = 0.10206207261596577f * LOG2E_F;
            for (int k = 0; k < 384; ++k) r += bfv(cqn + (size_t)t * 384 + k) * bfr(args.in[7][(size_t)k * 384 + n] * sc);
            if (!close_(bfv(qc + (size_t)t * 384 + n), r, 0.02f, 0.01f)) DBG_FAIL(6); }
        {   const int n = h2 % 512; float r = 0.f;
            for (int k = 0; k < 256; ++k) r += bfv(ckvn + (size_t)t * 256 + k) * bfr(args.in[8][(size_t)k * 512 + n]);
            if (!close_(bfv(kvc + (size_t)t * 512 + n), r, 0.02f, 0.02f)) DBG_FAIL(7); }
    }
    if (stage == 3) {
        const int gr = s >> 6, gc = s & 63;
        if (gid < 1024) {
            const int h = h2 % 6, dofs = ((h2 >> 8) & 1) * 32; float q[64], o[32];
            _Pragma("unroll") for (int d = 0; d < 64; ++d) { q[d] = bfv(hb + (size_t)t * DINP + H_NAQ + h * 64 + d); }
            _Pragma("unroll") for (int d = 0; d < 32; ++d) o[d] = 0.f;
            int r0 = gr - 4; r0 = r0 < 0 ? 0 : (r0 > 120 ? 120 : r0); int c0 = gc - 8; c0 = c0 < 0 ? 0 : (c0 > 48 ? 48 : c0);
            const float* rp = args.in[2] + (size_t)h * 465; float m = -1e30f, lsum = 0.f;
            for (int pass = 0; pass < 2; ++pass)
                for (int i = 0; i < 8; ++i) for (int j = 0; j < 16; ++j) { const int kr_ = r0 + i, kc = c0 + j; const size_t kt = (size_t)b * SEQ + kr_ * 64 + kc;
                    float sc = 0.f; _Pragma("unroll") for (int d = 0; d < 64; ++d) sc += q[d] * bfv(hb + kt * DINP + H_NAK + h * 64 + d);
                    sc += rp[(kr_ - gr + 7) * 31 + (kc - gc + 15)] * LOG2E_F;
                    if (pass == 0) m = fmaxf(m, sc); else { const float p = exp2f(sc - m); lsum += p; _Pragma("unroll") for (int d = 0; d < 32; ++d) o[d] += p * bfv(hb + kt * DINP + H_NAV + h * 64 + dofs + d); } }
            bool bad = false; _Pragma("unroll") for (int d = 0; d < 32; ++d) bad |= !close_(bfv(ya + (size_t)t * 384 + h * 64 + dofs + d), o[d] / lsum, 0.03f, 0.01f);
            if (bad) DBG_FAIL(8);
        } else if (gid < 1024 + 128) {
            const int head = h2 % 6, kvh = head / 3, dofs = ((h2 >> 8) & 1) * 32; float q[64], o[32]; float ssq = 0.f;
            _Pragma("unroll") for (int d = 0; d < 64; ++d) { q[d] = bfv(hb + (size_t)t * DINP + H_GQ + head * 64 + d); ssq += q[d] * q[d]; }
            _Pragma("unroll") for (int d = 0; d < 32; ++d) o[d] = 0.f;
            const float rstd = 1.0f / sqrtf(ssq / 64.0f + RMS_EPS);
            _Pragma("unroll") for (int d = 0; d < 64; ++d) q[d] = q[d] * rstd * args.in[3][d];
            _Pragma("unroll") for (int i = 0; i < 32; ++i) { float c, sn; ropecs(i, 16, s, c, sn); const float y1 = q[i], y2 = q[i + 32]; q[i] = y1 * c - y2 * sn; q[i + 32] = y1 * sn + y2 * c; }
            _Pragma("unroll") for (int d = 0; d < 64; ++d) q[d] = bfr(q[d] * 0.125f * LOG2E_F);
            float m = -1e30f, lsum = 0.f;
            for (int key = 0; key < SEQ; ++key) { const size_t kt = (size_t)b * SEQ + key; float sc = 0.f;
                _Pragma("unroll") for (int d = 0; d < 64; ++d) sc += q[d] * bfv(kB + kt * 128 + kvh * 64 + d);
                const float mn = fmaxf(m, sc), al = exp2f(m - mn), p = exp2f(sc - mn); m = mn; lsum = lsum * al + p;
                _Pragma("unroll") for (int d = 0; d < 32; ++d) o[d] = o[d] * al + p * bfv(hb + kt * DINP + H_GV + kvh * 64 + dofs + d); }
            bool bad = false; _Pragma("unroll") for (int d = 0; d < 32; ++d) bad |= !close_(bfv(yb + (size_t)t * 384 + head * 64 + dofs + d), o[d] / lsum, 0.03f, 0.003f);
            if (bad) DBG_FAIL(9);
        } else if (gid < 1024 + 256) {
            const int h = h2 % 4, dofs = ((h2 >> 8) & 1) * 32; float q[96], o[32];
            _Pragma("unroll") for (int d = 0; d < 96; ++d) q[d] = bfv(qc + (size_t)t * 384 + h * 96 + d);
            _Pragma("unroll") for (int i = 0; i < 16; ++i) { float c, sn; ropecs(i, 8, s, c, sn); const float y1 = q[64 + i], y2 = q[80 + i]; q[64 + i] = bfr(y1 * c - y2 * sn); q[80 + i] = bfr(y1 * sn + y2 * c); }
            _Pragma("unroll") for (int d = 0; d < 32; ++d) o[d] = 0.f;
            float m = -1e30f, lsum = 0.f;
            for (int key = 0; key < SEQ; ++key) { const size_t kt = (size_t)b * SEQ + key; float sc = 0.f;
                _Pragma("unroll") for (int d = 0; d < 64; ++d) sc += q[d] * bfv(kvc + kt * 512 + h * 128 + d);
                _Pragma("unroll") for (int d = 0; d < 32; ++d) sc += q[64 + d] * bfv(kr + kt * 32 + d);
                const float mn = fmaxf(m, sc), al = exp2f(m - mn), p = exp2f(sc - mn); m = mn; lsum = lsum * al + p;
                _Pragma("unroll") for (int d = 0; d < 32; ++d) o[d] = o[d] * al + p * bfv(kvc + kt * 512 + h * 128 + 64 + dofs + d); }
            bool bad = false; _Pragma("unroll") for (int d = 0; d < 32; ++d) bad |= !close_(bfv(yc + (size_t)t * 256 + h * 64 + dofs + d), o[d] / lsum, 0.03f, 0.003f);
            if (bad) DBG_FAIL(10);
        }
    }
    if (stage == 4) {
        const int n = h2 % 1024; float r = 0.f;
        { float a = 0.f; for (int k = 0; k < 384; ++k) a += bfv(ya + (size_t)t * 384 + k) * bfr(args.in[9][(size_t)k * 1024 + n]); r += a / (1.0f + expf(-bfv(hb + (size_t)t * DINP + H_GATE + n))); }
        { float a = 0.f; for (int k = 0; k < 384; ++k) a += bfv(yb + (size_t)t * 384 + k) * bfr(args.in[10][(size_t)k * 1024 + n]); r += a / (1.0f + expf(-bfv(hb + (size_t)t * DINP + H_GATE + 1024 + n))); }
        { float a = 0.f; for (int k = 0; k < 256; ++k) a += bfv(yc + (size_t)t * 256 + k) * bfr(args.in[11][(size_t)k * 1024 + n]); r += a / (1.0f + expf(-bfv(hb + (size_t)t * DINP + H_GATE + 2048 + n))); }
        if (!close_(bfv((const bf16*)(a2 + A2_MIXED) + (size_t)t * 1024 + n), r, 0.02f, 0.003f)) DBG_FAIL(11);
    }
    if (stage == 5) {
        const int n = h2 % 1024; float r = 0.f; const bf16* mx = (const bf16*)(a2 + A2_MIXED) + (size_t)t * 1024;
        for (int k = 0; k < 1024; ++k) r += bfv(mx + k) * bfr(args.in[12][(size_t)k * 1024 + n]);
        r += DN_ALPHA * args.in[0][(size_t)t * D + n];
        if (!close_(((const float*)(ws + WS_X1))[(size_t)t * D + n], r, 0.005f, 0.003f)) DBG_FAIL(12);
    }
    if (stage == 6) {
        const float* x1 = (const float*)(ws + WS_X1) + (size_t)t * D; const int* tok_e = (const int*)(ws + WS_TE); const int* tok_r = (const int*)(ws + WS_TR);
        const int* list_t = (const int*)(ws + WS_LT); const float* list_g = (const float*)(ws + WS_LG);
        float lg[32]; _Pragma("unroll") for (int e = 0; e < 32; ++e) lg[e] = args.in[16][e];
        for (int k = 0; k < 1024; ++k) { const float xv = x1[k]; _Pragma("unroll") for (int e = 0; e < 32; ++e) lg[e] += xv * args.in[15][(size_t)k * 32 + e]; }
        int se[4]; float sv[4]; unsigned used = 0;
        _Pragma("unroll") for (int r = 0; r < 4; ++r) { int be = -1; float bv = -INFINITY; _Pragma("unroll") for (int e = 0; e < 32; ++e) if (!((used >> e) & 1) && lg[e] > bv) { bv = lg[e]; be = e; } se[r] = be; sv[r] = bv; used |= 1u << be; }
        float fifth = -INFINITY; _Pragma("unroll") for (int e = 0; e < 32; ++e) if (!((used >> e) & 1)) fifth = fmaxf(fifth, lg[e]);
        const bool neartie = (sv[3] - fifth) < 2e-3f || (sv[0] - sv[1]) < 2e-3f || (sv[1] - sv[2]) < 2e-3f || (sv[2] - sv[3]) < 2e-3f;
        float den = 0.f; _Pragma("unroll") for (int r = 0; r < 4; ++r) den += expf(sv[r] - sv[0]);
        bool bad = false, badg = false;
        if (!neartie) _Pragma("unroll") for (int r = 0; r < 4; ++r) { const int e = tok_e[t * 4 + r], rk = tok_r[t * 4 + r]; if (e != se[r]) { bad = true; continue; }
            if (rk < 0 || rk >= LCAP || list_t[(size_t)e * LCAP + rk] != t) badg = true; else if (!close_(list_g[(size_t)e * LCAP + rk], expf(sv[r] - sv[0]) / den, 0.01f, 1e-4f)) badg = true; }
        if (bad) DBG_FAIL(13); if (badg) DBG_FAIL(14);
        { float sm = 0.f, sq = 0.f; for (int k = 0; k < 1024; ++k) { const float z = (x1[k] - args.in[14][k]) / args.in[13][k]; sm += z; sq += z * z; }
          if (fabsf(sm / 1024.f) > 2e-3f || fabsf(sq / 1024.f - 1.0f) > 1e-2f) DBG_FAIL(19); }
    }
    if (stage >= 7 && stage <= 9) {
        __shared__ int st[33], cn[32];
        if (threadIdx.x == 0) { int a = 0; for (int e2 = 0; e2 < 32; ++e2) { cn[e2] = (int)((const unsigned*)(ws + WS_CTL))[CW_CNT + 64 * l + e2]; st[e2] = a; a += ((cn[e2] + 255) >> 8) << 8; } st[32] = a; }
        __syncthreads();
        const int total = st[32]; const int sl = h1 % total; int e = 0; for (int k = 1; k < 32; ++k) if (sl >= st[k]) e = k; const int r = sl - st[e];
        const int* list_t = (const int*)(ws + WS_LT); const float* list_g = (const float*)(ws + WS_LG); const float* sg = (const float*)(ws + WS_SG);
        if (stage == 7) { int sum = 0; for (int k = 0; k < 32; ++k) sum += cn[k]; if (sum != TK) DBG_FAIL(15); }
        if (stage == 7 && r < cn[e]) {
            const bf16* xg = (const bf16*)(ws + WS_X1B) + (size_t)list_t[(size_t)e * LCAP + r] * D; const int f = h2 % 1024; const float* W = args.in[17] + (size_t)e * 1024 * 2048;
            float g = args.in[18][e * 2048 + f], u = args.in[18][e * 2048 + 1024 + f];
            for (int k = 0; k < 1024; ++k) { const float xv = bfv(xg + k); g += xv * bfr(W[(size_t)k * 2048 + f]); u += xv * bfr(W[(size_t)k * 2048 + 1024 + f]); }
            g = fminf(g, 7.0f); u = fminf(fmaxf(u, -7.0f), 7.0f); const float ref = g / (1.0f + expf(-1.702f * g)) * (u + 1.0f);
            if (!close_(bfv((const bf16*)(ws + WS_A2) + (size_t)sl * 1024 + f), ref, 0.03f, 0.02f)) DBG_FAIL(16);
        }
        if (stage == 8 && r < cn[e]) {
            const bf16* ab = (const bf16*)(ws + WS_A2) + (size_t)sl * 1024; const int n = h2 % 1024; const float* W = args.in[19] + (size_t)e * 1024 * 1024;
            float y = args.in[20][e * 1024 + n]; for (int k = 0; k < 1024; ++k) y += bfv(ab + k) * bfr(W[(size_t)k * 1024 + n]);
            y *= list_g[(size_t)e * LCAP + r];
            if (!close_(bfv((const bf16*)(ws + WS_H) + (size_t)sl * 1024 + n), y, 0.03f, 0.005f)) DBG_FAIL(17);
        }
        if (stage == 9) {
            const float* x1 = (const float*)(ws + WS_X1) + (size_t)t * D; const int* tok_e = (const int*)(ws + WS_TE); const int* tok_r = (const int*)(ws + WS_TR);
            const bf16* ybf = (const bf16*)(ws + WS_H); float sm = 0.f, sq = 0.f; const int n = h2 % 1024; float vn = 0.f;
            for (int k = 0; k < 1024; ++k) { float v = DN_ALPHA * x1[k]; for (int q = 0; q < 4; ++q) v += bfv(ybf + (size_t)(st[tok_e[t * 4 + q]] + tok_r[t * 4 + q]) * D + k); sm += v; sq += v * v; if (k == n) vn = v; }
            const float mean = sm / 1024.f, var = sq / 1024.f - mean * mean; const float ref = (vn - mean) / sqrtf(var + LN_EPS) * args.in[21][n] + args.in[22][n];
            if (!close_(((const float*)(ws + WS_X2))[(size_t)t * D + n], ref, 0.005f, 0.003f)) DBG_FAIL(18);
        }
    }
}
static void dbg_launch(int stage, const Args& a, hipStream_t stream) {
    switch (stage) {
#define DBGL(k) case k: hipLaunchKernelGGL(dbg_kernel<k>, dim3(8), dim3(256), 0, stream, a); break;
        DBGL(0) DBGL(1) DBGL(2) DBGL(3) DBGL(4) DBGL(5) DBGL(6) DBGL(7) DBGL(8) DBGL(9)
#undef DBGL
    }
}
#endif

extern "C" void kernel_launch(void* const* d_in, const int* in_sizes, int n_in, void* d_out, int out_size, void* d_ws, size_t ws_size, hipStream_t stream) {
    static int grid = 0;
    if (grid == 0) {
        if (n_in != 23 || in_sizes[0] != T * D || out_size != T * D || ws_size < WS_END) { fprintf(stderr, "kernel_launch: unexpected shapes / workspace (%d inputs, ws %zu, need %zu)\n", n_in, ws_size, (size_t)WS_END); grid = -1; return; }
        int dev = 0, cus = 0, per_cu = 0;
        if (hipGetDevice(&dev) != hipSuccess || hipDeviceGetAttribute(&cus, hipDeviceAttributeMultiprocessorCount, dev) != hipSuccess) { grid = -1; return; }
        if (hipFuncSetAttribute((const void*)mk_fwd, hipFuncAttributeMaxDynamicSharedMemorySize, LDS_BYTES) != hipSuccess) { fprintf(stderr, "kernel_launch: hipFuncSetAttribute failed\n"); grid = -1; return; }
        if (hipOccupancyMaxActiveBlocksPerMultiprocessor(&per_cu, (const void*)mk_fwd, NWAVES * 64, LDS_BYTES) != hipSuccess || per_cu < 1) { fprintf(stderr, "kernel_launch: occupancy query reports %d\n", per_cu); }
        (void)hipGetLastError();
        grid = cus;
    }
    if (grid < 0) return;
    if (hipMemsetAsync((char*)d_ws + WS_CTL, 0, CTL_ZERO_BYTES, stream) != hipSuccess) return;
    Args a{};
    for (int i = 0; i < 23; ++i) a.in[i] = (const float*)d_in[i];
    a.out = (float*)d_out; a.ws = (unsigned char*)d_ws; a.pad = 0;
#if MK_ONE_LAUNCH
    a.ph_lo = 0; a.ph_hi = NPH; a.use_bar = 1;
    hipLaunchKernelGGL(mk_fwd, dim3(grid), dim3(NWAVES * 64), LDS_BYTES, stream, a);
#else
    for (int p = 0; p < NPH; ++p) { a.ph_lo = p; a.ph_hi = p + 1; a.use_bar = 0; hipLaunchKernelGGL(mk_fwd, dim3(grid), dim3(NWAVES * 64), LDS_BYTES, stream, a);
#if MK_DEBUG
        if (p >= 1 && p <= PPL) dbg_launch(p - 1, a, stream);
#endif
    }
#endif
    const hipError_t le = hipPeekAtLastError();
    if (le != hipSuccess) fprintf(stderr, "kernel_launch: launch failed: %s\n", hipGetErrorName(le));
}
```

```cpp
#define MK_DEBUG 0
#define MK_ONE_LAUNCH 1
#include <hip/hip_runtime.h>
#include <hip/hip_bf16.h>
#include <cstdio>
#include <cstdint>
namespace pg8 {
#define PG8_LAS __attribute__((address_space(3)))
typedef unsigned short bf16_t;
typedef short bf16x8 __attribute__((ext_vector_type(8)));
typedef float f32x4 __attribute__((ext_vector_type(4)));
typedef unsigned u32x4 __attribute__((ext_vector_type(4)));
constexpr int BM = 256, BK = 64, HALF = 128, HTB = HALF * BK * 2  , STAGE_BYTES = 8 * HTB, NXCD = 8, WGM = 8;

__host__ __device__ __forceinline__ int lds_byte(int r, int c) { const int st = (r >> 4) * 2 + (c >> 5), rr = r & 15, cc = c & 31, ob = rr * 64 + cc * 2; return st * 1024 + (ob ^ (((ob >> 9) & 1) << 5)); }
__host__ __device__ __forceinline__ void stage_rc(int b, int& R, int& C) { const int st = b / 1024, sb = b % 1024, swz = sb ^ (((sb >> 9) & 1) << 5); R = (st >> 1) * 16 + swz / 64; C = (st & 1) * 32 + (swz % 64) / 2; }
__host__ __device__ __forceinline__ int perm32(int rho) { const int n = rho >> 4, i = rho & 15; return 8 * (i >> 2) + 4 * n + (i & 3); }

struct Unit { int pm, pn, e; };
struct Gemm { const bf16_t* A; const bf16_t* Bt; int M, N, K; size_t bstride; size_t astride; };

struct StaticOrder {
    int nM, nN, nwg, G, c;
    __host__ __device__ void init(int M, int N, int G_, int c_) { nM = M / BM; nN = N / BM; nwg = nM * nN; G = G_; c = c_; }
    __host__ __device__ bool next(int i, Unit& u) const {
        const long L = (long)i * G + c; if (L >= nwg) return false;
        int wgid = (int)L; { const int q = nwg / NXCD, r = nwg % NXCD, xcd = wgid % NXCD, off = wgid / NXCD; wgid = (xcd < r ? xcd * (q + 1) : r * (q + 1) + (xcd - r) * q) + off; }
        const int nig = WGM * nN, gid = wgid / nig, fm = gid * WGM, gsz = (nM - fm) < WGM ? (nM - fm) : WGM;
        u.pm = fm + ((wgid % nig) % gsz); u.pn = (wgid % nig) / gsz; u.e = 0; return true;
    }
    __device__ __forceinline__ void a_ready(const Unit&) const {}
    __device__ __forceinline__ void done(const Unit&) const {}
};

__device__ __forceinline__ unsigned cvt_pk_bf16(float lo, float hi) { unsigned r; asm volatile("v_cvt_pk_bf16_f32 %0, %1, %2" : "=v"(r) : "v"(lo), "v"(hi)); return r; }
typedef float f32x2 __attribute__((ext_vector_type(2)));


__device__ __forceinline__ float bf_lo(unsigned w) { return __uint_as_float(w << 16); }
__device__ __forceinline__ float bf_hi(unsigned w) { return __uint_as_float(w & 0xffff0000u); }
__device__ __forceinline__ float sigmoidf_(float z) { return __builtin_amdgcn_rcpf(1.0f + __builtin_amdgcn_exp2f(-1.4426950408889634f * z)); }
__device__ __forceinline__ u32x4 pack8(const f32x4& v0, const f32x4& v1) { u32x4 w; w.x = cvt_pk_bf16(v0[0], v0[1]); w.y = cvt_pk_bf16(v0[2], v0[3]); w.z = cvt_pk_bf16(v1[0], v1[1]); w.w = cvt_pk_bf16(v1[2], v1[3]); return w; }

struct EpiStore {
    static constexpr bool PERM = true, AFTER_DRAIN = false, CHAIN = false;
    bf16_t* O; int ldc; int nvalid;
    __device__ __forceinline__ void operator()(const f32x4 (&acc)[2][2][4][2], const Unit& u, int wr, int wc, int fr, int fq) const {
        const int row0 = u.pm * BM + wr * 64 + fr, col0 = u.pn * BM + wc * 32 + 8 * fq;
#pragma unroll
        for (int ai = 0; ai < 2; ++ai)
#pragma unroll
            for (int m = 0; m < 4; ++m) { bf16_t* rowp = O + (size_t)(row0 + ai * HALF + m * 16) * ldc + col0;
#pragma unroll
                for (int bj = 0; bj < 2; ++bj) { if (col0 + bj * HALF < nvalid) *(u32x4*)(rowp + bj * HALF) = pack8(acc[ai][bj][m][0], acc[ai][bj][m][1]); } }
    }
};
struct EpiGateChain {
    static constexpr bool PERM = true, AFTER_DRAIN = false, CHAIN = true;
    const bf16_t* gate; int ldg; bf16_t* mixed;
    __device__ __forceinline__ void chain(f32x4 (&acc)[2][2][4][2], const Unit& u, int wr, int wc, int fr, int fq) const {
        const int row0 = u.pm * BM + wr * 64 + fr, col0 = u.pn * BM + wc * 32 + 8 * fq;
#pragma unroll
        for (int ai = 0; ai < 2; ++ai)
#pragma unroll
            for (int m = 0; m < 4; ++m) { const size_t row = (size_t)(row0 + ai * HALF + m * 16);
#pragma unroll
                for (int bj = 0; bj < 2; ++bj) { const int col = col0 + bj * HALF;
                    const u32x4 ga = *(const u32x4*)(gate + row * ldg + u.e * 1024 + col);
                    f32x4 na0 = {1.f + __builtin_amdgcn_exp2f(-1.4426950408889634f * bf_lo(ga.x)), 1.f + __builtin_amdgcn_exp2f(-1.4426950408889634f * bf_hi(ga.x)), 1.f + __builtin_amdgcn_exp2f(-1.4426950408889634f * bf_lo(ga.y)), 1.f + __builtin_amdgcn_exp2f(-1.4426950408889634f * bf_hi(ga.y))};
                    f32x4 na1 = {1.f + __builtin_amdgcn_exp2f(-1.4426950408889634f * bf_lo(ga.z)), 1.f + __builtin_amdgcn_exp2f(-1.4426950408889634f * bf_hi(ga.z)), 1.f + __builtin_amdgcn_exp2f(-1.4426950408889634f * bf_lo(ga.w)), 1.f + __builtin_amdgcn_exp2f(-1.4426950408889634f * bf_hi(ga.w))};
                    f32x4 f0, f1;
#pragma unroll
                    for (int q = 0; q < 4; ++q) { f0[q] = __builtin_amdgcn_rcpf(na0[q]); f1[q] = __builtin_amdgcn_rcpf(na1[q]); }
                    if (u.e < 2) { const u32x4 gb = *(const u32x4*)(gate + row * ldg + (u.e + 1) * 1024 + col);
                        f0[0] *= 1.f + __builtin_amdgcn_exp2f(-1.4426950408889634f * bf_lo(gb.x)); f0[1] *= 1.f + __builtin_amdgcn_exp2f(-1.4426950408889634f * bf_hi(gb.x));
                        f0[2] *= 1.f + __builtin_amdgcn_exp2f(-1.4426950408889634f * bf_lo(gb.y)); f0[3] *= 1.f + __builtin_amdgcn_exp2f(-1.4426950408889634f * bf_hi(gb.y));
                        f1[0] *= 1.f + __builtin_amdgcn_exp2f(-1.4426950408889634f * bf_lo(gb.z)); f1[1] *= 1.f + __builtin_amdgcn_exp2f(-1.4426950408889634f * bf_hi(gb.z));
                        f1[2] *= 1.f + __builtin_amdgcn_exp2f(-1.4426950408889634f * bf_lo(gb.w)); f1[3] *= 1.f + __builtin_amdgcn_exp2f(-1.4426950408889634f * bf_hi(gb.w)); }
                    acc[ai][bj][m][0] *= f0; acc[ai][bj][m][1] *= f1;
                    if (u.e == 2) *(u32x4*)(mixed + row * 1024 + col) = pack8(acc[ai][bj][m][0], acc[ai][bj][m][1]); } }
    }
};
struct ChainOrder {
    StaticOrder so; int nch;
    __device__ __forceinline__ bool next(int i, Unit& u) const { const int t = i / nch; if (!so.next(t, u)) return false; u.e = i - t * nch; return true; }
    __device__ __forceinline__ void a_ready(const Unit&) const {}
    __device__ __forceinline__ void done(const Unit&) const {}
};
struct EpiResid {
    static constexpr bool PERM = true, AFTER_DRAIN = false, CHAIN = false;
    const float* x; float* pre; float alpha;
    __device__ __forceinline__ void operator()(const f32x4 (&acc)[2][2][4][2], const Unit& u, int wr, int wc, int fr, int fq) const {
        const int row0 = u.pm * BM + wr * 64 + fr, col0 = u.pn * BM + wc * 32 + 8 * fq;
#pragma unroll
        for (int ai = 0; ai < 2; ++ai)
#pragma unroll
            for (int m = 0; m < 4; ++m) { const size_t row = (size_t)(row0 + ai * HALF + m * 16);
#pragma unroll
                for (int bj = 0; bj < 2; ++bj) { const size_t off = row * 1024 + col0 + bj * HALF;
                    const f32x4 x0 = *(const f32x4*)(x + off), x1 = *(const f32x4*)(x + off + 4);
                    *(f32x4*)(pre + off) = x0 * alpha + acc[ai][bj][m][0]; *(f32x4*)(pre + off + 4) = x1 * alpha + acc[ai][bj][m][1]; } }
    }
};
struct EpiSwiglu {
    static constexpr bool PERM = true, AFTER_DRAIN = false, CHAIN = false;
    bf16_t* a; const float* bias;
    __device__ __forceinline__ void operator()(const f32x4 (&acc)[2][2][4][2], const Unit& u, int wr, int wc, int fr, int fq) const {
        const int row0 = u.pm * BM + wr * 64 + fr, j0 = wc * 32 + 8 * fq, oc = u.pn * HALF + j0;
        const float* bg = bias + (size_t)u.e * 2048 + oc; const float* bu = bg + 1024;
        const f32x4 bg0 = *(const f32x4*)bg, bg1 = *(const f32x4*)(bg + 4), bu0 = *(const f32x4*)bu, bu1 = *(const f32x4*)(bu + 4);
#pragma unroll
        for (int ai = 0; ai < 2; ++ai)
#pragma unroll
            for (int m = 0; m < 4; ++m) { const size_t row = (size_t)(row0 + ai * HALF + m * 16);
                f32x4 g[2] = {acc[ai][0][m][0] + bg0, acc[ai][0][m][1] + bg1}, uu[2] = {acc[ai][1][m][0] + bu0, acc[ai][1][m][1] + bu1}, r[2];
#pragma unroll
                for (int n = 0; n < 2; ++n)
#pragma unroll
                    for (int q = 0; q < 4; ++q) { const float gg = fminf(g[n][q], 7.0f), uc = fminf(fmaxf(uu[n][q], -7.0f), 7.0f);
                        r[n][q] = gg * sigmoidf_(1.702f * gg) * (uc + 1.0f); }
                *(u32x4*)(a + row * 1024 + oc) = pack8(r[0], r[1]); }
    }
};
struct EpiDown {
    static constexpr bool PERM = true, AFTER_DRAIN = false, CHAIN = false;
    bf16_t* y; const float* bias; const float* list_g; const PG8_LAS int* st; const PG8_LAS int* cn; int lcap;
    __device__ __forceinline__ void operator()(const f32x4 (&acc)[2][2][4][2], const Unit& u, int wr, int wc, int fr, int fq) const {
        const int row0 = u.pm * BM + wr * 64 + fr, col0 = u.pn * BM + wc * 32 + 8 * fq;
        const int st_e = st[u.e], cn_e = cn[u.e];
        f32x4 bv[2][2];
#pragma unroll
        for (int bj = 0; bj < 2; ++bj)
#pragma unroll
            for (int n = 0; n < 2; ++n) bv[bj][n] = *(const f32x4*)(bias + (size_t)u.e * 1024 + col0 + bj * HALF + 4 * n);
#pragma unroll
        for (int ai = 0; ai < 2; ++ai)
#pragma unroll
            for (int m = 0; m < 4; ++m) { const size_t row = (size_t)(row0 + ai * HALF + m * 16); const int rank = (int)row - st_e;
                const float gt = rank < cn_e ? list_g[(size_t)u.e * lcap + rank] : 0.f;
#pragma unroll
                for (int bj = 0; bj < 2; ++bj) { const f32x4 v0 = (acc[ai][bj][m][0] + bv[bj][0]) * gt, v1 = (acc[ai][bj][m][1] + bv[bj][1]) * gt;
                    *(u32x4*)(y + row * 1024 + col0 + bj * HALF) = pack8(v0, v1); } }
    }
};
struct MoeGather {
    const int* list_t; const PG8_LAS int* st; const PG8_LAS int* cn; int lcap;
    __device__ __forceinline__ int row(const Unit& u, int r) const { int rank = u.pm * BM + r - st[u.e]; const int c = cn[u.e]; rank = rank < c ? rank : c - 1; return list_t[(size_t)u.e * lcap + rank]; }
};
struct MoeOrder {
    int nN, nunits, G, c; const PG8_LAS int* tile_e;
    __device__ __forceinline__ bool next(int i, Unit& u) const {
        const long L = (long)i * G + c; if (L >= nunits) return false;
        const int tile = (int)L / nN; u.pm = tile; u.pn = (int)L % nN; u.e = __builtin_amdgcn_readfirstlane(tile_e[tile]); return true;
    }
    __device__ __forceinline__ void a_ready(const Unit&) const {}
    __device__ __forceinline__ void done(const Unit&) const {}
};

struct NoGather { };
template <class Epi, class Sched, bool ALIGN_EPI = false, bool SP2 = false, bool GATHER = false, class GS = NoGather>
__device__ __forceinline__ void gemm_phase(PG8_LAS unsigned char* lds, const Gemm g, const Sched& S, const Epi& E, const int tid, const GS gs = GS()) {
    const int wid = __builtin_amdgcn_readfirstlane(tid >> 6), lane = tid & 63, wr = wid >> 2, wc = wid & 3, fr = lane & 15, fq = lane >> 4;
    const int K = g.K, nt = K / BK;
    unsigned voffA[2], voffB[2];
#pragma unroll
    for (int i = 0; i < 2; ++i) { int R, C; stage_rc(tid * 16 + i * 8192, R, C); const int Rb = Epi::PERM ? ((R & ~31) + perm32(R & 31)) : R;
        voffA[i] = (unsigned)(R * K + C) * 2u; voffB[i] = (unsigned)(Rb * K + C) * 2u; }
    unsigned vc0[2], vc1[2], vn0[2], vn1[2];
#define PG8_GROWS(u_, o0, o1) do { _Pragma("unroll") for (int i_ = 0; i_ < 2; ++i_) { int R_, C_; stage_rc(tid * 16 + i_ * 8192, R_, C_); \
        o0[i_] = (unsigned)gs.row((u_), R_) * (unsigned)(K * 2) + (unsigned)(C_ * 2); o1[i_] = (unsigned)gs.row((u_), HALF + R_) * (unsigned)(K * 2) + (unsigned)(C_ * 2); } } while (0)
    const size_t kstep = (size_t)(BK * 2);
    const size_t hstep = (size_t)HALF * K * 2;
    const size_t tstep = 2 * hstep;
    const unsigned ldsw = (unsigned)wid * 1024u;
    const int aoff = lds_byte(wr * 64 + fr, fq * 8), boff = lds_byte(wc * 32 + fr, fq * 8);
#define PG8_SA(b, h) (((b) * 2 + (h)) * HTB)
#define PG8_SB(b, h) ((4 + (b) * 2 + (h)) * HTB)
#define PG8_STAGE(bufoff, gbase, voff) do { _Pragma("unroll") for (int _i = 0; _i < 2; ++_i) \
        __builtin_amdgcn_global_load_lds((const unsigned*)((const char*)(gbase) + (voff)[_i]), (PG8_LAS unsigned*)(lds + (bufoff) + ldsw + _i * 8192), 16, 0, 0); } while (0)
#define PG8_LDA(dst, b, h) do { _Pragma("unroll") for (int m = 0; m < 4; ++m) _Pragma("unroll") for (int k = 0; k < 2; ++k) dst[m][k] = *(const PG8_LAS bf16x8*)(lds + PG8_SA(b, h) + aoff + m * 2048 + k * 1024); } while (0)
#define PG8_LDB(dst, b, h) do { _Pragma("unroll") for (int n = 0; n < 2; ++n) _Pragma("unroll") for (int k = 0; k < 2; ++k) dst[n][k] = *(const PG8_LAS bf16x8*)(lds + PG8_SB(b, h) + boff + n * 2048 + k * 1024); } while (0)
#define PG8_MMA(ai, bj, At, Bt) do { __builtin_amdgcn_s_setprio(1); _Pragma("unroll") for (int m = 0; m < 4; ++m) _Pragma("unroll") for (int n = 0; n < 2; ++n) _Pragma("unroll") for (int k = 0; k < 2; ++k) \
        acc[ai][bj][m][n] = __builtin_amdgcn_mfma_f32_16x16x32_bf16(Bt[n][k], At[m][k], acc[ai][bj][m][n], 0, 0, 0); __builtin_amdgcn_s_setprio(0); } while (0)
#define PG8_WAIT_V(n) asm volatile("s_waitcnt vmcnt(" #n ")" ::: "memory")
#define PG8_WAIT_L(n) asm volatile("s_waitcnt lgkmcnt(" #n ")" ::: "memory")
#define PG8_BAR __builtin_amdgcn_s_barrier()
#define PG8_SCHED __builtin_amdgcn_sched_barrier(0)
    Unit cur, nxt; int ui = 0;
    if (!S.next(0, cur)) return;
    f32x4 acc[2][2][4][2];
#pragma unroll
    for (int a = 0; a < 2; ++a)
#pragma unroll
        for (int b = 0; b < 2; ++b)
#pragma unroll
            for (int m = 0; m < 4; ++m)
#pragma unroll
                for (int n = 0; n < 2; ++n) acc[a][b][m][n] = (f32x4){0.f, 0.f, 0.f, 0.f};
    bf16x8 At[4][2], B0[2][2], B1[2][2];
    const char* cA = GATHER ? (const char*)g.A : (const char*)g.A + (size_t)cur.pm * tstep + (size_t)cur.e * g.astride;
    if constexpr (GATHER) { PG8_GROWS(cur, vc0, vc1); } else { _Pragma("unroll") for (int i = 0; i < 2; ++i) { vc0[i] = voffA[i]; vc1[i] = voffA[i] + (unsigned)hstep; } }
#pragma unroll
    for (int i = 0; i < 2; ++i) { vn0[i] = vc0[i]; vn1[i] = vc1[i]; }
    const char* cB = (const char*)g.Bt + (size_t)cur.pn * tstep + (size_t)cur.e * g.bstride;
    S.a_ready(cur);
    if constexpr (SP2) {
        PG8_STAGE(PG8_SB(0, 0), cB, voffB); PG8_STAGE(PG8_SB(0, 1), cB + hstep, voffB); PG8_STAGE(PG8_SA(0, 0), cA, vc0); PG8_STAGE(PG8_SA(0, 1), cA, vc1);
        if (wr == 1) PG8_BAR;
        PG8_WAIT_V(2); PG8_BAR;
        PG8_STAGE(PG8_SB(1, 0), cB + kstep, voffB); PG8_STAGE(PG8_SA(1, 0), cA + kstep, vc0); PG8_STAGE(PG8_SB(1, 1), cB + hstep + kstep, voffB);
        PG8_WAIT_V(6); PG8_BAR;
    } else {
        PG8_STAGE(PG8_SB(0, 0), cB, voffB); PG8_STAGE(PG8_SA(0, 0), cA, vc0); PG8_STAGE(PG8_SB(0, 1), cB + hstep, voffB); PG8_STAGE(PG8_SA(0, 1), cA, vc1);
        if (wr == 1) PG8_BAR;
        PG8_WAIT_V(4); PG8_BAR;
        PG8_STAGE(PG8_SB(1, 0), cB + kstep, voffB); PG8_STAGE(PG8_SA(1, 0), cA + kstep, vc0); PG8_STAGE(PG8_SB(1, 1), cB + hstep + kstep, voffB);
        PG8_WAIT_V(6); PG8_BAR;
    }
    for (;;) {
        const bool has_next = S.next(ui + 1, nxt);
        const char* nA = GATHER ? cA : (has_next ? (const char*)g.A + (size_t)nxt.pm * tstep + (size_t)nxt.e * g.astride : cA);
        if constexpr (GATHER) { if (has_next) { PG8_GROWS(nxt, vn0, vn1); } } const char* nB = has_next ? (const char*)g.Bt + (size_t)nxt.pn * tstep + (size_t)nxt.e * g.bstride : cB;
        for (int t = 0; t < nt; t += 2) {
            const bool last = (t == nt - 2);
            const char* a1 = cA + (size_t)(t + 1) * kstep;
            const char* a2 = last ? nA : cA + (size_t)(t + 2) * kstep; const char* b2 = last ? nB : cB + (size_t)(t + 2) * kstep;
            const char* a3 = a2 + kstep; const char* b3 = b2 + kstep;
            unsigned vs0[2], vs1[2];
#pragma unroll
            for (int i = 0; i < 2; ++i) { vs0[i] = (GATHER && last) ? vn0[i] : vc0[i]; vs1[i] = (GATHER && last) ? vn1[i] : vc1[i]; }
            if (last && has_next) S.a_ready(nxt);
            if constexpr (SP2) {
            PG8_LDB(B0, 0, 0); PG8_LDB(B1, 0, 1); PG8_SCHED; PG8_LDA(At, 0, 0); PG8_STAGE(PG8_SA(1, 1), a1, vc1);
            PG8_WAIT_V(8); PG8_WAIT_L(0); PG8_BAR; PG8_MMA(0, 0, At, B0); PG8_MMA(0, 1, At, B1); PG8_BAR; PG8_SCHED;
            PG8_LDA(At, 0, 1); PG8_STAGE(PG8_SB(0, 0), b2, voffB); PG8_STAGE(PG8_SB(0, 1), b2 + hstep, voffB); PG8_STAGE(PG8_SA(0, 0), a2, vs0);
            PG8_WAIT_V(8); PG8_WAIT_L(0); PG8_BAR; PG8_MMA(1, 0, At, B0); PG8_MMA(1, 1, At, B1); PG8_BAR; PG8_SCHED;
            PG8_LDB(B0, 1, 0); PG8_LDB(B1, 1, 1); PG8_SCHED; PG8_LDA(At, 1, 0); PG8_STAGE(PG8_SA(0, 1), a2, vs1);
            PG8_WAIT_V(8); PG8_WAIT_L(0); PG8_BAR; PG8_MMA(0, 0, At, B0); PG8_MMA(0, 1, At, B1); PG8_BAR; PG8_SCHED;
            PG8_LDA(At, 1, 1); PG8_STAGE(PG8_SB(1, 0), b3, voffB); PG8_STAGE(PG8_SB(1, 1), b3 + hstep, voffB); PG8_STAGE(PG8_SA(1, 0), a3, vs0);
            PG8_WAIT_V(8); PG8_WAIT_L(0); PG8_BAR; PG8_MMA(1, 0, At, B0); PG8_MMA(1, 1, At, B1); PG8_BAR; PG8_SCHED;
            } else {
            PG8_LDB(B0, 0, 0); PG8_SCHED; PG8_LDA(At, 0, 0); PG8_STAGE(PG8_SA(1, 1), a1, vc1);
            PG8_WAIT_L(8); PG8_BAR; PG8_WAIT_L(0); PG8_MMA(0, 0, At, B0); PG8_BAR; PG8_SCHED;
            PG8_LDB(B1, 0, 1); PG8_STAGE(PG8_SB(0, 0), b2, voffB);
            PG8_BAR; PG8_WAIT_L(0); PG8_MMA(0, 1, At, B1); PG8_BAR;
            PG8_LDA(At, 0, 1); PG8_STAGE(PG8_SA(0, 0), a2, vs0);
            PG8_BAR; PG8_WAIT_L(0); PG8_MMA(1, 0, At, B0); PG8_BAR; PG8_SCHED;
            PG8_STAGE(PG8_SB(0, 1), b2 + hstep, voffB);
            PG8_WAIT_V(6); PG8_BAR; PG8_MMA(1, 1, At, B1); PG8_BAR;
            PG8_LDB(B0, 1, 0); PG8_SCHED; PG8_LDA(At, 1, 0); PG8_STAGE(PG8_SA(0, 1), a2, vs1);
            PG8_WAIT_L(8); PG8_BAR; PG8_WAIT_L(0); PG8_MMA(0, 0, At, B0); PG8_BAR; PG8_SCHED;
            PG8_LDB(B1, 1, 1); PG8_STAGE(PG8_SB(1, 0), b3, voffB);
            PG8_BAR; PG8_WAIT_L(0); PG8_MMA(0, 1, At, B1); PG8_BAR;
            PG8_LDA(At, 1, 1); PG8_STAGE(PG8_SA(1, 0), a3, vs0);
            PG8_BAR; PG8_WAIT_L(0); PG8_MMA(1, 0, At, B0); PG8_BAR; PG8_SCHED;
            PG8_STAGE(PG8_SB(1, 1), b3 + hstep, voffB);
            PG8_WAIT_V(6); PG8_BAR; PG8_MMA(1, 1, At, B1); PG8_BAR;
            }
        }
        if constexpr (ALIGN_EPI) { if (wr == 0) PG8_BAR; }
        if constexpr (!Epi::AFTER_DRAIN) { if constexpr (Epi::CHAIN) E.chain(acc, cur, wr, wc, fr, fq); else E(acc, cur, wr, wc, fr, fq); S.done(cur); }
        if (!has_next) break;
        if (!(Epi::CHAIN && nxt.e != 0)) {
#pragma unroll
        for (int a = 0; a < 2; ++a)
#pragma unroll
            for (int b = 0; b < 2; ++b)
#pragma unroll
                for (int m = 0; m < 4; ++m)
#pragma unroll
                    for (int n = 0; n < 2; ++n) acc[a][b][m][n] = (f32x4){0.f, 0.f, 0.f, 0.f};
        }
        cur = nxt; cA = nA; cB = nB; ++ui;
        if constexpr (GATHER) { _Pragma("unroll") for (int i = 0; i < 2; ++i) { vc0[i] = vn0[i]; vc1[i] = vn1[i]; } }
        if constexpr (ALIGN_EPI) { if (wr == 1) PG8_BAR; }
    }
    PG8_WAIT_V(0);
    if constexpr (!ALIGN_EPI) { if (wr == 0) PG8_BAR; }
    PG8_BAR;
    if constexpr (Epi::AFTER_DRAIN) { E.fused(acc, cur, wr, wc, fr, fq, lds, wid, lane); S.done(cur); }
#undef PG8_GROWS
#undef PG8_SA
#undef PG8_SB
#undef PG8_STAGE
#undef PG8_LDA
#undef PG8_LDB
#undef PG8_MMA
#undef PG8_WAIT_V
#undef PG8_WAIT_L
#undef PG8_BAR
#undef PG8_SCHED
}
}


namespace att {
typedef unsigned short bf16_t;
typedef short bf16x8 __attribute__((ext_vector_type(8)));
typedef short s16x4 __attribute__((ext_vector_type(4)));
typedef float f32x16 __attribute__((ext_vector_type(16)));
typedef unsigned u32x4 __attribute__((ext_vector_type(4)));
#define ALAS __attribute__((address_space(3)))
typedef ALAS unsigned char* ALAS_PTR;
#define ASBAR() __builtin_amdgcn_sched_barrier(0)
constexpr int QBLK = 32, KVBLK = 64;
constexpr float THR2 = 11.0f;
constexpr float LOG2E = 1.4426950408889634f, INV2PI = 0.15915494309189535f, LOG2_THETA = 13.287712379549449f;
constexpr int OFF_V = 0, VBUF = 8192, OFF_K = 16384, KBUF_MAX = 13312, OFF_WS = OFF_K + 2 * KBUF_MAX  , OFF_BIAS = OFF_WS + 2048  , ATT_LDS = OFF_BIAS + 2048;
__device__ __forceinline__ int crow(int r, int hi) { return (r & 3) + 8 * (r >> 2) + 4 * hi; }
__device__ __forceinline__ unsigned cvtpk(float lo, float hi) { unsigned r; asm volatile("v_cvt_pk_bf16_f32 %0, %1, %2" : "=v"(r) : "v"(lo), "v"(hi)); return r; }
__device__ __forceinline__ float bf2f(short s) { return __uint_as_float(((unsigned)(unsigned short)s) << 16); }
__device__ __forceinline__ short f2bf_s(float f) { return (short)(cvtpk(f, 0.f) & 0xffffu); }

struct UnitP {
    const bf16_t* Q; int ldq;
    const bf16_t* K0; int ldk0;
    const bf16_t* K1; int ldk1;
    const bf16_t* V; int ldv;
    bf16_t* O; int ldo;
    int nt;
    int grow0;
    const float* gain;
    int kr0;
    float cref;
};

typedef short v4i16_t __attribute__((ext_vector_type(4)));
__device__ __forceinline__ s16x4 vtr(const ALAS unsigned char* p) { return __builtin_bit_cast(s16x4, __builtin_amdgcn_ds_read_tr16_b64_v4i16((ALAS v4i16_t*)p)); }
__device__ __forceinline__ void pv_all(f32x16& o0, f32x16& o1, f32x16& lacc, const ALAS unsigned char* vp, bf16x8 pa0, bf16x8 pa1, bf16x8 pa2, bf16x8 pa3) {
    const bf16x8 ones = {(short)0x3F80, (short)0x3F80, (short)0x3F80, (short)0x3F80, (short)0x3F80, (short)0x3F80, (short)0x3F80, (short)0x3F80};
#define ATT_PK(L, H) (bf16x8){L[0], L[1], L[2], L[3], H[0], H[1], H[2], H[3]}
#define ATT_STEP(KS, PA) { const s16x4 l0 = vtr(vp + (KS) * 1024), h0 = vtr(vp + (KS) * 1024 + 512), l1 = vtr(vp + 4096 + (KS) * 1024), h1 = vtr(vp + 4096 + (KS) * 1024 + 512); \
        o0 = __builtin_amdgcn_mfma_f32_32x32x16_bf16(PA, ATT_PK(l0, h0), o0, 0, 0, 0); o1 = __builtin_amdgcn_mfma_f32_32x32x16_bf16(PA, ATT_PK(l1, h1), o1, 0, 0, 0); \
        lacc = __builtin_amdgcn_mfma_f32_32x32x16_bf16(PA, ones, lacc, 0, 0, 0); }
    ATT_STEP(0, pa0) ATT_STEP(1, pa1) ATT_STEP(2, pa2) ATT_STEP(3, pa3)
#undef ATT_STEP
#undef ATT_PK
}
template <int DQK> __device__ __forceinline__ void qkt(f32x16& p0, f32x16& p1, const ALAS unsigned char* Ks, const bf16x8* qr, const f32x16& cinit, int r32, int hi) {
    constexpr int KST = DQK * 2 + 16;
#pragma unroll
    for (int d0 = 0; d0 < DQK / 16; ++d0) { const int cb = (2 * d0 + hi) * 16;
        const bf16x8 b0 = *(const ALAS bf16x8*)(Ks + r32 * KST + cb);
        const bf16x8 b1 = *(const ALAS bf16x8*)(Ks + (32 + r32) * KST + cb);
        if (d0 == 0) { p0 = __builtin_amdgcn_mfma_f32_32x32x16_bf16(b0, qr[0], cinit, 0, 0, 0); p1 = __builtin_amdgcn_mfma_f32_32x32x16_bf16(b1, qr[0], cinit, 0, 0, 0); }
        else { p0 = __builtin_amdgcn_mfma_f32_32x32x16_bf16(b0, qr[d0], p0, 0, 0, 0); p1 = __builtin_amdgcn_mfma_f32_32x32x16_bf16(b1, qr[d0], p1, 0, 0, 0); } }
}
__device__ __forceinline__ void na_mask(f32x16& p0, f32x16& p1, const ALAS float* btab, int kr, int rq, int qc_in, int hi_in) {
    int qc = qc_in, hi = hi_in; asm volatile("" : "+v"(qc), "+v"(hi));
    int r0 = rq - 4; r0 = r0 < 0 ? 0 : (r0 > 120 ? 120 : r0);
    const bool rowok = (kr >= r0) && (kr < r0 + 8);
    int c0 = qc - 8; c0 = c0 < 0 ? 0 : (c0 > 48 ? 48 : c0);
    int dr = kr - rq + 7; dr = dr < 0 ? 0 : (dr > 14 ? 14 : dr);
    const ALAS float* brow = btab + dr * 31;
#pragma unroll
    for (int r = 0; r < 16; ++r) {
        const int ka = crow(r, hi), kb = 32 + ka;
        int ia = ka - qc + 15; ia = ia < 0 ? 0 : (ia > 30 ? 30 : ia);
        int ib = kb - qc + 15; ib = ib < 0 ? 0 : (ib > 30 ? 30 : ib);
        const bool oka = rowok && (ka >= c0) && (ka < c0 + 16), okb = rowok && (kb >= c0) && (kb < c0 + 16);
        p0[r] = oka ? p0[r] + brow[ia] : -1e30f;
        p1[r] = okb ? p1[r] + brow[ib] : -1e30f;
    }
}
__device__ __forceinline__ void lazySM(f32x16& p0, f32x16& p1, float& m_reg, bool& moved, float& alpha) {
    float pmax = p0[0];
#pragma unroll
    for (int r = 1; r < 16; ++r) pmax = fmaxf(pmax, p0[r]);
#pragma unroll
    for (int r = 0; r < 16; ++r) pmax = fmaxf(pmax, p1[r]);
    { auto rr = __builtin_amdgcn_permlane32_swap(__float_as_uint(pmax), __float_as_uint(pmax), false, false);
      pmax = fmaxf(__uint_as_float(rr[0]), __uint_as_float(rr[1])); }
    if (__builtin_expect(__all(pmax <= THR2), 1)) { alpha = 1.f; }
    else { const float dl = fmaxf(pmax, 0.f); m_reg += dl; alpha = __builtin_amdgcn_exp2f(-dl);
#pragma unroll
        for (int r = 0; r < 16; ++r) { p0[r] -= dl; p1[r] -= dl; }
        moved = true; }
#pragma unroll
    for (int r = 0; r < 16; ++r) p0[r] = __builtin_amdgcn_exp2f(p0[r]);
}
__device__ __forceinline__ void fixedSM(f32x16& p0) {
#pragma unroll
    for (int r = 0; r < 16; ++r) p0[r] = __builtin_amdgcn_exp2f(p0[r]);
}
__device__ __forceinline__ void finishSM(f32x16& p0, f32x16& p1, bf16x8& pa0, bf16x8& pa1, bf16x8& pa2, bf16x8& pa3) {
#pragma unroll
    for (int r = 0; r < 16; ++r) p1[r] = __builtin_amdgcn_exp2f(p1[r]);
    u32x4 w;
    w = (u32x4){cvtpk(p0[0], p0[1]), cvtpk(p0[2], p0[3]), cvtpk(p0[4], p0[5]), cvtpk(p0[6], p0[7])}; pa0 = __builtin_bit_cast(bf16x8, w);
    w = (u32x4){cvtpk(p0[8], p0[9]), cvtpk(p0[10], p0[11]), cvtpk(p0[12], p0[13]), cvtpk(p0[14], p0[15])}; pa1 = __builtin_bit_cast(bf16x8, w);
    w = (u32x4){cvtpk(p1[0], p1[1]), cvtpk(p1[2], p1[3]), cvtpk(p1[4], p1[5]), cvtpk(p1[6], p1[7])}; pa2 = __builtin_bit_cast(bf16x8, w);
    w = (u32x4){cvtpk(p1[8], p1[9]), cvtpk(p1[10], p1[11]), cvtpk(p1[12], p1[13]), cvtpk(p1[14], p1[15])}; pa3 = __builtin_bit_cast(bf16x8, w);
}
template <int DQK, int MODE>
__device__ __forceinline__ void attn_unit(const UnitP& u, ALAS unsigned char* lds, const int tid) {
    constexpr int ND = DQK / 16, KST = DQK * 2 + 16, KBUF = 64 * KST;
    static_assert(KBUF <= KBUF_MAX, "K buffer");
    const int wid = __builtin_amdgcn_readfirstlane(tid >> 6), lane = tid & 63, r32 = lane & 31, hi = lane >> 5;
    ALAS unsigned char* V_lds = lds + OFF_V; ALAS unsigned char* K_lds = lds + OFF_K;
    ALAS float* ws = (ALAS float*)(lds + OFF_WS) + wid * 64; ALAS float* al_l = ws + 32;
    const ALAS float* btab = (const ALAS float*)(lds + OFF_BIAS);
    float m_reg = 0.f; f32x16 o[2], lacc; o[0] = f32x16{}; o[1] = f32x16{}; lacc = f32x16{}; bf16x8 qr[ND];
    bool moved = false;
    const int grow = u.grow0 + (wid >> 1), gcol = (wid & 1) * 32 + r32;
    {
        const bf16_t* Qw = u.Q + (size_t)(wid * QBLK + r32) * u.ldq + hi * 8;
#pragma unroll
        for (int d0 = 0; d0 < ND; ++d0) qr[d0] = *(const bf16x8*)(Qw + d0 * 16);
        if constexpr (MODE == 0 || MODE == 3) {
            float x[4][8]; float ssq = 0.f;
#pragma unroll
            for (int d0 = 0; d0 < 4; ++d0)
#pragma unroll
                for (int j = 0; j < 8; ++j) { x[d0][j] = bf2f(qr[d0][j]); ssq += x[d0][j] * x[d0][j]; }
            { auto rr_ = __builtin_amdgcn_permlane32_swap(__float_as_uint(ssq), __float_as_uint(ssq), false, false); ssq = __uint_as_float(rr_[0]) + __uint_as_float(rr_[1]); }
            const float rstd = 1.0f / sqrtf(ssq * (1.0f / 64.0f) + 1e-6f);
#pragma unroll
            for (int d0 = 0; d0 < 4; ++d0)
#pragma unroll
                for (int j = 0; j < 8; ++j) x[d0][j] = x[d0][j] * rstd * u.gain[16 * d0 + 8 * hi + j];
#pragma unroll
            for (int d0 = 0; d0 < 2; ++d0)
#pragma unroll
                for (int j = 0; j < 8; ++j) { const float inv = exp2f(-(float)(8 * hi + j) * (LOG2_THETA / 16.0f));
                    const float ang = (float)(d0 == 0 ? grow : gcol) * inv * INV2PI; const float c = __builtin_amdgcn_cosf(ang), s = __builtin_amdgcn_sinf(ang);
                    const float y1 = x[d0][j], y2 = x[d0 + 2][j]; x[d0][j] = y1 * c - y2 * s; x[d0 + 2][j] = y1 * s + y2 * c; }
            constexpr float C2 = 0.125f * LOG2E;
#pragma unroll
            for (int d0 = 0; d0 < 4; ++d0) { u32x4 w = {cvtpk(x[d0][0] * C2, x[d0][1] * C2), cvtpk(x[d0][2] * C2, x[d0][3] * C2), cvtpk(x[d0][4] * C2, x[d0][5] * C2), cvtpk(x[d0][6] * C2, x[d0][7] * C2)};
                qr[d0] = __builtin_bit_cast(bf16x8, w); }
        }
        if constexpr (MODE == 1) {
            float y1[8], y2[8];
#pragma unroll
            for (int j = 0; j < 8; ++j) { const float inv = exp2f(-(float)j * (LOG2_THETA / 8.0f));
                const float ang = (float)(hi == 0 ? grow : gcol) * inv * INV2PI; const float c = __builtin_amdgcn_cosf(ang), s = __builtin_amdgcn_sinf(ang);
                const float a = bf2f(qr[4][j]), b = bf2f(qr[5][j]); y1[j] = a * c - b * s; y2[j] = a * s + b * c; }
            u32x4 w = {cvtpk(y1[0], y1[1]), cvtpk(y1[2], y1[3]), cvtpk(y1[4], y1[5]), cvtpk(y1[6], y1[7])}; qr[4] = __builtin_bit_cast(bf16x8, w);
            w = (u32x4){cvtpk(y2[0], y2[1]), cvtpk(y2[2], y2[3]), cvtpk(y2[4], y2[5]), cvtpk(y2[6], y2[7])}; qr[5] = __builtin_bit_cast(bf16x8, w);
        }
    }
    const int sk = tid >> 3, sc = tid & 7;
    const bf16_t* vsrc = u.V + (size_t)sk * u.ldv + sc * 8; const bf16_t* ksrc = u.K0 + (size_t)sk * u.ldk0 + sc * 8;
    const int vst = (sc >> 2) * 4096 + sk * 64 + (sc & 3) * 16, kst = sk * KST + sc * 16;
    const int sk2 = (tid & 255) >> 2, sc2 = tid & 3;
    const bf16_t* k2src = (DQK == 96) ? u.K1 + (size_t)sk2 * u.ldk1 + sc2 * 8 : nullptr;
    const int k2st = sk2 * KST + (8 + sc2) * 16;
    const ALAS unsigned char* vb0 = V_lds + ((lane >> 4) & 1) * 32 + (lane & 3) * 8 + (4 * hi + ((lane & 15) >> 2)) * 64;
    struct { bf16x8 v, k, k2; } sr_[2];
#define ATT_SLOAD(i, k0) do { sr_[i].v = *(const bf16x8*)(vsrc + (size_t)(k0) * u.ldv); sr_[i].k = *(const bf16x8*)(ksrc + (size_t)(k0) * u.ldk0); \
        if constexpr (DQK == 96) sr_[i].k2 = *(const bf16x8*)(k2src + (size_t)(k0) * u.ldk1); } while (0)
#define ATT_SWRITE(b, i) do { *(ALAS bf16x8*)(V_lds + (b) * VBUF + vst) = sr_[i].v; *(ALAS bf16x8*)(K_lds + (b) * KBUF + kst) = sr_[i].k; \
        if constexpr (DQK == 96) *(ALAS bf16x8*)(K_lds + (b) * KBUF + k2st) = sr_[i].k2; } while (0)
#define ATT_SWAIT() do { if constexpr (DQK == 96) asm volatile("s_waitcnt vmcnt(3)" ::: "memory"); else asm volatile("s_waitcnt vmcnt(2)" ::: "memory"); } while (0)
#define ATT_RESC(a) do { if constexpr (MODE != 0) { if (__any((a) < 1.f)) { if (hi == 0) al_l[r32] = (a); asm volatile("s_waitcnt lgkmcnt(0)" ::: "memory"); \
        _Pragma("unroll") for (int r = 0; r < 16; ++r) { const float f_ = al_l[crow(r, hi)]; o[0][r] *= f_; o[1][r] *= f_; lacc[r] *= f_; } } } } while (0)
#define ATT_SM(P0, P1, AL) do { if constexpr (MODE == 0) { fixedSM(P0); AL = 1.f; } else lazySM(P0, P1, m_reg, moved, AL); } while (0)
#define ATT_QKT(P0, P1, KS) do { if (MODE != 0 && moved) { f32x16 ng_; _Pragma("unroll") for (int r_ = 0; r_ < 16; ++r_) ng_[r_] = -m_reg; qkt<DQK>(P0, P1, KS, qr, ng_, r32, hi); } \
        else { const f32x16 z_ = f32x16{}; qkt<DQK>(P0, P1, KS, qr, z_, r32, hi); } } while (0)
#define ATT_PV(VB) pv_all(o[0], o[1], lacc, (VB), pa0, pa1, pa2, pa3)
#define ATT_MASK(P0, P1, j) do { if constexpr (MODE == 2) na_mask(P0, P1, btab, u.kr0 + (j), grow, gcol, hi); } while (0)
    f32x16 pA0, pA1, pB0, pB1; float alA, alB; bf16x8 pa0, pa1, pa2, pa3; const int NT = u.nt;
    constexpr int SE = 0, SO = 1;
    ATT_SLOAD(SE, 0); asm volatile("s_waitcnt vmcnt(0)" ::: "memory"); ATT_SWRITE(0, SE); __syncthreads();
    ATT_QKT(pA0, pA1, K_lds); ATT_MASK(pA0, pA1, 0); ATT_SM(pA0, pA1, alA);
    ATT_SLOAD(SO, KVBLK); if (2 < NT) ATT_SLOAD(SE, 2 * KVBLK);
    ATT_SWAIT(); ATT_SWRITE(1, SO); __syncthreads();
    for (int j = 1; j + 1 < NT; j += 2) {
        ASBAR(); ATT_QKT(pB0, pB1, K_lds + KBUF); ATT_MASK(pB0, pB1, j);
        finishSM(pA0, pA1, pa0, pa1, pa2, pa3); ASBAR();
        ATT_SLOAD(SO, (j + 2) * KVBLK); ASBAR();
        ATT_PV(vb0); ATT_SM(pB0, pB1, alB);
        __syncthreads(); ATT_SWAIT(); ATT_SWRITE(0, SE);
        ATT_RESC(alB); __syncthreads();
        ASBAR(); ATT_QKT(pA0, pA1, K_lds); ATT_MASK(pA0, pA1, j + 1);
        finishSM(pB0, pB1, pa0, pa1, pa2, pa3); ASBAR();
        if (j + 3 < NT) ATT_SLOAD(SE, (j + 3) * KVBLK); ASBAR();
        ATT_PV(vb0 + VBUF); ATT_SM(pA0, pA1, alA);
        __syncthreads(); ATT_SWAIT(); ATT_SWRITE(1, SO);
        ATT_RESC(alA); __syncthreads();
    }
    ASBAR(); ATT_QKT(pB0, pB1, K_lds + KBUF); ATT_MASK(pB0, pB1, NT - 1);
    finishSM(pA0, pA1, pa0, pa1, pa2, pa3); ASBAR();
    ATT_PV(vb0); ATT_SM(pB0, pB1, alB);
    __syncthreads(); ATT_RESC(alB);
    finishSM(pB0, pB1, pa0, pa1, pa2, pa3); ASBAR();
    ATT_PV(vb0 + VBUF);
    bf16_t* Ow = u.O + (size_t)(wid * QBLK) * u.ldo;
#pragma unroll
    for (int r = 0; r < 16; ++r) { const int orow = crow(r, hi); const float rl = __builtin_amdgcn_rcpf(lacc[r]);
#pragma unroll
        for (int d0 = 0; d0 < 2; ++d0) Ow[(size_t)orow * u.ldo + d0 * 32 + r32] = (bf16_t)f2bf_s(o[d0][r] * rl); }
    __syncthreads();
#undef ATT_SLOAD
#undef ATT_SWRITE
#undef ATT_SWAIT
#undef ATT_RESC
#undef ATT_SM
#undef ATT_QKT
#undef ATT_PV
#undef ATT_MASK
}
}


constexpr int NWAVES = 8;
#ifndef MK_DEBUG
#define MK_DEBUG 0
#endif
#ifndef MK_DBG_IGNORE
#define MK_DBG_IGNORE 0
#endif
#ifndef MK_ONE_LAUNCH
#define MK_ONE_LAUNCH 0
#endif
#ifndef REP_P
#define REP_P 1
#endif
#ifndef REP_A
#define REP_A 1
#endif
#ifndef REP_B
#define REP_B 1
#endif
#ifndef REP_C
#define REP_C 1
#endif
#ifndef REP_DG
#define REP_DG 1
#endif
#ifndef REP_DM
#define REP_DM 1
#endif
#ifndef REP_DN
#define REP_DN 1
#endif
#ifndef REP_E
#define REP_E 1
#endif
#ifndef REP_F
#define REP_F 1
#endif
#ifndef REP_H
#define REP_H 1
#endif
#ifndef REP_I
#define REP_I 1
#endif
#ifndef REP_J
#define REP_J 1
#endif
#ifndef REP_K
#define REP_K 1
#endif
constexpr int NB = 4, SEQ = 8192, T = NB * SEQ, D = 1024, DEPTH = 2, GW = 64;
constexpr int DIN = 5536, DINP = 5632;
constexpr int H_NAQ = 0, H_NAK = 384, H_NAV = 768, H_GQ = 1152, H_GK = 1536, H_GV = 1664, H_CQ = 1792, H_CKV = 2176, H_KR = 2432, H_GATE = 2464;
constexpr int NE = 32, TOPK = 4, FF = 1024, TK = T * TOPK;
constexpr int PSLOTS = TK + NE * 256;
constexpr int MAXTILES = PSLOTS / 256;
constexpr int LCAP = T;
constexpr float LN_EPS = 1e-5f, RMS_EPS = 1e-6f, DN_ALPHA = 1.4142135623730951f;
constexpr float LOG2E_F = 1.4426950408889634f;
constexpr int PPL = 10, NPH = 1 + DEPTH * PPL;

constexpr size_t MiB = 1u << 20;
constexpr size_t WS_CTL = 0, CTL_ZERO_BYTES = 1 * MiB;
constexpr size_t WB_IN = 0, WB_UQ = WB_IN + (size_t)DINP * 1024 * 2, WB_UKV = WB_UQ + (size_t)512 * 384 * 2, WB_BA = WB_UKV + (size_t)512 * 256 * 2,
                 WB_BB = WB_BA + (size_t)1024 * 384 * 2, WB_BC = WB_BB + (size_t)1024 * 384 * 2, WB_OUT = WB_BC + (size_t)1024 * 384 * 2,
                 WB_GU = WB_OUT + (size_t)1024 * 1024 * 2, WB_DN = WB_GU + (size_t)NE * 2048 * 1024 * 2, WB_LAYER = WB_DN + (size_t)NE * 1024 * 1024 * 2;
static_assert(WB_LAYER % 256 == 0, "weight block alignment");
constexpr size_t WS_W = 2 * MiB;
constexpr size_t WS_H = WS_W + 2 * WB_LAYER;
constexpr size_t SZ_H = (size_t)T * DINP * 2;
constexpr size_t WS_A2 = WS_H + SZ_H;
constexpr size_t A2_MIX = 0, A2_MIXED = A2_MIX + (size_t)T * 1024 * 4, A2_YA = A2_MIXED + (size_t)T * 1024 * 2, A2_YB = A2_YA + (size_t)T * 384 * 2,
                 A2_YC = A2_YB + (size_t)T * 384 * 2, A2_QC = A2_YC + (size_t)T * 384 * 2, A2_KVC = A2_QC + (size_t)T * 384 * 2, A2_KB = A2_KVC + (size_t)T * 512 * 2,
                 A2_CQN = A2_KB + (size_t)T * 128 * 2, A2_CKVN = A2_CQN + (size_t)T * 384 * 2, A2_KR = A2_CKVN + (size_t)T * 256 * 2, SZ_A2 = A2_KR + (size_t)T * 32 * 2;
static_assert(SZ_A2 >= (size_t)PSLOTS * 1024 * 2 && SZ_H >= (size_t)PSLOTS * 1024 * 2, "overlays fit");
constexpr size_t WS_X2 = WS_A2 + SZ_A2;
constexpr size_t WS_XB = WS_X2 + (size_t)T * D * 4;
constexpr size_t WS_X1 = WS_XB + (size_t)T * D * 2;
constexpr size_t WS_X1B = WS_X1 + (size_t)T * D * 4;
constexpr size_t WS_LT = WS_X1B + (size_t)T * D * 2;
constexpr size_t WS_LG = WS_LT + (size_t)NE * LCAP * 4;
constexpr size_t WS_TE = WS_LG + (size_t)NE * LCAP * 4;
constexpr size_t WS_TR = WS_TE + (size_t)T * 4 * 4;
constexpr size_t WS_SG = WS_TR + (size_t)T * 4 * 4;
constexpr size_t WS_END = WS_SG + (size_t)PSLOTS * 4;
constexpr int CW_BAR = 4096;
constexpr int CW_CNT = 16384;

constexpr int RING_BYTES = 131072, LDSCTL_OFF = 139264, MISC_OFF = LDSCTL_OFF + 64;
constexpr int TBL_OFF = LDSCTL_OFF + 256;
constexpr int TBL_START = TBL_OFF, TBL_TILEE = TBL_OFF + 512, TBL_RS = TBL_TILEE + 2304;
constexpr int LDS_BYTES = 155648;
static_assert(TBL_RS + 512 * 12 + 256 <= LDS_BYTES, "LDS map");

#define GAS __attribute__((address_space(1)))
#define LAS __attribute__((address_space(3)))
typedef unsigned short bf16;
typedef unsigned v4u __attribute__((ext_vector_type(4)));
typedef float f32x4 __attribute__((ext_vector_type(4)));
typedef GAS unsigned gu32;
#define RLX_AGENT __ATOMIC_RELAXED, __HIP_MEMORY_SCOPE_AGENT
#define LDS_WAIT() asm volatile("s_waitcnt lgkmcnt(0)" ::: "memory")
#define VM_WAIT() asm volatile("s_waitcnt vmcnt(0)" ::: "memory")
__device__ __forceinline__ unsigned f2bf(float f) { unsigned u = __builtin_bit_cast(unsigned, f); return (u + 0x7fffu + ((u >> 16) & 1u)) >> 16; }
__device__ __forceinline__ unsigned pk2(float lo, float hi) { unsigned r; asm("v_cvt_pk_bf16_f32 %0, %1, %2" : "=v"(r) : "v"(lo), "v"(hi)); return r; }
__device__ __forceinline__ float bflo(unsigned w) { return __uint_as_float(w << 16); }
__device__ __forceinline__ float bfhi(unsigned w) { return __uint_as_float(w & 0xffff0000u); }

template <int O> __device__ __forceinline__ float shx(float v, int lane) { return __int_as_float(__builtin_amdgcn_ds_bpermute((lane ^ O) << 2, __float_as_int(v))); }
template <int O> __device__ __forceinline__ int shxi(int v, int lane) { return __builtin_amdgcn_ds_bpermute((lane ^ O) << 2, v); }

#define XB_TMO      128
#define XB_XCNT(j)  (256  + 64 * (j))
#define XB_XSUB(j)  (1280 + 64 * (j))
#define XB_XGEN(j)  (2304 + 64 * (j))
#define XB_TOP      3328
#define XB_TOPGEN   3392
#define XCD_BAR_WORDS 3456
#define XB_SPIN_CAP (1u << 18)

__device__ __forceinline__ unsigned xb_ld(unsigned* p)              { return __hip_atomic_load(p, __ATOMIC_RELAXED, __HIP_MEMORY_SCOPE_AGENT); }
__device__ __forceinline__ unsigned xb_add(unsigned* p, unsigned v) { return __hip_atomic_fetch_add(p, v, __ATOMIC_RELAXED, __HIP_MEMORY_SCOPE_AGENT); }
__device__ __forceinline__ unsigned xb_xcc_id() { return (unsigned)__builtin_amdgcn_s_getreg((3 << 11) | 20) & 0xFu; }
#define XB_SPIN(cond, bar) do { unsigned _sp = 0; while (cond) { __builtin_amdgcn_s_sleep(1); \
    if ((++_sp & 255u) == 0u) { if (xb_ld(&(bar)[XB_TMO])) break; if (_sp > XB_SPIN_CAP) { atomicAdd(&(bar)[XB_TMO], 1u); break; } } } } while (0)

struct XcdBarrier {
    unsigned* bar; unsigned x;
    volatile LAS unsigned* st;
};

__device__ __forceinline__ XcdBarrier xcd_barrier_post(unsigned* bar, volatile LAS unsigned* st) {
    XcdBarrier b; b.bar = bar; b.x = xb_xcc_id(); b.st = st;
    if (threadIdx.x == 0) (void)xb_add(&bar[XB_XCNT(b.x)], 1u);
    return b;
}
__device__ __forceinline__ void xcd_barrier_complete(unsigned* bar, unsigned x, unsigned& nloc, unsigned& nx) {
    const unsigned G = gridDim.x * gridDim.y * gridDim.z;
    unsigned sum, cnt, mine, sp = 0u;
    for (;;) {
        sum = 0u; cnt = 0u; mine = 0u;
#pragma unroll
        for (unsigned j = 0; j < 16; ++j) { const unsigned c = xb_ld(&bar[XB_XCNT(j)]); sum += c; cnt += (c > 0u) ? 1u : 0u; mine = (j == x) ? c : mine; }
        if (sum == G) break;
        __builtin_amdgcn_s_sleep(1);
        if ((++sp & 255u) == 0u) { if (xb_ld(&bar[XB_TMO])) break; if (sp > XB_SPIN_CAP) { atomicAdd(&bar[XB_TMO], 1u); break; } }
    }
    nloc = mine > 0u ? mine : 1u; nx = cnt > 0u ? cnt : 1u;
}

__device__ __forceinline__ void xcd_barrier(const XcdBarrier& b) {
    asm volatile("s_waitcnt vmcnt(0)" ::: "memory");
    __syncthreads();
    if (threadIdx.x == 0) {
        unsigned* bar = b.bar;
        __builtin_amdgcn_s_waitcnt(0);
        unsigned nloc = b.st[0], nx = b.st[1];
        if (nloc == 0u) { xcd_barrier_complete(bar, b.x, nloc, nx); b.st[0] = nloc; b.st[1] = nx; }
        const unsigned old = xb_add(&bar[XB_XSUB(b.x)], 1u);
        const unsigned gen = old / nloc;
        if (old + 1u == (gen + 1u) * nloc) {
            __builtin_amdgcn_fence(__ATOMIC_RELEASE, "agent");
            asm volatile("s_waitcnt vmcnt(0)" ::: "memory");
            const unsigned og = xb_add(&bar[XB_TOP], 1u);
            const unsigned tg = og / nx;
            if (og + 1u == (tg + 1u) * nx) xb_add(&bar[XB_TOPGEN], 1u);
            else XB_SPIN(xb_ld(&bar[XB_TOPGEN]) == tg, bar);
            __builtin_amdgcn_fence(__ATOMIC_ACQUIRE, "agent");
            xb_add(&bar[XB_XGEN(b.x)], 1u);
            asm volatile("s_waitcnt vmcnt(0)" ::: "memory");
        } else {
            XB_SPIN(xb_ld(&bar[XB_XGEN(b.x)]) == gen, bar);
            __builtin_amdgcn_fence(__ATOMIC_ACQUIRE, "agent");
            asm volatile("s_waitcnt vmcnt(0)" ::: "memory");
        }
    }
    __syncthreads();
}


struct Frame {
    LAS unsigned char* lds;
    gu32* ctl;
    int tid, lane, wave;
    int vcu, G, bx;
    unsigned char* ws;
    float* out;
};
__device__ __forceinline__ const float* in_ptr(int i) {
    const void* base = (const void*)__builtin_amdgcn_kernarg_segment_ptr(); const GAS float* p;
    asm volatile("s_load_dwordx2 %0, %1, %2\n\ts_waitcnt lgkmcnt(0)" : "=s"(p) : "s"(base), "i"(i * 8) : "memory"); return (const float*)p;
}
#define INP(i) in_ptr(i)
template <int SITE> __device__ __forceinline__ Frame mkframe(LAS unsigned char* lds_in, unsigned char* ws_in, float* out_in, int wave_id, int bx0, int G0) {
    Frame F; int lane_;
    asm volatile("v_mbcnt_lo_u32_b32 %0, -1, 0\n\tv_mbcnt_hi_u32_b32 %0, -1, %0 ; site %1" : "=v"(lane_) : "n"(SITE));
    int bx = bx0, G = G0, wv = wave_id; asm volatile("; site %3" : "+s"(bx), "+s"(G), "+s"(wv) : "n"(SITE));
    GAS unsigned char* wsg = (GAS unsigned char*)ws_in; asm volatile("; site %1" : "+s"(wsg) : "n"(SITE)); unsigned char* ws = (unsigned char*)wsg;
    LAS unsigned char* l3 = lds_in; asm volatile("; site %1" : "+s"(l3) : "n"(SITE));
    const int tid = wv * 64 + lane_;
    F.lds = l3; F.tid = tid; F.lane = lane_; F.wave = wv;
    F.G = G; F.bx = bx; F.vcu = (G % 8 == 0) ? (bx % 8) * (G / 8) + bx / 8 : bx;
    F.ws = ws; F.ctl = (gu32*)(wsg + WS_CTL); F.out = out_in; return F;
}
__device__ __forceinline__ float wave_sum(float v, int lane) {
    v += shx<1>(v, lane); v += shx<2>(v, lane); v += shx<4>(v, lane); v += shx<8>(v, lane); v += shx<16>(v, lane); v += shx<32>(v, lane);
    return v;
}
__device__ __forceinline__ void tr_item(const float* W, int ldw, int Kd, int k0, int src_n0, bf16* WT, int dst_n0, float scale, LAS float* scr, int lane) {
    float v[32];
#pragma unroll
    for (int i = 0; i < 32; ++i) v[i] = W[(size_t)(k0 + 2 * i + (lane >> 5)) * ldw + src_n0 + (lane & 31)];
#pragma unroll
    for (int i = 0; i < 32; ++i) scr[(2 * i + (lane >> 5)) * 33 + (lane & 31)] = v[i];
    LDS_WAIT(); asm volatile("" ::: "memory");
    const int c = lane & 7;
#pragma unroll
    for (int j = 0; j < 4; ++j) { const int n = (lane >> 3) + 8 * j; const LAS float* s = scr + (8 * c) * 33 + n;
        v4u o; o.x = pk2(s[0 * 33] * scale, s[1 * 33] * scale); o.y = pk2(s[2 * 33] * scale, s[3 * 33] * scale); o.z = pk2(s[4 * 33] * scale, s[5 * 33] * scale); o.w = pk2(s[6 * 33] * scale, s[7 * 33] * scale);
        *(GAS v4u*)(WT + (size_t)(dst_n0 + n) * Kd + k0 + 8 * c) = o; }
    LDS_WAIT(); asm volatile("" ::: "memory");
}
template <int KIND> __device__ __forceinline__ void conv_matrix(Frame& F, const float* W, int K, int N, bf16* WT, float s, int gw, int NGW, LAS float* scr, int Kd = 0) {
    if (Kd == 0) Kd = K;
    const int nnb = N / 32, nkb = K / 64, nit = nnb * nkb;
    for (int it = gw; it < nit; it += NGW) {
        const int kb = it / nnb, nb = it % nnb; const int dst_n0 = 32 * nb; int src_n0 = dst_n0; float sc = s;
        if (KIND == 1) sc = (dst_n0 < 384) ? s : 1.0f;
        if (KIND == 2) { const int p = dst_n0 >> 8, j = dst_n0 & 255; src_n0 = (j < 128) ? (128 * p + j) : (1024 + 128 * p + (j - 128)); }
        tr_item(W, N, Kd, 64 * kb, src_n0, WT, dst_n0, sc, scr, F.lane);
    }
}
__device__ __forceinline__ void zero_rows(bf16* WT, int K, int n_lo, int n_hi, int gtid, int nthr) {
    const size_t n16 = (size_t)(n_hi - n_lo) * K / 8; GAS v4u* p = (GAS v4u*)(WT + (size_t)n_lo * K);
    for (size_t i = gtid; i < n16; i += nthr) p[i] = (v4u){0u, 0u, 0u, 0u};
}
__device__ __forceinline__ void p_prologue(Frame& F) {
    LAS float* scr = (LAS float*)(F.lds + F.wave * 16384);
    const int gw0 = F.vcu * NWAVES + F.wave, NGW = F.G * NWAVES, gtid = F.bx * (NWAVES * 64) + F.tid, nthr = F.G * NWAVES * 64;
    for (int l = 0; l < DEPTH; ++l) {
        unsigned char* wb = F.ws + WS_W + (size_t)l * WB_LAYER;
        int gw = gw0;
#define ROT(n) do { gw = (gw + NGW - ((n) % NGW)) % NGW; } while (0)
        conv_matrix<1>(F, INP(1) + (size_t)l * 1024 * DIN, 1024, DIN, (bf16*)(wb + WB_IN), 0.125f * LOG2E_F, gw, NGW, scr); ROT(16 * 173);
        zero_rows((bf16*)(wb + WB_IN), 1024, DIN, DINP, gtid, nthr);
        conv_matrix<0>(F, INP(7) + (size_t)l * 384 * 384, 384, 384, (bf16*)(wb + WB_UQ), 0.10206207261596577f * LOG2E_F, gw, NGW, scr); ROT(72);
        zero_rows((bf16*)(wb + WB_UQ), 384, 384, 512, gtid, nthr);
        conv_matrix<0>(F, INP(8) + (size_t)l * 256 * 512, 256, 512, (bf16*)(wb + WB_UKV), 1.0f, gw, NGW, scr); ROT(64);
        conv_matrix<0>(F, INP(9) + (size_t)l * 384 * 1024, 384, 1024, (bf16*)(wb + WB_BA), 1.0f, gw, NGW, scr); ROT(192);
        conv_matrix<0>(F, INP(10) + (size_t)l * 384 * 1024, 384, 1024, (bf16*)(wb + WB_BB), 1.0f, gw, NGW, scr); ROT(192);
        conv_matrix<0>(F, INP(11) + (size_t)l * 256 * 1024, 256, 1024, (bf16*)(wb + WB_BC), 1.0f, gw, NGW, scr, 384); ROT(64);
        for (int i = gtid; i < 1024 * 16; i += nthr) *((GAS v4u*)(wb + WB_BC) + (size_t)(i >> 4) * 48 + 32 + (i & 15)) = (v4u){0u, 0u, 0u, 0u};
        conv_matrix<0>(F, INP(12) + (size_t)l * 1024 * 1024, 1024, 1024, (bf16*)(wb + WB_OUT), 1.0f, gw, NGW, scr); ROT(512);
        for (int e = 0; e < NE; ++e) {
            conv_matrix<2>(F, INP(17) + ((size_t)l * NE + e) * 1024 * 2048, 1024, 2048, (bf16*)(wb + WB_GU) + (size_t)e * 2048 * 1024, 1.0f, gw, NGW, scr);
            conv_matrix<0>(F, INP(19) + ((size_t)l * NE + e) * 1024 * 1024, 1024, 1024, (bf16*)(wb + WB_DN) + (size_t)e * 1024 * 1024, 1.0f, gw, NGW, scr);
        }
#undef ROT
    }
    { const GAS f32x4* xs = (const GAS f32x4*)INP(0); GAS v4u* xd = (GAS v4u*)(F.ws + WS_XB);
      for (size_t i = gtid; i < (size_t)T * D / 8; i += nthr) { const f32x4 a = xs[2 * i], b = xs[2 * i + 1]; xd[i] = (v4u){pk2(a.x, a.y), pk2(a.z, a.w), pk2(b.x, b.y), pk2(b.z, b.w)}; } }
}

__device__ __forceinline__ void p_prep(Frame& F, int l) {
    const bf16* hb = (const bf16*)(F.ws + WS_H); unsigned char* a2 = F.ws + WS_A2;
    bf16* kB = (bf16*)(a2 + A2_KB); bf16* cqn = (bf16*)(a2 + A2_CQN); bf16* ckvn = (bf16*)(a2 + A2_CKVN); bf16* kr = (bf16*)(a2 + A2_KR);
    const float* gk = INP(4) + l * 64; const float* gq = INP(5) + l * 384; const float* gkv = INP(6) + l * 256;
    const int lane = F.lane, gw = F.vcu * NWAVES + F.wave, NGW = F.G * NWAVES;
    for (int t = gw; t < T; t += NGW) {
        const bf16* hr = hb + (size_t)t * DINP; const int s = t & (SEQ - 1); const float prow = (float)(s >> 6), pcol = (float)(s & 63);
        {   float x[8]; float ssq = 0.f; const int cc = lane & 7;
            if (lane < 16) { const v4u w = *(const GAS v4u*)(hr + H_GK + lane * 8); x[0] = bflo(w.x); x[1] = bfhi(w.x); x[2] = bflo(w.y); x[3] = bfhi(w.y); x[4] = bflo(w.z); x[5] = bfhi(w.z); x[6] = bflo(w.w); x[7] = bfhi(w.w); }
            else {
#pragma unroll
                for (int j = 0; j < 8; ++j) x[j] = 0.f; }
#pragma unroll
            for (int j = 0; j < 8; ++j) ssq += x[j] * x[j];
            ssq += shx<1>(ssq, lane); ssq += shx<2>(ssq, lane); ssq += shx<4>(ssq, lane);
            const float rstd = 1.0f / sqrtf(ssq * (1.0f / 64.0f) + RMS_EPS);
            float y[8], o[8];
#pragma unroll
            for (int j = 0; j < 8; ++j) y[j] = x[j] * rstd * gk[(cc * 8 + j) & 63];
#pragma unroll
            for (int j = 0; j < 8; ++j) { const float other = shx<4>(y[j], lane); const int i = 8 * (cc & 3) + j;
                const float inv = exp2f(-(float)(i & 15) * (att::LOG2_THETA / 16.0f)); const float ang = ((i < 16) ? prow : pcol) * inv * att::INV2PI;
                const float c = __builtin_amdgcn_cosf(ang), sn = __builtin_amdgcn_sinf(ang);
                o[j] = (cc < 4) ? (y[j] * c - other * sn) : (other * sn + y[j] * c); }
            if (lane < 16) *(GAS v4u*)(kB + (size_t)t * 128 + lane * 8) = (v4u){pk2(o[0], o[1]), pk2(o[2], o[3]), pk2(o[4], o[5]), pk2(o[6], o[7])};
        }
        {   float x[8]; float ssq = 0.f;
            if (lane < 48) { const v4u w = *(const GAS v4u*)(hr + H_CQ + lane * 8); x[0] = bflo(w.x); x[1] = bfhi(w.x); x[2] = bflo(w.y); x[3] = bfhi(w.y); x[4] = bflo(w.z); x[5] = bfhi(w.z); x[6] = bflo(w.w); x[7] = bfhi(w.w); }
            else {
#pragma unroll
                for (int j = 0; j < 8; ++j) x[j] = 0.f; }
#pragma unroll
            for (int j = 0; j < 8; ++j) ssq += x[j] * x[j];
            ssq = wave_sum(ssq, lane); const float rstd = 1.0f / sqrtf(ssq * (1.0f / 384.0f) + RMS_EPS);
            if (lane < 48) { float y[8];
#pragma unroll
                for (int j = 0; j < 8; ++j) y[j] = x[j] * rstd * gq[lane * 8 + j];
                *(GAS v4u*)(cqn + (size_t)t * 384 + lane * 8) = (v4u){pk2(y[0], y[1]), pk2(y[2], y[3]), pk2(y[4], y[5]), pk2(y[6], y[7])}; }
        }
        {   float x[8]; float ssq = 0.f;
            if (lane < 32) { const v4u w = *(const GAS v4u*)(hr + H_CKV + lane * 8); x[0] = bflo(w.x); x[1] = bfhi(w.x); x[2] = bflo(w.y); x[3] = bfhi(w.y); x[4] = bflo(w.z); x[5] = bfhi(w.z); x[6] = bflo(w.w); x[7] = bfhi(w.w); }
            else {
#pragma unroll
                for (int j = 0; j < 8; ++j) x[j] = 0.f; }
#pragma unroll
            for (int j = 0; j < 8; ++j) ssq += x[j] * x[j];
            ssq = wave_sum(ssq, lane); const float rstd = 1.0f / sqrtf(ssq * (1.0f / 256.0f) + RMS_EPS);
            if (lane < 32) { float y[8];
#pragma unroll
                for (int j = 0; j < 8; ++j) y[j] = x[j] * rstd * gkv[lane * 8 + j];
                *(GAS v4u*)(ckvn + (size_t)t * 256 + lane * 8) = (v4u){pk2(y[0], y[1]), pk2(y[2], y[3]), pk2(y[4], y[5]), pk2(y[6], y[7])}; }
        }
        {   float x[8]; const int cc = lane & 3;
            if (lane < 4) { const v4u w = *(const GAS v4u*)(hr + H_KR + lane * 8); x[0] = bflo(w.x); x[1] = bfhi(w.x); x[2] = bflo(w.y); x[3] = bfhi(w.y); x[4] = bflo(w.z); x[5] = bfhi(w.z); x[6] = bflo(w.w); x[7] = bfhi(w.w); }
            else {
#pragma unroll
                for (int j = 0; j < 8; ++j) x[j] = 0.f; }
            float o[8];
#pragma unroll
            for (int j = 0; j < 8; ++j) { const float other = shx<2>(x[j], lane);
                const float inv = exp2f(-(float)j * (att::LOG2_THETA / 8.0f)); const float ang = (((cc & 1) == 0) ? prow : pcol) * inv * att::INV2PI;
                const float c = __builtin_amdgcn_cosf(ang), sn = __builtin_amdgcn_sinf(ang);
                o[j] = (cc < 2) ? (x[j] * c - other * sn) : (other * sn + x[j] * c); }
            if (lane < 4) *(GAS v4u*)(kr + (size_t)t * 32 + lane * 8) = (v4u){pk2(o[0], o[1]), pk2(o[2], o[3]), pk2(o[4], o[5]), pk2(o[6], o[7])};
        }
    }
}


__device__ __forceinline__ int build_tables(Frame& F, int l) {
    LAS int* st = (LAS int*)(F.lds + TBL_START); LAS int* cn = st + 33; LAS int* te = (LAS int*)(F.lds + TBL_TILEE);
    __syncthreads();
    if (F.tid < NE) cn[F.tid] = (int)__hip_atomic_load(F.ctl + CW_CNT + 64 * l + F.tid, RLX_AGENT);
    __syncthreads();
    if (F.tid == 0) { int s = 0; for (int e = 0; e < NE; ++e) { st[e] = s; s += ((cn[e] + 255) >> 8) << 8; } st[NE] = s; }
    __syncthreads();
    const int total = st[NE];
    for (int tile = F.tid; tile < (total >> 8); tile += NWAVES * 64) { int e = 0; for (int k = 1; k < NE; ++k) e += (tile * 256 >= st[k]) ? 1 : 0; te[tile] = e; }
    __syncthreads();
    return total;
}

__device__ __forceinline__ void p_ln1_router(Frame& F, int l, const float* xcur) {
    const bf16* outb = (const bf16*)(F.ws + WS_X1); bf16* x1b = (bf16*)(F.ws + WS_X1B);
    int* list_t = (int*)(F.ws + WS_LT); float* list_g = (float*)(F.ws + WS_LG); int* tok_e = (int*)(F.ws + WS_TE); int* tok_r = (int*)(F.ws + WS_TR);
    const float* wr = INP(15) + (size_t)l * 1024 * NE; const float* br = INP(16) + l * NE;
    const int lane0 = F.lane, tid = F.tid;
    LAS unsigned char* wl = F.lds;
    LAS int* sel_e = (LAS int*)(F.lds + TBL_RS); LAS float* sel_g = (LAS float*)(sel_e + 512); LAS int* sel_r = sel_e + 1024; LAS int* hist = sel_e + 1536; LAS int* base = hist + 32;
    __syncthreads();
    for (int idx = tid; idx < 1024 * 8; idx += NWAVES * 64) { const int k = idx >> 3, c = idx & 7, kp = (k & 3) * 256 + (k >> 2), cp = c ^ ((kp >> 1) & 7);
        *(LAS f32x4*)(wl + (kp * 8 + cp) * 16) = *(const GAS f32x4*)(wr + (size_t)k * NE + c * 4); }
    __syncthreads();
    for (int tile = F.bx; tile < T / 128; tile += F.G) {
        if (tid < 32) hist[tid] = 0;
        __syncthreads();
        for (int it = 0; it < 16; ++it) {
            int lane = lane0; asm volatile("" : "+v"(lane));
            const int sw = (lane >> 1) & 7; const float bias_e = br[(lane >> 1) & 31];
            const GAS f32x4* lgp = (const GAS f32x4*)(INP(13) + l * D) + lane; const GAS f32x4* lbp = (const GAS f32x4*)(INP(14) + l * D) + lane;
            const int tl = F.wave * 16 + it, t = tile * 128 + tl;
            const GAS f32x4* xr = (const GAS f32x4*)(xcur + (size_t)t * D) + lane; const GAS unsigned long long* orr = (const GAS unsigned long long*)(outb + (size_t)t * D) + lane;
            f32x4 v[4]; float s = 0.f;
#pragma unroll
            for (int j = 0; j < 4; ++j) { const unsigned long long ow = orr[64 * j]; const unsigned olo = (unsigned)ow, ohi = (unsigned)(ow >> 32);
                v[j] = xr[64 * j] * DN_ALPHA + (f32x4){bflo(olo), bfhi(olo), bflo(ohi), bfhi(ohi)}; s += (v[j].x + v[j].y) + (v[j].z + v[j].w); }
            const float mean = wave_sum(s, lane) * (1.f / D); float s2 = 0.f;
#pragma unroll
            for (int j = 0; j < 4; ++j) { v[j] = v[j] - mean; s2 += (v[j].x * v[j].x + v[j].y * v[j].y) + (v[j].z * v[j].z + v[j].w * v[j].w); }
            const float rstd = 1.f / sqrtf(wave_sum(s2, lane) * (1.f / D) + LN_EPS);
            GAS unsigned long long* o8 = (GAS unsigned long long*)(x1b + (size_t)t * D) + lane;
#pragma unroll
            for (int j = 0; j < 4; ++j) { v[j] = v[j] * rstd * lgp[64 * j] + lbp[64 * j];
                o8[64 * j] = (unsigned long long)pk2(v[j].x, v[j].y) | ((unsigned long long)pk2(v[j].z, v[j].w) << 32); }
            float acc[32];
#pragma unroll
            for (int c = 0; c < 8; ++c) {
                int basec = lane * 128 + ((c ^ sw) << 4); asm volatile("" : "+v"(basec));
                const LAS unsigned char* wp = wl + basec;
                float a0 = 0.f, a1_ = 0.f, a2_ = 0.f, a3 = 0.f;
#pragma unroll
                for (int i = 0; i < 4; ++i)
#pragma unroll
                    for (int j = 0; j < 4; ++j) { const f32x4 w = *(const LAS f32x4*)(wp + (i * 256 + 64 * j) * 128); const float xv = v[j][i];
                        a0 += xv * w.x; a1_ += xv * w.y; a2_ += xv * w.z; a3 += xv * w.w; }
                acc[4 * c + 0] = a0; acc[4 * c + 1] = a1_; acc[4 * c + 2] = a2_; acc[4 * c + 3] = a3;
            }
            float a16[16], a8[8], a4[4], a2[2], a1;
            { const bool b = (lane & 32) != 0;
#pragma unroll
              for (int i = 0; i < 16; ++i) { const float send = b ? acc[i] : acc[16 + i]; const float keep = b ? acc[16 + i] : acc[i]; a16[i] = keep + shx<32>(send, lane); } }
            { const bool b = (lane & 16) != 0;
#pragma unroll
              for (int i = 0; i < 8; ++i) { const float send = b ? a16[i] : a16[8 + i]; const float keep = b ? a16[8 + i] : a16[i]; a8[i] = keep + shx<16>(send, lane); } }
            { const bool b = (lane & 8) != 0;
#pragma unroll
              for (int i = 0; i < 4; ++i) { const float send = b ? a8[i] : a8[4 + i]; const float keep = b ? a8[4 + i] : a8[i]; a4[i] = keep + shx<8>(send, lane); } }
            { const bool b = (lane & 4) != 0;
#pragma unroll
              for (int i = 0; i < 2; ++i) { const float send = b ? a4[i] : a4[2 + i]; const float keep = b ? a4[2 + i] : a4[i]; a2[i] = keep + shx<4>(send, lane); } }
            { const bool b = (lane & 2) != 0; const float send = b ? a2[0] : a2[1]; const float keep = b ? a2[1] : a2[0]; a1 = keep + shx<2>(send, lane); }
            a1 += shx<1>(a1, lane);
            float val = a1 + bias_e; const int my_e = (lane >> 1) & 31;
            float sv[4]; int se[4];
#pragma unroll
            for (int r = 0; r < 4; ++r) { float bv = val; int be = my_e;
#define TOPK_STEP(O) { const float ov = shx<O>(bv, lane); const int oe = shxi<O>(be, lane); if (ov > bv || (ov == bv && oe < be)) { bv = ov; be = oe; } }
                TOPK_STEP(2) TOPK_STEP(4) TOPK_STEP(8) TOPK_STEP(16) TOPK_STEP(32)
#undef TOPK_STEP
                sv[r] = bv; se[r] = be; if (my_e == be) val = -INFINITY; }
            const float e1 = __expf(sv[1] - sv[0]), e2 = __expf(sv[2] - sv[0]), e3 = __expf(sv[3] - sv[0]); const float rs = 1.0f / (1.0f + e1 + e2 + e3);
            if (lane < 4) { const int ee = lane == 0 ? se[0] : lane == 1 ? se[1] : lane == 2 ? se[2] : se[3]; const float gg = (lane == 0 ? 1.0f : lane == 1 ? e1 : lane == 2 ? e2 : e3) * rs;
                const int a = tl * 4 + lane; sel_e[a] = ee; sel_g[a] = gg; sel_r[a] = __hip_atomic_fetch_add(&hist[ee], 1, __ATOMIC_RELAXED, __HIP_MEMORY_SCOPE_WORKGROUP); }
        }
        __syncthreads();
        if (tid < 32) base[tid] = (int)__hip_atomic_fetch_add(F.ctl + CW_CNT + 64 * l + tid, (unsigned)hist[tid], RLX_AGENT);
        __syncthreads();
        { const int a = tid, e = sel_e[a], rank = base[e] + sel_r[a], t = tile * 128 + (a >> 2);
          list_t[(size_t)e * LCAP + rank] = t; list_g[(size_t)e * LCAP + rank] = sel_g[a]; tok_e[t * 4 + (a & 3)] = e; tok_r[t * 4 + (a & 3)] = rank; }
        __syncthreads();
    }
}

__device__ __forceinline__ void p_gather(Frame& F, int l) {
    const int total = build_tables(F, l);
    LAS int* st = (LAS int*)(F.lds + TBL_START); LAS int* cn = st + 33;
    const bf16* x1b = (const bf16*)(F.ws + WS_X1B); bf16* xg = (bf16*)(F.ws + WS_H); float* sg = (float*)(F.ws + WS_SG);
    const int* list_t = (const int*)(F.ws + WS_LT); const float* list_g = (const float*)(F.ws + WS_LG);
    const int lane = F.lane, gw = F.vcu * NWAVES + F.wave, NGW = F.G * NWAVES;
    for (int s = gw; s < total; s += NGW) {
        const bool pr = (lane < NE) && (s >= st[lane & 31]);
        const int e = __popcll(__ballot(pr)) - 1; const int r = s - st[e];
        GAS v4u* dst = (GAS v4u*)(xg + (size_t)s * D);
        if (r < cn[e]) { const int t = list_t[(size_t)e * LCAP + r]; const GAS v4u* src = (const GAS v4u*)(x1b + (size_t)t * D);
            dst[lane] = src[lane]; dst[64 + lane] = src[64 + lane]; if (lane == 0) sg[s] = list_g[(size_t)e * LCAP + r]; }
        else { unsigned zz = 0u; asm volatile("" : "+v"(zz)); const v4u z4 = {zz, zz, zz, zz}; dst[lane] = z4; dst[64 + lane] = z4; if (lane == 0) sg[s] = 0.f; }
    }
}

__device__ __forceinline__ void p_ln2(Frame& F, int l, float* dst, bool write_xb) {
    (void)build_tables(F, l);
    LAS int* st = (LAS int*)(F.lds + TBL_START);
    const bf16* x1b = (const bf16*)(F.ws + WS_X1B); const bf16* yb = (const bf16*)(F.ws + WS_H); bf16* xb = (bf16*)(F.ws + WS_XB);
    const int* tok_e = (const int*)(F.ws + WS_TE); const int* tok_r = (const int*)(F.ws + WS_TR);
    const int lane = F.lane, hl = lane & 31, half = lane >> 5, gw = F.vcu * NWAVES + F.wave, NGW = F.G * NWAVES;
    const float* lgp = INP(21) + l * D; const float* lbp = INP(22) + l * D;
    float dmult = 1.0f;
#if MK_DEBUG
    if (l == DEPTH - 1) { const unsigned mask = __hip_atomic_load(F.ctl + 20000, RLX_AGENT) & ~(unsigned)(MK_DBG_IGNORE); if (mask) dmult = 1.0f + (float)(__ffs((int)mask) - 1); }
#endif
    int t = 2 * gw + half;
    int e4 = 0, r4 = 0;
    if (t < T && hl < 4) { e4 = tok_e[t * 4 + hl]; r4 = tok_r[t * 4 + hl]; }
    for (; t < T; t += 2 * NGW) {
        int slot4 = st[e4] + r4;
        const int tn = t + 2 * NGW; int e4n = 0, r4n = 0;
        if (tn < T && hl < 4) { e4n = tok_e[tn * 4 + hl]; r4n = tok_r[tn * 4 + hl]; }
        int slot[4];
#pragma unroll
        for (int k = 0; k < 4; ++k) slot[k] = __builtin_amdgcn_ds_bpermute((half * 32 + k) << 2, slot4);
        const GAS v4u* xr = (const GAS v4u*)(x1b + (size_t)t * D) + hl;
        v4u xw[4], yw[4][4];
#pragma unroll
        for (int q = 0; q < 4; ++q) xw[q] = xr[32 * q];
#pragma unroll
        for (int k = 0; k < 4; ++k) { const GAS v4u* yr = (const GAS v4u*)(yb + (size_t)slot[k] * D) + hl;
#pragma unroll
            for (int q = 0; q < 4; ++q) yw[k][q] = yr[32 * q]; }
        float v[4][8]; float s = 0.f;
#pragma unroll
        for (int q = 0; q < 4; ++q) {
            v[q][0] = bflo(xw[q].x) * DN_ALPHA; v[q][1] = bfhi(xw[q].x) * DN_ALPHA; v[q][2] = bflo(xw[q].y) * DN_ALPHA; v[q][3] = bfhi(xw[q].y) * DN_ALPHA;
            v[q][4] = bflo(xw[q].z) * DN_ALPHA; v[q][5] = bfhi(xw[q].z) * DN_ALPHA; v[q][6] = bflo(xw[q].w) * DN_ALPHA; v[q][7] = bfhi(xw[q].w) * DN_ALPHA;
#pragma unroll
            for (int k = 0; k < 4; ++k) { v[q][0] += bflo(yw[k][q].x); v[q][1] += bfhi(yw[k][q].x); v[q][2] += bflo(yw[k][q].y); v[q][3] += bfhi(yw[k][q].y);
                v[q][4] += bflo(yw[k][q].z); v[q][5] += bfhi(yw[k][q].z); v[q][6] += bflo(yw[k][q].w); v[q][7] += bfhi(yw[k][q].w); }
#pragma unroll
            for (int i = 0; i < 8; ++i) s += v[q][i]; }
        s += shx<1>(s, lane); s += shx<2>(s, lane); s += shx<4>(s, lane); s += shx<8>(s, lane); s += shx<16>(s, lane);
        const float mean = s * (1.f / D); float s2 = 0.f;
#pragma unroll
        for (int q = 0; q < 4; ++q)
#pragma unroll
            for (int i = 0; i < 8; ++i) { v[q][i] -= mean; s2 += v[q][i] * v[q][i]; }
        s2 += shx<1>(s2, lane); s2 += shx<2>(s2, lane); s2 += shx<4>(s2, lane); s2 += shx<8>(s2, lane); s2 += shx<16>(s2, lane);
        const float rstd = 1.f / sqrtf(s2 * (1.f / D) + LN_EPS);
        GAS f32x4* orow = (GAS f32x4*)(dst + (size_t)t * D) + 2 * hl; GAS v4u* o16 = (GAS v4u*)(xb + (size_t)t * D) + hl;
#pragma unroll
        for (int q = 0; q < 4; ++q) { const GAS f32x4* gq = (const GAS f32x4*)(lgp + 256 * q) + 2 * hl; const GAS f32x4* bq = (const GAS f32x4*)(lbp + 256 * q) + 2 * hl;
            const f32x4 g0 = gq[0], g1 = gq[1], b0 = bq[0], b1 = bq[1];
            f32x4 y0 = {v[q][0] * rstd, v[q][1] * rstd, v[q][2] * rstd, v[q][3] * rstd}, y1 = {v[q][4] * rstd, v[q][5] * rstd, v[q][6] * rstd, v[q][7] * rstd};
            y0 = y0 * g0 + b0; y1 = y1 * g1 + b1;
            orow[64 * q] = y0 * dmult; orow[64 * q + 1] = y1 * dmult;
            if (write_xb) o16[32 * q] = (v4u){pk2(y0.x, y0.y), pk2(y0.z, y0.w), pk2(y1.x, y1.y), pk2(y1.z, y1.w)}; }
        e4 = e4n; r4 = r4n;
    }
}

template <int WHICH> __device__ __forceinline__ void p_attention(Frame& F, int l) {
    const bf16* hb = (const bf16*)(F.ws + WS_H); unsigned char* a2 = F.ws + WS_A2;
    const bf16* kB = (const bf16*)(a2 + A2_KB); const bf16* kr = (const bf16*)(a2 + A2_KR); const bf16* qc = (const bf16*)(a2 + A2_QC); const bf16* kvc = (const bf16*)(a2 + A2_KVC);
    bf16* ya = (bf16*)(a2 + A2_YA); bf16* yb = (bf16*)(a2 + A2_YB); bf16* yc = (bf16*)(a2 + A2_YC);
    att::ALAS_PTR lds = (att::ALAS_PTR)F.lds;
    __syncthreads();
    if (WHICH == 0) {
        float mq = fabsf((INP(3) + l * 64)[F.lane]), mk = fabsf((INP(4) + l * 64)[F.lane]);
#define MX_STEP(O) { mq = fmaxf(mq, shx<O>(mq, F.lane)); mk = fmaxf(mk, shx<O>(mk, F.lane)); }
        MX_STEP(1) MX_STEP(2) MX_STEP(4) MX_STEP(8) MX_STEP(16) MX_STEP(32)
#undef MX_STEP
        const float cref = __int_as_float(__builtin_amdgcn_readfirstlane(__float_as_int(8.0f * LOG2E_F * 1.03f * mq * mk)));
        const bool fixed_ok = cref < 60.0f;
        for (int idx = F.vcu; idx < 768; idx += F.G) {
            const int qi = idx >> 8, rem = idx & 255, bk = rem >> 5, qb = rem & 31, b = bk >> 1, kvh = bk & 1, head = kvh * 3 + qi;
            att::UnitP u; const size_t tb = (size_t)b * SEQ, tq = tb + (size_t)qb * 256;
            u.Q = hb + tq * DINP + H_GQ + head * 64; u.ldq = DINP; u.K0 = kB + tb * 128 + kvh * 64; u.ldk0 = 128; u.K1 = nullptr; u.ldk1 = 0;
            u.V = hb + tb * DINP + H_GV + kvh * 64; u.ldv = DINP; u.O = yb + tq * 384 + head * 64; u.ldo = 384; u.nt = SEQ / 64; u.grow0 = qb * 4; u.gain = INP(3) + l * 64; u.kr0 = 0; u.cref = cref;
            if (fixed_ok) att::attn_unit<64, 0>(u, lds, F.tid); else att::attn_unit<64, 3>(u, lds, F.tid);
        }
    }
    if (WHICH == 1) for (int idx = F.vcu; idx < 512; idx += F.G) {
        const int rnd = idx >> 8, rem = idx & 255, p = (rem >> 5) * 2 + rnd, qb = rem & 31, b = p >> 2, h = p & 3;
        att::UnitP u; const size_t tb = (size_t)b * SEQ, tq = tb + (size_t)qb * 256;
        u.Q = qc + tq * 384 + h * 96; u.ldq = 384; u.K0 = kvc + tb * 512 + h * 128; u.ldk0 = 512; u.K1 = kr + tb * 32; u.ldk1 = 32;
        u.V = kvc + tb * 512 + h * 128 + 64; u.ldv = 512; u.O = yc + tq * 384 + h * 64; u.ldo = 384; u.nt = SEQ / 64; u.grow0 = qb * 4; u.gain = nullptr; u.kr0 = 0; u.cref = 0.f;
        att::attn_unit<96, 1>(u, lds, F.tid);
    }
    if (WHICH == 2) for (int idx = F.vcu; idx < 768; idx += F.G) {
        const int b = idx / 192, rem = idx % 192, h = rem >> 5, rg = rem & 31, R0 = rg * 4;
        int r_lo = R0 - 4; r_lo = r_lo < 0 ? 0 : (r_lo > 120 ? 120 : r_lo);
        int r_hi = R0 - 1; r_hi = (r_hi < 0 ? 0 : (r_hi > 120 ? 120 : r_hi)) + 8;
        if ((r_hi - r_lo) & 1) { if (r_hi < 128) ++r_hi; else --r_lo; }
        {
            LAS float* bt = (LAS float*)(F.lds + att::OFF_BIAS); const float* rp = INP(2) + ((size_t)l * 6 + h) * 465;
            if (F.tid < 465) bt[F.tid] = rp[F.tid] * LOG2E_F; }
        att::UnitP u; const size_t tb = (size_t)b * SEQ, tq = tb + (size_t)R0 * 64, tk = tb + (size_t)r_lo * 64;
        u.Q = hb + tq * DINP + H_NAQ + h * 64; u.ldq = DINP; u.K0 = hb + tk * DINP + H_NAK + h * 64; u.ldk0 = DINP; u.K1 = nullptr; u.ldk1 = 0;
        u.V = hb + tk * DINP + H_NAV + h * 64; u.ldv = DINP; u.O = ya + tq * 384 + h * 64; u.ldo = 384; u.nt = r_hi - r_lo; u.grow0 = R0; u.gain = nullptr; u.kr0 = r_lo; u.cref = 0.f;
        att::attn_unit<64, 2>(u, lds, F.tid);
    }
}


struct Args { const float* in[23]; float* out; unsigned char* ws; int ph_lo, ph_hi, use_bar, pad; };
__global__ void __launch_bounds__(NWAVES * 64, 2) mk_fwd(Args args) {
    extern __shared__ __attribute__((aligned(16))) unsigned char lds[];
    const int wave_id = __builtin_amdgcn_readfirstlane((int)threadIdx.x >> 6), bx0 = blockIdx.x, G0 = gridDim.x;
    {   LAS unsigned* z = (LAS unsigned*)((LAS unsigned char*)lds + LDSCTL_OFF); for (int u = threadIdx.x; u < (LDS_BYTES - LDSCTL_OFF) / 4; u += NWAVES * 64) z[u] = 0u; }
    __syncthreads();
    XcdBarrier bar; bar.bar = (unsigned*)(args.ws + WS_CTL) + CW_BAR; bar.x = 0; bar.st = nullptr;
    if (args.use_bar) bar = xcd_barrier_post((unsigned*)(args.ws + WS_CTL) + CW_BAR, (volatile LAS unsigned*)((LAS unsigned char*)lds + MISC_OFF));
    const int lo = args.ph_lo, hi = args.ph_hi;
#define IN(k) (lo <= (k) && (k) < hi)
#define REPEAT(n) for (int rep_ = 0; rep_ < (n); ++rep_)
#define RSEAM(n) do { if (rep_ + 1 < (n)) { XcdBarrier b_ = bar; { GAS unsigned* bb_ = (GAS unsigned*)b_.bar; asm volatile("; rseam %1" : "+s"(bb_) : "n"(__COUNTER__)); b_.bar = (unsigned*)bb_; } xcd_barrier(b_); } } while (0)
#define SEAM(k) do { if (IN(k) && IN((k) + 1)) { XcdBarrier b_ = bar; { GAS unsigned* bb_ = (GAS unsigned*)b_.bar; asm volatile("; seam %1" : "+s"(bb_) : "n"(__COUNTER__)); b_.bar = (unsigned*)bb_; } xcd_barrier(b_); } } while (0)
#define FRAME() Frame F = mkframe<__COUNTER__>((LAS unsigned char*)lds, args.ws, args.out, wave_id, bx0, G0); unsigned char* ws = F.ws; unsigned char* a2 = ws + WS_A2; unsigned char* wb = ws + WS_W + (size_t)l * WB_LAYER; (void)a2; (void)wb

    if (IN(0)) REPEAT(REP_P) { Frame F = mkframe<__COUNTER__>((LAS unsigned char*)lds, args.ws, args.out, wave_id, bx0, G0); p_prologue(F); RSEAM(REP_P); } SEAM(0);

    for (int l = 0; l < DEPTH; ++l) {
        const int pb = 1 + l * PPL;
        if (IN(pb + 0)) REPEAT(REP_A) { FRAME();
            pg8::Gemm g{(const bf16*)(ws + WS_XB), (const bf16*)(wb + WB_IN), T, DINP, 1024, 0, 0}; pg8::StaticOrder S; S.init(T, DINP, F.G, F.bx);
            pg8::EpiStore E{(bf16*)(ws + WS_H), DINP, DINP};
            pg8::gemm_phase<pg8::EpiStore, pg8::StaticOrder, true, true>(F.lds, g, S, E, F.tid); RSEAM(REP_A);
        } SEAM(pb + 0);
        if (IN(pb + 1)) REPEAT(REP_B) { FRAME(); p_prep(F, l); RSEAM(REP_B); } SEAM(pb + 1);
        if (IN(pb + 2)) REPEAT(REP_C) {
            { FRAME(); pg8::Gemm g{(const bf16*)(a2 + A2_CQN), (const bf16*)(wb + WB_UQ), T, 512, 384, 0, 0}; pg8::StaticOrder S; S.init(T, 512, F.G, F.bx);
              pg8::EpiStore E{(bf16*)(a2 + A2_QC), 384, 384};
              pg8::gemm_phase<pg8::EpiStore, pg8::StaticOrder, true, true>(F.lds, g, S, E, F.tid); }
            { FRAME(); pg8::Gemm g{(const bf16*)(a2 + A2_CKVN), (const bf16*)(wb + WB_UKV), T, 512, 256, 0, 0}; pg8::StaticOrder S; S.init(T, 512, F.G, F.bx);
              pg8::EpiStore E{(bf16*)(a2 + A2_KVC), 512, 512};
              pg8::gemm_phase<pg8::EpiStore, pg8::StaticOrder, true, true>(F.lds, g, S, E, F.tid); }
            RSEAM(REP_C);
        } SEAM(pb + 2);
        if (IN(pb + 3)) { REPEAT(REP_DG) { FRAME(); p_attention<0>(F, l); RSEAM(REP_DG); } REPEAT(REP_DM) { FRAME(); p_attention<1>(F, l); RSEAM(REP_DM); } REPEAT(REP_DN) { FRAME(); p_attention<2>(F, l); RSEAM(REP_DN); } } SEAM(pb + 3);
        if (IN(pb + 4)) REPEAT(REP_E) { FRAME();
            pg8::Gemm g{(const bf16*)(a2 + A2_YA), (const bf16*)(wb + WB_BA), T, 1024, 384, (size_t)1024 * 384 * 2, (size_t)T * 384 * 2};
            pg8::ChainOrder S; S.so.init(T, 1024, F.G, F.bx); S.nch = 3;
            pg8::EpiGateChain E{(const bf16*)(ws + WS_H) + H_GATE, DINP, (bf16*)(a2 + A2_MIXED)};
            pg8::gemm_phase<pg8::EpiGateChain, pg8::ChainOrder, true, true>(F.lds, g, S, E, F.tid);
            RSEAM(REP_E);
        } SEAM(pb + 4);
        if (IN(pb + 5)) REPEAT(REP_F) { FRAME();
            pg8::Gemm g{(const bf16*)(a2 + A2_MIXED), (const bf16*)(wb + WB_OUT), T, 1024, 1024, 0, 0}; pg8::StaticOrder S; S.init(T, 1024, F.G, F.bx);
            pg8::EpiStore E{(bf16*)(ws + WS_X1), 1024, 1024};
            pg8::gemm_phase<pg8::EpiStore, pg8::StaticOrder, true, true>(F.lds, g, S, E, F.tid); RSEAM(REP_F);
        } SEAM(pb + 5);
        if (IN(pb + 6)) { FRAME(); p_ln1_router(F, l, (l == 0) ? INP(0) : (const float*)(ws + WS_X2)); } SEAM(pb + 6);
        if (IN(pb + 7)) REPEAT(REP_I) { FRAME();
            const int total = build_tables(F, l);
            pg8::Gemm g{(const bf16*)(ws + WS_X1B), (const bf16*)(wb + WB_GU), total, 2048, 1024, (size_t)2048 * 1024 * 2, 0};
            pg8::MoeGather gs{(const int*)(ws + WS_LT), (const LAS int*)(F.lds + TBL_START), (const LAS int*)(F.lds + TBL_START) + 33, LCAP};
            pg8::MoeOrder S{8, (total >> 8) * 8, F.G, F.vcu, (const LAS int*)(F.lds + TBL_TILEE)};
            pg8::EpiSwiglu E{(bf16*)(ws + WS_A2), INP(18) + (size_t)l * NE * 2048};
            pg8::gemm_phase<pg8::EpiSwiglu, pg8::MoeOrder, true, true, true, pg8::MoeGather>(F.lds, g, S, E, F.tid, gs); RSEAM(REP_I);
        } SEAM(pb + 7);
        if (IN(pb + 8)) REPEAT(REP_J) { FRAME();
            const int total = build_tables(F, l);
            pg8::Gemm g{(const bf16*)(ws + WS_A2), (const bf16*)(wb + WB_DN), total, 1024, 1024, (size_t)1024 * 1024 * 2, 0};
            pg8::MoeOrder S{4, (total >> 8) * 4, F.G, F.vcu, (const LAS int*)(F.lds + TBL_TILEE)};
            pg8::EpiDown E{(bf16*)(ws + WS_H), INP(20) + (size_t)l * NE * 1024, (const float*)(ws + WS_LG), (const LAS int*)(F.lds + TBL_START), (const LAS int*)(F.lds + TBL_START) + 33, LCAP};
            pg8::gemm_phase<pg8::EpiDown, pg8::MoeOrder, true, true>(F.lds, g, S, E, F.tid); RSEAM(REP_J);
        } SEAM(pb + 8);
        if (IN(pb + 9)) REPEAT(REP_K) { FRAME(); RSEAM(REP_K); p_ln2(F, l, (l == DEPTH - 1) ? F.out : (float*)(ws + WS_X2), l + 1 < DEPTH); }
        if (l + 1 < DEPTH) SEAM(pb + 9);
    }
#undef IN
#undef SEAM
}


#if MK_DEBUG
constexpr int CW_DBG = 20000;
__device__ __forceinline__ float bfr(float f) { return __uint_as_float(f2bf(f) << 16); }
__device__ __forceinline__ float bfv(const bf16* p) { return __uint_as_float(((unsigned)*p) << 16); }
__device__ __forceinline__ unsigned hsh(unsigned x) { x ^= x >> 16; x *= 0x7feb352du; x ^= x >> 15; x *= 0x846ca68bu; x ^= x >> 16; return x; }
__device__ __forceinline__ bool close_(float got, float ref, float rel, float abs_) { return fabsf(got - ref) <= rel * fabsf(ref) + abs_; }
__device__ __forceinline__ void ropecs(int i, int quarter, int s, float& c, float& sn) {
    const float pos = (i < quarter) ? (float)(s >> 6) : (float)(s & 63); const int m = (i < quarter) ? i : i - quarter;
    const float inv = exp2f(-(float)m / (float)quarter * 13.287712379549449f); const float ang = pos * inv * 0.15915494309189535f; c = __builtin_amdgcn_cosf(ang); sn = __builtin_amdgcn_sinf(ang);
}
#define DBG_FAIL(bit) atomicOr((unsigned*)(ws + WS_CTL) + CW_DBG, 1u << (bit))
template <int stage> __global__ void __launch_bounds__(256) dbg_kernel(Args args) {
    unsigned char* ws = args.ws; const int l = 0;
    const int gid = blockIdx.x * 256 + threadIdx.x;
    const bf16* hb = (const bf16*)(ws + WS_H); unsigned char* a2 = ws + WS_A2; unsigned char* wb = ws + WS_W + (size_t)l * WB_LAYER;
    const bf16* kB = (const bf16*)(a2 + A2_KB); const bf16* cqn = (const bf16*)(a2 + A2_CQN); const bf16* ckvn = (const bf16*)(a2 + A2_CKVN); const bf16* kr = (const bf16*)(a2 + A2_KR);
    const bf16* qc = (const bf16*)(a2 + A2_QC); const bf16* kvc = (const bf16*)(a2 + A2_KVC);
    const bf16* ya = (const bf16*)(a2 + A2_YA); const bf16* yb = (const bf16*)(a2 + A2_YB); const bf16* yc = (const bf16*)(a2 + A2_YC);
    const unsigned h1 = hsh(gid * 2654435761u + 12345u + stage * 977u), h2 = hsh(h1 + 0x9e3779b9u);
    const int t = h1 % T, s = t & (SEQ - 1), b = t / SEQ;
    if (stage == 0) {
        const int n = h2 % DIN; const float* x = args.in[0] + (size_t)t * D; const float* W = args.in[1];
        const float sc = (n < 384) ? 0.125f * LOG2E_F : 1.0f; float r = 0.f;
        for (int k = 0; k < 1024; ++k) r += bfr(x[k]) * bfr(W[(size_t)k * DIN + n] * sc);
        if (!close_(bfv(hb + (size_t)t * DINP + n), r, 0.02f, 0.02f)) DBG_FAIL(1);
    }
    if (stage == 1) {
        const bf16* hr = hb + (size_t)t * DINP;
        {   const int d = h2 % 128, head = d >> 6, dd = d & 63; float ssq = 0.f;
            for (int k = 0; k < 64; ++k) { const float v = bfv(hr + H_GK + head * 64 + k); ssq += v * v; }
            const float rstd = 1.0f / sqrtf(ssq / 64.0f + RMS_EPS); const float* g = args.in[4];
            const int i = dd & 31; const float y1 = bfv(hr + H_GK + head * 64 + i) * rstd * g[i], y2 = bfv(hr + H_GK + head * 64 + i + 32) * rstd * g[i + 32];
            float c, sn; ropecs(i, 16, s, c, sn); const float ref = (dd < 32) ? (y1 * c - y2 * sn) : (y1 * sn + y2 * c);
            if (!close_(bfv(kB + (size_t)t * 128 + d), ref, 0.02f, 0.01f)) DBG_FAIL(2); }
        {   const int d = h2 % 384; float ssq = 0.f; for (int k = 0; k < 384; ++k) { const float v = bfv(hr + H_CQ + k); ssq += v * v; }
            const float ref = bfv(hr + H_CQ + d) / sqrtf(ssq / 384.0f + RMS_EPS) * args.in[5][d];
            if (!close_(bfv(cqn + (size_t)t * 384 + d), ref, 0.02f, 0.01f)) DBG_FAIL(3); }
        {   const int d = h2 % 256; float ssq = 0.f; for (int k = 0; k < 256; ++k) { const float v = bfv(hr + H_CKV + k); ssq += v * v; }
            const float ref = bfv(hr + H_CKV + d) / sqrtf(ssq / 256.0f + RMS_EPS) * args.in[6][d];
            if (!close_(bfv(ckvn + (size_t)t * 256 + d), ref, 0.02f, 0.01f)) DBG_FAIL(4); }
        {   const int d = h2 % 32, i = d & 15; const float x1 = bfv(hr + H_KR + i), x2 = bfv(hr + H_KR + i + 16); float c, sn; ropecs(i, 8, s, c, sn);
            const float ref = (d < 16) ? (x1 * c - x2 * sn) : (x1 * sn + x2 * c);
            if (!close_(bfv(kr + (size_t)t * 32 + d), ref, 0.02f, 0.01f)) DBG_FAIL(5); }
    }
    if (stage == 2) {
        {   const int n = h2 % 384; float r = 0.f; const float sc = 0.10206207261596577f * LOG2E_F;
            for (int k = 0; k < 384; ++k) r += bfv(cqn + (size_t)t * 384 + k) * bfr(args.in[7][(size_t)k * 384 + n] * sc);
            if (!close_(bfv(qc + (size_t)t * 384 + n), r, 0.02f, 0.01f)) DBG_FAIL(6); }
        {   const int n = h2 % 512; float r = 0.f;
            for (int k = 0; k < 256; ++k) r += bfv(ckvn + (size_t)t * 256 + k) * bfr(args.in[8][(size_t)k * 512 + n]);
            if (!close_(bfv(kvc + (size_t)t * 512 + n), r, 0.02f, 0.02f)) DBG_FAIL(7); }
    }
    if (stage == 3) {
        const int gr = s >> 6, gc = s & 63;
        if (gid < 1024) {
            const int h = h2 % 6, dofs = ((h2 >> 8) & 1) * 32; float q[64], o[32];
            _Pragma("unroll") for (int d = 0; d < 64; ++d) { q[d] = bfv(hb + (size_t)t * DINP + H_NAQ + h * 64 + d); }
            _Pragma("unroll") for (int d = 0; d < 32; ++d) o[d] = 0.f;
            int r0 = gr - 4; r0 = r0 < 0 ? 0 : (r0 > 120 ? 120 : r0); int c0 = gc - 8; c0 = c0 < 0 ? 0 : (c0 > 48 ? 48 : c0);
            const float* rp = args.in[2] + (size_t)h * 465; float m = -1e30f, lsum = 0.f;
            for (int pass = 0; pass < 2; ++pass)
                for (int i = 0; i < 8; ++i) for (int j = 0; j < 16; ++j) { const int kr_ = r0 + i, kc = c0 + j; const size_t kt = (size_t)b * SEQ + kr_ * 64 + kc;
                    float sc = 0.f; _Pragma("unroll") for (int d = 0; d < 64; ++d) sc += q[d] * bfv(hb + kt * DINP + H_NAK + h * 64 + d);
                    sc += rp[(kr_ - gr + 7) * 31 + (kc - gc + 15)] * LOG2E_F;
                    if (pass == 0) m = fmaxf(m, sc); else { const float p = exp2f(sc - m); lsum += p; _Pragma("unroll") for (int d = 0; d < 32; ++d) o[d] += p * bfv(hb + kt * DINP + H_NAV + h * 64 + dofs + d); } }
            bool bad = false; _Pragma("unroll") for (int d = 0; d < 32; ++d) bad |= !close_(bfv(ya + (size_t)t * 384 + h * 64 + dofs + d), o[d] / lsum, 0.03f, 0.01f);
            if (bad) DBG_FAIL(8);
        } else if (gid < 1024 + 128) {
            const int head = h2 % 6, kvh = head / 3, dofs = ((h2 >> 8) & 1) * 32; float q[64], o[32]; float ssq = 0.f;
            _Pragma("unroll") for (int d = 0; d < 64; ++d) { q[d] = bfv(hb + (size_t)t * DINP + H_GQ + head * 64 + d); ssq += q[d] * q[d]; }
            _Pragma("unroll") for (int d = 0; d < 32; ++d) o[d] = 0.f;
            const float rstd = 1.0f / sqrtf(ssq / 64.0f + RMS_EPS);
            _Pragma("unroll") for (int d = 0; d < 64; ++d) q[d] = q[d] * rstd * args.in[3][d];
            _Pragma("unroll") for (int i = 0; i < 32; ++i) { float c, sn; ropecs(i, 16, s, c, sn); const float y1 = q[i], y2 = q[i + 32]; q[i] = y1 * c - y2 * sn; q[i + 32] = y1 * sn + y2 * c; }
            _Pragma("unroll") for (int d = 0; d < 64; ++d) q[d] = bfr(q[d] * 0.125f * LOG2E_F);
            float m = -1e30f, lsum = 0.f;
            for (int key = 0; key < SEQ; ++key) { const size_t kt = (size_t)b * SEQ + key; float sc = 0.f;
                _Pragma("unroll") for (int d = 0; d < 64; ++d) sc += q[d] * bfv(kB + kt * 128 + kvh * 64 + d);
                const float mn = fmaxf(m, sc), al = exp2f(m - mn), p = exp2f(sc - mn); m = mn; lsum = lsum * al + p;
                _Pragma("unroll") for (int d = 0; d < 32; ++d) o[d] = o[d] * al + p * bfv(hb + kt * DINP + H_GV + kvh * 64 + dofs + d); }
            bool bad = false; _Pragma("unroll") for (int d = 0; d < 32; ++d) bad |= !close_(bfv(yb + (size_t)t * 384 + head * 64 + dofs + d), o[d] / lsum, 0.03f, 0.003f);
            if (bad) DBG_FAIL(9);
        } else if (gid < 1024 + 256) {
            const int h = h2 % 4, dofs = ((h2 >> 8) & 1) * 32; float q[96], o[32];
            _Pragma("unroll") for (int d = 0; d < 96; ++d) q[d] = bfv(qc + (size_t)t * 384 + h * 96 + d);
            _Pragma("unroll") for (int i = 0; i < 16; ++i) { float c, sn; ropecs(i, 8, s, c, sn); const float y1 = q[64 + i], y2 = q[80 + i]; q[64 + i] = bfr(y1 * c - y2 * sn); q[80 + i] = bfr(y1 * sn + y2 * c); }
            _Pragma("unroll") for (int d = 0; d < 32; ++d) o[d] = 0.f;
            float m = -1e30f, lsum = 0.f;
            for (int key = 0; key < SEQ; ++key) { const size_t kt = (size_t)b * SEQ + key; float sc = 0.f;
                _Pragma("unroll") for (int d = 0; d < 64; ++d) sc += q[d] * bfv(kvc + kt * 512 + h * 128 + d);
                _Pragma("unroll") for (int d = 0; d < 32; ++d) sc += q[64 + d] * bfv(kr + kt * 32 + d);
                const float mn = fmaxf(m, sc), al = exp2f(m - mn), p = exp2f(sc - mn); m = mn; lsum = lsum * al + p;
                _Pragma("unroll") for (int d = 0; d < 32; ++d) o[d] = o[d] * al + p * bfv(kvc + kt * 512 + h * 128 + 64 + dofs + d); }
            bool bad = false; _Pragma("unroll") for (int d = 0; d < 32; ++d) bad |= !close_(bfv(yc + (size_t)t * 384 + h * 64 + dofs + d), o[d] / lsum, 0.03f, 0.003f);
            if (bad) DBG_FAIL(10);
        }
    }
    if (stage == 4) {
        const int n = h2 % 1024; float r = 0.f;
        { float a = 0.f; for (int k = 0; k < 384; ++k) a += bfv(ya + (size_t)t * 384 + k) * bfr(args.in[9][(size_t)k * 1024 + n]); r += a / (1.0f + expf(-bfv(hb + (size_t)t * DINP + H_GATE + n))); }
        { float a = 0.f; for (int k = 0; k < 384; ++k) a += bfv(yb + (size_t)t * 384 + k) * bfr(args.in[10][(size_t)k * 1024 + n]); r += a / (1.0f + expf(-bfv(hb + (size_t)t * DINP + H_GATE + 1024 + n))); }
        { float a = 0.f; for (int k = 0; k < 256; ++k) a += bfv(yc + (size_t)t * 384 + k) * bfr(args.in[11][(size_t)k * 1024 + n]); r += a / (1.0f + expf(-bfv(hb + (size_t)t * DINP + H_GATE + 2048 + n))); }
        if (!close_(bfv((const bf16*)(a2 + A2_MIXED) + (size_t)t * 1024 + n), r, 0.02f, 0.003f)) DBG_FAIL(11);
    }
    if (stage == 5) {
        const int n = h2 % 1024; float r = 0.f; const bf16* mx = (const bf16*)(a2 + A2_MIXED) + (size_t)t * 1024;
        for (int k = 0; k < 1024; ++k) r += bfv(mx + k) * bfr(args.in[12][(size_t)k * 1024 + n]);
        if (!close_(bfv((const bf16*)(ws + WS_X1) + (size_t)t * D + n), r, 0.02f, 0.002f)) DBG_FAIL(12);
    }
    if (stage == 6) {
        const bf16* x1 = (const bf16*)(ws + WS_X1B) + (size_t)t * D; const int* tok_e = (const int*)(ws + WS_TE); const int* tok_r = (const int*)(ws + WS_TR);
        const int* list_t = (const int*)(ws + WS_LT); const float* list_g = (const float*)(ws + WS_LG);
        float lg[32]; _Pragma("unroll") for (int e = 0; e < 32; ++e) lg[e] = args.in[16][e];
        for (int k = 0; k < 1024; ++k) { const float xv = bfv(x1 + k); _Pragma("unroll") for (int e = 0; e < 32; ++e) lg[e] += xv * args.in[15][(size_t)k * 32 + e]; }
        int se[4]; float sv[4]; unsigned used = 0;
        _Pragma("unroll") for (int r = 0; r < 4; ++r) { int be = -1; float bv = -INFINITY; _Pragma("unroll") for (int e = 0; e < 32; ++e) if (!((used >> e) & 1) && lg[e] > bv) { bv = lg[e]; be = e; } se[r] = be; sv[r] = bv; used |= 1u << be; }
        float fifth = -INFINITY; _Pragma("unroll") for (int e = 0; e < 32; ++e) if (!((used >> e) & 1)) fifth = fmaxf(fifth, lg[e]);
        const bool neartie = (sv[3] - fifth) < 3e-2f || (sv[0] - sv[1]) < 3e-2f || (sv[1] - sv[2]) < 3e-2f || (sv[2] - sv[3]) < 3e-2f;
        float den = 0.f; _Pragma("unroll") for (int r = 0; r < 4; ++r) den += expf(sv[r] - sv[0]);
        bool bad = false, badg = false;
        if (!neartie) _Pragma("unroll") for (int r = 0; r < 4; ++r) { const int e = tok_e[t * 4 + r], rk = tok_r[t * 4 + r]; if (e != se[r]) { bad = true; continue; }
            if (rk < 0 || rk >= LCAP || list_t[(size_t)e * LCAP + rk] != t) badg = true; else if (!close_(list_g[(size_t)e * LCAP + rk], expf(sv[r] - sv[0]) / den, 0.03f, 1e-3f)) badg = true; }
        if (bad) DBG_FAIL(13); if (badg) DBG_FAIL(14);
        { float sm = 0.f, sq = 0.f; for (int k = 0; k < 1024; ++k) { const float z = (bfv(x1 + k) - args.in[14][k]) / args.in[13][k]; sm += z; sq += z * z; }
          if (fabsf(sm / 1024.f) > 4e-3f || fabsf(sq / 1024.f - 1.0f) > 2e-2f) DBG_FAIL(19); }
    }
    if (stage >= 7 && stage <= 9) {
        __shared__ int st[33], cn[32];
        if (threadIdx.x == 0) { int a = 0; for (int e2 = 0; e2 < 32; ++e2) { cn[e2] = (int)((const unsigned*)(ws + WS_CTL))[CW_CNT + 64 * l + e2]; st[e2] = a; a += ((cn[e2] + 255) >> 8) << 8; } st[32] = a; }
        __syncthreads();
        const int total = st[32]; const int sl = h1 % total; int e = 0; for (int k = 1; k < 32; ++k) if (sl >= st[k]) e = k; const int r = sl - st[e];
        const int* list_t = (const int*)(ws + WS_LT); const float* list_g = (const float*)(ws + WS_LG); const float* sg = (const float*)(ws + WS_SG);
        if (stage == 7) { int sum = 0; for (int k = 0; k < 32; ++k) sum += cn[k]; if (sum != TK) DBG_FAIL(15); }
        if (stage == 7 && r < cn[e]) {
            const bf16* xg = (const bf16*)(ws + WS_X1B) + (size_t)list_t[(size_t)e * LCAP + r] * D; const int f = h2 % 1024; const float* W = args.in[17] + (size_t)e * 1024 * 2048;
            float g = args.in[18][e * 2048 + f], u = args.in[18][e * 2048 + 1024 + f];
            for (int k = 0; k < 1024; ++k) { const float xv = bfv(xg + k); g += xv * bfr(W[(size_t)k * 2048 + f]); u += xv * bfr(W[(size_t)k * 2048 + 1024 + f]); }
            g = fminf(g, 7.0f); u = fminf(fmaxf(u, -7.0f), 7.0f); const float ref = g / (1.0f + expf(-1.702f * g)) * (u + 1.0f);
            if (!close_(bfv((const bf16*)(ws + WS_A2) + (size_t)sl * 1024 + f), ref, 0.03f, 0.02f)) DBG_FAIL(16);
        }
        if (stage == 8 && r < cn[e]) {
            const bf16* ab = (const bf16*)(ws + WS_A2) + (size_t)sl * 1024; const int n = h2 % 1024; const float* W = args.in[19] + (size_t)e * 1024 * 1024;
            float y = args.in[20][e * 1024 + n]; for (int k = 0; k < 1024; ++k) y += bfv(ab + k) * bfr(W[(size_t)k * 1024 + n]);
            y *= list_g[(size_t)e * LCAP + r];
            if (!close_(bfv((const bf16*)(ws + WS_H) + (size_t)sl * 1024 + n), y, 0.03f, 0.005f)) DBG_FAIL(17);
        }
        if (stage == 9) {
            const bf16* x1 = (const bf16*)(ws + WS_X1B) + (size_t)t * D; const int* tok_e = (const int*)(ws + WS_TE); const int* tok_r = (const int*)(ws + WS_TR);
            const bf16* ybf = (const bf16*)(ws + WS_H); float sm = 0.f, sq = 0.f; const int n = h2 % 1024; float vn = 0.f;
            for (int k = 0; k < 1024; ++k) { float v = DN_ALPHA * bfv(x1 + k); for (int q = 0; q < 4; ++q) v += bfv(ybf + (size_t)(st[tok_e[t * 4 + q]] + tok_r[t * 4 + q]) * D + k); sm += v; sq += v * v; if (k == n) vn = v; }
            const float mean = sm / 1024.f, var = sq / 1024.f - mean * mean; const float ref = (vn - mean) / sqrtf(var + LN_EPS) * args.in[21][n] + args.in[22][n];
            if (!close_(((const float*)(ws + WS_X2))[(size_t)t * D + n], ref, 0.005f, 0.003f)) DBG_FAIL(18);
        }
    }
}
static void dbg_launch(int stage, const Args& a, hipStream_t stream) {
    switch (stage) {
#define DBGL(k) case k: hipLaunchKernelGGL(dbg_kernel<k>, dim3(8), dim3(256), 0, stream, a); break;
        DBGL(0) DBGL(1) DBGL(2) DBGL(3) DBGL(4) DBGL(5) DBGL(6) DBGL(7) DBGL(8) DBGL(9)
#undef DBGL
    }
}
#endif

extern "C" void kernel_launch(void* const* d_in, const int* in_sizes, int n_in, void* d_out, int out_size, void* d_ws, size_t ws_size, hipStream_t stream) {
    static int grid = 0;
    if (grid == 0) {
        if (n_in != 23 || in_sizes[0] != T * D || out_size != T * D || ws_size < WS_END) { fprintf(stderr, "kernel_launch: unexpected shapes / workspace (%d inputs, ws %zu, need %zu)\n", n_in, ws_size, (size_t)WS_END); grid = -1; return; }
        int dev = 0, cus = 0, per_cu = 0;
        if (hipGetDevice(&dev) != hipSuccess || hipDeviceGetAttribute(&cus, hipDeviceAttributeMultiprocessorCount, dev) != hipSuccess) { grid = -1; return; }
        if (hipFuncSetAttribute((const void*)mk_fwd, hipFuncAttributeMaxDynamicSharedMemorySize, LDS_BYTES) != hipSuccess) { fprintf(stderr, "kernel_launch: hipFuncSetAttribute failed\n"); grid = -1; return; }
        if (hipOccupancyMaxActiveBlocksPerMultiprocessor(&per_cu, (const void*)mk_fwd, NWAVES * 64, LDS_BYTES) != hipSuccess || per_cu < 1) { fprintf(stderr, "kernel_launch: occupancy query reports %d\n", per_cu); }
        (void)hipGetLastError();
        grid = cus;
    }
    if (grid < 0) return;
    if (hipMemsetAsync((char*)d_ws + WS_CTL, 0, CTL_ZERO_BYTES, stream) != hipSuccess) return;
    Args a{};
    for (int i = 0; i < 23; ++i) a.in[i] = (const float*)d_in[i];
    a.out = (float*)d_out; a.ws = (unsigned char*)d_ws; a.pad = 0;
#if MK_ONE_LAUNCH
    a.ph_lo = 0; a.ph_hi = NPH; a.use_bar = 1;
    hipLaunchKernelGGL(mk_fwd, dim3(grid), dim3(NWAVES * 64), LDS_BYTES, stream, a);
#else
    for (int p = 0; p < NPH; ++p) { a.ph_lo = p; a.ph_hi = p + 1; a.use_bar = 0; hipLaunchKernelGGL(mk_fwd, dim3(grid), dim3(NWAVES * 64), LDS_BYTES, stream, a);
#if MK_DEBUG
        if (p >= 1 && p <= PPL) dbg_launch(p - 1, a, stream);
#endif
    }
#endif
    const hipError_t le = hipPeekAtLastError();
    if (le != hipSuccess) fprintf(stderr, "kernel_launch: launch failed: %s\n", hipGetErrorName(le));
}
```

```cpp
#define MK_DEBUG 0
#define MK_ONE_LAUNCH 1
#include <hip/hip_runtime.h>
#include <hip/hip_bf16.h>
#include <cstdio>
#include <cstdint>
namespace pg8 {
#define PG8_LAS __attribute__((address_space(3)))
typedef unsigned short bf16_t;
typedef short bf16x8 __attribute__((ext_vector_type(8)));
typedef float f32x4 __attribute__((ext_vector_type(4)));
typedef unsigned u32x4 __attribute__((ext_vector_type(4)));
constexpr int BM = 256, BK = 64, HALF = 128, HTB = HALF * BK * 2  , STAGE_BYTES = 8 * HTB, NXCD = 8, WGM = 8;

__host__ __device__ __forceinline__ int lds_byte(int r, int c) { const int st = (r >> 4) * 2 + (c >> 5), rr = r & 15, cc = c & 31, ob = rr * 64 + cc * 2; return st * 1024 + (ob ^ (((ob >> 9) & 1) << 5)); }
__host__ __device__ __forceinline__ void stage_rc(int b, int& R, int& C) { const int st = b / 1024, sb = b % 1024, swz = sb ^ (((sb >> 9) & 1) << 5); R = (st >> 1) * 16 + swz / 64; C = (st & 1) * 32 + (swz % 64) / 2; }
__host__ __device__ __forceinline__ int perm32(int rho) { const int n = rho >> 4, i = rho & 15; return 8 * (i >> 2) + 4 * n + (i & 3); }

struct Unit { int pm, pn, e; };
struct Gemm { const bf16_t* A; const bf16_t* Bt; int M, N, K; size_t bstride; size_t astride; };

struct StaticOrder {
    int nM, nN, nwg, G, c;
    __host__ __device__ void init(int M, int N, int G_, int c_) { nM = M / BM; nN = N / BM; nwg = nM * nN; G = G_; c = c_; }
    __host__ __device__ bool next(int i, Unit& u) const {
        const long L = (long)i * G + c; if (L >= nwg) return false;
        int wgid = (int)L; { const int q = nwg / NXCD, r = nwg % NXCD, xcd = wgid % NXCD, off = wgid / NXCD; wgid = (xcd < r ? xcd * (q + 1) : r * (q + 1) + (xcd - r) * q) + off; }
        const int nig = WGM * nN, gid = wgid / nig, fm = gid * WGM, gsz = (nM - fm) < WGM ? (nM - fm) : WGM;
        u.pm = fm + ((wgid % nig) % gsz); u.pn = (wgid % nig) / gsz; u.e = 0; return true;
    }
    __device__ __forceinline__ void a_ready(const Unit&) const {}
    __device__ __forceinline__ void done(const Unit&) const {}
};

__device__ __forceinline__ unsigned cvt_pk_bf16(float lo, float hi) { unsigned r; asm volatile("v_cvt_pk_bf16_f32 %0, %1, %2" : "=v"(r) : "v"(lo), "v"(hi)); return r; }
typedef float f32x2 __attribute__((ext_vector_type(2)));


__device__ __forceinline__ float bf_lo(unsigned w) { return __uint_as_float(w << 16); }
__device__ __forceinline__ float bf_hi(unsigned w) { return __uint_as_float(w & 0xffff0000u); }
__device__ __forceinline__ float sigmoidf_(float z) { return __builtin_amdgcn_rcpf(1.0f + __builtin_amdgcn_exp2f(-1.4426950408889634f * z)); }
__device__ __forceinline__ u32x4 pack8(const f32x4& v0, const f32x4& v1) { u32x4 w; w.x = cvt_pk_bf16(v0[0], v0[1]); w.y = cvt_pk_bf16(v0[2], v0[3]); w.z = cvt_pk_bf16(v1[0], v1[1]); w.w = cvt_pk_bf16(v1[2], v1[3]); return w; }

struct EpiStore {
    static constexpr bool PERM = true, AFTER_DRAIN = false, CHAIN = false;
    bf16_t* O; int ldc; int nvalid;
    __device__ __forceinline__ void operator()(const f32x4 (&acc)[2][2][4][2], const Unit& u, int wr, int wc, int fr, int fq) const {
        const int row0 = u.pm * BM + wr * 64 + fr, col0 = u.pn * BM + wc * 32 + 8 * fq;
#pragma unroll
        for (int ai = 0; ai < 2; ++ai)
#pragma unroll
            for (int m = 0; m < 4; ++m) { bf16_t* rowp = O + (size_t)(row0 + ai * HALF + m * 16) * ldc + col0;
#pragma unroll
                for (int bj = 0; bj < 2; ++bj) { if (col0 + bj * HALF < nvalid) *(u32x4*)(rowp + bj * HALF) = pack8(acc[ai][bj][m][0], acc[ai][bj][m][1]); } }
    }
};
struct EpiGateChain {
    static constexpr bool PERM = true, AFTER_DRAIN = false, CHAIN = true;
    const bf16_t* gate; int ldg; bf16_t* mixed;
    __device__ __forceinline__ void chain(f32x4 (&acc)[2][2][4][2], const Unit& u, int wr, int wc, int fr, int fq) const {
        const int row0 = u.pm * BM + wr * 64 + fr, col0 = u.pn * BM + wc * 32 + 8 * fq;
#pragma unroll
        for (int ai = 0; ai < 2; ++ai)
#pragma unroll
            for (int m = 0; m < 4; ++m) { const size_t row = (size_t)(row0 + ai * HALF + m * 16);
#pragma unroll
                for (int bj = 0; bj < 2; ++bj) { const int col = col0 + bj * HALF;
                    const u32x4 ga = *(const u32x4*)(gate + row * ldg + u.e * 1024 + col);
                    f32x4 na0 = {1.f + __builtin_amdgcn_exp2f(-1.4426950408889634f * bf_lo(ga.x)), 1.f + __builtin_amdgcn_exp2f(-1.4426950408889634f * bf_hi(ga.x)), 1.f + __builtin_amdgcn_exp2f(-1.4426950408889634f * bf_lo(ga.y)), 1.f + __builtin_amdgcn_exp2f(-1.4426950408889634f * bf_hi(ga.y))};
                    f32x4 na1 = {1.f + __builtin_amdgcn_exp2f(-1.4426950408889634f * bf_lo(ga.z)), 1.f + __builtin_amdgcn_exp2f(-1.4426950408889634f * bf_hi(ga.z)), 1.f + __builtin_amdgcn_exp2f(-1.4426950408889634f * bf_lo(ga.w)), 1.f + __builtin_amdgcn_exp2f(-1.4426950408889634f * bf_hi(ga.w))};
                    f32x4 f0, f1;
#pragma unroll
                    for (int q = 0; q < 4; ++q) { f0[q] = __builtin_amdgcn_rcpf(na0[q]); f1[q] = __builtin_amdgcn_rcpf(na1[q]); }
                    if (u.e < 2) { const u32x4 gb = *(const u32x4*)(gate + row * ldg + (u.e + 1) * 1024 + col);
                        f0[0] *= 1.f + __builtin_amdgcn_exp2f(-1.4426950408889634f * bf_lo(gb.x)); f0[1] *= 1.f + __builtin_amdgcn_exp2f(-1.4426950408889634f * bf_hi(gb.x));
                        f0[2] *= 1.f + __builtin_amdgcn_exp2f(-1.4426950408889634f * bf_lo(gb.y)); f0[3] *= 1.f + __builtin_amdgcn_exp2f(-1.4426950408889634f * bf_hi(gb.y));
                        f1[0] *= 1.f + __builtin_amdgcn_exp2f(-1.4426950408889634f * bf_lo(gb.z)); f1[1] *= 1.f + __builtin_amdgcn_exp2f(-1.4426950408889634f * bf_hi(gb.z));
                        f1[2] *= 1.f + __builtin_amdgcn_exp2f(-1.4426950408889634f * bf_lo(gb.w)); f1[3] *= 1.f + __builtin_amdgcn_exp2f(-1.4426950408889634f * bf_hi(gb.w)); }
                    acc[ai][bj][m][0] *= f0; acc[ai][bj][m][1] *= f1;
                    if (u.e == 2) *(u32x4*)(mixed + row * 1024 + col) = pack8(acc[ai][bj][m][0], acc[ai][bj][m][1]); } }
    }
};
struct ChainOrder {
    StaticOrder so; int nch;
    __device__ __forceinline__ bool next(int i, Unit& u) const { const int t = i / nch; if (!so.next(t, u)) return false; u.e = i - t * nch; return true; }
    __device__ __forceinline__ void a_ready(const Unit&) const {}
    __device__ __forceinline__ void done(const Unit&) const {}
};
struct EpiResid {
    static constexpr bool PERM = true, AFTER_DRAIN = false, CHAIN = false;
    const float* x; float* pre; float alpha;
    __device__ __forceinline__ void operator()(const f32x4 (&acc)[2][2][4][2], const Unit& u, int wr, int wc, int fr, int fq) const {
        const int row0 = u.pm * BM + wr * 64 + fr, col0 = u.pn * BM + wc * 32 + 8 * fq;
#pragma unroll
        for (int ai = 0; ai < 2; ++ai)
#pragma unroll
            for (int m = 0; m < 4; ++m) { const size_t row = (size_t)(row0 + ai * HALF + m * 16);
#pragma unroll
                for (int bj = 0; bj < 2; ++bj) { const size_t off = row * 1024 + col0 + bj * HALF;
                    const f32x4 x0 = *(const f32x4*)(x + off), x1 = *(const f32x4*)(x + off + 4);
                    *(f32x4*)(pre + off) = x0 * alpha + acc[ai][bj][m][0]; *(f32x4*)(pre + off + 4) = x1 * alpha + acc[ai][bj][m][1]; } }
    }
};
struct EpiSwiglu {
    static constexpr bool PERM = true, AFTER_DRAIN = false, CHAIN = false;
    bf16_t* a; const float* bias;
    __device__ __forceinline__ void operator()(const f32x4 (&acc)[2][2][4][2], const Unit& u, int wr, int wc, int fr, int fq) const {
        const int row0 = u.pm * BM + wr * 64 + fr, j0 = wc * 32 + 8 * fq, oc = u.pn * HALF + j0;
        const float* bg = bias + (size_t)u.e * 2048 + oc; const float* bu = bg + 1024;
        const f32x4 bg0 = *(const f32x4*)bg, bg1 = *(const f32x4*)(bg + 4), bu0 = *(const f32x4*)bu, bu1 = *(const f32x4*)(bu + 4);
#pragma unroll
        for (int ai = 0; ai < 2; ++ai)
#pragma unroll
            for (int m = 0; m < 4; ++m) { const size_t row = (size_t)(row0 + ai * HALF + m * 16);
                f32x4 g[2] = {acc[ai][0][m][0] + bg0, acc[ai][0][m][1] + bg1}, uu[2] = {acc[ai][1][m][0] + bu0, acc[ai][1][m][1] + bu1}, r[2];
#pragma unroll
                for (int n = 0; n < 2; ++n)
#pragma unroll
                    for (int q = 0; q < 4; ++q) { const float gg = fminf(g[n][q], 7.0f), uc = fminf(fmaxf(uu[n][q], -7.0f), 7.0f);
                        r[n][q] = gg * sigmoidf_(1.702f * gg) * (uc + 1.0f); }
                *(u32x4*)(a + row * 1024 + oc) = pack8(r[0], r[1]); }
    }
};
struct EpiDown {
    static constexpr bool PERM = true, AFTER_DRAIN = false, CHAIN = false;
    bf16_t* y; const float* bias; const float* list_g; const PG8_LAS int* st; const PG8_LAS int* cn; int lcap;
    __device__ __forceinline__ void operator()(const f32x4 (&acc)[2][2][4][2], const Unit& u, int wr, int wc, int fr, int fq) const {
        const int row0 = u.pm * BM + wr * 64 + fr, col0 = u.pn * BM + wc * 32 + 8 * fq;
        const int st_e = st[u.e], cn_e = cn[u.e];
        f32x4 bv[2][2];
#pragma unroll
        for (int bj = 0; bj < 2; ++bj)
#pragma unroll
            for (int n = 0; n < 2; ++n) bv[bj][n] = *(const f32x4*)(bias + (size_t)u.e * 1024 + col0 + bj * HALF + 4 * n);
#pragma unroll
        for (int ai = 0; ai < 2; ++ai)
#pragma unroll
            for (int m = 0; m < 4; ++m) { const size_t row = (size_t)(row0 + ai * HALF + m * 16); const int rank = (int)row - st_e;
                const float gt = rank < cn_e ? list_g[(size_t)u.e * lcap + rank] : 0.f;
#pragma unroll
                for (int bj = 0; bj < 2; ++bj) { const f32x4 v0 = (acc[ai][bj][m][0] + bv[bj][0]) * gt, v1 = (acc[ai][bj][m][1] + bv[bj][1]) * gt;
                    *(u32x4*)(y + row * 1024 + col0 + bj * HALF) = pack8(v0, v1); } }
    }
};
struct MoeGather {
    const int* list_t; const PG8_LAS int* st; const PG8_LAS int* cn; int lcap;
    __device__ __forceinline__ int row(const Unit& u, int r) const { int rank = u.pm * BM + r - st[u.e]; const int c = cn[u.e]; rank = rank < c ? rank : c - 1; return list_t[(size_t)u.e * lcap + rank]; }
};
struct MoeOrder {
    int nN, nunits, G, c; const PG8_LAS int* tile_e;
    __device__ __forceinline__ bool next(int i, Unit& u) const {
        const long L = (long)i * G + c; if (L >= nunits) return false;
        const int tile = (int)L / nN; u.pm = tile; u.pn = (int)L % nN; u.e = __builtin_amdgcn_readfirstlane(tile_e[tile]); return true;
    }
    __device__ __forceinline__ void a_ready(const Unit&) const {}
    __device__ __forceinline__ void done(const Unit&) const {}
};

struct NoGather { };
template <class Epi, class Sched, bool ALIGN_EPI = false, bool SP2 = false, bool GATHER = false, class GS = NoGather>
__device__ __forceinline__ void gemm_phase(PG8_LAS unsigned char* lds, const Gemm g, const Sched& S, const Epi& E, const int tid, const GS gs = GS()) {
    const int wid = __builtin_amdgcn_readfirstlane(tid >> 6), lane = tid & 63, wr = wid >> 2, wc = wid & 3, fr = lane & 15, fq = lane >> 4;
    const int K = g.K, nt = K / BK;
    unsigned voffA[2], voffB[2];
#pragma unroll
    for (int i = 0; i < 2; ++i) { int R, C; stage_rc(tid * 16 + i * 8192, R, C); const int Rb = Epi::PERM ? ((R & ~31) + perm32(R & 31)) : R;
        voffA[i] = (unsigned)(R * K + C) * 2u; voffB[i] = (unsigned)(Rb * K + C) * 2u; }
    unsigned vc0[2], vc1[2], vn0[2], vn1[2];
#define PG8_GROWS(u_, o0, o1) do { _Pragma("unroll") for (int i_ = 0; i_ < 2; ++i_) { int R_, C_; stage_rc(tid * 16 + i_ * 8192, R_, C_); \
        o0[i_] = (unsigned)gs.row((u_), R_) * (unsigned)(K * 2) + (unsigned)(C_ * 2); o1[i_] = (unsigned)gs.row((u_), HALF + R_) * (unsigned)(K * 2) + (unsigned)(C_ * 2); } } while (0)
    const size_t kstep = (size_t)(BK * 2);
    const size_t hstep = (size_t)HALF * K * 2;
    const size_t tstep = 2 * hstep;
    const unsigned ldsw = (unsigned)wid * 1024u;
    const int aoff = lds_byte(wr * 64 + fr, fq * 8), boff = lds_byte(wc * 32 + fr, fq * 8);
#define PG8_SA(b, h) (((b) * 2 + (h)) * HTB)
#define PG8_SB(b, h) ((4 + (b) * 2 + (h)) * HTB)
#define PG8_STAGE(bufoff, gbase, voff) do { _Pragma("unroll") for (int _i = 0; _i < 2; ++_i) \
        __builtin_amdgcn_global_load_lds((const unsigned*)((const char*)(gbase) + (voff)[_i]), (PG8_LAS unsigned*)(lds + (bufoff) + ldsw + _i * 8192), 16, 0, 0); } while (0)
#define PG8_LDA(dst, b, h) do { _Pragma("unroll") for (int m = 0; m < 4; ++m) _Pragma("unroll") for (int k = 0; k < 2; ++k) dst[m][k] = *(const PG8_LAS bf16x8*)(lds + PG8_SA(b, h) + aoff + m * 2048 + k * 1024); } while (0)
#define PG8_LDB(dst, b, h) do { _Pragma("unroll") for (int n = 0; n < 2; ++n) _Pragma("unroll") for (int k = 0; k < 2; ++k) dst[n][k] = *(const PG8_LAS bf16x8*)(lds + PG8_SB(b, h) + boff + n * 2048 + k * 1024); } while (0)
#define PG8_MMA(ai, bj, At, Bt) do { __builtin_amdgcn_s_setprio(1); _Pragma("unroll") for (int m = 0; m < 4; ++m) _Pragma("unroll") for (int n = 0; n < 2; ++n) _Pragma("unroll") for (int k = 0; k < 2; ++k) \
        acc[ai][bj][m][n] = __builtin_amdgcn_mfma_f32_16x16x32_bf16(Bt[n][k], At[m][k], acc[ai][bj][m][n], 0, 0, 0); __builtin_amdgcn_s_setprio(0); } while (0)
#define PG8_WAIT_V(n) asm volatile("s_waitcnt vmcnt(" #n ")" ::: "memory")
#define PG8_WAIT_L(n) asm volatile("s_waitcnt lgkmcnt(" #n ")" ::: "memory")
#define PG8_BAR __builtin_amdgcn_s_barrier()
#define PG8_SCHED __builtin_amdgcn_sched_barrier(0)
    Unit cur, nxt; int ui = 0;
    if (!S.next(0, cur)) return;
    f32x4 acc[2][2][4][2];
#pragma unroll
    for (int a = 0; a < 2; ++a)
#pragma unroll
        for (int b = 0; b < 2; ++b)
#pragma unroll
            for (int m = 0; m < 4; ++m)
#pragma unroll
                for (int n = 0; n < 2; ++n) acc[a][b][m][n] = (f32x4){0.f, 0.f, 0.f, 0.f};
    bf16x8 At[4][2], B0[2][2], B1[2][2];
    const char* cA = GATHER ? (const char*)g.A : (const char*)g.A + (size_t)cur.pm * tstep + (size_t)cur.e * g.astride;
    if constexpr (GATHER) { PG8_GROWS(cur, vc0, vc1); } else { _Pragma("unroll") for (int i = 0; i < 2; ++i) { vc0[i] = voffA[i]; vc1[i] = voffA[i] + (unsigned)hstep; } }
#pragma unroll
    for (int i = 0; i < 2; ++i) { vn0[i] = vc0[i]; vn1[i] = vc1[i]; }
    const char* cB = (const char*)g.Bt + (size_t)cur.pn * tstep + (size_t)cur.e * g.bstride;
    S.a_ready(cur);
    if constexpr (SP2) {
        PG8_STAGE(PG8_SB(0, 0), cB, voffB); PG8_STAGE(PG8_SB(0, 1), cB + hstep, voffB); PG8_STAGE(PG8_SA(0, 0), cA, vc0); PG8_STAGE(PG8_SA(0, 1), cA, vc1);
        if (wr == 1) PG8_BAR;
        PG8_WAIT_V(2); PG8_BAR;
        PG8_STAGE(PG8_SB(1, 0), cB + kstep, voffB); PG8_STAGE(PG8_SA(1, 0), cA + kstep, vc0); PG8_STAGE(PG8_SB(1, 1), cB + hstep + kstep, voffB);
        PG8_WAIT_V(6); PG8_BAR;
    } else {
        PG8_STAGE(PG8_SB(0, 0), cB, voffB); PG8_STAGE(PG8_SA(0, 0), cA, vc0); PG8_STAGE(PG8_SB(0, 1), cB + hstep, voffB); PG8_STAGE(PG8_SA(0, 1), cA, vc1);
        if (wr == 1) PG8_BAR;
        PG8_WAIT_V(4); PG8_BAR;
        PG8_STAGE(PG8_SB(1, 0), cB + kstep, voffB); PG8_STAGE(PG8_SA(1, 0), cA + kstep, vc0); PG8_STAGE(PG8_SB(1, 1), cB + hstep + kstep, voffB);
        PG8_WAIT_V(6); PG8_BAR;
    }
    for (;;) {
        const bool has_next = S.next(ui + 1, nxt);
        const char* nA = GATHER ? cA : (has_next ? (const char*)g.A + (size_t)nxt.pm * tstep + (size_t)nxt.e * g.astride : cA);
        if constexpr (GATHER) { if (has_next) { PG8_GROWS(nxt, vn0, vn1); } } const char* nB = has_next ? (const char*)g.Bt + (size_t)nxt.pn * tstep + (size_t)nxt.e * g.bstride : cB;
        for (int t = 0; t < nt; t += 2) {
            const bool last = (t == nt - 2);
            const char* a1 = cA + (size_t)(t + 1) * kstep;
            const char* a2 = last ? nA : cA + (size_t)(t + 2) * kstep; const char* b2 = last ? nB : cB + (size_t)(t + 2) * kstep;
            const char* a3 = a2 + kstep; const char* b3 = b2 + kstep;
            unsigned vs0[2], vs1[2];
#pragma unroll
            for (int i = 0; i < 2; ++i) { vs0[i] = (GATHER && last) ? vn0[i] : vc0[i]; vs1[i] = (GATHER && last) ? vn1[i] : vc1[i]; }
            if (last && has_next) S.a_ready(nxt);
            if constexpr (SP2) {
            PG8_LDB(B0, 0, 0); PG8_LDB(B1, 0, 1); PG8_SCHED; PG8_LDA(At, 0, 0); PG8_STAGE(PG8_SA(1, 1), a1, vc1);
            PG8_WAIT_V(8); PG8_WAIT_L(0); PG8_BAR; PG8_MMA(0, 0, At, B0); PG8_MMA(0, 1, At, B1); PG8_BAR; PG8_SCHED;
            PG8_LDA(At, 0, 1); PG8_STAGE(PG8_SB(0, 0), b2, voffB); PG8_STAGE(PG8_SB(0, 1), b2 + hstep, voffB); PG8_STAGE(PG8_SA(0, 0), a2, vs0);
            PG8_WAIT_V(8); PG8_WAIT_L(0); PG8_BAR; PG8_MMA(1, 0, At, B0); PG8_MMA(1, 1, At, B1); PG8_BAR; PG8_SCHED;
            PG8_LDB(B0, 1, 0); PG8_LDB(B1, 1, 1); PG8_SCHED; PG8_LDA(At, 1, 0); PG8_STAGE(PG8_SA(0, 1), a2, vs1);
            PG8_WAIT_V(8); PG8_WAIT_L(0); PG8_BAR; PG8_MMA(0, 0, At, B0); PG8_MMA(0, 1, At, B1); PG8_BAR; PG8_SCHED;
            PG8_LDA(At, 1, 1); PG8_STAGE(PG8_SB(1, 0), b3, voffB); PG8_STAGE(PG8_SB(1, 1), b3 + hstep, voffB); PG8_STAGE(PG8_SA(1, 0), a3, vs0);
            PG8_WAIT_V(8); PG8_WAIT_L(0); PG8_BAR; PG8_MMA(1, 0, At, B0); PG8_MMA(1, 1, At, B1); PG8_BAR; PG8_SCHED;
            } else {
            PG8_LDB(B0, 0, 0); PG8_SCHED; PG8_LDA(At, 0, 0); PG8_STAGE(PG8_SA(1, 1), a1, vc1);
            PG8_WAIT_L(8); PG8_BAR; PG8_WAIT_L(0); PG8_MMA(0, 0, At, B0); PG8_BAR; PG8_SCHED;
            PG8_LDB(B1, 0, 1); PG8_STAGE(PG8_SB(0, 0), b2, voffB);
            PG8_BAR; PG8_WAIT_L(0); PG8_MMA(0, 1, At, B1); PG8_BAR;
            PG8_LDA(At, 0, 1); PG8_STAGE(PG8_SA(0, 0), a2, vs0);
            PG8_BAR; PG8_WAIT_L(0); PG8_MMA(1, 0, At, B0); PG8_BAR; PG8_SCHED;
            PG8_STAGE(PG8_SB(0, 1), b2 + hstep, voffB);
            PG8_WAIT_V(6); PG8_BAR; PG8_MMA(1, 1, At, B1); PG8_BAR;
            PG8_LDB(B0, 1, 0); PG8_SCHED; PG8_LDA(At, 1, 0); PG8_STAGE(PG8_SA(0, 1), a2, vs1);
            PG8_WAIT_L(8); PG8_BAR; PG8_WAIT_L(0); PG8_MMA(0, 0, At, B0); PG8_BAR; PG8_SCHED;
            PG8_LDB(B1, 1, 1); PG8_STAGE(PG8_SB(1, 0), b3, voffB);
            PG8_BAR; PG8_WAIT_L(0); PG8_MMA(0, 1, At, B1); PG8_BAR;
            PG8_LDA(At, 1, 1); PG8_STAGE(PG8_SA(1, 0), a3, vs0);
            PG8_BAR; PG8_WAIT_L(0); PG8_MMA(1, 0, At, B0); PG8_BAR; PG8_SCHED;
            PG8_STAGE(PG8_SB(1, 1), b3 + hstep, voffB);
            PG8_WAIT_V(6); PG8_BAR; PG8_MMA(1, 1, At, B1); PG8_BAR;
            }
        }
        if constexpr (ALIGN_EPI) { if (wr == 0) PG8_BAR; }
        if constexpr (!Epi::AFTER_DRAIN) { if constexpr (Epi::CHAIN) E.chain(acc, cur, wr, wc, fr, fq); else E(acc, cur, wr, wc, fr, fq); S.done(cur); }
        if (!has_next) break;
        if (!(Epi::CHAIN && nxt.e != 0)) {
#pragma unroll
        for (int a = 0; a < 2; ++a)
#pragma unroll
            for (int b = 0; b < 2; ++b)
#pragma unroll
                for (int m = 0; m < 4; ++m)
#pragma unroll
                    for (int n = 0; n < 2; ++n) acc[a][b][m][n] = (f32x4){0.f, 0.f, 0.f, 0.f};
        }
        cur = nxt; cA = nA; cB = nB; ++ui;
        if constexpr (GATHER) { _Pragma("unroll") for (int i = 0; i < 2; ++i) { vc0[i] = vn0[i]; vc1[i] = vn1[i]; } }
        if constexpr (ALIGN_EPI) { if (wr == 1) PG8_BAR; }
    }
    PG8_WAIT_V(0);
    if constexpr (!ALIGN_EPI) { if (wr == 0) PG8_BAR; }
    PG8_BAR;
    if constexpr (Epi::AFTER_DRAIN) { E.fused(acc, cur, wr, wc, fr, fq, lds, wid, lane); S.done(cur); }
#undef PG8_GROWS
#undef PG8_SA
#undef PG8_SB
#undef PG8_STAGE
#undef PG8_LDA
#undef PG8_LDB
#undef PG8_MMA
#undef PG8_WAIT_V
#undef PG8_WAIT_L
#undef PG8_BAR
#undef PG8_SCHED
}
}


namespace att {
typedef unsigned short bf16_t;
typedef short bf16x8 __attribute__((ext_vector_type(8)));
typedef short s16x4 __attribute__((ext_vector_type(4)));
typedef float f32x16 __attribute__((ext_vector_type(16)));
typedef unsigned u32x4 __attribute__((ext_vector_type(4)));
#define ALAS __attribute__((address_space(3)))
typedef ALAS unsigned char* ALAS_PTR;
#define ASBAR() __builtin_amdgcn_sched_barrier(0)
constexpr int QBLK = 32, KVBLK = 64;
constexpr float THR2 = 11.0f;
constexpr float LOG2E = 1.4426950408889634f, INV2PI = 0.15915494309189535f, LOG2_THETA = 13.287712379549449f;
constexpr int OFF_V = 0, VBUF = 8192, OFF_K = 16384, KBUF_MAX = 13312, OFF_WS = OFF_K + 2 * KBUF_MAX  , OFF_BIAS = OFF_WS + 2048  , ATT_LDS = OFF_BIAS + 2048;
__device__ __forceinline__ int crow(int r, int hi) { return (r & 3) + 8 * (r >> 2) + 4 * hi; }
__device__ __forceinline__ unsigned cvtpk(float lo, float hi) { unsigned r; asm volatile("v_cvt_pk_bf16_f32 %0, %1, %2" : "=v"(r) : "v"(lo), "v"(hi)); return r; }
__device__ __forceinline__ float bf2f(short s) { return __uint_as_float(((unsigned)(unsigned short)s) << 16); }
__device__ __forceinline__ short f2bf_s(float f) { return (short)(cvtpk(f, 0.f) & 0xffffu); }

struct UnitP {
    const bf16_t* Q; int ldq;
    const bf16_t* K0; int ldk0;
    const bf16_t* K1; int ldk1;
    const bf16_t* V; int ldv;
    bf16_t* O; int ldo;
    int nt;
    int grow0;
    const float* gain;
    int kr0;
    float cref;
};

typedef short v4i16_t __attribute__((ext_vector_type(4)));
__device__ __forceinline__ s16x4 vtr(const ALAS unsigned char* p) { return __builtin_bit_cast(s16x4, __builtin_amdgcn_ds_read_tr16_b64_v4i16((ALAS v4i16_t*)p)); }
__device__ __forceinline__ void pv_all(f32x16& o0, f32x16& o1, f32x16& lacc, const ALAS unsigned char* vp, bf16x8 pa0, bf16x8 pa1, bf16x8 pa2, bf16x8 pa3) {
    const bf16x8 ones = {(short)0x3F80, (short)0x3F80, (short)0x3F80, (short)0x3F80, (short)0x3F80, (short)0x3F80, (short)0x3F80, (short)0x3F80};
#define ATT_PK(L, H) (bf16x8){L[0], L[1], L[2], L[3], H[0], H[1], H[2], H[3]}
#define ATT_STEP(KS, PA) { const s16x4 l0 = vtr(vp + (KS) * 1024), h0 = vtr(vp + (KS) * 1024 + 512), l1 = vtr(vp + 4096 + (KS) * 1024), h1 = vtr(vp + 4096 + (KS) * 1024 + 512); \
        o0 = __builtin_amdgcn_mfma_f32_32x32x16_bf16(PA, ATT_PK(l0, h0), o0, 0, 0, 0); o1 = __builtin_amdgcn_mfma_f32_32x32x16_bf16(PA, ATT_PK(l1, h1), o1, 0, 0, 0); \
        lacc = __builtin_amdgcn_mfma_f32_32x32x16_bf16(PA, ones, lacc, 0, 0, 0); }
    ATT_STEP(0, pa0) ATT_STEP(1, pa1) ATT_STEP(2, pa2) ATT_STEP(3, pa3)
#undef ATT_STEP
#undef ATT_PK
}
template <int DQK> __device__ __forceinline__ void qkt(f32x16& p0, f32x16& p1, const ALAS unsigned char* Ks, const bf16x8* qr, const f32x16& cinit, int r32, int hi) {
    constexpr int KST = DQK * 2 + 16;
#pragma unroll
    for (int d0 = 0; d0 < DQK / 16; ++d0) { const int cb = (2 * d0 + hi) * 16;
        const bf16x8 b0 = *(const ALAS bf16x8*)(Ks + r32 * KST + cb);
        const bf16x8 b1 = *(const ALAS bf16x8*)(Ks + (32 + r32) * KST + cb);
        if (d0 == 0) { p0 = __builtin_amdgcn_mfma_f32_32x32x16_bf16(b0, qr[0], cinit, 0, 0, 0); p1 = __builtin_amdgcn_mfma_f32_32x32x16_bf16(b1, qr[0], cinit, 0, 0, 0); }
        else { p0 = __builtin_amdgcn_mfma_f32_32x32x16_bf16(b0, qr[d0], p0, 0, 0, 0); p1 = __builtin_amdgcn_mfma_f32_32x32x16_bf16(b1, qr[d0], p1, 0, 0, 0); } }
}
__device__ __forceinline__ void na_mask(f32x16& p0, f32x16& p1, const ALAS float* btab, int kr, int rq, int qc_in, int hi_in) {
    int qc = qc_in, hi = hi_in; asm volatile("" : "+v"(qc), "+v"(hi));
    int r0 = rq - 4; r0 = r0 < 0 ? 0 : (r0 > 120 ? 120 : r0);
    const bool rowok = (kr >= r0) && (kr < r0 + 8);
    int c0 = qc - 8; c0 = c0 < 0 ? 0 : (c0 > 48 ? 48 : c0);
    int dr = kr - rq + 7; dr = dr < 0 ? 0 : (dr > 14 ? 14 : dr);
    const ALAS float* brow = btab + dr * 31;
#pragma unroll
    for (int r = 0; r < 16; ++r) {
        const int ka = crow(r, hi), kb = 32 + ka;
        int ia = ka - qc + 15; ia = ia < 0 ? 0 : (ia > 30 ? 30 : ia);
        int ib = kb - qc + 15; ib = ib < 0 ? 0 : (ib > 30 ? 30 : ib);
        const bool oka = rowok && (ka >= c0) && (ka < c0 + 16), okb = rowok && (kb >= c0) && (kb < c0 + 16);
        p0[r] = oka ? p0[r] + brow[ia] : -1e30f;
        p1[r] = okb ? p1[r] + brow[ib] : -1e30f;
    }
}
__device__ __forceinline__ void lazySM(f32x16& p0, f32x16& p1, float& m_reg, bool& moved, float& alpha) {
    float pmax = p0[0];
#pragma unroll
    for (int r = 1; r < 16; ++r) pmax = fmaxf(pmax, p0[r]);
#pragma unroll
    for (int r = 0; r < 16; ++r) pmax = fmaxf(pmax, p1[r]);
    { auto rr = __builtin_amdgcn_permlane32_swap(__float_as_uint(pmax), __float_as_uint(pmax), false, false);
      pmax = fmaxf(__uint_as_float(rr[0]), __uint_as_float(rr[1])); }
    if (__builtin_expect(__all(pmax <= THR2), 1)) { alpha = 1.f; }
    else { const float dl = fmaxf(pmax, 0.f); m_reg += dl; alpha = __builtin_amdgcn_exp2f(-dl);
#pragma unroll
        for (int r = 0; r < 16; ++r) { p0[r] -= dl; p1[r] -= dl; }
        moved = true; }
#pragma unroll
    for (int r = 0; r < 16; ++r) p0[r] = __builtin_amdgcn_exp2f(p0[r]);
}
__device__ __forceinline__ void fixedSM(f32x16& p0) {
#pragma unroll
    for (int r = 0; r < 16; ++r) p0[r] = __builtin_amdgcn_exp2f(p0[r]);
}
__device__ __forceinline__ void finishSM(f32x16& p0, f32x16& p1, bf16x8& pa0, bf16x8& pa1, bf16x8& pa2, bf16x8& pa3) {
#pragma unroll
    for (int r = 0; r < 16; ++r) p1[r] = __builtin_amdgcn_exp2f(p1[r]);
    u32x4 w;
    w = (u32x4){cvtpk(p0[0], p0[1]), cvtpk(p0[2], p0[3]), cvtpk(p0[4], p0[5]), cvtpk(p0[6], p0[7])}; pa0 = __builtin_bit_cast(bf16x8, w);
    w = (u32x4){cvtpk(p0[8], p0[9]), cvtpk(p0[10], p0[11]), cvtpk(p0[12], p0[13]), cvtpk(p0[14], p0[15])}; pa1 = __builtin_bit_cast(bf16x8, w);
    w = (u32x4){cvtpk(p1[0], p1[1]), cvtpk(p1[2], p1[3]), cvtpk(p1[4], p1[5]), cvtpk(p1[6], p1[7])}; pa2 = __builtin_bit_cast(bf16x8, w);
    w = (u32x4){cvtpk(p1[8], p1[9]), cvtpk(p1[10], p1[11]), cvtpk(p1[12], p1[13]), cvtpk(p1[14], p1[15])}; pa3 = __builtin_bit_cast(bf16x8, w);
}
struct NoSide { static constexpr bool PLAIN = true; template <int P> __device__ __forceinline__ void step() {} };
template <int DQK, int MODE, class SIDE = NoSide>
__device__ __forceinline__ void attn_unit(const UnitP& u, ALAS unsigned char* lds, const int tid, SIDE& side) {
    constexpr int ND = DQK / 16, KST = DQK * 2 + 16, KBUF = 64 * KST;
    static_assert(KBUF <= KBUF_MAX, "K buffer");
    const int wid = __builtin_amdgcn_readfirstlane(tid >> 6), lane = tid & 63, r32 = lane & 31, hi = lane >> 5;
    ALAS unsigned char* V_lds = lds + OFF_V; ALAS unsigned char* K_lds = lds + OFF_K;
    ALAS float* ws = (ALAS float*)(lds + OFF_WS) + wid * 64; ALAS float* al_l = ws + 32;
    const ALAS float* btab = (const ALAS float*)(lds + OFF_BIAS);
    float m_reg = 0.f; f32x16 o[2], lacc; o[0] = f32x16{}; o[1] = f32x16{}; lacc = f32x16{}; bf16x8 qr[ND];
    bool moved = false;
    const int grow = u.grow0 + (wid >> 1), gcol = (wid & 1) * 32 + r32;
    {
        const bf16_t* Qw = u.Q + (size_t)(wid * QBLK + r32) * u.ldq + hi * 8;
#pragma unroll
        for (int d0 = 0; d0 < ND; ++d0) qr[d0] = *(const bf16x8*)(Qw + d0 * 16);
        if constexpr (MODE == 0 || MODE == 3) {
            float x[4][8]; float ssq = 0.f;
#pragma unroll
            for (int d0 = 0; d0 < 4; ++d0)
#pragma unroll
                for (int j = 0; j < 8; ++j) { x[d0][j] = bf2f(qr[d0][j]); ssq += x[d0][j] * x[d0][j]; }
            { auto rr_ = __builtin_amdgcn_permlane32_swap(__float_as_uint(ssq), __float_as_uint(ssq), false, false); ssq = __uint_as_float(rr_[0]) + __uint_as_float(rr_[1]); }
            const float rstd = 1.0f / sqrtf(ssq * (1.0f / 64.0f) + 1e-6f);
#pragma unroll
            for (int d0 = 0; d0 < 4; ++d0)
#pragma unroll
                for (int j = 0; j < 8; ++j) x[d0][j] = x[d0][j] * rstd * u.gain[16 * d0 + 8 * hi + j];
#pragma unroll
            for (int d0 = 0; d0 < 2; ++d0)
#pragma unroll
                for (int j = 0; j < 8; ++j) { const float inv = exp2f(-(float)(8 * hi + j) * (LOG2_THETA / 16.0f));
                    const float ang = (float)(d0 == 0 ? grow : gcol) * inv * INV2PI; const float c = __builtin_amdgcn_cosf(ang), s = __builtin_amdgcn_sinf(ang);
                    const float y1 = x[d0][j], y2 = x[d0 + 2][j]; x[d0][j] = y1 * c - y2 * s; x[d0 + 2][j] = y1 * s + y2 * c; }
            constexpr float C2 = 0.125f * LOG2E;
#pragma unroll
            for (int d0 = 0; d0 < 4; ++d0) { u32x4 w = {cvtpk(x[d0][0] * C2, x[d0][1] * C2), cvtpk(x[d0][2] * C2, x[d0][3] * C2), cvtpk(x[d0][4] * C2, x[d0][5] * C2), cvtpk(x[d0][6] * C2, x[d0][7] * C2)};
                qr[d0] = __builtin_bit_cast(bf16x8, w); }
        }
        if constexpr (MODE == 1) {
            float y1[8], y2[8];
#pragma unroll
            for (int j = 0; j < 8; ++j) { const float inv = exp2f(-(float)j * (LOG2_THETA / 8.0f));
                const float ang = (float)(hi == 0 ? grow : gcol) * inv * INV2PI; const float c = __builtin_amdgcn_cosf(ang), s = __builtin_amdgcn_sinf(ang);
                const float a = bf2f(qr[4][j]), b = bf2f(qr[5][j]); y1[j] = a * c - b * s; y2[j] = a * s + b * c; }
            u32x4 w = {cvtpk(y1[0], y1[1]), cvtpk(y1[2], y1[3]), cvtpk(y1[4], y1[5]), cvtpk(y1[6], y1[7])}; qr[4] = __builtin_bit_cast(bf16x8, w);
            w = (u32x4){cvtpk(y2[0], y2[1]), cvtpk(y2[2], y2[3]), cvtpk(y2[4], y2[5]), cvtpk(y2[6], y2[7])}; qr[5] = __builtin_bit_cast(bf16x8, w);
        }
    }
    const int sk = tid >> 3, sc = tid & 7;
    const bf16_t* vsrc = u.V + (size_t)sk * u.ldv + sc * 8; const bf16_t* ksrc = u.K0 + (size_t)sk * u.ldk0 + sc * 8;
    const int vst = (sc >> 2) * 4096 + sk * 64 + (sc & 3) * 16, kst = sk * KST + sc * 16;
    const int sk2 = (tid & 255) >> 2, sc2 = tid & 3;
    const bf16_t* k2src = (DQK == 96) ? u.K1 + (size_t)sk2 * u.ldk1 + sc2 * 8 : nullptr;
    const int k2st = sk2 * KST + (8 + sc2) * 16;
    const ALAS unsigned char* vb0 = V_lds + ((lane >> 4) & 1) * 32 + (lane & 3) * 8 + (4 * hi + ((lane & 15) >> 2)) * 64;
    struct { bf16x8 v, k, k2; } sr_[2];
#define ATT_SLOAD(i, k0) do { sr_[i].v = *(const bf16x8*)(vsrc + (size_t)(k0) * u.ldv); sr_[i].k = *(const bf16x8*)(ksrc + (size_t)(k0) * u.ldk0); \
        if constexpr (DQK == 96) sr_[i].k2 = *(const bf16x8*)(k2src + (size_t)(k0) * u.ldk1); } while (0)
#define ATT_SWRITE(b, i) do { *(ALAS bf16x8*)(V_lds + (b) * VBUF + vst) = sr_[i].v; *(ALAS bf16x8*)(K_lds + (b) * KBUF + kst) = sr_[i].k; \
        if constexpr (DQK == 96) *(ALAS bf16x8*)(K_lds + (b) * KBUF + k2st) = sr_[i].k2; } while (0)
#define ATT_SWAIT() do { if constexpr (SIDE::PLAIN) { if constexpr (DQK == 96) asm volatile("s_waitcnt vmcnt(3)" ::: "memory"); else asm volatile("s_waitcnt vmcnt(2)" ::: "memory"); } } while (0)
#define ATT_RESC(a) do { if constexpr (MODE != 0) { if (__any((a) < 1.f)) { if (hi == 0) al_l[r32] = (a); asm volatile("s_waitcnt lgkmcnt(0)" ::: "memory"); \
        _Pragma("unroll") for (int r = 0; r < 16; ++r) { const float f_ = al_l[crow(r, hi)]; o[0][r] *= f_; o[1][r] *= f_; lacc[r] *= f_; } } } } while (0)
#define ATT_SM(P0, P1, AL) do { if constexpr (MODE == 0) { fixedSM(P0); AL = 1.f; } else lazySM(P0, P1, m_reg, moved, AL); } while (0)
#define ATT_QKT(P0, P1, KS) do { if (MODE != 0 && moved) { f32x16 ng_; _Pragma("unroll") for (int r_ = 0; r_ < 16; ++r_) ng_[r_] = -m_reg; qkt<DQK>(P0, P1, KS, qr, ng_, r32, hi); } \
        else { const f32x16 z_ = f32x16{}; qkt<DQK>(P0, P1, KS, qr, z_, r32, hi); } } while (0)
#define ATT_PV(VB) pv_all(o[0], o[1], lacc, (VB), pa0, pa1, pa2, pa3)
#define ATT_MASK(P0, P1, j) do { if constexpr (MODE == 2) na_mask(P0, P1, btab, u.kr0 + (j), grow, gcol, hi); } while (0)
    f32x16 pA0, pA1, pB0, pB1; float alA, alB; bf16x8 pa0, pa1, pa2, pa3; const int NT = u.nt;
    constexpr int SE = 0, SO = 1;
    ATT_SLOAD(SE, 0); asm volatile("s_waitcnt vmcnt(0)" ::: "memory"); ATT_SWRITE(0, SE); __syncthreads();
    ATT_QKT(pA0, pA1, K_lds); ATT_MASK(pA0, pA1, 0); ATT_SM(pA0, pA1, alA);
    ATT_SLOAD(SO, KVBLK); if (2 < NT) ATT_SLOAD(SE, 2 * KVBLK);
    ATT_SWAIT(); ATT_SWRITE(1, SO); __syncthreads();
    for (int j = 1; j + 1 < NT; j += 2) {
        if constexpr (!SIDE::PLAIN) { if ((j & 7) == 1) side.template step<0>(); }
        ASBAR(); ATT_QKT(pB0, pB1, K_lds + KBUF); ATT_MASK(pB0, pB1, j);
        finishSM(pA0, pA1, pa0, pa1, pa2, pa3); ASBAR();
        ATT_SLOAD(SO, (j + 2) * KVBLK); ASBAR();
        ATT_PV(vb0); ATT_SM(pB0, pB1, alB);
        __syncthreads(); ATT_SWAIT(); ATT_SWRITE(0, SE);
        ATT_RESC(alB); __syncthreads();
        if constexpr (!SIDE::PLAIN) { if ((j & 7) == 5) side.template step<1>(); }
        ASBAR(); ATT_QKT(pA0, pA1, K_lds); ATT_MASK(pA0, pA1, j + 1);
        finishSM(pB0, pB1, pa0, pa1, pa2, pa3); ASBAR();
        if (j + 3 < NT) ATT_SLOAD(SE, (j + 3) * KVBLK); ASBAR();
        ATT_PV(vb0 + VBUF); ATT_SM(pA0, pA1, alA);
        __syncthreads(); ATT_SWAIT(); ATT_SWRITE(1, SO);
        ATT_RESC(alA); __syncthreads();
    }
    ASBAR(); ATT_QKT(pB0, pB1, K_lds + KBUF); ATT_MASK(pB0, pB1, NT - 1);
    finishSM(pA0, pA1, pa0, pa1, pa2, pa3); ASBAR();
    ATT_PV(vb0); ATT_SM(pB0, pB1, alB);
    __syncthreads(); ATT_RESC(alB);
    finishSM(pB0, pB1, pa0, pa1, pa2, pa3); ASBAR();
    ATT_PV(vb0 + VBUF);
    bf16_t* Ow = u.O + (size_t)(wid * QBLK) * u.ldo;
#pragma unroll
    for (int r = 0; r < 16; ++r) { const int orow = crow(r, hi); const float rl = __builtin_amdgcn_rcpf(lacc[r]);
#pragma unroll
        for (int d0 = 0; d0 < 2; ++d0) Ow[(size_t)orow * u.ldo + d0 * 32 + r32] = (bf16_t)f2bf_s(o[d0][r] * rl); }
    __syncthreads();
#undef ATT_SLOAD
#undef ATT_SWRITE
#undef ATT_SWAIT
#undef ATT_RESC
#undef ATT_SM
#undef ATT_QKT
#undef ATT_PV
#undef ATT_MASK
}
}


constexpr int NWAVES = 8;
#ifndef MK_DEBUG
#define MK_DEBUG 0
#endif
#ifndef MK_DBG_IGNORE
#define MK_DBG_IGNORE 0
#endif
#ifndef MK_ONE_LAUNCH
#define MK_ONE_LAUNCH 0
#endif
#ifndef REP_P
#define REP_P 1
#endif
#ifndef REP_A
#define REP_A 1
#endif
#ifndef REP_B
#define REP_B 1
#endif
#ifndef REP_C
#define REP_C 1
#endif
#ifndef REP_DG
#define REP_DG 1
#endif
#ifndef REP_DM
#define REP_DM 1
#endif
#ifndef REP_DN
#define REP_DN 1
#endif
#ifndef REP_E
#define REP_E 1
#endif
#ifndef REP_F
#define REP_F 1
#endif
#ifndef REP_H
#define REP_H 1
#endif
#ifndef REP_I
#define REP_I 1
#endif
#ifndef REP_J
#define REP_J 1
#endif
#ifndef REP_K
#define REP_K 1
#endif
constexpr int NB = 4, SEQ = 8192, T = NB * SEQ, D = 1024, DEPTH = 2, GW = 64;
constexpr int DIN = 5536, DINP = 5632;
constexpr int H_NAQ = 0, H_NAK = 384, H_NAV = 768, H_GQ = 1152, H_GK = 1536, H_GV = 1664, H_CQ = 1792, H_CKV = 2176, H_KR = 2432, H_GATE = 2464;
constexpr int NE = 32, TOPK = 4, FF = 1024, TK = T * TOPK;
constexpr int PSLOTS = TK + NE * 256;
constexpr int MAXTILES = PSLOTS / 256;
constexpr int LCAP = T;
constexpr float LN_EPS = 1e-5f, RMS_EPS = 1e-6f, DN_ALPHA = 1.4142135623730951f;
constexpr float LOG2E_F = 1.4426950408889634f;
constexpr int PPL = 10, NPH = 1 + DEPTH * PPL;

constexpr size_t MiB = 1u << 20;
constexpr size_t WS_CTL = 0, CTL_ZERO_BYTES = 1 * MiB;
constexpr size_t WB_IN = 0, WB_UQ = WB_IN + (size_t)DINP * 1024 * 2, WB_UKV = WB_UQ + (size_t)512 * 384 * 2, WB_BA = WB_UKV + (size_t)512 * 256 * 2,
                 WB_BB = WB_BA + (size_t)1024 * 384 * 2, WB_BC = WB_BB + (size_t)1024 * 384 * 2, WB_OUT = WB_BC + (size_t)1024 * 384 * 2,
                 WB_GU = WB_OUT + (size_t)1024 * 1024 * 2, WB_DN = WB_GU + (size_t)NE * 2048 * 1024 * 2, WB_LAYER = WB_DN + (size_t)NE * 1024 * 1024 * 2;
static_assert(WB_LAYER % 256 == 0, "weight block alignment");
constexpr size_t WS_W = 2 * MiB;
constexpr size_t WS_H = WS_W + 2 * WB_LAYER;
constexpr size_t SZ_H = (size_t)T * DINP * 2;
constexpr size_t WS_A2 = WS_H + SZ_H;
constexpr size_t A2_MIX = 0, A2_MIXED = A2_MIX + (size_t)T * 1024 * 4, A2_YA = A2_MIXED + (size_t)T * 1024 * 2, A2_YB = A2_YA + (size_t)T * 384 * 2,
                 A2_YC = A2_YB + (size_t)T * 384 * 2, A2_QC = A2_YC + (size_t)T * 384 * 2, A2_KVC = A2_QC + (size_t)T * 384 * 2, A2_KB = A2_KVC + (size_t)T * 512 * 2,
                 A2_CQN = A2_KB + (size_t)T * 128 * 2, A2_CKVN = A2_CQN + (size_t)T * 384 * 2, A2_KR = A2_CKVN + (size_t)T * 256 * 2, SZ_A2 = A2_KR + (size_t)T * 32 * 2;
static_assert(SZ_A2 >= (size_t)PSLOTS * 1024 * 2 && SZ_H >= (size_t)PSLOTS * 1024 * 2, "overlays fit");
constexpr size_t WS_X2 = WS_A2 + SZ_A2;
constexpr size_t WS_XB = WS_X2 + (size_t)T * D * 4;
constexpr size_t WS_X1 = WS_XB + (size_t)T * D * 2;
constexpr size_t WS_X1B = WS_X1 + (size_t)T * D * 4;
constexpr size_t WS_LT = WS_X1B + (size_t)T * D * 2;
constexpr size_t WS_LG = WS_LT + (size_t)NE * LCAP * 4;
constexpr size_t WS_TE = WS_LG + (size_t)NE * LCAP * 4;
constexpr size_t WS_TR = WS_TE + (size_t)T * 4 * 4;
constexpr size_t WS_SG = WS_TR + (size_t)T * 4 * 4;
constexpr size_t WS_END = WS_SG + (size_t)PSLOTS * 4;
constexpr int CW_BAR = 4096;
constexpr int CW_CNT = 16384;

constexpr int RING_BYTES = 131072, LDSCTL_OFF = 139264, MISC_OFF = LDSCTL_OFF + 64;
constexpr int TBL_OFF = LDSCTL_OFF + 256;
constexpr int TBL_START = TBL_OFF, TBL_TILEE = TBL_OFF + 512, TBL_RS = TBL_TILEE + 2304;
constexpr int LDS_BYTES = 155648;
static_assert(TBL_RS + 512 * 12 + 256 <= LDS_BYTES, "LDS map");

#define GAS __attribute__((address_space(1)))
#define LAS __attribute__((address_space(3)))
typedef unsigned short bf16;
typedef unsigned v4u __attribute__((ext_vector_type(4)));
typedef float f32x4 __attribute__((ext_vector_type(4)));
typedef GAS unsigned gu32;
#define RLX_AGENT __ATOMIC_RELAXED, __HIP_MEMORY_SCOPE_AGENT
#define LDS_WAIT() asm volatile("s_waitcnt lgkmcnt(0)" ::: "memory")
#define VM_WAIT() asm volatile("s_waitcnt vmcnt(0)" ::: "memory")
__device__ __forceinline__ unsigned f2bf(float f) { unsigned u = __builtin_bit_cast(unsigned, f); return (u + 0x7fffu + ((u >> 16) & 1u)) >> 16; }
__device__ __forceinline__ unsigned pk2(float lo, float hi) { unsigned r; asm("v_cvt_pk_bf16_f32 %0, %1, %2" : "=v"(r) : "v"(lo), "v"(hi)); return r; }
__device__ __forceinline__ float bflo(unsigned w) { return __uint_as_float(w << 16); }
__device__ __forceinline__ float bfhi(unsigned w) { return __uint_as_float(w & 0xffff0000u); }

template <int O> __device__ __forceinline__ float shx(float v, int lane) { return __int_as_float(__builtin_amdgcn_ds_bpermute((lane ^ O) << 2, __float_as_int(v))); }
template <int O> __device__ __forceinline__ int shxi(int v, int lane) { return __builtin_amdgcn_ds_bpermute((lane ^ O) << 2, v); }

#define XB_TMO      128
#define XB_XCNT(j)  (256  + 64 * (j))
#define XB_XSUB(j)  (1280 + 64 * (j))
#define XB_XGEN(j)  (2304 + 64 * (j))
#define XB_TOP      3328
#define XB_TOPGEN   3392
#define XCD_BAR_WORDS 3456
#define XB_SPIN_CAP (1u << 18)

__device__ __forceinline__ unsigned xb_ld(unsigned* p)              { return __hip_atomic_load(p, __ATOMIC_RELAXED, __HIP_MEMORY_SCOPE_AGENT); }
__device__ __forceinline__ unsigned xb_add(unsigned* p, unsigned v) { return __hip_atomic_fetch_add(p, v, __ATOMIC_RELAXED, __HIP_MEMORY_SCOPE_AGENT); }
__device__ __forceinline__ unsigned xb_xcc_id() { return (unsigned)__builtin_amdgcn_s_getreg((3 << 11) | 20) & 0xFu; }
#define XB_SPIN(cond, bar) do { unsigned _sp = 0; while (cond) { __builtin_amdgcn_s_sleep(1); \
    if ((++_sp & 255u) == 0u) { if (xb_ld(&(bar)[XB_TMO])) break; if (_sp > XB_SPIN_CAP) { atomicAdd(&(bar)[XB_TMO], 1u); break; } } } } while (0)

struct XcdBarrier {
    unsigned* bar; unsigned x;
    volatile LAS unsigned* st;
};

__device__ __forceinline__ XcdBarrier xcd_barrier_post(unsigned* bar, volatile LAS unsigned* st) {
    XcdBarrier b; b.bar = bar; b.x = xb_xcc_id(); b.st = st;
    if (threadIdx.x == 0) (void)xb_add(&bar[XB_XCNT(b.x)], 1u);
    return b;
}
__device__ __forceinline__ void xcd_barrier_complete(unsigned* bar, unsigned x, unsigned& nloc, unsigned& nx) {
    const unsigned G = gridDim.x * gridDim.y * gridDim.z;
    unsigned sum, cnt, mine, sp = 0u;
    for (;;) {
        sum = 0u; cnt = 0u; mine = 0u;
#pragma unroll
        for (unsigned j = 0; j < 16; ++j) { const unsigned c = xb_ld(&bar[XB_XCNT(j)]); sum += c; cnt += (c > 0u) ? 1u : 0u; mine = (j == x) ? c : mine; }
        if (sum == G) break;
        __builtin_amdgcn_s_sleep(1);
        if ((++sp & 255u) == 0u) { if (xb_ld(&bar[XB_TMO])) break; if (sp > XB_SPIN_CAP) { atomicAdd(&bar[XB_TMO], 1u); break; } }
    }
    nloc = mine > 0u ? mine : 1u; nx = cnt > 0u ? cnt : 1u;
}

__device__ __forceinline__ void xcd_barrier(const XcdBarrier& b) {
    asm volatile("s_waitcnt vmcnt(0)" ::: "memory");
    __syncthreads();
    if (threadIdx.x == 0) {
        unsigned* bar = b.bar;
        __builtin_amdgcn_s_waitcnt(0);
        unsigned nloc = b.st[0], nx = b.st[1];
        if (nloc == 0u) { xcd_barrier_complete(bar, b.x, nloc, nx); b.st[0] = nloc; b.st[1] = nx; }
        const unsigned old = xb_add(&bar[XB_XSUB(b.x)], 1u);
        const unsigned gen = old / nloc;
        if (old + 1u == (gen + 1u) * nloc) {
            __builtin_amdgcn_fence(__ATOMIC_RELEASE, "agent");
            asm volatile("s_waitcnt vmcnt(0)" ::: "memory");
            const unsigned og = xb_add(&bar[XB_TOP], 1u);
            const unsigned tg = og / nx;
            if (og + 1u == (tg + 1u) * nx) xb_add(&bar[XB_TOPGEN], 1u);
            else XB_SPIN(xb_ld(&bar[XB_TOPGEN]) == tg, bar);
            __builtin_amdgcn_fence(__ATOMIC_ACQUIRE, "agent");
            xb_add(&bar[XB_XGEN(b.x)], 1u);
            asm volatile("s_waitcnt vmcnt(0)" ::: "memory");
        } else {
            XB_SPIN(xb_ld(&bar[XB_XGEN(b.x)]) == gen, bar);
            __builtin_amdgcn_fence(__ATOMIC_ACQUIRE, "agent");
            asm volatile("s_waitcnt vmcnt(0)" ::: "memory");
        }
    }
    __syncthreads();
}


struct Frame {
    LAS unsigned char* lds;
    gu32* ctl;
    int tid, lane, wave;
    int vcu, G, bx;
    unsigned char* ws;
    float* out;
};
__device__ __forceinline__ const float* in_ptr(int i) {
    const void* base = (const void*)__builtin_amdgcn_kernarg_segment_ptr(); const GAS float* p;
    asm volatile("s_load_dwordx2 %0, %1, %2\n\ts_waitcnt lgkmcnt(0)" : "=s"(p) : "s"(base), "i"(i * 8) : "memory"); return (const float*)p;
}
#define INP(i) in_ptr(i)
template <int SITE> __device__ __forceinline__ Frame mkframe(LAS unsigned char* lds_in, unsigned char* ws_in, float* out_in, int wave_id, int bx0, int G0) {
    Frame F; int lane_;
    asm volatile("v_mbcnt_lo_u32_b32 %0, -1, 0\n\tv_mbcnt_hi_u32_b32 %0, -1, %0 ; site %1" : "=v"(lane_) : "n"(SITE));
    int bx = bx0, G = G0, wv = wave_id; asm volatile("; site %3" : "+s"(bx), "+s"(G), "+s"(wv) : "n"(SITE));
    GAS unsigned char* wsg = (GAS unsigned char*)ws_in; asm volatile("; site %1" : "+s"(wsg) : "n"(SITE)); unsigned char* ws = (unsigned char*)wsg;
    LAS unsigned char* l3 = lds_in; asm volatile("; site %1" : "+s"(l3) : "n"(SITE));
    const int tid = wv * 64 + lane_;
    F.lds = l3; F.tid = tid; F.lane = lane_; F.wave = wv;
    F.G = G; F.bx = bx; F.vcu = (G % 8 == 0) ? (bx % 8) * (G / 8) + bx / 8 : bx;
    F.ws = ws; F.ctl = (gu32*)(wsg + WS_CTL); F.out = out_in; return F;
}
__device__ __forceinline__ float wave_sum(float v, int lane) {
    v += shx<1>(v, lane); v += shx<2>(v, lane); v += shx<4>(v, lane); v += shx<8>(v, lane); v += shx<16>(v, lane); v += shx<32>(v, lane);
    return v;
}
__device__ __forceinline__ void tr_item(const float* W, int ldw, int Kd, int k0, int src_n0, bf16* WT, int dst_n0, float scale, LAS float* scr, int lane) {
    float v[32];
#pragma unroll
    for (int i = 0; i < 32; ++i) v[i] = W[(size_t)(k0 + 2 * i + (lane >> 5)) * ldw + src_n0 + (lane & 31)];
#pragma unroll
    for (int i = 0; i < 32; ++i) scr[(2 * i + (lane >> 5)) * 33 + (lane & 31)] = v[i];
    LDS_WAIT(); asm volatile("" ::: "memory");
    const int c = lane & 7;
#pragma unroll
    for (int j = 0; j < 4; ++j) { const int n = (lane >> 3) + 8 * j; const LAS float* s = scr + (8 * c) * 33 + n;
        v4u o; o.x = pk2(s[0 * 33] * scale, s[1 * 33] * scale); o.y = pk2(s[2 * 33] * scale, s[3 * 33] * scale); o.z = pk2(s[4 * 33] * scale, s[5 * 33] * scale); o.w = pk2(s[6 * 33] * scale, s[7 * 33] * scale);
        *(GAS v4u*)(WT + (size_t)(dst_n0 + n) * Kd + k0 + 8 * c) = o; }
    LDS_WAIT(); asm volatile("" ::: "memory");
}
template <int KIND> __device__ __forceinline__ void conv_matrix(Frame& F, const float* W, int K, int N, bf16* WT, float s, int gw, int NGW, LAS float* scr, int Kd = 0) {
    if (Kd == 0) Kd = K;
    const int nnb = N / 32, nkb = K / 64, nit = nnb * nkb;
    for (int it = gw; it < nit; it += NGW) {
        const int kb = it / nnb, nb = it % nnb; const int dst_n0 = 32 * nb; int src_n0 = dst_n0; float sc = s;
        if (KIND == 1) sc = (dst_n0 < 384) ? s : 1.0f;
        if (KIND == 2) { const int p = dst_n0 >> 8, j = dst_n0 & 255; src_n0 = (j < 128) ? (128 * p + j) : (1024 + 128 * p + (j - 128)); }
        tr_item(W, N, Kd, 64 * kb, src_n0, WT, dst_n0, sc, scr, F.lane);
    }
}
__device__ __forceinline__ void zero_rows(bf16* WT, int K, int n_lo, int n_hi, int gtid, int nthr) {
    const size_t n16 = (size_t)(n_hi - n_lo) * K / 8; GAS v4u* p = (GAS v4u*)(WT + (size_t)n_lo * K);
    for (size_t i = gtid; i < n16; i += nthr) p[i] = (v4u){0u, 0u, 0u, 0u};
}
__device__ __forceinline__ void p_prologue(Frame& F) {
    LAS float* scr = (LAS float*)(F.lds + F.wave * 16384);
    const int gw0 = F.vcu * NWAVES + F.wave, NGW = F.G * NWAVES, gtid = F.bx * (NWAVES * 64) + F.tid, nthr = F.G * NWAVES * 64;
    for (int l = 0; l < DEPTH; ++l) {
        unsigned char* wb = F.ws + WS_W + (size_t)l * WB_LAYER;
        int gw = gw0;
#define ROT(n) do { gw = (gw + NGW - ((n) % NGW)) % NGW; } while (0)
        conv_matrix<1>(F, INP(1) + (size_t)l * 1024 * DIN, 1024, DIN, (bf16*)(wb + WB_IN), 0.125f * LOG2E_F, gw, NGW, scr); ROT(16 * 173);
        zero_rows((bf16*)(wb + WB_IN), 1024, DIN, DINP, gtid, nthr);
        conv_matrix<0>(F, INP(7) + (size_t)l * 384 * 384, 384, 384, (bf16*)(wb + WB_UQ), 0.10206207261596577f * LOG2E_F, gw, NGW, scr); ROT(72);
        zero_rows((bf16*)(wb + WB_UQ), 384, 384, 512, gtid, nthr);
        conv_matrix<0>(F, INP(8) + (size_t)l * 256 * 512, 256, 512, (bf16*)(wb + WB_UKV), 1.0f, gw, NGW, scr); ROT(64);
        conv_matrix<0>(F, INP(9) + (size_t)l * 384 * 1024, 384, 1024, (bf16*)(wb + WB_BA), 1.0f, gw, NGW, scr); ROT(192);
        conv_matrix<0>(F, INP(10) + (size_t)l * 384 * 1024, 384, 1024, (bf16*)(wb + WB_BB), 1.0f, gw, NGW, scr); ROT(192);
        conv_matrix<0>(F, INP(11) + (size_t)l * 256 * 1024, 256, 1024, (bf16*)(wb + WB_BC), 1.0f, gw, NGW, scr, 384); ROT(64);
        for (int i = gtid; i < 1024 * 16; i += nthr) *((GAS v4u*)(wb + WB_BC) + (size_t)(i >> 4) * 48 + 32 + (i & 15)) = (v4u){0u, 0u, 0u, 0u};
        conv_matrix<0>(F, INP(12) + (size_t)l * 1024 * 1024, 1024, 1024, (bf16*)(wb + WB_OUT), 1.0f, gw, NGW, scr); ROT(512);
#undef ROT
    }
    { const GAS f32x4* xs = (const GAS f32x4*)INP(0); GAS v4u* xd = (GAS v4u*)(F.ws + WS_XB);
      for (size_t i = gtid; i < (size_t)T * D / 8; i += nthr) { const f32x4 a = xs[2 * i], b = xs[2 * i + 1]; xd[i] = (v4u){pk2(a.x, a.y), pk2(a.z, a.w), pk2(b.x, b.y), pk2(b.z, b.w)}; } }
}

constexpr int CONV_ITEMS = NE * 1024 + NE * 512, CONV_LDS_OFF = 49152, CONV_LDS_WAVE = 2 * 16 * 33 * 4;
struct MoeConv {
    static constexpr bool PLAIN = false;
    const float* Wgu; const float* Wdn; bf16* Tgu; bf16* Tdn;
    LAS float* scr; int lane; int gw, ngw, nmini; int s;
    float cvA[8], cvB[8];
    struct Mini { const float* W; bf16* WT; int ldw, k0, src_n0, dst_n0; };
    __device__ __forceinline__ Mini decode(int m) const {
        m = m < 0 ? 0 : (m >= nmini ? nmini - 1 : m);
        const int g = gw + (m >> 2) * ngw, q = m & 3; const bool gu = g < NE * 1024; const int h = gu ? g : g - NE * 1024;
        const int e = gu ? (h >> 10) : (h >> 9), r = gu ? (h & 1023) : (h & 511), kb = gu ? (r >> 6) : (r >> 5), nb = gu ? (r & 63) : (r & 31);
        Mini x; x.dst_n0 = 32 * nb; const int p = x.dst_n0 >> 8, j = x.dst_n0 & 255;
        x.src_n0 = gu ? ((j < 128) ? (128 * p + j) : (1024 + 128 * p + (j - 128))) : x.dst_n0; x.k0 = 64 * kb + 16 * q; x.ldw = gu ? 2048 : 1024;
        x.W = gu ? Wgu + (size_t)e * 1024 * 2048 : Wdn + (size_t)e * 1024 * 1024; x.WT = gu ? Tgu + (size_t)e * 2048 * 1024 : Tdn + (size_t)e * 1024 * 1024; return x;
    }
    __device__ __forceinline__ bool done() const { return s >= nmini + 3; }
    template <int P> __device__ __forceinline__ void step() {
        {   const Mini x = decode(s - 3); const LAS float* b = scr + (1 - P) * (16 * 33); const int n = lane >> 1, kh = lane & 1; const LAS float* p = b + (8 * kh) * 33 + n;
            v4u o; o.x = pk2(p[0 * 33], p[1 * 33]); o.y = pk2(p[2 * 33], p[3 * 33]); o.z = pk2(p[4 * 33], p[5 * 33]); o.w = pk2(p[6 * 33], p[7 * 33]);
            *(GAS v4u*)(x.WT + (size_t)(x.dst_n0 + n) * 1024 + x.k0 + 8 * kh) = o; }
        {   LAS float* b = scr + P * (16 * 33);
#pragma unroll
            for (int jj = 0; jj < 8; ++jj) b[(2 * jj + (lane >> 5)) * 33 + (lane & 31)] = P ? cvB[jj] : cvA[jj]; }
        {   const Mini x = decode(s); const GAS float* src = (const GAS float*)x.W + (size_t)(x.k0 + (lane >> 5)) * x.ldw + x.src_n0 + (lane & 31);
#pragma unroll
            for (int jj = 0; jj < 8; ++jj) { const float v = src[(size_t)(2 * jj) * x.ldw]; if (P) cvB[jj] = v; else cvA[jj] = v; } }
        ++s;
    }
};
__device__ __forceinline__ void p_prep(Frame& F, int l) {
    const bf16* hb = (const bf16*)(F.ws + WS_H); unsigned char* a2 = F.ws + WS_A2;
    bf16* kB = (bf16*)(a2 + A2_KB); bf16* cqn = (bf16*)(a2 + A2_CQN); bf16* ckvn = (bf16*)(a2 + A2_CKVN); bf16* kr = (bf16*)(a2 + A2_KR);
    const float* gk = INP(4) + l * 64; const float* gq = INP(5) + l * 384; const float* gkv = INP(6) + l * 256;
    const int lane = F.lane, gw = F.vcu * NWAVES + F.wave, NGW = F.G * NWAVES;
    for (int t = gw; t < T; t += NGW) {
        const bf16* hr = hb + (size_t)t * DINP; const int s = t & (SEQ - 1); const float prow = (float)(s >> 6), pcol = (float)(s & 63);
        {   float x[8]; float ssq = 0.f; const int cc = lane & 7;
            if (lane < 16) { const v4u w = *(const GAS v4u*)(hr + H_GK + lane * 8); x[0] = bflo(w.x); x[1] = bfhi(w.x); x[2] = bflo(w.y); x[3] = bfhi(w.y); x[4] = bflo(w.z); x[5] = bfhi(w.z); x[6] = bflo(w.w); x[7] = bfhi(w.w); }
            else {
#pragma unroll
                for (int j = 0; j < 8; ++j) x[j] = 0.f; }
#pragma unroll
            for (int j = 0; j < 8; ++j) ssq += x[j] * x[j];
            ssq += shx<1>(ssq, lane); ssq += shx<2>(ssq, lane); ssq += shx<4>(ssq, lane);
            const float rstd = 1.0f / sqrtf(ssq * (1.0f / 64.0f) + RMS_EPS);
            float y[8], o[8];
#pragma unroll
            for (int j = 0; j < 8; ++j) y[j] = x[j] * rstd * gk[(cc * 8 + j) & 63];
#pragma unroll
            for (int j = 0; j < 8; ++j) { const float other = shx<4>(y[j], lane); const int i = 8 * (cc & 3) + j;
                const float inv = exp2f(-(float)(i & 15) * (att::LOG2_THETA / 16.0f)); const float ang = ((i < 16) ? prow : pcol) * inv * att::INV2PI;
                const float c = __builtin_amdgcn_cosf(ang), sn = __builtin_amdgcn_sinf(ang);
                o[j] = (cc < 4) ? (y[j] * c - other * sn) : (other * sn + y[j] * c); }
            if (lane < 16) *(GAS v4u*)(kB + (size_t)t * 128 + lane * 8) = (v4u){pk2(o[0], o[1]), pk2(o[2], o[3]), pk2(o[4], o[5]), pk2(o[6], o[7])};
        }
        {   float x[8]; float ssq = 0.f;
            if (lane < 48) { const v4u w = *(const GAS v4u*)(hr + H_CQ + lane * 8); x[0] = bflo(w.x); x[1] = bfhi(w.x); x[2] = bflo(w.y); x[3] = bfhi(w.y); x[4] = bflo(w.z); x[5] = bfhi(w.z); x[6] = bflo(w.w); x[7] = bfhi(w.w); }
            else {
#pragma unroll
                for (int j = 0; j < 8; ++j) x[j] = 0.f; }
#pragma unroll
            for (int j = 0; j < 8; ++j) ssq += x[j] * x[j];
            ssq = wave_sum(ssq, lane); const float rstd = 1.0f / sqrtf(ssq * (1.0f / 384.0f) + RMS_EPS);
            if (lane < 48) { float y[8];
#pragma unroll
                for (int j = 0; j < 8; ++j) y[j] = x[j] * rstd * gq[lane * 8 + j];
                *(GAS v4u*)(cqn + (size_t)t * 384 + lane * 8) = (v4u){pk2(y[0], y[1]), pk2(y[2], y[3]), pk2(y[4], y[5]), pk2(y[6], y[7])}; }
        }
        {   float x[8]; float ssq = 0.f;
            if (lane < 32) { const v4u w = *(const GAS v4u*)(hr + H_CKV + lane * 8); x[0] = bflo(w.x); x[1] = bfhi(w.x); x[2] = bflo(w.y); x[3] = bfhi(w.y); x[4] = bflo(w.z); x[5] = bfhi(w.z); x[6] = bflo(w.w); x[7] = bfhi(w.w); }
            else {
#pragma unroll
                for (int j = 0; j < 8; ++j) x[j] = 0.f; }
#pragma unroll
            for (int j = 0; j < 8; ++j) ssq += x[j] * x[j];
            ssq = wave_sum(ssq, lane); const float rstd = 1.0f / sqrtf(ssq * (1.0f / 256.0f) + RMS_EPS);
            if (lane < 32) { float y[8];
#pragma unroll
                for (int j = 0; j < 8; ++j) y[j] = x[j] * rstd * gkv[lane * 8 + j];
                *(GAS v4u*)(ckvn + (size_t)t * 256 + lane * 8) = (v4u){pk2(y[0], y[1]), pk2(y[2], y[3]), pk2(y[4], y[5]), pk2(y[6], y[7])}; }
        }
        {   float x[8]; const int cc = lane & 3;
            if (lane < 4) { const v4u w = *(const GAS v4u*)(hr + H_KR + lane * 8); x[0] = bflo(w.x); x[1] = bfhi(w.x); x[2] = bflo(w.y); x[3] = bfhi(w.y); x[4] = bflo(w.z); x[5] = bfhi(w.z); x[6] = bflo(w.w); x[7] = bfhi(w.w); }
            else {
#pragma unroll
                for (int j = 0; j < 8; ++j) x[j] = 0.f; }
            float o[8];
#pragma unroll
            for (int j = 0; j < 8; ++j) { const float other = shx<2>(x[j], lane);
                const float inv = exp2f(-(float)j * (att::LOG2_THETA / 8.0f)); const float ang = (((cc & 1) == 0) ? prow : pcol) * inv * att::INV2PI;
                const float c = __builtin_amdgcn_cosf(ang), sn = __builtin_amdgcn_sinf(ang);
                o[j] = (cc < 2) ? (x[j] * c - other * sn) : (other * sn + x[j] * c); }
            if (lane < 4) *(GAS v4u*)(kr + (size_t)t * 32 + lane * 8) = (v4u){pk2(o[0], o[1]), pk2(o[2], o[3]), pk2(o[4], o[5]), pk2(o[6], o[7])};
        }
    }
}


__device__ __forceinline__ int build_tables(Frame& F, int l) {
    LAS int* st = (LAS int*)(F.lds + TBL_START); LAS int* cn = st + 33; LAS int* te = (LAS int*)(F.lds + TBL_TILEE);
    __syncthreads();
    if (F.tid < NE) cn[F.tid] = (int)__hip_atomic_load(F.ctl + CW_CNT + 64 * l + F.tid, RLX_AGENT);
    __syncthreads();
    if (F.tid == 0) { int s = 0; for (int e = 0; e < NE; ++e) { st[e] = s; s += ((cn[e] + 255) >> 8) << 8; } st[NE] = s; }
    __syncthreads();
    const int total = st[NE];
    for (int tile = F.tid; tile < (total >> 8); tile += NWAVES * 64) { int e = 0; for (int k = 1; k < NE; ++k) e += (tile * 256 >= st[k]) ? 1 : 0; te[tile] = e; }
    __syncthreads();
    return total;
}

__device__ __forceinline__ void p_ln1_router(Frame& F, int l, const float* xcur) {
    const bf16* outb = (const bf16*)(F.ws + WS_X1); bf16* x1b = (bf16*)(F.ws + WS_X1B);
    int* list_t = (int*)(F.ws + WS_LT); float* list_g = (float*)(F.ws + WS_LG); int* tok_e = (int*)(F.ws + WS_TE); int* tok_r = (int*)(F.ws + WS_TR);
    const float* wr = INP(15) + (size_t)l * 1024 * NE; const float* br = INP(16) + l * NE;
    const int lane0 = F.lane, tid = F.tid;
    LAS unsigned char* wl = F.lds;
    LAS int* sel_e = (LAS int*)(F.lds + TBL_RS); LAS float* sel_g = (LAS float*)(sel_e + 512); LAS int* sel_r = sel_e + 1024; LAS int* hist = sel_e + 1536; LAS int* base = hist + 32;
    __syncthreads();
    for (int idx = tid; idx < 1024 * 8; idx += NWAVES * 64) { const int k = idx >> 3, c = idx & 7, kp = (k & 3) * 256 + (k >> 2), cp = c ^ ((kp >> 1) & 7);
        *(LAS f32x4*)(wl + (kp * 8 + cp) * 16) = *(const GAS f32x4*)(wr + (size_t)k * NE + c * 4); }
    __syncthreads();
    for (int tile = F.bx; tile < T / 128; tile += F.G) {
        if (tid < 32) hist[tid] = 0;
        __syncthreads();
        for (int it = 0; it < 16; ++it) {
            int lane = lane0; asm volatile("" : "+v"(lane));
            const int sw = (lane >> 1) & 7; const float bias_e = br[(lane >> 1) & 31];
            const GAS f32x4* lgp = (const GAS f32x4*)(INP(13) + l * D) + lane; const GAS f32x4* lbp = (const GAS f32x4*)(INP(14) + l * D) + lane;
            const int tl = F.wave * 16 + it, t = tile * 128 + tl;
            const GAS f32x4* xr = (const GAS f32x4*)(xcur + (size_t)t * D) + lane; const GAS unsigned long long* orr = (const GAS unsigned long long*)(outb + (size_t)t * D) + lane;
            f32x4 v[4]; float s = 0.f;
#pragma unroll
            for (int j = 0; j < 4; ++j) { const unsigned long long ow = orr[64 * j]; const unsigned olo = (unsigned)ow, ohi = (unsigned)(ow >> 32);
                v[j] = xr[64 * j] * DN_ALPHA + (f32x4){bflo(olo), bfhi(olo), bflo(ohi), bfhi(ohi)}; s += (v[j].x + v[j].y) + (v[j].z + v[j].w); }
            const float mean = wave_sum(s, lane) * (1.f / D); float s2 = 0.f;
#pragma unroll
            for (int j = 0; j < 4; ++j) { v[j] = v[j] - mean; s2 += (v[j].x * v[j].x + v[j].y * v[j].y) + (v[j].z * v[j].z + v[j].w * v[j].w); }
            const float rstd = 1.f / sqrtf(wave_sum(s2, lane) * (1.f / D) + LN_EPS);
            GAS unsigned long long* o8 = (GAS unsigned long long*)(x1b + (size_t)t * D) + lane;
#pragma unroll
            for (int j = 0; j < 4; ++j) { v[j] = v[j] * rstd * lgp[64 * j] + lbp[64 * j];
                o8[64 * j] = (unsigned long long)pk2(v[j].x, v[j].y) | ((unsigned long long)pk2(v[j].z, v[j].w) << 32); }
            float acc[32];
#pragma unroll
            for (int c = 0; c < 8; ++c) {
                int basec = lane * 128 + ((c ^ sw) << 4); asm volatile("" : "+v"(basec));
                const LAS unsigned char* wp = wl + basec;
                float a0 = 0.f, a1_ = 0.f, a2_ = 0.f, a3 = 0.f;
#pragma unroll
                for (int i = 0; i < 4; ++i)
#pragma unroll
                    for (int j = 0; j < 4; ++j) { const f32x4 w = *(const LAS f32x4*)(wp + (i * 256 + 64 * j) * 128); const float xv = v[j][i];
                        a0 += xv * w.x; a1_ += xv * w.y; a2_ += xv * w.z; a3 += xv * w.w; }
                acc[4 * c + 0] = a0; acc[4 * c + 1] = a1_; acc[4 * c + 2] = a2_; acc[4 * c + 3] = a3;
            }
            float a16[16], a8[8], a4[4], a2[2], a1;
            { const bool b = (lane & 32) != 0;
#pragma unroll
              for (int i = 0; i < 16; ++i) { const float send = b ? acc[i] : acc[16 + i]; const float keep = b ? acc[16 + i] : acc[i]; a16[i] = keep + shx<32>(send, lane); } }
            { const bool b = (lane & 16) != 0;
#pragma unroll
              for (int i = 0; i < 8; ++i) { const float send = b ? a16[i] : a16[8 + i]; const float keep = b ? a16[8 + i] : a16[i]; a8[i] = keep + shx<16>(send, lane); } }
            { const bool b = (lane & 8) != 0;
#pragma unroll
              for (int i = 0; i < 4; ++i) { const float send = b ? a8[i] : a8[4 + i]; const float keep = b ? a8[4 + i] : a8[i]; a4[i] = keep + shx<8>(send, lane); } }
            { const bool b = (lane & 4) != 0;
#pragma unroll
              for (int i = 0; i < 2; ++i) { const float send = b ? a4[i] : a4[2 + i]; const float keep = b ? a4[2 + i] : a4[i]; a2[i] = keep + shx<4>(send, lane); } }
            { const bool b = (lane & 2) != 0; const float send = b ? a2[0] : a2[1]; const float keep = b ? a2[1] : a2[0]; a1 = keep + shx<2>(send, lane); }
            a1 += shx<1>(a1, lane);
            float val = a1 + bias_e; const int my_e = (lane >> 1) & 31;
            float sv[4]; int se[4];
#pragma unroll
            for (int r = 0; r < 4; ++r) { float bv = val; int be = my_e;
#define TOPK_STEP(O) { const float ov = shx<O>(bv, lane); const int oe = shxi<O>(be, lane); if (ov > bv || (ov == bv && oe < be)) { bv = ov; be = oe; } }
                TOPK_STEP(2) TOPK_STEP(4) TOPK_STEP(8) TOPK_STEP(16) TOPK_STEP(32)
#undef TOPK_STEP
                sv[r] = bv; se[r] = be; if (my_e == be) val = -INFINITY; }
            const float e1 = __expf(sv[1] - sv[0]), e2 = __expf(sv[2] - sv[0]), e3 = __expf(sv[3] - sv[0]); const float rs = 1.0f / (1.0f + e1 + e2 + e3);
            if (lane < 4) { const int ee = lane == 0 ? se[0] : lane == 1 ? se[1] : lane == 2 ? se[2] : se[3]; const float gg = (lane == 0 ? 1.0f : lane == 1 ? e1 : lane == 2 ? e2 : e3) * rs;
                const int a = tl * 4 + lane; sel_e[a] = ee; sel_g[a] = gg; sel_r[a] = __hip_atomic_fetch_add(&hist[ee], 1, __ATOMIC_RELAXED, __HIP_MEMORY_SCOPE_WORKGROUP); }
        }
        __syncthreads();
        if (tid < 32) base[tid] = (int)__hip_atomic_fetch_add(F.ctl + CW_CNT + 64 * l + tid, (unsigned)hist[tid], RLX_AGENT);
        __syncthreads();
        { const int a = tid, e = sel_e[a], rank = base[e] + sel_r[a], t = tile * 128 + (a >> 2);
          list_t[(size_t)e * LCAP + rank] = t; list_g[(size_t)e * LCAP + rank] = sel_g[a]; tok_e[t * 4 + (a & 3)] = e; tok_r[t * 4 + (a & 3)] = rank; }
        __syncthreads();
    }
}

__device__ __forceinline__ void p_gather(Frame& F, int l) {
    const int total = build_tables(F, l);
    LAS int* st = (LAS int*)(F.lds + TBL_START); LAS int* cn = st + 33;
    const bf16* x1b = (const bf16*)(F.ws + WS_X1B); bf16* xg = (bf16*)(F.ws + WS_H); float* sg = (float*)(F.ws + WS_SG);
    const int* list_t = (const int*)(F.ws + WS_LT); const float* list_g = (const float*)(F.ws + WS_LG);
    const int lane = F.lane, gw = F.vcu * NWAVES + F.wave, NGW = F.G * NWAVES;
    for (int s = gw; s < total; s += NGW) {
        const bool pr = (lane < NE) && (s >= st[lane & 31]);
        const int e = __popcll(__ballot(pr)) - 1; const int r = s - st[e];
        GAS v4u* dst = (GAS v4u*)(xg + (size_t)s * D);
        if (r < cn[e]) { const int t = list_t[(size_t)e * LCAP + r]; const GAS v4u* src = (const GAS v4u*)(x1b + (size_t)t * D);
            dst[lane] = src[lane]; dst[64 + lane] = src[64 + lane]; if (lane == 0) sg[s] = list_g[(size_t)e * LCAP + r]; }
        else { unsigned zz = 0u; asm volatile("" : "+v"(zz)); const v4u z4 = {zz, zz, zz, zz}; dst[lane] = z4; dst[64 + lane] = z4; if (lane == 0) sg[s] = 0.f; }
    }
}

__device__ __forceinline__ void p_ln2(Frame& F, int l, float* dst, bool write_xb) {
    (void)build_tables(F, l);
    LAS int* st = (LAS int*)(F.lds + TBL_START);
    const bf16* x1b = (const bf16*)(F.ws + WS_X1B); const bf16* yb = (const bf16*)(F.ws + WS_H); bf16* xb = (bf16*)(F.ws + WS_XB);
    const int* tok_e = (const int*)(F.ws + WS_TE); const int* tok_r = (const int*)(F.ws + WS_TR);
    const int lane = F.lane, hl = lane & 31, half = lane >> 5, gw = F.vcu * NWAVES + F.wave, NGW = F.G * NWAVES;
    const float* lgp = INP(21) + l * D; const float* lbp = INP(22) + l * D;
    float dmult = 1.0f;
#if MK_DEBUG
    if (l == DEPTH - 1) { const unsigned mask = __hip_atomic_load(F.ctl + 20000, RLX_AGENT) & ~(unsigned)(MK_DBG_IGNORE); if (mask) dmult = 1.0f + (float)(__ffs((int)mask) - 1); }
#endif
    int t = 2 * gw + half;
    int e4 = 0, r4 = 0;
    if (t < T && hl < 4) { e4 = tok_e[t * 4 + hl]; r4 = tok_r[t * 4 + hl]; }
    for (; t < T; t += 2 * NGW) {
        int slot4 = st[e4] + r4;
        const int tn = t + 2 * NGW; int e4n = 0, r4n = 0;
        if (tn < T && hl < 4) { e4n = tok_e[tn * 4 + hl]; r4n = tok_r[tn * 4 + hl]; }
        int slot[4];
#pragma unroll
        for (int k = 0; k < 4; ++k) slot[k] = __builtin_amdgcn_ds_bpermute((half * 32 + k) << 2, slot4);
        const GAS v4u* xr = (const GAS v4u*)(x1b + (size_t)t * D) + hl;
        v4u xw[4], yw[4][4];
#pragma unroll
        for (int q = 0; q < 4; ++q) xw[q] = xr[32 * q];
#pragma unroll
        for (int k = 0; k < 4; ++k) { const GAS v4u* yr = (const GAS v4u*)(yb + (size_t)slot[k] * D) + hl;
#pragma unroll
            for (int q = 0; q < 4; ++q) yw[k][q] = yr[32 * q]; }
        float v[4][8]; float s = 0.f;
#pragma unroll
        for (int q = 0; q < 4; ++q) {
            v[q][0] = bflo(xw[q].x) * DN_ALPHA; v[q][1] = bfhi(xw[q].x) * DN_ALPHA; v[q][2] = bflo(xw[q].y) * DN_ALPHA; v[q][3] = bfhi(xw[q].y) * DN_ALPHA;
            v[q][4] = bflo(xw[q].z) * DN_ALPHA; v[q][5] = bfhi(xw[q].z) * DN_ALPHA; v[q][6] = bflo(xw[q].w) * DN_ALPHA; v[q][7] = bfhi(xw[q].w) * DN_ALPHA;
#pragma unroll
            for (int k = 0; k < 4; ++k) { v[q][0] += bflo(yw[k][q].x); v[q][1] += bfhi(yw[k][q].x); v[q][2] += bflo(yw[k][q].y); v[q][3] += bfhi(yw[k][q].y);
                v[q][4] += bflo(yw[k][q].z); v[q][5] += bfhi(yw[k][q].z); v[q][6] += bflo(yw[k][q].w); v[q][7] += bfhi(yw[k][q].w); }
#pragma unroll
            for (int i = 0; i < 8; ++i) s += v[q][i]; }
        s += shx<1>(s, lane); s += shx<2>(s, lane); s += shx<4>(s, lane); s += shx<8>(s, lane); s += shx<16>(s, lane);
        const float mean = s * (1.f / D); float s2 = 0.f;
#pragma unroll
        for (int q = 0; q < 4; ++q)
#pragma unroll
            for (int i = 0; i < 8; ++i) { v[q][i] -= mean; s2 += v[q][i] * v[q][i]; }
        s2 += shx<1>(s2, lane); s2 += shx<2>(s2, lane); s2 += shx<4>(s2, lane); s2 += shx<8>(s2, lane); s2 += shx<16>(s2, lane);
        const float rstd = 1.f / sqrtf(s2 * (1.f / D) + LN_EPS);
        GAS f32x4* orow = (GAS f32x4*)(dst + (size_t)t * D) + 2 * hl; GAS v4u* o16 = (GAS v4u*)(xb + (size_t)t * D) + hl;
#pragma unroll
        for (int q = 0; q < 4; ++q) { const GAS f32x4* gq = (const GAS f32x4*)(lgp + 256 * q) + 2 * hl; const GAS f32x4* bq = (const GAS f32x4*)(lbp + 256 * q) + 2 * hl;
            const f32x4 g0 = gq[0], g1 = gq[1], b0 = bq[0], b1 = bq[1];
            f32x4 y0 = {v[q][0] * rstd, v[q][1] * rstd, v[q][2] * rstd, v[q][3] * rstd}, y1 = {v[q][4] * rstd, v[q][5] * rstd, v[q][6] * rstd, v[q][7] * rstd};
            y0 = y0 * g0 + b0; y1 = y1 * g1 + b1;
            orow[64 * q] = y0 * dmult; orow[64 * q + 1] = y1 * dmult;
            if (write_xb) o16[32 * q] = (v4u){pk2(y0.x, y0.y), pk2(y0.z, y0.w), pk2(y1.x, y1.y), pk2(y1.z, y1.w)}; }
        e4 = e4n; r4 = r4n;
    }
}

template <int WHICH> __device__ __forceinline__ void p_attention(Frame& F, int l) {
    const bf16* hb = (const bf16*)(F.ws + WS_H); unsigned char* a2 = F.ws + WS_A2;
    const bf16* kB = (const bf16*)(a2 + A2_KB); const bf16* kr = (const bf16*)(a2 + A2_KR); const bf16* qc = (const bf16*)(a2 + A2_QC); const bf16* kvc = (const bf16*)(a2 + A2_KVC);
    bf16* ya = (bf16*)(a2 + A2_YA); bf16* yb = (bf16*)(a2 + A2_YB); bf16* yc = (bf16*)(a2 + A2_YC);
    att::ALAS_PTR lds = (att::ALAS_PTR)F.lds;
    att::NoSide noside;
    __syncthreads();
    if (WHICH == 0) {
        float mq = fabsf((INP(3) + l * 64)[F.lane]), mk = fabsf((INP(4) + l * 64)[F.lane]);
#define MX_STEP(O) { mq = fmaxf(mq, shx<O>(mq, F.lane)); mk = fmaxf(mk, shx<O>(mk, F.lane)); }
        MX_STEP(1) MX_STEP(2) MX_STEP(4) MX_STEP(8) MX_STEP(16) MX_STEP(32)
#undef MX_STEP
        const float cref = __int_as_float(__builtin_amdgcn_readfirstlane(__float_as_int(8.0f * LOG2E_F * 1.03f * mq * mk)));
        const bool fixed_ok = cref < 60.0f;
        unsigned char* wbl = F.ws + WS_W + (size_t)l * WB_LAYER;
        MoeConv cv; cv.Wgu = INP(17) + (size_t)l * NE * 1024 * 2048; cv.Wdn = INP(19) + (size_t)l * NE * 1024 * 1024; cv.Tgu = (bf16*)(wbl + WB_GU); cv.Tdn = (bf16*)(wbl + WB_DN);
        cv.scr = (LAS float*)(F.lds + CONV_LDS_OFF + F.wave * CONV_LDS_WAVE); cv.lane = F.lane; cv.ngw = F.G * NWAVES; cv.gw = F.vcu * NWAVES + F.wave; cv.s = 0;
        cv.nmini = 4 * ((CONV_ITEMS - cv.gw + cv.ngw - 1) / cv.ngw);
#pragma unroll
        for (int i_ = 0; i_ < 8; ++i_) { cv.cvA[i_] = 0.f; cv.cvB[i_] = 0.f; }
        for (int idx = F.vcu; idx < 768; idx += F.G) {
            const int qi = idx >> 8, rem = idx & 255, bk = rem >> 5, qb = rem & 31, b = bk >> 1, kvh = bk & 1, head = kvh * 3 + qi;
            att::UnitP u; const size_t tb = (size_t)b * SEQ, tq = tb + (size_t)qb * 256;
            u.Q = hb + tq * DINP + H_GQ + head * 64; u.ldq = DINP; u.K0 = kB + tb * 128 + kvh * 64; u.ldk0 = 128; u.K1 = nullptr; u.ldk1 = 0;
            u.V = hb + tb * DINP + H_GV + kvh * 64; u.ldv = DINP; u.O = yb + tq * 384 + head * 64; u.ldo = 384; u.nt = SEQ / 64; u.grow0 = qb * 4; u.gain = INP(3) + l * 64; u.kr0 = 0; u.cref = cref;
            if (fixed_ok) att::attn_unit<64, 0, MoeConv>(u, lds, F.tid, cv); else att::attn_unit<64, 3, MoeConv>(u, lds, F.tid, cv);
        }
        while (!cv.done()) { cv.step<0>(); cv.step<1>(); }
    }
    if (WHICH == 1) for (int idx = F.vcu; idx < 512; idx += F.G) {
        const int rnd = idx >> 8, rem = idx & 255, p = (rem >> 5) * 2 + rnd, qb = rem & 31, b = p >> 2, h = p & 3;
        att::UnitP u; const size_t tb = (size_t)b * SEQ, tq = tb + (size_t)qb * 256;
        u.Q = qc + tq * 384 + h * 96; u.ldq = 384; u.K0 = kvc + tb * 512 + h * 128; u.ldk0 = 512; u.K1 = kr + tb * 32; u.ldk1 = 32;
        u.V = kvc + tb * 512 + h * 128 + 64; u.ldv = 512; u.O = yc + tq * 384 + h * 64; u.ldo = 384; u.nt = SEQ / 64; u.grow0 = qb * 4; u.gain = nullptr; u.kr0 = 0; u.cref = 0.f;
        att::attn_unit<96, 1>(u, lds, F.tid, noside);
    }
    if (WHICH == 2) for (int idx = F.vcu; idx < 768; idx += F.G) {
        const int b = idx / 192, rem = idx % 192, h = rem >> 5, rg = rem & 31, R0 = rg * 4;
        int r_lo = R0 - 4; r_lo = r_lo < 0 ? 0 : (r_lo > 120 ? 120 : r_lo);
        int r_hi = R0 - 1; r_hi = (r_hi < 0 ? 0 : (r_hi > 120 ? 120 : r_hi)) + 8;
        if ((r_hi - r_lo) & 1) { if (r_hi < 128) ++r_hi; else --r_lo; }
        {
            LAS float* bt = (LAS float*)(F.lds + att::OFF_BIAS); const float* rp = INP(2) + ((size_t)l * 6 + h) * 465;
            if (F.tid < 465) bt[F.tid] = rp[F.tid] * LOG2E_F; }
        att::UnitP u; const size_t tb = (size_t)b * SEQ, tq = tb + (size_t)R0 * 64, tk = tb + (size_t)r_lo * 64;
        u.Q = hb + tq * DINP + H_NAQ + h * 64; u.ldq = DINP; u.K0 = hb + tk * DINP + H_NAK + h * 64; u.ldk0 = DINP; u.K1 = nullptr; u.ldk1 = 0;
        u.V = hb + tk * DINP + H_NAV + h * 64; u.ldv = DINP; u.O = ya + tq * 384 + h * 64; u.ldo = 384; u.nt = r_hi - r_lo; u.grow0 = R0; u.gain = nullptr; u.kr0 = r_lo; u.cref = 0.f;
        att::attn_unit<64, 2>(u, lds, F.tid, noside);
    }
}


struct Args { const float* in[23]; float* out; unsigned char* ws; int ph_lo, ph_hi, use_bar, pad; };
__global__ void __launch_bounds__(NWAVES * 64, 2) mk_fwd(Args args) {
    extern __shared__ __attribute__((aligned(16))) unsigned char lds[];
    const int wave_id = __builtin_amdgcn_readfirstlane((int)threadIdx.x >> 6), bx0 = blockIdx.x, G0 = gridDim.x;
    {   LAS unsigned* z = (LAS unsigned*)((LAS unsigned char*)lds + LDSCTL_OFF); for (int u = threadIdx.x; u < (LDS_BYTES - LDSCTL_OFF) / 4; u += NWAVES * 64) z[u] = 0u; }
    __syncthreads();
    XcdBarrier bar; bar.bar = (unsigned*)(args.ws + WS_CTL) + CW_BAR; bar.x = 0; bar.st = nullptr;
    if (args.use_bar) bar = xcd_barrier_post((unsigned*)(args.ws + WS_CTL) + CW_BAR, (volatile LAS unsigned*)((LAS unsigned char*)lds + MISC_OFF));
    const int lo = args.ph_lo, hi = args.ph_hi;
#define IN(k) (lo <= (k) && (k) < hi)
#define REPEAT(n) for (int rep_ = 0; rep_ < (n); ++rep_)
#define RSEAM(n) do { if (rep_ + 1 < (n)) { XcdBarrier b_ = bar; { GAS unsigned* bb_ = (GAS unsigned*)b_.bar; asm volatile("; rseam %1" : "+s"(bb_) : "n"(__COUNTER__)); b_.bar = (unsigned*)bb_; } xcd_barrier(b_); } } while (0)
#define SEAM(k) do { if (IN(k) && IN((k) + 1)) { XcdBarrier b_ = bar; { GAS unsigned* bb_ = (GAS unsigned*)b_.bar; asm volatile("; seam %1" : "+s"(bb_) : "n"(__COUNTER__)); b_.bar = (unsigned*)bb_; } xcd_barrier(b_); } } while (0)
#define FRAME() Frame F = mkframe<__COUNTER__>((LAS unsigned char*)lds, args.ws, args.out, wave_id, bx0, G0); unsigned char* ws = F.ws; unsigned char* a2 = ws + WS_A2; unsigned char* wb = ws + WS_W + (size_t)l * WB_LAYER; (void)a2; (void)wb

    if (IN(0)) REPEAT(REP_P) { Frame F = mkframe<__COUNTER__>((LAS unsigned char*)lds, args.ws, args.out, wave_id, bx0, G0); p_prologue(F); RSEAM(REP_P); } SEAM(0);

    for (int l = 0; l < DEPTH; ++l) {
        const int pb = 1 + l * PPL;
        if (IN(pb + 0)) REPEAT(REP_A) { FRAME();
            pg8::Gemm g{(const bf16*)(ws + WS_XB), (const bf16*)(wb + WB_IN), T, DINP, 1024, 0, 0}; pg8::StaticOrder S; S.init(T, DINP, F.G, F.bx);
            pg8::EpiStore E{(bf16*)(ws + WS_H), DINP, DINP};
            pg8::gemm_phase<pg8::EpiStore, pg8::StaticOrder, true, true>(F.lds, g, S, E, F.tid); RSEAM(REP_A);
        } SEAM(pb + 0);
        if (IN(pb + 1)) REPEAT(REP_B) { FRAME(); p_prep(F, l); RSEAM(REP_B); } SEAM(pb + 1);
        if (IN(pb + 2)) REPEAT(REP_C) {
            { FRAME(); pg8::Gemm g{(const bf16*)(a2 + A2_CQN), (const bf16*)(wb + WB_UQ), T, 512, 384, 0, 0}; pg8::StaticOrder S; S.init(T, 512, F.G, F.bx);
              pg8::EpiStore E{(bf16*)(a2 + A2_QC), 384, 384};
              pg8::gemm_phase<pg8::EpiStore, pg8::StaticOrder, true, true>(F.lds, g, S, E, F.tid); }
            { FRAME(); pg8::Gemm g{(const bf16*)(a2 + A2_CKVN), (const bf16*)(wb + WB_UKV), T, 512, 256, 0, 0}; pg8::StaticOrder S; S.init(T, 512, F.G, F.bx);
              pg8::EpiStore E{(bf16*)(a2 + A2_KVC), 512, 512};
              pg8::gemm_phase<pg8::EpiStore, pg8::StaticOrder, true, true>(F.lds, g, S, E, F.tid); }
            RSEAM(REP_C);
        } SEAM(pb + 2);
        if (IN(pb + 3)) { REPEAT(REP_DG) { FRAME(); p_attention<0>(F, l); RSEAM(REP_DG); } REPEAT(REP_DM) { FRAME(); p_attention<1>(F, l); RSEAM(REP_DM); } REPEAT(REP_DN) { FRAME(); p_attention<2>(F, l); RSEAM(REP_DN); } } SEAM(pb + 3);
        if (IN(pb + 4)) REPEAT(REP_E) { FRAME();
            pg8::Gemm g{(const bf16*)(a2 + A2_YA), (const bf16*)(wb + WB_BA), T, 1024, 384, (size_t)1024 * 384 * 2, (size_t)T * 384 * 2};
            pg8::ChainOrder S; S.so.init(T, 1024, F.G, F.bx); S.nch = 3;
            pg8::EpiGateChain E{(const bf16*)(ws + WS_H) + H_GATE, DINP, (bf16*)(a2 + A2_MIXED)};
            pg8::gemm_phase<pg8::EpiGateChain, pg8::ChainOrder, true, true>(F.lds, g, S, E, F.tid);
            RSEAM(REP_E);
        } SEAM(pb + 4);
        if (IN(pb + 5)) REPEAT(REP_F) { FRAME();
            pg8::Gemm g{(const bf16*)(a2 + A2_MIXED), (const bf16*)(wb + WB_OUT), T, 1024, 1024, 0, 0}; pg8::StaticOrder S; S.init(T, 1024, F.G, F.bx);
            pg8::EpiStore E{(bf16*)(ws + WS_X1), 1024, 1024};
            pg8::gemm_phase<pg8::EpiStore, pg8::StaticOrder, true, true>(F.lds, g, S, E, F.tid); RSEAM(REP_F);
        } SEAM(pb + 5);
        if (IN(pb + 6)) { FRAME(); p_ln1_router(F, l, (l == 0) ? INP(0) : (const float*)(ws + WS_X2)); } SEAM(pb + 6);
        if (IN(pb + 7)) REPEAT(REP_I) { FRAME();
            const int total = build_tables(F, l);
            pg8::Gemm g{(const bf16*)(ws + WS_X1B), (const bf16*)(wb + WB_GU), total, 2048, 1024, (size_t)2048 * 1024 * 2, 0};
            pg8::MoeGather gs{(const int*)(ws + WS_LT), (const LAS int*)(F.lds + TBL_START), (const LAS int*)(F.lds + TBL_START) + 33, LCAP};
            pg8::MoeOrder S{8, (total >> 8) * 8, F.G, F.vcu, (const LAS int*)(F.lds + TBL_TILEE)};
            pg8::EpiSwiglu E{(bf16*)(ws + WS_A2), INP(18) + (size_t)l * NE * 2048};
            pg8::gemm_phase<pg8::EpiSwiglu, pg8::MoeOrder, true, true, true, pg8::MoeGather>(F.lds, g, S, E, F.tid, gs); RSEAM(REP_I);
        } SEAM(pb + 7);
        if (IN(pb + 8)) REPEAT(REP_J) { FRAME();
            const int total = build_tables(F, l);
            pg8::Gemm g{(const bf16*)(ws + WS_A2), (const bf16*)(wb + WB_DN), total, 1024, 1024, (size_t)1024 * 1024 * 2, 0};
            pg8::MoeOrder S{4, (total >> 8) * 4, F.G, F.vcu, (const LAS int*)(F.lds + TBL_TILEE)};
            pg8::EpiDown E{(bf16*)(ws + WS_H), INP(20) + (size_t)l * NE * 1024, (const float*)(ws + WS_LG), (const LAS int*)(F.lds + TBL_START), (const LAS int*)(F.lds + TBL_START) + 33, LCAP};
            pg8::gemm_phase<pg8::EpiDown, pg8::MoeOrder, true, true>(F.lds, g, S, E, F.tid); RSEAM(REP_J);
        } SEAM(pb + 8);
        if (IN(pb + 9)) REPEAT(REP_K) { FRAME(); RSEAM(REP_K); p_ln2(F, l, (l == DEPTH - 1) ? F.out : (float*)(ws + WS_X2), l + 1 < DEPTH); }
        if (l + 1 < DEPTH) SEAM(pb + 9);
    }
#undef IN
#undef SEAM
}


#if MK_DEBUG
constexpr int CW_DBG = 20000;
__device__ __forceinline__ float bfr(float f) { return __uint_as_float(f2bf(f) << 16); }
__device__ __forceinline__ float bfv(const bf16* p) { return __uint_as_float(((unsigned)*p) << 16); }
__device__ __forceinline__ unsigned hsh(unsigned x) { x ^= x >> 16; x *= 0x7feb352du; x ^= x >> 15; x *= 0x846ca68bu; x ^= x >> 16; return x; }
__device__ __forceinline__ bool close_(float got, float ref, float rel, float abs_) { return fabsf(got - ref) <= rel * fabsf(ref) + abs_; }
__device__ __forceinline__ void ropecs(int i, int quarter, int s, float& c, float& sn) {
    const float pos = (i < quarter) ? (float)(s >> 6) : (float)(s & 63); const int m = (i < quarter) ? i : i - quarter;
    const float inv = exp2f(-(float)m / (float)quarter * 13.287712379549449f); const float ang = pos * inv * 0.15915494309189535f; c = __builtin_amdgcn_cosf(ang); sn = __builtin_amdgcn_sinf(ang);
}
#define DBG_FAIL(bit) atomicOr((unsigned*)(ws + WS_CTL) + CW_DBG, 1u << (bit))
template <int stage> __global__ void __launch_bounds__(256) dbg_kernel(Args args) {
    unsigned char* ws = args.ws; const int l = 0;
    const int gid = blockIdx.x * 256 + threadIdx.x;
    const bf16* hb = (const bf16*)(ws + WS_H); unsigned char* a2 = ws + WS_A2; unsigned char* wb = ws + WS_W + (size_t)l * WB_LAYER;
    const bf16* kB = (const bf16*)(a2 + A2_KB); const bf16* cqn = (const bf16*)(a2 + A2_CQN); const bf16* ckvn = (const bf16*)(a2 + A2_CKVN); const bf16* kr = (const bf16*)(a2 + A2_KR);
    const bf16* qc = (const bf16*)(a2 + A2_QC); const bf16* kvc = (const bf16*)(a2 + A2_KVC);
    const bf16* ya = (const bf16*)(a2 + A2_YA); const bf16* yb = (const bf16*)(a2 + A2_YB); const bf16* yc = (const bf16*)(a2 + A2_YC);
    const unsigned h1 = hsh(gid * 2654435761u + 12345u + stage * 977u), h2 = hsh(h1 + 0x9e3779b9u);
    const int t = h1 % T, s = t & (SEQ - 1), b = t / SEQ;
    if (stage == 0) {
        const int n = h2 % DIN; const float* x = args.in[0] + (size_t)t * D; const float* W = args.in[1];
        const float sc = (n < 384) ? 0.125f * LOG2E_F : 1.0f; float r = 0.f;
        for (int k = 0; k < 1024; ++k) r += bfr(x[k]) * bfr(W[(size_t)k * DIN + n] * sc);
        if (!close_(bfv(hb + (size_t)t * DINP + n), r, 0.02f, 0.02f)) DBG_FAIL(1);
    }
    if (stage == 1) {
        const bf16* hr = hb + (size_t)t * DINP;
        {   const int d = h2 % 128, head = d >> 6, dd = d & 63; float ssq = 0.f;
            for (int k = 0; k < 64; ++k) { const float v = bfv(hr + H_GK + head * 64 + k); ssq += v * v; }
            const float rstd = 1.0f / sqrtf(ssq / 64.0f + RMS_EPS); const float* g = args.in[4];
            const int i = dd & 31; const float y1 = bfv(hr + H_GK + head * 64 + i) * rstd * g[i], y2 = bfv(hr + H_GK + head * 64 + i + 32) * rstd * g[i + 32];
            float c, sn; ropecs(i, 16, s, c, sn); const float ref = (dd < 32) ? (y1 * c - y2 * sn) : (y1 * sn + y2 * c);
            if (!close_(bfv(kB + (size_t)t * 128 + d), ref, 0.02f, 0.01f)) DBG_FAIL(2); }
        {   const int d = h2 % 384; float ssq = 0.f; for (int k = 0; k < 384; ++k) { const float v = bfv(hr + H_CQ + k); ssq += v * v; }
            const float ref = bfv(hr + H_CQ + d) / sqrtf(ssq / 384.0f + RMS_EPS) * args.in[5][d];
            if (!close_(bfv(cqn + (size_t)t * 384 + d), ref, 0.02f, 0.01f)) DBG_FAIL(3); }
        {   const int d = h2 % 256; float ssq = 0.f; for (int k = 0; k < 256; ++k) { const float v = bfv(hr + H_CKV + k); ssq += v * v; }
            const float ref = bfv(hr + H_CKV + d) / sqrtf(ssq / 256.0f + RMS_EPS) * args.in[6][d];
            if (!close_(bfv(ckvn + (size_t)t * 256 + d), ref, 0.02f, 0.01f)) DBG_FAIL(4); }
        {   const int d = h2 % 32, i = d & 15; const float x1 = bfv(hr + H_KR + i), x2 = bfv(hr + H_KR + i + 16); float c, sn; ropecs(i, 8, s, c, sn);
            const float ref = (d < 16) ? (x1 * c - x2 * sn) : (x1 * sn + x2 * c);
            if (!close_(bfv(kr + (size_t)t * 32 + d), ref, 0.02f, 0.01f)) DBG_FAIL(5); }
    }
    if (stage == 2) {
        {   const int n = h2 % 384; float r = 0.f; const float sc = 0.10206207261596577f * LOG2E_F;
            for (int k = 0; k < 384; ++k) r += bfv(cqn + (size_t)t * 384 + k) * bfr(args.in[7][(size_t)k * 384 + n] * sc);
            if (!close_(bfv(qc + (size_t)t * 384 + n), r, 0.02f, 0.01f)) DBG_FAIL(6); }
        {   const int n = h2 % 512; float r = 0.f;
            for (int k = 0; k < 256; ++k) r += bfv(ckvn + (size_t)t * 256 + k) * bfr(args.in[8][(size_t)k * 512 + n]);
            if (!close_(bfv(kvc + (size_t)t * 512 + n), r, 0.02f, 0.02f)) DBG_FAIL(7); }
    }
    if (stage == 3) {
        const int gr = s >> 6, gc = s & 63;
        if (gid < 1024) {
            const int h = h2 % 6, dofs = ((h2 >> 8) & 1) * 32; float q[64], o[32];
            _Pragma("unroll") for (int d = 0; d < 64; ++d) { q[d] = bfv(hb + (size_t)t * DINP + H_NAQ + h * 64 + d); }
            _Pragma("unroll") for (int d = 0; d < 32; ++d) o[d] = 0.f;
            int r0 = gr - 4; r0 = r0 < 0 ? 0 : (r0 > 120 ? 120 : r0); int c0 = gc - 8; c0 = c0 < 0 ? 0 : (c0 > 48 ? 48 : c0);
            const float* rp = args.in[2] + (size_t)h * 465; float m = -1e30f, lsum = 0.f;
            for (int pass = 0; pass < 2; ++pass)
                for (int i = 0; i < 8; ++i) for (int j = 0; j < 16; ++j) { const int kr_ = r0 + i, kc = c0 + j; const size_t kt = (size_t)b * SEQ + kr_ * 64 + kc;
                    float sc = 0.f; _Pragma("unroll") for (int d = 0; d < 64; ++d) sc += q[d] * bfv(hb + kt * DINP + H_NAK + h * 64 + d);
                    sc += rp[(kr_ - gr + 7) * 31 + (kc - gc + 15)] * LOG2E_F;
                    if (pass == 0) m = fmaxf(m, sc); else { const float p = exp2f(sc - m); lsum += p; _Pragma("unroll") for (int d = 0; d < 32; ++d) o[d] += p * bfv(hb + kt * DINP + H_NAV + h * 64 + dofs + d); } }
            bool bad = false; _Pragma("unroll") for (int d = 0; d < 32; ++d) bad |= !close_(bfv(ya + (size_t)t * 384 + h * 64 + dofs + d), o[d] / lsum, 0.03f, 0.01f);
            if (bad) DBG_FAIL(8);
        } else if (gid < 1024 + 128) {
            const int head = h2 % 6, kvh = head / 3, dofs = ((h2 >> 8) & 1) * 32; float q[64], o[32]; float ssq = 0.f;
            _Pragma("unroll") for (int d = 0; d < 64; ++d) { q[d] = bfv(hb + (size_t)t * DINP + H_GQ + head * 64 + d); ssq += q[d] * q[d]; }
            _Pragma("unroll") for (int d = 0; d < 32; ++d) o[d] = 0.f;
            const float rstd = 1.0f / sqrtf(ssq / 64.0f + RMS_EPS);
            _Pragma("unroll") for (int d = 0; d < 64; ++d) q[d] = q[d] * rstd * args.in[3][d];
            _Pragma("unroll") for (int i = 0; i < 32; ++i) { float c, sn; ropecs(i, 16, s, c, sn); const float y1 = q[i], y2 = q[i + 32]; q[i] = y1 * c - y2 * sn; q[i + 32] = y1 * sn + y2 * c; }
            _Pragma("unroll") for (int d = 0; d < 64; ++d) q[d] = bfr(q[d] * 0.125f * LOG2E_F);
            float m = -1e30f, lsum = 0.f;
            for (int key = 0; key < SEQ; ++key) { const size_t kt = (size_t)b * SEQ + key; float sc = 0.f;
                _Pragma("unroll") for (int d = 0; d < 64; ++d) sc += q[d] * bfv(kB + kt * 128 + kvh * 64 + d);
                const float mn = fmaxf(m, sc), al = exp2f(m - mn), p = exp2f(sc - mn); m = mn; lsum = lsum * al + p;
                _Pragma("unroll") for (int d = 0; d < 32; ++d) o[d] = o[d] * al + p * bfv(hb + kt * DINP + H_GV + kvh * 64 + dofs + d); }
            bool bad = false; _Pragma("unroll") for (int d = 0; d < 32; ++d) bad |= !close_(bfv(yb + (size_t)t * 384 + head * 64 + dofs + d), o[d] / lsum, 0.03f, 0.003f);
            if (bad) DBG_FAIL(9);
        } else if (gid < 1024 + 256) {
            const int h = h2 % 4, dofs = ((h2 >> 8) & 1) * 32; float q[96], o[32];
            _Pragma("unroll") for (int d = 0; d < 96; ++d) q[d] = bfv(qc + (size_t)t * 384 + h * 96 + d);
            _Pragma("unroll") for (int i = 0; i < 16; ++i) { float c, sn; ropecs(i, 8, s, c, sn); const float y1 = q[64 + i], y2 = q[80 + i]; q[64 + i] = bfr(y1 * c - y2 * sn); q[80 + i] = bfr(y1 * sn + y2 * c); }
            _Pragma("unroll") for (int d = 0; d < 32; ++d) o[d] = 0.f;
            float m = -1e30f, lsum = 0.f;
            for (int key = 0; key < SEQ; ++key) { const size_t kt = (size_t)b * SEQ + key; float sc = 0.f;
                _Pragma("unroll") for (int d = 0; d < 64; ++d) sc += q[d] * bfv(kvc + kt * 512 + h * 128 + d);
                _Pragma("unroll") for (int d = 0; d < 32; ++d) sc += q[64 + d] * bfv(kr + kt * 32 + d);
                const float mn = fmaxf(m, sc), al = exp2f(m - mn), p = exp2f(sc - mn); m = mn; lsum = lsum * al + p;
                _Pragma("unroll") for (int d = 0; d < 32; ++d) o[d] = o[d] * al + p * bfv(kvc + kt * 512 + h * 128 + 64 + dofs + d); }
            bool bad = false; _Pragma("unroll") for (int d = 0; d < 32; ++d) bad |= !close_(bfv(yc + (size_t)t * 384 + h * 64 + dofs + d), o[d] / lsum, 0.03f, 0.003f);
            if (bad) DBG_FAIL(10);
        }
    }
    if (stage == 4) {
        const int n = h2 % 1024; float r = 0.f;
        { float a = 0.f; for (int k = 0; k < 384; ++k) a += bfv(ya + (size_t)t * 384 + k) * bfr(args.in[9][(size_t)k * 1024 + n]); r += a / (1.0f + expf(-bfv(hb + (size_t)t * DINP + H_GATE + n))); }
        { float a = 0.f; for (int k = 0; k < 384; ++k) a += bfv(yb + (size_t)t * 384 + k) * bfr(args.in[10][(size_t)k * 1024 + n]); r += a / (1.0f + expf(-bfv(hb + (size_t)t * DINP + H_GATE + 1024 + n))); }
        { float a = 0.f; for (int k = 0; k < 256; ++k) a += bfv(yc + (size_t)t * 384 + k) * bfr(args.in[11][(size_t)k * 1024 + n]); r += a / (1.0f + expf(-bfv(hb + (size_t)t * DINP + H_GATE + 2048 + n))); }
        if (!close_(bfv((const bf16*)(a2 + A2_MIXED) + (size_t)t * 1024 + n), r, 0.02f, 0.003f)) DBG_FAIL(11);
    }
    if (stage == 5) {
        const int n = h2 % 1024; float r = 0.f; const bf16* mx = (const bf16*)(a2 + A2_MIXED) + (size_t)t * 1024;
        for (int k = 0; k < 1024; ++k) r += bfv(mx + k) * bfr(args.in[12][(size_t)k * 1024 + n]);
        if (!close_(bfv((const bf16*)(ws + WS_X1) + (size_t)t * D + n), r, 0.02f, 0.002f)) DBG_FAIL(12);
    }
    if (stage == 6) {
        const bf16* x1 = (const bf16*)(ws + WS_X1B) + (size_t)t * D; const int* tok_e = (const int*)(ws + WS_TE); const int* tok_r = (const int*)(ws + WS_TR);
        const int* list_t = (const int*)(ws + WS_LT); const float* list_g = (const float*)(ws + WS_LG);
        float lg[32]; _Pragma("unroll") for (int e = 0; e < 32; ++e) lg[e] = args.in[16][e];
        for (int k = 0; k < 1024; ++k) { const float xv = bfv(x1 + k); _Pragma("unroll") for (int e = 0; e < 32; ++e) lg[e] += xv * args.in[15][(size_t)k * 32 + e]; }
        int se[4]; float sv[4]; unsigned used = 0;
        _Pragma("unroll") for (int r = 0; r < 4; ++r) { int be = -1; float bv = -INFINITY; _Pragma("unroll") for (int e = 0; e < 32; ++e) if (!((used >> e) & 1) && lg[e] > bv) { bv = lg[e]; be = e; } se[r] = be; sv[r] = bv; used |= 1u << be; }
        float fifth = -INFINITY; _Pragma("unroll") for (int e = 0; e < 32; ++e) if (!((used >> e) & 1)) fifth = fmaxf(fifth, lg[e]);
        const bool neartie = (sv[3] - fifth) < 3e-2f || (sv[0] - sv[1]) < 3e-2f || (sv[1] - sv[2]) < 3e-2f || (sv[2] - sv[3]) < 3e-2f;
        float den = 0.f; _Pragma("unroll") for (int r = 0; r < 4; ++r) den += expf(sv[r] - sv[0]);
        bool bad = false, badg = false;
        if (!neartie) _Pragma("unroll") for (int r = 0; r < 4; ++r) { const int e = tok_e[t * 4 + r], rk = tok_r[t * 4 + r]; if (e != se[r]) { bad = true; continue; }
            if (rk < 0 || rk >= LCAP || list_t[(size_t)e * LCAP + rk] != t) badg = true; else if (!close_(list_g[(size_t)e * LCAP + rk], expf(sv[r] - sv[0]) / den, 0.03f, 1e-3f)) badg = true; }
        if (bad) DBG_FAIL(13); if (badg) DBG_FAIL(14);
        { float sm = 0.f, sq = 0.f; for (int k = 0; k < 1024; ++k) { const float z = (bfv(x1 + k) - args.in[14][k]) / args.in[13][k]; sm += z; sq += z * z; }
          if (fabsf(sm / 1024.f) > 4e-3f || fabsf(sq / 1024.f - 1.0f) > 2e-2f) DBG_FAIL(19); }
    }
    if (stage >= 7 && stage <= 9) {
        __shared__ int st[33], cn[32];
        if (threadIdx.x == 0) { int a = 0; for (int e2 = 0; e2 < 32; ++e2) { cn[e2] = (int)((const unsigned*)(ws + WS_CTL))[CW_CNT + 64 * l + e2]; st[e2] = a; a += ((cn[e2] + 255) >> 8) << 8; } st[32] = a; }
        __syncthreads();
        const int total = st[32]; const int sl = h1 % total; int e = 0; for (int k = 1; k < 32; ++k) if (sl >= st[k]) e = k; const int r = sl - st[e];
        const int* list_t = (const int*)(ws + WS_LT); const float* list_g = (const float*)(ws + WS_LG); const float* sg = (const float*)(ws + WS_SG);
        if (stage == 7) { int sum = 0; for (int k = 0; k < 32; ++k) sum += cn[k]; if (sum != TK) DBG_FAIL(15); }
        if (stage == 7 && r < cn[e]) {
            const bf16* xg = (const bf16*)(ws + WS_X1B) + (size_t)list_t[(size_t)e * LCAP + r] * D; const int f = h2 % 1024; const float* W = args.in[17] + (size_t)e * 1024 * 2048;
            float g = args.in[18][e * 2048 + f], u = args.in[18][e * 2048 + 1024 + f];
            for (int k = 0; k < 1024; ++k) { const float xv = bfv(xg + k); g += xv * bfr(W[(size_t)k * 2048 + f]); u += xv * bfr(W[(size_t)k * 2048 + 1024 + f]); }
            g = fminf(g, 7.0f); u = fminf(fmaxf(u, -7.0f), 7.0f); const float ref = g / (1.0f + expf(-1.702f * g)) * (u + 1.0f);
            if (!close_(bfv((const bf16*)(ws + WS_A2) + (size_t)sl * 1024 + f), ref, 0.03f, 0.02f)) DBG_FAIL(16);
        }
        if (stage == 8 && r < cn[e]) {
            const bf16* ab = (const bf16*)(ws + WS_A2) + (size_t)sl * 1024; const int n = h2 % 1024; const float* W = args.in[19] + (size_t)e * 1024 * 1024;
            float y = args.in[20][e * 1024 + n]; for (int k = 0; k < 1024; ++k) y += bfv(ab + k) * bfr(W[(size_t)k * 1024 + n]);
            y *= list_g[(size_t)e * LCAP + r];
            if (!close_(bfv((const bf16*)(ws + WS_H) + (size_t)sl * 1024 + n), y, 0.03f, 0.005f)) DBG_FAIL(17);
        }
        if (stage == 9) {
            const bf16* x1 = (const bf16*)(ws + WS_X1B) + (size_t)t * D; const int* tok_e = (const int*)(ws + WS_TE); const int* tok_r = (const int*)(ws + WS_TR);
            const bf16* ybf = (const bf16*)(ws + WS_H); float sm = 0.f, sq = 0.f; const int n = h2 % 1024; float vn = 0.f;
            for (int k = 0; k < 1024; ++k) { float v = DN_ALPHA * bfv(x1 + k); for (int q = 0; q < 4; ++q) v += bfv(ybf + (size_t)(st[tok_e[t * 4 + q]] + tok_r[t * 4 + q]) * D + k); sm += v; sq += v * v; if (k == n) vn = v; }
            const float mean = sm / 1024.f, var = sq / 1024.f - mean * mean; const float ref = (vn - mean) / sqrtf(var + LN_EPS) * args.in[21][n] + args.in[22][n];
            if (!close_(((const float*)(ws + WS_X2))[(size_t)t * D + n], ref, 0.005f, 0.003f)) DBG_FAIL(18);
        }
    }
}
static void dbg_launch(int stage, const Args& a, hipStream_t stream) {
    switch (stage) {
#define DBGL(k) case k: hipLaunchKernelGGL(dbg_kernel<k>, dim3(8), dim3(256), 0, stream, a); break;
        DBGL(0) DBGL(1) DBGL(2) DBGL(3) DBGL(4) DBGL(5) DBGL(6) DBGL(7) DBGL(8) DBGL(9)
#undef DBGL
    }
}
#endif

extern "C" void kernel_launch(void* const* d_in, const int* in_sizes, int n_in, void* d_out, int out_size, void* d_ws, size_t ws_size, hipStream_t stream) {
    static int grid = 0;
    if (grid == 0) {
        if (n_in != 23 || in_sizes[0] != T * D || out_size != T * D || ws_size < WS_END) { fprintf(stderr, "kernel_launch: unexpected shapes / workspace (%d inputs, ws %zu, need %zu)\n", n_in, ws_size, (size_t)WS_END); grid = -1; return; }
        int dev = 0, cus = 0, per_cu = 0;
        if (hipGetDevice(&dev) != hipSuccess || hipDeviceGetAttribute(&cus, hipDeviceAttributeMultiprocessorCount, dev) != hipSuccess) { grid = -1; return; }
        if (hipFuncSetAttribute((const void*)mk_fwd, hipFuncAttributeMaxDynamicSharedMemorySize, LDS_BYTES) != hipSuccess) { fprintf(stderr, "kernel_launch: hipFuncSetAttribute failed\n"); grid = -1; return; }
        if (hipOccupancyMaxActiveBlocksPerMultiprocessor(&per_cu, (const void*)mk_fwd, NWAVES * 64, LDS_BYTES) != hipSuccess || per_cu < 1) { fprintf(stderr, "kernel_launch: occupancy query reports %d\n", per_cu); }
        (void)hipGetLastError();
        grid = cus;
    }
    if (grid < 0) return;
    if (hipMemsetAsync((char*)d_ws + WS_CTL, 0, CTL_ZERO_BYTES, stream) != hipSuccess) return;
    Args a{};
    for (int i = 0; i < 23; ++i) a.in[i] = (const float*)d_in[i];
    a.out = (float*)d_out; a.ws = (unsigned char*)d_ws; a.pad = 0;
#if MK_ONE_LAUNCH
    a.ph_lo = 0; a.ph_hi = NPH; a.use_bar = 1;
    hipLaunchKernelGGL(mk_fwd, dim3(grid), dim3(NWAVES * 64), LDS_BYTES, stream, a);
#else
    for (int p = 0; p < NPH; ++p) { a.ph_lo = p; a.ph_hi = p + 1; a.use_bar = 0; hipLaunchKernelGGL(mk_fwd, dim3(grid), dim3(NWAVES * 64), LDS_BYTES, stream, a);
#if MK_DEBUG
        if (p >= 1 && p <= PPL) dbg_launch(p - 1, a, stream);
#endif
    }
#endif
    const hipError_t le = hipPeekAtLastError();
    if (le != hipSuccess) fprintf(stderr, "kernel_launch: launch failed: %s\n", hipGetErrorName(le));
}
```

```cpp
#define MK_DEBUG 0
#define MK_ONE_LAUNCH 1
#include <hip/hip_runtime.h>
#include <hip/hip_bf16.h>
#include <cstdio>
#include <cstdint>
namespace pg8 {
#define PG8_LAS __attribute__((address_space(3)))
typedef unsigned short bf16_t;
typedef short bf16x8 __attribute__((ext_vector_type(8)));
typedef float f32x4 __attribute__((ext_vector_type(4)));
typedef unsigned u32x4 __attribute__((ext_vector_type(4)));
constexpr int BM = 256, BK = 64, HALF = 128, HTB = HALF * BK * 2  , STAGE_BYTES = 8 * HTB, NXCD = 8, WGM = 8;

__host__ __device__ __forceinline__ int lds_byte(int r, int c) { const int st = (r >> 4) * 2 + (c >> 5), rr = r & 15, cc = c & 31, ob = rr * 64 + cc * 2; return st * 1024 + (ob ^ (((ob >> 9) & 1) << 5)); }
__host__ __device__ __forceinline__ void stage_rc(int b, int& R, int& C) { const int st = b / 1024, sb = b % 1024, swz = sb ^ (((sb >> 9) & 1) << 5); R = (st >> 1) * 16 + swz / 64; C = (st & 1) * 32 + (swz % 64) / 2; }
__host__ __device__ __forceinline__ int perm32(int rho) { const int n = rho >> 4, i = rho & 15; return 8 * (i >> 2) + 4 * n + (i & 3); }

struct Unit { int pm, pn, e; };
struct Gemm { const bf16_t* A; const bf16_t* Bt; int M, N, K; size_t bstride; size_t astride; };

struct StaticOrder {
    int nM, nN, nwg, G, c;
    __host__ __device__ void init(int M, int N, int G_, int c_) { nM = M / BM; nN = N / BM; nwg = nM * nN; G = G_; c = c_; }
    __host__ __device__ bool next(int i, Unit& u) const {
        const long L = (long)i * G + c; if (L >= nwg) return false;
        int wgid = (int)L; { const int q = nwg / NXCD, r = nwg % NXCD, xcd = wgid % NXCD, off = wgid / NXCD; wgid = (xcd < r ? xcd * (q + 1) : r * (q + 1) + (xcd - r) * q) + off; }
        const int nig = WGM * nN, gid = wgid / nig, fm = gid * WGM, gsz = (nM - fm) < WGM ? (nM - fm) : WGM;
        u.pm = fm + ((wgid % nig) % gsz); u.pn = (wgid % nig) / gsz; u.e = 0; return true;
    }
    __device__ __forceinline__ void a_ready(const Unit&) const {}
    __device__ __forceinline__ void done(const Unit&) const {}
};

__device__ __forceinline__ unsigned cvt_pk_bf16(float lo, float hi) { unsigned r; asm volatile("v_cvt_pk_bf16_f32 %0, %1, %2" : "=v"(r) : "v"(lo), "v"(hi)); return r; }
typedef float f32x2 __attribute__((ext_vector_type(2)));


__device__ __forceinline__ float bf_lo(unsigned w) { return __uint_as_float(w << 16); }
__device__ __forceinline__ float bf_hi(unsigned w) { return __uint_as_float(w & 0xffff0000u); }
__device__ __forceinline__ float sigmoidf_(float z) { return __builtin_amdgcn_rcpf(1.0f + __builtin_amdgcn_exp2f(-1.4426950408889634f * z)); }
__device__ __forceinline__ u32x4 pack8(const f32x4& v0, const f32x4& v1) { u32x4 w; w.x = cvt_pk_bf16(v0[0], v0[1]); w.y = cvt_pk_bf16(v0[2], v0[3]); w.z = cvt_pk_bf16(v1[0], v1[1]); w.w = cvt_pk_bf16(v1[2], v1[3]); return w; }

struct EpiStore {
    static constexpr bool PERM = true, AFTER_DRAIN = false, CHAIN = false;
    bf16_t* O; int ldc; int nvalid;
    __device__ __forceinline__ void operator()(const f32x4 (&acc)[2][2][4][2], const Unit& u, int wr, int wc, int fr, int fq) const {
        const int row0 = u.pm * BM + wr * 64 + fr, col0 = u.pn * BM + wc * 32 + 8 * fq;
#pragma unroll
        for (int ai = 0; ai < 2; ++ai)
#pragma unroll
            for (int m = 0; m < 4; ++m) { bf16_t* rowp = O + (size_t)(row0 + ai * HALF + m * 16) * ldc + col0;
#pragma unroll
                for (int bj = 0; bj < 2; ++bj) { if (col0 + bj * HALF < nvalid) *(u32x4*)(rowp + bj * HALF) = pack8(acc[ai][bj][m][0], acc[ai][bj][m][1]); } }
    }
};
struct EpiGateChain {
    static constexpr bool PERM = true, AFTER_DRAIN = false, CHAIN = true;
    const bf16_t* gate; int ldg; bf16_t* mixed;
    __device__ __forceinline__ void chain(f32x4 (&acc)[2][2][4][2], const Unit& u, int wr, int wc, int fr, int fq) const {
        const int row0 = u.pm * BM + wr * 64 + fr, col0 = u.pn * BM + wc * 32 + 8 * fq;
#pragma unroll
        for (int ai = 0; ai < 2; ++ai)
#pragma unroll
            for (int m = 0; m < 4; ++m) { const size_t row = (size_t)(row0 + ai * HALF + m * 16);
#pragma unroll
                for (int bj = 0; bj < 2; ++bj) { const int col = col0 + bj * HALF;
                    const u32x4 ga = *(const u32x4*)(gate + row * ldg + u.e * 1024 + col);
                    f32x4 na0 = {1.f + __builtin_amdgcn_exp2f(-1.4426950408889634f * bf_lo(ga.x)), 1.f + __builtin_amdgcn_exp2f(-1.4426950408889634f * bf_hi(ga.x)), 1.f + __builtin_amdgcn_exp2f(-1.4426950408889634f * bf_lo(ga.y)), 1.f + __builtin_amdgcn_exp2f(-1.4426950408889634f * bf_hi(ga.y))};
                    f32x4 na1 = {1.f + __builtin_amdgcn_exp2f(-1.4426950408889634f * bf_lo(ga.z)), 1.f + __builtin_amdgcn_exp2f(-1.4426950408889634f * bf_hi(ga.z)), 1.f + __builtin_amdgcn_exp2f(-1.4426950408889634f * bf_lo(ga.w)), 1.f + __builtin_amdgcn_exp2f(-1.4426950408889634f * bf_hi(ga.w))};
                    f32x4 f0, f1;
#pragma unroll
                    for (int q = 0; q < 4; ++q) { f0[q] = __builtin_amdgcn_rcpf(na0[q]); f1[q] = __builtin_amdgcn_rcpf(na1[q]); }
                    if (u.e < 2) { const u32x4 gb = *(const u32x4*)(gate + row * ldg + (u.e + 1) * 1024 + col);
                        f0[0] *= 1.f + __builtin_amdgcn_exp2f(-1.4426950408889634f * bf_lo(gb.x)); f0[1] *= 1.f + __builtin_amdgcn_exp2f(-1.4426950408889634f * bf_hi(gb.x));
                        f0[2] *= 1.f + __builtin_amdgcn_exp2f(-1.4426950408889634f * bf_lo(gb.y)); f0[3] *= 1.f + __builtin_amdgcn_exp2f(-1.4426950408889634f * bf_hi(gb.y));
                        f1[0] *= 1.f + __builtin_amdgcn_exp2f(-1.4426950408889634f * bf_lo(gb.z)); f1[1] *= 1.f + __builtin_amdgcn_exp2f(-1.4426950408889634f * bf_hi(gb.z));
                        f1[2] *= 1.f + __builtin_amdgcn_exp2f(-1.4426950408889634f * bf_lo(gb.w)); f1[3] *= 1.f + __builtin_amdgcn_exp2f(-1.4426950408889634f * bf_hi(gb.w)); }
                    acc[ai][bj][m][0] *= f0; acc[ai][bj][m][1] *= f1;
                    if (u.e == 2) *(u32x4*)(mixed + row * 1024 + col) = pack8(acc[ai][bj][m][0], acc[ai][bj][m][1]); } }
    }
};
struct ChainOrder {
    StaticOrder so; int nch;
    __device__ __forceinline__ bool next(int i, Unit& u) const { const int t = i / nch; if (!so.next(t, u)) return false; u.e = i - t * nch; return true; }
    __device__ __forceinline__ void a_ready(const Unit&) const {}
    __device__ __forceinline__ void done(const Unit&) const {}
};
struct EpiResid {
    static constexpr bool PERM = true, AFTER_DRAIN = false, CHAIN = false;
    const float* x; float* pre; float alpha;
    __device__ __forceinline__ void operator()(const f32x4 (&acc)[2][2][4][2], const Unit& u, int wr, int wc, int fr, int fq) const {
        const int row0 = u.pm * BM + wr * 64 + fr, col0 = u.pn * BM + wc * 32 + 8 * fq;
#pragma unroll
        for (int ai = 0; ai < 2; ++ai)
#pragma unroll
            for (int m = 0; m < 4; ++m) { const size_t row = (size_t)(row0 + ai * HALF + m * 16);
#pragma unroll
                for (int bj = 0; bj < 2; ++bj) { const size_t off = row * 1024 + col0 + bj * HALF;
                    const f32x4 x0 = *(const f32x4*)(x + off), x1 = *(const f32x4*)(x + off + 4);
                    *(f32x4*)(pre + off) = x0 * alpha + acc[ai][bj][m][0]; *(f32x4*)(pre + off + 4) = x1 * alpha + acc[ai][bj][m][1]; } }
    }
};
struct EpiSwiglu {
    static constexpr bool PERM = true, AFTER_DRAIN = false, CHAIN = false;
    bf16_t* a; const float* bias;
    __device__ __forceinline__ void operator()(const f32x4 (&acc)[2][2][4][2], const Unit& u, int wr, int wc, int fr, int fq) const {
        const int row0 = u.pm * BM + wr * 64 + fr, j0 = wc * 32 + 8 * fq, oc = u.pn * HALF + j0;
        const float* bg = bias + (size_t)u.e * 2048 + oc; const float* bu = bg + 1024;
        const f32x4 bg0 = *(const f32x4*)bg, bg1 = *(const f32x4*)(bg + 4), bu0 = *(const f32x4*)bu, bu1 = *(const f32x4*)(bu + 4);
#pragma unroll
        for (int ai = 0; ai < 2; ++ai)
#pragma unroll
            for (int m = 0; m < 4; ++m) { const size_t row = (size_t)(row0 + ai * HALF + m * 16);
                f32x4 g[2] = {acc[ai][0][m][0] + bg0, acc[ai][0][m][1] + bg1}, uu[2] = {acc[ai][1][m][0] + bu0, acc[ai][1][m][1] + bu1}, r[2];
#pragma unroll
                for (int n = 0; n < 2; ++n)
#pragma unroll
                    for (int q = 0; q < 4; ++q) { const float gg = fminf(g[n][q], 7.0f), uc = fminf(fmaxf(uu[n][q], -7.0f), 7.0f);
                        r[n][q] = gg * sigmoidf_(1.702f * gg) * (uc + 1.0f); }
                *(u32x4*)(a + row * 1024 + oc) = pack8(r[0], r[1]); }
    }
};
struct EpiDown {
    static constexpr bool PERM = true, AFTER_DRAIN = false, CHAIN = false;
    bf16_t* y; const float* bias; const float* list_g; const PG8_LAS int* st; const PG8_LAS int* cn; int lcap;
    __device__ __forceinline__ void operator()(const f32x4 (&acc)[2][2][4][2], const Unit& u, int wr, int wc, int fr, int fq) const {
        const int row0 = u.pm * BM + wr * 64 + fr, col0 = u.pn * BM + wc * 32 + 8 * fq;
        const int st_e = st[u.e], cn_e = cn[u.e];
        f32x4 bv[2][2];
#pragma unroll
        for (int bj = 0; bj < 2; ++bj)
#pragma unroll
            for (int n = 0; n < 2; ++n) bv[bj][n] = *(const f32x4*)(bias + (size_t)u.e * 1024 + col0 + bj * HALF + 4 * n);
#pragma unroll
        for (int ai = 0; ai < 2; ++ai)
#pragma unroll
            for (int m = 0; m < 4; ++m) { const size_t row = (size_t)(row0 + ai * HALF + m * 16); const int rank = (int)row - st_e;
                const float gt = rank < cn_e ? list_g[(size_t)u.e * lcap + rank] : 0.f;
#pragma unroll
                for (int bj = 0; bj < 2; ++bj) { const f32x4 v0 = (acc[ai][bj][m][0] + bv[bj][0]) * gt, v1 = (acc[ai][bj][m][1] + bv[bj][1]) * gt;
                    *(u32x4*)(y + row * 1024 + col0 + bj * HALF) = pack8(v0, v1); } }
    }
};
struct MoeGather {
    const int* list_t; const PG8_LAS int* st; const PG8_LAS int* cn; int lcap;
    __device__ __forceinline__ int row(const Unit& u, int r) const { int rank = u.pm * BM + r - st[u.e]; const int c = cn[u.e]; rank = rank < c ? rank : c - 1; return list_t[(size_t)u.e * lcap + rank]; }
};
struct MoeOrder {
    int nN, nunits, G, c; const PG8_LAS int* tile_e;
    __device__ __forceinline__ bool next(int i, Unit& u) const {
        const long L = (long)i * G + c; if (L >= nunits) return false;
        const int tile = (int)L / nN; u.pm = tile; u.pn = (int)L % nN; u.e = __builtin_amdgcn_readfirstlane(tile_e[tile]); return true;
    }
    __device__ __forceinline__ void a_ready(const Unit&) const {}
    __device__ __forceinline__ void done(const Unit&) const {}
};

struct NoGather { };
template <class Epi, class Sched, bool ALIGN_EPI = false, bool SP2 = false, bool GATHER = false, class GS = NoGather>
__device__ __forceinline__ void gemm_phase(PG8_LAS unsigned char* lds, const Gemm g, const Sched& S, const Epi& E, const int tid, const GS gs = GS()) {
    const int wid = __builtin_amdgcn_readfirstlane(tid >> 6), lane = tid & 63, wr = wid >> 2, wc = wid & 3, fr = lane & 15, fq = lane >> 4;
    const int K = g.K, nt = K / BK;
    unsigned voffA[2], voffB[2];
#pragma unroll
    for (int i = 0; i < 2; ++i) { int R, C; stage_rc(tid * 16 + i * 8192, R, C); const int Rb = Epi::PERM ? ((R & ~31) + perm32(R & 31)) : R;
        voffA[i] = (unsigned)(R * K + C) * 2u; voffB[i] = (unsigned)(Rb * K + C) * 2u; }
    unsigned vc0[2], vc1[2], vn0[2], vn1[2];
#define PG8_GROWS(u_, o0, o1) do { _Pragma("unroll") for (int i_ = 0; i_ < 2; ++i_) { int R_, C_; stage_rc(tid * 16 + i_ * 8192, R_, C_); \
        o0[i_] = (unsigned)gs.row((u_), R_) * (unsigned)(K * 2) + (unsigned)(C_ * 2); o1[i_] = (unsigned)gs.row((u_), HALF + R_) * (unsigned)(K * 2) + (unsigned)(C_ * 2); } } while (0)
    const size_t kstep = (size_t)(BK * 2);
    const size_t hstep = (size_t)HALF * K * 2;
    const size_t tstep = 2 * hstep;
    const unsigned ldsw = (unsigned)wid * 1024u;
    const int aoff = lds_byte(wr * 64 + fr, fq * 8), boff = lds_byte(wc * 32 + fr, fq * 8);
#define PG8_SA(b, h) (((b) * 2 + (h)) * HTB)
#define PG8_SB(b, h) ((4 + (b) * 2 + (h)) * HTB)
#define PG8_STAGE(bufoff, gbase, voff) do { _Pragma("unroll") for (int _i = 0; _i < 2; ++_i) \
        __builtin_amdgcn_global_load_lds((const unsigned*)((const char*)(gbase) + (voff)[_i]), (PG8_LAS unsigned*)(lds + (bufoff) + ldsw + _i * 8192), 16, 0, 0); } while (0)
#define PG8_LDA(dst, b, h) do { _Pragma("unroll") for (int m = 0; m < 4; ++m) _Pragma("unroll") for (int k = 0; k < 2; ++k) dst[m][k] = *(const PG8_LAS bf16x8*)(lds + PG8_SA(b, h) + aoff + m * 2048 + k * 1024); } while (0)
#define PG8_LDB(dst, b, h) do { _Pragma("unroll") for (int n = 0; n < 2; ++n) _Pragma("unroll") for (int k = 0; k < 2; ++k) dst[n][k] = *(const PG8_LAS bf16x8*)(lds + PG8_SB(b, h) + boff + n * 2048 + k * 1024); } while (0)
#define PG8_MMA(ai, bj, At, Bt) do { __builtin_amdgcn_s_setprio(1); _Pragma("unroll") for (int m = 0; m < 4; ++m) _Pragma("unroll") for (int n = 0; n < 2; ++n) _Pragma("unroll") for (int k = 0; k < 2; ++k) \
        acc[ai][bj][m][n] = __builtin_amdgcn_mfma_f32_16x16x32_bf16(Bt[n][k], At[m][k], acc[ai][bj][m][n], 0, 0, 0); __builtin_amdgcn_s_setprio(0); } while (0)
#define PG8_WAIT_V(n) asm volatile("s_waitcnt vmcnt(" #n ")" ::: "memory")
#define PG8_WAIT_L(n) asm volatile("s_waitcnt lgkmcnt(" #n ")" ::: "memory")
#define PG8_BAR __builtin_amdgcn_s_barrier()
#define PG8_SCHED __builtin_amdgcn_sched_barrier(0)
    Unit cur, nxt; int ui = 0;
    if (!S.next(0, cur)) return;
    f32x4 acc[2][2][4][2];
#pragma unroll
    for (int a = 0; a < 2; ++a)
#pragma unroll
        for (int b = 0; b < 2; ++b)
#pragma unroll
            for (int m = 0; m < 4; ++m)
#pragma unroll
                for (int n = 0; n < 2; ++n) acc[a][b][m][n] = (f32x4){0.f, 0.f, 0.f, 0.f};
    bf16x8 At[4][2], B0[2][2], B1[2][2];
    const char* cA = GATHER ? (const char*)g.A : (const char*)g.A + (size_t)cur.pm * tstep + (size_t)cur.e * g.astride;
    if constexpr (GATHER) { PG8_GROWS(cur, vc0, vc1); } else { _Pragma("unroll") for (int i = 0; i < 2; ++i) { vc0[i] = voffA[i]; vc1[i] = voffA[i] + (unsigned)hstep; } }
#pragma unroll
    for (int i = 0; i < 2; ++i) { vn0[i] = vc0[i]; vn1[i] = vc1[i]; }
    const char* cB = (const char*)g.Bt + (size_t)cur.pn * tstep + (size_t)cur.e * g.bstride;
    S.a_ready(cur);
    if constexpr (SP2) {
        PG8_STAGE(PG8_SB(0, 0), cB, voffB); PG8_STAGE(PG8_SB(0, 1), cB + hstep, voffB); PG8_STAGE(PG8_SA(0, 0), cA, vc0); PG8_STAGE(PG8_SA(0, 1), cA, vc1);
        if (wr == 1) PG8_BAR;
        PG8_WAIT_V(2); PG8_BAR;
        PG8_STAGE(PG8_SB(1, 0), cB + kstep, voffB); PG8_STAGE(PG8_SA(1, 0), cA + kstep, vc0); PG8_STAGE(PG8_SB(1, 1), cB + hstep + kstep, voffB);
        PG8_WAIT_V(6); PG8_BAR;
    } else {
        PG8_STAGE(PG8_SB(0, 0), cB, voffB); PG8_STAGE(PG8_SA(0, 0), cA, vc0); PG8_STAGE(PG8_SB(0, 1), cB + hstep, voffB); PG8_STAGE(PG8_SA(0, 1), cA, vc1);
        if (wr == 1) PG8_BAR;
        PG8_WAIT_V(4); PG8_BAR;
        PG8_STAGE(PG8_SB(1, 0), cB + kstep, voffB); PG8_STAGE(PG8_SA(1, 0), cA + kstep, vc0); PG8_STAGE(PG8_SB(1, 1), cB + hstep + kstep, voffB);
        PG8_WAIT_V(6); PG8_BAR;
    }
    for (;;) {
        const bool has_next = S.next(ui + 1, nxt);
        const char* nA = GATHER ? cA : (has_next ? (const char*)g.A + (size_t)nxt.pm * tstep + (size_t)nxt.e * g.astride : cA);
        if constexpr (GATHER) { if (has_next) { PG8_GROWS(nxt, vn0, vn1); } } const char* nB = has_next ? (const char*)g.Bt + (size_t)nxt.pn * tstep + (size_t)nxt.e * g.bstride : cB;
        for (int t = 0; t < nt; t += 2) {
            const bool last = (t == nt - 2);
            const char* a1 = cA + (size_t)(t + 1) * kstep;
            const char* a2 = last ? nA : cA + (size_t)(t + 2) * kstep; const char* b2 = last ? nB : cB + (size_t)(t + 2) * kstep;
            const char* a3 = a2 + kstep; const char* b3 = b2 + kstep;
            unsigned vs0[2], vs1[2];
#pragma unroll
            for (int i = 0; i < 2; ++i) { vs0[i] = (GATHER && last) ? vn0[i] : vc0[i]; vs1[i] = (GATHER && last) ? vn1[i] : vc1[i]; }
            if (last && has_next) S.a_ready(nxt);
            if constexpr (SP2) {
            PG8_LDB(B0, 0, 0); PG8_LDB(B1, 0, 1); PG8_SCHED; PG8_LDA(At, 0, 0); PG8_STAGE(PG8_SA(1, 1), a1, vc1);
            PG8_WAIT_V(8); PG8_WAIT_L(0); PG8_BAR; PG8_MMA(0, 0, At, B0); PG8_MMA(0, 1, At, B1); PG8_BAR; PG8_SCHED;
            PG8_LDA(At, 0, 1); PG8_STAGE(PG8_SB(0, 0), b2, voffB); PG8_STAGE(PG8_SB(0, 1), b2 + hstep, voffB); PG8_STAGE(PG8_SA(0, 0), a2, vs0);
            PG8_WAIT_V(8); PG8_WAIT_L(0); PG8_BAR; PG8_MMA(1, 0, At, B0); PG8_MMA(1, 1, At, B1); PG8_BAR; PG8_SCHED;
            PG8_LDB(B0, 1, 0); PG8_LDB(B1, 1, 1); PG8_SCHED; PG8_LDA(At, 1, 0); PG8_STAGE(PG8_SA(0, 1), a2, vs1);
            PG8_WAIT_V(8); PG8_WAIT_L(0); PG8_BAR; PG8_MMA(0, 0, At, B0); PG8_MMA(0, 1, At, B1); PG8_BAR; PG8_SCHED;
            PG8_LDA(At, 1, 1); PG8_STAGE(PG8_SB(1, 0), b3, voffB); PG8_STAGE(PG8_SB(1, 1), b3 + hstep, voffB); PG8_STAGE(PG8_SA(1, 0), a3, vs0);
            PG8_WAIT_V(8); PG8_WAIT_L(0); PG8_BAR; PG8_MMA(1, 0, At, B0); PG8_MMA(1, 1, At, B1); PG8_BAR; PG8_SCHED;
            } else {
            PG8_LDB(B0, 0, 0); PG8_SCHED; PG8_LDA(At, 0, 0); PG8_STAGE(PG8_SA(1, 1), a1, vc1);
            PG8_WAIT_L(8); PG8_BAR; PG8_WAIT_L(0); PG8_MMA(0, 0, At, B0); PG8_BAR; PG8_SCHED;
            PG8_LDB(B1, 0, 1); PG8_STAGE(PG8_SB(0, 0), b2, voffB);
            PG8_BAR; PG8_WAIT_L(0); PG8_MMA(0, 1, At, B1); PG8_BAR;
            PG8_LDA(At, 0, 1); PG8_STAGE(PG8_SA(0, 0), a2, vs0);
            PG8_BAR; PG8_WAIT_L(0); PG8_MMA(1, 0, At, B0); PG8_BAR; PG8_SCHED;
            PG8_STAGE(PG8_SB(0, 1), b2 + hstep, voffB);
            PG8_WAIT_V(6); PG8_BAR; PG8_MMA(1, 1, At, B1); PG8_BAR;
            PG8_LDB(B0, 1, 0); PG8_SCHED; PG8_LDA(At, 1, 0); PG8_STAGE(PG8_SA(0, 1), a2, vs1);
            PG8_WAIT_L(8); PG8_BAR; PG8_WAIT_L(0); PG8_MMA(0, 0, At, B0); PG8_BAR; PG8_SCHED;
            PG8_LDB(B1, 1, 1); PG8_STAGE(PG8_SB(1, 0), b3, voffB);
            PG8_BAR; PG8_WAIT_L(0); PG8_MMA(0, 1, At, B1); PG8_BAR;
            PG8_LDA(At, 1, 1); PG8_STAGE(PG8_SA(1, 0), a3, vs0);
            PG8_BAR; PG8_WAIT_L(0); PG8_MMA(1, 0, At, B0); PG8_BAR; PG8_SCHED;
            PG8_STAGE(PG8_SB(1, 1), b3 + hstep, voffB);
            PG8_WAIT_V(6); PG8_BAR; PG8_MMA(1, 1, At, B1); PG8_BAR;
            }
        }
        if constexpr (ALIGN_EPI) { if (wr == 0) PG8_BAR; }
        if constexpr (!Epi::AFTER_DRAIN) { if constexpr (Epi::CHAIN) E.chain(acc, cur, wr, wc, fr, fq); else E(acc, cur, wr, wc, fr, fq); S.done(cur); }
        if (!has_next) break;
        if (!(Epi::CHAIN && nxt.e != 0)) {
#pragma unroll
        for (int a = 0; a < 2; ++a)
#pragma unroll
            for (int b = 0; b < 2; ++b)
#pragma unroll
                for (int m = 0; m < 4; ++m)
#pragma unroll
                    for (int n = 0; n < 2; ++n) acc[a][b][m][n] = (f32x4){0.f, 0.f, 0.f, 0.f};
        }
        cur = nxt; cA = nA; cB = nB; ++ui;
        if constexpr (GATHER) { _Pragma("unroll") for (int i = 0; i < 2; ++i) { vc0[i] = vn0[i]; vc1[i] = vn1[i]; } }
        if constexpr (ALIGN_EPI) { if (wr == 1) PG8_BAR; }
    }
    PG8_WAIT_V(0);
    if constexpr (!ALIGN_EPI) { if (wr == 0) PG8_BAR; }
    PG8_BAR;
    if constexpr (Epi::AFTER_DRAIN) { E.fused(acc, cur, wr, wc, fr, fq, lds, wid, lane); S.done(cur); }
#undef PG8_GROWS
#undef PG8_SA
#undef PG8_SB
#undef PG8_STAGE
#undef PG8_LDA
#undef PG8_LDB
#undef PG8_MMA
#undef PG8_WAIT_V
#undef PG8_WAIT_L
#undef PG8_BAR
#undef PG8_SCHED
}
}


namespace att {
typedef unsigned short bf16_t;
typedef short bf16x8 __attribute__((ext_vector_type(8)));
typedef short s16x4 __attribute__((ext_vector_type(4)));
typedef float f32x16 __attribute__((ext_vector_type(16)));
typedef unsigned u32x4 __attribute__((ext_vector_type(4)));
#define ALAS __attribute__((address_space(3)))
typedef ALAS unsigned char* ALAS_PTR;
#define ASBAR() __builtin_amdgcn_sched_barrier(0)
constexpr int QBLK = 32, KVBLK = 64;
constexpr float THR2 = 11.0f;
constexpr float LOG2E = 1.4426950408889634f, INV2PI = 0.15915494309189535f, LOG2_THETA = 13.287712379549449f;
constexpr int OFF_V = 0, VBUF = 8192, OFF_K = 16384, KBUF_MAX = 13312, OFF_WS = OFF_K + 2 * KBUF_MAX  , OFF_BIAS = OFF_WS + 2048  , ATT_LDS = OFF_BIAS + 2048;
__device__ __forceinline__ int crow(int r, int hi) { return (r & 3) + 8 * (r >> 2) + 4 * hi; }
__device__ __forceinline__ unsigned cvtpk(float lo, float hi) { unsigned r; asm volatile("v_cvt_pk_bf16_f32 %0, %1, %2" : "=v"(r) : "v"(lo), "v"(hi)); return r; }
__device__ __forceinline__ float bf2f(short s) { return __uint_as_float(((unsigned)(unsigned short)s) << 16); }
__device__ __forceinline__ short f2bf_s(float f) { return (short)(cvtpk(f, 0.f) & 0xffffu); }

struct UnitP {
    const bf16_t* Q; int ldq;
    const bf16_t* K0; int ldk0;
    const bf16_t* K1; int ldk1;
    const bf16_t* V; int ldv;
    bf16_t* O; int ldo;
    int nt;
    int grow0;
    const float* gain;
    int kr0;
    float cref;
};

typedef short v4i16_t __attribute__((ext_vector_type(4)));
__device__ __forceinline__ s16x4 vtr(const ALAS unsigned char* p) { return __builtin_bit_cast(s16x4, __builtin_amdgcn_ds_read_tr16_b64_v4i16((ALAS v4i16_t*)p)); }
__device__ __forceinline__ void pv_all(f32x16& o0, f32x16& o1, f32x16& lacc, const ALAS unsigned char* vp, bf16x8 pa0, bf16x8 pa1, bf16x8 pa2, bf16x8 pa3) {
    const bf16x8 ones = {(short)0x3F80, (short)0x3F80, (short)0x3F80, (short)0x3F80, (short)0x3F80, (short)0x3F80, (short)0x3F80, (short)0x3F80};
#define ATT_PK(L, H) (bf16x8){L[0], L[1], L[2], L[3], H[0], H[1], H[2], H[3]}
#define ATT_STEP(KS, PA) { const s16x4 l0 = vtr(vp + (KS) * 1024), h0 = vtr(vp + (KS) * 1024 + 512), l1 = vtr(vp + 4096 + (KS) * 1024), h1 = vtr(vp + 4096 + (KS) * 1024 + 512); \
        o0 = __builtin_amdgcn_mfma_f32_32x32x16_bf16(PA, ATT_PK(l0, h0), o0, 0, 0, 0); o1 = __builtin_amdgcn_mfma_f32_32x32x16_bf16(PA, ATT_PK(l1, h1), o1, 0, 0, 0); \
        lacc = __builtin_amdgcn_mfma_f32_32x32x16_bf16(PA, ones, lacc, 0, 0, 0); }
    ATT_STEP(0, pa0) ATT_STEP(1, pa1) ATT_STEP(2, pa2) ATT_STEP(3, pa3)
#undef ATT_STEP
#undef ATT_PK
}
template <int DQK> __device__ __forceinline__ void qkt(f32x16& p0, f32x16& p1, const ALAS unsigned char* Ks, const bf16x8* qr, const f32x16& cinit, int r32, int hi) {
    constexpr int KST = DQK * 2 + 16;
#pragma unroll
    for (int d0 = 0; d0 < DQK / 16; ++d0) { const int cb = (2 * d0 + hi) * 16;
        const bf16x8 b0 = *(const ALAS bf16x8*)(Ks + r32 * KST + cb);
        const bf16x8 b1 = *(const ALAS bf16x8*)(Ks + (32 + r32) * KST + cb);
        if (d0 == 0) { p0 = __builtin_amdgcn_mfma_f32_32x32x16_bf16(b0, qr[0], cinit, 0, 0, 0); p1 = __builtin_amdgcn_mfma_f32_32x32x16_bf16(b1, qr[0], cinit, 0, 0, 0); }
        else { p0 = __builtin_amdgcn_mfma_f32_32x32x16_bf16(b0, qr[d0], p0, 0, 0, 0); p1 = __builtin_amdgcn_mfma_f32_32x32x16_bf16(b1, qr[d0], p1, 0, 0, 0); } }
}
__device__ __forceinline__ void na_mask(f32x16& p0, f32x16& p1, const ALAS float* btab, int kr, int rq, int qc_in, int hi_in) {
    int qc = qc_in, hi = hi_in; asm volatile("" : "+v"(qc), "+v"(hi));
    int r0 = rq - 4; r0 = r0 < 0 ? 0 : (r0 > 120 ? 120 : r0);
    const bool rowok = (kr >= r0) && (kr < r0 + 8);
    int c0 = qc - 8; c0 = c0 < 0 ? 0 : (c0 > 48 ? 48 : c0);
    int dr = kr - rq + 7; dr = dr < 0 ? 0 : (dr > 14 ? 14 : dr);
    const ALAS float* brow = btab + dr * 31;
#pragma unroll
    for (int r = 0; r < 16; ++r) {
        const int ka = crow(r, hi), kb = 32 + ka;
        int ia = ka - qc + 15; ia = ia < 0 ? 0 : (ia > 30 ? 30 : ia);
        int ib = kb - qc + 15; ib = ib < 0 ? 0 : (ib > 30 ? 30 : ib);
        const bool oka = rowok && (ka >= c0) && (ka < c0 + 16), okb = rowok && (kb >= c0) && (kb < c0 + 16);
        p0[r] = oka ? p0[r] + brow[ia] : -1e30f;
        p1[r] = okb ? p1[r] + brow[ib] : -1e30f;
    }
}
__device__ __forceinline__ void lazySM(f32x16& p0, f32x16& p1, float& m_reg, bool& moved, float& alpha) {
    float pmax = p0[0];
#pragma unroll
    for (int r = 1; r < 16; ++r) pmax = fmaxf(pmax, p0[r]);
#pragma unroll
    for (int r = 0; r < 16; ++r) pmax = fmaxf(pmax, p1[r]);
    { auto rr = __builtin_amdgcn_permlane32_swap(__float_as_uint(pmax), __float_as_uint(pmax), false, false);
      pmax = fmaxf(__uint_as_float(rr[0]), __uint_as_float(rr[1])); }
    if (__builtin_expect(__all(pmax <= THR2), 1)) { alpha = 1.f; }
    else { const float dl = fmaxf(pmax, 0.f); m_reg += dl; alpha = __builtin_amdgcn_exp2f(-dl);
#pragma unroll
        for (int r = 0; r < 16; ++r) { p0[r] -= dl; p1[r] -= dl; }
        moved = true; }
#pragma unroll
    for (int r = 0; r < 16; ++r) p0[r] = __builtin_amdgcn_exp2f(p0[r]);
}
__device__ __forceinline__ void fixedSM(f32x16& p0) {
#pragma unroll
    for (int r = 0; r < 16; ++r) p0[r] = __builtin_amdgcn_exp2f(p0[r]);
}
__device__ __forceinline__ void finishSM(f32x16& p0, f32x16& p1, bf16x8& pa0, bf16x8& pa1, bf16x8& pa2, bf16x8& pa3) {
#pragma unroll
    for (int r = 0; r < 16; ++r) p1[r] = __builtin_amdgcn_exp2f(p1[r]);
    u32x4 w;
    w = (u32x4){cvtpk(p0[0], p0[1]), cvtpk(p0[2], p0[3]), cvtpk(p0[4], p0[5]), cvtpk(p0[6], p0[7])}; pa0 = __builtin_bit_cast(bf16x8, w);
    w = (u32x4){cvtpk(p0[8], p0[9]), cvtpk(p0[10], p0[11]), cvtpk(p0[12], p0[13]), cvtpk(p0[14], p0[15])}; pa1 = __builtin_bit_cast(bf16x8, w);
    w = (u32x4){cvtpk(p1[0], p1[1]), cvtpk(p1[2], p1[3]), cvtpk(p1[4], p1[5]), cvtpk(p1[6], p1[7])}; pa2 = __builtin_bit_cast(bf16x8, w);
    w = (u32x4){cvtpk(p1[8], p1[9]), cvtpk(p1[10], p1[11]), cvtpk(p1[12], p1[13]), cvtpk(p1[14], p1[15])}; pa3 = __builtin_bit_cast(bf16x8, w);
}
struct NoSide { static constexpr bool PLAIN = true; template <int P> __device__ __forceinline__ void step() {} };
template <int DQK, int MODE, class SIDE = NoSide>
__device__ __forceinline__ void attn_unit(const UnitP& u, ALAS unsigned char* lds, const int tid, SIDE& side) {
    constexpr int ND = DQK / 16, KST = DQK * 2 + 16, KBUF = 64 * KST;
    static_assert(KBUF <= KBUF_MAX, "K buffer");
    const int wid = __builtin_amdgcn_readfirstlane(tid >> 6), lane = tid & 63, r32 = lane & 31, hi = lane >> 5;
    ALAS unsigned char* V_lds = lds + OFF_V; ALAS unsigned char* K_lds = lds + OFF_K;
    ALAS float* ws = (ALAS float*)(lds + OFF_WS) + wid * 64; ALAS float* al_l = ws + 32;
    const ALAS float* btab = (const ALAS float*)(lds + OFF_BIAS);
    float m_reg = 0.f; f32x16 o[2], lacc; o[0] = f32x16{}; o[1] = f32x16{}; lacc = f32x16{}; bf16x8 qr[ND];
    bool moved = false;
    const int grow = u.grow0 + (wid >> 1), gcol = (wid & 1) * 32 + r32;
    {
        const bf16_t* Qw = u.Q + (size_t)(wid * QBLK + r32) * u.ldq + hi * 8;
#pragma unroll
        for (int d0 = 0; d0 < ND; ++d0) qr[d0] = *(const bf16x8*)(Qw + d0 * 16);
        if constexpr (MODE == 0 || MODE == 3) {
            float x[4][8]; float ssq = 0.f;
#pragma unroll
            for (int d0 = 0; d0 < 4; ++d0)
#pragma unroll
                for (int j = 0; j < 8; ++j) { x[d0][j] = bf2f(qr[d0][j]); ssq += x[d0][j] * x[d0][j]; }
            { auto rr_ = __builtin_amdgcn_permlane32_swap(__float_as_uint(ssq), __float_as_uint(ssq), false, false); ssq = __uint_as_float(rr_[0]) + __uint_as_float(rr_[1]); }
            const float rstd = 1.0f / sqrtf(ssq * (1.0f / 64.0f) + 1e-6f);
#pragma unroll
            for (int d0 = 0; d0 < 4; ++d0)
#pragma unroll
                for (int j = 0; j < 8; ++j) x[d0][j] = x[d0][j] * rstd * u.gain[16 * d0 + 8 * hi + j];
#pragma unroll
            for (int d0 = 0; d0 < 2; ++d0)
#pragma unroll
                for (int j = 0; j < 8; ++j) { const float inv = exp2f(-(float)(8 * hi + j) * (LOG2_THETA / 16.0f));
                    const float ang = (float)(d0 == 0 ? grow : gcol) * inv * INV2PI; const float c = __builtin_amdgcn_cosf(ang), s = __builtin_amdgcn_sinf(ang);
                    const float y1 = x[d0][j], y2 = x[d0 + 2][j]; x[d0][j] = y1 * c - y2 * s; x[d0 + 2][j] = y1 * s + y2 * c; }
            constexpr float C2 = 0.125f * LOG2E;
#pragma unroll
            for (int d0 = 0; d0 < 4; ++d0) { u32x4 w = {cvtpk(x[d0][0] * C2, x[d0][1] * C2), cvtpk(x[d0][2] * C2, x[d0][3] * C2), cvtpk(x[d0][4] * C2, x[d0][5] * C2), cvtpk(x[d0][6] * C2, x[d0][7] * C2)};
                qr[d0] = __builtin_bit_cast(bf16x8, w); }
        }
        if constexpr (MODE == 1) {
            float y1[8], y2[8];
#pragma unroll
            for (int j = 0; j < 8; ++j) { const float inv = exp2f(-(float)j * (LOG2_THETA / 8.0f));
                const float ang = (float)(hi == 0 ? grow : gcol) * inv * INV2PI; const float c = __builtin_amdgcn_cosf(ang), s = __builtin_amdgcn_sinf(ang);
                const float a = bf2f(qr[4][j]), b = bf2f(qr[5][j]); y1[j] = a * c - b * s; y2[j] = a * s + b * c; }
            u32x4 w = {cvtpk(y1[0], y1[1]), cvtpk(y1[2], y1[3]), cvtpk(y1[4], y1[5]), cvtpk(y1[6], y1[7])}; qr[4] = __builtin_bit_cast(bf16x8, w);
            w = (u32x4){cvtpk(y2[0], y2[1]), cvtpk(y2[2], y2[3]), cvtpk(y2[4], y2[5]), cvtpk(y2[6], y2[7])}; qr[5] = __builtin_bit_cast(bf16x8, w);
        }
    }
    const int sk = tid >> 3, sc = tid & 7;
    const bf16_t* vsrc = u.V + (size_t)sk * u.ldv + sc * 8; const bf16_t* ksrc = u.K0 + (size_t)sk * u.ldk0 + sc * 8;
    const int vst = (sc >> 2) * 4096 + sk * 64 + (sc & 3) * 16, kst = sk * KST + sc * 16;
    const int sk2 = (tid & 255) >> 2, sc2 = tid & 3;
    const bf16_t* k2src = (DQK == 96) ? u.K1 + (size_t)sk2 * u.ldk1 + sc2 * 8 : nullptr;
    const int k2st = sk2 * KST + (8 + sc2) * 16;
    const ALAS unsigned char* vb0 = V_lds + ((lane >> 4) & 1) * 32 + (lane & 3) * 8 + (4 * hi + ((lane & 15) >> 2)) * 64;
    struct { bf16x8 v, k, k2; } sr_[2];
#define ATT_SLOAD(i, k0) do { sr_[i].v = *(const bf16x8*)(vsrc + (size_t)(k0) * u.ldv); sr_[i].k = *(const bf16x8*)(ksrc + (size_t)(k0) * u.ldk0); \
        if constexpr (DQK == 96) sr_[i].k2 = *(const bf16x8*)(k2src + (size_t)(k0) * u.ldk1); } while (0)
#define ATT_SWRITE(b, i) do { *(ALAS bf16x8*)(V_lds + (b) * VBUF + vst) = sr_[i].v; *(ALAS bf16x8*)(K_lds + (b) * KBUF + kst) = sr_[i].k; \
        if constexpr (DQK == 96) *(ALAS bf16x8*)(K_lds + (b) * KBUF + k2st) = sr_[i].k2; } while (0)
#define ATT_SWAIT() do { if constexpr (SIDE::PLAIN) { if constexpr (DQK == 96) asm volatile("s_waitcnt vmcnt(3)" ::: "memory"); else asm volatile("s_waitcnt vmcnt(2)" ::: "memory"); } } while (0)
#define ATT_RESC(a) do { if constexpr (MODE != 0) { if (__any((a) < 1.f)) { if (hi == 0) al_l[r32] = (a); asm volatile("s_waitcnt lgkmcnt(0)" ::: "memory"); \
        _Pragma("unroll") for (int r = 0; r < 16; ++r) { const float f_ = al_l[crow(r, hi)]; o[0][r] *= f_; o[1][r] *= f_; lacc[r] *= f_; } } } } while (0)
#define ATT_SM(P0, P1, AL) do { if constexpr (MODE == 0) { fixedSM(P0); AL = 1.f; } else lazySM(P0, P1, m_reg, moved, AL); } while (0)
#define ATT_QKT(P0, P1, KS) do { if (MODE != 0 && moved) { f32x16 ng_; _Pragma("unroll") for (int r_ = 0; r_ < 16; ++r_) ng_[r_] = -m_reg; qkt<DQK>(P0, P1, KS, qr, ng_, r32, hi); } \
        else { const f32x16 z_ = f32x16{}; qkt<DQK>(P0, P1, KS, qr, z_, r32, hi); } } while (0)
#define ATT_PV(VB) pv_all(o[0], o[1], lacc, (VB), pa0, pa1, pa2, pa3)
#define ATT_MASK(P0, P1, j) do { if constexpr (MODE == 2) na_mask(P0, P1, btab, u.kr0 + (j), grow, gcol, hi); } while (0)
    f32x16 pA0, pA1, pB0, pB1; float alA, alB; bf16x8 pa0, pa1, pa2, pa3; const int NT = u.nt;
    constexpr int SE = 0, SO = 1;
    ATT_SLOAD(SE, 0); asm volatile("s_waitcnt vmcnt(0)" ::: "memory"); ATT_SWRITE(0, SE); __syncthreads();
    ATT_QKT(pA0, pA1, K_lds); ATT_MASK(pA0, pA1, 0); ATT_SM(pA0, pA1, alA);
    ATT_SLOAD(SO, KVBLK); if (2 < NT) ATT_SLOAD(SE, 2 * KVBLK);
    ATT_SWAIT(); ATT_SWRITE(1, SO); __syncthreads();
    for (int j = 1; j + 1 < NT; j += 2) {
        if constexpr (!SIDE::PLAIN) { if ((j & 7) == 1) side.template step<0>(); }
        ASBAR(); ATT_QKT(pB0, pB1, K_lds + KBUF); ATT_MASK(pB0, pB1, j);
        finishSM(pA0, pA1, pa0, pa1, pa2, pa3); ASBAR();
        ATT_SLOAD(SO, (j + 2) * KVBLK); ASBAR();
        ATT_PV(vb0); ATT_SM(pB0, pB1, alB);
        __syncthreads(); ATT_SWAIT(); ATT_SWRITE(0, SE);
        ATT_RESC(alB); __syncthreads();
        if constexpr (!SIDE::PLAIN) { if ((j & 7) == 5) side.template step<1>(); }
        ASBAR(); ATT_QKT(pA0, pA1, K_lds); ATT_MASK(pA0, pA1, j + 1);
        finishSM(pB0, pB1, pa0, pa1, pa2, pa3); ASBAR();
        if (j + 3 < NT) ATT_SLOAD(SE, (j + 3) * KVBLK); ASBAR();
        ATT_PV(vb0 + VBUF); ATT_SM(pA0, pA1, alA);
        __syncthreads(); ATT_SWAIT(); ATT_SWRITE(1, SO);
        ATT_RESC(alA); __syncthreads();
    }
    ASBAR(); ATT_QKT(pB0, pB1, K_lds + KBUF); ATT_MASK(pB0, pB1, NT - 1);
    finishSM(pA0, pA1, pa0, pa1, pa2, pa3); ASBAR();
    ATT_PV(vb0); ATT_SM(pB0, pB1, alB);
    __syncthreads(); ATT_RESC(alB);
    finishSM(pB0, pB1, pa0, pa1, pa2, pa3); ASBAR();
    ATT_PV(vb0 + VBUF);
    bf16_t* Ow = u.O + (size_t)(wid * QBLK) * u.ldo;
#pragma unroll
    for (int r = 0; r < 16; ++r) { const int orow = crow(r, hi); const float rl = __builtin_amdgcn_rcpf(lacc[r]);
#pragma unroll
        for (int d0 = 0; d0 < 2; ++d0) Ow[(size_t)orow * u.ldo + d0 * 32 + r32] = (bf16_t)f2bf_s(o[d0][r] * rl); }
    __syncthreads();
#undef ATT_SLOAD
#undef ATT_SWRITE
#undef ATT_SWAIT
#undef ATT_RESC
#undef ATT_SM
#undef ATT_QKT
#undef ATT_PV
#undef ATT_MASK
}
}


constexpr int NWAVES = 8;
#ifndef MK_DEBUG
#define MK_DEBUG 0
#endif
#ifndef MK_DBG_IGNORE
#define MK_DBG_IGNORE 0
#endif
#ifndef MK_ONE_LAUNCH
#define MK_ONE_LAUNCH 0
#endif
#ifndef REP_P
#define REP_P 1
#endif
#ifndef REP_A
#define REP_A 1
#endif
#ifndef REP_B
#define REP_B 1
#endif
#ifndef REP_C
#define REP_C 1
#endif
#ifndef REP_DG
#define REP_DG 1
#endif
#ifndef REP_DM
#define REP_DM 1
#endif
#ifndef REP_DN
#define REP_DN 1
#endif
#ifndef REP_E
#define REP_E 1
#endif
#ifndef REP_F
#define REP_F 1
#endif
#ifndef REP_H
#define REP_H 1
#endif
#ifndef REP_I
#define REP_I 1
#endif
#ifndef REP_J
#define REP_J 1
#endif
#ifndef REP_K
#define REP_K 1
#endif
constexpr int NB = 4, SEQ = 8192, T = NB * SEQ, D = 1024, DEPTH = 2, GW = 64;
constexpr int DIN = 5536, DINP = 5632;
constexpr int H_NAQ = 0, H_NAK = 384, H_NAV = 768, H_GQ = 1152, H_GK = 1536, H_GV = 1664, H_CQ = 1792, H_CKV = 2176, H_KR = 2432, H_GATE = 2464;
constexpr int NE = 32, TOPK = 4, FF = 1024, TK = T * TOPK;
constexpr int PSLOTS = TK + NE * 256;
constexpr int MAXTILES = PSLOTS / 256;
constexpr int LCAP = T;
constexpr float LN_EPS = 1e-5f, RMS_EPS = 1e-6f, DN_ALPHA = 1.4142135623730951f;
constexpr float LOG2E_F = 1.4426950408889634f;
constexpr int PPL = 10, NPH = 1 + DEPTH * PPL;

constexpr size_t MiB = 1u << 20;
constexpr size_t WS_CTL = 0, CTL_ZERO_BYTES = 1 * MiB;
constexpr size_t WB_IN = 0, WB_UQ = WB_IN + (size_t)DINP * 1024 * 2, WB_UKV = WB_UQ + (size_t)512 * 384 * 2, WB_BA = WB_UKV + (size_t)512 * 256 * 2,
                 WB_BB = WB_BA + (size_t)1024 * 384 * 2, WB_BC = WB_BB + (size_t)1024 * 384 * 2, WB_OUT = WB_BC + (size_t)1024 * 384 * 2,
                 WB_GU = WB_OUT + (size_t)1024 * 1024 * 2, WB_DN = WB_GU + (size_t)NE * 2048 * 1024 * 2, WB_LAYER = WB_DN + (size_t)NE * 1024 * 1024 * 2;
static_assert(WB_LAYER % 256 == 0, "weight block alignment");
constexpr size_t WS_W = 2 * MiB;
constexpr size_t WS_H = WS_W + 2 * WB_LAYER;
constexpr size_t SZ_H = (size_t)T * DINP * 2;
constexpr size_t WS_A2 = WS_H + SZ_H;
constexpr size_t A2_MIX = 0, A2_MIXED = A2_MIX + (size_t)T * 1024 * 4, A2_YA = A2_MIXED + (size_t)T * 1024 * 2, A2_YB = A2_YA + (size_t)T * 384 * 2,
                 A2_YC = A2_YB + (size_t)T * 384 * 2, A2_QC = A2_YC + (size_t)T * 384 * 2, A2_KVC = A2_QC + (size_t)T * 384 * 2, A2_KB = A2_KVC + (size_t)T * 512 * 2,
                 A2_CQN = A2_KB + (size_t)T * 128 * 2, A2_CKVN = A2_CQN + (size_t)T * 384 * 2, A2_KR = A2_CKVN + (size_t)T * 256 * 2, SZ_A2 = A2_KR + (size_t)T * 32 * 2;
static_assert(SZ_A2 >= (size_t)PSLOTS * 1024 * 2 && SZ_H >= (size_t)PSLOTS * 1024 * 2, "overlays fit");
constexpr size_t WS_X2 = WS_A2 + SZ_A2;
constexpr size_t WS_XB = WS_X2 + (size_t)T * D * 4;
constexpr size_t WS_X1 = WS_XB + (size_t)T * D * 2;
constexpr size_t WS_X1B = WS_X1 + (size_t)T * D * 4;
constexpr size_t WS_LT = WS_X1B + (size_t)T * D * 2;
constexpr size_t WS_LG = WS_LT + (size_t)NE * LCAP * 4;
constexpr size_t WS_TE = WS_LG + (size_t)NE * LCAP * 4;
constexpr size_t WS_TR = WS_TE + (size_t)T * 4 * 4;
constexpr size_t WS_SG = WS_TR + (size_t)T * 4 * 4;
constexpr size_t WS_END = WS_SG + (size_t)PSLOTS * 4;
constexpr int CW_BAR = 4096;
constexpr int CW_CNT = 16384;

constexpr int RING_BYTES = 131072, LDSCTL_OFF = 139264, MISC_OFF = LDSCTL_OFF + 64;
constexpr int TBL_OFF = LDSCTL_OFF + 256;
constexpr int TBL_START = TBL_OFF, TBL_TILEE = TBL_OFF + 512, TBL_RS = TBL_TILEE + 2304;
constexpr int LDS_BYTES = 155648;
static_assert(TBL_RS + 512 * 12 + 256 <= LDS_BYTES, "LDS map");

#define GAS __attribute__((address_space(1)))
#define LAS __attribute__((address_space(3)))
typedef unsigned short bf16;
typedef unsigned v4u __attribute__((ext_vector_type(4)));
typedef float f32x4 __attribute__((ext_vector_type(4)));
typedef GAS unsigned gu32;
#define RLX_AGENT __ATOMIC_RELAXED, __HIP_MEMORY_SCOPE_AGENT
#define LDS_WAIT() asm volatile("s_waitcnt lgkmcnt(0)" ::: "memory")
#define VM_WAIT() asm volatile("s_waitcnt vmcnt(0)" ::: "memory")
__device__ __forceinline__ unsigned f2bf(float f) { unsigned u = __builtin_bit_cast(unsigned, f); return (u + 0x7fffu + ((u >> 16) & 1u)) >> 16; }
__device__ __forceinline__ unsigned pk2(float lo, float hi) { unsigned r; asm("v_cvt_pk_bf16_f32 %0, %1, %2" : "=v"(r) : "v"(lo), "v"(hi)); return r; }
__device__ __forceinline__ float bflo(unsigned w) { return __uint_as_float(w << 16); }
__device__ __forceinline__ float bfhi(unsigned w) { return __uint_as_float(w & 0xffff0000u); }

template <int O> __device__ __forceinline__ float shx(float v, int lane) { return __int_as_float(__builtin_amdgcn_ds_bpermute((lane ^ O) << 2, __float_as_int(v))); }
template <int O> __device__ __forceinline__ int shxi(int v, int lane) { return __builtin_amdgcn_ds_bpermute((lane ^ O) << 2, v); }

#define XB_TMO      128
#define XB_XCNT(j)  (256  + 64 * (j))
#define XB_XSUB(j)  (1280 + 64 * (j))
#define XB_XGEN(j)  (2304 + 64 * (j))
#define XB_TOP      3328
#define XB_TOPGEN   3392
#define XCD_BAR_WORDS 3456
#define XB_SPIN_CAP (1u << 18)

__device__ __forceinline__ unsigned xb_ld(unsigned* p)              { return __hip_atomic_load(p, __ATOMIC_RELAXED, __HIP_MEMORY_SCOPE_AGENT); }
__device__ __forceinline__ unsigned xb_add(unsigned* p, unsigned v) { return __hip_atomic_fetch_add(p, v, __ATOMIC_RELAXED, __HIP_MEMORY_SCOPE_AGENT); }
__device__ __forceinline__ unsigned xb_xcc_id() { return (unsigned)__builtin_amdgcn_s_getreg((3 << 11) | 20) & 0xFu; }
#define XB_SPIN(cond, bar) do { unsigned _sp = 0; while (cond) { __builtin_amdgcn_s_sleep(1); \
    if ((++_sp & 255u) == 0u) { if (xb_ld(&(bar)[XB_TMO])) break; if (_sp > XB_SPIN_CAP) { atomicAdd(&(bar)[XB_TMO], 1u); break; } } } } while (0)

struct XcdBarrier {
    unsigned* bar; unsigned x;
    volatile LAS unsigned* st;
};

__device__ __forceinline__ XcdBarrier xcd_barrier_post(unsigned* bar, volatile LAS unsigned* st) {
    XcdBarrier b; b.bar = bar; b.x = xb_xcc_id(); b.st = st;
    if (threadIdx.x == 0) (void)xb_add(&bar[XB_XCNT(b.x)], 1u);
    return b;
}
__device__ __forceinline__ void xcd_barrier_complete(unsigned* bar, unsigned x, unsigned& nloc, unsigned& nx) {
    const unsigned G = gridDim.x * gridDim.y * gridDim.z;
    unsigned sum, cnt, mine, sp = 0u;
    for (;;) {
        sum = 0u; cnt = 0u; mine = 0u;
#pragma unroll
        for (unsigned j = 0; j < 16; ++j) { const unsigned c = xb_ld(&bar[XB_XCNT(j)]); sum += c; cnt += (c > 0u) ? 1u : 0u; mine = (j == x) ? c : mine; }
        if (sum == G) break;
        __builtin_amdgcn_s_sleep(1);
        if ((++sp & 255u) == 0u) { if (xb_ld(&bar[XB_TMO])) break; if (sp > XB_SPIN_CAP) { atomicAdd(&bar[XB_TMO], 1u); break; } }
    }
    nloc = mine > 0u ? mine : 1u; nx = cnt > 0u ? cnt : 1u;
}

__device__ __forceinline__ void xcd_barrier(const XcdBarrier& b) {
    asm volatile("s_waitcnt vmcnt(0)" ::: "memory");
    __syncthreads();
    if (threadIdx.x == 0) {
        unsigned* bar = b.bar;
        __builtin_amdgcn_s_waitcnt(0);
        unsigned nloc = b.st[0], nx = b.st[1];
        if (nloc == 0u) { xcd_barrier_complete(bar, b.x, nloc, nx); b.st[0] = nloc; b.st[1] = nx; }
        const unsigned old = xb_add(&bar[XB_XSUB(b.x)], 1u);
        const unsigned gen = old / nloc;
        if (old + 1u == (gen + 1u) * nloc) {
            __builtin_amdgcn_fence(__ATOMIC_RELEASE, "agent");
            asm volatile("s_waitcnt vmcnt(0)" ::: "memory");
            const unsigned og = xb_add(&bar[XB_TOP], 1u);
            const unsigned tg = og / nx;
            if (og + 1u == (tg + 1u) * nx) xb_add(&bar[XB_TOPGEN], 1u);
            else XB_SPIN(xb_ld(&bar[XB_TOPGEN]) == tg, bar);
            __builtin_amdgcn_fence(__ATOMIC_ACQUIRE, "agent");
            xb_add(&bar[XB_XGEN(b.x)], 1u);
            asm volatile("s_waitcnt vmcnt(0)" ::: "memory");
        } else {
            XB_SPIN(xb_ld(&bar[XB_XGEN(b.x)]) == gen, bar);
            __builtin_amdgcn_fence(__ATOMIC_ACQUIRE, "agent");
            asm volatile("s_waitcnt vmcnt(0)" ::: "memory");
        }
    }
    __syncthreads();
}


struct Frame {
    LAS unsigned char* lds;
    gu32* ctl;
    int tid, lane, wave;
    int vcu, G, bx;
    unsigned char* ws;
    float* out;
};
__device__ __forceinline__ const float* in_ptr(int i) {
    const void* base = (const void*)__builtin_amdgcn_kernarg_segment_ptr(); const GAS float* p;
    asm volatile("s_load_dwordx2 %0, %1, %2\n\ts_waitcnt lgkmcnt(0)" : "=s"(p) : "s"(base), "i"(i * 8) : "memory"); return (const float*)p;
}
#define INP(i) in_ptr(i)
template <int SITE> __device__ __forceinline__ Frame mkframe(LAS unsigned char* lds_in, unsigned char* ws_in, float* out_in, int wave_id, int bx0, int G0) {
    Frame F; int lane_;
    asm volatile("v_mbcnt_lo_u32_b32 %0, -1, 0\n\tv_mbcnt_hi_u32_b32 %0, -1, %0 ; site %1" : "=v"(lane_) : "n"(SITE));
    int bx = bx0, G = G0, wv = wave_id; asm volatile("; site %3" : "+s"(bx), "+s"(G), "+s"(wv) : "n"(SITE));
    GAS unsigned char* wsg = (GAS unsigned char*)ws_in; asm volatile("; site %1" : "+s"(wsg) : "n"(SITE)); unsigned char* ws = (unsigned char*)wsg;
    LAS unsigned char* l3 = lds_in; asm volatile("; site %1" : "+s"(l3) : "n"(SITE));
    const int tid = wv * 64 + lane_;
    F.lds = l3; F.tid = tid; F.lane = lane_; F.wave = wv;
    F.G = G; F.bx = bx; F.vcu = (G % 8 == 0) ? (bx % 8) * (G / 8) + bx / 8 : bx;
    F.ws = ws; F.ctl = (gu32*)(wsg + WS_CTL); F.out = out_in; return F;
}
__device__ __forceinline__ float wave_sum(float v, int lane) {
    v += shx<1>(v, lane); v += shx<2>(v, lane); v += shx<4>(v, lane); v += shx<8>(v, lane); v += shx<16>(v, lane); v += shx<32>(v, lane);
    return v;
}
__device__ __forceinline__ void tr_item(const float* W, int ldw, int Kd, int k0, int src_n0, bf16* WT, int dst_n0, float scale, LAS float* scr, int lane) {
    float v[32];
#pragma unroll
    for (int i = 0; i < 32; ++i) v[i] = W[(size_t)(k0 + 2 * i + (lane >> 5)) * ldw + src_n0 + (lane & 31)];
#pragma unroll
    for (int i = 0; i < 32; ++i) scr[(2 * i + (lane >> 5)) * 33 + (lane & 31)] = v[i];
    LDS_WAIT(); asm volatile("" ::: "memory");
    const int c = lane & 7;
#pragma unroll
    for (int j = 0; j < 4; ++j) { const int n = (lane >> 3) + 8 * j; const LAS float* s = scr + (8 * c) * 33 + n;
        v4u o; o.x = pk2(s[0 * 33] * scale, s[1 * 33] * scale); o.y = pk2(s[2 * 33] * scale, s[3 * 33] * scale); o.z = pk2(s[4 * 33] * scale, s[5 * 33] * scale); o.w = pk2(s[6 * 33] * scale, s[7 * 33] * scale);
        *(GAS v4u*)(WT + (size_t)(dst_n0 + n) * Kd + k0 + 8 * c) = o; }
    LDS_WAIT(); asm volatile("" ::: "memory");
}
template <int KIND> __device__ __forceinline__ void conv_matrix(Frame& F, const float* W, int K, int N, bf16* WT, float s, int gw, int NGW, LAS float* scr, int Kd = 0) {
    if (Kd == 0) Kd = K;
    const int nnb = N / 32, nkb = K / 64, nit = nnb * nkb;
    for (int it = gw; it < nit; it += NGW) {
        const int kb = it / nnb, nb = it % nnb; const int dst_n0 = 32 * nb; int src_n0 = dst_n0; float sc = s;
        if (KIND == 1) sc = (dst_n0 < 384) ? s : 1.0f;
        if (KIND == 2) { const int p = dst_n0 >> 8, j = dst_n0 & 255; src_n0 = (j < 128) ? (128 * p + j) : (1024 + 128 * p + (j - 128)); }
        tr_item(W, N, Kd, 64 * kb, src_n0, WT, dst_n0, sc, scr, F.lane);
    }
}
__device__ __forceinline__ void zero_rows(bf16* WT, int K, int n_lo, int n_hi, int gtid, int nthr) {
    const size_t n16 = (size_t)(n_hi - n_lo) * K / 8; GAS v4u* p = (GAS v4u*)(WT + (size_t)n_lo * K);
    for (size_t i = gtid; i < n16; i += nthr) p[i] = (v4u){0u, 0u, 0u, 0u};
}
__device__ __forceinline__ void p_prologue(Frame& F) {
    LAS float* scr = (LAS float*)(F.lds + F.wave * 16384);
    const int gw0 = F.vcu * NWAVES + F.wave, NGW = F.G * NWAVES, gtid = F.bx * (NWAVES * 64) + F.tid, nthr = F.G * NWAVES * 64;
    for (int l = 0; l < DEPTH; ++l) {
        unsigned char* wb = F.ws + WS_W + (size_t)l * WB_LAYER;
        int gw = gw0;
#define ROT(n) do { gw = (gw + NGW - ((n) % NGW)) % NGW; } while (0)
        conv_matrix<1>(F, INP(1) + (size_t)l * 1024 * DIN, 1024, DIN, (bf16*)(wb + WB_IN), 0.125f * LOG2E_F, gw, NGW, scr); ROT(16 * 173);
        zero_rows((bf16*)(wb + WB_IN), 1024, DIN, DINP, gtid, nthr);
        conv_matrix<0>(F, INP(7) + (size_t)l * 384 * 384, 384, 384, (bf16*)(wb + WB_UQ), 0.10206207261596577f * LOG2E_F, gw, NGW, scr); ROT(72);
        zero_rows((bf16*)(wb + WB_UQ), 384, 384, 512, gtid, nthr);
        conv_matrix<0>(F, INP(8) + (size_t)l * 256 * 512, 256, 512, (bf16*)(wb + WB_UKV), 1.0f, gw, NGW, scr); ROT(64);
        conv_matrix<0>(F, INP(9) + (size_t)l * 384 * 1024, 384, 1024, (bf16*)(wb + WB_BA), 1.0f, gw, NGW, scr); ROT(192);
        conv_matrix<0>(F, INP(10) + (size_t)l * 384 * 1024, 384, 1024, (bf16*)(wb + WB_BB), 1.0f, gw, NGW, scr); ROT(192);
        conv_matrix<0>(F, INP(11) + (size_t)l * 256 * 1024, 256, 1024, (bf16*)(wb + WB_BC), 1.0f, gw, NGW, scr, 384); ROT(64);
        for (int i = gtid; i < 1024 * 16; i += nthr) *((GAS v4u*)(wb + WB_BC) + (size_t)(i >> 4) * 48 + 32 + (i & 15)) = (v4u){0u, 0u, 0u, 0u};
        conv_matrix<0>(F, INP(12) + (size_t)l * 1024 * 1024, 1024, 1024, (bf16*)(wb + WB_OUT), 1.0f, gw, NGW, scr); ROT(512);
#undef ROT
    }
    { const GAS f32x4* xs = (const GAS f32x4*)INP(0); GAS v4u* xd = (GAS v4u*)(F.ws + WS_XB);
      for (size_t i = gtid; i < (size_t)T * D / 8; i += nthr) { const f32x4 a = xs[2 * i], b = xs[2 * i + 1]; xd[i] = (v4u){pk2(a.x, a.y), pk2(a.z, a.w), pk2(b.x, b.y), pk2(b.z, b.w)}; } }
}

constexpr int CONV_ITEMS = NE * 1024 + NE * 512, CONV_LDS_OFF = 49152, CONV_LDS_WAVE = 2 * 16 * 33 * 4;
struct MoeConv {
    static constexpr bool PLAIN = false;
    const float* Wgu; const float* Wdn; bf16* Tgu; bf16* Tdn;
    LAS float* scr; int lane; int gw, ngw, nmini; int s;
    float cvA[8], cvB[8];
    struct Mini { const float* W; bf16* WT; int ldw, k0, src_n0, dst_n0; };
    __device__ __forceinline__ Mini decode(int m) const {
        m = m < 0 ? 0 : (m >= nmini ? nmini - 1 : m);
        const int g = gw + (m >> 2) * ngw, q = m & 3; const bool gu = g < NE * 1024; const int h = gu ? g : g - NE * 1024;
        const int e = gu ? (h >> 10) : (h >> 9), r = gu ? (h & 1023) : (h & 511), kb = gu ? (r >> 6) : (r >> 5), nb = gu ? (r & 63) : (r & 31);
        Mini x; x.dst_n0 = 32 * nb; const int p = x.dst_n0 >> 8, j = x.dst_n0 & 255;
        x.src_n0 = gu ? ((j < 128) ? (128 * p + j) : (1024 + 128 * p + (j - 128))) : x.dst_n0; x.k0 = 64 * kb + 16 * q; x.ldw = gu ? 2048 : 1024;
        x.W = gu ? Wgu + (size_t)e * 1024 * 2048 : Wdn + (size_t)e * 1024 * 1024; x.WT = gu ? Tgu + (size_t)e * 2048 * 1024 : Tdn + (size_t)e * 1024 * 1024; return x;
    }
    __device__ __forceinline__ bool done() const { return s >= nmini + 3; }
    template <int P> __device__ __forceinline__ void step() {
        {   const Mini x = decode(s - 3); const LAS float* b = scr + (1 - P) * (16 * 33); const int n = lane >> 1, kh = lane & 1; const LAS float* p = b + (8 * kh) * 33 + n;
            v4u o; o.x = pk2(p[0 * 33], p[1 * 33]); o.y = pk2(p[2 * 33], p[3 * 33]); o.z = pk2(p[4 * 33], p[5 * 33]); o.w = pk2(p[6 * 33], p[7 * 33]);
            *(GAS v4u*)(x.WT + (size_t)(x.dst_n0 + n) * 1024 + x.k0 + 8 * kh) = o; }
        {   LAS float* b = scr + P * (16 * 33);
#pragma unroll
            for (int jj = 0; jj < 8; ++jj) b[(2 * jj + (lane >> 5)) * 33 + (lane & 31)] = P ? cvB[jj] : cvA[jj]; }
        {   const Mini x = decode(s); const GAS float* src = (const GAS float*)x.W + (size_t)(x.k0 + (lane >> 5)) * x.ldw + x.src_n0 + (lane & 31);
#pragma unroll
            for (int jj = 0; jj < 8; ++jj) { const float v = src[(size_t)(2 * jj) * x.ldw]; if (P) cvB[jj] = v; else cvA[jj] = v; } }
        ++s;
    }
};
__device__ __forceinline__ void p_prep(Frame& F, int l) {
    const bf16* hb = (const bf16*)(F.ws + WS_H); unsigned char* a2 = F.ws + WS_A2;
    bf16* kB = (bf16*)(a2 + A2_KB); bf16* cqn = (bf16*)(a2 + A2_CQN); bf16* ckvn = (bf16*)(a2 + A2_CKVN); bf16* kr = (bf16*)(a2 + A2_KR);
    const float* gk = INP(4) + l * 64; const float* gq = INP(5) + l * 384; const float* gkv = INP(6) + l * 256;
    const int lane = F.lane, gw = F.vcu * NWAVES + F.wave, NGW = F.G * NWAVES;
    v4u nk = {0u, 0u, 0u, 0u}, nq = nk, nkv = nk, nr = nk;
    if (gw < T) { const bf16* h0 = hb + (size_t)gw * DINP; if (lane < 16) nk = *(const GAS v4u*)(h0 + H_GK + lane * 8); if (lane < 48) nq = *(const GAS v4u*)(h0 + H_CQ + lane * 8);
        if (lane < 32) nkv = *(const GAS v4u*)(h0 + H_CKV + lane * 8); if (lane < 4) nr = *(const GAS v4u*)(h0 + H_KR + lane * 8); }
    for (int t = gw; t < T; t += NGW) {
        const v4u wk_ = nk, wq_ = nq, wkv_ = nkv, wr_ = nr;
        if (t + NGW < T) { const bf16* h1 = hb + (size_t)(t + NGW) * DINP; if (lane < 16) nk = *(const GAS v4u*)(h1 + H_GK + lane * 8); if (lane < 48) nq = *(const GAS v4u*)(h1 + H_CQ + lane * 8);
            if (lane < 32) nkv = *(const GAS v4u*)(h1 + H_CKV + lane * 8); if (lane < 4) nr = *(const GAS v4u*)(h1 + H_KR + lane * 8); }
        const int s = t & (SEQ - 1); const float prow = (float)(s >> 6), pcol = (float)(s & 63);
        {   float x[8]; float ssq = 0.f; const int cc = lane & 7;
            if (lane < 16) { const v4u w = wk_; x[0] = bflo(w.x); x[1] = bfhi(w.x); x[2] = bflo(w.y); x[3] = bfhi(w.y); x[4] = bflo(w.z); x[5] = bfhi(w.z); x[6] = bflo(w.w); x[7] = bfhi(w.w); }
            else {
#pragma unroll
                for (int j = 0; j < 8; ++j) x[j] = 0.f; }
#pragma unroll
            for (int j = 0; j < 8; ++j) ssq += x[j] * x[j];
            ssq += shx<1>(ssq, lane); ssq += shx<2>(ssq, lane); ssq += shx<4>(ssq, lane);
            const float rstd = 1.0f / sqrtf(ssq * (1.0f / 64.0f) + RMS_EPS);
            float y[8], o[8];
#pragma unroll
            for (int j = 0; j < 8; ++j) y[j] = x[j] * rstd * gk[(cc * 8 + j) & 63];
#pragma unroll
            for (int j = 0; j < 8; ++j) { const float other = shx<4>(y[j], lane); const int i = 8 * (cc & 3) + j;
                const float inv = exp2f(-(float)(i & 15) * (att::LOG2_THETA / 16.0f)); const float ang = ((i < 16) ? prow : pcol) * inv * att::INV2PI;
                const float c = __builtin_amdgcn_cosf(ang), sn = __builtin_amdgcn_sinf(ang);
                o[j] = (cc < 4) ? (y[j] * c - other * sn) : (other * sn + y[j] * c); }
            if (lane < 16) *(GAS v4u*)(kB + (size_t)t * 128 + lane * 8) = (v4u){pk2(o[0], o[1]), pk2(o[2], o[3]), pk2(o[4], o[5]), pk2(o[6], o[7])};
        }
        {   float x[8]; float ssq = 0.f;
            if (lane < 48) { const v4u w = wq_; x[0] = bflo(w.x); x[1] = bfhi(w.x); x[2] = bflo(w.y); x[3] = bfhi(w.y); x[4] = bflo(w.z); x[5] = bfhi(w.z); x[6] = bflo(w.w); x[7] = bfhi(w.w); }
            else {
#pragma unroll
                for (int j = 0; j < 8; ++j) x[j] = 0.f; }
#pragma unroll
            for (int j = 0; j < 8; ++j) ssq += x[j] * x[j];
            ssq = wave_sum(ssq, lane); const float rstd = 1.0f / sqrtf(ssq * (1.0f / 384.0f) + RMS_EPS);
            if (lane < 48) { float y[8];
#pragma unroll
                for (int j = 0; j < 8; ++j) y[j] = x[j] * rstd * gq[lane * 8 + j];
                *(GAS v4u*)(cqn + (size_t)t * 384 + lane * 8) = (v4u){pk2(y[0], y[1]), pk2(y[2], y[3]), pk2(y[4], y[5]), pk2(y[6], y[7])}; }
        }
        {   float x[8]; float ssq = 0.f;
            if (lane < 32) { const v4u w = wkv_; x[0] = bflo(w.x); x[1] = bfhi(w.x); x[2] = bflo(w.y); x[3] = bfhi(w.y); x[4] = bflo(w.z); x[5] = bfhi(w.z); x[6] = bflo(w.w); x[7] = bfhi(w.w); }
            else {
#pragma unroll
                for (int j = 0; j < 8; ++j) x[j] = 0.f; }
#pragma unroll
            for (int j = 0; j < 8; ++j) ssq += x[j] * x[j];
            ssq = wave_sum(ssq, lane); const float rstd = 1.0f / sqrtf(ssq * (1.0f / 256.0f) + RMS_EPS);
            if (lane < 32) { float y[8];
#pragma unroll
                for (int j = 0; j < 8; ++j) y[j] = x[j] * rstd * gkv[lane * 8 + j];
                *(GAS v4u*)(ckvn + (size_t)t * 256 + lane * 8) = (v4u){pk2(y[0], y[1]), pk2(y[2], y[3]), pk2(y[4], y[5]), pk2(y[6], y[7])}; }
        }
        {   float x[8]; const int cc = lane & 3;
            if (lane < 4) { const v4u w = wr_; x[0] = bflo(w.x); x[1] = bfhi(w.x); x[2] = bflo(w.y); x[3] = bfhi(w.y); x[4] = bflo(w.z); x[5] = bfhi(w.z); x[6] = bflo(w.w); x[7] = bfhi(w.w); }
            else {
#pragma unroll
                for (int j = 0; j < 8; ++j) x[j] = 0.f; }
            float o[8];
#pragma unroll
            for (int j = 0; j < 8; ++j) { const float other = shx<2>(x[j], lane);
                const float inv = exp2f(-(float)j * (att::LOG2_THETA / 8.0f)); const float ang = (((cc & 1) == 0) ? prow : pcol) * inv * att::INV2PI;
                const float c = __builtin_amdgcn_cosf(ang), sn = __builtin_amdgcn_sinf(ang);
                o[j] = (cc < 2) ? (x[j] * c - other * sn) : (other * sn + x[j] * c); }
            if (lane < 4) *(GAS v4u*)(kr + (size_t)t * 32 + lane * 8) = (v4u){pk2(o[0], o[1]), pk2(o[2], o[3]), pk2(o[4], o[5]), pk2(o[6], o[7])};
        }
    }
}


__device__ __forceinline__ int build_tables(Frame& F, int l) {
    LAS int* st = (LAS int*)(F.lds + TBL_START); LAS int* cn = st + 33; LAS int* te = (LAS int*)(F.lds + TBL_TILEE);
    __syncthreads();
    if (F.tid < NE) cn[F.tid] = (int)__hip_atomic_load(F.ctl + CW_CNT + 64 * l + F.tid, RLX_AGENT);
    __syncthreads();
    if (F.tid == 0) { int s = 0; for (int e = 0; e < NE; ++e) { st[e] = s; s += ((cn[e] + 255) >> 8) << 8; } st[NE] = s; }
    __syncthreads();
    const int total = st[NE];
    for (int tile = F.tid; tile < (total >> 8); tile += NWAVES * 64) { int e = 0; for (int k = 1; k < NE; ++k) e += (tile * 256 >= st[k]) ? 1 : 0; te[tile] = e; }
    __syncthreads();
    return total;
}

__device__ __forceinline__ void p_ln1_router(Frame& F, int l, const float* xcur) {
    const bf16* outb = (const bf16*)(F.ws + WS_X1); bf16* x1b = (bf16*)(F.ws + WS_X1B);
    int* list_t = (int*)(F.ws + WS_LT); float* list_g = (float*)(F.ws + WS_LG); int* tok_e = (int*)(F.ws + WS_TE); int* tok_r = (int*)(F.ws + WS_TR);
    const float* wr = INP(15) + (size_t)l * 1024 * NE; const float* br = INP(16) + l * NE;
    const int lane0 = F.lane, tid = F.tid;
    LAS unsigned char* wl = F.lds;
    LAS int* sel_e = (LAS int*)(F.lds + TBL_RS); LAS float* sel_g = (LAS float*)(sel_e + 512); LAS int* sel_r = sel_e + 1024; LAS int* hist = sel_e + 1536; LAS int* base = hist + 32;
    __syncthreads();
    for (int idx = tid; idx < 1024 * 8; idx += NWAVES * 64) { const int k = idx >> 3, c = idx & 7, kp = (k & 3) * 256 + (k >> 2), cp = c ^ ((kp >> 1) & 7);
        *(LAS f32x4*)(wl + (kp * 8 + cp) * 16) = *(const GAS f32x4*)(wr + (size_t)k * NE + c * 4); }
    __syncthreads();
    for (int tile = F.bx; tile < T / 128; tile += F.G) {
        if (tid < 32) hist[tid] = 0;
        __syncthreads();
        f32x4 px[4]; unsigned long long po[4];
        {   const int t0 = tile * 128 + F.wave * 16; const GAS f32x4* xr0 = (const GAS f32x4*)(xcur + (size_t)t0 * D) + lane0; const GAS unsigned long long* or0 = (const GAS unsigned long long*)(outb + (size_t)t0 * D) + lane0;
#pragma unroll
            for (int j = 0; j < 4; ++j) { px[j] = xr0[64 * j]; po[j] = or0[64 * j]; } }
        for (int it = 0; it < 16; ++it) {
            int lane = lane0; asm volatile("" : "+v"(lane));
            const int sw = (lane >> 1) & 7; const float bias_e = br[(lane >> 1) & 31];
            const GAS f32x4* lgp = (const GAS f32x4*)(INP(13) + l * D) + lane; const GAS f32x4* lbp = (const GAS f32x4*)(INP(14) + l * D) + lane;
            const int tl = F.wave * 16 + it, t = tile * 128 + tl;
            f32x4 v[4]; float s = 0.f;
#pragma unroll
            for (int j = 0; j < 4; ++j) { const unsigned long long ow = po[j]; const unsigned olo = (unsigned)ow, ohi = (unsigned)(ow >> 32);
                v[j] = px[j] * DN_ALPHA + (f32x4){bflo(olo), bfhi(olo), bflo(ohi), bfhi(ohi)}; s += (v[j].x + v[j].y) + (v[j].z + v[j].w); }
            if (it + 1 < 16) { const GAS f32x4* xr = (const GAS f32x4*)(xcur + (size_t)(t + 1) * D) + lane; const GAS unsigned long long* orr = (const GAS unsigned long long*)(outb + (size_t)(t + 1) * D) + lane;
#pragma unroll
                for (int j = 0; j < 4; ++j) { px[j] = xr[64 * j]; po[j] = orr[64 * j]; } }
            const float mean = wave_sum(s, lane) * (1.f / D); float s2 = 0.f;
#pragma unroll
            for (int j = 0; j < 4; ++j) { v[j] = v[j] - mean; s2 += (v[j].x * v[j].x + v[j].y * v[j].y) + (v[j].z * v[j].z + v[j].w * v[j].w); }
            const float rstd = 1.f / sqrtf(wave_sum(s2, lane) * (1.f / D) + LN_EPS);
            GAS unsigned long long* o8 = (GAS unsigned long long*)(x1b + (size_t)t * D) + lane;
#pragma unroll
            for (int j = 0; j < 4; ++j) { v[j] = v[j] * rstd * lgp[64 * j] + lbp[64 * j];
                o8[64 * j] = (unsigned long long)pk2(v[j].x, v[j].y) | ((unsigned long long)pk2(v[j].z, v[j].w) << 32); }
            float acc[32];
#pragma unroll
            for (int c = 0; c < 8; ++c) {
                int basec = lane * 128 + ((c ^ sw) << 4); asm volatile("" : "+v"(basec));
                const LAS unsigned char* wp = wl + basec;
                float a0 = 0.f, a1_ = 0.f, a2_ = 0.f, a3 = 0.f;
#pragma unroll
                for (int i = 0; i < 4; ++i)
#pragma unroll
                    for (int j = 0; j < 4; ++j) { const f32x4 w = *(const LAS f32x4*)(wp + (i * 256 + 64 * j) * 128); const float xv = v[j][i];
                        a0 += xv * w.x; a1_ += xv * w.y; a2_ += xv * w.z; a3 += xv * w.w; }
                acc[4 * c + 0] = a0; acc[4 * c + 1] = a1_; acc[4 * c + 2] = a2_; acc[4 * c + 3] = a3;
            }
            float a16[16], a8[8], a4[4], a2[2], a1;
            { const bool b = (lane & 32) != 0;
#pragma unroll
              for (int i = 0; i < 16; ++i) { const float send = b ? acc[i] : acc[16 + i]; const float keep = b ? acc[16 + i] : acc[i]; a16[i] = keep + shx<32>(send, lane); } }
            { const bool b = (lane & 16) != 0;
#pragma unroll
              for (int i = 0; i < 8; ++i) { const float send = b ? a16[i] : a16[8 + i]; const float keep = b ? a16[8 + i] : a16[i]; a8[i] = keep + shx<16>(send, lane); } }
            { const bool b = (lane & 8) != 0;
#pragma unroll
              for (int i = 0; i < 4; ++i) { const float send = b ? a8[i] : a8[4 + i]; const float keep = b ? a8[4 + i] : a8[i]; a4[i] = keep + shx<8>(send, lane); } }
            { const bool b = (lane & 4) != 0;
#pragma unroll
              for (int i = 0; i < 2; ++i) { const float send = b ? a4[i] : a4[2 + i]; const float keep = b ? a4[2 + i] : a4[i]; a2[i] = keep + shx<4>(send, lane); } }
            { const bool b = (lane & 2) != 0; const float send = b ? a2[0] : a2[1]; const float keep = b ? a2[1] : a2[0]; a1 = keep + shx<2>(send, lane); }
            a1 += shx<1>(a1, lane);
            float val = a1 + bias_e; const int my_e = (lane >> 1) & 31;
            float sv[4]; int se[4];
#pragma unroll
            for (int r = 0; r < 4; ++r) { float bv = val; int be = my_e;
#define TOPK_STEP(O) { const float ov = shx<O>(bv, lane); const int oe = shxi<O>(be, lane); if (ov > bv || (ov == bv && oe < be)) { bv = ov; be = oe; } }
                TOPK_STEP(2) TOPK_STEP(4) TOPK_STEP(8) TOPK_STEP(16) TOPK_STEP(32)
#undef TOPK_STEP
                sv[r] = bv; se[r] = be; if (my_e == be) val = -INFINITY; }
            const float e1 = __expf(sv[1] - sv[0]), e2 = __expf(sv[2] - sv[0]), e3 = __expf(sv[3] - sv[0]); const float rs = 1.0f / (1.0f + e1 + e2 + e3);
            if (lane < 4) { const int ee = lane == 0 ? se[0] : lane == 1 ? se[1] : lane == 2 ? se[2] : se[3]; const float gg = (lane == 0 ? 1.0f : lane == 1 ? e1 : lane == 2 ? e2 : e3) * rs;
                const int a = tl * 4 + lane; sel_e[a] = ee; sel_g[a] = gg; sel_r[a] = __hip_atomic_fetch_add(&hist[ee], 1, __ATOMIC_RELAXED, __HIP_MEMORY_SCOPE_WORKGROUP); }
        }
        __syncthreads();
        if (tid < 32) base[tid] = (int)__hip_atomic_fetch_add(F.ctl + CW_CNT + 64 * l + tid, (unsigned)hist[tid], RLX_AGENT);
        __syncthreads();
        { const int a = tid, e = sel_e[a], rank = base[e] + sel_r[a], t = tile * 128 + (a >> 2);
          list_t[(size_t)e * LCAP + rank] = t; list_g[(size_t)e * LCAP + rank] = sel_g[a]; tok_e[t * 4 + (a & 3)] = e; tok_r[t * 4 + (a & 3)] = rank; }
        __syncthreads();
    }
}

__device__ __forceinline__ void p_gather(Frame& F, int l) {
    const int total = build_tables(F, l);
    LAS int* st = (LAS int*)(F.lds + TBL_START); LAS int* cn = st + 33;
    const bf16* x1b = (const bf16*)(F.ws + WS_X1B); bf16* xg = (bf16*)(F.ws + WS_H); float* sg = (float*)(F.ws + WS_SG);
    const int* list_t = (const int*)(F.ws + WS_LT); const float* list_g = (const float*)(F.ws + WS_LG);
    const int lane = F.lane, gw = F.vcu * NWAVES + F.wave, NGW = F.G * NWAVES;
    for (int s = gw; s < total; s += NGW) {
        const bool pr = (lane < NE) && (s >= st[lane & 31]);
        const int e = __popcll(__ballot(pr)) - 1; const int r = s - st[e];
        GAS v4u* dst = (GAS v4u*)(xg + (size_t)s * D);
        if (r < cn[e]) { const int t = list_t[(size_t)e * LCAP + r]; const GAS v4u* src = (const GAS v4u*)(x1b + (size_t)t * D);
            dst[lane] = src[lane]; dst[64 + lane] = src[64 + lane]; if (lane == 0) sg[s] = list_g[(size_t)e * LCAP + r]; }
        else { unsigned zz = 0u; asm volatile("" : "+v"(zz)); const v4u z4 = {zz, zz, zz, zz}; dst[lane] = z4; dst[64 + lane] = z4; if (lane == 0) sg[s] = 0.f; }
    }
}

__device__ __forceinline__ void p_ln2(Frame& F, int l, float* dst, bool write_xb) {
    (void)build_tables(F, l);
    LAS int* st = (LAS int*)(F.lds + TBL_START);
    const bf16* x1b = (const bf16*)(F.ws + WS_X1B); const bf16* yb = (const bf16*)(F.ws + WS_H); bf16* xb = (bf16*)(F.ws + WS_XB);
    const int* tok_e = (const int*)(F.ws + WS_TE); const int* tok_r = (const int*)(F.ws + WS_TR);
    const int lane = F.lane, hl = lane & 31, half = lane >> 5, gw = F.vcu * NWAVES + F.wave, NGW = F.G * NWAVES;
    const float* lgp = INP(21) + l * D; const float* lbp = INP(22) + l * D;
    float dmult = 1.0f;
#if MK_DEBUG
    if (l == DEPTH - 1) { const unsigned mask = __hip_atomic_load(F.ctl + 20000, RLX_AGENT) & ~(unsigned)(MK_DBG_IGNORE); if (mask) dmult = 1.0f + (float)(__ffs((int)mask) - 1); }
#endif
    int t = 2 * gw + half;
    int e4 = 0, r4 = 0;
    if (t < T && hl < 4) { e4 = tok_e[t * 4 + hl]; r4 = tok_r[t * 4 + hl]; }
    for (; t < T; t += 2 * NGW) {
        int slot4 = st[e4] + r4;
        const int tn = t + 2 * NGW; int e4n = 0, r4n = 0;
        if (tn < T && hl < 4) { e4n = tok_e[tn * 4 + hl]; r4n = tok_r[tn * 4 + hl]; }
        int slot[4];
#pragma unroll
        for (int k = 0; k < 4; ++k) slot[k] = __builtin_amdgcn_ds_bpermute((half * 32 + k) << 2, slot4);
        const GAS v4u* xr = (const GAS v4u*)(x1b + (size_t)t * D) + hl;
        v4u xw[4], yw[4][4];
#pragma unroll
        for (int q = 0; q < 4; ++q) xw[q] = xr[32 * q];
#pragma unroll
        for (int k = 0; k < 4; ++k) { const GAS v4u* yr = (const GAS v4u*)(yb + (size_t)slot[k] * D) + hl;
#pragma unroll
            for (int q = 0; q < 4; ++q) yw[k][q] = yr[32 * q]; }
        float v[4][8]; float s = 0.f;
#pragma unroll
        for (int q = 0; q < 4; ++q) {
            v[q][0] = bflo(xw[q].x) * DN_ALPHA; v[q][1] = bfhi(xw[q].x) * DN_ALPHA; v[q][2] = bflo(xw[q].y) * DN_ALPHA; v[q][3] = bfhi(xw[q].y) * DN_ALPHA;
            v[q][4] = bflo(xw[q].z) * DN_ALPHA; v[q][5] = bfhi(xw[q].z) * DN_ALPHA; v[q][6] = bflo(xw[q].w) * DN_ALPHA; v[q][7] = bfhi(xw[q].w) * DN_ALPHA;
#pragma unroll
            for (int k = 0; k < 4; ++k) { v[q][0] += bflo(yw[k][q].x); v[q][1] += bfhi(yw[k][q].x); v[q][2] += bflo(yw[k][q].y); v[q][3] += bfhi(yw[k][q].y);
                v[q][4] += bflo(yw[k][q].z); v[q][5] += bfhi(yw[k][q].z); v[q][6] += bflo(yw[k][q].w); v[q][7] += bfhi(yw[k][q].w); }
#pragma unroll
            for (int i = 0; i < 8; ++i) s += v[q][i]; }
        s += shx<1>(s, lane); s += shx<2>(s, lane); s += shx<4>(s, lane); s += shx<8>(s, lane); s += shx<16>(s, lane);
        const float mean = s * (1.f / D); float s2 = 0.f;
#pragma unroll
        for (int q = 0; q < 4; ++q)
#pragma unroll
            for (int i = 0; i < 8; ++i) { v[q][i] -= mean; s2 += v[q][i] * v[q][i]; }
        s2 += shx<1>(s2, lane); s2 += shx<2>(s2, lane); s2 += shx<4>(s2, lane); s2 += shx<8>(s2, lane); s2 += shx<16>(s2, lane);
        const float rstd = 1.f / sqrtf(s2 * (1.f / D) + LN_EPS);
        GAS f32x4* orow = (GAS f32x4*)(dst + (size_t)t * D) + 2 * hl; GAS v4u* o16 = (GAS v4u*)(xb + (size_t)t * D) + hl;
#pragma unroll
        for (int q = 0; q < 4; ++q) { const GAS f32x4* gq = (const GAS f32x4*)(lgp + 256 * q) + 2 * hl; const GAS f32x4* bq = (const GAS f32x4*)(lbp + 256 * q) + 2 * hl;
            const f32x4 g0 = gq[0], g1 = gq[1], b0 = bq[0], b1 = bq[1];
            f32x4 y0 = {v[q][0] * rstd, v[q][1] * rstd, v[q][2] * rstd, v[q][3] * rstd}, y1 = {v[q][4] * rstd, v[q][5] * rstd, v[q][6] * rstd, v[q][7] * rstd};
            y0 = y0 * g0 + b0; y1 = y1 * g1 + b1;
            orow[64 * q] = y0 * dmult; orow[64 * q + 1] = y1 * dmult;
            if (write_xb) o16[32 * q] = (v4u){pk2(y0.x, y0.y), pk2(y0.z, y0.w), pk2(y1.x, y1.y), pk2(y1.z, y1.w)}; }
        e4 = e4n; r4 = r4n;
    }
}

template <int WHICH> __device__ __forceinline__ void p_attention(Frame& F, int l) {
    const bf16* hb = (const bf16*)(F.ws + WS_H); unsigned char* a2 = F.ws + WS_A2;
    const bf16* kB = (const bf16*)(a2 + A2_KB); const bf16* kr = (const bf16*)(a2 + A2_KR); const bf16* qc = (const bf16*)(a2 + A2_QC); const bf16* kvc = (const bf16*)(a2 + A2_KVC);
    bf16* ya = (bf16*)(a2 + A2_YA); bf16* yb = (bf16*)(a2 + A2_YB); bf16* yc = (bf16*)(a2 + A2_YC);
    att::ALAS_PTR lds = (att::ALAS_PTR)F.lds;
    att::NoSide noside;
    __syncthreads();
    if (WHICH == 0) {
        float mq = fabsf((INP(3) + l * 64)[F.lane]), mk = fabsf((INP(4) + l * 64)[F.lane]);
#define MX_STEP(O) { mq = fmaxf(mq, shx<O>(mq, F.lane)); mk = fmaxf(mk, shx<O>(mk, F.lane)); }
        MX_STEP(1) MX_STEP(2) MX_STEP(4) MX_STEP(8) MX_STEP(16) MX_STEP(32)
#undef MX_STEP
        const float cref = __int_as_float(__builtin_amdgcn_readfirstlane(__float_as_int(8.0f * LOG2E_F * 1.03f * mq * mk)));
        const bool fixed_ok = cref < 60.0f;
        unsigned char* wbl = F.ws + WS_W + (size_t)l * WB_LAYER;
        MoeConv cv; cv.Wgu = INP(17) + (size_t)l * NE * 1024 * 2048; cv.Wdn = INP(19) + (size_t)l * NE * 1024 * 1024; cv.Tgu = (bf16*)(wbl + WB_GU); cv.Tdn = (bf16*)(wbl + WB_DN);
        cv.scr = (LAS float*)(F.lds + CONV_LDS_OFF + F.wave * CONV_LDS_WAVE); cv.lane = F.lane; cv.ngw = F.G * NWAVES; cv.gw = F.vcu * NWAVES + F.wave; cv.s = 0;
        cv.nmini = 4 * ((CONV_ITEMS - cv.gw + cv.ngw - 1) / cv.ngw);
#pragma unroll
        for (int i_ = 0; i_ < 8; ++i_) { cv.cvA[i_] = 0.f; cv.cvB[i_] = 0.f; }
        for (int idx = F.vcu; idx < 768; idx += F.G) {
            const int qi = idx >> 8, rem = idx & 255, bk = rem >> 5, qb = rem & 31, b = bk >> 1, kvh = bk & 1, head = kvh * 3 + qi;
            att::UnitP u; const size_t tb = (size_t)b * SEQ, tq = tb + (size_t)qb * 256;
            u.Q = hb + tq * DINP + H_GQ + head * 64; u.ldq = DINP; u.K0 = kB + tb * 128 + kvh * 64; u.ldk0 = 128; u.K1 = nullptr; u.ldk1 = 0;
            u.V = hb + tb * DINP + H_GV + kvh * 64; u.ldv = DINP; u.O = yb + tq * 384 + head * 64; u.ldo = 384; u.nt = SEQ / 64; u.grow0 = qb * 4; u.gain = INP(3) + l * 64; u.kr0 = 0; u.cref = cref;
            if (fixed_ok) att::attn_unit<64, 0, MoeConv>(u, lds, F.tid, cv); else att::attn_unit<64, 3, MoeConv>(u, lds, F.tid, cv);
        }
        while (!cv.done()) { cv.step<0>(); cv.step<1>(); }
    }
    if (WHICH == 1) for (int idx = F.vcu; idx < 512; idx += F.G) {
        const int rnd = idx >> 8, rem = idx & 255, p = (rem >> 5) * 2 + rnd, qb = rem & 31, b = p >> 2, h = p & 3;
        att::UnitP u; const size_t tb = (size_t)b * SEQ, tq = tb + (size_t)qb * 256;
        u.Q = qc + tq * 384 + h * 96; u.ldq = 384; u.K0 = kvc + tb * 512 + h * 128; u.ldk0 = 512; u.K1 = kr + tb * 32; u.ldk1 = 32;
        u.V = kvc + tb * 512 + h * 128 + 64; u.ldv = 512; u.O = yc + tq * 384 + h * 64; u.ldo = 384; u.nt = SEQ / 64; u.grow0 = qb * 4; u.gain = nullptr; u.kr0 = 0; u.cref = 0.f;
        att::attn_unit<96, 1>(u, lds, F.tid, noside);
    }
    if (WHICH == 2) for (int idx = F.vcu; idx < 768; idx += F.G) {
        const int b = idx / 192, rem = idx % 192, h = rem >> 5, rg = rem & 31, R0 = rg * 4;
        int r_lo = R0 - 4; r_lo = r_lo < 0 ? 0 : (r_lo > 120 ? 120 : r_lo);
        int r_hi = R0 - 1; r_hi = (r_hi < 0 ? 0 : (r_hi > 120 ? 120 : r_hi)) + 8;
        if ((r_hi - r_lo) & 1) { if (r_hi < 128) ++r_hi; else --r_lo; }
        {
            LAS float* bt = (LAS float*)(F.lds + att::OFF_BIAS); const float* rp = INP(2) + ((size_t)l * 6 + h) * 465;
            if (F.tid < 465) bt[F.tid] = rp[F.tid] * LOG2E_F; }
        att::UnitP u; const size_t tb = (size_t)b * SEQ, tq = tb + (size_t)R0 * 64, tk = tb + (size_t)r_lo * 64;
        u.Q = hb + tq * DINP + H_NAQ + h * 64; u.ldq = DINP; u.K0 = hb + tk * DINP + H_NAK + h * 64; u.ldk0 = DINP; u.K1 = nullptr; u.ldk1 = 0;
        u.V = hb + tk * DINP + H_NAV + h * 64; u.ldv = DINP; u.O = ya + tq * 384 + h * 64; u.ldo = 384; u.nt = r_hi - r_lo; u.grow0 = R0; u.gain = nullptr; u.kr0 = r_lo; u.cref = 0.f;
        att::attn_unit<64, 2>(u, lds, F.tid, noside);
    }
}


struct Args { const float* in[23]; float* out; unsigned char* ws; int ph_lo, ph_hi, use_bar, pad; };
__global__ void __launch_bounds__(NWAVES * 64, 2) mk_fwd(Args args) {
    extern __shared__ __attribute__((aligned(16))) unsigned char lds[];
    const int wave_id = __builtin_amdgcn_readfirstlane((int)threadIdx.x >> 6), bx0 = blockIdx.x, G0 = gridDim.x;
    {   LAS unsigned* z = (LAS unsigned*)((LAS unsigned char*)lds + LDSCTL_OFF); for (int u = threadIdx.x; u < (LDS_BYTES - LDSCTL_OFF) / 4; u += NWAVES * 64) z[u] = 0u; }
    __syncthreads();
    XcdBarrier bar; bar.bar = (unsigned*)(args.ws + WS_CTL) + CW_BAR; bar.x = 0; bar.st = nullptr;
    if (args.use_bar) bar = xcd_barrier_post((unsigned*)(args.ws + WS_CTL) + CW_BAR, (volatile LAS unsigned*)((LAS unsigned char*)lds + MISC_OFF));
    const int lo = args.ph_lo, hi = args.ph_hi;
#define IN(k) (lo <= (k) && (k) < hi)
#define REPEAT(n) for (int rep_ = 0; rep_ < (n); ++rep_)
#define RSEAM(n) do { if (rep_ + 1 < (n)) { XcdBarrier b_ = bar; { GAS unsigned* bb_ = (GAS unsigned*)b_.bar; asm volatile("; rseam %1" : "+s"(bb_) : "n"(__COUNTER__)); b_.bar = (unsigned*)bb_; } xcd_barrier(b_); } } while (0)
#define SEAM(k) do { if (IN(k) && IN((k) + 1)) { XcdBarrier b_ = bar; { GAS unsigned* bb_ = (GAS unsigned*)b_.bar; asm volatile("; seam %1" : "+s"(bb_) : "n"(__COUNTER__)); b_.bar = (unsigned*)bb_; } xcd_barrier(b_); } } while (0)
#define FRAME() Frame F = mkframe<__COUNTER__>((LAS unsigned char*)lds, args.ws, args.out, wave_id, bx0, G0); unsigned char* ws = F.ws; unsigned char* a2 = ws + WS_A2; unsigned char* wb = ws + WS_W + (size_t)l * WB_LAYER; (void)a2; (void)wb

    if (IN(0)) REPEAT(REP_P) { Frame F = mkframe<__COUNTER__>((LAS unsigned char*)lds, args.ws, args.out, wave_id, bx0, G0); p_prologue(F); RSEAM(REP_P); } SEAM(0);

    for (int l = 0; l < DEPTH; ++l) {
        const int pb = 1 + l * PPL;
        if (IN(pb + 0)) REPEAT(REP_A) { FRAME();
            pg8::Gemm g{(const bf16*)(ws + WS_XB), (const bf16*)(wb + WB_IN), T, DINP, 1024, 0, 0}; pg8::StaticOrder S; S.init(T, DINP, F.G, F.bx);
            pg8::EpiStore E{(bf16*)(ws + WS_H), DINP, DINP};
            pg8::gemm_phase<pg8::EpiStore, pg8::StaticOrder, true, true>(F.lds, g, S, E, F.tid); RSEAM(REP_A);
        } SEAM(pb + 0);
        if (IN(pb + 1)) REPEAT(REP_B) { FRAME(); p_prep(F, l); RSEAM(REP_B); } SEAM(pb + 1);
        if (IN(pb + 2)) REPEAT(REP_C) {
            { FRAME(); pg8::Gemm g{(const bf16*)(a2 + A2_CQN), (const bf16*)(wb + WB_UQ), T, 512, 384, 0, 0}; pg8::StaticOrder S; S.init(T, 512, F.G, F.bx);
              pg8::EpiStore E{(bf16*)(a2 + A2_QC), 384, 384};
              pg8::gemm_phase<pg8::EpiStore, pg8::StaticOrder, true, true>(F.lds, g, S, E, F.tid); }
            { FRAME(); pg8::Gemm g{(const bf16*)(a2 + A2_CKVN), (const bf16*)(wb + WB_UKV), T, 512, 256, 0, 0}; pg8::StaticOrder S; S.init(T, 512, F.G, F.bx);
              pg8::EpiStore E{(bf16*)(a2 + A2_KVC), 512, 512};
              pg8::gemm_phase<pg8::EpiStore, pg8::StaticOrder, true, true>(F.lds, g, S, E, F.tid); }
            RSEAM(REP_C);
        } SEAM(pb + 2);
        if (IN(pb + 3)) { REPEAT(REP_DG) { FRAME(); p_attention<0>(F, l); RSEAM(REP_DG); } REPEAT(REP_DM) { FRAME(); p_attention<1>(F, l); RSEAM(REP_DM); } REPEAT(REP_DN) { FRAME(); p_attention<2>(F, l); RSEAM(REP_DN); } } SEAM(pb + 3);
        if (IN(pb + 4)) REPEAT(REP_E) { FRAME();
            pg8::Gemm g{(const bf16*)(a2 + A2_YA), (const bf16*)(wb + WB_BA), T, 1024, 384, (size_t)1024 * 384 * 2, (size_t)T * 384 * 2};
            pg8::ChainOrder S; S.so.init(T, 1024, F.G, F.bx); S.nch = 3;
            pg8::EpiGateChain E{(const bf16*)(ws + WS_H) + H_GATE, DINP, (bf16*)(a2 + A2_MIXED)};
            pg8::gemm_phase<pg8::EpiGateChain, pg8::ChainOrder, true, true>(F.lds, g, S, E, F.tid);
            RSEAM(REP_E);
        } SEAM(pb + 4);
        if (IN(pb + 5)) REPEAT(REP_F) { FRAME();
            pg8::Gemm g{(const bf16*)(a2 + A2_MIXED), (const bf16*)(wb + WB_OUT), T, 1024, 1024, 0, 0}; pg8::StaticOrder S; S.init(T, 1024, F.G, F.bx);
            pg8::EpiStore E{(bf16*)(ws + WS_X1), 1024, 1024};
            pg8::gemm_phase<pg8::EpiStore, pg8::StaticOrder, true, true>(F.lds, g, S, E, F.tid); RSEAM(REP_F);
        } SEAM(pb + 5);
        if (IN(pb + 6)) { FRAME(); p_ln1_router(F, l, (l == 0) ? INP(0) : (const float*)(ws + WS_X2)); } SEAM(pb + 6);
        if (IN(pb + 7)) REPEAT(REP_I) { FRAME();
            const int total = build_tables(F, l);
            pg8::Gemm g{(const bf16*)(ws + WS_X1B), (const bf16*)(wb + WB_GU), total, 2048, 1024, (size_t)2048 * 1024 * 2, 0};
            pg8::MoeGather gs{(const int*)(ws + WS_LT), (const LAS int*)(F.lds + TBL_START), (const LAS int*)(F.lds + TBL_START) + 33, LCAP};
            pg8::MoeOrder S{8, (total >> 8) * 8, F.G, F.vcu, (const LAS int*)(F.lds + TBL_TILEE)};
            pg8::EpiSwiglu E{(bf16*)(ws + WS_A2), INP(18) + (size_t)l * NE * 2048};
            pg8::gemm_phase<pg8::EpiSwiglu, pg8::MoeOrder, true, true, true, pg8::MoeGather>(F.lds, g, S, E, F.tid, gs); RSEAM(REP_I);
        } SEAM(pb + 7);
        if (IN(pb + 8)) REPEAT(REP_J) { FRAME();
            const int total = build_tables(F, l);
            pg8::Gemm g{(const bf16*)(ws + WS_A2), (const bf16*)(wb + WB_DN), total, 1024, 1024, (size_t)1024 * 1024 * 2, 0};
            pg8::MoeOrder S{4, (total >> 8) * 4, F.G, F.vcu, (const LAS int*)(F.lds + TBL_TILEE)};
            pg8::EpiDown E{(bf16*)(ws + WS_H), INP(20) + (size_t)l * NE * 1024, (const float*)(ws + WS_LG), (const LAS int*)(F.lds + TBL_START), (const LAS int*)(F.lds + TBL_START) + 33, LCAP};
            pg8::gemm_phase<pg8::EpiDown, pg8::MoeOrder, true, true>(F.lds, g, S, E, F.tid); RSEAM(REP_J);
        } SEAM(pb + 8);
        if (IN(pb + 9)) REPEAT(REP_K) { FRAME(); RSEAM(REP_K); p_ln2(F, l, (l == DEPTH - 1) ? F.out : (float*)(ws + WS_X2), l + 1 < DEPTH); }
        if (l + 1 < DEPTH) SEAM(pb + 9);
    }
#undef IN
#undef SEAM
}


#if MK_DEBUG
constexpr int CW_DBG = 20000;
__device__ __forceinline__ float bfr(float f) { return __uint_as_float(f2bf(f) << 16); }
__device__ __forceinline__ float bfv(const bf16* p) { return __uint_as_float(((unsigned)*p) << 16); }
__device__ __forceinline__ unsigned hsh(unsigned x) { x ^= x >> 16; x *= 0x7feb352du; x ^= x >> 15; x *= 0x846ca68bu; x ^= x >> 16; return x; }
__device__ __forceinline__ bool close_(float got, float ref, float rel, float abs_) { return fabsf(got - ref) <= rel * fabsf(ref) + abs_; }
__device__ __forceinline__ void ropecs(int i, int quarter, int s, float& c, float& sn) {
    const float pos = (i < quarter) ? (float)(s >> 6) : (float)(s & 63); const int m = (i < quarter) ? i : i - quarter;
    const float inv = exp2f(-(float)m / (float)quarter * 13.287712379549449f); const float ang = pos * inv * 0.15915494309189535f; c = __builtin_amdgcn_cosf(ang); sn = __builtin_amdgcn_sinf(ang);
}
#define DBG_FAIL(bit) atomicOr((unsigned*)(ws + WS_CTL) + CW_DBG, 1u << (bit))
template <int stage> __global__ void __launch_bounds__(256) dbg_kernel(Args args) {
    unsigned char* ws = args.ws; const int l = 0;
    const int gid = blockIdx.x * 256 + threadIdx.x;
    const bf16* hb = (const bf16*)(ws + WS_H); unsigned char* a2 = ws + WS_A2; unsigned char* wb = ws + WS_W + (size_t)l * WB_LAYER;
    const bf16* kB = (const bf16*)(a2 + A2_KB); const bf16* cqn = (const bf16*)(a2 + A2_CQN); const bf16* ckvn = (const bf16*)(a2 + A2_CKVN); const bf16* kr = (const bf16*)(a2 + A2_KR);
    const bf16* qc = (const bf16*)(a2 + A2_QC); const bf16* kvc = (const bf16*)(a2 + A2_KVC);
    const bf16* ya = (const bf16*)(a2 + A2_YA); const bf16* yb = (const bf16*)(a2 + A2_YB); const bf16* yc = (const bf16*)(a2 + A2_YC);
    const unsigned h1 = hsh(gid * 2654435761u + 12345u + stage * 977u), h2 = hsh(h1 + 0x9e3779b9u);
    const int t = h1 % T, s = t & (SEQ - 1), b = t / SEQ;
    if (stage == 0) {
        const int n = h2 % DIN; const float* x = args.in[0] + (size_t)t * D; const float* W = args.in[1];
        const float sc = (n < 384) ? 0.125f * LOG2E_F : 1.0f; float r = 0.f;
        for (int k = 0; k < 1024; ++k) r += bfr(x[k]) * bfr(W[(size_t)k * DIN + n] * sc);
        if (!close_(bfv(hb + (size_t)t * DINP + n), r, 0.02f, 0.02f)) DBG_FAIL(1);
    }
    if (stage == 1) {
        const bf16* hr = hb + (size_t)t * DINP;
        {   const int d = h2 % 128, head = d >> 6, dd = d & 63; float ssq = 0.f;
            for (int k = 0; k < 64; ++k) { const float v = bfv(hr + H_GK + head * 64 + k); ssq += v * v; }
            const float rstd = 1.0f / sqrtf(ssq / 64.0f + RMS_EPS); const float* g = args.in[4];
            const int i = dd & 31; const float y1 = bfv(hr + H_GK + head * 64 + i) * rstd * g[i], y2 = bfv(hr + H_GK + head * 64 + i + 32) * rstd * g[i + 32];
            float c, sn; ropecs(i, 16, s, c, sn); const float ref = (dd < 32) ? (y1 * c - y2 * sn) : (y1 * sn + y2 * c);
            if (!close_(bfv(kB + (size_t)t * 128 + d), ref, 0.02f, 0.01f)) DBG_FAIL(2); }
        {   const int d = h2 % 384; float ssq = 0.f; for (int k = 0; k < 384; ++k) { const float v = bfv(hr + H_CQ + k); ssq += v * v; }
            const float ref = bfv(hr + H_CQ + d) / sqrtf(ssq / 384.0f + RMS_EPS) * args.in[5][d];
            if (!close_(bfv(cqn + (size_t)t * 384 + d), ref, 0.02f, 0.01f)) DBG_FAIL(3); }
        {   const int d = h2 % 256; float ssq = 0.f; for (int k = 0; k < 256; ++k) { const float v = bfv(hr + H_CKV + k); ssq += v * v; }
            const float ref = bfv(hr + H_CKV + d) / sqrtf(ssq / 256.0f + RMS_EPS) * args.in[6][d];
            if (!close_(bfv(ckvn + (size_t)t * 256 + d), ref, 0.02f, 0.01f)) DBG_FAIL(4); }
        {   const int d = h2 % 32, i = d & 15; const float x1 = bfv(hr + H_KR + i), x2 = bfv(hr + H_KR + i + 16); float c, sn; ropecs(i, 8, s, c, sn);
            const float ref = (d < 16) ? (x1 * c - x2 * sn) : (x1 * sn + x2 * c);
            if (!close_(bfv(kr + (size_t)t * 32 + d), ref, 0.02f, 0.01f)) DBG_FAIL(5); }
    }
    if (stage == 2) {
        {   const int n = h2 % 384; float r = 0.f; const float sc = 0.10206207261596577f * LOG2E_F;
            for (int k = 0; k < 384; ++k) r += bfv(cqn + (size_t)t * 384 + k) * bfr(args.in[7][(size_t)k * 384 + n] * sc);
            if (!close_(bfv(qc + (size_t)t * 384 + n), r, 0.02f, 0.01f)) DBG_FAIL(6); }
        {   const int n = h2 % 512; float r = 0.f;
            for (int k = 0; k < 256; ++k) r += bfv(ckvn + (size_t)t * 256 + k) * bfr(args.in[8][(size_t)k * 512 + n]);
            if (!close_(bfv(kvc + (size_t)t * 512 + n), r, 0.02f, 0.02f)) DBG_FAIL(7); }
    }
    if (stage == 3) {
        const int gr = s >> 6, gc = s & 63;
        if (gid < 1024) {
            const int h = h2 % 6, dofs = ((h2 >> 8) & 1) * 32; float q[64], o[32];
            _Pragma("unroll") for (int d = 0; d < 64; ++d) { q[d] = bfv(hb + (size_t)t * DINP + H_NAQ + h * 64 + d); }
            _Pragma("unroll") for (int d = 0; d < 32; ++d) o[d] = 0.f;
            int r0 = gr - 4; r0 = r0 < 0 ? 0 : (r0 > 120 ? 120 : r0); int c0 = gc - 8; c0 = c0 < 0 ? 0 : (c0 > 48 ? 48 : c0);
            const float* rp = args.in[2] + (size_t)h * 465; float m = -1e30f, lsum = 0.f;
            for (int pass = 0; pass < 2; ++pass)
                for (int i = 0; i < 8; ++i) for (int j = 0; j < 16; ++j) { const int kr_ = r0 + i, kc = c0 + j; const size_t kt = (size_t)b * SEQ + kr_ * 64 + kc;
                    float sc = 0.f; _Pragma("unroll") for (int d = 0; d < 64; ++d) sc += q[d] * bfv(hb + kt * DINP + H_NAK + h * 64 + d);
                    sc += rp[(kr_ - gr + 7) * 31 + (kc - gc + 15)] * LOG2E_F;
                    if (pass == 0) m = fmaxf(m, sc); else { const float p = exp2f(sc - m); lsum += p; _Pragma("unroll") for (int d = 0; d < 32; ++d) o[d] += p * bfv(hb + kt * DINP + H_NAV + h * 64 + dofs + d); } }
            bool bad = false; _Pragma("unroll") for (int d = 0; d < 32; ++d) bad |= !close_(bfv(ya + (size_t)t * 384 + h * 64 + dofs + d), o[d] / lsum, 0.03f, 0.01f);
            if (bad) DBG_FAIL(8);
        } else if (gid < 1024 + 128) {
            const int head = h2 % 6, kvh = head / 3, dofs = ((h2 >> 8) & 1) * 32; float q[64], o[32]; float ssq = 0.f;
            _Pragma("unroll") for (int d = 0; d < 64; ++d) { q[d] = bfv(hb + (size_t)t * DINP + H_GQ + head * 64 + d); ssq += q[d] * q[d]; }
            _Pragma("unroll") for (int d = 0; d < 32; ++d) o[d] = 0.f;
            const float rstd = 1.0f / sqrtf(ssq / 64.0f + RMS_EPS);
            _Pragma("unroll") for (int d = 0; d < 64; ++d) q[d] = q[d] * rstd * args.in[3][d];
            _Pragma("unroll") for (int i = 0; i < 32; ++i) { float c, sn; ropecs(i, 16, s, c, sn); const float y1 = q[i], y2 = q[i + 32]; q[i] = y1 * c - y2 * sn; q[i + 32] = y1 * sn + y2 * c; }
            _Pragma("unroll") for (int d = 0; d < 64; ++d) q[d] = bfr(q[d] * 0.125f * LOG2E_F);
            float m = -1e30f, lsum = 0.f;
            for (int key = 0; key < SEQ; ++key) { const size_t kt = (size_t)b * SEQ + key; float sc = 0.f;
                _Pragma("unroll") for (int d = 0; d < 64; ++d) sc += q[d] * bfv(kB + kt * 128 + kvh * 64 + d);
                const float mn = fmaxf(m, sc), al = exp2f(m - mn), p = exp2f(sc - mn); m = mn; lsum = lsum * al + p;
                _Pragma("unroll") for (int d = 0; d < 32; ++d) o[d] = o[d] * al + p * bfv(hb + kt * DINP + H_GV + kvh * 64 + dofs + d); }
            bool bad = false; _Pragma("unroll") for (int d = 0; d < 32; ++d) bad |= !close_(bfv(yb + (size_t)t * 384 + head * 64 + dofs + d), o[d] / lsum, 0.03f, 0.003f);
            if (bad) DBG_FAIL(9);
        } else if (gid < 1024 + 256) {
            const int h = h2 % 4, dofs = ((h2 >> 8) & 1) * 32; float q[96], o[32];
            _Pragma("unroll") for (int d = 0; d < 96; ++d) q[d] = bfv(qc + (size_t)t * 384 + h * 96 + d);
            _Pragma("unroll") for (int i = 0; i < 16; ++i) { float c, sn; ropecs(i, 8, s, c, sn); const float y1 = q[64 + i], y2 = q[80 + i]; q[64 + i] = bfr(y1 * c - y2 * sn); q[80 + i] = bfr(y1 * sn + y2 * c); }
            _Pragma("unroll") for (int d = 0; d < 32; ++d) o[d] = 0.f;
            float m = -1e30f, lsum = 0.f;
            for (int key = 0; key < SEQ; ++key) { const size_t kt = (size_t)b * SEQ + key; float sc = 0.f;
                _Pragma("unroll") for (int d = 0; d < 64; ++d) sc += q[d] * bfv(kvc + kt * 512 + h * 128 + d);
                _Pragma("unroll") for (int d = 0; d < 32; ++d) sc += q[64 + d] * bfv(kr + kt * 32 + d);
                const float mn = fmaxf(m, sc), al = exp2f(m - mn), p = exp2f(sc - mn); m = mn; lsum = lsum * al + p;
                _Pragma("unroll") for (int d = 0; d < 32; ++d) o[d] = o[d] * al + p * bfv(kvc + kt * 512 + h * 128 + 64 + dofs + d); }
            bool bad = false; _Pragma("unroll") for (int d = 0; d < 32; ++d) bad |= !close_(bfv(yc + (size_t)t * 384 + h * 64 + dofs + d), o[d] / lsum, 0.03f, 0.003f);
            if (bad) DBG_FAIL(10);
        }
    }
    if (stage == 4) {
        const int n = h2 % 1024; float r = 0.f;
        { float a = 0.f; for (int k = 0; k < 384; ++k) a += bfv(ya + (size_t)t * 384 + k) * bfr(args.in[9][(size_t)k * 1024 + n]); r += a / (1.0f + expf(-bfv(hb + (size_t)t * DINP + H_GATE + n))); }
        { float a = 0.f; for (int k = 0; k < 384; ++k) a += bfv(yb + (size_t)t * 384 + k) * bfr(args.in[10][(size_t)k * 1024 + n]); r += a / (1.0f + expf(-bfv(hb + (size_t)t * DINP + H_GATE + 1024 + n))); }
        { float a = 0.f; for (int k = 0; k < 256; ++k) a += bfv(yc + (size_t)t * 384 + k) * bfr(args.in[11][(size_t)k * 1024 + n]); r += a / (1.0f + expf(-bfv(hb + (size_t)t * DINP + H_GATE + 2048 + n))); }
        if (!close_(bfv((const bf16*)(a2 + A2_MIXED) + (size_t)t * 1024 + n), r, 0.02f, 0.003f)) DBG_FAIL(11);
    }
    if (stage == 5) {
        const int n = h2 % 1024; float r = 0.f; const bf16* mx = (const bf16*)(a2 + A2_MIXED) + (size_t)t * 1024;
        for (int k = 0; k < 1024; ++k) r += bfv(mx + k) * bfr(args.in[12][(size_t)k * 1024 + n]);
        if (!close_(bfv((const bf16*)(ws + WS_X1) + (size_t)t * D + n), r, 0.02f, 0.002f)) DBG_FAIL(12);
    }
    if (stage == 6) {
        const bf16* x1 = (const bf16*)(ws + WS_X1B) + (size_t)t * D; const int* tok_e = (const int*)(ws + WS_TE); const int* tok_r = (const int*)(ws + WS_TR);
        const int* list_t = (const int*)(ws + WS_LT); const float* list_g = (const float*)(ws + WS_LG);
        float lg[32]; _Pragma("unroll") for (int e = 0; e < 32; ++e) lg[e] = args.in[16][e];
        for (int k = 0; k < 1024; ++k) { const float xv = bfv(x1 + k); _Pragma("unroll") for (int e = 0; e < 32; ++e) lg[e] += xv * args.in[15][(size_t)k * 32 + e]; }
        int se[4]; float sv[4]; unsigned used = 0;
        _Pragma("unroll") for (int r = 0; r < 4; ++r) { int be = -1; float bv = -INFINITY; _Pragma("unroll") for (int e = 0; e < 32; ++e) if (!((used >> e) & 1) && lg[e] > bv) { bv = lg[e]; be = e; } se[r] = be; sv[r] = bv; used |= 1u << be; }
        float fifth = -INFINITY; _Pragma("unroll") for (int e = 0; e < 32; ++e) if (!((used >> e) & 1)) fifth = fmaxf(fifth, lg[e]);
        const bool neartie = (sv[3] - fifth) < 3e-2f || (sv[0] - sv[1]) < 3e-2f || (sv[1] - sv[2]) < 3e-2f || (sv[2] - sv[3]) < 3e-2f;
        float den = 0.f; _Pragma("unroll") for (int r = 0; r < 4; ++r) den += expf(sv[r] - sv[0]);
        bool bad = false, badg = false;
        if (!neartie) _Pragma("unroll") for (int r = 0; r < 4; ++r) { const int e = tok_e[t * 4 + r], rk = tok_r[t * 4 + r]; if (e != se[r]) { bad = true; continue; }
            if (rk < 0 || rk >= LCAP || list_t[(size_t)e * LCAP + rk] != t) badg = true; else if (!close_(list_g[(size_t)e * LCAP + rk], expf(sv[r] - sv[0]) / den, 0.03f, 1e-3f)) badg = true; }
        if (bad) DBG_FAIL(13); if (badg) DBG_FAIL(14);
        { float sm = 0.f, sq = 0.f; for (int k = 0; k < 1024; ++k) { const float z = (bfv(x1 + k) - args.in[14][k]) / args.in[13][k]; sm += z; sq += z * z; }
          if (fabsf(sm / 1024.f) > 4e-3f || fabsf(sq / 1024.f - 1.0f) > 2e-2f) DBG_FAIL(19); }
    }
    if (stage >= 7 && stage <= 9) {
        __shared__ int st[33], cn[32];
        if (threadIdx.x == 0) { int a = 0; for (int e2 = 0; e2 < 32; ++e2) { cn[e2] = (int)((const unsigned*)(ws + WS_CTL))[CW_CNT + 64 * l + e2]; st[e2] = a; a += ((cn[e2] + 255) >> 8) << 8; } st[32] = a; }
        __syncthreads();
        const int total = st[32]; const int sl = h1 % total; int e = 0; for (int k = 1; k < 32; ++k) if (sl >= st[k]) e = k; const int r = sl - st[e];
        const int* list_t = (const int*)(ws + WS_LT); const float* list_g = (const float*)(ws + WS_LG); const float* sg = (const float*)(ws + WS_SG);
        if (stage == 7) { int sum = 0; for (int k = 0; k < 32; ++k) sum += cn[k]; if (sum != TK) DBG_FAIL(15); }
        if (stage == 7 && r < cn[e]) {
            const bf16* xg = (const bf16*)(ws + WS_X1B) + (size_t)list_t[(size_t)e * LCAP + r] * D; const int f = h2 % 1024; const float* W = args.in[17] + (size_t)e * 1024 * 2048;
            float g = args.in[18][e * 2048 + f], u = args.in[18][e * 2048 + 1024 + f];
            for (int k = 0; k < 1024; ++k) { const float xv = bfv(xg + k); g += xv * bfr(W[(size_t)k * 2048 + f]); u += xv * bfr(W[(size_t)k * 2048 + 1024 + f]); }
            g = fminf(g, 7.0f); u = fminf(fmaxf(u, -7.0f), 7.0f); const float ref = g / (1.0f + expf(-1.702f * g)) * (u + 1.0f);
            if (!close_(bfv((const bf16*)(ws + WS_A2) + (size_t)sl * 1024 + f), ref, 0.03f, 0.02f)) DBG_FAIL(16);
        }
        if (stage == 8 && r < cn[e]) {
            const bf16* ab = (const bf16*)(ws + WS_A2) + (size_t)sl * 1024; const int n = h2 % 1024; const float* W = args.in[19] + (size_t)e * 1024 * 1024;
            float y = args.in[20][e * 1024 + n]; for (int k = 0; k < 1024; ++k) y += bfv(ab + k) * bfr(W[(size_t)k * 1024 + n]);
            y *= list_g[(size_t)e * LCAP + r];
            if (!close_(bfv((const bf16*)(ws + WS_H) + (size_t)sl * 1024 + n), y, 0.03f, 0.005f)) DBG_FAIL(17);
        }
        if (stage == 9) {
            const bf16* x1 = (const bf16*)(ws + WS_X1B) + (size_t)t * D; const int* tok_e = (const int*)(ws + WS_TE); const int* tok_r = (const int*)(ws + WS_TR);
            const bf16* ybf = (const bf16*)(ws + WS_H); float sm = 0.f, sq = 0.f; const int n = h2 % 1024; float vn = 0.f;
            for (int k = 0; k < 1024; ++k) { float v = DN_ALPHA * bfv(x1 + k); for (int q = 0; q < 4; ++q) v += bfv(ybf + (size_t)(st[tok_e[t * 4 + q]] + tok_r[t * 4 + q]) * D + k); sm += v; sq += v * v; if (k == n) vn = v; }
            const float mean = sm / 1024.f, var = sq / 1024.f - mean * mean; const float ref = (vn - mean) / sqrtf(var + LN_EPS) * args.in[21][n] + args.in[22][n];
            if (!close_(((const float*)(ws + WS_X2))[(size_t)t * D + n], ref, 0.005f, 0.003f)) DBG_FAIL(18);
        }
    }
}
static void dbg_launch(int stage, const Args& a, hipStream_t stream) {
    switch (stage) {
#define DBGL(k) case k: hipLaunchKernelGGL(dbg_kernel<k>, dim3(8), dim3(256), 0, stream, a); break;
        DBGL(0) DBGL(1) DBGL(2) DBGL(3) DBGL(4) DBGL(5) DBGL(6) DBGL(7) DBGL(8) DBGL(9)
#undef DBGL
    }
}
#endif

extern "C" void kernel_launch(void* const* d_in, const int* in_sizes, int n_in, void* d_out, int out_size, void* d_ws, size_t ws_size, hipStream_t stream) {
    static int grid = 0;
    if (grid == 0) {
        if (n_in != 23 || in_sizes[0] != T * D || out_size != T * D || ws_size < WS_END) { fprintf(stderr, "kernel_launch: unexpected shapes / workspace (%d inputs, ws %zu, need %zu)\n", n_in, ws_size, (size_t)WS_END); grid = -1; return; }
        int dev = 0, cus = 0, per_cu = 0;
        if (hipGetDevice(&dev) != hipSuccess || hipDeviceGetAttribute(&cus, hipDeviceAttributeMultiprocessorCount, dev) != hipSuccess) { grid = -1; return; }
        if (hipFuncSetAttribute((const void*)mk_fwd, hipFuncAttributeMaxDynamicSharedMemorySize, LDS_BYTES) != hipSuccess) { fprintf(stderr, "kernel_launch: hipFuncSetAttribute failed\n"); grid = -1; return; }
        if (hipOccupancyMaxActiveBlocksPerMultiprocessor(&per_cu, (const void*)mk_fwd, NWAVES * 64, LDS_BYTES) != hipSuccess || per_cu < 1) { fprintf(stderr, "kernel_launch: occupancy query reports %d\n", per_cu); }
        (void)hipGetLastError();
        grid = cus;
    }
    if (grid < 0) return;
    if (hipMemsetAsync((char*)d_ws + WS_CTL, 0, CTL_ZERO_BYTES, stream) != hipSuccess) return;
    Args a{};
    for (int i = 0; i < 23; ++i) a.in[i] = (const float*)d_in[i];
    a.out = (float*)d_out; a.ws = (unsigned char*)d_ws; a.pad = 0;
#if MK_ONE_LAUNCH
    a.ph_lo = 0; a.ph_hi = NPH; a.use_bar = 1;
    hipLaunchKernelGGL(mk_fwd, dim3(grid), dim3(NWAVES * 64), LDS_BYTES, stream, a);
#else
    for (int p = 0; p < NPH; ++p) { a.ph_lo = p; a.ph_hi = p + 1; a.use_bar = 0; hipLaunchKernelGGL(mk_fwd, dim3(grid), dim3(NWAVES * 64), LDS_BYTES, stream, a);
#if MK_DEBUG
        if (p >= 1 && p <= PPL) dbg_launch(p - 1, a, stream);
#endif
    }
#endif
    const hipError_t le = hipPeekAtLastError();
    if (le != hipSuccess) fprintf(stderr, "kernel_launch: launch failed: %s\n", hipGetErrorName(le));
}
```

```cpp
#define MK_DEBUG 0
#define MK_ONE_LAUNCH 1
#include <hip/hip_runtime.h>
#include <hip/hip_bf16.h>
#include <cstdio>
#include <cstdint>
namespace pg8 {
#define PG8_LAS __attribute__((address_space(3)))
typedef unsigned short bf16_t;
typedef short bf16x8 __attribute__((ext_vector_type(8)));
typedef float f32x4 __attribute__((ext_vector_type(4)));
typedef unsigned u32x4 __attribute__((ext_vector_type(4)));
constexpr int BM = 256, BK = 64, HALF = 128, HTB = HALF * BK * 2  , STAGE_BYTES = 8 * HTB, NXCD = 8, WGM = 8;

__host__ __device__ __forceinline__ int lds_byte(int r, int c) { const int st = (r >> 4) * 2 + (c >> 5), rr = r & 15, cc = c & 31, ob = rr * 64 + cc * 2; return st * 1024 + (ob ^ (((ob >> 9) & 1) << 5)); }
__host__ __device__ __forceinline__ void stage_rc(int b, int& R, int& C) { const int st = b / 1024, sb = b % 1024, swz = sb ^ (((sb >> 9) & 1) << 5); R = (st >> 1) * 16 + swz / 64; C = (st & 1) * 32 + (swz % 64) / 2; }
__host__ __device__ __forceinline__ int perm32(int rho) { const int n = rho >> 4, i = rho & 15; return 8 * (i >> 2) + 4 * n + (i & 3); }

struct Unit { int pm, pn, e; };
struct Gemm { const bf16_t* A; const bf16_t* Bt; int M, N, K; size_t bstride; size_t astride; };

struct StaticOrder {
    int nM, nN, nwg, G, c;
    __host__ __device__ void init(int M, int N, int G_, int c_) { nM = M / BM; nN = N / BM; nwg = nM * nN; G = G_; c = c_; }
    __host__ __device__ bool next(int i, Unit& u) const {
        const long L = (long)i * G + c; if (L >= nwg) return false;
        int wgid = (int)L; { const int q = nwg / NXCD, r = nwg % NXCD, xcd = wgid % NXCD, off = wgid / NXCD; wgid = (xcd < r ? xcd * (q + 1) : r * (q + 1) + (xcd - r) * q) + off; }
        const int nig = WGM * nN, gid = wgid / nig, fm = gid * WGM, gsz = (nM - fm) < WGM ? (nM - fm) : WGM;
        u.pm = fm + ((wgid % nig) % gsz); u.pn = (wgid % nig) / gsz; u.e = 0; return true;
    }
    __device__ __forceinline__ void a_ready(const Unit&) const {}
    __device__ __forceinline__ void done(const Unit&) const {}
};

__device__ __forceinline__ unsigned cvt_pk_bf16(float lo, float hi) { unsigned r; asm volatile("v_cvt_pk_bf16_f32 %0, %1, %2" : "=v"(r) : "v"(lo), "v"(hi)); return r; }
typedef float f32x2 __attribute__((ext_vector_type(2)));


__device__ __forceinline__ float bf_lo(unsigned w) { return __uint_as_float(w << 16); }
__device__ __forceinline__ float bf_hi(unsigned w) { return __uint_as_float(w & 0xffff0000u); }
__device__ __forceinline__ float sigmoidf_(float z) { return __builtin_amdgcn_rcpf(1.0f + __builtin_amdgcn_exp2f(-1.4426950408889634f * z)); }
__device__ __forceinline__ u32x4 pack8(const f32x4& v0, const f32x4& v1) { u32x4 w; w.x = cvt_pk_bf16(v0[0], v0[1]); w.y = cvt_pk_bf16(v0[2], v0[3]); w.z = cvt_pk_bf16(v1[0], v1[1]); w.w = cvt_pk_bf16(v1[2], v1[3]); return w; }

struct EpiStore {
    static constexpr bool PERM = true, AFTER_DRAIN = false, CHAIN = false;
    bf16_t* O; int ldc; int nvalid;
    __device__ __forceinline__ void operator()(const f32x4 (&acc)[2][2][4][2], const Unit& u, int wr, int wc, int fr, int fq) const {
        const int row0 = u.pm * BM + wr * 64 + fr, col0 = u.pn * BM + wc * 32 + 8 * fq;
#pragma unroll
        for (int ai = 0; ai < 2; ++ai)
#pragma unroll
            for (int m = 0; m < 4; ++m) { bf16_t* rowp = O + (size_t)(row0 + ai * HALF + m * 16) * ldc + col0;
#pragma unroll
                for (int bj = 0; bj < 2; ++bj) { if (col0 + bj * HALF < nvalid) *(u32x4*)(rowp + bj * HALF) = pack8(acc[ai][bj][m][0], acc[ai][bj][m][1]); } }
    }
};
struct EpiGateChain {
    static constexpr bool PERM = true, AFTER_DRAIN = false, CHAIN = true;
    const bf16_t* gate; int ldg; bf16_t* mixed;
    __device__ __forceinline__ void chain(f32x4 (&acc)[2][2][4][2], const Unit& u, int wr, int wc, int fr, int fq) const {
        const int row0 = u.pm * BM + wr * 64 + fr, col0 = u.pn * BM + wc * 32 + 8 * fq;
#pragma unroll
        for (int ai = 0; ai < 2; ++ai)
#pragma unroll
            for (int m = 0; m < 4; ++m) { const size_t row = (size_t)(row0 + ai * HALF + m * 16);
#pragma unroll
                for (int bj = 0; bj < 2; ++bj) { const int col = col0 + bj * HALF;
                    const u32x4 ga = *(const u32x4*)(gate + row * ldg + u.e * 1024 + col);
                    f32x4 na0 = {1.f + __builtin_amdgcn_exp2f(-1.4426950408889634f * bf_lo(ga.x)), 1.f + __builtin_amdgcn_exp2f(-1.4426950408889634f * bf_hi(ga.x)), 1.f + __builtin_amdgcn_exp2f(-1.4426950408889634f * bf_lo(ga.y)), 1.f + __builtin_amdgcn_exp2f(-1.4426950408889634f * bf_hi(ga.y))};
                    f32x4 na1 = {1.f + __builtin_amdgcn_exp2f(-1.4426950408889634f * bf_lo(ga.z)), 1.f + __builtin_amdgcn_exp2f(-1.4426950408889634f * bf_hi(ga.z)), 1.f + __builtin_amdgcn_exp2f(-1.4426950408889634f * bf_lo(ga.w)), 1.f + __builtin_amdgcn_exp2f(-1.4426950408889634f * bf_hi(ga.w))};
                    f32x4 f0, f1;
#pragma unroll
                    for (int q = 0; q < 4; ++q) { f0[q] = __builtin_amdgcn_rcpf(na0[q]); f1[q] = __builtin_amdgcn_rcpf(na1[q]); }
                    if (u.e < 2) { const u32x4 gb = *(const u32x4*)(gate + row * ldg + (u.e + 1) * 1024 + col);
                        f0[0] *= 1.f + __builtin_amdgcn_exp2f(-1.4426950408889634f * bf_lo(gb.x)); f0[1] *= 1.f + __builtin_amdgcn_exp2f(-1.4426950408889634f * bf_hi(gb.x));
                        f0[2] *= 1.f + __builtin_amdgcn_exp2f(-1.4426950408889634f * bf_lo(gb.y)); f0[3] *= 1.f + __builtin_amdgcn_exp2f(-1.4426950408889634f * bf_hi(gb.y));
                        f1[0] *= 1.f + __builtin_amdgcn_exp2f(-1.4426950408889634f * bf_lo(gb.z)); f1[1] *= 1.f + __builtin_amdgcn_exp2f(-1.4426950408889634f * bf_hi(gb.z));
                        f1[2] *= 1.f + __builtin_amdgcn_exp2f(-1.4426950408889634f * bf_lo(gb.w)); f1[3] *= 1.f + __builtin_amdgcn_exp2f(-1.4426950408889634f * bf_hi(gb.w)); }
                    acc[ai][bj][m][0] *= f0; acc[ai][bj][m][1] *= f1;
                    if (u.e == 2) *(u32x4*)(mixed + row * 1024 + col) = pack8(acc[ai][bj][m][0], acc[ai][bj][m][1]); } }
    }
};
struct ChainOrder {
    StaticOrder so; int nch;
    __device__ __forceinline__ bool next(int i, Unit& u) const { const int t = i / nch; if (!so.next(t, u)) return false; u.e = i - t * nch; return true; }
    __device__ __forceinline__ void a_ready(const Unit&) const {}
    __device__ __forceinline__ void done(const Unit&) const {}
};
struct EpiResid {
    static constexpr bool PERM = true, AFTER_DRAIN = false, CHAIN = false;
    const float* x; float* pre; float alpha;
    __device__ __forceinline__ void operator()(const f32x4 (&acc)[2][2][4][2], const Unit& u, int wr, int wc, int fr, int fq) const {
        const int row0 = u.pm * BM + wr * 64 + fr, col0 = u.pn * BM + wc * 32 + 8 * fq;
#pragma unroll
        for (int ai = 0; ai < 2; ++ai)
#pragma unroll
            for (int m = 0; m < 4; ++m) { const size_t row = (size_t)(row0 + ai * HALF + m * 16);
#pragma unroll
                for (int bj = 0; bj < 2; ++bj) { const size_t off = row * 1024 + col0 + bj * HALF;
                    const f32x4 x0 = *(const f32x4*)(x + off), x1 = *(const f32x4*)(x + off + 4);
                    *(f32x4*)(pre + off) = x0 * alpha + acc[ai][bj][m][0]; *(f32x4*)(pre + off + 4) = x1 * alpha + acc[ai][bj][m][1]; } }
    }
};
struct EpiSwiglu {
    static constexpr bool PERM = true, AFTER_DRAIN = false, CHAIN = false;
    bf16_t* a; const float* bias;
    __device__ __forceinline__ void operator()(const f32x4 (&acc)[2][2][4][2], const Unit& u, int wr, int wc, int fr, int fq) const {
        const int row0 = u.pm * BM + wr * 64 + fr, j0 = wc * 32 + 8 * fq, oc = u.pn * HALF + j0;
        const float* bg = bias + (size_t)u.e * 2048 + oc; const float* bu = bg + 1024;
        const f32x4 bg0 = *(const f32x4*)bg, bg1 = *(const f32x4*)(bg + 4), bu0 = *(const f32x4*)bu, bu1 = *(const f32x4*)(bu + 4);
#pragma unroll
        for (int ai = 0; ai < 2; ++ai)
#pragma unroll
            for (int m = 0; m < 4; ++m) { const size_t row = (size_t)(row0 + ai * HALF + m * 16);
                f32x4 g[2] = {acc[ai][0][m][0] + bg0, acc[ai][0][m][1] + bg1}, uu[2] = {acc[ai][1][m][0] + bu0, acc[ai][1][m][1] + bu1}, r[2];
#pragma unroll
                for (int n = 0; n < 2; ++n)
#pragma unroll
                    for (int q = 0; q < 4; ++q) { const float gg = fminf(g[n][q], 7.0f), uc = fminf(fmaxf(uu[n][q], -7.0f), 7.0f);
                        r[n][q] = gg * sigmoidf_(1.702f * gg) * (uc + 1.0f); }
                *(u32x4*)(a + row * 1024 + oc) = pack8(r[0], r[1]); }
    }
};
struct EpiDown {
    static constexpr bool PERM = true, AFTER_DRAIN = false, CHAIN = false;
    bf16_t* y; const float* bias; const float* list_g; const PG8_LAS int* st; const PG8_LAS int* cn; int lcap;
    __device__ __forceinline__ void operator()(const f32x4 (&acc)[2][2][4][2], const Unit& u, int wr, int wc, int fr, int fq) const {
        const int row0 = u.pm * BM + wr * 64 + fr, col0 = u.pn * BM + wc * 32 + 8 * fq;
        const int st_e = st[u.e], cn_e = cn[u.e];
        f32x4 bv[2][2];
#pragma unroll
        for (int bj = 0; bj < 2; ++bj)
#pragma unroll
            for (int n = 0; n < 2; ++n) bv[bj][n] = *(const f32x4*)(bias + (size_t)u.e * 1024 + col0 + bj * HALF + 4 * n);
#pragma unroll
        for (int ai = 0; ai < 2; ++ai)
#pragma unroll
            for (int m = 0; m < 4; ++m) { const size_t row = (size_t)(row0 + ai * HALF + m * 16); const int rank = (int)row - st_e;
                const float gt = rank < cn_e ? list_g[(size_t)u.e * lcap + rank] : 0.f;
#pragma unroll
                for (int bj = 0; bj < 2; ++bj) { const f32x4 v0 = (acc[ai][bj][m][0] + bv[bj][0]) * gt, v1 = (acc[ai][bj][m][1] + bv[bj][1]) * gt;
                    *(u32x4*)(y + row * 1024 + col0 + bj * HALF) = pack8(v0, v1); } }
    }
};
struct MoeGather {
    const int* list_t; const PG8_LAS int* st; const PG8_LAS int* cn; int lcap;
    __device__ __forceinline__ int row(const Unit& u, int r) const { int rank = u.pm * BM + r - st[u.e]; const int c = cn[u.e]; rank = rank < c ? rank : c - 1; return list_t[(size_t)u.e * lcap + rank]; }
};
struct MoeOrder {
    int nN, nunits, G, c; const PG8_LAS int* tile_e;
    __device__ __forceinline__ bool next(int i, Unit& u) const {
        const long L = (long)i * G + c; if (L >= nunits) return false;
        const int tile = (int)L / nN; u.pm = tile; u.pn = (int)L % nN; u.e = __builtin_amdgcn_readfirstlane(tile_e[tile]); return true;
    }
    __device__ __forceinline__ void a_ready(const Unit&) const {}
    __device__ __forceinline__ void done(const Unit&) const {}
};

struct NoGather { };
template <class Epi, class Sched, bool ALIGN_EPI = false, bool SP2 = false, bool GATHER = false, class GS = NoGather>
__device__ __forceinline__ void gemm_phase(PG8_LAS unsigned char* lds, const Gemm g, const Sched& S, const Epi& E, const int tid, const GS gs = GS()) {
    const int wid = __builtin_amdgcn_readfirstlane(tid >> 6), lane = tid & 63, wr = wid >> 2, wc = wid & 3, fr = lane & 15, fq = lane >> 4;
    const int K = g.K, nt = K / BK;
    unsigned voffA[2], voffB[2];
#pragma unroll
    for (int i = 0; i < 2; ++i) { int R, C; stage_rc(tid * 16 + i * 8192, R, C); const int Rb = Epi::PERM ? ((R & ~31) + perm32(R & 31)) : R;
        voffA[i] = (unsigned)(R * K + C) * 2u; voffB[i] = (unsigned)(Rb * K + C) * 2u; }
    unsigned vc0[2], vc1[2], vn0[2], vn1[2];
#define PG8_GROWS(u_, o0, o1) do { _Pragma("unroll") for (int i_ = 0; i_ < 2; ++i_) { int R_, C_; stage_rc(tid * 16 + i_ * 8192, R_, C_); \
        o0[i_] = (unsigned)gs.row((u_), R_) * (unsigned)(K * 2) + (unsigned)(C_ * 2); o1[i_] = (unsigned)gs.row((u_), HALF + R_) * (unsigned)(K * 2) + (unsigned)(C_ * 2); } } while (0)
    const size_t kstep = (size_t)(BK * 2);
    const size_t hstep = (size_t)HALF * K * 2;
    const size_t tstep = 2 * hstep;
    const unsigned ldsw = (unsigned)wid * 1024u;
    const int aoff = lds_byte(wr * 64 + fr, fq * 8), boff = lds_byte(wc * 32 + fr, fq * 8);
#define PG8_SA(b, h) (((b) * 2 + (h)) * HTB)
#define PG8_SB(b, h) ((4 + (b) * 2 + (h)) * HTB)
#define PG8_STAGE(bufoff, gbase, voff) do { _Pragma("unroll") for (int _i = 0; _i < 2; ++_i) \
        __builtin_amdgcn_global_load_lds((const unsigned*)((const char*)(gbase) + (voff)[_i]), (PG8_LAS unsigned*)(lds + (bufoff) + ldsw + _i * 8192), 16, 0, 0); } while (0)
#define PG8_LDA(dst, b, h) do { _Pragma("unroll") for (int m = 0; m < 4; ++m) _Pragma("unroll") for (int k = 0; k < 2; ++k) dst[m][k] = *(const PG8_LAS bf16x8*)(lds + PG8_SA(b, h) + aoff + m * 2048 + k * 1024); } while (0)
#define PG8_LDB(dst, b, h) do { _Pragma("unroll") for (int n = 0; n < 2; ++n) _Pragma("unroll") for (int k = 0; k < 2; ++k) dst[n][k] = *(const PG8_LAS bf16x8*)(lds + PG8_SB(b, h) + boff + n * 2048 + k * 1024); } while (0)
#define PG8_MMA(ai, bj, At, Bt) do { __builtin_amdgcn_s_setprio(1); _Pragma("unroll") for (int m = 0; m < 4; ++m) _Pragma("unroll") for (int n = 0; n < 2; ++n) _Pragma("unroll") for (int k = 0; k < 2; ++k) \
        acc[ai][bj][m][n] = __builtin_amdgcn_mfma_f32_16x16x32_bf16(Bt[n][k], At[m][k], acc[ai][bj][m][n], 0, 0, 0); __builtin_amdgcn_s_setprio(0); } while (0)
#define PG8_WAIT_V(n) asm volatile("s_waitcnt vmcnt(" #n ")" ::: "memory")
#define PG8_WAIT_L(n) asm volatile("s_waitcnt lgkmcnt(" #n ")" ::: "memory")
#define PG8_BAR __builtin_amdgcn_s_barrier()
#define PG8_SCHED __builtin_amdgcn_sched_barrier(0)
    Unit cur, nxt; int ui = 0;
    if (!S.next(0, cur)) return;
    f32x4 acc[2][2][4][2];
#pragma unroll
    for (int a = 0; a < 2; ++a)
#pragma unroll
        for (int b = 0; b < 2; ++b)
#pragma unroll
            for (int m = 0; m < 4; ++m)
#pragma unroll
                for (int n = 0; n < 2; ++n) acc[a][b][m][n] = (f32x4){0.f, 0.f, 0.f, 0.f};
    bf16x8 At[4][2], B0[2][2], B1[2][2];
    const char* cA = GATHER ? (const char*)g.A : (const char*)g.A + (size_t)cur.pm * tstep + (size_t)cur.e * g.astride;
    if constexpr (GATHER) { PG8_GROWS(cur, vc0, vc1); } else { _Pragma("unroll") for (int i = 0; i < 2; ++i) { vc0[i] = voffA[i]; vc1[i] = voffA[i] + (unsigned)hstep; } }
#pragma unroll
    for (int i = 0; i < 2; ++i) { vn0[i] = vc0[i]; vn1[i] = vc1[i]; }
    const char* cB = (const char*)g.Bt + (size_t)cur.pn * tstep + (size_t)cur.e * g.bstride;
    S.a_ready(cur);
    if constexpr (SP2) {
        PG8_STAGE(PG8_SB(0, 0), cB, voffB); PG8_STAGE(PG8_SB(0, 1), cB + hstep, voffB); PG8_STAGE(PG8_SA(0, 0), cA, vc0); PG8_STAGE(PG8_SA(0, 1), cA, vc1);
        if (wr == 1) PG8_BAR;
        PG8_WAIT_V(2); PG8_BAR;
        PG8_STAGE(PG8_SB(1, 0), cB + kstep, voffB); PG8_STAGE(PG8_SA(1, 0), cA + kstep, vc0); PG8_STAGE(PG8_SB(1, 1), cB + hstep + kstep, voffB);
        PG8_WAIT_V(6); PG8_BAR;
    } else {
        PG8_STAGE(PG8_SB(0, 0), cB, voffB); PG8_STAGE(PG8_SA(0, 0), cA, vc0); PG8_STAGE(PG8_SB(0, 1), cB + hstep, voffB); PG8_STAGE(PG8_SA(0, 1), cA, vc1);
        if (wr == 1) PG8_BAR;
        PG8_WAIT_V(4); PG8_BAR;
        PG8_STAGE(PG8_SB(1, 0), cB + kstep, voffB); PG8_STAGE(PG8_SA(1, 0), cA + kstep, vc0); PG8_STAGE(PG8_SB(1, 1), cB + hstep + kstep, voffB);
        PG8_WAIT_V(6); PG8_BAR;
    }
    for (;;) {
        const bool has_next = S.next(ui + 1, nxt);
        const char* nA = GATHER ? cA : (has_next ? (const char*)g.A + (size_t)nxt.pm * tstep + (size_t)nxt.e * g.astride : cA);
        if constexpr (GATHER) { if (has_next) { PG8_GROWS(nxt, vn0, vn1); } } const char* nB = has_next ? (const char*)g.Bt + (size_t)nxt.pn * tstep + (size_t)nxt.e * g.bstride : cB;
        for (int t = 0; t < nt; t += 2) {
            const bool last = (t == nt - 2);
            const char* a1 = cA + (size_t)(t + 1) * kstep;
            const char* a2 = last ? nA : cA + (size_t)(t + 2) * kstep; const char* b2 = last ? nB : cB + (size_t)(t + 2) * kstep;
            const char* a3 = a2 + kstep; const char* b3 = b2 + kstep;
            unsigned vs0[2], vs1[2];
#pragma unroll
            for (int i = 0; i < 2; ++i) { vs0[i] = (GATHER && last) ? vn0[i] : vc0[i]; vs1[i] = (GATHER && last) ? vn1[i] : vc1[i]; }
            if (last && has_next) S.a_ready(nxt);
            if constexpr (SP2) {
            PG8_LDB(B0, 0, 0); PG8_LDB(B1, 0, 1); PG8_SCHED; PG8_LDA(At, 0, 0); PG8_STAGE(PG8_SA(1, 1), a1, vc1);
            PG8_WAIT_V(8); PG8_WAIT_L(0); PG8_BAR; PG8_MMA(0, 0, At, B0); PG8_MMA(0, 1, At, B1); PG8_BAR; PG8_SCHED;
            PG8_LDA(At, 0, 1); PG8_STAGE(PG8_SB(0, 0), b2, voffB); PG8_STAGE(PG8_SB(0, 1), b2 + hstep, voffB); PG8_STAGE(PG8_SA(0, 0), a2, vs0);
            PG8_WAIT_V(8); PG8_WAIT_L(0); PG8_BAR; PG8_MMA(1, 0, At, B0); PG8_MMA(1, 1, At, B1); PG8_BAR; PG8_SCHED;
            PG8_LDB(B0, 1, 0); PG8_LDB(B1, 1, 1); PG8_SCHED; PG8_LDA(At, 1, 0); PG8_STAGE(PG8_SA(0, 1), a2, vs1);
            PG8_WAIT_V(8); PG8_WAIT_L(0); PG8_BAR; PG8_MMA(0, 0, At, B0); PG8_MMA(0, 1, At, B1); PG8_BAR; PG8_SCHED;
            PG8_LDA(At, 1, 1); PG8_STAGE(PG8_SB(1, 0), b3, voffB); PG8_STAGE(PG8_SB(1, 1), b3 + hstep, voffB); PG8_STAGE(PG8_SA(1, 0), a3, vs0);
            PG8_WAIT_V(8); PG8_WAIT_L(0); PG8_BAR; PG8_MMA(1, 0, At, B0); PG8_MMA(1, 1, At, B1); PG8_BAR; PG8_SCHED;
            } else {
            PG8_LDB(B0, 0, 0); PG8_SCHED; PG8_LDA(At, 0, 0); PG8_STAGE(PG8_SA(1, 1), a1, vc1);
            PG8_WAIT_L(8); PG8_BAR; PG8_WAIT_L(0); PG8_MMA(0, 0, At, B0); PG8_BAR; PG8_SCHED;
            PG8_LDB(B1, 0, 1); PG8_STAGE(PG8_SB(0, 0), b2, voffB);
            PG8_BAR; PG8_WAIT_L(0); PG8_MMA(0, 1, At, B1); PG8_BAR;
            PG8_LDA(At, 0, 1); PG8_STAGE(PG8_SA(0, 0), a2, vs0);
            PG8_BAR; PG8_WAIT_L(0); PG8_MMA(1, 0, At, B0); PG8_BAR; PG8_SCHED;
            PG8_STAGE(PG8_SB(0, 1), b2 + hstep, voffB);
            PG8_WAIT_V(6); PG8_BAR; PG8_MMA(1, 1, At, B1); PG8_BAR;
            PG8_LDB(B0, 1, 0); PG8_SCHED; PG8_LDA(At, 1, 0); PG8_STAGE(PG8_SA(0, 1), a2, vs1);
            PG8_WAIT_L(8); PG8_BAR; PG8_WAIT_L(0); PG8_MMA(0, 0, At, B0); PG8_BAR; PG8_SCHED;
            PG8_LDB(B1, 1, 1); PG8_STAGE(PG8_SB(1, 0), b3, voffB);
            PG8_BAR; PG8_WAIT_L(0); PG8_MMA(0, 1, At, B1); PG8_BAR;
            PG8_LDA(At, 1, 1); PG8_STAGE(PG8_SA(1, 0), a3, vs0);
            PG8_BAR; PG8_WAIT_L(0); PG8_MMA(1, 0, At, B0); PG8_BAR; PG8_SCHED;
            PG8_STAGE(PG8_SB(1, 1), b3 + hstep, voffB);
            PG8_WAIT_V(6); PG8_BAR; PG8_MMA(1, 1, At, B1); PG8_BAR;
            }
        }
        if constexpr (ALIGN_EPI) { if (wr == 0) PG8_BAR; }
        if constexpr (!Epi::AFTER_DRAIN) { if constexpr (Epi::CHAIN) E.chain(acc, cur, wr, wc, fr, fq); else E(acc, cur, wr, wc, fr, fq); S.done(cur); }
        if (!has_next) break;
        if (!(Epi::CHAIN && nxt.e != 0)) {
#pragma unroll
        for (int a = 0; a < 2; ++a)
#pragma unroll
            for (int b = 0; b < 2; ++b)
#pragma unroll
                for (int m = 0; m < 4; ++m)
#pragma unroll
                    for (int n = 0; n < 2; ++n) acc[a][b][m][n] = (f32x4){0.f, 0.f, 0.f, 0.f};
        }
        cur = nxt; cA = nA; cB = nB; ++ui;
        if constexpr (GATHER) { _Pragma("unroll") for (int i = 0; i < 2; ++i) { vc0[i] = vn0[i]; vc1[i] = vn1[i]; } }
        if constexpr (ALIGN_EPI) { if (wr == 1) PG8_BAR; }
    }
    PG8_WAIT_V(0);
    if constexpr (!ALIGN_EPI) { if (wr == 0) PG8_BAR; }
    PG8_BAR;
    if constexpr (Epi::AFTER_DRAIN) { E.fused(acc, cur, wr, wc, fr, fq, lds, wid, lane); S.done(cur); }
#undef PG8_GROWS
#undef PG8_SA
#undef PG8_SB
#undef PG8_STAGE
#undef PG8_LDA
#undef PG8_LDB
#undef PG8_MMA
#undef PG8_WAIT_V
#undef PG8_WAIT_L
#undef PG8_BAR
#undef PG8_SCHED
}
}


namespace att {
typedef unsigned short bf16_t;
typedef short bf16x8 __attribute__((ext_vector_type(8)));
typedef short s16x4 __attribute__((ext_vector_type(4)));
typedef float f32x16 __attribute__((ext_vector_type(16)));
typedef unsigned u32x4 __attribute__((ext_vector_type(4)));
#define ALAS __attribute__((address_space(3)))
typedef ALAS unsigned char* ALAS_PTR;
#define ASBAR() __builtin_amdgcn_sched_barrier(0)
constexpr int QBLK = 32, KVBLK = 64;
constexpr float THR2 = 11.0f;
constexpr float LOG2E = 1.4426950408889634f, INV2PI = 0.15915494309189535f, LOG2_THETA = 13.287712379549449f;
constexpr int OFF_V = 0, VBUF = 8192, OFF_K = 16384, KBUF_MAX = 13312, OFF_WS = OFF_K + 2 * KBUF_MAX  , OFF_BIAS = OFF_WS + 2048  , ATT_LDS = OFF_BIAS + 2048;
__device__ __forceinline__ int crow(int r, int hi) { return (r & 3) + 8 * (r >> 2) + 4 * hi; }
__device__ __forceinline__ unsigned cvtpk(float lo, float hi) { unsigned r; asm volatile("v_cvt_pk_bf16_f32 %0, %1, %2" : "=v"(r) : "v"(lo), "v"(hi)); return r; }
__device__ __forceinline__ float bf2f(short s) { return __uint_as_float(((unsigned)(unsigned short)s) << 16); }
__device__ __forceinline__ short f2bf_s(float f) { return (short)(cvtpk(f, 0.f) & 0xffffu); }

struct UnitP {
    const bf16_t* Q; int ldq;
    const bf16_t* K0; int ldk0;
    const bf16_t* K1; int ldk1;
    const bf16_t* V; int ldv;
    bf16_t* O; int ldo;
    int nt;
    int grow0;
    const float* gain;
    int kr0;
    float cref;
};

typedef short v4i16_t __attribute__((ext_vector_type(4)));
__device__ __forceinline__ s16x4 vtr(const ALAS unsigned char* p) { return __builtin_bit_cast(s16x4, __builtin_amdgcn_ds_read_tr16_b64_v4i16((ALAS v4i16_t*)p)); }
__device__ __forceinline__ void pv_all(f32x16& o0, f32x16& o1, f32x16& lacc, const ALAS unsigned char* vp, bf16x8 pa0, bf16x8 pa1, bf16x8 pa2, bf16x8 pa3) {
    const bf16x8 ones = {(short)0x3F80, (short)0x3F80, (short)0x3F80, (short)0x3F80, (short)0x3F80, (short)0x3F80, (short)0x3F80, (short)0x3F80};
#define ATT_PK(L, H) (bf16x8){L[0], L[1], L[2], L[3], H[0], H[1], H[2], H[3]}
#define ATT_STEP(KS, PA) { const s16x4 l0 = vtr(vp + (KS) * 1024), h0 = vtr(vp + (KS) * 1024 + 512), l1 = vtr(vp + 4096 + (KS) * 1024), h1 = vtr(vp + 4096 + (KS) * 1024 + 512); \
        o0 = __builtin_amdgcn_mfma_f32_32x32x16_bf16(PA, ATT_PK(l0, h0), o0, 0, 0, 0); o1 = __builtin_amdgcn_mfma_f32_32x32x16_bf16(PA, ATT_PK(l1, h1), o1, 0, 0, 0); \
        lacc = __builtin_amdgcn_mfma_f32_32x32x16_bf16(PA, ones, lacc, 0, 0, 0); }
    ATT_STEP(0, pa0) ATT_STEP(1, pa1) ATT_STEP(2, pa2) ATT_STEP(3, pa3)
#undef ATT_STEP
#undef ATT_PK
}
template <int DQK> __device__ __forceinline__ void qkt(f32x16& p0, f32x16& p1, const ALAS unsigned char* Ks, const bf16x8* qr, const f32x16& cinit, int r32, int hi) {
    constexpr int KST = DQK * 2 + 16;
#pragma unroll
    for (int d0 = 0; d0 < DQK / 16; ++d0) { const int cb = (2 * d0 + hi) * 16;
        const bf16x8 b0 = *(const ALAS bf16x8*)(Ks + r32 * KST + cb);
        const bf16x8 b1 = *(const ALAS bf16x8*)(Ks + (32 + r32) * KST + cb);
        if (d0 == 0) { p0 = __builtin_amdgcn_mfma_f32_32x32x16_bf16(b0, qr[0], cinit, 0, 0, 0); p1 = __builtin_amdgcn_mfma_f32_32x32x16_bf16(b1, qr[0], cinit, 0, 0, 0); }
        else { p0 = __builtin_amdgcn_mfma_f32_32x32x16_bf16(b0, qr[d0], p0, 0, 0, 0); p1 = __builtin_amdgcn_mfma_f32_32x32x16_bf16(b1, qr[d0], p1, 0, 0, 0); } }
}
__device__ __forceinline__ void na_mask(f32x16& p0, f32x16& p1, const ALAS float* btab, int kr, int rq, int qc_in, int hi_in) {
    int qc = qc_in, hi = hi_in; asm volatile("" : "+v"(qc), "+v"(hi));
    int r0 = rq - 4; r0 = r0 < 0 ? 0 : (r0 > 120 ? 120 : r0);
    const bool rowok = (kr >= r0) && (kr < r0 + 8);
    int c0 = qc - 8; c0 = c0 < 0 ? 0 : (c0 > 48 ? 48 : c0);
    int dr = kr - rq + 7; dr = dr < 0 ? 0 : (dr > 14 ? 14 : dr);
    const ALAS float* brow = btab + dr * 31;
#pragma unroll
    for (int r = 0; r < 16; ++r) {
        const int ka = crow(r, hi), kb = 32 + ka;
        int ia = ka - qc + 15; ia = ia < 0 ? 0 : (ia > 30 ? 30 : ia);
        int ib = kb - qc + 15; ib = ib < 0 ? 0 : (ib > 30 ? 30 : ib);
        const bool oka = rowok && (ka >= c0) && (ka < c0 + 16), okb = rowok && (kb >= c0) && (kb < c0 + 16);
        p0[r] = oka ? p0[r] + brow[ia] : -1e30f;
        p1[r] = okb ? p1[r] + brow[ib] : -1e30f;
    }
}
__device__ __forceinline__ void lazySM(f32x16& p0, f32x16& p1, float& m_reg, bool& moved, float& alpha) {
    float pmax = p0[0];
#pragma unroll
    for (int r = 1; r < 16; ++r) pmax = fmaxf(pmax, p0[r]);
#pragma unroll
    for (int r = 0; r < 16; ++r) pmax = fmaxf(pmax, p1[r]);
    { auto rr = __builtin_amdgcn_permlane32_swap(__float_as_uint(pmax), __float_as_uint(pmax), false, false);
      pmax = fmaxf(__uint_as_float(rr[0]), __uint_as_float(rr[1])); }
    if (__builtin_expect(__all(pmax <= THR2), 1)) { alpha = 1.f; }
    else { const float dl = fmaxf(pmax, 0.f); m_reg += dl; alpha = __builtin_amdgcn_exp2f(-dl);
#pragma unroll
        for (int r = 0; r < 16; ++r) { p0[r] -= dl; p1[r] -= dl; }
        moved = true; }
#pragma unroll
    for (int r = 0; r < 16; ++r) p0[r] = __builtin_amdgcn_exp2f(p0[r]);
}
__device__ __forceinline__ void fixedSM(f32x16& p0) {
#pragma unroll
    for (int r = 0; r < 16; ++r) p0[r] = __builtin_amdgcn_exp2f(p0[r]);
}
__device__ __forceinline__ void finishSM(f32x16& p0, f32x16& p1, bf16x8& pa0, bf16x8& pa1, bf16x8& pa2, bf16x8& pa3) {
#pragma unroll
    for (int r = 0; r < 16; ++r) p1[r] = __builtin_amdgcn_exp2f(p1[r]);
    u32x4 w;
    w = (u32x4){cvtpk(p0[0], p0[1]), cvtpk(p0[2], p0[3]), cvtpk(p0[4], p0[5]), cvtpk(p0[6], p0[7])}; pa0 = __builtin_bit_cast(bf16x8, w);
    w = (u32x4){cvtpk(p0[8], p0[9]), cvtpk(p0[10], p0[11]), cvtpk(p0[12], p0[13]), cvtpk(p0[14], p0[15])}; pa1 = __builtin_bit_cast(bf16x8, w);
    w = (u32x4){cvtpk(p1[0], p1[1]), cvtpk(p1[2], p1[3]), cvtpk(p1[4], p1[5]), cvtpk(p1[6], p1[7])}; pa2 = __builtin_bit_cast(bf16x8, w);
    w = (u32x4){cvtpk(p1[8], p1[9]), cvtpk(p1[10], p1[11]), cvtpk(p1[12], p1[13]), cvtpk(p1[14], p1[15])}; pa3 = __builtin_bit_cast(bf16x8, w);
}
struct NoSide { static constexpr bool PLAIN = true; template <int P> __device__ __forceinline__ void step() {} };
template <int DQK, int MODE, class SIDE = NoSide>
__device__ __forceinline__ void attn_unit(const UnitP& u, ALAS unsigned char* lds, const int tid, SIDE& side) {
    constexpr int ND = DQK / 16, KST = DQK * 2 + 16, KBUF = 64 * KST;
    static_assert(KBUF <= KBUF_MAX, "K buffer");
    const int wid = __builtin_amdgcn_readfirstlane(tid >> 6), lane = tid & 63, r32 = lane & 31, hi = lane >> 5;
    ALAS unsigned char* V_lds = lds + OFF_V; ALAS unsigned char* K_lds = lds + OFF_K;
    ALAS float* ws = (ALAS float*)(lds + OFF_WS) + wid * 64; ALAS float* al_l = ws + 32;
    const ALAS float* btab = (const ALAS float*)(lds + OFF_BIAS);
    float m_reg = 0.f; f32x16 o[2], lacc; o[0] = f32x16{}; o[1] = f32x16{}; lacc = f32x16{}; bf16x8 qr[ND];
    bool moved = false;
    const int grow = u.grow0 + (wid >> 1), gcol = (wid & 1) * 32 + r32;
    {
        const bf16_t* Qw = u.Q + (size_t)(wid * QBLK + r32) * u.ldq + hi * 8;
#pragma unroll
        for (int d0 = 0; d0 < ND; ++d0) qr[d0] = *(const bf16x8*)(Qw + d0 * 16);
        if constexpr (MODE == 0 || MODE == 3) {
            float x[4][8]; float ssq = 0.f;
#pragma unroll
            for (int d0 = 0; d0 < 4; ++d0)
#pragma unroll
                for (int j = 0; j < 8; ++j) { x[d0][j] = bf2f(qr[d0][j]); ssq += x[d0][j] * x[d0][j]; }
            { auto rr_ = __builtin_amdgcn_permlane32_swap(__float_as_uint(ssq), __float_as_uint(ssq), false, false); ssq = __uint_as_float(rr_[0]) + __uint_as_float(rr_[1]); }
            const float rstd = 1.0f / sqrtf(ssq * (1.0f / 64.0f) + 1e-6f);
#pragma unroll
            for (int d0 = 0; d0 < 4; ++d0)
#pragma unroll
                for (int j = 0; j < 8; ++j) x[d0][j] = x[d0][j] * rstd * u.gain[16 * d0 + 8 * hi + j];
#pragma unroll
            for (int d0 = 0; d0 < 2; ++d0)
#pragma unroll
                for (int j = 0; j < 8; ++j) { const float inv = exp2f(-(float)(8 * hi + j) * (LOG2_THETA / 16.0f));
                    const float ang = (float)(d0 == 0 ? grow : gcol) * inv * INV2PI; const float c = __builtin_amdgcn_cosf(ang), s = __builtin_amdgcn_sinf(ang);
                    const float y1 = x[d0][j], y2 = x[d0 + 2][j]; x[d0][j] = y1 * c - y2 * s; x[d0 + 2][j] = y1 * s + y2 * c; }
            constexpr float C2 = 0.125f * LOG2E;
#pragma unroll
            for (int d0 = 0; d0 < 4; ++d0) { u32x4 w = {cvtpk(x[d0][0] * C2, x[d0][1] * C2), cvtpk(x[d0][2] * C2, x[d0][3] * C2), cvtpk(x[d0][4] * C2, x[d0][5] * C2), cvtpk(x[d0][6] * C2, x[d0][7] * C2)};
                qr[d0] = __builtin_bit_cast(bf16x8, w); }
        }
        if constexpr (MODE == 1) {
            float y1[8], y2[8];
#pragma unroll
            for (int j = 0; j < 8; ++j) { const float inv = exp2f(-(float)j * (LOG2_THETA / 8.0f));
                const float ang = (float)(hi == 0 ? grow : gcol) * inv * INV2PI; const float c = __builtin_amdgcn_cosf(ang), s = __builtin_amdgcn_sinf(ang);
                const float a = bf2f(qr[4][j]), b = bf2f(qr[5][j]); y1[j] = a * c - b * s; y2[j] = a * s + b * c; }
            u32x4 w = {cvtpk(y1[0], y1[1]), cvtpk(y1[2], y1[3]), cvtpk(y1[4], y1[5]), cvtpk(y1[6], y1[7])}; qr[4] = __builtin_bit_cast(bf16x8, w);
            w = (u32x4){cvtpk(y2[0], y2[1]), cvtpk(y2[2], y2[3]), cvtpk(y2[4], y2[5]), cvtpk(y2[6], y2[7])}; qr[5] = __builtin_bit_cast(bf16x8, w);
        }
    }
    const int sk = tid >> 3, sc = tid & 7;
    const bf16_t* vsrc = u.V + (size_t)sk * u.ldv + sc * 8; const bf16_t* ksrc = u.K0 + (size_t)sk * u.ldk0 + sc * 8;
    const int vst = (sc >> 2) * 4096 + sk * 64 + (sc & 3) * 16, kst = sk * KST + sc * 16;
    const int sk2 = (tid & 255) >> 2, sc2 = tid & 3;
    const bf16_t* k2src = (DQK == 96) ? u.K1 + (size_t)sk2 * u.ldk1 + sc2 * 8 : nullptr;
    const int k2st = sk2 * KST + (8 + sc2) * 16;
    const ALAS unsigned char* vb0 = V_lds + ((lane >> 4) & 1) * 32 + (lane & 3) * 8 + (4 * hi + ((lane & 15) >> 2)) * 64;
    struct { bf16x8 v, k, k2; } sr_[2];
#define ATT_SLOAD(i, k0) do { sr_[i].v = *(const bf16x8*)(vsrc + (size_t)(k0) * u.ldv); sr_[i].k = *(const bf16x8*)(ksrc + (size_t)(k0) * u.ldk0); \
        if constexpr (DQK == 96) sr_[i].k2 = *(const bf16x8*)(k2src + (size_t)(k0) * u.ldk1); } while (0)
#define ATT_SWRITE(b, i) do { *(ALAS bf16x8*)(V_lds + (b) * VBUF + vst) = sr_[i].v; *(ALAS bf16x8*)(K_lds + (b) * KBUF + kst) = sr_[i].k; \
        if constexpr (DQK == 96) *(ALAS bf16x8*)(K_lds + (b) * KBUF + k2st) = sr_[i].k2; } while (0)
#define ATT_SWAIT() do { if constexpr (SIDE::PLAIN) { if constexpr (DQK == 96) asm volatile("s_waitcnt vmcnt(3)" ::: "memory"); else asm volatile("s_waitcnt vmcnt(2)" ::: "memory"); } } while (0)
#define ATT_RESC(a) do { if constexpr (MODE != 0) { if (__any((a) < 1.f)) { if (hi == 0) al_l[r32] = (a); asm volatile("s_waitcnt lgkmcnt(0)" ::: "memory"); \
        _Pragma("unroll") for (int r = 0; r < 16; ++r) { const float f_ = al_l[crow(r, hi)]; o[0][r] *= f_; o[1][r] *= f_; lacc[r] *= f_; } } } } while (0)
#define ATT_SM(P0, P1, AL) do { if constexpr (MODE == 0) { fixedSM(P0); AL = 1.f; } else lazySM(P0, P1, m_reg, moved, AL); } while (0)
#define ATT_QKT(P0, P1, KS) do { if (MODE != 0 && moved) { f32x16 ng_; _Pragma("unroll") for (int r_ = 0; r_ < 16; ++r_) ng_[r_] = -m_reg; qkt<DQK>(P0, P1, KS, qr, ng_, r32, hi); } \
        else { const f32x16 z_ = f32x16{}; qkt<DQK>(P0, P1, KS, qr, z_, r32, hi); } } while (0)
#define ATT_PV(VB) pv_all(o[0], o[1], lacc, (VB), pa0, pa1, pa2, pa3)
#define ATT_MASK(P0, P1, j) do { if constexpr (MODE == 2) na_mask(P0, P1, btab, u.kr0 + (j), grow, gcol, hi); } while (0)
    f32x16 pA0, pA1, pB0, pB1; float alA, alB; bf16x8 pa0, pa1, pa2, pa3; const int NT = u.nt;
    constexpr int SE = 0, SO = 1;
    ATT_SLOAD(SE, 0); asm volatile("s_waitcnt vmcnt(0)" ::: "memory"); ATT_SWRITE(0, SE); __syncthreads();
    ATT_QKT(pA0, pA1, K_lds); ATT_MASK(pA0, pA1, 0); ATT_SM(pA0, pA1, alA);
    ATT_SLOAD(SO, KVBLK); if (2 < NT) ATT_SLOAD(SE, 2 * KVBLK);
    ATT_SWAIT(); ATT_SWRITE(1, SO); __syncthreads();
    if (wid >= 4) __builtin_amdgcn_s_setprio(1);
    for (int j = 1; j + 1 < NT; j += 2) {
        if constexpr (!SIDE::PLAIN) { if ((j & 7) == 1) side.template step<0>(); }
        ASBAR(); ATT_QKT(pB0, pB1, K_lds + KBUF); ATT_MASK(pB0, pB1, j);
        finishSM(pA0, pA1, pa0, pa1, pa2, pa3); ASBAR();
        ATT_SLOAD(SO, (j + 2) * KVBLK); ASBAR();
        ATT_PV(vb0); ATT_SM(pB0, pB1, alB);
        __syncthreads(); ATT_SWAIT(); ATT_SWRITE(0, SE);
        ATT_RESC(alB); __syncthreads();
        if constexpr (!SIDE::PLAIN) { if ((j & 7) == 5) side.template step<1>(); }
        ASBAR(); ATT_QKT(pA0, pA1, K_lds); ATT_MASK(pA0, pA1, j + 1);
        finishSM(pB0, pB1, pa0, pa1, pa2, pa3); ASBAR();
        if (j + 3 < NT) ATT_SLOAD(SE, (j + 3) * KVBLK); ASBAR();
        ATT_PV(vb0 + VBUF); ATT_SM(pA0, pA1, alA);
        __syncthreads(); ATT_SWAIT(); ATT_SWRITE(1, SO);
        ATT_RESC(alA); __syncthreads();
    }
    ASBAR(); ATT_QKT(pB0, pB1, K_lds + KBUF); ATT_MASK(pB0, pB1, NT - 1);
    finishSM(pA0, pA1, pa0, pa1, pa2, pa3); ASBAR();
    ATT_PV(vb0); ATT_SM(pB0, pB1, alB);
    __syncthreads(); ATT_RESC(alB);
    finishSM(pB0, pB1, pa0, pa1, pa2, pa3); ASBAR();
    ATT_PV(vb0 + VBUF);
    __builtin_amdgcn_s_setprio(0);
    bf16_t* Ow = u.O + (size_t)(wid * QBLK) * u.ldo;
#pragma unroll
    for (int r = 0; r < 16; ++r) { const int orow = crow(r, hi); const float rl = __builtin_amdgcn_rcpf(lacc[r]);
#pragma unroll
        for (int d0 = 0; d0 < 2; ++d0) Ow[(size_t)orow * u.ldo + d0 * 32 + r32] = (bf16_t)f2bf_s(o[d0][r] * rl); }
    __syncthreads();
#undef ATT_SLOAD
#undef ATT_SWRITE
#undef ATT_SWAIT
#undef ATT_RESC
#undef ATT_SM
#undef ATT_QKT
#undef ATT_PV
#undef ATT_MASK
}
}


constexpr int NWAVES = 8;
#ifndef MK_DEBUG
#define MK_DEBUG 0
#endif
#ifndef MK_DBG_IGNORE
#define MK_DBG_IGNORE 0
#endif
#ifndef MK_ONE_LAUNCH
#define MK_ONE_LAUNCH 0
#endif
#ifndef REP_P
#define REP_P 1
#endif
#ifndef REP_A
#define REP_A 1
#endif
#ifndef REP_B
#define REP_B 1
#endif
#ifndef REP_C
#define REP_C 1
#endif
#ifndef REP_DG
#define REP_DG 1
#endif
#ifndef REP_DM
#define REP_DM 1
#endif
#ifndef REP_DN
#define REP_DN 1
#endif
#ifndef REP_E
#define REP_E 1
#endif
#ifndef REP_F
#define REP_F 1
#endif
#ifndef REP_H
#define REP_H 1
#endif
#ifndef REP_I
#define REP_I 1
#endif
#ifndef REP_J
#define REP_J 1
#endif
#ifndef REP_K
#define REP_K 1
#endif
constexpr int NB = 4, SEQ = 8192, T = NB * SEQ, D = 1024, DEPTH = 2, GW = 64;
constexpr int DIN = 5536, DINP = 5632;
constexpr int H_NAQ = 0, H_NAK = 384, H_NAV = 768, H_GQ = 1152, H_GK = 1536, H_GV = 1664, H_CQ = 1792, H_CKV = 2176, H_KR = 2432, H_GATE = 2464;
constexpr int NE = 32, TOPK = 4, FF = 1024, TK = T * TOPK;
constexpr int PSLOTS = TK + NE * 256;
constexpr int MAXTILES = PSLOTS / 256;
constexpr int LCAP = T;
constexpr float LN_EPS = 1e-5f, RMS_EPS = 1e-6f, DN_ALPHA = 1.4142135623730951f;
constexpr float LOG2E_F = 1.4426950408889634f;
constexpr int PPL = 10, NPH = 1 + DEPTH * PPL;

constexpr size_t MiB = 1u << 20;
constexpr size_t WS_CTL = 0, CTL_ZERO_BYTES = 1 * MiB;
constexpr size_t WB_IN = 0, WB_UQ = WB_IN + (size_t)DINP * 1024 * 2, WB_UKV = WB_UQ + (size_t)512 * 384 * 2, WB_BA = WB_UKV + (size_t)512 * 256 * 2,
                 WB_BB = WB_BA + (size_t)1024 * 384 * 2, WB_BC = WB_BB + (size_t)1024 * 384 * 2, WB_OUT = WB_BC + (size_t)1024 * 384 * 2,
                 WB_GU = WB_OUT + (size_t)1024 * 1024 * 2, WB_DN = WB_GU + (size_t)NE * 2048 * 1024 * 2, WB_LAYER = WB_DN + (size_t)NE * 1024 * 1024 * 2;
static_assert(WB_LAYER % 256 == 0, "weight block alignment");
constexpr size_t WS_W = 2 * MiB;
constexpr size_t WS_H = WS_W + 2 * WB_LAYER;
constexpr size_t SZ_H = (size_t)T * DINP * 2;
constexpr size_t WS_A2 = WS_H + SZ_H;
constexpr size_t A2_MIX = 0, A2_MIXED = A2_MIX + (size_t)T * 1024 * 4, A2_YA = A2_MIXED + (size_t)T * 1024 * 2, A2_YB = A2_YA + (size_t)T * 384 * 2,
                 A2_YC = A2_YB + (size_t)T * 384 * 2, A2_QC = A2_YC + (size_t)T * 384 * 2, A2_KVC = A2_QC + (size_t)T * 384 * 2, A2_KB = A2_KVC + (size_t)T * 512 * 2,
                 A2_CQN = A2_KB + (size_t)T * 128 * 2, A2_CKVN = A2_CQN + (size_t)T * 384 * 2, A2_KR = A2_CKVN + (size_t)T * 256 * 2, SZ_A2 = A2_KR + (size_t)T * 32 * 2;
static_assert(SZ_A2 >= (size_t)PSLOTS * 1024 * 2 && SZ_H >= (size_t)PSLOTS * 1024 * 2, "overlays fit");
constexpr size_t WS_X2 = WS_A2 + SZ_A2;
constexpr size_t WS_XB = WS_X2 + (size_t)T * D * 4;
constexpr size_t WS_X1 = WS_XB + (size_t)T * D * 2;
constexpr size_t WS_X1B = WS_X1 + (size_t)T * D * 4;
constexpr size_t WS_LT = WS_X1B + (size_t)T * D * 2;
constexpr size_t WS_LG = WS_LT + (size_t)NE * LCAP * 4;
constexpr size_t WS_TE = WS_LG + (size_t)NE * LCAP * 4;
constexpr size_t WS_TR = WS_TE + (size_t)T * 4 * 4;
constexpr size_t WS_SG = WS_TR + (size_t)T * 4 * 4;
constexpr size_t WS_END = WS_SG + (size_t)PSLOTS * 4;
constexpr int CW_BAR = 4096;
constexpr int CW_CNT = 16384;

constexpr int RING_BYTES = 131072, LDSCTL_OFF = 139264, MISC_OFF = LDSCTL_OFF + 64;
constexpr int TBL_OFF = LDSCTL_OFF + 256;
constexpr int TBL_START = TBL_OFF, TBL_TILEE = TBL_OFF + 512, TBL_RS = TBL_TILEE + 2304;
constexpr int LDS_BYTES = 155648;
static_assert(TBL_RS + 512 * 12 + 256 <= LDS_BYTES, "LDS map");

#define GAS __attribute__((address_space(1)))
#define LAS __attribute__((address_space(3)))
typedef unsigned short bf16;
typedef unsigned v4u __attribute__((ext_vector_type(4)));
typedef float f32x4 __attribute__((ext_vector_type(4)));
typedef GAS unsigned gu32;
#define RLX_AGENT __ATOMIC_RELAXED, __HIP_MEMORY_SCOPE_AGENT
#define LDS_WAIT() asm volatile("s_waitcnt lgkmcnt(0)" ::: "memory")
#define VM_WAIT() asm volatile("s_waitcnt vmcnt(0)" ::: "memory")
__device__ __forceinline__ unsigned f2bf(float f) { unsigned u = __builtin_bit_cast(unsigned, f); return (u + 0x7fffu + ((u >> 16) & 1u)) >> 16; }
__device__ __forceinline__ unsigned pk2(float lo, float hi) { unsigned r; asm("v_cvt_pk_bf16_f32 %0, %1, %2" : "=v"(r) : "v"(lo), "v"(hi)); return r; }
__device__ __forceinline__ float bflo(unsigned w) { return __uint_as_float(w << 16); }
__device__ __forceinline__ float bfhi(unsigned w) { return __uint_as_float(w & 0xffff0000u); }

template <int O> __device__ __forceinline__ float shx(float v, int lane) { return __int_as_float(__builtin_amdgcn_ds_bpermute((lane ^ O) << 2, __float_as_int(v))); }
template <int O> __device__ __forceinline__ int shxi(int v, int lane) { return __builtin_amdgcn_ds_bpermute((lane ^ O) << 2, v); }

#define XB_TMO      128
#define XB_XCNT(j)  (256  + 64 * (j))
#define XB_XSUB(j)  (1280 + 64 * (j))
#define XB_XGEN(j)  (2304 + 64 * (j))
#define XB_TOP      3328
#define XB_TOPGEN   3392
#define XCD_BAR_WORDS 3456
#define XB_SPIN_CAP (1u << 18)

__device__ __forceinline__ unsigned xb_ld(unsigned* p)              { return __hip_atomic_load(p, __ATOMIC_RELAXED, __HIP_MEMORY_SCOPE_AGENT); }
__device__ __forceinline__ unsigned xb_add(unsigned* p, unsigned v) { return __hip_atomic_fetch_add(p, v, __ATOMIC_RELAXED, __HIP_MEMORY_SCOPE_AGENT); }
__device__ __forceinline__ unsigned xb_xcc_id() { return (unsigned)__builtin_amdgcn_s_getreg((3 << 11) | 20) & 0xFu; }
#define XB_SPIN(cond, bar) do { unsigned _sp = 0; while (cond) { __builtin_amdgcn_s_sleep(1); \
    if ((++_sp & 255u) == 0u) { if (xb_ld(&(bar)[XB_TMO])) break; if (_sp > XB_SPIN_CAP) { atomicAdd(&(bar)[XB_TMO], 1u); break; } } } } while (0)

struct XcdBarrier {
    unsigned* bar; unsigned x;
    volatile LAS unsigned* st;
};

__device__ __forceinline__ XcdBarrier xcd_barrier_post(unsigned* bar, volatile LAS unsigned* st) {
    XcdBarrier b; b.bar = bar; b.x = xb_xcc_id(); b.st = st;
    if (threadIdx.x == 0) (void)xb_add(&bar[XB_XCNT(b.x)], 1u);
    return b;
}
__device__ __forceinline__ void xcd_barrier_complete(unsigned* bar, unsigned x, unsigned& nloc, unsigned& nx) {
    const unsigned G = gridDim.x * gridDim.y * gridDim.z;
    unsigned sum, cnt, mine, sp = 0u;
    for (;;) {
        sum = 0u; cnt = 0u; mine = 0u;
#pragma unroll
        for (unsigned j = 0; j < 16; ++j) { const unsigned c = xb_ld(&bar[XB_XCNT(j)]); sum += c; cnt += (c > 0u) ? 1u : 0u; mine = (j == x) ? c : mine; }
        if (sum == G) break;
        __builtin_amdgcn_s_sleep(1);
        if ((++sp & 255u) == 0u) { if (xb_ld(&bar[XB_TMO])) break; if (sp > XB_SPIN_CAP) { atomicAdd(&bar[XB_TMO], 1u); break; } }
    }
    nloc = mine > 0u ? mine : 1u; nx = cnt > 0u ? cnt : 1u;
}

__device__ __forceinline__ void xcd_barrier(const XcdBarrier& b) {
    asm volatile("s_waitcnt vmcnt(0)" ::: "memory");
    __syncthreads();
    if (threadIdx.x == 0) {
        unsigned* bar = b.bar;
        __builtin_amdgcn_s_waitcnt(0);
        unsigned nloc = b.st[0], nx = b.st[1];
        if (nloc == 0u) { xcd_barrier_complete(bar, b.x, nloc, nx); b.st[0] = nloc; b.st[1] = nx; }
        const unsigned old = xb_add(&bar[XB_XSUB(b.x)], 1u);
        const unsigned gen = old / nloc;
        if (old + 1u == (gen + 1u) * nloc) {
            __builtin_amdgcn_fence(__ATOMIC_RELEASE, "agent");
            asm volatile("s_waitcnt vmcnt(0)" ::: "memory");
            const unsigned og = xb_add(&bar[XB_TOP], 1u);
            const unsigned tg = og / nx;
            if (og + 1u == (tg + 1u) * nx) xb_add(&bar[XB_TOPGEN], 1u);
            else XB_SPIN(xb_ld(&bar[XB_TOPGEN]) == tg, bar);
            __builtin_amdgcn_fence(__ATOMIC_ACQUIRE, "agent");
            xb_add(&bar[XB_XGEN(b.x)], 1u);
            asm volatile("s_waitcnt vmcnt(0)" ::: "memory");
        } else {
            XB_SPIN(xb_ld(&bar[XB_XGEN(b.x)]) == gen, bar);
            __builtin_amdgcn_fence(__ATOMIC_ACQUIRE, "agent");
            asm volatile("s_waitcnt vmcnt(0)" ::: "memory");
        }
    }
    __syncthreads();
}


struct Frame {
    LAS unsigned char* lds;
    gu32* ctl;
    int tid, lane, wave;
    int vcu, G, bx;
    unsigned char* ws;
    float* out;
};
__device__ __forceinline__ const float* in_ptr(int i) {
    const void* base = (const void*)__builtin_amdgcn_kernarg_segment_ptr(); const GAS float* p;
    asm volatile("s_load_dwordx2 %0, %1, %2\n\ts_waitcnt lgkmcnt(0)" : "=s"(p) : "s"(base), "i"(i * 8) : "memory"); return (const float*)p;
}
#define INP(i) in_ptr(i)
template <int SITE> __device__ __forceinline__ Frame mkframe(LAS unsigned char* lds_in, unsigned char* ws_in, float* out_in, int wave_id, int bx0, int G0) {
    Frame F; int lane_;
    asm volatile("v_mbcnt_lo_u32_b32 %0, -1, 0\n\tv_mbcnt_hi_u32_b32 %0, -1, %0 ; site %1" : "=v"(lane_) : "n"(SITE));
    int bx = bx0, G = G0, wv = wave_id; asm volatile("; site %3" : "+s"(bx), "+s"(G), "+s"(wv) : "n"(SITE));
    GAS unsigned char* wsg = (GAS unsigned char*)ws_in; asm volatile("; site %1" : "+s"(wsg) : "n"(SITE)); unsigned char* ws = (unsigned char*)wsg;
    LAS unsigned char* l3 = lds_in; asm volatile("; site %1" : "+s"(l3) : "n"(SITE));
    const int tid = wv * 64 + lane_;
    F.lds = l3; F.tid = tid; F.lane = lane_; F.wave = wv;
    F.G = G; F.bx = bx; F.vcu = (G % 8 == 0) ? (bx % 8) * (G / 8) + bx / 8 : bx;
    F.ws = ws; F.ctl = (gu32*)(wsg + WS_CTL); F.out = out_in; return F;
}
__device__ __forceinline__ float wave_sum(float v, int lane) {
    v += shx<1>(v, lane); v += shx<2>(v, lane); v += shx<4>(v, lane); v += shx<8>(v, lane); v += shx<16>(v, lane); v += shx<32>(v, lane);
    return v;
}
__device__ __forceinline__ void tr_item(const float* W, int ldw, int Kd, int k0, int src_n0, bf16* WT, int dst_n0, float scale, LAS float* scr, int lane) {
    float v[32];
#pragma unroll
    for (int i = 0; i < 32; ++i) v[i] = W[(size_t)(k0 + 2 * i + (lane >> 5)) * ldw + src_n0 + (lane & 31)];
#pragma unroll
    for (int i = 0; i < 32; ++i) scr[(2 * i + (lane >> 5)) * 33 + (lane & 31)] = v[i];
    LDS_WAIT(); asm volatile("" ::: "memory");
    const int c = lane & 7;
#pragma unroll
    for (int j = 0; j < 4; ++j) { const int n = (lane >> 3) + 8 * j; const LAS float* s = scr + (8 * c) * 33 + n;
        v4u o; o.x = pk2(s[0 * 33] * scale, s[1 * 33] * scale); o.y = pk2(s[2 * 33] * scale, s[3 * 33] * scale); o.z = pk2(s[4 * 33] * scale, s[5 * 33] * scale); o.w = pk2(s[6 * 33] * scale, s[7 * 33] * scale);
        *(GAS v4u*)(WT + (size_t)(dst_n0 + n) * Kd + k0 + 8 * c) = o; }
    LDS_WAIT(); asm volatile("" ::: "memory");
}
template <int KIND> __device__ __forceinline__ void conv_matrix(Frame& F, const float* W, int K, int N, bf16* WT, float s, int gw, int NGW, LAS float* scr, int Kd = 0) {
    if (Kd == 0) Kd = K;
    const int nnb = N / 32, nkb = K / 64, nit = nnb * nkb;
    for (int it = gw; it < nit; it += NGW) {
        const int kb = it / nnb, nb = it % nnb; const int dst_n0 = 32 * nb; int src_n0 = dst_n0; float sc = s;
        if (KIND == 1) sc = (dst_n0 < 384) ? s : 1.0f;
        if (KIND == 2) { const int p = dst_n0 >> 8, j = dst_n0 & 255; src_n0 = (j < 128) ? (128 * p + j) : (1024 + 128 * p + (j - 128)); }
        tr_item(W, N, Kd, 64 * kb, src_n0, WT, dst_n0, sc, scr, F.lane);
    }
}
__device__ __forceinline__ void zero_rows(bf16* WT, int K, int n_lo, int n_hi, int gtid, int nthr) {
    const size_t n16 = (size_t)(n_hi - n_lo) * K / 8; GAS v4u* p = (GAS v4u*)(WT + (size_t)n_lo * K);
    for (size_t i = gtid; i < n16; i += nthr) p[i] = (v4u){0u, 0u, 0u, 0u};
}
__device__ __forceinline__ void p_prologue(Frame& F) {
    LAS float* scr = (LAS float*)(F.lds + F.wave * 16384);
    const int gw0 = F.vcu * NWAVES + F.wave, NGW = F.G * NWAVES, gtid = F.bx * (NWAVES * 64) + F.tid, nthr = F.G * NWAVES * 64;
    for (int l = 0; l < DEPTH; ++l) {
        unsigned char* wb = F.ws + WS_W + (size_t)l * WB_LAYER;
        int gw = gw0;
#define ROT(n) do { gw = (gw + NGW - ((n) % NGW)) % NGW; } while (0)
        conv_matrix<1>(F, INP(1) + (size_t)l * 1024 * DIN, 1024, DIN, (bf16*)(wb + WB_IN), 0.125f * LOG2E_F, gw, NGW, scr); ROT(16 * 173);
        zero_rows((bf16*)(wb + WB_IN), 1024, DIN, DINP, gtid, nthr);
        conv_matrix<0>(F, INP(7) + (size_t)l * 384 * 384, 384, 384, (bf16*)(wb + WB_UQ), 0.10206207261596577f * LOG2E_F, gw, NGW, scr); ROT(72);
        zero_rows((bf16*)(wb + WB_UQ), 384, 384, 512, gtid, nthr);
        conv_matrix<0>(F, INP(8) + (size_t)l * 256 * 512, 256, 512, (bf16*)(wb + WB_UKV), 1.0f, gw, NGW, scr); ROT(64);
        conv_matrix<0>(F, INP(9) + (size_t)l * 384 * 1024, 384, 1024, (bf16*)(wb + WB_BA), 1.0f, gw, NGW, scr); ROT(192);
        conv_matrix<0>(F, INP(10) + (size_t)l * 384 * 1024, 384, 1024, (bf16*)(wb + WB_BB), 1.0f, gw, NGW, scr); ROT(192);
        conv_matrix<0>(F, INP(11) + (size_t)l * 256 * 1024, 256, 1024, (bf16*)(wb + WB_BC), 1.0f, gw, NGW, scr, 384); ROT(64);
        for (int i = gtid; i < 1024 * 16; i += nthr) *((GAS v4u*)(wb + WB_BC) + (size_t)(i >> 4) * 48 + 32 + (i & 15)) = (v4u){0u, 0u, 0u, 0u};
        conv_matrix<0>(F, INP(12) + (size_t)l * 1024 * 1024, 1024, 1024, (bf16*)(wb + WB_OUT), 1.0f, gw, NGW, scr); ROT(512);
#undef ROT
    }
    { const GAS f32x4* xs = (const GAS f32x4*)INP(0); GAS v4u* xd = (GAS v4u*)(F.ws + WS_XB);
      for (size_t i = gtid; i < (size_t)T * D / 8; i += nthr) { const f32x4 a = xs[2 * i], b = xs[2 * i + 1]; xd[i] = (v4u){pk2(a.x, a.y), pk2(a.z, a.w), pk2(b.x, b.y), pk2(b.z, b.w)}; } }
}

constexpr int CONV_ITEMS = NE * 1024 + NE * 512, CONV_LDS_OFF = 49152, CONV_LDS_WAVE = 2 * 16 * 33 * 4;
struct MoeConv {
    static constexpr bool PLAIN = false;
    const float* Wgu; const float* Wdn; bf16* Tgu; bf16* Tdn;
    LAS float* scr; int lane; int gw, ngw, nmini; int s;
    float cvA[8], cvB[8];
    struct Mini { const float* W; bf16* WT; int ldw, k0, src_n0, dst_n0; };
    __device__ __forceinline__ Mini decode(int m) const {
        m = m < 0 ? 0 : (m >= nmini ? nmini - 1 : m);
        const int g = gw + (m >> 2) * ngw, q = m & 3; const bool gu = g < NE * 1024; const int h = gu ? g : g - NE * 1024;
        const int e = gu ? (h >> 10) : (h >> 9), r = gu ? (h & 1023) : (h & 511), kb = gu ? (r >> 6) : (r >> 5), nb = gu ? (r & 63) : (r & 31);
        Mini x; x.dst_n0 = 32 * nb; const int p = x.dst_n0 >> 8, j = x.dst_n0 & 255;
        x.src_n0 = gu ? ((j < 128) ? (128 * p + j) : (1024 + 128 * p + (j - 128))) : x.dst_n0; x.k0 = 64 * kb + 16 * q; x.ldw = gu ? 2048 : 1024;
        x.W = gu ? Wgu + (size_t)e * 1024 * 2048 : Wdn + (size_t)e * 1024 * 1024; x.WT = gu ? Tgu + (size_t)e * 2048 * 1024 : Tdn + (size_t)e * 1024 * 1024; return x;
    }
    __device__ __forceinline__ bool done() const { return s >= nmini + 3; }
    template <int P> __device__ __forceinline__ void step() {
        {   const Mini x = decode(s - 3); const LAS float* b = scr + (1 - P) * (16 * 33); const int n = lane >> 1, kh = lane & 1; const LAS float* p = b + (8 * kh) * 33 + n;
            v4u o; o.x = pk2(p[0 * 33], p[1 * 33]); o.y = pk2(p[2 * 33], p[3 * 33]); o.z = pk2(p[4 * 33], p[5 * 33]); o.w = pk2(p[6 * 33], p[7 * 33]);
            *(GAS v4u*)(x.WT + (size_t)(x.dst_n0 + n) * 1024 + x.k0 + 8 * kh) = o; }
        {   LAS float* b = scr + P * (16 * 33);
#pragma unroll
            for (int jj = 0; jj < 8; ++jj) b[(2 * jj + (lane >> 5)) * 33 + (lane & 31)] = P ? cvB[jj] : cvA[jj]; }
        {   const Mini x = decode(s); const GAS float* src = (const GAS float*)x.W + (size_t)(x.k0 + (lane >> 5)) * x.ldw + x.src_n0 + (lane & 31);
#pragma unroll
            for (int jj = 0; jj < 8; ++jj) { const float v = src[(size_t)(2 * jj) * x.ldw]; if (P) cvB[jj] = v; else cvA[jj] = v; } }
        ++s;
    }
};
__device__ __forceinline__ void p_prep(Frame& F, int l) {
    const bf16* hb = (const bf16*)(F.ws + WS_H); unsigned char* a2 = F.ws + WS_A2;
    bf16* kB = (bf16*)(a2 + A2_KB); bf16* cqn = (bf16*)(a2 + A2_CQN); bf16* ckvn = (bf16*)(a2 + A2_CKVN); bf16* kr = (bf16*)(a2 + A2_KR);
    const float* gk = INP(4) + l * 64; const float* gq = INP(5) + l * 384; const float* gkv = INP(6) + l * 256;
    const int lane = F.lane, gw = F.vcu * NWAVES + F.wave, NGW = F.G * NWAVES;
    v4u nk = {0u, 0u, 0u, 0u}, nq = nk, nkv = nk, nr = nk;
    if (gw < T) { const bf16* h0 = hb + (size_t)gw * DINP; if (lane < 16) nk = *(const GAS v4u*)(h0 + H_GK + lane * 8); if (lane < 48) nq = *(const GAS v4u*)(h0 + H_CQ + lane * 8);
        if (lane < 32) nkv = *(const GAS v4u*)(h0 + H_CKV + lane * 8); if (lane < 4) nr = *(const GAS v4u*)(h0 + H_KR + lane * 8); }
    for (int t = gw; t < T; t += NGW) {
        const v4u wk_ = nk, wq_ = nq, wkv_ = nkv, wr_ = nr;
        if (t + NGW < T) { const bf16* h1 = hb + (size_t)(t + NGW) * DINP; if (lane < 16) nk = *(const GAS v4u*)(h1 + H_GK + lane * 8); if (lane < 48) nq = *(const GAS v4u*)(h1 + H_CQ + lane * 8);
            if (lane < 32) nkv = *(const GAS v4u*)(h1 + H_CKV + lane * 8); if (lane < 4) nr = *(const GAS v4u*)(h1 + H_KR + lane * 8); }
        const int s = t & (SEQ - 1); const float prow = (float)(s >> 6), pcol = (float)(s & 63);
        {   float x[8]; float ssq = 0.f; const int cc = lane & 7;
            if (lane < 16) { const v4u w = wk_; x[0] = bflo(w.x); x[1] = bfhi(w.x); x[2] = bflo(w.y); x[3] = bfhi(w.y); x[4] = bflo(w.z); x[5] = bfhi(w.z); x[6] = bflo(w.w); x[7] = bfhi(w.w); }
            else {
#pragma unroll
                for (int j = 0; j < 8; ++j) x[j] = 0.f; }
#pragma unroll
            for (int j = 0; j < 8; ++j) ssq += x[j] * x[j];
            ssq += shx<1>(ssq, lane); ssq += shx<2>(ssq, lane); ssq += shx<4>(ssq, lane);
            const float rstd = 1.0f / sqrtf(ssq * (1.0f / 64.0f) + RMS_EPS);
            float y[8], o[8];
#pragma unroll
            for (int j = 0; j < 8; ++j) y[j] = x[j] * rstd * gk[(cc * 8 + j) & 63];
#pragma unroll
            for (int j = 0; j < 8; ++j) { const float other = shx<4>(y[j], lane); const int i = 8 * (cc & 3) + j;
                const float inv = exp2f(-(float)(i & 15) * (att::LOG2_THETA / 16.0f)); const float ang = ((i < 16) ? prow : pcol) * inv * att::INV2PI;
                const float c = __builtin_amdgcn_cosf(ang), sn = __builtin_amdgcn_sinf(ang);
                o[j] = (cc < 4) ? (y[j] * c - other * sn) : (other * sn + y[j] * c); }
            if (lane < 16) *(GAS v4u*)(kB + (size_t)t * 128 + lane * 8) = (v4u){pk2(o[0], o[1]), pk2(o[2], o[3]), pk2(o[4], o[5]), pk2(o[6], o[7])};
        }
        {   float x[8]; float ssq = 0.f;
            if (lane < 48) { const v4u w = wq_; x[0] = bflo(w.x); x[1] = bfhi(w.x); x[2] = bflo(w.y); x[3] = bfhi(w.y); x[4] = bflo(w.z); x[5] = bfhi(w.z); x[6] = bflo(w.w); x[7] = bfhi(w.w); }
            else {
#pragma unroll
                for (int j = 0; j < 8; ++j) x[j] = 0.f; }
#pragma unroll
            for (int j = 0; j < 8; ++j) ssq += x[j] * x[j];
            ssq = wave_sum(ssq, lane); const float rstd = 1.0f / sqrtf(ssq * (1.0f / 384.0f) + RMS_EPS);
            if (lane < 48) { float y[8];
#pragma unroll
                for (int j = 0; j < 8; ++j) y[j] = x[j] * rstd * gq[lane * 8 + j];
                *(GAS v4u*)(cqn + (size_t)t * 384 + lane * 8) = (v4u){pk2(y[0], y[1]), pk2(y[2], y[3]), pk2(y[4], y[5]), pk2(y[6], y[7])}; }
        }
        {   float x[8]; float ssq = 0.f;
            if (lane < 32) { const v4u w = wkv_; x[0] = bflo(w.x); x[1] = bfhi(w.x); x[2] = bflo(w.y); x[3] = bfhi(w.y); x[4] = bflo(w.z); x[5] = bfhi(w.z); x[6] = bflo(w.w); x[7] = bfhi(w.w); }
            else {
#pragma unroll
                for (int j = 0; j < 8; ++j) x[j] = 0.f; }
#pragma unroll
            for (int j = 0; j < 8; ++j) ssq += x[j] * x[j];
            ssq = wave_sum(ssq, lane); const float rstd = 1.0f / sqrtf(ssq * (1.0f / 256.0f) + RMS_EPS);
            if (lane < 32) { float y[8];
#pragma unroll
                for (int j = 0; j < 8; ++j) y[j] = x[j] * rstd * gkv[lane * 8 + j];
                *(GAS v4u*)(ckvn + (size_t)t * 256 + lane * 8) = (v4u){pk2(y[0], y[1]), pk2(y[2], y[3]), pk2(y[4], y[5]), pk2(y[6], y[7])}; }
        }
        {   float x[8]; const int cc = lane & 3;
            if (lane < 4) { const v4u w = wr_; x[0] = bflo(w.x); x[1] = bfhi(w.x); x[2] = bflo(w.y); x[3] = bfhi(w.y); x[4] = bflo(w.z); x[5] = bfhi(w.z); x[6] = bflo(w.w); x[7] = bfhi(w.w); }
            else {
#pragma unroll
                for (int j = 0; j < 8; ++j) x[j] = 0.f; }
            float o[8];
#pragma unroll
            for (int j = 0; j < 8; ++j) { const float other = shx<2>(x[j], lane);
                const float inv = exp2f(-(float)j * (att::LOG2_THETA / 8.0f)); const float ang = (((cc & 1) == 0) ? prow : pcol) * inv * att::INV2PI;
                const float c = __builtin_amdgcn_cosf(ang), sn = __builtin_amdgcn_sinf(ang);
                o[j] = (cc < 2) ? (x[j] * c - other * sn) : (other * sn + x[j] * c); }
            if (lane < 4) *(GAS v4u*)(kr + (size_t)t * 32 + lane * 8) = (v4u){pk2(o[0], o[1]), pk2(o[2], o[3]), pk2(o[4], o[5]), pk2(o[6], o[7])};
        }
    }
}


__device__ __forceinline__ int build_tables(Frame& F, int l) {
    LAS int* st = (LAS int*)(F.lds + TBL_START); LAS int* cn = st + 33; LAS int* te = (LAS int*)(F.lds + TBL_TILEE);
    __syncthreads();
    if (F.tid < NE) cn[F.tid] = (int)__hip_atomic_load(F.ctl + CW_CNT + 64 * l + F.tid, RLX_AGENT);
    __syncthreads();
    if (F.tid == 0) { int s = 0; for (int e = 0; e < NE; ++e) { st[e] = s; s += ((cn[e] + 255) >> 8) << 8; } st[NE] = s; }
    __syncthreads();
    const int total = st[NE];
    for (int tile = F.tid; tile < (total >> 8); tile += NWAVES * 64) { int e = 0; for (int k = 1; k < NE; ++k) e += (tile * 256 >= st[k]) ? 1 : 0; te[tile] = e; }
    __syncthreads();
    return total;
}

template <bool XBF> __device__ __forceinline__ void p_ln1_router(Frame& F, int l, const void* xin) {
    const float* xcur = (const float*)xin; const bf16* xcb = (const bf16*)xin;
    const bf16* outb = (const bf16*)(F.ws + WS_X1); bf16* x1b = (bf16*)(F.ws + WS_X1B);
    int* list_t = (int*)(F.ws + WS_LT); float* list_g = (float*)(F.ws + WS_LG); int* tok_e = (int*)(F.ws + WS_TE); int* tok_r = (int*)(F.ws + WS_TR);
    const float* wr = INP(15) + (size_t)l * 1024 * NE; const float* br = INP(16) + l * NE;
    const int lane0 = F.lane, tid = F.tid;
    LAS unsigned char* wl = F.lds;
    LAS int* sel_e = (LAS int*)(F.lds + TBL_RS); LAS float* sel_g = (LAS float*)(sel_e + 512); LAS int* sel_r = sel_e + 1024; LAS int* hist = sel_e + 1536; LAS int* base = hist + 32;
    __syncthreads();
    for (int idx = tid; idx < 1024 * 8; idx += NWAVES * 64) { const int k = idx >> 3, c = idx & 7, kp = (k & 3) * 256 + (k >> 2), cp = c ^ ((kp >> 1) & 7);
        *(LAS f32x4*)(wl + (kp * 8 + cp) * 16) = *(const GAS f32x4*)(wr + (size_t)k * NE + c * 4); }
    __syncthreads();
    for (int tile = F.bx; tile < T / 128; tile += F.G) {
        if (tid < 32) hist[tid] = 0;
        __syncthreads();
        f32x4 px[4]; unsigned long long po[4], pxb[4];
        {   const int t0 = tile * 128 + F.wave * 16; const GAS f32x4* xr0 = (const GAS f32x4*)(xcur + (size_t)t0 * D) + lane0; const GAS unsigned long long* or0 = (const GAS unsigned long long*)(outb + (size_t)t0 * D) + lane0;
#pragma unroll
            for (int j = 0; j < 4; ++j) { if (XBF) pxb[j] = ((const GAS unsigned long long*)(xcb + (size_t)t0 * D) + lane0)[64 * j]; else px[j] = xr0[64 * j]; po[j] = or0[64 * j]; } }
        for (int it = 0; it < 16; ++it) {
            int lane = lane0; asm volatile("" : "+v"(lane));
            const int sw = (lane >> 1) & 7; const float bias_e = br[(lane >> 1) & 31];
            const GAS f32x4* lgp = (const GAS f32x4*)(INP(13) + l * D) + lane; const GAS f32x4* lbp = (const GAS f32x4*)(INP(14) + l * D) + lane;
            const int tl = F.wave * 16 + it, t = tile * 128 + tl;
            f32x4 v[4]; float s = 0.f;
#pragma unroll
            for (int j = 0; j < 4; ++j) { const unsigned long long ow = po[j]; const unsigned olo = (unsigned)ow, ohi = (unsigned)(ow >> 32);
                f32x4 xv_; if (XBF) { const unsigned xlo = (unsigned)pxb[j], xhi = (unsigned)(pxb[j] >> 32); xv_ = (f32x4){bflo(xlo), bfhi(xlo), bflo(xhi), bfhi(xhi)}; } else xv_ = px[j];
                v[j] = xv_ * DN_ALPHA + (f32x4){bflo(olo), bfhi(olo), bflo(ohi), bfhi(ohi)}; s += (v[j].x + v[j].y) + (v[j].z + v[j].w); }
            if (it + 1 < 16) { const GAS f32x4* xr = (const GAS f32x4*)(xcur + (size_t)(t + 1) * D) + lane; const GAS unsigned long long* orr = (const GAS unsigned long long*)(outb + (size_t)(t + 1) * D) + lane;
#pragma unroll
                for (int j = 0; j < 4; ++j) { if (XBF) pxb[j] = ((const GAS unsigned long long*)(xcb + (size_t)(t + 1) * D) + lane)[64 * j]; else px[j] = xr[64 * j]; po[j] = orr[64 * j]; } }
            const float mean = wave_sum(s, lane) * (1.f / D); float s2 = 0.f;
#pragma unroll
            for (int j = 0; j < 4; ++j) { v[j] = v[j] - mean; s2 += (v[j].x * v[j].x + v[j].y * v[j].y) + (v[j].z * v[j].z + v[j].w * v[j].w); }
            const float rstd = 1.f / sqrtf(wave_sum(s2, lane) * (1.f / D) + LN_EPS);
            GAS unsigned long long* o8 = (GAS unsigned long long*)(x1b + (size_t)t * D) + lane;
#pragma unroll
            for (int j = 0; j < 4; ++j) { v[j] = v[j] * rstd * lgp[64 * j] + lbp[64 * j];
                o8[64 * j] = (unsigned long long)pk2(v[j].x, v[j].y) | ((unsigned long long)pk2(v[j].z, v[j].w) << 32); }
            float acc[32];
#pragma unroll
            for (int c = 0; c < 8; ++c) {
                int basec = lane * 128 + ((c ^ sw) << 4); asm volatile("" : "+v"(basec));
                const LAS unsigned char* wp = wl + basec;
                typedef float f32x2p __attribute__((ext_vector_type(2)));
                f32x2p a01 = {0.f, 0.f}, a23 = {0.f, 0.f};
#pragma unroll
                for (int i = 0; i < 4; ++i)
#pragma unroll
                    for (int j = 0; j < 4; ++j) { const f32x4 w = *(const LAS f32x4*)(wp + (i * 256 + 64 * j) * 128); const float xv = v[j][i]; const f32x2p x2 = {xv, xv};
                        a01 = __builtin_elementwise_fma(x2, (f32x2p){w.x, w.y}, a01); a23 = __builtin_elementwise_fma(x2, (f32x2p){w.z, w.w}, a23); }
                acc[4 * c + 0] = a01.x; acc[4 * c + 1] = a01.y; acc[4 * c + 2] = a23.x; acc[4 * c + 3] = a23.y;
            }
            float a16[16], a8[8], a4[4], a2[2], a1;
            { const bool b = (lane & 32) != 0;
#pragma unroll
              for (int i = 0; i < 16; ++i) { const float send = b ? acc[i] : acc[16 + i]; const float keep = b ? acc[16 + i] : acc[i]; a16[i] = keep + shx<32>(send, lane); } }
            { const bool b = (lane & 16) != 0;
#pragma unroll
              for (int i = 0; i < 8; ++i) { const float send = b ? a16[i] : a16[8 + i]; const float keep = b ? a16[8 + i] : a16[i]; a8[i] = keep + shx<16>(send, lane); } }
            { const bool b = (lane & 8) != 0;
#pragma unroll
              for (int i = 0; i < 4; ++i) { const float send = b ? a8[i] : a8[4 + i]; const float keep = b ? a8[4 + i] : a8[i]; a4[i] = keep + shx<8>(send, lane); } }
            { const bool b = (lane & 4) != 0;
#pragma unroll
              for (int i = 0; i < 2; ++i) { const float send = b ? a4[i] : a4[2 + i]; const float keep = b ? a4[2 + i] : a4[i]; a2[i] = keep + shx<4>(send, lane); } }
            { const bool b = (lane & 2) != 0; const float send = b ? a2[0] : a2[1]; const float keep = b ? a2[1] : a2[0]; a1 = keep + shx<2>(send, lane); }
            a1 += shx<1>(a1, lane);
            float val = a1 + bias_e; const int my_e = (lane >> 1) & 31;
            float sv[4]; int se[4];
#pragma unroll
            for (int r = 0; r < 4; ++r) { float bv = val; int be = my_e;
#define TOPK_STEP(O) { const float ov = shx<O>(bv, lane); const int oe = shxi<O>(be, lane); if (ov > bv || (ov == bv && oe < be)) { bv = ov; be = oe; } }
                TOPK_STEP(2) TOPK_STEP(4) TOPK_STEP(8) TOPK_STEP(16) TOPK_STEP(32)
#undef TOPK_STEP
                sv[r] = bv; se[r] = be; if (my_e == be) val = -INFINITY; }
            const float e1 = __expf(sv[1] - sv[0]), e2 = __expf(sv[2] - sv[0]), e3 = __expf(sv[3] - sv[0]); const float rs = 1.0f / (1.0f + e1 + e2 + e3);
            if (lane < 4) { const int ee = lane == 0 ? se[0] : lane == 1 ? se[1] : lane == 2 ? se[2] : se[3]; const float gg = (lane == 0 ? 1.0f : lane == 1 ? e1 : lane == 2 ? e2 : e3) * rs;
                const int a = tl * 4 + lane; sel_e[a] = ee; sel_g[a] = gg; sel_r[a] = __hip_atomic_fetch_add(&hist[ee], 1, __ATOMIC_RELAXED, __HIP_MEMORY_SCOPE_WORKGROUP); }
        }
        __syncthreads();
        if (tid < 32) base[tid] = (int)__hip_atomic_fetch_add(F.ctl + CW_CNT + 64 * l + tid, (unsigned)hist[tid], RLX_AGENT);
        __syncthreads();
        { const int a = tid, e = sel_e[a], rank = base[e] + sel_r[a], t = tile * 128 + (a >> 2);
          list_t[(size_t)e * LCAP + rank] = t; list_g[(size_t)e * LCAP + rank] = sel_g[a]; tok_e[t * 4 + (a & 3)] = e; tok_r[t * 4 + (a & 3)] = rank; }
        __syncthreads();
    }
}

__device__ __forceinline__ void p_gather(Frame& F, int l) {
    const int total = build_tables(F, l);
    LAS int* st = (LAS int*)(F.lds + TBL_START); LAS int* cn = st + 33;
    const bf16* x1b = (const bf16*)(F.ws + WS_X1B); bf16* xg = (bf16*)(F.ws + WS_H); float* sg = (float*)(F.ws + WS_SG);
    const int* list_t = (const int*)(F.ws + WS_LT); const float* list_g = (const float*)(F.ws + WS_LG);
    const int lane = F.lane, gw = F.vcu * NWAVES + F.wave, NGW = F.G * NWAVES;
    for (int s = gw; s < total; s += NGW) {
        const bool pr = (lane < NE) && (s >= st[lane & 31]);
        const int e = __popcll(__ballot(pr)) - 1; const int r = s - st[e];
        GAS v4u* dst = (GAS v4u*)(xg + (size_t)s * D);
        if (r < cn[e]) { const int t = list_t[(size_t)e * LCAP + r]; const GAS v4u* src = (const GAS v4u*)(x1b + (size_t)t * D);
            dst[lane] = src[lane]; dst[64 + lane] = src[64 + lane]; if (lane == 0) sg[s] = list_g[(size_t)e * LCAP + r]; }
        else { unsigned zz = 0u; asm volatile("" : "+v"(zz)); const v4u z4 = {zz, zz, zz, zz}; dst[lane] = z4; dst[64 + lane] = z4; if (lane == 0) sg[s] = 0.f; }
    }
}

__device__ __forceinline__ void p_ln2(Frame& F, int l, float* dst, bool write_f32, bool write_xb) {
    (void)build_tables(F, l);
    LAS int* st = (LAS int*)(F.lds + TBL_START);
    const bf16* x1b = (const bf16*)(F.ws + WS_X1B); const bf16* yb = (const bf16*)(F.ws + WS_H); bf16* xb = (bf16*)(F.ws + WS_XB);
    const int* tok_e = (const int*)(F.ws + WS_TE); const int* tok_r = (const int*)(F.ws + WS_TR);
    const int lane = F.lane, hl = lane & 31, half = lane >> 5, gw = F.vcu * NWAVES + F.wave, NGW = F.G * NWAVES;
    const float* lgp = INP(21) + l * D; const float* lbp = INP(22) + l * D;
    float dmult = 1.0f;
#if MK_DEBUG
    if (l == DEPTH - 1) { const unsigned mask = __hip_atomic_load(F.ctl + 20000, RLX_AGENT) & ~(unsigned)(MK_DBG_IGNORE); if (mask) dmult = 1.0f + (float)(__ffs((int)mask) - 1); }
#endif
    int t = 2 * gw + half;
    int e4 = 0, r4 = 0;
    if (t < T && hl < 4) { e4 = tok_e[t * 4 + hl]; r4 = tok_r[t * 4 + hl]; }
    v4u xn[4] = {{0u, 0u, 0u, 0u}, {0u, 0u, 0u, 0u}, {0u, 0u, 0u, 0u}, {0u, 0u, 0u, 0u}};
    if (t < T) { const GAS v4u* xr = (const GAS v4u*)(x1b + (size_t)t * D) + hl;
#pragma unroll
        for (int q = 0; q < 4; ++q) xn[q] = xr[32 * q]; }
    for (; t < T; t += 2 * NGW) {
        int slot4 = st[e4] + r4;
        const int tn = t + 2 * NGW; int e4n = 0, r4n = 0;
        if (tn < T && hl < 4) { e4n = tok_e[tn * 4 + hl]; r4n = tok_r[tn * 4 + hl]; }
        int slot[4];
#pragma unroll
        for (int k = 0; k < 4; ++k) slot[k] = __builtin_amdgcn_ds_bpermute((half * 32 + k) << 2, slot4);
        v4u xw[4], yw[4][4];
#pragma unroll
        for (int q = 0; q < 4; ++q) xw[q] = xn[q];
        if (tn < T) { const GAS v4u* xr = (const GAS v4u*)(x1b + (size_t)tn * D) + hl;
#pragma unroll
            for (int q = 0; q < 4; ++q) xn[q] = xr[32 * q]; }
#pragma unroll
        for (int k = 0; k < 4; ++k) { const GAS v4u* yr = (const GAS v4u*)(yb + (size_t)slot[k] * D) + hl;
#pragma unroll
            for (int q = 0; q < 4; ++q) yw[k][q] = yr[32 * q]; }
        float v[4][8]; float s = 0.f;
#pragma unroll
        for (int q = 0; q < 4; ++q) {
            v[q][0] = bflo(xw[q].x) * DN_ALPHA; v[q][1] = bfhi(xw[q].x) * DN_ALPHA; v[q][2] = bflo(xw[q].y) * DN_ALPHA; v[q][3] = bfhi(xw[q].y) * DN_ALPHA;
            v[q][4] = bflo(xw[q].z) * DN_ALPHA; v[q][5] = bfhi(xw[q].z) * DN_ALPHA; v[q][6] = bflo(xw[q].w) * DN_ALPHA; v[q][7] = bfhi(xw[q].w) * DN_ALPHA;
#pragma unroll
            for (int k = 0; k < 4; ++k) { v[q][0] += bflo(yw[k][q].x); v[q][1] += bfhi(yw[k][q].x); v[q][2] += bflo(yw[k][q].y); v[q][3] += bfhi(yw[k][q].y);
                v[q][4] += bflo(yw[k][q].z); v[q][5] += bfhi(yw[k][q].z); v[q][6] += bflo(yw[k][q].w); v[q][7] += bfhi(yw[k][q].w); }
#pragma unroll
            for (int i = 0; i < 8; ++i) s += v[q][i]; }
        s += shx<1>(s, lane); s += shx<2>(s, lane); s += shx<4>(s, lane); s += shx<8>(s, lane); s += shx<16>(s, lane);
        const float mean = s * (1.f / D); float s2 = 0.f;
#pragma unroll
        for (int q = 0; q < 4; ++q)
#pragma unroll
            for (int i = 0; i < 8; ++i) { v[q][i] -= mean; s2 += v[q][i] * v[q][i]; }
        s2 += shx<1>(s2, lane); s2 += shx<2>(s2, lane); s2 += shx<4>(s2, lane); s2 += shx<8>(s2, lane); s2 += shx<16>(s2, lane);
        const float rstd = 1.f / sqrtf(s2 * (1.f / D) + LN_EPS);
        GAS f32x4* orow = (GAS f32x4*)(dst + (size_t)t * D) + 2 * hl; GAS v4u* o16 = (GAS v4u*)(xb + (size_t)t * D) + hl;
#pragma unroll
        for (int q = 0; q < 4; ++q) { const GAS f32x4* gq = (const GAS f32x4*)(lgp + 256 * q) + 2 * hl; const GAS f32x4* bq = (const GAS f32x4*)(lbp + 256 * q) + 2 * hl;
            const f32x4 g0 = gq[0], g1 = gq[1], b0 = bq[0], b1 = bq[1];
            f32x4 y0 = {v[q][0] * rstd, v[q][1] * rstd, v[q][2] * rstd, v[q][3] * rstd}, y1 = {v[q][4] * rstd, v[q][5] * rstd, v[q][6] * rstd, v[q][7] * rstd};
            y0 = y0 * g0 + b0; y1 = y1 * g1 + b1;
            if (write_f32) { orow[64 * q] = y0 * dmult; orow[64 * q + 1] = y1 * dmult; }
            if (write_xb) o16[32 * q] = (v4u){pk2(y0.x, y0.y), pk2(y0.z, y0.w), pk2(y1.x, y1.y), pk2(y1.z, y1.w)}; }
        e4 = e4n; r4 = r4n;
    }
}

template <int WHICH> __device__ __forceinline__ void p_attention(Frame& F, int l) {
    const bf16* hb = (const bf16*)(F.ws + WS_H); unsigned char* a2 = F.ws + WS_A2;
    const bf16* kB = (const bf16*)(a2 + A2_KB); const bf16* kr = (const bf16*)(a2 + A2_KR); const bf16* qc = (const bf16*)(a2 + A2_QC); const bf16* kvc = (const bf16*)(a2 + A2_KVC);
    bf16* ya = (bf16*)(a2 + A2_YA); bf16* yb = (bf16*)(a2 + A2_YB); bf16* yc = (bf16*)(a2 + A2_YC);
    att::ALAS_PTR lds = (att::ALAS_PTR)F.lds;
    att::NoSide noside;
    __syncthreads();
    if (WHICH == 0) {
        float mq = fabsf((INP(3) + l * 64)[F.lane]), mk = fabsf((INP(4) + l * 64)[F.lane]);
#define MX_STEP(O) { mq = fmaxf(mq, shx<O>(mq, F.lane)); mk = fmaxf(mk, shx<O>(mk, F.lane)); }
        MX_STEP(1) MX_STEP(2) MX_STEP(4) MX_STEP(8) MX_STEP(16) MX_STEP(32)
#undef MX_STEP
        const float cref = __int_as_float(__builtin_amdgcn_readfirstlane(__float_as_int(8.0f * LOG2E_F * 1.03f * mq * mk)));
        const bool fixed_ok = cref < 60.0f;
        unsigned char* wbl = F.ws + WS_W + (size_t)l * WB_LAYER;
        MoeConv cv; cv.Wgu = INP(17) + (size_t)l * NE * 1024 * 2048; cv.Wdn = INP(19) + (size_t)l * NE * 1024 * 1024; cv.Tgu = (bf16*)(wbl + WB_GU); cv.Tdn = (bf16*)(wbl + WB_DN);
        cv.scr = (LAS float*)(F.lds + CONV_LDS_OFF + F.wave * CONV_LDS_WAVE); cv.lane = F.lane; cv.ngw = F.G * NWAVES; cv.gw = F.vcu * NWAVES + F.wave; cv.s = 0;
        cv.nmini = 4 * ((CONV_ITEMS - cv.gw + cv.ngw - 1) / cv.ngw);
#pragma unroll
        for (int i_ = 0; i_ < 8; ++i_) { cv.cvA[i_] = 0.f; cv.cvB[i_] = 0.f; }
        for (int idx = F.vcu; idx < 768; idx += F.G) {
            const int qi = idx >> 8, rem = idx & 255, bk = rem >> 5, qb = rem & 31, b = bk >> 1, kvh = bk & 1, head = kvh * 3 + qi;
            att::UnitP u; const size_t tb = (size_t)b * SEQ, tq = tb + (size_t)qb * 256;
            u.Q = hb + tq * DINP + H_GQ + head * 64; u.ldq = DINP; u.K0 = kB + tb * 128 + kvh * 64; u.ldk0 = 128; u.K1 = nullptr; u.ldk1 = 0;
            u.V = hb + tb * DINP + H_GV + kvh * 64; u.ldv = DINP; u.O = yb + tq * 384 + head * 64; u.ldo = 384; u.nt = SEQ / 64; u.grow0 = qb * 4; u.gain = INP(3) + l * 64; u.kr0 = 0; u.cref = cref;
            if (fixed_ok) att::attn_unit<64, 0, MoeConv>(u, lds, F.tid, cv); else att::attn_unit<64, 3, MoeConv>(u, lds, F.tid, cv);
        }
        while (!cv.done()) { cv.step<0>(); cv.step<1>(); }
    }
    if (WHICH == 1) for (int idx = F.vcu; idx < 512; idx += F.G) {
        const int rnd = idx >> 8, rem = idx & 255, p = (rem >> 5) * 2 + rnd, qb = rem & 31, b = p >> 2, h = p & 3;
        att::UnitP u; const size_t tb = (size_t)b * SEQ, tq = tb + (size_t)qb * 256;
        u.Q = qc + tq * 384 + h * 96; u.ldq = 384; u.K0 = kvc + tb * 512 + h * 128; u.ldk0 = 512; u.K1 = kr + tb * 32; u.ldk1 = 32;
        u.V = kvc + tb * 512 + h * 128 + 64; u.ldv = 512; u.O = yc + tq * 384 + h * 64; u.ldo = 384; u.nt = SEQ / 64; u.grow0 = qb * 4; u.gain = nullptr; u.kr0 = 0; u.cref = 0.f;
        att::attn_unit<96, 1>(u, lds, F.tid, noside);
    }
    if (WHICH == 2) for (int idx = F.vcu; idx < 768; idx += F.G) {
        const int b = idx / 192, rem = idx % 192, h = rem >> 5, rg = rem & 31, R0 = rg * 4;
        int r_lo = R0 - 4; r_lo = r_lo < 0 ? 0 : (r_lo > 120 ? 120 : r_lo);
        int r_hi = R0 - 1; r_hi = (r_hi < 0 ? 0 : (r_hi > 120 ? 120 : r_hi)) + 8;
        if ((r_hi - r_lo) & 1) { if (r_hi < 128) ++r_hi; else --r_lo; }
        {
            LAS float* bt = (LAS float*)(F.lds + att::OFF_BIAS); const float* rp = INP(2) + ((size_t)l * 6 + h) * 465;
            if (F.tid < 465) bt[F.tid] = rp[F.tid] * LOG2E_F; }
        att::UnitP u; const size_t tb = (size_t)b * SEQ, tq = tb + (size_t)R0 * 64, tk = tb + (size_t)r_lo * 64;
        u.Q = hb + tq * DINP + H_NAQ + h * 64; u.ldq = DINP; u.K0 = hb + tk * DINP + H_NAK + h * 64; u.ldk0 = DINP; u.K1 = nullptr; u.ldk1 = 0;
        u.V = hb + tk * DINP + H_NAV + h * 64; u.ldv = DINP; u.O = ya + tq * 384 + h * 64; u.ldo = 384; u.nt = r_hi - r_lo; u.grow0 = R0; u.gain = nullptr; u.kr0 = r_lo; u.cref = 0.f;
        att::attn_unit<64, 2>(u, lds, F.tid, noside);
    }
}


struct Args { const float* in[23]; float* out; unsigned char* ws; int ph_lo, ph_hi, use_bar, pad; };
__global__ void __launch_bounds__(NWAVES * 64, 2) mk_fwd(Args args) {
    extern __shared__ __attribute__((aligned(16))) unsigned char lds[];
    const int wave_id = __builtin_amdgcn_readfirstlane((int)threadIdx.x >> 6), bx0 = blockIdx.x, G0 = gridDim.x;
    {   LAS unsigned* z = (LAS unsigned*)((LAS unsigned char*)lds + LDSCTL_OFF); for (int u = threadIdx.x; u < (LDS_BYTES - LDSCTL_OFF) / 4; u += NWAVES * 64) z[u] = 0u; }
    __syncthreads();
    XcdBarrier bar; bar.bar = (unsigned*)(args.ws + WS_CTL) + CW_BAR; bar.x = 0; bar.st = nullptr;
    if (args.use_bar) bar = xcd_barrier_post((unsigned*)(args.ws + WS_CTL) + CW_BAR, (volatile LAS unsigned*)((LAS unsigned char*)lds + MISC_OFF));
    const int lo = args.ph_lo, hi = args.ph_hi;
#define IN(k) (lo <= (k) && (k) < hi)
#define REPEAT(n) for (int rep_ = 0; rep_ < (n); ++rep_)
#define RSEAM(n) do { if (rep_ + 1 < (n)) { XcdBarrier b_ = bar; { GAS unsigned* bb_ = (GAS unsigned*)b_.bar; asm volatile("; rseam %1" : "+s"(bb_) : "n"(__COUNTER__)); b_.bar = (unsigned*)bb_; } xcd_barrier(b_); } } while (0)
#define SEAM(k) do { if (IN(k) && IN((k) + 1)) { XcdBarrier b_ = bar; { GAS unsigned* bb_ = (GAS unsigned*)b_.bar; asm volatile("; seam %1" : "+s"(bb_) : "n"(__COUNTER__)); b_.bar = (unsigned*)bb_; } xcd_barrier(b_); } } while (0)
#define FRAME() Frame F = mkframe<__COUNTER__>((LAS unsigned char*)lds, args.ws, args.out, wave_id, bx0, G0); unsigned char* ws = F.ws; unsigned char* a2 = ws + WS_A2; unsigned char* wb = ws + WS_W + (size_t)l * WB_LAYER; (void)a2; (void)wb

    if (IN(0)) REPEAT(REP_P) { Frame F = mkframe<__COUNTER__>((LAS unsigned char*)lds, args.ws, args.out, wave_id, bx0, G0); p_prologue(F); RSEAM(REP_P); } SEAM(0);

    for (int l = 0; l < DEPTH; ++l) {
        const int pb = 1 + l * PPL;
        if (IN(pb + 0)) REPEAT(REP_A) { FRAME();
            pg8::Gemm g{(const bf16*)(ws + WS_XB), (const bf16*)(wb + WB_IN), T, DINP, 1024, 0, 0}; pg8::StaticOrder S; S.init(T, DINP, F.G, F.bx);
            pg8::EpiStore E{(bf16*)(ws + WS_H), DINP, DINP};
            pg8::gemm_phase<pg8::EpiStore, pg8::StaticOrder, true, true>(F.lds, g, S, E, F.tid); RSEAM(REP_A);
        } SEAM(pb + 0);
        if (IN(pb + 1)) REPEAT(REP_B) { FRAME(); p_prep(F, l); RSEAM(REP_B); } SEAM(pb + 1);
        if (IN(pb + 2)) REPEAT(REP_C) {
            { FRAME(); pg8::Gemm g{(const bf16*)(a2 + A2_CQN), (const bf16*)(wb + WB_UQ), T, 512, 384, 0, 0}; pg8::StaticOrder S; S.init(T, 512, F.G, F.bx);
              pg8::EpiStore E{(bf16*)(a2 + A2_QC), 384, 384};
              pg8::gemm_phase<pg8::EpiStore, pg8::StaticOrder, true, true>(F.lds, g, S, E, F.tid); }
            { FRAME(); pg8::Gemm g{(const bf16*)(a2 + A2_CKVN), (const bf16*)(wb + WB_UKV), T, 512, 256, 0, 0}; pg8::StaticOrder S; S.init(T, 512, F.G, F.bx);
              pg8::EpiStore E{(bf16*)(a2 + A2_KVC), 512, 512};
              pg8::gemm_phase<pg8::EpiStore, pg8::StaticOrder, true, true>(F.lds, g, S, E, F.tid); }
            RSEAM(REP_C);
        } SEAM(pb + 2);
        if (IN(pb + 3)) { REPEAT(REP_DG) { FRAME(); p_attention<0>(F, l); RSEAM(REP_DG); } REPEAT(REP_DM) { FRAME(); p_attention<1>(F, l); RSEAM(REP_DM); } REPEAT(REP_DN) { FRAME(); p_attention<2>(F, l); RSEAM(REP_DN); } } SEAM(pb + 3);
        if (IN(pb + 4)) REPEAT(REP_E) { FRAME();
            pg8::Gemm g{(const bf16*)(a2 + A2_YA), (const bf16*)(wb + WB_BA), T, 1024, 384, (size_t)1024 * 384 * 2, (size_t)T * 384 * 2};
            pg8::ChainOrder S; S.so.init(T, 1024, F.G, F.bx); S.nch = 3;
            pg8::EpiGateChain E{(const bf16*)(ws + WS_H) + H_GATE, DINP, (bf16*)(a2 + A2_MIXED)};
            pg8::gemm_phase<pg8::EpiGateChain, pg8::ChainOrder, true, true>(F.lds, g, S, E, F.tid);
            RSEAM(REP_E);
        } SEAM(pb + 4);
        if (IN(pb + 5)) REPEAT(REP_F) { FRAME();
            pg8::Gemm g{(const bf16*)(a2 + A2_MIXED), (const bf16*)(wb + WB_OUT), T, 1024, 1024, 0, 0}; pg8::StaticOrder S; S.init(T, 1024, F.G, F.bx);
            pg8::EpiStore E{(bf16*)(ws + WS_X1), 1024, 1024};
            pg8::gemm_phase<pg8::EpiStore, pg8::StaticOrder, true, true>(F.lds, g, S, E, F.tid); RSEAM(REP_F);
        } SEAM(pb + 5);
        if (IN(pb + 6)) { FRAME(); if (l == 0) p_ln1_router<false>(F, l, INP(0)); else p_ln1_router<true>(F, l, ws + WS_XB); } SEAM(pb + 6);
        if (IN(pb + 7)) REPEAT(REP_I) { FRAME();
            const int total = build_tables(F, l);
            pg8::Gemm g{(const bf16*)(ws + WS_X1B), (const bf16*)(wb + WB_GU), total, 2048, 1024, (size_t)2048 * 1024 * 2, 0};
            pg8::MoeGather gs{(const int*)(ws + WS_LT), (const LAS int*)(F.lds + TBL_START), (const LAS int*)(F.lds + TBL_START) + 33, LCAP};
            pg8::MoeOrder S{8, (total >> 8) * 8, F.G, F.vcu, (const LAS int*)(F.lds + TBL_TILEE)};
            pg8::EpiSwiglu E{(bf16*)(ws + WS_A2), INP(18) + (size_t)l * NE * 2048};
            pg8::gemm_phase<pg8::EpiSwiglu, pg8::MoeOrder, true, true, true, pg8::MoeGather>(F.lds, g, S, E, F.tid, gs); RSEAM(REP_I);
        } SEAM(pb + 7);
        if (IN(pb + 8)) REPEAT(REP_J) { FRAME();
            const int total = build_tables(F, l);
            pg8::Gemm g{(const bf16*)(ws + WS_A2), (const bf16*)(wb + WB_DN), total, 1024, 1024, (size_t)1024 * 1024 * 2, 0};
            pg8::MoeOrder S{4, (total >> 8) * 4, F.G, F.vcu, (const LAS int*)(F.lds + TBL_TILEE)};
            pg8::EpiDown E{(bf16*)(ws + WS_H), INP(20) + (size_t)l * NE * 1024, (const float*)(ws + WS_LG), (const LAS int*)(F.lds + TBL_START), (const LAS int*)(F.lds + TBL_START) + 33, LCAP};
            pg8::gemm_phase<pg8::EpiDown, pg8::MoeOrder, true, true>(F.lds, g, S, E, F.tid); RSEAM(REP_J);
        } SEAM(pb + 8);
        if (IN(pb + 9)) REPEAT(REP_K) { FRAME(); RSEAM(REP_K); p_ln2(F, l, F.out, l == DEPTH - 1, l + 1 < DEPTH); }
        if (l + 1 < DEPTH) SEAM(pb + 9);
    }
#undef IN
#undef SEAM
}


#if MK_DEBUG
constexpr int CW_DBG = 20000;
__device__ __forceinline__ float bfr(float f) { return __uint_as_float(f2bf(f) << 16); }
__device__ __forceinline__ float bfv(const bf16* p) { return __uint_as_float(((unsigned)*p) << 16); }
__device__ __forceinline__ unsigned hsh(unsigned x) { x ^= x >> 16; x *= 0x7feb352du; x ^= x >> 15; x *= 0x846ca68bu; x ^= x >> 16; return x; }
__device__ __forceinline__ bool close_(float got, float ref, float rel, float abs_) { return fabsf(got - ref) <= rel * fabsf(ref) + abs_; }
__device__ __forceinline__ void ropecs(int i, int quarter, int s, float& c, float& sn) {
    const float pos = (i < quarter) ? (float)(s >> 6) : (float)(s & 63); const int m = (i < quarter) ? i : i - quarter;
    const float inv = exp2f(-(float)m / (float)quarter * 13.287712379549449f); const float ang = pos * inv * 0.15915494309189535f; c = __builtin_amdgcn_cosf(ang); sn = __builtin_amdgcn_sinf(ang);
}
#define DBG_FAIL(bit) atomicOr((unsigned*)(ws + WS_CTL) + CW_DBG, 1u << (bit))
template <int stage> __global__ void __launch_bounds__(256) dbg_kernel(Args args) {
    unsigned char* ws = args.ws; const int l = 0;
    const int gid = blockIdx.x * 256 + threadIdx.x;
    const bf16* hb = (const bf16*)(ws + WS_H); unsigned char* a2 = ws + WS_A2; unsigned char* wb = ws + WS_W + (size_t)l * WB_LAYER;
    const bf16* kB = (const bf16*)(a2 + A2_KB); const bf16* cqn = (const bf16*)(a2 + A2_CQN); const bf16* ckvn = (const bf16*)(a2 + A2_CKVN); const bf16* kr = (const bf16*)(a2 + A2_KR);
    const bf16* qc = (const bf16*)(a2 + A2_QC); const bf16* kvc = (const bf16*)(a2 + A2_KVC);
    const bf16* ya = (const bf16*)(a2 + A2_YA); const bf16* yb = (const bf16*)(a2 + A2_YB); const bf16* yc = (const bf16*)(a2 + A2_YC);
    const unsigned h1 = hsh(gid * 2654435761u + 12345u + stage * 977u), h2 = hsh(h1 + 0x9e3779b9u);
    const int t = h1 % T, s = t & (SEQ - 1), b = t / SEQ;
    if (stage == 0) {
        const int n = h2 % DIN; const float* x = args.in[0] + (size_t)t * D; const float* W = args.in[1];
        const float sc = (n < 384) ? 0.125f * LOG2E_F : 1.0f; float r = 0.f;
        for (int k = 0; k < 1024; ++k) r += bfr(x[k]) * bfr(W[(size_t)k * DIN + n] * sc);
        if (!close_(bfv(hb + (size_t)t * DINP + n), r, 0.02f, 0.02f)) DBG_FAIL(1);
    }
    if (stage == 1) {
        const bf16* hr = hb + (size_t)t * DINP;
        {   const int d = h2 % 128, head = d >> 6, dd = d & 63; float ssq = 0.f;
            for (int k = 0; k < 64; ++k) { const float v = bfv(hr + H_GK + head * 64 + k); ssq += v * v; }
            const float rstd = 1.0f / sqrtf(ssq / 64.0f + RMS_EPS); const float* g = args.in[4];
            const int i = dd & 31; const float y1 = bfv(hr + H_GK + head * 64 + i) * rstd * g[i], y2 = bfv(hr + H_GK + head * 64 + i + 32) * rstd * g[i + 32];
            float c, sn; ropecs(i, 16, s, c, sn); const float ref = (dd < 32) ? (y1 * c - y2 * sn) : (y1 * sn + y2 * c);
            if (!close_(bfv(kB + (size_t)t * 128 + d), ref, 0.02f, 0.01f)) DBG_FAIL(2); }
        {   const int d = h2 % 384; float ssq = 0.f; for (int k = 0; k < 384; ++k) { const float v = bfv(hr + H_CQ + k); ssq += v * v; }
            const float ref = bfv(hr + H_CQ + d) / sqrtf(ssq / 384.0f + RMS_EPS) * args.in[5][d];
            if (!close_(bfv(cqn + (size_t)t * 384 + d), ref, 0.02f, 0.01f)) DBG_FAIL(3); }
        {   const int d = h2 % 256; float ssq = 0.f; for (int k = 0; k < 256; ++k) { const float v = bfv(hr + H_CKV + k); ssq += v * v; }
            const float ref = bfv(hr + H_CKV + d) / sqrtf(ssq / 256.0f + RMS_EPS) * args.in[6][d];
            if (!close_(bfv(ckvn + (size_t)t * 256 + d), ref, 0.02f, 0.01f)) DBG_FAIL(4); }
        {   const int d = h2 % 32, i = d & 15; const float x1 = bfv(hr + H_KR + i), x2 = bfv(hr + H_KR + i + 16); float c, sn; ropecs(i, 8, s, c, sn);
            const float ref = (d < 16) ? (x1 * c - x2 * sn) : (x1 * sn + x2 * c);
            if (!close_(bfv(kr + (size_t)t * 32 + d), ref, 0.02f, 0.01f)) DBG_FAIL(5); }
    }
    if (stage == 2) {
        {   const int n = h2 % 384; float r = 0.f; const float sc = 0.10206207261596577f * LOG2E_F;
            for (int k = 0; k < 384; ++k) r += bfv(cqn + (size_t)t * 384 + k) * bfr(args.in[7][(size_t)k * 384 + n] * sc);
            if (!close_(bfv(qc + (size_t)t * 384 + n), r, 0.02f, 0.01f)) DBG_FAIL(6); }
        {   const int n = h2 % 512; float r = 0.f;
            for (int k = 0; k < 256; ++k) r += bfv(ckvn + (size_t)t * 256 + k) * bfr(args.in[8][(size_t)k * 512 + n]);
            if (!close_(bfv(kvc + (size_t)t * 512 + n), r, 0.02f, 0.02f)) DBG_FAIL(7); }
    }
    if (stage == 3) {
        const int gr = s >> 6, gc = s & 63;
        if (gid < 1024) {
            const int h = h2 % 6, dofs = ((h2 >> 8) & 1) * 32; float q[64], o[32];
            _Pragma("unroll") for (int d = 0; d < 64; ++d) { q[d] = bfv(hb + (size_t)t * DINP + H_NAQ + h * 64 + d); }
            _Pragma("unroll") for (int d = 0; d < 32; ++d) o[d] = 0.f;
            int r0 = gr - 4; r0 = r0 < 0 ? 0 : (r0 > 120 ? 120 : r0); int c0 = gc - 8; c0 = c0 < 0 ? 0 : (c0 > 48 ? 48 : c0);
            const float* rp = args.in[2] + (size_t)h * 465; float m = -1e30f, lsum = 0.f;
            for (int pass = 0; pass < 2; ++pass)
                for (int i = 0; i < 8; ++i) for (int j = 0; j < 16; ++j) { const int kr_ = r0 + i, kc = c0 + j; const size_t kt = (size_t)b * SEQ + kr_ * 64 + kc;
                    float sc = 0.f; _Pragma("unroll") for (int d = 0; d < 64; ++d) sc += q[d] * bfv(hb + kt * DINP + H_NAK + h * 64 + d);
                    sc += rp[(kr_ - gr + 7) * 31 + (kc - gc + 15)] * LOG2E_F;
                    if (pass == 0) m = fmaxf(m, sc); else { const float p = exp2f(sc - m); lsum += p; _Pragma("unroll") for (int d = 0; d < 32; ++d) o[d] += p * bfv(hb + kt * DINP + H_NAV + h * 64 + dofs + d); } }
            bool bad = false; _Pragma("unroll") for (int d = 0; d < 32; ++d) bad |= !close_(bfv(ya + (size_t)t * 384 + h * 64 + dofs + d), o[d] / lsum, 0.03f, 0.01f);
            if (bad) DBG_FAIL(8);
        } else if (gid < 1024 + 128) {
            const int head = h2 % 6, kvh = head / 3, dofs = ((h2 >> 8) & 1) * 32; float q[64], o[32]; float ssq = 0.f;
            _Pragma("unroll") for (int d = 0; d < 64; ++d) { q[d] = bfv(hb + (size_t)t * DINP + H_GQ + head * 64 + d); ssq += q[d] * q[d]; }
            _Pragma("unroll") for (int d = 0; d < 32; ++d) o[d] = 0.f;
            const float rstd = 1.0f / sqrtf(ssq / 64.0f + RMS_EPS);
            _Pragma("unroll") for (int d = 0; d < 64; ++d) q[d] = q[d] * rstd * args.in[3][d];
            _Pragma("unroll") for (int i = 0; i < 32; ++i) { float c, sn; ropecs(i, 16, s, c, sn); const float y1 = q[i], y2 = q[i + 32]; q[i] = y1 * c - y2 * sn; q[i + 32] = y1 * sn + y2 * c; }
            _Pragma("unroll") for (int d = 0; d < 64; ++d) q[d] = bfr(q[d] * 0.125f * LOG2E_F);
            float m = -1e30f, lsum = 0.f;
            for (int key = 0; key < SEQ; ++key) { const size_t kt = (size_t)b * SEQ + key; float sc = 0.f;
                _Pragma("unroll") for (int d = 0; d < 64; ++d) sc += q[d] * bfv(kB + kt * 128 + kvh * 64 + d);
                const float mn = fmaxf(m, sc), al = exp2f(m - mn), p = exp2f(sc - mn); m = mn; lsum = lsum * al + p;
                _Pragma("unroll") for (int d = 0; d < 32; ++d) o[d] = o[d] * al + p * bfv(hb + kt * DINP + H_GV + kvh * 64 + dofs + d); }
            bool bad = false; _Pragma("unroll") for (int d = 0; d < 32; ++d) bad |= !close_(bfv(yb + (size_t)t * 384 + head * 64 + dofs + d), o[d] / lsum, 0.03f, 0.003f);
            if (bad) DBG_FAIL(9);
        } else if (gid < 1024 + 256) {
            const int h = h2 % 4, dofs = ((h2 >> 8) & 1) * 32; float q[96], o[32];
            _Pragma("unroll") for (int d = 0; d < 96; ++d) q[d] = bfv(qc + (size_t)t * 384 + h * 96 + d);
            _Pragma("unroll") for (int i = 0; i < 16; ++i) { float c, sn; ropecs(i, 8, s, c, sn); const float y1 = q[64 + i], y2 = q[80 + i]; q[64 + i] = bfr(y1 * c - y2 * sn); q[80 + i] = bfr(y1 * sn + y2 * c); }
            _Pragma("unroll") for (int d = 0; d < 32; ++d) o[d] = 0.f;
            float m = -1e30f, lsum = 0.f;
            for (int key = 0; key < SEQ; ++key) { const size_t kt = (size_t)b * SEQ + key; float sc = 0.f;
                _Pragma("unroll") for (int d = 0; d < 64; ++d) sc += q[d] * bfv(kvc + kt * 512 + h * 128 + d);
                _Pragma("unroll") for (int d = 0; d < 32; ++d) sc += q[64 + d] * bfv(kr + kt * 32 + d);
                const float mn = fmaxf(m, sc), al = exp2f(m - mn), p = exp2f(sc - mn); m = mn; lsum = lsum * al + p;
                _Pragma("unroll") for (int d = 0; d < 32; ++d) o[d] = o[d] * al + p * bfv(kvc + kt * 512 + h * 128 + 64 + dofs + d); }
            bool bad = false; _Pragma("unroll") for (int d = 0; d < 32; ++d) bad |= !close_(bfv(yc + (size_t)t * 384 + h * 64 + dofs + d), o[d] / lsum, 0.03f, 0.003f);
            if (bad) DBG_FAIL(10);
        }
    }
    if (stage == 4) {
        const int n = h2 % 1024; float r = 0.f;
        { float a = 0.f; for (int k = 0; k < 384; ++k) a += bfv(ya + (size_t)t * 384 + k) * bfr(args.in[9][(size_t)k * 1024 + n]); r += a / (1.0f + expf(-bfv(hb + (size_t)t * DINP + H_GATE + n))); }
        { float a = 0.f; for (int k = 0; k < 384; ++k) a += bfv(yb + (size_t)t * 384 + k) * bfr(args.in[10][(size_t)k * 1024 + n]); r += a / (1.0f + expf(-bfv(hb + (size_t)t * DINP + H_GATE + 1024 + n))); }
        { float a = 0.f; for (int k = 0; k < 256; ++k) a += bfv(yc + (size_t)t * 384 + k) * bfr(args.in[11][(size_t)k * 1024 + n]); r += a / (1.0f + expf(-bfv(hb + (size_t)t * DINP + H_GATE + 2048 + n))); }
        if (!close_(bfv((const bf16*)(a2 + A2_MIXED) + (size_t)t * 1024 + n), r, 0.02f, 0.003f)) DBG_FAIL(11);
    }
    if (stage == 5) {
        const int n = h2 % 1024; float r = 0.f; const bf16* mx = (const bf16*)(a2 + A2_MIXED) + (size_t)t * 1024;
        for (int k = 0; k < 1024; ++k) r += bfv(mx + k) * bfr(args.in[12][(size_t)k * 1024 + n]);
        if (!close_(bfv((const bf16*)(ws + WS_X1) + (size_t)t * D + n), r, 0.02f, 0.002f)) DBG_FAIL(12);
    }
    if (stage == 6) {
        const bf16* x1 = (const bf16*)(ws + WS_X1B) + (size_t)t * D; const int* tok_e = (const int*)(ws + WS_TE); const int* tok_r = (const int*)(ws + WS_TR);
        const int* list_t = (const int*)(ws + WS_LT); const float* list_g = (const float*)(ws + WS_LG);
        float lg[32]; _Pragma("unroll") for (int e = 0; e < 32; ++e) lg[e] = args.in[16][e];
        for (int k = 0; k < 1024; ++k) { const float xv = bfv(x1 + k); _Pragma("unroll") for (int e = 0; e < 32; ++e) lg[e] += xv * args.in[15][(size_t)k * 32 + e]; }
        int se[4]; float sv[4]; unsigned used = 0;
        _Pragma("unroll") for (int r = 0; r < 4; ++r) { int be = -1; float bv = -INFINITY; _Pragma("unroll") for (int e = 0; e < 32; ++e) if (!((used >> e) & 1) && lg[e] > bv) { bv = lg[e]; be = e; } se[r] = be; sv[r] = bv; used |= 1u << be; }
        float fifth = -INFINITY; _Pragma("unroll") for (int e = 0; e < 32; ++e) if (!((used >> e) & 1)) fifth = fmaxf(fifth, lg[e]);
        const bool neartie = (sv[3] - fifth) < 3e-2f || (sv[0] - sv[1]) < 3e-2f || (sv[1] - sv[2]) < 3e-2f || (sv[2] - sv[3]) < 3e-2f;
        float den = 0.f; _Pragma("unroll") for (int r = 0; r < 4; ++r) den += expf(sv[r] - sv[0]);
        bool bad = false, badg = false;
        if (!neartie) _Pragma("unroll") for (int r = 0; r < 4; ++r) { const int e = tok_e[t * 4 + r], rk = tok_r[t * 4 + r]; if (e != se[r]) { bad = true; continue; }
            if (rk < 0 || rk >= LCAP || list_t[(size_t)e * LCAP + rk] != t) badg = true; else if (!close_(list_g[(size_t)e * LCAP + rk], expf(sv[r] - sv[0]) / den, 0.03f, 1e-3f)) badg = true; }
        if (bad) DBG_FAIL(13); if (badg) DBG_FAIL(14);
        { float sm = 0.f, sq = 0.f; for (int k = 0; k < 1024; ++k) { const float z = (bfv(x1 + k) - args.in[14][k]) / args.in[13][k]; sm += z; sq += z * z; }
          if (fabsf(sm / 1024.f) > 4e-3f || fabsf(sq / 1024.f - 1.0f) > 2e-2f) DBG_FAIL(19); }
    }
    if (stage >= 7 && stage <= 9) {
        __shared__ int st[33], cn[32];
        if (threadIdx.x == 0) { int a = 0; for (int e2 = 0; e2 < 32; ++e2) { cn[e2] = (int)((const unsigned*)(ws + WS_CTL))[CW_CNT + 64 * l + e2]; st[e2] = a; a += ((cn[e2] + 255) >> 8) << 8; } st[32] = a; }
        __syncthreads();
        const int total = st[32]; const int sl = h1 % total; int e = 0; for (int k = 1; k < 32; ++k) if (sl >= st[k]) e = k; const int r = sl - st[e];
        const int* list_t = (const int*)(ws + WS_LT); const float* list_g = (const float*)(ws + WS_LG); const float* sg = (const float*)(ws + WS_SG);
        if (stage == 7) { int sum = 0; for (int k = 0; k < 32; ++k) sum += cn[k]; if (sum != TK) DBG_FAIL(15); }
        if (stage == 7 && r < cn[e]) {
            const bf16* xg = (const bf16*)(ws + WS_X1B) + (size_t)list_t[(size_t)e * LCAP + r] * D; const int f = h2 % 1024; const float* W = args.in[17] + (size_t)e * 1024 * 2048;
            float g = args.in[18][e * 2048 + f], u = args.in[18][e * 2048 + 1024 + f];
            for (int k = 0; k < 1024; ++k) { const float xv = bfv(xg + k); g += xv * bfr(W[(size_t)k * 2048 + f]); u += xv * bfr(W[(size_t)k * 2048 + 1024 + f]); }
            g = fminf(g, 7.0f); u = fminf(fmaxf(u, -7.0f), 7.0f); const float ref = g / (1.0f + expf(-1.702f * g)) * (u + 1.0f);
            if (!close_(bfv((const bf16*)(ws + WS_A2) + (size_t)sl * 1024 + f), ref, 0.03f, 0.02f)) DBG_FAIL(16);
        }
        if (stage == 8 && r < cn[e]) {
            const bf16* ab = (const bf16*)(ws + WS_A2) + (size_t)sl * 1024; const int n = h2 % 1024; const float* W = args.in[19] + (size_t)e * 1024 * 1024;
            float y = args.in[20][e * 1024 + n]; for (int k = 0; k < 1024; ++k) y += bfv(ab + k) * bfr(W[(size_t)k * 1024 + n]);
            y *= list_g[(size_t)e * LCAP + r];
            if (!close_(bfv((const bf16*)(ws + WS_H) + (size_t)sl * 1024 + n), y, 0.03f, 0.005f)) DBG_FAIL(17);
        }
        if (stage == 9) {
            const bf16* x1 = (const bf16*)(ws + WS_X1B) + (size_t)t * D; const int* tok_e = (const int*)(ws + WS_TE); const int* tok_r = (const int*)(ws + WS_TR);
            const bf16* ybf = (const bf16*)(ws + WS_H); float sm = 0.f, sq = 0.f; const int n = h2 % 1024; float vn = 0.f;
            for (int k = 0; k < 1024; ++k) { float v = DN_ALPHA * bfv(x1 + k); for (int q = 0; q < 4; ++q) v += bfv(ybf + (size_t)(st[tok_e[t * 4 + q]] + tok_r[t * 4 + q]) * D + k); sm += v; sq += v * v; if (k == n) vn = v; }
            const float mean = sm / 1024.f, var = sq / 1024.f - mean * mean; const float ref = (vn - mean) / sqrtf(var + LN_EPS) * args.in[21][n] + args.in[22][n];
            if (!close_(bfv((const bf16*)(ws + WS_XB) + (size_t)t * D + n), ref, 0.01f, 0.01f)) DBG_FAIL(18);
        }
    }
}
static void dbg_launch(int stage, const Args& a, hipStream_t stream) {
    switch (stage) {
#define DBGL(k) case k: hipLaunchKernelGGL(dbg_kernel<k>, dim3(8), dim3(256), 0, stream, a); break;
        DBGL(0) DBGL(1) DBGL(2) DBGL(3) DBGL(4) DBGL(5) DBGL(6) DBGL(7) DBGL(8) DBGL(9)
#undef DBGL
    }
}
#endif

extern "C" void kernel_launch(void* const* d_in, const int* in_sizes, int n_in, void* d_out, int out_size, void* d_ws, size_t ws_size, hipStream_t stream) {
    static int grid = 0;
    if (grid == 0) {
        if (n_in != 23 || in_sizes[0] != T * D || out_size != T * D || ws_size < WS_END) { fprintf(stderr, "kernel_launch: unexpected shapes / workspace (%d inputs, ws %zu, need %zu)\n", n_in, ws_size, (size_t)WS_END); grid = -1; return; }
        int dev = 0, cus = 0, per_cu = 0;
        if (hipGetDevice(&dev) != hipSuccess || hipDeviceGetAttribute(&cus, hipDeviceAttributeMultiprocessorCount, dev) != hipSuccess) { grid = -1; return; }
        if (hipFuncSetAttribute((const void*)mk_fwd, hipFuncAttributeMaxDynamicSharedMemorySize, LDS_BYTES) != hipSuccess) { fprintf(stderr, "kernel_launch: hipFuncSetAttribute failed\n"); grid = -1; return; }
        if (hipOccupancyMaxActiveBlocksPerMultiprocessor(&per_cu, (const void*)mk_fwd, NWAVES * 64, LDS_BYTES) != hipSuccess || per_cu < 1) { fprintf(stderr, "kernel_launch: occupancy query reports %d\n", per_cu); }
        (void)hipGetLastError();
        grid = cus;
    }
    if (grid < 0) return;
    if (hipMemsetAsync((char*)d_ws + WS_CTL, 0, CTL_ZERO_BYTES, stream) != hipSuccess) return;
    Args a{};
    for (int i = 0; i < 23; ++i) a.in[i] = (const float*)d_in[i];
    a.out = (float*)d_out; a.ws = (unsigned char*)d_ws; a.pad = 0;
#if MK_ONE_LAUNCH
    a.ph_lo = 0; a.ph_hi = NPH; a.use_bar = 1;
    hipLaunchKernelGGL(mk_fwd, dim3(grid), dim3(NWAVES * 64), LDS_BYTES, stream, a);
#else
    for (int p = 0; p < NPH; ++p) { a.ph_lo = p; a.ph_hi = p + 1; a.use_bar = 0; hipLaunchKernelGGL(mk_fwd, dim3(grid), dim3(NWAVES * 64), LDS_BYTES, stream, a);
#if MK_DEBUG
        if (p >= 1 && p <= PPL) dbg_launch(p - 1, a, stream);
#endif
    }
#endif
    const hipError_t le = hipPeekAtLastError();
    if (le != hipSuccess) fprintf(stderr, "kernel_launch: launch failed: %s\n", hipGetErrorName(le));
}
```

```cpp
#define MK_DEBUG 0
#define MK_ONE_LAUNCH 1
#include <hip/hip_runtime.h>
#include <hip/hip_bf16.h>
#include <cstdio>
#include <cstdint>
namespace pg8 {
#define PG8_LAS __attribute__((address_space(3)))
typedef unsigned short bf16_t;
typedef short bf16x8 __attribute__((ext_vector_type(8)));
typedef float f32x4 __attribute__((ext_vector_type(4)));
typedef unsigned u32x4 __attribute__((ext_vector_type(4)));
constexpr int BM = 256, BK = 64, HALF = 128, HTB = HALF * BK * 2  , STAGE_BYTES = 8 * HTB, NXCD = 8, WGM = 8;

__host__ __device__ __forceinline__ int lds_byte(int r, int c) { const int st = (r >> 4) * 2 + (c >> 5), rr = r & 15, cc = c & 31, ob = rr * 64 + cc * 2; return st * 1024 + (ob ^ (((ob >> 9) & 1) << 5)); }
__host__ __device__ __forceinline__ void stage_rc(int b, int& R, int& C) { const int st = b / 1024, sb = b % 1024, swz = sb ^ (((sb >> 9) & 1) << 5); R = (st >> 1) * 16 + swz / 64; C = (st & 1) * 32 + (swz % 64) / 2; }
__host__ __device__ __forceinline__ int perm32(int rho) { const int n = rho >> 4, i = rho & 15; return 8 * (i >> 2) + 4 * n + (i & 3); }

struct Unit { int pm, pn, e; };
struct Gemm { const bf16_t* A; const bf16_t* Bt; int M, N, K; size_t bstride; size_t astride; const void* base; };

struct StaticOrder {
    int nM, nN, nwg, G, c;
    __host__ __device__ void init(int M, int N, int G_, int c_) { nM = M / BM; nN = N / BM; nwg = nM * nN; G = G_; c = c_; }
    __host__ __device__ bool next(int i, Unit& u) const {
        const long L = (long)i * G + c; if (L >= nwg) return false;
        int wgid = (int)L; { const int q = nwg / NXCD, r = nwg % NXCD, xcd = wgid % NXCD, off = wgid / NXCD; wgid = (xcd < r ? xcd * (q + 1) : r * (q + 1) + (xcd - r) * q) + off; }
        const int nig = WGM * nN, gid = wgid / nig, fm = gid * WGM, gsz = (nM - fm) < WGM ? (nM - fm) : WGM;
        u.pm = fm + ((wgid % nig) % gsz); u.pn = (wgid % nig) / gsz; u.e = 0; return true;
    }
    __device__ __forceinline__ void a_ready(const Unit&) const {}
    __device__ __forceinline__ void done(const Unit&) const {}
};

__device__ __forceinline__ unsigned cvt_pk_bf16(float lo, float hi) { unsigned r; asm volatile("v_cvt_pk_bf16_f32 %0, %1, %2" : "=v"(r) : "v"(lo), "v"(hi)); return r; }
typedef float f32x2 __attribute__((ext_vector_type(2)));


__device__ __forceinline__ float bf_lo(unsigned w) { return __uint_as_float(w << 16); }
__device__ __forceinline__ float bf_hi(unsigned w) { return __uint_as_float(w & 0xffff0000u); }
__device__ __forceinline__ float sigmoidf_(float z) { return __builtin_amdgcn_rcpf(1.0f + __builtin_amdgcn_exp2f(-1.4426950408889634f * z)); }
__device__ __forceinline__ u32x4 pack8(const f32x4& v0, const f32x4& v1) { u32x4 w; w.x = cvt_pk_bf16(v0[0], v0[1]); w.y = cvt_pk_bf16(v0[2], v0[3]); w.z = cvt_pk_bf16(v1[0], v1[1]); w.w = cvt_pk_bf16(v1[2], v1[3]); return w; }

__device__ __forceinline__ unsigned pk4_fp8(float a, float b, float c, float d) { int r = __builtin_amdgcn_cvt_pk_fp8_f32(a, b, 0, false); r = __builtin_amdgcn_cvt_pk_fp8_f32(c, d, r, true); return (unsigned)r; }
struct EpiStore {
    static constexpr bool PERM = true, AFTER_DRAIN = false, CHAIN = false;
    bf16_t* O; int ldc; int nvalid; float ascale;
    __device__ __forceinline__ void operator()(const f32x4 (&acc)[2][2][4][2], const Unit& u, int wr, int wc, int fr, int fq) const {
        const int row0 = u.pm * BM + wr * 64 + fr, col0 = u.pn * BM + wc * 32 + 8 * fq;
#pragma unroll
        for (int ai = 0; ai < 2; ++ai)
#pragma unroll
            for (int m = 0; m < 4; ++m) { bf16_t* rowp = O + (size_t)(row0 + ai * HALF + m * 16) * ldc + col0;
#pragma unroll
                for (int bj = 0; bj < 2; ++bj) { if (col0 + bj * HALF < nvalid) *(u32x4*)(rowp + bj * HALF) = pack8(acc[ai][bj][m][0] * ascale, acc[ai][bj][m][1] * ascale); } }
    }
};
struct EpiGateChain {
    static constexpr bool PERM = true, AFTER_DRAIN = false, CHAIN = true;
    const bf16_t* gate; int ldg; bf16_t* mixed;
    __device__ __forceinline__ void chain(f32x4 (&acc)[2][2][4][2], const Unit& u, int wr, int wc, int fr, int fq) const {
        const int row0 = u.pm * BM + wr * 64 + fr, col0 = u.pn * BM + wc * 32 + 8 * fq;
#pragma unroll
        for (int ai = 0; ai < 2; ++ai)
#pragma unroll
            for (int m = 0; m < 4; ++m) { const size_t row = (size_t)(row0 + ai * HALF + m * 16);
#pragma unroll
                for (int bj = 0; bj < 2; ++bj) { const int col = col0 + bj * HALF;
                    const u32x4 ga = *(const u32x4*)(gate + row * ldg + u.e * 1024 + col);
                    f32x4 na0 = {1.f + __builtin_amdgcn_exp2f(-1.4426950408889634f * bf_lo(ga.x)), 1.f + __builtin_amdgcn_exp2f(-1.4426950408889634f * bf_hi(ga.x)), 1.f + __builtin_amdgcn_exp2f(-1.4426950408889634f * bf_lo(ga.y)), 1.f + __builtin_amdgcn_exp2f(-1.4426950408889634f * bf_hi(ga.y))};
                    f32x4 na1 = {1.f + __builtin_amdgcn_exp2f(-1.4426950408889634f * bf_lo(ga.z)), 1.f + __builtin_amdgcn_exp2f(-1.4426950408889634f * bf_hi(ga.z)), 1.f + __builtin_amdgcn_exp2f(-1.4426950408889634f * bf_lo(ga.w)), 1.f + __builtin_amdgcn_exp2f(-1.4426950408889634f * bf_hi(ga.w))};
                    f32x4 f0, f1;
#pragma unroll
                    for (int q = 0; q < 4; ++q) { f0[q] = __builtin_amdgcn_rcpf(na0[q]); f1[q] = __builtin_amdgcn_rcpf(na1[q]); }
                    if (u.e < 2) { const u32x4 gb = *(const u32x4*)(gate + row * ldg + (u.e + 1) * 1024 + col);
                        f0[0] *= 1.f + __builtin_amdgcn_exp2f(-1.4426950408889634f * bf_lo(gb.x)); f0[1] *= 1.f + __builtin_amdgcn_exp2f(-1.4426950408889634f * bf_hi(gb.x));
                        f0[2] *= 1.f + __builtin_amdgcn_exp2f(-1.4426950408889634f * bf_lo(gb.y)); f0[3] *= 1.f + __builtin_amdgcn_exp2f(-1.4426950408889634f * bf_hi(gb.y));
                        f1[0] *= 1.f + __builtin_amdgcn_exp2f(-1.4426950408889634f * bf_lo(gb.z)); f1[1] *= 1.f + __builtin_amdgcn_exp2f(-1.4426950408889634f * bf_hi(gb.z));
                        f1[2] *= 1.f + __builtin_amdgcn_exp2f(-1.4426950408889634f * bf_lo(gb.w)); f1[3] *= 1.f + __builtin_amdgcn_exp2f(-1.4426950408889634f * bf_hi(gb.w)); }
                    acc[ai][bj][m][0] *= f0; acc[ai][bj][m][1] *= f1;
                    if (u.e == 2) *(u32x4*)(mixed + row * 1024 + col) = pack8(acc[ai][bj][m][0], acc[ai][bj][m][1]); } }
    }
};
struct ChainOrder {
    StaticOrder so; int nch;
    __device__ __forceinline__ bool next(int i, Unit& u) const { const int t = i / nch; if (!so.next(t, u)) return false; u.e = i - t * nch; return true; }
    __device__ __forceinline__ void a_ready(const Unit&) const {}
    __device__ __forceinline__ void done(const Unit&) const {}
};
struct EpiResid {
    static constexpr bool PERM = true, AFTER_DRAIN = false, CHAIN = false;
    const float* x; float* pre; float alpha;
    __device__ __forceinline__ void operator()(const f32x4 (&acc)[2][2][4][2], const Unit& u, int wr, int wc, int fr, int fq) const {
        const int row0 = u.pm * BM + wr * 64 + fr, col0 = u.pn * BM + wc * 32 + 8 * fq;
#pragma unroll
        for (int ai = 0; ai < 2; ++ai)
#pragma unroll
            for (int m = 0; m < 4; ++m) { const size_t row = (size_t)(row0 + ai * HALF + m * 16);
#pragma unroll
                for (int bj = 0; bj < 2; ++bj) { const size_t off = row * 1024 + col0 + bj * HALF;
                    const f32x4 x0 = *(const f32x4*)(x + off), x1 = *(const f32x4*)(x + off + 4);
                    *(f32x4*)(pre + off) = x0 * alpha + acc[ai][bj][m][0]; *(f32x4*)(pre + off + 4) = x1 * alpha + acc[ai][bj][m][1]; } }
    }
};
template <bool OUT8> struct EpiSwigluT {
    static constexpr bool PERM = true, AFTER_DRAIN = false, CHAIN = false;
    void* a; const float* bias; float ascale, oscale;
    __device__ __forceinline__ void operator()(const f32x4 (&acc)[2][2][4][2], const Unit& u, int wr, int wc, int fr, int fq) const {
        const int row0 = u.pm * BM + wr * 64 + fr, j0 = wc * 32 + 8 * fq, oc = u.pn * HALF + j0;
        const float* bg = bias + (size_t)u.e * 2048 + oc; const float* bu = bg + 1024;
        const f32x4 bg0 = *(const f32x4*)bg, bg1 = *(const f32x4*)(bg + 4), bu0 = *(const f32x4*)bu, bu1 = *(const f32x4*)(bu + 4);
#pragma unroll
        for (int ai = 0; ai < 2; ++ai)
#pragma unroll
            for (int m = 0; m < 4; ++m) { const size_t row = (size_t)(row0 + ai * HALF + m * 16);
                f32x4 g[2] = {acc[ai][0][m][0] * ascale + bg0, acc[ai][0][m][1] * ascale + bg1}, uu[2] = {acc[ai][1][m][0] * ascale + bu0, acc[ai][1][m][1] * ascale + bu1}, r[2];
#pragma unroll
                for (int n = 0; n < 2; ++n)
#pragma unroll
                    for (int q = 0; q < 4; ++q) { const float gg = fminf(g[n][q], 7.0f), uc = fminf(fmaxf(uu[n][q], -7.0f), 7.0f);
                        r[n][q] = gg * sigmoidf_(1.702f * gg) * (uc + 1.0f); }
                if constexpr (OUT8) { typedef unsigned u32x2 __attribute__((ext_vector_type(2)));
                    *(u32x2*)((unsigned char*)a + row * 1024 + oc) = (u32x2){pk4_fp8(r[0][0] * oscale, r[0][1] * oscale, r[0][2] * oscale, r[0][3] * oscale), pk4_fp8(r[1][0] * oscale, r[1][1] * oscale, r[1][2] * oscale, r[1][3] * oscale)}; }
                else *(u32x4*)((bf16_t*)a + row * 1024 + oc) = pack8(r[0], r[1]);
                asm volatile("" ::: "memory"); }
    }
};
struct EpiDown {
    static constexpr bool PERM = true, AFTER_DRAIN = false, CHAIN = false;
    bf16_t* y; const float* bias; const float* list_g; const PG8_LAS int* st; const PG8_LAS int* cn; int lcap; float ascale;
    __device__ __forceinline__ void operator()(const f32x4 (&acc)[2][2][4][2], const Unit& u, int wr, int wc, int fr, int fq) const {
        const int row0 = u.pm * BM + wr * 64 + fr, col0 = u.pn * BM + wc * 32 + 8 * fq;
        const int st_e = st[u.e], cn_e = cn[u.e];
        f32x4 bv[2][2];
#pragma unroll
        for (int bj = 0; bj < 2; ++bj)
#pragma unroll
            for (int n = 0; n < 2; ++n) bv[bj][n] = *(const f32x4*)(bias + (size_t)u.e * 1024 + col0 + bj * HALF + 4 * n);
#pragma unroll
        for (int ai = 0; ai < 2; ++ai)
#pragma unroll
            for (int m = 0; m < 4; ++m) { const size_t row = (size_t)(row0 + ai * HALF + m * 16); const int rank = (int)row - st_e;
                const float gt = rank < cn_e ? list_g[(size_t)u.e * lcap + rank] : 0.f;
#pragma unroll
                for (int bj = 0; bj < 2; ++bj) { const f32x4 v0 = (acc[ai][bj][m][0] * ascale + bv[bj][0]) * gt, v1 = (acc[ai][bj][m][1] * ascale + bv[bj][1]) * gt;
                    *(u32x4*)(y + row * 1024 + col0 + bj * HALF) = pack8(v0, v1); } }
    }
};
struct MoeGather {
    const int* list_t; const PG8_LAS int* st; const PG8_LAS int* cn; int lcap;
    __device__ __forceinline__ int row(const Unit& u, int r) const { int rank = u.pm * BM + r - st[u.e]; const int c = cn[u.e]; rank = rank < c ? rank : c - 1; return list_t[(size_t)u.e * lcap + rank]; }
};
struct MoeOrder {
    int nN, nunits, G, c; const PG8_LAS int* tile_e;
    __device__ __forceinline__ bool next(int i, Unit& u) const {
        const long L = (long)i * G + c; if (L >= nunits) return false;
        const int tile = (int)L / nN; u.pm = tile; u.pn = (int)L % nN; u.e = __builtin_amdgcn_readfirstlane(tile_e[tile]); return true;
    }
    __device__ __forceinline__ void a_ready(const Unit&) const {}
    __device__ __forceinline__ void done(const Unit&) const {}
};

template <int ES> struct PtSel { typedef const char* T; static __device__ __forceinline__ T mk(const char* p, const char*) { return p; } };
template <> struct PtSel<1> { typedef unsigned T; static __device__ __forceinline__ T mk(const char* p, const char* base) { return (unsigned)(size_t)(p - base); } };
struct NoGather { };
typedef int i32x8 __attribute__((ext_vector_type(8)));
template <class Epi, class Sched, bool ALIGN_EPI = false, bool SP2 = false, bool GATHER = false, class GS = NoGather, int ESIZE = 2>
__device__ __forceinline__ void gemm_phase(PG8_LAS unsigned char* lds, const Gemm g, const Sched& S, const Epi& E, const int tid, const GS gs = GS()) {
    const int wid = __builtin_amdgcn_readfirstlane(tid >> 6), lane = tid & 63, wr = wid >> 2, wc = wid & 3, fr = lane & 15, fq = lane >> 4;
    const int K = g.K * ESIZE / 2; int nt = K / BK;
    if constexpr (ESIZE == 1) asm volatile("" : "+s"(nt));
    int sc8 = 0x7F7F7F7F; if constexpr (ESIZE == 1) asm volatile("" : "+v"(sc8));
    typedef typename PtSel<ESIZE>::T PT;
    __amdgpu_buffer_rsrc_t rsrc = __builtin_amdgcn_make_buffer_rsrc((void*)g.base, 0, 0x7fffffff, 0x00020000);
#define PG8_PT(p) PtSel<ESIZE>::mk((const char*)(p), (const char*)g.base)
    unsigned voffA[2], voffB[2];
#pragma unroll
    for (int i = 0; i < 2; ++i) { int R, C; stage_rc(tid * 16 + i * 8192, R, C); const int Rb = Epi::PERM ? ((R & ~31) + perm32(R & 31)) : R;
        voffA[i] = (unsigned)(R * K + C) * 2u; voffB[i] = (unsigned)(Rb * K + C) * 2u; }
    unsigned vc0[2], vc1[2], vn0[2], vn1[2];
#define PG8_GROWS(u_, o0, o1) do { _Pragma("unroll") for (int i_ = 0; i_ < 2; ++i_) { int R_, C_; stage_rc(tid * 16 + i_ * 8192, R_, C_); \
        o0[i_] = (unsigned)gs.row((u_), R_) * (unsigned)(K * 2) + (unsigned)(C_ * 2); o1[i_] = (unsigned)gs.row((u_), HALF + R_) * (unsigned)(K * 2) + (unsigned)(C_ * 2); } } while (0)
    const size_t kstep = (size_t)(BK * 2);
    const size_t hstep = (size_t)HALF * K * 2;
    const size_t tstep = 2 * hstep;
    const unsigned ldsw = (unsigned)wid * 1024u;
    const int aoff = lds_byte(wr * 64 + fr, fq * 8), boff = lds_byte(wc * 32 + fr, fq * 8);
#define PG8_SA(b, h) (((b) * 2 + (h)) * HTB)
#define PG8_SB(b, h) ((4 + (b) * 2 + (h)) * HTB)
#define PG8_STAGE(bufoff, gbase, voff) do { _Pragma("unroll") for (int _i = 0; _i < 2; ++_i) { \
        if constexpr (ESIZE == 2) __builtin_amdgcn_global_load_lds((const unsigned*)((const char*)(size_t)(gbase) + (voff)[_i]), (PG8_LAS unsigned*)(lds + (bufoff) + ldsw + _i * 8192), 16, 0, 0); \
        else __builtin_amdgcn_raw_ptr_buffer_load_lds(rsrc, (PG8_LAS void*)(lds + (bufoff) + ldsw + _i * 8192), 16, (int)(voff)[_i], (int)(size_t)(gbase), 0, 0); } } while (0)
typedef int i32x4_ __attribute__((ext_vector_type(4)));
#define PG8_LD8(off) __builtin_shufflevector(*(const PG8_LAS i32x4_*)(lds + (off)), *(const PG8_LAS i32x4_*)(lds + (off) + 1024), 0, 1, 2, 3, 4, 5, 6, 7)
#define PG8_LDA(dst, b, h) do { if constexpr (ESIZE == 2) { _Pragma("unroll") for (int m = 0; m < 4; ++m) _Pragma("unroll") for (int k = 0; k < 2; ++k) dst[m][k] = *(const PG8_LAS bf16x8*)(lds + PG8_SA(b, h) + aoff + m * 2048 + k * 1024); } \
        else { _Pragma("unroll") for (int m = 0; m < 4; ++m) dst##8[m] = PG8_LD8(PG8_SA(b, h) + aoff + m * 2048); } } while (0)
#define PG8_LDB(dst, b, h) do { if constexpr (ESIZE == 2) { _Pragma("unroll") for (int n = 0; n < 2; ++n) _Pragma("unroll") for (int k = 0; k < 2; ++k) dst[n][k] = *(const PG8_LAS bf16x8*)(lds + PG8_SB(b, h) + boff + n * 2048 + k * 1024); } \
        else { _Pragma("unroll") for (int n = 0; n < 2; ++n) dst##8[n] = PG8_LD8(PG8_SB(b, h) + boff + n * 2048); } } while (0)
#define PG8_F8CAT(x, y) (i32x8){((const int*)&(x))[0], ((const int*)&(x))[1], ((const int*)&(x))[2], ((const int*)&(x))[3], ((const int*)&(y))[0], ((const int*)&(y))[1], ((const int*)&(y))[2], ((const int*)&(y))[3]}
#define PG8_MMA(ai, bj, At, Bt) do { __builtin_amdgcn_s_setprio(1); if constexpr (ESIZE == 2) { _Pragma("unroll") for (int m = 0; m < 4; ++m) _Pragma("unroll") for (int n = 0; n < 2; ++n) _Pragma("unroll") for (int k = 0; k < 2; ++k) \
        acc[ai][bj][m][n] = __builtin_amdgcn_mfma_f32_16x16x32_bf16(Bt[n][k], At[m][k], acc[ai][bj][m][n], 0, 0, 0); } \
        else { _Pragma("unroll") for (int m = 0; m < 4; ++m) _Pragma("unroll") for (int n = 0; n < 2; ++n) \
        asm volatile("v_mfma_scale_f32_16x16x128_f8f6f4 %0, %1, %2, %0, %3, %3 op_sel_hi:[0,0,0]" : "+v"(acc[ai][bj][m][n]) : "v"(Bt##8[n]), "v"(At##8[m]), "v"(sc8)); \
        }   \
        __builtin_amdgcn_s_setprio(0); } while (0)
#define PG8_WAIT_V(n) asm volatile("s_waitcnt vmcnt(" #n ")" ::: "memory")
#define PG8_WAIT_L(n) asm volatile("s_waitcnt lgkmcnt(" #n ")" ::: "memory")
#define PG8_BAR __builtin_amdgcn_s_barrier()
#define PG8_SCHED __builtin_amdgcn_sched_barrier(0)
    Unit cur, nxt; int ui = 0;
    if (!S.next(0, cur)) return;
    f32x4 acc[2][2][4][2];
#pragma unroll
    for (int a = 0; a < 2; ++a)
#pragma unroll
        for (int b = 0; b < 2; ++b)
#pragma unroll
            for (int m = 0; m < 4; ++m)
#pragma unroll
                for (int n = 0; n < 2; ++n) acc[a][b][m][n] = (f32x4){0.f, 0.f, 0.f, 0.f};
    bf16x8 At[4][2], B0[2][2], B1[2][2];
    i32x8 At8[4], B08[2], B18[2];
    PT cA = PG8_PT(GATHER ? (const char*)g.A : (const char*)g.A + (size_t)cur.pm * tstep + (size_t)cur.e * g.astride);
    if constexpr (GATHER) { PG8_GROWS(cur, vc0, vc1); } else { _Pragma("unroll") for (int i = 0; i < 2; ++i) { vc0[i] = voffA[i]; vc1[i] = voffA[i] + (unsigned)hstep; } }
#pragma unroll
    for (int i = 0; i < 2; ++i) { vn0[i] = vc0[i]; vn1[i] = vc1[i]; }
    PT cB = PG8_PT((const char*)g.Bt + (size_t)cur.pn * tstep + (size_t)cur.e * g.bstride);
    S.a_ready(cur);
    if constexpr (SP2) {
        PG8_STAGE(PG8_SB(0, 0), cB, voffB); PG8_STAGE(PG8_SB(0, 1), cB + hstep, voffB); PG8_STAGE(PG8_SA(0, 0), cA, vc0); PG8_STAGE(PG8_SA(0, 1), cA, vc1);
        if (wr == 1) PG8_BAR;
        PG8_WAIT_V(2); PG8_BAR;
        PG8_STAGE(PG8_SB(1, 0), cB + kstep, voffB); PG8_STAGE(PG8_SA(1, 0), cA + kstep, vc0); PG8_STAGE(PG8_SB(1, 1), cB + hstep + kstep, voffB);
        PG8_WAIT_V(6); PG8_BAR;
    } else {
        PG8_STAGE(PG8_SB(0, 0), cB, voffB); PG8_STAGE(PG8_SA(0, 0), cA, vc0); PG8_STAGE(PG8_SB(0, 1), cB + hstep, voffB); PG8_STAGE(PG8_SA(0, 1), cA, vc1);
        if (wr == 1) PG8_BAR;
        PG8_WAIT_V(4); PG8_BAR;
        PG8_STAGE(PG8_SB(1, 0), cB + kstep, voffB); PG8_STAGE(PG8_SA(1, 0), cA + kstep, vc0); PG8_STAGE(PG8_SB(1, 1), cB + hstep + kstep, voffB);
        PG8_WAIT_V(6); PG8_BAR;
    }
    for (;;) {
        const bool has_next = S.next(ui + 1, nxt);
        const PT nA = GATHER ? cA : (has_next ? PG8_PT((const char*)g.A + (size_t)nxt.pm * tstep + (size_t)nxt.e * g.astride) : cA);
        if constexpr (GATHER) { if (has_next) { PG8_GROWS(nxt, vn0, vn1); } } const PT nB = has_next ? PG8_PT((const char*)g.Bt + (size_t)nxt.pn * tstep + (size_t)nxt.e * g.bstride) : cB;
        for (int t = 0; t < nt; t += 2) {
            const bool last = (t == nt - 2);
            const PT a1 = cA + (unsigned)((t + 1) * (int)kstep);
            const PT a2 = last ? nA : cA + (unsigned)((t + 2) * (int)kstep); const PT b2 = last ? nB : cB + (unsigned)((t + 2) * (int)kstep);
            const PT a3 = a2 + (unsigned)kstep; const PT b3 = b2 + (unsigned)kstep;
            unsigned vs0[2], vs1[2];
#pragma unroll
            for (int i = 0; i < 2; ++i) { vs0[i] = (GATHER && last) ? vn0[i] : vc0[i]; vs1[i] = (GATHER && last) ? vn1[i] : vc1[i]; }
            if (last && has_next) S.a_ready(nxt);
            if constexpr (SP2) {
            PG8_LDB(B0, 0, 0); PG8_LDB(B1, 0, 1); PG8_SCHED; PG8_LDA(At, 0, 0); PG8_STAGE(PG8_SA(1, 1), a1, vc1);
            PG8_WAIT_V(8); PG8_WAIT_L(0); PG8_BAR; PG8_MMA(0, 0, At, B0); PG8_MMA(0, 1, At, B1); PG8_BAR; PG8_SCHED;
            PG8_LDA(At, 0, 1); PG8_STAGE(PG8_SB(0, 0), b2, voffB); PG8_STAGE(PG8_SB(0, 1), b2 + hstep, voffB); PG8_STAGE(PG8_SA(0, 0), a2, vs0);
            PG8_WAIT_V(8); PG8_WAIT_L(0); PG8_BAR; PG8_MMA(1, 0, At, B0); PG8_MMA(1, 1, At, B1); PG8_BAR; PG8_SCHED;
            PG8_LDB(B0, 1, 0); PG8_LDB(B1, 1, 1); PG8_SCHED; PG8_LDA(At, 1, 0); PG8_STAGE(PG8_SA(0, 1), a2, vs1);
            PG8_WAIT_V(8); PG8_WAIT_L(0); PG8_BAR; PG8_MMA(0, 0, At, B0); PG8_MMA(0, 1, At, B1); PG8_BAR; PG8_SCHED;
            PG8_LDA(At, 1, 1); PG8_STAGE(PG8_SB(1, 0), b3, voffB); PG8_STAGE(PG8_SB(1, 1), b3 + hstep, voffB); PG8_STAGE(PG8_SA(1, 0), a3, vs0);
            PG8_WAIT_V(8); PG8_WAIT_L(0); PG8_BAR; PG8_MMA(1, 0, At, B0); PG8_MMA(1, 1, At, B1); PG8_BAR; PG8_SCHED;
            } else {
            PG8_LDB(B0, 0, 0); PG8_SCHED; PG8_LDA(At, 0, 0); PG8_STAGE(PG8_SA(1, 1), a1, vc1);
            PG8_WAIT_L(8); PG8_BAR; PG8_WAIT_L(0); PG8_MMA(0, 0, At, B0); PG8_BAR; PG8_SCHED;
            PG8_LDB(B1, 0, 1); PG8_STAGE(PG8_SB(0, 0), b2, voffB);
            PG8_BAR; PG8_WAIT_L(0); PG8_MMA(0, 1, At, B1); PG8_BAR;
            PG8_LDA(At, 0, 1); PG8_STAGE(PG8_SA(0, 0), a2, vs0);
            PG8_BAR; PG8_WAIT_L(0); PG8_MMA(1, 0, At, B0); PG8_BAR; PG8_SCHED;
            PG8_STAGE(PG8_SB(0, 1), b2 + hstep, voffB);
            PG8_WAIT_V(6); PG8_BAR; PG8_MMA(1, 1, At, B1); PG8_BAR;
            PG8_LDB(B0, 1, 0); PG8_SCHED; PG8_LDA(At, 1, 0); PG8_STAGE(PG8_SA(0, 1), a2, vs1);
            PG8_WAIT_L(8); PG8_BAR; PG8_WAIT_L(0); PG8_MMA(0, 0, At, B0); PG8_BAR; PG8_SCHED;
            PG8_LDB(B1, 1, 1); PG8_STAGE(PG8_SB(1, 0), b3, voffB);
            PG8_BAR; PG8_WAIT_L(0); PG8_MMA(0, 1, At, B1); PG8_BAR;
            PG8_LDA(At, 1, 1); PG8_STAGE(PG8_SA(1, 0), a3, vs0);
            PG8_BAR; PG8_WAIT_L(0); PG8_MMA(1, 0, At, B0); PG8_BAR; PG8_SCHED;
            PG8_STAGE(PG8_SB(1, 1), b3 + hstep, voffB);
            PG8_WAIT_V(6); PG8_BAR; PG8_MMA(1, 1, At, B1); PG8_BAR;
            }
        }
        if constexpr (ESIZE == 1) asm volatile("s_nop 15\n\ts_nop 15" ::: "memory");
        if constexpr (ALIGN_EPI) { if (wr == 0) PG8_BAR; }
        if constexpr (!Epi::AFTER_DRAIN) { if constexpr (Epi::CHAIN) E.chain(acc, cur, wr, wc, fr, fq); else E(acc, cur, wr, wc, fr, fq); S.done(cur); }
        if (!has_next) break;
        if (!(Epi::CHAIN && nxt.e != 0)) {
#pragma unroll
        for (int a = 0; a < 2; ++a)
#pragma unroll
            for (int b = 0; b < 2; ++b)
#pragma unroll
                for (int m = 0; m < 4; ++m)
#pragma unroll
                    for (int n = 0; n < 2; ++n) acc[a][b][m][n] = (f32x4){0.f, 0.f, 0.f, 0.f};
        }
        cur = nxt; cA = nA; cB = nB; ++ui;
        if constexpr (GATHER) { _Pragma("unroll") for (int i = 0; i < 2; ++i) { vc0[i] = vn0[i]; vc1[i] = vn1[i]; } }
        if constexpr (ALIGN_EPI) { if (wr == 1) PG8_BAR; }
    }
    PG8_WAIT_V(0);
    if constexpr (!ALIGN_EPI) { if (wr == 0) PG8_BAR; }
    PG8_BAR;
    if constexpr (Epi::AFTER_DRAIN) { E.fused(acc, cur, wr, wc, fr, fq, lds, wid, lane); S.done(cur); }
#undef PG8_GROWS
#undef PG8_PT
#undef PG8_SA
#undef PG8_SB
#undef PG8_STAGE
#undef PG8_LDA
#undef PG8_LD8
#undef PG8_LDB
#undef PG8_MMA
#undef PG8_F8CAT
#undef PG8_WAIT_V
#undef PG8_WAIT_L
#undef PG8_BAR
#undef PG8_SCHED
}
}


namespace att {
typedef unsigned short bf16_t;
typedef short bf16x8 __attribute__((ext_vector_type(8)));
typedef short s16x4 __attribute__((ext_vector_type(4)));
typedef float f32x16 __attribute__((ext_vector_type(16)));
typedef unsigned u32x4 __attribute__((ext_vector_type(4)));
#define ALAS __attribute__((address_space(3)))
typedef ALAS unsigned char* ALAS_PTR;
#define ASBAR() __builtin_amdgcn_sched_barrier(0)
constexpr int QBLK = 32, KVBLK = 64;
constexpr float THR2 = 11.0f;
constexpr float LOG2E = 1.4426950408889634f, INV2PI = 0.15915494309189535f, LOG2_THETA = 13.287712379549449f;
constexpr int OFF_V = 0, VBUF = 8192, OFF_K = 16384, KBUF_MAX = 13312, OFF_WS = OFF_K + 2 * KBUF_MAX  , OFF_BIAS = OFF_WS + 2048  , ATT_LDS = OFF_BIAS + 2048;
__device__ __forceinline__ int crow(int r, int hi) { return (r & 3) + 8 * (r >> 2) + 4 * hi; }
__device__ __forceinline__ unsigned cvtpk(float lo, float hi) { unsigned r; asm volatile("v_cvt_pk_bf16_f32 %0, %1, %2" : "=v"(r) : "v"(lo), "v"(hi)); return r; }
__device__ __forceinline__ float bf2f(short s) { return __uint_as_float(((unsigned)(unsigned short)s) << 16); }
__device__ __forceinline__ short f2bf_s(float f) { return (short)(cvtpk(f, 0.f) & 0xffffu); }

struct UnitP {
    const bf16_t* Q; int ldq;
    const bf16_t* K0; int ldk0;
    const bf16_t* K1; int ldk1;
    const bf16_t* V; int ldv;
    bf16_t* O; int ldo;
    int nt;
    int grow0;
    const float* gain;
    int kr0;
    float cref;
};

typedef short v4i16_t __attribute__((ext_vector_type(4)));
__device__ __forceinline__ s16x4 vtr(const ALAS unsigned char* p) { return __builtin_bit_cast(s16x4, __builtin_amdgcn_ds_read_tr16_b64_v4i16((ALAS v4i16_t*)p)); }
__device__ __forceinline__ void pv_all(f32x16& o0, f32x16& o1, f32x16& lacc, const ALAS unsigned char* vp, bf16x8 pa0, bf16x8 pa1, bf16x8 pa2, bf16x8 pa3) {
    const bf16x8 ones = {(short)0x3F80, (short)0x3F80, (short)0x3F80, (short)0x3F80, (short)0x3F80, (short)0x3F80, (short)0x3F80, (short)0x3F80};
#define ATT_PK(L, H) (bf16x8){L[0], L[1], L[2], L[3], H[0], H[1], H[2], H[3]}
#define ATT_STEP(KS, PA) { const s16x4 l0 = vtr(vp + (KS) * 1024), h0 = vtr(vp + (KS) * 1024 + 512), l1 = vtr(vp + 4096 + (KS) * 1024), h1 = vtr(vp + 4096 + (KS) * 1024 + 512); \
        o0 = __builtin_amdgcn_mfma_f32_32x32x16_bf16(PA, ATT_PK(l0, h0), o0, 0, 0, 0); o1 = __builtin_amdgcn_mfma_f32_32x32x16_bf16(PA, ATT_PK(l1, h1), o1, 0, 0, 0); \
        lacc = __builtin_amdgcn_mfma_f32_32x32x16_bf16(PA, ones, lacc, 0, 0, 0); }
    ATT_STEP(0, pa0) ATT_STEP(1, pa1) ATT_STEP(2, pa2) ATT_STEP(3, pa3)
#undef ATT_STEP
#undef ATT_PK
}
template <int DQK> __device__ __forceinline__ void qkt(f32x16& p0, f32x16& p1, const ALAS unsigned char* Ks, const bf16x8* qr, const f32x16& cinit, int r32, int hi) {
    constexpr int KST = DQK * 2 + 16;
#pragma unroll
    for (int d0 = 0; d0 < DQK / 16; ++d0) { const int cb = (2 * d0 + hi) * 16;
        const bf16x8 b0 = *(const ALAS bf16x8*)(Ks + r32 * KST + cb);
        const bf16x8 b1 = *(const ALAS bf16x8*)(Ks + (32 + r32) * KST + cb);
        if (d0 == 0) { p0 = __builtin_amdgcn_mfma_f32_32x32x16_bf16(b0, qr[0], cinit, 0, 0, 0); p1 = __builtin_amdgcn_mfma_f32_32x32x16_bf16(b1, qr[0], cinit, 0, 0, 0); }
        else { p0 = __builtin_amdgcn_mfma_f32_32x32x16_bf16(b0, qr[d0], p0, 0, 0, 0); p1 = __builtin_amdgcn_mfma_f32_32x32x16_bf16(b1, qr[d0], p1, 0, 0, 0); } }
}
__device__ __forceinline__ void na_mask(f32x16& p0, f32x16& p1, const ALAS float* btab, int kr, int rq, int qc_in, int hi_in) {
    int qc = qc_in, hi = hi_in; asm volatile("" : "+v"(qc), "+v"(hi));
    int r0 = rq - 4; r0 = r0 < 0 ? 0 : (r0 > 120 ? 120 : r0);
    const bool rowok = (kr >= r0) && (kr < r0 + 8);
    int c0 = qc - 8; c0 = c0 < 0 ? 0 : (c0 > 48 ? 48 : c0);
    int dr = kr - rq + 7; dr = dr < 0 ? 0 : (dr > 14 ? 14 : dr);
    const ALAS float* brow = btab + dr * 31;
#pragma unroll
    for (int r = 0; r < 16; ++r) {
        const int ka = crow(r, hi), kb = 32 + ka;
        int ia = ka - qc + 15; ia = ia < 0 ? 0 : (ia > 30 ? 30 : ia);
        int ib = kb - qc + 15; ib = ib < 0 ? 0 : (ib > 30 ? 30 : ib);
        const bool oka = rowok && (ka >= c0) && (ka < c0 + 16), okb = rowok && (kb >= c0) && (kb < c0 + 16);
        p0[r] = oka ? p0[r] + brow[ia] : -1e30f;
        p1[r] = okb ? p1[r] + brow[ib] : -1e30f;
    }
}
__device__ __forceinline__ void lazySM(f32x16& p0, f32x16& p1, float& m_reg, bool& moved, float& alpha) {
    float pmax = p0[0];
#pragma unroll
    for (int r = 1; r < 16; ++r) pmax = fmaxf(pmax, p0[r]);
#pragma unroll
    for (int r = 0; r < 16; ++r) pmax = fmaxf(pmax, p1[r]);
    { auto rr = __builtin_amdgcn_permlane32_swap(__float_as_uint(pmax), __float_as_uint(pmax), false, false);
      pmax = fmaxf(__uint_as_float(rr[0]), __uint_as_float(rr[1])); }
    if (__builtin_expect(__all(pmax <= THR2), 1)) { alpha = 1.f; }
    else { const float dl = fmaxf(pmax, 0.f); m_reg += dl; alpha = __builtin_amdgcn_exp2f(-dl);
#pragma unroll
        for (int r = 0; r < 16; ++r) { p0[r] -= dl; p1[r] -= dl; }
        moved = true; }
#pragma unroll
    for (int r = 0; r < 16; ++r) p0[r] = __builtin_amdgcn_exp2f(p0[r]);
}
__device__ __forceinline__ void fixedSM(f32x16& p0) {
#pragma unroll
    for (int r = 0; r < 16; ++r) p0[r] = __builtin_amdgcn_exp2f(p0[r]);
}
__device__ __forceinline__ void finishSM(f32x16& p0, f32x16& p1, bf16x8& pa0, bf16x8& pa1, bf16x8& pa2, bf16x8& pa3) {
#pragma unroll
    for (int r = 0; r < 16; ++r) p1[r] = __builtin_amdgcn_exp2f(p1[r]);
    u32x4 w;
    w = (u32x4){cvtpk(p0[0], p0[1]), cvtpk(p0[2], p0[3]), cvtpk(p0[4], p0[5]), cvtpk(p0[6], p0[7])}; pa0 = __builtin_bit_cast(bf16x8, w);
    w = (u32x4){cvtpk(p0[8], p0[9]), cvtpk(p0[10], p0[11]), cvtpk(p0[12], p0[13]), cvtpk(p0[14], p0[15])}; pa1 = __builtin_bit_cast(bf16x8, w);
    w = (u32x4){cvtpk(p1[0], p1[1]), cvtpk(p1[2], p1[3]), cvtpk(p1[4], p1[5]), cvtpk(p1[6], p1[7])}; pa2 = __builtin_bit_cast(bf16x8, w);
    w = (u32x4){cvtpk(p1[8], p1[9]), cvtpk(p1[10], p1[11]), cvtpk(p1[12], p1[13]), cvtpk(p1[14], p1[15])}; pa3 = __builtin_bit_cast(bf16x8, w);
}
struct NoSide { static constexpr bool PLAIN = true; template <int P> __device__ __forceinline__ void step() {} };
template <int DQK, int MODE, class SIDE = NoSide>
__device__ __forceinline__ void attn_unit(const UnitP& u, ALAS unsigned char* lds, const int tid, SIDE& side) {
    constexpr int ND = DQK / 16, KST = DQK * 2 + 16, KBUF = 64 * KST;
    static_assert(KBUF <= KBUF_MAX, "K buffer");
    const int wid = __builtin_amdgcn_readfirstlane(tid >> 6), lane = tid & 63, r32 = lane & 31, hi = lane >> 5;
    ALAS unsigned char* V_lds = lds + OFF_V; ALAS unsigned char* K_lds = lds + OFF_K;
    ALAS float* ws = (ALAS float*)(lds + OFF_WS) + wid * 64; ALAS float* al_l = ws + 32;
    const ALAS float* btab = (const ALAS float*)(lds + OFF_BIAS);
    float m_reg = 0.f; f32x16 o[2], lacc; o[0] = f32x16{}; o[1] = f32x16{}; lacc = f32x16{}; bf16x8 qr[ND];
    bool moved = false;
    const int grow = u.grow0 + (wid >> 1), gcol = (wid & 1) * 32 + r32;
    {
        const bf16_t* Qw = u.Q + (size_t)(wid * QBLK + r32) * u.ldq + hi * 8;
#pragma unroll
        for (int d0 = 0; d0 < ND; ++d0) qr[d0] = *(const bf16x8*)(Qw + d0 * 16);
        if constexpr (MODE == 0 || MODE == 3) {
            float x[4][8]; float ssq = 0.f;
#pragma unroll
            for (int d0 = 0; d0 < 4; ++d0)
#pragma unroll
                for (int j = 0; j < 8; ++j) { x[d0][j] = bf2f(qr[d0][j]); ssq += x[d0][j] * x[d0][j]; }
            { auto rr_ = __builtin_amdgcn_permlane32_swap(__float_as_uint(ssq), __float_as_uint(ssq), false, false); ssq = __uint_as_float(rr_[0]) + __uint_as_float(rr_[1]); }
            const float rstd = 1.0f / sqrtf(ssq * (1.0f / 64.0f) + 1e-6f);
#pragma unroll
            for (int d0 = 0; d0 < 4; ++d0)
#pragma unroll
                for (int j = 0; j < 8; ++j) x[d0][j] = x[d0][j] * rstd * u.gain[16 * d0 + 8 * hi + j];
#pragma unroll
            for (int d0 = 0; d0 < 2; ++d0)
#pragma unroll
                for (int j = 0; j < 8; ++j) { const float inv = exp2f(-(float)(8 * hi + j) * (LOG2_THETA / 16.0f));
                    const float ang = (float)(d0 == 0 ? grow : gcol) * inv * INV2PI; const float c = __builtin_amdgcn_cosf(ang), s = __builtin_amdgcn_sinf(ang);
                    const float y1 = x[d0][j], y2 = x[d0 + 2][j]; x[d0][j] = y1 * c - y2 * s; x[d0 + 2][j] = y1 * s + y2 * c; }
            constexpr float C2 = 0.125f * LOG2E;
#pragma unroll
            for (int d0 = 0; d0 < 4; ++d0) { u32x4 w = {cvtpk(x[d0][0] * C2, x[d0][1] * C2), cvtpk(x[d0][2] * C2, x[d0][3] * C2), cvtpk(x[d0][4] * C2, x[d0][5] * C2), cvtpk(x[d0][6] * C2, x[d0][7] * C2)};
                qr[d0] = __builtin_bit_cast(bf16x8, w); }
        }
        if constexpr (MODE == 1) {
            float y1[8], y2[8];
#pragma unroll
            for (int j = 0; j < 8; ++j) { const float inv = exp2f(-(float)j * (LOG2_THETA / 8.0f));
                const float ang = (float)(hi == 0 ? grow : gcol) * inv * INV2PI; const float c = __builtin_amdgcn_cosf(ang), s = __builtin_amdgcn_sinf(ang);
                const float a = bf2f(qr[4][j]), b = bf2f(qr[5][j]); y1[j] = a * c - b * s; y2[j] = a * s + b * c; }
            u32x4 w = {cvtpk(y1[0], y1[1]), cvtpk(y1[2], y1[3]), cvtpk(y1[4], y1[5]), cvtpk(y1[6], y1[7])}; qr[4] = __builtin_bit_cast(bf16x8, w);
            w = (u32x4){cvtpk(y2[0], y2[1]), cvtpk(y2[2], y2[3]), cvtpk(y2[4], y2[5]), cvtpk(y2[6], y2[7])}; qr[5] = __builtin_bit_cast(bf16x8, w);
        }
    }
    const int sk = tid >> 3, sc = tid & 7;
    const bf16_t* vsrc = u.V + (size_t)sk * u.ldv + sc * 8; const bf16_t* ksrc = u.K0 + (size_t)sk * u.ldk0 + sc * 8;
    const int vst = (sc >> 2) * 4096 + sk * 64 + (sc & 3) * 16, kst = sk * KST + sc * 16;
    const int sk2 = (tid & 255) >> 2, sc2 = tid & 3;
    const bf16_t* k2src = (DQK == 96) ? u.K1 + (size_t)sk2 * u.ldk1 + sc2 * 8 : nullptr;
    const int k2st = sk2 * KST + (8 + sc2) * 16;
    const ALAS unsigned char* vb0 = V_lds + ((lane >> 4) & 1) * 32 + (lane & 3) * 8 + (4 * hi + ((lane & 15) >> 2)) * 64;
    struct { bf16x8 v, k, k2; } sr_[2];
#define ATT_SLOAD(i, k0) do { sr_[i].v = *(const bf16x8*)(vsrc + (size_t)(k0) * u.ldv); sr_[i].k = *(const bf16x8*)(ksrc + (size_t)(k0) * u.ldk0); \
        if constexpr (DQK == 96) sr_[i].k2 = *(const bf16x8*)(k2src + (size_t)(k0) * u.ldk1); } while (0)
#define ATT_SWRITE(b, i) do { *(ALAS bf16x8*)(V_lds + (b) * VBUF + vst) = sr_[i].v; *(ALAS bf16x8*)(K_lds + (b) * KBUF + kst) = sr_[i].k; \
        if constexpr (DQK == 96) *(ALAS bf16x8*)(K_lds + (b) * KBUF + k2st) = sr_[i].k2; } while (0)
#define ATT_SWAIT() do { if constexpr (SIDE::PLAIN) { if constexpr (DQK == 96) asm volatile("s_waitcnt vmcnt(3)" ::: "memory"); else asm volatile("s_waitcnt vmcnt(2)" ::: "memory"); } } while (0)
#define ATT_RESC(a) do { if constexpr (MODE != 0) { if (__any((a) < 1.f)) { if (hi == 0) al_l[r32] = (a); asm volatile("s_waitcnt lgkmcnt(0)" ::: "memory"); \
        _Pragma("unroll") for (int r = 0; r < 16; ++r) { const float f_ = al_l[crow(r, hi)]; o[0][r] *= f_; o[1][r] *= f_; lacc[r] *= f_; } } } } while (0)
#define ATT_SM(P0, P1, AL) do { if constexpr (MODE == 0) { fixedSM(P0); AL = 1.f; } else lazySM(P0, P1, m_reg, moved, AL); } while (0)
#define ATT_QKT(P0, P1, KS) do { if (MODE != 0 && moved) { f32x16 ng_; _Pragma("unroll") for (int r_ = 0; r_ < 16; ++r_) ng_[r_] = -m_reg; qkt<DQK>(P0, P1, KS, qr, ng_, r32, hi); } \
        else { const f32x16 z_ = f32x16{}; qkt<DQK>(P0, P1, KS, qr, z_, r32, hi); } } while (0)
#define ATT_PV(VB) pv_all(o[0], o[1], lacc, (VB), pa0, pa1, pa2, pa3)
#define ATT_MASK(P0, P1, j) do { if constexpr (MODE == 2) na_mask(P0, P1, btab, u.kr0 + (j), grow, gcol, hi); } while (0)
    f32x16 pA0, pA1, pB0, pB1; float alA, alB; bf16x8 pa0, pa1, pa2, pa3; const int NT = u.nt;
    constexpr int SE = 0, SO = 1;
    ATT_SLOAD(SE, 0); asm volatile("s_waitcnt vmcnt(0)" ::: "memory"); ATT_SWRITE(0, SE); __syncthreads();
    ATT_QKT(pA0, pA1, K_lds); ATT_MASK(pA0, pA1, 0); ATT_SM(pA0, pA1, alA);
    ATT_SLOAD(SO, KVBLK); if (2 < NT) ATT_SLOAD(SE, 2 * KVBLK);
    ATT_SWAIT(); ATT_SWRITE(1, SO); __syncthreads();
    if (wid >= 4) __builtin_amdgcn_s_setprio(1);
    for (int j = 1; j + 1 < NT; j += 2) {
        if constexpr (!SIDE::PLAIN) { if ((j & 7) == 1) side.template step<0>(); }
        ASBAR(); ATT_QKT(pB0, pB1, K_lds + KBUF); ATT_MASK(pB0, pB1, j);
        finishSM(pA0, pA1, pa0, pa1, pa2, pa3); ASBAR();
        ATT_SLOAD(SO, (j + 2) * KVBLK); ASBAR();
        ATT_PV(vb0); ATT_SM(pB0, pB1, alB);
        __syncthreads(); ATT_SWAIT(); ATT_SWRITE(0, SE);
        ATT_RESC(alB); __syncthreads();
        if constexpr (!SIDE::PLAIN) { if ((j & 7) == 5) side.template step<1>(); }
        ASBAR(); ATT_QKT(pA0, pA1, K_lds); ATT_MASK(pA0, pA1, j + 1);
        finishSM(pB0, pB1, pa0, pa1, pa2, pa3); ASBAR();
        if (j + 3 < NT) ATT_SLOAD(SE, (j + 3) * KVBLK); ASBAR();
        ATT_PV(vb0 + VBUF); ATT_SM(pA0, pA1, alA);
        __syncthreads(); ATT_SWAIT(); ATT_SWRITE(1, SO);
        ATT_RESC(alA); __syncthreads();
    }
    ASBAR(); ATT_QKT(pB0, pB1, K_lds + KBUF); ATT_MASK(pB0, pB1, NT - 1);
    finishSM(pA0, pA1, pa0, pa1, pa2, pa3); ASBAR();
    ATT_PV(vb0); ATT_SM(pB0, pB1, alB);
    __syncthreads(); ATT_RESC(alB);
    finishSM(pB0, pB1, pa0, pa1, pa2, pa3); ASBAR();
    ATT_PV(vb0 + VBUF);
    __builtin_amdgcn_s_setprio(0);
    bf16_t* Ow = u.O + (size_t)(wid * QBLK) * u.ldo;
#pragma unroll
    for (int r = 0; r < 16; ++r) { const int orow = crow(r, hi); const float rl = __builtin_amdgcn_rcpf(lacc[r]);
#pragma unroll
        for (int d0 = 0; d0 < 2; ++d0) Ow[(size_t)orow * u.ldo + d0 * 32 + r32] = (bf16_t)f2bf_s(o[d0][r] * rl); }
    __syncthreads();
#undef ATT_SLOAD
#undef ATT_SWRITE
#undef ATT_SWAIT
#undef ATT_RESC
#undef ATT_SM
#undef ATT_QKT
#undef ATT_PV
#undef ATT_MASK
}
}


constexpr int NWAVES = 8;
#ifndef MK_DEBUG
#define MK_DEBUG 0
#endif
#ifndef MK_DBG_IGNORE
#define MK_DBG_IGNORE 0
#endif
#ifndef MK_ONE_LAUNCH
#define MK_ONE_LAUNCH 0
#endif
#ifndef REP_P
#define REP_P 1
#endif
#ifndef REP_A
#define REP_A 1
#endif
#ifndef REP_B
#define REP_B 1
#endif
#ifndef REP_C
#define REP_C 1
#endif
#ifndef REP_DG
#define REP_DG 1
#endif
#ifndef REP_DM
#define REP_DM 1
#endif
#ifndef REP_DN
#define REP_DN 1
#endif
#ifndef REP_E
#define REP_E 1
#endif
#ifndef REP_F
#define REP_F 1
#endif
#ifndef REP_H
#define REP_H 1
#endif
#ifndef REP_I
#define REP_I 1
#endif
#ifndef REP_J
#define REP_J 1
#endif
#ifndef REP_K
#define REP_K 1
#endif
#ifndef MK_FP8_LAST
#define MK_FP8_LAST 1
#endif
constexpr int NB = 4, SEQ = 8192, T = NB * SEQ, D = 1024, DEPTH = 2, GW = 64;
constexpr int DIN = 5536, DINP = 5632;
constexpr int H_NAQ = 0, H_NAK = 384, H_NAV = 768, H_GQ = 1152, H_GK = 1536, H_GV = 1664, H_CQ = 1792, H_CKV = 2176, H_KR = 2432, H_GATE = 2464;
constexpr int NE = 32, TOPK = 4, FF = 1024, TK = T * TOPK;
constexpr int PSLOTS = TK + NE * 256;
constexpr int MAXTILES = PSLOTS / 256;
constexpr int LCAP = T;
constexpr float LN_EPS = 1e-5f, RMS_EPS = 1e-6f, DN_ALPHA = 1.4142135623730951f;
constexpr float LOG2E_F = 1.4426950408889634f;
constexpr int PPL = 10, NPH = 1 + DEPTH * PPL;

constexpr size_t MiB = 1u << 20;
constexpr size_t WS_CTL = 0, CTL_ZERO_BYTES = 1 * MiB;
constexpr size_t WB_IN = 0, WB_UQ = WB_IN + (size_t)DINP * 1024 * 2, WB_UKV = WB_UQ + (size_t)512 * 384 * 2, WB_BA = WB_UKV + (size_t)512 * 256 * 2,
                 WB_BB = WB_BA + (size_t)1024 * 384 * 2, WB_BC = WB_BB + (size_t)1024 * 384 * 2, WB_OUT = WB_BC + (size_t)1024 * 384 * 2,
                 WB_GU = WB_OUT + (size_t)1024 * 1024 * 2, WB_DN = WB_GU + (size_t)NE * 2048 * 1024 * 2, WB_LAYER = WB_DN + (size_t)NE * 1024 * 1024 * 2;
static_assert(WB_LAYER % 256 == 0, "weight block alignment");
constexpr size_t WS_W = 2 * MiB;
constexpr size_t WS_H = WS_W + 2 * WB_LAYER;
constexpr size_t SZ_H = (size_t)T * DINP * 2;
constexpr size_t WS_A2 = WS_H + SZ_H;
constexpr size_t A2_MIX = 0, A2_MIXED = A2_MIX + (size_t)T * 1024 * 4, A2_YA = A2_MIXED + (size_t)T * 1024 * 2, A2_YB = A2_YA + (size_t)T * 384 * 2,
                 A2_YC = A2_YB + (size_t)T * 384 * 2, A2_QC = A2_YC + (size_t)T * 384 * 2, A2_KVC = A2_QC + (size_t)T * 384 * 2, A2_KB = A2_KVC + (size_t)T * 512 * 2,
                 A2_CQN = A2_KB + (size_t)T * 128 * 2, A2_CKVN = A2_CQN + (size_t)T * 384 * 2, A2_KR = A2_CKVN + (size_t)T * 256 * 2, SZ_A2 = A2_KR + (size_t)T * 32 * 2;
static_assert(SZ_A2 >= (size_t)PSLOTS * 1024 * 2 && SZ_H >= (size_t)PSLOTS * 1024 * 2, "overlays fit");
constexpr size_t WS_X2 = WS_A2 + SZ_A2;
constexpr size_t WS_XB = WS_X2 + (size_t)T * D * 4;
constexpr size_t WS_X1 = WS_XB + (size_t)T * D * 2;
constexpr size_t WS_X1B = WS_X1 + (size_t)T * D * 4;
constexpr size_t WS_LT = WS_X1B + (size_t)T * D * 2;
constexpr size_t WS_LG = WS_LT + (size_t)NE * LCAP * 4;
constexpr size_t WS_TE = WS_LG + (size_t)NE * LCAP * 4;
constexpr size_t WS_TR = WS_TE + (size_t)T * 4 * 4;
constexpr size_t WS_SG = WS_TR + (size_t)T * 4 * 4;
constexpr size_t WS_END = WS_SG + (size_t)PSLOTS * 4;
constexpr int CW_BAR = 4096;
constexpr int CW_CNT = 16384;

constexpr int RING_BYTES = 131072, LDSCTL_OFF = 139264, MISC_OFF = LDSCTL_OFF + 64;
constexpr int TBL_OFF = LDSCTL_OFF + 256;
constexpr int TBL_START = TBL_OFF, TBL_TILEE = TBL_OFF + 512, TBL_RS = TBL_TILEE + 2304;
constexpr int LDS_BYTES = 155648;
static_assert(TBL_RS + 512 * 12 + 256 <= LDS_BYTES, "LDS map");

#define GAS __attribute__((address_space(1)))
#define LAS __attribute__((address_space(3)))
typedef unsigned short bf16;
typedef unsigned v4u __attribute__((ext_vector_type(4)));
typedef float f32x4 __attribute__((ext_vector_type(4)));
typedef GAS unsigned gu32;
#define RLX_AGENT __ATOMIC_RELAXED, __HIP_MEMORY_SCOPE_AGENT
#define LDS_WAIT() asm volatile("s_waitcnt lgkmcnt(0)" ::: "memory")
#define VM_WAIT() asm volatile("s_waitcnt vmcnt(0)" ::: "memory")
__device__ __forceinline__ unsigned f2bf(float f) { unsigned u = __builtin_bit_cast(unsigned, f); return (u + 0x7fffu + ((u >> 16) & 1u)) >> 16; }
__device__ __forceinline__ unsigned pk2(float lo, float hi) { unsigned r; asm("v_cvt_pk_bf16_f32 %0, %1, %2" : "=v"(r) : "v"(lo), "v"(hi)); return r; }
__device__ __forceinline__ float bflo(unsigned w) { return __uint_as_float(w << 16); }
__device__ __forceinline__ float bfhi(unsigned w) { return __uint_as_float(w & 0xffff0000u); }

template <int O> __device__ __forceinline__ float shx(float v, int lane) { return __int_as_float(__builtin_amdgcn_ds_bpermute((lane ^ O) << 2, __float_as_int(v))); }
template <int O> __device__ __forceinline__ int shxi(int v, int lane) { return __builtin_amdgcn_ds_bpermute((lane ^ O) << 2, v); }

#define XB_TMO      128
#define XB_XCNT(j)  (256  + 64 * (j))
#define XB_XSUB(j)  (1280 + 64 * (j))
#define XB_XGEN(j)  (2304 + 64 * (j))
#define XB_TOP      3328
#define XB_TOPGEN   3392
#define XCD_BAR_WORDS 3456
#define XB_SPIN_CAP (1u << 18)

__device__ __forceinline__ unsigned xb_ld(unsigned* p)              { return __hip_atomic_load(p, __ATOMIC_RELAXED, __HIP_MEMORY_SCOPE_AGENT); }
__device__ __forceinline__ unsigned xb_add(unsigned* p, unsigned v) { return __hip_atomic_fetch_add(p, v, __ATOMIC_RELAXED, __HIP_MEMORY_SCOPE_AGENT); }
__device__ __forceinline__ unsigned xb_xcc_id() { return (unsigned)__builtin_amdgcn_s_getreg((3 << 11) | 20) & 0xFu; }
#define XB_SPIN(cond, bar) do { unsigned _sp = 0; while (cond) { __builtin_amdgcn_s_sleep(1); \
    if ((++_sp & 255u) == 0u) { if (xb_ld(&(bar)[XB_TMO])) break; if (_sp > XB_SPIN_CAP) { atomicAdd(&(bar)[XB_TMO], 1u); break; } } } } while (0)

struct XcdBarrier {
    unsigned* bar; unsigned x;
    volatile LAS unsigned* st;
};

__device__ __forceinline__ XcdBarrier xcd_barrier_post(unsigned* bar, volatile LAS unsigned* st) {
    XcdBarrier b; b.bar = bar; b.x = xb_xcc_id(); b.st = st;
    if (threadIdx.x == 0) (void)xb_add(&bar[XB_XCNT(b.x)], 1u);
    return b;
}
__device__ __forceinline__ void xcd_barrier_complete(unsigned* bar, unsigned x, unsigned& nloc, unsigned& nx) {
    const unsigned G = gridDim.x * gridDim.y * gridDim.z;
    unsigned sum, cnt, mine, sp = 0u;
    for (;;) {
        sum = 0u; cnt = 0u; mine = 0u;
#pragma unroll
        for (unsigned j = 0; j < 16; ++j) { const unsigned c = xb_ld(&bar[XB_XCNT(j)]); sum += c; cnt += (c > 0u) ? 1u : 0u; mine = (j == x) ? c : mine; }
        if (sum == G) break;
        __builtin_amdgcn_s_sleep(1);
        if ((++sp & 255u) == 0u) { if (xb_ld(&bar[XB_TMO])) break; if (sp > XB_SPIN_CAP) { atomicAdd(&bar[XB_TMO], 1u); break; } }
    }
    nloc = mine > 0u ? mine : 1u; nx = cnt > 0u ? cnt : 1u;
}

__device__ __forceinline__ void xcd_barrier(const XcdBarrier& b) {
    asm volatile("s_waitcnt vmcnt(0)" ::: "memory");
    __syncthreads();
    if (threadIdx.x == 0) {
        unsigned* bar = b.bar;
        __builtin_amdgcn_s_waitcnt(0);
        unsigned nloc = b.st[0], nx = b.st[1];
        if (nloc == 0u) { xcd_barrier_complete(bar, b.x, nloc, nx); b.st[0] = nloc; b.st[1] = nx; }
        const unsigned old = xb_add(&bar[XB_XSUB(b.x)], 1u);
        const unsigned gen = old / nloc;
        if (old + 1u == (gen + 1u) * nloc) {
            __builtin_amdgcn_fence(__ATOMIC_RELEASE, "agent");
            asm volatile("s_waitcnt vmcnt(0)" ::: "memory");
            const unsigned og = xb_add(&bar[XB_TOP], 1u);
            const unsigned tg = og / nx;
            if (og + 1u == (tg + 1u) * nx) xb_add(&bar[XB_TOPGEN], 1u);
            else XB_SPIN(xb_ld(&bar[XB_TOPGEN]) == tg, bar);
            __builtin_amdgcn_fence(__ATOMIC_ACQUIRE, "agent");
            xb_add(&bar[XB_XGEN(b.x)], 1u);
            asm volatile("s_waitcnt vmcnt(0)" ::: "memory");
        } else {
            XB_SPIN(xb_ld(&bar[XB_XGEN(b.x)]) == gen, bar);
            __builtin_amdgcn_fence(__ATOMIC_ACQUIRE, "agent");
            asm volatile("s_waitcnt vmcnt(0)" ::: "memory");
        }
    }
    __syncthreads();
}


struct Frame {
    LAS unsigned char* lds;
    gu32* ctl;
    int tid, lane, wave;
    int vcu, G, bx;
    unsigned char* ws;
    float* out;
};
__device__ __forceinline__ const float* in_ptr(int i) {
    const void* base = (const void*)__builtin_amdgcn_kernarg_segment_ptr(); const GAS float* p;
    asm volatile("s_load_dwordx2 %0, %1, %2\n\ts_waitcnt lgkmcnt(0)" : "=s"(p) : "s"(base), "i"(i * 8) : "memory"); return (const float*)p;
}
#define INP(i) in_ptr(i)
template <int SITE> __device__ __forceinline__ Frame mkframe(LAS unsigned char* lds_in, unsigned char* ws_in, float* out_in, int wave_id, int bx0, int G0) {
    Frame F; int lane_;
    asm volatile("v_mbcnt_lo_u32_b32 %0, -1, 0\n\tv_mbcnt_hi_u32_b32 %0, -1, %0 ; site %1" : "=v"(lane_) : "n"(SITE));
    int bx = bx0, G = G0, wv = wave_id; asm volatile("; site %3" : "+s"(bx), "+s"(G), "+s"(wv) : "n"(SITE));
    GAS unsigned char* wsg = (GAS unsigned char*)ws_in; asm volatile("; site %1" : "+s"(wsg) : "n"(SITE)); unsigned char* ws = (unsigned char*)wsg;
    LAS unsigned char* l3 = lds_in; asm volatile("; site %1" : "+s"(l3) : "n"(SITE));
    const int tid = wv * 64 + lane_;
    F.lds = l3; F.tid = tid; F.lane = lane_; F.wave = wv;
    F.G = G; F.bx = bx; F.vcu = (G % 8 == 0) ? (bx % 8) * (G / 8) + bx / 8 : bx;
    F.ws = ws; F.ctl = (gu32*)(wsg + WS_CTL); F.out = out_in; return F;
}
__device__ __forceinline__ float wave_sum(float v, int lane) {
    v += shx<1>(v, lane); v += shx<2>(v, lane); v += shx<4>(v, lane); v += shx<8>(v, lane); v += shx<16>(v, lane); v += shx<32>(v, lane);
    return v;
}
template <bool F8> __device__ __forceinline__ void tr_item(const float* W, int ldw, int Kd, int k0, int src_n0, bf16* WT, int dst_n0, float scale, LAS float* scr, int lane) {
    float v[32];
#pragma unroll
    for (int i = 0; i < 32; ++i) v[i] = W[(size_t)(k0 + 2 * i + (lane >> 5)) * ldw + src_n0 + (lane & 31)];
#pragma unroll
    for (int i = 0; i < 32; ++i) scr[(2 * i + (lane >> 5)) * 33 + (lane & 31)] = v[i];
    LDS_WAIT(); asm volatile("" ::: "memory");
    const int c = lane & 7;
#pragma unroll
    for (int j = 0; j < 4; ++j) { const int n = (lane >> 3) + 8 * j; const LAS float* s = scr + (8 * c) * 33 + n;
        if constexpr (F8) { typedef unsigned u32x2 __attribute__((ext_vector_type(2)));
            *(GAS u32x2*)((unsigned char*)WT + (size_t)(dst_n0 + n) * Kd + k0 + 8 * c) = (u32x2){pg8::pk4_fp8(s[0 * 33] * scale, s[1 * 33] * scale, s[2 * 33] * scale, s[3 * 33] * scale), pg8::pk4_fp8(s[4 * 33] * scale, s[5 * 33] * scale, s[6 * 33] * scale, s[7 * 33] * scale)}; }
        else { v4u o; o.x = pk2(s[0 * 33] * scale, s[1 * 33] * scale); o.y = pk2(s[2 * 33] * scale, s[3 * 33] * scale); o.z = pk2(s[4 * 33] * scale, s[5 * 33] * scale); o.w = pk2(s[6 * 33] * scale, s[7 * 33] * scale);
            *(GAS v4u*)(WT + (size_t)(dst_n0 + n) * Kd + k0 + 8 * c) = o; } }
    LDS_WAIT(); asm volatile("" ::: "memory");
}
template <int KIND, bool F8 = false> __device__ __forceinline__ void conv_matrix(Frame& F, const float* W, int K, int N, bf16* WT, float s, int gw, int NGW, LAS float* scr, int Kd = 0) {
    if (Kd == 0) Kd = K;
    const int nnb = N / 32, nkb = K / 64, nit = nnb * nkb;
    for (int it = gw; it < nit; it += NGW) {
        const int kb = it / nnb, nb = it % nnb; const int dst_n0 = 32 * nb; int src_n0 = dst_n0; float sc = s;
        if (KIND == 1) sc = (dst_n0 < 384) ? s : 1.0f;
        if (F8) sc *= 32.0f;
        if (KIND == 2) { const int p = dst_n0 >> 8, j = dst_n0 & 255; src_n0 = (j < 128) ? (128 * p + j) : (1024 + 128 * p + (j - 128)); }
        tr_item<F8>(W, N, Kd, 64 * kb, src_n0, WT, dst_n0, sc, scr, F.lane);
    }
}
__device__ __forceinline__ void zero_rows(bf16* WT, int K, int n_lo, int n_hi, int gtid, int nthr) {
    const size_t n16 = (size_t)(n_hi - n_lo) * K / 8; GAS v4u* p = (GAS v4u*)(WT + (size_t)n_lo * K);
    for (size_t i = gtid; i < n16; i += nthr) p[i] = (v4u){0u, 0u, 0u, 0u};
}
__device__ __forceinline__ void p_prologue(Frame& F) {
    LAS float* scr = (LAS float*)(F.lds + F.wave * 16384);
    const int gw0 = F.vcu * NWAVES + F.wave, NGW = F.G * NWAVES, gtid = F.bx * (NWAVES * 64) + F.tid, nthr = F.G * NWAVES * 64;
    for (int l = 0; l < DEPTH; ++l) {
        unsigned char* wb = F.ws + WS_W + (size_t)l * WB_LAYER;
        int gw = gw0;
#define ROT(n) do { gw = (gw + NGW - ((n) % NGW)) % NGW; } while (0)
        if (MK_FP8_LAST && l == DEPTH - 1) { conv_matrix<1, true>(F, INP(1) + (size_t)l * 1024 * DIN, 1024, DIN, (bf16*)(wb + WB_IN), 0.125f * LOG2E_F, gw, NGW, scr); zero_rows((bf16*)(wb + WB_IN), 512, DIN, DINP, gtid, nthr); }
        else { conv_matrix<1>(F, INP(1) + (size_t)l * 1024 * DIN, 1024, DIN, (bf16*)(wb + WB_IN), 0.125f * LOG2E_F, gw, NGW, scr); zero_rows((bf16*)(wb + WB_IN), 1024, DIN, DINP, gtid, nthr); }
        ROT(16 * 173);
        conv_matrix<0>(F, INP(7) + (size_t)l * 384 * 384, 384, 384, (bf16*)(wb + WB_UQ), 0.10206207261596577f * LOG2E_F, gw, NGW, scr); ROT(72);
        zero_rows((bf16*)(wb + WB_UQ), 384, 384, 512, gtid, nthr);
        conv_matrix<0>(F, INP(8) + (size_t)l * 256 * 512, 256, 512, (bf16*)(wb + WB_UKV), 1.0f, gw, NGW, scr); ROT(64);
        conv_matrix<0>(F, INP(9) + (size_t)l * 384 * 1024, 384, 1024, (bf16*)(wb + WB_BA), 1.0f, gw, NGW, scr); ROT(192);
        conv_matrix<0>(F, INP(10) + (size_t)l * 384 * 1024, 384, 1024, (bf16*)(wb + WB_BB), 1.0f, gw, NGW, scr); ROT(192);
        conv_matrix<0>(F, INP(11) + (size_t)l * 256 * 1024, 256, 1024, (bf16*)(wb + WB_BC), 1.0f, gw, NGW, scr, 384); ROT(64);
        for (int i = gtid; i < 1024 * 16; i += nthr) *((GAS v4u*)(wb + WB_BC) + (size_t)(i >> 4) * 48 + 32 + (i & 15)) = (v4u){0u, 0u, 0u, 0u};
        conv_matrix<0>(F, INP(12) + (size_t)l * 1024 * 1024, 1024, 1024, (bf16*)(wb + WB_OUT), 1.0f, gw, NGW, scr); ROT(512);
#undef ROT
    }
    { const GAS f32x4* xs = (const GAS f32x4*)INP(0); GAS v4u* xd = (GAS v4u*)(F.ws + WS_XB);
      for (size_t i = gtid; i < (size_t)T * D / 8; i += nthr) { const f32x4 a = xs[2 * i], b = xs[2 * i + 1]; xd[i] = (v4u){pk2(a.x, a.y), pk2(a.z, a.w), pk2(b.x, b.y), pk2(b.z, b.w)}; } }
}

constexpr int CONV_ITEMS = NE * 1024 + NE * 512, CONV_LDS_OFF = 49152, CONV_LDS_WAVE = 2 * 16 * 33 * 4;
struct MoeConv {
    static constexpr bool PLAIN = false;
    const float* Wgu; const float* Wdn; unsigned char* Tgu; unsigned char* Tdn; bool f8;
    LAS float* scr; int lane; int gw, ngw, nmini; int s;
    float cvA[8], cvB[8];
    struct Mini { const float* W; unsigned char* WT; int ldw, k0, src_n0, dst_n0; float sc; };
    __device__ __forceinline__ Mini decode(int m) const {
        m = m < 0 ? 0 : (m >= nmini ? nmini - 1 : m);
        const int g = gw + (m >> 2) * ngw, q = m & 3; const bool gu = g < NE * 1024; const int h = gu ? g : g - NE * 1024;
        const int e = gu ? (h >> 10) : (h >> 9), r = gu ? (h & 1023) : (h & 511), kb = gu ? (r >> 6) : (r >> 5), nb = gu ? (r & 63) : (r & 31);
        Mini x; x.dst_n0 = 32 * nb; const int p = x.dst_n0 >> 8, j = x.dst_n0 & 255;
        x.src_n0 = gu ? ((j < 128) ? (128 * p + j) : (1024 + 128 * p + (j - 128))) : x.dst_n0; x.k0 = 64 * kb + 16 * q; x.ldw = gu ? 2048 : 1024;
        x.W = gu ? Wgu + (size_t)e * 1024 * 2048 : Wdn + (size_t)e * 1024 * 1024; const size_t es = f8 ? 1 : 2; x.WT = gu ? Tgu + (size_t)e * 2048 * 1024 * es : Tdn + (size_t)e * 1024 * 1024 * es; x.sc = gu ? 64.0f : 128.0f; return x;
    }
    __device__ __forceinline__ bool done() const { return s >= nmini + 3; }
    template <int P> __device__ __forceinline__ void step() {
        {   const Mini x = decode(s - 3); const LAS float* b = scr + (1 - P) * (16 * 33); const int n = lane >> 1, kh = lane & 1; const LAS float* p = b + (8 * kh) * 33 + n;
            const float q0 = p[0 * 33], q1 = p[1 * 33], q2 = p[2 * 33], q3 = p[3 * 33], q4 = p[4 * 33], q5 = p[5 * 33], q6 = p[6 * 33], q7 = p[7 * 33];
            const size_t eo = (size_t)(x.dst_n0 + n) * 1024 + x.k0 + 8 * kh;
            if (f8) { typedef unsigned u32x2 __attribute__((ext_vector_type(2)));
                *(GAS u32x2*)(x.WT + eo) = (u32x2){pg8::pk4_fp8(q0 * x.sc, q1 * x.sc, q2 * x.sc, q3 * x.sc), pg8::pk4_fp8(q4 * x.sc, q5 * x.sc, q6 * x.sc, q7 * x.sc)}; }
            else { v4u o; o.x = pk2(q0, q1); o.y = pk2(q2, q3); o.z = pk2(q4, q5); o.w = pk2(q6, q7); *(GAS v4u*)(x.WT + eo * 2) = o; } }
        {   LAS float* b = scr + P * (16 * 33);
#pragma unroll
            for (int jj = 0; jj < 8; ++jj) b[(2 * jj + (lane >> 5)) * 33 + (lane & 31)] = P ? cvB[jj] : cvA[jj]; }
        {   const Mini x = decode(s); const GAS float* src = (const GAS float*)x.W + (size_t)(x.k0 + (lane >> 5)) * x.ldw + x.src_n0 + (lane & 31);
#pragma unroll
            for (int jj = 0; jj < 8; ++jj) { const float v = src[(size_t)(2 * jj) * x.ldw]; if (P) cvB[jj] = v; else cvA[jj] = v; } }
        ++s;
    }
};
__device__ __forceinline__ void p_prep(Frame& F, int l) {
    const bf16* hb = (const bf16*)(F.ws + WS_H); unsigned char* a2 = F.ws + WS_A2;
    bf16* kB = (bf16*)(a2 + A2_KB); bf16* cqn = (bf16*)(a2 + A2_CQN); bf16* ckvn = (bf16*)(a2 + A2_CKVN); bf16* kr = (bf16*)(a2 + A2_KR);
    const float* gk = INP(4) + l * 64; const float* gq = INP(5) + l * 384; const float* gkv = INP(6) + l * 256;
    const int lane = F.lane, gw = F.vcu * NWAVES + F.wave, NGW = F.G * NWAVES;
    v4u nk = {0u, 0u, 0u, 0u}, nq = nk, nkv = nk, nr = nk;
    if (gw < T) { const bf16* h0 = hb + (size_t)gw * DINP; if (lane < 16) nk = *(const GAS v4u*)(h0 + H_GK + lane * 8); if (lane < 48) nq = *(const GAS v4u*)(h0 + H_CQ + lane * 8);
        if (lane < 32) nkv = *(const GAS v4u*)(h0 + H_CKV + lane * 8); if (lane < 4) nr = *(const GAS v4u*)(h0 + H_KR + lane * 8); }
    for (int t = gw; t < T; t += NGW) {
        const v4u wk_ = nk, wq_ = nq, wkv_ = nkv, wr_ = nr;
        if (t + NGW < T) { const bf16* h1 = hb + (size_t)(t + NGW) * DINP; if (lane < 16) nk = *(const GAS v4u*)(h1 + H_GK + lane * 8); if (lane < 48) nq = *(const GAS v4u*)(h1 + H_CQ + lane * 8);
            if (lane < 32) nkv = *(const GAS v4u*)(h1 + H_CKV + lane * 8); if (lane < 4) nr = *(const GAS v4u*)(h1 + H_KR + lane * 8); }
        const int s = t & (SEQ - 1); const float prow = (float)(s >> 6), pcol = (float)(s & 63);
        {   float x[8]; float ssq = 0.f; const int cc = lane & 7;
            if (lane < 16) { const v4u w = wk_; x[0] = bflo(w.x); x[1] = bfhi(w.x); x[2] = bflo(w.y); x[3] = bfhi(w.y); x[4] = bflo(w.z); x[5] = bfhi(w.z); x[6] = bflo(w.w); x[7] = bfhi(w.w); }
            else {
#pragma unroll
                for (int j = 0; j < 8; ++j) x[j] = 0.f; }
#pragma unroll
            for (int j = 0; j < 8; ++j) ssq += x[j] * x[j];
            ssq += shx<1>(ssq, lane); ssq += shx<2>(ssq, lane); ssq += shx<4>(ssq, lane);
            const float rstd = 1.0f / sqrtf(ssq * (1.0f / 64.0f) + RMS_EPS);
            float y[8], o[8];
#pragma unroll
            for (int j = 0; j < 8; ++j) y[j] = x[j] * rstd * gk[(cc * 8 + j) & 63];
#pragma unroll
            for (int j = 0; j < 8; ++j) { const float other = shx<4>(y[j], lane); const int i = 8 * (cc & 3) + j;
                const float inv = exp2f(-(float)(i & 15) * (att::LOG2_THETA / 16.0f)); const float ang = ((i < 16) ? prow : pcol) * inv * att::INV2PI;
                const float c = __builtin_amdgcn_cosf(ang), sn = __builtin_amdgcn_sinf(ang);
                o[j] = (cc < 4) ? (y[j] * c - other * sn) : (other * sn + y[j] * c); }
            if (lane < 16) *(GAS v4u*)(kB + (size_t)t * 128 + lane * 8) = (v4u){pk2(o[0], o[1]), pk2(o[2], o[3]), pk2(o[4], o[5]), pk2(o[6], o[7])};
        }
        {   float x[8]; float ssq = 0.f;
            if (lane < 48) { const v4u w = wq_; x[0] = bflo(w.x); x[1] = bfhi(w.x); x[2] = bflo(w.y); x[3] = bfhi(w.y); x[4] = bflo(w.z); x[5] = bfhi(w.z); x[6] = bflo(w.w); x[7] = bfhi(w.w); }
            else {
#pragma unroll
                for (int j = 0; j < 8; ++j) x[j] = 0.f; }
#pragma unroll
            for (int j = 0; j < 8; ++j) ssq += x[j] * x[j];
            ssq = wave_sum(ssq, lane); const float rstd = 1.0f / sqrtf(ssq * (1.0f / 384.0f) + RMS_EPS);
            if (lane < 48) { float y[8];
#pragma unroll
                for (int j = 0; j < 8; ++j) y[j] = x[j] * rstd * gq[lane * 8 + j];
                *(GAS v4u*)(cqn + (size_t)t * 384 + lane * 8) = (v4u){pk2(y[0], y[1]), pk2(y[2], y[3]), pk2(y[4], y[5]), pk2(y[6], y[7])}; }
        }
        {   float x[8]; float ssq = 0.f;
            if (lane < 32) { const v4u w = wkv_; x[0] = bflo(w.x); x[1] = bfhi(w.x); x[2] = bflo(w.y); x[3] = bfhi(w.y); x[4] = bflo(w.z); x[5] = bfhi(w.z); x[6] = bflo(w.w); x[7] = bfhi(w.w); }
            else {
#pragma unroll
                for (int j = 0; j < 8; ++j) x[j] = 0.f; }
#pragma unroll
            for (int j = 0; j < 8; ++j) ssq += x[j] * x[j];
            ssq = wave_sum(ssq, lane); const float rstd = 1.0f / sqrtf(ssq * (1.0f / 256.0f) + RMS_EPS);
            if (lane < 32) { float y[8];
#pragma unroll
                for (int j = 0; j < 8; ++j) y[j] = x[j] * rstd * gkv[lane * 8 + j];
                *(GAS v4u*)(ckvn + (size_t)t * 256 + lane * 8) = (v4u){pk2(y[0], y[1]), pk2(y[2], y[3]), pk2(y[4], y[5]), pk2(y[6], y[7])}; }
        }
        {   float x[8]; const int cc = lane & 3;
            if (lane < 4) { const v4u w = wr_; x[0] = bflo(w.x); x[1] = bfhi(w.x); x[2] = bflo(w.y); x[3] = bfhi(w.y); x[4] = bflo(w.z); x[5] = bfhi(w.z); x[6] = bflo(w.w); x[7] = bfhi(w.w); }
            else {
#pragma unroll
                for (int j = 0; j < 8; ++j) x[j] = 0.f; }
            float o[8];
#pragma unroll
            for (int j = 0; j < 8; ++j) { const float other = shx<2>(x[j], lane);
                const float inv = exp2f(-(float)j * (att::LOG2_THETA / 8.0f)); const float ang = (((cc & 1) == 0) ? prow : pcol) * inv * att::INV2PI;
                const float c = __builtin_amdgcn_cosf(ang), sn = __builtin_amdgcn_sinf(ang);
                o[j] = (cc < 2) ? (x[j] * c - other * sn) : (other * sn + x[j] * c); }
            if (lane < 4) *(GAS v4u*)(kr + (size_t)t * 32 + lane * 8) = (v4u){pk2(o[0], o[1]), pk2(o[2], o[3]), pk2(o[4], o[5]), pk2(o[6], o[7])};
        }
    }
}


__device__ __forceinline__ int build_tables(Frame& F, int l) {
    LAS int* st = (LAS int*)(F.lds + TBL_START); LAS int* cn = st + 33; LAS int* te = (LAS int*)(F.lds + TBL_TILEE);
    __syncthreads();
    if (F.tid < NE) cn[F.tid] = (int)__hip_atomic_load(F.ctl + CW_CNT + 64 * l + F.tid, RLX_AGENT);
    __syncthreads();
    if (F.tid == 0) { int s = 0; for (int e = 0; e < NE; ++e) { st[e] = s; s += ((cn[e] + 255) >> 8) << 8; } st[NE] = s; }
    __syncthreads();
    const int total = st[NE];
    for (int tile = F.tid; tile < (total >> 8); tile += NWAVES * 64) { int e = 0; for (int k = 1; k < NE; ++k) e += (tile * 256 >= st[k]) ? 1 : 0; te[tile] = e; }
    __syncthreads();
    return total;
}

template <bool XBF> __device__ __forceinline__ void p_ln1_router(Frame& F, int l, const void* xin) {
    const bool w8 = MK_FP8_LAST && (l == DEPTH - 1); unsigned char* x1f8 = F.ws + WS_X2;
    const float* xcur = (const float*)xin; const bf16* xcb = (const bf16*)xin;
    const bf16* outb = (const bf16*)(F.ws + WS_X1); bf16* x1b = (bf16*)(F.ws + WS_X1B);
    int* list_t = (int*)(F.ws + WS_LT); float* list_g = (float*)(F.ws + WS_LG); int* tok_e = (int*)(F.ws + WS_TE); int* tok_r = (int*)(F.ws + WS_TR);
    const float* wr = INP(15) + (size_t)l * 1024 * NE; const float* br = INP(16) + l * NE;
    const int lane0 = F.lane, tid = F.tid;
    LAS unsigned char* wl = F.lds;
    LAS int* sel_e = (LAS int*)(F.lds + TBL_RS); LAS float* sel_g = (LAS float*)(sel_e + 512); LAS int* sel_r = sel_e + 1024; LAS int* hist = sel_e + 1536; LAS int* base = hist + 32;
    __syncthreads();
    for (int idx = tid; idx < 1024 * 8; idx += NWAVES * 64) { const int k = idx >> 3, c = idx & 7, kp = (k & 3) * 256 + (k >> 2), cp = c ^ ((kp >> 1) & 7);
        *(LAS f32x4*)(wl + (kp * 8 + cp) * 16) = *(const GAS f32x4*)(wr + (size_t)k * NE + c * 4); }
    __syncthreads();
    for (int tile = F.bx; tile < T / 128; tile += F.G) {
        if (tid < 32) hist[tid] = 0;
        __syncthreads();
        f32x4 px[4]; unsigned long long po[4], pxb[4];
        {   const int t0 = tile * 128 + F.wave * 16; const GAS f32x4* xr0 = (const GAS f32x4*)(xcur + (size_t)t0 * D) + lane0; const GAS unsigned long long* or0 = (const GAS unsigned long long*)(outb + (size_t)t0 * D) + lane0;
#pragma unroll
            for (int j = 0; j < 4; ++j) { if (XBF) pxb[j] = ((const GAS unsigned long long*)(xcb + (size_t)t0 * D) + lane0)[64 * j]; else px[j] = xr0[64 * j]; po[j] = or0[64 * j]; } }
        for (int it = 0; it < 16; ++it) {
            int lane = lane0; asm volatile("" : "+v"(lane));
            const int sw = (lane >> 1) & 7; const float bias_e = br[(lane >> 1) & 31];
            const GAS f32x4* lgp = (const GAS f32x4*)(INP(13) + l * D) + lane; const GAS f32x4* lbp = (const GAS f32x4*)(INP(14) + l * D) + lane;
            const int tl = F.wave * 16 + it, t = tile * 128 + tl;
            f32x4 v[4]; float s = 0.f;
#pragma unroll
            for (int j = 0; j < 4; ++j) { const unsigned long long ow = po[j]; const unsigned olo = (unsigned)ow, ohi = (unsigned)(ow >> 32);
                f32x4 xv_; if (XBF) { const unsigned xlo = (unsigned)pxb[j], xhi = (unsigned)(pxb[j] >> 32); xv_ = (f32x4){bflo(xlo), bfhi(xlo), bflo(xhi), bfhi(xhi)}; } else xv_ = px[j];
                v[j] = xv_ * DN_ALPHA + (f32x4){bflo(olo), bfhi(olo), bflo(ohi), bfhi(ohi)}; s += (v[j].x + v[j].y) + (v[j].z + v[j].w); }
            if (it + 1 < 16) { const GAS f32x4* xr = (const GAS f32x4*)(xcur + (size_t)(t + 1) * D) + lane; const GAS unsigned long long* orr = (const GAS unsigned long long*)(outb + (size_t)(t + 1) * D) + lane;
#pragma unroll
                for (int j = 0; j < 4; ++j) { if (XBF) pxb[j] = ((const GAS unsigned long long*)(xcb + (size_t)(t + 1) * D) + lane)[64 * j]; else px[j] = xr[64 * j]; po[j] = orr[64 * j]; } }
            const float mean = wave_sum(s, lane) * (1.f / D); float s2 = 0.f;
#pragma unroll
            for (int j = 0; j < 4; ++j) { v[j] = v[j] - mean; s2 += (v[j].x * v[j].x + v[j].y * v[j].y) + (v[j].z * v[j].z + v[j].w * v[j].w); }
            const float rstd = 1.f / sqrtf(wave_sum(s2, lane) * (1.f / D) + LN_EPS);
            GAS unsigned long long* o8 = (GAS unsigned long long*)(x1b + (size_t)t * D) + lane;
#pragma unroll
            for (int j = 0; j < 4; ++j) { v[j] = v[j] * rstd * lgp[64 * j] + lbp[64 * j];
                o8[64 * j] = (unsigned long long)pk2(v[j].x, v[j].y) | ((unsigned long long)pk2(v[j].z, v[j].w) << 32);
                if (w8) ((GAS unsigned*)(x1f8 + (size_t)t * D))[64 * j + lane] = pg8::pk4_fp8(v[j].x * 16.0f, v[j].y * 16.0f, v[j].z * 16.0f, v[j].w * 16.0f); }
            float acc[32];
#pragma unroll
            for (int c = 0; c < 8; ++c) {
                int basec = lane * 128 + ((c ^ sw) << 4); asm volatile("" : "+v"(basec));
                const LAS unsigned char* wp = wl + basec;
                typedef float f32x2p __attribute__((ext_vector_type(2)));
                f32x2p a01 = {0.f, 0.f}, a23 = {0.f, 0.f};
#pragma unroll
                for (int i = 0; i < 4; ++i)
#pragma unroll
                    for (int j = 0; j < 4; ++j) { const f32x4 w = *(const LAS f32x4*)(wp + (i * 256 + 64 * j) * 128); const float xv = v[j][i]; const f32x2p x2 = {xv, xv};
                        a01 = __builtin_elementwise_fma(x2, (f32x2p){w.x, w.y}, a01); a23 = __builtin_elementwise_fma(x2, (f32x2p){w.z, w.w}, a23); }
                acc[4 * c + 0] = a01.x; acc[4 * c + 1] = a01.y; acc[4 * c + 2] = a23.x; acc[4 * c + 3] = a23.y;
            }
            float a16[16], a8[8], a4[4], a2[2], a1;
            { const bool b = (lane & 32) != 0;
#pragma unroll
              for (int i = 0; i < 16; ++i) { const float send = b ? acc[i] : acc[16 + i]; const float keep = b ? acc[16 + i] : acc[i]; a16[i] = keep + shx<32>(send, lane); } }
            { const bool b = (lane & 16) != 0;
#pragma unroll
              for (int i = 0; i < 8; ++i) { const float send = b ? a16[i] : a16[8 + i]; const float keep = b ? a16[8 + i] : a16[i]; a8[i] = keep + shx<16>(send, lane); } }
            { const bool b = (lane & 8) != 0;
#pragma unroll
              for (int i = 0; i < 4; ++i) { const float send = b ? a8[i] : a8[4 + i]; const float keep = b ? a8[4 + i] : a8[i]; a4[i] = keep + shx<8>(send, lane); } }
            { const bool b = (lane & 4) != 0;
#pragma unroll
              for (int i = 0; i < 2; ++i) { const float send = b ? a4[i] : a4[2 + i]; const float keep = b ? a4[2 + i] : a4[i]; a2[i] = keep + shx<4>(send, lane); } }
            { const bool b = (lane & 2) != 0; const float send = b ? a2[0] : a2[1]; const float keep = b ? a2[1] : a2[0]; a1 = keep + shx<2>(send, lane); }
            a1 += shx<1>(a1, lane);
            float val = a1 + bias_e; const int my_e = (lane >> 1) & 31;
            float sv[4]; int se[4];
#pragma unroll
            for (int r = 0; r < 4; ++r) { float bv = val; int be = my_e;
#define TOPK_STEP(O) { const float ov = shx<O>(bv, lane); const int oe = shxi<O>(be, lane); if (ov > bv || (ov == bv && oe < be)) { bv = ov; be = oe; } }
                TOPK_STEP(2) TOPK_STEP(4) TOPK_STEP(8) TOPK_STEP(16) TOPK_STEP(32)
#undef TOPK_STEP
                sv[r] = bv; se[r] = be; if (my_e == be) val = -INFINITY; }
            const float e1 = __expf(sv[1] - sv[0]), e2 = __expf(sv[2] - sv[0]), e3 = __expf(sv[3] - sv[0]); const float rs = 1.0f / (1.0f + e1 + e2 + e3);
            if (lane < 4) { const int ee = lane == 0 ? se[0] : lane == 1 ? se[1] : lane == 2 ? se[2] : se[3]; const float gg = (lane == 0 ? 1.0f : lane == 1 ? e1 : lane == 2 ? e2 : e3) * rs;
                const int a = tl * 4 + lane; sel_e[a] = ee; sel_g[a] = gg; sel_r[a] = __hip_atomic_fetch_add(&hist[ee], 1, __ATOMIC_RELAXED, __HIP_MEMORY_SCOPE_WORKGROUP); }
        }
        __syncthreads();
        if (tid < 32) base[tid] = (int)__hip_atomic_fetch_add(F.ctl + CW_CNT + 64 * l + tid, (unsigned)hist[tid], RLX_AGENT);
        __syncthreads();
        { const int a = tid, e = sel_e[a], rank = base[e] + sel_r[a], t = tile * 128 + (a >> 2);
          list_t[(size_t)e * LCAP + rank] = t; list_g[(size_t)e * LCAP + rank] = sel_g[a]; tok_e[t * 4 + (a & 3)] = e; tok_r[t * 4 + (a & 3)] = rank; }
        __syncthreads();
    }
}

__device__ __forceinline__ void p_gather(Frame& F, int l) {
    const int total = build_tables(F, l);
    LAS int* st = (LAS int*)(F.lds + TBL_START); LAS int* cn = st + 33;
    const bf16* x1b = (const bf16*)(F.ws + WS_X1B); bf16* xg = (bf16*)(F.ws + WS_H); float* sg = (float*)(F.ws + WS_SG);
    const int* list_t = (const int*)(F.ws + WS_LT); const float* list_g = (const float*)(F.ws + WS_LG);
    const int lane = F.lane, gw = F.vcu * NWAVES + F.wave, NGW = F.G * NWAVES;
    for (int s = gw; s < total; s += NGW) {
        const bool pr = (lane < NE) && (s >= st[lane & 31]);
        const int e = __popcll(__ballot(pr)) - 1; const int r = s - st[e];
        GAS v4u* dst = (GAS v4u*)(xg + (size_t)s * D);
        if (r < cn[e]) { const int t = list_t[(size_t)e * LCAP + r]; const GAS v4u* src = (const GAS v4u*)(x1b + (size_t)t * D);
            dst[lane] = src[lane]; dst[64 + lane] = src[64 + lane]; if (lane == 0) sg[s] = list_g[(size_t)e * LCAP + r]; }
        else { unsigned zz = 0u; asm volatile("" : "+v"(zz)); const v4u z4 = {zz, zz, zz, zz}; dst[lane] = z4; dst[64 + lane] = z4; if (lane == 0) sg[s] = 0.f; }
    }
}

__device__ __forceinline__ void p_ln2(Frame& F, int l, float* dst, bool write_f32, bool write_xb) {
    (void)build_tables(F, l);
    LAS int* st = (LAS int*)(F.lds + TBL_START);
    const bf16* x1b = (const bf16*)(F.ws + WS_X1B); const bf16* yb = (const bf16*)(F.ws + WS_H); bf16* xb = (bf16*)(F.ws + WS_XB);
    const int* tok_e = (const int*)(F.ws + WS_TE); const int* tok_r = (const int*)(F.ws + WS_TR);
    const int lane = F.lane, hl = lane & 31, half = lane >> 5, gw = F.vcu * NWAVES + F.wave, NGW = F.G * NWAVES;
    const float* lgp = INP(21) + l * D; const float* lbp = INP(22) + l * D;
    float dmult = 1.0f;
#if MK_DEBUG
    if (l == DEPTH - 1) { const unsigned mask = __hip_atomic_load(F.ctl + 20000, RLX_AGENT) & ~(unsigned)(MK_DBG_IGNORE); if (mask) dmult = 1.0f + (float)(__ffs((int)mask) - 1); }
#endif
    int t = 2 * gw + half;
    int e4 = 0, r4 = 0;
    if (t < T && hl < 4) { e4 = tok_e[t * 4 + hl]; r4 = tok_r[t * 4 + hl]; }
    v4u xn[4] = {{0u, 0u, 0u, 0u}, {0u, 0u, 0u, 0u}, {0u, 0u, 0u, 0u}, {0u, 0u, 0u, 0u}};
    if (t < T) { const GAS v4u* xr = (const GAS v4u*)(x1b + (size_t)t * D) + hl;
#pragma unroll
        for (int q = 0; q < 4; ++q) xn[q] = xr[32 * q]; }
    for (; t < T; t += 2 * NGW) {
        int slot4 = st[e4] + r4;
        const int tn = t + 2 * NGW; int e4n = 0, r4n = 0;
        if (tn < T && hl < 4) { e4n = tok_e[tn * 4 + hl]; r4n = tok_r[tn * 4 + hl]; }
        int slot[4];
#pragma unroll
        for (int k = 0; k < 4; ++k) slot[k] = __builtin_amdgcn_ds_bpermute((half * 32 + k) << 2, slot4);
        v4u xw[4], yw[4][4];
#pragma unroll
        for (int q = 0; q < 4; ++q) xw[q] = xn[q];
        if (tn < T) { const GAS v4u* xr = (const GAS v4u*)(x1b + (size_t)tn * D) + hl;
#pragma unroll
            for (int q = 0; q < 4; ++q) xn[q] = xr[32 * q]; }
#pragma unroll
        for (int k = 0; k < 4; ++k) { const GAS v4u* yr = (const GAS v4u*)(yb + (size_t)slot[k] * D) + hl;
#pragma unroll
            for (int q = 0; q < 4; ++q) yw[k][q] = yr[32 * q]; }
        float v[4][8]; float s = 0.f;
#pragma unroll
        for (int q = 0; q < 4; ++q) {
            v[q][0] = bflo(xw[q].x) * DN_ALPHA; v[q][1] = bfhi(xw[q].x) * DN_ALPHA; v[q][2] = bflo(xw[q].y) * DN_ALPHA; v[q][3] = bfhi(xw[q].y) * DN_ALPHA;
            v[q][4] = bflo(xw[q].z) * DN_ALPHA; v[q][5] = bfhi(xw[q].z) * DN_ALPHA; v[q][6] = bflo(xw[q].w) * DN_ALPHA; v[q][7] = bfhi(xw[q].w) * DN_ALPHA;
#pragma unroll
            for (int k = 0; k < 4; ++k) { v[q][0] += bflo(yw[k][q].x); v[q][1] += bfhi(yw[k][q].x); v[q][2] += bflo(yw[k][q].y); v[q][3] += bfhi(yw[k][q].y);
                v[q][4] += bflo(yw[k][q].z); v[q][5] += bfhi(yw[k][q].z); v[q][6] += bflo(yw[k][q].w); v[q][7] += bfhi(yw[k][q].w); }
#pragma unroll
            for (int i = 0; i < 8; ++i) s += v[q][i]; }
        s += shx<1>(s, lane); s += shx<2>(s, lane); s += shx<4>(s, lane); s += shx<8>(s, lane); s += shx<16>(s, lane);
        const float mean = s * (1.f / D); float s2 = 0.f;
#pragma unroll
        for (int q = 0; q < 4; ++q)
#pragma unroll
            for (int i = 0; i < 8; ++i) { v[q][i] -= mean; s2 += v[q][i] * v[q][i]; }
        s2 += shx<1>(s2, lane); s2 += shx<2>(s2, lane); s2 += shx<4>(s2, lane); s2 += shx<8>(s2, lane); s2 += shx<16>(s2, lane);
        const float rstd = 1.f / sqrtf(s2 * (1.f / D) + LN_EPS);
        GAS f32x4* orow = (GAS f32x4*)(dst + (size_t)t * D) + 2 * hl; GAS v4u* o16 = (GAS v4u*)(xb + (size_t)t * D) + hl;
#pragma unroll
        for (int q = 0; q < 4; ++q) { const GAS f32x4* gq = (const GAS f32x4*)(lgp + 256 * q) + 2 * hl; const GAS f32x4* bq = (const GAS f32x4*)(lbp + 256 * q) + 2 * hl;
            const f32x4 g0 = gq[0], g1 = gq[1], b0 = bq[0], b1 = bq[1];
            f32x4 y0 = {v[q][0] * rstd, v[q][1] * rstd, v[q][2] * rstd, v[q][3] * rstd}, y1 = {v[q][4] * rstd, v[q][5] * rstd, v[q][6] * rstd, v[q][7] * rstd};
            y0 = y0 * g0 + b0; y1 = y1 * g1 + b1;
            if (write_f32) { orow[64 * q] = y0 * dmult; orow[64 * q + 1] = y1 * dmult; }
            if (write_xb) { o16[32 * q] = (v4u){pk2(y0.x, y0.y), pk2(y0.z, y0.w), pk2(y1.x, y1.y), pk2(y1.z, y1.w)};
                if (MK_FP8_LAST && l + 1 == DEPTH - 1) { typedef unsigned u32x2 __attribute__((ext_vector_type(2)));
                    ((GAS u32x2*)(F.ws + WS_X2 + (size_t)t * D))[hl + 32 * q] = (u32x2){pg8::pk4_fp8(y0.x * 16.f, y0.y * 16.f, y0.z * 16.f, y0.w * 16.f), pg8::pk4_fp8(y1.x * 16.f, y1.y * 16.f, y1.z * 16.f, y1.w * 16.f)}; } } }
        e4 = e4n; r4 = r4n;
    }
}

template <int WHICH> __device__ __forceinline__ void p_attention(Frame& F, int l) {
    const bf16* hb = (const bf16*)(F.ws + WS_H); unsigned char* a2 = F.ws + WS_A2;
    const bf16* kB = (const bf16*)(a2 + A2_KB); const bf16* kr = (const bf16*)(a2 + A2_KR); const bf16* qc = (const bf16*)(a2 + A2_QC); const bf16* kvc = (const bf16*)(a2 + A2_KVC);
    bf16* ya = (bf16*)(a2 + A2_YA); bf16* yb = (bf16*)(a2 + A2_YB); bf16* yc = (bf16*)(a2 + A2_YC);
    att::ALAS_PTR lds = (att::ALAS_PTR)F.lds;
    att::NoSide noside;
    __syncthreads();
    if (WHICH == 0) {
        float mq = fabsf((INP(3) + l * 64)[F.lane]), mk = fabsf((INP(4) + l * 64)[F.lane]);
#define MX_STEP(O) { mq = fmaxf(mq, shx<O>(mq, F.lane)); mk = fmaxf(mk, shx<O>(mk, F.lane)); }
        MX_STEP(1) MX_STEP(2) MX_STEP(4) MX_STEP(8) MX_STEP(16) MX_STEP(32)
#undef MX_STEP
        const float cref = __int_as_float(__builtin_amdgcn_readfirstlane(__float_as_int(8.0f * LOG2E_F * 1.03f * mq * mk)));
        const bool fixed_ok = cref < 60.0f;
        unsigned char* wbl = F.ws + WS_W + (size_t)l * WB_LAYER;
        MoeConv cv; cv.Wgu = INP(17) + (size_t)l * NE * 1024 * 2048; cv.Wdn = INP(19) + (size_t)l * NE * 1024 * 1024; cv.Tgu = wbl + WB_GU; cv.Tdn = wbl + WB_DN; cv.f8 = MK_FP8_LAST && (l == DEPTH - 1);
        cv.scr = (LAS float*)(F.lds + CONV_LDS_OFF + F.wave * CONV_LDS_WAVE); cv.lane = F.lane; cv.ngw = F.G * NWAVES; cv.gw = F.vcu * NWAVES + F.wave; cv.s = 0;
        cv.nmini = 4 * ((CONV_ITEMS - cv.gw + cv.ngw - 1) / cv.ngw);
#pragma unroll
        for (int i_ = 0; i_ < 8; ++i_) { cv.cvA[i_] = 0.f; cv.cvB[i_] = 0.f; }
        for (int idx = F.vcu; idx < 768; idx += F.G) {
            const int qi = idx >> 8, rem = idx & 255, bk = rem >> 5, qb = rem & 31, b = bk >> 1, kvh = bk & 1, head = kvh * 3 + qi;
            att::UnitP u; const size_t tb = (size_t)b * SEQ, tq = tb + (size_t)qb * 256;
            u.Q = hb + tq * DINP + H_GQ + head * 64; u.ldq = DINP; u.K0 = kB + tb * 128 + kvh * 64; u.ldk0 = 128; u.K1 = nullptr; u.ldk1 = 0;
            u.V = hb + tb * DINP + H_GV + kvh * 64; u.ldv = DINP; u.O = yb + tq * 384 + head * 64; u.ldo = 384; u.nt = SEQ / 64; u.grow0 = qb * 4; u.gain = INP(3) + l * 64; u.kr0 = 0; u.cref = cref;
            if (fixed_ok) att::attn_unit<64, 0, MoeConv>(u, lds, F.tid, cv); else att::attn_unit<64, 3, MoeConv>(u, lds, F.tid, cv);
        }
        while (!cv.done()) { cv.step<0>(); cv.step<1>(); }
    }
    if (WHICH == 1) for (int idx = F.vcu; idx < 512; idx += F.G) {
        const int rnd = idx >> 8, rem = idx & 255, p = (rem >> 5) * 2 + rnd, qb = rem & 31, b = p >> 2, h = p & 3;
        att::UnitP u; const size_t tb = (size_t)b * SEQ, tq = tb + (size_t)qb * 256;
        u.Q = qc + tq * 384 + h * 96; u.ldq = 384; u.K0 = kvc + tb * 512 + h * 128; u.ldk0 = 512; u.K1 = kr + tb * 32; u.ldk1 = 32;
        u.V = kvc + tb * 512 + h * 128 + 64; u.ldv = 512; u.O = yc + tq * 384 + h * 64; u.ldo = 384; u.nt = SEQ / 64; u.grow0 = qb * 4; u.gain = nullptr; u.kr0 = 0; u.cref = 0.f;
        att::attn_unit<96, 1>(u, lds, F.tid, noside);
    }
    if (WHICH == 2) for (int idx = F.vcu; idx < 768; idx += F.G) {
        const int b = idx / 192, rem = idx % 192, h = rem >> 5, rg = rem & 31, R0 = rg * 4;
        int r_lo = R0 - 4; r_lo = r_lo < 0 ? 0 : (r_lo > 120 ? 120 : r_lo);
        int r_hi = R0 - 1; r_hi = (r_hi < 0 ? 0 : (r_hi > 120 ? 120 : r_hi)) + 8;
        if ((r_hi - r_lo) & 1) { if (r_hi < 128) ++r_hi; else --r_lo; }
        {
            LAS float* bt = (LAS float*)(F.lds + att::OFF_BIAS); const float* rp = INP(2) + ((size_t)l * 6 + h) * 465;
            if (F.tid < 465) bt[F.tid] = rp[F.tid] * LOG2E_F; }
        att::UnitP u; const size_t tb = (size_t)b * SEQ, tq = tb + (size_t)R0 * 64, tk = tb + (size_t)r_lo * 64;
        u.Q = hb + tq * DINP + H_NAQ + h * 64; u.ldq = DINP; u.K0 = hb + tk * DINP + H_NAK + h * 64; u.ldk0 = DINP; u.K1 = nullptr; u.ldk1 = 0;
        u.V = hb + tk * DINP + H_NAV + h * 64; u.ldv = DINP; u.O = ya + tq * 384 + h * 64; u.ldo = 384; u.nt = r_hi - r_lo; u.grow0 = R0; u.gain = nullptr; u.kr0 = r_lo; u.cref = 0.f;
        att::attn_unit<64, 2>(u, lds, F.tid, noside);
    }
}


struct Args { const float* in[23]; float* out; unsigned char* ws; int ph_lo, ph_hi, use_bar, pad; };
__global__ void __launch_bounds__(NWAVES * 64, 2) mk_fwd(Args args) {
    extern __shared__ __attribute__((aligned(16))) unsigned char lds[];
    const int wave_id = __builtin_amdgcn_readfirstlane((int)threadIdx.x >> 6), bx0 = blockIdx.x, G0 = gridDim.x;
    {   LAS unsigned* z = (LAS unsigned*)((LAS unsigned char*)lds + LDSCTL_OFF); for (int u = threadIdx.x; u < (LDS_BYTES - LDSCTL_OFF) / 4; u += NWAVES * 64) z[u] = 0u; }
    __syncthreads();
    XcdBarrier bar; bar.bar = (unsigned*)(args.ws + WS_CTL) + CW_BAR; bar.x = 0; bar.st = nullptr;
    if (args.use_bar) bar = xcd_barrier_post((unsigned*)(args.ws + WS_CTL) + CW_BAR, (volatile LAS unsigned*)((LAS unsigned char*)lds + MISC_OFF));
    const int lo = args.ph_lo, hi = args.ph_hi;
#define IN(k) (lo <= (k) && (k) < hi)
#define REPEAT(n) for (int rep_ = 0; rep_ < (n); ++rep_)
#define RSEAM(n) do { if (rep_ + 1 < (n)) { XcdBarrier b_ = bar; { GAS unsigned* bb_ = (GAS unsigned*)b_.bar; asm volatile("; rseam %1" : "+s"(bb_) : "n"(__COUNTER__)); b_.bar = (unsigned*)bb_; } xcd_barrier(b_); } } while (0)
#define SEAM(k) do { if (IN(k) && IN((k) + 1)) { XcdBarrier b_ = bar; { GAS unsigned* bb_ = (GAS unsigned*)b_.bar; asm volatile("; seam %1" : "+s"(bb_) : "n"(__COUNTER__)); b_.bar = (unsigned*)bb_; } xcd_barrier(b_); } } while (0)
#define FRAME() Frame F = mkframe<__COUNTER__>((LAS unsigned char*)lds, args.ws, args.out, wave_id, bx0, G0); unsigned char* ws = F.ws; unsigned char* a2 = ws + WS_A2; unsigned char* wb = ws + WS_W + (size_t)l * WB_LAYER; (void)a2; (void)wb

    if (IN(0)) REPEAT(REP_P) { Frame F = mkframe<__COUNTER__>((LAS unsigned char*)lds, args.ws, args.out, wave_id, bx0, G0); p_prologue(F); RSEAM(REP_P); } SEAM(0);

    for (int l = 0; l < DEPTH; ++l) {
        const int pb = 1 + l * PPL;
        if (IN(pb + 0)) REPEAT(REP_A) { FRAME();
            pg8::StaticOrder S; S.init(T, DINP, F.G, F.bx);
            if (!(MK_FP8_LAST && l == DEPTH - 1)) {
                pg8::Gemm g{(const bf16*)(ws + WS_XB), (const bf16*)(wb + WB_IN), T, DINP, 1024, 0, 0, nullptr};
                pg8::EpiStore E{(bf16*)(ws + WS_H), DINP, DINP, 1.0f};
                pg8::gemm_phase<pg8::EpiStore, pg8::StaticOrder, true, true>(F.lds, g, S, E, F.tid);
            } else {
                pg8::Gemm g{(const bf16*)(ws + WS_X2), (const bf16*)(wb + WB_IN), T, DINP, 1024, 0, 0, (const void*)ws};
                pg8::EpiStore E{(bf16*)(ws + WS_H), DINP, DINP, 1.0f / 512.0f};
                pg8::gemm_phase<pg8::EpiStore, pg8::StaticOrder, true, true, false, pg8::NoGather, 1>(F.lds, g, S, E, F.tid);
            }
            RSEAM(REP_A);
        } SEAM(pb + 0);
        if (IN(pb + 1)) REPEAT(REP_B) { FRAME(); p_prep(F, l); RSEAM(REP_B); } SEAM(pb + 1);
        if (IN(pb + 2)) REPEAT(REP_C) {
            { FRAME(); pg8::Gemm g{(const bf16*)(a2 + A2_CQN), (const bf16*)(wb + WB_UQ), T, 512, 384, 0, 0, nullptr}; pg8::StaticOrder S; S.init(T, 512, F.G, F.bx);
              pg8::EpiStore E{(bf16*)(a2 + A2_QC), 384, 384, 1.0f};
              pg8::gemm_phase<pg8::EpiStore, pg8::StaticOrder, true, true>(F.lds, g, S, E, F.tid); }
            { FRAME(); pg8::Gemm g{(const bf16*)(a2 + A2_CKVN), (const bf16*)(wb + WB_UKV), T, 512, 256, 0, 0, nullptr}; pg8::StaticOrder S; S.init(T, 512, F.G, F.bx);
              pg8::EpiStore E{(bf16*)(a2 + A2_KVC), 512, 512, 1.0f};
              pg8::gemm_phase<pg8::EpiStore, pg8::StaticOrder, true, true>(F.lds, g, S, E, F.tid); }
            RSEAM(REP_C);
        } SEAM(pb + 2);
        if (IN(pb + 3)) { REPEAT(REP_DG) { FRAME(); p_attention<0>(F, l); RSEAM(REP_DG); } REPEAT(REP_DM) { FRAME(); p_attention<1>(F, l); RSEAM(REP_DM); } REPEAT(REP_DN) { FRAME(); p_attention<2>(F, l); RSEAM(REP_DN); } } SEAM(pb + 3);
        if (IN(pb + 4)) REPEAT(REP_E) { FRAME();
            pg8::Gemm g{(const bf16*)(a2 + A2_YA), (const bf16*)(wb + WB_BA), T, 1024, 384, (size_t)1024 * 384 * 2, (size_t)T * 384 * 2, nullptr};
            pg8::ChainOrder S; S.so.init(T, 1024, F.G, F.bx); S.nch = 3;
            pg8::EpiGateChain E{(const bf16*)(ws + WS_H) + H_GATE, DINP, (bf16*)(a2 + A2_MIXED)};
            pg8::gemm_phase<pg8::EpiGateChain, pg8::ChainOrder, true, true>(F.lds, g, S, E, F.tid);
            RSEAM(REP_E);
        } SEAM(pb + 4);
        if (IN(pb + 5)) REPEAT(REP_F) { FRAME();
            pg8::Gemm g{(const bf16*)(a2 + A2_MIXED), (const bf16*)(wb + WB_OUT), T, 1024, 1024, 0, 0, nullptr}; pg8::StaticOrder S; S.init(T, 1024, F.G, F.bx);
            pg8::EpiStore E{(bf16*)(ws + WS_X1), 1024, 1024, 1.0f};
            pg8::gemm_phase<pg8::EpiStore, pg8::StaticOrder, true, true>(F.lds, g, S, E, F.tid); RSEAM(REP_F);
        } SEAM(pb + 5);
        if (IN(pb + 6)) { FRAME(); if (l == 0) p_ln1_router<false>(F, l, INP(0)); else p_ln1_router<true>(F, l, ws + WS_XB); } SEAM(pb + 6);
        const bool f8l = MK_FP8_LAST && (l == DEPTH - 1);
        if (IN(pb + 7)) REPEAT(REP_I) { FRAME();
            const int total = build_tables(F, l);
            pg8::MoeOrder S{8, (total >> 8) * 8, F.G, F.vcu, (const LAS int*)(F.lds + TBL_TILEE)};
            pg8::MoeGather gs{(const int*)(ws + WS_LT), (const LAS int*)(F.lds + TBL_START), (const LAS int*)(F.lds + TBL_START) + 33, LCAP};
            if (!f8l) {
                pg8::Gemm g{(const bf16*)(ws + WS_X1B), (const bf16*)(wb + WB_GU), total, 2048, 1024, (size_t)2048 * 1024 * 2, 0, nullptr};
                pg8::EpiSwigluT<false> E{(void*)(ws + WS_A2), INP(18) + (size_t)l * NE * 2048, 1.0f, 1.0f};
                pg8::gemm_phase<pg8::EpiSwigluT<false>, pg8::MoeOrder, true, true, true, pg8::MoeGather>(F.lds, g, S, E, F.tid, gs);
            } else {
                pg8::Gemm g{(const bf16*)(ws + WS_X2), (const bf16*)(wb + WB_GU), total, 2048, 1024, (size_t)2048 * 1024, 0, (const void*)ws};
                pg8::EpiSwigluT<true> E{(void*)(ws + WS_A2), INP(18) + (size_t)l * NE * 2048, 1.0f / 1024.0f, 4.0f};
                pg8::gemm_phase<pg8::EpiSwigluT<true>, pg8::MoeOrder, true, true, true, pg8::MoeGather, 1>(F.lds, g, S, E, F.tid, gs);
            }
            RSEAM(REP_I);
        } SEAM(pb + 7);
        if (IN(pb + 8)) REPEAT(REP_J) { FRAME();
            const int total = build_tables(F, l);
            pg8::MoeOrder S{4, (total >> 8) * 4, F.G, F.vcu, (const LAS int*)(F.lds + TBL_TILEE)};
            if (!f8l) {
                pg8::Gemm g{(const bf16*)(ws + WS_A2), (const bf16*)(wb + WB_DN), total, 1024, 1024, (size_t)1024 * 1024 * 2, 0, nullptr};
                pg8::EpiDown E{(bf16*)(ws + WS_H), INP(20) + (size_t)l * NE * 1024, (const float*)(ws + WS_LG), (const LAS int*)(F.lds + TBL_START), (const LAS int*)(F.lds + TBL_START) + 33, LCAP, 1.0f};
                pg8::gemm_phase<pg8::EpiDown, pg8::MoeOrder, true, true>(F.lds, g, S, E, F.tid);
            } else {
                pg8::Gemm g{(const bf16*)(ws + WS_A2), (const bf16*)(wb + WB_DN), total, 1024, 1024, (size_t)1024 * 1024, 0, (const void*)ws};
                pg8::EpiDown E{(bf16*)(ws + WS_H), INP(20) + (size_t)l * NE * 1024, (const float*)(ws + WS_LG), (const LAS int*)(F.lds + TBL_START), (const LAS int*)(F.lds + TBL_START) + 33, LCAP, 1.0f / 512.0f};
                pg8::gemm_phase<pg8::EpiDown, pg8::MoeOrder, true, true, false, pg8::NoGather, 1>(F.lds, g, S, E, F.tid);
            }
            RSEAM(REP_J);
        } SEAM(pb + 8);
        if (IN(pb + 9)) REPEAT(REP_K) { FRAME(); RSEAM(REP_K); p_ln2(F, l, F.out, l == DEPTH - 1, l + 1 < DEPTH); }
        if (l + 1 < DEPTH) SEAM(pb + 9);
    }
#undef IN
#undef SEAM
}


#if MK_DEBUG
constexpr int CW_DBG = 20000;
__device__ __forceinline__ float bfr(float f) { return __uint_as_float(f2bf(f) << 16); }
__device__ __forceinline__ float bfv(const bf16* p) { return __uint_as_float(((unsigned)*p) << 16); }
__device__ __forceinline__ unsigned hsh(unsigned x) { x ^= x >> 16; x *= 0x7feb352du; x ^= x >> 15; x *= 0x846ca68bu; x ^= x >> 16; return x; }
__device__ __forceinline__ bool close_(float got, float ref, float rel, float abs_) { return fabsf(got - ref) <= rel * fabsf(ref) + abs_; }
__device__ __forceinline__ void ropecs(int i, int quarter, int s, float& c, float& sn) {
    const float pos = (i < quarter) ? (float)(s >> 6) : (float)(s & 63); const int m = (i < quarter) ? i : i - quarter;
    const float inv = exp2f(-(float)m / (float)quarter * 13.287712379549449f); const float ang = pos * inv * 0.15915494309189535f; c = __builtin_amdgcn_cosf(ang); sn = __builtin_amdgcn_sinf(ang);
}
#define DBG_FAIL(bit) atomicOr((unsigned*)(ws + WS_CTL) + CW_DBG, 1u << (bit))
template <int stage> __global__ void __launch_bounds__(256) dbg_kernel(Args args) {
    unsigned char* ws = args.ws; const int l = 0;
    const int gid = blockIdx.x * 256 + threadIdx.x;
    const bf16* hb = (const bf16*)(ws + WS_H); unsigned char* a2 = ws + WS_A2; unsigned char* wb = ws + WS_W + (size_t)l * WB_LAYER;
    const bf16* kB = (const bf16*)(a2 + A2_KB); const bf16* cqn = (const bf16*)(a2 + A2_CQN); const bf16* ckvn = (const bf16*)(a2 + A2_CKVN); const bf16* kr = (const bf16*)(a2 + A2_KR);
    const bf16* qc = (const bf16*)(a2 + A2_QC); const bf16* kvc = (const bf16*)(a2 + A2_KVC);
    const bf16* ya = (const bf16*)(a2 + A2_YA); const bf16* yb = (const bf16*)(a2 + A2_YB); const bf16* yc = (const bf16*)(a2 + A2_YC);
    const unsigned h1 = hsh(gid * 2654435761u + 12345u + stage * 977u), h2 = hsh(h1 + 0x9e3779b9u);
    const int t = h1 % T, s = t & (SEQ - 1), b = t / SEQ;
    if (stage == 0) {
        const int n = h2 % DIN; const float* x = args.in[0] + (size_t)t * D; const float* W = args.in[1];
        const float sc = (n < 384) ? 0.125f * LOG2E_F : 1.0f; float r = 0.f;
        for (int k = 0; k < 1024; ++k) r += bfr(x[k]) * bfr(W[(size_t)k * DIN + n] * sc);
        if (!close_(bfv(hb + (size_t)t * DINP + n), r, 0.02f, 0.02f)) DBG_FAIL(1);
    }
    if (stage == 1) {
        const bf16* hr = hb + (size_t)t * DINP;
        {   const int d = h2 % 128, head = d >> 6, dd = d & 63; float ssq = 0.f;
            for (int k = 0; k < 64; ++k) { const float v = bfv(hr + H_GK + head * 64 + k); ssq += v * v; }
            const float rstd = 1.0f / sqrtf(ssq / 64.0f + RMS_EPS); const float* g = args.in[4];
            const int i = dd & 31; const float y1 = bfv(hr + H_GK + head * 64 + i) * rstd * g[i], y2 = bfv(hr + H_GK + head * 64 + i + 32) * rstd * g[i + 32];
            float c, sn; ropecs(i, 16, s, c, sn); const float ref = (dd < 32) ? (y1 * c - y2 * sn) : (y1 * sn + y2 * c);
            if (!close_(bfv(kB + (size_t)t * 128 + d), ref, 0.02f, 0.01f)) DBG_FAIL(2); }
        {   const int d = h2 % 384; float ssq = 0.f; for (int k = 0; k < 384; ++k) { const float v = bfv(hr + H_CQ + k); ssq += v * v; }
            const float ref = bfv(hr + H_CQ + d) / sqrtf(ssq / 384.0f + RMS_EPS) * args.in[5][d];
            if (!close_(bfv(cqn + (size_t)t * 384 + d), ref, 0.02f, 0.01f)) DBG_FAIL(3); }
        {   const int d = h2 % 256; float ssq = 0.f; for (int k = 0; k < 256; ++k) { const float v = bfv(hr + H_CKV + k); ssq += v * v; }
            const float ref = bfv(hr + H_CKV + d) / sqrtf(ssq / 256.0f + RMS_EPS) * args.in[6][d];
            if (!close_(bfv(ckvn + (size_t)t * 256 + d), ref, 0.02f, 0.01f)) DBG_FAIL(4); }
        {   const int d = h2 % 32, i = d & 15; const float x1 = bfv(hr + H_KR + i), x2 = bfv(hr + H_KR + i + 16); float c, sn; ropecs(i, 8, s, c, sn);
            const float ref = (d < 16) ? (x1 * c - x2 * sn) : (x1 * sn + x2 * c);
            if (!close_(bfv(kr + (size_t)t * 32 + d), ref, 0.02f, 0.01f)) DBG_FAIL(5); }
    }
    if (stage == 2) {
        {   const int n = h2 % 384; float r = 0.f; const float sc = 0.10206207261596577f * LOG2E_F;
            for (int k = 0; k < 384; ++k) r += bfv(cqn + (size_t)t * 384 + k) * bfr(args.in[7][(size_t)k * 384 + n] * sc);
            if (!close_(bfv(qc + (size_t)t * 384 + n), r, 0.02f, 0.01f)) DBG_FAIL(6); }
        {   const int n = h2 % 512; float r = 0.f;
            for (int k = 0; k < 256; ++k) r += bfv(ckvn + (size_t)t * 256 + k) * bfr(args.in[8][(size_t)k * 512 + n]);
            if (!close_(bfv(kvc + (size_t)t * 512 + n), r, 0.02f, 0.02f)) DBG_FAIL(7); }
    }
    if (stage == 3) {
        const int gr = s >> 6, gc = s & 63;
        if (gid < 1024) {
            const int h = h2 % 6, dofs = ((h2 >> 8) & 1) * 32; float q[64], o[32];
            _Pragma("unroll") for (int d = 0; d < 64; ++d) { q[d] = bfv(hb + (size_t)t * DINP + H_NAQ + h * 64 + d); }
            _Pragma("unroll") for (int d = 0; d < 32; ++d) o[d] = 0.f;
            int r0 = gr - 4; r0 = r0 < 0 ? 0 : (r0 > 120 ? 120 : r0); int c0 = gc - 8; c0 = c0 < 0 ? 0 : (c0 > 48 ? 48 : c0);
            const float* rp = args.in[2] + (size_t)h * 465; float m = -1e30f, lsum = 0.f;
            for (int pass = 0; pass < 2; ++pass)
                for (int i = 0; i < 8; ++i) for (int j = 0; j < 16; ++j) { const int kr_ = r0 + i, kc = c0 + j; const size_t kt = (size_t)b * SEQ + kr_ * 64 + kc;
                    float sc = 0.f; _Pragma("unroll") for (int d = 0; d < 64; ++d) sc += q[d] * bfv(hb + kt * DINP + H_NAK + h * 64 + d);
                    sc += rp[(kr_ - gr + 7) * 31 + (kc - gc + 15)] * LOG2E_F;
                    if (pass == 0) m = fmaxf(m, sc); else { const float p = exp2f(sc - m); lsum += p; _Pragma("unroll") for (int d = 0; d < 32; ++d) o[d] += p * bfv(hb + kt * DINP + H_NAV + h * 64 + dofs + d); } }
            bool bad = false; _Pragma("unroll") for (int d = 0; d < 32; ++d) bad |= !close_(bfv(ya + (size_t)t * 384 + h * 64 + dofs + d), o[d] / lsum, 0.03f, 0.01f);
            if (bad) DBG_FAIL(8);
        } else if (gid < 1024 + 128) {
            const int head = h2 % 6, kvh = head / 3, dofs = ((h2 >> 8) & 1) * 32; float q[64], o[32]; float ssq = 0.f;
            _Pragma("unroll") for (int d = 0; d < 64; ++d) { q[d] = bfv(hb + (size_t)t * DINP + H_GQ + head * 64 + d); ssq += q[d] * q[d]; }
            _Pragma("unroll") for (int d = 0; d < 32; ++d) o[d] = 0.f;
            const float rstd = 1.0f / sqrtf(ssq / 64.0f + RMS_EPS);
            _Pragma("unroll") for (int d = 0; d < 64; ++d) q[d] = q[d] * rstd * args.in[3][d];
            _Pragma("unroll") for (int i = 0; i < 32; ++i) { float c, sn; ropecs(i, 16, s, c, sn); const float y1 = q[i], y2 = q[i + 32]; q[i] = y1 * c - y2 * sn; q[i + 32] = y1 * sn + y2 * c; }
            _Pragma("unroll") for (int d = 0; d < 64; ++d) q[d] = bfr(q[d] * 0.125f * LOG2E_F);
            float m = -1e30f, lsum = 0.f;
            for (int key = 0; key < SEQ; ++key) { const size_t kt = (size_t)b * SEQ + key; float sc = 0.f;
                _Pragma("unroll") for (int d = 0; d < 64; ++d) sc += q[d] * bfv(kB + kt * 128 + kvh * 64 + d);
                const float mn = fmaxf(m, sc), al = exp2f(m - mn), p = exp2f(sc - mn); m = mn; lsum = lsum * al + p;
                _Pragma("unroll") for (int d = 0; d < 32; ++d) o[d] = o[d] * al + p * bfv(hb + kt * DINP + H_GV + kvh * 64 + dofs + d); }
            bool bad = false; _Pragma("unroll") for (int d = 0; d < 32; ++d) bad |= !close_(bfv(yb + (size_t)t * 384 + head * 64 + dofs + d), o[d] / lsum, 0.03f, 0.003f);
            if (bad) DBG_FAIL(9);
        } else if (gid < 1024 + 256) {
            const int h = h2 % 4, dofs = ((h2 >> 8) & 1) * 32; float q[96], o[32];
            _Pragma("unroll") for (int d = 0; d < 96; ++d) q[d] = bfv(qc + (size_t)t * 384 + h * 96 + d);
            _Pragma("unroll") for (int i = 0; i < 16; ++i) { float c, sn; ropecs(i, 8, s, c, sn); const float y1 = q[64 + i], y2 = q[80 + i]; q[64 + i] = bfr(y1 * c - y2 * sn); q[80 + i] = bfr(y1 * sn + y2 * c); }
            _Pragma("unroll") for (int d = 0; d < 32; ++d) o[d] = 0.f;
            float m = -1e30f, lsum = 0.f;
            for (int key = 0; key < SEQ; ++key) { const size_t kt = (size_t)b * SEQ + key; float sc = 0.f;
                _Pragma("unroll") for (int d = 0; d < 64; ++d) sc += q[d] * bfv(kvc + kt * 512 + h * 128 + d);
                _Pragma("unroll") for (int d = 0; d < 32; ++d) sc += q[64 + d] * bfv(kr + kt * 32 + d);
                const float mn = fmaxf(m, sc), al = exp2f(m - mn), p = exp2f(sc - mn); m = mn; lsum = lsum * al + p;
                _Pragma("unroll") for (int d = 0; d < 32; ++d) o[d] = o[d] * al + p * bfv(kvc + kt * 512 + h * 128 + 64 + dofs + d); }
            bool bad = false; _Pragma("unroll") for (int d = 0; d < 32; ++d) bad |= !close_(bfv(yc + (size_t)t * 384 + h * 64 + dofs + d), o[d] / lsum, 0.03f, 0.003f);
            if (bad) DBG_FAIL(10);
        }
    }
    if (stage == 4) {
        const int n = h2 % 1024; float r = 0.f;
        { float a = 0.f; for (int k = 0; k < 384; ++k) a += bfv(ya + (size_t)t * 384 + k) * bfr(args.in[9][(size_t)k * 1024 + n]); r += a / (1.0f + expf(-bfv(hb + (size_t)t * DINP + H_GATE + n))); }
        { float a = 0.f; for (int k = 0; k < 384; ++k) a += bfv(yb + (size_t)t * 384 + k) * bfr(args.in[10][(size_t)k * 1024 + n]); r += a / (1.0f + expf(-bfv(hb + (size_t)t * DINP + H_GATE + 1024 + n))); }
        { float a = 0.f; for (int k = 0; k < 256; ++k) a += bfv(yc + (size_t)t * 384 + k) * bfr(args.in[11][(size_t)k * 1024 + n]); r += a / (1.0f + expf(-bfv(hb + (size_t)t * DINP + H_GATE + 2048 + n))); }
        if (!close_(bfv((const bf16*)(a2 + A2_MIXED) + (size_t)t * 1024 + n), r, 0.02f, 0.003f)) DBG_FAIL(11);
    }
    if (stage == 5) {
        const int n = h2 % 1024; float r = 0.f; const bf16* mx = (const bf16*)(a2 + A2_MIXED) + (size_t)t * 1024;
        for (int k = 0; k < 1024; ++k) r += bfv(mx + k) * bfr(args.in[12][(size_t)k * 1024 + n]);
        if (!close_(bfv((const bf16*)(ws + WS_X1) + (size_t)t * D + n), r, 0.02f, 0.002f)) DBG_FAIL(12);
    }
    if (stage == 6) {
        const bf16* x1 = (const bf16*)(ws + WS_X1B) + (size_t)t * D; const int* tok_e = (const int*)(ws + WS_TE); const int* tok_r = (const int*)(ws + WS_TR);
        const int* list_t = (const int*)(ws + WS_LT); const float* list_g = (const float*)(ws + WS_LG);
        float lg[32]; _Pragma("unroll") for (int e = 0; e < 32; ++e) lg[e] = args.in[16][e];
        for (int k = 0; k < 1024; ++k) { const float xv = bfv(x1 + k); _Pragma("unroll") for (int e = 0; e < 32; ++e) lg[e] += xv * args.in[15][(size_t)k * 32 + e]; }
        int se[4]; float sv[4]; unsigned used = 0;
        _Pragma("unroll") for (int r = 0; r < 4; ++r) { int be = -1; float bv = -INFINITY; _Pragma("unroll") for (int e = 0; e < 32; ++e) if (!((used >> e) & 1) && lg[e] > bv) { bv = lg[e]; be = e; } se[r] = be; sv[r] = bv; used |= 1u << be; }
        float fifth = -INFINITY; _Pragma("unroll") for (int e = 0; e < 32; ++e) if (!((used >> e) & 1)) fifth = fmaxf(fifth, lg[e]);
        const bool neartie = (sv[3] - fifth) < 3e-2f || (sv[0] - sv[1]) < 3e-2f || (sv[1] - sv[2]) < 3e-2f || (sv[2] - sv[3]) < 3e-2f;
        float den = 0.f; _Pragma("unroll") for (int r = 0; r < 4; ++r) den += expf(sv[r] - sv[0]);
        bool bad = false, badg = false;
        if (!neartie) _Pragma("unroll") for (int r = 0; r < 4; ++r) { const int e = tok_e[t * 4 + r], rk = tok_r[t * 4 + r]; if (e != se[r]) { bad = true; continue; }
            if (rk < 0 || rk >= LCAP || list_t[(size_t)e * LCAP + rk] != t) badg = true; else if (!close_(list_g[(size_t)e * LCAP + rk], expf(sv[r] - sv[0]) / den, 0.03f, 1e-3f)) badg = true; }
        if (bad) DBG_FAIL(13); if (badg) DBG_FAIL(14);
        { float sm = 0.f, sq = 0.f; for (int k = 0; k < 1024; ++k) { const float z = (bfv(x1 + k) - args.in[14][k]) / args.in[13][k]; sm += z; sq += z * z; }
          if (fabsf(sm / 1024.f) > 4e-3f || fabsf(sq / 1024.f - 1.0f) > 2e-2f) DBG_FAIL(19); }
    }
    if (stage >= 7 && stage <= 9) {
        __shared__ int st[33], cn[32];
        if (threadIdx.x == 0) { int a = 0; for (int e2 = 0; e2 < 32; ++e2) { cn[e2] = (int)((const unsigned*)(ws + WS_CTL))[CW_CNT + 64 * l + e2]; st[e2] = a; a += ((cn[e2] + 255) >> 8) << 8; } st[32] = a; }
        __syncthreads();
        const int total = st[32]; const int sl = h1 % total; int e = 0; for (int k = 1; k < 32; ++k) if (sl >= st[k]) e = k; const int r = sl - st[e];
        const int* list_t = (const int*)(ws + WS_LT); const float* list_g = (const float*)(ws + WS_LG); const float* sg = (const float*)(ws + WS_SG);
        if (stage == 7) { int sum = 0; for (int k = 0; k < 32; ++k) sum += cn[k]; if (sum != TK) DBG_FAIL(15); }
        if (stage == 7 && r < cn[e]) {
            const bf16* xg = (const bf16*)(ws + WS_X1B) + (size_t)list_t[(size_t)e * LCAP + r] * D; const int f = h2 % 1024; const float* W = args.in[17] + (size_t)e * 1024 * 2048;
            float g = args.in[18][e * 2048 + f], u = args.in[18][e * 2048 + 1024 + f];
            for (int k = 0; k < 1024; ++k) { const float xv = bfv(xg + k); g += xv * bfr(W[(size_t)k * 2048 + f]); u += xv * bfr(W[(size_t)k * 2048 + 1024 + f]); }
            g = fminf(g, 7.0f); u = fminf(fmaxf(u, -7.0f), 7.0f); const float ref = g / (1.0f + expf(-1.702f * g)) * (u + 1.0f);
            if (!close_(bfv((const bf16*)(ws + WS_A2) + (size_t)sl * 1024 + f), ref, 0.03f, 0.02f)) DBG_FAIL(16);
        }
        if (stage == 8 && r < cn[e]) {
            const bf16* ab = (const bf16*)(ws + WS_A2) + (size_t)sl * 1024; const int n = h2 % 1024; const float* W = args.in[19] + (size_t)e * 1024 * 1024;
            float y = args.in[20][e * 1024 + n]; for (int k = 0; k < 1024; ++k) y += bfv(ab + k) * bfr(W[(size_t)k * 1024 + n]);
            y *= list_g[(size_t)e * LCAP + r];
            if (!close_(bfv((const bf16*)(ws + WS_H) + (size_t)sl * 1024 + n), y, 0.03f, 0.005f)) DBG_FAIL(17);
        }
        if (stage == 9) {
            const bf16* x1 = (const bf16*)(ws + WS_X1B) + (size_t)t * D; const int* tok_e = (const int*)(ws + WS_TE); const int* tok_r = (const int*)(ws + WS_TR);
            const bf16* ybf = (const bf16*)(ws + WS_H); float sm = 0.f, sq = 0.f; const int n = h2 % 1024; float vn = 0.f;
            for (int k = 0; k < 1024; ++k) { float v = DN_ALPHA * bfv(x1 + k); for (int q = 0; q < 4; ++q) v += bfv(ybf + (size_t)(st[tok_e[t * 4 + q]] + tok_r[t * 4 + q]) * D + k); sm += v; sq += v * v; if (k == n) vn = v; }
            const float mean = sm / 1024.f, var = sq / 1024.f - mean * mean; const float ref = (vn - mean) / sqrtf(var + LN_EPS) * args.in[21][n] + args.in[22][n];
            if (!close_(bfv((const bf16*)(ws + WS_XB) + (size_t)t * D + n), ref, 0.01f, 0.01f)) DBG_FAIL(18);
        }
    }
}
static void dbg_launch(int stage, const Args& a, hipStream_t stream) {
    switch (stage) {
#define DBGL(k) case k: hipLaunchKernelGGL(dbg_kernel<k>, dim3(8), dim3(256), 0, stream, a); break;
        DBGL(0) DBGL(1) DBGL(2) DBGL(3) DBGL(4) DBGL(5) DBGL(6) DBGL(7) DBGL(8) DBGL(9)
#undef DBGL
    }
}
#endif

extern "C" void kernel_launch(void* const* d_in, const int* in_sizes, int n_in, void* d_out, int out_size, void* d_ws, size_t ws_size, hipStream_t stream) {
    static int grid = 0;
    if (grid == 0) {
        if (n_in != 23 || in_sizes[0] != T * D || out_size != T * D || ws_size < WS_END) { fprintf(stderr, "kernel_launch: unexpected shapes / workspace (%d inputs, ws %zu, need %zu)\n", n_in, ws_size, (size_t)WS_END); grid = -1; return; }
        int dev = 0, cus = 0, per_cu = 0;
        if (hipGetDevice(&dev) != hipSuccess || hipDeviceGetAttribute(&cus, hipDeviceAttributeMultiprocessorCount, dev) != hipSuccess) { grid = -1; return; }
        if (hipFuncSetAttribute((const void*)mk_fwd, hipFuncAttributeMaxDynamicSharedMemorySize, LDS_BYTES) != hipSuccess) { fprintf(stderr, "kernel_launch: hipFuncSetAttribute failed\n"); grid = -1; return; }
        if (hipOccupancyMaxActiveBlocksPerMultiprocessor(&per_cu, (const void*)mk_fwd, NWAVES * 64, LDS_BYTES) != hipSuccess || per_cu < 1) { fprintf(stderr, "kernel_launch: occupancy query reports %d\n", per_cu); }
        (void)hipGetLastError();
        grid = cus;
    }
    if (grid < 0) return;
    if (hipMemsetAsync((char*)d_ws + WS_CTL, 0, CTL_ZERO_BYTES, stream) != hipSuccess) return;
    Args a{};
    for (int i = 0; i < 23; ++i) a.in[i] = (const float*)d_in[i];
    a.out = (float*)d_out; a.ws = (unsigned char*)d_ws; a.pad = 0;
#if MK_ONE_LAUNCH
    a.ph_lo = 0; a.ph_hi = NPH; a.use_bar = 1;
    hipLaunchKernelGGL(mk_fwd, dim3(grid), dim3(NWAVES * 64), LDS_BYTES, stream, a);
#else
    for (int p = 0; p < NPH; ++p) { a.ph_lo = p; a.ph_hi = p + 1; a.use_bar = 0; hipLaunchKernelGGL(mk_fwd, dim3(grid), dim3(NWAVES * 64), LDS_BYTES, stream, a);
#if MK_DEBUG
        if (p >= 1 && p <= PPL) dbg_launch(p - 1, a, stream);
#endif
    }
#endif
    const hipError_t le = hipPeekAtLastError();
    if (le != hipSuccess) fprintf(stderr, "kernel_launch: launch failed: %s\n", hipGetErrorName(le));
}
```

```cpp
#define MK_DEBUG 0
#define MK_ONE_LAUNCH 1
#include <hip/hip_runtime.h>
#include <hip/hip_bf16.h>
#include <cstdio>
#include <cstdint>
namespace pg8 {
#define PG8_LAS __attribute__((address_space(3)))
typedef unsigned short bf16_t;
typedef short bf16x8 __attribute__((ext_vector_type(8)));
typedef float f32x4 __attribute__((ext_vector_type(4)));
typedef unsigned u32x4 __attribute__((ext_vector_type(4)));
constexpr int BM = 256, BK = 64, HALF = 128, HTB = HALF * BK * 2  , STAGE_BYTES = 8 * HTB, NXCD = 8, WGM = 8;

__host__ __device__ __forceinline__ int lds_byte(int r, int c) { const int st = (r >> 4) * 2 + (c >> 5), rr = r & 15, cc = c & 31, ob = rr * 64 + cc * 2; return st * 1024 + (ob ^ (((ob >> 9) & 1) << 5)); }
__host__ __device__ __forceinline__ void stage_rc(int b, int& R, int& C) { const int st = b / 1024, sb = b % 1024, swz = sb ^ (((sb >> 9) & 1) << 5); R = (st >> 1) * 16 + swz / 64; C = (st & 1) * 32 + (swz % 64) / 2; }
__host__ __device__ __forceinline__ int perm32(int rho) { const int n = rho >> 4, i = rho & 15; return 8 * (i >> 2) + 4 * n + (i & 3); }

struct Unit { int pm, pn, e; };
struct Gemm { const bf16_t* A; const bf16_t* Bt; int M, N, K; size_t bstride; size_t astride; const void* base; };

struct StaticOrder {
    int nM, nN, nwg, G, c;
    __host__ __device__ void init(int M, int N, int G_, int c_) { nM = M / BM; nN = N / BM; nwg = nM * nN; G = G_; c = c_; }
    __host__ __device__ bool next(int i, Unit& u) const {
        const long L = (long)i * G + c; if (L >= nwg) return false;
        int wgid = (int)L; { const int q = nwg / NXCD, r = nwg % NXCD, xcd = wgid % NXCD, off = wgid / NXCD; wgid = (xcd < r ? xcd * (q + 1) : r * (q + 1) + (xcd - r) * q) + off; }
        const int nig = WGM * nN, gid = wgid / nig, fm = gid * WGM, gsz = (nM - fm) < WGM ? (nM - fm) : WGM;
        u.pm = fm + ((wgid % nig) % gsz); u.pn = (wgid % nig) / gsz; u.e = 0; return true;
    }
    __device__ __forceinline__ void a_ready(const Unit&) const {}
    __device__ __forceinline__ void done(const Unit&) const {}
};

__device__ __forceinline__ unsigned cvt_pk_bf16(float lo, float hi) { unsigned r; asm volatile("v_cvt_pk_bf16_f32 %0, %1, %2" : "=v"(r) : "v"(lo), "v"(hi)); return r; }
typedef float f32x2 __attribute__((ext_vector_type(2)));


__device__ __forceinline__ float bf_lo(unsigned w) { return __uint_as_float(w << 16); }
__device__ __forceinline__ float bf_hi(unsigned w) { return __uint_as_float(w & 0xffff0000u); }
__device__ __forceinline__ float sigmoidf_(float z) { return __builtin_amdgcn_rcpf(1.0f + __builtin_amdgcn_exp2f(-1.4426950408889634f * z)); }
__device__ __forceinline__ u32x4 pack8(const f32x4& v0, const f32x4& v1) { u32x4 w; w.x = cvt_pk_bf16(v0[0], v0[1]); w.y = cvt_pk_bf16(v0[2], v0[3]); w.z = cvt_pk_bf16(v1[0], v1[1]); w.w = cvt_pk_bf16(v1[2], v1[3]); return w; }

__device__ __forceinline__ unsigned pk4_fp8(float a, float b, float c, float d) { int r = __builtin_amdgcn_cvt_pk_fp8_f32(a, b, 0, false); r = __builtin_amdgcn_cvt_pk_fp8_f32(c, d, r, true); return (unsigned)r; }
struct EpiStore {
    static constexpr bool PERM = true, AFTER_DRAIN = false, CHAIN = false;
    bf16_t* O; int ldc; int nvalid; float ascale;
    __device__ __forceinline__ void operator()(const f32x4 (&acc)[2][2][4][2], const Unit& u, int wr, int wc, int fr, int fq) const {
        const int row0 = u.pm * BM + wr * 64 + fr, col0 = u.pn * BM + wc * 32 + 8 * fq;
#pragma unroll
        for (int ai = 0; ai < 2; ++ai)
#pragma unroll
            for (int m = 0; m < 4; ++m) { bf16_t* rowp = O + (size_t)(row0 + ai * HALF + m * 16) * ldc + col0;
#pragma unroll
                for (int bj = 0; bj < 2; ++bj) { if (col0 + bj * HALF < nvalid) *(u32x4*)(rowp + bj * HALF) = pack8(acc[ai][bj][m][0] * ascale, acc[ai][bj][m][1] * ascale); } }
    }
};
struct EpiGateChain {
    static constexpr bool PERM = true, AFTER_DRAIN = false, CHAIN = true;
    const bf16_t* gate; int ldg; bf16_t* mixed;
    __device__ __forceinline__ void chain(f32x4 (&acc)[2][2][4][2], const Unit& u, int wr, int wc, int fr, int fq) const {
        const int row0 = u.pm * BM + wr * 64 + fr, col0 = u.pn * BM + wc * 32 + 8 * fq;
#pragma unroll
        for (int ai = 0; ai < 2; ++ai)
#pragma unroll
            for (int m = 0; m < 4; ++m) { const size_t row = (size_t)(row0 + ai * HALF + m * 16);
#pragma unroll
                for (int bj = 0; bj < 2; ++bj) { const int col = col0 + bj * HALF;
                    const u32x4 ga = *(const u32x4*)(gate + row * ldg + u.e * 1024 + col);
                    f32x4 na0 = {1.f + __builtin_amdgcn_exp2f(-1.4426950408889634f * bf_lo(ga.x)), 1.f + __builtin_amdgcn_exp2f(-1.4426950408889634f * bf_hi(ga.x)), 1.f + __builtin_amdgcn_exp2f(-1.4426950408889634f * bf_lo(ga.y)), 1.f + __builtin_amdgcn_exp2f(-1.4426950408889634f * bf_hi(ga.y))};
                    f32x4 na1 = {1.f + __builtin_amdgcn_exp2f(-1.4426950408889634f * bf_lo(ga.z)), 1.f + __builtin_amdgcn_exp2f(-1.4426950408889634f * bf_hi(ga.z)), 1.f + __builtin_amdgcn_exp2f(-1.4426950408889634f * bf_lo(ga.w)), 1.f + __builtin_amdgcn_exp2f(-1.4426950408889634f * bf_hi(ga.w))};
                    f32x4 f0, f1;
#pragma unroll
                    for (int q = 0; q < 4; ++q) { f0[q] = __builtin_amdgcn_rcpf(na0[q]); f1[q] = __builtin_amdgcn_rcpf(na1[q]); }
                    if (u.e < 2) { const u32x4 gb = *(const u32x4*)(gate + row * ldg + (u.e + 1) * 1024 + col);
                        f0[0] *= 1.f + __builtin_amdgcn_exp2f(-1.4426950408889634f * bf_lo(gb.x)); f0[1] *= 1.f + __builtin_amdgcn_exp2f(-1.4426950408889634f * bf_hi(gb.x));
                        f0[2] *= 1.f + __builtin_amdgcn_exp2f(-1.4426950408889634f * bf_lo(gb.y)); f0[3] *= 1.f + __builtin_amdgcn_exp2f(-1.4426950408889634f * bf_hi(gb.y));
                        f1[0] *= 1.f + __builtin_amdgcn_exp2f(-1.4426950408889634f * bf_lo(gb.z)); f1[1] *= 1.f + __builtin_amdgcn_exp2f(-1.4426950408889634f * bf_hi(gb.z));
                        f1[2] *= 1.f + __builtin_amdgcn_exp2f(-1.4426950408889634f * bf_lo(gb.w)); f1[3] *= 1.f + __builtin_amdgcn_exp2f(-1.4426950408889634f * bf_hi(gb.w)); }
                    acc[ai][bj][m][0] *= f0; acc[ai][bj][m][1] *= f1;
                    if (u.e == 2) *(u32x4*)(mixed + row * 1024 + col) = pack8(acc[ai][bj][m][0], acc[ai][bj][m][1]); } }
    }
};
struct ChainOrder {
    StaticOrder so; int nch;
    __device__ __forceinline__ bool next(int i, Unit& u) const { const int t = i / nch; if (!so.next(t, u)) return false; u.e = i - t * nch; return true; }
    __device__ __forceinline__ void a_ready(const Unit&) const {}
    __device__ __forceinline__ void done(const Unit&) const {}
};
struct EpiResid {
    static constexpr bool PERM = true, AFTER_DRAIN = false, CHAIN = false;
    const float* x; float* pre; float alpha;
    __device__ __forceinline__ void operator()(const f32x4 (&acc)[2][2][4][2], const Unit& u, int wr, int wc, int fr, int fq) const {
        const int row0 = u.pm * BM + wr * 64 + fr, col0 = u.pn * BM + wc * 32 + 8 * fq;
#pragma unroll
        for (int ai = 0; ai < 2; ++ai)
#pragma unroll
            for (int m = 0; m < 4; ++m) { const size_t row = (size_t)(row0 + ai * HALF + m * 16);
#pragma unroll
                for (int bj = 0; bj < 2; ++bj) { const size_t off = row * 1024 + col0 + bj * HALF;
                    const f32x4 x0 = *(const f32x4*)(x + off), x1 = *(const f32x4*)(x + off + 4);
                    *(f32x4*)(pre + off) = x0 * alpha + acc[ai][bj][m][0]; *(f32x4*)(pre + off + 4) = x1 * alpha + acc[ai][bj][m][1]; } }
    }
};
template <bool OUT8> struct EpiSwigluT {
    static constexpr bool PERM = true, AFTER_DRAIN = false, CHAIN = false;
    void* a; const float* bias; float ascale, oscale;
    __device__ __forceinline__ void operator()(const f32x4 (&acc)[2][2][4][2], const Unit& u, int wr, int wc, int fr, int fq) const {
        const int row0 = u.pm * BM + wr * 64 + fr, j0 = wc * 32 + 8 * fq, oc = u.pn * HALF + j0;
        const float* bg = bias + (size_t)u.e * 2048 + oc; const float* bu = bg + 1024;
        const f32x4 bg0 = *(const f32x4*)bg, bg1 = *(const f32x4*)(bg + 4), bu0 = *(const f32x4*)bu, bu1 = *(const f32x4*)(bu + 4);
#pragma unroll
        for (int ai = 0; ai < 2; ++ai)
#pragma unroll
            for (int m = 0; m < 4; ++m) { const size_t row = (size_t)(row0 + ai * HALF + m * 16);
                f32x4 g[2] = {acc[ai][0][m][0] * ascale + bg0, acc[ai][0][m][1] * ascale + bg1}, uu[2] = {acc[ai][1][m][0] * ascale + bu0, acc[ai][1][m][1] * ascale + bu1}, r[2];
#pragma unroll
                for (int n = 0; n < 2; ++n)
#pragma unroll
                    for (int q = 0; q < 4; ++q) { const float gg = fminf(g[n][q], 7.0f), uc = fminf(fmaxf(uu[n][q], -7.0f), 7.0f);
                        r[n][q] = gg * sigmoidf_(1.702f * gg) * (uc + 1.0f); }
                if constexpr (OUT8) { typedef unsigned u32x2 __attribute__((ext_vector_type(2)));
                    *(u32x2*)((unsigned char*)a + row * 1024 + oc) = (u32x2){pk4_fp8(r[0][0] * oscale, r[0][1] * oscale, r[0][2] * oscale, r[0][3] * oscale), pk4_fp8(r[1][0] * oscale, r[1][1] * oscale, r[1][2] * oscale, r[1][3] * oscale)}; }
                else *(u32x4*)((bf16_t*)a + row * 1024 + oc) = pack8(r[0], r[1]);
                asm volatile("" ::: "memory"); }
    }
};
struct EpiDown {
    static constexpr bool PERM = true, AFTER_DRAIN = false, CHAIN = false;
    bf16_t* y; const float* bias; const float* list_g; const PG8_LAS int* st; const PG8_LAS int* cn; int lcap; float ascale;
    __device__ __forceinline__ void operator()(const f32x4 (&acc)[2][2][4][2], const Unit& u, int wr, int wc, int fr, int fq) const {
        const int row0 = u.pm * BM + wr * 64 + fr, col0 = u.pn * BM + wc * 32 + 8 * fq;
        const int st_e = st[u.e], cn_e = cn[u.e];
        f32x4 bv[2][2];
#pragma unroll
        for (int bj = 0; bj < 2; ++bj)
#pragma unroll
            for (int n = 0; n < 2; ++n) bv[bj][n] = *(const f32x4*)(bias + (size_t)u.e * 1024 + col0 + bj * HALF + 4 * n);
#pragma unroll
        for (int ai = 0; ai < 2; ++ai)
#pragma unroll
            for (int m = 0; m < 4; ++m) { const size_t row = (size_t)(row0 + ai * HALF + m * 16); const int rank = (int)row - st_e;
                const float gt = rank < cn_e ? list_g[(size_t)u.e * lcap + rank] : 0.f;
#pragma unroll
                for (int bj = 0; bj < 2; ++bj) { const f32x4 v0 = (acc[ai][bj][m][0] * ascale + bv[bj][0]) * gt, v1 = (acc[ai][bj][m][1] * ascale + bv[bj][1]) * gt;
                    *(u32x4*)(y + row * 1024 + col0 + bj * HALF) = pack8(v0, v1); } }
    }
};
struct MoeGather {
    const int* list_t; const PG8_LAS int* st; const PG8_LAS int* cn; int lcap;
    __device__ __forceinline__ int row(const Unit& u, int r) const { int rank = u.pm * BM + r - st[u.e]; const int c = cn[u.e]; rank = rank < c ? rank : c - 1; return list_t[(size_t)u.e * lcap + rank]; }
};
struct MoeOrder {
    int nN, nunits, G, c; const PG8_LAS int* tile_e;
    __device__ __forceinline__ bool next(int i, Unit& u) const {
        const long L = (long)i * G + c; if (L >= nunits) return false;
        const int tile = (int)L / nN; u.pm = tile; u.pn = (int)L % nN; u.e = __builtin_amdgcn_readfirstlane(tile_e[tile]); return true;
    }
    __device__ __forceinline__ void a_ready(const Unit&) const {}
    __device__ __forceinline__ void done(const Unit&) const {}
};

template <int ES> struct PtSel { typedef const char* T; static __device__ __forceinline__ T mk(const char* p, const char*) { return p; } };
template <> struct PtSel<1> { typedef unsigned T; static __device__ __forceinline__ T mk(const char* p, const char* base) { return (unsigned)(size_t)(p - base); } };
struct NoGather { };
typedef int i32x8 __attribute__((ext_vector_type(8)));
template <class Epi, class Sched, bool ALIGN_EPI = false, bool SP2 = false, bool GATHER = false, class GS = NoGather, int ESIZE = 2>
__device__ __forceinline__ void gemm_phase(PG8_LAS unsigned char* lds, const Gemm g, const Sched& S, const Epi& E, const int tid, const GS gs = GS()) {
    const int wid = __builtin_amdgcn_readfirstlane(tid >> 6), lane = tid & 63, wr = wid >> 2, wc = wid & 3, fr = lane & 15, fq = lane >> 4;
    const int K = g.K * ESIZE / 2; int nt = K / BK;
    if constexpr (ESIZE == 1) asm volatile("" : "+s"(nt));
    int sc8 = 0x7F7F7F7F; if constexpr (ESIZE == 1) asm volatile("" : "+v"(sc8));
    typedef typename PtSel<ESIZE>::T PT;
    __amdgpu_buffer_rsrc_t rsrc = __builtin_amdgcn_make_buffer_rsrc((void*)g.base, 0, 0x7fffffff, 0x00020000);
#define PG8_PT(p) PtSel<ESIZE>::mk((const char*)(p), (const char*)g.base)
    unsigned voffA[2], voffB[2];
#pragma unroll
    for (int i = 0; i < 2; ++i) { int R, C; stage_rc(tid * 16 + i * 8192, R, C); const int Rb = Epi::PERM ? ((R & ~31) + perm32(R & 31)) : R;
        voffA[i] = (unsigned)(R * K + C) * 2u; voffB[i] = (unsigned)(Rb * K + C) * 2u; }
    unsigned vc0[2], vc1[2], vn0[2], vn1[2];
#define PG8_GROWS(u_, o0, o1) do { _Pragma("unroll") for (int i_ = 0; i_ < 2; ++i_) { int R_, C_; stage_rc(tid * 16 + i_ * 8192, R_, C_); \
        o0[i_] = (unsigned)gs.row((u_), R_) * (unsigned)(K * 2) + (unsigned)(C_ * 2); o1[i_] = (unsigned)gs.row((u_), HALF + R_) * (unsigned)(K * 2) + (unsigned)(C_ * 2); } } while (0)
    const size_t kstep = (size_t)(BK * 2);
    const size_t hstep = (size_t)HALF * K * 2;
    const size_t tstep = 2 * hstep;
    const unsigned ldsw = (unsigned)wid * 1024u;
    const int aoff = lds_byte(wr * 64 + fr, fq * 8), boff = lds_byte(wc * 32 + fr, fq * 8);
#define PG8_SA(b, h) (((b) * 2 + (h)) * HTB)
#define PG8_SB(b, h) ((4 + (b) * 2 + (h)) * HTB)
#define PG8_STAGE(bufoff, gbase, voff) do { _Pragma("unroll") for (int _i = 0; _i < 2; ++_i) { \
        if constexpr (ESIZE == 2) __builtin_amdgcn_global_load_lds((const unsigned*)((const char*)(size_t)(gbase) + (voff)[_i]), (PG8_LAS unsigned*)(lds + (bufoff) + ldsw + _i * 8192), 16, 0, 0); \
        else __builtin_amdgcn_raw_ptr_buffer_load_lds(rsrc, (PG8_LAS void*)(lds + (bufoff) + ldsw + _i * 8192), 16, (int)(voff)[_i], (int)(size_t)(gbase), 0, 0); } } while (0)
typedef int i32x4_ __attribute__((ext_vector_type(4)));
#define PG8_LD8(off) __builtin_shufflevector(*(const PG8_LAS i32x4_*)(lds + (off)), *(const PG8_LAS i32x4_*)(lds + (off) + 1024), 0, 1, 2, 3, 4, 5, 6, 7)
#define PG8_LDA(dst, b, h) do { if constexpr (ESIZE == 2) { _Pragma("unroll") for (int m = 0; m < 4; ++m) _Pragma("unroll") for (int k = 0; k < 2; ++k) dst[m][k] = *(const PG8_LAS bf16x8*)(lds + PG8_SA(b, h) + aoff + m * 2048 + k * 1024); } \
        else { _Pragma("unroll") for (int m = 0; m < 4; ++m) dst##8[m] = PG8_LD8(PG8_SA(b, h) + aoff + m * 2048); } } while (0)
#define PG8_LDB(dst, b, h) do { if constexpr (ESIZE == 2) { _Pragma("unroll") for (int n = 0; n < 2; ++n) _Pragma("unroll") for (int k = 0; k < 2; ++k) dst[n][k] = *(const PG8_LAS bf16x8*)(lds + PG8_SB(b, h) + boff + n * 2048 + k * 1024); } \
        else { _Pragma("unroll") for (int n = 0; n < 2; ++n) dst##8[n] = PG8_LD8(PG8_SB(b, h) + boff + n * 2048); } } while (0)
#define PG8_F8CAT(x, y) (i32x8){((const int*)&(x))[0], ((const int*)&(x))[1], ((const int*)&(x))[2], ((const int*)&(x))[3], ((const int*)&(y))[0], ((const int*)&(y))[1], ((const int*)&(y))[2], ((const int*)&(y))[3]}
#define PG8_MMA(ai, bj, At, Bt) do { __builtin_amdgcn_s_setprio(1); if constexpr (ESIZE == 2) { _Pragma("unroll") for (int m = 0; m < 4; ++m) _Pragma("unroll") for (int n = 0; n < 2; ++n) _Pragma("unroll") for (int k = 0; k < 2; ++k) \
        acc[ai][bj][m][n] = __builtin_amdgcn_mfma_f32_16x16x32_bf16(Bt[n][k], At[m][k], acc[ai][bj][m][n], 0, 0, 0); } \
        else { _Pragma("unroll") for (int m = 0; m < 4; ++m) _Pragma("unroll") for (int n = 0; n < 2; ++n) \
        asm volatile("v_mfma_scale_f32_16x16x128_f8f6f4 %0, %1, %2, %0, %3, %3 op_sel_hi:[0,0,0]" : "+v"(acc[ai][bj][m][n]) : "v"(Bt##8[n]), "v"(At##8[m]), "v"(sc8)); \
        }   \
        __builtin_amdgcn_s_setprio(0); } while (0)
#define PG8_WAIT_V(n) asm volatile("s_waitcnt vmcnt(" #n ")" ::: "memory")
#define PG8_WAIT_L(n) asm volatile("s_waitcnt lgkmcnt(" #n ")" ::: "memory")
#define PG8_BAR __builtin_amdgcn_s_barrier()
#define PG8_SCHED __builtin_amdgcn_sched_barrier(0)
    Unit cur, nxt; int ui = 0;
    if (!S.next(0, cur)) return;
    f32x4 acc[2][2][4][2];
#pragma unroll
    for (int a = 0; a < 2; ++a)
#pragma unroll
        for (int b = 0; b < 2; ++b)
#pragma unroll
            for (int m = 0; m < 4; ++m)
#pragma unroll
                for (int n = 0; n < 2; ++n) acc[a][b][m][n] = (f32x4){0.f, 0.f, 0.f, 0.f};
    bf16x8 At[4][2], B0[2][2], B1[2][2];
    i32x8 At8[4], B08[2], B18[2];
    PT cA = PG8_PT(GATHER ? (const char*)g.A : (const char*)g.A + (size_t)cur.pm * tstep + (size_t)cur.e * g.astride);
    if constexpr (GATHER) { PG8_GROWS(cur, vc0, vc1); } else { _Pragma("unroll") for (int i = 0; i < 2; ++i) { vc0[i] = voffA[i]; vc1[i] = voffA[i] + (unsigned)hstep; } }
#pragma unroll
    for (int i = 0; i < 2; ++i) { vn0[i] = vc0[i]; vn1[i] = vc1[i]; }
    PT cB = PG8_PT((const char*)g.Bt + (size_t)cur.pn * tstep + (size_t)cur.e * g.bstride);
    S.a_ready(cur);
    if constexpr (SP2) {
        PG8_STAGE(PG8_SB(0, 0), cB, voffB); PG8_STAGE(PG8_SB(0, 1), cB + hstep, voffB); PG8_STAGE(PG8_SA(0, 0), cA, vc0); PG8_STAGE(PG8_SA(0, 1), cA, vc1);
        if (wr == 1) PG8_BAR;
        PG8_WAIT_V(2); PG8_BAR;
        PG8_STAGE(PG8_SB(1, 0), cB + kstep, voffB); PG8_STAGE(PG8_SA(1, 0), cA + kstep, vc0); PG8_STAGE(PG8_SB(1, 1), cB + hstep + kstep, voffB);
        PG8_WAIT_V(6); PG8_BAR;
    } else {
        PG8_STAGE(PG8_SB(0, 0), cB, voffB); PG8_STAGE(PG8_SA(0, 0), cA, vc0); PG8_STAGE(PG8_SB(0, 1), cB + hstep, voffB); PG8_STAGE(PG8_SA(0, 1), cA, vc1);
        if (wr == 1) PG8_BAR;
        PG8_WAIT_V(4); PG8_BAR;
        PG8_STAGE(PG8_SB(1, 0), cB + kstep, voffB); PG8_STAGE(PG8_SA(1, 0), cA + kstep, vc0); PG8_STAGE(PG8_SB(1, 1), cB + hstep + kstep, voffB);
        PG8_WAIT_V(6); PG8_BAR;
    }
    for (;;) {
        const bool has_next = S.next(ui + 1, nxt);
        const PT nA = GATHER ? cA : (has_next ? PG8_PT((const char*)g.A + (size_t)nxt.pm * tstep + (size_t)nxt.e * g.astride) : cA);
        if constexpr (GATHER) { if (has_next) { PG8_GROWS(nxt, vn0, vn1); } } const PT nB = has_next ? PG8_PT((const char*)g.Bt + (size_t)nxt.pn * tstep + (size_t)nxt.e * g.bstride) : cB;
        for (int t = 0; t < nt; t += 2) {
            const bool last = (t == nt - 2);
            const PT a1 = cA + (unsigned)((t + 1) * (int)kstep);
            const PT a2 = last ? nA : cA + (unsigned)((t + 2) * (int)kstep); const PT b2 = last ? nB : cB + (unsigned)((t + 2) * (int)kstep);
            const PT a3 = a2 + (unsigned)kstep; const PT b3 = b2 + (unsigned)kstep;
            unsigned vs0[2], vs1[2];
#pragma unroll
            for (int i = 0; i < 2; ++i) { vs0[i] = (GATHER && last) ? vn0[i] : vc0[i]; vs1[i] = (GATHER && last) ? vn1[i] : vc1[i]; }
            if (last && has_next) S.a_ready(nxt);
            if constexpr (SP2) {
            PG8_LDB(B0, 0, 0); PG8_LDB(B1, 0, 1); PG8_SCHED; PG8_LDA(At, 0, 0); PG8_STAGE(PG8_SA(1, 1), a1, vc1);
            PG8_WAIT_V(8); PG8_WAIT_L(0); PG8_BAR; PG8_MMA(0, 0, At, B0); PG8_MMA(0, 1, At, B1); PG8_BAR; PG8_SCHED;
            PG8_LDA(At, 0, 1); PG8_STAGE(PG8_SB(0, 0), b2, voffB); PG8_STAGE(PG8_SB(0, 1), b2 + hstep, voffB); PG8_STAGE(PG8_SA(0, 0), a2, vs0);
            PG8_WAIT_V(8); PG8_WAIT_L(0); PG8_BAR; PG8_MMA(1, 0, At, B0); PG8_MMA(1, 1, At, B1); PG8_BAR; PG8_SCHED;
            PG8_LDB(B0, 1, 0); PG8_LDB(B1, 1, 1); PG8_SCHED; PG8_LDA(At, 1, 0); PG8_STAGE(PG8_SA(0, 1), a2, vs1);
            PG8_WAIT_V(8); PG8_WAIT_L(0); PG8_BAR; PG8_MMA(0, 0, At, B0); PG8_MMA(0, 1, At, B1); PG8_BAR; PG8_SCHED;
            PG8_LDA(At, 1, 1); PG8_STAGE(PG8_SB(1, 0), b3, voffB); PG8_STAGE(PG8_SB(1, 1), b3 + hstep, voffB); PG8_STAGE(PG8_SA(1, 0), a3, vs0);
            PG8_WAIT_V(8); PG8_WAIT_L(0); PG8_BAR; PG8_MMA(1, 0, At, B0); PG8_MMA(1, 1, At, B1); PG8_BAR; PG8_SCHED;
            } else {
            PG8_LDB(B0, 0, 0); PG8_SCHED; PG8_LDA(At, 0, 0); PG8_STAGE(PG8_SA(1, 1), a1, vc1);
            PG8_WAIT_L(8); PG8_BAR; PG8_WAIT_L(0); PG8_MMA(0, 0, At, B0); PG8_BAR; PG8_SCHED;
            PG8_LDB(B1, 0, 1); PG8_STAGE(PG8_SB(0, 0), b2, voffB);
            PG8_BAR; PG8_WAIT_L(0); PG8_MMA(0, 1, At, B1); PG8_BAR;
            PG8_LDA(At, 0, 1); PG8_STAGE(PG8_SA(0, 0), a2, vs0);
            PG8_BAR; PG8_WAIT_L(0); PG8_MMA(1, 0, At, B0); PG8_BAR; PG8_SCHED;
            PG8_STAGE(PG8_SB(0, 1), b2 + hstep, voffB);
            PG8_WAIT_V(6); PG8_BAR; PG8_MMA(1, 1, At, B1); PG8_BAR;
            PG8_LDB(B0, 1, 0); PG8_SCHED; PG8_LDA(At, 1, 0); PG8_STAGE(PG8_SA(0, 1), a2, vs1);
            PG8_WAIT_L(8); PG8_BAR; PG8_WAIT_L(0); PG8_MMA(0, 0, At, B0); PG8_BAR; PG8_SCHED;
            PG8_LDB(B1, 1, 1); PG8_STAGE(PG8_SB(1, 0), b3, voffB);
            PG8_BAR; PG8_WAIT_L(0); PG8_MMA(0, 1, At, B1); PG8_BAR;
            PG8_LDA(At, 1, 1); PG8_STAGE(PG8_SA(1, 0), a3, vs0);
            PG8_BAR; PG8_WAIT_L(0); PG8_MMA(1, 0, At, B0); PG8_BAR; PG8_SCHED;
            PG8_STAGE(PG8_SB(1, 1), b3 + hstep, voffB);
            PG8_WAIT_V(6); PG8_BAR; PG8_MMA(1, 1, At, B1); PG8_BAR;
            }
        }
        if constexpr (ESIZE == 1) asm volatile("s_nop 15\n\ts_nop 15" ::: "memory");
        if constexpr (ALIGN_EPI) { if (wr == 0) PG8_BAR; }
        if constexpr (!Epi::AFTER_DRAIN) { if constexpr (Epi::CHAIN) E.chain(acc, cur, wr, wc, fr, fq); else E(acc, cur, wr, wc, fr, fq); S.done(cur); }
        if (!has_next) break;
        if (!(Epi::CHAIN && nxt.e != 0)) {
#pragma unroll
        for (int a = 0; a < 2; ++a)
#pragma unroll
            for (int b = 0; b < 2; ++b)
#pragma unroll
                for (int m = 0; m < 4; ++m)
#pragma unroll
                    for (int n = 0; n < 2; ++n) acc[a][b][m][n] = (f32x4){0.f, 0.f, 0.f, 0.f};
        }
        cur = nxt; cA = nA; cB = nB; ++ui;
        if constexpr (GATHER) { _Pragma("unroll") for (int i = 0; i < 2; ++i) { vc0[i] = vn0[i]; vc1[i] = vn1[i]; } }
        if constexpr (ALIGN_EPI) { if (wr == 1) PG8_BAR; }
    }
    PG8_WAIT_V(0);
    if constexpr (!ALIGN_EPI) { if (wr == 0) PG8_BAR; }
    PG8_BAR;
    if constexpr (Epi::AFTER_DRAIN) { E.fused(acc, cur, wr, wc, fr, fq, lds, wid, lane); S.done(cur); }
#undef PG8_GROWS
#undef PG8_PT
#undef PG8_SA
#undef PG8_SB
#undef PG8_STAGE
#undef PG8_LDA
#undef PG8_LD8
#undef PG8_LDB
#undef PG8_MMA
#undef PG8_F8CAT
#undef PG8_WAIT_V
#undef PG8_WAIT_L
#undef PG8_BAR
#undef PG8_SCHED
}
}


namespace att {
typedef unsigned short bf16_t;
typedef short bf16x8 __attribute__((ext_vector_type(8)));
typedef short s16x4 __attribute__((ext_vector_type(4)));
typedef float f32x16 __attribute__((ext_vector_type(16)));
typedef unsigned u32x4 __attribute__((ext_vector_type(4)));
#define ALAS __attribute__((address_space(3)))
typedef ALAS unsigned char* ALAS_PTR;
#define ASBAR() __builtin_amdgcn_sched_barrier(0)
constexpr int QBLK = 32, KVBLK = 64;
constexpr float THR2 = 11.0f;
constexpr float LOG2E = 1.4426950408889634f, INV2PI = 0.15915494309189535f, LOG2_THETA = 13.287712379549449f;
constexpr int OFF_V = 0, VBUF = 8192, OFF_K = 16384, KBUF_MAX = 13312, OFF_WS = OFF_K + 2 * KBUF_MAX  , OFF_BIAS = OFF_WS + 2048  , ATT_LDS = OFF_BIAS + 2048;
__device__ __forceinline__ int crow(int r, int hi) { return (r & 3) + 8 * (r >> 2) + 4 * hi; }
__device__ __forceinline__ unsigned cvtpk(float lo, float hi) { unsigned r; asm volatile("v_cvt_pk_bf16_f32 %0, %1, %2" : "=v"(r) : "v"(lo), "v"(hi)); return r; }
__device__ __forceinline__ float bf2f(short s) { return __uint_as_float(((unsigned)(unsigned short)s) << 16); }
__device__ __forceinline__ short f2bf_s(float f) { return (short)(cvtpk(f, 0.f) & 0xffffu); }

struct UnitP {
    const bf16_t* Q; int ldq;
    const bf16_t* K0; int ldk0;
    const bf16_t* K1; int ldk1;
    const bf16_t* V; int ldv;
    bf16_t* O; int ldo;
    int nt;
    int grow0;
    const float* gain;
    int kr0;
    float cref;
};

typedef short v4i16_t __attribute__((ext_vector_type(4)));
__device__ __forceinline__ s16x4 vtr(const ALAS unsigned char* p) { return __builtin_bit_cast(s16x4, __builtin_amdgcn_ds_read_tr16_b64_v4i16((ALAS v4i16_t*)p)); }
__device__ __forceinline__ void pv_all(f32x16& o0, f32x16& o1, f32x16& lacc, const ALAS unsigned char* vp, bf16x8 pa0, bf16x8 pa1, bf16x8 pa2, bf16x8 pa3) {
    const bf16x8 ones = {(short)0x3F80, (short)0x3F80, (short)0x3F80, (short)0x3F80, (short)0x3F80, (short)0x3F80, (short)0x3F80, (short)0x3F80};
#define ATT_PK(L, H) (bf16x8){L[0], L[1], L[2], L[3], H[0], H[1], H[2], H[3]}
#define ATT_STEP(KS, PA) { const s16x4 l0 = vtr(vp + (KS) * 1024), h0 = vtr(vp + (KS) * 1024 + 512), l1 = vtr(vp + 4096 + (KS) * 1024), h1 = vtr(vp + 4096 + (KS) * 1024 + 512); \
        o0 = __builtin_amdgcn_mfma_f32_32x32x16_bf16(PA, ATT_PK(l0, h0), o0, 0, 0, 0); o1 = __builtin_amdgcn_mfma_f32_32x32x16_bf16(PA, ATT_PK(l1, h1), o1, 0, 0, 0); \
        lacc = __builtin_amdgcn_mfma_f32_32x32x16_bf16(PA, ones, lacc, 0, 0, 0); }
    ATT_STEP(0, pa0) ATT_STEP(1, pa1) ATT_STEP(2, pa2) ATT_STEP(3, pa3)
#undef ATT_STEP
#undef ATT_PK
}
template <int DQK> __device__ __forceinline__ void qkt(f32x16& p0, f32x16& p1, const ALAS unsigned char* Ks, const bf16x8* qr, const f32x16& cinit, int r32, int hi) {
    constexpr int KST = DQK * 2 + 16;
#pragma unroll
    for (int d0 = 0; d0 < DQK / 16; ++d0) { const int cb = (2 * d0 + hi) * 16;
        const bf16x8 b0 = *(const ALAS bf16x8*)(Ks + r32 * KST + cb);
        const bf16x8 b1 = *(const ALAS bf16x8*)(Ks + (32 + r32) * KST + cb);
        if (d0 == 0) { p0 = __builtin_amdgcn_mfma_f32_32x32x16_bf16(b0, qr[0], cinit, 0, 0, 0); p1 = __builtin_amdgcn_mfma_f32_32x32x16_bf16(b1, qr[0], cinit, 0, 0, 0); }
        else { p0 = __builtin_amdgcn_mfma_f32_32x32x16_bf16(b0, qr[d0], p0, 0, 0, 0); p1 = __builtin_amdgcn_mfma_f32_32x32x16_bf16(b1, qr[d0], p1, 0, 0, 0); } }
}
__device__ __forceinline__ void na_mask(f32x16& p0, f32x16& p1, const ALAS float* btab, int kr, int rq, int qc_in, int hi_in) {
    int qc = qc_in, hi = hi_in; asm volatile("" : "+v"(qc), "+v"(hi));
    int r0 = rq - 4; r0 = r0 < 0 ? 0 : (r0 > 120 ? 120 : r0);
    const bool rowok = (kr >= r0) && (kr < r0 + 8);
    int c0 = qc - 8; c0 = c0 < 0 ? 0 : (c0 > 48 ? 48 : c0);
    int dr = kr - rq + 7; dr = dr < 0 ? 0 : (dr > 14 ? 14 : dr);
    const ALAS float* brow = btab + dr * 31;
#pragma unroll
    for (int r = 0; r < 16; ++r) {
        const int ka = crow(r, hi), kb = 32 + ka;
        int ia = ka - qc + 15; ia = ia < 0 ? 0 : (ia > 30 ? 30 : ia);
        int ib = kb - qc + 15; ib = ib < 0 ? 0 : (ib > 30 ? 30 : ib);
        const bool oka = rowok && (ka >= c0) && (ka < c0 + 16), okb = rowok && (kb >= c0) && (kb < c0 + 16);
        p0[r] = oka ? p0[r] + brow[ia] : -1e30f;
        p1[r] = okb ? p1[r] + brow[ib] : -1e30f;
    }
}
__device__ __forceinline__ void lazySM(f32x16& p0, f32x16& p1, float& m_reg, bool& moved, float& alpha) {
    float pmax = p0[0];
#pragma unroll
    for (int r = 1; r < 16; ++r) pmax = fmaxf(pmax, p0[r]);
#pragma unroll
    for (int r = 0; r < 16; ++r) pmax = fmaxf(pmax, p1[r]);
    { auto rr = __builtin_amdgcn_permlane32_swap(__float_as_uint(pmax), __float_as_uint(pmax), false, false);
      pmax = fmaxf(__uint_as_float(rr[0]), __uint_as_float(rr[1])); }
    if (__builtin_expect(__all(pmax <= THR2), 1)) { alpha = 1.f; }
    else { const float dl = fmaxf(pmax, 0.f); m_reg += dl; alpha = __builtin_amdgcn_exp2f(-dl);
#pragma unroll
        for (int r = 0; r < 16; ++r) { p0[r] -= dl; p1[r] -= dl; }
        moved = true; }
#pragma unroll
    for (int r = 0; r < 16; ++r) p0[r] = __builtin_amdgcn_exp2f(p0[r]);
}
__device__ __forceinline__ void fixedSM(f32x16& p0) {
#pragma unroll
    for (int r = 0; r < 16; ++r) p0[r] = __builtin_amdgcn_exp2f(p0[r]);
}
__device__ __forceinline__ void finishSM(f32x16& p0, f32x16& p1, bf16x8& pa0, bf16x8& pa1, bf16x8& pa2, bf16x8& pa3) {
#pragma unroll
    for (int r = 0; r < 16; ++r) p1[r] = __builtin_amdgcn_exp2f(p1[r]);
    u32x4 w;
    w = (u32x4){cvtpk(p0[0], p0[1]), cvtpk(p0[2], p0[3]), cvtpk(p0[4], p0[5]), cvtpk(p0[6], p0[7])}; pa0 = __builtin_bit_cast(bf16x8, w);
    w = (u32x4){cvtpk(p0[8], p0[9]), cvtpk(p0[10], p0[11]), cvtpk(p0[12], p0[13]), cvtpk(p0[14], p0[15])}; pa1 = __builtin_bit_cast(bf16x8, w);
    w = (u32x4){cvtpk(p1[0], p1[1]), cvtpk(p1[2], p1[3]), cvtpk(p1[4], p1[5]), cvtpk(p1[6], p1[7])}; pa2 = __builtin_bit_cast(bf16x8, w);
    w = (u32x4){cvtpk(p1[8], p1[9]), cvtpk(p1[10], p1[11]), cvtpk(p1[12], p1[13]), cvtpk(p1[14], p1[15])}; pa3 = __builtin_bit_cast(bf16x8, w);
}
struct NoSide { static constexpr bool PLAIN = true; template <int P> __device__ __forceinline__ void step() {} };
template <int DQK, int MODE, class SIDE = NoSide>
__device__ __forceinline__ void attn_unit(const UnitP& u, ALAS unsigned char* lds, const int tid, SIDE& side) {
    constexpr int ND = DQK / 16, KST = DQK * 2 + 16, KBUF = 64 * KST;
    static_assert(KBUF <= KBUF_MAX, "K buffer");
    const int wid = __builtin_amdgcn_readfirstlane(tid >> 6), lane = tid & 63, r32 = lane & 31, hi = lane >> 5;
    ALAS unsigned char* V_lds = lds + OFF_V; ALAS unsigned char* K_lds = lds + OFF_K;
    ALAS float* ws = (ALAS float*)(lds + OFF_WS) + wid * 64; ALAS float* al_l = ws + 32;
    const ALAS float* btab = (const ALAS float*)(lds + OFF_BIAS);
    float m_reg = 0.f; f32x16 o[2], lacc; o[0] = f32x16{}; o[1] = f32x16{}; lacc = f32x16{}; bf16x8 qr[ND];
    bool moved = false;
    const int grow = u.grow0 + (wid >> 1), gcol = (wid & 1) * 32 + r32;
    {
        const bf16_t* Qw = u.Q + (size_t)(wid * QBLK + r32) * u.ldq + hi * 8;
#pragma unroll
        for (int d0 = 0; d0 < ND; ++d0) qr[d0] = *(const bf16x8*)(Qw + d0 * 16);
        if constexpr (MODE == 0 || MODE == 3) {
            float x[4][8]; float ssq = 0.f;
#pragma unroll
            for (int d0 = 0; d0 < 4; ++d0)
#pragma unroll
                for (int j = 0; j < 8; ++j) { x[d0][j] = bf2f(qr[d0][j]); ssq += x[d0][j] * x[d0][j]; }
            { auto rr_ = __builtin_amdgcn_permlane32_swap(__float_as_uint(ssq), __float_as_uint(ssq), false, false); ssq = __uint_as_float(rr_[0]) + __uint_as_float(rr_[1]); }
            const float rstd = 1.0f / sqrtf(ssq * (1.0f / 64.0f) + 1e-6f);
#pragma unroll
            for (int d0 = 0; d0 < 4; ++d0)
#pragma unroll
                for (int j = 0; j < 8; ++j) x[d0][j] = x[d0][j] * rstd * u.gain[16 * d0 + 8 * hi + j];
#pragma unroll
            for (int d0 = 0; d0 < 2; ++d0)
#pragma unroll
                for (int j = 0; j < 8; ++j) { const float inv = exp2f(-(float)(8 * hi + j) * (LOG2_THETA / 16.0f));
                    const float ang = (float)(d0 == 0 ? grow : gcol) * inv * INV2PI; const float c = __builtin_amdgcn_cosf(ang), s = __builtin_amdgcn_sinf(ang);
                    const float y1 = x[d0][j], y2 = x[d0 + 2][j]; x[d0][j] = y1 * c - y2 * s; x[d0 + 2][j] = y1 * s + y2 * c; }
            constexpr float C2 = 0.125f * LOG2E;
#pragma unroll
            for (int d0 = 0; d0 < 4; ++d0) { u32x4 w = {cvtpk(x[d0][0] * C2, x[d0][1] * C2), cvtpk(x[d0][2] * C2, x[d0][3] * C2), cvtpk(x[d0][4] * C2, x[d0][5] * C2), cvtpk(x[d0][6] * C2, x[d0][7] * C2)};
                qr[d0] = __builtin_bit_cast(bf16x8, w); }
        }
        if constexpr (MODE == 1) {
            float y1[8], y2[8];
#pragma unroll
            for (int j = 0; j < 8; ++j) { const float inv = exp2f(-(float)j * (LOG2_THETA / 8.0f));
                const float ang = (float)(hi == 0 ? grow : gcol) * inv * INV2PI; const float c = __builtin_amdgcn_cosf(ang), s = __builtin_amdgcn_sinf(ang);
                const float a = bf2f(qr[4][j]), b = bf2f(qr[5][j]); y1[j] = a * c - b * s; y2[j] = a * s + b * c; }
            u32x4 w = {cvtpk(y1[0], y1[1]), cvtpk(y1[2], y1[3]), cvtpk(y1[4], y1[5]), cvtpk(y1[6], y1[7])}; qr[4] = __builtin_bit_cast(bf16x8, w);
            w = (u32x4){cvtpk(y2[0], y2[1]), cvtpk(y2[2], y2[3]), cvtpk(y2[4], y2[5]), cvtpk(y2[6], y2[7])}; qr[5] = __builtin_bit_cast(bf16x8, w);
        }
    }
    const int sk = tid >> 3, sc = tid & 7;
    const unsigned vsoff = (unsigned)(sk * u.ldv + sc * 8) * 2u, ksoff = (unsigned)(sk * u.ldk0 + sc * 8) * 2u;
    const int vst = (sc >> 2) * 4096 + sk * 64 + (sc & 3) * 16, kst = sk * KST + sc * 16;
    const int sk2 = (tid & 255) >> 2, sc2 = tid & 3;
    const unsigned k2soff = (DQK == 96) ? (unsigned)(sk2 * u.ldk1 + sc2 * 8) * 2u : 0u;
    const int k2st = sk2 * KST + (8 + sc2) * 16;
    const ALAS unsigned char* vb0 = V_lds + ((lane >> 4) & 1) * 32 + (lane & 3) * 8 + (4 * hi + ((lane & 15) >> 2)) * 64;
    struct { bf16x8 v, k, k2; } sr_[2];
#define ATT_SLOAD(i, k0) do { sr_[i].v = *(const bf16x8*)((const char*)(u.V + (size_t)(k0) * u.ldv) + vsoff); sr_[i].k = *(const bf16x8*)((const char*)(u.K0 + (size_t)(k0) * u.ldk0) + ksoff); \
        if constexpr (DQK == 96) sr_[i].k2 = *(const bf16x8*)((const char*)(u.K1 + (size_t)(k0) * u.ldk1) + k2soff); } while (0)
#define ATT_SWRITE(b, i) do { *(ALAS bf16x8*)(V_lds + (b) * VBUF + vst) = sr_[i].v; *(ALAS bf16x8*)(K_lds + (b) * KBUF + kst) = sr_[i].k; \
        if constexpr (DQK == 96) *(ALAS bf16x8*)(K_lds + (b) * KBUF + k2st) = sr_[i].k2; } while (0)
#define ATT_SWAIT() do { if constexpr (SIDE::PLAIN) { if constexpr (DQK == 96) asm volatile("s_waitcnt vmcnt(3)" ::: "memory"); else asm volatile("s_waitcnt vmcnt(2)" ::: "memory"); } } while (0)
#define ATT_RESC(a) do { if constexpr (MODE != 0) { if (__any((a) < 1.f)) { if (hi == 0) al_l[r32] = (a); asm volatile("s_waitcnt lgkmcnt(0)" ::: "memory"); \
        _Pragma("unroll") for (int r = 0; r < 16; ++r) { const float f_ = al_l[crow(r, hi)]; o[0][r] *= f_; o[1][r] *= f_; lacc[r] *= f_; } } } } while (0)
#define ATT_SM(P0, P1, AL) do { if constexpr (MODE == 0) { fixedSM(P0); AL = 1.f; } else lazySM(P0, P1, m_reg, moved, AL); } while (0)
#define ATT_QKT(P0, P1, KS) do { if (MODE != 0 && moved) { f32x16 ng_; _Pragma("unroll") for (int r_ = 0; r_ < 16; ++r_) ng_[r_] = -m_reg; qkt<DQK>(P0, P1, KS, qr, ng_, r32, hi); } \
        else { const f32x16 z_ = f32x16{}; qkt<DQK>(P0, P1, KS, qr, z_, r32, hi); } } while (0)
#define ATT_PV(VB) pv_all(o[0], o[1], lacc, (VB), pa0, pa1, pa2, pa3)
#define ATT_MASK(P0, P1, j) do { if constexpr (MODE == 2) na_mask(P0, P1, btab, u.kr0 + (j), grow, gcol, hi); } while (0)
    f32x16 pA0, pA1, pB0, pB1; float alA, alB; bf16x8 pa0, pa1, pa2, pa3; const int NT = u.nt;
    constexpr int SE = 0, SO = 1;
    ATT_SLOAD(SE, 0); asm volatile("s_waitcnt vmcnt(0)" ::: "memory"); ATT_SWRITE(0, SE); __syncthreads();
    ATT_QKT(pA0, pA1, K_lds); ATT_MASK(pA0, pA1, 0); ATT_SM(pA0, pA1, alA);
    ATT_SLOAD(SO, KVBLK); if (2 < NT) ATT_SLOAD(SE, 2 * KVBLK);
    ATT_SWAIT(); ATT_SWRITE(1, SO); __syncthreads();
    if (wid >= 4) __builtin_amdgcn_s_setprio(1);
    for (int j = 1; j + 1 < NT; j += 2) {
        if constexpr (!SIDE::PLAIN) { if ((j & 7) == 1) side.template step<0>(); }
        ASBAR(); ATT_QKT(pB0, pB1, K_lds + KBUF); ATT_MASK(pB0, pB1, j);
        finishSM(pA0, pA1, pa0, pa1, pa2, pa3); ASBAR();
        ATT_SLOAD(SO, (j + 2) * KVBLK); ASBAR();
        ATT_PV(vb0); ATT_SM(pB0, pB1, alB);
        __syncthreads(); ATT_SWAIT(); ATT_SWRITE(0, SE);
        ATT_RESC(alB); __syncthreads();
        if constexpr (!SIDE::PLAIN) { if ((j & 7) == 5) side.template step<1>(); }
        ASBAR(); ATT_QKT(pA0, pA1, K_lds); ATT_MASK(pA0, pA1, j + 1);
        finishSM(pB0, pB1, pa0, pa1, pa2, pa3); ASBAR();
        if (j + 3 < NT) ATT_SLOAD(SE, (j + 3) * KVBLK); ASBAR();
        ATT_PV(vb0 + VBUF); ATT_SM(pA0, pA1, alA);
        __syncthreads(); ATT_SWAIT(); ATT_SWRITE(1, SO);
        ATT_RESC(alA); __syncthreads();
    }
    ASBAR(); ATT_QKT(pB0, pB1, K_lds + KBUF); ATT_MASK(pB0, pB1, NT - 1);
    finishSM(pA0, pA1, pa0, pa1, pa2, pa3); ASBAR();
    ATT_PV(vb0); ATT_SM(pB0, pB1, alB);
    __syncthreads(); ATT_RESC(alB);
    finishSM(pB0, pB1, pa0, pa1, pa2, pa3); ASBAR();
    ATT_PV(vb0 + VBUF);
    __builtin_amdgcn_s_setprio(0);
    bf16_t* Ow = u.O + (size_t)(wid * QBLK) * u.ldo;
#pragma unroll
    for (int r = 0; r < 16; ++r) { const int orow = crow(r, hi); const float rl = __builtin_amdgcn_rcpf(lacc[r]);
#pragma unroll
        for (int d0 = 0; d0 < 2; ++d0) Ow[(size_t)orow * u.ldo + d0 * 32 + r32] = (bf16_t)f2bf_s(o[d0][r] * rl); }
    __syncthreads();
#undef ATT_SLOAD
#undef ATT_SWRITE
#undef ATT_SWAIT
#undef ATT_RESC
#undef ATT_SM
#undef ATT_QKT
#undef ATT_PV
#undef ATT_MASK
}
}


constexpr int NWAVES = 8;
#ifndef MK_DEBUG
#define MK_DEBUG 0
#endif
#ifndef MK_DBG_IGNORE
#define MK_DBG_IGNORE 0
#endif
#ifndef MK_ONE_LAUNCH
#define MK_ONE_LAUNCH 0
#endif
#ifndef REP_P
#define REP_P 1
#endif
#ifndef REP_A
#define REP_A 1
#endif
#ifndef REP_B
#define REP_B 1
#endif
#ifndef REP_C
#define REP_C 1
#endif
#ifndef REP_DG
#define REP_DG 1
#endif
#ifndef REP_DM
#define REP_DM 1
#endif
#ifndef REP_DN
#define REP_DN 1
#endif
#ifndef REP_E
#define REP_E 1
#endif
#ifndef REP_F
#define REP_F 1
#endif
#ifndef REP_H
#define REP_H 1
#endif
#ifndef REP_I
#define REP_I 1
#endif
#ifndef REP_J
#define REP_J 1
#endif
#ifndef REP_K
#define REP_K 1
#endif
#ifndef MK_FP8_LAST
#define MK_FP8_LAST 1
#endif
#ifndef MK_FP8_MOE_ALL
#define MK_FP8_MOE_ALL 1
#endif
#define F8MOE(l) (MK_FP8_LAST && ((l) == DEPTH - 1 || MK_FP8_MOE_ALL))
#ifndef MK_FP8_IN_ALL
#define MK_FP8_IN_ALL 1
#endif
#define F8IN(l) (MK_FP8_LAST && ((l) == DEPTH - 1 || MK_FP8_IN_ALL))
constexpr int NB = 4, SEQ = 8192, T = NB * SEQ, D = 1024, DEPTH = 2, GW = 64;
constexpr int DIN = 5536, DINP = 5632;
constexpr int H_NAQ = 0, H_NAK = 384, H_NAV = 768, H_GQ = 1152, H_GK = 1536, H_GV = 1664, H_CQ = 1792, H_CKV = 2176, H_KR = 2432, H_GATE = 2464;
constexpr int NE = 32, TOPK = 4, FF = 1024, TK = T * TOPK;
constexpr int PSLOTS = TK + NE * 256;
constexpr int MAXTILES = PSLOTS / 256;
constexpr int LCAP = T;
constexpr float LN_EPS = 1e-5f, RMS_EPS = 1e-6f, DN_ALPHA = 1.4142135623730951f;
constexpr float LOG2E_F = 1.4426950408889634f;
constexpr int PPL = 10, NPH = 1 + DEPTH * PPL;

constexpr size_t MiB = 1u << 20;
constexpr size_t WS_CTL = 0, CTL_ZERO_BYTES = 1 * MiB;
constexpr size_t WB_IN = 0, WB_UQ = WB_IN + (size_t)DINP * 1024 * 2, WB_UKV = WB_UQ + (size_t)512 * 384 * 2, WB_BA = WB_UKV + (size_t)512 * 256 * 2,
                 WB_BB = WB_BA + (size_t)1024 * 384 * 2, WB_BC = WB_BB + (size_t)1024 * 384 * 2, WB_OUT = WB_BC + (size_t)1024 * 384 * 2,
                 WB_GU = WB_OUT + (size_t)1024 * 1024 * 2, WB_DN = WB_GU + (size_t)NE * 2048 * 1024 * 2, WB_LAYER = WB_DN + (size_t)NE * 1024 * 1024 * 2;
static_assert(WB_LAYER % 256 == 0, "weight block alignment");
constexpr size_t WS_W = 2 * MiB;
constexpr size_t WS_H = WS_W + 2 * WB_LAYER;
constexpr size_t SZ_H = (size_t)T * DINP * 2;
constexpr size_t WS_A2 = WS_H + SZ_H;
constexpr size_t A2_MIX = 0, A2_MIXED = A2_MIX + (size_t)T * 1024 * 4, A2_YA = A2_MIXED + (size_t)T * 1024 * 2, A2_YB = A2_YA + (size_t)T * 384 * 2,
                 A2_YC = A2_YB + (size_t)T * 384 * 2, A2_QC = A2_YC + (size_t)T * 384 * 2, A2_KVC = A2_QC + (size_t)T * 384 * 2, A2_KB = A2_KVC + (size_t)T * 512 * 2,
                 A2_CQN = A2_KB + (size_t)T * 128 * 2, A2_CKVN = A2_CQN + (size_t)T * 384 * 2, A2_KR = A2_CKVN + (size_t)T * 256 * 2, SZ_A2 = A2_KR + (size_t)T * 32 * 2;
static_assert(SZ_A2 >= (size_t)PSLOTS * 1024 * 2 && SZ_H >= (size_t)PSLOTS * 1024 * 2, "overlays fit");
constexpr size_t WS_X2 = WS_A2 + SZ_A2;
constexpr size_t WS_XB = WS_X2 + (size_t)T * D * 4;
constexpr size_t WS_X1 = WS_XB + (size_t)T * D * 2;
constexpr size_t WS_X1B = WS_X1 + (size_t)T * D * 4;
constexpr size_t WS_LT = WS_X1B + (size_t)T * D * 2;
constexpr size_t WS_LG = WS_LT + (size_t)NE * LCAP * 4;
constexpr size_t WS_TE = WS_LG + (size_t)NE * LCAP * 4;
constexpr size_t WS_TR = WS_TE + (size_t)T * 4 * 4;
constexpr size_t WS_SG = WS_TR + (size_t)T * 4 * 4;
constexpr size_t WS_END = WS_SG + (size_t)PSLOTS * 4;
constexpr int CW_BAR = 4096;
constexpr int CW_CNT = 16384;

constexpr int RING_BYTES = 131072, LDSCTL_OFF = 139264, MISC_OFF = LDSCTL_OFF + 64;
constexpr int TBL_OFF = LDSCTL_OFF + 256;
constexpr int TBL_START = TBL_OFF, TBL_TILEE = TBL_OFF + 512, TBL_RS = TBL_TILEE + 2304;
constexpr int LDS_BYTES = 155648;
static_assert(TBL_RS + 512 * 12 + 256 <= LDS_BYTES, "LDS map");

#define GAS __attribute__((address_space(1)))
#define LAS __attribute__((address_space(3)))
typedef unsigned short bf16;
typedef unsigned v4u __attribute__((ext_vector_type(4)));
typedef float f32x4 __attribute__((ext_vector_type(4)));
typedef GAS unsigned gu32;
#define RLX_AGENT __ATOMIC_RELAXED, __HIP_MEMORY_SCOPE_AGENT
#define LDS_WAIT() asm volatile("s_waitcnt lgkmcnt(0)" ::: "memory")
#define VM_WAIT() asm volatile("s_waitcnt vmcnt(0)" ::: "memory")
__device__ __forceinline__ unsigned f2bf(float f) { unsigned u = __builtin_bit_cast(unsigned, f); return (u + 0x7fffu + ((u >> 16) & 1u)) >> 16; }
__device__ __forceinline__ unsigned pk2(float lo, float hi) { unsigned r; asm("v_cvt_pk_bf16_f32 %0, %1, %2" : "=v"(r) : "v"(lo), "v"(hi)); return r; }
__device__ __forceinline__ float bflo(unsigned w) { return __uint_as_float(w << 16); }
__device__ __forceinline__ float bfhi(unsigned w) { return __uint_as_float(w & 0xffff0000u); }

template <int O> __device__ __forceinline__ float shx(float v, int lane) { return __int_as_float(__builtin_amdgcn_ds_bpermute((lane ^ O) << 2, __float_as_int(v))); }
template <int O> __device__ __forceinline__ int shxi(int v, int lane) { return __builtin_amdgcn_ds_bpermute((lane ^ O) << 2, v); }

#define XB_TMO      128
#define XB_XCNT(j)  (256  + 64 * (j))
#define XB_XSUB(j)  (1280 + 64 * (j))
#define XB_XGEN(j)  (2304 + 64 * (j))
#define XB_TOP      3328
#define XB_TOPGEN   3392
#define XCD_BAR_WORDS 3456
#define XB_SPIN_CAP (1u << 18)

__device__ __forceinline__ unsigned xb_ld(unsigned* p)              { return __hip_atomic_load(p, __ATOMIC_RELAXED, __HIP_MEMORY_SCOPE_AGENT); }
__device__ __forceinline__ unsigned xb_add(unsigned* p, unsigned v) { return __hip_atomic_fetch_add(p, v, __ATOMIC_RELAXED, __HIP_MEMORY_SCOPE_AGENT); }
__device__ __forceinline__ unsigned xb_xcc_id() { return (unsigned)__builtin_amdgcn_s_getreg((3 << 11) | 20) & 0xFu; }
#define XB_SPIN(cond, bar) do { unsigned _sp = 0; while (cond) { __builtin_amdgcn_s_sleep(1); \
    if ((++_sp & 255u) == 0u) { if (xb_ld(&(bar)[XB_TMO])) break; if (_sp > XB_SPIN_CAP) { atomicAdd(&(bar)[XB_TMO], 1u); break; } } } } while (0)

struct XcdBarrier {
    unsigned* bar; unsigned x;
    volatile LAS unsigned* st;
};

__device__ __forceinline__ XcdBarrier xcd_barrier_post(unsigned* bar, volatile LAS unsigned* st) {
    XcdBarrier b; b.bar = bar; b.x = xb_xcc_id(); b.st = st;
    if (threadIdx.x == 0) (void)xb_add(&bar[XB_XCNT(b.x)], 1u);
    return b;
}
__device__ __forceinline__ void xcd_barrier_complete(unsigned* bar, unsigned x, unsigned& nloc, unsigned& nx) {
    const unsigned G = gridDim.x * gridDim.y * gridDim.z;
    unsigned sum, cnt, mine, sp = 0u;
    for (;;) {
        sum = 0u; cnt = 0u; mine = 0u;
#pragma unroll
        for (unsigned j = 0; j < 16; ++j) { const unsigned c = xb_ld(&bar[XB_XCNT(j)]); sum += c; cnt += (c > 0u) ? 1u : 0u; mine = (j == x) ? c : mine; }
        if (sum == G) break;
        __builtin_amdgcn_s_sleep(1);
        if ((++sp & 255u) == 0u) { if (xb_ld(&bar[XB_TMO])) break; if (sp > XB_SPIN_CAP) { atomicAdd(&bar[XB_TMO], 1u); break; } }
    }
    nloc = mine > 0u ? mine : 1u; nx = cnt > 0u ? cnt : 1u;
}

__device__ __forceinline__ void xcd_barrier(const XcdBarrier& b) {
    asm volatile("s_waitcnt vmcnt(0)" ::: "memory");
    __syncthreads();
    if (threadIdx.x == 0) {
        unsigned* bar = b.bar;
        __builtin_amdgcn_s_waitcnt(0);
        unsigned nloc = b.st[0], nx = b.st[1];
        if (nloc == 0u) { xcd_barrier_complete(bar, b.x, nloc, nx); b.st[0] = nloc; b.st[1] = nx; }
        const unsigned old = xb_add(&bar[XB_XSUB(b.x)], 1u);
        const unsigned gen = old / nloc;
        if (old + 1u == (gen + 1u) * nloc) {
            __builtin_amdgcn_fence(__ATOMIC_RELEASE, "agent");
            asm volatile("s_waitcnt vmcnt(0)" ::: "memory");
            const unsigned og = xb_add(&bar[XB_TOP], 1u);
            const unsigned tg = og / nx;
            if (og + 1u == (tg + 1u) * nx) xb_add(&bar[XB_TOPGEN], 1u);
            else XB_SPIN(xb_ld(&bar[XB_TOPGEN]) == tg, bar);
            __builtin_amdgcn_fence(__ATOMIC_ACQUIRE, "agent");
            xb_add(&bar[XB_XGEN(b.x)], 1u);
            asm volatile("s_waitcnt vmcnt(0)" ::: "memory");
        } else {
            XB_SPIN(xb_ld(&bar[XB_XGEN(b.x)]) == gen, bar);
            __builtin_amdgcn_fence(__ATOMIC_ACQUIRE, "agent");
            asm volatile("s_waitcnt vmcnt(0)" ::: "memory");
        }
    }
    __syncthreads();
}


struct Frame {
    LAS unsigned char* lds;
    gu32* ctl;
    int tid, lane, wave;
    int vcu, G, bx;
    unsigned char* ws;
    float* out;
};
__device__ __forceinline__ const float* in_ptr(int i) {
    const void* base = (const void*)__builtin_amdgcn_kernarg_segment_ptr(); const GAS float* p;
    asm volatile("s_load_dwordx2 %0, %1, %2\n\ts_waitcnt lgkmcnt(0)" : "=s"(p) : "s"(base), "i"(i * 8) : "memory"); return (const float*)p;
}
#define INP(i) in_ptr(i)
template <int SITE> __device__ __forceinline__ Frame mkframe(LAS unsigned char* lds_in, unsigned char* ws_in, float* out_in, int wave_id, int bx0, int G0) {
    Frame F; int lane_;
    asm volatile("v_mbcnt_lo_u32_b32 %0, -1, 0\n\tv_mbcnt_hi_u32_b32 %0, -1, %0 ; site %1" : "=v"(lane_) : "n"(SITE));
    int bx = bx0, G = G0, wv = wave_id; asm volatile("; site %3" : "+s"(bx), "+s"(G), "+s"(wv) : "n"(SITE));
    GAS unsigned char* wsg = (GAS unsigned char*)ws_in; asm volatile("; site %1" : "+s"(wsg) : "n"(SITE)); unsigned char* ws = (unsigned char*)wsg;
    LAS unsigned char* l3 = lds_in; asm volatile("; site %1" : "+s"(l3) : "n"(SITE));
    const int tid = wv * 64 + lane_;
    F.lds = l3; F.tid = tid; F.lane = lane_; F.wave = wv;
    F.G = G; F.bx = bx; F.vcu = (G % 8 == 0) ? (bx % 8) * (G / 8) + bx / 8 : bx;
    F.ws = ws; F.ctl = (gu32*)(wsg + WS_CTL); F.out = out_in; return F;
}
__device__ __forceinline__ float wave_sum(float v, int lane) {
    v += shx<1>(v, lane); v += shx<2>(v, lane); v += shx<4>(v, lane); v += shx<8>(v, lane); v += shx<16>(v, lane); v += shx<32>(v, lane);
    return v;
}
template <bool F8> __device__ __forceinline__ void tr_item(const float* W, int ldw, int Kd, int k0, int src_n0, bf16* WT, int dst_n0, float scale, LAS float* scr, int lane) {
    float v[32];
#pragma unroll
    for (int i = 0; i < 32; ++i) v[i] = W[(size_t)(k0 + 2 * i + (lane >> 5)) * ldw + src_n0 + (lane & 31)];
#pragma unroll
    for (int i = 0; i < 32; ++i) scr[(2 * i + (lane >> 5)) * 33 + (lane & 31)] = v[i];
    LDS_WAIT(); asm volatile("" ::: "memory");
    const int c = lane & 7;
#pragma unroll
    for (int j = 0; j < 4; ++j) { const int n = (lane >> 3) + 8 * j; const LAS float* s = scr + (8 * c) * 33 + n;
        if constexpr (F8) { typedef unsigned u32x2 __attribute__((ext_vector_type(2)));
            *(GAS u32x2*)((unsigned char*)WT + (size_t)(dst_n0 + n) * Kd + k0 + 8 * c) = (u32x2){pg8::pk4_fp8(s[0 * 33] * scale, s[1 * 33] * scale, s[2 * 33] * scale, s[3 * 33] * scale), pg8::pk4_fp8(s[4 * 33] * scale, s[5 * 33] * scale, s[6 * 33] * scale, s[7 * 33] * scale)}; }
        else { v4u o; o.x = pk2(s[0 * 33] * scale, s[1 * 33] * scale); o.y = pk2(s[2 * 33] * scale, s[3 * 33] * scale); o.z = pk2(s[4 * 33] * scale, s[5 * 33] * scale); o.w = pk2(s[6 * 33] * scale, s[7 * 33] * scale);
            *(GAS v4u*)(WT + (size_t)(dst_n0 + n) * Kd + k0 + 8 * c) = o; } }
    LDS_WAIT(); asm volatile("" ::: "memory");
}
template <int KIND, bool F8 = false> __device__ __forceinline__ void conv_matrix(Frame& F, const float* W, int K, int N, bf16* WT, float s, int gw, int NGW, LAS float* scr, int Kd = 0) {
    if (Kd == 0) Kd = K;
    const int nnb = N / 32, nkb = K / 64, nit = nnb * nkb;
    for (int it = gw; it < nit; it += NGW) {
        const int kb = it / nnb, nb = it % nnb; const int dst_n0 = 32 * nb; int src_n0 = dst_n0; float sc = s;
        if (KIND == 1) sc = (dst_n0 < 384) ? s : 1.0f;
        if (F8) sc *= 32.0f;
        if (KIND == 2) { const int p = dst_n0 >> 8, j = dst_n0 & 255; src_n0 = (j < 128) ? (128 * p + j) : (1024 + 128 * p + (j - 128)); }
        tr_item<F8>(W, N, Kd, 64 * kb, src_n0, WT, dst_n0, sc, scr, F.lane);
    }
}
__device__ __forceinline__ void zero_rows(bf16* WT, int K, int n_lo, int n_hi, int gtid, int nthr) {
    const size_t n16 = (size_t)(n_hi - n_lo) * K / 8; GAS v4u* p = (GAS v4u*)(WT + (size_t)n_lo * K);
    for (size_t i = gtid; i < n16; i += nthr) p[i] = (v4u){0u, 0u, 0u, 0u};
}
__device__ __forceinline__ void p_prologue(Frame& F) {
    LAS float* scr = (LAS float*)(F.lds + F.wave * 16384);
    const int gw0 = F.vcu * NWAVES + F.wave, NGW = F.G * NWAVES, gtid = F.bx * (NWAVES * 64) + F.tid, nthr = F.G * NWAVES * 64;
    for (int l = 0; l < DEPTH; ++l) {
        unsigned char* wb = F.ws + WS_W + (size_t)l * WB_LAYER;
        int gw = gw0;
#define ROT(n) do { gw = (gw + NGW - ((n) % NGW)) % NGW; } while (0)
        if (F8IN(l)) { conv_matrix<1, true>(F, INP(1) + (size_t)l * 1024 * DIN, 1024, DIN, (bf16*)(wb + WB_IN), 0.125f * LOG2E_F, gw, NGW, scr); zero_rows((bf16*)(wb + WB_IN), 512, DIN, DINP, gtid, nthr); }
        else { conv_matrix<1>(F, INP(1) + (size_t)l * 1024 * DIN, 1024, DIN, (bf16*)(wb + WB_IN), 0.125f * LOG2E_F, gw, NGW, scr); zero_rows((bf16*)(wb + WB_IN), 1024, DIN, DINP, gtid, nthr); }
        ROT(16 * 173);
        conv_matrix<0>(F, INP(7) + (size_t)l * 384 * 384, 384, 384, (bf16*)(wb + WB_UQ), 0.10206207261596577f * LOG2E_F, gw, NGW, scr); ROT(72);
        zero_rows((bf16*)(wb + WB_UQ), 384, 384, 512, gtid, nthr);
        conv_matrix<0>(F, INP(8) + (size_t)l * 256 * 512, 256, 512, (bf16*)(wb + WB_UKV), 1.0f, gw, NGW, scr); ROT(64);
        conv_matrix<0>(F, INP(9) + (size_t)l * 384 * 1024, 384, 1024, (bf16*)(wb + WB_BA), 1.0f, gw, NGW, scr); ROT(192);
        conv_matrix<0>(F, INP(10) + (size_t)l * 384 * 1024, 384, 1024, (bf16*)(wb + WB_BB), 1.0f, gw, NGW, scr); ROT(192);
        conv_matrix<0>(F, INP(11) + (size_t)l * 256 * 1024, 256, 1024, (bf16*)(wb + WB_BC), 1.0f, gw, NGW, scr, 384); ROT(64);
        for (int i = gtid; i < 1024 * 16; i += nthr) *((GAS v4u*)(wb + WB_BC) + (size_t)(i >> 4) * 48 + 32 + (i & 15)) = (v4u){0u, 0u, 0u, 0u};
        conv_matrix<0>(F, INP(12) + (size_t)l * 1024 * 1024, 1024, 1024, (bf16*)(wb + WB_OUT), 1.0f, gw, NGW, scr); ROT(512);
#undef ROT
    }
    { const GAS f32x4* xs = (const GAS f32x4*)INP(0); GAS v4u* xd = (GAS v4u*)(F.ws + WS_XB);
      typedef unsigned u32x2 __attribute__((ext_vector_type(2))); GAS u32x2* x8 = (GAS u32x2*)(F.ws + WS_X2);
      for (size_t i = gtid; i < (size_t)T * D / 8; i += nthr) { const f32x4 a = xs[2 * i], b = xs[2 * i + 1]; xd[i] = (v4u){pk2(a.x, a.y), pk2(a.z, a.w), pk2(b.x, b.y), pk2(b.z, b.w)};
          if (F8IN(0)) x8[i] = (u32x2){pg8::pk4_fp8(a.x * 16.f, a.y * 16.f, a.z * 16.f, a.w * 16.f), pg8::pk4_fp8(b.x * 16.f, b.y * 16.f, b.z * 16.f, b.w * 16.f)}; } }
}

constexpr int CONV_ITEMS = NE * 1024 + NE * 512, CONV_LDS_OFF = 49152, CONV_LDS_WAVE = 2 * 16 * 33 * 4;
struct MoeConv {
    static constexpr bool PLAIN = false;
    const float* Wgu; const float* Wdn; unsigned char* Tgu; unsigned char* Tdn; bool f8;
    LAS float* scr; int lane; int gw, ngw, nmini; int s;
    float cvA[8], cvB[8];
    struct Mini { const float* W; unsigned char* WT; int ldw, k0, src_n0, dst_n0; float sc; };
    __device__ __forceinline__ Mini decode(int m) const {
        m = m < 0 ? 0 : (m >= nmini ? nmini - 1 : m);
        const int g = gw + (m >> 2) * ngw, q = m & 3; const bool gu = g < NE * 1024; const int h = gu ? g : g - NE * 1024;
        const int e = gu ? (h >> 10) : (h >> 9), r = gu ? (h & 1023) : (h & 511), kb = gu ? (r >> 6) : (r >> 5), nb = gu ? (r & 63) : (r & 31);
        Mini x; x.dst_n0 = 32 * nb; const int p = x.dst_n0 >> 8, j = x.dst_n0 & 255;
        x.src_n0 = gu ? ((j < 128) ? (128 * p + j) : (1024 + 128 * p + (j - 128))) : x.dst_n0; x.k0 = 64 * kb + 16 * q; x.ldw = gu ? 2048 : 1024;
        x.W = gu ? Wgu + (size_t)e * 1024 * 2048 : Wdn + (size_t)e * 1024 * 1024; const size_t es = f8 ? 1 : 2; x.WT = gu ? Tgu + (size_t)e * 2048 * 1024 * es : Tdn + (size_t)e * 1024 * 1024 * es; x.sc = gu ? 64.0f : 128.0f; return x;
    }
    __device__ __forceinline__ bool done() const { return s >= nmini + 3; }
    template <int P> __device__ __forceinline__ void step() {
        {   const Mini x = decode(s - 3); const LAS float* b = scr + (1 - P) * (16 * 33); const int n = lane >> 1, kh = lane & 1; const LAS float* p = b + (8 * kh) * 33 + n;
            const float q0 = p[0 * 33], q1 = p[1 * 33], q2 = p[2 * 33], q3 = p[3 * 33], q4 = p[4 * 33], q5 = p[5 * 33], q6 = p[6 * 33], q7 = p[7 * 33];
            const size_t eo = (size_t)(x.dst_n0 + n) * 1024 + x.k0 + 8 * kh;
            if (f8) { typedef unsigned u32x2 __attribute__((ext_vector_type(2)));
                *(GAS u32x2*)(x.WT + eo) = (u32x2){pg8::pk4_fp8(q0 * x.sc, q1 * x.sc, q2 * x.sc, q3 * x.sc), pg8::pk4_fp8(q4 * x.sc, q5 * x.sc, q6 * x.sc, q7 * x.sc)}; }
            else { v4u o; o.x = pk2(q0, q1); o.y = pk2(q2, q3); o.z = pk2(q4, q5); o.w = pk2(q6, q7); *(GAS v4u*)(x.WT + eo * 2) = o; } }
        {   LAS float* b = scr + P * (16 * 33);
#pragma unroll
            for (int jj = 0; jj < 8; ++jj) b[(2 * jj + (lane >> 5)) * 33 + (lane & 31)] = P ? cvB[jj] : cvA[jj]; }
        {   const Mini x = decode(s); const GAS float* src = (const GAS float*)x.W + (size_t)(x.k0 + (lane >> 5)) * x.ldw + x.src_n0 + (lane & 31);
#pragma unroll
            for (int jj = 0; jj < 8; ++jj) { const float v = src[(size_t)(2 * jj) * x.ldw]; if (P) cvB[jj] = v; else cvA[jj] = v; } }
        ++s;
    }
};
__device__ __forceinline__ void p_prep(Frame& F, int l) {
    const bf16* hb = (const bf16*)(F.ws + WS_H); unsigned char* a2 = F.ws + WS_A2;
    bf16* kB = (bf16*)(a2 + A2_KB); bf16* cqn = (bf16*)(a2 + A2_CQN); bf16* ckvn = (bf16*)(a2 + A2_CKVN); bf16* kr = (bf16*)(a2 + A2_KR);
    const float* gk = INP(4) + l * 64; const float* gq = INP(5) + l * 384; const float* gkv = INP(6) + l * 256;
    const int lane = F.lane, gw = F.vcu * NWAVES + F.wave, NGW = F.G * NWAVES;
    v4u nk = {0u, 0u, 0u, 0u}, nq = nk, nkv = nk, nr = nk;
    if (gw < T) { const bf16* h0 = hb + (size_t)gw * DINP; if (lane < 16) nk = *(const GAS v4u*)(h0 + H_GK + lane * 8); if (lane < 48) nq = *(const GAS v4u*)(h0 + H_CQ + lane * 8);
        if (lane < 32) nkv = *(const GAS v4u*)(h0 + H_CKV + lane * 8); if (lane < 4) nr = *(const GAS v4u*)(h0 + H_KR + lane * 8); }
    for (int t = gw; t < T; t += NGW) {
        const v4u wk_ = nk, wq_ = nq, wkv_ = nkv, wr_ = nr;
        if (t + NGW < T) { const bf16* h1 = hb + (size_t)(t + NGW) * DINP; if (lane < 16) nk = *(const GAS v4u*)(h1 + H_GK + lane * 8); if (lane < 48) nq = *(const GAS v4u*)(h1 + H_CQ + lane * 8);
            if (lane < 32) nkv = *(const GAS v4u*)(h1 + H_CKV + lane * 8); if (lane < 4) nr = *(const GAS v4u*)(h1 + H_KR + lane * 8); }
        const int s = t & (SEQ - 1); const float prow = (float)(s >> 6), pcol = (float)(s & 63);
        {   float x[8]; float ssq = 0.f; const int cc = lane & 7;
            if (lane < 16) { const v4u w = wk_; x[0] = bflo(w.x); x[1] = bfhi(w.x); x[2] = bflo(w.y); x[3] = bfhi(w.y); x[4] = bflo(w.z); x[5] = bfhi(w.z); x[6] = bflo(w.w); x[7] = bfhi(w.w); }
            else {
#pragma unroll
                for (int j = 0; j < 8; ++j) x[j] = 0.f; }
#pragma unroll
            for (int j = 0; j < 8; ++j) ssq += x[j] * x[j];
            ssq += shx<1>(ssq, lane); ssq += shx<2>(ssq, lane); ssq += shx<4>(ssq, lane);
            const float rstd = 1.0f / sqrtf(ssq * (1.0f / 64.0f) + RMS_EPS);
            float y[8], o[8];
#pragma unroll
            for (int j = 0; j < 8; ++j) y[j] = x[j] * rstd * gk[(cc * 8 + j) & 63];
#pragma unroll
            for (int j = 0; j < 8; ++j) { const float other = shx<4>(y[j], lane); const int i = 8 * (cc & 3) + j;
                const float inv = exp2f(-(float)(i & 15) * (att::LOG2_THETA / 16.0f)); const float ang = ((i < 16) ? prow : pcol) * inv * att::INV2PI;
                const float c = __builtin_amdgcn_cosf(ang), sn = __builtin_amdgcn_sinf(ang);
                o[j] = (cc < 4) ? (y[j] * c - other * sn) : (other * sn + y[j] * c); }
            if (lane < 16) *(GAS v4u*)(kB + (size_t)t * 128 + lane * 8) = (v4u){pk2(o[0], o[1]), pk2(o[2], o[3]), pk2(o[4], o[5]), pk2(o[6], o[7])};
        }
        {   float x[8]; float ssq = 0.f;
            if (lane < 48) { const v4u w = wq_; x[0] = bflo(w.x); x[1] = bfhi(w.x); x[2] = bflo(w.y); x[3] = bfhi(w.y); x[4] = bflo(w.z); x[5] = bfhi(w.z); x[6] = bflo(w.w); x[7] = bfhi(w.w); }
            else {
#pragma unroll
                for (int j = 0; j < 8; ++j) x[j] = 0.f; }
#pragma unroll
            for (int j = 0; j < 8; ++j) ssq += x[j] * x[j];
            ssq = wave_sum(ssq, lane); const float rstd = 1.0f / sqrtf(ssq * (1.0f / 384.0f) + RMS_EPS);
            if (lane < 48) { float y[8];
#pragma unroll
                for (int j = 0; j < 8; ++j) y[j] = x[j] * rstd * gq[lane * 8 + j];
                *(GAS v4u*)(cqn + (size_t)t * 384 + lane * 8) = (v4u){pk2(y[0], y[1]), pk2(y[2], y[3]), pk2(y[4], y[5]), pk2(y[6], y[7])}; }
        }
        {   float x[8]; float ssq = 0.f;
            if (lane < 32) { const v4u w = wkv_; x[0] = bflo(w.x); x[1] = bfhi(w.x); x[2] = bflo(w.y); x[3] = bfhi(w.y); x[4] = bflo(w.z); x[5] = bfhi(w.z); x[6] = bflo(w.w); x[7] = bfhi(w.w); }
            else {
#pragma unroll
                for (int j = 0; j < 8; ++j) x[j] = 0.f; }
#pragma unroll
            for (int j = 0; j < 8; ++j) ssq += x[j] * x[j];
            ssq = wave_sum(ssq, lane); const float rstd = 1.0f / sqrtf(ssq * (1.0f / 256.0f) + RMS_EPS);
            if (lane < 32) { float y[8];
#pragma unroll
                for (int j = 0; j < 8; ++j) y[j] = x[j] * rstd * gkv[lane * 8 + j];
                *(GAS v4u*)(ckvn + (size_t)t * 256 + lane * 8) = (v4u){pk2(y[0], y[1]), pk2(y[2], y[3]), pk2(y[4], y[5]), pk2(y[6], y[7])}; }
        }
        {   float x[8]; const int cc = lane & 3;
            if (lane < 4) { const v4u w = wr_; x[0] = bflo(w.x); x[1] = bfhi(w.x); x[2] = bflo(w.y); x[3] = bfhi(w.y); x[4] = bflo(w.z); x[5] = bfhi(w.z); x[6] = bflo(w.w); x[7] = bfhi(w.w); }
            else {
#pragma unroll
                for (int j = 0; j < 8; ++j) x[j] = 0.f; }
            float o[8];
#pragma unroll
            for (int j = 0; j < 8; ++j) { const float other = shx<2>(x[j], lane);
                const float inv = exp2f(-(float)j * (att::LOG2_THETA / 8.0f)); const float ang = (((cc & 1) == 0) ? prow : pcol) * inv * att::INV2PI;
                const float c = __builtin_amdgcn_cosf(ang), sn = __builtin_amdgcn_sinf(ang);
                o[j] = (cc < 2) ? (x[j] * c - other * sn) : (other * sn + x[j] * c); }
            if (lane < 4) *(GAS v4u*)(kr + (size_t)t * 32 + lane * 8) = (v4u){pk2(o[0], o[1]), pk2(o[2], o[3]), pk2(o[4], o[5]), pk2(o[6], o[7])};
        }
    }
}


__device__ __forceinline__ int build_tables(Frame& F, int l) {
    LAS int* st = (LAS int*)(F.lds + TBL_START); LAS int* cn = st + 33; LAS int* te = (LAS int*)(F.lds + TBL_TILEE);
    __syncthreads();
    if (F.tid < NE) cn[F.tid] = (int)__hip_atomic_load(F.ctl + CW_CNT + 64 * l + F.tid, RLX_AGENT);
    __syncthreads();
    if (F.tid == 0) { int s = 0; for (int e = 0; e < NE; ++e) { st[e] = s; s += ((cn[e] + 255) >> 8) << 8; } st[NE] = s; }
    __syncthreads();
    const int total = st[NE];
    for (int tile = F.tid; tile < (total >> 8); tile += NWAVES * 64) { int e = 0; for (int k = 1; k < NE; ++k) e += (tile * 256 >= st[k]) ? 1 : 0; te[tile] = e; }
    __syncthreads();
    return total;
}

template <bool XBF> __device__ __forceinline__ void p_ln1_router(Frame& F, int l, const void* xin) {
    const bool w8 = F8MOE(l); unsigned char* x1f8 = F.ws + WS_X2;
    const float* xcur = (const float*)xin; const bf16* xcb = (const bf16*)xin;
    const bf16* outb = (const bf16*)(F.ws + WS_X1); bf16* x1b = (bf16*)(F.ws + WS_X1B);
    int* list_t = (int*)(F.ws + WS_LT); float* list_g = (float*)(F.ws + WS_LG); int* tok_e = (int*)(F.ws + WS_TE); int* tok_r = (int*)(F.ws + WS_TR);
    const float* wr = INP(15) + (size_t)l * 1024 * NE; const float* br = INP(16) + l * NE;
    const int lane0 = F.lane, tid = F.tid;
    LAS unsigned char* wl = F.lds;
    LAS int* sel_e = (LAS int*)(F.lds + TBL_RS); LAS float* sel_g = (LAS float*)(sel_e + 512); LAS int* sel_r = sel_e + 1024; LAS int* hist = sel_e + 1536; LAS int* base = hist + 32;
    __syncthreads();
    for (int idx = tid; idx < 1024 * 8; idx += NWAVES * 64) { const int k = idx >> 3, c = idx & 7, kp = (k & 3) * 256 + (k >> 2), cp = c ^ ((kp >> 1) & 7);
        *(LAS f32x4*)(wl + (kp * 8 + cp) * 16) = *(const GAS f32x4*)(wr + (size_t)k * NE + c * 4); }
    __syncthreads();
    for (int tile = F.bx; tile < T / 128; tile += F.G) {
        if (tid < 32) hist[tid] = 0;
        __syncthreads();
        f32x4 px[4]; unsigned long long po[4], pxb[4];
        {   const int t0 = tile * 128 + F.wave * 16; const GAS f32x4* xr0 = (const GAS f32x4*)(xcur + (size_t)t0 * D) + lane0; const GAS unsigned long long* or0 = (const GAS unsigned long long*)(outb + (size_t)t0 * D) + lane0;
#pragma unroll
            for (int j = 0; j < 4; ++j) { if (XBF) pxb[j] = ((const GAS unsigned long long*)(xcb + (size_t)t0 * D) + lane0)[64 * j]; else px[j] = xr0[64 * j]; po[j] = or0[64 * j]; } }
        for (int it = 0; it < 16; ++it) {
            int lane = lane0; asm volatile("" : "+v"(lane));
            const int sw = (lane >> 1) & 7; const float bias_e = br[(lane >> 1) & 31];
            const GAS f32x4* lgp = (const GAS f32x4*)(INP(13) + l * D) + lane; const GAS f32x4* lbp = (const GAS f32x4*)(INP(14) + l * D) + lane;
            const int tl = F.wave * 16 + it, t = tile * 128 + tl;
            f32x4 v[4]; float s = 0.f;
#pragma unroll
            for (int j = 0; j < 4; ++j) { const unsigned long long ow = po[j]; const unsigned olo = (unsigned)ow, ohi = (unsigned)(ow >> 32);
                f32x4 xv_; if (XBF) { const unsigned xlo = (unsigned)pxb[j], xhi = (unsigned)(pxb[j] >> 32); xv_ = (f32x4){bflo(xlo), bfhi(xlo), bflo(xhi), bfhi(xhi)}; } else xv_ = px[j];
                v[j] = xv_ * DN_ALPHA + (f32x4){bflo(olo), bfhi(olo), bflo(ohi), bfhi(ohi)}; s += (v[j].x + v[j].y) + (v[j].z + v[j].w); }
            if (it + 1 < 16) { const GAS f32x4* xr = (const GAS f32x4*)(xcur + (size_t)(t + 1) * D) + lane; const GAS unsigned long long* orr = (const GAS unsigned long long*)(outb + (size_t)(t + 1) * D) + lane;
#pragma unroll
                for (int j = 0; j < 4; ++j) { if (XBF) pxb[j] = ((const GAS unsigned long long*)(xcb + (size_t)(t + 1) * D) + lane)[64 * j]; else px[j] = xr[64 * j]; po[j] = orr[64 * j]; } }
            const float mean = wave_sum(s, lane) * (1.f / D); float s2 = 0.f;
#pragma unroll
            for (int j = 0; j < 4; ++j) { v[j] = v[j] - mean; s2 += (v[j].x * v[j].x + v[j].y * v[j].y) + (v[j].z * v[j].z + v[j].w * v[j].w); }
            const float rstd = 1.f / sqrtf(wave_sum(s2, lane) * (1.f / D) + LN_EPS);
            GAS unsigned long long* o8 = (GAS unsigned long long*)(x1b + (size_t)t * D) + lane;
#pragma unroll
            for (int j = 0; j < 4; ++j) { v[j] = v[j] * rstd * lgp[64 * j] + lbp[64 * j];
                o8[64 * j] = (unsigned long long)pk2(v[j].x, v[j].y) | ((unsigned long long)pk2(v[j].z, v[j].w) << 32);
                if (w8) ((GAS unsigned*)(x1f8 + (size_t)t * D))[64 * j + lane] = pg8::pk4_fp8(v[j].x * 16.0f, v[j].y * 16.0f, v[j].z * 16.0f, v[j].w * 16.0f); }
            float acc[32];
#pragma unroll
            for (int c = 0; c < 8; ++c) {
                int basec = lane * 128 + ((c ^ sw) << 4); asm volatile("" : "+v"(basec));
                const LAS unsigned char* wp = wl + basec;
                typedef float f32x2p __attribute__((ext_vector_type(2)));
                f32x2p a01 = {0.f, 0.f}, a23 = {0.f, 0.f};
#pragma unroll
                for (int i = 0; i < 4; ++i)
#pragma unroll
                    for (int j = 0; j < 4; ++j) { const f32x4 w = *(const LAS f32x4*)(wp + (i * 256 + 64 * j) * 128); const float xv = v[j][i]; const f32x2p x2 = {xv, xv};
                        a01 = __builtin_elementwise_fma(x2, (f32x2p){w.x, w.y}, a01); a23 = __builtin_elementwise_fma(x2, (f32x2p){w.z, w.w}, a23); }
                acc[4 * c + 0] = a01.x; acc[4 * c + 1] = a01.y; acc[4 * c + 2] = a23.x; acc[4 * c + 3] = a23.y;
            }
            float a16[16], a8[8], a4[4], a2[2], a1;
            { const bool b = (lane & 32) != 0;
#pragma unroll
              for (int i = 0; i < 16; ++i) { const float send = b ? acc[i] : acc[16 + i]; const float keep = b ? acc[16 + i] : acc[i]; a16[i] = keep + shx<32>(send, lane); } }
            { const bool b = (lane & 16) != 0;
#pragma unroll
              for (int i = 0; i < 8; ++i) { const float send = b ? a16[i] : a16[8 + i]; const float keep = b ? a16[8 + i] : a16[i]; a8[i] = keep + shx<16>(send, lane); } }
            { const bool b = (lane & 8) != 0;
#pragma unroll
              for (int i = 0; i < 4; ++i) { const float send = b ? a8[i] : a8[4 + i]; const float keep = b ? a8[4 + i] : a8[i]; a4[i] = keep + shx<8>(send, lane); } }
            { const bool b = (lane & 4) != 0;
#pragma unroll
              for (int i = 0; i < 2; ++i) { const float send = b ? a4[i] : a4[2 + i]; const float keep = b ? a4[2 + i] : a4[i]; a2[i] = keep + shx<4>(send, lane); } }
            { const bool b = (lane & 2) != 0; const float send = b ? a2[0] : a2[1]; const float keep = b ? a2[1] : a2[0]; a1 = keep + shx<2>(send, lane); }
            a1 += shx<1>(a1, lane);
            float val = a1 + bias_e; const int my_e = (lane >> 1) & 31;
            float sv[4]; int se[4];
#pragma unroll
            for (int r = 0; r < 4; ++r) { float bv = val; int be = my_e;
#define TOPK_STEP(O) { const float ov = shx<O>(bv, lane); const int oe = shxi<O>(be, lane); if (ov > bv || (ov == bv && oe < be)) { bv = ov; be = oe; } }
                TOPK_STEP(2) TOPK_STEP(4) TOPK_STEP(8) TOPK_STEP(16) TOPK_STEP(32)
#undef TOPK_STEP
                sv[r] = bv; se[r] = be; if (my_e == be) val = -INFINITY; }
            const float e1 = __expf(sv[1] - sv[0]), e2 = __expf(sv[2] - sv[0]), e3 = __expf(sv[3] - sv[0]); const float rs = 1.0f / (1.0f + e1 + e2 + e3);
            if (lane < 4) { const int ee = lane == 0 ? se[0] : lane == 1 ? se[1] : lane == 2 ? se[2] : se[3]; const float gg = (lane == 0 ? 1.0f : lane == 1 ? e1 : lane == 2 ? e2 : e3) * rs;
                const int a = tl * 4 + lane; sel_e[a] = ee; sel_g[a] = gg; sel_r[a] = __hip_atomic_fetch_add(&hist[ee], 1, __ATOMIC_RELAXED, __HIP_MEMORY_SCOPE_WORKGROUP); }
        }
        __syncthreads();
        if (tid < 32) base[tid] = (int)__hip_atomic_fetch_add(F.ctl + CW_CNT + 64 * l + tid, (unsigned)hist[tid], RLX_AGENT);
        __syncthreads();
        { const int a = tid, e = sel_e[a], rank = base[e] + sel_r[a], t = tile * 128 + (a >> 2);
          list_t[(size_t)e * LCAP + rank] = t; list_g[(size_t)e * LCAP + rank] = sel_g[a]; tok_e[t * 4 + (a & 3)] = e; tok_r[t * 4 + (a & 3)] = rank; }
        __syncthreads();
    }
}

__device__ __forceinline__ void p_gather(Frame& F, int l) {
    const int total = build_tables(F, l);
    LAS int* st = (LAS int*)(F.lds + TBL_START); LAS int* cn = st + 33;
    const bf16* x1b = (const bf16*)(F.ws + WS_X1B); bf16* xg = (bf16*)(F.ws + WS_H); float* sg = (float*)(F.ws + WS_SG);
    const int* list_t = (const int*)(F.ws + WS_LT); const float* list_g = (const float*)(F.ws + WS_LG);
    const int lane = F.lane, gw = F.vcu * NWAVES + F.wave, NGW = F.G * NWAVES;
    for (int s = gw; s < total; s += NGW) {
        const bool pr = (lane < NE) && (s >= st[lane & 31]);
        const int e = __popcll(__ballot(pr)) - 1; const int r = s - st[e];
        GAS v4u* dst = (GAS v4u*)(xg + (size_t)s * D);
        if (r < cn[e]) { const int t = list_t[(size_t)e * LCAP + r]; const GAS v4u* src = (const GAS v4u*)(x1b + (size_t)t * D);
            dst[lane] = src[lane]; dst[64 + lane] = src[64 + lane]; if (lane == 0) sg[s] = list_g[(size_t)e * LCAP + r]; }
        else { unsigned zz = 0u; asm volatile("" : "+v"(zz)); const v4u z4 = {zz, zz, zz, zz}; dst[lane] = z4; dst[64 + lane] = z4; if (lane == 0) sg[s] = 0.f; }
    }
}

__device__ __forceinline__ void p_ln2(Frame& F, int l, float* dst, bool write_f32, bool write_xb) {
    (void)build_tables(F, l);
    LAS int* st = (LAS int*)(F.lds + TBL_START);
    const bf16* x1b = (const bf16*)(F.ws + WS_X1B); const bf16* yb = (const bf16*)(F.ws + WS_H); bf16* xb = (bf16*)(F.ws + WS_XB);
    const int* tok_e = (const int*)(F.ws + WS_TE); const int* tok_r = (const int*)(F.ws + WS_TR);
    const int lane = F.lane, hl = lane & 31, half = lane >> 5, gw = F.vcu * NWAVES + F.wave, NGW = F.G * NWAVES;
    const float* lgp = INP(21) + l * D; const float* lbp = INP(22) + l * D;
    float dmult = 1.0f;
#if MK_DEBUG
    if (l == DEPTH - 1) { const unsigned mask = __hip_atomic_load(F.ctl + 20000, RLX_AGENT) & ~(unsigned)(MK_DBG_IGNORE); if (mask) dmult = 1.0f + (float)(__ffs((int)mask) - 1); }
#endif
    int t = 2 * gw + half;
    int e4 = 0, r4 = 0;
    if (t < T && hl < 4) { e4 = tok_e[t * 4 + hl]; r4 = tok_r[t * 4 + hl]; }
    v4u xn[4] = {{0u, 0u, 0u, 0u}, {0u, 0u, 0u, 0u}, {0u, 0u, 0u, 0u}, {0u, 0u, 0u, 0u}};
    if (t < T) { const GAS v4u* xr = (const GAS v4u*)(x1b + (size_t)t * D) + hl;
#pragma unroll
        for (int q = 0; q < 4; ++q) xn[q] = xr[32 * q]; }
    for (; t < T; t += 2 * NGW) {
        int slot4 = st[e4] + r4;
        const int tn = t + 2 * NGW; int e4n = 0, r4n = 0;
        if (tn < T && hl < 4) { e4n = tok_e[tn * 4 + hl]; r4n = tok_r[tn * 4 + hl]; }
        int slot[4];
#pragma unroll
        for (int k = 0; k < 4; ++k) slot[k] = __builtin_amdgcn_ds_bpermute((half * 32 + k) << 2, slot4);
        v4u xw[4], yw[4][4];
#pragma unroll
        for (int q = 0; q < 4; ++q) xw[q] = xn[q];
        if (tn < T) { const GAS v4u* xr = (const GAS v4u*)(x1b + (size_t)tn * D) + hl;
#pragma unroll
            for (int q = 0; q < 4; ++q) xn[q] = xr[32 * q]; }
#pragma unroll
        for (int k = 0; k < 4; ++k) { const GAS v4u* yr = (const GAS v4u*)(yb + (size_t)slot[k] * D) + hl;
#pragma unroll
            for (int q = 0; q < 4; ++q) yw[k][q] = yr[32 * q]; }
        float v[4][8]; float s = 0.f;
#pragma unroll
        for (int q = 0; q < 4; ++q) {
            v[q][0] = bflo(xw[q].x) * DN_ALPHA; v[q][1] = bfhi(xw[q].x) * DN_ALPHA; v[q][2] = bflo(xw[q].y) * DN_ALPHA; v[q][3] = bfhi(xw[q].y) * DN_ALPHA;
            v[q][4] = bflo(xw[q].z) * DN_ALPHA; v[q][5] = bfhi(xw[q].z) * DN_ALPHA; v[q][6] = bflo(xw[q].w) * DN_ALPHA; v[q][7] = bfhi(xw[q].w) * DN_ALPHA;
#pragma unroll
            for (int k = 0; k < 4; ++k) { v[q][0] += bflo(yw[k][q].x); v[q][1] += bfhi(yw[k][q].x); v[q][2] += bflo(yw[k][q].y); v[q][3] += bfhi(yw[k][q].y);
                v[q][4] += bflo(yw[k][q].z); v[q][5] += bfhi(yw[k][q].z); v[q][6] += bflo(yw[k][q].w); v[q][7] += bfhi(yw[k][q].w); }
#pragma unroll
            for (int i = 0; i < 8; ++i) s += v[q][i]; }
        s += shx<1>(s, lane); s += shx<2>(s, lane); s += shx<4>(s, lane); s += shx<8>(s, lane); s += shx<16>(s, lane);
        const float mean = s * (1.f / D); float s2 = 0.f;
#pragma unroll
        for (int q = 0; q < 4; ++q)
#pragma unroll
            for (int i = 0; i < 8; ++i) { v[q][i] -= mean; s2 += v[q][i] * v[q][i]; }
        s2 += shx<1>(s2, lane); s2 += shx<2>(s2, lane); s2 += shx<4>(s2, lane); s2 += shx<8>(s2, lane); s2 += shx<16>(s2, lane);
        const float rstd = 1.f / sqrtf(s2 * (1.f / D) + LN_EPS);
        GAS f32x4* orow = (GAS f32x4*)(dst + (size_t)t * D) + 2 * hl; GAS v4u* o16 = (GAS v4u*)(xb + (size_t)t * D) + hl;
#pragma unroll
        for (int q = 0; q < 4; ++q) { const GAS f32x4* gq = (const GAS f32x4*)(lgp + 256 * q) + 2 * hl; const GAS f32x4* bq = (const GAS f32x4*)(lbp + 256 * q) + 2 * hl;
            const f32x4 g0 = gq[0], g1 = gq[1], b0 = bq[0], b1 = bq[1];
            f32x4 y0 = {v[q][0] * rstd, v[q][1] * rstd, v[q][2] * rstd, v[q][3] * rstd}, y1 = {v[q][4] * rstd, v[q][5] * rstd, v[q][6] * rstd, v[q][7] * rstd};
            y0 = y0 * g0 + b0; y1 = y1 * g1 + b1;
            if (write_f32) { orow[64 * q] = y0 * dmult; orow[64 * q + 1] = y1 * dmult; }
            if (write_xb) { o16[32 * q] = (v4u){pk2(y0.x, y0.y), pk2(y0.z, y0.w), pk2(y1.x, y1.y), pk2(y1.z, y1.w)};
                if (F8IN(l + 1)) { typedef unsigned u32x2 __attribute__((ext_vector_type(2)));
                    ((GAS u32x2*)(F.ws + WS_X2 + (size_t)t * D))[hl + 32 * q] = (u32x2){pg8::pk4_fp8(y0.x * 16.f, y0.y * 16.f, y0.z * 16.f, y0.w * 16.f), pg8::pk4_fp8(y1.x * 16.f, y1.y * 16.f, y1.z * 16.f, y1.w * 16.f)}; } } }
        e4 = e4n; r4 = r4n;
    }
}

template <int WHICH> __device__ __forceinline__ void p_attention(Frame& F, int l) {
    const bf16* hb = (const bf16*)(F.ws + WS_H); unsigned char* a2 = F.ws + WS_A2;
    const bf16* kB = (const bf16*)(a2 + A2_KB); const bf16* kr = (const bf16*)(a2 + A2_KR); const bf16* qc = (const bf16*)(a2 + A2_QC); const bf16* kvc = (const bf16*)(a2 + A2_KVC);
    bf16* ya = (bf16*)(a2 + A2_YA); bf16* yb = (bf16*)(a2 + A2_YB); bf16* yc = (bf16*)(a2 + A2_YC);
    att::ALAS_PTR lds = (att::ALAS_PTR)F.lds;
    att::NoSide noside;
    __syncthreads();
    if (WHICH == 0) {
        float mq = fabsf((INP(3) + l * 64)[F.lane]), mk = fabsf((INP(4) + l * 64)[F.lane]);
#define MX_STEP(O) { mq = fmaxf(mq, shx<O>(mq, F.lane)); mk = fmaxf(mk, shx<O>(mk, F.lane)); }
        MX_STEP(1) MX_STEP(2) MX_STEP(4) MX_STEP(8) MX_STEP(16) MX_STEP(32)
#undef MX_STEP
        const float cref = __int_as_float(__builtin_amdgcn_readfirstlane(__float_as_int(8.0f * LOG2E_F * 1.03f * mq * mk)));
        const bool fixed_ok = cref < 60.0f;
        unsigned char* wbl = F.ws + WS_W + (size_t)l * WB_LAYER;
        MoeConv cv; cv.Wgu = INP(17) + (size_t)l * NE * 1024 * 2048; cv.Wdn = INP(19) + (size_t)l * NE * 1024 * 1024; cv.Tgu = wbl + WB_GU; cv.Tdn = wbl + WB_DN; cv.f8 = F8MOE(l);
        cv.scr = (LAS float*)(F.lds + CONV_LDS_OFF + F.wave * CONV_LDS_WAVE); cv.lane = F.lane; cv.ngw = F.G * NWAVES; cv.gw = F.vcu * NWAVES + F.wave; cv.s = 0;
        cv.nmini = 4 * ((CONV_ITEMS - cv.gw + cv.ngw - 1) / cv.ngw);
#pragma unroll
        for (int i_ = 0; i_ < 8; ++i_) { cv.cvA[i_] = 0.f; cv.cvB[i_] = 0.f; }
        for (int idx = F.vcu; idx < 768; idx += F.G) {
            const int qi = idx >> 8, rem = idx & 255, bk = rem >> 5, qb = rem & 31, b = bk >> 1, kvh = bk & 1, head = kvh * 3 + qi;
            att::UnitP u; const size_t tb = (size_t)b * SEQ, tq = tb + (size_t)qb * 256;
            u.Q = hb + tq * DINP + H_GQ + head * 64; u.ldq = DINP; u.K0 = kB + tb * 128 + kvh * 64; u.ldk0 = 128; u.K1 = nullptr; u.ldk1 = 0;
            u.V = hb + tb * DINP + H_GV + kvh * 64; u.ldv = DINP; u.O = yb + tq * 384 + head * 64; u.ldo = 384; u.nt = SEQ / 64; u.grow0 = qb * 4; u.gain = INP(3) + l * 64; u.kr0 = 0; u.cref = cref;
            if (fixed_ok) att::attn_unit<64, 0, MoeConv>(u, lds, F.tid, cv); else att::attn_unit<64, 3, MoeConv>(u, lds, F.tid, cv);
        }
        while (!cv.done()) { cv.step<0>(); cv.step<1>(); }
    }
    if (WHICH == 1) for (int idx = F.vcu; idx < 512; idx += F.G) {
        const int rnd = idx >> 8, rem = idx & 255, p = (rem >> 5) * 2 + rnd, qb = rem & 31, b = p >> 2, h = p & 3;
        att::UnitP u; const size_t tb = (size_t)b * SEQ, tq = tb + (size_t)qb * 256;
        u.Q = qc + tq * 384 + h * 96; u.ldq = 384; u.K0 = kvc + tb * 512 + h * 128; u.ldk0 = 512; u.K1 = kr + tb * 32; u.ldk1 = 32;
        u.V = kvc + tb * 512 + h * 128 + 64; u.ldv = 512; u.O = yc + tq * 384 + h * 64; u.ldo = 384; u.nt = SEQ / 64; u.grow0 = qb * 4; u.gain = nullptr; u.kr0 = 0; u.cref = 0.f;
        att::attn_unit<96, 1>(u, lds, F.tid, noside);
    }
    if (WHICH == 2) for (int idx = F.vcu; idx < 768; idx += F.G) {
        const int b = idx / 192, rem = idx % 192, h = rem >> 5, rg = rem & 31, R0 = rg * 4;
        int r_lo = R0 - 4; r_lo = r_lo < 0 ? 0 : (r_lo > 120 ? 120 : r_lo);
        int r_hi = R0 - 1; r_hi = (r_hi < 0 ? 0 : (r_hi > 120 ? 120 : r_hi)) + 8;
        if ((r_hi - r_lo) & 1) { if (r_hi < 128) ++r_hi; else --r_lo; }
        {
            LAS float* bt = (LAS float*)(F.lds + att::OFF_BIAS); const float* rp = INP(2) + ((size_t)l * 6 + h) * 465;
            if (F.tid < 465) bt[F.tid] = rp[F.tid] * LOG2E_F; }
        att::UnitP u; const size_t tb = (size_t)b * SEQ, tq = tb + (size_t)R0 * 64, tk = tb + (size_t)r_lo * 64;
        u.Q = hb + tq * DINP + H_NAQ + h * 64; u.ldq = DINP; u.K0 = hb + tk * DINP + H_NAK + h * 64; u.ldk0 = DINP; u.K1 = nullptr; u.ldk1 = 0;
        u.V = hb + tk * DINP + H_NAV + h * 64; u.ldv = DINP; u.O = ya + tq * 384 + h * 64; u.ldo = 384; u.nt = r_hi - r_lo; u.grow0 = R0; u.gain = nullptr; u.kr0 = r_lo; u.cref = 0.f;
        att::attn_unit<64, 2>(u, lds, F.tid, noside);
    }
}


struct Args { const float* in[23]; float* out; unsigned char* ws; int ph_lo, ph_hi, use_bar, pad; };
__global__ void __launch_bounds__(NWAVES * 64, 2) mk_fwd(Args args) {
    extern __shared__ __attribute__((aligned(16))) unsigned char lds[];
    const int wave_id = __builtin_amdgcn_readfirstlane((int)threadIdx.x >> 6), bx0 = blockIdx.x, G0 = gridDim.x;
    {   LAS unsigned* z = (LAS unsigned*)((LAS unsigned char*)lds + LDSCTL_OFF); for (int u = threadIdx.x; u < (LDS_BYTES - LDSCTL_OFF) / 4; u += NWAVES * 64) z[u] = 0u; }
    __syncthreads();
    XcdBarrier bar; bar.bar = (unsigned*)(args.ws + WS_CTL) + CW_BAR; bar.x = 0; bar.st = nullptr;
    if (args.use_bar) bar = xcd_barrier_post((unsigned*)(args.ws + WS_CTL) + CW_BAR, (volatile LAS unsigned*)((LAS unsigned char*)lds + MISC_OFF));
    const int lo = args.ph_lo, hi = args.ph_hi;
#define IN(k) (lo <= (k) && (k) < hi)
#define REPEAT(n) for (int rep_ = 0; rep_ < (n); ++rep_)
#define RSEAM(n) do { if (rep_ + 1 < (n)) { XcdBarrier b_ = bar; { GAS unsigned* bb_ = (GAS unsigned*)b_.bar; asm volatile("; rseam %1" : "+s"(bb_) : "n"(__COUNTER__)); b_.bar = (unsigned*)bb_; } xcd_barrier(b_); } } while (0)
#define SEAM(k) do { if (IN(k) && IN((k) + 1)) { XcdBarrier b_ = bar; { GAS unsigned* bb_ = (GAS unsigned*)b_.bar; asm volatile("; seam %1" : "+s"(bb_) : "n"(__COUNTER__)); b_.bar = (unsigned*)bb_; } xcd_barrier(b_); } } while (0)
#define FRAME() Frame F = mkframe<__COUNTER__>((LAS unsigned char*)lds, args.ws, args.out, wave_id, bx0, G0); unsigned char* ws = F.ws; unsigned char* a2 = ws + WS_A2; unsigned char* wb = ws + WS_W + (size_t)l * WB_LAYER; (void)a2; (void)wb

    if (IN(0)) REPEAT(REP_P) { Frame F = mkframe<__COUNTER__>((LAS unsigned char*)lds, args.ws, args.out, wave_id, bx0, G0); p_prologue(F); RSEAM(REP_P); } SEAM(0);

    for (int l = 0; l < DEPTH; ++l) {
        const int pb = 1 + l * PPL;
        if (IN(pb + 0)) REPEAT(REP_A) { FRAME();
            pg8::StaticOrder S; S.init(T, DINP, F.G, F.bx);
            if (!F8IN(l)) {
                pg8::Gemm g{(const bf16*)(ws + WS_XB), (const bf16*)(wb + WB_IN), T, DINP, 1024, 0, 0, nullptr};
                pg8::EpiStore E{(bf16*)(ws + WS_H), DINP, DINP, 1.0f};
                pg8::gemm_phase<pg8::EpiStore, pg8::StaticOrder, true, true>(F.lds, g, S, E, F.tid);
            } else {
                pg8::Gemm g{(const bf16*)(ws + WS_X2), (const bf16*)(wb + WB_IN), T, DINP, 1024, 0, 0, (const void*)ws};
                pg8::EpiStore E{(bf16*)(ws + WS_H), DINP, DINP, 1.0f / 512.0f};
                pg8::gemm_phase<pg8::EpiStore, pg8::StaticOrder, true, true, false, pg8::NoGather, 1>(F.lds, g, S, E, F.tid);
            }
            RSEAM(REP_A);
        } SEAM(pb + 0);
        if (IN(pb + 1)) REPEAT(REP_B) { FRAME(); p_prep(F, l); RSEAM(REP_B); } SEAM(pb + 1);
        if (IN(pb + 2)) REPEAT(REP_C) {
            { FRAME(); pg8::Gemm g{(const bf16*)(a2 + A2_CQN), (const bf16*)(wb + WB_UQ), T, 512, 384, 0, 0, nullptr}; pg8::StaticOrder S; S.init(T, 512, F.G, F.bx);
              pg8::EpiStore E{(bf16*)(a2 + A2_QC), 384, 384, 1.0f};
              pg8::gemm_phase<pg8::EpiStore, pg8::StaticOrder, true, true>(F.lds, g, S, E, F.tid); }
            { FRAME(); pg8::Gemm g{(const bf16*)(a2 + A2_CKVN), (const bf16*)(wb + WB_UKV), T, 512, 256, 0, 0, nullptr}; pg8::StaticOrder S; S.init(T, 512, F.G, F.bx);
              pg8::EpiStore E{(bf16*)(a2 + A2_KVC), 512, 512, 1.0f};
              pg8::gemm_phase<pg8::EpiStore, pg8::StaticOrder, true, true>(F.lds, g, S, E, F.tid); }
            RSEAM(REP_C);
        } SEAM(pb + 2);
        if (IN(pb + 3)) { REPEAT(REP_DG) { FRAME(); p_attention<0>(F, l); RSEAM(REP_DG); } REPEAT(REP_DM) { FRAME(); p_attention<1>(F, l); RSEAM(REP_DM); } REPEAT(REP_DN) { FRAME(); p_attention<2>(F, l); RSEAM(REP_DN); } } SEAM(pb + 3);
        if (IN(pb + 4)) REPEAT(REP_E) { FRAME();
            pg8::Gemm g{(const bf16*)(a2 + A2_YA), (const bf16*)(wb + WB_BA), T, 1024, 384, (size_t)1024 * 384 * 2, (size_t)T * 384 * 2, nullptr};
            pg8::ChainOrder S; S.so.init(T, 1024, F.G, F.bx); S.nch = 3;
            pg8::EpiGateChain E{(const bf16*)(ws + WS_H) + H_GATE, DINP, (bf16*)(a2 + A2_MIXED)};
            pg8::gemm_phase<pg8::EpiGateChain, pg8::ChainOrder, true, true>(F.lds, g, S, E, F.tid);
            RSEAM(REP_E);
        } SEAM(pb + 4);
        if (IN(pb + 5)) REPEAT(REP_F) { FRAME();
            pg8::Gemm g{(const bf16*)(a2 + A2_MIXED), (const bf16*)(wb + WB_OUT), T, 1024, 1024, 0, 0, nullptr}; pg8::StaticOrder S; S.init(T, 1024, F.G, F.bx);
            pg8::EpiStore E{(bf16*)(ws + WS_X1), 1024, 1024, 1.0f};
            pg8::gemm_phase<pg8::EpiStore, pg8::StaticOrder, true, true>(F.lds, g, S, E, F.tid); RSEAM(REP_F);
        } SEAM(pb + 5);
        if (IN(pb + 6)) { FRAME(); if (l == 0) p_ln1_router<false>(F, l, INP(0)); else p_ln1_router<true>(F, l, ws + WS_XB); } SEAM(pb + 6);
        const bool f8l = F8MOE(l);
        if (IN(pb + 7)) REPEAT(REP_I) { FRAME();
            const int total = build_tables(F, l);
            pg8::MoeOrder S{8, (total >> 8) * 8, F.G, F.vcu, (const LAS int*)(F.lds + TBL_TILEE)};
            pg8::MoeGather gs{(const int*)(ws + WS_LT), (const LAS int*)(F.lds + TBL_START), (const LAS int*)(F.lds + TBL_START) + 33, LCAP};
            if (!f8l) {
                pg8::Gemm g{(const bf16*)(ws + WS_X1B), (const bf16*)(wb + WB_GU), total, 2048, 1024, (size_t)2048 * 1024 * 2, 0, nullptr};
                pg8::EpiSwigluT<false> E{(void*)(ws + WS_A2), INP(18) + (size_t)l * NE * 2048, 1.0f, 1.0f};
                pg8::gemm_phase<pg8::EpiSwigluT<false>, pg8::MoeOrder, true, true, true, pg8::MoeGather>(F.lds, g, S, E, F.tid, gs);
            } else {
                pg8::Gemm g{(const bf16*)(ws + WS_X2), (const bf16*)(wb + WB_GU), total, 2048, 1024, (size_t)2048 * 1024, 0, (const void*)ws};
                pg8::EpiSwigluT<true> E{(void*)(ws + WS_A2), INP(18) + (size_t)l * NE * 2048, 1.0f / 1024.0f, 4.0f};
                pg8::gemm_phase<pg8::EpiSwigluT<true>, pg8::MoeOrder, true, true, true, pg8::MoeGather, 1>(F.lds, g, S, E, F.tid, gs);
            }
            RSEAM(REP_I);
        } SEAM(pb + 7);
        if (IN(pb + 8)) REPEAT(REP_J) { FRAME();
            const int total = build_tables(F, l);
            pg8::MoeOrder S{4, (total >> 8) * 4, F.G, F.vcu, (const LAS int*)(F.lds + TBL_TILEE)};
            if (!f8l) {
                pg8::Gemm g{(const bf16*)(ws + WS_A2), (const bf16*)(wb + WB_DN), total, 1024, 1024, (size_t)1024 * 1024 * 2, 0, nullptr};
                pg8::EpiDown E{(bf16*)(ws + WS_H), INP(20) + (size_t)l * NE * 1024, (const float*)(ws + WS_LG), (const LAS int*)(F.lds + TBL_START), (const LAS int*)(F.lds + TBL_START) + 33, LCAP, 1.0f};
                pg8::gemm_phase<pg8::EpiDown, pg8::MoeOrder, true, true>(F.lds, g, S, E, F.tid);
            } else {
                pg8::Gemm g{(const bf16*)(ws + WS_A2), (const bf16*)(wb + WB_DN), total, 1024, 1024, (size_t)1024 * 1024, 0, (const void*)ws};
                pg8::EpiDown E{(bf16*)(ws + WS_H), INP(20) + (size_t)l * NE * 1024, (const float*)(ws + WS_LG), (const LAS int*)(F.lds + TBL_START), (const LAS int*)(F.lds + TBL_START) + 33, LCAP, 1.0f / 512.0f};
                pg8::gemm_phase<pg8::EpiDown, pg8::MoeOrder, true, true, false, pg8::NoGather, 1>(F.lds, g, S, E, F.tid);
            }
            RSEAM(REP_J);
        } SEAM(pb + 8);
        if (IN(pb + 9)) REPEAT(REP_K) { FRAME(); RSEAM(REP_K); p_ln2(F, l, F.out, l == DEPTH - 1, l + 1 < DEPTH); }
        if (l + 1 < DEPTH) SEAM(pb + 9);
    }
#undef IN
#undef SEAM
}


#if MK_DEBUG
constexpr int CW_DBG = 20000;
__device__ __forceinline__ float bfr(float f) { return __uint_as_float(f2bf(f) << 16); }
__device__ __forceinline__ float bfv(const bf16* p) { return __uint_as_float(((unsigned)*p) << 16); }
__device__ __forceinline__ unsigned hsh(unsigned x) { x ^= x >> 16; x *= 0x7feb352du; x ^= x >> 15; x *= 0x846ca68bu; x ^= x >> 16; return x; }
__device__ __forceinline__ bool close_(float got, float ref, float rel, float abs_) { return fabsf(got - ref) <= rel * fabsf(ref) + abs_; }
__device__ __forceinline__ void ropecs(int i, int quarter, int s, float& c, float& sn) {
    const float pos = (i < quarter) ? (float)(s >> 6) : (float)(s & 63); const int m = (i < quarter) ? i : i - quarter;
    const float inv = exp2f(-(float)m / (float)quarter * 13.287712379549449f); const float ang = pos * inv * 0.15915494309189535f; c = __builtin_amdgcn_cosf(ang); sn = __builtin_amdgcn_sinf(ang);
}
#define DBG_FAIL(bit) atomicOr((unsigned*)(ws + WS_CTL) + CW_DBG, 1u << (bit))
template <int stage> __global__ void __launch_bounds__(256) dbg_kernel(Args args) {
    unsigned char* ws = args.ws; const int l = 0;
    const int gid = blockIdx.x * 256 + threadIdx.x;
    const bf16* hb = (const bf16*)(ws + WS_H); unsigned char* a2 = ws + WS_A2; unsigned char* wb = ws + WS_W + (size_t)l * WB_LAYER;
    const bf16* kB = (const bf16*)(a2 + A2_KB); const bf16* cqn = (const bf16*)(a2 + A2_CQN); const bf16* ckvn = (const bf16*)(a2 + A2_CKVN); const bf16* kr = (const bf16*)(a2 + A2_KR);
    const bf16* qc = (const bf16*)(a2 + A2_QC); const bf16* kvc = (const bf16*)(a2 + A2_KVC);
    const bf16* ya = (const bf16*)(a2 + A2_YA); const bf16* yb = (const bf16*)(a2 + A2_YB); const bf16* yc = (const bf16*)(a2 + A2_YC);
    const unsigned h1 = hsh(gid * 2654435761u + 12345u + stage * 977u), h2 = hsh(h1 + 0x9e3779b9u);
    const int t = h1 % T, s = t & (SEQ - 1), b = t / SEQ;
    if (stage == 0) {
        const int n = h2 % DIN; const float* x = args.in[0] + (size_t)t * D; const float* W = args.in[1];
        const float sc = (n < 384) ? 0.125f * LOG2E_F : 1.0f; float r = 0.f;
        for (int k = 0; k < 1024; ++k) r += bfr(x[k]) * bfr(W[(size_t)k * DIN + n] * sc);
        if (!close_(bfv(hb + (size_t)t * DINP + n), r, 0.02f, 0.02f)) DBG_FAIL(1);
    }
    if (stage == 1) {
        const bf16* hr = hb + (size_t)t * DINP;
        {   const int d = h2 % 128, head = d >> 6, dd = d & 63; float ssq = 0.f;
            for (int k = 0; k < 64; ++k) { const float v = bfv(hr + H_GK + head * 64 + k); ssq += v * v; }
            const float rstd = 1.0f / sqrtf(ssq / 64.0f + RMS_EPS); const float* g = args.in[4];
            const int i = dd & 31; const float y1 = bfv(hr + H_GK + head * 64 + i) * rstd * g[i], y2 = bfv(hr + H_GK + head * 64 + i + 32) * rstd * g[i + 32];
            float c, sn; ropecs(i, 16, s, c, sn); const float ref = (dd < 32) ? (y1 * c - y2 * sn) : (y1 * sn + y2 * c);
            if (!close_(bfv(kB + (size_t)t * 128 + d), ref, 0.02f, 0.01f)) DBG_FAIL(2); }
        {   const int d = h2 % 384; float ssq = 0.f; for (int k = 0; k < 384; ++k) { const float v = bfv(hr + H_CQ + k); ssq += v * v; }
            const float ref = bfv(hr + H_CQ + d) / sqrtf(ssq / 384.0f + RMS_EPS) * args.in[5][d];
            if (!close_(bfv(cqn + (size_t)t * 384 + d), ref, 0.02f, 0.01f)) DBG_FAIL(3); }
        {   const int d = h2 % 256; float ssq = 0.f; for (int k = 0; k < 256; ++k) { const float v = bfv(hr + H_CKV + k); ssq += v * v; }
            const float ref = bfv(hr + H_CKV + d) / sqrtf(ssq / 256.0f + RMS_EPS) * args.in[6][d];
            if (!close_(bfv(ckvn + (size_t)t * 256 + d), ref, 0.02f, 0.01f)) DBG_FAIL(4); }
        {   const int d = h2 % 32, i = d & 15; const float x1 = bfv(hr + H_KR + i), x2 = bfv(hr + H_KR + i + 16); float c, sn; ropecs(i, 8, s, c, sn);
            const float ref = (d < 16) ? (x1 * c - x2 * sn) : (x1 * sn + x2 * c);
            if (!close_(bfv(kr + (size_t)t * 32 + d), ref, 0.02f, 0.01f)) DBG_FAIL(5); }
    }
    if (stage == 2) {
        {   const int n = h2 % 384; float r = 0.f; const float sc = 0.10206207261596577f * LOG2E_F;
            for (int k = 0; k < 384; ++k) r += bfv(cqn + (size_t)t * 384 + k) * bfr(args.in[7][(size_t)k * 384 + n] * sc);
            if (!close_(bfv(qc + (size_t)t * 384 + n), r, 0.02f, 0.01f)) DBG_FAIL(6); }
        {   const int n = h2 % 512; float r = 0.f;
            for (int k = 0; k < 256; ++k) r += bfv(ckvn + (size_t)t * 256 + k) * bfr(args.in[8][(size_t)k * 512 + n]);
            if (!close_(bfv(kvc + (size_t)t * 512 + n), r, 0.02f, 0.02f)) DBG_FAIL(7); }
    }
    if (stage == 3) {
        const int gr = s >> 6, gc = s & 63;
        if (gid < 1024) {
            const int h = h2 % 6, dofs = ((h2 >> 8) & 1) * 32; float q[64], o[32];
            _Pragma("unroll") for (int d = 0; d < 64; ++d) { q[d] = bfv(hb + (size_t)t * DINP + H_NAQ + h * 64 + d); }
            _Pragma("unroll") for (int d = 0; d < 32; ++d) o[d] = 0.f;
            int r0 = gr - 4; r0 = r0 < 0 ? 0 : (r0 > 120 ? 120 : r0); int c0 = gc - 8; c0 = c0 < 0 ? 0 : (c0 > 48 ? 48 : c0);
            const float* rp = args.in[2] + (size_t)h * 465; float m = -1e30f, lsum = 0.f;
            for (int pass = 0; pass < 2; ++pass)
                for (int i = 0; i < 8; ++i) for (int j = 0; j < 16; ++j) { const int kr_ = r0 + i, kc = c0 + j; const size_t kt = (size_t)b * SEQ + kr_ * 64 + kc;
                    float sc = 0.f; _Pragma("unroll") for (int d = 0; d < 64; ++d) sc += q[d] * bfv(hb + kt * DINP + H_NAK + h * 64 + d);
                    sc += rp[(kr_ - gr + 7) * 31 + (kc - gc + 15)] * LOG2E_F;
                    if (pass == 0) m = fmaxf(m, sc); else { const float p = exp2f(sc - m); lsum += p; _Pragma("unroll") for (int d = 0; d < 32; ++d) o[d] += p * bfv(hb + kt * DINP + H_NAV + h * 64 + dofs + d); } }
            bool bad = false; _Pragma("unroll") for (int d = 0; d < 32; ++d) bad |= !close_(bfv(ya + (size_t)t * 384 + h * 64 + dofs + d), o[d] / lsum, 0.03f, 0.01f);
            if (bad) DBG_FAIL(8);
        } else if (gid < 1024 + 128) {
            const int head = h2 % 6, kvh = head / 3, dofs = ((h2 >> 8) & 1) * 32; float q[64], o[32]; float ssq = 0.f;
            _Pragma("unroll") for (int d = 0; d < 64; ++d) { q[d] = bfv(hb + (size_t)t * DINP + H_GQ + head * 64 + d); ssq += q[d] * q[d]; }
            _Pragma("unroll") for (int d = 0; d < 32; ++d) o[d] = 0.f;
            const float rstd = 1.0f / sqrtf(ssq / 64.0f + RMS_EPS);
            _Pragma("unroll") for (int d = 0; d < 64; ++d) q[d] = q[d] * rstd * args.in[3][d];
            _Pragma("unroll") for (int i = 0; i < 32; ++i) { float c, sn; ropecs(i, 16, s, c, sn); const float y1 = q[i], y2 = q[i + 32]; q[i] = y1 * c - y2 * sn; q[i + 32] = y1 * sn + y2 * c; }
            _Pragma("unroll") for (int d = 0; d < 64; ++d) q[d] = bfr(q[d] * 0.125f * LOG2E_F);
            float m = -1e30f, lsum = 0.f;
            for (int key = 0; key < SEQ; ++key) { const size_t kt = (size_t)b * SEQ + key; float sc = 0.f;
                _Pragma("unroll") for (int d = 0; d < 64; ++d) sc += q[d] * bfv(kB + kt * 128 + kvh * 64 + d);
                const float mn = fmaxf(m, sc), al = exp2f(m - mn), p = exp2f(sc - mn); m = mn; lsum = lsum * al + p;
                _Pragma("unroll") for (int d = 0; d < 32; ++d) o[d] = o[d] * al + p * bfv(hb + kt * DINP + H_GV + kvh * 64 + dofs + d); }
            bool bad = false; _Pragma("unroll") for (int d = 0; d < 32; ++d) bad |= !close_(bfv(yb + (size_t)t * 384 + head * 64 + dofs + d), o[d] / lsum, 0.03f, 0.003f);
            if (bad) DBG_FAIL(9);
        } else if (gid < 1024 + 256) {
            const int h = h2 % 4, dofs = ((h2 >> 8) & 1) * 32; float q[96], o[32];
            _Pragma("unroll") for (int d = 0; d < 96; ++d) q[d] = bfv(qc + (size_t)t * 384 + h * 96 + d);
            _Pragma("unroll") for (int i = 0; i < 16; ++i) { float c, sn; ropecs(i, 8, s, c, sn); const float y1 = q[64 + i], y2 = q[80 + i]; q[64 + i] = bfr(y1 * c - y2 * sn); q[80 + i] = bfr(y1 * sn + y2 * c); }
            _Pragma("unroll") for (int d = 0; d < 32; ++d) o[d] = 0.f;
            float m = -1e30f, lsum = 0.f;
            for (int key = 0; key < SEQ; ++key) { const size_t kt = (size_t)b * SEQ + key; float sc = 0.f;
                _Pragma("unroll") for (int d = 0; d < 64; ++d) sc += q[d] * bfv(kvc + kt * 512 + h * 128 + d);
                _Pragma("unroll") for (int d = 0; d < 32; ++d) sc += q[64 + d] * bfv(kr + kt * 32 + d);
                const float mn = fmaxf(m, sc), al = exp2f(m - mn), p = exp2f(sc - mn); m = mn; lsum = lsum * al + p;
                _Pragma("unroll") for (int d = 0; d < 32; ++d) o[d] = o[d] * al + p * bfv(kvc + kt * 512 + h * 128 + 64 + dofs + d); }
            bool bad = false; _Pragma("unroll") for (int d = 0; d < 32; ++d) bad |= !close_(bfv(yc + (size_t)t * 384 + h * 64 + dofs + d), o[d] / lsum, 0.03f, 0.003f);
            if (bad) DBG_FAIL(10);
        }
    }
    if (stage == 4) {
        const int n = h2 % 1024; float r = 0.f;
        { float a = 0.f; for (int k = 0; k < 384; ++k) a += bfv(ya + (size_t)t * 384 + k) * bfr(args.in[9][(size_t)k * 1024 + n]); r += a / (1.0f + expf(-bfv(hb + (size_t)t * DINP + H_GATE + n))); }
        { float a = 0.f; for (int k = 0; k < 384; ++k) a += bfv(yb + (size_t)t * 384 + k) * bfr(args.in[10][(size_t)k * 1024 + n]); r += a / (1.0f + expf(-bfv(hb + (size_t)t * DINP + H_GATE + 1024 + n))); }
        { float a = 0.f; for (int k = 0; k < 256; ++k) a += bfv(yc + (size_t)t * 384 + k) * bfr(args.in[11][(size_t)k * 1024 + n]); r += a / (1.0f + expf(-bfv(hb + (size_t)t * DINP + H_GATE + 2048 + n))); }
        if (!close_(bfv((const bf16*)(a2 + A2_MIXED) + (size_t)t * 1024 + n), r, 0.02f, 0.003f)) DBG_FAIL(11);
    }
    if (stage == 5) {
        const int n = h2 % 1024; float r = 0.f; const bf16* mx = (const bf16*)(a2 + A2_MIXED) + (size_t)t * 1024;
        for (int k = 0; k < 1024; ++k) r += bfv(mx + k) * bfr(args.in[12][(size_t)k * 1024 + n]);
        if (!close_(bfv((const bf16*)(ws + WS_X1) + (size_t)t * D + n), r, 0.02f, 0.002f)) DBG_FAIL(12);
    }
    if (stage == 6) {
        const bf16* x1 = (const bf16*)(ws + WS_X1B) + (size_t)t * D; const int* tok_e = (const int*)(ws + WS_TE); const int* tok_r = (const int*)(ws + WS_TR);
        const int* list_t = (const int*)(ws + WS_LT); const float* list_g = (const float*)(ws + WS_LG);
        float lg[32]; _Pragma("unroll") for (int e = 0; e < 32; ++e) lg[e] = args.in[16][e];
        for (int k = 0; k < 1024; ++k) { const float xv = bfv(x1 + k); _Pragma("unroll") for (int e = 0; e < 32; ++e) lg[e] += xv * args.in[15][(size_t)k * 32 + e]; }
        int se[4]; float sv[4]; unsigned used = 0;
        _Pragma("unroll") for (int r = 0; r < 4; ++r) { int be = -1; float bv = -INFINITY; _Pragma("unroll") for (int e = 0; e < 32; ++e) if (!((used >> e) & 1) && lg[e] > bv) { bv = lg[e]; be = e; } se[r] = be; sv[r] = bv; used |= 1u << be; }
        float fifth = -INFINITY; _Pragma("unroll") for (int e = 0; e < 32; ++e) if (!((used >> e) & 1)) fifth = fmaxf(fifth, lg[e]);
        const bool neartie = (sv[3] - fifth) < 3e-2f || (sv[0] - sv[1]) < 3e-2f || (sv[1] - sv[2]) < 3e-2f || (sv[2] - sv[3]) < 3e-2f;
        float den = 0.f; _Pragma("unroll") for (int r = 0; r < 4; ++r) den += expf(sv[r] - sv[0]);
        bool bad = false, badg = false;
        if (!neartie) _Pragma("unroll") for (int r = 0; r < 4; ++r) { const int e = tok_e[t * 4 + r], rk = tok_r[t * 4 + r]; if (e != se[r]) { bad = true; continue; }
            if (rk < 0 || rk >= LCAP || list_t[(size_t)e * LCAP + rk] != t) badg = true; else if (!close_(list_g[(size_t)e * LCAP + rk], expf(sv[r] - sv[0]) / den, 0.03f, 1e-3f)) badg = true; }
        if (bad) DBG_FAIL(13); if (badg) DBG_FAIL(14);
        { float sm = 0.f, sq = 0.f; for (int k = 0; k < 1024; ++k) { const float z = (bfv(x1 + k) - args.in[14][k]) / args.in[13][k]; sm += z; sq += z * z; }
          if (fabsf(sm / 1024.f) > 4e-3f || fabsf(sq / 1024.f - 1.0f) > 2e-2f) DBG_FAIL(19); }
    }
    if (stage >= 7 && stage <= 9) {
        __shared__ int st[33], cn[32];
        if (threadIdx.x == 0) { int a = 0; for (int e2 = 0; e2 < 32; ++e2) { cn[e2] = (int)((const unsigned*)(ws + WS_CTL))[CW_CNT + 64 * l + e2]; st[e2] = a; a += ((cn[e2] + 255) >> 8) << 8; } st[32] = a; }
        __syncthreads();
        const int total = st[32]; const int sl = h1 % total; int e = 0; for (int k = 1; k < 32; ++k) if (sl >= st[k]) e = k; const int r = sl - st[e];
        const int* list_t = (const int*)(ws + WS_LT); const float* list_g = (const float*)(ws + WS_LG); const float* sg = (const float*)(ws + WS_SG);
        if (stage == 7) { int sum = 0; for (int k = 0; k < 32; ++k) sum += cn[k]; if (sum != TK) DBG_FAIL(15); }
        if (stage == 7 && r < cn[e]) {
            const bf16* xg = (const bf16*)(ws + WS_X1B) + (size_t)list_t[(size_t)e * LCAP + r] * D; const int f = h2 % 1024; const float* W = args.in[17] + (size_t)e * 1024 * 2048;
            float g = args.in[18][e * 2048 + f], u = args.in[18][e * 2048 + 1024 + f];
            for (int k = 0; k < 1024; ++k) { const float xv = bfv(xg + k); g += xv * bfr(W[(size_t)k * 2048 + f]); u += xv * bfr(W[(size_t)k * 2048 + 1024 + f]); }
            g = fminf(g, 7.0f); u = fminf(fmaxf(u, -7.0f), 7.0f); const float ref = g / (1.0f + expf(-1.702f * g)) * (u + 1.0f);
            if (!close_(bfv((const bf16*)(ws + WS_A2) + (size_t)sl * 1024 + f), ref, 0.03f, 0.02f)) DBG_FAIL(16);
        }
        if (stage == 8 && r < cn[e]) {
            const bf16* ab = (const bf16*)(ws + WS_A2) + (size_t)sl * 1024; const int n = h2 % 1024; const float* W = args.in[19] + (size_t)e * 1024 * 1024;
            float y = args.in[20][e * 1024 + n]; for (int k = 0; k < 1024; ++k) y += bfv(ab + k) * bfr(W[(size_t)k * 1024 + n]);
            y *= list_g[(size_t)e * LCAP + r];
            if (!close_(bfv((const bf16*)(ws + WS_H) + (size_t)sl * 1024 + n), y, 0.03f, 0.005f)) DBG_FAIL(17);
        }
        if (stage == 9) {
            const bf16* x1 = (const bf16*)(ws + WS_X1B) + (size_t)t * D; const int* tok_e = (const int*)(ws + WS_TE); const int* tok_r = (const int*)(ws + WS_TR);
            const bf16* ybf = (const bf16*)(ws + WS_H); float sm = 0.f, sq = 0.f; const int n = h2 % 1024; float vn = 0.f;
            for (int k = 0; k < 1024; ++k) { float v = DN_ALPHA * bfv(x1 + k); for (int q = 0; q < 4; ++q) v += bfv(ybf + (size_t)(st[tok_e[t * 4 + q]] + tok_r[t * 4 + q]) * D + k); sm += v; sq += v * v; if (k == n) vn = v; }
            const float mean = sm / 1024.f, var = sq / 1024.f - mean * mean; const float ref = (vn - mean) / sqrtf(var + LN_EPS) * args.in[21][n] + args.in[22][n];
            if (!close_(bfv((const bf16*)(ws + WS_XB) + (size_t)t * D + n), ref, 0.01f, 0.01f)) DBG_FAIL(18);
        }
    }
}
static void dbg_launch(int stage, const Args& a, hipStream_t stream) {
    switch (stage) {
#define DBGL(k) case k: hipLaunchKernelGGL(dbg_kernel<k>, dim3(8), dim3(256), 0, stream, a); break;
        DBGL(0) DBGL(1) DBGL(2) DBGL(3) DBGL(4) DBGL(5) DBGL(6) DBGL(7) DBGL(8) DBGL(9)
#undef DBGL
    }
}
#endif

extern "C" void kernel_launch(void* const* d_in, const int* in_sizes, int n_in, void* d_out, int out_size, void* d_ws, size_t ws_size, hipStream_t stream) {
    static int grid = 0;
    if (grid == 0) {
        if (n_in != 23 || in_sizes[0] != T * D || out_size != T * D || ws_size < WS_END) { fprintf(stderr, "kernel_launch: unexpected shapes / workspace (%d inputs, ws %zu, need %zu)\n", n_in, ws_size, (size_t)WS_END); grid = -1; return; }
        int dev = 0, cus = 0, per_cu = 0;
        if (hipGetDevice(&dev) != hipSuccess || hipDeviceGetAttribute(&cus, hipDeviceAttributeMultiprocessorCount, dev) != hipSuccess) { grid = -1; return; }
        if (hipFuncSetAttribute((const void*)mk_fwd, hipFuncAttributeMaxDynamicSharedMemorySize, LDS_BYTES) != hipSuccess) { fprintf(stderr, "kernel_launch: hipFuncSetAttribute failed\n"); grid = -1; return; }
        if (hipOccupancyMaxActiveBlocksPerMultiprocessor(&per_cu, (const void*)mk_fwd, NWAVES * 64, LDS_BYTES) != hipSuccess || per_cu < 1) { fprintf(stderr, "kernel_launch: occupancy query reports %d\n", per_cu); }
        (void)hipGetLastError();
        grid = cus;
    }
    if (grid < 0) return;
    if (hipMemsetAsync((char*)d_ws + WS_CTL, 0, CTL_ZERO_BYTES, stream) != hipSuccess) return;
    Args a{};
    for (int i = 0; i < 23; ++i) a.in[i] = (const float*)d_in[i];
    a.out = (float*)d_out; a.ws = (unsigned char*)d_ws; a.pad = 0;
#if MK_ONE_LAUNCH
    a.ph_lo = 0; a.ph_hi = NPH; a.use_bar = 1;
    hipLaunchKernelGGL(mk_fwd, dim3(grid), dim3(NWAVES * 64), LDS_BYTES, stream, a);
#else
    for (int p = 0; p < NPH; ++p) { a.ph_lo = p; a.ph_hi = p + 1; a.use_bar = 0; hipLaunchKernelGGL(mk_fwd, dim3(grid), dim3(NWAVES * 64), LDS_BYTES, stream, a);
#if MK_DEBUG
        if (p >= 1 && p <= PPL) dbg_launch(p - 1, a, stream);
#endif
    }
#endif
    const hipError_t le = hipPeekAtLastError();
    if (le != hipSuccess) fprintf(stderr, "kernel_launch: launch failed: %s\n", hipGetErrorName(le));
}
```

```cpp
#define MK_DEBUG 0
#define MK_ONE_LAUNCH 1
#include <hip/hip_runtime.h>
#include <hip/hip_bf16.h>
#include <cstdio>
#include <cstdint>
namespace pg8 {
#define PG8_LAS __attribute__((address_space(3)))
typedef unsigned short bf16_t;
typedef short bf16x8 __attribute__((ext_vector_type(8)));
typedef float f32x4 __attribute__((ext_vector_type(4)));
typedef unsigned u32x4 __attribute__((ext_vector_type(4)));
constexpr int BM = 256, BK = 64, HALF = 128, HTB = HALF * BK * 2  , STAGE_BYTES = 8 * HTB, NXCD = 8, WGM = 8;

__host__ __device__ __forceinline__ int lds_byte(int r, int c) { const int st = (r >> 4) * 2 + (c >> 5), rr = r & 15, cc = c & 31, ob = rr * 64 + cc * 2; return st * 1024 + (ob ^ (((ob >> 9) & 1) << 5)); }
__host__ __device__ __forceinline__ void stage_rc(int b, int& R, int& C) { const int st = b / 1024, sb = b % 1024, swz = sb ^ (((sb >> 9) & 1) << 5); R = (st >> 1) * 16 + swz / 64; C = (st & 1) * 32 + (swz % 64) / 2; }
__host__ __device__ __forceinline__ int perm32(int rho) { const int n = rho >> 4, i = rho & 15; return 8 * (i >> 2) + 4 * n + (i & 3); }

struct Unit { int pm, pn, e; };
struct Gemm { const bf16_t* A; const bf16_t* Bt; int M, N, K; size_t bstride; size_t astride; const void* base; };

struct StaticOrder {
    int nM, nN, nwg, G, c;
    __host__ __device__ void init(int M, int N, int G_, int c_) { nM = M / BM; nN = N / BM; nwg = nM * nN; G = G_; c = c_; }
    __host__ __device__ bool next(int i, Unit& u) const {
        const long L = (long)i * G + c; if (L >= nwg) return false;
        int wgid = (int)L; { const int q = nwg / NXCD, r = nwg % NXCD, xcd = wgid % NXCD, off = wgid / NXCD; wgid = (xcd < r ? xcd * (q + 1) : r * (q + 1) + (xcd - r) * q) + off; }
        const int nig = WGM * nN, gid = wgid / nig, fm = gid * WGM, gsz = (nM - fm) < WGM ? (nM - fm) : WGM;
        u.pm = fm + ((wgid % nig) % gsz); u.pn = (wgid % nig) / gsz; u.e = 0; return true;
    }
    __device__ __forceinline__ void a_ready(const Unit&) const {}
    __device__ __forceinline__ void done(const Unit&) const {}
};

__device__ __forceinline__ unsigned cvt_pk_bf16(float lo, float hi) { unsigned r; asm volatile("v_cvt_pk_bf16_f32 %0, %1, %2" : "=v"(r) : "v"(lo), "v"(hi)); return r; }
typedef float f32x2 __attribute__((ext_vector_type(2)));


__device__ __forceinline__ float bf_lo(unsigned w) { return __uint_as_float(w << 16); }
__device__ __forceinline__ float bf_hi(unsigned w) { return __uint_as_float(w & 0xffff0000u); }
__device__ __forceinline__ float sigmoidf_(float z) { return __builtin_amdgcn_rcpf(1.0f + __builtin_amdgcn_exp2f(-1.4426950408889634f * z)); }
__device__ __forceinline__ u32x4 pack8(const f32x4& v0, const f32x4& v1) { u32x4 w; w.x = cvt_pk_bf16(v0[0], v0[1]); w.y = cvt_pk_bf16(v0[2], v0[3]); w.z = cvt_pk_bf16(v1[0], v1[1]); w.w = cvt_pk_bf16(v1[2], v1[3]); return w; }
__device__ __forceinline__ float sat8(float v) { return __builtin_amdgcn_fmed3f(v, -448.0f, 448.0f); }
__device__ __forceinline__ unsigned pk4_fp8(float a, float b, float c, float d) { int r = __builtin_amdgcn_cvt_pk_fp8_f32(sat8(a), sat8(b), 0, false); r = __builtin_amdgcn_cvt_pk_fp8_f32(sat8(c), sat8(d), r, true); return (unsigned)r; }

struct EpiStore {
    static constexpr bool PERM = true, AFTER_DRAIN = false, CHAIN = false;
    bf16_t* O; int ldc; int nvalid; float ascale;
    __device__ __forceinline__ void operator()(const f32x4 (&acc)[2][2][4][2], const Unit& u, int wr, int wc, int fr, int fq) const {
        const int row0 = u.pm * BM + wr * 64 + fr, col0 = u.pn * BM + wc * 32 + 8 * fq;
#pragma unroll
        for (int ai = 0; ai < 2; ++ai)
#pragma unroll
            for (int m = 0; m < 4; ++m) { bf16_t* rowp = O + (size_t)(row0 + ai * HALF + m * 16) * ldc + col0;
#pragma unroll
                for (int bj = 0; bj < 2; ++bj) { if (col0 + bj * HALF < nvalid) *(u32x4*)(rowp + bj * HALF) = pack8(acc[ai][bj][m][0] * ascale, acc[ai][bj][m][1] * ascale); } }
    }
};
struct EpiGateChain {
    static constexpr bool PERM = true, AFTER_DRAIN = false, CHAIN = true;
    const bf16_t* gate; int ldg; void* mixed; float oscale;
    __device__ __forceinline__ void chain(f32x4 (&acc)[2][2][4][2], const Unit& u, int wr, int wc, int fr, int fq) const {
        const int row0 = u.pm * BM + wr * 64 + fr, col0 = u.pn * BM + wc * 32 + 8 * fq;
#pragma unroll
        for (int ai = 0; ai < 2; ++ai)
#pragma unroll
            for (int m = 0; m < 4; ++m) { const size_t row = (size_t)(row0 + ai * HALF + m * 16);
#pragma unroll
                for (int bj = 0; bj < 2; ++bj) { const int col = col0 + bj * HALF;
                    const u32x4 ga = *(const u32x4*)(gate + row * ldg + u.e * 1024 + col);
                    f32x4 na0 = {1.f + __builtin_amdgcn_exp2f(-1.4426950408889634f * bf_lo(ga.x)), 1.f + __builtin_amdgcn_exp2f(-1.4426950408889634f * bf_hi(ga.x)), 1.f + __builtin_amdgcn_exp2f(-1.4426950408889634f * bf_lo(ga.y)), 1.f + __builtin_amdgcn_exp2f(-1.4426950408889634f * bf_hi(ga.y))};
                    f32x4 na1 = {1.f + __builtin_amdgcn_exp2f(-1.4426950408889634f * bf_lo(ga.z)), 1.f + __builtin_amdgcn_exp2f(-1.4426950408889634f * bf_hi(ga.z)), 1.f + __builtin_amdgcn_exp2f(-1.4426950408889634f * bf_lo(ga.w)), 1.f + __builtin_amdgcn_exp2f(-1.4426950408889634f * bf_hi(ga.w))};
                    f32x4 f0, f1;
#pragma unroll
                    for (int q = 0; q < 4; ++q) { f0[q] = __builtin_amdgcn_rcpf(na0[q]); f1[q] = __builtin_amdgcn_rcpf(na1[q]); }
                    if (u.e < 2) { const u32x4 gb = *(const u32x4*)(gate + row * ldg + (u.e + 1) * 1024 + col);
                        f0[0] *= 1.f + __builtin_amdgcn_exp2f(-1.4426950408889634f * bf_lo(gb.x)); f0[1] *= 1.f + __builtin_amdgcn_exp2f(-1.4426950408889634f * bf_hi(gb.x));
                        f0[2] *= 1.f + __builtin_amdgcn_exp2f(-1.4426950408889634f * bf_lo(gb.y)); f0[3] *= 1.f + __builtin_amdgcn_exp2f(-1.4426950408889634f * bf_hi(gb.y));
                        f1[0] *= 1.f + __builtin_amdgcn_exp2f(-1.4426950408889634f * bf_lo(gb.z)); f1[1] *= 1.f + __builtin_amdgcn_exp2f(-1.4426950408889634f * bf_hi(gb.z));
                        f1[2] *= 1.f + __builtin_amdgcn_exp2f(-1.4426950408889634f * bf_lo(gb.w)); f1[3] *= 1.f + __builtin_amdgcn_exp2f(-1.4426950408889634f * bf_hi(gb.w)); }
                    acc[ai][bj][m][0] *= f0; acc[ai][bj][m][1] *= f1;
                    if (u.e == 2) { if (oscale == 0.f) *(u32x4*)((bf16_t*)mixed + row * 1024 + col) = pack8(acc[ai][bj][m][0], acc[ai][bj][m][1]);
                        else { typedef unsigned u32x2 __attribute__((ext_vector_type(2))); const f32x4 a0 = acc[ai][bj][m][0] * oscale, a1 = acc[ai][bj][m][1] * oscale;
                            *(u32x2*)((unsigned char*)mixed + row * 1024 + col) = (u32x2){pk4_fp8(a0[0], a0[1], a0[2], a0[3]), pk4_fp8(a1[0], a1[1], a1[2], a1[3])}; } } } }
    }
};
struct ChainOrder {
    StaticOrder so; int nch;
    __device__ __forceinline__ bool next(int i, Unit& u) const { const int t = i / nch; if (!so.next(t, u)) return false; u.e = i - t * nch; return true; }
    __device__ __forceinline__ void a_ready(const Unit&) const {}
    __device__ __forceinline__ void done(const Unit&) const {}
};
struct EpiResid {
    static constexpr bool PERM = true, AFTER_DRAIN = false, CHAIN = false;
    const float* x; float* pre; float alpha;
    __device__ __forceinline__ void operator()(const f32x4 (&acc)[2][2][4][2], const Unit& u, int wr, int wc, int fr, int fq) const {
        const int row0 = u.pm * BM + wr * 64 + fr, col0 = u.pn * BM + wc * 32 + 8 * fq;
#pragma unroll
        for (int ai = 0; ai < 2; ++ai)
#pragma unroll
            for (int m = 0; m < 4; ++m) { const size_t row = (size_t)(row0 + ai * HALF + m * 16);
#pragma unroll
                for (int bj = 0; bj < 2; ++bj) { const size_t off = row * 1024 + col0 + bj * HALF;
                    const f32x4 x0 = *(const f32x4*)(x + off), x1 = *(const f32x4*)(x + off + 4);
                    *(f32x4*)(pre + off) = x0 * alpha + acc[ai][bj][m][0]; *(f32x4*)(pre + off + 4) = x1 * alpha + acc[ai][bj][m][1]; } }
    }
};
template <bool OUT8> struct EpiSwigluT {
    static constexpr bool PERM = true, AFTER_DRAIN = false, CHAIN = false;
    void* a; const float* bias; float ascale, oscale;
    __device__ __forceinline__ void operator()(const f32x4 (&acc)[2][2][4][2], const Unit& u, int wr, int wc, int fr, int fq) const {
        const int row0 = u.pm * BM + wr * 64 + fr, j0 = wc * 32 + 8 * fq, oc = u.pn * HALF + j0;
        const float* bg = bias + (size_t)u.e * 2048 + oc; const float* bu = bg + 1024;
        const f32x4 bg0 = *(const f32x4*)bg, bg1 = *(const f32x4*)(bg + 4), bu0 = *(const f32x4*)bu, bu1 = *(const f32x4*)(bu + 4);
#pragma unroll
        for (int ai = 0; ai < 2; ++ai)
#pragma unroll
            for (int m = 0; m < 4; ++m) { const size_t row = (size_t)(row0 + ai * HALF + m * 16);
                f32x4 g[2] = {acc[ai][0][m][0] * ascale + bg0, acc[ai][0][m][1] * ascale + bg1}, uu[2] = {acc[ai][1][m][0] * ascale + bu0, acc[ai][1][m][1] * ascale + bu1}, r[2];
#pragma unroll
                for (int n = 0; n < 2; ++n)
#pragma unroll
                    for (int q = 0; q < 4; ++q) { const float gg = fminf(g[n][q], 7.0f), uc = fminf(fmaxf(uu[n][q], -7.0f), 7.0f);
                        r[n][q] = gg * sigmoidf_(1.702f * gg) * (uc + 1.0f); }
                if constexpr (OUT8) { typedef unsigned u32x2 __attribute__((ext_vector_type(2)));
                    *(u32x2*)((unsigned char*)a + row * 1024 + oc) = (u32x2){pk4_fp8(r[0][0] * oscale, r[0][1] * oscale, r[0][2] * oscale, r[0][3] * oscale), pk4_fp8(r[1][0] * oscale, r[1][1] * oscale, r[1][2] * oscale, r[1][3] * oscale)}; }
                else *(u32x4*)((bf16_t*)a + row * 1024 + oc) = pack8(r[0], r[1]);
                asm volatile("" ::: "memory"); }
    }
};
struct EpiDown {
    static constexpr bool PERM = true, AFTER_DRAIN = false, CHAIN = false;
    bf16_t* y; const float* bias; const float* list_g; const PG8_LAS int* st; const PG8_LAS int* cn; int lcap; float ascale;
    __device__ __forceinline__ void operator()(const f32x4 (&acc)[2][2][4][2], const Unit& u, int wr, int wc, int fr, int fq) const {
        const int row0 = u.pm * BM + wr * 64 + fr, col0 = u.pn * BM + wc * 32 + 8 * fq;
        const int st_e = st[u.e], cn_e = cn[u.e];
        f32x4 bv[2][2];
#pragma unroll
        for (int bj = 0; bj < 2; ++bj)
#pragma unroll
            for (int n = 0; n < 2; ++n) bv[bj][n] = *(const f32x4*)(bias + (size_t)u.e * 1024 + col0 + bj * HALF + 4 * n);
#pragma unroll
        for (int ai = 0; ai < 2; ++ai)
#pragma unroll
            for (int m = 0; m < 4; ++m) { const size_t row = (size_t)(row0 + ai * HALF + m * 16); const int rank = (int)row - st_e;
                const float gt = rank < cn_e ? list_g[(size_t)u.e * lcap + rank] : 0.f;
#pragma unroll
                for (int bj = 0; bj < 2; ++bj) { const f32x4 v0 = (acc[ai][bj][m][0] * ascale + bv[bj][0]) * gt, v1 = (acc[ai][bj][m][1] * ascale + bv[bj][1]) * gt;
                    *(u32x4*)(y + row * 1024 + col0 + bj * HALF) = pack8(v0, v1); } }
    }
};
struct MoeGather {
    const int* list_t; const PG8_LAS int* st; const PG8_LAS int* cn; int lcap;
    __device__ __forceinline__ int row(const Unit& u, int r) const { int rank = u.pm * BM + r - st[u.e]; const int c = cn[u.e]; rank = rank < c ? rank : c - 1; return list_t[(size_t)u.e * lcap + rank]; }
};
struct MoeOrder {
    int nN, nunits, G, c; const PG8_LAS int* tile_e;
    __device__ __forceinline__ bool next(int i, Unit& u) const {
        const long L = (long)i * G + c; if (L >= nunits) return false;
        const int tile = (int)L / nN; u.pm = tile; u.pn = (int)L % nN; u.e = __builtin_amdgcn_readfirstlane(tile_e[tile]); return true;
    }
    __device__ __forceinline__ void a_ready(const Unit&) const {}
    __device__ __forceinline__ void done(const Unit&) const {}
};

template <int ES> struct PtSel { typedef const char* T; static __device__ __forceinline__ T mk(const char* p, const char*) { return p; } };
template <> struct PtSel<1> { typedef unsigned T; static __device__ __forceinline__ T mk(const char* p, const char* base) { return (unsigned)(size_t)(p - base); } };
struct NoGather { };
typedef int i32x8 __attribute__((ext_vector_type(8)));
template <class Epi, class Sched, bool ALIGN_EPI = false, bool SP2 = false, bool GATHER = false, class GS = NoGather, int ESIZE = 2>
__device__ __forceinline__ void gemm_phase(PG8_LAS unsigned char* lds, const Gemm g, const Sched& S, const Epi& E, const int tid, const GS gs = GS()) {
    const int wid = __builtin_amdgcn_readfirstlane(tid >> 6), lane = tid & 63, wr = wid >> 2, wc = wid & 3, fr = lane & 15, fq = lane >> 4;
    const int K = g.K * ESIZE / 2; int nt = K / BK;
    if constexpr (ESIZE == 1) asm volatile("" : "+s"(nt));
    int sc8 = 0x7F7F7F7F; if constexpr (ESIZE == 1) asm volatile("" : "+v"(sc8));
    typedef typename PtSel<ESIZE>::T PT;
    __amdgpu_buffer_rsrc_t rsrc = __builtin_amdgcn_make_buffer_rsrc((void*)g.base, 0, 0x7fffffff, 0x00020000);
#define PG8_PT(p) PtSel<ESIZE>::mk((const char*)(p), (const char*)g.base)
    unsigned voffA[2], voffB[2];
#pragma unroll
    for (int i = 0; i < 2; ++i) { int R, C; stage_rc(tid * 16 + i * 8192, R, C); const int Rb = Epi::PERM ? ((R & ~31) + perm32(R & 31)) : R;
        voffA[i] = (unsigned)(R * K + C) * 2u; voffB[i] = (unsigned)(Rb * K + C) * 2u; }
    unsigned vc0[2], vc1[2], vn0[2], vn1[2];
#define PG8_GROWS(u_, o0, o1) do { _Pragma("unroll") for (int i_ = 0; i_ < 2; ++i_) { int R_, C_; stage_rc(tid * 16 + i_ * 8192, R_, C_); \
        o0[i_] = (unsigned)gs.row((u_), R_) * (unsigned)(K * 2) + (unsigned)(C_ * 2); o1[i_] = (unsigned)gs.row((u_), HALF + R_) * (unsigned)(K * 2) + (unsigned)(C_ * 2); } } while (0)
    const size_t kstep = (size_t)(BK * 2);
    const size_t hstep = (size_t)HALF * K * 2;
    const size_t tstep = 2 * hstep;
    const unsigned ldsw = (unsigned)wid * 1024u;
    const int aoff = lds_byte(wr * 64 + fr, fq * 8), boff = lds_byte(wc * 32 + fr, fq * 8);
#define PG8_SA(b, h) (((b) * 2 + (h)) * HTB)
#define PG8_SB(b, h) ((4 + (b) * 2 + (h)) * HTB)
#define PG8_STAGE(bufoff, gbase, voff) do { _Pragma("unroll") for (int _i = 0; _i < 2; ++_i) { \
        if constexpr (ESIZE == 2) __builtin_amdgcn_global_load_lds((const unsigned*)((const char*)(size_t)(gbase) + (voff)[_i]), (PG8_LAS unsigned*)(lds + (bufoff) + ldsw + _i * 8192), 16, 0, 0); \
        else __builtin_amdgcn_raw_ptr_buffer_load_lds(rsrc, (PG8_LAS void*)(lds + (bufoff) + ldsw + _i * 8192), 16, (int)(voff)[_i], (int)(size_t)(gbase), 0, 0); } } while (0)
typedef int i32x4_ __attribute__((ext_vector_type(4)));
#define PG8_LD8(off) __builtin_shufflevector(*(const PG8_LAS i32x4_*)(lds + (off)), *(const PG8_LAS i32x4_*)(lds + (off) + 1024), 0, 1, 2, 3, 4, 5, 6, 7)
#define PG8_LDA(dst, b, h) do { if constexpr (ESIZE == 2) { _Pragma("unroll") for (int m = 0; m < 4; ++m) _Pragma("unroll") for (int k = 0; k < 2; ++k) dst[m][k] = *(const PG8_LAS bf16x8*)(lds + PG8_SA(b, h) + aoff + m * 2048 + k * 1024); } \
        else { _Pragma("unroll") for (int m = 0; m < 4; ++m) dst##8[m] = PG8_LD8(PG8_SA(b, h) + aoff + m * 2048); } } while (0)
#define PG8_LDB(dst, b, h) do { if constexpr (ESIZE == 2) { _Pragma("unroll") for (int n = 0; n < 2; ++n) _Pragma("unroll") for (int k = 0; k < 2; ++k) dst[n][k] = *(const PG8_LAS bf16x8*)(lds + PG8_SB(b, h) + boff + n * 2048 + k * 1024); } \
        else { _Pragma("unroll") for (int n = 0; n < 2; ++n) dst##8[n] = PG8_LD8(PG8_SB(b, h) + boff + n * 2048); } } while (0)
#define PG8_F8CAT(x, y) (i32x8){((const int*)&(x))[0], ((const int*)&(x))[1], ((const int*)&(x))[2], ((const int*)&(x))[3], ((const int*)&(y))[0], ((const int*)&(y))[1], ((const int*)&(y))[2], ((const int*)&(y))[3]}
#define PG8_MMA(ai, bj, At, Bt) do { __builtin_amdgcn_s_setprio(1); if constexpr (ESIZE == 2) { _Pragma("unroll") for (int m = 0; m < 4; ++m) _Pragma("unroll") for (int n = 0; n < 2; ++n) _Pragma("unroll") for (int k = 0; k < 2; ++k) \
        acc[ai][bj][m][n] = __builtin_amdgcn_mfma_f32_16x16x32_bf16(Bt[n][k], At[m][k], acc[ai][bj][m][n], 0, 0, 0); } \
        else { _Pragma("unroll") for (int m = 0; m < 4; ++m) _Pragma("unroll") for (int n = 0; n < 2; ++n) \
        asm volatile("v_mfma_scale_f32_16x16x128_f8f6f4 %0, %1, %2, %0, %3, %3 op_sel_hi:[0,0,0]" : "+v"(acc[ai][bj][m][n]) : "v"(Bt##8[n]), "v"(At##8[m]), "v"(sc8)); \
        }   \
        __builtin_amdgcn_s_setprio(0); } while (0)
#define PG8_WAIT_V(n) asm volatile("s_waitcnt vmcnt(" #n ")" ::: "memory")
#define PG8_WAIT_L(n) asm volatile("s_waitcnt lgkmcnt(" #n ")" ::: "memory")
#define PG8_BAR __builtin_amdgcn_s_barrier()
#define PG8_SCHED __builtin_amdgcn_sched_barrier(0)
    Unit cur, nxt; int ui = 0;
    if (!S.next(0, cur)) return;
    f32x4 acc[2][2][4][2];
#pragma unroll
    for (int a = 0; a < 2; ++a)
#pragma unroll
        for (int b = 0; b < 2; ++b)
#pragma unroll
            for (int m = 0; m < 4; ++m)
#pragma unroll
                for (int n = 0; n < 2; ++n) acc[a][b][m][n] = (f32x4){0.f, 0.f, 0.f, 0.f};
    bf16x8 At[4][2], B0[2][2], B1[2][2];
    i32x8 At8[4], B08[2], B18[2];
    PT cA = PG8_PT(GATHER ? (const char*)g.A : (const char*)g.A + (size_t)cur.pm * tstep + (size_t)cur.e * g.astride);
    if constexpr (GATHER) { PG8_GROWS(cur, vc0, vc1); } else { _Pragma("unroll") for (int i = 0; i < 2; ++i) { vc0[i] = voffA[i]; vc1[i] = voffA[i] + (unsigned)hstep; } }
#pragma unroll
    for (int i = 0; i < 2; ++i) { vn0[i] = vc0[i]; vn1[i] = vc1[i]; }
    PT cB = PG8_PT((const char*)g.Bt + (size_t)cur.pn * tstep + (size_t)cur.e * g.bstride);
    S.a_ready(cur);
    if constexpr (SP2) {
        PG8_STAGE(PG8_SB(0, 0), cB, voffB); PG8_STAGE(PG8_SB(0, 1), cB + hstep, voffB); PG8_STAGE(PG8_SA(0, 0), cA, vc0); PG8_STAGE(PG8_SA(0, 1), cA, vc1);
        if (wr == 1) PG8_BAR;
        PG8_WAIT_V(2); PG8_BAR;
        PG8_STAGE(PG8_SB(1, 0), cB + kstep, voffB); PG8_STAGE(PG8_SA(1, 0), cA + kstep, vc0); PG8_STAGE(PG8_SB(1, 1), cB + hstep + kstep, voffB);
        PG8_WAIT_V(6); PG8_BAR;
    } else {
        PG8_STAGE(PG8_SB(0, 0), cB, voffB); PG8_STAGE(PG8_SA(0, 0), cA, vc0); PG8_STAGE(PG8_SB(0, 1), cB + hstep, voffB); PG8_STAGE(PG8_SA(0, 1), cA, vc1);
        if (wr == 1) PG8_BAR;
        PG8_WAIT_V(4); PG8_BAR;
        PG8_STAGE(PG8_SB(1, 0), cB + kstep, voffB); PG8_STAGE(PG8_SA(1, 0), cA + kstep, vc0); PG8_STAGE(PG8_SB(1, 1), cB + hstep + kstep, voffB);
        PG8_WAIT_V(6); PG8_BAR;
    }
    for (;;) {
        const bool has_next = S.next(ui + 1, nxt);
        const PT nA = GATHER ? cA : (has_next ? PG8_PT((const char*)g.A + (size_t)nxt.pm * tstep + (size_t)nxt.e * g.astride) : cA);
        if constexpr (GATHER) { if (has_next) { PG8_GROWS(nxt, vn0, vn1); } } const PT nB = has_next ? PG8_PT((const char*)g.Bt + (size_t)nxt.pn * tstep + (size_t)nxt.e * g.bstride) : cB;
        for (int t = 0; t < nt; t += 2) {
            const bool last = (t == nt - 2);
            const PT a1 = cA + (unsigned)((t + 1) * (int)kstep);
            const PT a2 = last ? nA : cA + (unsigned)((t + 2) * (int)kstep); const PT b2 = last ? nB : cB + (unsigned)((t + 2) * (int)kstep);
            const PT a3 = a2 + (unsigned)kstep; const PT b3 = b2 + (unsigned)kstep;
            unsigned vs0[2], vs1[2];
#pragma unroll
            for (int i = 0; i < 2; ++i) { vs0[i] = (GATHER && last) ? vn0[i] : vc0[i]; vs1[i] = (GATHER && last) ? vn1[i] : vc1[i]; }
            if (last && has_next) S.a_ready(nxt);
            if constexpr (SP2) {
            PG8_LDB(B0, 0, 0); PG8_LDB(B1, 0, 1); PG8_SCHED; PG8_LDA(At, 0, 0); PG8_STAGE(PG8_SA(1, 1), a1, vc1);
            PG8_WAIT_V(8); PG8_WAIT_L(0); PG8_BAR; PG8_MMA(0, 0, At, B0); PG8_MMA(0, 1, At, B1); PG8_BAR; PG8_SCHED;
            PG8_LDA(At, 0, 1); PG8_STAGE(PG8_SB(0, 0), b2, voffB); PG8_STAGE(PG8_SB(0, 1), b2 + hstep, voffB); PG8_STAGE(PG8_SA(0, 0), a2, vs0);
            PG8_WAIT_V(8); PG8_WAIT_L(0); PG8_BAR; PG8_MMA(1, 0, At, B0); PG8_MMA(1, 1, At, B1); PG8_BAR; PG8_SCHED;
            PG8_LDB(B0, 1, 0); PG8_LDB(B1, 1, 1); PG8_SCHED; PG8_LDA(At, 1, 0); PG8_STAGE(PG8_SA(0, 1), a2, vs1);
            PG8_WAIT_V(8); PG8_WAIT_L(0); PG8_BAR; PG8_MMA(0, 0, At, B0); PG8_MMA(0, 1, At, B1); PG8_BAR; PG8_SCHED;
            PG8_LDA(At, 1, 1); PG8_STAGE(PG8_SB(1, 0), b3, voffB); PG8_STAGE(PG8_SB(1, 1), b3 + hstep, voffB); PG8_STAGE(PG8_SA(1, 0), a3, vs0);
            PG8_WAIT_V(8); PG8_WAIT_L(0); PG8_BAR; PG8_MMA(1, 0, At, B0); PG8_MMA(1, 1, At, B1); PG8_BAR; PG8_SCHED;
            } else {
            PG8_LDB(B0, 0, 0); PG8_SCHED; PG8_LDA(At, 0, 0); PG8_STAGE(PG8_SA(1, 1), a1, vc1);
            PG8_WAIT_L(8); PG8_BAR; PG8_WAIT_L(0); PG8_MMA(0, 0, At, B0); PG8_BAR; PG8_SCHED;
            PG8_LDB(B1, 0, 1); PG8_STAGE(PG8_SB(0, 0), b2, voffB);
            PG8_BAR; PG8_WAIT_L(0); PG8_MMA(0, 1, At, B1); PG8_BAR;
            PG8_LDA(At, 0, 1); PG8_STAGE(PG8_SA(0, 0), a2, vs0);
            PG8_BAR; PG8_WAIT_L(0); PG8_MMA(1, 0, At, B0); PG8_BAR; PG8_SCHED;
            PG8_STAGE(PG8_SB(0, 1), b2 + hstep, voffB);
            PG8_WAIT_V(6); PG8_BAR; PG8_MMA(1, 1, At, B1); PG8_BAR;
            PG8_LDB(B0, 1, 0); PG8_SCHED; PG8_LDA(At, 1, 0); PG8_STAGE(PG8_SA(0, 1), a2, vs1);
            PG8_WAIT_L(8); PG8_BAR; PG8_WAIT_L(0); PG8_MMA(0, 0, At, B0); PG8_BAR; PG8_SCHED;
            PG8_LDB(B1, 1, 1); PG8_STAGE(PG8_SB(1, 0), b3, voffB);
            PG8_BAR; PG8_WAIT_L(0); PG8_MMA(0, 1, At, B1); PG8_BAR;
            PG8_LDA(At, 1, 1); PG8_STAGE(PG8_SA(1, 0), a3, vs0);
            PG8_BAR; PG8_WAIT_L(0); PG8_MMA(1, 0, At, B0); PG8_BAR; PG8_SCHED;
            PG8_STAGE(PG8_SB(1, 1), b3 + hstep, voffB);
            PG8_WAIT_V(6); PG8_BAR; PG8_MMA(1, 1, At, B1); PG8_BAR;
            }
        }
        if constexpr (ESIZE == 1) asm volatile("s_nop 15\n\ts_nop 15" ::: "memory");
        if constexpr (ALIGN_EPI) { if (wr == 0) PG8_BAR; }
        if constexpr (!Epi::AFTER_DRAIN) { if constexpr (Epi::CHAIN) E.chain(acc, cur, wr, wc, fr, fq); else E(acc, cur, wr, wc, fr, fq); S.done(cur); }
        if (!has_next) break;
        if (!(Epi::CHAIN && nxt.e != 0)) {
#pragma unroll
        for (int a = 0; a < 2; ++a)
#pragma unroll
            for (int b = 0; b < 2; ++b)
#pragma unroll
                for (int m = 0; m < 4; ++m)
#pragma unroll
                    for (int n = 0; n < 2; ++n) acc[a][b][m][n] = (f32x4){0.f, 0.f, 0.f, 0.f};
        }
        cur = nxt; cA = nA; cB = nB; ++ui;
        if constexpr (GATHER) { _Pragma("unroll") for (int i = 0; i < 2; ++i) { vc0[i] = vn0[i]; vc1[i] = vn1[i]; } }
        if constexpr (ALIGN_EPI) { if (wr == 1) PG8_BAR; }
    }
    PG8_WAIT_V(0);
    if constexpr (!ALIGN_EPI) { if (wr == 0) PG8_BAR; }
    PG8_BAR;
    if constexpr (Epi::AFTER_DRAIN) { E.fused(acc, cur, wr, wc, fr, fq, lds, wid, lane); S.done(cur); }
#undef PG8_GROWS
#undef PG8_PT
#undef PG8_SA
#undef PG8_SB
#undef PG8_STAGE
#undef PG8_LDA
#undef PG8_LD8
#undef PG8_LDB
#undef PG8_MMA
#undef PG8_F8CAT
#undef PG8_WAIT_V
#undef PG8_WAIT_L
#undef PG8_BAR
#undef PG8_SCHED
}
}


namespace att {
typedef unsigned short bf16_t;
typedef short bf16x8 __attribute__((ext_vector_type(8)));
typedef short s16x4 __attribute__((ext_vector_type(4)));
typedef float f32x16 __attribute__((ext_vector_type(16)));
typedef unsigned u32x4 __attribute__((ext_vector_type(4)));
#define ALAS __attribute__((address_space(3)))
typedef ALAS unsigned char* ALAS_PTR;
#define ASBAR() __builtin_amdgcn_sched_barrier(0)
constexpr int QBLK = 32, KVBLK = 64;
constexpr float THR2 = 11.0f;
constexpr float LOG2E = 1.4426950408889634f, INV2PI = 0.15915494309189535f, LOG2_THETA = 13.287712379549449f;
constexpr int OFF_V = 0, VBUF = 8192, OFF_K = 16384, KBUF_MAX = 13312, OFF_WS = OFF_K + 2 * KBUF_MAX  , OFF_BIAS = OFF_WS + 2048  , ATT_LDS = OFF_BIAS + 2048;
__device__ __forceinline__ int crow(int r, int hi) { return (r & 3) + 8 * (r >> 2) + 4 * hi; }
__device__ __forceinline__ unsigned cvtpk(float lo, float hi) { unsigned r; asm volatile("v_cvt_pk_bf16_f32 %0, %1, %2" : "=v"(r) : "v"(lo), "v"(hi)); return r; }
__device__ __forceinline__ float bf2f(short s) { return __uint_as_float(((unsigned)(unsigned short)s) << 16); }
__device__ __forceinline__ short f2bf_s(float f) { return (short)(cvtpk(f, 0.f) & 0xffffu); }

struct UnitP {
    const bf16_t* Q; int ldq;
    const bf16_t* K0; int ldk0;
    const bf16_t* K1; int ldk1;
    const bf16_t* V; int ldv;
    bf16_t* O; int ldo;
    int nt;
    int grow0;
    const float* gain;
    int kr0;
    const unsigned char* K8; int ldk8;
    float cref;
};

typedef short v4i16_t __attribute__((ext_vector_type(4)));
__device__ __forceinline__ s16x4 vtr(const ALAS unsigned char* p) { return __builtin_bit_cast(s16x4, __builtin_amdgcn_ds_read_tr16_b64_v4i16((ALAS v4i16_t*)p)); }
__device__ __forceinline__ void pv_all(f32x16& o0, f32x16& o1, f32x16& lacc, const ALAS unsigned char* vp, bf16x8 pa0, bf16x8 pa1, bf16x8 pa2, bf16x8 pa3) {
    const bf16x8 ones = {(short)0x3F80, (short)0x3F80, (short)0x3F80, (short)0x3F80, (short)0x3F80, (short)0x3F80, (short)0x3F80, (short)0x3F80};
#define ATT_PK(L, H) (bf16x8){L[0], L[1], L[2], L[3], H[0], H[1], H[2], H[3]}
#define ATT_STEP(KS, PA) { const s16x4 l0 = vtr(vp + (KS) * 1024), h0 = vtr(vp + (KS) * 1024 + 512), l1 = vtr(vp + 4096 + (KS) * 1024), h1 = vtr(vp + 4096 + (KS) * 1024 + 512); \
        o0 = __builtin_amdgcn_mfma_f32_32x32x16_bf16(PA, ATT_PK(l0, h0), o0, 0, 0, 0); o1 = __builtin_amdgcn_mfma_f32_32x32x16_bf16(PA, ATT_PK(l1, h1), o1, 0, 0, 0); \
        lacc = __builtin_amdgcn_mfma_f32_32x32x16_bf16(PA, ones, lacc, 0, 0, 0); }
    ATT_STEP(0, pa0) ATT_STEP(1, pa1) ATT_STEP(2, pa2) ATT_STEP(3, pa3)
#undef ATT_STEP
#undef ATT_PK
}
template <int DQK> __device__ __forceinline__ void qkt(f32x16& p0, f32x16& p1, const ALAS unsigned char* Ks, const bf16x8* qr, const f32x16& cinit, int r32, int hi) {
    constexpr int KST = DQK * 2 + 16;
#pragma unroll
    for (int d0 = 0; d0 < DQK / 16; ++d0) { const int cb = (2 * d0 + hi) * 16;
        const bf16x8 b0 = *(const ALAS bf16x8*)(Ks + r32 * KST + cb);
        const bf16x8 b1 = *(const ALAS bf16x8*)(Ks + (32 + r32) * KST + cb);
        if (d0 == 0) { p0 = __builtin_amdgcn_mfma_f32_32x32x16_bf16(b0, qr[0], cinit, 0, 0, 0); p1 = __builtin_amdgcn_mfma_f32_32x32x16_bf16(b1, qr[0], cinit, 0, 0, 0); }
        else { p0 = __builtin_amdgcn_mfma_f32_32x32x16_bf16(b0, qr[d0], p0, 0, 0, 0); p1 = __builtin_amdgcn_mfma_f32_32x32x16_bf16(b1, qr[d0], p1, 0, 0, 0); } }
}
__device__ __forceinline__ void na_mask(f32x16& p0, f32x16& p1, const ALAS float* btab, int kr, int rq, int qc_in, int hi_in) {
    int qc = qc_in, hi = hi_in; asm volatile("" : "+v"(qc), "+v"(hi));
    int r0 = rq - 4; r0 = r0 < 0 ? 0 : (r0 > 120 ? 120 : r0);
    const bool rowok = (kr >= r0) && (kr < r0 + 8);
    int c0 = qc - 8; c0 = c0 < 0 ? 0 : (c0 > 48 ? 48 : c0);
    int dr = kr - rq + 7; dr = dr < 0 ? 0 : (dr > 14 ? 14 : dr);
    const ALAS float* brow = btab + dr * 31;
#pragma unroll
    for (int r = 0; r < 16; ++r) {
        const int ka = crow(r, hi), kb = 32 + ka;
        int ia = ka - qc + 15; ia = ia < 0 ? 0 : (ia > 30 ? 30 : ia);
        int ib = kb - qc + 15; ib = ib < 0 ? 0 : (ib > 30 ? 30 : ib);
        const bool oka = rowok && (ka >= c0) && (ka < c0 + 16), okb = rowok && (kb >= c0) && (kb < c0 + 16);
        p0[r] = oka ? p0[r] + brow[ia] : -1e30f;
        p1[r] = okb ? p1[r] + brow[ib] : -1e30f;
    }
}
__device__ __forceinline__ void lazySM(f32x16& p0, f32x16& p1, float& m_reg, bool& moved, float& alpha) {
    float pmax = p0[0];
#pragma unroll
    for (int r = 1; r < 16; ++r) pmax = fmaxf(pmax, p0[r]);
#pragma unroll
    for (int r = 0; r < 16; ++r) pmax = fmaxf(pmax, p1[r]);
    { auto rr = __builtin_amdgcn_permlane32_swap(__float_as_uint(pmax), __float_as_uint(pmax), false, false);
      pmax = fmaxf(__uint_as_float(rr[0]), __uint_as_float(rr[1])); }
    if (__builtin_expect(__all(pmax <= THR2), 1)) { alpha = 1.f; }
    else { const float dl = fmaxf(pmax, 0.f); m_reg += dl; alpha = __builtin_amdgcn_exp2f(-dl);
#pragma unroll
        for (int r = 0; r < 16; ++r) { p0[r] -= dl; p1[r] -= dl; }
        moved = true; }
#pragma unroll
    for (int r = 0; r < 16; ++r) p0[r] = __builtin_amdgcn_exp2f(p0[r]);
}
__device__ __forceinline__ void fixedSM(f32x16& p0) {
#pragma unroll
    for (int r = 0; r < 16; ++r) p0[r] = __builtin_amdgcn_exp2f(p0[r]);
}
__device__ __forceinline__ void finishSM(f32x16& p0, f32x16& p1, bf16x8& pa0, bf16x8& pa1, bf16x8& pa2, bf16x8& pa3) {
#pragma unroll
    for (int r = 0; r < 16; ++r) p1[r] = __builtin_amdgcn_exp2f(p1[r]);
    u32x4 w;
    w = (u32x4){cvtpk(p0[0], p0[1]), cvtpk(p0[2], p0[3]), cvtpk(p0[4], p0[5]), cvtpk(p0[6], p0[7])}; pa0 = __builtin_bit_cast(bf16x8, w);
    w = (u32x4){cvtpk(p0[8], p0[9]), cvtpk(p0[10], p0[11]), cvtpk(p0[12], p0[13]), cvtpk(p0[14], p0[15])}; pa1 = __builtin_bit_cast(bf16x8, w);
    w = (u32x4){cvtpk(p1[0], p1[1]), cvtpk(p1[2], p1[3]), cvtpk(p1[4], p1[5]), cvtpk(p1[6], p1[7])}; pa2 = __builtin_bit_cast(bf16x8, w);
    w = (u32x4){cvtpk(p1[8], p1[9]), cvtpk(p1[10], p1[11]), cvtpk(p1[12], p1[13]), cvtpk(p1[14], p1[15])}; pa3 = __builtin_bit_cast(bf16x8, w);
}
struct NoSide { static constexpr bool PLAIN = true; template <int P> __device__ __forceinline__ void step() {} };
typedef int i32x8 __attribute__((ext_vector_type(8)));
typedef int i32x4 __attribute__((ext_vector_type(4)));
template <int DQK, int MODE, class SIDE = NoSide, bool K8 = false>
__device__ __forceinline__ void attn_unit(const UnitP& u, ALAS unsigned char* lds, const int tid, SIDE& side) {
    static_assert(!K8 || (DQK == 64 && MODE == 0), "fp8 QK^T: GQA fixed-reference form only");
    constexpr int ND = DQK / 16, KST = K8 ? 80 : DQK * 2 + 16, KBUF = 64 * KST;
    static_assert(KBUF <= KBUF_MAX, "K buffer");
    const int wid = __builtin_amdgcn_readfirstlane(tid >> 6), lane = tid & 63, r32 = lane & 31, hi = lane >> 5;
    ALAS unsigned char* V_lds = lds + OFF_V; ALAS unsigned char* K_lds = lds + OFF_K;
    ALAS float* ws = (ALAS float*)(lds + OFF_WS) + wid * 64; ALAS float* al_l = ws + 32;
    const ALAS float* btab = (const ALAS float*)(lds + OFF_BIAS);
    float m_reg = 0.f; f32x16 o[2], lacc; o[0] = f32x16{}; o[1] = f32x16{}; lacc = f32x16{}; bf16x8 qr[ND];
    bool moved = false;
    const int grow = u.grow0 + (wid >> 1), gcol = (wid & 1) * 32 + r32;
    {
        const bf16_t* Qw = u.Q + (size_t)(wid * QBLK + r32) * u.ldq + hi * 8;
#pragma unroll
        for (int d0 = 0; d0 < ND; ++d0) qr[d0] = *(const bf16x8*)(Qw + d0 * 16);
        if constexpr (MODE == 0 || MODE == 3) {
            float x[4][8]; float ssq = 0.f;
#pragma unroll
            for (int d0 = 0; d0 < 4; ++d0)
#pragma unroll
                for (int j = 0; j < 8; ++j) { x[d0][j] = bf2f(qr[d0][j]); ssq += x[d0][j] * x[d0][j]; }
            { auto rr_ = __builtin_amdgcn_permlane32_swap(__float_as_uint(ssq), __float_as_uint(ssq), false, false); ssq = __uint_as_float(rr_[0]) + __uint_as_float(rr_[1]); }
            const float rstd = 1.0f / sqrtf(ssq * (1.0f / 64.0f) + 1e-6f);
#pragma unroll
            for (int d0 = 0; d0 < 4; ++d0)
#pragma unroll
                for (int j = 0; j < 8; ++j) x[d0][j] = x[d0][j] * rstd * u.gain[16 * d0 + 8 * hi + j];
#pragma unroll
            for (int d0 = 0; d0 < 2; ++d0)
#pragma unroll
                for (int j = 0; j < 8; ++j) { const float inv = exp2f(-(float)(8 * hi + j) * (LOG2_THETA / 16.0f));
                    const float ang = (float)(d0 == 0 ? grow : gcol) * inv * INV2PI; const float c = __builtin_amdgcn_cosf(ang), s = __builtin_amdgcn_sinf(ang);
                    const float y1 = x[d0][j], y2 = x[d0 + 2][j]; x[d0][j] = y1 * c - y2 * s; x[d0 + 2][j] = y1 * s + y2 * c; }
            constexpr float C2 = 0.125f * LOG2E;
#pragma unroll
            for (int d0 = 0; d0 < 4; ++d0) { u32x4 w = {cvtpk(x[d0][0] * C2, x[d0][1] * C2), cvtpk(x[d0][2] * C2, x[d0][3] * C2), cvtpk(x[d0][4] * C2, x[d0][5] * C2), cvtpk(x[d0][6] * C2, x[d0][7] * C2)};
                qr[d0] = __builtin_bit_cast(bf16x8, w); }
        }
        if constexpr (MODE == 1) {
            float y1[8], y2[8];
#pragma unroll
            for (int j = 0; j < 8; ++j) { const float inv = exp2f(-(float)j * (LOG2_THETA / 8.0f));
                const float ang = (float)(hi == 0 ? grow : gcol) * inv * INV2PI; const float c = __builtin_amdgcn_cosf(ang), s = __builtin_amdgcn_sinf(ang);
                const float a = bf2f(qr[4][j]), b = bf2f(qr[5][j]); y1[j] = a * c - b * s; y2[j] = a * s + b * c; }
            u32x4 w = {cvtpk(y1[0], y1[1]), cvtpk(y1[2], y1[3]), cvtpk(y1[4], y1[5]), cvtpk(y1[6], y1[7])}; qr[4] = __builtin_bit_cast(bf16x8, w);
            w = (u32x4){cvtpk(y2[0], y2[1]), cvtpk(y2[2], y2[3]), cvtpk(y2[4], y2[5]), cvtpk(y2[6], y2[7])}; qr[5] = __builtin_bit_cast(bf16x8, w);
        }
    }
    i32x8 qr8 = {0, 0, 0, 0, 0, 0, 0, 0}; int sc8 = 0x7F7F7F7F;
    if constexpr (K8) {
#pragma unroll
        for (int d0 = 0; d0 < 4; ++d0) { float f_[8];
#pragma unroll
            for (int j = 0; j < 8; ++j) f_[j] = bf2f(qr[d0][j]);
            qr8[2 * d0] = (int)pg8::pk4_fp8(f_[0], f_[1], f_[2], f_[3]); qr8[2 * d0 + 1] = (int)pg8::pk4_fp8(f_[4], f_[5], f_[6], f_[7]); }
        asm volatile("" : "+v"(sc8)); }
    const int sk = tid >> 3, sc = tid & 7;
    const unsigned vsoff = (unsigned)(sk * u.ldv + sc * 8) * 2u, ksoff = K8 ? (unsigned)(sk * u.ldk8 + sc * 8) : (unsigned)(sk * u.ldk0 + sc * 8) * 2u;
    const int vst = (sc >> 2) * 4096 + sk * 64 + (sc & 3) * 16, kst = K8 ? sk * KST + sc * 8 : sk * KST + sc * 16;
    const int sk2 = (tid & 255) >> 2, sc2 = tid & 3;
    const unsigned k2soff = (DQK == 96) ? (unsigned)(sk2 * u.ldk1 + sc2 * 8) * 2u : 0u;
    const int k2st = sk2 * KST + (8 + sc2) * 16;
    const ALAS unsigned char* vb0 = V_lds + ((lane >> 4) & 1) * 32 + (lane & 3) * 8 + (4 * hi + ((lane & 15) >> 2)) * 64;
    typedef unsigned long long u64_; struct { bf16x8 v, k, k2; u64_ k8; } sr_[2];
#define ATT_SLOAD(i, k0) do { sr_[i].v = *(const bf16x8*)((const char*)(u.V + (size_t)(k0) * u.ldv) + vsoff); \
        if constexpr (K8) sr_[i].k8 = *(const u64_*)((const char*)(u.K8 + (size_t)(k0) * u.ldk8) + ksoff); else sr_[i].k = *(const bf16x8*)((const char*)(u.K0 + (size_t)(k0) * u.ldk0) + ksoff); \
        if constexpr (DQK == 96) sr_[i].k2 = *(const bf16x8*)((const char*)(u.K1 + (size_t)(k0) * u.ldk1) + k2soff); } while (0)
#define ATT_SWRITE(b, i) do { *(ALAS bf16x8*)(V_lds + (b) * VBUF + vst) = sr_[i].v; \
        if constexpr (K8) *(ALAS u64_*)(K_lds + (b) * KBUF + kst) = sr_[i].k8; else *(ALAS bf16x8*)(K_lds + (b) * KBUF + kst) = sr_[i].k; \
        if constexpr (DQK == 96) *(ALAS bf16x8*)(K_lds + (b) * KBUF + k2st) = sr_[i].k2; } while (0)
#define ATT_SWAIT() do { if constexpr (SIDE::PLAIN) { if constexpr (DQK == 96) asm volatile("s_waitcnt vmcnt(3)" ::: "memory"); else asm volatile("s_waitcnt vmcnt(2)" ::: "memory"); } } while (0)
#define ATT_RESC(a) do { if constexpr (MODE != 0) { if (__any((a) < 1.f)) { if (hi == 0) al_l[r32] = (a); asm volatile("s_waitcnt lgkmcnt(0)" ::: "memory"); \
        _Pragma("unroll") for (int r = 0; r < 16; ++r) { const float f_ = al_l[crow(r, hi)]; o[0][r] *= f_; o[1][r] *= f_; lacc[r] *= f_; } } } } while (0)
#define ATT_SM(P0, P1, AL) do { if constexpr (MODE == 0) { fixedSM(P0); AL = 1.f; } else lazySM(P0, P1, m_reg, moved, AL); } while (0)
#define ATT_QKT8(P0, P1, KS) do { const ALAS unsigned char* kp_ = (KS) + r32 * 80 + hi * 32; \
        const i32x8 ka_ = __builtin_shufflevector(*(const ALAS i32x4*)kp_, *(const ALAS i32x4*)(kp_ + 16), 0, 1, 2, 3, 4, 5, 6, 7); \
        const i32x8 kb_ = __builtin_shufflevector(*(const ALAS i32x4*)(kp_ + 32 * 80), *(const ALAS i32x4*)(kp_ + 32 * 80 + 16), 0, 1, 2, 3, 4, 5, 6, 7); \
        asm volatile("v_mfma_scale_f32_32x32x64_f8f6f4 %0, %1, %2, 0, %3, %3 op_sel_hi:[0,0,0]" : "=&v"(P0) : "v"(ka_), "v"(qr8), "v"(sc8)); \
        asm volatile("v_mfma_scale_f32_32x32x64_f8f6f4 %0, %1, %2, 0, %3, %3 op_sel_hi:[0,0,0]" : "=&v"(P1) : "v"(kb_), "v"(qr8), "v"(sc8)); } while (0)
#define ATT_QKT(P0, P1, KS) do { if constexpr (K8) ATT_QKT8(P0, P1, KS); else if (MODE != 0 && moved) { f32x16 ng_; _Pragma("unroll") for (int r_ = 0; r_ < 16; ++r_) ng_[r_] = -m_reg; qkt<DQK>(P0, P1, KS, qr, ng_, r32, hi); } \
        else { const f32x16 z_ = f32x16{}; qkt<DQK>(P0, P1, KS, qr, z_, r32, hi); } } while (0)
#define ATT_PV(VB) pv_all(o[0], o[1], lacc, (VB), pa0, pa1, pa2, pa3)
#define ATT_MASK(P0, P1, j) do { if constexpr (MODE == 2) na_mask(P0, P1, btab, u.kr0 + (j), grow, gcol, hi); } while (0)
    f32x16 pA0, pA1, pB0, pB1; float alA, alB; bf16x8 pa0, pa1, pa2, pa3; const int NT = u.nt;
    constexpr int SE = 0, SO = 1;
    ATT_SLOAD(SE, 0); asm volatile("s_waitcnt vmcnt(0)" ::: "memory"); ATT_SWRITE(0, SE); __syncthreads();
    ATT_QKT(pA0, pA1, K_lds); if constexpr (K8) asm volatile("s_nop 15\n\ts_nop 15\n\ts_nop 15\n\ts_nop 15\n\ts_nop 15\n\ts_nop 15\n\ts_nop 15\n\ts_nop 15\n\ts_nop 15\n\ts_nop 15" ::: "memory");
    ATT_MASK(pA0, pA1, 0); ATT_SM(pA0, pA1, alA);
    ATT_SLOAD(SO, KVBLK); if (2 < NT) ATT_SLOAD(SE, 2 * KVBLK);
    ATT_SWAIT(); ATT_SWRITE(1, SO); __syncthreads();
    if (wid >= 4) __builtin_amdgcn_s_setprio(1);
    for (int j = 1; j + 1 < NT; j += 2) {
        if constexpr (!SIDE::PLAIN) { if ((j & 15) < 4) side.template step<0>(); }
        ASBAR(); ATT_QKT(pB0, pB1, K_lds + KBUF); ATT_MASK(pB0, pB1, j);
        finishSM(pA0, pA1, pa0, pa1, pa2, pa3); ASBAR();
        ATT_SLOAD(SO, (j + 2) * KVBLK); ASBAR();
        ATT_PV(vb0); if constexpr (K8) ASBAR();
        ATT_SM(pB0, pB1, alB);
        __syncthreads(); ATT_SWAIT(); ATT_SWRITE(0, SE);
        ATT_RESC(alB); __syncthreads();
        if constexpr (!SIDE::PLAIN) { if ((j & 15) < 4) side.template step<1>(); }
        ASBAR(); ATT_QKT(pA0, pA1, K_lds); ATT_MASK(pA0, pA1, j + 1);
        finishSM(pB0, pB1, pa0, pa1, pa2, pa3); ASBAR();
        if (j + 3 < NT) ATT_SLOAD(SE, (j + 3) * KVBLK); ASBAR();
        ATT_PV(vb0 + VBUF); if constexpr (K8) ASBAR();
        ATT_SM(pA0, pA1, alA);
        __syncthreads(); ATT_SWAIT(); ATT_SWRITE(1, SO);
        ATT_RESC(alA); __syncthreads();
    }
    ASBAR(); ATT_QKT(pB0, pB1, K_lds + KBUF); ATT_MASK(pB0, pB1, NT - 1);
    finishSM(pA0, pA1, pa0, pa1, pa2, pa3); ASBAR();
    ATT_PV(vb0); if constexpr (K8) ASBAR();
    ATT_SM(pB0, pB1, alB);
    __syncthreads(); ATT_RESC(alB);
    finishSM(pB0, pB1, pa0, pa1, pa2, pa3); ASBAR();
    ATT_PV(vb0 + VBUF);
    __builtin_amdgcn_s_setprio(0);
    bf16_t* Ow = u.O + (size_t)(wid * QBLK) * u.ldo;
#pragma unroll
    for (int r = 0; r < 16; ++r) { const int orow = crow(r, hi); const float rl = __builtin_amdgcn_rcpf(lacc[r]);
#pragma unroll
        for (int d0 = 0; d0 < 2; ++d0) Ow[(size_t)orow * u.ldo + d0 * 32 + r32] = (bf16_t)f2bf_s(o[d0][r] * rl); }
    __syncthreads();
#undef ATT_SLOAD
#undef ATT_SWRITE
#undef ATT_SWAIT
#undef ATT_RESC
#undef ATT_SM
#undef ATT_QKT
#undef ATT_QKT8
#undef ATT_PV
#undef ATT_MASK
}
}


constexpr int NWAVES = 8;
#ifndef MK_DEBUG
#define MK_DEBUG 0
#endif
#ifndef MK_DBG_IGNORE
#define MK_DBG_IGNORE 0
#endif
#ifndef MK_ONE_LAUNCH
#define MK_ONE_LAUNCH 0
#endif
#ifndef REP_P
#define REP_P 1
#endif
#ifndef REP_A
#define REP_A 1
#endif
#ifndef REP_B
#define REP_B 1
#endif
#ifndef REP_C
#define REP_C 1
#endif
#ifndef REP_DG
#define REP_DG 1
#endif
#ifndef REP_DM
#define REP_DM 1
#endif
#ifndef REP_DN
#define REP_DN 1
#endif
#ifndef REP_E
#define REP_E 1
#endif
#ifndef REP_F
#define REP_F 1
#endif
#ifndef REP_H
#define REP_H 1
#endif
#ifndef REP_I
#define REP_I 1
#endif
#ifndef REP_J
#define REP_J 1
#endif
#ifndef REP_K
#define REP_K 1
#endif
#ifndef MK_FP8_LAST
#define MK_FP8_LAST 1
#endif
#ifndef MK_FP8_MOE_ALL
#define MK_FP8_MOE_ALL 1
#endif
#define F8MOE(l) (MK_FP8_LAST && ((l) == DEPTH - 1 || MK_FP8_MOE_ALL))
#ifndef MK_FP8_IN_ALL
#define MK_FP8_IN_ALL 1
#endif
#define F8IN(l) (MK_FP8_LAST && ((l) == DEPTH - 1 || MK_FP8_IN_ALL))
#ifndef MK_FP8_QK
#define MK_FP8_QK 1
#endif
#ifndef MK_FP8_OUT
#define MK_FP8_OUT 1
#endif
constexpr int NB = 4, SEQ = 8192, T = NB * SEQ, D = 1024, DEPTH = 2, GW = 64;
constexpr int DIN = 5536, DINP = 5632;
constexpr int H_NAQ = 0, H_NAK = 384, H_NAV = 768, H_GQ = 1152, H_GK = 1536, H_GV = 1664, H_CQ = 1792, H_CKV = 2176, H_KR = 2432, H_GATE = 2464;
constexpr int NE = 32, TOPK = 4, FF = 1024, TK = T * TOPK;
constexpr int PSLOTS = TK + NE * 256;
constexpr int MAXTILES = PSLOTS / 256;
constexpr int LCAP = T;
constexpr float LN_EPS = 1e-5f, RMS_EPS = 1e-6f, DN_ALPHA = 1.4142135623730951f;
constexpr float LOG2E_F = 1.4426950408889634f;
constexpr int PPL = 10, NPH = 1 + DEPTH * PPL;

constexpr size_t MiB = 1u << 20;
constexpr size_t WS_CTL = 0, CTL_ZERO_BYTES = 1 * MiB;
constexpr size_t WB_IN = 0, WB_UQ = WB_IN + (size_t)DINP * 1024 * 2, WB_UKV = WB_UQ + (size_t)512 * 384 * 2, WB_BA = WB_UKV + (size_t)512 * 256 * 2,
                 WB_BB = WB_BA + (size_t)1024 * 384 * 2, WB_BC = WB_BB + (size_t)1024 * 384 * 2, WB_OUT = WB_BC + (size_t)1024 * 384 * 2,
                 WB_GU = WB_OUT + (size_t)1024 * 1024 * 2, WB_DN = WB_GU + (size_t)NE * 2048 * 1024 * 2, WB_LAYER = WB_DN + (size_t)NE * 1024 * 1024 * 2;
static_assert(WB_LAYER % 256 == 0, "weight block alignment");
constexpr size_t WS_W = 2 * MiB;
constexpr size_t WS_H = WS_W + 2 * WB_LAYER;
constexpr size_t SZ_H = (size_t)T * DINP * 2;
constexpr size_t WS_A2 = WS_H + SZ_H;
constexpr size_t A2_MIX = 0, A2_MIXED = A2_MIX + (size_t)T * 1024 * 4, A2_YA = A2_MIXED + (size_t)T * 1024 * 2, A2_YB = A2_YA + (size_t)T * 384 * 2,
                 A2_YC = A2_YB + (size_t)T * 384 * 2, A2_QC = A2_YC + (size_t)T * 384 * 2, A2_KVC = A2_QC + (size_t)T * 384 * 2, A2_KB = A2_KVC + (size_t)T * 512 * 2,
                 A2_CQN = A2_KB + (size_t)T * 128 * 2, A2_CKVN = A2_CQN + (size_t)T * 384 * 2, A2_KR = A2_CKVN + (size_t)T * 256 * 2, A2_K8 = A2_KR + (size_t)T * 32 * 2, SZ_A2 = A2_K8 + (size_t)T * 128;
static_assert(SZ_A2 >= (size_t)PSLOTS * 1024 * 2 && SZ_H >= (size_t)PSLOTS * 1024 * 2, "overlays fit");
constexpr size_t WS_X2 = WS_A2 + SZ_A2;
constexpr size_t WS_XB = WS_X2 + (size_t)T * D * 4;
constexpr size_t WS_X1 = WS_XB + (size_t)T * D * 2;
constexpr size_t WS_X1B = WS_X1 + (size_t)T * D * 4;
constexpr size_t WS_LT = WS_X1B + (size_t)T * D * 2;
constexpr size_t WS_LG = WS_LT + (size_t)NE * LCAP * 4;
constexpr size_t WS_TE = WS_LG + (size_t)NE * LCAP * 4;
constexpr size_t WS_TR = WS_TE + (size_t)T * 4 * 4;
constexpr size_t WS_SG = WS_TR + (size_t)T * 4 * 4;
constexpr size_t WS_END = WS_SG + (size_t)PSLOTS * 4;
constexpr int CW_BAR = 4096;
constexpr int CW_CNT = 16384;

constexpr int RING_BYTES = 131072, LDSCTL_OFF = 139264, MISC_OFF = LDSCTL_OFF + 64;
constexpr int TBL_OFF = LDSCTL_OFF + 256;
constexpr int TBL_START = TBL_OFF, TBL_TILEE = TBL_OFF + 512, TBL_RS = TBL_TILEE + 2304;
constexpr int LDS_BYTES = 155648;
static_assert(TBL_RS + 512 * 12 + 256 <= LDS_BYTES, "LDS map");

#define GAS __attribute__((address_space(1)))
#define LAS __attribute__((address_space(3)))
typedef unsigned short bf16;
typedef unsigned v4u __attribute__((ext_vector_type(4)));
typedef float f32x4 __attribute__((ext_vector_type(4)));
typedef GAS unsigned gu32;
#define RLX_AGENT __ATOMIC_RELAXED, __HIP_MEMORY_SCOPE_AGENT
#define LDS_WAIT() asm volatile("s_waitcnt lgkmcnt(0)" ::: "memory")
#define VM_WAIT() asm volatile("s_waitcnt vmcnt(0)" ::: "memory")
__device__ __forceinline__ unsigned f2bf(float f) { unsigned u = __builtin_bit_cast(unsigned, f); return (u + 0x7fffu + ((u >> 16) & 1u)) >> 16; }
__device__ __forceinline__ unsigned pk2(float lo, float hi) { unsigned r; asm("v_cvt_pk_bf16_f32 %0, %1, %2" : "=v"(r) : "v"(lo), "v"(hi)); return r; }
__device__ __forceinline__ float bflo(unsigned w) { return __uint_as_float(w << 16); }
__device__ __forceinline__ float bfhi(unsigned w) { return __uint_as_float(w & 0xffff0000u); }

template <int O> __device__ __forceinline__ float shx(float v, int lane) { return __int_as_float(__builtin_amdgcn_ds_bpermute((lane ^ O) << 2, __float_as_int(v))); }
template <int O> __device__ __forceinline__ int shxi(int v, int lane) { return __builtin_amdgcn_ds_bpermute((lane ^ O) << 2, v); }

#define XB_TMO      128
#define XB_XCNT(j)  (256  + 64 * (j))
#define XB_XSUB(j)  (1280 + 64 * (j))
#define XB_XGEN(j)  (2304 + 64 * (j))
#define XB_TOP      3328
#define XB_TOPGEN   3392
#define XCD_BAR_WORDS 3456
#define XB_SPIN_CAP (1u << 18)

__device__ __forceinline__ unsigned xb_ld(unsigned* p)              { return __hip_atomic_load(p, __ATOMIC_RELAXED, __HIP_MEMORY_SCOPE_AGENT); }
__device__ __forceinline__ unsigned xb_add(unsigned* p, unsigned v) { return __hip_atomic_fetch_add(p, v, __ATOMIC_RELAXED, __HIP_MEMORY_SCOPE_AGENT); }
__device__ __forceinline__ unsigned xb_xcc_id() { return (unsigned)__builtin_amdgcn_s_getreg((3 << 11) | 20) & 0xFu; }
#define XB_SPIN(cond, bar) do { unsigned _sp = 0; while (cond) { __builtin_amdgcn_s_sleep(1); \
    if ((++_sp & 255u) == 0u) { if (xb_ld(&(bar)[XB_TMO])) break; if (_sp > XB_SPIN_CAP) { atomicAdd(&(bar)[XB_TMO], 1u); break; } } } } while (0)

struct XcdBarrier {
    unsigned* bar; unsigned x;
    volatile LAS unsigned* st;
};

__device__ __forceinline__ XcdBarrier xcd_barrier_post(unsigned* bar, volatile LAS unsigned* st) {
    XcdBarrier b; b.bar = bar; b.x = xb_xcc_id(); b.st = st;
    if (threadIdx.x == 0) (void)xb_add(&bar[XB_XCNT(b.x)], 1u);
    return b;
}
__device__ __forceinline__ void xcd_barrier_complete(unsigned* bar, unsigned x, unsigned& nloc, unsigned& nx) {
    const unsigned G = gridDim.x * gridDim.y * gridDim.z;
    unsigned sum, cnt, mine, sp = 0u;
    for (;;) {
        sum = 0u; cnt = 0u; mine = 0u;
#pragma unroll
        for (unsigned j = 0; j < 16; ++j) { const unsigned c = xb_ld(&bar[XB_XCNT(j)]); sum += c; cnt += (c > 0u) ? 1u : 0u; mine = (j == x) ? c : mine; }
        if (sum == G) break;
        __builtin_amdgcn_s_sleep(1);
        if ((++sp & 255u) == 0u) { if (xb_ld(&bar[XB_TMO])) break; if (sp > XB_SPIN_CAP) { atomicAdd(&bar[XB_TMO], 1u); break; } }
    }
    nloc = mine > 0u ? mine : 1u; nx = cnt > 0u ? cnt : 1u;
}

__device__ __forceinline__ void xcd_barrier(const XcdBarrier& b) {
    asm volatile("s_waitcnt vmcnt(0)" ::: "memory");
    __syncthreads();
    if (threadIdx.x == 0) {
        unsigned* bar = b.bar;
        __builtin_amdgcn_s_waitcnt(0);
        unsigned nloc = b.st[0], nx = b.st[1];
        if (nloc == 0u) { xcd_barrier_complete(bar, b.x, nloc, nx); b.st[0] = nloc; b.st[1] = nx; }
        const unsigned old = xb_add(&bar[XB_XSUB(b.x)], 1u);
        const unsigned gen = old / nloc;
        if (old + 1u == (gen + 1u) * nloc) {
            __builtin_amdgcn_fence(__ATOMIC_RELEASE, "agent");
            asm volatile("s_waitcnt vmcnt(0)" ::: "memory");
            const unsigned og = xb_add(&bar[XB_TOP], 1u);
            const unsigned tg = og / nx;
            if (og + 1u == (tg + 1u) * nx) xb_add(&bar[XB_TOPGEN], 1u);
            else XB_SPIN(xb_ld(&bar[XB_TOPGEN]) == tg, bar);
            __builtin_amdgcn_fence(__ATOMIC_ACQUIRE, "agent");
            xb_add(&bar[XB_XGEN(b.x)], 1u);
            asm volatile("s_waitcnt vmcnt(0)" ::: "memory");
        } else {
            XB_SPIN(xb_ld(&bar[XB_XGEN(b.x)]) == gen, bar);
            __builtin_amdgcn_fence(__ATOMIC_ACQUIRE, "agent");
            asm volatile("s_waitcnt vmcnt(0)" ::: "memory");
        }
    }
    __syncthreads();
}


struct Frame {
    LAS unsigned char* lds;
    gu32* ctl;
    int tid, lane, wave;
    int vcu, G, bx;
    unsigned char* ws;
    float* out;
};
__device__ __forceinline__ const float* in_ptr(int i) {
    const void* base = (const void*)__builtin_amdgcn_kernarg_segment_ptr(); const GAS float* p;
    asm volatile("s_load_dwordx2 %0, %1, %2\n\ts_waitcnt lgkmcnt(0)" : "=s"(p) : "s"(base), "i"(i * 8) : "memory"); return (const float*)p;
}
#define INP(i) in_ptr(i)
template <int SITE> __device__ __forceinline__ Frame mkframe(LAS unsigned char* lds_in, unsigned char* ws_in, float* out_in, int wave_id, int bx0, int G0) {
    Frame F; int lane_;
    asm volatile("v_mbcnt_lo_u32_b32 %0, -1, 0\n\tv_mbcnt_hi_u32_b32 %0, -1, %0 ; site %1" : "=v"(lane_) : "n"(SITE));
    int bx = bx0, G = G0, wv = wave_id; asm volatile("; site %3" : "+s"(bx), "+s"(G), "+s"(wv) : "n"(SITE));
    GAS unsigned char* wsg = (GAS unsigned char*)ws_in; asm volatile("; site %1" : "+s"(wsg) : "n"(SITE)); unsigned char* ws = (unsigned char*)wsg;
    LAS unsigned char* l3 = lds_in; asm volatile("; site %1" : "+s"(l3) : "n"(SITE));
    const int tid = wv * 64 + lane_;
    F.lds = l3; F.tid = tid; F.lane = lane_; F.wave = wv;
    F.G = G; F.bx = bx; F.vcu = (G % 8 == 0) ? (bx % 8) * (G / 8) + bx / 8 : bx;
    F.ws = ws; F.ctl = (gu32*)(wsg + WS_CTL); F.out = out_in; return F;
}
__device__ __forceinline__ float wave_sum(float v, int lane) {
    v += shx<1>(v, lane); v += shx<2>(v, lane); v += shx<4>(v, lane); v += shx<8>(v, lane); v += shx<16>(v, lane); v += shx<32>(v, lane);
    return v;
}
template <bool F8> __device__ __forceinline__ void tr_item(const float* W, int ldw, int Kd, int k0, int src_n0, bf16* WT, int dst_n0, float scale, LAS float* scr, int lane) {
    float v[32];
#pragma unroll
    for (int i = 0; i < 32; ++i) v[i] = W[(size_t)(k0 + 2 * i + (lane >> 5)) * ldw + src_n0 + (lane & 31)];
#pragma unroll
    for (int i = 0; i < 32; ++i) scr[(2 * i + (lane >> 5)) * 33 + (lane & 31)] = v[i];
    LDS_WAIT(); asm volatile("" ::: "memory");
    const int c = lane & 7;
#pragma unroll
    for (int j = 0; j < 4; ++j) { const int n = (lane >> 3) + 8 * j; const LAS float* s = scr + (8 * c) * 33 + n;
        if constexpr (F8) { typedef unsigned u32x2 __attribute__((ext_vector_type(2)));
            *(GAS u32x2*)((unsigned char*)WT + (size_t)(dst_n0 + n) * Kd + k0 + 8 * c) = (u32x2){pg8::pk4_fp8(s[0 * 33] * scale, s[1 * 33] * scale, s[2 * 33] * scale, s[3 * 33] * scale), pg8::pk4_fp8(s[4 * 33] * scale, s[5 * 33] * scale, s[6 * 33] * scale, s[7 * 33] * scale)}; }
        else { v4u o; o.x = pk2(s[0 * 33] * scale, s[1 * 33] * scale); o.y = pk2(s[2 * 33] * scale, s[3 * 33] * scale); o.z = pk2(s[4 * 33] * scale, s[5 * 33] * scale); o.w = pk2(s[6 * 33] * scale, s[7 * 33] * scale);
            *(GAS v4u*)(WT + (size_t)(dst_n0 + n) * Kd + k0 + 8 * c) = o; } }
    LDS_WAIT(); asm volatile("" ::: "memory");
}
template <int KIND, bool F8 = false> __device__ __forceinline__ void conv_matrix(Frame& F, const float* W, int K, int N, bf16* WT, float s, int gw, int NGW, LAS float* scr, int Kd = 0) {
    if (Kd == 0) Kd = K;
    const int nnb = N / 32, nkb = K / 64, nit = nnb * nkb;
    for (int it = gw; it < nit; it += NGW) {
        const int kb = it / nnb, nb = it % nnb; const int dst_n0 = 32 * nb; int src_n0 = dst_n0; float sc = s;
        if (KIND == 1) sc = (dst_n0 < 384) ? s : 1.0f;
        if (F8) sc *= 32.0f;
        if (KIND == 2) { const int p = dst_n0 >> 8, j = dst_n0 & 255; src_n0 = (j < 128) ? (128 * p + j) : (1024 + 128 * p + (j - 128)); }
        tr_item<F8>(W, N, Kd, 64 * kb, src_n0, WT, dst_n0, sc, scr, F.lane);
    }
}
__device__ __forceinline__ void zero_rows(bf16* WT, int K, int n_lo, int n_hi, int gtid, int nthr) {
    const size_t n16 = (size_t)(n_hi - n_lo) * K / 8; GAS v4u* p = (GAS v4u*)(WT + (size_t)n_lo * K);
    for (size_t i = gtid; i < n16; i += nthr) p[i] = (v4u){0u, 0u, 0u, 0u};
}
__device__ __forceinline__ void p_prologue(Frame& F) {
    LAS float* scr = (LAS float*)(F.lds + F.wave * 16384);
    const int gw0 = F.vcu * NWAVES + F.wave, NGW = F.G * NWAVES, gtid = F.bx * (NWAVES * 64) + F.tid, nthr = F.G * NWAVES * 64;
    for (int l = 0; l < DEPTH; ++l) {
        unsigned char* wb = F.ws + WS_W + (size_t)l * WB_LAYER;
        int gw = gw0;
#define ROT(n) do { gw = (gw + NGW - ((n) % NGW)) % NGW; } while (0)
        if (F8IN(l)) { conv_matrix<1, true>(F, INP(1) + (size_t)l * 1024 * DIN, 1024, DIN, (bf16*)(wb + WB_IN), 0.125f * LOG2E_F, gw, NGW, scr); zero_rows((bf16*)(wb + WB_IN), 512, DIN, DINP, gtid, nthr); }
        else { conv_matrix<1>(F, INP(1) + (size_t)l * 1024 * DIN, 1024, DIN, (bf16*)(wb + WB_IN), 0.125f * LOG2E_F, gw, NGW, scr); zero_rows((bf16*)(wb + WB_IN), 1024, DIN, DINP, gtid, nthr); }
        ROT(16 * 173);
        conv_matrix<0>(F, INP(7) + (size_t)l * 384 * 384, 384, 384, (bf16*)(wb + WB_UQ), 0.10206207261596577f * LOG2E_F, gw, NGW, scr); ROT(72);
        zero_rows((bf16*)(wb + WB_UQ), 384, 384, 512, gtid, nthr);
        conv_matrix<0>(F, INP(8) + (size_t)l * 256 * 512, 256, 512, (bf16*)(wb + WB_UKV), 1.0f, gw, NGW, scr); ROT(64);
        conv_matrix<0>(F, INP(9) + (size_t)l * 384 * 1024, 384, 1024, (bf16*)(wb + WB_BA), 1.0f, gw, NGW, scr); ROT(192);
        conv_matrix<0>(F, INP(10) + (size_t)l * 384 * 1024, 384, 1024, (bf16*)(wb + WB_BB), 1.0f, gw, NGW, scr); ROT(192);
        conv_matrix<0>(F, INP(11) + (size_t)l * 256 * 1024, 256, 1024, (bf16*)(wb + WB_BC), 1.0f, gw, NGW, scr, 384); ROT(64);
        for (int i = gtid; i < 1024 * 16; i += nthr) *((GAS v4u*)(wb + WB_BC) + (size_t)(i >> 4) * 48 + 32 + (i & 15)) = (v4u){0u, 0u, 0u, 0u};
        if (MK_FP8_OUT) conv_matrix<3, true>(F, INP(12) + (size_t)l * 1024 * 1024, 1024, 1024, (bf16*)(wb + WB_OUT), 2.0f, gw, NGW, scr); else conv_matrix<0>(F, INP(12) + (size_t)l * 1024 * 1024, 1024, 1024, (bf16*)(wb + WB_OUT), 1.0f, gw, NGW, scr);
        ROT(512);
#undef ROT
    }
    { const GAS f32x4* xs = (const GAS f32x4*)INP(0); GAS v4u* xd = (GAS v4u*)(F.ws + WS_XB);
      typedef unsigned u32x2 __attribute__((ext_vector_type(2))); GAS u32x2* x8 = (GAS u32x2*)(F.ws + WS_X2);
      for (size_t i = gtid; i < (size_t)T * D / 8; i += nthr) { const f32x4 a = xs[2 * i], b = xs[2 * i + 1]; xd[i] = (v4u){pk2(a.x, a.y), pk2(a.z, a.w), pk2(b.x, b.y), pk2(b.z, b.w)};
          if (F8IN(0)) x8[i] = (u32x2){pg8::pk4_fp8(a.x * 16.f, a.y * 16.f, a.z * 16.f, a.w * 16.f), pg8::pk4_fp8(b.x * 16.f, b.y * 16.f, b.z * 16.f, b.w * 16.f)}; } }
}

constexpr int CONV_ITEMS = NE * 1024 + NE * 512, CONV_LDS_OFF = 49152, CONV_LDS_WAVE = 2 * 16 * 33 * 4;
struct MoeConv {
    static constexpr bool PLAIN = false;
    const float* Wgu; const float* Wdn; unsigned char* Tgu; unsigned char* Tdn; bool f8;
    LAS float* scr; int lane; int gw, ngw, nmini; int s;
    float cvA[8], cvB[8];
    struct Mini { const float* W; unsigned char* WT; int ldw, k0, src_n0, dst_n0; float sc; };
    __device__ __forceinline__ Mini decode(int m) const {
        m = m < 0 ? 0 : (m >= nmini ? nmini - 1 : m);
        const int g = gw + (m >> 2) * ngw, q = m & 3; const bool gu = g < NE * 1024; const int h = gu ? g : g - NE * 1024;
        const int e = gu ? (h >> 10) : (h >> 9), r = gu ? (h & 1023) : (h & 511), kb = gu ? (r >> 6) : (r >> 5), nb = gu ? (r & 63) : (r & 31);
        Mini x; x.dst_n0 = 32 * nb; const int p = x.dst_n0 >> 8, j = x.dst_n0 & 255;
        x.src_n0 = gu ? ((j < 128) ? (128 * p + j) : (1024 + 128 * p + (j - 128))) : x.dst_n0; x.k0 = 64 * kb + 16 * q; x.ldw = gu ? 2048 : 1024;
        x.W = gu ? Wgu + (size_t)e * 1024 * 2048 : Wdn + (size_t)e * 1024 * 1024; const size_t es = f8 ? 1 : 2; x.WT = gu ? Tgu + (size_t)e * 2048 * 1024 * es : Tdn + (size_t)e * 1024 * 1024 * es; x.sc = gu ? 64.0f : 128.0f; return x;
    }
    __device__ __forceinline__ bool done() const { return s >= nmini + 3; }
    template <int P> __device__ __forceinline__ void step() {
        {   const Mini x = decode(s - 3); const LAS float* b = scr + (1 - P) * (16 * 33); const int n = lane >> 1, kh = lane & 1; const LAS float* p = b + (8 * kh) * 33 + n;
            const float q0 = p[0 * 33], q1 = p[1 * 33], q2 = p[2 * 33], q3 = p[3 * 33], q4 = p[4 * 33], q5 = p[5 * 33], q6 = p[6 * 33], q7 = p[7 * 33];
            const size_t eo = (size_t)(x.dst_n0 + n) * 1024 + x.k0 + 8 * kh;
            if (f8) { typedef unsigned u32x2 __attribute__((ext_vector_type(2)));
                *(GAS u32x2*)(x.WT + eo) = (u32x2){pg8::pk4_fp8(q0 * x.sc, q1 * x.sc, q2 * x.sc, q3 * x.sc), pg8::pk4_fp8(q4 * x.sc, q5 * x.sc, q6 * x.sc, q7 * x.sc)}; }
            else { v4u o; o.x = pk2(q0, q1); o.y = pk2(q2, q3); o.z = pk2(q4, q5); o.w = pk2(q6, q7); *(GAS v4u*)(x.WT + eo * 2) = o; } }
        {   LAS float* b = scr + P * (16 * 33);
#pragma unroll
            for (int jj = 0; jj < 8; ++jj) b[(2 * jj + (lane >> 5)) * 33 + (lane & 31)] = P ? cvB[jj] : cvA[jj]; }
        {   const Mini x = decode(s); const GAS float* src = (const GAS float*)x.W + (size_t)(x.k0 + (lane >> 5)) * x.ldw + x.src_n0 + (lane & 31);
#pragma unroll
            for (int jj = 0; jj < 8; ++jj) { const float v = src[(size_t)(2 * jj) * x.ldw]; if (P) cvB[jj] = v; else cvA[jj] = v; } }
        ++s;
    }
};
__device__ __forceinline__ void p_prep(Frame& F, int l) {
    const bf16* hb = (const bf16*)(F.ws + WS_H); unsigned char* a2 = F.ws + WS_A2;
    unsigned char* k8 = a2 + A2_K8; bf16* kB = (bf16*)(a2 + A2_KB); bf16* cqn = (bf16*)(a2 + A2_CQN); bf16* ckvn = (bf16*)(a2 + A2_CKVN); bf16* kr = (bf16*)(a2 + A2_KR);
    const float* gk = INP(4) + l * 64; const float* gq = INP(5) + l * 384; const float* gkv = INP(6) + l * 256;
    const int lane = F.lane, gw = F.vcu * NWAVES + F.wave, NGW = F.G * NWAVES;
    v4u nk = {0u, 0u, 0u, 0u}, nq = nk, nkv = nk, nr = nk;
    if (gw < T) { const bf16* h0 = hb + (size_t)gw * DINP; if (lane < 16) nk = *(const GAS v4u*)(h0 + H_GK + lane * 8); if (lane < 48) nq = *(const GAS v4u*)(h0 + H_CQ + lane * 8);
        if (lane < 32) nkv = *(const GAS v4u*)(h0 + H_CKV + lane * 8); if (lane < 4) nr = *(const GAS v4u*)(h0 + H_KR + lane * 8); }
    for (int t = gw; t < T; t += NGW) {
        const v4u wk_ = nk, wq_ = nq, wkv_ = nkv, wr_ = nr;
        if (t + NGW < T) { const bf16* h1 = hb + (size_t)(t + NGW) * DINP; if (lane < 16) nk = *(const GAS v4u*)(h1 + H_GK + lane * 8); if (lane < 48) nq = *(const GAS v4u*)(h1 + H_CQ + lane * 8);
            if (lane < 32) nkv = *(const GAS v4u*)(h1 + H_CKV + lane * 8); if (lane < 4) nr = *(const GAS v4u*)(h1 + H_KR + lane * 8); }
        const int s = t & (SEQ - 1); const float prow = (float)(s >> 6), pcol = (float)(s & 63);
        {   float x[8]; float ssq = 0.f; const int cc = lane & 7;
            if (lane < 16) { const v4u w = wk_; x[0] = bflo(w.x); x[1] = bfhi(w.x); x[2] = bflo(w.y); x[3] = bfhi(w.y); x[4] = bflo(w.z); x[5] = bfhi(w.z); x[6] = bflo(w.w); x[7] = bfhi(w.w); }
            else {
#pragma unroll
                for (int j = 0; j < 8; ++j) x[j] = 0.f; }
#pragma unroll
            for (int j = 0; j < 8; ++j) ssq += x[j] * x[j];
            ssq += shx<1>(ssq, lane); ssq += shx<2>(ssq, lane); ssq += shx<4>(ssq, lane);
            const float rstd = 1.0f / sqrtf(ssq * (1.0f / 64.0f) + RMS_EPS);
            float y[8], o[8];
#pragma unroll
            for (int j = 0; j < 8; ++j) y[j] = x[j] * rstd * gk[(cc * 8 + j) & 63];
#pragma unroll
            for (int j = 0; j < 8; ++j) { const float other = shx<4>(y[j], lane); const int i = 8 * (cc & 3) + j;
                const float inv = exp2f(-(float)(i & 15) * (att::LOG2_THETA / 16.0f)); const float ang = ((i < 16) ? prow : pcol) * inv * att::INV2PI;
                const float c = __builtin_amdgcn_cosf(ang), sn = __builtin_amdgcn_sinf(ang);
                o[j] = (cc < 4) ? (y[j] * c - other * sn) : (other * sn + y[j] * c); }
            if (lane < 16) { *(GAS v4u*)(kB + (size_t)t * 128 + lane * 8) = (v4u){pk2(o[0], o[1]), pk2(o[2], o[3]), pk2(o[4], o[5]), pk2(o[6], o[7])};
                typedef unsigned u32x2 __attribute__((ext_vector_type(2)));
                *(GAS u32x2*)(k8 + (size_t)t * 128 + (lane >> 3) * 64 + 32 * (cc & 1) + 8 * (cc >> 1)) = (u32x2){pg8::pk4_fp8(o[0], o[1], o[2], o[3]), pg8::pk4_fp8(o[4], o[5], o[6], o[7])}; }
        }
        {   float x[8]; float ssq = 0.f;
            if (lane < 48) { const v4u w = wq_; x[0] = bflo(w.x); x[1] = bfhi(w.x); x[2] = bflo(w.y); x[3] = bfhi(w.y); x[4] = bflo(w.z); x[5] = bfhi(w.z); x[6] = bflo(w.w); x[7] = bfhi(w.w); }
            else {
#pragma unroll
                for (int j = 0; j < 8; ++j) x[j] = 0.f; }
#pragma unroll
            for (int j = 0; j < 8; ++j) ssq += x[j] * x[j];
            ssq = wave_sum(ssq, lane); const float rstd = 1.0f / sqrtf(ssq * (1.0f / 384.0f) + RMS_EPS);
            if (lane < 48) { float y[8];
#pragma unroll
                for (int j = 0; j < 8; ++j) y[j] = x[j] * rstd * gq[lane * 8 + j];
                *(GAS v4u*)(cqn + (size_t)t * 384 + lane * 8) = (v4u){pk2(y[0], y[1]), pk2(y[2], y[3]), pk2(y[4], y[5]), pk2(y[6], y[7])}; }
        }
        {   float x[8]; float ssq = 0.f;
            if (lane < 32) { const v4u w = wkv_; x[0] = bflo(w.x); x[1] = bfhi(w.x); x[2] = bflo(w.y); x[3] = bfhi(w.y); x[4] = bflo(w.z); x[5] = bfhi(w.z); x[6] = bflo(w.w); x[7] = bfhi(w.w); }
            else {
#pragma unroll
                for (int j = 0; j < 8; ++j) x[j] = 0.f; }
#pragma unroll
            for (int j = 0; j < 8; ++j) ssq += x[j] * x[j];
            ssq = wave_sum(ssq, lane); const float rstd = 1.0f / sqrtf(ssq * (1.0f / 256.0f) + RMS_EPS);
            if (lane < 32) { float y[8];
#pragma unroll
                for (int j = 0; j < 8; ++j) y[j] = x[j] * rstd * gkv[lane * 8 + j];
                *(GAS v4u*)(ckvn + (size_t)t * 256 + lane * 8) = (v4u){pk2(y[0], y[1]), pk2(y[2], y[3]), pk2(y[4], y[5]), pk2(y[6], y[7])}; }
        }
        {   float x[8]; const int cc = lane & 3;
            if (lane < 4) { const v4u w = wr_; x[0] = bflo(w.x); x[1] = bfhi(w.x); x[2] = bflo(w.y); x[3] = bfhi(w.y); x[4] = bflo(w.z); x[5] = bfhi(w.z); x[6] = bflo(w.w); x[7] = bfhi(w.w); }
            else {
#pragma unroll
                for (int j = 0; j < 8; ++j) x[j] = 0.f; }
            float o[8];
#pragma unroll
            for (int j = 0; j < 8; ++j) { const float other = shx<2>(x[j], lane);
                const float inv = exp2f(-(float)j * (att::LOG2_THETA / 8.0f)); const float ang = (((cc & 1) == 0) ? prow : pcol) * inv * att::INV2PI;
                const float c = __builtin_amdgcn_cosf(ang), sn = __builtin_amdgcn_sinf(ang);
                o[j] = (cc < 2) ? (x[j] * c - other * sn) : (other * sn + x[j] * c); }
            if (lane < 4) *(GAS v4u*)(kr + (size_t)t * 32 + lane * 8) = (v4u){pk2(o[0], o[1]), pk2(o[2], o[3]), pk2(o[4], o[5]), pk2(o[6], o[7])};
        }
    }
}


__device__ __forceinline__ int build_tables(Frame& F, int l) {
    LAS int* st = (LAS int*)(F.lds + TBL_START); LAS int* cn = st + 33; LAS int* te = (LAS int*)(F.lds + TBL_TILEE);
    __syncthreads();
    if (F.tid < NE) cn[F.tid] = (int)__hip_atomic_load(F.ctl + CW_CNT + 64 * l + F.tid, RLX_AGENT);
    __syncthreads();
    if (F.tid == 0) { int s = 0; for (int e = 0; e < NE; ++e) { st[e] = s; s += ((cn[e] + 255) >> 8) << 8; } st[NE] = s; }
    __syncthreads();
    const int total = st[NE];
    for (int tile = F.tid; tile < (total >> 8); tile += NWAVES * 64) { int e = 0; for (int k = 1; k < NE; ++k) e += (tile * 256 >= st[k]) ? 1 : 0; te[tile] = e; }
    __syncthreads();
    return total;
}

template <bool XBF> __device__ __forceinline__ void p_ln1_router(Frame& F, int l, const void* xin) {
    const bool w8 = F8MOE(l); unsigned char* x1f8 = F.ws + WS_X2;
    const float* xcur = (const float*)xin; const bf16* xcb = (const bf16*)xin;
    const bf16* outb = (const bf16*)(F.ws + WS_X1); bf16* x1b = (bf16*)(F.ws + WS_X1B);
    int* list_t = (int*)(F.ws + WS_LT); float* list_g = (float*)(F.ws + WS_LG); int* tok_e = (int*)(F.ws + WS_TE); int* tok_r = (int*)(F.ws + WS_TR);
    const float* wr = INP(15) + (size_t)l * 1024 * NE; const float* br = INP(16) + l * NE;
    const int lane0 = F.lane, tid = F.tid;
    LAS unsigned char* wl = F.lds;
    LAS int* sel_e = (LAS int*)(F.lds + TBL_RS); LAS float* sel_g = (LAS float*)(sel_e + 512); LAS int* sel_r = sel_e + 1024; LAS int* hist = sel_e + 1536; LAS int* base = hist + 32;
    __syncthreads();
    for (int idx = tid; idx < 1024 * 8; idx += NWAVES * 64) { const int k = idx >> 3, c = idx & 7, kp = (k & 3) * 256 + (k >> 2), cp = c ^ ((kp >> 1) & 7);
        *(LAS f32x4*)(wl + (kp * 8 + cp) * 16) = *(const GAS f32x4*)(wr + (size_t)k * NE + c * 4); }
    __syncthreads();
    for (int tile = F.bx; tile < T / 128; tile += F.G) {
        if (tid < 32) hist[tid] = 0;
        __syncthreads();
        f32x4 px[4]; unsigned long long po[4], pxb[4];
        {   const int t0 = tile * 128 + F.wave * 16; const GAS f32x4* xr0 = (const GAS f32x4*)(xcur + (size_t)t0 * D) + lane0; const GAS unsigned long long* or0 = (const GAS unsigned long long*)(outb + (size_t)t0 * D) + lane0;
#pragma unroll
            for (int j = 0; j < 4; ++j) { if (XBF) pxb[j] = ((const GAS unsigned long long*)(xcb + (size_t)t0 * D) + lane0)[64 * j]; else px[j] = xr0[64 * j]; po[j] = or0[64 * j]; } }
        for (int it = 0; it < 16; ++it) {
            int lane = lane0; asm volatile("" : "+v"(lane));
            const int sw = (lane >> 1) & 7; const float bias_e = br[(lane >> 1) & 31];
            const GAS f32x4* lgp = (const GAS f32x4*)(INP(13) + l * D) + lane; const GAS f32x4* lbp = (const GAS f32x4*)(INP(14) + l * D) + lane;
            const int tl = F.wave * 16 + it, t = tile * 128 + tl;
            f32x4 v[4]; float s = 0.f;
#pragma unroll
            for (int j = 0; j < 4; ++j) { const unsigned long long ow = po[j]; const unsigned olo = (unsigned)ow, ohi = (unsigned)(ow >> 32);
                f32x4 xv_; if (XBF) { const unsigned xlo = (unsigned)pxb[j], xhi = (unsigned)(pxb[j] >> 32); xv_ = (f32x4){bflo(xlo), bfhi(xlo), bflo(xhi), bfhi(xhi)}; } else xv_ = px[j];
                v[j] = xv_ * DN_ALPHA + (f32x4){bflo(olo), bfhi(olo), bflo(ohi), bfhi(ohi)}; s += (v[j].x + v[j].y) + (v[j].z + v[j].w); }
            if (it + 1 < 16) { const GAS f32x4* xr = (const GAS f32x4*)(xcur + (size_t)(t + 1) * D) + lane; const GAS unsigned long long* orr = (const GAS unsigned long long*)(outb + (size_t)(t + 1) * D) + lane;
#pragma unroll
                for (int j = 0; j < 4; ++j) { if (XBF) pxb[j] = ((const GAS unsigned long long*)(xcb + (size_t)(t + 1) * D) + lane)[64 * j]; else px[j] = xr[64 * j]; po[j] = orr[64 * j]; } }
            const float mean = wave_sum(s, lane) * (1.f / D); float s2 = 0.f;
#pragma unroll
            for (int j = 0; j < 4; ++j) { v[j] = v[j] - mean; s2 += (v[j].x * v[j].x + v[j].y * v[j].y) + (v[j].z * v[j].z + v[j].w * v[j].w); }
            const float rstd = 1.f / sqrtf(wave_sum(s2, lane) * (1.f / D) + LN_EPS);
            GAS unsigned long long* o8 = (GAS unsigned long long*)(x1b + (size_t)t * D) + lane;
#pragma unroll
            for (int j = 0; j < 4; ++j) { v[j] = v[j] * rstd * lgp[64 * j] + lbp[64 * j];
                o8[64 * j] = (unsigned long long)pk2(v[j].x, v[j].y) | ((unsigned long long)pk2(v[j].z, v[j].w) << 32);
                if (w8) ((GAS unsigned*)(x1f8 + (size_t)t * D))[64 * j + lane] = pg8::pk4_fp8(v[j].x * 16.0f, v[j].y * 16.0f, v[j].z * 16.0f, v[j].w * 16.0f); }
            float acc[32];
#pragma unroll
            for (int c = 0; c < 8; ++c) {
                int basec = lane * 128 + ((c ^ sw) << 4); asm volatile("" : "+v"(basec));
                const LAS unsigned char* wp = wl + basec;
                typedef float f32x2p __attribute__((ext_vector_type(2)));
                f32x2p a01 = {0.f, 0.f}, a23 = {0.f, 0.f};
#pragma unroll
                for (int i = 0; i < 4; ++i)
#pragma unroll
                    for (int j = 0; j < 4; ++j) { const f32x4 w = *(const LAS f32x4*)(wp + (i * 256 + 64 * j) * 128); const float xv = v[j][i]; const f32x2p x2 = {xv, xv};
                        a01 = __builtin_elementwise_fma(x2, (f32x2p){w.x, w.y}, a01); a23 = __builtin_elementwise_fma(x2, (f32x2p){w.z, w.w}, a23); }
                acc[4 * c + 0] = a01.x; acc[4 * c + 1] = a01.y; acc[4 * c + 2] = a23.x; acc[4 * c + 3] = a23.y;
            }
            float a16[16], a8[8], a4[4], a2[2], a1;
            { const bool b = (lane & 32) != 0;
#pragma unroll
              for (int i = 0; i < 16; ++i) { const float send = b ? acc[i] : acc[16 + i]; const float keep = b ? acc[16 + i] : acc[i]; a16[i] = keep + shx<32>(send, lane); } }
            { const bool b = (lane & 16) != 0;
#pragma unroll
              for (int i = 0; i < 8; ++i) { const float send = b ? a16[i] : a16[8 + i]; const float keep = b ? a16[8 + i] : a16[i]; a8[i] = keep + shx<16>(send, lane); } }
            { const bool b = (lane & 8) != 0;
#pragma unroll
              for (int i = 0; i < 4; ++i) { const float send = b ? a8[i] : a8[4 + i]; const float keep = b ? a8[4 + i] : a8[i]; a4[i] = keep + shx<8>(send, lane); } }
            { const bool b = (lane & 4) != 0;
#pragma unroll
              for (int i = 0; i < 2; ++i) { const float send = b ? a4[i] : a4[2 + i]; const float keep = b ? a4[2 + i] : a4[i]; a2[i] = keep + shx<4>(send, lane); } }
            { const bool b = (lane & 2) != 0; const float send = b ? a2[0] : a2[1]; const float keep = b ? a2[1] : a2[0]; a1 = keep + shx<2>(send, lane); }
            a1 += shx<1>(a1, lane);
            float val = a1 + bias_e; const int my_e = (lane >> 1) & 31;
            float sv[4]; int se[4];
#pragma unroll
            for (int r = 0; r < 4; ++r) { float bv = val; int be = my_e;
#define TOPK_STEP(O) { const float ov = shx<O>(bv, lane); const int oe = shxi<O>(be, lane); if (ov > bv || (ov == bv && oe < be)) { bv = ov; be = oe; } }
                TOPK_STEP(2) TOPK_STEP(4) TOPK_STEP(8) TOPK_STEP(16) TOPK_STEP(32)
#undef TOPK_STEP
                sv[r] = bv; se[r] = be; if (my_e == be) val = -INFINITY; }
            const float e1 = __expf(sv[1] - sv[0]), e2 = __expf(sv[2] - sv[0]), e3 = __expf(sv[3] - sv[0]); const float rs = 1.0f / (1.0f + e1 + e2 + e3);
            if (lane < 4) { const int ee = lane == 0 ? se[0] : lane == 1 ? se[1] : lane == 2 ? se[2] : se[3]; const float gg = (lane == 0 ? 1.0f : lane == 1 ? e1 : lane == 2 ? e2 : e3) * rs;
                const int a = tl * 4 + lane; sel_e[a] = ee; sel_g[a] = gg; sel_r[a] = __hip_atomic_fetch_add(&hist[ee], 1, __ATOMIC_RELAXED, __HIP_MEMORY_SCOPE_WORKGROUP); }
        }
        __syncthreads();
        if (tid < 32) base[tid] = (int)__hip_atomic_fetch_add(F.ctl + CW_CNT + 64 * l + tid, (unsigned)hist[tid], RLX_AGENT);
        __syncthreads();
        { const int a = tid, e = sel_e[a], rank = base[e] + sel_r[a], t = tile * 128 + (a >> 2);
          list_t[(size_t)e * LCAP + rank] = t; list_g[(size_t)e * LCAP + rank] = sel_g[a]; tok_e[t * 4 + (a & 3)] = e; tok_r[t * 4 + (a & 3)] = rank; }
        __syncthreads();
    }
}

__device__ __forceinline__ void p_gather(Frame& F, int l) {
    const int total = build_tables(F, l);
    LAS int* st = (LAS int*)(F.lds + TBL_START); LAS int* cn = st + 33;
    const bf16* x1b = (const bf16*)(F.ws + WS_X1B); bf16* xg = (bf16*)(F.ws + WS_H); float* sg = (float*)(F.ws + WS_SG);
    const int* list_t = (const int*)(F.ws + WS_LT); const float* list_g = (const float*)(F.ws + WS_LG);
    const int lane = F.lane, gw = F.vcu * NWAVES + F.wave, NGW = F.G * NWAVES;
    for (int s = gw; s < total; s += NGW) {
        const bool pr = (lane < NE) && (s >= st[lane & 31]);
        const int e = __popcll(__ballot(pr)) - 1; const int r = s - st[e];
        GAS v4u* dst = (GAS v4u*)(xg + (size_t)s * D);
        if (r < cn[e]) { const int t = list_t[(size_t)e * LCAP + r]; const GAS v4u* src = (const GAS v4u*)(x1b + (size_t)t * D);
            dst[lane] = src[lane]; dst[64 + lane] = src[64 + lane]; if (lane == 0) sg[s] = list_g[(size_t)e * LCAP + r]; }
        else { unsigned zz = 0u; asm volatile("" : "+v"(zz)); const v4u z4 = {zz, zz, zz, zz}; dst[lane] = z4; dst[64 + lane] = z4; if (lane == 0) sg[s] = 0.f; }
    }
}

__device__ __forceinline__ void p_ln2(Frame& F, int l, float* dst, bool write_f32, bool write_xb) {
    (void)build_tables(F, l);
    LAS int* st = (LAS int*)(F.lds + TBL_START);
    const bf16* x1b = (const bf16*)(F.ws + WS_X1B); const bf16* yb = (const bf16*)(F.ws + WS_H); bf16* xb = (bf16*)(F.ws + WS_XB);
    const int* tok_e = (const int*)(F.ws + WS_TE); const int* tok_r = (const int*)(F.ws + WS_TR);
    const int lane = F.lane, hl = lane & 31, half = lane >> 5, gw = F.vcu * NWAVES + F.wave, NGW = F.G * NWAVES;
    const float* lgp = INP(21) + l * D; const float* lbp = INP(22) + l * D;
    float dmult = 1.0f;
#if MK_DEBUG
    if (l == DEPTH - 1) { const unsigned mask = __hip_atomic_load(F.ctl + 20000, RLX_AGENT) & ~(unsigned)(MK_DBG_IGNORE); if (mask) dmult = 1.0f + (float)(__ffs((int)mask) - 1); }
#endif
    int t = 2 * gw + half;
    int e4 = 0, r4 = 0;
    if (t < T && hl < 4) { e4 = tok_e[t * 4 + hl]; r4 = tok_r[t * 4 + hl]; }
    v4u xn[4] = {{0u, 0u, 0u, 0u}, {0u, 0u, 0u, 0u}, {0u, 0u, 0u, 0u}, {0u, 0u, 0u, 0u}};
    if (t < T) { const GAS v4u* xr = (const GAS v4u*)(x1b + (size_t)t * D) + hl;
#pragma unroll
        for (int q = 0; q < 4; ++q) xn[q] = xr[32 * q]; }
    for (; t < T; t += 2 * NGW) {
        int slot4 = st[e4] + r4;
        const int tn = t + 2 * NGW; int e4n = 0, r4n = 0;
        if (tn < T && hl < 4) { e4n = tok_e[tn * 4 + hl]; r4n = tok_r[tn * 4 + hl]; }
        int slot[4];
#pragma unroll
        for (int k = 0; k < 4; ++k) slot[k] = __builtin_amdgcn_ds_bpermute((half * 32 + k) << 2, slot4);
        v4u xw[4], yw[4][4];
#pragma unroll
        for (int q = 0; q < 4; ++q) xw[q] = xn[q];
        if (tn < T) { const GAS v4u* xr = (const GAS v4u*)(x1b + (size_t)tn * D) + hl;
#pragma unroll
            for (int q = 0; q < 4; ++q) xn[q] = xr[32 * q]; }
#pragma unroll
        for (int k = 0; k < 4; ++k) { const GAS v4u* yr = (const GAS v4u*)(yb + (size_t)slot[k] * D) + hl;
#pragma unroll
            for (int q = 0; q < 4; ++q) yw[k][q] = yr[32 * q]; }
        float v[4][8]; float s = 0.f;
#pragma unroll
        for (int q = 0; q < 4; ++q) {
            v[q][0] = bflo(xw[q].x) * DN_ALPHA; v[q][1] = bfhi(xw[q].x) * DN_ALPHA; v[q][2] = bflo(xw[q].y) * DN_ALPHA; v[q][3] = bfhi(xw[q].y) * DN_ALPHA;
            v[q][4] = bflo(xw[q].z) * DN_ALPHA; v[q][5] = bfhi(xw[q].z) * DN_ALPHA; v[q][6] = bflo(xw[q].w) * DN_ALPHA; v[q][7] = bfhi(xw[q].w) * DN_ALPHA;
#pragma unroll
            for (int k = 0; k < 4; ++k) { v[q][0] += bflo(yw[k][q].x); v[q][1] += bfhi(yw[k][q].x); v[q][2] += bflo(yw[k][q].y); v[q][3] += bfhi(yw[k][q].y);
                v[q][4] += bflo(yw[k][q].z); v[q][5] += bfhi(yw[k][q].z); v[q][6] += bflo(yw[k][q].w); v[q][7] += bfhi(yw[k][q].w); }
#pragma unroll
            for (int i = 0; i < 8; ++i) s += v[q][i]; }
        s += shx<1>(s, lane); s += shx<2>(s, lane); s += shx<4>(s, lane); s += shx<8>(s, lane); s += shx<16>(s, lane);
        const float mean = s * (1.f / D); float s2 = 0.f;
#pragma unroll
        for (int q = 0; q < 4; ++q)
#pragma unroll
            for (int i = 0; i < 8; ++i) { v[q][i] -= mean; s2 += v[q][i] * v[q][i]; }
        s2 += shx<1>(s2, lane); s2 += shx<2>(s2, lane); s2 += shx<4>(s2, lane); s2 += shx<8>(s2, lane); s2 += shx<16>(s2, lane);
        const float rstd = 1.f / sqrtf(s2 * (1.f / D) + LN_EPS);
        GAS f32x4* orow = (GAS f32x4*)(dst + (size_t)t * D) + 2 * hl; GAS v4u* o16 = (GAS v4u*)(xb + (size_t)t * D) + hl;
#pragma unroll
        for (int q = 0; q < 4; ++q) { const GAS f32x4* gq = (const GAS f32x4*)(lgp + 256 * q) + 2 * hl; const GAS f32x4* bq = (const GAS f32x4*)(lbp + 256 * q) + 2 * hl;
            const f32x4 g0 = gq[0], g1 = gq[1], b0 = bq[0], b1 = bq[1];
            f32x4 y0 = {v[q][0] * rstd, v[q][1] * rstd, v[q][2] * rstd, v[q][3] * rstd}, y1 = {v[q][4] * rstd, v[q][5] * rstd, v[q][6] * rstd, v[q][7] * rstd};
            y0 = y0 * g0 + b0; y1 = y1 * g1 + b1;
            if (write_f32) { orow[64 * q] = y0 * dmult; orow[64 * q + 1] = y1 * dmult; }
            if (write_xb) { o16[32 * q] = (v4u){pk2(y0.x, y0.y), pk2(y0.z, y0.w), pk2(y1.x, y1.y), pk2(y1.z, y1.w)};
                if (F8IN(l + 1)) { typedef unsigned u32x2 __attribute__((ext_vector_type(2)));
                    ((GAS u32x2*)(F.ws + WS_X2 + (size_t)t * D))[hl + 32 * q] = (u32x2){pg8::pk4_fp8(y0.x * 16.f, y0.y * 16.f, y0.z * 16.f, y0.w * 16.f), pg8::pk4_fp8(y1.x * 16.f, y1.y * 16.f, y1.z * 16.f, y1.w * 16.f)}; } } }
        e4 = e4n; r4 = r4n;
    }
}

template <int WHICH> __device__ __forceinline__ void p_attention(Frame& F, int l) {
    const bf16* hb = (const bf16*)(F.ws + WS_H); unsigned char* a2 = F.ws + WS_A2;
    const bf16* kB = (const bf16*)(a2 + A2_KB); const bf16* kr = (const bf16*)(a2 + A2_KR); const bf16* qc = (const bf16*)(a2 + A2_QC); const bf16* kvc = (const bf16*)(a2 + A2_KVC);
    bf16* ya = (bf16*)(a2 + A2_YA); bf16* yb = (bf16*)(a2 + A2_YB); bf16* yc = (bf16*)(a2 + A2_YC);
    att::ALAS_PTR lds = (att::ALAS_PTR)F.lds;
    att::NoSide noside;
    __syncthreads();
    if (WHICH == 0) {
        float mq = fabsf((INP(3) + l * 64)[F.lane]), mk = fabsf((INP(4) + l * 64)[F.lane]);
#define MX_STEP(O) { mq = fmaxf(mq, shx<O>(mq, F.lane)); mk = fmaxf(mk, shx<O>(mk, F.lane)); }
        MX_STEP(1) MX_STEP(2) MX_STEP(4) MX_STEP(8) MX_STEP(16) MX_STEP(32)
#undef MX_STEP
        const float cref = __int_as_float(__builtin_amdgcn_readfirstlane(__float_as_int(8.0f * LOG2E_F * 1.03f * mq * mk)));
        const bool fixed_ok = cref < 60.0f;
        unsigned char* wbl = F.ws + WS_W + (size_t)l * WB_LAYER;
        MoeConv cv; cv.Wgu = INP(17) + (size_t)l * NE * 1024 * 2048; cv.Wdn = INP(19) + (size_t)l * NE * 1024 * 1024; cv.Tgu = wbl + WB_GU; cv.Tdn = wbl + WB_DN; cv.f8 = F8MOE(l);
        cv.scr = (LAS float*)(F.lds + CONV_LDS_OFF + F.wave * CONV_LDS_WAVE); cv.lane = F.lane; cv.ngw = F.G * NWAVES; cv.gw = F.vcu * NWAVES + F.wave; cv.s = 0;
        cv.nmini = 4 * ((CONV_ITEMS - cv.gw + cv.ngw - 1) / cv.ngw);
#pragma unroll
        for (int i_ = 0; i_ < 8; ++i_) { cv.cvA[i_] = 0.f; cv.cvB[i_] = 0.f; }
        for (int idx = F.vcu; idx < 768; idx += F.G) {
            const int qi = idx >> 8, rem = idx & 255, bk = rem >> 5, qb = rem & 31, b = bk >> 1, kvh = bk & 1, head = kvh * 3 + qi;
            att::UnitP u; const size_t tb = (size_t)b * SEQ, tq = tb + (size_t)qb * 256;
            u.Q = hb + tq * DINP + H_GQ + head * 64; u.ldq = DINP; u.K0 = kB + tb * 128 + kvh * 64; u.ldk0 = 128; u.K1 = nullptr; u.ldk1 = 0;
            u.V = hb + tb * DINP + H_GV + kvh * 64; u.ldv = DINP; u.O = yb + tq * 384 + head * 64; u.ldo = 384; u.nt = SEQ / 64; u.grow0 = qb * 4; u.gain = INP(3) + l * 64; u.kr0 = 0; u.cref = cref;
            u.K8 = a2 + A2_K8 + tb * 128 + kvh * 64; u.ldk8 = 128;
            if (fixed_ok) att::attn_unit<64, 0, MoeConv, MK_FP8_QK != 0>(u, lds, F.tid, cv); else att::attn_unit<64, 3, MoeConv>(u, lds, F.tid, cv);
        }
        while (!cv.done()) { cv.step<0>(); cv.step<1>(); }
    }
    if (WHICH == 1) for (int idx = F.vcu; idx < 512; idx += F.G) {
        const int rnd = idx >> 8, rem = idx & 255, p = (rem >> 5) * 2 + rnd, qb = rem & 31, b = p >> 2, h = p & 3;
        att::UnitP u; const size_t tb = (size_t)b * SEQ, tq = tb + (size_t)qb * 256;
        u.Q = qc + tq * 384 + h * 96; u.ldq = 384; u.K0 = kvc + tb * 512 + h * 128; u.ldk0 = 512; u.K1 = kr + tb * 32; u.ldk1 = 32;
        u.V = kvc + tb * 512 + h * 128 + 64; u.ldv = 512; u.O = yc + tq * 384 + h * 64; u.ldo = 384; u.nt = SEQ / 64; u.grow0 = qb * 4; u.gain = nullptr; u.kr0 = 0; u.cref = 0.f; u.K8 = nullptr; u.ldk8 = 0;
        att::attn_unit<96, 1>(u, lds, F.tid, noside);
    }
    if (WHICH == 2) for (int idx = F.vcu; idx < 768; idx += F.G) {
        const int b = idx / 192, rem = idx % 192, h = rem >> 5, rg = rem & 31, R0 = rg * 4;
        int r_lo = R0 - 4; r_lo = r_lo < 0 ? 0 : (r_lo > 120 ? 120 : r_lo);
        int r_hi = R0 - 1; r_hi = (r_hi < 0 ? 0 : (r_hi > 120 ? 120 : r_hi)) + 8;
        if ((r_hi - r_lo) & 1) { if (r_hi < 128) ++r_hi; else --r_lo; }
        {
            LAS float* bt = (LAS float*)(F.lds + att::OFF_BIAS); const float* rp = INP(2) + ((size_t)l * 6 + h) * 465;
            if (F.tid < 465) bt[F.tid] = rp[F.tid] * LOG2E_F; }
        att::UnitP u; const size_t tb = (size_t)b * SEQ, tq = tb + (size_t)R0 * 64, tk = tb + (size_t)r_lo * 64;
        u.Q = hb + tq * DINP + H_NAQ + h * 64; u.ldq = DINP; u.K0 = hb + tk * DINP + H_NAK + h * 64; u.ldk0 = DINP; u.K1 = nullptr; u.ldk1 = 0;
        u.V = hb + tk * DINP + H_NAV + h * 64; u.ldv = DINP; u.O = ya + tq * 384 + h * 64; u.ldo = 384; u.nt = r_hi - r_lo; u.grow0 = R0; u.gain = nullptr; u.kr0 = r_lo; u.cref = 0.f; u.K8 = nullptr; u.ldk8 = 0;
        att::attn_unit<64, 2>(u, lds, F.tid, noside);
    }
}


struct Args { const float* in[23]; float* out; unsigned char* ws; int ph_lo, ph_hi, use_bar, pad; };
__global__ void __launch_bounds__(NWAVES * 64, 2) mk_fwd(Args args) {
    extern __shared__ __attribute__((aligned(16))) unsigned char lds[];
    const int wave_id = __builtin_amdgcn_readfirstlane((int)threadIdx.x >> 6), bx0 = blockIdx.x, G0 = gridDim.x;
    {   LAS unsigned* z = (LAS unsigned*)((LAS unsigned char*)lds + LDSCTL_OFF); for (int u = threadIdx.x; u < (LDS_BYTES - LDSCTL_OFF) / 4; u += NWAVES * 64) z[u] = 0u; }
    __syncthreads();
    XcdBarrier bar; bar.bar = (unsigned*)(args.ws + WS_CTL) + CW_BAR; bar.x = 0; bar.st = nullptr;
    if (args.use_bar) bar = xcd_barrier_post((unsigned*)(args.ws + WS_CTL) + CW_BAR, (volatile LAS unsigned*)((LAS unsigned char*)lds + MISC_OFF));
    const int lo = args.ph_lo, hi = args.ph_hi;
#define IN(k) (lo <= (k) && (k) < hi)
#define REPEAT(n) for (int rep_ = 0; rep_ < (n); ++rep_)
#define RSEAM(n) do { if (rep_ + 1 < (n)) { XcdBarrier b_ = bar; { GAS unsigned* bb_ = (GAS unsigned*)b_.bar; asm volatile("; rseam %1" : "+s"(bb_) : "n"(__COUNTER__)); b_.bar = (unsigned*)bb_; } xcd_barrier(b_); } } while (0)
#define SEAM(k) do { if (IN(k) && IN((k) + 1)) { XcdBarrier b_ = bar; { GAS unsigned* bb_ = (GAS unsigned*)b_.bar; asm volatile("; seam %1" : "+s"(bb_) : "n"(__COUNTER__)); b_.bar = (unsigned*)bb_; } xcd_barrier(b_); } } while (0)
#define FRAME() Frame F = mkframe<__COUNTER__>((LAS unsigned char*)lds, args.ws, args.out, wave_id, bx0, G0); unsigned char* ws = F.ws; unsigned char* a2 = ws + WS_A2; unsigned char* wb = ws + WS_W + (size_t)l * WB_LAYER; (void)a2; (void)wb

    if (IN(0)) REPEAT(REP_P) { Frame F = mkframe<__COUNTER__>((LAS unsigned char*)lds, args.ws, args.out, wave_id, bx0, G0); p_prologue(F); RSEAM(REP_P); } SEAM(0);

    for (int l = 0; l < DEPTH; ++l) {
        const int pb = 1 + l * PPL;
        if (IN(pb + 0)) REPEAT(REP_A) { FRAME();
            pg8::StaticOrder S; S.init(T, DINP, F.G, F.bx);
            if (!F8IN(l)) {
                pg8::Gemm g{(const bf16*)(ws + WS_XB), (const bf16*)(wb + WB_IN), T, DINP, 1024, 0, 0, nullptr};
                pg8::EpiStore E{(bf16*)(ws + WS_H), DINP, DINP, 1.0f};
                pg8::gemm_phase<pg8::EpiStore, pg8::StaticOrder, true, true>(F.lds, g, S, E, F.tid);
            } else {
                pg8::Gemm g{(const bf16*)(ws + WS_X2), (const bf16*)(wb + WB_IN), T, DINP, 1024, 0, 0, (const void*)ws};
                pg8::EpiStore E{(bf16*)(ws + WS_H), DINP, DINP, 1.0f / 512.0f};
                pg8::gemm_phase<pg8::EpiStore, pg8::StaticOrder, true, true, false, pg8::NoGather, 1>(F.lds, g, S, E, F.tid);
            }
            RSEAM(REP_A);
        } SEAM(pb + 0);
        if (IN(pb + 1)) REPEAT(REP_B) { FRAME(); p_prep(F, l); RSEAM(REP_B); } SEAM(pb + 1);
        if (IN(pb + 2)) REPEAT(REP_C) {
            { FRAME(); pg8::Gemm g{(const bf16*)(a2 + A2_CQN), (const bf16*)(wb + WB_UQ), T, 512, 384, 0, 0, nullptr}; pg8::StaticOrder S; S.init(T, 512, F.G, F.bx);
              pg8::EpiStore E{(bf16*)(a2 + A2_QC), 384, 384, 1.0f};
              pg8::gemm_phase<pg8::EpiStore, pg8::StaticOrder, true, true>(F.lds, g, S, E, F.tid); }
            { FRAME(); pg8::Gemm g{(const bf16*)(a2 + A2_CKVN), (const bf16*)(wb + WB_UKV), T, 512, 256, 0, 0, nullptr}; pg8::StaticOrder S; S.init(T, 512, F.G, F.bx);
              pg8::EpiStore E{(bf16*)(a2 + A2_KVC), 512, 512, 1.0f};
              pg8::gemm_phase<pg8::EpiStore, pg8::StaticOrder, true, true>(F.lds, g, S, E, F.tid); }
            RSEAM(REP_C);
        } SEAM(pb + 2);
        if (IN(pb + 3)) { REPEAT(REP_DG) { FRAME(); p_attention<0>(F, l); RSEAM(REP_DG); } REPEAT(REP_DM) { FRAME(); p_attention<1>(F, l); RSEAM(REP_DM); } REPEAT(REP_DN) { FRAME(); p_attention<2>(F, l); RSEAM(REP_DN); } } SEAM(pb + 3);
        if (IN(pb + 4)) REPEAT(REP_E) { FRAME();
            pg8::Gemm g{(const bf16*)(a2 + A2_YA), (const bf16*)(wb + WB_BA), T, 1024, 384, (size_t)1024 * 384 * 2, (size_t)T * 384 * 2, nullptr};
            pg8::ChainOrder S; S.so.init(T, 1024, F.G, F.bx); S.nch = 3;
            pg8::EpiGateChain E{(const bf16*)(ws + WS_H) + H_GATE, DINP, (void*)(a2 + A2_MIXED), MK_FP8_OUT ? 256.0f : 0.0f};
            pg8::gemm_phase<pg8::EpiGateChain, pg8::ChainOrder, true, true>(F.lds, g, S, E, F.tid);
            RSEAM(REP_E);
        } SEAM(pb + 4);
        if (IN(pb + 5)) REPEAT(REP_F) { FRAME();
            pg8::StaticOrder S; S.init(T, 1024, F.G, F.bx);
            if (!MK_FP8_OUT) { pg8::Gemm g{(const bf16*)(a2 + A2_MIXED), (const bf16*)(wb + WB_OUT), T, 1024, 1024, 0, 0, nullptr};
                pg8::EpiStore E{(bf16*)(ws + WS_X1), 1024, 1024, 1.0f};
                pg8::gemm_phase<pg8::EpiStore, pg8::StaticOrder, true, true>(F.lds, g, S, E, F.tid); }
            else { pg8::Gemm g{(const bf16*)(a2 + A2_MIXED), (const bf16*)(wb + WB_OUT), T, 1024, 1024, 0, 0, (const void*)ws};
                pg8::EpiStore E{(bf16*)(ws + WS_X1), 1024, 1024, 1.0f / 16384.0f};
                pg8::gemm_phase<pg8::EpiStore, pg8::StaticOrder, true, true, false, pg8::NoGather, 1>(F.lds, g, S, E, F.tid); }
            RSEAM(REP_F);
        } SEAM(pb + 5);
        if (IN(pb + 6)) { FRAME(); if (l == 0) p_ln1_router<false>(F, l, INP(0)); else p_ln1_router<true>(F, l, ws + WS_XB); } SEAM(pb + 6);
        const bool f8l = F8MOE(l);
        if (IN(pb + 7)) REPEAT(REP_I) { FRAME();
            const int total = build_tables(F, l);
            pg8::MoeOrder S{8, (total >> 8) * 8, F.G, F.vcu, (const LAS int*)(F.lds + TBL_TILEE)};
            pg8::MoeGather gs{(const int*)(ws + WS_LT), (const LAS int*)(F.lds + TBL_START), (const LAS int*)(F.lds + TBL_START) + 33, LCAP};
            if (!f8l) {
                pg8::Gemm g{(const bf16*)(ws + WS_X1B), (const bf16*)(wb + WB_GU), total, 2048, 1024, (size_t)2048 * 1024 * 2, 0, nullptr};
                pg8::EpiSwigluT<false> E{(void*)(ws + WS_A2), INP(18) + (size_t)l * NE * 2048, 1.0f, 1.0f};
                pg8::gemm_phase<pg8::EpiSwigluT<false>, pg8::MoeOrder, true, true, true, pg8::MoeGather>(F.lds, g, S, E, F.tid, gs);
            } else {
                pg8::Gemm g{(const bf16*)(ws + WS_X2), (const bf16*)(wb + WB_GU), total, 2048, 1024, (size_t)2048 * 1024, 0, (const void*)ws};
                pg8::EpiSwigluT<true> E{(void*)(ws + WS_A2), INP(18) + (size_t)l * NE * 2048, 1.0f / 1024.0f, 4.0f};
                pg8::gemm_phase<pg8::EpiSwigluT<true>, pg8::MoeOrder, true, true, true, pg8::MoeGather, 1>(F.lds, g, S, E, F.tid, gs);
            }
            RSEAM(REP_I);
        } SEAM(pb + 7);
        if (IN(pb + 8)) REPEAT(REP_J) { FRAME();
            const int total = build_tables(F, l);
            pg8::MoeOrder S{4, (total >> 8) * 4, F.G, F.vcu, (const LAS int*)(F.lds + TBL_TILEE)};
            if (!f8l) {
                pg8::Gemm g{(const bf16*)(ws + WS_A2), (const bf16*)(wb + WB_DN), total, 1024, 1024, (size_t)1024 * 1024 * 2, 0, nullptr};
                pg8::EpiDown E{(bf16*)(ws + WS_H), INP(20) + (size_t)l * NE * 1024, (const float*)(ws + WS_LG), (const LAS int*)(F.lds + TBL_START), (const LAS int*)(F.lds + TBL_START) + 33, LCAP, 1.0f};
                pg8::gemm_phase<pg8::EpiDown, pg8::MoeOrder, true, true>(F.lds, g, S, E, F.tid);
            } else {
                pg8::Gemm g{(const bf16*)(ws + WS_A2), (const bf16*)(wb + WB_DN), total, 1024, 1024, (size_t)1024 * 1024, 0, (const void*)ws};
                pg8::EpiDown E{(bf16*)(ws + WS_H), INP(20) + (size_t)l * NE * 1024, (const float*)(ws + WS_LG), (const LAS int*)(F.lds + TBL_START), (const LAS int*)(F.lds + TBL_START) + 33, LCAP, 1.0f / 512.0f};
                pg8::gemm_phase<pg8::EpiDown, pg8::MoeOrder, true, true, false, pg8::NoGather, 1>(F.lds, g, S, E, F.tid);
            }
            RSEAM(REP_J);
        } SEAM(pb + 8);
        if (IN(pb + 9)) REPEAT(REP_K) { FRAME(); RSEAM(REP_K); p_ln2(F, l, F.out, l == DEPTH - 1, l + 1 < DEPTH); }
        if (l + 1 < DEPTH) SEAM(pb + 9);
    }
#undef IN
#undef SEAM
}


#if MK_DEBUG
constexpr int CW_DBG = 20000;
__device__ __forceinline__ float bfr(float f) { return __uint_as_float(f2bf(f) << 16); }
__device__ __forceinline__ float bfv(const bf16* p) { return __uint_as_float(((unsigned)*p) << 16); }
__device__ __forceinline__ unsigned hsh(unsigned x) { x ^= x >> 16; x *= 0x7feb352du; x ^= x >> 15; x *= 0x846ca68bu; x ^= x >> 16; return x; }
__device__ __forceinline__ bool close_(float got, float ref, float rel, float abs_) { return fabsf(got - ref) <= rel * fabsf(ref) + abs_; }
__device__ __forceinline__ void ropecs(int i, int quarter, int s, float& c, float& sn) {
    const float pos = (i < quarter) ? (float)(s >> 6) : (float)(s & 63); const int m = (i < quarter) ? i : i - quarter;
    const float inv = exp2f(-(float)m / (float)quarter * 13.287712379549449f); const float ang = pos * inv * 0.15915494309189535f; c = __builtin_amdgcn_cosf(ang); sn = __builtin_amdgcn_sinf(ang);
}
#define DBG_FAIL(bit) atomicOr((unsigned*)(ws + WS_CTL) + CW_DBG, 1u << (bit))
template <int stage> __global__ void __launch_bounds__(256) dbg_kernel(Args args) {
    unsigned char* ws = args.ws; const int l = 0;
    const int gid = blockIdx.x * 256 + threadIdx.x;
    const bf16* hb = (const bf16*)(ws + WS_H); unsigned char* a2 = ws + WS_A2; unsigned char* wb = ws + WS_W + (size_t)l * WB_LAYER;
    const bf16* kB = (const bf16*)(a2 + A2_KB); const bf16* cqn = (const bf16*)(a2 + A2_CQN); const bf16* ckvn = (const bf16*)(a2 + A2_CKVN); const bf16* kr = (const bf16*)(a2 + A2_KR);
    const bf16* qc = (const bf16*)(a2 + A2_QC); const bf16* kvc = (const bf16*)(a2 + A2_KVC);
    const bf16* ya = (const bf16*)(a2 + A2_YA); const bf16* yb = (const bf16*)(a2 + A2_YB); const bf16* yc = (const bf16*)(a2 + A2_YC);
    const unsigned h1 = hsh(gid * 2654435761u + 12345u + stage * 977u), h2 = hsh(h1 + 0x9e3779b9u);
    const int t = h1 % T, s = t & (SEQ - 1), b = t / SEQ;
    if (stage == 0) {
        const int n = h2 % DIN; const float* x = args.in[0] + (size_t)t * D; const float* W = args.in[1];
        const float sc = (n < 384) ? 0.125f * LOG2E_F : 1.0f; float r = 0.f;
        for (int k = 0; k < 1024; ++k) r += bfr(x[k]) * bfr(W[(size_t)k * DIN + n] * sc);
        if (!close_(bfv(hb + (size_t)t * DINP + n), r, 0.02f, 0.02f)) DBG_FAIL(1);
    }
    if (stage == 1) {
        const bf16* hr = hb + (size_t)t * DINP;
        {   const int d = h2 % 128, head = d >> 6, dd = d & 63; float ssq = 0.f;
            for (int k = 0; k < 64; ++k) { const float v = bfv(hr + H_GK + head * 64 + k); ssq += v * v; }
            const float rstd = 1.0f / sqrtf(ssq / 64.0f + RMS_EPS); const float* g = args.in[4];
            const int i = dd & 31; const float y1 = bfv(hr + H_GK + head * 64 + i) * rstd * g[i], y2 = bfv(hr + H_GK + head * 64 + i + 32) * rstd * g[i + 32];
            float c, sn; ropecs(i, 16, s, c, sn); const float ref = (dd < 32) ? (y1 * c - y2 * sn) : (y1 * sn + y2 * c);
            if (!close_(bfv(kB + (size_t)t * 128 + d), ref, 0.02f, 0.01f)) DBG_FAIL(2); }
        {   const int d = h2 % 384; float ssq = 0.f; for (int k = 0; k < 384; ++k) { const float v = bfv(hr + H_CQ + k); ssq += v * v; }
            const float ref = bfv(hr + H_CQ + d) / sqrtf(ssq / 384.0f + RMS_EPS) * args.in[5][d];
            if (!close_(bfv(cqn + (size_t)t * 384 + d), ref, 0.02f, 0.01f)) DBG_FAIL(3); }
        {   const int d = h2 % 256; float ssq = 0.f; for (int k = 0; k < 256; ++k) { const float v = bfv(hr + H_CKV + k); ssq += v * v; }
            const float ref = bfv(hr + H_CKV + d) / sqrtf(ssq / 256.0f + RMS_EPS) * args.in[6][d];
            if (!close_(bfv(ckvn + (size_t)t * 256 + d), ref, 0.02f, 0.01f)) DBG_FAIL(4); }
        {   const int d = h2 % 32, i = d & 15; const float x1 = bfv(hr + H_KR + i), x2 = bfv(hr + H_KR + i + 16); float c, sn; ropecs(i, 8, s, c, sn);
            const float ref = (d < 16) ? (x1 * c - x2 * sn) : (x1 * sn + x2 * c);
            if (!close_(bfv(kr + (size_t)t * 32 + d), ref, 0.02f, 0.01f)) DBG_FAIL(5); }
    }
    if (stage == 2) {
        {   const int n = h2 % 384; float r = 0.f; const float sc = 0.10206207261596577f * LOG2E_F;
            for (int k = 0; k < 384; ++k) r += bfv(cqn + (size_t)t * 384 + k) * bfr(args.in[7][(size_t)k * 384 + n] * sc);
            if (!close_(bfv(qc + (size_t)t * 384 + n), r, 0.02f, 0.01f)) DBG_FAIL(6); }
        {   const int n = h2 % 512; float r = 0.f;
            for (int k = 0; k < 256; ++k) r += bfv(ckvn + (size_t)t * 256 + k) * bfr(args.in[8][(size_t)k * 512 + n]);
            if (!close_(bfv(kvc + (size_t)t * 512 + n), r, 0.02f, 0.02f)) DBG_FAIL(7); }
    }
    if (stage == 3) {
        const int gr = s >> 6, gc = s & 63;
        if (gid < 1024) {
            const int h = h2 % 6, dofs = ((h2 >> 8) & 1) * 32; float q[64], o[32];
            _Pragma("unroll") for (int d = 0; d < 64; ++d) { q[d] = bfv(hb + (size_t)t * DINP + H_NAQ + h * 64 + d); }
            _Pragma("unroll") for (int d = 0; d < 32; ++d) o[d] = 0.f;
            int r0 = gr - 4; r0 = r0 < 0 ? 0 : (r0 > 120 ? 120 : r0); int c0 = gc - 8; c0 = c0 < 0 ? 0 : (c0 > 48 ? 48 : c0);
            const float* rp = args.in[2] + (size_t)h * 465; float m = -1e30f, lsum = 0.f;
            for (int pass = 0; pass < 2; ++pass)
                for (int i = 0; i < 8; ++i) for (int j = 0; j < 16; ++j) { const int kr_ = r0 + i, kc = c0 + j; const size_t kt = (size_t)b * SEQ + kr_ * 64 + kc;
                    float sc = 0.f; _Pragma("unroll") for (int d = 0; d < 64; ++d) sc += q[d] * bfv(hb + kt * DINP + H_NAK + h * 64 + d);
                    sc += rp[(kr_ - gr + 7) * 31 + (kc - gc + 15)] * LOG2E_F;
                    if (pass == 0) m = fmaxf(m, sc); else { const float p = exp2f(sc - m); lsum += p; _Pragma("unroll") for (int d = 0; d < 32; ++d) o[d] += p * bfv(hb + kt * DINP + H_NAV + h * 64 + dofs + d); } }
            bool bad = false; _Pragma("unroll") for (int d = 0; d < 32; ++d) bad |= !close_(bfv(ya + (size_t)t * 384 + h * 64 + dofs + d), o[d] / lsum, 0.03f, 0.01f);
            if (bad) DBG_FAIL(8);
        } else if (gid < 1024 + 128) {
            const int head = h2 % 6, kvh = head / 3, dofs = ((h2 >> 8) & 1) * 32; float q[64], o[32]; float ssq = 0.f;
            _Pragma("unroll") for (int d = 0; d < 64; ++d) { q[d] = bfv(hb + (size_t)t * DINP + H_GQ + head * 64 + d); ssq += q[d] * q[d]; }
            _Pragma("unroll") for (int d = 0; d < 32; ++d) o[d] = 0.f;
            const float rstd = 1.0f / sqrtf(ssq / 64.0f + RMS_EPS);
            _Pragma("unroll") for (int d = 0; d < 64; ++d) q[d] = q[d] * rstd * args.in[3][d];
            _Pragma("unroll") for (int i = 0; i < 32; ++i) { float c, sn; ropecs(i, 16, s, c, sn); const float y1 = q[i], y2 = q[i + 32]; q[i] = y1 * c - y2 * sn; q[i + 32] = y1 * sn + y2 * c; }
            _Pragma("unroll") for (int d = 0; d < 64; ++d) q[d] = bfr(q[d] * 0.125f * LOG2E_F);
            float m = -1e30f, lsum = 0.f;
            for (int key = 0; key < SEQ; ++key) { const size_t kt = (size_t)b * SEQ + key; float sc = 0.f;
                _Pragma("unroll") for (int d = 0; d < 64; ++d) sc += q[d] * bfv(kB + kt * 128 + kvh * 64 + d);
                const float mn = fmaxf(m, sc), al = exp2f(m - mn), p = exp2f(sc - mn); m = mn; lsum = lsum * al + p;
                _Pragma("unroll") for (int d = 0; d < 32; ++d) o[d] = o[d] * al + p * bfv(hb + kt * DINP + H_GV + kvh * 64 + dofs + d); }
            bool bad = false; _Pragma("unroll") for (int d = 0; d < 32; ++d) bad |= !close_(bfv(yb + (size_t)t * 384 + head * 64 + dofs + d), o[d] / lsum, 0.03f, 0.003f);
            if (bad) DBG_FAIL(9);
        } else if (gid < 1024 + 256) {
            const int h = h2 % 4, dofs = ((h2 >> 8) & 1) * 32; float q[96], o[32];
            _Pragma("unroll") for (int d = 0; d < 96; ++d) q[d] = bfv(qc + (size_t)t * 384 + h * 96 + d);
            _Pragma("unroll") for (int i = 0; i < 16; ++i) { float c, sn; ropecs(i, 8, s, c, sn); const float y1 = q[64 + i], y2 = q[80 + i]; q[64 + i] = bfr(y1 * c - y2 * sn); q[80 + i] = bfr(y1 * sn + y2 * c); }
            _Pragma("unroll") for (int d = 0; d < 32; ++d) o[d] = 0.f;
            float m = -1e30f, lsum = 0.f;
            for (int key = 0; key < SEQ; ++key) { const size_t kt = (size_t)b * SEQ + key; float sc = 0.f;
                _Pragma("unroll") for (int d = 0; d < 64; ++d) sc += q[d] * bfv(kvc + kt * 512 + h * 128 + d);
                _Pragma("unroll") for (int d = 0; d < 32; ++d) sc += q[64 + d] * bfv(kr + kt * 32 + d);
                const float mn = fmaxf(m, sc), al = exp2f(m - mn), p = exp2f(sc - mn); m = mn; lsum = lsum * al + p;
                _Pragma("unroll") for (int d = 0; d < 32; ++d) o[d] = o[d] * al + p * bfv(kvc + kt * 512 + h * 128 + 64 + dofs + d); }
            bool bad = false; _Pragma("unroll") for (int d = 0; d < 32; ++d) bad |= !close_(bfv(yc + (size_t)t * 384 + h * 64 + dofs + d), o[d] / lsum, 0.03f, 0.003f);
            if (bad) DBG_FAIL(10);
        }
    }
    if (stage == 4) {
        const int n = h2 % 1024; float r = 0.f;
        { float a = 0.f; for (int k = 0; k < 384; ++k) a += bfv(ya + (size_t)t * 384 + k) * bfr(args.in[9][(size_t)k * 1024 + n]); r += a / (1.0f + expf(-bfv(hb + (size_t)t * DINP + H_GATE + n))); }
        { float a = 0.f; for (int k = 0; k < 384; ++k) a += bfv(yb + (size_t)t * 384 + k) * bfr(args.in[10][(size_t)k * 1024 + n]); r += a / (1.0f + expf(-bfv(hb + (size_t)t * DINP + H_GATE + 1024 + n))); }
        { float a = 0.f; for (int k = 0; k < 256; ++k) a += bfv(yc + (size_t)t * 384 + k) * bfr(args.in[11][(size_t)k * 1024 + n]); r += a / (1.0f + expf(-bfv(hb + (size_t)t * DINP + H_GATE + 2048 + n))); }
        if (!close_(bfv((const bf16*)(a2 + A2_MIXED) + (size_t)t * 1024 + n), r, 0.02f, 0.003f)) DBG_FAIL(11);
    }
    if (stage == 5) {
        const int n = h2 % 1024; float r = 0.f; const bf16* mx = (const bf16*)(a2 + A2_MIXED) + (size_t)t * 1024;
        for (int k = 0; k < 1024; ++k) r += bfv(mx + k) * bfr(args.in[12][(size_t)k * 1024 + n]);
        if (!close_(bfv((const bf16*)(ws + WS_X1) + (size_t)t * D + n), r, 0.02f, 0.002f)) DBG_FAIL(12);
    }
    if (stage == 6) {
        const bf16* x1 = (const bf16*)(ws + WS_X1B) + (size_t)t * D; const int* tok_e = (const int*)(ws + WS_TE); const int* tok_r = (const int*)(ws + WS_TR);
        const int* list_t = (const int*)(ws + WS_LT); const float* list_g = (const float*)(ws + WS_LG);
        float lg[32]; _Pragma("unroll") for (int e = 0; e < 32; ++e) lg[e] = args.in[16][e];
        for (int k = 0; k < 1024; ++k) { const float xv = bfv(x1 + k); _Pragma("unroll") for (int e = 0; e < 32; ++e) lg[e] += xv * args.in[15][(size_t)k * 32 + e]; }
        int se[4]; float sv[4]; unsigned used = 0;
        _Pragma("unroll") for (int r = 0; r < 4; ++r) { int be = -1; float bv = -INFINITY; _Pragma("unroll") for (int e = 0; e < 32; ++e) if (!((used >> e) & 1) && lg[e] > bv) { bv = lg[e]; be = e; } se[r] = be; sv[r] = bv; used |= 1u << be; }
        float fifth = -INFINITY; _Pragma("unroll") for (int e = 0; e < 32; ++e) if (!((used >> e) & 1)) fifth = fmaxf(fifth, lg[e]);
        const bool neartie = (sv[3] - fifth) < 3e-2f || (sv[0] - sv[1]) < 3e-2f || (sv[1] - sv[2]) < 3e-2f || (sv[2] - sv[3]) < 3e-2f;
        float den = 0.f; _Pragma("unroll") for (int r = 0; r < 4; ++r) den += expf(sv[r] - sv[0]);
        bool bad = false, badg = false;
        if (!neartie) _Pragma("unroll") for (int r = 0; r < 4; ++r) { const int e = tok_e[t * 4 + r], rk = tok_r[t * 4 + r]; if (e != se[r]) { bad = true; continue; }
            if (rk < 0 || rk >= LCAP || list_t[(size_t)e * LCAP + rk] != t) badg = true; else if (!close_(list_g[(size_t)e * LCAP + rk], expf(sv[r] - sv[0]) / den, 0.03f, 1e-3f)) badg = true; }
        if (bad) DBG_FAIL(13); if (badg) DBG_FAIL(14);
        { float sm = 0.f, sq = 0.f; for (int k = 0; k < 1024; ++k) { const float z = (bfv(x1 + k) - args.in[14][k]) / args.in[13][k]; sm += z; sq += z * z; }
          if (fabsf(sm / 1024.f) > 4e-3f || fabsf(sq / 1024.f - 1.0f) > 2e-2f) DBG_FAIL(19); }
    }
    if (stage >= 7 && stage <= 9) {
        __shared__ int st[33], cn[32];
        if (threadIdx.x == 0) { int a = 0; for (int e2 = 0; e2 < 32; ++e2) { cn[e2] = (int)((const unsigned*)(ws + WS_CTL))[CW_CNT + 64 * l + e2]; st[e2] = a; a += ((cn[e2] + 255) >> 8) << 8; } st[32] = a; }
        __syncthreads();
        const int total = st[32]; const int sl = h1 % total; int e = 0; for (int k = 1; k < 32; ++k) if (sl >= st[k]) e = k; const int r = sl - st[e];
        const int* list_t = (const int*)(ws + WS_LT); const float* list_g = (const float*)(ws + WS_LG); const float* sg = (const float*)(ws + WS_SG);
        if (stage == 7) { int sum = 0; for (int k = 0; k < 32; ++k) sum += cn[k]; if (sum != TK) DBG_FAIL(15); }
        if (stage == 7 && r < cn[e]) {
            const bf16* xg = (const bf16*)(ws + WS_X1B) + (size_t)list_t[(size_t)e * LCAP + r] * D; const int f = h2 % 1024; const float* W = args.in[17] + (size_t)e * 1024 * 2048;
            float g = args.in[18][e * 2048 + f], u = args.in[18][e * 2048 + 1024 + f];
            for (int k = 0; k < 1024; ++k) { const float xv = bfv(xg + k); g += xv * bfr(W[(size_t)k * 2048 + f]); u += xv * bfr(W[(size_t)k * 2048 + 1024 + f]); }
            g = fminf(g, 7.0f); u = fminf(fmaxf(u, -7.0f), 7.0f); const float ref = g / (1.0f + expf(-1.702f * g)) * (u + 1.0f);
            if (!close_(bfv((const bf16*)(ws + WS_A2) + (size_t)sl * 1024 + f), ref, 0.03f, 0.02f)) DBG_FAIL(16);
        }
        if (stage == 8 && r < cn[e]) {
            const bf16* ab = (const bf16*)(ws + WS_A2) + (size_t)sl * 1024; const int n = h2 % 1024; const float* W = args.in[19] + (size_t)e * 1024 * 1024;
            float y = args.in[20][e * 1024 + n]; for (int k = 0; k < 1024; ++k) y += bfv(ab + k) * bfr(W[(size_t)k * 1024 + n]);
            y *= list_g[(size_t)e * LCAP + r];
            if (!close_(bfv((const bf16*)(ws + WS_H) + (size_t)sl * 1024 + n), y, 0.03f, 0.005f)) DBG_FAIL(17);
        }
        if (stage == 9) {
            const bf16* x1 = (const bf16*)(ws + WS_X1B) + (size_t)t * D; const int* tok_e = (const int*)(ws + WS_TE); const int* tok_r = (const int*)(ws + WS_TR);
            const bf16* ybf = (const bf16*)(ws + WS_H); float sm = 0.f, sq = 0.f; const int n = h2 % 1024; float vn = 0.f;
            for (int k = 0; k < 1024; ++k) { float v = DN_ALPHA * bfv(x1 + k); for (int q = 0; q < 4; ++q) v += bfv(ybf + (size_t)(st[tok_e[t * 4 + q]] + tok_r[t * 4 + q]) * D + k); sm += v; sq += v * v; if (k == n) vn = v; }
            const float mean = sm / 1024.f, var = sq / 1024.f - mean * mean; const float ref = (vn - mean) / sqrtf(var + LN_EPS) * args.in[21][n] + args.in[22][n];
            if (!close_(bfv((const bf16*)(ws + WS_XB) + (size_t)t * D + n), ref, 0.01f, 0.01f)) DBG_FAIL(18);
        }
    }
}
static void dbg_launch(int stage, const Args& a, hipStream_t stream) {
    switch (stage) {
#define DBGL(k) case k: hipLaunchKernelGGL(dbg_kernel<k>, dim3(8), dim3(256), 0, stream, a); break;
        DBGL(0) DBGL(1) DBGL(2) DBGL(3) DBGL(4) DBGL(5) DBGL(6) DBGL(7) DBGL(8) DBGL(9)
#undef DBGL
    }
}
#endif

extern "C" void kernel_launch(void* const* d_in, const int* in_sizes, int n_in, void* d_out, int out_size, void* d_ws, size_t ws_size, hipStream_t stream) {
    static int grid = 0;
    if (grid == 0) {
        if (n_in != 23 || in_sizes[0] != T * D || out_size != T * D || ws_size < WS_END) { fprintf(stderr, "kernel_launch: unexpected shapes / workspace (%d inputs, ws %zu, need %zu)\n", n_in, ws_size, (size_t)WS_END); grid = -1; return; }
        int dev = 0, cus = 0, per_cu = 0;
        if (hipGetDevice(&dev) != hipSuccess || hipDeviceGetAttribute(&cus, hipDeviceAttributeMultiprocessorCount, dev) != hipSuccess) { grid = -1; return; }
        if (hipFuncSetAttribute((const void*)mk_fwd, hipFuncAttributeMaxDynamicSharedMemorySize, LDS_BYTES) != hipSuccess) { fprintf(stderr, "kernel_launch: hipFuncSetAttribute failed\n"); grid = -1; return; }
        if (hipOccupancyMaxActiveBlocksPerMultiprocessor(&per_cu, (const void*)mk_fwd, NWAVES * 64, LDS_BYTES) != hipSuccess || per_cu < 1) { fprintf(stderr, "kernel_launch: occupancy query reports %d\n", per_cu); }
        (void)hipGetLastError();
        grid = cus;
    }
    if (grid < 0) return;
    if (hipMemsetAsync((char*)d_ws + WS_CTL, 0, CTL_ZERO_BYTES, stream) != hipSuccess) return;
    Args a{};
    for (int i = 0; i < 23; ++i) a.in[i] = (const float*)d_in[i];
    a.out = (float*)d_out; a.ws = (unsigned char*)d_ws; a.pad = 0;
#if MK_ONE_LAUNCH
    a.ph_lo = 0; a.ph_hi = NPH; a.use_bar = 1;
    hipLaunchKernelGGL(mk_fwd, dim3(grid), dim3(NWAVES * 64), LDS_BYTES, stream, a);
#else
    for (int p = 0; p < NPH; ++p) { a.ph_lo = p; a.ph_hi = p + 1; a.use_bar = 0; hipLaunchKernelGGL(mk_fwd, dim3(grid), dim3(NWAVES * 64), LDS_BYTES, stream, a);
#if MK_DEBUG
        if (p >= 1 && p <= PPL) dbg_launch(p - 1, a, stream);
#endif
    }
#endif
    const hipError_t le = hipPeekAtLastError();
    if (le != hipSuccess) fprintf(stderr, "kernel_launch: launch failed: %s\n", hipGetErrorName(le));
}
```

```cpp
#define MK_DEBUG 0
#define MK_ONE_LAUNCH 1
#ifndef MK_FP8_QK
#define MK_FP8_QK 1
#endif
#ifndef MK_FP8_PV
#define MK_FP8_PV 1
#endif
#include <hip/hip_runtime.h>
#include <hip/hip_bf16.h>
#include <cstdio>
#include <cstdint>
namespace pg8 {
#define PG8_LAS __attribute__((address_space(3)))
typedef unsigned short bf16_t;
typedef short bf16x8 __attribute__((ext_vector_type(8)));
typedef float f32x4 __attribute__((ext_vector_type(4)));
typedef unsigned u32x4 __attribute__((ext_vector_type(4)));
constexpr int BM = 256, BK = 64, HALF = 128, HTB = HALF * BK * 2  , STAGE_BYTES = 8 * HTB, NXCD = 8, WGM = 8;

__host__ __device__ __forceinline__ int lds_byte(int r, int c) { const int st = (r >> 4) * 2 + (c >> 5), rr = r & 15, cc = c & 31, ob = rr * 64 + cc * 2; return st * 1024 + (ob ^ (((ob >> 9) & 1) << 5)); }
__host__ __device__ __forceinline__ void stage_rc(int b, int& R, int& C) { const int st = b / 1024, sb = b % 1024, swz = sb ^ (((sb >> 9) & 1) << 5); R = (st >> 1) * 16 + swz / 64; C = (st & 1) * 32 + (swz % 64) / 2; }
__host__ __device__ __forceinline__ int perm32(int rho) { const int n = rho >> 4, i = rho & 15; return 8 * (i >> 2) + 4 * n + (i & 3); }

struct Unit { int pm, pn, e; };
struct Gemm { const bf16_t* A; const bf16_t* Bt; int M, N, K; size_t bstride; size_t astride; const void* base; };

struct StaticOrder {
    int nM, nN, nwg, G, c;
    __host__ __device__ void init(int M, int N, int G_, int c_) { nM = M / BM; nN = N / BM; nwg = nM * nN; G = G_; c = c_; }
    __host__ __device__ bool next(int i, Unit& u) const {
        const long L = (long)i * G + c; if (L >= nwg) return false;
        int wgid = (int)L; { const int q = nwg / NXCD, r = nwg % NXCD, xcd = wgid % NXCD, off = wgid / NXCD; wgid = (xcd < r ? xcd * (q + 1) : r * (q + 1) + (xcd - r) * q) + off; }
        const int nig = WGM * nN, gid = wgid / nig, fm = gid * WGM, gsz = (nM - fm) < WGM ? (nM - fm) : WGM;
        u.pm = fm + ((wgid % nig) % gsz); u.pn = (wgid % nig) / gsz; u.e = 0; return true;
    }
    __device__ __forceinline__ void a_ready(const Unit&) const {}
    __device__ __forceinline__ void done(const Unit&) const {}
};

__device__ __forceinline__ unsigned cvt_pk_bf16(float lo, float hi) { unsigned r; asm volatile("v_cvt_pk_bf16_f32 %0, %1, %2" : "=v"(r) : "v"(lo), "v"(hi)); return r; }
typedef float f32x2 __attribute__((ext_vector_type(2)));


__device__ __forceinline__ float bf_lo(unsigned w) { return __uint_as_float(w << 16); }
__device__ __forceinline__ float bf_hi(unsigned w) { return __uint_as_float(w & 0xffff0000u); }
__device__ __forceinline__ float sigmoidf_(float z) { return __builtin_amdgcn_rcpf(1.0f + __builtin_amdgcn_exp2f(-1.4426950408889634f * z)); }
__device__ __forceinline__ u32x4 pack8(const f32x4& v0, const f32x4& v1) { u32x4 w; w.x = cvt_pk_bf16(v0[0], v0[1]); w.y = cvt_pk_bf16(v0[2], v0[3]); w.z = cvt_pk_bf16(v1[0], v1[1]); w.w = cvt_pk_bf16(v1[2], v1[3]); return w; }
__device__ __forceinline__ float sat8(float v) { return __builtin_amdgcn_fmed3f(v, -448.0f, 448.0f); }
__device__ __forceinline__ unsigned pk4_fp8(float a, float b, float c, float d) { int r = __builtin_amdgcn_cvt_pk_fp8_f32(sat8(a), sat8(b), 0, false); r = __builtin_amdgcn_cvt_pk_fp8_f32(sat8(c), sat8(d), r, true); return (unsigned)r; }

struct EpiStore {
    static constexpr bool PERM = true, AFTER_DRAIN = false, CHAIN = false;
    bf16_t* O; int ldc; int nvalid; float ascale;
    __device__ __forceinline__ void operator()(const f32x4 (&acc)[2][2][4][2], const Unit& u, int wr, int wc, int fr, int fq) const {
        const int row0 = u.pm * BM + wr * 64 + fr, col0 = u.pn * BM + wc * 32 + 8 * fq;
#pragma unroll
        for (int ai = 0; ai < 2; ++ai)
#pragma unroll
            for (int m = 0; m < 4; ++m) { bf16_t* rowp = O + (size_t)(row0 + ai * HALF + m * 16) * ldc + col0;
#pragma unroll
                for (int bj = 0; bj < 2; ++bj) { if (col0 + bj * HALF < nvalid) *(u32x4*)(rowp + bj * HALF) = pack8(acc[ai][bj][m][0] * ascale, acc[ai][bj][m][1] * ascale); } }
    }
};
struct EpiGateChain {
    static constexpr bool PERM = true, AFTER_DRAIN = false, CHAIN = true;
    const bf16_t* gate; int ldg; void* mixed; float oscale;
    __device__ __forceinline__ void chain(f32x4 (&acc)[2][2][4][2], const Unit& u, int wr, int wc, int fr, int fq) const {
        const int row0 = u.pm * BM + wr * 64 + fr, col0 = u.pn * BM + wc * 32 + 8 * fq;
#pragma unroll
        for (int ai = 0; ai < 2; ++ai)
#pragma unroll
            for (int m = 0; m < 4; ++m) { const size_t row = (size_t)(row0 + ai * HALF + m * 16);
#pragma unroll
                for (int bj = 0; bj < 2; ++bj) { const int col = col0 + bj * HALF;
                    const u32x4 ga = *(const u32x4*)(gate + row * ldg + u.e * 1024 + col);
                    f32x4 na0 = {1.f + __builtin_amdgcn_exp2f(-1.4426950408889634f * bf_lo(ga.x)), 1.f + __builtin_amdgcn_exp2f(-1.4426950408889634f * bf_hi(ga.x)), 1.f + __builtin_amdgcn_exp2f(-1.4426950408889634f * bf_lo(ga.y)), 1.f + __builtin_amdgcn_exp2f(-1.4426950408889634f * bf_hi(ga.y))};
                    f32x4 na1 = {1.f + __builtin_amdgcn_exp2f(-1.4426950408889634f * bf_lo(ga.z)), 1.f + __builtin_amdgcn_exp2f(-1.4426950408889634f * bf_hi(ga.z)), 1.f + __builtin_amdgcn_exp2f(-1.4426950408889634f * bf_lo(ga.w)), 1.f + __builtin_amdgcn_exp2f(-1.4426950408889634f * bf_hi(ga.w))};
                    f32x4 f0, f1;
#pragma unroll
                    for (int q = 0; q < 4; ++q) { f0[q] = __builtin_amdgcn_rcpf(na0[q]); f1[q] = __builtin_amdgcn_rcpf(na1[q]); }
                    if (u.e < 2) { const u32x4 gb = *(const u32x4*)(gate + row * ldg + (u.e + 1) * 1024 + col);
                        f0[0] *= 1.f + __builtin_amdgcn_exp2f(-1.4426950408889634f * bf_lo(gb.x)); f0[1] *= 1.f + __builtin_amdgcn_exp2f(-1.4426950408889634f * bf_hi(gb.x));
                        f0[2] *= 1.f + __builtin_amdgcn_exp2f(-1.4426950408889634f * bf_lo(gb.y)); f0[3] *= 1.f + __builtin_amdgcn_exp2f(-1.4426950408889634f * bf_hi(gb.y));
                        f1[0] *= 1.f + __builtin_amdgcn_exp2f(-1.4426950408889634f * bf_lo(gb.z)); f1[1] *= 1.f + __builtin_amdgcn_exp2f(-1.4426950408889634f * bf_hi(gb.z));
                        f1[2] *= 1.f + __builtin_amdgcn_exp2f(-1.4426950408889634f * bf_lo(gb.w)); f1[3] *= 1.f + __builtin_amdgcn_exp2f(-1.4426950408889634f * bf_hi(gb.w)); }
                    acc[ai][bj][m][0] *= f0; acc[ai][bj][m][1] *= f1;
                    if (u.e == 2) { if (oscale == 0.f) *(u32x4*)((bf16_t*)mixed + row * 1024 + col) = pack8(acc[ai][bj][m][0], acc[ai][bj][m][1]);
                        else { typedef unsigned u32x2 __attribute__((ext_vector_type(2))); const f32x4 a0 = acc[ai][bj][m][0] * oscale, a1 = acc[ai][bj][m][1] * oscale;
                            *(u32x2*)((unsigned char*)mixed + row * 1024 + col) = (u32x2){pk4_fp8(a0[0], a0[1], a0[2], a0[3]), pk4_fp8(a1[0], a1[1], a1[2], a1[3])}; } } } }
    }
};
struct ChainOrder {
    StaticOrder so; int nch;
    __device__ __forceinline__ bool next(int i, Unit& u) const { const int t = i / nch; if (!so.next(t, u)) return false; u.e = i - t * nch; return true; }
    __device__ __forceinline__ void a_ready(const Unit&) const {}
    __device__ __forceinline__ void done(const Unit&) const {}
};
struct EpiResid {
    static constexpr bool PERM = true, AFTER_DRAIN = false, CHAIN = false;
    const float* x; float* pre; float alpha;
    __device__ __forceinline__ void operator()(const f32x4 (&acc)[2][2][4][2], const Unit& u, int wr, int wc, int fr, int fq) const {
        const int row0 = u.pm * BM + wr * 64 + fr, col0 = u.pn * BM + wc * 32 + 8 * fq;
#pragma unroll
        for (int ai = 0; ai < 2; ++ai)
#pragma unroll
            for (int m = 0; m < 4; ++m) { const size_t row = (size_t)(row0 + ai * HALF + m * 16);
#pragma unroll
                for (int bj = 0; bj < 2; ++bj) { const size_t off = row * 1024 + col0 + bj * HALF;
                    const f32x4 x0 = *(const f32x4*)(x + off), x1 = *(const f32x4*)(x + off + 4);
                    *(f32x4*)(pre + off) = x0 * alpha + acc[ai][bj][m][0]; *(f32x4*)(pre + off + 4) = x1 * alpha + acc[ai][bj][m][1]; } }
    }
};
template <bool OUT8> struct EpiSwigluT {
    static constexpr bool PERM = true, AFTER_DRAIN = false, CHAIN = false;
    void* a; const float* bias; float ascale, oscale;
    __device__ __forceinline__ void operator()(const f32x4 (&acc)[2][2][4][2], const Unit& u, int wr, int wc, int fr, int fq) const {
        const int row0 = u.pm * BM + wr * 64 + fr, j0 = wc * 32 + 8 * fq, oc = u.pn * HALF + j0;
        const float* bg = bias + (size_t)u.e * 2048 + oc; const float* bu = bg + 1024;
        const f32x4 bg0 = *(const f32x4*)bg, bg1 = *(const f32x4*)(bg + 4), bu0 = *(const f32x4*)bu, bu1 = *(const f32x4*)(bu + 4);
#pragma unroll
        for (int ai = 0; ai < 2; ++ai)
#pragma unroll
            for (int m = 0; m < 4; ++m) { const size_t row = (size_t)(row0 + ai * HALF + m * 16);
                f32x4 g[2] = {acc[ai][0][m][0] * ascale + bg0, acc[ai][0][m][1] * ascale + bg1}, uu[2] = {acc[ai][1][m][0] * ascale + bu0, acc[ai][1][m][1] * ascale + bu1}, r[2];
#pragma unroll
                for (int n = 0; n < 2; ++n)
#pragma unroll
                    for (int q = 0; q < 4; ++q) { const float gg = fminf(g[n][q], 7.0f), uc = fminf(fmaxf(uu[n][q], -7.0f), 7.0f);
                        r[n][q] = gg * sigmoidf_(1.702f * gg) * (uc + 1.0f); }
                if constexpr (OUT8) { typedef unsigned u32x2 __attribute__((ext_vector_type(2)));
                    *(u32x2*)((unsigned char*)a + row * 1024 + oc) = (u32x2){pk4_fp8(r[0][0] * oscale, r[0][1] * oscale, r[0][2] * oscale, r[0][3] * oscale), pk4_fp8(r[1][0] * oscale, r[1][1] * oscale, r[1][2] * oscale, r[1][3] * oscale)}; }
                else *(u32x4*)((bf16_t*)a + row * 1024 + oc) = pack8(r[0], r[1]);
                asm volatile("" ::: "memory"); }
    }
};
struct EpiDown {
    static constexpr bool PERM = true, AFTER_DRAIN = false, CHAIN = false;
    bf16_t* y; const float* bias; const float* list_g; const PG8_LAS int* st; const PG8_LAS int* cn; int lcap; float ascale;
    __device__ __forceinline__ void operator()(const f32x4 (&acc)[2][2][4][2], const Unit& u, int wr, int wc, int fr, int fq) const {
        const int row0 = u.pm * BM + wr * 64 + fr, col0 = u.pn * BM + wc * 32 + 8 * fq;
        const int st_e = st[u.e], cn_e = cn[u.e];
        f32x4 bv[2][2];
#pragma unroll
        for (int bj = 0; bj < 2; ++bj)
#pragma unroll
            for (int n = 0; n < 2; ++n) bv[bj][n] = *(const f32x4*)(bias + (size_t)u.e * 1024 + col0 + bj * HALF + 4 * n);
#pragma unroll
        for (int ai = 0; ai < 2; ++ai)
#pragma unroll
            for (int m = 0; m < 4; ++m) { const size_t row = (size_t)(row0 + ai * HALF + m * 16); const int rank = (int)row - st_e;
                const float gt = rank < cn_e ? list_g[(size_t)u.e * lcap + rank] : 0.f;
#pragma unroll
                for (int bj = 0; bj < 2; ++bj) { const f32x4 v0 = (acc[ai][bj][m][0] * ascale + bv[bj][0]) * gt, v1 = (acc[ai][bj][m][1] * ascale + bv[bj][1]) * gt;
                    *(u32x4*)(y + row * 1024 + col0 + bj * HALF) = pack8(v0, v1); } }
    }
};
struct MoeGather {
    const int* list_t; const PG8_LAS int* st; const PG8_LAS int* cn; int lcap;
    __device__ __forceinline__ int row(const Unit& u, int r) const { int rank = u.pm * BM + r - st[u.e]; const int c = cn[u.e]; rank = rank < c ? rank : c - 1; return list_t[(size_t)u.e * lcap + rank]; }
};
struct MoeOrder {
    int nN, nunits, G, c; const PG8_LAS int* tile_e;
    __device__ __forceinline__ bool next(int i, Unit& u) const {
        const long L = (long)i * G + c; if (L >= nunits) return false;
        const int tile = (int)L / nN; u.pm = tile; u.pn = (int)L % nN; u.e = __builtin_amdgcn_readfirstlane(tile_e[tile]); return true;
    }
    __device__ __forceinline__ void a_ready(const Unit&) const {}
    __device__ __forceinline__ void done(const Unit&) const {}
};

template <int ES> struct PtSel { typedef const char* T; static __device__ __forceinline__ T mk(const char* p, const char*) { return p; } };
template <> struct PtSel<1> { typedef unsigned T; static __device__ __forceinline__ T mk(const char* p, const char* base) { return (unsigned)(size_t)(p - base); } };
struct NoGather { };
typedef int i32x8 __attribute__((ext_vector_type(8)));
template <class Epi, class Sched, bool ALIGN_EPI = false, bool SP2 = false, bool GATHER = false, class GS = NoGather, int ESIZE = 2>
__device__ __forceinline__ void gemm_phase(PG8_LAS unsigned char* lds, const Gemm g, const Sched& S, const Epi& E, const int tid, const GS gs = GS()) {
    const int wid = __builtin_amdgcn_readfirstlane(tid >> 6), lane = tid & 63, wr = wid >> 2, wc = wid & 3, fr = lane & 15, fq = lane >> 4;
    const int K = g.K * ESIZE / 2; int nt = K / BK;
    if constexpr (ESIZE == 1) asm volatile("" : "+s"(nt));
    int sc8 = 0x7F7F7F7F; if constexpr (ESIZE == 1) asm volatile("" : "+v"(sc8));
    typedef typename PtSel<ESIZE>::T PT;
    __amdgpu_buffer_rsrc_t rsrc = __builtin_amdgcn_make_buffer_rsrc((void*)g.base, 0, 0x7fffffff, 0x00020000);
#define PG8_PT(p) PtSel<ESIZE>::mk((const char*)(p), (const char*)g.base)
    unsigned voffA[2], voffB[2];
#pragma unroll
    for (int i = 0; i < 2; ++i) { int R, C; stage_rc(tid * 16 + i * 8192, R, C); const int Rb = Epi::PERM ? ((R & ~31) + perm32(R & 31)) : R;
        voffA[i] = (unsigned)(R * K + C) * 2u; voffB[i] = (unsigned)(Rb * K + C) * 2u; }
    unsigned vc0[2], vc1[2], vn0[2], vn1[2];
#define PG8_GROWS(u_, o0, o1) do { _Pragma("unroll") for (int i_ = 0; i_ < 2; ++i_) { int R_, C_; stage_rc(tid * 16 + i_ * 8192, R_, C_); \
        o0[i_] = (unsigned)gs.row((u_), R_) * (unsigned)(K * 2) + (unsigned)(C_ * 2); o1[i_] = (unsigned)gs.row((u_), HALF + R_) * (unsigned)(K * 2) + (unsigned)(C_ * 2); } } while (0)
    const size_t kstep = (size_t)(BK * 2);
    const size_t hstep = (size_t)HALF * K * 2;
    const size_t tstep = 2 * hstep;
    const unsigned ldsw = (unsigned)wid * 1024u;
    const int aoff = lds_byte(wr * 64 + fr, fq * 8), boff = lds_byte(wc * 32 + fr, fq * 8);
#define PG8_SA(b, h) (((b) * 2 + (h)) * HTB)
#define PG8_SB(b, h) ((4 + (b) * 2 + (h)) * HTB)
#define PG8_STAGE(bufoff, gbase, voff) do { _Pragma("unroll") for (int _i = 0; _i < 2; ++_i) { \
        if constexpr (ESIZE == 2) __builtin_amdgcn_global_load_lds((const unsigned*)((const char*)(size_t)(gbase) + (voff)[_i]), (PG8_LAS unsigned*)(lds + (bufoff) + ldsw + _i * 8192), 16, 0, 0); \
        else __builtin_amdgcn_raw_ptr_buffer_load_lds(rsrc, (PG8_LAS void*)(lds + (bufoff) + ldsw + _i * 8192), 16, (int)(voff)[_i], (int)(size_t)(gbase), 0, 0); } } while (0)
typedef int i32x4_ __attribute__((ext_vector_type(4)));
#define PG8_LD8(off) __builtin_shufflevector(*(const PG8_LAS i32x4_*)(lds + (off)), *(const PG8_LAS i32x4_*)(lds + (off) + 1024), 0, 1, 2, 3, 4, 5, 6, 7)
#define PG8_LDA(dst, b, h) do { if constexpr (ESIZE == 2) { _Pragma("unroll") for (int m = 0; m < 4; ++m) _Pragma("unroll") for (int k = 0; k < 2; ++k) dst[m][k] = *(const PG8_LAS bf16x8*)(lds + PG8_SA(b, h) + aoff + m * 2048 + k * 1024); } \
        else { _Pragma("unroll") for (int m = 0; m < 4; ++m) dst##8[m] = PG8_LD8(PG8_SA(b, h) + aoff + m * 2048); } } while (0)
#define PG8_LDB(dst, b, h) do { if constexpr (ESIZE == 2) { _Pragma("unroll") for (int n = 0; n < 2; ++n) _Pragma("unroll") for (int k = 0; k < 2; ++k) dst[n][k] = *(const PG8_LAS bf16x8*)(lds + PG8_SB(b, h) + boff + n * 2048 + k * 1024); } \
        else { _Pragma("unroll") for (int n = 0; n < 2; ++n) dst##8[n] = PG8_LD8(PG8_SB(b, h) + boff + n * 2048); } } while (0)
#define PG8_F8CAT(x, y) (i32x8){((const int*)&(x))[0], ((const int*)&(x))[1], ((const int*)&(x))[2], ((const int*)&(x))[3], ((const int*)&(y))[0], ((const int*)&(y))[1], ((const int*)&(y))[2], ((const int*)&(y))[3]}
#define PG8_MMA(ai, bj, At, Bt) do { __builtin_amdgcn_s_setprio(1); if constexpr (ESIZE == 2) { _Pragma("unroll") for (int m = 0; m < 4; ++m) _Pragma("unroll") for (int n = 0; n < 2; ++n) _Pragma("unroll") for (int k = 0; k < 2; ++k) \
        acc[ai][bj][m][n] = __builtin_amdgcn_mfma_f32_16x16x32_bf16(Bt[n][k], At[m][k], acc[ai][bj][m][n], 0, 0, 0); } \
        else { _Pragma("unroll") for (int m = 0; m < 4; ++m) _Pragma("unroll") for (int n = 0; n < 2; ++n) \
        asm volatile("v_mfma_scale_f32_16x16x128_f8f6f4 %0, %1, %2, %0, %3, %3 op_sel_hi:[0,0,0]" : "+v"(acc[ai][bj][m][n]) : "v"(Bt##8[n]), "v"(At##8[m]), "v"(sc8)); \
        }   \
        __builtin_amdgcn_s_setprio(0); } while (0)
#define PG8_WAIT_V(n) asm volatile("s_waitcnt vmcnt(" #n ")" ::: "memory")
#define PG8_WAIT_L(n) asm volatile("s_waitcnt lgkmcnt(" #n ")" ::: "memory")
#define PG8_BAR __builtin_amdgcn_s_barrier()
#define PG8_SCHED __builtin_amdgcn_sched_barrier(0)
    Unit cur, nxt; int ui = 0;
    if (!S.next(0, cur)) return;
    f32x4 acc[2][2][4][2];
#pragma unroll
    for (int a = 0; a < 2; ++a)
#pragma unroll
        for (int b = 0; b < 2; ++b)
#pragma unroll
            for (int m = 0; m < 4; ++m)
#pragma unroll
                for (int n = 0; n < 2; ++n) acc[a][b][m][n] = (f32x4){0.f, 0.f, 0.f, 0.f};
    bf16x8 At[4][2], B0[2][2], B1[2][2];
    i32x8 At8[4], B08[2], B18[2];
    PT cA = PG8_PT(GATHER ? (const char*)g.A : (const char*)g.A + (size_t)cur.pm * tstep + (size_t)cur.e * g.astride);
    if constexpr (GATHER) { PG8_GROWS(cur, vc0, vc1); } else { _Pragma("unroll") for (int i = 0; i < 2; ++i) { vc0[i] = voffA[i]; vc1[i] = voffA[i] + (unsigned)hstep; } }
#pragma unroll
    for (int i = 0; i < 2; ++i) { vn0[i] = vc0[i]; vn1[i] = vc1[i]; }
    PT cB = PG8_PT((const char*)g.Bt + (size_t)cur.pn * tstep + (size_t)cur.e * g.bstride);
    S.a_ready(cur);
    if constexpr (SP2) {
        PG8_STAGE(PG8_SB(0, 0), cB, voffB); PG8_STAGE(PG8_SB(0, 1), cB + hstep, voffB); PG8_STAGE(PG8_SA(0, 0), cA, vc0); PG8_STAGE(PG8_SA(0, 1), cA, vc1);
        if (wr == 1) PG8_BAR;
        PG8_WAIT_V(2); PG8_BAR;
        PG8_STAGE(PG8_SB(1, 0), cB + kstep, voffB); PG8_STAGE(PG8_SA(1, 0), cA + kstep, vc0); PG8_STAGE(PG8_SB(1, 1), cB + hstep + kstep, voffB);
        PG8_WAIT_V(6); PG8_BAR;
    } else {
        PG8_STAGE(PG8_SB(0, 0), cB, voffB); PG8_STAGE(PG8_SA(0, 0), cA, vc0); PG8_STAGE(PG8_SB(0, 1), cB + hstep, voffB); PG8_STAGE(PG8_SA(0, 1), cA, vc1);
        if (wr == 1) PG8_BAR;
        PG8_WAIT_V(4); PG8_BAR;
        PG8_STAGE(PG8_SB(1, 0), cB + kstep, voffB); PG8_STAGE(PG8_SA(1, 0), cA + kstep, vc0); PG8_STAGE(PG8_SB(1, 1), cB + hstep + kstep, voffB);
        PG8_WAIT_V(6); PG8_BAR;
    }
    for (;;) {
        const bool has_next = S.next(ui + 1, nxt);
        const PT nA = GATHER ? cA : (has_next ? PG8_PT((const char*)g.A + (size_t)nxt.pm * tstep + (size_t)nxt.e * g.astride) : cA);
        if constexpr (GATHER) { if (has_next) { PG8_GROWS(nxt, vn0, vn1); } } const PT nB = has_next ? PG8_PT((const char*)g.Bt + (size_t)nxt.pn * tstep + (size_t)nxt.e * g.bstride) : cB;
        for (int t = 0; t < nt; t += 2) {
            const bool last = (t == nt - 2);
            const PT a1 = cA + (unsigned)((t + 1) * (int)kstep);
            const PT a2 = last ? nA : cA + (unsigned)((t + 2) * (int)kstep); const PT b2 = last ? nB : cB + (unsigned)((t + 2) * (int)kstep);
            const PT a3 = a2 + (unsigned)kstep; const PT b3 = b2 + (unsigned)kstep;
            unsigned vs0[2], vs1[2];
#pragma unroll
            for (int i = 0; i < 2; ++i) { vs0[i] = (GATHER && last) ? vn0[i] : vc0[i]; vs1[i] = (GATHER && last) ? vn1[i] : vc1[i]; }
            if (last && has_next) S.a_ready(nxt);
            if constexpr (SP2) {
            PG8_LDB(B0, 0, 0); PG8_LDB(B1, 0, 1); PG8_SCHED; PG8_LDA(At, 0, 0); PG8_STAGE(PG8_SA(1, 1), a1, vc1);
            PG8_WAIT_V(8); PG8_WAIT_L(0); PG8_BAR; PG8_MMA(0, 0, At, B0); PG8_MMA(0, 1, At, B1); PG8_BAR; PG8_SCHED;
            PG8_LDA(At, 0, 1); PG8_STAGE(PG8_SB(0, 0), b2, voffB); PG8_STAGE(PG8_SB(0, 1), b2 + hstep, voffB); PG8_STAGE(PG8_SA(0, 0), a2, vs0);
            PG8_WAIT_V(8); PG8_WAIT_L(0); PG8_BAR; PG8_MMA(1, 0, At, B0); PG8_MMA(1, 1, At, B1); PG8_BAR; PG8_SCHED;
            PG8_LDB(B0, 1, 0); PG8_LDB(B1, 1, 1); PG8_SCHED; PG8_LDA(At, 1, 0); PG8_STAGE(PG8_SA(0, 1), a2, vs1);
            PG8_WAIT_V(8); PG8_WAIT_L(0); PG8_BAR; PG8_MMA(0, 0, At, B0); PG8_MMA(0, 1, At, B1); PG8_BAR; PG8_SCHED;
            PG8_LDA(At, 1, 1); PG8_STAGE(PG8_SB(1, 0), b3, voffB); PG8_STAGE(PG8_SB(1, 1), b3 + hstep, voffB); PG8_STAGE(PG8_SA(1, 0), a3, vs0);
            PG8_WAIT_V(8); PG8_WAIT_L(0); PG8_BAR; PG8_MMA(1, 0, At, B0); PG8_MMA(1, 1, At, B1); PG8_BAR; PG8_SCHED;
            } else {
            PG8_LDB(B0, 0, 0); PG8_SCHED; PG8_LDA(At, 0, 0); PG8_STAGE(PG8_SA(1, 1), a1, vc1);
            PG8_WAIT_L(8); PG8_BAR; PG8_WAIT_L(0); PG8_MMA(0, 0, At, B0); PG8_BAR; PG8_SCHED;
            PG8_LDB(B1, 0, 1); PG8_STAGE(PG8_SB(0, 0), b2, voffB);
            PG8_BAR; PG8_WAIT_L(0); PG8_MMA(0, 1, At, B1); PG8_BAR;
            PG8_LDA(At, 0, 1); PG8_STAGE(PG8_SA(0, 0), a2, vs0);
            PG8_BAR; PG8_WAIT_L(0); PG8_MMA(1, 0, At, B0); PG8_BAR; PG8_SCHED;
            PG8_STAGE(PG8_SB(0, 1), b2 + hstep, voffB);
            PG8_WAIT_V(6); PG8_BAR; PG8_MMA(1, 1, At, B1); PG8_BAR;
            PG8_LDB(B0, 1, 0); PG8_SCHED; PG8_LDA(At, 1, 0); PG8_STAGE(PG8_SA(0, 1), a2, vs1);
            PG8_WAIT_L(8); PG8_BAR; PG8_WAIT_L(0); PG8_MMA(0, 0, At, B0); PG8_BAR; PG8_SCHED;
            PG8_LDB(B1, 1, 1); PG8_STAGE(PG8_SB(1, 0), b3, voffB);
            PG8_BAR; PG8_WAIT_L(0); PG8_MMA(0, 1, At, B1); PG8_BAR;
            PG8_LDA(At, 1, 1); PG8_STAGE(PG8_SA(1, 0), a3, vs0);
            PG8_BAR; PG8_WAIT_L(0); PG8_MMA(1, 0, At, B0); PG8_BAR; PG8_SCHED;
            PG8_STAGE(PG8_SB(1, 1), b3 + hstep, voffB);
            PG8_WAIT_V(6); PG8_BAR; PG8_MMA(1, 1, At, B1); PG8_BAR;
            }
        }
        if constexpr (ESIZE == 1) asm volatile("s_nop 15\n\ts_nop 15" ::: "memory");
        if constexpr (ALIGN_EPI) { if (wr == 0) PG8_BAR; }
        if constexpr (!Epi::AFTER_DRAIN) { if constexpr (Epi::CHAIN) E.chain(acc, cur, wr, wc, fr, fq); else E(acc, cur, wr, wc, fr, fq); S.done(cur); }
        if (!has_next) break;
        if (!(Epi::CHAIN && nxt.e != 0)) {
#pragma unroll
        for (int a = 0; a < 2; ++a)
#pragma unroll
            for (int b = 0; b < 2; ++b)
#pragma unroll
                for (int m = 0; m < 4; ++m)
#pragma unroll
                    for (int n = 0; n < 2; ++n) acc[a][b][m][n] = (f32x4){0.f, 0.f, 0.f, 0.f};
        }
        cur = nxt; cA = nA; cB = nB; ++ui;
        if constexpr (GATHER) { _Pragma("unroll") for (int i = 0; i < 2; ++i) { vc0[i] = vn0[i]; vc1[i] = vn1[i]; } }
        if constexpr (ALIGN_EPI) { if (wr == 1) PG8_BAR; }
    }
    PG8_WAIT_V(0);
    if constexpr (!ALIGN_EPI) { if (wr == 0) PG8_BAR; }
    PG8_BAR;
    if constexpr (Epi::AFTER_DRAIN) { E.fused(acc, cur, wr, wc, fr, fq, lds, wid, lane); S.done(cur); }
#undef PG8_GROWS
#undef PG8_PT
#undef PG8_SA
#undef PG8_SB
#undef PG8_STAGE
#undef PG8_LDA
#undef PG8_LD8
#undef PG8_LDB
#undef PG8_MMA
#undef PG8_F8CAT
#undef PG8_WAIT_V
#undef PG8_WAIT_L
#undef PG8_BAR
#undef PG8_SCHED
}
}


namespace att {
typedef unsigned short bf16_t;
typedef short bf16x8 __attribute__((ext_vector_type(8)));
typedef short s16x4 __attribute__((ext_vector_type(4)));
typedef float f32x16 __attribute__((ext_vector_type(16)));
typedef unsigned u32x4 __attribute__((ext_vector_type(4)));
#define ALAS __attribute__((address_space(3)))
typedef ALAS unsigned char* ALAS_PTR;
#define ASBAR() __builtin_amdgcn_sched_barrier(0)
constexpr int QBLK = 32, KVBLK = 64;
constexpr float THR2 = 11.0f;
constexpr float LOG2E = 1.4426950408889634f, INV2PI = 0.15915494309189535f, LOG2_THETA = 13.287712379549449f;
constexpr int OFF_V = 0, VBUF = 8192, OFF_K = 16384, KBUF_MAX = 13312, OFF_WS = OFF_K + 2 * KBUF_MAX  , OFF_BIAS = OFF_WS + 2048  , ATT_LDS = OFF_BIAS + 2048;
__device__ __forceinline__ int crow(int r, int hi) { return (r & 3) + 8 * (r >> 2) + 4 * hi; }
__device__ __forceinline__ unsigned cvtpk(float lo, float hi) { unsigned r; asm volatile("v_cvt_pk_bf16_f32 %0, %1, %2" : "=v"(r) : "v"(lo), "v"(hi)); return r; }
__device__ __forceinline__ float bf2f(short s) { return __uint_as_float(((unsigned)(unsigned short)s) << 16); }
__device__ __forceinline__ short f2bf_s(float f) { return (short)(cvtpk(f, 0.f) & 0xffffu); }

struct UnitP {
    const bf16_t* Q; int ldq;
    const bf16_t* K0; int ldk0;
    const bf16_t* K1; int ldk1;
    const bf16_t* V; int ldv;
    bf16_t* O; int ldo;
    int nt;
    int grow0;
    const float* gain;
    int kr0;
    const unsigned char* V8;
    const unsigned char* K8; int ldk8;
    float cref;
};

typedef short v4i16_t __attribute__((ext_vector_type(4)));
__device__ __forceinline__ s16x4 vtr(const ALAS unsigned char* p) { return __builtin_bit_cast(s16x4, __builtin_amdgcn_ds_read_tr16_b64_v4i16((ALAS v4i16_t*)p)); }
__device__ __forceinline__ void pv_all(f32x16& o0, f32x16& o1, f32x16& lacc, const ALAS unsigned char* vp, bf16x8 pa0, bf16x8 pa1, bf16x8 pa2, bf16x8 pa3) {
    const bf16x8 ones = {(short)0x3F80, (short)0x3F80, (short)0x3F80, (short)0x3F80, (short)0x3F80, (short)0x3F80, (short)0x3F80, (short)0x3F80};
#define ATT_PK(L, H) (bf16x8){L[0], L[1], L[2], L[3], H[0], H[1], H[2], H[3]}
#define ATT_STEP(KS, PA) { const s16x4 l0 = vtr(vp + (KS) * 1024), h0 = vtr(vp + (KS) * 1024 + 512), l1 = vtr(vp + 4096 + (KS) * 1024), h1 = vtr(vp + 4096 + (KS) * 1024 + 512); \
        o0 = __builtin_amdgcn_mfma_f32_32x32x16_bf16(PA, ATT_PK(l0, h0), o0, 0, 0, 0); o1 = __builtin_amdgcn_mfma_f32_32x32x16_bf16(PA, ATT_PK(l1, h1), o1, 0, 0, 0); \
        lacc = __builtin_amdgcn_mfma_f32_32x32x16_bf16(PA, ones, lacc, 0, 0, 0); }
    ATT_STEP(0, pa0) ATT_STEP(1, pa1) ATT_STEP(2, pa2) ATT_STEP(3, pa3)
#undef ATT_STEP
#undef ATT_PK
}
template <int DQK> __device__ __forceinline__ void qkt(f32x16& p0, f32x16& p1, const ALAS unsigned char* Ks, const bf16x8* qr, const f32x16& cinit, int r32, int hi) {
    constexpr int KST = DQK * 2 + 16;
#pragma unroll
    for (int d0 = 0; d0 < DQK / 16; ++d0) { const int cb = (2 * d0 + hi) * 16;
        const bf16x8 b0 = *(const ALAS bf16x8*)(Ks + r32 * KST + cb);
        const bf16x8 b1 = *(const ALAS bf16x8*)(Ks + (32 + r32) * KST + cb);
        if (d0 == 0) { p0 = __builtin_amdgcn_mfma_f32_32x32x16_bf16(b0, qr[0], cinit, 0, 0, 0); p1 = __builtin_amdgcn_mfma_f32_32x32x16_bf16(b1, qr[0], cinit, 0, 0, 0); }
        else { p0 = __builtin_amdgcn_mfma_f32_32x32x16_bf16(b0, qr[d0], p0, 0, 0, 0); p1 = __builtin_amdgcn_mfma_f32_32x32x16_bf16(b1, qr[d0], p1, 0, 0, 0); } }
}
__device__ __forceinline__ void na_mask(f32x16& p0, f32x16& p1, const ALAS float* btab, int kr, int rq, int qc_in, int hi_in) {
    int qc = qc_in, hi = hi_in; asm volatile("" : "+v"(qc), "+v"(hi));
    int r0 = rq - 4; r0 = r0 < 0 ? 0 : (r0 > 120 ? 120 : r0);
    const bool rowok = (kr >= r0) && (kr < r0 + 8);
    int c0 = qc - 8; c0 = c0 < 0 ? 0 : (c0 > 48 ? 48 : c0);
    int dr = kr - rq + 7; dr = dr < 0 ? 0 : (dr > 14 ? 14 : dr);
    const ALAS float* brow = btab + dr * 31;
#pragma unroll
    for (int r = 0; r < 16; ++r) {
        const int ka = crow(r, hi), kb = 32 + ka;
        int ia = ka - qc + 15; ia = ia < 0 ? 0 : (ia > 30 ? 30 : ia);
        int ib = kb - qc + 15; ib = ib < 0 ? 0 : (ib > 30 ? 30 : ib);
        const bool oka = rowok && (ka >= c0) && (ka < c0 + 16), okb = rowok && (kb >= c0) && (kb < c0 + 16);
        p0[r] = oka ? p0[r] + brow[ia] : -1e30f;
        p1[r] = okb ? p1[r] + brow[ib] : -1e30f;
    }
}
__device__ __forceinline__ void lazySM(f32x16& p0, f32x16& p1, float& m_reg, bool& moved, float& alpha) {
    float pmax = p0[0];
#pragma unroll
    for (int r = 1; r < 16; ++r) pmax = fmaxf(pmax, p0[r]);
#pragma unroll
    for (int r = 0; r < 16; ++r) pmax = fmaxf(pmax, p1[r]);
    { auto rr = __builtin_amdgcn_permlane32_swap(__float_as_uint(pmax), __float_as_uint(pmax), false, false);
      pmax = fmaxf(__uint_as_float(rr[0]), __uint_as_float(rr[1])); }
    if (__builtin_expect(__all(pmax <= THR2), 1)) { alpha = 1.f; }
    else { const float dl = fmaxf(pmax, 0.f); m_reg += dl; alpha = __builtin_amdgcn_exp2f(-dl);
#pragma unroll
        for (int r = 0; r < 16; ++r) { p0[r] -= dl; p1[r] -= dl; }
        moved = true; }
#pragma unroll
    for (int r = 0; r < 16; ++r) p0[r] = __builtin_amdgcn_exp2f(p0[r]);
}
__device__ __forceinline__ void fixedSM(f32x16& p0) {
#pragma unroll
    for (int r = 0; r < 16; ++r) p0[r] = __builtin_amdgcn_exp2f(p0[r]);
}
__device__ __forceinline__ void finishSM(f32x16& p0, f32x16& p1, bf16x8& pa0, bf16x8& pa1, bf16x8& pa2, bf16x8& pa3) {
#pragma unroll
    for (int r = 0; r < 16; ++r) p1[r] = __builtin_amdgcn_exp2f(p1[r]);
    u32x4 w;
    w = (u32x4){cvtpk(p0[0], p0[1]), cvtpk(p0[2], p0[3]), cvtpk(p0[4], p0[5]), cvtpk(p0[6], p0[7])}; pa0 = __builtin_bit_cast(bf16x8, w);
    w = (u32x4){cvtpk(p0[8], p0[9]), cvtpk(p0[10], p0[11]), cvtpk(p0[12], p0[13]), cvtpk(p0[14], p0[15])}; pa1 = __builtin_bit_cast(bf16x8, w);
    w = (u32x4){cvtpk(p1[0], p1[1]), cvtpk(p1[2], p1[3]), cvtpk(p1[4], p1[5]), cvtpk(p1[6], p1[7])}; pa2 = __builtin_bit_cast(bf16x8, w);
    w = (u32x4){cvtpk(p1[8], p1[9]), cvtpk(p1[10], p1[11]), cvtpk(p1[12], p1[13]), cvtpk(p1[14], p1[15])}; pa3 = __builtin_bit_cast(bf16x8, w);
}
struct NoSide { static constexpr bool PLAIN = true; template <int P> __device__ __forceinline__ void step() {} };
typedef int i32x8 __attribute__((ext_vector_type(8)));
typedef int i32x4 __attribute__((ext_vector_type(4)));
template <int DQK, int MODE, class SIDE = NoSide, bool K8 = false>
__device__ __forceinline__ void attn_unit(const UnitP& u, ALAS unsigned char* lds, const int tid, SIDE& side) {
    static_assert(!K8 || (DQK == 64 && MODE == 0), "fp8 QK^T: GQA fixed-reference form only");
    constexpr int ND = DQK / 16, KST = K8 ? 80 : DQK * 2 + 16, KBUF = 64 * KST;
    constexpr bool PV8 = K8 && (MK_FP8_PV != 0);
    static_assert(KBUF <= KBUF_MAX, "K buffer");
    const int wid = __builtin_amdgcn_readfirstlane(tid >> 6), lane = tid & 63, r32 = lane & 31, hi = lane >> 5;
    ALAS unsigned char* V_lds = lds + OFF_V; ALAS unsigned char* K_lds = lds + OFF_K;
    ALAS float* ws = (ALAS float*)(lds + OFF_WS) + wid * 64; ALAS float* al_l = ws + 32;
    const ALAS float* btab = (const ALAS float*)(lds + OFF_BIAS);
    float m_reg = 0.f; f32x16 o[2], lacc; o[0] = f32x16{}; o[1] = f32x16{}; lacc = f32x16{}; bf16x8 qr[ND];
    bool moved = false;
    const int grow = u.grow0 + (wid >> 1), gcol = (wid & 1) * 32 + r32;
    {
        const bf16_t* Qw = u.Q + (size_t)(wid * QBLK + r32) * u.ldq + hi * 8;
#pragma unroll
        for (int d0 = 0; d0 < ND; ++d0) qr[d0] = *(const bf16x8*)(Qw + d0 * 16);
        if constexpr (MODE == 0 || MODE == 3) {
            float x[4][8]; float ssq = 0.f;
#pragma unroll
            for (int d0 = 0; d0 < 4; ++d0)
#pragma unroll
                for (int j = 0; j < 8; ++j) { x[d0][j] = bf2f(qr[d0][j]); ssq += x[d0][j] * x[d0][j]; }
            { auto rr_ = __builtin_amdgcn_permlane32_swap(__float_as_uint(ssq), __float_as_uint(ssq), false, false); ssq = __uint_as_float(rr_[0]) + __uint_as_float(rr_[1]); }
            const float rstd = 1.0f / sqrtf(ssq * (1.0f / 64.0f) + 1e-6f);
#pragma unroll
            for (int d0 = 0; d0 < 4; ++d0)
#pragma unroll
                for (int j = 0; j < 8; ++j) x[d0][j] = x[d0][j] * rstd * u.gain[16 * d0 + 8 * hi + j];
#pragma unroll
            for (int d0 = 0; d0 < 2; ++d0)
#pragma unroll
                for (int j = 0; j < 8; ++j) { const float inv = exp2f(-(float)(8 * hi + j) * (LOG2_THETA / 16.0f));
                    const float ang = (float)(d0 == 0 ? grow : gcol) * inv * INV2PI; const float c = __builtin_amdgcn_cosf(ang), s = __builtin_amdgcn_sinf(ang);
                    const float y1 = x[d0][j], y2 = x[d0 + 2][j]; x[d0][j] = y1 * c - y2 * s; x[d0 + 2][j] = y1 * s + y2 * c; }
            constexpr float C2 = 0.125f * LOG2E;
#pragma unroll
            for (int d0 = 0; d0 < 4; ++d0) { u32x4 w = {cvtpk(x[d0][0] * C2, x[d0][1] * C2), cvtpk(x[d0][2] * C2, x[d0][3] * C2), cvtpk(x[d0][4] * C2, x[d0][5] * C2), cvtpk(x[d0][6] * C2, x[d0][7] * C2)};
                qr[d0] = __builtin_bit_cast(bf16x8, w); }
        }
        if constexpr (MODE == 1) {
            float y1[8], y2[8];
#pragma unroll
            for (int j = 0; j < 8; ++j) { const float inv = exp2f(-(float)j * (LOG2_THETA / 8.0f));
                const float ang = (float)(hi == 0 ? grow : gcol) * inv * INV2PI; const float c = __builtin_amdgcn_cosf(ang), s = __builtin_amdgcn_sinf(ang);
                const float a = bf2f(qr[4][j]), b = bf2f(qr[5][j]); y1[j] = a * c - b * s; y2[j] = a * s + b * c; }
            u32x4 w = {cvtpk(y1[0], y1[1]), cvtpk(y1[2], y1[3]), cvtpk(y1[4], y1[5]), cvtpk(y1[6], y1[7])}; qr[4] = __builtin_bit_cast(bf16x8, w);
            w = (u32x4){cvtpk(y2[0], y2[1]), cvtpk(y2[2], y2[3]), cvtpk(y2[4], y2[5]), cvtpk(y2[6], y2[7])}; qr[5] = __builtin_bit_cast(bf16x8, w);
        }
    }
    i32x8 qr8 = {0, 0, 0, 0, 0, 0, 0, 0}; int sc8 = 0x7F7F7F7F;
    if constexpr (K8) {
#pragma unroll
        for (int d0 = 0; d0 < 4; ++d0) { float f_[8];
#pragma unroll
            for (int j = 0; j < 8; ++j) f_[j] = bf2f(qr[d0][j]);
            qr8[2 * d0] = (int)pg8::pk4_fp8(f_[0], f_[1], f_[2], f_[3]); qr8[2 * d0 + 1] = (int)pg8::pk4_fp8(f_[4], f_[5], f_[6], f_[7]); }
        asm volatile("" : "+v"(sc8)); }
    const int sk = tid >> 3, sc = tid & 7;
    const unsigned vsoff = (unsigned)(sk * u.ldv + sc * 8) * 2u, ksoff = K8 ? (unsigned)(sk * u.ldk8 + sc * 8) : (unsigned)(sk * u.ldk0 + sc * 8) * 2u;
    const int vst = (sc >> 2) * 4096 + sk * 64 + (sc & 3) * 16, kst = K8 ? sk * KST + sc * 8 : sk * KST + sc * 16;
    const int sk2 = (tid & 255) >> 2, sc2 = tid & 3;
    const unsigned k2soff = (DQK == 96) ? (unsigned)(sk2 * u.ldk1 + sc2 * 8) * 2u : 0u;
    const int k2st = sk2 * KST + (8 + sc2) * 16;
    const ALAS unsigned char* vb0 = V_lds + ((lane >> 4) & 1) * 32 + (lane & 3) * 8 + (4 * hi + ((lane & 15) >> 2)) * 64;
    typedef unsigned long long u64_; struct { bf16x8 v, k, k2; u64_ k8, v8; } sr_[2];
    const unsigned v8soff = (unsigned)(sk * 64 + sc * 8); const int v8st = sk * 80 + sc * 8;
#define ATT_SLOAD(i, k0) do { if constexpr (PV8) sr_[i].v8 = *(const u64_*)((const char*)(u.V8 + (size_t)(k0) * 64) + v8soff); else sr_[i].v = *(const bf16x8*)((const char*)(u.V + (size_t)(k0) * u.ldv) + vsoff); \
        if constexpr (K8) sr_[i].k8 = *(const u64_*)((const char*)(u.K8 + (size_t)(k0) * u.ldk8) + ksoff); else sr_[i].k = *(const bf16x8*)((const char*)(u.K0 + (size_t)(k0) * u.ldk0) + ksoff); \
        if constexpr (DQK == 96) sr_[i].k2 = *(const bf16x8*)((const char*)(u.K1 + (size_t)(k0) * u.ldk1) + k2soff); } while (0)
#define ATT_SWRITE(b, i) do { if constexpr (PV8) *(ALAS u64_*)(V_lds + (b) * VBUF + v8st) = sr_[i].v8; else *(ALAS bf16x8*)(V_lds + (b) * VBUF + vst) = sr_[i].v; \
        if constexpr (K8) *(ALAS u64_*)(K_lds + (b) * KBUF + kst) = sr_[i].k8; else *(ALAS bf16x8*)(K_lds + (b) * KBUF + kst) = sr_[i].k; \
        if constexpr (DQK == 96) *(ALAS bf16x8*)(K_lds + (b) * KBUF + k2st) = sr_[i].k2; } while (0)
#define ATT_SWAIT() do { if constexpr (SIDE::PLAIN) { if constexpr (DQK == 96) asm volatile("s_waitcnt vmcnt(3)" ::: "memory"); else asm volatile("s_waitcnt vmcnt(2)" ::: "memory"); } } while (0)
#define ATT_RESC(a) do { if constexpr (MODE != 0) { if (__any((a) < 1.f)) { if (hi == 0) al_l[r32] = (a); asm volatile("s_waitcnt lgkmcnt(0)" ::: "memory"); \
        _Pragma("unroll") for (int r = 0; r < 16; ++r) { const float f_ = al_l[crow(r, hi)]; o[0][r] *= f_; o[1][r] *= f_; lacc[r] *= f_; } } } } while (0)
#define ATT_SM(P0, P1, AL) do { if constexpr (MODE == 0) { fixedSM(P0); AL = 1.f; } else lazySM(P0, P1, m_reg, moved, AL); } while (0)
#define ATT_QKT8(P0, P1, KS) do { const ALAS unsigned char* kp_ = (KS) + r32 * 80 + hi * 32; \
        const i32x8 ka_ = __builtin_shufflevector(*(const ALAS i32x4*)kp_, *(const ALAS i32x4*)(kp_ + 16), 0, 1, 2, 3, 4, 5, 6, 7); \
        const i32x8 kb_ = __builtin_shufflevector(*(const ALAS i32x4*)(kp_ + 32 * 80), *(const ALAS i32x4*)(kp_ + 32 * 80 + 16), 0, 1, 2, 3, 4, 5, 6, 7); \
        asm volatile("v_mfma_scale_f32_32x32x64_f8f6f4 %0, %1, %2, 0, %3, %3 op_sel_hi:[0,0,0]" : "=&v"(P0) : "v"(ka_), "v"(qr8), "v"(sc8)); \
        asm volatile("v_mfma_scale_f32_32x32x64_f8f6f4 %0, %1, %2, 0, %3, %3 op_sel_hi:[0,0,0]" : "=&v"(P1) : "v"(kb_), "v"(qr8), "v"(sc8)); } while (0)
#define ATT_QKT(P0, P1, KS) do { if constexpr (K8) ATT_QKT8(P0, P1, KS); else if (MODE != 0 && moved) { f32x16 ng_; _Pragma("unroll") for (int r_ = 0; r_ < 16; ++r_) ng_[r_] = -m_reg; qkt<DQK>(P0, P1, KS, qr, ng_, r32, hi); } \
        else { const f32x16 z_ = f32x16{}; qkt<DQK>(P0, P1, KS, qr, z_, r32, hi); } } while (0)
#define ATT_PV8(BUF) do { const ALAS unsigned char* vp_ = V_lds + (BUF) * VBUF + r32 * 80 + hi * 32; \
        const i32x8 va_ = __builtin_shufflevector(*(const ALAS i32x4*)vp_, *(const ALAS i32x4*)(vp_ + 16), 0, 1, 2, 3, 4, 5, 6, 7); \
        const i32x8 vb_ = __builtin_shufflevector(*(const ALAS i32x4*)(vp_ + 32 * 80), *(const ALAS i32x4*)(vp_ + 32 * 80 + 16), 0, 1, 2, 3, 4, 5, 6, 7); \
        asm volatile("v_mfma_scale_f32_32x32x64_f8f6f4 %0, %1, %2, %0, %3, %3 op_sel_hi:[0,0,0] cbsz:1 blgp:1" : "+v"(o[0]) : "v"(p8), "v"(va_), "v"(sc8)); \
        asm volatile("v_mfma_scale_f32_32x32x64_f8f6f4 %0, %1, %2, %0, %3, %3 op_sel_hi:[0,0,0] cbsz:1 blgp:1" : "+v"(o[1]) : "v"(p8), "v"(vb_), "v"(sc8)); \
        asm volatile("v_mfma_scale_f32_32x32x64_f8f6f4 %0, %1, %2, %0, %3, %3 op_sel_hi:[0,0,0] cbsz:1 blgp:1" : "+v"(lacc) : "v"(p8), "v"(ones8), "v"(sc8)); } while (0)
#define ATT_PV(VB) do { if constexpr (PV8) ATT_PV8(((VB) == vb0) ? 0 : 1); else pv_all(o[0], o[1], lacc, (VB), pa0, pa1, pa2, pa3); } while (0)
#define ATT_FIN(P0, P1) do { if constexpr (PV8) { _Pragma("unroll") for (int r_ = 0; r_ < 16; ++r_) P1[r_] = __builtin_amdgcn_exp2f(P1[r_]); \
        _Pragma("unroll") for (int g_ = 0; g_ < 4; ++g_) { int w_ = __builtin_amdgcn_cvt_pk_bf8_f32(P0[4 * g_], P0[4 * g_ + 1], 0, false); p8[g_] = __builtin_amdgcn_cvt_pk_bf8_f32(P0[4 * g_ + 2], P0[4 * g_ + 3], w_, true); \
            w_ = __builtin_amdgcn_cvt_pk_bf8_f32(P1[4 * g_], P1[4 * g_ + 1], 0, false); p8[4 + g_] = __builtin_amdgcn_cvt_pk_bf8_f32(P1[4 * g_ + 2], P1[4 * g_ + 3], w_, true); } } \
        else finishSM(P0, P1, pa0, pa1, pa2, pa3); } while (0)
#define ATT_MASK(P0, P1, j) do { if constexpr (MODE == 2) na_mask(P0, P1, btab, u.kr0 + (j), grow, gcol, hi); } while (0)
    f32x16 pA0, pA1, pB0, pB1; float alA, alB; bf16x8 pa0, pa1, pa2, pa3; const int NT = u.nt;
    i32x8 p8 = {0, 0, 0, 0, 0, 0, 0, 0}; i32x8 ones8 = {0x3C3C3C3C, 0x3C3C3C3C, 0x3C3C3C3C, 0x3C3C3C3C, 0x3C3C3C3C, 0x3C3C3C3C, 0x3C3C3C3C, 0x3C3C3C3C};
    if constexpr (PV8) { int o1_ = 0x3C3C3C3C; asm volatile("" : "+v"(o1_)); ones8 = (i32x8){o1_, o1_, o1_, o1_, o1_, o1_, o1_, o1_}; asm volatile("" : "+v"(ones8)); }
    constexpr int SE = 0, SO = 1;
    ATT_SLOAD(SE, 0); asm volatile("s_waitcnt vmcnt(0)" ::: "memory"); ATT_SWRITE(0, SE); __syncthreads();
    ATT_QKT(pA0, pA1, K_lds); if constexpr (K8) asm volatile("s_nop 15\n\ts_nop 15\n\ts_nop 15\n\ts_nop 15\n\ts_nop 15\n\ts_nop 15\n\ts_nop 15\n\ts_nop 15\n\ts_nop 15\n\ts_nop 15" : "+v"(pA0), "+v"(pA1) :: "memory");
    ATT_MASK(pA0, pA1, 0); ATT_SM(pA0, pA1, alA);
    ATT_SLOAD(SO, KVBLK); if (2 < NT) ATT_SLOAD(SE, 2 * KVBLK);
    ATT_SWAIT(); ATT_SWRITE(1, SO); __syncthreads();
    if (wid >= 4) __builtin_amdgcn_s_setprio(1);
    for (int j = 1; j + 1 < NT; j += 2) {
        if constexpr (!SIDE::PLAIN) { if ((j & 15) < 4) side.template step<0>(); }
        ASBAR(); ATT_QKT(pB0, pB1, K_lds + KBUF); ATT_MASK(pB0, pB1, j);
        ATT_FIN(pA0, pA1); ASBAR();
        ATT_SLOAD(SO, (j + 2) * KVBLK); ASBAR();
        ATT_PV(vb0); if constexpr (K8) ASBAR();
        ATT_SM(pB0, pB1, alB);
        __syncthreads(); ATT_SWAIT(); ATT_SWRITE(0, SE);
        ATT_RESC(alB); __syncthreads();
        if constexpr (!SIDE::PLAIN) { if ((j & 15) < 4) side.template step<1>(); }
        ASBAR(); ATT_QKT(pA0, pA1, K_lds); ATT_MASK(pA0, pA1, j + 1);
        ATT_FIN(pB0, pB1); ASBAR();
        if (j + 3 < NT) ATT_SLOAD(SE, (j + 3) * KVBLK); ASBAR();
        ATT_PV(vb0 + VBUF); if constexpr (K8) ASBAR();
        ATT_SM(pA0, pA1, alA);
        __syncthreads(); ATT_SWAIT(); ATT_SWRITE(1, SO);
        ATT_RESC(alA); __syncthreads();
    }
    ASBAR(); ATT_QKT(pB0, pB1, K_lds + KBUF); ATT_MASK(pB0, pB1, NT - 1);
    ATT_FIN(pA0, pA1); ASBAR();
    ATT_PV(vb0); if constexpr (K8) ASBAR();
    ATT_SM(pB0, pB1, alB);
    __syncthreads(); ATT_RESC(alB);
    ATT_FIN(pB0, pB1); ASBAR();
    ATT_PV(vb0 + VBUF);
    __builtin_amdgcn_s_setprio(0);
    if constexpr (PV8) asm volatile("s_nop 15\n\ts_nop 15\n\ts_nop 15\n\ts_nop 15\n\ts_nop 15\n\ts_nop 15\n\ts_nop 15\n\ts_nop 15\n\ts_nop 15\n\ts_nop 15\n\ts_nop 15\n\ts_nop 15\n\ts_nop 15\n\ts_nop 15" : "+v"(o[0]), "+v"(o[1]), "+v"(lacc) :: "memory");
    bf16_t* Ow = u.O + (size_t)(wid * QBLK) * u.ldo;
#pragma unroll
    for (int r = 0; r < 16; ++r) { const int orow = crow(r, hi); const float rl = __builtin_amdgcn_rcpf(lacc[r]);
#pragma unroll
        for (int d0 = 0; d0 < 2; ++d0) Ow[(size_t)orow * u.ldo + d0 * 32 + r32] = (bf16_t)f2bf_s(o[d0][r] * rl); }
    __syncthreads();
#undef ATT_SLOAD
#undef ATT_SWRITE
#undef ATT_SWAIT
#undef ATT_RESC
#undef ATT_SM
#undef ATT_QKT
#undef ATT_QKT8
#undef ATT_PV8
#undef ATT_FIN
#undef ATT_PV
#undef ATT_MASK
}
}


constexpr int NWAVES = 8;
#ifndef MK_DEBUG
#define MK_DEBUG 0
#endif
#ifndef MK_DBG_IGNORE
#define MK_DBG_IGNORE 0
#endif
#ifndef MK_ONE_LAUNCH
#define MK_ONE_LAUNCH 0
#endif
#ifndef REP_P
#define REP_P 1
#endif
#ifndef REP_A
#define REP_A 1
#endif
#ifndef REP_B
#define REP_B 1
#endif
#ifndef REP_C
#define REP_C 1
#endif
#ifndef REP_DG
#define REP_DG 1
#endif
#ifndef REP_DM
#define REP_DM 1
#endif
#ifndef REP_DN
#define REP_DN 1
#endif
#ifndef REP_E
#define REP_E 1
#endif
#ifndef REP_F
#define REP_F 1
#endif
#ifndef REP_H
#define REP_H 1
#endif
#ifndef REP_I
#define REP_I 1
#endif
#ifndef REP_J
#define REP_J 1
#endif
#ifndef REP_K
#define REP_K 1
#endif
#ifndef MK_FP8_LAST
#define MK_FP8_LAST 1
#endif
#ifndef MK_FP8_MOE_ALL
#define MK_FP8_MOE_ALL 1
#endif
#define F8MOE(l) (MK_FP8_LAST && ((l) == DEPTH - 1 || MK_FP8_MOE_ALL))
#ifndef MK_FP8_IN_ALL
#define MK_FP8_IN_ALL 1
#endif
#define F8IN(l) (MK_FP8_LAST && ((l) == DEPTH - 1 || MK_FP8_IN_ALL))
#ifndef MK_FP8_QK
#define MK_FP8_QK 1
#endif
#ifndef MK_FP8_PV
#define MK_FP8_PV 1
#endif
#ifndef MK_FP8_OUT
#define MK_FP8_OUT 1
#endif
constexpr int NB = 4, SEQ = 8192, T = NB * SEQ, D = 1024, DEPTH = 2, GW = 64;
constexpr int DIN = 5536, DINP = 5632;
constexpr int H_NAQ = 0, H_NAK = 384, H_NAV = 768, H_GQ = 1152, H_GK = 1536, H_GV = 1664, H_CQ = 1792, H_CKV = 2176, H_KR = 2432, H_GATE = 2464;
constexpr int NE = 32, TOPK = 4, FF = 1024, TK = T * TOPK;
constexpr int PSLOTS = TK + NE * 256;
constexpr int MAXTILES = PSLOTS / 256;
constexpr int LCAP = T;
constexpr float LN_EPS = 1e-5f, RMS_EPS = 1e-6f, DN_ALPHA = 1.4142135623730951f;
constexpr float LOG2E_F = 1.4426950408889634f;
constexpr int PPL = 10, NPH = 1 + DEPTH * PPL;

constexpr size_t MiB = 1u << 20;
constexpr size_t WS_CTL = 0, CTL_ZERO_BYTES = 1 * MiB;
constexpr size_t WB_IN = 0, WB_UQ = WB_IN + (size_t)DINP * 1024 * 2, WB_UKV = WB_UQ + (size_t)512 * 384 * 2, WB_BA = WB_UKV + (size_t)512 * 256 * 2,
                 WB_BB = WB_BA + (size_t)1024 * 384 * 2, WB_BC = WB_BB + (size_t)1024 * 384 * 2, WB_OUT = WB_BC + (size_t)1024 * 384 * 2,
                 WB_GU = WB_OUT + (size_t)1024 * 1024 * 2, WB_DN = WB_GU + (size_t)NE * 2048 * 1024 * 2, WB_LAYER = WB_DN + (size_t)NE * 1024 * 1024 * 2;
static_assert(WB_LAYER % 256 == 0, "weight block alignment");
constexpr size_t WS_W = 2 * MiB;
constexpr size_t WS_H = WS_W + 2 * WB_LAYER;
constexpr size_t SZ_H = (size_t)T * DINP * 2;
constexpr size_t WS_A2 = WS_H + SZ_H;
constexpr size_t A2_MIX = 0, A2_MIXED = A2_MIX + (size_t)T * 1024 * 4, A2_YA = A2_MIXED + (size_t)T * 1024 * 2, A2_YB = A2_YA + (size_t)T * 384 * 2,
                 A2_YC = A2_YB + (size_t)T * 384 * 2, A2_QC = A2_YC + (size_t)T * 384 * 2, A2_KVC = A2_QC + (size_t)T * 384 * 2, A2_KB = A2_KVC + (size_t)T * 512 * 2,
                 A2_CQN = A2_KB + (size_t)T * 128 * 2, A2_CKVN = A2_CQN + (size_t)T * 384 * 2, A2_KR = A2_CKVN + (size_t)T * 256 * 2, A2_K8 = A2_KR + (size_t)T * 32 * 2, A2_VT8 = A2_K8 + (size_t)T * 128, SZ_A2 = A2_VT8 + (size_t)T * 128;
static_assert(SZ_A2 >= (size_t)PSLOTS * 1024 * 2 && SZ_H >= (size_t)PSLOTS * 1024 * 2, "overlays fit");
constexpr size_t WS_X2 = WS_A2 + SZ_A2;
constexpr size_t WS_XB = WS_X2 + (size_t)T * D * 4;
constexpr size_t WS_X1 = WS_XB + (size_t)T * D * 2;
constexpr size_t WS_X1B = WS_X1 + (size_t)T * D * 4;
constexpr size_t WS_LT = WS_X1B + (size_t)T * D * 2;
constexpr size_t WS_LG = WS_LT + (size_t)NE * LCAP * 4;
constexpr size_t WS_TE = WS_LG + (size_t)NE * LCAP * 4;
constexpr size_t WS_TR = WS_TE + (size_t)T * 4 * 4;
constexpr size_t WS_SG = WS_TR + (size_t)T * 4 * 4;
constexpr size_t WS_END = WS_SG + (size_t)PSLOTS * 4;
constexpr int CW_BAR = 4096;
constexpr int CW_CNT = 16384;

constexpr int RING_BYTES = 131072, LDSCTL_OFF = 139264, MISC_OFF = LDSCTL_OFF + 64;
constexpr int TBL_OFF = LDSCTL_OFF + 256;
constexpr int TBL_START = TBL_OFF, TBL_TILEE = TBL_OFF + 512, TBL_RS = TBL_TILEE + 2304;
constexpr int LDS_BYTES = 155648;
static_assert(TBL_RS + 512 * 12 + 256 <= LDS_BYTES, "LDS map");

#define GAS __attribute__((address_space(1)))
#define LAS __attribute__((address_space(3)))
typedef unsigned short bf16;
typedef unsigned v4u __attribute__((ext_vector_type(4)));
typedef float f32x4 __attribute__((ext_vector_type(4)));
typedef GAS unsigned gu32;
#define RLX_AGENT __ATOMIC_RELAXED, __HIP_MEMORY_SCOPE_AGENT
#define LDS_WAIT() asm volatile("s_waitcnt lgkmcnt(0)" ::: "memory")
#define VM_WAIT() asm volatile("s_waitcnt vmcnt(0)" ::: "memory")
__device__ __forceinline__ unsigned f2bf(float f) { unsigned u = __builtin_bit_cast(unsigned, f); return (u + 0x7fffu + ((u >> 16) & 1u)) >> 16; }
__device__ __forceinline__ unsigned pk2(float lo, float hi) { unsigned r; asm("v_cvt_pk_bf16_f32 %0, %1, %2" : "=v"(r) : "v"(lo), "v"(hi)); return r; }
__device__ __forceinline__ float bflo(unsigned w) { return __uint_as_float(w << 16); }
__device__ __forceinline__ float bfhi(unsigned w) { return __uint_as_float(w & 0xffff0000u); }

template <int O> __device__ __forceinline__ float shx(float v, int lane) { return __int_as_float(__builtin_amdgcn_ds_bpermute((lane ^ O) << 2, __float_as_int(v))); }
template <int O> __device__ __forceinline__ int shxi(int v, int lane) { return __builtin_amdgcn_ds_bpermute((lane ^ O) << 2, v); }

#define XB_TMO      128
#define XB_XCNT(j)  (256  + 64 * (j))
#define XB_XSUB(j)  (1280 + 64 * (j))
#define XB_XGEN(j)  (2304 + 64 * (j))
#define XB_TOP      3328
#define XB_TOPGEN   3392
#define XCD_BAR_WORDS 3456
#define XB_SPIN_CAP (1u << 18)

__device__ __forceinline__ unsigned xb_ld(unsigned* p)              { return __hip_atomic_load(p, __ATOMIC_RELAXED, __HIP_MEMORY_SCOPE_AGENT); }
__device__ __forceinline__ unsigned xb_add(unsigned* p, unsigned v) { return __hip_atomic_fetch_add(p, v, __ATOMIC_RELAXED, __HIP_MEMORY_SCOPE_AGENT); }
__device__ __forceinline__ unsigned xb_xcc_id() { return (unsigned)__builtin_amdgcn_s_getreg((3 << 11) | 20) & 0xFu; }
#define XB_SPIN(cond, bar) do { unsigned _sp = 0; while (cond) { __builtin_amdgcn_s_sleep(1); \
    if ((++_sp & 255u) == 0u) { if (xb_ld(&(bar)[XB_TMO])) break; if (_sp > XB_SPIN_CAP) { atomicAdd(&(bar)[XB_TMO], 1u); break; } } } } while (0)

struct XcdBarrier {
    unsigned* bar; unsigned x;
    volatile LAS unsigned* st;
};

__device__ __forceinline__ XcdBarrier xcd_barrier_post(unsigned* bar, volatile LAS unsigned* st) {
    XcdBarrier b; b.bar = bar; b.x = xb_xcc_id(); b.st = st;
    if (threadIdx.x == 0) (void)xb_add(&bar[XB_XCNT(b.x)], 1u);
    return b;
}
__device__ __forceinline__ void xcd_barrier_complete(unsigned* bar, unsigned x, unsigned& nloc, unsigned& nx) {
    const unsigned G = gridDim.x * gridDim.y * gridDim.z;
    unsigned sum, cnt, mine, sp = 0u;
    for (;;) {
        sum = 0u; cnt = 0u; mine = 0u;
#pragma unroll
        for (unsigned j = 0; j < 16; ++j) { const unsigned c = xb_ld(&bar[XB_XCNT(j)]); sum += c; cnt += (c > 0u) ? 1u : 0u; mine = (j == x) ? c : mine; }
        if (sum == G) break;
        __builtin_amdgcn_s_sleep(1);
        if ((++sp & 255u) == 0u) { if (xb_ld(&bar[XB_TMO])) break; if (sp > XB_SPIN_CAP) { atomicAdd(&bar[XB_TMO], 1u); break; } }
    }
    nloc = mine > 0u ? mine : 1u; nx = cnt > 0u ? cnt : 1u;
}

__device__ __forceinline__ void xcd_barrier(const XcdBarrier& b) {
    asm volatile("s_waitcnt vmcnt(0)" ::: "memory");
    __syncthreads();
    if (threadIdx.x == 0) {
        unsigned* bar = b.bar;
        __builtin_amdgcn_s_waitcnt(0);
        unsigned nloc = b.st[0], nx = b.st[1];
        if (nloc == 0u) { xcd_barrier_complete(bar, b.x, nloc, nx); b.st[0] = nloc; b.st[1] = nx; }
        const unsigned old = xb_add(&bar[XB_XSUB(b.x)], 1u);
        const unsigned gen = old / nloc;
        if (old + 1u == (gen + 1u) * nloc) {
            __builtin_amdgcn_fence(__ATOMIC_RELEASE, "agent");
            asm volatile("s_waitcnt vmcnt(0)" ::: "memory");
            const unsigned og = xb_add(&bar[XB_TOP], 1u);
            const unsigned tg = og / nx;
            if (og + 1u == (tg + 1u) * nx) xb_add(&bar[XB_TOPGEN], 1u);
            else XB_SPIN(xb_ld(&bar[XB_TOPGEN]) == tg, bar);
            __builtin_amdgcn_fence(__ATOMIC_ACQUIRE, "agent");
            xb_add(&bar[XB_XGEN(b.x)], 1u);
            asm volatile("s_waitcnt vmcnt(0)" ::: "memory");
        } else {
            XB_SPIN(xb_ld(&bar[XB_XGEN(b.x)]) == gen, bar);
            __builtin_amdgcn_fence(__ATOMIC_ACQUIRE, "agent");
            asm volatile("s_waitcnt vmcnt(0)" ::: "memory");
        }
    }
    __syncthreads();
}


struct Frame {
    LAS unsigned char* lds;
    gu32* ctl;
    int tid, lane, wave;
    int vcu, G, bx;
    unsigned char* ws;
    float* out;
};
__device__ __forceinline__ const float* in_ptr(int i) {
    const void* base = (const void*)__builtin_amdgcn_kernarg_segment_ptr(); const GAS float* p;
    asm volatile("s_load_dwordx2 %0, %1, %2\n\ts_waitcnt lgkmcnt(0)" : "=s"(p) : "s"(base), "i"(i * 8) : "memory"); return (const float*)p;
}
#define INP(i) in_ptr(i)
template <int SITE> __device__ __forceinline__ Frame mkframe(LAS unsigned char* lds_in, unsigned char* ws_in, float* out_in, int wave_id, int bx0, int G0) {
    Frame F; int lane_;
    asm volatile("v_mbcnt_lo_u32_b32 %0, -1, 0\n\tv_mbcnt_hi_u32_b32 %0, -1, %0 ; site %1" : "=v"(lane_) : "n"(SITE));
    int bx = bx0, G = G0, wv = wave_id; asm volatile("; site %3" : "+s"(bx), "+s"(G), "+s"(wv) : "n"(SITE));
    GAS unsigned char* wsg = (GAS unsigned char*)ws_in; asm volatile("; site %1" : "+s"(wsg) : "n"(SITE)); unsigned char* ws = (unsigned char*)wsg;
    LAS unsigned char* l3 = lds_in; asm volatile("; site %1" : "+s"(l3) : "n"(SITE));
    const int tid = wv * 64 + lane_;
    F.lds = l3; F.tid = tid; F.lane = lane_; F.wave = wv;
    F.G = G; F.bx = bx; F.vcu = (G % 8 == 0) ? (bx % 8) * (G / 8) + bx / 8 : bx;
    F.ws = ws; F.ctl = (gu32*)(wsg + WS_CTL); F.out = out_in; return F;
}
__device__ __forceinline__ float wave_sum(float v, int lane) {
    v += shx<1>(v, lane); v += shx<2>(v, lane); v += shx<4>(v, lane); v += shx<8>(v, lane); v += shx<16>(v, lane); v += shx<32>(v, lane);
    return v;
}
template <bool F8> __device__ __forceinline__ void tr_item(const float* W, int ldw, int Kd, int k0, int src_n0, bf16* WT, int dst_n0, float scale, LAS float* scr, int lane) {
    float v[32];
#pragma unroll
    for (int i = 0; i < 32; ++i) v[i] = W[(size_t)(k0 + 2 * i + (lane >> 5)) * ldw + src_n0 + (lane & 31)];
#pragma unroll
    for (int i = 0; i < 32; ++i) scr[(2 * i + (lane >> 5)) * 33 + (lane & 31)] = v[i];
    LDS_WAIT(); asm volatile("" ::: "memory");
    const int c = lane & 7;
#pragma unroll
    for (int j = 0; j < 4; ++j) { const int n = (lane >> 3) + 8 * j; const LAS float* s = scr + (8 * c) * 33 + n;
        if constexpr (F8) { typedef unsigned u32x2 __attribute__((ext_vector_type(2)));
            *(GAS u32x2*)((unsigned char*)WT + (size_t)(dst_n0 + n) * Kd + k0 + 8 * c) = (u32x2){pg8::pk4_fp8(s[0 * 33] * scale, s[1 * 33] * scale, s[2 * 33] * scale, s[3 * 33] * scale), pg8::pk4_fp8(s[4 * 33] * scale, s[5 * 33] * scale, s[6 * 33] * scale, s[7 * 33] * scale)}; }
        else { v4u o; o.x = pk2(s[0 * 33] * scale, s[1 * 33] * scale); o.y = pk2(s[2 * 33] * scale, s[3 * 33] * scale); o.z = pk2(s[4 * 33] * scale, s[5 * 33] * scale); o.w = pk2(s[6 * 33] * scale, s[7 * 33] * scale);
            *(GAS v4u*)(WT + (size_t)(dst_n0 + n) * Kd + k0 + 8 * c) = o; } }
    LDS_WAIT(); asm volatile("" ::: "memory");
}
template <int KIND, bool F8 = false> __device__ __forceinline__ void conv_matrix(Frame& F, const float* W, int K, int N, bf16* WT, float s, int gw, int NGW, LAS float* scr, int Kd = 0) {
    if (Kd == 0) Kd = K;
    const int nnb = N / 32, nkb = K / 64, nit = nnb * nkb;
    for (int it = gw; it < nit; it += NGW) {
        const int kb = it / nnb, nb = it % nnb; const int dst_n0 = 32 * nb; int src_n0 = dst_n0; float sc = s;
        if (KIND == 1) sc = (dst_n0 < 384) ? s : 1.0f;
        if (F8) sc *= 32.0f;
        if (KIND == 2) { const int p = dst_n0 >> 8, j = dst_n0 & 255; src_n0 = (j < 128) ? (128 * p + j) : (1024 + 128 * p + (j - 128)); }
        tr_item<F8>(W, N, Kd, 64 * kb, src_n0, WT, dst_n0, sc, scr, F.lane);
    }
}
__device__ __forceinline__ void zero_rows(bf16* WT, int K, int n_lo, int n_hi, int gtid, int nthr) {
    const size_t n16 = (size_t)(n_hi - n_lo) * K / 8; GAS v4u* p = (GAS v4u*)(WT + (size_t)n_lo * K);
    for (size_t i = gtid; i < n16; i += nthr) p[i] = (v4u){0u, 0u, 0u, 0u};
}
__device__ __forceinline__ void p_prologue(Frame& F) {
    LAS float* scr = (LAS float*)(F.lds + F.wave * 16384);
    const int gw0 = F.vcu * NWAVES + F.wave, NGW = F.G * NWAVES, gtid = F.bx * (NWAVES * 64) + F.tid, nthr = F.G * NWAVES * 64;
    for (int l = 0; l < DEPTH; ++l) {
        unsigned char* wb = F.ws + WS_W + (size_t)l * WB_LAYER;
        int gw = gw0;
#define ROT(n) do { gw = (gw + NGW - ((n) % NGW)) % NGW; } while (0)
        if (F8IN(l)) { conv_matrix<1, true>(F, INP(1) + (size_t)l * 1024 * DIN, 1024, DIN, (bf16*)(wb + WB_IN), 0.125f * LOG2E_F, gw, NGW, scr); zero_rows((bf16*)(wb + WB_IN), 512, DIN, DINP, gtid, nthr); }
        else { conv_matrix<1>(F, INP(1) + (size_t)l * 1024 * DIN, 1024, DIN, (bf16*)(wb + WB_IN), 0.125f * LOG2E_F, gw, NGW, scr); zero_rows((bf16*)(wb + WB_IN), 1024, DIN, DINP, gtid, nthr); }
        ROT(16 * 173);
        conv_matrix<0>(F, INP(7) + (size_t)l * 384 * 384, 384, 384, (bf16*)(wb + WB_UQ), 0.10206207261596577f * LOG2E_F, gw, NGW, scr); ROT(72);
        zero_rows((bf16*)(wb + WB_UQ), 384, 384, 512, gtid, nthr);
        conv_matrix<0>(F, INP(8) + (size_t)l * 256 * 512, 256, 512, (bf16*)(wb + WB_UKV), 1.0f, gw, NGW, scr); ROT(64);
        conv_matrix<0>(F, INP(9) + (size_t)l * 384 * 1024, 384, 1024, (bf16*)(wb + WB_BA), 1.0f, gw, NGW, scr); ROT(192);
        conv_matrix<0>(F, INP(10) + (size_t)l * 384 * 1024, 384, 1024, (bf16*)(wb + WB_BB), 1.0f, gw, NGW, scr); ROT(192);
        conv_matrix<0>(F, INP(11) + (size_t)l * 256 * 1024, 256, 1024, (bf16*)(wb + WB_BC), 1.0f, gw, NGW, scr, 384); ROT(64);
        for (int i = gtid; i < 1024 * 16; i += nthr) *((GAS v4u*)(wb + WB_BC) + (size_t)(i >> 4) * 48 + 32 + (i & 15)) = (v4u){0u, 0u, 0u, 0u};
        if (MK_FP8_OUT) conv_matrix<3, true>(F, INP(12) + (size_t)l * 1024 * 1024, 1024, 1024, (bf16*)(wb + WB_OUT), 2.0f, gw, NGW, scr); else conv_matrix<0>(F, INP(12) + (size_t)l * 1024 * 1024, 1024, 1024, (bf16*)(wb + WB_OUT), 1.0f, gw, NGW, scr);
        ROT(512);
#undef ROT
    }
    { const GAS f32x4* xs = (const GAS f32x4*)INP(0); GAS v4u* xd = (GAS v4u*)(F.ws + WS_XB);
      typedef unsigned u32x2 __attribute__((ext_vector_type(2))); GAS u32x2* x8 = (GAS u32x2*)(F.ws + WS_X2);
      for (size_t i = gtid; i < (size_t)T * D / 8; i += nthr) { const f32x4 a = xs[2 * i], b = xs[2 * i + 1]; xd[i] = (v4u){pk2(a.x, a.y), pk2(a.z, a.w), pk2(b.x, b.y), pk2(b.z, b.w)};
          if (F8IN(0)) x8[i] = (u32x2){pg8::pk4_fp8(a.x * 16.f, a.y * 16.f, a.z * 16.f, a.w * 16.f), pg8::pk4_fp8(b.x * 16.f, b.y * 16.f, b.z * 16.f, b.w * 16.f)}; } }
}

constexpr int CONV_ITEMS = NE * 1024 + NE * 512, CONV_LDS_OFF = 49152, CONV_LDS_WAVE = 2 * 16 * 33 * 4;
struct MoeConv {
    static constexpr bool PLAIN = false;
    const float* Wgu; const float* Wdn; unsigned char* Tgu; unsigned char* Tdn; bool f8;
    LAS float* scr; int lane; int gw, ngw, nmini; int s;
    float cvA[8], cvB[8];
    struct Mini { const float* W; unsigned char* WT; int ldw, k0, src_n0, dst_n0; float sc; };
    __device__ __forceinline__ Mini decode(int m) const {
        m = m < 0 ? 0 : (m >= nmini ? nmini - 1 : m);
        const int g = gw + (m >> 2) * ngw, q = m & 3; const bool gu = g < NE * 1024; const int h = gu ? g : g - NE * 1024;
        const int e = gu ? (h >> 10) : (h >> 9), r = gu ? (h & 1023) : (h & 511), kb = gu ? (r >> 6) : (r >> 5), nb = gu ? (r & 63) : (r & 31);
        Mini x; x.dst_n0 = 32 * nb; const int p = x.dst_n0 >> 8, j = x.dst_n0 & 255;
        x.src_n0 = gu ? ((j < 128) ? (128 * p + j) : (1024 + 128 * p + (j - 128))) : x.dst_n0; x.k0 = 64 * kb + 16 * q; x.ldw = gu ? 2048 : 1024;
        x.W = gu ? Wgu + (size_t)e * 1024 * 2048 : Wdn + (size_t)e * 1024 * 1024; const size_t es = f8 ? 1 : 2; x.WT = gu ? Tgu + (size_t)e * 2048 * 1024 * es : Tdn + (size_t)e * 1024 * 1024 * es; x.sc = gu ? 64.0f : 128.0f; return x;
    }
    __device__ __forceinline__ bool done() const { return s >= nmini + 3; }
    template <int P> __device__ __forceinline__ void step() {
        {   const Mini x = decode(s - 3); const LAS float* b = scr + (1 - P) * (16 * 33); const int n = lane >> 1, kh = lane & 1; const LAS float* p = b + (8 * kh) * 33 + n;
            const float q0 = p[0 * 33], q1 = p[1 * 33], q2 = p[2 * 33], q3 = p[3 * 33], q4 = p[4 * 33], q5 = p[5 * 33], q6 = p[6 * 33], q7 = p[7 * 33];
            const size_t eo = (size_t)(x.dst_n0 + n) * 1024 + x.k0 + 8 * kh;
            if (f8) { typedef unsigned u32x2 __attribute__((ext_vector_type(2)));
                *(GAS u32x2*)(x.WT + eo) = (u32x2){pg8::pk4_fp8(q0 * x.sc, q1 * x.sc, q2 * x.sc, q3 * x.sc), pg8::pk4_fp8(q4 * x.sc, q5 * x.sc, q6 * x.sc, q7 * x.sc)}; }
            else { v4u o; o.x = pk2(q0, q1); o.y = pk2(q2, q3); o.z = pk2(q4, q5); o.w = pk2(q6, q7); *(GAS v4u*)(x.WT + eo * 2) = o; } }
        {   LAS float* b = scr + P * (16 * 33);
#pragma unroll
            for (int jj = 0; jj < 8; ++jj) b[(2 * jj + (lane >> 5)) * 33 + (lane & 31)] = P ? cvB[jj] : cvA[jj]; }
        {   const Mini x = decode(s); const GAS float* src = (const GAS float*)x.W + (size_t)(x.k0 + (lane >> 5)) * x.ldw + x.src_n0 + (lane & 31);
#pragma unroll
            for (int jj = 0; jj < 8; ++jj) { const float v = src[(size_t)(2 * jj) * x.ldw]; if (P) cvB[jj] = v; else cvA[jj] = v; } }
        ++s;
    }
};
__device__ __forceinline__ void p_prep(Frame& F, int l) {
    const bf16* hb = (const bf16*)(F.ws + WS_H); unsigned char* a2 = F.ws + WS_A2;
    unsigned char* k8 = a2 + A2_K8; unsigned char* vt8 = a2 + A2_VT8; bf16* kB = (bf16*)(a2 + A2_KB); bf16* cqn = (bf16*)(a2 + A2_CQN); bf16* ckvn = (bf16*)(a2 + A2_CKVN); bf16* kr = (bf16*)(a2 + A2_KR);
    const float* gk = INP(4) + l * 64; const float* gq = INP(5) + l * 384; const float* gkv = INP(6) + l * 256;
    const int lane = F.lane, gw = F.vcu * NWAVES + F.wave, NGW = F.G * NWAVES;
    v4u nk = {0u, 0u, 0u, 0u}, nq = nk, nkv = nk, nr = nk;
    if (gw < T) { const bf16* h0 = hb + (size_t)gw * DINP; if (lane < 16) nk = *(const GAS v4u*)(h0 + H_GK + lane * 8); if (lane < 48) nq = *(const GAS v4u*)(h0 + H_CQ + lane * 8);
        if (lane < 32) nkv = *(const GAS v4u*)(h0 + H_CKV + lane * 8); if (lane < 4) nr = *(const GAS v4u*)(h0 + H_KR + lane * 8); }
    for (int t = gw; t < T; t += NGW) {
        const v4u wk_ = nk, wq_ = nq, wkv_ = nkv, wr_ = nr;
        if (t + NGW < T) { const bf16* h1 = hb + (size_t)(t + NGW) * DINP; if (lane < 16) nk = *(const GAS v4u*)(h1 + H_GK + lane * 8); if (lane < 48) nq = *(const GAS v4u*)(h1 + H_CQ + lane * 8);
            if (lane < 32) nkv = *(const GAS v4u*)(h1 + H_CKV + lane * 8); if (lane < 4) nr = *(const GAS v4u*)(h1 + H_KR + lane * 8); }
        const int s = t & (SEQ - 1); const float prow = (float)(s >> 6), pcol = (float)(s & 63);
        if (MK_FP8_QK) {
            const int kk = s & 63, k5 = kk & 31, hh = (k5 >> 2) & 1, ii = (kk >> 5) * 16 + (k5 & 3) + 4 * (k5 >> 3), pos = 32 * hh + ii, bb = t / SEQ;
            const bf16* vrow = hb + (size_t)t * DINP + H_GV;
#pragma unroll
            for (int kvh = 0; kvh < 2; ++kvh) { const float vv = bflo((unsigned)vrow[kvh * 64 + lane]);
                vt8[(((size_t)(bb * 2 + kvh) * (SEQ / 64) + (s >> 6)) * 64 + lane) * 64 + pos] = (unsigned char)((unsigned)__builtin_amdgcn_cvt_pk_bf8_f32(vv, 0.f, 0, false) & 0xffu); } }
        {   float x[8]; float ssq = 0.f; const int cc = lane & 7;
            if (lane < 16) { const v4u w = wk_; x[0] = bflo(w.x); x[1] = bfhi(w.x); x[2] = bflo(w.y); x[3] = bfhi(w.y); x[4] = bflo(w.z); x[5] = bfhi(w.z); x[6] = bflo(w.w); x[7] = bfhi(w.w); }
            else {
#pragma unroll
                for (int j = 0; j < 8; ++j) x[j] = 0.f; }
#pragma unroll
            for (int j = 0; j < 8; ++j) ssq += x[j] * x[j];
            ssq += shx<1>(ssq, lane); ssq += shx<2>(ssq, lane); ssq += shx<4>(ssq, lane);
            const float rstd = 1.0f / sqrtf(ssq * (1.0f / 64.0f) + RMS_EPS);
            float y[8], o[8];
#pragma unroll
            for (int j = 0; j < 8; ++j) y[j] = x[j] * rstd * gk[(cc * 8 + j) & 63];
#pragma unroll
            for (int j = 0; j < 8; ++j) { const float other = shx<4>(y[j], lane); const int i = 8 * (cc & 3) + j;
                const float inv = exp2f(-(float)(i & 15) * (att::LOG2_THETA / 16.0f)); const float ang = ((i < 16) ? prow : pcol) * inv * att::INV2PI;
                const float c = __builtin_amdgcn_cosf(ang), sn = __builtin_amdgcn_sinf(ang);
                o[j] = (cc < 4) ? (y[j] * c - other * sn) : (other * sn + y[j] * c); }
            if (lane < 16) { *(GAS v4u*)(kB + (size_t)t * 128 + lane * 8) = (v4u){pk2(o[0], o[1]), pk2(o[2], o[3]), pk2(o[4], o[5]), pk2(o[6], o[7])};
                typedef unsigned u32x2 __attribute__((ext_vector_type(2)));
                *(GAS u32x2*)(k8 + (size_t)t * 128 + (lane >> 3) * 64 + 32 * (cc & 1) + 8 * (cc >> 1)) = (u32x2){pg8::pk4_fp8(o[0], o[1], o[2], o[3]), pg8::pk4_fp8(o[4], o[5], o[6], o[7])}; }
        }
        {   float x[8]; float ssq = 0.f;
            if (lane < 48) { const v4u w = wq_; x[0] = bflo(w.x); x[1] = bfhi(w.x); x[2] = bflo(w.y); x[3] = bfhi(w.y); x[4] = bflo(w.z); x[5] = bfhi(w.z); x[6] = bflo(w.w); x[7] = bfhi(w.w); }
            else {
#pragma unroll
                for (int j = 0; j < 8; ++j) x[j] = 0.f; }
#pragma unroll
            for (int j = 0; j < 8; ++j) ssq += x[j] * x[j];
            ssq = wave_sum(ssq, lane); const float rstd = 1.0f / sqrtf(ssq * (1.0f / 384.0f) + RMS_EPS);
            if (lane < 48) { float y[8];
#pragma unroll
                for (int j = 0; j < 8; ++j) y[j] = x[j] * rstd * gq[lane * 8 + j];
                *(GAS v4u*)(cqn + (size_t)t * 384 + lane * 8) = (v4u){pk2(y[0], y[1]), pk2(y[2], y[3]), pk2(y[4], y[5]), pk2(y[6], y[7])}; }
        }
        {   float x[8]; float ssq = 0.f;
            if (lane < 32) { const v4u w = wkv_; x[0] = bflo(w.x); x[1] = bfhi(w.x); x[2] = bflo(w.y); x[3] = bfhi(w.y); x[4] = bflo(w.z); x[5] = bfhi(w.z); x[6] = bflo(w.w); x[7] = bfhi(w.w); }
            else {
#pragma unroll
                for (int j = 0; j < 8; ++j) x[j] = 0.f; }
#pragma unroll
            for (int j = 0; j < 8; ++j) ssq += x[j] * x[j];
            ssq = wave_sum(ssq, lane); const float rstd = 1.0f / sqrtf(ssq * (1.0f / 256.0f) + RMS_EPS);
            if (lane < 32) { float y[8];
#pragma unroll
                for (int j = 0; j < 8; ++j) y[j] = x[j] * rstd * gkv[lane * 8 + j];
                *(GAS v4u*)(ckvn + (size_t)t * 256 + lane * 8) = (v4u){pk2(y[0], y[1]), pk2(y[2], y[3]), pk2(y[4], y[5]), pk2(y[6], y[7])}; }
        }
        {   float x[8]; const int cc = lane & 3;
            if (lane < 4) { const v4u w = wr_; x[0] = bflo(w.x); x[1] = bfhi(w.x); x[2] = bflo(w.y); x[3] = bfhi(w.y); x[4] = bflo(w.z); x[5] = bfhi(w.z); x[6] = bflo(w.w); x[7] = bfhi(w.w); }
            else {
#pragma unroll
                for (int j = 0; j < 8; ++j) x[j] = 0.f; }
            float o[8];
#pragma unroll
            for (int j = 0; j < 8; ++j) { const float other = shx<2>(x[j], lane);
                const float inv = exp2f(-(float)j * (att::LOG2_THETA / 8.0f)); const float ang = (((cc & 1) == 0) ? prow : pcol) * inv * att::INV2PI;
                const float c = __builtin_amdgcn_cosf(ang), sn = __builtin_amdgcn_sinf(ang);
                o[j] = (cc < 2) ? (x[j] * c - other * sn) : (other * sn + x[j] * c); }
            if (lane < 4) *(GAS v4u*)(kr + (size_t)t * 32 + lane * 8) = (v4u){pk2(o[0], o[1]), pk2(o[2], o[3]), pk2(o[4], o[5]), pk2(o[6], o[7])};
        }
    }
}


__device__ __forceinline__ int build_tables(Frame& F, int l) {
    LAS int* st = (LAS int*)(F.lds + TBL_START); LAS int* cn = st + 33; LAS int* te = (LAS int*)(F.lds + TBL_TILEE);
    __syncthreads();
    if (F.tid < NE) cn[F.tid] = (int)__hip_atomic_load(F.ctl + CW_CNT + 64 * l + F.tid, RLX_AGENT);
    __syncthreads();
    if (F.tid == 0) { int s = 0; for (int e = 0; e < NE; ++e) { st[e] = s; s += ((cn[e] + 255) >> 8) << 8; } st[NE] = s; }
    __syncthreads();
    const int total = st[NE];
    for (int tile = F.tid; tile < (total >> 8); tile += NWAVES * 64) { int e = 0; for (int k = 1; k < NE; ++k) e += (tile * 256 >= st[k]) ? 1 : 0; te[tile] = e; }
    __syncthreads();
    return total;
}

template <bool XBF> __device__ __forceinline__ void p_ln1_router(Frame& F, int l, const void* xin) {
    const bool w8 = F8MOE(l); unsigned char* x1f8 = F.ws + WS_X2;
    const float* xcur = (const float*)xin; const bf16* xcb = (const bf16*)xin;
    const bf16* outb = (const bf16*)(F.ws + WS_X1); bf16* x1b = (bf16*)(F.ws + WS_X1B);
    int* list_t = (int*)(F.ws + WS_LT); float* list_g = (float*)(F.ws + WS_LG); int* tok_e = (int*)(F.ws + WS_TE); int* tok_r = (int*)(F.ws + WS_TR);
    const float* wr = INP(15) + (size_t)l * 1024 * NE; const float* br = INP(16) + l * NE;
    const int lane0 = F.lane, tid = F.tid;
    LAS unsigned char* wl = F.lds;
    LAS int* sel_e = (LAS int*)(F.lds + TBL_RS); LAS float* sel_g = (LAS float*)(sel_e + 512); LAS int* sel_r = sel_e + 1024; LAS int* hist = sel_e + 1536; LAS int* base = hist + 32;
    __syncthreads();
    for (int idx = tid; idx < 1024 * 8; idx += NWAVES * 64) { const int k = idx >> 3, c = idx & 7, kp = (k & 3) * 256 + (k >> 2), cp = c ^ ((kp >> 1) & 7);
        *(LAS f32x4*)(wl + (kp * 8 + cp) * 16) = *(const GAS f32x4*)(wr + (size_t)k * NE + c * 4); }
    __syncthreads();
    for (int tile = F.bx; tile < T / 128; tile += F.G) {
        if (tid < 32) hist[tid] = 0;
        __syncthreads();
        f32x4 px[4]; unsigned long long po[4], pxb[4];
        {   const int t0 = tile * 128 + F.wave * 16; const GAS f32x4* xr0 = (const GAS f32x4*)(xcur + (size_t)t0 * D) + lane0; const GAS unsigned long long* or0 = (const GAS unsigned long long*)(outb + (size_t)t0 * D) + lane0;
#pragma unroll
            for (int j = 0; j < 4; ++j) { if (XBF) pxb[j] = ((const GAS unsigned long long*)(xcb + (size_t)t0 * D) + lane0)[64 * j]; else px[j] = xr0[64 * j]; po[j] = or0[64 * j]; } }
        for (int it = 0; it < 16; ++it) {
            int lane = lane0; asm volatile("" : "+v"(lane));
            const int sw = (lane >> 1) & 7; const float bias_e = br[(lane >> 1) & 31];
            const GAS f32x4* lgp = (const GAS f32x4*)(INP(13) + l * D) + lane; const GAS f32x4* lbp = (const GAS f32x4*)(INP(14) + l * D) + lane;
            const int tl = F.wave * 16 + it, t = tile * 128 + tl;
            f32x4 v[4]; float s = 0.f;
#pragma unroll
            for (int j = 0; j < 4; ++j) { const unsigned long long ow = po[j]; const unsigned olo = (unsigned)ow, ohi = (unsigned)(ow >> 32);
                f32x4 xv_; if (XBF) { const unsigned xlo = (unsigned)pxb[j], xhi = (unsigned)(pxb[j] >> 32); xv_ = (f32x4){bflo(xlo), bfhi(xlo), bflo(xhi), bfhi(xhi)}; } else xv_ = px[j];
                v[j] = xv_ * DN_ALPHA + (f32x4){bflo(olo), bfhi(olo), bflo(ohi), bfhi(ohi)}; s += (v[j].x + v[j].y) + (v[j].z + v[j].w); }
            if (it + 1 < 16) { const GAS f32x4* xr = (const GAS f32x4*)(xcur + (size_t)(t + 1) * D) + lane; const GAS unsigned long long* orr = (const GAS unsigned long long*)(outb + (size_t)(t + 1) * D) + lane;
#pragma unroll
                for (int j = 0; j < 4; ++j) { if (XBF) pxb[j] = ((const GAS unsigned long long*)(xcb + (size_t)(t + 1) * D) + lane)[64 * j]; else px[j] = xr[64 * j]; po[j] = orr[64 * j]; } }
            const float mean = wave_sum(s, lane) * (1.f / D); float s2 = 0.f;
#pragma unroll
            for (int j = 0; j < 4; ++j) { v[j] = v[j] - mean; s2 += (v[j].x * v[j].x + v[j].y * v[j].y) + (v[j].z * v[j].z + v[j].w * v[j].w); }
            const float rstd = 1.f / sqrtf(wave_sum(s2, lane) * (1.f / D) + LN_EPS);
            GAS unsigned long long* o8 = (GAS unsigned long long*)(x1b + (size_t)t * D) + lane;
#pragma unroll
            for (int j = 0; j < 4; ++j) { v[j] = v[j] * rstd * lgp[64 * j] + lbp[64 * j];
                o8[64 * j] = (unsigned long long)pk2(v[j].x, v[j].y) | ((unsigned long long)pk2(v[j].z, v[j].w) << 32);
                if (w8) ((GAS unsigned*)(x1f8 + (size_t)t * D))[64 * j + lane] = pg8::pk4_fp8(v[j].x * 16.0f, v[j].y * 16.0f, v[j].z * 16.0f, v[j].w * 16.0f); }
            float acc[32];
#pragma unroll
            for (int c = 0; c < 8; ++c) {
                int basec = lane * 128 + ((c ^ sw) << 4); asm volatile("" : "+v"(basec));
                const LAS unsigned char* wp = wl + basec;
                typedef float f32x2p __attribute__((ext_vector_type(2)));
                f32x2p a01 = {0.f, 0.f}, a23 = {0.f, 0.f};
#pragma unroll
                for (int i = 0; i < 4; ++i)
#pragma unroll
                    for (int j = 0; j < 4; ++j) { const f32x4 w = *(const LAS f32x4*)(wp + (i * 256 + 64 * j) * 128); const float xv = v[j][i]; const f32x2p x2 = {xv, xv};
                        a01 = __builtin_elementwise_fma(x2, (f32x2p){w.x, w.y}, a01); a23 = __builtin_elementwise_fma(x2, (f32x2p){w.z, w.w}, a23); }
                acc[4 * c + 0] = a01.x; acc[4 * c + 1] = a01.y; acc[4 * c + 2] = a23.x; acc[4 * c + 3] = a23.y;
            }
            float a16[16], a8[8], a4[4], a2[2], a1;
            { const bool b = (lane & 32) != 0;
#pragma unroll
              for (int i = 0; i < 16; ++i) { const float send = b ? acc[i] : acc[16 + i]; const float keep = b ? acc[16 + i] : acc[i]; a16[i] = keep + shx<32>(send, lane); } }
            { const bool b = (lane & 16) != 0;
#pragma unroll
              for (int i = 0; i < 8; ++i) { const float send = b ? a16[i] : a16[8 + i]; const float keep = b ? a16[8 + i] : a16[i]; a8[i] = keep + shx<16>(send, lane); } }
            { const bool b = (lane & 8) != 0;
#pragma unroll
              for (int i = 0; i < 4; ++i) { const float send = b ? a8[i] : a8[4 + i]; const float keep = b ? a8[4 + i] : a8[i]; a4[i] = keep + shx<8>(send, lane); } }
            { const bool b = (lane & 4) != 0;
#pragma unroll
              for (int i = 0; i < 2; ++i) { const float send = b ? a4[i] : a4[2 + i]; const float keep = b ? a4[2 + i] : a4[i]; a2[i] = keep + shx<4>(send, lane); } }
            { const bool b = (lane & 2) != 0; const float send = b ? a2[0] : a2[1]; const float keep = b ? a2[1] : a2[0]; a1 = keep + shx<2>(send, lane); }
            a1 += shx<1>(a1, lane);
            float val = a1 + bias_e; const int my_e = (lane >> 1) & 31;
            float sv[4]; int se[4];
#pragma unroll
            for (int r = 0; r < 4; ++r) { float bv = val; int be = my_e;
#define TOPK_STEP(O) { const float ov = shx<O>(bv, lane); const int oe = shxi<O>(be, lane); if (ov > bv || (ov == bv && oe < be)) { bv = ov; be = oe; } }
                TOPK_STEP(2) TOPK_STEP(4) TOPK_STEP(8) TOPK_STEP(16) TOPK_STEP(32)
#undef TOPK_STEP
                sv[r] = bv; se[r] = be; if (my_e == be) val = -INFINITY; }
            const float e1 = __expf(sv[1] - sv[0]), e2 = __expf(sv[2] - sv[0]), e3 = __expf(sv[3] - sv[0]); const float rs = 1.0f / (1.0f + e1 + e2 + e3);
            if (lane < 4) { const int ee = lane == 0 ? se[0] : lane == 1 ? se[1] : lane == 2 ? se[2] : se[3]; const float gg = (lane == 0 ? 1.0f : lane == 1 ? e1 : lane == 2 ? e2 : e3) * rs;
                const int a = tl * 4 + lane; sel_e[a] = ee; sel_g[a] = gg; sel_r[a] = __hip_atomic_fetch_add(&hist[ee], 1, __ATOMIC_RELAXED, __HIP_MEMORY_SCOPE_WORKGROUP); }
        }
        __syncthreads();
        if (tid < 32) base[tid] = (int)__hip_atomic_fetch_add(F.ctl + CW_CNT + 64 * l + tid, (unsigned)hist[tid], RLX_AGENT);
        __syncthreads();
        { const int a = tid, e = sel_e[a], rank = base[e] + sel_r[a], t = tile * 128 + (a >> 2);
          list_t[(size_t)e * LCAP + rank] = t; list_g[(size_t)e * LCAP + rank] = sel_g[a]; tok_e[t * 4 + (a & 3)] = e; tok_r[t * 4 + (a & 3)] = rank; }
        __syncthreads();
    }
}

__device__ __forceinline__ void p_gather(Frame& F, int l) {
    const int total = build_tables(F, l);
    LAS int* st = (LAS int*)(F.lds + TBL_START); LAS int* cn = st + 33;
    const bf16* x1b = (const bf16*)(F.ws + WS_X1B); bf16* xg = (bf16*)(F.ws + WS_H); float* sg = (float*)(F.ws + WS_SG);
    const int* list_t = (const int*)(F.ws + WS_LT); const float* list_g = (const float*)(F.ws + WS_LG);
    const int lane = F.lane, gw = F.vcu * NWAVES + F.wave, NGW = F.G * NWAVES;
    for (int s = gw; s < total; s += NGW) {
        const bool pr = (lane < NE) && (s >= st[lane & 31]);
        const int e = __popcll(__ballot(pr)) - 1; const int r = s - st[e];
        GAS v4u* dst = (GAS v4u*)(xg + (size_t)s * D);
        if (r < cn[e]) { const int t = list_t[(size_t)e * LCAP + r]; const GAS v4u* src = (const GAS v4u*)(x1b + (size_t)t * D);
            dst[lane] = src[lane]; dst[64 + lane] = src[64 + lane]; if (lane == 0) sg[s] = list_g[(size_t)e * LCAP + r]; }
        else { unsigned zz = 0u; asm volatile("" : "+v"(zz)); const v4u z4 = {zz, zz, zz, zz}; dst[lane] = z4; dst[64 + lane] = z4; if (lane == 0) sg[s] = 0.f; }
    }
}

__device__ __forceinline__ void p_ln2(Frame& F, int l, float* dst, bool write_f32, bool write_xb) {
    (void)build_tables(F, l);
    LAS int* st = (LAS int*)(F.lds + TBL_START);
    const bf16* x1b = (const bf16*)(F.ws + WS_X1B); const bf16* yb = (const bf16*)(F.ws + WS_H); bf16* xb = (bf16*)(F.ws + WS_XB);
    const int* tok_e = (const int*)(F.ws + WS_TE); const int* tok_r = (const int*)(F.ws + WS_TR);
    const int lane = F.lane, hl = lane & 31, half = lane >> 5, gw = F.vcu * NWAVES + F.wave, NGW = F.G * NWAVES;
    const float* lgp = INP(21) + l * D; const float* lbp = INP(22) + l * D;
    float dmult = 1.0f;
#if MK_DEBUG
    if (l == DEPTH - 1) { const unsigned mask = __hip_atomic_load(F.ctl + 20000, RLX_AGENT) & ~(unsigned)(MK_DBG_IGNORE); if (mask) dmult = 1.0f + (float)(__ffs((int)mask) - 1); }
#endif
    int t = 2 * gw + half;
    int e4 = 0, r4 = 0;
    if (t < T && hl < 4) { e4 = tok_e[t * 4 + hl]; r4 = tok_r[t * 4 + hl]; }
    v4u xn[4] = {{0u, 0u, 0u, 0u}, {0u, 0u, 0u, 0u}, {0u, 0u, 0u, 0u}, {0u, 0u, 0u, 0u}};
    if (t < T) { const GAS v4u* xr = (const GAS v4u*)(x1b + (size_t)t * D) + hl;
#pragma unroll
        for (int q = 0; q < 4; ++q) xn[q] = xr[32 * q]; }
    for (; t < T; t += 2 * NGW) {
        int slot4 = st[e4] + r4;
        const int tn = t + 2 * NGW; int e4n = 0, r4n = 0;
        if (tn < T && hl < 4) { e4n = tok_e[tn * 4 + hl]; r4n = tok_r[tn * 4 + hl]; }
        int slot[4];
#pragma unroll
        for (int k = 0; k < 4; ++k) slot[k] = __builtin_amdgcn_ds_bpermute((half * 32 + k) << 2, slot4);
        v4u xw[4], yw[4][4];
#pragma unroll
        for (int q = 0; q < 4; ++q) xw[q] = xn[q];
        if (tn < T) { const GAS v4u* xr = (const GAS v4u*)(x1b + (size_t)tn * D) + hl;
#pragma unroll
            for (int q = 0; q < 4; ++q) xn[q] = xr[32 * q]; }
#pragma unroll
        for (int k = 0; k < 4; ++k) { const GAS v4u* yr = (const GAS v4u*)(yb + (size_t)slot[k] * D) + hl;
#pragma unroll
            for (int q = 0; q < 4; ++q) yw[k][q] = yr[32 * q]; }
        float v[4][8]; float s = 0.f;
#pragma unroll
        for (int q = 0; q < 4; ++q) {
            v[q][0] = bflo(xw[q].x) * DN_ALPHA; v[q][1] = bfhi(xw[q].x) * DN_ALPHA; v[q][2] = bflo(xw[q].y) * DN_ALPHA; v[q][3] = bfhi(xw[q].y) * DN_ALPHA;
            v[q][4] = bflo(xw[q].z) * DN_ALPHA; v[q][5] = bfhi(xw[q].z) * DN_ALPHA; v[q][6] = bflo(xw[q].w) * DN_ALPHA; v[q][7] = bfhi(xw[q].w) * DN_ALPHA;
#pragma unroll
            for (int k = 0; k < 4; ++k) { v[q][0] += bflo(yw[k][q].x); v[q][1] += bfhi(yw[k][q].x); v[q][2] += bflo(yw[k][q].y); v[q][3] += bfhi(yw[k][q].y);
                v[q][4] += bflo(yw[k][q].z); v[q][5] += bfhi(yw[k][q].z); v[q][6] += bflo(yw[k][q].w); v[q][7] += bfhi(yw[k][q].w); }
#pragma unroll
            for (int i = 0; i < 8; ++i) s += v[q][i]; }
        s += shx<1>(s, lane); s += shx<2>(s, lane); s += shx<4>(s, lane); s += shx<8>(s, lane); s += shx<16>(s, lane);
        const float mean = s * (1.f / D); float s2 = 0.f;
#pragma unroll
        for (int q = 0; q < 4; ++q)
#pragma unroll
            for (int i = 0; i < 8; ++i) { v[q][i] -= mean; s2 += v[q][i] * v[q][i]; }
        s2 += shx<1>(s2, lane); s2 += shx<2>(s2, lane); s2 += shx<4>(s2, lane); s2 += shx<8>(s2, lane); s2 += shx<16>(s2, lane);
        const float rstd = 1.f / sqrtf(s2 * (1.f / D) + LN_EPS);
        GAS f32x4* orow = (GAS f32x4*)(dst + (size_t)t * D) + 2 * hl; GAS v4u* o16 = (GAS v4u*)(xb + (size_t)t * D) + hl;
#pragma unroll
        for (int q = 0; q < 4; ++q) { const GAS f32x4* gq = (const GAS f32x4*)(lgp + 256 * q) + 2 * hl; const GAS f32x4* bq = (const GAS f32x4*)(lbp + 256 * q) + 2 * hl;
            const f32x4 g0 = gq[0], g1 = gq[1], b0 = bq[0], b1 = bq[1];
            f32x4 y0 = {v[q][0] * rstd, v[q][1] * rstd, v[q][2] * rstd, v[q][3] * rstd}, y1 = {v[q][4] * rstd, v[q][5] * rstd, v[q][6] * rstd, v[q][7] * rstd};
            y0 = y0 * g0 + b0; y1 = y1 * g1 + b1;
            if (write_f32) { orow[64 * q] = y0 * dmult; orow[64 * q + 1] = y1 * dmult; }
            if (write_xb) { o16[32 * q] = (v4u){pk2(y0.x, y0.y), pk2(y0.z, y0.w), pk2(y1.x, y1.y), pk2(y1.z, y1.w)};
                if (F8IN(l + 1)) { typedef unsigned u32x2 __attribute__((ext_vector_type(2)));
                    ((GAS u32x2*)(F.ws + WS_X2 + (size_t)t * D))[hl + 32 * q] = (u32x2){pg8::pk4_fp8(y0.x * 16.f, y0.y * 16.f, y0.z * 16.f, y0.w * 16.f), pg8::pk4_fp8(y1.x * 16.f, y1.y * 16.f, y1.z * 16.f, y1.w * 16.f)}; } } }
        e4 = e4n; r4 = r4n;
    }
}

template <int WHICH> __device__ __forceinline__ void p_attention(Frame& F, int l) {
    const bf16* hb = (const bf16*)(F.ws + WS_H); unsigned char* a2 = F.ws + WS_A2;
    const bf16* kB = (const bf16*)(a2 + A2_KB); const bf16* kr = (const bf16*)(a2 + A2_KR); const bf16* qc = (const bf16*)(a2 + A2_QC); const bf16* kvc = (const bf16*)(a2 + A2_KVC);
    bf16* ya = (bf16*)(a2 + A2_YA); bf16* yb = (bf16*)(a2 + A2_YB); bf16* yc = (bf16*)(a2 + A2_YC);
    att::ALAS_PTR lds = (att::ALAS_PTR)F.lds;
    att::NoSide noside;
    __syncthreads();
    if (WHICH == 0) {
        float mq = fabsf((INP(3) + l * 64)[F.lane]), mk = fabsf((INP(4) + l * 64)[F.lane]);
#define MX_STEP(O) { mq = fmaxf(mq, shx<O>(mq, F.lane)); mk = fmaxf(mk, shx<O>(mk, F.lane)); }
        MX_STEP(1) MX_STEP(2) MX_STEP(4) MX_STEP(8) MX_STEP(16) MX_STEP(32)
#undef MX_STEP
        const float cref = __int_as_float(__builtin_amdgcn_readfirstlane(__float_as_int(8.0f * LOG2E_F * 1.03f * mq * mk)));
        const bool fixed_ok = cref < 60.0f;
        unsigned char* wbl = F.ws + WS_W + (size_t)l * WB_LAYER;
        MoeConv cv; cv.Wgu = INP(17) + (size_t)l * NE * 1024 * 2048; cv.Wdn = INP(19) + (size_t)l * NE * 1024 * 1024; cv.Tgu = wbl + WB_GU; cv.Tdn = wbl + WB_DN; cv.f8 = F8MOE(l);
        cv.scr = (LAS float*)(F.lds + CONV_LDS_OFF + F.wave * CONV_LDS_WAVE); cv.lane = F.lane; cv.ngw = F.G * NWAVES; cv.gw = F.vcu * NWAVES + F.wave; cv.s = 0;
        cv.nmini = 4 * ((CONV_ITEMS - cv.gw + cv.ngw - 1) / cv.ngw);
#pragma unroll
        for (int i_ = 0; i_ < 8; ++i_) { cv.cvA[i_] = 0.f; cv.cvB[i_] = 0.f; }
        for (int idx = F.vcu; idx < 768; idx += F.G) {
            const int qi = idx >> 8, rem = idx & 255, bk = rem >> 5, qb = rem & 31, b = bk >> 1, kvh = bk & 1, head = kvh * 3 + qi;
            att::UnitP u; const size_t tb = (size_t)b * SEQ, tq = tb + (size_t)qb * 256;
            u.Q = hb + tq * DINP + H_GQ + head * 64; u.ldq = DINP; u.K0 = kB + tb * 128 + kvh * 64; u.ldk0 = 128; u.K1 = nullptr; u.ldk1 = 0;
            u.V = hb + tb * DINP + H_GV + kvh * 64; u.ldv = DINP; u.O = yb + tq * 384 + head * 64; u.ldo = 384; u.nt = SEQ / 64; u.grow0 = qb * 4; u.gain = INP(3) + l * 64; u.kr0 = 0; u.cref = cref;
            u.K8 = a2 + A2_K8 + tb * 128 + kvh * 64; u.ldk8 = 128; u.V8 = a2 + A2_VT8 + (size_t)(b * 2 + kvh) * (SEQ / 64) * 4096;
            if (MK_FP8_QK && cref <= 15.0f) att::attn_unit<64, 0, MoeConv, true>(u, lds, F.tid, cv);
            else if (!MK_FP8_QK && fixed_ok) att::attn_unit<64, 0, MoeConv, false>(u, lds, F.tid, cv);
            else att::attn_unit<64, 3, MoeConv>(u, lds, F.tid, cv);
        }
        while (!cv.done()) { cv.step<0>(); cv.step<1>(); }
    }
    if (WHICH == 1) for (int idx = F.vcu; idx < 512; idx += F.G) {
        const int rnd = idx >> 8, rem = idx & 255, p = (rem >> 5) * 2 + rnd, qb = rem & 31, b = p >> 2, h = p & 3;
        att::UnitP u; const size_t tb = (size_t)b * SEQ, tq = tb + (size_t)qb * 256;
        u.Q = qc + tq * 384 + h * 96; u.ldq = 384; u.K0 = kvc + tb * 512 + h * 128; u.ldk0 = 512; u.K1 = kr + tb * 32; u.ldk1 = 32;
        u.V = kvc + tb * 512 + h * 128 + 64; u.ldv = 512; u.O = yc + tq * 384 + h * 64; u.ldo = 384; u.nt = SEQ / 64; u.grow0 = qb * 4; u.gain = nullptr; u.kr0 = 0; u.cref = 0.f; u.K8 = nullptr; u.ldk8 = 0; u.V8 = nullptr;
        att::attn_unit<96, 1>(u, lds, F.tid, noside);
    }
    if (WHICH == 2) for (int idx = F.vcu; idx < 768; idx += F.G) {
        const int b = idx / 192, rem = idx % 192, h = rem >> 5, rg = rem & 31, R0 = rg * 4;
        int r_lo = R0 - 4; r_lo = r_lo < 0 ? 0 : (r_lo > 120 ? 120 : r_lo);
        int r_hi = R0 - 1; r_hi = (r_hi < 0 ? 0 : (r_hi > 120 ? 120 : r_hi)) + 8;
        if ((r_hi - r_lo) & 1) { if (r_hi < 128) ++r_hi; else --r_lo; }
        {
            LAS float* bt = (LAS float*)(F.lds + att::OFF_BIAS); const float* rp = INP(2) + ((size_t)l * 6 + h) * 465;
            if (F.tid < 465) bt[F.tid] = rp[F.tid] * LOG2E_F; }
        att::UnitP u; const size_t tb = (size_t)b * SEQ, tq = tb + (size_t)R0 * 64, tk = tb + (size_t)r_lo * 64;
        u.Q = hb + tq * DINP + H_NAQ + h * 64; u.ldq = DINP; u.K0 = hb + tk * DINP + H_NAK + h * 64; u.ldk0 = DINP; u.K1 = nullptr; u.ldk1 = 0;
        u.V = hb + tk * DINP + H_NAV + h * 64; u.ldv = DINP; u.O = ya + tq * 384 + h * 64; u.ldo = 384; u.nt = r_hi - r_lo; u.grow0 = R0; u.gain = nullptr; u.kr0 = r_lo; u.cref = 0.f; u.K8 = nullptr; u.ldk8 = 0; u.V8 = nullptr;
        att::attn_unit<64, 2>(u, lds, F.tid, noside);
    }
}


struct Args { const float* in[23]; float* out; unsigned char* ws; int ph_lo, ph_hi, use_bar, pad; };
__global__ void __launch_bounds__(NWAVES * 64, 2) mk_fwd(Args args) {
    extern __shared__ __attribute__((aligned(16))) unsigned char lds[];
    const int wave_id = __builtin_amdgcn_readfirstlane((int)threadIdx.x >> 6), bx0 = blockIdx.x, G0 = gridDim.x;
    {   LAS unsigned* z = (LAS unsigned*)((LAS unsigned char*)lds + LDSCTL_OFF); for (int u = threadIdx.x; u < (LDS_BYTES - LDSCTL_OFF) / 4; u += NWAVES * 64) z[u] = 0u; }
    __syncthreads();
    XcdBarrier bar; bar.bar = (unsigned*)(args.ws + WS_CTL) + CW_BAR; bar.x = 0; bar.st = nullptr;
    if (args.use_bar) bar = xcd_barrier_post((unsigned*)(args.ws + WS_CTL) + CW_BAR, (volatile LAS unsigned*)((LAS unsigned char*)lds + MISC_OFF));
    const int lo = args.ph_lo, hi = args.ph_hi;
#define IN(k) (lo <= (k) && (k) < hi)
#define REPEAT(n) for (int rep_ = 0; rep_ < (n); ++rep_)
#define RSEAM(n) do { if (rep_ + 1 < (n)) { XcdBarrier b_ = bar; { GAS unsigned* bb_ = (GAS unsigned*)b_.bar; asm volatile("; rseam %1" : "+s"(bb_) : "n"(__COUNTER__)); b_.bar = (unsigned*)bb_; } xcd_barrier(b_); } } while (0)
#define SEAM(k) do { if (IN(k) && IN((k) + 1)) { XcdBarrier b_ = bar; { GAS unsigned* bb_ = (GAS unsigned*)b_.bar; asm volatile("; seam %1" : "+s"(bb_) : "n"(__COUNTER__)); b_.bar = (unsigned*)bb_; } xcd_barrier(b_); } } while (0)
#define FRAME() Frame F = mkframe<__COUNTER__>((LAS unsigned char*)lds, args.ws, args.out, wave_id, bx0, G0); unsigned char* ws = F.ws; unsigned char* a2 = ws + WS_A2; unsigned char* wb = ws + WS_W + (size_t)l * WB_LAYER; (void)a2; (void)wb

    if (IN(0)) REPEAT(REP_P) { Frame F = mkframe<__COUNTER__>((LAS unsigned char*)lds, args.ws, args.out, wave_id, bx0, G0); p_prologue(F); RSEAM(REP_P); } SEAM(0);

    for (int l = 0; l < DEPTH; ++l) {
        const int pb = 1 + l * PPL;
        if (IN(pb + 0)) REPEAT(REP_A) { FRAME();
            pg8::StaticOrder S; S.init(T, DINP, F.G, F.bx);
            if (!F8IN(l)) {
                pg8::Gemm g{(const bf16*)(ws + WS_XB), (const bf16*)(wb + WB_IN), T, DINP, 1024, 0, 0, nullptr};
                pg8::EpiStore E{(bf16*)(ws + WS_H), DINP, DINP, 1.0f};
                pg8::gemm_phase<pg8::EpiStore, pg8::StaticOrder, true, true>(F.lds, g, S, E, F.tid);
            } else {
                pg8::Gemm g{(const bf16*)(ws + WS_X2), (const bf16*)(wb + WB_IN), T, DINP, 1024, 0, 0, (const void*)ws};
                pg8::EpiStore E{(bf16*)(ws + WS_H), DINP, DINP, 1.0f / 512.0f};
                pg8::gemm_phase<pg8::EpiStore, pg8::StaticOrder, true, true, false, pg8::NoGather, 1>(F.lds, g, S, E, F.tid);
            }
            RSEAM(REP_A);
        } SEAM(pb + 0);
        if (IN(pb + 1)) REPEAT(REP_B) { FRAME(); p_prep(F, l); RSEAM(REP_B); } SEAM(pb + 1);
        if (IN(pb + 2)) REPEAT(REP_C) {
            { FRAME(); pg8::Gemm g{(const bf16*)(a2 + A2_CQN), (const bf16*)(wb + WB_UQ), T, 512, 384, 0, 0, nullptr}; pg8::StaticOrder S; S.init(T, 512, F.G, F.bx);
              pg8::EpiStore E{(bf16*)(a2 + A2_QC), 384, 384, 1.0f};
              pg8::gemm_phase<pg8::EpiStore, pg8::StaticOrder, true, true>(F.lds, g, S, E, F.tid); }
            { FRAME(); pg8::Gemm g{(const bf16*)(a2 + A2_CKVN), (const bf16*)(wb + WB_UKV), T, 512, 256, 0, 0, nullptr}; pg8::StaticOrder S; S.init(T, 512, F.G, F.bx);
              pg8::EpiStore E{(bf16*)(a2 + A2_KVC), 512, 512, 1.0f};
              pg8::gemm_phase<pg8::EpiStore, pg8::StaticOrder, true, true>(F.lds, g, S, E, F.tid); }
            RSEAM(REP_C);
        } SEAM(pb + 2);
        if (IN(pb + 3)) { REPEAT(REP_DG) { FRAME(); p_attention<0>(F, l); RSEAM(REP_DG); } REPEAT(REP_DM) { FRAME(); p_attention<1>(F, l); RSEAM(REP_DM); } REPEAT(REP_DN) { FRAME(); p_attention<2>(F, l); RSEAM(REP_DN); } } SEAM(pb + 3);
        if (IN(pb + 4)) REPEAT(REP_E) { FRAME();
            pg8::Gemm g{(const bf16*)(a2 + A2_YA), (const bf16*)(wb + WB_BA), T, 1024, 384, (size_t)1024 * 384 * 2, (size_t)T * 384 * 2, nullptr};
            pg8::ChainOrder S; S.so.init(T, 1024, F.G, F.bx); S.nch = 3;
            pg8::EpiGateChain E{(const bf16*)(ws + WS_H) + H_GATE, DINP, (void*)(a2 + A2_MIXED), MK_FP8_OUT ? 256.0f : 0.0f};
            pg8::gemm_phase<pg8::EpiGateChain, pg8::ChainOrder, true, true>(F.lds, g, S, E, F.tid);
            RSEAM(REP_E);
        } SEAM(pb + 4);
        if (IN(pb + 5)) REPEAT(REP_F) { FRAME();
            pg8::StaticOrder S; S.init(T, 1024, F.G, F.bx);
            if (!MK_FP8_OUT) { pg8::Gemm g{(const bf16*)(a2 + A2_MIXED), (const bf16*)(wb + WB_OUT), T, 1024, 1024, 0, 0, nullptr};
                pg8::EpiStore E{(bf16*)(ws + WS_X1), 1024, 1024, 1.0f};
                pg8::gemm_phase<pg8::EpiStore, pg8::StaticOrder, true, true>(F.lds, g, S, E, F.tid); }
            else { pg8::Gemm g{(const bf16*)(a2 + A2_MIXED), (const bf16*)(wb + WB_OUT), T, 1024, 1024, 0, 0, (const void*)ws};
                pg8::EpiStore E{(bf16*)(ws + WS_X1), 1024, 1024, 1.0f / 16384.0f};
                pg8::gemm_phase<pg8::EpiStore, pg8::StaticOrder, true, true, false, pg8::NoGather, 1>(F.lds, g, S, E, F.tid); }
            RSEAM(REP_F);
        } SEAM(pb + 5);
        if (IN(pb + 6)) { FRAME(); if (l == 0) p_ln1_router<false>(F, l, INP(0)); else p_ln1_router<true>(F, l, ws + WS_XB); } SEAM(pb + 6);
        const bool f8l = F8MOE(l);
        if (IN(pb + 7)) REPEAT(REP_I) { FRAME();
            const int total = build_tables(F, l);
            pg8::MoeOrder S{8, (total >> 8) * 8, F.G, F.vcu, (const LAS int*)(F.lds + TBL_TILEE)};
            pg8::MoeGather gs{(const int*)(ws + WS_LT), (const LAS int*)(F.lds + TBL_START), (const LAS int*)(F.lds + TBL_START) + 33, LCAP};
            if (!f8l) {
                pg8::Gemm g{(const bf16*)(ws + WS_X1B), (const bf16*)(wb + WB_GU), total, 2048, 1024, (size_t)2048 * 1024 * 2, 0, nullptr};
                pg8::EpiSwigluT<false> E{(void*)(ws + WS_A2), INP(18) + (size_t)l * NE * 2048, 1.0f, 1.0f};
                pg8::gemm_phase<pg8::EpiSwigluT<false>, pg8::MoeOrder, true, true, true, pg8::MoeGather>(F.lds, g, S, E, F.tid, gs);
            } else {
                pg8::Gemm g{(const bf16*)(ws + WS_X2), (const bf16*)(wb + WB_GU), total, 2048, 1024, (size_t)2048 * 1024, 0, (const void*)ws};
                pg8::EpiSwigluT<true> E{(void*)(ws + WS_A2), INP(18) + (size_t)l * NE * 2048, 1.0f / 1024.0f, 4.0f};
                pg8::gemm_phase<pg8::EpiSwigluT<true>, pg8::MoeOrder, true, true, true, pg8::MoeGather, 1>(F.lds, g, S, E, F.tid, gs);
            }
            RSEAM(REP_I);
        } SEAM(pb + 7);
        if (IN(pb + 8)) REPEAT(REP_J) { FRAME();
            const int total = build_tables(F, l);
            pg8::MoeOrder S{4, (total >> 8) * 4, F.G, F.vcu, (const LAS int*)(F.lds + TBL_TILEE)};
            if (!f8l) {
                pg8::Gemm g{(const bf16*)(ws + WS_A2), (const bf16*)(wb + WB_DN), total, 1024, 1024, (size_t)1024 * 1024 * 2, 0, nullptr};
                pg8::EpiDown E{(bf16*)(ws + WS_H), INP(20) + (size_t)l * NE * 1024, (const float*)(ws + WS_LG), (const LAS int*)(F.lds + TBL_START), (const LAS int*)(F.lds + TBL_START) + 33, LCAP, 1.0f};
                pg8::gemm_phase<pg8::EpiDown, pg8::MoeOrder, true, true>(F.lds, g, S, E, F.tid);
            } else {
                pg8::Gemm g{(const bf16*)(ws + WS_A2), (const bf16*)(wb + WB_DN), total, 1024, 1024, (size_t)1024 * 1024, 0, (const void*)ws};
                pg8::EpiDown E{(bf16*)(ws + WS_H), INP(20) + (size_t)l * NE * 1024, (const float*)(ws + WS_LG), (const LAS int*)(F.lds + TBL_START), (const LAS int*)(F.lds + TBL_START) + 33, LCAP, 1.0f / 512.0f};
                pg8::gemm_phase<pg8::EpiDown, pg8::MoeOrder, true, true, false, pg8::NoGather, 1>(F.lds, g, S, E, F.tid);
            }
            RSEAM(REP_J);
        } SEAM(pb + 8);
        if (IN(pb + 9)) REPEAT(REP_K) { FRAME(); RSEAM(REP_K); p_ln2(F, l, F.out, l == DEPTH - 1, l + 1 < DEPTH); }
        if (l + 1 < DEPTH) SEAM(pb + 9);
    }
#undef IN
#undef SEAM
}


#if MK_DEBUG
constexpr int CW_DBG = 20000;
__device__ __forceinline__ float bfr(float f) { return __uint_as_float(f2bf(f) << 16); }
__device__ __forceinline__ float bfv(const bf16* p) { return __uint_as_float(((unsigned)*p) << 16); }
__device__ __forceinline__ unsigned hsh(unsigned x) { x ^= x >> 16; x *= 0x7feb352du; x ^= x >> 15; x *= 0x846ca68bu; x ^= x >> 16; return x; }
__device__ __forceinline__ bool close_(float got, float ref, float rel, float abs_) { return fabsf(got - ref) <= rel * fabsf(ref) + abs_; }
__device__ __forceinline__ void ropecs(int i, int quarter, int s, float& c, float& sn) {
    const float pos = (i < quarter) ? (float)(s >> 6) : (float)(s & 63); const int m = (i < quarter) ? i : i - quarter;
    const float inv = exp2f(-(float)m / (float)quarter * 13.287712379549449f); const float ang = pos * inv * 0.15915494309189535f; c = __builtin_amdgcn_cosf(ang); sn = __builtin_amdgcn_sinf(ang);
}
#define DBG_FAIL(bit) atomicOr((unsigned*)(ws + WS_CTL) + CW_DBG, 1u << (bit))
template <int stage> __global__ void __launch_bounds__(256) dbg_kernel(Args args) {
    unsigned char* ws = args.ws; const int l = 0;
    const int gid = blockIdx.x * 256 + threadIdx.x;
    const bf16* hb = (const bf16*)(ws + WS_H); unsigned char* a2 = ws + WS_A2; unsigned char* wb = ws + WS_W + (size_t)l * WB_LAYER;
    const bf16* kB = (const bf16*)(a2 + A2_KB); const bf16* cqn = (const bf16*)(a2 + A2_CQN); const bf16* ckvn = (const bf16*)(a2 + A2_CKVN); const bf16* kr = (const bf16*)(a2 + A2_KR);
    const bf16* qc = (const bf16*)(a2 + A2_QC); const bf16* kvc = (const bf16*)(a2 + A2_KVC);
    const bf16* ya = (const bf16*)(a2 + A2_YA); const bf16* yb = (const bf16*)(a2 + A2_YB); const bf16* yc = (const bf16*)(a2 + A2_YC);
    const unsigned h1 = hsh(gid * 2654435761u + 12345u + stage * 977u), h2 = hsh(h1 + 0x9e3779b9u);
    const int t = h1 % T, s = t & (SEQ - 1), b = t / SEQ;
    if (stage == 0) {
        const int n = h2 % DIN; const float* x = args.in[0] + (size_t)t * D; const float* W = args.in[1];
        const float sc = (n < 384) ? 0.125f * LOG2E_F : 1.0f; float r = 0.f;
        for (int k = 0; k < 1024; ++k) r += bfr(x[k]) * bfr(W[(size_t)k * DIN + n] * sc);
        if (!close_(bfv(hb + (size_t)t * DINP + n), r, 0.02f, 0.02f)) DBG_FAIL(1);
    }
    if (stage == 1) {
        const bf16* hr = hb + (size_t)t * DINP;
        {   const int d = h2 % 128, head = d >> 6, dd = d & 63; float ssq = 0.f;
            for (int k = 0; k < 64; ++k) { const float v = bfv(hr + H_GK + head * 64 + k); ssq += v * v; }
            const float rstd = 1.0f / sqrtf(ssq / 64.0f + RMS_EPS); const float* g = args.in[4];
            const int i = dd & 31; const float y1 = bfv(hr + H_GK + head * 64 + i) * rstd * g[i], y2 = bfv(hr + H_GK + head * 64 + i + 32) * rstd * g[i + 32];
            float c, sn; ropecs(i, 16, s, c, sn); const float ref = (dd < 32) ? (y1 * c - y2 * sn) : (y1 * sn + y2 * c);
            if (!close_(bfv(kB + (size_t)t * 128 + d), ref, 0.02f, 0.01f)) DBG_FAIL(2); }
        {   const int d = h2 % 384; float ssq = 0.f; for (int k = 0; k < 384; ++k) { const float v = bfv(hr + H_CQ + k); ssq += v * v; }
            const float ref = bfv(hr + H_CQ + d) / sqrtf(ssq / 384.0f + RMS_EPS) * args.in[5][d];
            if (!close_(bfv(cqn + (size_t)t * 384 + d), ref, 0.02f, 0.01f)) DBG_FAIL(3); }
        {   const int d = h2 % 256; float ssq = 0.f; for (int k = 0; k < 256; ++k) { const float v = bfv(hr + H_CKV + k); ssq += v * v; }
            const float ref = bfv(hr + H_CKV + d) / sqrtf(ssq / 256.0f + RMS_EPS) * args.in[6][d];
            if (!close_(bfv(ckvn + (size_t)t * 256 + d), ref, 0.02f, 0.01f)) DBG_FAIL(4); }
        {   const int d = h2 % 32, i = d & 15; const float x1 = bfv(hr + H_KR + i), x2 = bfv(hr + H_KR + i + 16); float c, sn; ropecs(i, 8, s, c, sn);
            const float ref = (d < 16) ? (x1 * c - x2 * sn) : (x1 * sn + x2 * c);
            if (!close_(bfv(kr + (size_t)t * 32 + d), ref, 0.02f, 0.01f)) DBG_FAIL(5); }
    }
    if (stage == 2) {
        {   const int n = h2 % 384; float r = 0.f; const float sc = 0.10206207261596577f * LOG2E_F;
            for (int k = 0; k < 384; ++k) r += bfv(cqn + (size_t)t * 384 + k) * bfr(args.in[7][(size_t)k * 384 + n] * sc);
            if (!close_(bfv(qc + (size_t)t * 384 + n), r, 0.02f, 0.01f)) DBG_FAIL(6); }
        {   const int n = h2 % 512; float r = 0.f;
            for (int k = 0; k < 256; ++k) r += bfv(ckvn + (size_t)t * 256 + k) * bfr(args.in[8][(size_t)k * 512 + n]);
            if (!close_(bfv(kvc + (size_t)t * 512 + n), r, 0.02f, 0.02f)) DBG_FAIL(7); }
    }
    if (stage == 3) {
        const int gr = s >> 6, gc = s & 63;
        if (gid < 1024) {
            const int h = h2 % 6, dofs = ((h2 >> 8) & 1) * 32; float q[64], o[32];
            _Pragma("unroll") for (int d = 0; d < 64; ++d) { q[d] = bfv(hb + (size_t)t * DINP + H_NAQ + h * 64 + d); }
            _Pragma("unroll") for (int d = 0; d < 32; ++d) o[d] = 0.f;
            int r0 = gr - 4; r0 = r0 < 0 ? 0 : (r0 > 120 ? 120 : r0); int c0 = gc - 8; c0 = c0 < 0 ? 0 : (c0 > 48 ? 48 : c0);
            const float* rp = args.in[2] + (size_t)h * 465; float m = -1e30f, lsum = 0.f;
            for (int pass = 0; pass < 2; ++pass)
                for (int i = 0; i < 8; ++i) for (int j = 0; j < 16; ++j) { const int kr_ = r0 + i, kc = c0 + j; const size_t kt = (size_t)b * SEQ + kr_ * 64 + kc;
                    float sc = 0.f; _Pragma("unroll") for (int d = 0; d < 64; ++d) sc += q[d] * bfv(hb + kt * DINP + H_NAK + h * 64 + d);
                    sc += rp[(kr_ - gr + 7) * 31 + (kc - gc + 15)] * LOG2E_F;
                    if (pass == 0) m = fmaxf(m, sc); else { const float p = exp2f(sc - m); lsum += p; _Pragma("unroll") for (int d = 0; d < 32; ++d) o[d] += p * bfv(hb + kt * DINP + H_NAV + h * 64 + dofs + d); } }
            bool bad = false; _Pragma("unroll") for (int d = 0; d < 32; ++d) bad |= !close_(bfv(ya + (size_t)t * 384 + h * 64 + dofs + d), o[d] / lsum, 0.03f, 0.01f);
            if (bad) DBG_FAIL(8);
        } else if (gid < 1024 + 128) {
            const int head = h2 % 6, kvh = head / 3, dofs = ((h2 >> 8) & 1) * 32; float q[64], o[32]; float ssq = 0.f;
            _Pragma("unroll") for (int d = 0; d < 64; ++d) { q[d] = bfv(hb + (size_t)t * DINP + H_GQ + head * 64 + d); ssq += q[d] * q[d]; }
            _Pragma("unroll") for (int d = 0; d < 32; ++d) o[d] = 0.f;
            const float rstd = 1.0f / sqrtf(ssq / 64.0f + RMS_EPS);
            _Pragma("unroll") for (int d = 0; d < 64; ++d) q[d] = q[d] * rstd * args.in[3][d];
            _Pragma("unroll") for (int i = 0; i < 32; ++i) { float c, sn; ropecs(i, 16, s, c, sn); const float y1 = q[i], y2 = q[i + 32]; q[i] = y1 * c - y2 * sn; q[i + 32] = y1 * sn + y2 * c; }
            _Pragma("unroll") for (int d = 0; d < 64; ++d) q[d] = bfr(q[d] * 0.125f * LOG2E_F);
            float m = -1e30f, lsum = 0.f;
            for (int key = 0; key < SEQ; ++key) { const size_t kt = (size_t)b * SEQ + key; float sc = 0.f;
                _Pragma("unroll") for (int d = 0; d < 64; ++d) sc += q[d] * bfv(kB + kt * 128 + kvh * 64 + d);
                const float mn = fmaxf(m, sc), al = exp2f(m - mn), p = exp2f(sc - mn); m = mn; lsum = lsum * al + p;
                _Pragma("unroll") for (int d = 0; d < 32; ++d) o[d] = o[d] * al + p * bfv(hb + kt * DINP + H_GV + kvh * 64 + dofs + d); }
            bool bad = false; _Pragma("unroll") for (int d = 0; d < 32; ++d) bad |= !close_(bfv(yb + (size_t)t * 384 + head * 64 + dofs + d), o[d] / lsum, 0.03f, MK_FP8_QK ? 0.012f : 0.003f);
            if (bad) DBG_FAIL(9);
        } else if (gid < 1024 + 256) {
            const int h = h2 % 4, dofs = ((h2 >> 8) & 1) * 32; float q[96], o[32];
            _Pragma("unroll") for (int d = 0; d < 96; ++d) q[d] = bfv(qc + (size_t)t * 384 + h * 96 + d);
            _Pragma("unroll") for (int i = 0; i < 16; ++i) { float c, sn; ropecs(i, 8, s, c, sn); const float y1 = q[64 + i], y2 = q[80 + i]; q[64 + i] = bfr(y1 * c - y2 * sn); q[80 + i] = bfr(y1 * sn + y2 * c); }
            _Pragma("unroll") for (int d = 0; d < 32; ++d) o[d] = 0.f;
            float m = -1e30f, lsum = 0.f;
            for (int key = 0; key < SEQ; ++key) { const size_t kt = (size_t)b * SEQ + key; float sc = 0.f;
                _Pragma("unroll") for (int d = 0; d < 64; ++d) sc += q[d] * bfv(kvc + kt * 512 + h * 128 + d);
                _Pragma("unroll") for (int d = 0; d < 32; ++d) sc += q[64 + d] * bfv(kr + kt * 32 + d);
                const float mn = fmaxf(m, sc), al = exp2f(m - mn), p = exp2f(sc - mn); m = mn; lsum = lsum * al + p;
                _Pragma("unroll") for (int d = 0; d < 32; ++d) o[d] = o[d] * al + p * bfv(kvc + kt * 512 + h * 128 + 64 + dofs + d); }
            bool bad = false; _Pragma("unroll") for (int d = 0; d < 32; ++d) bad |= !close_(bfv(yc + (size_t)t * 384 + h * 64 + dofs + d), o[d] / lsum, 0.03f, 0.003f);
            if (bad) DBG_FAIL(10);
        }
    }
    if (stage == 4) {
        const int n = h2 % 1024; float r = 0.f;
        { float a = 0.f; for (int k = 0; k < 384; ++k) a += bfv(ya + (size_t)t * 384 + k) * bfr(args.in[9][(size_t)k * 1024 + n]); r += a / (1.0f + expf(-bfv(hb + (size_t)t * DINP + H_GATE + n))); }
        { float a = 0.f; for (int k = 0; k < 384; ++k) a += bfv(yb + (size_t)t * 384 + k) * bfr(args.in[10][(size_t)k * 1024 + n]); r += a / (1.0f + expf(-bfv(hb + (size_t)t * DINP + H_GATE + 1024 + n))); }
        { float a = 0.f; for (int k = 0; k < 256; ++k) a += bfv(yc + (size_t)t * 384 + k) * bfr(args.in[11][(size_t)k * 1024 + n]); r += a / (1.0f + expf(-bfv(hb + (size_t)t * DINP + H_GATE + 2048 + n))); }
        if (!close_(bfv((const bf16*)(a2 + A2_MIXED) + (size_t)t * 1024 + n), r, 0.02f, 0.003f)) DBG_FAIL(11);
    }
    if (stage == 5) {
        const int n = h2 % 1024; float r = 0.f; const bf16* mx = (const bf16*)(a2 + A2_MIXED) + (size_t)t * 1024;
        for (int k = 0; k < 1024; ++k) r += bfv(mx + k) * bfr(args.in[12][(size_t)k * 1024 + n]);
        if (!close_(bfv((const bf16*)(ws + WS_X1) + (size_t)t * D + n), r, 0.02f, 0.002f)) DBG_FAIL(12);
    }
    if (stage == 6) {
        const bf16* x1 = (const bf16*)(ws + WS_X1B) + (size_t)t * D; const int* tok_e = (const int*)(ws + WS_TE); const int* tok_r = (const int*)(ws + WS_TR);
        const int* list_t = (const int*)(ws + WS_LT); const float* list_g = (const float*)(ws + WS_LG);
        float lg[32]; _Pragma("unroll") for (int e = 0; e < 32; ++e) lg[e] = args.in[16][e];
        for (int k = 0; k < 1024; ++k) { const float xv = bfv(x1 + k); _Pragma("unroll") for (int e = 0; e < 32; ++e) lg[e] += xv * args.in[15][(size_t)k * 32 + e]; }
        int se[4]; float sv[4]; unsigned used = 0;
        _Pragma("unroll") for (int r = 0; r < 4; ++r) { int be = -1; float bv = -INFINITY; _Pragma("unroll") for (int e = 0; e < 32; ++e) if (!((used >> e) & 1) && lg[e] > bv) { bv = lg[e]; be = e; } se[r] = be; sv[r] = bv; used |= 1u << be; }
        float fifth = -INFINITY; _Pragma("unroll") for (int e = 0; e < 32; ++e) if (!((used >> e) & 1)) fifth = fmaxf(fifth, lg[e]);
        const bool neartie = (sv[3] - fifth) < 3e-2f || (sv[0] - sv[1]) < 3e-2f || (sv[1] - sv[2]) < 3e-2f || (sv[2] - sv[3]) < 3e-2f;
        float den = 0.f; _Pragma("unroll") for (int r = 0; r < 4; ++r) den += expf(sv[r] - sv[0]);
        bool bad = false, badg = false;
        if (!neartie) _Pragma("unroll") for (int r = 0; r < 4; ++r) { const int e = tok_e[t * 4 + r], rk = tok_r[t * 4 + r]; if (e != se[r]) { bad = true; continue; }
            if (rk < 0 || rk >= LCAP || list_t[(size_t)e * LCAP + rk] != t) badg = true; else if (!close_(list_g[(size_t)e * LCAP + rk], expf(sv[r] - sv[0]) / den, 0.03f, 1e-3f)) badg = true; }
        if (bad) DBG_FAIL(13); if (badg) DBG_FAIL(14);
        { float sm = 0.f, sq = 0.f; for (int k = 0; k < 1024; ++k) { const float z = (bfv(x1 + k) - args.in[14][k]) / args.in[13][k]; sm += z; sq += z * z; }
          if (fabsf(sm / 1024.f) > 4e-3f || fabsf(sq / 1024.f - 1.0f) > 2e-2f) DBG_FAIL(19); }
    }
    if (stage >= 7 && stage <= 9) {
        __shared__ int st[33], cn[32];
        if (threadIdx.x == 0) { int a = 0; for (int e2 = 0; e2 < 32; ++e2) { cn[e2] = (int)((const unsigned*)(ws + WS_CTL))[CW_CNT + 64 * l + e2]; st[e2] = a; a += ((cn[e2] + 255) >> 8) << 8; } st[32] = a; }
        __syncthreads();
        const int total = st[32]; const int sl = h1 % total; int e = 0; for (int k = 1; k < 32; ++k) if (sl >= st[k]) e = k; const int r = sl - st[e];
        const int* list_t = (const int*)(ws + WS_LT); const float* list_g = (const float*)(ws + WS_LG); const float* sg = (const float*)(ws + WS_SG);
        if (stage == 7) { int sum = 0; for (int k = 0; k < 32; ++k) sum += cn[k]; if (sum != TK) DBG_FAIL(15); }
        if (stage == 7 && r < cn[e]) {
            const bf16* xg = (const bf16*)(ws + WS_X1B) + (size_t)list_t[(size_t)e * LCAP + r] * D; const int f = h2 % 1024; const float* W = args.in[17] + (size_t)e * 1024 * 2048;
            float g = args.in[18][e * 2048 + f], u = args.in[18][e * 2048 + 1024 + f];
            for (int k = 0; k < 1024; ++k) { const float xv = bfv(xg + k); g += xv * bfr(W[(size_t)k * 2048 + f]); u += xv * bfr(W[(size_t)k * 2048 + 1024 + f]); }
            g = fminf(g, 7.0f); u = fminf(fmaxf(u, -7.0f), 7.0f); const float ref = g / (1.0f + expf(-1.702f * g)) * (u + 1.0f);
            if (!close_(bfv((const bf16*)(ws + WS_A2) + (size_t)sl * 1024 + f), ref, 0.03f, 0.02f)) DBG_FAIL(16);
        }
        if (stage == 8 && r < cn[e]) {
            const bf16* ab = (const bf16*)(ws + WS_A2) + (size_t)sl * 1024; const int n = h2 % 1024; const float* W = args.in[19] + (size_t)e * 1024 * 1024;
            float y = args.in[20][e * 1024 + n]; for (int k = 0; k < 1024; ++k) y += bfv(ab + k) * bfr(W[(size_t)k * 1024 + n]);
            y *= list_g[(size_t)e * LCAP + r];
            if (!close_(bfv((const bf16*)(ws + WS_H) + (size_t)sl * 1024 + n), y, 0.03f, 0.005f)) DBG_FAIL(17);
        }
        if (stage == 9) {
            const bf16* x1 = (const bf16*)(ws + WS_X1B) + (size_t)t * D; const int* tok_e = (const int*)(ws + WS_TE); const int* tok_r = (const int*)(ws + WS_TR);
            const bf16* ybf = (const bf16*)(ws + WS_H); float sm = 0.f, sq = 0.f; const int n = h2 % 1024; float vn = 0.f;
            for (int k = 0; k < 1024; ++k) { float v = DN_ALPHA * bfv(x1 + k); for (int q = 0; q < 4; ++q) v += bfv(ybf + (size_t)(st[tok_e[t * 4 + q]] + tok_r[t * 4 + q]) * D + k); sm += v; sq += v * v; if (k == n) vn = v; }
            const float mean = sm / 1024.f, var = sq / 1024.f - mean * mean; const float ref = (vn - mean) / sqrtf(var + LN_EPS) * args.in[21][n] + args.in[22][n];
            if (!close_(bfv((const bf16*)(ws + WS_XB) + (size_t)t * D + n), ref, 0.01f, 0.01f)) DBG_FAIL(18);
        }
    }
}
static void dbg_launch(int stage, const Args& a, hipStream_t stream) {
    switch (stage) {
#define DBGL(k) case k: hipLaunchKernelGGL(dbg_kernel<k>, dim3(8), dim3(256), 0, stream, a); break;
        DBGL(0) DBGL(1) DBGL(2) DBGL(3) DBGL(4) DBGL(5) DBGL(6) DBGL(7) DBGL(8) DBGL(9)
#undef DBGL
    }
}
#endif

extern "C" void kernel_launch(void* const* d_in, const int* in_sizes, int n_in, void* d_out, int out_size, void* d_ws, size_t ws_size, hipStream_t stream) {
    static int grid = 0;
    if (grid == 0) {
        if (n_in != 23 || in_sizes[0] != T * D || out_size != T * D || ws_size < WS_END) { fprintf(stderr, "kernel_launch: unexpected shapes / workspace (%d inputs, ws %zu, need %zu)\n", n_in, ws_size, (size_t)WS_END); grid = -1; return; }
        int dev = 0, cus = 0, per_cu = 0;
        if (hipGetDevice(&dev) != hipSuccess || hipDeviceGetAttribute(&cus, hipDeviceAttributeMultiprocessorCount, dev) != hipSuccess) { grid = -1; return; }
        if (hipFuncSetAttribute((const void*)mk_fwd, hipFuncAttributeMaxDynamicSharedMemorySize, LDS_BYTES) != hipSuccess) { fprintf(stderr, "kernel_launch: hipFuncSetAttribute failed\n"); grid = -1; return; }
        if (hipOccupancyMaxActiveBlocksPerMultiprocessor(&per_cu, (const void*)mk_fwd, NWAVES * 64, LDS_BYTES) != hipSuccess || per_cu < 1) { fprintf(stderr, "kernel_launch: occupancy query reports %d\n", per_cu); }
        (void)hipGetLastError();
        grid = cus;
    }
    if (grid < 0) return;
    if (hipMemsetAsync((char*)d_ws + WS_CTL, 0, CTL_ZERO_BYTES, stream) != hipSuccess) return;
    Args a{};
    for (int i = 0; i < 23; ++i) a.in[i] = (const float*)d_in[i];
    a.out = (float*)d_out; a.ws = (unsigned char*)d_ws; a.pad = 0;
#if MK_ONE_LAUNCH
    a.ph_lo = 0; a.ph_hi = NPH; a.use_bar = 1;
    hipLaunchKernelGGL(mk_fwd, dim3(grid), dim3(NWAVES * 64), LDS_BYTES, stream, a);
#else
    for (int p = 0; p < NPH; ++p) { a.ph_lo = p; a.ph_hi = p + 1; a.use_bar = 0; hipLaunchKernelGGL(mk_fwd, dim3(grid), dim3(NWAVES * 64), LDS_BYTES, stream, a);
#if MK_DEBUG
        if (p >= 1 && p <= PPL) dbg_launch(p - 1, a, stream);
#endif
    }
#endif
    const hipError_t le = hipPeekAtLastError();
    if (le != hipSuccess) fprintf(stderr, "kernel_launch: launch failed: %s\n", hipGetErrorName(le));
}
```

```cpp
#define MK_DEBUG 0
#define MK_ONE_LAUNCH 1
#ifndef MK_KVC_BF16
#define MK_KVC_BF16 MK_DEBUG
#endif
#ifndef MK_E8
#define MK_E8 (!MK_DEBUG)
#endif
#ifndef MK_OUT8
#define MK_OUT8 1
#endif
#ifndef MK_Y8
#define MK_Y8 1
#endif
#ifndef MK_GATE_EXP
#define MK_GATE_EXP (!MK_DEBUG)
#endif
#ifndef MK_FP8_QK
#define MK_FP8_QK 1
#endif
#ifndef MK_FP8_PV
#define MK_FP8_PV 1
#endif
#include <hip/hip_runtime.h>
#include <hip/hip_bf16.h>
#include <cstdio>
#include <cstdint>
namespace pg8 {
#define PG8_LAS __attribute__((address_space(3)))
typedef unsigned short bf16_t;
typedef short bf16x8 __attribute__((ext_vector_type(8)));
typedef float f32x4 __attribute__((ext_vector_type(4)));
typedef unsigned u32x4 __attribute__((ext_vector_type(4)));
constexpr int BM = 256, BK = 64, HALF = 128, HTB = HALF * BK * 2  , STAGE_BYTES = 8 * HTB, NXCD = 8, WGM = 8;

__host__ __device__ __forceinline__ int lds_byte(int r, int c) { const int st = (r >> 4) * 2 + (c >> 5), rr = r & 15, cc = c & 31, ob = rr * 64 + cc * 2; return st * 1024 + (ob ^ (((ob >> 9) & 1) << 5)); }
__host__ __device__ __forceinline__ void stage_rc(int b, int& R, int& C) { const int st = b / 1024, sb = b % 1024, swz = sb ^ (((sb >> 9) & 1) << 5); R = (st >> 1) * 16 + swz / 64; C = (st & 1) * 32 + (swz % 64) / 2; }
__host__ __device__ __forceinline__ int perm32(int rho) { const int n = rho >> 4, i = rho & 15; return 8 * (i >> 2) + 4 * n + (i & 3); }

struct Unit { int pm, pn, e; };
struct Gemm { const bf16_t* A; const bf16_t* Bt; int M, N, K; size_t bstride; size_t astride; const void* base; int ktrim; };

struct StaticOrder {
    int nM, nN, nwg, G, c;
    __host__ __device__ void init(int M, int N, int G_, int c_) { nM = M / BM; nN = N / BM; nwg = nM * nN; G = G_; c = c_; }
    __host__ __device__ bool next(int i, Unit& u) const {
        const long L = (long)i * G + c; if (L >= nwg) return false;
        int wgid = (int)L; { const int q = nwg / NXCD, r = nwg % NXCD, xcd = wgid % NXCD, off = wgid / NXCD; wgid = (xcd < r ? xcd * (q + 1) : r * (q + 1) + (xcd - r) * q) + off; }
        const int nig = WGM * nN, gid = wgid / nig, fm = gid * WGM, gsz = (nM - fm) < WGM ? (nM - fm) : WGM;
        u.pm = fm + ((wgid % nig) % gsz); u.pn = (wgid % nig) / gsz; u.e = 0; return true;
    }
    __device__ __forceinline__ void a_ready(const Unit&) const {}
    __device__ __forceinline__ void done(const Unit&) const {}
};

__device__ __forceinline__ unsigned cvt_pk_bf16(float lo, float hi) { unsigned r; asm volatile("v_cvt_pk_bf16_f32 %0, %1, %2" : "=v"(r) : "v"(lo), "v"(hi)); return r; }
typedef float f32x2 __attribute__((ext_vector_type(2)));


__device__ __forceinline__ float bf_lo(unsigned w) { return __uint_as_float(w << 16); }
__device__ __forceinline__ float bf_hi(unsigned w) { return __uint_as_float(w & 0xffff0000u); }
__device__ __forceinline__ float sigmoidf_(float z) { return __builtin_amdgcn_rcpf(1.0f + __builtin_amdgcn_exp2f(-1.4426950408889634f * z)); }
__device__ __forceinline__ u32x4 pack8(const f32x4& v0, const f32x4& v1) { u32x4 w; w.x = cvt_pk_bf16(v0[0], v0[1]); w.y = cvt_pk_bf16(v0[2], v0[3]); w.z = cvt_pk_bf16(v1[0], v1[1]); w.w = cvt_pk_bf16(v1[2], v1[3]); return w; }
__device__ __forceinline__ float sat8(float v) { return __builtin_amdgcn_fmed3f(v, -448.0f, 448.0f); }
__device__ __forceinline__ unsigned pk4_fp8(float a, float b, float c, float d) { int r = __builtin_amdgcn_cvt_pk_fp8_f32(sat8(a), sat8(b), 0, false); r = __builtin_amdgcn_cvt_pk_fp8_f32(sat8(c), sat8(d), r, true); return (unsigned)r; }

#ifndef EPI_NT_DN
#define EPI_NT_DN 0
#endif
#ifndef EPI_NT_GU
#define EPI_NT_GU 0
#endif
#ifndef EPI_NT
#define EPI_NT 1
#endif
struct EpiStore {
    static constexpr bool PERM = true, AFTER_DRAIN = false, CHAIN = false, BUFSTAGE = true; static constexpr int PRE = 0;
    bf16_t* O; int ldc; int nvalid; float ascale;
    __device__ __forceinline__ void operator()(const f32x4 (&acc)[2][2][4][2], const Unit& u, int wr, int wc, int fr_in, int fq_in) const {
        int ln_; asm volatile("v_mbcnt_lo_u32_b32 %0, -1, 0\n\tv_mbcnt_hi_u32_b32 %0, -1, %0" : "=v"(ln_)); const int fr = ln_ & 15, fq = ln_ >> 4; (void)fr_in; (void)fq_in;
        const int row0 = u.pm * BM + wr * 64 + fr, col0 = u.pn * BM + wc * 32 + 8 * fq;
#pragma unroll
        for (int ai = 0; ai < 2; ++ai)
#pragma unroll
            for (int m = 0; m < 4; ++m) { bf16_t* rowp = O + (size_t)(row0 + ai * HALF + m * 16) * ldc + col0;
#pragma unroll
                for (int bj = 0; bj < 2; ++bj) { if (col0 + bj * HALF < nvalid) *(u32x4*)(rowp + bj * HALF) = pack8(acc[ai][bj][m][0] * ascale, acc[ai][bj][m][1] * ascale); } }
    }
};
struct EpiStoreF8 {
    static constexpr bool PERM = true, AFTER_DRAIN = false, CHAIN = false, BUFSTAGE = true; static constexpr int PRE = 0;
    unsigned char* O8; int ldc; float ascale;
    __device__ __forceinline__ void operator()(const f32x4 (&acc)[2][2][4][2], const Unit& u, int wr, int wc, int fr_in, int fq_in) const {
        int ln_; asm volatile("v_mbcnt_lo_u32_b32 %0, -1, 0\n\tv_mbcnt_hi_u32_b32 %0, -1, %0" : "=v"(ln_)); const int fr = ln_ & 15, fq = ln_ >> 4; (void)fr_in; (void)fq_in;
        const int row0 = u.pm * BM + wr * 64 + fr, col0 = u.pn * BM + wc * 32 + 8 * fq; typedef unsigned u32x2 __attribute__((ext_vector_type(2)));
#pragma unroll
        for (int ai = 0; ai < 2; ++ai)
#pragma unroll
            for (int m = 0; m < 4; ++m) { unsigned char* rowp = O8 + (size_t)(row0 + ai * HALF + m * 16) * ldc + col0;
#pragma unroll
                for (int bj = 0; bj < 2; ++bj) { const f32x4 v0 = acc[ai][bj][m][0] * ascale, v1 = acc[ai][bj][m][1] * ascale;
                    *(u32x2*)(rowp + bj * HALF) = (u32x2){pk4_fp8(v0[0], v0[1], v0[2], v0[3]), pk4_fp8(v1[0], v1[1], v1[2], v1[3])}; } }
    }
};
struct EpiStoreGE {
    static constexpr bool PERM = true, AFTER_DRAIN = false, CHAIN = false, BUFSTAGE = true; static constexpr int PRE = 0;
    bf16_t* O; int ldc; int nvalid; float ascale; int gcol0;
    __device__ __forceinline__ void operator()(const f32x4 (&acc)[2][2][4][2], const Unit& u, int wr, int wc, int fr_in, int fq_in) const {
        int ln_; asm volatile("v_mbcnt_lo_u32_b32 %0, -1, 0\n\tv_mbcnt_hi_u32_b32 %0, -1, %0" : "=v"(ln_)); const int fr = ln_ & 15, fq = ln_ >> 4; (void)fr_in; (void)fq_in;
        const int row0 = u.pm * BM + wr * 64 + fr, col0 = u.pn * BM + wc * 32 + 8 * fq; const float sx = -1.4426950408889634f * ascale;
#pragma unroll
        for (int ai = 0; ai < 2; ++ai)
#pragma unroll
            for (int m = 0; m < 4; ++m) { bf16_t* rowp = O + (size_t)(row0 + ai * HALF + m * 16) * ldc + col0;
#pragma unroll
                for (int bj = 0; bj < 2; ++bj) { const int gc = col0 + bj * HALF - gcol0;
                    if (col0 + bj * HALF < nvalid) { f32x4 v0 = acc[ai][bj][m][0] * ascale, v1 = acc[ai][bj][m][1] * ascale;
                        if (gc >= 0 && gc < 3072) {
#pragma unroll
                            for (int q = 0; q < 4; ++q) { v0[q] = __builtin_amdgcn_exp2f(__builtin_amdgcn_fmed3f(acc[ai][bj][m][0][q] * sx, -115.0f, 115.0f)); v1[q] = __builtin_amdgcn_exp2f(__builtin_amdgcn_fmed3f(acc[ai][bj][m][1][q] * sx, -115.0f, 115.0f)); } }
                        *(u32x4*)(rowp + bj * HALF) = pack8(v0, v1); } } }
    }
};
struct EpiStoreV8 {
    static constexpr bool PERM = true, AFTER_DRAIN = false, CHAIN = false, BUFSTAGE = true; static constexpr int PRE = 0;
    bf16_t* O; unsigned char* vt8; unsigned char* k8m;
    __device__ __forceinline__ void operator()(const f32x4 (&acc)[2][2][4][2], const Unit& u, int wr, int wc, int fr_in, int fq_in) const {
        int ln_; asm volatile("v_mbcnt_lo_u32_b32 %0, -1, 0\n\tv_mbcnt_hi_u32_b32 %0, -1, %0" : "=v"(ln_)); const int fr = ln_ & 15, fq = ln_ >> 4; (void)fr_in; (void)fq_in;
        const int row0 = u.pm * BM + wr * 64 + fr, col0 = u.pn * BM + wc * 32 + 8 * fq;
#pragma unroll
        for (int ai = 0; ai < 2; ++ai)
#pragma unroll
            for (int m = 0; m < 4; ++m) { const int row = row0 + ai * HALF + m * 16; bf16_t* rowp = O + (size_t)row * 512 + col0;
                const int s_ = row & 8191, bb = row >> 13, kk = s_ & 63, k5 = kk & 31, pos = 32 * ((k5 >> 2) & 1) + (kk >> 5) * 16 + (k5 & 3) + 4 * (k5 >> 3);
#pragma unroll
                for (int bj = 0; bj < 2; ++bj) {
#if MK_KVC_BF16
                    *(u32x4*)(rowp + bj * HALF) = pack8(acc[ai][bj][m][0], acc[ai][bj][m][1]);
#else
                    (void)rowp;
#endif
                    if (wc < 2) { typedef unsigned u32x2 __attribute__((ext_vector_type(2)));
                        *(u32x2*)(k8m + (size_t)row * 256 + (u.pn * 2 + bj) * 64 + wc * 32 + 8 * fq) = (u32x2){pk4_fp8(acc[ai][bj][m][0][0], acc[ai][bj][m][0][1], acc[ai][bj][m][0][2], acc[ai][bj][m][0][3]), pk4_fp8(acc[ai][bj][m][1][0], acc[ai][bj][m][1][1], acc[ai][bj][m][1][2], acc[ai][bj][m][1][3])}; }
                    if (wc >= 2) {
                        unsigned char* bp = vt8 + ((size_t)((bb * 4 + u.pn * 2 + bj) * 128 + (s_ >> 6)) * 64 + (wc - 2) * 32 + 8 * fq) * 64 + pos;
#pragma unroll
                        for (int n = 0; n < 2; ++n) { const unsigned w0 = (unsigned)__builtin_amdgcn_cvt_pk_bf8_f32(acc[ai][bj][m][n][0], acc[ai][bj][m][n][1], 0, false), w1 = (unsigned)__builtin_amdgcn_cvt_pk_bf8_f32(acc[ai][bj][m][n][2], acc[ai][bj][m][n][3], 0, false);
                            bp[(4 * n + 0) * 64] = (unsigned char)(w0 & 0xffu); bp[(4 * n + 1) * 64] = (unsigned char)((w0 >> 8) & 0xffu); bp[(4 * n + 2) * 64] = (unsigned char)(w1 & 0xffu); bp[(4 * n + 3) * 64] = (unsigned char)((w1 >> 8) & 0xffu); } } } }
    }
};
struct EpiGateChain {
    static constexpr bool PERM = true, AFTER_DRAIN = false, CHAIN = true, BUFSTAGE = true; static constexpr int PRE = 0;
    const bf16_t* gate; int ldg; void* mixed; float oscale;
    __device__ __forceinline__ void chain(f32x4 (&acc)[2][2][4][2], const Unit& u, int wr, int wc, int fr_in, int fq_in) const {
        int ln_; asm volatile("v_mbcnt_lo_u32_b32 %0, -1, 0\n\tv_mbcnt_hi_u32_b32 %0, -1, %0" : "=v"(ln_)); const int fr = ln_ & 15, fq = ln_ >> 4; (void)fr_in; (void)fq_in;
        const int row0 = u.pm * BM + wr * 64 + fr, col0 = u.pn * BM + wc * 32 + 8 * fq;
        const int eb = u.e < 2 ? u.e + 1 : u.e;
#pragma unroll
        for (int ai = 0; ai < 2; ++ai) {
            u32x4 ga[4][2], gb[4][2];
#pragma unroll
            for (int m = 0; m < 4; ++m) { const size_t row = (size_t)(row0 + ai * HALF + m * 16);
#pragma unroll
                for (int bj = 0; bj < 2; ++bj) { const int col = col0 + bj * HALF;
                    ga[m][bj] = *(const u32x4*)(gate + row * ldg + u.e * 1024 + col); gb[m][bj] = *(const u32x4*)(gate + row * ldg + eb * 1024 + col); } }
#pragma unroll
            for (int m = 0; m < 4; ++m) { const size_t row = (size_t)(row0 + ai * HALF + m * 16);
#pragma unroll
                for (int bj = 0; bj < 2; ++bj) { const int col = col0 + bj * HALF; const u32x4 a_ = ga[m][bj], b_ = gb[m][bj];
#if MK_GATE_EXP
                    const f32x4 na0 = {1.f + bf_lo(a_.x), 1.f + bf_hi(a_.x), 1.f + bf_lo(a_.y), 1.f + bf_hi(a_.y)}, na1 = {1.f + bf_lo(a_.z), 1.f + bf_hi(a_.z), 1.f + bf_lo(a_.w), 1.f + bf_hi(a_.w)};
                    f32x4 f0, f1;
#pragma unroll
                    for (int q = 0; q < 4; ++q) { f0[q] = __builtin_amdgcn_rcpf(na0[q]); f1[q] = __builtin_amdgcn_rcpf(na1[q]); }
                    if (u.e < 2) { f0 *= (f32x4){1.f + bf_lo(b_.x), 1.f + bf_hi(b_.x), 1.f + bf_lo(b_.y), 1.f + bf_hi(b_.y)}; f1 *= (f32x4){1.f + bf_lo(b_.z), 1.f + bf_hi(b_.z), 1.f + bf_lo(b_.w), 1.f + bf_hi(b_.w)}; }
#else
                    f32x4 na0 = {1.f + __builtin_amdgcn_exp2f(-1.4426950408889634f * bf_lo(a_.x)), 1.f + __builtin_amdgcn_exp2f(-1.4426950408889634f * bf_hi(a_.x)), 1.f + __builtin_amdgcn_exp2f(-1.4426950408889634f * bf_lo(a_.y)), 1.f + __builtin_amdgcn_exp2f(-1.4426950408889634f * bf_hi(a_.y))};
                    f32x4 na1 = {1.f + __builtin_amdgcn_exp2f(-1.4426950408889634f * bf_lo(a_.z)), 1.f + __builtin_amdgcn_exp2f(-1.4426950408889634f * bf_hi(a_.z)), 1.f + __builtin_amdgcn_exp2f(-1.4426950408889634f * bf_lo(a_.w)), 1.f + __builtin_amdgcn_exp2f(-1.4426950408889634f * bf_hi(a_.w))};
                    f32x4 f0, f1;
#pragma unroll
                    for (int q = 0; q < 4; ++q) { f0[q] = __builtin_amdgcn_rcpf(na0[q]); f1[q] = __builtin_amdgcn_rcpf(na1[q]); }
                    if (u.e < 2) {
                        f0[0] *= 1.f + __builtin_amdgcn_exp2f(-1.4426950408889634f * bf_lo(b_.x)); f0[1] *= 1.f + __builtin_amdgcn_exp2f(-1.4426950408889634f * bf_hi(b_.x));
                        f0[2] *= 1.f + __builtin_amdgcn_exp2f(-1.4426950408889634f * bf_lo(b_.y)); f0[3] *= 1.f + __builtin_amdgcn_exp2f(-1.4426950408889634f * bf_hi(b_.y));
                        f1[0] *= 1.f + __builtin_amdgcn_exp2f(-1.4426950408889634f * bf_lo(b_.z)); f1[1] *= 1.f + __builtin_amdgcn_exp2f(-1.4426950408889634f * bf_hi(b_.z));
                        f1[2] *= 1.f + __builtin_amdgcn_exp2f(-1.4426950408889634f * bf_lo(b_.w)); f1[3] *= 1.f + __builtin_amdgcn_exp2f(-1.4426950408889634f * bf_hi(b_.w)); }
#endif
                    acc[ai][bj][m][0] *= f0; acc[ai][bj][m][1] *= f1;
                    if (u.e == 2) { if (oscale == 0.f) *(u32x4*)((bf16_t*)mixed + row * 1024 + col) = pack8(acc[ai][bj][m][0], acc[ai][bj][m][1]);
                        else { typedef unsigned u32x2 __attribute__((ext_vector_type(2))); const f32x4 a0 = acc[ai][bj][m][0] * oscale, a1 = acc[ai][bj][m][1] * oscale;
                            *(u32x2*)((unsigned char*)mixed + row * 1024 + col) = (u32x2){pk4_fp8(a0[0], a0[1], a0[2], a0[3]), pk4_fp8(a1[0], a1[1], a1[2], a1[3])}; } } } } }
    }
};
struct ChainOrder {
    StaticOrder so; int nch;
    __device__ __forceinline__ bool next(int i, Unit& u) const { const int t = i / nch; if (!so.next(t, u)) return false; u.e = i - t * nch; return true; }
    __device__ __forceinline__ void a_ready(const Unit&) const {}
    __device__ __forceinline__ void done(const Unit&) const {}
};
struct EpiResid {
    static constexpr bool PERM = true, AFTER_DRAIN = false, CHAIN = false, BUFSTAGE = false; static constexpr int PRE = 0;
    const float* x; float* pre; float alpha;
    __device__ __forceinline__ void operator()(const f32x4 (&acc)[2][2][4][2], const Unit& u, int wr, int wc, int fr, int fq) const {
        const int row0 = u.pm * BM + wr * 64 + fr, col0 = u.pn * BM + wc * 32 + 8 * fq;
#pragma unroll
        for (int ai = 0; ai < 2; ++ai)
#pragma unroll
            for (int m = 0; m < 4; ++m) { const size_t row = (size_t)(row0 + ai * HALF + m * 16);
#pragma unroll
                for (int bj = 0; bj < 2; ++bj) { const size_t off = row * 1024 + col0 + bj * HALF;
                    const f32x4 x0 = *(const f32x4*)(x + off), x1 = *(const f32x4*)(x + off + 4);
                    *(f32x4*)(pre + off) = x0 * alpha + acc[ai][bj][m][0]; *(f32x4*)(pre + off + 4) = x1 * alpha + acc[ai][bj][m][1]; } }
    }
};
template <bool OUT8> struct EpiSwigluT {
    static constexpr bool PERM = true, AFTER_DRAIN = false, CHAIN = false, BUFSTAGE = false; static constexpr int PRE = 1;
    __device__ __forceinline__ const char* pre_src(const Unit& u, int, int lane) const { return (const char*)(bias + (size_t)u.e * 2048 + (lane >> 5) * 1024 + u.pn * HALF + (lane & 31) * 4); }
    __device__ __forceinline__ void pre(const f32x4 (&acc)[2][2][4][2], const Unit& u, int wr, int wc, int fr, int fq, const PG8_LAS unsigned char* pl) const { run<true>(acc, u, wr, wc, fr, fq, pl); }
    __device__ __forceinline__ void operator()(const f32x4 (&acc)[2][2][4][2], const Unit& u, int wr, int wc, int fr, int fq) const { run<false>(acc, u, wr, wc, fr, fq, nullptr); }
    void* a; const float* bias; float ascale, oscale;
    template <bool FROM_LDS> __device__ __forceinline__ void run(const f32x4 (&acc)[2][2][4][2], const Unit& u, int wr, int wc, int fr, int fq, const PG8_LAS unsigned char* pl) const {
        const int row0 = u.pm * BM + wr * 64 + fr, j0 = wc * 32 + 8 * fq, oc = u.pn * HALF + j0;
        f32x4 bg0, bg1, bu0, bu1;
        if constexpr (FROM_LDS) { const PG8_LAS float* pb = (const PG8_LAS float*)pl + j0; bg0 = *(const PG8_LAS f32x4*)pb; bg1 = *(const PG8_LAS f32x4*)(pb + 4); bu0 = *(const PG8_LAS f32x4*)(pb + 128); bu1 = *(const PG8_LAS f32x4*)(pb + 132); }
        else { const float* bg = bias + (size_t)u.e * 2048 + oc; const float* bu = bg + 1024; bg0 = *(const f32x4*)bg; bg1 = *(const f32x4*)(bg + 4); bu0 = *(const f32x4*)bu; bu1 = *(const f32x4*)(bu + 4); }
#pragma unroll
        for (int ai = 0; ai < 2; ++ai)
#pragma unroll
            for (int m = 0; m < 4; ++m) { const size_t row = (size_t)(row0 + ai * HALF + m * 16);
                f32x4 g[2] = {acc[ai][0][m][0] * ascale + bg0, acc[ai][0][m][1] * ascale + bg1}, uu[2] = {acc[ai][1][m][0] * ascale + bu0, acc[ai][1][m][1] * ascale + bu1}, r[2];
#pragma unroll
                for (int n = 0; n < 2; ++n)
#pragma unroll
                    for (int q = 0; q < 4; ++q) { const float gg = fminf(g[n][q], 7.0f), uc = fminf(fmaxf(uu[n][q], -7.0f), 7.0f);
                        r[n][q] = gg * sigmoidf_(1.702f * gg) * (uc + 1.0f); }
                if constexpr (OUT8) { typedef unsigned u32x2 __attribute__((ext_vector_type(2)));
                    const u32x2 w_ = (u32x2){pk4_fp8(r[0][0] * oscale, r[0][1] * oscale, r[0][2] * oscale, r[0][3] * oscale), pk4_fp8(r[1][0] * oscale, r[1][1] * oscale, r[1][2] * oscale, r[1][3] * oscale)};
#if EPI_NT_GU
                    __builtin_nontemporal_store(w_, (u32x2*)((unsigned char*)a + row * 1024 + oc));
#else
                    *(u32x2*)((unsigned char*)a + row * 1024 + oc) = w_;
#endif
                }
                else *(u32x4*)((bf16_t*)a + row * 1024 + oc) = pack8(r[0], r[1]);
                asm volatile("" ::: "memory"); }
    }
};
struct EpiDown {
    static constexpr bool PERM = true, AFTER_DRAIN = false, CHAIN = false, BUFSTAGE = false; static constexpr int PRE = 2;
    __device__ __forceinline__ const char* pre_src(const Unit& u, int piece, int lane) const {
        return piece == 0 ? (const char*)(bias + (size_t)u.e * 1024 + u.pn * BM + lane * 4) : (const char*)(list_g + (size_t)u.e * lcap + (u.pm * BM - st[u.e]) + lane * 4); }
    __device__ __forceinline__ void pre(const f32x4 (&acc)[2][2][4][2], const Unit& u, int wr, int wc, int fr, int fq, const PG8_LAS unsigned char* pl) const { run<true>(acc, u, wr, wc, fr, fq, pl); }
    __device__ __forceinline__ void operator()(const f32x4 (&acc)[2][2][4][2], const Unit& u, int wr, int wc, int fr, int fq) const { run<false>(acc, u, wr, wc, fr, fq, nullptr); }
    bf16_t* y; const float* bias; const float* list_g; const PG8_LAS int* st; const PG8_LAS int* cn; int lcap; float ascale;
    template <bool FROM_LDS> __device__ __forceinline__ void run(const f32x4 (&acc)[2][2][4][2], const Unit& u, int wr, int wc, int fr, int fq, const PG8_LAS unsigned char* pl) const {
        const int row0 = u.pm * BM + wr * 64 + fr, col0 = u.pn * BM + wc * 32 + 8 * fq;
        const int st_e = st[u.e], cn_e = cn[u.e];
        f32x4 bv[2][2];
#pragma unroll
        for (int bj = 0; bj < 2; ++bj)
#pragma unroll
            for (int n = 0; n < 2; ++n) { if constexpr (FROM_LDS) bv[bj][n] = *(const PG8_LAS f32x4*)((const PG8_LAS float*)pl + wc * 32 + 8 * fq + bj * HALF + 4 * n); else bv[bj][n] = *(const f32x4*)(bias + (size_t)u.e * 1024 + col0 + bj * HALF + 4 * n); }
#pragma unroll
        for (int ai = 0; ai < 2; ++ai)
#pragma unroll
            for (int m = 0; m < 4; ++m) { const size_t row = (size_t)(row0 + ai * HALF + m * 16); const int rank = (int)row - st_e;
                float gt; if constexpr (FROM_LDS) { const float gl_ = ((const PG8_LAS float*)pl)[256 + wr * 64 + fr + ai * HALF + m * 16]; gt = rank < cn_e ? gl_ : 0.f; } else gt = rank < cn_e ? list_g[(size_t)u.e * lcap + rank] : 0.f;
#pragma unroll
                for (int bj = 0; bj < 2; ++bj) { const f32x4 v0 = (acc[ai][bj][m][0] * ascale + bv[bj][0]) * gt, v1 = (acc[ai][bj][m][1] * ascale + bv[bj][1]) * gt;
#if MK_Y8
                    if (ascale != 1.0f) { typedef unsigned u32x2 __attribute__((ext_vector_type(2)));
                        *(u32x2*)((unsigned char*)y + row * 1024 + col0 + bj * HALF) = (u32x2){pk4_fp8(v0[0] * 32.f, v0[1] * 32.f, v0[2] * 32.f, v0[3] * 32.f), pk4_fp8(v1[0] * 32.f, v1[1] * 32.f, v1[2] * 32.f, v1[3] * 32.f)}; }
                    else
#endif
                    *(u32x4*)(y + row * 1024 + col0 + bj * HALF) = pack8(v0, v1);
                } }
    }
};
struct MoeGather {
    const int* list_t; const PG8_LAS int* st; const PG8_LAS int* cn; int lcap;
    __device__ __forceinline__ const char* pre_src(const Unit& u, int lane) const { return (const char*)(list_t + (size_t)u.e * lcap + (u.pm * BM - st[u.e]) + lane * 4); }
    __device__ __forceinline__ int lim(const Unit& u) const { return cn[u.e] - 1 - (u.pm * BM - st[u.e]); }
    __device__ __forceinline__ int row(const Unit& u, int r) const { int rank = u.pm * BM + r - st[u.e]; const int c = cn[u.e]; rank = rank < c ? rank : c - 1; return list_t[(size_t)u.e * lcap + rank]; }
};
struct MoeOrder {
    int nN, nunits, G, c; const PG8_LAS int* tile_e;
    __device__ __forceinline__ bool next(int i, Unit& u) const {
        const long L = (long)i * G + c; if (L >= nunits) return false;
        const int tile = (int)L / nN; u.pm = tile; u.pn = (int)L % nN; u.e = __builtin_amdgcn_readfirstlane(tile_e[tile]); return true;
    }
    __device__ __forceinline__ void a_ready(const Unit&) const {}
    __device__ __forceinline__ void done(const Unit&) const {}
};

template <int ES> struct PtSel { typedef const char* T; static __device__ __forceinline__ T mk(const char* p, const char*) { return p; } };
template <> struct PtSel<1> { typedef unsigned T; static __device__ __forceinline__ T mk(const char* p, const char* base) { return (unsigned)(size_t)(p - base); } };
struct NoGather { };
typedef int i32x8 __attribute__((ext_vector_type(8)));
template <class Epi, class Sched, bool ALIGN_EPI = false, bool SP2 = false, bool GATHER = false, class GS = NoGather, int ESIZE = 2, int PROBE = 0>
__device__ __forceinline__ void gemm_phase(PG8_LAS unsigned char* lds, const Gemm g, const Sched& S, const Epi& E, const int tid, const GS gs = GS()) {
    const int wid = __builtin_amdgcn_readfirstlane(tid >> 6), lane = tid & 63, wr = wid >> 2, wc = wid & 3, fr = lane & 15, fq = lane >> 4;
    const int K = g.K * ESIZE / 2; int nt = K / BK - g.ktrim;
    if constexpr (ESIZE == 1) asm volatile("" : "+s"(nt));
    int sc8 = 0x7F7F7F7F; if constexpr (ESIZE == 1) asm volatile("" : "+v"(sc8));
    constexpr bool BUFS = (ESIZE == 1) || Epi::BUFSTAGE;
    typedef typename PtSel<BUFS ? 1 : 2>::T PT;
    __amdgpu_buffer_rsrc_t rsrc = __builtin_amdgcn_make_buffer_rsrc((void*)g.base, 0, 0x7fffffff, 0x00020000);
#define PG8_PT(p) PtSel<BUFS ? 1 : 2>::mk((const char*)(p), (const char*)g.base)
    unsigned voffA[2], voffB[2];
#pragma unroll
    for (int i = 0; i < 2; ++i) { int R, C; stage_rc(tid * 16 + i * 8192, R, C); const int Rb = Epi::PERM ? ((R & ~31) + perm32(R & 31)) : R;
        voffA[i] = (unsigned)(R * K + C) * 2u; voffB[i] = (unsigned)(Rb * K + C) * 2u; }
    unsigned vc0[2], vc1[2], vn0[2], vn1[2];
#define PG8_GROWS(u_, o0, o1) do { _Pragma("unroll") for (int i_ = 0; i_ < 2; ++i_) { int R_, C_; stage_rc(tid * 16 + i_ * 8192, R_, C_); \
        o0[i_] = (unsigned)gs.row((u_), R_) * (unsigned)(K * 2) + (unsigned)(C_ * 2); o1[i_] = (unsigned)gs.row((u_), HALF + R_) * (unsigned)(K * 2) + (unsigned)(C_ * 2); } } while (0)
#define PG8_GROWS_USE(o0, o1, b_) do { const PG8_LAS int* rw_ = (const PG8_LAS int*)(lds + STAGE_BYTES + (b_) * 2048 + Epi::PRE * 1024); const int lim_ = gs.lim(nxt); \
        _Pragma("unroll") for (int i_ = 0; i_ < 2; ++i_) { int R_, C_; stage_rc(tid * 16 + i_ * 8192, R_, C_); const int r0_ = rw_[R_ < lim_ ? R_ : lim_], r1_ = rw_[HALF + R_ < lim_ ? HALF + R_ : lim_]; \
        o0[i_] = (unsigned)r0_ * (unsigned)(K * 2) + (unsigned)(C_ * 2); o1[i_] = (unsigned)r1_ * (unsigned)(K * 2) + (unsigned)(C_ * 2); } } while (0)
    constexpr int PRE_OFF = STAGE_BYTES, PRE_BUF = 2048, EPRE = Epi::PRE;
    static_assert(EPRE + (GATHER ? 1 : 0) <= 2, "two pieces per unit");
#define PG8_PRE(u_, b_) do { if constexpr (EPRE > 0) { if (wid < EPRE) __builtin_amdgcn_global_load_lds((const unsigned*)E.pre_src((u_), wid, lane), (PG8_LAS unsigned*)(lds + PRE_OFF + (b_) * PRE_BUF + wid * 1024), 16, 0, 0); } \
        if constexpr (GATHER) { if (wid == EPRE) __builtin_amdgcn_global_load_lds((const unsigned*)gs.pre_src((u_), lane), (PG8_LAS unsigned*)(lds + PRE_OFF + (b_) * PRE_BUF + EPRE * 1024), 16, 0, 0); } } while (0)
    int pbuf = 0;
    const size_t kstep = (size_t)(BK * 2);
    const size_t hstep = (size_t)HALF * K * 2;
    const size_t tstep = 2 * hstep;
    const unsigned ldsw = (unsigned)wid * 1024u;
    const int aoff = lds_byte(wr * 64 + fr, fq * 8), boff = lds_byte(wc * 32 + fr, fq * 8);
#define PG8_SA(b, h) (((b) * 2 + (h)) * HTB)
#define PG8_SB(b, h) ((4 + (b) * 2 + (h)) * HTB)
#define PG8_STAGE(bufoff, gbase, voff) do { if constexpr (!(PROBE & 4)) _Pragma("unroll") for (int _i = 0; _i < 2; ++_i) { \
        if constexpr (!BUFS) __builtin_amdgcn_global_load_lds((const unsigned*)((const char*)(size_t)(gbase) + (voff)[_i]), (PG8_LAS unsigned*)(lds + (bufoff) + ldsw + _i * 8192), 16, 0, 0); \
        else __builtin_amdgcn_raw_ptr_buffer_load_lds(rsrc, (PG8_LAS void*)(lds + (bufoff) + ldsw + _i * 8192), 16, (int)(voff)[_i], (int)(size_t)(gbase), 0, 0); } } while (0)
typedef int i32x4_ __attribute__((ext_vector_type(4)));
#define PG8_LD8(off) __builtin_shufflevector(*(const PG8_LAS i32x4_*)(lds + (off)), *(const PG8_LAS i32x4_*)(lds + (off) + 1024), 0, 1, 2, 3, 4, 5, 6, 7)
#define PG8_LDA(dst, b, h) do { if constexpr (PROBE & 2) { } else if constexpr (ESIZE == 2) { _Pragma("unroll") for (int m = 0; m < 4; ++m) _Pragma("unroll") for (int k = 0; k < 2; ++k) dst[m][k] = *(const PG8_LAS bf16x8*)(lds + PG8_SA(b, h) + aoff + m * 2048 + k * 1024); } \
        else { _Pragma("unroll") for (int m = 0; m < 4; ++m) dst##8[m] = PG8_LD8(PG8_SA(b, h) + aoff + m * 2048); } } while (0)
#define PG8_LDB(dst, b, h) do { if constexpr (PROBE & 2) { } else if constexpr (ESIZE == 2) { _Pragma("unroll") for (int n = 0; n < 2; ++n) _Pragma("unroll") for (int k = 0; k < 2; ++k) dst[n][k] = *(const PG8_LAS bf16x8*)(lds + PG8_SB(b, h) + boff + n * 2048 + k * 1024); } \
        else { _Pragma("unroll") for (int n = 0; n < 2; ++n) dst##8[n] = PG8_LD8(PG8_SB(b, h) + boff + n * 2048); } } while (0)
#define PG8_F8CAT(x, y) (i32x8){((const int*)&(x))[0], ((const int*)&(x))[1], ((const int*)&(x))[2], ((const int*)&(x))[3], ((const int*)&(y))[0], ((const int*)&(y))[1], ((const int*)&(y))[2], ((const int*)&(y))[3]}
#define PG8_MMA(ai, bj, At, Bt) do { __builtin_amdgcn_s_setprio(1); if constexpr (PROBE & 1) { } else if constexpr (ESIZE == 2) { _Pragma("unroll") for (int m = 0; m < 4; ++m) _Pragma("unroll") for (int n = 0; n < 2; ++n) _Pragma("unroll") for (int k = 0; k < 2; ++k) \
        acc[ai][bj][m][n] = __builtin_amdgcn_mfma_f32_16x16x32_bf16(Bt[n][k], At[m][k], acc[ai][bj][m][n], 0, 0, 0); } \
        else { _Pragma("unroll") for (int m = 0; m < 4; ++m) _Pragma("unroll") for (int n = 0; n < 2; ++n) \
        asm volatile("v_mfma_scale_f32_16x16x128_f8f6f4 %0, %1, %2, %0, %3, %3 op_sel_hi:[0,0,0]" : "+v"(acc[ai][bj][m][n]) : "v"(Bt##8[n]), "v"(At##8[m]), "v"(sc8)); \
        }   \
        __builtin_amdgcn_s_setprio(0); } while (0)
#define PG8_WAIT_V(n) asm volatile("s_waitcnt vmcnt(" #n ")" ::: "memory")
#define PG8_WAIT_L(n) asm volatile("s_waitcnt lgkmcnt(" #n ")" ::: "memory")
#define PG8_BAR __builtin_amdgcn_s_barrier()
#define PG8_SCHED __builtin_amdgcn_sched_barrier(0)
    Unit cur, nxt; int ui = 0;
    if (!S.next(0, cur)) return;
    f32x4 acc[2][2][4][2];
#pragma unroll
    for (int a = 0; a < 2; ++a)
#pragma unroll
        for (int b = 0; b < 2; ++b)
#pragma unroll
            for (int m = 0; m < 4; ++m)
#pragma unroll
                for (int n = 0; n < 2; ++n) acc[a][b][m][n] = (f32x4){0.f, 0.f, 0.f, 0.f};
    bf16x8 At[4][2], B0[2][2], B1[2][2];
    i32x8 At8[4] = {}, B08[2] = {}, B18[2] = {};
    PT cA = PG8_PT(GATHER ? (const char*)g.A : (const char*)g.A + (size_t)cur.pm * tstep + (size_t)cur.e * g.astride);
    if constexpr (GATHER) { PG8_GROWS(cur, vc0, vc1); } else { _Pragma("unroll") for (int i = 0; i < 2; ++i) { vc0[i] = voffA[i]; vc1[i] = voffA[i] + (unsigned)hstep; } }
#pragma unroll
    for (int i = 0; i < 2; ++i) { vn0[i] = vc0[i]; vn1[i] = vc1[i]; }
    PT cB = PG8_PT((const char*)g.Bt + (size_t)cur.pn * tstep + (size_t)cur.e * g.bstride);
    S.a_ready(cur); PG8_PRE(cur, 0);
    if constexpr (SP2) {
        PG8_STAGE(PG8_SB(0, 0), cB, voffB); PG8_STAGE(PG8_SB(0, 1), cB + hstep, voffB); PG8_STAGE(PG8_SA(0, 0), cA, vc0); PG8_STAGE(PG8_SA(0, 1), cA, vc1);
        if (wr == 1) PG8_BAR;
        PG8_WAIT_V(2); PG8_BAR;
        PG8_STAGE(PG8_SB(1, 0), cB + kstep, voffB); PG8_STAGE(PG8_SA(1, 0), cA + kstep, vc0); PG8_STAGE(PG8_SB(1, 1), cB + hstep + kstep, voffB);
        PG8_WAIT_V(6); PG8_BAR;
    } else {
        PG8_STAGE(PG8_SB(0, 0), cB, voffB); PG8_STAGE(PG8_SA(0, 0), cA, vc0); PG8_STAGE(PG8_SB(0, 1), cB + hstep, voffB); PG8_STAGE(PG8_SA(0, 1), cA, vc1);
        if (wr == 1) PG8_BAR;
        PG8_WAIT_V(4); PG8_BAR;
        PG8_STAGE(PG8_SB(1, 0), cB + kstep, voffB); PG8_STAGE(PG8_SA(1, 0), cA + kstep, vc0); PG8_STAGE(PG8_SB(1, 1), cB + hstep + kstep, voffB);
        PG8_WAIT_V(6); PG8_BAR;
    }
    for (;;) {
        const bool has_next = S.next(ui + 1, nxt);
        const PT nA = GATHER ? cA : (has_next ? PG8_PT((const char*)g.A + (size_t)nxt.pm * tstep + (size_t)nxt.e * g.astride) : cA);
        const int nbuf = pbuf == 2 ? 0 : pbuf + 1; if (has_next) PG8_PRE(nxt, nbuf);
        const PT nB = has_next ? PG8_PT((const char*)g.Bt + (size_t)nxt.pn * tstep + (size_t)nxt.e * g.bstride) : cB;
        for (int t = 0; t < nt; t += 2) {
            const bool last = (t == nt - 2);
            const PT a1 = cA + (unsigned)((t + 1) * (int)kstep);
            const PT a2 = last ? nA : cA + (unsigned)((t + 2) * (int)kstep); const PT b2 = last ? nB : cB + (unsigned)((t + 2) * (int)kstep);
            const PT a3 = a2 + (unsigned)kstep; const PT b3 = b2 + (unsigned)kstep;
            if constexpr (GATHER) { if (last && has_next) { PG8_GROWS_USE(vn0, vn1, nbuf); } }
            unsigned vs0[2], vs1[2];
#pragma unroll
            for (int i = 0; i < 2; ++i) { vs0[i] = (GATHER && last) ? vn0[i] : vc0[i]; vs1[i] = (GATHER && last) ? vn1[i] : vc1[i]; }
            if (last && has_next) S.a_ready(nxt);
            if constexpr (SP2) {
            PG8_LDB(B0, 0, 0); PG8_LDB(B1, 0, 1); PG8_SCHED; PG8_LDA(At, 0, 0); PG8_STAGE(PG8_SA(1, 1), a1, vc1);
            PG8_WAIT_V(8); PG8_WAIT_L(0); PG8_BAR; PG8_MMA(0, 0, At, B0); PG8_MMA(0, 1, At, B1); PG8_BAR; PG8_SCHED;
            PG8_LDA(At, 0, 1); PG8_STAGE(PG8_SB(0, 0), b2, voffB); PG8_STAGE(PG8_SB(0, 1), b2 + hstep, voffB); PG8_STAGE(PG8_SA(0, 0), a2, vs0);
            PG8_WAIT_V(8); PG8_WAIT_L(0); PG8_BAR; PG8_MMA(1, 0, At, B0); PG8_MMA(1, 1, At, B1); PG8_BAR; PG8_SCHED;
            PG8_LDB(B0, 1, 0); PG8_LDB(B1, 1, 1); PG8_SCHED; PG8_LDA(At, 1, 0); PG8_STAGE(PG8_SA(0, 1), a2, vs1);
            PG8_WAIT_V(8); PG8_WAIT_L(0); PG8_BAR; PG8_MMA(0, 0, At, B0); PG8_MMA(0, 1, At, B1); PG8_BAR; PG8_SCHED;
            PG8_LDA(At, 1, 1); PG8_STAGE(PG8_SB(1, 0), b3, voffB); PG8_STAGE(PG8_SB(1, 1), b3 + hstep, voffB); PG8_STAGE(PG8_SA(1, 0), a3, vs0);
            PG8_WAIT_V(8); PG8_WAIT_L(0); PG8_BAR; PG8_MMA(1, 0, At, B0); PG8_MMA(1, 1, At, B1); PG8_BAR; PG8_SCHED;
            } else {
            PG8_LDB(B0, 0, 0); PG8_SCHED; PG8_LDA(At, 0, 0); PG8_STAGE(PG8_SA(1, 1), a1, vc1);
            PG8_WAIT_L(8); PG8_BAR; PG8_WAIT_L(0); PG8_MMA(0, 0, At, B0); PG8_BAR; PG8_SCHED;
            PG8_LDB(B1, 0, 1); PG8_STAGE(PG8_SB(0, 0), b2, voffB);
            PG8_BAR; PG8_WAIT_L(0); PG8_MMA(0, 1, At, B1); PG8_BAR;
            PG8_LDA(At, 0, 1); PG8_STAGE(PG8_SA(0, 0), a2, vs0);
            PG8_BAR; PG8_WAIT_L(0); PG8_MMA(1, 0, At, B0); PG8_BAR; PG8_SCHED;
            PG8_STAGE(PG8_SB(0, 1), b2 + hstep, voffB);
            PG8_WAIT_V(6); PG8_BAR; PG8_MMA(1, 1, At, B1); PG8_BAR;
            PG8_LDB(B0, 1, 0); PG8_SCHED; PG8_LDA(At, 1, 0); PG8_STAGE(PG8_SA(0, 1), a2, vs1);
            PG8_WAIT_L(8); PG8_BAR; PG8_WAIT_L(0); PG8_MMA(0, 0, At, B0); PG8_BAR; PG8_SCHED;
            PG8_LDB(B1, 1, 1); PG8_STAGE(PG8_SB(1, 0), b3, voffB);
            PG8_BAR; PG8_WAIT_L(0); PG8_MMA(0, 1, At, B1); PG8_BAR;
            PG8_LDA(At, 1, 1); PG8_STAGE(PG8_SA(1, 0), a3, vs0);
            PG8_BAR; PG8_WAIT_L(0); PG8_MMA(1, 0, At, B0); PG8_BAR; PG8_SCHED;
            PG8_STAGE(PG8_SB(1, 1), b3 + hstep, voffB);
            PG8_WAIT_V(6); PG8_BAR; PG8_MMA(1, 1, At, B1); PG8_BAR;
            }
        }
        if constexpr (ESIZE == 1) asm volatile("s_nop 15\n\ts_nop 15" ::: "memory");
        if constexpr (ALIGN_EPI) { if (wr == 0) PG8_BAR; }
        if constexpr (PROBE & 8) { } else if constexpr (!Epi::AFTER_DRAIN) { if constexpr (Epi::CHAIN) E.chain(acc, cur, wr, wc, fr, fq); else if constexpr (EPRE > 0) E.pre(acc, cur, wr, wc, fr, fq, lds + PRE_OFF + pbuf * PRE_BUF); else E(acc, cur, wr, wc, fr, fq); S.done(cur); }
        if (!has_next) break;
        if (!(Epi::CHAIN && nxt.e != 0)) {
#pragma unroll
        for (int a = 0; a < 2; ++a)
#pragma unroll
            for (int b = 0; b < 2; ++b)
#pragma unroll
                for (int m = 0; m < 4; ++m)
#pragma unroll
                    for (int n = 0; n < 2; ++n) acc[a][b][m][n] = (f32x4){0.f, 0.f, 0.f, 0.f};
        }
        cur = nxt; cA = nA; cB = nB; ++ui; pbuf = nbuf;
        if constexpr (GATHER) { _Pragma("unroll") for (int i = 0; i < 2; ++i) { vc0[i] = vn0[i]; vc1[i] = vn1[i]; } }
        if constexpr (ALIGN_EPI) { if (wr == 1) PG8_BAR; }
    }
    PG8_WAIT_V(0);
    if constexpr (!ALIGN_EPI) { if (wr == 0) PG8_BAR; }
    PG8_BAR;
    if constexpr (Epi::AFTER_DRAIN) { E.fused(acc, cur, wr, wc, fr, fq, lds, wid, lane); S.done(cur); }
#undef PG8_GROWS
#undef PG8_GROWS_USE
#undef PG8_PRE
#undef PG8_PT
#undef PG8_SA
#undef PG8_SB
#undef PG8_STAGE
#undef PG8_LDA
#undef PG8_LD8
#undef PG8_LDB
#undef PG8_MMA
#undef PG8_F8CAT
#undef PG8_WAIT_V
#undef PG8_WAIT_L
#undef PG8_BAR
#undef PG8_SCHED
}
}


namespace att {
typedef unsigned short bf16_t;
typedef short bf16x8 __attribute__((ext_vector_type(8)));
typedef short s16x4 __attribute__((ext_vector_type(4)));
typedef float f32x16 __attribute__((ext_vector_type(16)));
typedef unsigned u32x4 __attribute__((ext_vector_type(4)));
#define ALAS __attribute__((address_space(3)))
typedef ALAS unsigned char* ALAS_PTR;
#define ASBAR() __builtin_amdgcn_sched_barrier(0)
constexpr int QBLK = 32, KVBLK = 64;
constexpr float THR2 = 11.0f;
constexpr float LOG2E = 1.4426950408889634f, INV2PI = 0.15915494309189535f, LOG2_THETA = 13.287712379549449f;
constexpr int OFF_V = 0, VBUF = 8192, OFF_K = 16384, KBUF_MAX = 13312, OFF_WS = OFF_K + 2 * KBUF_MAX  , OFF_BIAS = OFF_WS + 2048  , ATT_LDS = OFF_BIAS + 7680;
__device__ __forceinline__ int crow(int r, int hi) { return (r & 3) + 8 * (r >> 2) + 4 * hi; }
__device__ __forceinline__ unsigned cvtpk(float lo, float hi) { unsigned r; asm volatile("v_cvt_pk_bf16_f32 %0, %1, %2" : "=v"(r) : "v"(lo), "v"(hi)); return r; }
__device__ __forceinline__ float bf2f(short s) { return __uint_as_float(((unsigned)(unsigned short)s) << 16); }
__device__ __forceinline__ short f2bf_s(float f) { return (short)(cvtpk(f, 0.f) & 0xffffu); }

struct UnitP {
    const bf16_t* Q; int ldq;
    const bf16_t* K0; int ldk0;
    const bf16_t* K1; int ldk1;
    const bf16_t* V; int ldv;
    bf16_t* O; int ldo;
    int nt;
    int grow0;
    const float* gain;
    int kr0;
    const unsigned char* V8;
    const unsigned char* K8; int ldk8;
    float cref;
};

typedef short v4i16_t __attribute__((ext_vector_type(4)));
__device__ __forceinline__ s16x4 vtr(const ALAS unsigned char* p) { return __builtin_bit_cast(s16x4, __builtin_amdgcn_ds_read_tr16_b64_v4i16((ALAS v4i16_t*)p)); }
__device__ __forceinline__ void pv_all(f32x16& o0, f32x16& o1, f32x16& lacc, const ALAS unsigned char* vp, bf16x8 pa0, bf16x8 pa1, bf16x8 pa2, bf16x8 pa3) {
    const bf16x8 ones = {(short)0x3F80, (short)0x3F80, (short)0x3F80, (short)0x3F80, (short)0x3F80, (short)0x3F80, (short)0x3F80, (short)0x3F80};
#define ATT_PK(L, H) (bf16x8){L[0], L[1], L[2], L[3], H[0], H[1], H[2], H[3]}
#define ATT_STEP(KS, PA) { const s16x4 l0 = vtr(vp + (KS) * 1024), h0 = vtr(vp + (KS) * 1024 + 512), l1 = vtr(vp + 4096 + (KS) * 1024), h1 = vtr(vp + 4096 + (KS) * 1024 + 512); \
        o0 = __builtin_amdgcn_mfma_f32_32x32x16_bf16(PA, ATT_PK(l0, h0), o0, 0, 0, 0); o1 = __builtin_amdgcn_mfma_f32_32x32x16_bf16(PA, ATT_PK(l1, h1), o1, 0, 0, 0); \
        lacc = __builtin_amdgcn_mfma_f32_32x32x16_bf16(PA, ones, lacc, 0, 0, 0); }
    ATT_STEP(0, pa0) ATT_STEP(1, pa1) ATT_STEP(2, pa2) ATT_STEP(3, pa3)
#undef ATT_STEP
#undef ATT_PK
}
template <int DQK> __device__ __forceinline__ void qkt(f32x16& p0, f32x16& p1, const ALAS unsigned char* Ks, const bf16x8* qr, const f32x16& cinit, int r32, int hi) {
    constexpr int KST = DQK * 2 + 16;
#pragma unroll
    for (int d0 = 0; d0 < DQK / 16; ++d0) { const int cb = (2 * d0 + hi) * 16;
        const bf16x8 b0 = *(const ALAS bf16x8*)(Ks + r32 * KST + cb);
        const bf16x8 b1 = *(const ALAS bf16x8*)(Ks + (32 + r32) * KST + cb);
        if (d0 == 0) { p0 = __builtin_amdgcn_mfma_f32_32x32x16_bf16(b0, qr[0], cinit, 0, 0, 0); p1 = __builtin_amdgcn_mfma_f32_32x32x16_bf16(b1, qr[0], cinit, 0, 0, 0); }
        else { p0 = __builtin_amdgcn_mfma_f32_32x32x16_bf16(b0, qr[d0], p0, 0, 0, 0); p1 = __builtin_amdgcn_mfma_f32_32x32x16_bf16(b1, qr[d0], p1, 0, 0, 0); } }
}
__device__ __forceinline__ void na_mask(f32x16& p0, f32x16& p1, const ALAS float* btab, int kr, int rq, int qc_in, int hi_in) {
    int qc = qc_in, hi = hi_in; asm volatile("" : "+v"(qc), "+v"(hi));
    int r0 = rq - 4; r0 = r0 < 0 ? 0 : (r0 > 120 ? 120 : r0);
    const bool rowok = (kr >= r0) && (kr < r0 + 8);
    if (!rowok) {
#pragma unroll
        for (int r = 0; r < 16; ++r) { p0[r] = -1e30f; p1[r] = -1e30f; }
        return; }
    int c0 = qc - 8; c0 = c0 < 0 ? 0 : (c0 > 48 ? 48 : c0);
    int dr = kr - rq + 7; dr = dr < 0 ? 0 : (dr > 14 ? 14 : dr);
    const ALAS float* brow = btab + dr * 128 + (48 + 15 + 4 * hi - qc);
    const int cb = 4 * hi - c0;
#pragma unroll
    for (int r = 0; r < 16; ++r) {
        const int ka = (r & 3) + 8 * (r >> 2);
        const bool oka = (unsigned)(ka + cb) < 16u, okb = (unsigned)(ka + 32 + cb) < 16u;
        p0[r] = oka ? p0[r] + brow[ka] : -1e30f;
        p1[r] = okb ? p1[r] + brow[ka + 32] : -1e30f;
    }
}
__device__ __forceinline__ void lazySM(f32x16& p0, f32x16& p1, float& m_reg, bool& moved, float& alpha) {
    float pmax = p0[0];
#pragma unroll
    for (int r = 1; r < 16; ++r) pmax = fmaxf(pmax, p0[r]);
#pragma unroll
    for (int r = 0; r < 16; ++r) pmax = fmaxf(pmax, p1[r]);
    { auto rr = __builtin_amdgcn_permlane32_swap(__float_as_uint(pmax), __float_as_uint(pmax), false, false);
      pmax = fmaxf(__uint_as_float(rr[0]), __uint_as_float(rr[1])); }
    if (__builtin_expect(__all(pmax <= THR2), 1)) { alpha = 1.f; }
    else { const float dl = fmaxf(pmax, 0.f); m_reg += dl; alpha = __builtin_amdgcn_exp2f(-dl);
#pragma unroll
        for (int r = 0; r < 16; ++r) { p0[r] -= dl; p1[r] -= dl; }
        moved = true; }
#pragma unroll
    for (int r = 0; r < 16; ++r) p0[r] = __builtin_amdgcn_exp2f(p0[r]);
}
__device__ __forceinline__ void fixedSM(f32x16& p0) {
#pragma unroll
    for (int r = 0; r < 16; ++r) p0[r] = __builtin_amdgcn_exp2f(p0[r]);
}
__device__ __forceinline__ void finishSM(f32x16& p0, f32x16& p1, bf16x8& pa0, bf16x8& pa1, bf16x8& pa2, bf16x8& pa3) {
#pragma unroll
    for (int r = 0; r < 16; ++r) p1[r] = __builtin_amdgcn_exp2f(p1[r]);
    u32x4 w;
    w = (u32x4){cvtpk(p0[0], p0[1]), cvtpk(p0[2], p0[3]), cvtpk(p0[4], p0[5]), cvtpk(p0[6], p0[7])}; pa0 = __builtin_bit_cast(bf16x8, w);
    w = (u32x4){cvtpk(p0[8], p0[9]), cvtpk(p0[10], p0[11]), cvtpk(p0[12], p0[13]), cvtpk(p0[14], p0[15])}; pa1 = __builtin_bit_cast(bf16x8, w);
    w = (u32x4){cvtpk(p1[0], p1[1]), cvtpk(p1[2], p1[3]), cvtpk(p1[4], p1[5]), cvtpk(p1[6], p1[7])}; pa2 = __builtin_bit_cast(bf16x8, w);
    w = (u32x4){cvtpk(p1[8], p1[9]), cvtpk(p1[10], p1[11]), cvtpk(p1[12], p1[13]), cvtpk(p1[14], p1[15])}; pa3 = __builtin_bit_cast(bf16x8, w);
}
struct NoSide { static constexpr bool PLAIN = true; template <int P> __device__ __forceinline__ void step() {} template <int P> __device__ __forceinline__ void load() {} };
typedef int i32x8 __attribute__((ext_vector_type(8)));
typedef int i32x4 __attribute__((ext_vector_type(4)));
template <int DQK, int MODE, class SIDE = NoSide, bool K8 = false, bool P8 = false>
__device__ __forceinline__ void attn_unit(const UnitP& u, ALAS unsigned char* lds, const int tid, SIDE& side) {
    static_assert(!K8 || (DQK == 64 && MODE == 0) || (DQK == 96 && MODE == 1), "fp8 QK^T: GQA fixed-reference form, or MLA (its 64 un-roped dims in fp8, the 32 rope dims stay bf16)");
    constexpr bool K8M = K8 && MODE == 1;
    constexpr int ND = DQK / 16, KST = K8 ? (K8M ? 144 : 80) : DQK * 2 + 16, KBUF = 64 * KST;
    constexpr bool PV8 = P8;
    static_assert(!P8 || MODE == 0 || MODE == 1, "8-bit P.V: dense forms only");
    static_assert(KBUF <= KBUF_MAX, "K buffer");
    const int wid = __builtin_amdgcn_readfirstlane(tid >> 6), lane = tid & 63, r32 = lane & 31, hi = lane >> 5;
    ALAS unsigned char* V_lds = lds + OFF_V; ALAS unsigned char* K_lds = lds + OFF_K;
    ALAS float* ws = (ALAS float*)(lds + OFF_WS) + wid * 64; ALAS float* al_l = ws + 32;
    const ALAS float* btab = (const ALAS float*)(lds + OFF_BIAS);
    float m_reg = 0.f; f32x16 o[2], lacc; o[0] = f32x16{}; o[1] = f32x16{}; lacc = f32x16{}; bf16x8 qr[ND];
    bool moved = false;
    const int grow = u.grow0 + (wid >> 1), gcol = (wid & 1) * 32 + r32;
    const int sk = tid >> 3, sc = tid & 7;
    const unsigned vsoff = (unsigned)(sk * u.ldv + sc * 8) * 2u, ksoff = K8 ? (unsigned)(sk * u.ldk8 + sc * 8) : (unsigned)(sk * u.ldk0 + sc * 8) * 2u;
    const int vst = (sc >> 2) * 4096 + sk * 64 + (sc & 3) * 16, kst = K8 ? sk * KST + sc * 8 : sk * KST + sc * 16;
    const int sk2 = (tid & 255) >> 2, sc2 = tid & 3;
    const unsigned k2soff = (DQK == 96) ? (unsigned)(sk2 * u.ldk1 + sc2 * 8) * 2u : 0u;
    const int k2st = sk2 * KST + (K8M ? 64 : 128) + sc2 * 16;
    const ALAS unsigned char* vb0 = V_lds + ((lane >> 4) & 1) * 32 + (lane & 3) * 8 + (4 * hi + ((lane & 15) >> 2)) * 64;
    typedef unsigned long long u64_; struct { bf16x8 v, k, k2; u64_ k8, v8; } sr_[2];
    const unsigned v8soff = (unsigned)(sk * 64 + sc * 8); const int v8st = sk * 80 + sc * 8;
#define ATT_SLOAD(i, k0) do { if constexpr (PV8) sr_[i].v8 = *(const u64_*)((const char*)(u.V8 + (size_t)(k0) * 64) + v8soff); else sr_[i].v = *(const bf16x8*)((const char*)(u.V + (size_t)(k0) * u.ldv) + vsoff); \
        if constexpr (K8) sr_[i].k8 = *(const u64_*)((const char*)(u.K8 + (size_t)(k0) * u.ldk8) + ksoff); else sr_[i].k = *(const bf16x8*)((const char*)(u.K0 + (size_t)(k0) * u.ldk0) + ksoff); \
        if constexpr (DQK == 96) sr_[i].k2 = *(const bf16x8*)((const char*)(u.K1 + (size_t)(k0) * u.ldk1) + k2soff); } while (0)
#define ATT_SWRITE(b, i) do { if constexpr (PV8) *(ALAS u64_*)(V_lds + vo_w + v8st) = sr_[i].v8; else *(ALAS bf16x8*)(V_lds + (b) * VBUF + vst) = sr_[i].v; \
        if constexpr (K8) *(ALAS u64_*)(K_lds + (b) * KBUF + kst) = sr_[i].k8; else *(ALAS bf16x8*)(K_lds + (b) * KBUF + kst) = sr_[i].k; \
        if constexpr (DQK == 96) *(ALAS bf16x8*)(K_lds + (b) * KBUF + k2st) = sr_[i].k2; } while (0)
#define ATT_SWAIT() do { if constexpr (SIDE::PLAIN) { if constexpr (DQK == 96) asm volatile("s_waitcnt vmcnt(3)" ::: "memory"); else asm volatile("s_waitcnt vmcnt(2)" ::: "memory"); } } while (0)
    constexpr int SE = 0, SO = 1;
    ATT_SLOAD(SE, 0); ATT_SLOAD(SO, KVBLK);
    {
        const bf16_t* Qw = u.Q + (size_t)(wid * QBLK + r32) * u.ldq + hi * 8;
#pragma unroll
        for (int d0 = K8M ? 4 : 0; d0 < ND; ++d0) qr[d0] = *(const bf16x8*)(Qw + d0 * 16);
        if constexpr (MODE == 0 || MODE == 3) {
            float x[4][8]; float ssq = 0.f;
#pragma unroll
            for (int d0 = 0; d0 < 4; ++d0)
#pragma unroll
                for (int j = 0; j < 8; ++j) { x[d0][j] = bf2f(qr[d0][j]); ssq += x[d0][j] * x[d0][j]; }
            { auto rr_ = __builtin_amdgcn_permlane32_swap(__float_as_uint(ssq), __float_as_uint(ssq), false, false); ssq = __uint_as_float(rr_[0]) + __uint_as_float(rr_[1]); }
            const float rstd = 1.0f / sqrtf(ssq * (1.0f / 64.0f) + 1e-6f);
#pragma unroll
            for (int d0 = 0; d0 < 4; ++d0)
#pragma unroll
                for (int j = 0; j < 8; ++j) x[d0][j] = x[d0][j] * rstd * u.gain[16 * d0 + 8 * hi + j];
#pragma unroll
            for (int d0 = 0; d0 < 2; ++d0)
#pragma unroll
                for (int j = 0; j < 8; ++j) { const float inv = exp2f(-(float)(8 * hi + j) * (LOG2_THETA / 16.0f));
                    const float ang = (float)(d0 == 0 ? grow : gcol) * inv * INV2PI; const float c = __builtin_amdgcn_cosf(ang), s = __builtin_amdgcn_sinf(ang);
                    const float y1 = x[d0][j], y2 = x[d0 + 2][j]; x[d0][j] = y1 * c - y2 * s; x[d0 + 2][j] = y1 * s + y2 * c; }
            constexpr float C2 = 0.125f * LOG2E;
#pragma unroll
            for (int d0 = 0; d0 < 4; ++d0) { u32x4 w = {cvtpk(x[d0][0] * C2, x[d0][1] * C2), cvtpk(x[d0][2] * C2, x[d0][3] * C2), cvtpk(x[d0][4] * C2, x[d0][5] * C2), cvtpk(x[d0][6] * C2, x[d0][7] * C2)};
                qr[d0] = __builtin_bit_cast(bf16x8, w); }
        }
        if constexpr (MODE == 1) {
            float y1[8], y2[8];
#pragma unroll
            for (int j = 0; j < 8; ++j) { const float inv = exp2f(-(float)j * (LOG2_THETA / 8.0f));
                const float ang = (float)(hi == 0 ? grow : gcol) * inv * INV2PI; const float c = __builtin_amdgcn_cosf(ang), s = __builtin_amdgcn_sinf(ang);
                const float a = bf2f(qr[4][j]), b = bf2f(qr[5][j]); y1[j] = a * c - b * s; y2[j] = a * s + b * c; }
            u32x4 w = {cvtpk(y1[0], y1[1]), cvtpk(y1[2], y1[3]), cvtpk(y1[4], y1[5]), cvtpk(y1[6], y1[7])}; qr[4] = __builtin_bit_cast(bf16x8, w);
            w = (u32x4){cvtpk(y2[0], y2[1]), cvtpk(y2[2], y2[3]), cvtpk(y2[4], y2[5]), cvtpk(y2[6], y2[7])}; qr[5] = __builtin_bit_cast(bf16x8, w);
        }
    }
    i32x8 qr8 = {0, 0, 0, 0, 0, 0, 0, 0}; int sc8 = 0x7F7F7F7F;
    if constexpr (K8M) {
        const bf16_t* Qn = u.Q + (size_t)(wid * QBLK + r32) * u.ldq + hi * 32;
#pragma unroll
        for (int i = 0; i < 4; ++i) { const bf16x8 qv = *(const bf16x8*)(Qn + 8 * i);
            qr8[2 * i] = (int)pg8::pk4_fp8(bf2f(qv[0]), bf2f(qv[1]), bf2f(qv[2]), bf2f(qv[3])); qr8[2 * i + 1] = (int)pg8::pk4_fp8(bf2f(qv[4]), bf2f(qv[5]), bf2f(qv[6]), bf2f(qv[7])); }
    }
    if constexpr (K8 && !K8M) {
#pragma unroll
        for (int d0 = 0; d0 < 4; ++d0) { float f_[8];
#pragma unroll
            for (int j = 0; j < 8; ++j) f_[j] = bf2f(qr[d0][j]);
            qr8[2 * d0] = (int)pg8::pk4_fp8(f_[0], f_[1], f_[2], f_[3]); qr8[2 * d0 + 1] = (int)pg8::pk4_fp8(f_[4], f_[5], f_[6], f_[7]); }
    }
    if constexpr (K8 || P8) asm volatile("" : "+v"(sc8));
#define ATT_RESC(a) do { if constexpr (MODE != 0) { if (__any((a) < 1.f)) { if (hi == 0) al_l[r32] = (a); asm volatile("s_waitcnt lgkmcnt(0)" ::: "memory"); \
        if constexpr (PV8) asm volatile("s_nop 15\n\ts_nop 15\n\ts_nop 15\n\ts_nop 15\n\ts_nop 15\n\ts_nop 15\n\ts_nop 15\n\ts_nop 15\n\ts_nop 15\n\ts_nop 15\n\ts_nop 15\n\ts_nop 15" : "+v"(o[0]), "+v"(o[1]), "+v"(lacc) :: "memory");     \
        _Pragma("unroll") for (int r = 0; r < 16; ++r) { const float f_ = al_l[crow(r, hi)]; o[0][r] *= f_; o[1][r] *= f_; lacc[r] *= f_; } \
        if constexpr (PV8) asm volatile("s_nop 7" : "+v"(o[0]), "+v"(o[1]), "+v"(lacc) :: "memory"); } } } while (0)
#define ATT_SM(P0, P1, AL) do { if constexpr (MODE == 0) { fixedSM(P0); AL = 1.f; } else lazySM(P0, P1, m_reg, moved, AL); } while (0)
#define ATT_QKT8(P0, P1, KS) do { const ALAS unsigned char* kp_ = (KS) + r32 * 80 + hi * 32; \
        const i32x8 ka_ = __builtin_shufflevector(*(const ALAS i32x4*)kp_, *(const ALAS i32x4*)(kp_ + 16), 0, 1, 2, 3, 4, 5, 6, 7); \
        const i32x8 kb_ = __builtin_shufflevector(*(const ALAS i32x4*)(kp_ + 32 * 80), *(const ALAS i32x4*)(kp_ + 32 * 80 + 16), 0, 1, 2, 3, 4, 5, 6, 7); \
        asm volatile("v_mfma_scale_f32_32x32x64_f8f6f4 %0, %1, %2, 0, %3, %3 op_sel_hi:[0,0,0]" : "=&v"(P0) : "v"(ka_), "v"(qr8), "v"(sc8)); \
        asm volatile("v_mfma_scale_f32_32x32x64_f8f6f4 %0, %1, %2, 0, %3, %3 op_sel_hi:[0,0,0]" : "=&v"(P1) : "v"(kb_), "v"(qr8), "v"(sc8)); } while (0)
#define ATT_QKT8M(P0, P1, KS) do { const ALAS unsigned char* kp_ = (KS) + r32 * KST + hi * 32; \
        const i32x8 ka_ = __builtin_shufflevector(*(const ALAS i32x4*)kp_, *(const ALAS i32x4*)(kp_ + 16), 0, 1, 2, 3, 4, 5, 6, 7); \
        const i32x8 kb_ = __builtin_shufflevector(*(const ALAS i32x4*)(kp_ + 32 * KST), *(const ALAS i32x4*)(kp_ + 32 * KST + 16), 0, 1, 2, 3, 4, 5, 6, 7); \
        const ALAS unsigned char* rp_ = (KS) + r32 * KST + 64 + hi * 16; \
        const bf16x8 r00_ = *(const ALAS bf16x8*)rp_, r01_ = *(const ALAS bf16x8*)(rp_ + 32), r10_ = *(const ALAS bf16x8*)(rp_ + 32 * KST), r11_ = *(const ALAS bf16x8*)(rp_ + 32 * KST + 32); \
        f32x16 ci_; _Pragma("unroll") for (int r_ = 0; r_ < 16; ++r_) ci_[r_] = moved ? -m_reg : 0.f; \
        P0 = __builtin_amdgcn_mfma_f32_32x32x16_bf16(r00_, qr[4], ci_, 0, 0, 0); P1 = __builtin_amdgcn_mfma_f32_32x32x16_bf16(r10_, qr[4], ci_, 0, 0, 0); \
        P0 = __builtin_amdgcn_mfma_f32_32x32x16_bf16(r01_, qr[5], P0, 0, 0, 0); P1 = __builtin_amdgcn_mfma_f32_32x32x16_bf16(r11_, qr[5], P1, 0, 0, 0); \
          \
        asm volatile("s_nop 15\n\ts_nop 15\n\ts_nop 7\n\tv_mfma_scale_f32_32x32x64_f8f6f4 %0, %1, %2, %0, %3, %3 op_sel_hi:[0,0,0]" : "+v"(P0) : "v"(ka_), "v"(qr8), "v"(sc8), "v"(P1)); \
        asm volatile("v_mfma_scale_f32_32x32x64_f8f6f4 %0, %1, %2, %0, %3, %3 op_sel_hi:[0,0,0]" : "+v"(P1) : "v"(kb_), "v"(qr8), "v"(sc8)); } while (0)
#define ATT_QKT(P0, P1, KS) do { if constexpr (K8M) ATT_QKT8M(P0, P1, KS); else if constexpr (K8) ATT_QKT8(P0, P1, KS); else if (MODE != 0 && moved) { f32x16 ng_; _Pragma("unroll") for (int r_ = 0; r_ < 16; ++r_) ng_[r_] = -m_reg; qkt<DQK>(P0, P1, KS, qr, ng_, r32, hi); } \
        else { const f32x16 z_ = f32x16{}; qkt<DQK>(P0, P1, KS, qr, z_, r32, hi); } } while (0)
#define ATT_PV8(VOFF) do { const ALAS unsigned char* vp_ = V_lds + (VOFF) + r32 * 80 + hi * 32; \
        const i32x8 va_ = __builtin_shufflevector(*(const ALAS i32x4*)vp_, *(const ALAS i32x4*)(vp_ + 16), 0, 1, 2, 3, 4, 5, 6, 7); \
        const i32x8 vb_ = __builtin_shufflevector(*(const ALAS i32x4*)(vp_ + 32 * 80), *(const ALAS i32x4*)(vp_ + 32 * 80 + 16), 0, 1, 2, 3, 4, 5, 6, 7); \
        asm volatile("v_mfma_scale_f32_32x32x64_f8f6f4 %0, %1, %2, %0, %3, %3 op_sel_hi:[0,0,0] cbsz:1 blgp:1" : "+v"(o[0]) : "v"(p8), "v"(va_), "v"(sc8)); \
        asm volatile("v_mfma_scale_f32_32x32x64_f8f6f4 %0, %1, %2, %0, %3, %3 op_sel_hi:[0,0,0] cbsz:1 blgp:1" : "+v"(o[1]) : "v"(p8), "v"(vb_), "v"(sc8)); \
        asm volatile("v_mfma_scale_f32_32x32x64_f8f6f4 %0, %1, %2, %0, %3, %3 op_sel_hi:[0,0,0] cbsz:1 blgp:1" : "+v"(lacc) : "v"(p8), "v"(ones8), "v"(sc8)); } while (0)
#define ATT_PV(VB) do { if constexpr (PV8) ATT_PV8(vo_r); else pv_all(o[0], o[1], lacc, (VB), pa0, pa1, pa2, pa3); } while (0)
    constexpr int VB8 = 5120; int vo_r = 0, vo_c = VB8, vo_w = 0; (void)vo_c;
#define ATT_VROT() do { if constexpr (PV8) { const int t_ = vo_r; vo_r = vo_c; vo_c = vo_w; vo_w = t_; } } while (0)
#define ATT_BAR1() do { if constexpr (!PV8) __syncthreads(); } while (0)
#define ATT_FIN(P0, P1) do { if constexpr (PV8) { _Pragma("unroll") for (int r_ = 0; r_ < 16; ++r_) P1[r_] = __builtin_amdgcn_exp2f(P1[r_]); \
        _Pragma("unroll") for (int g_ = 0; g_ < 4; ++g_) { int w_ = __builtin_amdgcn_cvt_pk_bf8_f32(P0[4 * g_], P0[4 * g_ + 1], p8[g_], false); p8[g_] = __builtin_amdgcn_cvt_pk_bf8_f32(P0[4 * g_ + 2], P0[4 * g_ + 3], w_, true); \
            w_ = __builtin_amdgcn_cvt_pk_bf8_f32(P1[4 * g_], P1[4 * g_ + 1], p8[4 + g_], false); p8[4 + g_] = __builtin_amdgcn_cvt_pk_bf8_f32(P1[4 * g_ + 2], P1[4 * g_ + 3], w_, true); } }        \
        else finishSM(P0, P1, pa0, pa1, pa2, pa3); } while (0)
#define ATT_MASK(P0, P1, j) do { if constexpr (MODE == 2) na_mask(P0, P1, btab, u.kr0 + (j), grow, gcol, hi); } while (0)
    f32x16 pA0, pA1, pB0, pB1; float alA, alB; bf16x8 pa0, pa1, pa2, pa3; const int NT = u.nt;
    i32x8 p8 = {0, 0, 0, 0, 0, 0, 0, 0}; i32x8 ones8 = {0x3C3C3C3C, 0x3C3C3C3C, 0x3C3C3C3C, 0x3C3C3C3C, 0x3C3C3C3C, 0x3C3C3C3C, 0x3C3C3C3C, 0x3C3C3C3C};
    if constexpr (PV8) { int o1_ = 0x3C3C3C3C; asm volatile("" : "+v"(o1_)); ones8 = (i32x8){o1_, o1_, o1_, o1_, o1_, o1_, o1_, o1_}; asm volatile("" : "+v"(ones8)); }
    asm volatile("s_waitcnt vmcnt(0)" ::: "memory"); ATT_SWRITE(0, SE); __syncthreads(); vo_w = VB8;
    ATT_QKT(pA0, pA1, K_lds); if constexpr (K8) asm volatile("s_nop 15\n\ts_nop 15\n\ts_nop 15\n\ts_nop 15\n\ts_nop 15\n\ts_nop 15\n\ts_nop 15\n\ts_nop 15\n\ts_nop 15\n\ts_nop 15" : "+v"(pA0), "+v"(pA1) :: "memory");
    ATT_MASK(pA0, pA1, 0);
    if constexpr (PV8 && MODE != 0) {
        float pm_ = pA0[0];
#pragma unroll
        for (int r = 1; r < 16; ++r) pm_ = fmaxf(pm_, pA0[r]);
#pragma unroll
        for (int r = 0; r < 16; ++r) pm_ = fmaxf(pm_, pA1[r]);
        { auto rr_ = __builtin_amdgcn_permlane32_swap(__float_as_uint(pm_), __float_as_uint(pm_), false, false); pm_ = fmaxf(__uint_as_float(rr_[0]), __uint_as_float(rr_[1])); }
        m_reg = pm_ - 8.0f; moved = true;
#pragma unroll
        for (int r = 0; r < 16; ++r) { pA0[r] -= m_reg; pA1[r] -= m_reg; }
    }
    ATT_SM(pA0, pA1, alA);
    if (2 < NT) ATT_SLOAD(SE, 2 * KVBLK);
    ATT_SWAIT(); ATT_SWRITE(1, SO); __syncthreads(); vo_w = 2 * VB8;
    if (wid >= 4) __builtin_amdgcn_s_setprio(1);
#define ATT_BODY(ACT) { \
        if constexpr (!SIDE::PLAIN && (ACT)) side.template step<0>(); \
        ASBAR(); ATT_QKT(pB0, pB1, K_lds + KBUF); ATT_MASK(pB0, pB1, j); \
        ATT_FIN(pA0, pA1); ASBAR(); \
        ATT_SLOAD(SO, (j + 2) * KVBLK); if constexpr (!SIDE::PLAIN && (ACT)) side.template load<0>(); ASBAR(); \
        ATT_PV(vb0); if constexpr (K8) ASBAR();        \
        ATT_SM(pB0, pB1, alB); \
        ATT_BAR1(); ATT_SWAIT(); ATT_SWRITE(0, SE); \
        ATT_RESC(alB); __syncthreads(); ATT_VROT(); \
        if constexpr (!SIDE::PLAIN && (ACT)) side.template step<1>(); \
        ASBAR(); ATT_QKT(pA0, pA1, K_lds); ATT_MASK(pA0, pA1, j + 1); \
        ATT_FIN(pB0, pB1); ASBAR(); \
        ATT_SLOAD(SE, (j + 3 < NT ? j + 3 : NT - 1) * KVBLK);        \
        if constexpr (!SIDE::PLAIN && (ACT)) side.template load<1>(); ASBAR(); \
        ATT_PV(vb0 + VBUF); if constexpr (K8) ASBAR(); \
        ATT_SM(pA0, pA1, alA); \
        ATT_BAR1(); ATT_SWAIT(); ATT_SWRITE(1, SO); \
        ATT_RESC(alA); __syncthreads(); ATT_VROT(); }
    if constexpr (SIDE::PLAIN) { for (int j = 1; j + 1 < NT; j += 2) ATT_BODY(false) }
    else { int j = 1; const int ntrip = (NT - 1) / 2, ng = ntrip / 7, rem = ntrip - 7 * ng;
        for (int g = 0; g < ng; ++g) {
#pragma unroll
            for (int a_ = 0; a_ < 2; ++a_) { ATT_BODY(true) j += 2; }
#pragma nounroll
            for (int k_ = 0; k_ < 5; ++k_) { ATT_BODY(false) j += 2; } }
#pragma nounroll
        for (int k_ = 0; k_ < rem; ++k_) { ATT_BODY(false) j += 2; } }
#undef ATT_BODY
    ASBAR(); ATT_QKT(pB0, pB1, K_lds + KBUF); ATT_MASK(pB0, pB1, NT - 1);
    ATT_FIN(pA0, pA1); ASBAR();
    ATT_PV(vb0); if constexpr (K8) ASBAR();
    ATT_SM(pB0, pB1, alB);
    __syncthreads(); ATT_RESC(alB);
    ATT_FIN(pB0, pB1); ASBAR(); ATT_VROT();
    ATT_PV(vb0 + VBUF);
    __builtin_amdgcn_s_setprio(0);
    if constexpr (PV8) asm volatile("s_nop 15\n\ts_nop 15\n\ts_nop 15\n\ts_nop 15\n\ts_nop 15\n\ts_nop 15\n\ts_nop 15\n\ts_nop 15\n\ts_nop 15\n\ts_nop 15\n\ts_nop 15\n\ts_nop 15\n\ts_nop 15\n\ts_nop 15" : "+v"(o[0]), "+v"(o[1]), "+v"(lacc) :: "memory");
#if MK_E8
    bf16_t* Ow = (bf16_t*)((unsigned char*)u.O + (size_t)(wid * QBLK) * u.ldo);
#else
    bf16_t* Ow = u.O + (size_t)(wid * QBLK) * u.ldo;
#endif
#pragma unroll
    for (int r = 0; r < 16; ++r) { const int orow = crow(r, hi); const float rl = __builtin_amdgcn_rcpf(lacc[r]);
#pragma unroll
        for (int d0 = 0; d0 < 2; ++d0) {
#if MK_E8
            ((unsigned char*)Ow)[(size_t)orow * u.ldo + d0 * 32 + r32] = (unsigned char)(pg8::pk4_fp8(o[d0][r] * rl * 64.0f, 0.f, 0.f, 0.f) & 0xffu);
#else
            Ow[(size_t)orow * u.ldo + d0 * 32 + r32] = (bf16_t)f2bf_s(o[d0][r] * rl);
#endif
        } }
    __syncthreads();
#undef ATT_SLOAD
#undef ATT_SWRITE
#undef ATT_SWAIT
#undef ATT_RESC
#undef ATT_SM
#undef ATT_QKT
#undef ATT_QKT8
#undef ATT_QKT8M
#undef ATT_PV8
#undef ATT_VROT
#undef ATT_BAR1
#undef ATT_FIN
#undef ATT_PV
#undef ATT_MASK
}
}


constexpr int NWAVES = 8;
#ifndef MK_DEBUG
#define MK_DEBUG 0
#endif
#ifndef MK_DBG_IGNORE
#define MK_DBG_IGNORE 0
#endif
#ifndef MK_ONE_LAUNCH
#define MK_ONE_LAUNCH 0
#endif
#ifndef REP_P
#define REP_P 1
#endif
#ifndef REP_A
#define REP_A 1
#endif
#ifndef REP_B
#define REP_B 1
#endif
#ifndef REP_C
#define REP_C 1
#endif
#ifndef REP_DG
#define REP_DG 1
#endif
#ifndef REP_DM
#define REP_DM 1
#endif
#ifndef REP_DN
#define REP_DN 1
#endif
#ifndef REP_E
#define REP_E 1
#endif
#ifndef REP_F
#define REP_F 1
#endif
#ifndef REP_H
#define REP_H 1
#endif
#ifndef REP_I
#define REP_I 1
#endif
#ifndef REP_J
#define REP_J 1
#endif
#ifndef REP_K
#define REP_K 1
#endif
#ifndef MK_FP8_LAST
#define MK_FP8_LAST 1
#endif
#ifndef MK_FP8_MOE_ALL
#define MK_FP8_MOE_ALL 1
#endif
#define F8MOE(l) (MK_FP8_LAST && ((l) == DEPTH - 1 || MK_FP8_MOE_ALL))
#ifndef MK_FP8_IN_ALL
#define MK_FP8_IN_ALL 1
#endif
#define F8IN(l) (MK_FP8_LAST && ((l) == DEPTH - 1 || MK_FP8_IN_ALL))
#ifndef MK_FP8_QK
#define MK_FP8_QK 1
#endif
#ifndef MK_FP8_PV
#define MK_FP8_PV 1
#endif
#ifndef MK_FP8_PVM
#define MK_FP8_PVM 1
#endif
#ifndef MK_FP8_QKM
#define MK_FP8_QKM 1
#endif
#ifndef MK_FP8_OUT
#define MK_FP8_OUT 1
#endif
constexpr int NB = 4, SEQ = 8192, T = NB * SEQ, D = 1024, DEPTH = 2, GW = 64;
constexpr int DIN = 5536, DINP = 5632;
constexpr int H_NAQ = 0, H_NAK = 384, H_NAV = 768, H_GQ = 1152, H_GK = 1536, H_GV = 1664, H_CQ = 1792, H_CKV = 2176, H_KR = 2432, H_GATE = 2464;
constexpr int NE = 32, TOPK = 4, FF = 1024, TK = T * TOPK;
constexpr int PSLOTS = TK + NE * 256;
constexpr int MAXTILES = PSLOTS / 256;
constexpr int LCAP = T;
constexpr float LN_EPS = 1e-5f, RMS_EPS = 1e-6f, DN_ALPHA = 1.4142135623730951f;
constexpr float LOG2E_F = 1.4426950408889634f;
constexpr int PPL = 10, NPH = 1 + DEPTH * PPL;

constexpr size_t MiB = 1u << 20;
constexpr size_t WS_CTL = 0, CTL_ZERO_BYTES = 1 * MiB;
constexpr size_t WB_IN = 0, WB_UQ = WB_IN + (size_t)DINP * 1024 * 2, WB_UKV = WB_UQ + (size_t)512 * 384 * 2, WB_BA = WB_UKV + (size_t)512 * 256 * 2,
                 WB_BB = WB_BA + (size_t)1024 * 384 * 2, WB_BC = WB_BB + (size_t)1024 * 384 * 2, WB_OUT = WB_BC + (size_t)1024 * 384 * 2,
                 WB_GU = WB_OUT + (size_t)1024 * 1024 * 2, WB_DN = WB_GU + (size_t)NE * 2048 * 1024 * 2, WB_LAYER = WB_DN + (size_t)NE * 1024 * 1024 * 2;
static_assert(WB_LAYER % 256 == 0, "weight block alignment");
constexpr size_t WS_W = 2 * MiB;
constexpr size_t WS_H = WS_W + 2 * WB_LAYER;
constexpr size_t SZ_H = (size_t)T * DINP * 2;
constexpr size_t WS_A2 = WS_H + SZ_H;
constexpr size_t A2_MIX = 0, A2_MIXED = A2_MIX + (size_t)T * 1024 * 4, A2_YA = A2_MIXED + (size_t)T * 1024 * 2, A2_YB = A2_YA + (size_t)T * 384 * 2,
                 A2_YC = A2_YB + (size_t)T * 384 * 2, A2_QC = A2_YC + (size_t)T * 384 * 2, A2_KVC = A2_QC + (size_t)T * 384 * 2, A2_KB = A2_KVC + (size_t)T * 512 * 2,
                 A2_CQN = A2_KB + (size_t)T * 128 * 2, A2_CKVN = A2_CQN + (size_t)T * 384 * 2, A2_KR = A2_CKVN + (size_t)T * 256 * 2, A2_K8 = A2_KR + (size_t)T * 32 * 2, A2_VT8 = A2_K8 + (size_t)T * 128, A2_VT8M = A2_VT8 + (size_t)T * 128, A2_K8M = A2_VT8M + (size_t)T * 256, SZ_A2 = A2_K8M + (size_t)T * 256;
static_assert(SZ_A2 >= (size_t)PSLOTS * 1024 * 2 && SZ_H >= (size_t)PSLOTS * 1024 * 2, "overlays fit");
constexpr size_t WS_X2 = WS_A2 + SZ_A2;
constexpr size_t WS_XB = WS_X2 + (size_t)T * D * 4;
constexpr size_t WS_X1 = WS_XB + (size_t)T * D * 2;
constexpr size_t WS_X1B = WS_X1 + (size_t)T * D * 4;
constexpr size_t WS_LT = WS_X1B + (size_t)T * D * 2;
constexpr size_t WS_LG = WS_LT + (size_t)NE * LCAP * 4;
constexpr size_t WS_TE = WS_LG + (size_t)NE * LCAP * 4;
constexpr size_t WS_TR = WS_TE + (size_t)T * 4 * 4;
constexpr size_t WS_SG = WS_TR + (size_t)T * 4 * 4;
constexpr size_t WS_END = WS_SG + (size_t)PSLOTS * 4;
constexpr int CW_BAR = 4096;
constexpr int CW_CNT = 16384;

constexpr int RING_BYTES = 131072, LDSCTL_OFF = 139264, MISC_OFF = LDSCTL_OFF + 64;
constexpr int TBL_OFF = LDSCTL_OFF + 256;
constexpr int TBL_START = TBL_OFF, TBL_TILEE = TBL_OFF + 512, TBL_RS = TBL_TILEE + 2304;
constexpr int LDS_BYTES = 155648;
static_assert(TBL_RS + 512 * 12 + 256 <= LDS_BYTES, "LDS map");

#define GAS __attribute__((address_space(1)))
#define LAS __attribute__((address_space(3)))
typedef unsigned short bf16;
typedef unsigned v4u __attribute__((ext_vector_type(4)));
typedef float f32x4 __attribute__((ext_vector_type(4)));
typedef GAS unsigned gu32;
#define RLX_AGENT __ATOMIC_RELAXED, __HIP_MEMORY_SCOPE_AGENT
#define LDS_WAIT() asm volatile("s_waitcnt lgkmcnt(0)" ::: "memory")
#define VM_WAIT() asm volatile("s_waitcnt vmcnt(0)" ::: "memory")
__device__ __forceinline__ unsigned f2bf(float f) { unsigned u = __builtin_bit_cast(unsigned, f); return (u + 0x7fffu + ((u >> 16) & 1u)) >> 16; }
__device__ __forceinline__ unsigned pk2(float lo, float hi) { unsigned r; asm("v_cvt_pk_bf16_f32 %0, %1, %2" : "=v"(r) : "v"(lo), "v"(hi)); return r; }
__device__ __forceinline__ float bflo(unsigned w) { return __uint_as_float(w << 16); }
__device__ __forceinline__ float bfhi(unsigned w) { return __uint_as_float(w & 0xffff0000u); }

template <int O> __device__ __forceinline__ float shx(float v, int lane) { return __int_as_float(__builtin_amdgcn_ds_bpermute((lane ^ O) << 2, __float_as_int(v))); }
template <int O> __device__ __forceinline__ int shxi(int v, int lane) { return __builtin_amdgcn_ds_bpermute((lane ^ O) << 2, v); }

#define XB_TMO      128
#define XB_XCNT(j)  (256  + 64 * (j))
#define XB_XSUB(j)  (1280 + 64 * (j))
#define XB_XGEN(j)  (2304 + 64 * (j))
#define XB_TOP      3328
#define XB_TOPGEN   3392
#define XCD_BAR_WORDS 3456
#define XB_SPIN_CAP (1u << 18)

__device__ __forceinline__ unsigned xb_ld(unsigned* p)              { return __hip_atomic_load(p, __ATOMIC_RELAXED, __HIP_MEMORY_SCOPE_AGENT); }
__device__ __forceinline__ unsigned xb_add(unsigned* p, unsigned v) { return __hip_atomic_fetch_add(p, v, __ATOMIC_RELAXED, __HIP_MEMORY_SCOPE_AGENT); }
__device__ __forceinline__ unsigned xb_xcc_id() { return (unsigned)__builtin_amdgcn_s_getreg((3 << 11) | 20) & 0xFu; }
#define XB_SPIN(cond, bar) do { unsigned _sp = 0; while (cond) { __builtin_amdgcn_s_sleep(1); \
    if ((++_sp & 255u) == 0u) { if (xb_ld(&(bar)[XB_TMO])) break; if (_sp > XB_SPIN_CAP) { atomicAdd(&(bar)[XB_TMO], 1u); break; } } } } while (0)

struct XcdBarrier {
    unsigned* bar; unsigned x;
    volatile LAS unsigned* st;
};

__device__ __forceinline__ XcdBarrier xcd_barrier_post(unsigned* bar, volatile LAS unsigned* st) {
    XcdBarrier b; b.bar = bar; b.x = xb_xcc_id(); b.st = st;
    if (threadIdx.x == 0) (void)xb_add(&bar[XB_XCNT(b.x)], 1u);
    return b;
}
__device__ __forceinline__ void xcd_barrier_complete(unsigned* bar, unsigned x, unsigned& nloc, unsigned& nx) {
    const unsigned G = gridDim.x * gridDim.y * gridDim.z;
    unsigned sum, cnt, mine, sp = 0u;
    for (;;) {
        sum = 0u; cnt = 0u; mine = 0u;
#pragma unroll
        for (unsigned j = 0; j < 16; ++j) { const unsigned c = xb_ld(&bar[XB_XCNT(j)]); sum += c; cnt += (c > 0u) ? 1u : 0u; mine = (j == x) ? c : mine; }
        if (sum == G) break;
        __builtin_amdgcn_s_sleep(1);
        if ((++sp & 255u) == 0u) { if (xb_ld(&bar[XB_TMO])) break; if (sp > XB_SPIN_CAP) { atomicAdd(&bar[XB_TMO], 1u); break; } }
    }
    nloc = mine > 0u ? mine : 1u; nx = cnt > 0u ? cnt : 1u;
}

__device__ __forceinline__ void xcd_barrier(const XcdBarrier& b) {
    asm volatile("s_waitcnt vmcnt(0)" ::: "memory");
    __syncthreads();
    if (threadIdx.x == 0) {
        unsigned* bar = b.bar;
        __builtin_amdgcn_s_waitcnt(0);
        unsigned nloc = b.st[0], nx = b.st[1];
        if (nloc == 0u) { xcd_barrier_complete(bar, b.x, nloc, nx); b.st[0] = nloc; b.st[1] = nx; }
        const unsigned old = xb_add(&bar[XB_XSUB(b.x)], 1u);
        const unsigned gen = old / nloc;
        if (old + 1u == (gen + 1u) * nloc) {
            __builtin_amdgcn_fence(__ATOMIC_RELEASE, "agent");
            asm volatile("s_waitcnt vmcnt(0)" ::: "memory");
            const unsigned og = xb_add(&bar[XB_TOP], 1u);
            const unsigned tg = og / nx;
            if (og + 1u == (tg + 1u) * nx) xb_add(&bar[XB_TOPGEN], 1u);
            else XB_SPIN(xb_ld(&bar[XB_TOPGEN]) == tg, bar);
            __builtin_amdgcn_fence(__ATOMIC_ACQUIRE, "agent");
            xb_add(&bar[XB_XGEN(b.x)], 1u);
            asm volatile("s_waitcnt vmcnt(0)" ::: "memory");
        } else {
            XB_SPIN(xb_ld(&bar[XB_XGEN(b.x)]) == gen, bar);
            __builtin_amdgcn_fence(__ATOMIC_ACQUIRE, "agent");
            asm volatile("s_waitcnt vmcnt(0)" ::: "memory");
        }
    }
    __syncthreads();
}


struct Frame {
    LAS unsigned char* lds;
    gu32* ctl;
    int tid, lane, wave;
    int vcu, G, bx;
    unsigned char* ws;
    float* out;
};
__device__ __forceinline__ void stagger(const Frame& F, int grp, int ticks) {
    if (grp > 0 && F.tid == 0) { const unsigned long long t0 = __builtin_amdgcn_s_memrealtime(); const unsigned long long d = (unsigned long long)(grp * ticks);
        while (__builtin_amdgcn_s_memrealtime() - t0 < d) __builtin_amdgcn_s_sleep(4); }
    __syncthreads();
}
__device__ __forceinline__ const float* in_ptr(int i) {
    const void* base = (const void*)__builtin_amdgcn_kernarg_segment_ptr(); const GAS float* p;
    asm volatile("s_load_dwordx2 %0, %1, %2\n\ts_waitcnt lgkmcnt(0)" : "=s"(p) : "s"(base), "i"(i * 8) : "memory"); return (const float*)p;
}
#define INP(i) in_ptr(i)
template <int SITE> __device__ __forceinline__ Frame mkframe(LAS unsigned char* lds_in, unsigned char* ws_in, float* out_in, int wave_id, int bx0, int G0) {
    Frame F; int lane_;
    asm volatile("v_mbcnt_lo_u32_b32 %0, -1, 0\n\tv_mbcnt_hi_u32_b32 %0, -1, %0 ; site %1" : "=v"(lane_) : "n"(SITE));
    int bx = bx0, G = G0, wv = wave_id; asm volatile("; site %3" : "+s"(bx), "+s"(G), "+s"(wv) : "n"(SITE));
    GAS unsigned char* wsg = (GAS unsigned char*)ws_in; asm volatile("; site %1" : "+s"(wsg) : "n"(SITE)); unsigned char* ws = (unsigned char*)wsg;
    LAS unsigned char* l3 = lds_in; asm volatile("; site %1" : "+s"(l3) : "n"(SITE));
    const int tid = wv * 64 + lane_;
    F.lds = l3; F.tid = tid; F.lane = lane_; F.wave = wv;
    F.G = G; F.bx = bx; F.vcu = (G % 8 == 0) ? (bx % 8) * (G / 8) + bx / 8 : bx;
    F.ws = ws; F.ctl = (gu32*)(wsg + WS_CTL); F.out = out_in; return F;
}
__device__ __forceinline__ float wave_sum(float v, int lane) {
    v += shx<1>(v, lane); v += shx<2>(v, lane); v += shx<4>(v, lane); v += shx<8>(v, lane); v += shx<16>(v, lane); v += shx<32>(v, lane);
    return v;
}
template <bool F8> __device__ __forceinline__ void tr_item(const float* W, int ldw, int Kd, int k0, int src_n0, bf16* WT, int dst_n0, float scale, LAS float* scr, int lane) {
    float v[32];
#pragma unroll
    for (int i = 0; i < 32; ++i) v[i] = W[(size_t)(k0 + 2 * i + (lane >> 5)) * ldw + src_n0 + (lane & 31)];
#pragma unroll
    for (int i = 0; i < 32; ++i) scr[(2 * i + (lane >> 5)) * 33 + (lane & 31)] = v[i];
    LDS_WAIT(); asm volatile("" ::: "memory");
    const int c = lane & 7;
#pragma unroll
    for (int j = 0; j < 4; ++j) { const int n = (lane >> 3) + 8 * j; const LAS float* s = scr + (8 * c) * 33 + n;
        if constexpr (F8) { typedef unsigned u32x2 __attribute__((ext_vector_type(2)));
            *(GAS u32x2*)((unsigned char*)WT + (size_t)(dst_n0 + n) * Kd + k0 + 8 * c) = (u32x2){pg8::pk4_fp8(s[0 * 33] * scale, s[1 * 33] * scale, s[2 * 33] * scale, s[3 * 33] * scale), pg8::pk4_fp8(s[4 * 33] * scale, s[5 * 33] * scale, s[6 * 33] * scale, s[7 * 33] * scale)}; }
        else { v4u o; o.x = pk2(s[0 * 33] * scale, s[1 * 33] * scale); o.y = pk2(s[2 * 33] * scale, s[3 * 33] * scale); o.z = pk2(s[4 * 33] * scale, s[5 * 33] * scale); o.w = pk2(s[6 * 33] * scale, s[7 * 33] * scale);
            *(GAS v4u*)(WT + (size_t)(dst_n0 + n) * Kd + k0 + 8 * c) = o; } }
    LDS_WAIT(); asm volatile("" ::: "memory");
}
template <int KIND, bool F8 = false> __device__ __forceinline__ void conv_matrix(Frame& F, const float* W, int K, int N, bf16* WT, float s, int gw, int NGW, LAS float* scr, int Kd = 0) {
    if (Kd == 0) Kd = K;
    const int nnb = N / 32, nkb = K / 64, nit = nnb * nkb;
    for (int it = gw; it < nit; it += NGW) {
        const int kb = it / nnb, nb = it % nnb; const int dst_n0 = 32 * nb; int src_n0 = dst_n0; float sc = s;
        if (KIND == 1) sc = (dst_n0 < 384) ? s : 1.0f;
        if (F8) sc *= 32.0f;
        if (KIND == 2) { const int p = dst_n0 >> 8, j = dst_n0 & 255; src_n0 = (j < 128) ? (128 * p + j) : (1024 + 128 * p + (j - 128)); }
        tr_item<F8>(W, N, Kd, 64 * kb, src_n0, WT, dst_n0, sc, scr, F.lane);
    }
}
__device__ __forceinline__ void zero_rows(bf16* WT, int K, int n_lo, int n_hi, int gtid, int nthr) {
    const size_t n16 = (size_t)(n_hi - n_lo) * K / 8; GAS v4u* p = (GAS v4u*)(WT + (size_t)n_lo * K);
    for (size_t i = gtid; i < n16; i += nthr) p[i] = (v4u){0u, 0u, 0u, 0u};
}
__device__ __forceinline__ void p_prologue(Frame& F) {
    LAS float* scr = (LAS float*)(F.lds + F.wave * 16384);
    const int gw0 = F.vcu * NWAVES + F.wave, NGW = F.G * NWAVES, gtid = F.bx * (NWAVES * 64) + F.tid, nthr = F.G * NWAVES * 64;
    for (int l = 0; l < DEPTH; ++l) {
        unsigned char* wb = F.ws + WS_W + (size_t)l * WB_LAYER;
        int gw = gw0;
#define ROT(n) do { gw = (gw + NGW - ((n) % NGW)) % NGW; } while (0)
        if (F8IN(l)) { conv_matrix<1, true>(F, INP(1) + (size_t)l * 1024 * DIN, 1024, DIN, (bf16*)(wb + WB_IN), 0.125f * LOG2E_F, gw, NGW, scr); zero_rows((bf16*)(wb + WB_IN), 512, DIN, DINP, gtid, nthr); }
        else { conv_matrix<1>(F, INP(1) + (size_t)l * 1024 * DIN, 1024, DIN, (bf16*)(wb + WB_IN), 0.125f * LOG2E_F, gw, NGW, scr); zero_rows((bf16*)(wb + WB_IN), 1024, DIN, DINP, gtid, nthr); }
        ROT(16 * 173);
        conv_matrix<0>(F, INP(7) + (size_t)l * 384 * 384, 384, 384, (bf16*)(wb + WB_UQ), 0.10206207261596577f * LOG2E_F, gw, NGW, scr); ROT(72);
        zero_rows((bf16*)(wb + WB_UQ), 384, 384, 512, gtid, nthr);
        conv_matrix<0>(F, INP(8) + (size_t)l * 256 * 512, 256, 512, (bf16*)(wb + WB_UKV), 1.0f, gw, NGW, scr); ROT(64);
#if MK_E8
        conv_matrix<0, true>(F, INP(9) + (size_t)l * 384 * 1024, 384, 1024, (bf16*)(wb + WB_BA), 1.0f, gw, NGW, scr, 512); ROT(192);
        conv_matrix<0, true>(F, INP(10) + (size_t)l * 384 * 1024, 384, 1024, (bf16*)(wb + WB_BB), 1.0f, gw, NGW, scr, 512); ROT(192);
        conv_matrix<0, true>(F, INP(11) + (size_t)l * 256 * 1024, 256, 1024, (bf16*)(wb + WB_BC), 1.0f, gw, NGW, scr, 512); ROT(64);
        for (int i = gtid; i < 1024 * 8; i += nthr) { *((GAS v4u*)(wb + WB_BA + (size_t)(i >> 3) * 512 + 384) + (i & 7)) = (v4u){0u, 0u, 0u, 0u}; *((GAS v4u*)(wb + WB_BB + (size_t)(i >> 3) * 512 + 384) + (i & 7)) = (v4u){0u, 0u, 0u, 0u}; }
        for (int i = gtid; i < 1024 * 16; i += nthr) *((GAS v4u*)(wb + WB_BC + (size_t)(i >> 4) * 512 + 256) + (i & 15)) = (v4u){0u, 0u, 0u, 0u};
#else
        conv_matrix<0>(F, INP(9) + (size_t)l * 384 * 1024, 384, 1024, (bf16*)(wb + WB_BA), 1.0f, gw, NGW, scr); ROT(192);
        conv_matrix<0>(F, INP(10) + (size_t)l * 384 * 1024, 384, 1024, (bf16*)(wb + WB_BB), 1.0f, gw, NGW, scr); ROT(192);
        conv_matrix<0>(F, INP(11) + (size_t)l * 256 * 1024, 256, 1024, (bf16*)(wb + WB_BC), 1.0f, gw, NGW, scr, 384); ROT(64);
        for (int i = gtid; i < 1024 * 16; i += nthr) *((GAS v4u*)(wb + WB_BC) + (size_t)(i >> 4) * 48 + 32 + (i & 15)) = (v4u){0u, 0u, 0u, 0u};
#endif
        if (MK_FP8_OUT) conv_matrix<3, true>(F, INP(12) + (size_t)l * 1024 * 1024, 1024, 1024, (bf16*)(wb + WB_OUT), 2.0f, gw, NGW, scr); else conv_matrix<0>(F, INP(12) + (size_t)l * 1024 * 1024, 1024, 1024, (bf16*)(wb + WB_OUT), 1.0f, gw, NGW, scr);
        ROT(512);
#undef ROT
    }
    { const GAS f32x4* xs = (const GAS f32x4*)INP(0); GAS v4u* xd = (GAS v4u*)(F.ws + WS_XB);
      typedef unsigned u32x2 __attribute__((ext_vector_type(2))); GAS u32x2* x8 = (GAS u32x2*)(F.ws + WS_X2);
      for (size_t i = gtid; i < (size_t)T * D / 8; i += nthr) { const f32x4 a = xs[2 * i], b = xs[2 * i + 1]; xd[i] = (v4u){pk2(a.x, a.y), pk2(a.z, a.w), pk2(b.x, b.y), pk2(b.z, b.w)};
          if (F8IN(0)) x8[i] = (u32x2){pg8::pk4_fp8(a.x * 16.f, a.y * 16.f, a.z * 16.f, a.w * 16.f), pg8::pk4_fp8(b.x * 16.f, b.y * 16.f, b.z * 16.f, b.w * 16.f)}; } }
}

constexpr int CONV_ITEMS = NE * 1024 + NE * 512, CONV_LDS_OFF = 49152, CONV_LDS_WAVE = 2 * 16 * 33 * 4;
struct MoeConv {
    static constexpr bool PLAIN = false;
    const float* Wgu; const float* Wdn; unsigned char* Tgu; unsigned char* Tdn; bool f8;
    LAS float* scr; int lane; int gw, ngw, nmini; int s;
    float cvA[8], cvB[8];
    struct Mini { const float* W; unsigned char* WT; int ldw, k0, src_n0, dst_n0; float sc; };
    __device__ __forceinline__ Mini decode(int m) const {
        m = m < 0 ? 0 : (m >= nmini ? nmini - 1 : m);
        const int g = gw + (m >> 2) * ngw, q = m & 3; const bool gu = g < NE * 1024; const int h = gu ? g : g - NE * 1024;
        const int e = gu ? (h >> 10) : (h >> 9), r = gu ? (h & 1023) : (h & 511), kb = gu ? (r >> 6) : (r >> 5), nb = gu ? (r & 63) : (r & 31);
        Mini x; x.dst_n0 = 32 * nb; const int p = x.dst_n0 >> 8, j = x.dst_n0 & 255;
        x.src_n0 = gu ? ((j < 128) ? (128 * p + j) : (1024 + 128 * p + (j - 128))) : x.dst_n0; x.k0 = 64 * kb + 16 * q; x.ldw = gu ? 2048 : 1024;
        x.W = gu ? Wgu + (size_t)e * 1024 * 2048 : Wdn + (size_t)e * 1024 * 1024; const size_t es = f8 ? 1 : 2; x.WT = gu ? Tgu + (size_t)e * 2048 * 1024 * es : Tdn + (size_t)e * 1024 * 1024 * es; x.sc = gu ? 64.0f : 128.0f; return x;
    }
    __device__ __forceinline__ bool done() const { return s >= nmini + 3; }
    template <int P> __device__ __forceinline__ void step() {
        {   const Mini x = decode(s - 3); const LAS float* b = scr + (1 - P) * (16 * 33); const int n = lane >> 1, kh = lane & 1; const LAS float* p = b + (8 * kh) * 33 + n;
            const float q0 = p[0 * 33], q1 = p[1 * 33], q2 = p[2 * 33], q3 = p[3 * 33], q4 = p[4 * 33], q5 = p[5 * 33], q6 = p[6 * 33], q7 = p[7 * 33];
            const size_t eo = (size_t)(x.dst_n0 + n) * 1024 + x.k0 + 8 * kh;
            if (f8) { typedef unsigned u32x2 __attribute__((ext_vector_type(2)));
                *(GAS u32x2*)(x.WT + eo) = (u32x2){pg8::pk4_fp8(q0 * x.sc, q1 * x.sc, q2 * x.sc, q3 * x.sc), pg8::pk4_fp8(q4 * x.sc, q5 * x.sc, q6 * x.sc, q7 * x.sc)}; }
            else { v4u o; o.x = pk2(q0, q1); o.y = pk2(q2, q3); o.z = pk2(q4, q5); o.w = pk2(q6, q7); *(GAS v4u*)(x.WT + eo * 2) = o; } }
        {   LAS float* b = scr + P * (16 * 33);
#pragma unroll
            for (int jj = 0; jj < 8; ++jj) b[(2 * jj + (lane >> 5)) * 33 + (lane & 31)] = P ? cvB[jj] : cvA[jj]; }
    }
    template <int P> __device__ __forceinline__ void load() {
        {   const Mini x = decode(s); const GAS float* src = (const GAS float*)x.W + (size_t)(x.k0 + (lane >> 5)) * x.ldw + x.src_n0 + (lane & 31);
#pragma unroll
            for (int jj = 0; jj < 8; ++jj) { const float v = src[(size_t)(2 * jj) * x.ldw]; if (P) cvB[jj] = v; else cvA[jj] = v; } }
        ++s;
    }
};
__device__ __forceinline__ void p_prep(Frame& F, int l) {
    const bf16* hb = (const bf16*)(F.ws + WS_H); unsigned char* a2 = F.ws + WS_A2;
    unsigned char* k8 = a2 + A2_K8; unsigned char* vt8 = a2 + A2_VT8; bf16* kB = (bf16*)(a2 + A2_KB); bf16* cqn = (bf16*)(a2 + A2_CQN); bf16* ckvn = (bf16*)(a2 + A2_CKVN); bf16* kr = (bf16*)(a2 + A2_KR);
    const float* gk = INP(4) + l * 64; const float* gq = INP(5) + l * 384; const float* gkv = INP(6) + l * 256;
    const int lane = F.lane, gw = F.vcu * NWAVES + F.wave, NGW = F.G * NWAVES;
    v4u nk = {0u, 0u, 0u, 0u}, nq = nk, nkv = nk, nr = nk;
    if (gw < T) { const bf16* h0 = hb + (size_t)gw * DINP; if (lane < 16) nk = *(const GAS v4u*)(h0 + H_GK + lane * 8); if (lane < 48) nq = *(const GAS v4u*)(h0 + H_CQ + lane * 8);
        if (lane < 32) nkv = *(const GAS v4u*)(h0 + H_CKV + lane * 8); if (lane < 4) nr = *(const GAS v4u*)(h0 + H_KR + lane * 8); }
    if (MK_FP8_QK) {
        for (int th = gw; th < NB * (SEQ / 64) * 2; th += NGW) { const int kvh = th & 1, tile = (th >> 1) & (SEQ / 64 - 1), bb = th >> 8;
            const GAS bf16* vcol = (const GAS bf16*)(hb + ((size_t)bb * SEQ + (size_t)tile * 64) * DINP + H_GV + kvh * 64 + lane);
            unsigned short vv[64];
#pragma unroll
            for (int kk = 0; kk < 64; ++kk) vv[kk] = vcol[(size_t)kk * DINP];
            unsigned w[16];
#pragma unroll
            for (int g4 = 0; g4 < 16; ++g4) { const int wi = 8 * (g4 & 1) + 4 * (g4 >> 3) + ((g4 >> 1) & 3);
                int d_ = __builtin_amdgcn_cvt_pk_bf8_f32(bflo((unsigned)vv[4 * g4]), bflo((unsigned)vv[4 * g4 + 1]), 0, false);
                d_ = __builtin_amdgcn_cvt_pk_bf8_f32(bflo((unsigned)vv[4 * g4 + 2]), bflo((unsigned)vv[4 * g4 + 3]), d_, true); w[wi] = (unsigned)d_; }
            GAS v4u* dst = (GAS v4u*)(vt8 + ((size_t)th * 64 + lane) * 64);
            dst = (GAS v4u*)(vt8 + ((((size_t)(bb * 2 + kvh) * (SEQ / 64) + tile) * 64 + lane) * 64));
#pragma unroll
            for (int q = 0; q < 4; ++q) dst[q] = (v4u){w[4 * q], w[4 * q + 1], w[4 * q + 2], w[4 * q + 3]}; }
    }
    for (int t = gw; t < T; t += NGW) {
        const v4u wk_ = nk, wq_ = nq, wkv_ = nkv, wr_ = nr;
        if (t + NGW < T) { const bf16* h1 = hb + (size_t)(t + NGW) * DINP; if (lane < 16) nk = *(const GAS v4u*)(h1 + H_GK + lane * 8); if (lane < 48) nq = *(const GAS v4u*)(h1 + H_CQ + lane * 8);
            if (lane < 32) nkv = *(const GAS v4u*)(h1 + H_CKV + lane * 8); if (lane < 4) nr = *(const GAS v4u*)(h1 + H_KR + lane * 8); }
        const int s = t & (SEQ - 1); const float prow = (float)(s >> 6), pcol = (float)(s & 63);
#if MK_E8
        if (lane < 32) { unsigned char* yz = a2 + (lane < 8 ? A2_YA : (lane < 16 ? A2_YB : A2_YC)) + (size_t)t * 512 + (lane < 16 ? 384 + (lane & 7) * 16 : 256 + (lane - 16) * 16);
            unsigned z_ = 0u; asm volatile("v_mov_b32 %0, 0" : "=v"(z_)); *(GAS v4u*)yz = (v4u){z_, z_, z_, z_}; }
#endif
        {   float x[8]; float ssq = 0.f; const int cc = lane & 7;
            if (lane < 16) { const v4u w = wk_; x[0] = bflo(w.x); x[1] = bfhi(w.x); x[2] = bflo(w.y); x[3] = bfhi(w.y); x[4] = bflo(w.z); x[5] = bfhi(w.z); x[6] = bflo(w.w); x[7] = bfhi(w.w); }
            else {
#pragma unroll
                for (int j = 0; j < 8; ++j) x[j] = 0.f; }
#pragma unroll
            for (int j = 0; j < 8; ++j) ssq += x[j] * x[j];
            ssq += shx<1>(ssq, lane); ssq += shx<2>(ssq, lane); ssq += shx<4>(ssq, lane);
            const float rstd = 1.0f / sqrtf(ssq * (1.0f / 64.0f) + RMS_EPS);
            float y[8], o[8];
#pragma unroll
            for (int j = 0; j < 8; ++j) y[j] = x[j] * rstd * gk[(cc * 8 + j) & 63];
#pragma unroll
            for (int j = 0; j < 8; ++j) { const float other = shx<4>(y[j], lane); const int i = 8 * (cc & 3) + j;
                const float inv = exp2f(-(float)(i & 15) * (att::LOG2_THETA / 16.0f)); const float ang = ((i < 16) ? prow : pcol) * inv * att::INV2PI;
                const float c = __builtin_amdgcn_cosf(ang), sn = __builtin_amdgcn_sinf(ang);
                o[j] = (cc < 4) ? (y[j] * c - other * sn) : (other * sn + y[j] * c); }
            if (lane < 16) { *(GAS v4u*)(kB + (size_t)t * 128 + lane * 8) = (v4u){pk2(o[0], o[1]), pk2(o[2], o[3]), pk2(o[4], o[5]), pk2(o[6], o[7])};
                typedef unsigned u32x2 __attribute__((ext_vector_type(2)));
                *(GAS u32x2*)(k8 + (size_t)t * 128 + (lane >> 3) * 64 + 32 * (cc & 1) + 8 * (cc >> 1)) = (u32x2){pg8::pk4_fp8(o[0], o[1], o[2], o[3]), pg8::pk4_fp8(o[4], o[5], o[6], o[7])}; }
        }
        {   float x[8]; float ssq = 0.f;
            if (lane < 48) { const v4u w = wq_; x[0] = bflo(w.x); x[1] = bfhi(w.x); x[2] = bflo(w.y); x[3] = bfhi(w.y); x[4] = bflo(w.z); x[5] = bfhi(w.z); x[6] = bflo(w.w); x[7] = bfhi(w.w); }
            else {
#pragma unroll
                for (int j = 0; j < 8; ++j) x[j] = 0.f; }
#pragma unroll
            for (int j = 0; j < 8; ++j) ssq += x[j] * x[j];
            ssq = wave_sum(ssq, lane); const float rstd = 1.0f / sqrtf(ssq * (1.0f / 384.0f) + RMS_EPS);
            if (lane < 48) { float y[8];
#pragma unroll
                for (int j = 0; j < 8; ++j) y[j] = x[j] * rstd * gq[lane * 8 + j];
                *(GAS v4u*)(cqn + (size_t)t * 384 + lane * 8) = (v4u){pk2(y[0], y[1]), pk2(y[2], y[3]), pk2(y[4], y[5]), pk2(y[6], y[7])}; }
        }
        {   float x[8]; float ssq = 0.f;
            if (lane < 32) { const v4u w = wkv_; x[0] = bflo(w.x); x[1] = bfhi(w.x); x[2] = bflo(w.y); x[3] = bfhi(w.y); x[4] = bflo(w.z); x[5] = bfhi(w.z); x[6] = bflo(w.w); x[7] = bfhi(w.w); }
            else {
#pragma unroll
                for (int j = 0; j < 8; ++j) x[j] = 0.f; }
#pragma unroll
            for (int j = 0; j < 8; ++j) ssq += x[j] * x[j];
            ssq = wave_sum(ssq, lane); const float rstd = 1.0f / sqrtf(ssq * (1.0f / 256.0f) + RMS_EPS);
            if (lane < 32) { float y[8];
#pragma unroll
                for (int j = 0; j < 8; ++j) y[j] = x[j] * rstd * gkv[lane * 8 + j];
                *(GAS v4u*)(ckvn + (size_t)t * 256 + lane * 8) = (v4u){pk2(y[0], y[1]), pk2(y[2], y[3]), pk2(y[4], y[5]), pk2(y[6], y[7])}; }
        }
        {   float x[8]; const int cc = lane & 3;
            if (lane < 4) { const v4u w = wr_; x[0] = bflo(w.x); x[1] = bfhi(w.x); x[2] = bflo(w.y); x[3] = bfhi(w.y); x[4] = bflo(w.z); x[5] = bfhi(w.z); x[6] = bflo(w.w); x[7] = bfhi(w.w); }
            else {
#pragma unroll
                for (int j = 0; j < 8; ++j) x[j] = 0.f; }
            float o[8];
#pragma unroll
            for (int j = 0; j < 8; ++j) { const float other = shx<2>(x[j], lane);
                const float inv = exp2f(-(float)j * (att::LOG2_THETA / 8.0f)); const float ang = (((cc & 1) == 0) ? prow : pcol) * inv * att::INV2PI;
                const float c = __builtin_amdgcn_cosf(ang), sn = __builtin_amdgcn_sinf(ang);
                o[j] = (cc < 2) ? (x[j] * c - other * sn) : (other * sn + x[j] * c); }
            if (lane < 4) *(GAS v4u*)(kr + (size_t)t * 32 + lane * 8) = (v4u){pk2(o[0], o[1]), pk2(o[2], o[3]), pk2(o[4], o[5]), pk2(o[6], o[7])};
        }
    }
}


__device__ __forceinline__ int build_tables(Frame& F, int l) {
    LAS int* st = (LAS int*)(F.lds + TBL_START); LAS int* cn = st + 33; LAS int* te = (LAS int*)(F.lds + TBL_TILEE);
    __syncthreads();
    if (F.tid < NE) cn[F.tid] = (int)__hip_atomic_load(F.ctl + CW_CNT + 64 * l + F.tid, RLX_AGENT);
    __syncthreads();
    if (F.tid == 0) { int s = 0; for (int e = 0; e < NE; ++e) { st[e] = s; s += ((cn[e] + 255) >> 8) << 8; } st[NE] = s; }
    __syncthreads();
    const int total = st[NE];
    for (int tile = F.tid; tile < (total >> 8); tile += NWAVES * 64) { int e = 0; for (int k = 1; k < NE; ++k) e += (tile * 256 >= st[k]) ? 1 : 0; te[tile] = e; }
    __syncthreads();
    return total;
}

template <bool XBF> __device__ __forceinline__ void p_ln1_router(Frame& F, int l, const void* xin) {
    const bool w8 = F8MOE(l); unsigned char* x1f8 = F.ws + WS_X2;
    const float* xcur = (const float*)xin; const bf16* xcb = (const bf16*)xin;
    const bf16* outb = (const bf16*)(F.ws + WS_X1); bf16* x1b = (bf16*)(F.ws + WS_X1B);
    int* list_t = (int*)(F.ws + WS_LT); float* list_g = (float*)(F.ws + WS_LG); int* tok_e = (int*)(F.ws + WS_TE); int* tok_r = (int*)(F.ws + WS_TR);
    const float* wr = INP(15) + (size_t)l * 1024 * NE; const float* br = INP(16) + l * NE;
    const int lane0 = F.lane, tid = F.tid;
    LAS unsigned char* wl = F.lds;
    LAS int* sel_e = (LAS int*)(F.lds + TBL_RS); LAS float* sel_g = (LAS float*)(sel_e + 512); LAS int* sel_r = sel_e + 1024; LAS int* hist = sel_e + 1536; LAS int* base = hist + 32;
    __syncthreads();
    for (int idx = tid; idx < 1024 * 8; idx += NWAVES * 64) { const int k = idx >> 3, c = idx & 7, kp = (k & 3) * 256 + (k >> 2), cp = c ^ ((kp >> 1) & 7);
        *(LAS f32x4*)(wl + (kp * 8 + cp) * 16) = *(const GAS f32x4*)(wr + (size_t)k * NE + c * 4); }
    __syncthreads();
    for (int tile = F.bx; tile < T / 128; tile += F.G) {
        if (tid < 32) hist[tid] = 0;
        __syncthreads();
        f32x4 px[4]; unsigned long long po[4], pxb[4]; constexpr bool O8 = (MK_OUT8 != 0) && (MK_FP8_OUT != 0); const unsigned char* out8 = F.ws + WS_X1;
        {   const int t0 = tile * 128 + F.wave * 16; const GAS f32x4* xr0 = (const GAS f32x4*)(xcur + (size_t)t0 * D) + lane0; const GAS unsigned long long* or0 = (const GAS unsigned long long*)(outb + (size_t)t0 * D) + lane0;
#pragma unroll
            for (int j = 0; j < 4; ++j) { if (XBF) pxb[j] = ((const GAS unsigned long long*)(xcb + (size_t)t0 * D) + lane0)[64 * j]; else px[j] = xr0[64 * j]; if (O8) po[j] = ((const GAS unsigned*)(out8 + (size_t)t0 * D) + lane0)[64 * j]; else po[j] = or0[64 * j]; } }
        for (int it = 0; it < 16; ++it) {
            int lane = lane0; asm volatile("" : "+v"(lane));
            const int sw = (lane >> 1) & 7; const float bias_e = br[(lane >> 1) & 31];
            const GAS f32x4* lgp = (const GAS f32x4*)(INP(13) + l * D) + lane; const GAS f32x4* lbp = (const GAS f32x4*)(INP(14) + l * D) + lane;
            const int tl = F.wave * 16 + it, t = tile * 128 + tl;
            f32x4 v[4]; float s = 0.f;
#pragma unroll
            for (int j = 0; j < 4; ++j) { const unsigned long long ow = po[j]; const unsigned olo = (unsigned)ow, ohi = (unsigned)(ow >> 32);
                f32x4 xv_; if (XBF) { const unsigned xlo = (unsigned)pxb[j], xhi = (unsigned)(pxb[j] >> 32); xv_ = (f32x4){bflo(xlo), bfhi(xlo), bflo(xhi), bfhi(xhi)}; } else xv_ = px[j];
                f32x4 ov_; if (O8) { const auto a0 = __builtin_amdgcn_cvt_pk_f32_fp8((int)olo, false), a1 = __builtin_amdgcn_cvt_pk_f32_fp8((int)olo, true); ov_ = (f32x4){a0[0], a0[1], a1[0], a1[1]} * (1.0f / 32.0f); } else ov_ = (f32x4){bflo(olo), bfhi(olo), bflo(ohi), bfhi(ohi)};
                v[j] = xv_ * DN_ALPHA + ov_; s += (v[j].x + v[j].y) + (v[j].z + v[j].w); }
            if (it + 1 < 16) { const GAS f32x4* xr = (const GAS f32x4*)(xcur + (size_t)(t + 1) * D) + lane; const GAS unsigned long long* orr = (const GAS unsigned long long*)(outb + (size_t)(t + 1) * D) + lane;
#pragma unroll
                for (int j = 0; j < 4; ++j) { if (XBF) pxb[j] = ((const GAS unsigned long long*)(xcb + (size_t)(t + 1) * D) + lane)[64 * j]; else px[j] = xr[64 * j]; if (O8) po[j] = ((const GAS unsigned*)(out8 + (size_t)(t + 1) * D) + lane)[64 * j]; else po[j] = orr[64 * j]; } }
            const float mean = wave_sum(s, lane) * (1.f / D); float s2 = 0.f;
#pragma unroll
            for (int j = 0; j < 4; ++j) { v[j] = v[j] - mean; s2 += (v[j].x * v[j].x + v[j].y * v[j].y) + (v[j].z * v[j].z + v[j].w * v[j].w); }
            const float rstd = 1.f / sqrtf(wave_sum(s2, lane) * (1.f / D) + LN_EPS);
            GAS unsigned long long* o8 = (GAS unsigned long long*)(x1b + (size_t)t * D) + lane;
#pragma unroll
            for (int j = 0; j < 4; ++j) { v[j] = v[j] * rstd * lgp[64 * j] + lbp[64 * j];
                o8[64 * j] = (unsigned long long)pk2(v[j].x, v[j].y) | ((unsigned long long)pk2(v[j].z, v[j].w) << 32);
                if (w8) ((GAS unsigned*)(x1f8 + (size_t)t * D))[64 * j + lane] = pg8::pk4_fp8(v[j].x * 16.0f, v[j].y * 16.0f, v[j].z * 16.0f, v[j].w * 16.0f); }
            float acc[32];
#pragma unroll
            for (int c = 0; c < 8; ++c) {
                int basec = lane * 128 + ((c ^ sw) << 4); asm volatile("" : "+v"(basec));
                const LAS unsigned char* wp = wl + basec;
                typedef float f32x2p __attribute__((ext_vector_type(2)));
                f32x2p a01 = {0.f, 0.f}, a23 = {0.f, 0.f};
#pragma unroll
                for (int i = 0; i < 4; ++i)
#pragma unroll
                    for (int j = 0; j < 4; ++j) { const f32x4 w = *(const LAS f32x4*)(wp + (i * 256 + 64 * j) * 128); const float xv = v[j][i]; const f32x2p x2 = {xv, xv};
                        a01 = __builtin_elementwise_fma(x2, (f32x2p){w.x, w.y}, a01); a23 = __builtin_elementwise_fma(x2, (f32x2p){w.z, w.w}, a23); }
                acc[4 * c + 0] = a01.x; acc[4 * c + 1] = a01.y; acc[4 * c + 2] = a23.x; acc[4 * c + 3] = a23.y;
            }
            float a16[16], a8[8], a4[4], a2[2], a1;
            { const bool b = (lane & 32) != 0;
#pragma unroll
              for (int i = 0; i < 16; ++i) { const float send = b ? acc[i] : acc[16 + i]; const float keep = b ? acc[16 + i] : acc[i]; a16[i] = keep + shx<32>(send, lane); } }
            { const bool b = (lane & 16) != 0;
#pragma unroll
              for (int i = 0; i < 8; ++i) { const float send = b ? a16[i] : a16[8 + i]; const float keep = b ? a16[8 + i] : a16[i]; a8[i] = keep + shx<16>(send, lane); } }
            { const bool b = (lane & 8) != 0;
#pragma unroll
              for (int i = 0; i < 4; ++i) { const float send = b ? a8[i] : a8[4 + i]; const float keep = b ? a8[4 + i] : a8[i]; a4[i] = keep + shx<8>(send, lane); } }
            { const bool b = (lane & 4) != 0;
#pragma unroll
              for (int i = 0; i < 2; ++i) { const float send = b ? a4[i] : a4[2 + i]; const float keep = b ? a4[2 + i] : a4[i]; a2[i] = keep + shx<4>(send, lane); } }
            { const bool b = (lane & 2) != 0; const float send = b ? a2[0] : a2[1]; const float keep = b ? a2[1] : a2[0]; a1 = keep + shx<2>(send, lane); }
            a1 += shx<1>(a1, lane);
            float val = a1 + bias_e; const int my_e = (lane >> 1) & 31;
            float sv[4]; int se[4];
#pragma unroll
            for (int r = 0; r < 4; ++r) { float bv = val; int be = my_e;
#define TOPK_STEP(O) { const float ov = shx<O>(bv, lane); const int oe = shxi<O>(be, lane); if (ov > bv || (ov == bv && oe < be)) { bv = ov; be = oe; } }
                TOPK_STEP(2) TOPK_STEP(4) TOPK_STEP(8) TOPK_STEP(16) TOPK_STEP(32)
#undef TOPK_STEP
                sv[r] = bv; se[r] = be; if (my_e == be) val = -INFINITY; }
            const float e1 = __expf(sv[1] - sv[0]), e2 = __expf(sv[2] - sv[0]), e3 = __expf(sv[3] - sv[0]); const float rs = 1.0f / (1.0f + e1 + e2 + e3);
            if (lane < 4) { const int ee = lane == 0 ? se[0] : lane == 1 ? se[1] : lane == 2 ? se[2] : se[3]; const float gg = (lane == 0 ? 1.0f : lane == 1 ? e1 : lane == 2 ? e2 : e3) * rs;
                const int a = tl * 4 + lane; sel_e[a] = ee; sel_g[a] = gg; sel_r[a] = __hip_atomic_fetch_add(&hist[ee], 1, __ATOMIC_RELAXED, __HIP_MEMORY_SCOPE_WORKGROUP); }
        }
        __syncthreads();
        if (tid < 32) base[tid] = (int)__hip_atomic_fetch_add(F.ctl + CW_CNT + 64 * l + tid, (unsigned)hist[tid], RLX_AGENT);
        __syncthreads();
        { const int a = tid, e = sel_e[a], rank = base[e] + sel_r[a], t = tile * 128 + (a >> 2);
          list_t[(size_t)e * LCAP + rank] = t; list_g[(size_t)e * LCAP + rank] = sel_g[a]; tok_e[t * 4 + (a & 3)] = e; tok_r[t * 4 + (a & 3)] = rank; }
        __syncthreads();
    }
}

__device__ __forceinline__ void p_gather(Frame& F, int l) {
    const int total = build_tables(F, l);
    LAS int* st = (LAS int*)(F.lds + TBL_START); LAS int* cn = st + 33;
    const bf16* x1b = (const bf16*)(F.ws + WS_X1B); bf16* xg = (bf16*)(F.ws + WS_H); float* sg = (float*)(F.ws + WS_SG);
    const int* list_t = (const int*)(F.ws + WS_LT); const float* list_g = (const float*)(F.ws + WS_LG);
    const int lane = F.lane, gw = F.vcu * NWAVES + F.wave, NGW = F.G * NWAVES;
    for (int s = gw; s < total; s += NGW) {
        const bool pr = (lane < NE) && (s >= st[lane & 31]);
        const int e = __popcll(__ballot(pr)) - 1; const int r = s - st[e];
        GAS v4u* dst = (GAS v4u*)(xg + (size_t)s * D);
        if (r < cn[e]) { const int t = list_t[(size_t)e * LCAP + r]; const GAS v4u* src = (const GAS v4u*)(x1b + (size_t)t * D);
            dst[lane] = src[lane]; dst[64 + lane] = src[64 + lane]; if (lane == 0) sg[s] = list_g[(size_t)e * LCAP + r]; }
        else { unsigned zz = 0u; asm volatile("" : "+v"(zz)); const v4u z4 = {zz, zz, zz, zz}; dst[lane] = z4; dst[64 + lane] = z4; if (lane == 0) sg[s] = 0.f; }
    }
}

__device__ __forceinline__ void p_ln2(Frame& F, int l, float* dst, bool write_f32, bool write_xb) {
    (void)build_tables(F, l);
    LAS int* st = (LAS int*)(F.lds + TBL_START);
    const bf16* x1b = (const bf16*)(F.ws + WS_X1B); const bf16* yb = (const bf16*)(F.ws + WS_H); bf16* xb = (bf16*)(F.ws + WS_XB);
    const int* tok_e = (const int*)(F.ws + WS_TE); const int* tok_r = (const int*)(F.ws + WS_TR);
    const int lane = F.lane, hl = lane & 31, half = lane >> 5, gw = F.vcu * NWAVES + F.wave, NGW = F.G * NWAVES;
    const float* lgp = INP(21) + l * D; const float* lbp = INP(22) + l * D;
    float dmult = 1.0f;
#if MK_DEBUG
    if (l == DEPTH - 1) { const unsigned mask = __hip_atomic_load(F.ctl + 20000, RLX_AGENT) & ~(unsigned)(MK_DBG_IGNORE); if (mask) dmult = 1.0f + (float)(__ffs((int)mask) - 1); }
#endif
    static_assert(!MK_Y8 || (MK_FP8_LAST && MK_FP8_MOE_ALL), "MK_Y8: every layer's down-projection leaves fp8 rows");
    typedef unsigned u32x2y __attribute__((ext_vector_type(2))); constexpr bool y8 = true; v4u yw16[4][4]; (void)yw16;
    int t = 2 * gw + half; const int step = 2 * NGW, k4 = hl & 3;
    if (t < T) {
        const int niter = (T - 1 - t) / step + 1;
        v4u xn[4]; u32x2y yn[4][4];
        int eB = tok_e[t * 4 + k4], rB = tok_r[t * 4 + k4];
#define LN2_FETCH(tt) do { const int slot4_ = st[eB] + rB; int slot_[4]; _Pragma("unroll") for (int k = 0; k < 4; ++k) slot_[k] = __builtin_amdgcn_ds_bpermute((half * 32 + k) << 2, slot4_); \
            { const GAS v4u* xr_ = (const GAS v4u*)(x1b + (size_t)(tt) * D) + hl; _Pragma("unroll") for (int q = 0; q < 4; ++q) xn[q] = xr_[32 * q]; } \
            _Pragma("unroll") for (int k = 0; k < 4; ++k) { const GAS u32x2y* yr_ = (const GAS u32x2y*)((const unsigned char*)yb + (size_t)slot_[k] * D) + hl; _Pragma("unroll") for (int q = 0; q < 4; ++q) yn[k][q] = yr_[32 * q]; } } while (0)
        LN2_FETCH(t);
        { const int tb = t + step < T ? t + step : t; eB = tok_e[tb * 4 + k4]; rB = tok_r[tb * 4 + k4]; }
        auto ln2_token = [&](const int t, const v4u (&xw)[4], const u32x2y (&yw)[4][4]) __attribute__((always_inline)) {
        float v[4][8]; float s = 0.f;
#pragma unroll
        for (int q = 0; q < 4; ++q) {
            v[q][0] = bflo(xw[q].x) * DN_ALPHA; v[q][1] = bfhi(xw[q].x) * DN_ALPHA; v[q][2] = bflo(xw[q].y) * DN_ALPHA; v[q][3] = bfhi(xw[q].y) * DN_ALPHA;
            v[q][4] = bflo(xw[q].z) * DN_ALPHA; v[q][5] = bfhi(xw[q].z) * DN_ALPHA; v[q][6] = bflo(xw[q].w) * DN_ALPHA; v[q][7] = bfhi(xw[q].w) * DN_ALPHA;
#pragma unroll
#if MK_Y8
            for (int k = 0; k < 4; ++k) { if (y8) { const auto a0 = __builtin_amdgcn_cvt_pk_f32_fp8((int)yw[k][q].x, false), a1 = __builtin_amdgcn_cvt_pk_f32_fp8((int)yw[k][q].x, true), a2 = __builtin_amdgcn_cvt_pk_f32_fp8((int)yw[k][q].y, false), a3 = __builtin_amdgcn_cvt_pk_f32_fp8((int)yw[k][q].y, true);
                    v[q][0] += a0[0] * (1.f / 32.f); v[q][1] += a0[1] * (1.f / 32.f); v[q][2] += a1[0] * (1.f / 32.f); v[q][3] += a1[1] * (1.f / 32.f); v[q][4] += a2[0] * (1.f / 32.f); v[q][5] += a2[1] * (1.f / 32.f); v[q][6] += a3[0] * (1.f / 32.f); v[q][7] += a3[1] * (1.f / 32.f); }
                else { v[q][0] += bflo(yw16[k][q].x); v[q][1] += bfhi(yw16[k][q].x); v[q][2] += bflo(yw16[k][q].y); v[q][3] += bfhi(yw16[k][q].y);
                    v[q][4] += bflo(yw16[k][q].z); v[q][5] += bfhi(yw16[k][q].z); v[q][6] += bflo(yw16[k][q].w); v[q][7] += bfhi(yw16[k][q].w); } }
#else
            for (int k = 0; k < 4; ++k) { v[q][0] += bflo(yw[k][q].x); v[q][1] += bfhi(yw[k][q].x); v[q][2] += bflo(yw[k][q].y); v[q][3] += bfhi(yw[k][q].y);
                v[q][4] += bflo(yw[k][q].z); v[q][5] += bfhi(yw[k][q].z); v[q][6] += bflo(yw[k][q].w); v[q][7] += bfhi(yw[k][q].w); }
#endif
#pragma unroll
            for (int i = 0; i < 8; ++i) s += v[q][i]; }
        s += shx<1>(s, lane); s += shx<2>(s, lane); s += shx<4>(s, lane); s += shx<8>(s, lane); s += shx<16>(s, lane);
        const float mean = s * (1.f / D); float s2 = 0.f;
#pragma unroll
        for (int q = 0; q < 4; ++q)
#pragma unroll
            for (int i = 0; i < 8; ++i) { v[q][i] -= mean; s2 += v[q][i] * v[q][i]; }
        s2 += shx<1>(s2, lane); s2 += shx<2>(s2, lane); s2 += shx<4>(s2, lane); s2 += shx<8>(s2, lane); s2 += shx<16>(s2, lane);
        const float rstd = 1.f / sqrtf(s2 * (1.f / D) + LN_EPS);
        GAS f32x4* orow = (GAS f32x4*)(dst + (size_t)t * D) + 2 * hl; GAS v4u* o16 = (GAS v4u*)(xb + (size_t)t * D) + hl;
#pragma unroll
        for (int q = 0; q < 4; ++q) { const GAS f32x4* gq = (const GAS f32x4*)(lgp + 256 * q) + 2 * hl; const GAS f32x4* bq = (const GAS f32x4*)(lbp + 256 * q) + 2 * hl;
            const f32x4 g0 = gq[0], g1 = gq[1], b0 = bq[0], b1 = bq[1];
            f32x4 y0 = {v[q][0] * rstd, v[q][1] * rstd, v[q][2] * rstd, v[q][3] * rstd}, y1 = {v[q][4] * rstd, v[q][5] * rstd, v[q][6] * rstd, v[q][7] * rstd};
            y0 = y0 * g0 + b0; y1 = y1 * g1 + b1;
            if (write_f32) { orow[64 * q] = y0 * dmult; orow[64 * q + 1] = y1 * dmult; }
            if (write_xb) { o16[32 * q] = (v4u){pk2(y0.x, y0.y), pk2(y0.z, y0.w), pk2(y1.x, y1.y), pk2(y1.z, y1.w)};
                if (F8IN(l + 1)) { typedef unsigned u32x2 __attribute__((ext_vector_type(2)));
                    ((GAS u32x2*)(F.ws + WS_X2 + (size_t)t * D))[hl + 32 * q] = (u32x2){pg8::pk4_fp8(y0.x * 16.f, y0.y * 16.f, y0.z * 16.f, y0.w * 16.f), pg8::pk4_fp8(y1.x * 16.f, y1.y * 16.f, y1.z * 16.f, y1.w * 16.f)}; } } }
        };
        for (int it = 0; it + 1 < niter; ++it, t += step) {
            v4u xw[4]; u32x2y yw[4][4];
#pragma unroll
            for (int q = 0; q < 4; ++q) { xw[q] = xn[q];
#pragma unroll
                for (int k = 0; k < 4; ++k) yw[k][q] = yn[k][q]; }
            LN2_FETCH(t + step);
            { const int tc = t + 2 * step < T ? t + 2 * step : t + step; eB = tok_e[tc * 4 + k4]; rB = tok_r[tc * 4 + k4]; }
            ln2_token(t, xw, yw);
        }
        ln2_token(t, xn, yn);
#undef LN2_FETCH
    }
}

template <int WHICH> __device__ __forceinline__ void p_attention(Frame& F, int l) {
    const bf16* hb = (const bf16*)(F.ws + WS_H); unsigned char* a2 = F.ws + WS_A2;
    const bf16* kB = (const bf16*)(a2 + A2_KB); const bf16* kr = (const bf16*)(a2 + A2_KR); const bf16* qc = (const bf16*)(a2 + A2_QC); const bf16* kvc = (const bf16*)(a2 + A2_KVC);
    bf16* ya = (bf16*)(a2 + A2_YA); bf16* yb = (bf16*)(a2 + A2_YB); bf16* yc = (bf16*)(a2 + A2_YC);
    att::ALAS_PTR lds = (att::ALAS_PTR)F.lds;
    att::NoSide noside;
    __syncthreads();
    if (WHICH == 0) {
        float mq = fabsf((INP(3) + l * 64)[F.lane]), mk = fabsf((INP(4) + l * 64)[F.lane]);
#define MX_STEP(O) { mq = fmaxf(mq, shx<O>(mq, F.lane)); mk = fmaxf(mk, shx<O>(mk, F.lane)); }
        MX_STEP(1) MX_STEP(2) MX_STEP(4) MX_STEP(8) MX_STEP(16) MX_STEP(32)
#undef MX_STEP
        const float cref = __int_as_float(__builtin_amdgcn_readfirstlane(__float_as_int(8.0f * LOG2E_F * 1.03f * mq * mk)));
        const bool fixed_ok = cref < 60.0f;
        unsigned char* wbl = F.ws + WS_W + (size_t)l * WB_LAYER;
        MoeConv cv; cv.Wgu = INP(17) + (size_t)l * NE * 1024 * 2048; cv.Wdn = INP(19) + (size_t)l * NE * 1024 * 1024; cv.Tgu = wbl + WB_GU; cv.Tdn = wbl + WB_DN; cv.f8 = F8MOE(l);
        cv.scr = (LAS float*)(F.lds + CONV_LDS_OFF + F.wave * CONV_LDS_WAVE); cv.lane = F.lane; cv.ngw = F.G * NWAVES; cv.gw = F.vcu * NWAVES + F.wave; cv.s = 0;
        cv.nmini = 4 * ((CONV_ITEMS - cv.gw + cv.ngw - 1) / cv.ngw);
#pragma unroll
        for (int i_ = 0; i_ < 8; ++i_) { cv.cvA[i_] = 0.f; cv.cvB[i_] = 0.f; }
        for (int idx = F.vcu; idx < 768; idx += F.G) {
            const int qi = idx >> 8, rem = idx & 255, bk = rem >> 5, qb = rem & 31, b = bk >> 1, kvh = bk & 1, head = kvh * 3 + qi;
            att::UnitP u; const size_t tb = (size_t)b * SEQ, tq = tb + (size_t)qb * 256;
            u.Q = hb + tq * DINP + H_GQ + head * 64; u.ldq = DINP; u.K0 = kB + tb * 128 + kvh * 64; u.ldk0 = 128; u.K1 = nullptr; u.ldk1 = 0;
            u.V = hb + tb * DINP + H_GV + kvh * 64; u.ldv = DINP; u.O = MK_E8 ? (bf16*)((unsigned char*)yb + tq * 512 + head * 64) : yb + tq * 384 + head * 64; u.ldo = MK_E8 ? 512 : 384; u.nt = SEQ / 64; u.grow0 = qb * 4; u.gain = INP(3) + l * 64; u.kr0 = 0; u.cref = cref;
            u.K8 = a2 + A2_K8 + tb * 128 + kvh * 64; u.ldk8 = 128; u.V8 = a2 + A2_VT8 + (size_t)(b * 2 + kvh) * (SEQ / 64) * 4096;
            if (MK_FP8_QK && cref <= 15.0f) att::attn_unit<64, 0, MoeConv, true, (MK_FP8_PV != 0)>(u, lds, F.tid, cv);
            else if (!MK_FP8_QK && fixed_ok) att::attn_unit<64, 0, MoeConv, false>(u, lds, F.tid, cv);
            else att::attn_unit<64, 3, MoeConv>(u, lds, F.tid, cv);
        }
        while (!cv.done()) { cv.step<0>(); cv.load<0>(); cv.step<1>(); cv.load<1>(); }
    }
    if (WHICH == 1) for (int idx = F.vcu; idx < 512; idx += F.G) {
        const int rnd = idx >> 8, rem = idx & 255, p = (rem >> 5) * 2 + rnd, qb = rem & 31, b = p >> 2, h = p & 3;
        att::UnitP u; const size_t tb = (size_t)b * SEQ, tq = tb + (size_t)qb * 256;
        u.Q = qc + tq * 384 + h * 96; u.ldq = 384; u.K0 = kvc + tb * 512 + h * 128; u.ldk0 = 512; u.K1 = kr + tb * 32; u.ldk1 = 32;
        u.V = kvc + tb * 512 + h * 128 + 64; u.ldv = 512; u.O = MK_E8 ? (bf16*)((unsigned char*)yc + tq * 512 + h * 64) : yc + tq * 384 + h * 64; u.ldo = MK_E8 ? 512 : 384; u.nt = SEQ / 64; u.grow0 = qb * 4; u.gain = nullptr; u.kr0 = 0; u.cref = 0.f; u.K8 = a2 + A2_K8M + tb * 256 + h * 64; u.ldk8 = 256; u.V8 = a2 + A2_VT8M + (size_t)(b * 4 + h) * (SEQ / 64) * 4096;
        att::attn_unit<96, 1, att::NoSide, (MK_FP8_QKM != 0 && MK_FP8_PVM != 0), (MK_FP8_PVM != 0)>(u, lds, F.tid, noside);
    }
    if (WHICH == 2) for (int idx = F.vcu; idx < 768; idx += F.G) {
        const int b = idx / 192, rem = idx % 192, h = rem >> 5, rg = rem & 31, R0 = rg * 4;
        int r_lo = R0 - 4; r_lo = r_lo < 0 ? 0 : (r_lo > 120 ? 120 : r_lo);
        int r_hi = R0 - 1; r_hi = (r_hi < 0 ? 0 : (r_hi > 120 ? 120 : r_hi)) + 8;
        if ((r_hi - r_lo) & 1) { if (r_hi < 128) ++r_hi; else --r_lo; }
        {
            LAS float* bt = (LAS float*)(F.lds + att::OFF_BIAS); const float* rp = INP(2) + ((size_t)l * 6 + h) * 465;
#pragma unroll
            for (int k = 0; k < 4; ++k) { const int e = F.tid + 512 * k, dr = e >> 7, x = (e & 127) - 48;
                if (e < 15 * 128) bt[e] = (x >= 0 && x <= 30) ? rp[dr * 31 + x] * LOG2E_F : 0.f; } }
        att::UnitP u; const size_t tb = (size_t)b * SEQ, tq = tb + (size_t)R0 * 64, tk = tb + (size_t)r_lo * 64;
        u.Q = hb + tq * DINP + H_NAQ + h * 64; u.ldq = DINP; u.K0 = hb + tk * DINP + H_NAK + h * 64; u.ldk0 = DINP; u.K1 = nullptr; u.ldk1 = 0;
        u.V = hb + tk * DINP + H_NAV + h * 64; u.ldv = DINP; u.O = MK_E8 ? (bf16*)((unsigned char*)ya + tq * 512 + h * 64) : ya + tq * 384 + h * 64; u.ldo = MK_E8 ? 512 : 384; u.nt = r_hi - r_lo; u.grow0 = R0; u.gain = nullptr; u.kr0 = r_lo; u.cref = 0.f; u.K8 = nullptr; u.ldk8 = 0; u.V8 = nullptr;
        att::attn_unit<64, 2>(u, lds, F.tid, noside);
    }
}


#ifndef STAG_A
#define STAG_A 0
#endif
#ifndef NT_A
#define NT_A 1
#endif
#ifndef STAG_AG
#define STAG_AG 4
#endif
#ifndef STAG_J
#define STAG_J 0
#endif
#ifndef STAG_I
#define STAG_I 0
#endif
#ifndef PROBE_AM
#define PROBE_AM 0
#endif
#ifndef PROBE_I1
#define PROBE_I1 0
#endif
struct Args { const float* in[23]; float* out; unsigned char* ws; int ph_lo, ph_hi, use_bar, pad; };
__global__ void __launch_bounds__(NWAVES * 64, 2) mk_fwd(Args args) {
    extern __shared__ __attribute__((aligned(16))) unsigned char lds[];
    const int wave_id = __builtin_amdgcn_readfirstlane((int)threadIdx.x >> 6), bx0 = blockIdx.x, G0 = gridDim.x;
    {   LAS unsigned* z = (LAS unsigned*)((LAS unsigned char*)lds + LDSCTL_OFF); for (int u = threadIdx.x; u < (LDS_BYTES - LDSCTL_OFF) / 4; u += NWAVES * 64) z[u] = 0u; }
    __syncthreads();
    XcdBarrier bar; bar.bar = (unsigned*)(args.ws + WS_CTL) + CW_BAR; bar.x = 0; bar.st = nullptr;
    if (args.use_bar) bar = xcd_barrier_post((unsigned*)(args.ws + WS_CTL) + CW_BAR, (volatile LAS unsigned*)((LAS unsigned char*)lds + MISC_OFF));
    const int lo = args.ph_lo, hi = args.ph_hi;
#define IN(k) (lo <= (k) && (k) < hi)
#define REPEAT(n) for (int rep_ = 0; rep_ < (n); ++rep_)
#define RSEAM(n) do { if (rep_ + 1 < (n)) { XcdBarrier b_ = bar; { GAS unsigned* bb_ = (GAS unsigned*)b_.bar; asm volatile("; rseam %1" : "+s"(bb_) : "n"(__COUNTER__)); b_.bar = (unsigned*)bb_; } xcd_barrier(b_); } } while (0)
#define SEAM(k) do { if (IN(k) && IN((k) + 1)) { XcdBarrier b_ = bar; { GAS unsigned* bb_ = (GAS unsigned*)b_.bar; asm volatile("; seam %1" : "+s"(bb_) : "n"(__COUNTER__)); b_.bar = (unsigned*)bb_; } xcd_barrier(b_); } } while (0)
#define FRAME() Frame F = mkframe<__COUNTER__>((LAS unsigned char*)lds, args.ws, args.out, wave_id, bx0, G0); unsigned char* ws = F.ws; unsigned char* a2 = ws + WS_A2; unsigned char* wb = ws + WS_W + (size_t)l * WB_LAYER; (void)a2; (void)wb

    if (IN(0)) REPEAT(REP_P) { Frame F = mkframe<__COUNTER__>((LAS unsigned char*)lds, args.ws, args.out, wave_id, bx0, G0); p_prologue(F); RSEAM(REP_P); } SEAM(0);

    for (int l = 0; l < DEPTH; ++l) {
        const int pb = 1 + l * PPL;
        if (IN(pb + 0)) REPEAT(REP_A) { FRAME();
            pg8::StaticOrder S; S.init(T, DINP, F.G, F.bx);
            if (!F8IN(l)) {
                pg8::Gemm g{(const bf16*)(ws + WS_XB), (const bf16*)(wb + WB_IN), T, DINP, 1024, 0, 0, (const void*)ws};
                pg8::EpiStore E{(bf16*)(ws + WS_H), DINP, DINP, 1.0f};
                pg8::gemm_phase<pg8::EpiStore, pg8::StaticOrder, true, true>(F.lds, g, S, E, F.tid);
            } else {
                pg8::Gemm g{(const bf16*)(ws + WS_X2), (const bf16*)(wb + WB_IN), T, DINP, 1024, 0, 0, (const void*)ws};
#if MK_GATE_EXP
                pg8::EpiStoreGE E{(bf16*)(ws + WS_H), DINP, DINP, 1.0f / 512.0f, H_GATE};
                pg8::gemm_phase<pg8::EpiStoreGE, pg8::StaticOrder, true, true, false, pg8::NoGather, 1>(F.lds, g, S, E, F.tid);
#else
                pg8::EpiStore E{(bf16*)(ws + WS_H), DINP, DINP, 1.0f / 512.0f};
                pg8::gemm_phase<pg8::EpiStore, pg8::StaticOrder, true, true, false, pg8::NoGather, 1>(F.lds, g, S, E, F.tid);
#endif
            }
            RSEAM(REP_A);
        } SEAM(pb + 0);
        if (IN(pb + 1)) REPEAT(REP_B) { FRAME(); p_prep(F, l); RSEAM(REP_B); } SEAM(pb + 1);
        if (IN(pb + 2)) REPEAT(REP_C) {
            { FRAME(); pg8::Gemm g{(const bf16*)(a2 + A2_CQN), (const bf16*)(wb + WB_UQ), T, 512, 384, 0, 0, (const void*)ws}; pg8::StaticOrder S; S.init(T, 512, F.G, F.bx);
              pg8::EpiStore E{(bf16*)(a2 + A2_QC), 384, 384, 1.0f};
              pg8::gemm_phase<pg8::EpiStore, pg8::StaticOrder, true, true>(F.lds, g, S, E, F.tid); }
            { FRAME(); pg8::Gemm g{(const bf16*)(a2 + A2_CKVN), (const bf16*)(wb + WB_UKV), T, 512, 256, 0, 0, (const void*)ws}; pg8::StaticOrder S; S.init(T, 512, F.G, F.bx);
#if MK_FP8_PVM
              pg8::EpiStoreV8 E{(bf16*)(a2 + A2_KVC), a2 + A2_VT8M, a2 + A2_K8M};
              pg8::gemm_phase<pg8::EpiStoreV8, pg8::StaticOrder, true, true>(F.lds, g, S, E, F.tid); }
#else
              pg8::EpiStore E{(bf16*)(a2 + A2_KVC), 512, 512, 1.0f};
              pg8::gemm_phase<pg8::EpiStore, pg8::StaticOrder, true, true>(F.lds, g, S, E, F.tid); }
#endif
            RSEAM(REP_C);
        } SEAM(pb + 2);
        if (IN(pb + 3)) { REPEAT(REP_DG) { FRAME(); p_attention<0>(F, l); RSEAM(REP_DG); } REPEAT(REP_DM) { FRAME(); p_attention<1>(F, l); RSEAM(REP_DM); } REPEAT(REP_DN) { FRAME(); p_attention<2>(F, l); RSEAM(REP_DN); } } SEAM(pb + 3);
        if (IN(pb + 4)) REPEAT(REP_E) { FRAME();
            pg8::ChainOrder S; S.so.init(T, 1024, F.G, F.bx); S.nch = 3;
#if MK_E8
            pg8::Gemm g{(const bf16*)(a2 + A2_YA), (const bf16*)(wb + WB_BA), T, 1024, 512, (size_t)1024 * 384 * 2, (size_t)T * 384 * 2, (const void*)ws};
            pg8::EpiGateChain E{(const bf16*)(ws + WS_H) + H_GATE, DINP, (void*)(a2 + A2_MIXED), 256.0f / 2048.0f};
            pg8::gemm_phase<pg8::EpiGateChain, pg8::ChainOrder, true, true, false, pg8::NoGather, 1>(F.lds, g, S, E, F.tid);
#else
            pg8::Gemm g{(const bf16*)(a2 + A2_YA), (const bf16*)(wb + WB_BA), T, 1024, 384, (size_t)1024 * 384 * 2, (size_t)T * 384 * 2, (const void*)ws};
            pg8::EpiGateChain E{(const bf16*)(ws + WS_H) + H_GATE, DINP, (void*)(a2 + A2_MIXED), MK_FP8_OUT ? 256.0f : 0.0f};
            pg8::gemm_phase<pg8::EpiGateChain, pg8::ChainOrder, true, true>(F.lds, g, S, E, F.tid);
#endif
            RSEAM(REP_E);
        } SEAM(pb + 4);
        if (IN(pb + 5)) REPEAT(REP_F) { FRAME();
            pg8::StaticOrder S; S.init(T, 1024, F.G, F.bx);
            if (!MK_FP8_OUT) { pg8::Gemm g{(const bf16*)(a2 + A2_MIXED), (const bf16*)(wb + WB_OUT), T, 1024, 1024, 0, 0, (const void*)ws};
                pg8::EpiStore E{(bf16*)(ws + WS_X1), 1024, 1024, 1.0f};
                pg8::gemm_phase<pg8::EpiStore, pg8::StaticOrder, true, true>(F.lds, g, S, E, F.tid); }
            else { pg8::Gemm g{(const bf16*)(a2 + A2_MIXED), (const bf16*)(wb + WB_OUT), T, 1024, 1024, 0, 0, (const void*)ws};
#if MK_OUT8
                pg8::EpiStoreF8 E{ws + WS_X1, 1024, 32.0f / 16384.0f};
                pg8::gemm_phase<pg8::EpiStoreF8, pg8::StaticOrder, true, true, false, pg8::NoGather, 1>(F.lds, g, S, E, F.tid); }
#else
                pg8::EpiStore E{(bf16*)(ws + WS_X1), 1024, 1024, 1.0f / 16384.0f};
                pg8::gemm_phase<pg8::EpiStore, pg8::StaticOrder, true, true, false, pg8::NoGather, 1>(F.lds, g, S, E, F.tid); }
#endif
            RSEAM(REP_F);
        } SEAM(pb + 5);
        if (IN(pb + 6)) { FRAME(); p_ln1_router<true>(F, l, ws + WS_XB);   } SEAM(pb + 6);
        const bool f8l = F8MOE(l);
        if (IN(pb + 7)) REPEAT(REP_I) { FRAME();
            const int total = build_tables(F, l);
            pg8::MoeOrder S{8, (total >> 8) * 8, F.G, F.vcu, (const LAS int*)(F.lds + TBL_TILEE)};
            pg8::MoeGather gs{(const int*)(ws + WS_LT), (const LAS int*)(F.lds + TBL_START), (const LAS int*)(F.lds + TBL_START) + 33, LCAP};
            if (!f8l) {
                pg8::Gemm g{(const bf16*)(ws + WS_X1B), (const bf16*)(wb + WB_GU), total, 2048, 1024, (size_t)2048 * 1024 * 2, 0, nullptr};
                pg8::EpiSwigluT<false> E{(void*)(ws + WS_A2), INP(18) + (size_t)l * NE * 2048, 1.0f, 1.0f};
                pg8::gemm_phase<pg8::EpiSwigluT<false>, pg8::MoeOrder, true, true, true, pg8::MoeGather>(F.lds, g, S, E, F.tid, gs);
            } else {
                pg8::Gemm g{(const bf16*)(ws + WS_X2), (const bf16*)(wb + WB_GU), total, 2048, 1024, (size_t)2048 * 1024, 0, (const void*)ws, (rep_ + 1 < REP_I) ? PROBE_I1 : 0};
                pg8::EpiSwigluT<true> E{(void*)(ws + WS_A2), INP(18) + (size_t)l * NE * 2048, 1.0f / 1024.0f, 4.0f};
                if (STAG_I > 0) stagger(F, (F.vcu * 4) / F.G, STAG_I);
                pg8::gemm_phase<pg8::EpiSwigluT<true>, pg8::MoeOrder, true, true, true, pg8::MoeGather, 1>(F.lds, g, S, E, F.tid, gs);
            }
            RSEAM(REP_I);
        } SEAM(pb + 7);
        if (IN(pb + 8)) REPEAT(REP_J) { FRAME();
            const int total = build_tables(F, l);
            pg8::MoeOrder S{4, (total >> 8) * 4, F.G, F.vcu, (const LAS int*)(F.lds + TBL_TILEE)};
            if (!f8l) {
                pg8::Gemm g{(const bf16*)(ws + WS_A2), (const bf16*)(wb + WB_DN), total, 1024, 1024, (size_t)1024 * 1024 * 2, 0, nullptr};
                pg8::EpiDown E{(bf16*)(ws + WS_H), INP(20) + (size_t)l * NE * 1024, (const float*)(ws + WS_LG), (const LAS int*)(F.lds + TBL_START), (const LAS int*)(F.lds + TBL_START) + 33, LCAP, 1.0f};
                pg8::gemm_phase<pg8::EpiDown, pg8::MoeOrder, true, true>(F.lds, g, S, E, F.tid);
            } else {
                pg8::Gemm g{(const bf16*)(ws + WS_A2), (const bf16*)(wb + WB_DN), total, 1024, 1024, (size_t)1024 * 1024, 0, (const void*)ws};
                pg8::EpiDown E{(bf16*)(ws + WS_H), INP(20) + (size_t)l * NE * 1024, (const float*)(ws + WS_LG), (const LAS int*)(F.lds + TBL_START), (const LAS int*)(F.lds + TBL_START) + 33, LCAP, 1.0f / 512.0f};
                if (STAG_J > 0) stagger(F, (F.vcu * 4) / F.G, STAG_J);
                pg8::gemm_phase<pg8::EpiDown, pg8::MoeOrder, true, true, false, pg8::NoGather, 1>(F.lds, g, S, E, F.tid);
            }
            RSEAM(REP_J);
        } SEAM(pb + 8);
        if (IN(pb + 9)) REPEAT(REP_K) { FRAME(); RSEAM(REP_K); p_ln2(F, l, F.out, l == DEPTH - 1, l + 1 < DEPTH); }
        if (l + 1 < DEPTH) SEAM(pb + 9);
    }
#undef IN
#undef SEAM
}


#if MK_DEBUG
constexpr int CW_DBG = 20000;
__device__ __forceinline__ float bfr(float f) { return __uint_as_float(f2bf(f) << 16); }
__device__ __forceinline__ float bfv(const bf16* p) { return __uint_as_float(((unsigned)*p) << 16); }
__device__ __forceinline__ unsigned hsh(unsigned x) { x ^= x >> 16; x *= 0x7feb352du; x ^= x >> 15; x *= 0x846ca68bu; x ^= x >> 16; return x; }
__device__ __forceinline__ bool close_(float got, float ref, float rel, float abs_) { return fabsf(got - ref) <= rel * fabsf(ref) + abs_; }
__device__ __forceinline__ void ropecs(int i, int quarter, int s, float& c, float& sn) {
    const float pos = (i < quarter) ? (float)(s >> 6) : (float)(s & 63); const int m = (i < quarter) ? i : i - quarter;
    const float inv = exp2f(-(float)m / (float)quarter * 13.287712379549449f); const float ang = pos * inv * 0.15915494309189535f; c = __builtin_amdgcn_cosf(ang); sn = __builtin_amdgcn_sinf(ang);
}
#define DBG_FAIL(bit) atomicOr((unsigned*)(ws + WS_CTL) + CW_DBG, 1u << (bit))
template <int stage> __global__ void __launch_bounds__(256) dbg_kernel(Args args) {
    unsigned char* ws = args.ws; const int l = 0;
    const int gid = blockIdx.x * 256 + threadIdx.x;
    const bf16* hb = (const bf16*)(ws + WS_H); unsigned char* a2 = ws + WS_A2; unsigned char* wb = ws + WS_W + (size_t)l * WB_LAYER;
    const bf16* kB = (const bf16*)(a2 + A2_KB); const bf16* cqn = (const bf16*)(a2 + A2_CQN); const bf16* ckvn = (const bf16*)(a2 + A2_CKVN); const bf16* kr = (const bf16*)(a2 + A2_KR);
    const bf16* qc = (const bf16*)(a2 + A2_QC); const bf16* kvc = (const bf16*)(a2 + A2_KVC);
    const bf16* ya = (const bf16*)(a2 + A2_YA); const bf16* yb = (const bf16*)(a2 + A2_YB); const bf16* yc = (const bf16*)(a2 + A2_YC);
    const unsigned h1 = hsh(gid * 2654435761u + 12345u + stage * 977u), h2 = hsh(h1 + 0x9e3779b9u);
    const int t = h1 % T, s = t & (SEQ - 1), b = t / SEQ;
    if (stage == 0) {
        const int n = h2 % DIN; const float* x = args.in[0] + (size_t)t * D; const float* W = args.in[1];
        const float sc = (n < 384) ? 0.125f * LOG2E_F : 1.0f; float r = 0.f;
        for (int k = 0; k < 1024; ++k) r += bfr(x[k]) * bfr(W[(size_t)k * DIN + n] * sc);
        if (!close_(bfv(hb + (size_t)t * DINP + n), r, 0.02f, 0.02f)) DBG_FAIL(1);
    }
    if (stage == 1) {
        const bf16* hr = hb + (size_t)t * DINP;
        {   const int d = h2 % 128, head = d >> 6, dd = d & 63; float ssq = 0.f;
            for (int k = 0; k < 64; ++k) { const float v = bfv(hr + H_GK + head * 64 + k); ssq += v * v; }
            const float rstd = 1.0f / sqrtf(ssq / 64.0f + RMS_EPS); const float* g = args.in[4];
            const int i = dd & 31; const float y1 = bfv(hr + H_GK + head * 64 + i) * rstd * g[i], y2 = bfv(hr + H_GK + head * 64 + i + 32) * rstd * g[i + 32];
            float c, sn; ropecs(i, 16, s, c, sn); const float ref = (dd < 32) ? (y1 * c - y2 * sn) : (y1 * sn + y2 * c);
            if (!close_(bfv(kB + (size_t)t * 128 + d), ref, 0.02f, 0.01f)) DBG_FAIL(2); }
        {   const int d = h2 % 384; float ssq = 0.f; for (int k = 0; k < 384; ++k) { const float v = bfv(hr + H_CQ + k); ssq += v * v; }
            const float ref = bfv(hr + H_CQ + d) / sqrtf(ssq / 384.0f + RMS_EPS) * args.in[5][d];
            if (!close_(bfv(cqn + (size_t)t * 384 + d), ref, 0.02f, 0.01f)) DBG_FAIL(3); }
        {   const int d = h2 % 256; float ssq = 0.f; for (int k = 0; k < 256; ++k) { const float v = bfv(hr + H_CKV + k); ssq += v * v; }
            const float ref = bfv(hr + H_CKV + d) / sqrtf(ssq / 256.0f + RMS_EPS) * args.in[6][d];
            if (!close_(bfv(ckvn + (size_t)t * 256 + d), ref, 0.02f, 0.01f)) DBG_FAIL(4); }
        {   const int d = h2 % 32, i = d & 15; const float x1 = bfv(hr + H_KR + i), x2 = bfv(hr + H_KR + i + 16); float c, sn; ropecs(i, 8, s, c, sn);
            const float ref = (d < 16) ? (x1 * c - x2 * sn) : (x1 * sn + x2 * c);
            if (!close_(bfv(kr + (size_t)t * 32 + d), ref, 0.02f, 0.01f)) DBG_FAIL(5); }
    }
    if (stage == 2) {
        {   const int n = h2 % 384; float r = 0.f; const float sc = 0.10206207261596577f * LOG2E_F;
            for (int k = 0; k < 384; ++k) r += bfv(cqn + (size_t)t * 384 + k) * bfr(args.in[7][(size_t)k * 384 + n] * sc);
            if (!close_(bfv(qc + (size_t)t * 384 + n), r, 0.02f, 0.01f)) DBG_FAIL(6); }
        {   const int n = h2 % 512; float r = 0.f;
            for (int k = 0; k < 256; ++k) r += bfv(ckvn + (size_t)t * 256 + k) * bfr(args.in[8][(size_t)k * 512 + n]);
            if (!close_(bfv(kvc + (size_t)t * 512 + n), r, 0.02f, 0.02f)) DBG_FAIL(7); }
    }
    if (stage == 3) {
        const int gr = s >> 6, gc = s & 63;
        if (gid < 1024) {
            const int h = h2 % 6, dofs = ((h2 >> 8) & 1) * 32; float q[64], o[32];
            _Pragma("unroll") for (int d = 0; d < 64; ++d) { q[d] = bfv(hb + (size_t)t * DINP + H_NAQ + h * 64 + d); }
            _Pragma("unroll") for (int d = 0; d < 32; ++d) o[d] = 0.f;
            int r0 = gr - 4; r0 = r0 < 0 ? 0 : (r0 > 120 ? 120 : r0); int c0 = gc - 8; c0 = c0 < 0 ? 0 : (c0 > 48 ? 48 : c0);
            const float* rp = args.in[2] + (size_t)h * 465; float m = -1e30f, lsum = 0.f;
            for (int pass = 0; pass < 2; ++pass)
                for (int i = 0; i < 8; ++i) for (int j = 0; j < 16; ++j) { const int kr_ = r0 + i, kc = c0 + j; const size_t kt = (size_t)b * SEQ + kr_ * 64 + kc;
                    float sc = 0.f; _Pragma("unroll") for (int d = 0; d < 64; ++d) sc += q[d] * bfv(hb + kt * DINP + H_NAK + h * 64 + d);
                    sc += rp[(kr_ - gr + 7) * 31 + (kc - gc + 15)] * LOG2E_F;
                    if (pass == 0) m = fmaxf(m, sc); else { const float p = exp2f(sc - m); lsum += p; _Pragma("unroll") for (int d = 0; d < 32; ++d) o[d] += p * bfv(hb + kt * DINP + H_NAV + h * 64 + dofs + d); } }
            bool bad = false; _Pragma("unroll") for (int d = 0; d < 32; ++d) bad |= !close_(bfv(ya + (size_t)t * 384 + h * 64 + dofs + d), o[d] / lsum, 0.03f, 0.01f);
            if (bad) DBG_FAIL(8);
        } else if (gid < 1024 + 128) {
            const int head = h2 % 6, kvh = head / 3, dofs = ((h2 >> 8) & 1) * 32; float q[64], o[32]; float ssq = 0.f;
            _Pragma("unroll") for (int d = 0; d < 64; ++d) { q[d] = bfv(hb + (size_t)t * DINP + H_GQ + head * 64 + d); ssq += q[d] * q[d]; }
            _Pragma("unroll") for (int d = 0; d < 32; ++d) o[d] = 0.f;
            const float rstd = 1.0f / sqrtf(ssq / 64.0f + RMS_EPS);
            _Pragma("unroll") for (int d = 0; d < 64; ++d) q[d] = q[d] * rstd * args.in[3][d];
            _Pragma("unroll") for (int i = 0; i < 32; ++i) { float c, sn; ropecs(i, 16, s, c, sn); const float y1 = q[i], y2 = q[i + 32]; q[i] = y1 * c - y2 * sn; q[i + 32] = y1 * sn + y2 * c; }
            _Pragma("unroll") for (int d = 0; d < 64; ++d) q[d] = bfr(q[d] * 0.125f * LOG2E_F);
            float m = -1e30f, lsum = 0.f;
            for (int key = 0; key < SEQ; ++key) { const size_t kt = (size_t)b * SEQ + key; float sc = 0.f;
                _Pragma("unroll") for (int d = 0; d < 64; ++d) sc += q[d] * bfv(kB + kt * 128 + kvh * 64 + d);
                const float mn = fmaxf(m, sc), al = exp2f(m - mn), p = exp2f(sc - mn); m = mn; lsum = lsum * al + p;
                _Pragma("unroll") for (int d = 0; d < 32; ++d) o[d] = o[d] * al + p * bfv(hb + kt * DINP + H_GV + kvh * 64 + dofs + d); }
            bool bad = false; _Pragma("unroll") for (int d = 0; d < 32; ++d) bad |= !close_(bfv(yb + (size_t)t * 384 + head * 64 + dofs + d), o[d] / lsum, 0.03f, MK_FP8_QK ? 0.012f : 0.003f);
            if (bad) DBG_FAIL(9);
        } else if (gid < 1024 + 256) {
            const int h = h2 % 4, dofs = ((h2 >> 8) & 1) * 32; float q[96], o[32];
            _Pragma("unroll") for (int d = 0; d < 96; ++d) q[d] = bfv(qc + (size_t)t * 384 + h * 96 + d);
            _Pragma("unroll") for (int i = 0; i < 16; ++i) { float c, sn; ropecs(i, 8, s, c, sn); const float y1 = q[64 + i], y2 = q[80 + i]; q[64 + i] = bfr(y1 * c - y2 * sn); q[80 + i] = bfr(y1 * sn + y2 * c); }
            _Pragma("unroll") for (int d = 0; d < 32; ++d) o[d] = 0.f;
            float m = -1e30f, lsum = 0.f;
            for (int key = 0; key < SEQ; ++key) { const size_t kt = (size_t)b * SEQ + key; float sc = 0.f;
                _Pragma("unroll") for (int d = 0; d < 64; ++d) sc += q[d] * bfv(kvc + kt * 512 + h * 128 + d);
                _Pragma("unroll") for (int d = 0; d < 32; ++d) sc += q[64 + d] * bfv(kr + kt * 32 + d);
                const float mn = fmaxf(m, sc), al = exp2f(m - mn), p = exp2f(sc - mn); m = mn; lsum = lsum * al + p;
                _Pragma("unroll") for (int d = 0; d < 32; ++d) o[d] = o[d] * al + p * bfv(kvc + kt * 512 + h * 128 + 64 + dofs + d); }
            bool bad = false; _Pragma("unroll") for (int d = 0; d < 32; ++d) bad |= !close_(bfv(yc + (size_t)t * 384 + h * 64 + dofs + d), o[d] / lsum, 0.03f, 0.003f);
            if (bad) DBG_FAIL(10);
        }
    }
    if (stage == 4) {
        const int n = h2 % 1024; float r = 0.f;
        { float a = 0.f; for (int k = 0; k < 384; ++k) a += bfv(ya + (size_t)t * 384 + k) * bfr(args.in[9][(size_t)k * 1024 + n]); r += a / (1.0f + expf(-bfv(hb + (size_t)t * DINP + H_GATE + n))); }
        { float a = 0.f; for (int k = 0; k < 384; ++k) a += bfv(yb + (size_t)t * 384 + k) * bfr(args.in[10][(size_t)k * 1024 + n]); r += a / (1.0f + expf(-bfv(hb + (size_t)t * DINP + H_GATE + 1024 + n))); }
        { float a = 0.f; for (int k = 0; k < 256; ++k) a += bfv(yc + (size_t)t * 384 + k) * bfr(args.in[11][(size_t)k * 1024 + n]); r += a / (1.0f + expf(-bfv(hb + (size_t)t * DINP + H_GATE + 2048 + n))); }
        if (!close_(bfv((const bf16*)(a2 + A2_MIXED) + (size_t)t * 1024 + n), r, 0.02f, 0.003f)) DBG_FAIL(11);
    }
    if (stage == 5) {
        const int n = h2 % 1024; float r = 0.f; const bf16* mx = (const bf16*)(a2 + A2_MIXED) + (size_t)t * 1024;
        for (int k = 0; k < 1024; ++k) r += bfv(mx + k) * bfr(args.in[12][(size_t)k * 1024 + n]);
        if (!close_(bfv((const bf16*)(ws + WS_X1) + (size_t)t * D + n), r, 0.02f, 0.002f)) DBG_FAIL(12);
    }
    if (stage == 6) {
        const bf16* x1 = (const bf16*)(ws + WS_X1B) + (size_t)t * D; const int* tok_e = (const int*)(ws + WS_TE); const int* tok_r = (const int*)(ws + WS_TR);
        const int* list_t = (const int*)(ws + WS_LT); const float* list_g = (const float*)(ws + WS_LG);
        float lg[32]; _Pragma("unroll") for (int e = 0; e < 32; ++e) lg[e] = args.in[16][e];
        for (int k = 0; k < 1024; ++k) { const float xv = bfv(x1 + k); _Pragma("unroll") for (int e = 0; e < 32; ++e) lg[e] += xv * args.in[15][(size_t)k * 32 + e]; }
        int se[4]; float sv[4]; unsigned used = 0;
        _Pragma("unroll") for (int r = 0; r < 4; ++r) { int be = -1; float bv = -INFINITY; _Pragma("unroll") for (int e = 0; e < 32; ++e) if (!((used >> e) & 1) && lg[e] > bv) { bv = lg[e]; be = e; } se[r] = be; sv[r] = bv; used |= 1u << be; }
        float fifth = -INFINITY; _Pragma("unroll") for (int e = 0; e < 32; ++e) if (!((used >> e) & 1)) fifth = fmaxf(fifth, lg[e]);
        const bool neartie = (sv[3] - fifth) < 3e-2f || (sv[0] - sv[1]) < 3e-2f || (sv[1] - sv[2]) < 3e-2f || (sv[2] - sv[3]) < 3e-2f;
        float den = 0.f; _Pragma("unroll") for (int r = 0; r < 4; ++r) den += expf(sv[r] - sv[0]);
        bool bad = false, badg = false;
        if (!neartie) _Pragma("unroll") for (int r = 0; r < 4; ++r) { const int e = tok_e[t * 4 + r], rk = tok_r[t * 4 + r]; if (e != se[r]) { bad = true; continue; }
            if (rk < 0 || rk >= LCAP || list_t[(size_t)e * LCAP + rk] != t) badg = true; else if (!close_(list_g[(size_t)e * LCAP + rk], expf(sv[r] - sv[0]) / den, 0.03f, 1e-3f)) badg = true; }
        if (bad) DBG_FAIL(13); if (badg) DBG_FAIL(14);
        { float sm = 0.f, sq = 0.f; for (int k = 0; k < 1024; ++k) { const float z = (bfv(x1 + k) - args.in[14][k]) / args.in[13][k]; sm += z; sq += z * z; }
          if (fabsf(sm / 1024.f) > 4e-3f || fabsf(sq / 1024.f - 1.0f) > 2e-2f) DBG_FAIL(19); }
    }
    if (stage >= 7 && stage <= 9) {
        __shared__ int st[33], cn[32];
        if (threadIdx.x == 0) { int a = 0; for (int e2 = 0; e2 < 32; ++e2) { cn[e2] = (int)((const unsigned*)(ws + WS_CTL))[CW_CNT + 64 * l + e2]; st[e2] = a; a += ((cn[e2] + 255) >> 8) << 8; } st[32] = a; }
        __syncthreads();
        const int total = st[32]; const int sl = h1 % total; int e = 0; for (int k = 1; k < 32; ++k) if (sl >= st[k]) e = k; const int r = sl - st[e];
        const int* list_t = (const int*)(ws + WS_LT); const float* list_g = (const float*)(ws + WS_LG); const float* sg = (const float*)(ws + WS_SG);
        if (stage == 7) { int sum = 0; for (int k = 0; k < 32; ++k) sum += cn[k]; if (sum != TK) DBG_FAIL(15); }
        if (stage == 7 && r < cn[e]) {
            const bf16* xg = (const bf16*)(ws + WS_X1B) + (size_t)list_t[(size_t)e * LCAP + r] * D; const int f = h2 % 1024; const float* W = args.in[17] + (size_t)e * 1024 * 2048;
            float g = args.in[18][e * 2048 + f], u = args.in[18][e * 2048 + 1024 + f];
            for (int k = 0; k < 1024; ++k) { const float xv = bfv(xg + k); g += xv * bfr(W[(size_t)k * 2048 + f]); u += xv * bfr(W[(size_t)k * 2048 + 1024 + f]); }
            g = fminf(g, 7.0f); u = fminf(fmaxf(u, -7.0f), 7.0f); const float ref = g / (1.0f + expf(-1.702f * g)) * (u + 1.0f);
            if (!close_(bfv((const bf16*)(ws + WS_A2) + (size_t)sl * 1024 + f), ref, 0.03f, 0.02f)) DBG_FAIL(16);
        }
        if (stage == 8 && r < cn[e]) {
            const bf16* ab = (const bf16*)(ws + WS_A2) + (size_t)sl * 1024; const int n = h2 % 1024; const float* W = args.in[19] + (size_t)e * 1024 * 1024;
            float y = args.in[20][e * 1024 + n]; for (int k = 0; k < 1024; ++k) y += bfv(ab + k) * bfr(W[(size_t)k * 1024 + n]);
            y *= list_g[(size_t)e * LCAP + r];
            if (!close_(bfv((const bf16*)(ws + WS_H) + (size_t)sl * 1024 + n), y, 0.03f, 0.005f)) DBG_FAIL(17);
        }
        if (stage == 9) {
            const bf16* x1 = (const bf16*)(ws + WS_X1B) + (size_t)t * D; const int* tok_e = (const int*)(ws + WS_TE); const int* tok_r = (const int*)(ws + WS_TR);
            const bf16* ybf = (const bf16*)(ws + WS_H); float sm = 0.f, sq = 0.f; const int n = h2 % 1024; float vn = 0.f;
            for (int k = 0; k < 1024; ++k) { float v = DN_ALPHA * bfv(x1 + k); for (int q = 0; q < 4; ++q) v += bfv(ybf + (size_t)(st[tok_e[t * 4 + q]] + tok_r[t * 4 + q]) * D + k); sm += v; sq += v * v; if (k == n) vn = v; }
            const float mean = sm / 1024.f, var = sq / 1024.f - mean * mean; const float ref = (vn - mean) / sqrtf(var + LN_EPS) * args.in[21][n] + args.in[22][n];
            if (!close_(bfv((const bf16*)(ws + WS_XB) + (size_t)t * D + n), ref, 0.01f, 0.01f)) DBG_FAIL(18);
        }
    }
}
static void dbg_launch(int stage, const Args& a, hipStream_t stream) {
    switch (stage) {
#define DBGL(k) case k: hipLaunchKernelGGL(dbg_kernel<k>, dim3(8), dim3(256), 0, stream, a); break;
        DBGL(0) DBGL(1) DBGL(2) DBGL(3) DBGL(4) DBGL(5) DBGL(6) DBGL(7) DBGL(8) DBGL(9)
#undef DBGL
    }
}
#endif

extern "C" void kernel_launch(void* const* d_in, const int* in_sizes, int n_in, void* d_out, int out_size, void* d_ws, size_t ws_size, hipStream_t stream) {
    static int grid = 0;
    if (grid == 0) {
        if (n_in != 23 || in_sizes[0] != T * D || out_size != T * D || ws_size < WS_END) { fprintf(stderr, "kernel_launch: unexpected shapes / workspace (%d inputs, ws %zu, need %zu)\n", n_in, ws_size, (size_t)WS_END); grid = -1; return; }
        int dev = 0, cus = 0, per_cu = 0;
        if (hipGetDevice(&dev) != hipSuccess || hipDeviceGetAttribute(&cus, hipDeviceAttributeMultiprocessorCount, dev) != hipSuccess) { grid = -1; return; }
        if (hipFuncSetAttribute((const void*)mk_fwd, hipFuncAttributeMaxDynamicSharedMemorySize, LDS_BYTES) != hipSuccess) { fprintf(stderr, "kernel_launch: hipFuncSetAttribute failed\n"); grid = -1; return; }
        if (hipOccupancyMaxActiveBlocksPerMultiprocessor(&per_cu, (const void*)mk_fwd, NWAVES * 64, LDS_BYTES) != hipSuccess || per_cu < 1) { fprintf(stderr, "kernel_launch: occupancy query reports %d\n", per_cu); }
        (void)hipGetLastError();
        grid = cus;
    }
    if (grid < 0) return;
    if (hipMemsetAsync((char*)d_ws + WS_CTL, 0, CTL_ZERO_BYTES, stream) != hipSuccess) return;
    Args a{};
    for (int i = 0; i < 23; ++i) a.in[i] = (const float*)d_in[i];
    a.out = (float*)d_out; a.ws = (unsigned char*)d_ws; a.pad = 0;
#if MK_ONE_LAUNCH
    a.ph_lo = 0; a.ph_hi = NPH; a.use_bar = 1;
    hipLaunchKernelGGL(mk_fwd, dim3(grid), dim3(NWAVES * 64), LDS_BYTES, stream, a);
#else
    for (int p = 0; p < NPH; ++p) { a.ph_lo = p; a.ph_hi = p + 1; a.use_bar = 0; hipLaunchKernelGGL(mk_fwd, dim3(grid), dim3(NWAVES * 64), LDS_BYTES, stream, a);
#if MK_DEBUG
        if (p >= 1 && p <= PPL) dbg_launch(p - 1, a, stream);
#endif
    }
#endif
    const hipError_t le = hipPeekAtLastError();
    if (le != hipSuccess) fprintf(stderr, "kernel_launch: launch failed: %s\n", hipGetErrorName(le));
}
```

```cpp
#define MK_DEBUG 0
#define MK_ONE_LAUNCH 1
#ifndef MK_KVC_BF16
#define MK_KVC_BF16 MK_DEBUG
#endif
#ifndef MK_E8
#define MK_E8 (!MK_DEBUG)
#endif
#ifndef MK_OUT8
#define MK_OUT8 1
#endif
#ifndef MK_Y8
#define MK_Y8 1
#endif
#ifndef MK_GATE_EXP
#define MK_GATE_EXP (!MK_DEBUG)
#endif
#ifndef MK_FP8_QK
#define MK_FP8_QK 1
#endif
#ifndef MK_FP8_PV
#define MK_FP8_PV 1
#endif
#include <hip/hip_runtime.h>
#include <hip/hip_bf16.h>
#include <cstdio>
#include <cstdint>
namespace pg8 {
#define PG8_LAS __attribute__((address_space(3)))
typedef unsigned short bf16_t;
typedef short bf16x8 __attribute__((ext_vector_type(8)));
typedef float f32x4 __attribute__((ext_vector_type(4)));
typedef unsigned u32x4 __attribute__((ext_vector_type(4)));
constexpr int BM = 256, BK = 64, HALF = 128, HTB = HALF * BK * 2  , STAGE_BYTES = 8 * HTB, NXCD = 8, WGM = 8;

__host__ __device__ __forceinline__ int lds_byte(int r, int c) { const int st = (r >> 4) * 2 + (c >> 5), rr = r & 15, cc = c & 31, ob = rr * 64 + cc * 2; return st * 1024 + (ob ^ (((ob >> 9) & 1) << 5)); }
__host__ __device__ __forceinline__ void stage_rc(int b, int& R, int& C) { const int st = b / 1024, sb = b % 1024, swz = sb ^ (((sb >> 9) & 1) << 5); R = (st >> 1) * 16 + swz / 64; C = (st & 1) * 32 + (swz % 64) / 2; }
__host__ __device__ __forceinline__ int perm32(int rho) { const int n = rho >> 4, i = rho & 15; return 8 * (i >> 2) + 4 * n + (i & 3); }

struct Unit { int pm, pn, e; };
struct Gemm { const bf16_t* A; const bf16_t* Bt; int M, N, K; size_t bstride; size_t astride; const void* base; int ktrim; };

struct StaticOrder {
    int nM, nN, nwg, G, c;
    __host__ __device__ void init(int M, int N, int G_, int c_) { nM = M / BM; nN = N / BM; nwg = nM * nN; G = G_; c = c_; }
    __host__ __device__ bool next(int i, Unit& u) const {
        const long L = (long)i * G + c; if (L >= nwg) return false;
        int wgid = (int)L; { const int q = nwg / NXCD, r = nwg % NXCD, xcd = wgid % NXCD, off = wgid / NXCD; wgid = (xcd < r ? xcd * (q + 1) : r * (q + 1) + (xcd - r) * q) + off; }
        const int nig = WGM * nN, gid = wgid / nig, fm = gid * WGM, gsz = (nM - fm) < WGM ? (nM - fm) : WGM;
        u.pm = fm + ((wgid % nig) % gsz); u.pn = (wgid % nig) / gsz; u.e = 0; return true;
    }
    __device__ __forceinline__ void a_ready(const Unit&) const {}
    __device__ __forceinline__ void done(const Unit&) const {}
};

__device__ __forceinline__ unsigned cvt_pk_bf16(float lo, float hi) { unsigned r; asm volatile("v_cvt_pk_bf16_f32 %0, %1, %2" : "=v"(r) : "v"(lo), "v"(hi)); return r; }
typedef float f32x2 __attribute__((ext_vector_type(2)));


__device__ __forceinline__ float bf_lo(unsigned w) { return __uint_as_float(w << 16); }
__device__ __forceinline__ float bf_hi(unsigned w) { return __uint_as_float(w & 0xffff0000u); }
__device__ __forceinline__ float sigmoidf_(float z) { return __builtin_amdgcn_rcpf(1.0f + __builtin_amdgcn_exp2f(-1.4426950408889634f * z)); }
__device__ __forceinline__ u32x4 pack8(const f32x4& v0, const f32x4& v1) { u32x4 w; w.x = cvt_pk_bf16(v0[0], v0[1]); w.y = cvt_pk_bf16(v0[2], v0[3]); w.z = cvt_pk_bf16(v1[0], v1[1]); w.w = cvt_pk_bf16(v1[2], v1[3]); return w; }
__device__ __forceinline__ float sat8(float v) { return __builtin_amdgcn_fmed3f(v, -448.0f, 448.0f); }
__device__ __forceinline__ unsigned pk4_fp8(float a, float b, float c, float d) { int r = __builtin_amdgcn_cvt_pk_fp8_f32(sat8(a), sat8(b), 0, false); r = __builtin_amdgcn_cvt_pk_fp8_f32(sat8(c), sat8(d), r, true); return (unsigned)r; }
__device__ __forceinline__ unsigned pk4_fp8_ns(float a, float b, float c, float d) { int r = __builtin_amdgcn_cvt_pk_fp8_f32(a, b, 0, false); r = __builtin_amdgcn_cvt_pk_fp8_f32(c, d, r, true); return (unsigned)r; }

#ifndef EPI_NT_DN
#define EPI_NT_DN 0
#endif
#ifndef EPI_NT_GU
#define EPI_NT_GU 0
#endif
#ifndef EPI_NT
#define EPI_NT 1
#endif
struct EpiStore {
    static constexpr bool PERM = true, AFTER_DRAIN = false, CHAIN = false, BUFSTAGE = true; static constexpr int PRE = 0;
    bf16_t* O; int ldc; int nvalid; float ascale;
    __device__ __forceinline__ void operator()(const f32x4 (&acc)[2][2][4][2], const Unit& u, int wr, int wc, int fr_in, int fq_in) const {
        int ln_; asm volatile("v_mbcnt_lo_u32_b32 %0, -1, 0\n\tv_mbcnt_hi_u32_b32 %0, -1, %0" : "=v"(ln_)); const int fr = ln_ & 15, fq = ln_ >> 4; (void)fr_in; (void)fq_in;
        const int row0 = u.pm * BM + wr * 64 + fr, col0 = u.pn * BM + wc * 32 + 8 * fq;
#pragma unroll
        for (int ai = 0; ai < 2; ++ai)
#pragma unroll
            for (int m = 0; m < 4; ++m) { bf16_t* rowp = O + (size_t)(row0 + ai * HALF + m * 16) * ldc + col0;
#pragma unroll
                for (int bj = 0; bj < 2; ++bj) { if (col0 + bj * HALF < nvalid) *(u32x4*)(rowp + bj * HALF) = pack8(acc[ai][bj][m][0] * ascale, acc[ai][bj][m][1] * ascale); } }
    }
};
struct EpiStoreF8 {
    static constexpr bool PERM = true, AFTER_DRAIN = false, CHAIN = false, BUFSTAGE = true; static constexpr int PRE = 0;
    unsigned char* O8; int ldc; float ascale;
    __device__ __forceinline__ void operator()(const f32x4 (&acc)[2][2][4][2], const Unit& u, int wr, int wc, int fr_in, int fq_in) const {
        int ln_; asm volatile("v_mbcnt_lo_u32_b32 %0, -1, 0\n\tv_mbcnt_hi_u32_b32 %0, -1, %0" : "=v"(ln_)); const int fr = ln_ & 15, fq = ln_ >> 4; (void)fr_in; (void)fq_in;
        const int row0 = u.pm * BM + wr * 64 + fr, col0 = u.pn * BM + wc * 32 + 8 * fq; typedef unsigned u32x2 __attribute__((ext_vector_type(2)));
#pragma unroll
        for (int ai = 0; ai < 2; ++ai)
#pragma unroll
            for (int m = 0; m < 4; ++m) { unsigned char* rowp = O8 + (size_t)(row0 + ai * HALF + m * 16) * ldc + col0;
#pragma unroll
                for (int bj = 0; bj < 2; ++bj) { const f32x4 v0 = acc[ai][bj][m][0] * ascale, v1 = acc[ai][bj][m][1] * ascale;
                    *(u32x2*)(rowp + bj * HALF) = (u32x2){pk4_fp8(v0[0], v0[1], v0[2], v0[3]), pk4_fp8(v1[0], v1[1], v1[2], v1[3])}; } }
    }
};
struct EpiStoreGE {
    static constexpr bool PERM = true, AFTER_DRAIN = false, CHAIN = false, BUFSTAGE = true; static constexpr int PRE = 0;
    bf16_t* O; int ldc; int nvalid; float ascale; int gcol0;
    __device__ __forceinline__ void operator()(const f32x4 (&acc)[2][2][4][2], const Unit& u, int wr, int wc, int fr_in, int fq_in) const {
        int ln_; asm volatile("v_mbcnt_lo_u32_b32 %0, -1, 0\n\tv_mbcnt_hi_u32_b32 %0, -1, %0" : "=v"(ln_)); const int fr = ln_ & 15, fq = ln_ >> 4; (void)fr_in; (void)fq_in;
        const int row0 = u.pm * BM + wr * 64 + fr, col0 = u.pn * BM + wc * 32 + 8 * fq; const float sx = -1.4426950408889634f * ascale;
#pragma unroll
        for (int ai = 0; ai < 2; ++ai)
#pragma unroll
            for (int m = 0; m < 4; ++m) { bf16_t* rowp = O + (size_t)(row0 + ai * HALF + m * 16) * ldc + col0;
#pragma unroll
                for (int bj = 0; bj < 2; ++bj) { const int gc = col0 + bj * HALF - gcol0;
                    if (col0 + bj * HALF < nvalid) { f32x4 v0 = acc[ai][bj][m][0] * ascale, v1 = acc[ai][bj][m][1] * ascale;
                        if (gc >= 0 && gc < 3072) {
#pragma unroll
                            for (int q = 0; q < 4; ++q) { v0[q] = 1.0f + __builtin_amdgcn_exp2f(__builtin_amdgcn_fmed3f(acc[ai][bj][m][0][q] * sx, -115.0f, 115.0f)); v1[q] = 1.0f + __builtin_amdgcn_exp2f(__builtin_amdgcn_fmed3f(acc[ai][bj][m][1][q] * sx, -115.0f, 115.0f)); } }
                        *(u32x4*)(rowp + bj * HALF) = pack8(v0, v1); } } }
    }
};
struct EpiStoreV8 {
    static constexpr bool PERM = true, AFTER_DRAIN = false, CHAIN = false, BUFSTAGE = true; static constexpr int PRE = 0;
    bf16_t* O; unsigned char* vt8; unsigned char* k8m;
    __device__ __forceinline__ void operator()(const f32x4 (&acc)[2][2][4][2], const Unit& u, int wr, int wc, int fr_in, int fq_in) const {
        int ln_; asm volatile("v_mbcnt_lo_u32_b32 %0, -1, 0\n\tv_mbcnt_hi_u32_b32 %0, -1, %0" : "=v"(ln_)); const int fr = ln_ & 15, fq = ln_ >> 4; (void)fr_in; (void)fq_in;
        const int row0 = u.pm * BM + wr * 64 + fr, col0 = u.pn * BM + wc * 32 + 8 * fq;
#pragma unroll
        for (int ai = 0; ai < 2; ++ai)
#pragma unroll
            for (int m = 0; m < 4; ++m) { const int row = row0 + ai * HALF + m * 16; bf16_t* rowp = O + (size_t)row * 512 + col0;
                const int s_ = row & 8191, bb = row >> 13, kk = s_ & 63, k5 = kk & 31, pos = 32 * ((k5 >> 2) & 1) + (kk >> 5) * 16 + (k5 & 3) + 4 * (k5 >> 3);
#pragma unroll
                for (int bj = 0; bj < 2; ++bj) {
#if MK_KVC_BF16
                    *(u32x4*)(rowp + bj * HALF) = pack8(acc[ai][bj][m][0], acc[ai][bj][m][1]);
#else
                    (void)rowp;
#endif
                    if (wc < 2) { typedef unsigned u32x2 __attribute__((ext_vector_type(2)));
                        *(u32x2*)(k8m + (size_t)row * 256 + (u.pn * 2 + bj) * 64 + wc * 32 + 8 * fq) = (u32x2){pk4_fp8(acc[ai][bj][m][0][0], acc[ai][bj][m][0][1], acc[ai][bj][m][0][2], acc[ai][bj][m][0][3]), pk4_fp8(acc[ai][bj][m][1][0], acc[ai][bj][m][1][1], acc[ai][bj][m][1][2], acc[ai][bj][m][1][3])}; }
                    if (wc >= 2) {
                        unsigned char* bp = vt8 + ((size_t)((bb * 4 + u.pn * 2 + bj) * 128 + (s_ >> 6)) * 64 + (wc - 2) * 32 + 8 * fq) * 64 + pos;
#pragma unroll
                        for (int n = 0; n < 2; ++n) { const unsigned w0 = (unsigned)__builtin_amdgcn_cvt_pk_bf8_f32(acc[ai][bj][m][n][0], acc[ai][bj][m][n][1], 0, false), w1 = (unsigned)__builtin_amdgcn_cvt_pk_bf8_f32(acc[ai][bj][m][n][2], acc[ai][bj][m][n][3], 0, false);
                            bp[(4 * n + 0) * 64] = (unsigned char)(w0 & 0xffu); bp[(4 * n + 1) * 64] = (unsigned char)((w0 >> 8) & 0xffu); bp[(4 * n + 2) * 64] = (unsigned char)(w1 & 0xffu); bp[(4 * n + 3) * 64] = (unsigned char)((w1 >> 8) & 0xffu); } } } }
    }
};
struct EpiGateChain {
    static constexpr bool PERM = true, AFTER_DRAIN = false, CHAIN = true, BUFSTAGE = true; static constexpr int PRE = 0;
    const bf16_t* gate; int ldg; void* mixed; float oscale;
    __device__ __forceinline__ void chain(f32x4 (&acc)[2][2][4][2], const Unit& u, int wr, int wc, int fr_in, int fq_in) const {
        int ln_; asm volatile("v_mbcnt_lo_u32_b32 %0, -1, 0\n\tv_mbcnt_hi_u32_b32 %0, -1, %0" : "=v"(ln_)); const int fr = ln_ & 15, fq = ln_ >> 4; (void)fr_in; (void)fq_in;
        const int row0 = u.pm * BM + wr * 64 + fr, col0 = u.pn * BM + wc * 32 + 8 * fq;
        const int eb = u.e < 2 ? u.e + 1 : u.e;
#if MK_GATE_EXP
        struct GG { u32x4 a[2][2], b[2][2]; } X, Y;
#define CH_LOAD(G, grp) do { _Pragma("unroll") for (int mm = 0; mm < 2; ++mm) { const size_t row = (size_t)(row0 + ((grp) >> 1) * HALF + (2 * ((grp) & 1) + mm) * 16); \
            _Pragma("unroll") for (int bj = 0; bj < 2; ++bj) { const int col = col0 + bj * HALF; G.a[mm][bj] = *(const u32x4*)(gate + row * ldg + u.e * 1024 + col); G.b[mm][bj] = *(const u32x4*)(gate + row * ldg + eb * 1024 + col); } } } while (0)
#define CH_COMP(G, grp) do { _Pragma("unroll") for (int mm = 0; mm < 2; ++mm) { const int ai = (grp) >> 1, m = 2 * ((grp) & 1) + mm; const size_t row = (size_t)(row0 + ai * HALF + m * 16); \
            _Pragma("unroll") for (int bj = 0; bj < 2; ++bj) { const int col = col0 + bj * HALF; const u32x4 a_ = G.a[mm][bj], b_ = G.b[mm][bj]; \
                f32x4 f0 = {__builtin_amdgcn_rcpf(bf_lo(a_.x)), __builtin_amdgcn_rcpf(bf_hi(a_.x)), __builtin_amdgcn_rcpf(bf_lo(a_.y)), __builtin_amdgcn_rcpf(bf_hi(a_.y))}; \
                f32x4 f1 = {__builtin_amdgcn_rcpf(bf_lo(a_.z)), __builtin_amdgcn_rcpf(bf_hi(a_.z)), __builtin_amdgcn_rcpf(bf_lo(a_.w)), __builtin_amdgcn_rcpf(bf_hi(a_.w))}; \
                if (u.e < 2) { f0 *= (f32x4){bf_lo(b_.x), bf_hi(b_.x), bf_lo(b_.y), bf_hi(b_.y)}; f1 *= (f32x4){bf_lo(b_.z), bf_hi(b_.z), bf_lo(b_.w), bf_hi(b_.w)}; } \
                acc[ai][bj][m][0] *= f0; acc[ai][bj][m][1] *= f1; \
                if (u.e == 2) { if (oscale == 0.f) *(u32x4*)((bf16_t*)mixed + row * 1024 + col) = pack8(acc[ai][bj][m][0], acc[ai][bj][m][1]); \
                    else { typedef unsigned u32x2 __attribute__((ext_vector_type(2))); const f32x4 a0 = acc[ai][bj][m][0] * oscale, a1 = acc[ai][bj][m][1] * oscale; \
                        *(u32x2*)((unsigned char*)mixed + row * 1024 + col) = (u32x2){pk4_fp8(a0[0], a0[1], a0[2], a0[3]), pk4_fp8(a1[0], a1[1], a1[2], a1[3])}; } } } } } while (0)
        CH_LOAD(X, 0);
        CH_LOAD(Y, 1); __builtin_amdgcn_sched_barrier(0); CH_COMP(X, 0); __builtin_amdgcn_sched_barrier(0);
        CH_LOAD(X, 2); __builtin_amdgcn_sched_barrier(0); CH_COMP(Y, 1); __builtin_amdgcn_sched_barrier(0);
        CH_LOAD(Y, 3); __builtin_amdgcn_sched_barrier(0); CH_COMP(X, 2); __builtin_amdgcn_sched_barrier(0);
        CH_COMP(Y, 3);
#undef CH_LOAD
#undef CH_COMP
#else
#pragma unroll
        for (int ai = 0; ai < 2; ++ai) {
            u32x4 ga[4][2], gb[4][2];
#pragma unroll
            for (int m = 0; m < 4; ++m) { const size_t row = (size_t)(row0 + ai * HALF + m * 16);
#pragma unroll
                for (int bj = 0; bj < 2; ++bj) { const int col = col0 + bj * HALF;
                    ga[m][bj] = *(const u32x4*)(gate + row * ldg + u.e * 1024 + col); gb[m][bj] = *(const u32x4*)(gate + row * ldg + eb * 1024 + col); } }
#pragma unroll
            for (int m = 0; m < 4; ++m) { const size_t row = (size_t)(row0 + ai * HALF + m * 16);
#pragma unroll
                for (int bj = 0; bj < 2; ++bj) { const int col = col0 + bj * HALF; const u32x4 a_ = ga[m][bj], b_ = gb[m][bj];
#if MK_GATE_EXP
                    const f32x4 na0 = {1.f + bf_lo(a_.x), 1.f + bf_hi(a_.x), 1.f + bf_lo(a_.y), 1.f + bf_hi(a_.y)}, na1 = {1.f + bf_lo(a_.z), 1.f + bf_hi(a_.z), 1.f + bf_lo(a_.w), 1.f + bf_hi(a_.w)};
                    f32x4 f0, f1;
#pragma unroll
                    for (int q = 0; q < 4; ++q) { f0[q] = __builtin_amdgcn_rcpf(na0[q]); f1[q] = __builtin_amdgcn_rcpf(na1[q]); }
                    if (u.e < 2) { f0 *= (f32x4){1.f + bf_lo(b_.x), 1.f + bf_hi(b_.x), 1.f + bf_lo(b_.y), 1.f + bf_hi(b_.y)}; f1 *= (f32x4){1.f + bf_lo(b_.z), 1.f + bf_hi(b_.z), 1.f + bf_lo(b_.w), 1.f + bf_hi(b_.w)}; }
#else
                    f32x4 na0 = {1.f + __builtin_amdgcn_exp2f(-1.4426950408889634f * bf_lo(a_.x)), 1.f + __builtin_amdgcn_exp2f(-1.4426950408889634f * bf_hi(a_.x)), 1.f + __builtin_amdgcn_exp2f(-1.4426950408889634f * bf_lo(a_.y)), 1.f + __builtin_amdgcn_exp2f(-1.4426950408889634f * bf_hi(a_.y))};
                    f32x4 na1 = {1.f + __builtin_amdgcn_exp2f(-1.4426950408889634f * bf_lo(a_.z)), 1.f + __builtin_amdgcn_exp2f(-1.4426950408889634f * bf_hi(a_.z)), 1.f + __builtin_amdgcn_exp2f(-1.4426950408889634f * bf_lo(a_.w)), 1.f + __builtin_amdgcn_exp2f(-1.4426950408889634f * bf_hi(a_.w))};
                    f32x4 f0, f1;
#pragma unroll
                    for (int q = 0; q < 4; ++q) { f0[q] = __builtin_amdgcn_rcpf(na0[q]); f1[q] = __builtin_amdgcn_rcpf(na1[q]); }
                    if (u.e < 2) {
                        f0[0] *= 1.f + __builtin_amdgcn_exp2f(-1.4426950408889634f * bf_lo(b_.x)); f0[1] *= 1.f + __builtin_amdgcn_exp2f(-1.4426950408889634f * bf_hi(b_.x));
                        f0[2] *= 1.f + __builtin_amdgcn_exp2f(-1.4426950408889634f * bf_lo(b_.y)); f0[3] *= 1.f + __builtin_amdgcn_exp2f(-1.4426950408889634f * bf_hi(b_.y));
                        f1[0] *= 1.f + __builtin_amdgcn_exp2f(-1.4426950408889634f * bf_lo(b_.z)); f1[1] *= 1.f + __builtin_amdgcn_exp2f(-1.4426950408889634f * bf_hi(b_.z));
                        f1[2] *= 1.f + __builtin_amdgcn_exp2f(-1.4426950408889634f * bf_lo(b_.w)); f1[3] *= 1.f + __builtin_amdgcn_exp2f(-1.4426950408889634f * bf_hi(b_.w)); }
#endif
                    acc[ai][bj][m][0] *= f0; acc[ai][bj][m][1] *= f1;
                    if (u.e == 2) { if (oscale == 0.f) *(u32x4*)((bf16_t*)mixed + row * 1024 + col) = pack8(acc[ai][bj][m][0], acc[ai][bj][m][1]);
                        else { typedef unsigned u32x2 __attribute__((ext_vector_type(2))); const f32x4 a0 = acc[ai][bj][m][0] * oscale, a1 = acc[ai][bj][m][1] * oscale;
                            *(u32x2*)((unsigned char*)mixed + row * 1024 + col) = (u32x2){pk4_fp8(a0[0], a0[1], a0[2], a0[3]), pk4_fp8(a1[0], a1[1], a1[2], a1[3])}; } } } } }
#endif
    }
};
struct ChainOrder {
    StaticOrder so; int nch;
    __device__ __forceinline__ bool next(int i, Unit& u) const { const int t = i / nch; if (!so.next(t, u)) return false; u.e = i - t * nch; return true; }
    __device__ __forceinline__ void a_ready(const Unit&) const {}
    __device__ __forceinline__ void done(const Unit&) const {}
};
struct EpiResid {
    static constexpr bool PERM = true, AFTER_DRAIN = false, CHAIN = false, BUFSTAGE = false; static constexpr int PRE = 0;
    const float* x; float* pre; float alpha;
    __device__ __forceinline__ void operator()(const f32x4 (&acc)[2][2][4][2], const Unit& u, int wr, int wc, int fr, int fq) const {
        const int row0 = u.pm * BM + wr * 64 + fr, col0 = u.pn * BM + wc * 32 + 8 * fq;
#pragma unroll
        for (int ai = 0; ai < 2; ++ai)
#pragma unroll
            for (int m = 0; m < 4; ++m) { const size_t row = (size_t)(row0 + ai * HALF + m * 16);
#pragma unroll
                for (int bj = 0; bj < 2; ++bj) { const size_t off = row * 1024 + col0 + bj * HALF;
                    const f32x4 x0 = *(const f32x4*)(x + off), x1 = *(const f32x4*)(x + off + 4);
                    *(f32x4*)(pre + off) = x0 * alpha + acc[ai][bj][m][0]; *(f32x4*)(pre + off + 4) = x1 * alpha + acc[ai][bj][m][1]; } }
    }
};
template <bool OUT8> struct EpiSwigluT {
    static constexpr bool PERM = true, AFTER_DRAIN = false, CHAIN = false, BUFSTAGE = false; static constexpr int PRE = 1;
    __device__ __forceinline__ const char* pre_src(const Unit& u, int, int lane) const { return (const char*)(bias + (size_t)u.e * 2048 + (lane >> 5) * 1024 + u.pn * HALF + (lane & 31) * 4); }
    __device__ __forceinline__ void pre(const f32x4 (&acc)[2][2][4][2], const Unit& u, int wr, int wc, int fr, int fq, const PG8_LAS unsigned char* pl) const { run<true>(acc, u, wr, wc, fr, fq, pl); }
    __device__ __forceinline__ void operator()(const f32x4 (&acc)[2][2][4][2], const Unit& u, int wr, int wc, int fr, int fq) const { run<false>(acc, u, wr, wc, fr, fq, nullptr); }
    void* a; const float* bias; float ascale, oscale;
    template <bool FROM_LDS> __device__ __forceinline__ void run(const f32x4 (&acc)[2][2][4][2], const Unit& u, int wr, int wc, int fr, int fq, const PG8_LAS unsigned char* pl) const {
        const int row0 = u.pm * BM + wr * 64 + fr, j0 = wc * 32 + 8 * fq, oc = u.pn * HALF + j0;
        f32x4 bg0, bg1, bu0, bu1;
        if constexpr (FROM_LDS) { const PG8_LAS float* pb = (const PG8_LAS float*)pl + j0; bg0 = *(const PG8_LAS f32x4*)pb; bg1 = *(const PG8_LAS f32x4*)(pb + 4); bu0 = *(const PG8_LAS f32x4*)(pb + 128); bu1 = *(const PG8_LAS f32x4*)(pb + 132); }
        else { const float* bg = bias + (size_t)u.e * 2048 + oc; const float* bu = bg + 1024; bg0 = *(const f32x4*)bg; bg1 = *(const f32x4*)(bg + 4); bu0 = *(const f32x4*)bu; bu1 = *(const f32x4*)(bu + 4); }
#pragma unroll
        for (int ai = 0; ai < 2; ++ai)
#pragma unroll
            for (int m = 0; m < 4; ++m) { const size_t row = (size_t)(row0 + ai * HALF + m * 16);
                f32x4 g[2] = {acc[ai][0][m][0] * ascale + bg0, acc[ai][0][m][1] * ascale + bg1}, uu[2] = {acc[ai][1][m][0] * ascale + bu0, acc[ai][1][m][1] * ascale + bu1}, r[2];
#pragma unroll
                for (int n = 0; n < 2; ++n)
#pragma unroll
                    for (int q = 0; q < 4; ++q) { const float gg = fminf(g[n][q], 7.0f), uc = fminf(fmaxf(uu[n][q], -7.0f), 7.0f);
                        r[n][q] = gg * sigmoidf_(1.702f * gg) * (OUT8 ? __builtin_fmaf(uc, oscale, oscale) : uc + 1.0f); }
                if constexpr (OUT8) { typedef unsigned u32x2 __attribute__((ext_vector_type(2)));
                    const u32x2 w_ = (u32x2){pk4_fp8_ns(r[0][0], r[0][1], r[0][2], r[0][3]), pk4_fp8_ns(r[1][0], r[1][1], r[1][2], r[1][3])};
#if EPI_NT_GU
                    __builtin_nontemporal_store(w_, (u32x2*)((unsigned char*)a + row * 1024 + oc));
#else
                    *(u32x2*)((unsigned char*)a + row * 1024 + oc) = w_;
#endif
                }
                else *(u32x4*)((bf16_t*)a + row * 1024 + oc) = pack8(r[0], r[1]);
                }
    }
};
struct EpiDown {
    static constexpr bool PERM = true, AFTER_DRAIN = false, CHAIN = false, BUFSTAGE = false; static constexpr int PRE = 2;
    __device__ __forceinline__ const char* pre_src(const Unit& u, int piece, int lane) const {
        return piece == 0 ? (const char*)(bias + (size_t)u.e * 1024 + u.pn * BM + lane * 4) : (const char*)(list_g + (size_t)u.e * lcap + (u.pm * BM - st[u.e]) + lane * 4); }
    __device__ __forceinline__ void pre(const f32x4 (&acc)[2][2][4][2], const Unit& u, int wr, int wc, int fr, int fq, const PG8_LAS unsigned char* pl) const { run<true>(acc, u, wr, wc, fr, fq, pl); }
    __device__ __forceinline__ void operator()(const f32x4 (&acc)[2][2][4][2], const Unit& u, int wr, int wc, int fr, int fq) const { run<false>(acc, u, wr, wc, fr, fq, nullptr); }
    bf16_t* y; const float* bias; const float* list_g; const PG8_LAS int* st; const PG8_LAS int* cn; int lcap; float ascale;
    template <bool FROM_LDS> __device__ __forceinline__ void run(const f32x4 (&acc)[2][2][4][2], const Unit& u, int wr, int wc, int fr, int fq, const PG8_LAS unsigned char* pl) const {
        const int row0 = u.pm * BM + wr * 64 + fr, col0 = u.pn * BM + wc * 32 + 8 * fq;
        const int st_e = st[u.e], cn_e = cn[u.e];
        f32x4 bv[2][2];
#pragma unroll
        for (int bj = 0; bj < 2; ++bj)
#pragma unroll
            for (int n = 0; n < 2; ++n) { if constexpr (FROM_LDS) bv[bj][n] = *(const PG8_LAS f32x4*)((const PG8_LAS float*)pl + wc * 32 + 8 * fq + bj * HALF + 4 * n); else bv[bj][n] = *(const f32x4*)(bias + (size_t)u.e * 1024 + col0 + bj * HALF + 4 * n); }
#pragma unroll
        for (int ai = 0; ai < 2; ++ai)
#pragma unroll
            for (int m = 0; m < 4; ++m) { const size_t row = (size_t)(row0 + ai * HALF + m * 16); const int rank = (int)row - st_e;
                float gt; if constexpr (FROM_LDS) { const float gl_ = ((const PG8_LAS float*)pl)[256 + wr * 64 + fr + ai * HALF + m * 16]; gt = rank < cn_e ? gl_ : 0.f; } else gt = rank < cn_e ? list_g[(size_t)u.e * lcap + rank] : 0.f;
                const float gts = (MK_Y8 && ascale != 1.0f) ? gt * 32.0f : gt;
#pragma unroll
                for (int bj = 0; bj < 2; ++bj) { const f32x4 v0 = (acc[ai][bj][m][0] * ascale + bv[bj][0]) * gts, v1 = (acc[ai][bj][m][1] * ascale + bv[bj][1]) * gts;
#if MK_Y8
                    if (ascale != 1.0f) { typedef unsigned u32x2 __attribute__((ext_vector_type(2)));
                        *(u32x2*)((unsigned char*)y + row * 1024 + col0 + bj * HALF) = (u32x2){pk4_fp8(v0[0], v0[1], v0[2], v0[3]), pk4_fp8(v1[0], v1[1], v1[2], v1[3])}; }
                    else
#endif
                    *(u32x4*)(y + row * 1024 + col0 + bj * HALF) = pack8(v0, v1);
                } }
    }
};
struct MoeGather {
    const int* list_t; const PG8_LAS int* st; const PG8_LAS int* cn; int lcap;
    __device__ __forceinline__ const char* pre_src(const Unit& u, int lane) const { return (const char*)(list_t + (size_t)u.e * lcap + (u.pm * BM - st[u.e]) + lane * 4); }
    __device__ __forceinline__ int lim(const Unit& u) const { return cn[u.e] - 1 - (u.pm * BM - st[u.e]); }
    __device__ __forceinline__ int row(const Unit& u, int r) const { int rank = u.pm * BM + r - st[u.e]; const int c = cn[u.e]; rank = rank < c ? rank : c - 1; return list_t[(size_t)u.e * lcap + rank]; }
};
struct MoeOrder {
    int nN, nunits, G, c; const PG8_LAS int* tile_e;
    __device__ __forceinline__ bool next(int i, Unit& u) const {
        const long L = (long)i * G + c; if (L >= nunits) return false;
        const int tile = (int)L / nN; u.pm = tile; u.pn = (int)L % nN; u.e = __builtin_amdgcn_readfirstlane(tile_e[tile]); return true;
    }
    __device__ __forceinline__ void a_ready(const Unit&) const {}
    __device__ __forceinline__ void done(const Unit&) const {}
};

template <int ES> struct PtSel { typedef const char* T; static __device__ __forceinline__ T mk(const char* p, const char*) { return p; } };
template <> struct PtSel<1> { typedef unsigned T; static __device__ __forceinline__ T mk(const char* p, const char* base) { return (unsigned)(size_t)(p - base); } };
struct NoGather { };
typedef int i32x8 __attribute__((ext_vector_type(8)));
template <class Epi, class Sched, bool ALIGN_EPI = false, bool SP2 = false, bool GATHER = false, class GS = NoGather, int ESIZE = 2, int PROBE = 0>
__device__ __forceinline__ void gemm_phase(PG8_LAS unsigned char* lds, const Gemm g, const Sched& S, const Epi& E, const int tid, const GS gs = GS()) {
    const int wid = __builtin_amdgcn_readfirstlane(tid >> 6), lane = tid & 63, wr = wid >> 2, wc = wid & 3, fr = lane & 15, fq = lane >> 4;
    const int K = g.K * ESIZE / 2; int nt = K / BK - g.ktrim;
    if constexpr (ESIZE == 1) asm volatile("" : "+s"(nt));
    int sc8 = 0x7F7F7F7F; if constexpr (ESIZE == 1) asm volatile("" : "+v"(sc8));
    constexpr bool BUFS = (ESIZE == 1) || Epi::BUFSTAGE;
    typedef typename PtSel<BUFS ? 1 : 2>::T PT;
    __amdgpu_buffer_rsrc_t rsrc = __builtin_amdgcn_make_buffer_rsrc((void*)g.base, 0, 0x7fffffff, 0x00020000);
#define PG8_PT(p) PtSel<BUFS ? 1 : 2>::mk((const char*)(p), (const char*)g.base)
    unsigned voffA[2], voffB[2];
#pragma unroll
    for (int i = 0; i < 2; ++i) { int R, C; stage_rc(tid * 16 + i * 8192, R, C); const int Rb = Epi::PERM ? ((R & ~31) + perm32(R & 31)) : R;
        voffA[i] = (unsigned)(R * K + C) * 2u; voffB[i] = (unsigned)(Rb * K + C) * 2u; }
    unsigned vc0[2], vc1[2], vn0[2], vn1[2];
#define PG8_GROWS(u_, o0, o1) do { _Pragma("unroll") for (int i_ = 0; i_ < 2; ++i_) { int R_, C_; stage_rc(tid * 16 + i_ * 8192, R_, C_); \
        o0[i_] = (unsigned)gs.row((u_), R_) * (unsigned)(K * 2) + (unsigned)(C_ * 2); o1[i_] = (unsigned)gs.row((u_), HALF + R_) * (unsigned)(K * 2) + (unsigned)(C_ * 2); } } while (0)
#define PG8_GROWS_USE(o0, o1, b_) do { const PG8_LAS int* rw_ = (const PG8_LAS int*)(lds + STAGE_BYTES + (b_) * 2048 + Epi::PRE * 1024); const int lim_ = gs.lim(nxt); \
        _Pragma("unroll") for (int i_ = 0; i_ < 2; ++i_) { int R_, C_; stage_rc(tid * 16 + i_ * 8192, R_, C_); const int r0_ = rw_[R_ < lim_ ? R_ : lim_], r1_ = rw_[HALF + R_ < lim_ ? HALF + R_ : lim_]; \
        o0[i_] = (unsigned)r0_ * (unsigned)(K * 2) + (unsigned)(C_ * 2); o1[i_] = (unsigned)r1_ * (unsigned)(K * 2) + (unsigned)(C_ * 2); } } while (0)
    constexpr int PRE_OFF = STAGE_BYTES, PRE_BUF = 2048, EPRE = Epi::PRE;
    static_assert(EPRE + (GATHER ? 1 : 0) <= 2, "two pieces per unit");
#define PG8_PRE(u_, b_) do { if constexpr (EPRE > 0) { if (wid < EPRE) __builtin_amdgcn_global_load_lds((const unsigned*)E.pre_src((u_), wid, lane), (PG8_LAS unsigned*)(lds + PRE_OFF + (b_) * PRE_BUF + wid * 1024), 16, 0, 0); } \
        if constexpr (GATHER) { if (wid == EPRE) __builtin_amdgcn_global_load_lds((const unsigned*)gs.pre_src((u_), lane), (PG8_LAS unsigned*)(lds + PRE_OFF + (b_) * PRE_BUF + EPRE * 1024), 16, 0, 0); } } while (0)
    int pbuf = 0;
    const size_t kstep = (size_t)(BK * 2);
    const size_t hstep = (size_t)HALF * K * 2;
    const size_t tstep = 2 * hstep;
    const unsigned ldsw = (unsigned)wid * 1024u;
    const int aoff = lds_byte(wr * 64 + fr, fq * 8), boff = lds_byte(wc * 32 + fr, fq * 8);
#define PG8_SA(b, h) (((b) * 2 + (h)) * HTB)
#define PG8_SB(b, h) ((4 + (b) * 2 + (h)) * HTB)
#define PG8_STAGE(bufoff, gbase, voff) do { if constexpr (!(PROBE & 4)) _Pragma("unroll") for (int _i = 0; _i < 2; ++_i) { \
        if constexpr (!BUFS) __builtin_amdgcn_global_load_lds((const unsigned*)((const char*)(size_t)(gbase) + (voff)[_i]), (PG8_LAS unsigned*)(lds + (bufoff) + ldsw + _i * 8192), 16, 0, 0); \
        else __builtin_amdgcn_raw_ptr_buffer_load_lds(rsrc, (PG8_LAS void*)(lds + (bufoff) + ldsw + _i * 8192), 16, (int)(voff)[_i], (int)(size_t)(gbase), 0, 0); } } while (0)
typedef int i32x4_ __attribute__((ext_vector_type(4)));
#define PG8_LD8(off) __builtin_shufflevector(*(const PG8_LAS i32x4_*)(lds + (off)), *(const PG8_LAS i32x4_*)(lds + (off) + 1024), 0, 1, 2, 3, 4, 5, 6, 7)
#define PG8_LDA(dst, b, h) do { if constexpr (PROBE & 2) { } else if constexpr (ESIZE == 2) { _Pragma("unroll") for (int m = 0; m < 4; ++m) _Pragma("unroll") for (int k = 0; k < 2; ++k) dst[m][k] = *(const PG8_LAS bf16x8*)(lds + PG8_SA(b, h) + aoff + m * 2048 + k * 1024); } \
        else { _Pragma("unroll") for (int m = 0; m < 4; ++m) dst##8[m] = PG8_LD8(PG8_SA(b, h) + aoff + m * 2048); } } while (0)
#define PG8_LDB(dst, b, h) do { if constexpr (PROBE & 2) { } else if constexpr (ESIZE == 2) { _Pragma("unroll") for (int n = 0; n < 2; ++n) _Pragma("unroll") for (int k = 0; k < 2; ++k) dst[n][k] = *(const PG8_LAS bf16x8*)(lds + PG8_SB(b, h) + boff + n * 2048 + k * 1024); } \
        else { _Pragma("unroll") for (int n = 0; n < 2; ++n) dst##8[n] = PG8_LD8(PG8_SB(b, h) + boff + n * 2048); } } while (0)
#define PG8_F8CAT(x, y) (i32x8){((const int*)&(x))[0], ((const int*)&(x))[1], ((const int*)&(x))[2], ((const int*)&(x))[3], ((const int*)&(y))[0], ((const int*)&(y))[1], ((const int*)&(y))[2], ((const int*)&(y))[3]}
#define PG8_MMA(ai, bj, At, Bt) do { __builtin_amdgcn_s_setprio(1); if constexpr (PROBE & 1) { } else if constexpr (ESIZE == 2) { _Pragma("unroll") for (int m = 0; m < 4; ++m) _Pragma("unroll") for (int n = 0; n < 2; ++n) _Pragma("unroll") for (int k = 0; k < 2; ++k) \
        acc[ai][bj][m][n] = __builtin_amdgcn_mfma_f32_16x16x32_bf16(Bt[n][k], At[m][k], acc[ai][bj][m][n], 0, 0, 0); } \
        else { _Pragma("unroll") for (int m = 0; m < 4; ++m) _Pragma("unroll") for (int n = 0; n < 2; ++n) \
        asm volatile("v_mfma_scale_f32_16x16x128_f8f6f4 %0, %1, %2, %0, %3, %3 op_sel_hi:[0,0,0]" : "+v"(acc[ai][bj][m][n]) : "v"(Bt##8[n]), "v"(At##8[m]), "v"(sc8)); \
        }   \
        __builtin_amdgcn_s_setprio(0); } while (0)
#define PG8_WAIT_V(n) asm volatile("s_waitcnt vmcnt(" #n ")" ::: "memory")
#define PG8_WAIT_L(n) asm volatile("s_waitcnt lgkmcnt(" #n ")" ::: "memory")
#define PG8_BAR __builtin_amdgcn_s_barrier()
#define PG8_SCHED __builtin_amdgcn_sched_barrier(0)
    Unit cur, nxt; int ui = 0;
    if (!S.next(0, cur)) return;
    f32x4 acc[2][2][4][2];
#pragma unroll
    for (int a = 0; a < 2; ++a)
#pragma unroll
        for (int b = 0; b < 2; ++b)
#pragma unroll
            for (int m = 0; m < 4; ++m)
#pragma unroll
                for (int n = 0; n < 2; ++n) acc[a][b][m][n] = (f32x4){0.f, 0.f, 0.f, 0.f};
    bf16x8 At[4][2], B0[2][2], B1[2][2];
    i32x8 At8[4] = {}, B08[2] = {}, B18[2] = {};
    PT cA = PG8_PT(GATHER ? (const char*)g.A : (const char*)g.A + (size_t)cur.pm * tstep + (size_t)cur.e * g.astride);
    if constexpr (GATHER) { PG8_GROWS(cur, vc0, vc1); } else { _Pragma("unroll") for (int i = 0; i < 2; ++i) { vc0[i] = voffA[i]; vc1[i] = voffA[i] + (unsigned)hstep; } }
#pragma unroll
    for (int i = 0; i < 2; ++i) { vn0[i] = vc0[i]; vn1[i] = vc1[i]; }
    PT cB = PG8_PT((const char*)g.Bt + (size_t)cur.pn * tstep + (size_t)cur.e * g.bstride);
    S.a_ready(cur); PG8_PRE(cur, 0);
    if constexpr (SP2) {
        PG8_STAGE(PG8_SB(0, 0), cB, voffB); PG8_STAGE(PG8_SB(0, 1), cB + hstep, voffB); PG8_STAGE(PG8_SA(0, 0), cA, vc0); PG8_STAGE(PG8_SA(0, 1), cA, vc1);
        if (wr == 1) PG8_BAR;
        PG8_WAIT_V(2); PG8_BAR;
        PG8_STAGE(PG8_SB(1, 0), cB + kstep, voffB); PG8_STAGE(PG8_SA(1, 0), cA + kstep, vc0); PG8_STAGE(PG8_SB(1, 1), cB + hstep + kstep, voffB);
        PG8_WAIT_V(6); PG8_BAR;
    } else {
        PG8_STAGE(PG8_SB(0, 0), cB, voffB); PG8_STAGE(PG8_SA(0, 0), cA, vc0); PG8_STAGE(PG8_SB(0, 1), cB + hstep, voffB); PG8_STAGE(PG8_SA(0, 1), cA, vc1);
        if (wr == 1) PG8_BAR;
        PG8_WAIT_V(4); PG8_BAR;
        PG8_STAGE(PG8_SB(1, 0), cB + kstep, voffB); PG8_STAGE(PG8_SA(1, 0), cA + kstep, vc0); PG8_STAGE(PG8_SB(1, 1), cB + hstep + kstep, voffB);
        PG8_WAIT_V(6); PG8_BAR;
    }
    for (;;) {
        const bool has_next = S.next(ui + 1, nxt);
        const PT nA = GATHER ? cA : (has_next ? PG8_PT((const char*)g.A + (size_t)nxt.pm * tstep + (size_t)nxt.e * g.astride) : cA);
        const int nbuf = pbuf == 2 ? 0 : pbuf + 1; if (has_next) PG8_PRE(nxt, nbuf);
        const PT nB = has_next ? PG8_PT((const char*)g.Bt + (size_t)nxt.pn * tstep + (size_t)nxt.e * g.bstride) : cB;
        for (int t = 0; t < nt; t += 2) {
            const bool last = (t == nt - 2);
            const PT a1 = cA + (unsigned)((t + 1) * (int)kstep);
            const PT a2 = last ? nA : cA + (unsigned)((t + 2) * (int)kstep); const PT b2 = last ? nB : cB + (unsigned)((t + 2) * (int)kstep);
            const PT a3 = a2 + (unsigned)kstep; const PT b3 = b2 + (unsigned)kstep;
            if constexpr (GATHER) { if (last && has_next) { PG8_GROWS_USE(vn0, vn1, nbuf); } }
            unsigned vs0[2], vs1[2];
#pragma unroll
            for (int i = 0; i < 2; ++i) { vs0[i] = (GATHER && last) ? vn0[i] : vc0[i]; vs1[i] = (GATHER && last) ? vn1[i] : vc1[i]; }
            if (last && has_next) S.a_ready(nxt);
            if constexpr (SP2) {
            PG8_LDB(B0, 0, 0); PG8_LDB(B1, 0, 1); PG8_SCHED; PG8_LDA(At, 0, 0); PG8_STAGE(PG8_SA(1, 1), a1, vc1);
            PG8_WAIT_V(8); PG8_WAIT_L(0); PG8_BAR; PG8_MMA(0, 0, At, B0); PG8_MMA(0, 1, At, B1); PG8_BAR; PG8_SCHED;
            PG8_LDA(At, 0, 1); PG8_STAGE(PG8_SB(0, 0), b2, voffB); PG8_STAGE(PG8_SB(0, 1), b2 + hstep, voffB); PG8_STAGE(PG8_SA(0, 0), a2, vs0);
            PG8_WAIT_V(8); PG8_WAIT_L(0); PG8_BAR; PG8_MMA(1, 0, At, B0); PG8_MMA(1, 1, At, B1); PG8_BAR; PG8_SCHED;
            PG8_LDB(B0, 1, 0); PG8_LDB(B1, 1, 1); PG8_SCHED; PG8_LDA(At, 1, 0); PG8_STAGE(PG8_SA(0, 1), a2, vs1);
            PG8_WAIT_V(8); PG8_WAIT_L(0); PG8_BAR; PG8_MMA(0, 0, At, B0); PG8_MMA(0, 1, At, B1); PG8_BAR; PG8_SCHED;
            PG8_LDA(At, 1, 1); PG8_STAGE(PG8_SB(1, 0), b3, voffB); PG8_STAGE(PG8_SB(1, 1), b3 + hstep, voffB); PG8_STAGE(PG8_SA(1, 0), a3, vs0);
            PG8_WAIT_V(8); PG8_WAIT_L(0); PG8_BAR; PG8_MMA(1, 0, At, B0); PG8_MMA(1, 1, At, B1); PG8_BAR; PG8_SCHED;
            } else {
            PG8_LDB(B0, 0, 0); PG8_SCHED; PG8_LDA(At, 0, 0); PG8_STAGE(PG8_SA(1, 1), a1, vc1);
            PG8_WAIT_L(8); PG8_BAR; PG8_WAIT_L(0); PG8_MMA(0, 0, At, B0); PG8_BAR; PG8_SCHED;
            PG8_LDB(B1, 0, 1); PG8_STAGE(PG8_SB(0, 0), b2, voffB);
            PG8_BAR; PG8_WAIT_L(0); PG8_MMA(0, 1, At, B1); PG8_BAR;
            PG8_LDA(At, 0, 1); PG8_STAGE(PG8_SA(0, 0), a2, vs0);
            PG8_BAR; PG8_WAIT_L(0); PG8_MMA(1, 0, At, B0); PG8_BAR; PG8_SCHED;
            PG8_STAGE(PG8_SB(0, 1), b2 + hstep, voffB);
            PG8_WAIT_V(6); PG8_BAR; PG8_MMA(1, 1, At, B1); PG8_BAR;
            PG8_LDB(B0, 1, 0); PG8_SCHED; PG8_LDA(At, 1, 0); PG8_STAGE(PG8_SA(0, 1), a2, vs1);
            PG8_WAIT_L(8); PG8_BAR; PG8_WAIT_L(0); PG8_MMA(0, 0, At, B0); PG8_BAR; PG8_SCHED;
            PG8_LDB(B1, 1, 1); PG8_STAGE(PG8_SB(1, 0), b3, voffB);
            PG8_BAR; PG8_WAIT_L(0); PG8_MMA(0, 1, At, B1); PG8_BAR;
            PG8_LDA(At, 1, 1); PG8_STAGE(PG8_SA(1, 0), a3, vs0);
            PG8_BAR; PG8_WAIT_L(0); PG8_MMA(1, 0, At, B0); PG8_BAR; PG8_SCHED;
            PG8_STAGE(PG8_SB(1, 1), b3 + hstep, voffB);
            PG8_WAIT_V(6); PG8_BAR; PG8_MMA(1, 1, At, B1); PG8_BAR;
            }
        }
        if constexpr (ESIZE == 1) asm volatile("s_nop 15\n\ts_nop 15" ::: "memory");
        if constexpr (ALIGN_EPI) { if (wr == 0) PG8_BAR; }
        if constexpr (PROBE & 8) { } else if constexpr (!Epi::AFTER_DRAIN) { if constexpr (Epi::CHAIN) E.chain(acc, cur, wr, wc, fr, fq); else if constexpr (EPRE > 0) E.pre(acc, cur, wr, wc, fr, fq, lds + PRE_OFF + pbuf * PRE_BUF); else E(acc, cur, wr, wc, fr, fq); S.done(cur); }
        if (!has_next) break;
        if (!(Epi::CHAIN && nxt.e != 0)) {
#pragma unroll
        for (int a = 0; a < 2; ++a)
#pragma unroll
            for (int b = 0; b < 2; ++b)
#pragma unroll
                for (int m = 0; m < 4; ++m)
#pragma unroll
                    for (int n = 0; n < 2; ++n) acc[a][b][m][n] = (f32x4){0.f, 0.f, 0.f, 0.f};
        }
        cur = nxt; cA = nA; cB = nB; ++ui; pbuf = nbuf;
        if constexpr (GATHER) { _Pragma("unroll") for (int i = 0; i < 2; ++i) { vc0[i] = vn0[i]; vc1[i] = vn1[i]; } }
        if constexpr (ALIGN_EPI) { if (wr == 1) PG8_BAR; }
    }
    PG8_WAIT_V(0);
    if constexpr (!ALIGN_EPI) { if (wr == 0) PG8_BAR; }
    PG8_BAR;
    if constexpr (Epi::AFTER_DRAIN) { E.fused(acc, cur, wr, wc, fr, fq, lds, wid, lane); S.done(cur); }
#undef PG8_GROWS
#undef PG8_GROWS_USE
#undef PG8_PRE
#undef PG8_PT
#undef PG8_SA
#undef PG8_SB
#undef PG8_STAGE
#undef PG8_LDA
#undef PG8_LD8
#undef PG8_LDB
#undef PG8_MMA
#undef PG8_F8CAT
#undef PG8_WAIT_V
#undef PG8_WAIT_L
#undef PG8_BAR
#undef PG8_SCHED
}
}


namespace att {
typedef unsigned short bf16_t;
typedef short bf16x8 __attribute__((ext_vector_type(8)));
typedef short s16x4 __attribute__((ext_vector_type(4)));
typedef float f32x16 __attribute__((ext_vector_type(16)));
typedef unsigned u32x4 __attribute__((ext_vector_type(4)));
#define ALAS __attribute__((address_space(3)))
typedef ALAS unsigned char* ALAS_PTR;
#define ASBAR() __builtin_amdgcn_sched_barrier(0)
constexpr int QBLK = 32, KVBLK = 64;
constexpr float THR2 = 11.0f;
constexpr float LOG2E = 1.4426950408889634f, INV2PI = 0.15915494309189535f, LOG2_THETA = 13.287712379549449f;
constexpr int OFF_V = 0, VBUF = 8192, OFF_K = 16384, KBUF_MAX = 13312, OFF_WS = OFF_K + 2 * KBUF_MAX  , OFF_BIAS = OFF_WS + 2048  , ATT_LDS = OFF_BIAS + 7680;
__device__ __forceinline__ int crow(int r, int hi) { return (r & 3) + 8 * (r >> 2) + 4 * hi; }
__device__ __forceinline__ unsigned cvtpk(float lo, float hi) { unsigned r; asm volatile("v_cvt_pk_bf16_f32 %0, %1, %2" : "=v"(r) : "v"(lo), "v"(hi)); return r; }
__device__ __forceinline__ float bf2f(short s) { return __uint_as_float(((unsigned)(unsigned short)s) << 16); }
__device__ __forceinline__ short f2bf_s(float f) { return (short)(cvtpk(f, 0.f) & 0xffffu); }

struct UnitP {
    const bf16_t* Q; int ldq;
    const bf16_t* K0; int ldk0;
    const bf16_t* K1; int ldk1;
    const bf16_t* V; int ldv;
    bf16_t* O; int ldo;
    int nt;
    int grow0;
    const float* gain;
    int kr0;
    const unsigned char* V8;
    const unsigned char* K8; int ldk8;
    float cref;
};

typedef short v4i16_t __attribute__((ext_vector_type(4)));
__device__ __forceinline__ s16x4 vtr(const ALAS unsigned char* p) { return __builtin_bit_cast(s16x4, __builtin_amdgcn_ds_read_tr16_b64_v4i16((ALAS v4i16_t*)p)); }
__device__ __forceinline__ void pv_all(f32x16& o0, f32x16& o1, f32x16& lacc, const ALAS unsigned char* vp, bf16x8 pa0, bf16x8 pa1, bf16x8 pa2, bf16x8 pa3) {
    const bf16x8 ones = {(short)0x3F80, (short)0x3F80, (short)0x3F80, (short)0x3F80, (short)0x3F80, (short)0x3F80, (short)0x3F80, (short)0x3F80};
#define ATT_PK(L, H) (bf16x8){L[0], L[1], L[2], L[3], H[0], H[1], H[2], H[3]}
#define ATT_STEP(KS, PA) { const s16x4 l0 = vtr(vp + (KS) * 1024), h0 = vtr(vp + (KS) * 1024 + 512), l1 = vtr(vp + 4096 + (KS) * 1024), h1 = vtr(vp + 4096 + (KS) * 1024 + 512); \
        o0 = __builtin_amdgcn_mfma_f32_32x32x16_bf16(PA, ATT_PK(l0, h0), o0, 0, 0, 0); o1 = __builtin_amdgcn_mfma_f32_32x32x16_bf16(PA, ATT_PK(l1, h1), o1, 0, 0, 0); \
        lacc = __builtin_amdgcn_mfma_f32_32x32x16_bf16(PA, ones, lacc, 0, 0, 0); }
    ATT_STEP(0, pa0) ATT_STEP(1, pa1) ATT_STEP(2, pa2) ATT_STEP(3, pa3)
#undef ATT_STEP
#undef ATT_PK
}
template <int DQK> __device__ __forceinline__ void qkt(f32x16& p0, f32x16& p1, const ALAS unsigned char* Ks, const bf16x8* qr, const f32x16& cinit, int r32, int hi) {
    constexpr int KST = DQK * 2 + 16;
#pragma unroll
    for (int d0 = 0; d0 < DQK / 16; ++d0) { const int cb = (2 * d0 + hi) * 16;
        const bf16x8 b0 = *(const ALAS bf16x8*)(Ks + r32 * KST + cb);
        const bf16x8 b1 = *(const ALAS bf16x8*)(Ks + (32 + r32) * KST + cb);
        if (d0 == 0) { p0 = __builtin_amdgcn_mfma_f32_32x32x16_bf16(b0, qr[0], cinit, 0, 0, 0); p1 = __builtin_amdgcn_mfma_f32_32x32x16_bf16(b1, qr[0], cinit, 0, 0, 0); }
        else { p0 = __builtin_amdgcn_mfma_f32_32x32x16_bf16(b0, qr[d0], p0, 0, 0, 0); p1 = __builtin_amdgcn_mfma_f32_32x32x16_bf16(b1, qr[d0], p1, 0, 0, 0); } }
}
__device__ __forceinline__ void na_mask(f32x16& p0, f32x16& p1, const ALAS float* btab, int kr, int rq, int qc_in, int hi_in) {
    int qc = qc_in, hi = hi_in; asm volatile("" : "+v"(qc), "+v"(hi));
    int r0 = rq - 4; r0 = r0 < 0 ? 0 : (r0 > 120 ? 120 : r0);
    const bool rowok = (kr >= r0) && (kr < r0 + 8);
    if (!rowok) {
#pragma unroll
        for (int r = 0; r < 16; ++r) { p0[r] = -1e30f; p1[r] = -1e30f; }
        return; }
    int c0 = qc - 8; c0 = c0 < 0 ? 0 : (c0 > 48 ? 48 : c0);
    int dr = kr - rq + 7; dr = dr < 0 ? 0 : (dr > 14 ? 14 : dr);
    const ALAS float* brow = btab + dr * 128 + (48 + 15 + 4 * hi - qc);
    const int cb = 4 * hi - c0;
#pragma unroll
    for (int r = 0; r < 16; ++r) {
        const int ka = (r & 3) + 8 * (r >> 2);
        const bool oka = (unsigned)(ka + cb) < 16u, okb = (unsigned)(ka + 32 + cb) < 16u;
        p0[r] = oka ? p0[r] + brow[ka] : -1e30f;
        p1[r] = okb ? p1[r] + brow[ka + 32] : -1e30f;
    }
}
__device__ __forceinline__ void lazySM(f32x16& p0, f32x16& p1, float& m_reg, bool& moved, float& alpha) {
    float pmax = p0[0];
#pragma unroll
    for (int r = 1; r < 16; ++r) pmax = fmaxf(pmax, p0[r]);
#pragma unroll
    for (int r = 0; r < 16; ++r) pmax = fmaxf(pmax, p1[r]);
    { auto rr = __builtin_amdgcn_permlane32_swap(__float_as_uint(pmax), __float_as_uint(pmax), false, false);
      pmax = fmaxf(__uint_as_float(rr[0]), __uint_as_float(rr[1])); }
    if (__builtin_expect(__all(pmax <= THR2), 1)) { alpha = 1.f; }
    else { const float dl = fmaxf(pmax, 0.f); m_reg += dl; alpha = __builtin_amdgcn_exp2f(-dl);
#pragma unroll
        for (int r = 0; r < 16; ++r) { p0[r] -= dl; p1[r] -= dl; }
        moved = true; }
#pragma unroll
    for (int r = 0; r < 16; ++r) p0[r] = __builtin_amdgcn_exp2f(p0[r]);
}
__device__ __forceinline__ void fixedSM(f32x16& p0) {
#pragma unroll
    for (int r = 0; r < 16; ++r) p0[r] = __builtin_amdgcn_exp2f(p0[r]);
}
__device__ __forceinline__ void finishSM(f32x16& p0, f32x16& p1, bf16x8& pa0, bf16x8& pa1, bf16x8& pa2, bf16x8& pa3) {
#pragma unroll
    for (int r = 0; r < 16; ++r) p1[r] = __builtin_amdgcn_exp2f(p1[r]);
    u32x4 w;
    w = (u32x4){cvtpk(p0[0], p0[1]), cvtpk(p0[2], p0[3]), cvtpk(p0[4], p0[5]), cvtpk(p0[6], p0[7])}; pa0 = __builtin_bit_cast(bf16x8, w);
    w = (u32x4){cvtpk(p0[8], p0[9]), cvtpk(p0[10], p0[11]), cvtpk(p0[12], p0[13]), cvtpk(p0[14], p0[15])}; pa1 = __builtin_bit_cast(bf16x8, w);
    w = (u32x4){cvtpk(p1[0], p1[1]), cvtpk(p1[2], p1[3]), cvtpk(p1[4], p1[5]), cvtpk(p1[6], p1[7])}; pa2 = __builtin_bit_cast(bf16x8, w);
    w = (u32x4){cvtpk(p1[8], p1[9]), cvtpk(p1[10], p1[11]), cvtpk(p1[12], p1[13]), cvtpk(p1[14], p1[15])}; pa3 = __builtin_bit_cast(bf16x8, w);
}
struct NoSide { static constexpr bool PLAIN = true; template <int P> __device__ __forceinline__ void step() {} template <int P> __device__ __forceinline__ void load() {} };
typedef int i32x8 __attribute__((ext_vector_type(8)));
typedef int i32x4 __attribute__((ext_vector_type(4)));
template <int DQK, int MODE, class SIDE = NoSide, bool K8 = false, bool P8 = false>
__device__ __forceinline__ void attn_unit(const UnitP& u, ALAS unsigned char* lds, const int tid, SIDE& side) {
    static_assert(!K8 || (DQK == 64 && MODE == 0) || (DQK == 96 && MODE == 1), "fp8 QK^T: GQA fixed-reference form, or MLA (its 64 un-roped dims in fp8, the 32 rope dims stay bf16)");
    constexpr bool K8M = K8 && MODE == 1;
    constexpr int ND = DQK / 16, KST = K8 ? (K8M ? 144 : 80) : DQK * 2 + 16, KBUF = 64 * KST;
    constexpr bool PV8 = P8;
    static_assert(!P8 || MODE == 0 || MODE == 1, "8-bit P.V: dense forms only");
    static_assert(KBUF <= KBUF_MAX, "K buffer");
    const int wid = __builtin_amdgcn_readfirstlane(tid >> 6), lane = tid & 63, r32 = lane & 31, hi = lane >> 5;
    ALAS unsigned char* V_lds = lds + OFF_V; ALAS unsigned char* K_lds = lds + OFF_K;
    ALAS float* ws = (ALAS float*)(lds + OFF_WS) + wid * 64; ALAS float* al_l = ws + 32;
    const ALAS float* btab = (const ALAS float*)(lds + OFF_BIAS);
    float m_reg = 0.f; f32x16 o[2], lacc; o[0] = f32x16{}; o[1] = f32x16{}; lacc = f32x16{}; bf16x8 qr[ND];
    bool moved = false;
    const int grow = u.grow0 + (wid >> 1), gcol = (wid & 1) * 32 + r32;
    int r0w_ = grow - 4; r0w_ = r0w_ < 0 ? 0 : (r0w_ > 120 ? 120 : r0w_); const int jlo_ = r0w_ - u.kr0, jhi_ = jlo_ + 8;
#define ATT_OK(j) (MODE != 2 || ((j) >= jlo_ && (j) < jhi_))
    {
        const bf16_t* Qw = u.Q + (size_t)(wid * QBLK + r32) * u.ldq + hi * 8;
#pragma unroll
        for (int d0 = K8M ? 4 : 0; d0 < ND; ++d0) qr[d0] = *(const bf16x8*)(Qw + d0 * 16);
        if constexpr (MODE == 0 || MODE == 3) {
            float x[4][8]; float ssq = 0.f;
#pragma unroll
            for (int d0 = 0; d0 < 4; ++d0)
#pragma unroll
                for (int j = 0; j < 8; ++j) { x[d0][j] = bf2f(qr[d0][j]); ssq += x[d0][j] * x[d0][j]; }
            { auto rr_ = __builtin_amdgcn_permlane32_swap(__float_as_uint(ssq), __float_as_uint(ssq), false, false); ssq = __uint_as_float(rr_[0]) + __uint_as_float(rr_[1]); }
            const float rstd = 1.0f / sqrtf(ssq * (1.0f / 64.0f) + 1e-6f);
#pragma unroll
            for (int d0 = 0; d0 < 4; ++d0)
#pragma unroll
                for (int j = 0; j < 8; ++j) x[d0][j] = x[d0][j] * rstd * u.gain[16 * d0 + 8 * hi + j];
#pragma unroll
            for (int d0 = 0; d0 < 2; ++d0)
#pragma unroll
                for (int j = 0; j < 8; ++j) { const float inv = exp2f(-(float)(8 * hi + j) * (LOG2_THETA / 16.0f));
                    const float ang = (float)(d0 == 0 ? grow : gcol) * inv * INV2PI; const float c = __builtin_amdgcn_cosf(ang), s = __builtin_amdgcn_sinf(ang);
                    const float y1 = x[d0][j], y2 = x[d0 + 2][j]; x[d0][j] = y1 * c - y2 * s; x[d0 + 2][j] = y1 * s + y2 * c; }
            constexpr float C2 = 0.125f * LOG2E;
#pragma unroll
            for (int d0 = 0; d0 < 4; ++d0) { u32x4 w = {cvtpk(x[d0][0] * C2, x[d0][1] * C2), cvtpk(x[d0][2] * C2, x[d0][3] * C2), cvtpk(x[d0][4] * C2, x[d0][5] * C2), cvtpk(x[d0][6] * C2, x[d0][7] * C2)};
                qr[d0] = __builtin_bit_cast(bf16x8, w); }
        }
        if constexpr (MODE == 1) {
            float y1[8], y2[8];
#pragma unroll
            for (int j = 0; j < 8; ++j) { const float inv = exp2f(-(float)j * (LOG2_THETA / 8.0f));
                const float ang = (float)(hi == 0 ? grow : gcol) * inv * INV2PI; const float c = __builtin_amdgcn_cosf(ang), s = __builtin_amdgcn_sinf(ang);
                const float a = bf2f(qr[4][j]), b = bf2f(qr[5][j]); y1[j] = a * c - b * s; y2[j] = a * s + b * c; }
            u32x4 w = {cvtpk(y1[0], y1[1]), cvtpk(y1[2], y1[3]), cvtpk(y1[4], y1[5]), cvtpk(y1[6], y1[7])}; qr[4] = __builtin_bit_cast(bf16x8, w);
            w = (u32x4){cvtpk(y2[0], y2[1]), cvtpk(y2[2], y2[3]), cvtpk(y2[4], y2[5]), cvtpk(y2[6], y2[7])}; qr[5] = __builtin_bit_cast(bf16x8, w);
        }
    }
    i32x8 qr8 = {0, 0, 0, 0, 0, 0, 0, 0}; int sc8 = 0x7F7F7F7F;
    if constexpr (K8M) {
        const bf16_t* Qn = u.Q + (size_t)(wid * QBLK + r32) * u.ldq + hi * 32;
#pragma unroll
        for (int i = 0; i < 4; ++i) { const bf16x8 qv = *(const bf16x8*)(Qn + 8 * i);
            qr8[2 * i] = (int)pg8::pk4_fp8(bf2f(qv[0]), bf2f(qv[1]), bf2f(qv[2]), bf2f(qv[3])); qr8[2 * i + 1] = (int)pg8::pk4_fp8(bf2f(qv[4]), bf2f(qv[5]), bf2f(qv[6]), bf2f(qv[7])); }
    }
    if constexpr (K8 && !K8M) {
#pragma unroll
        for (int d0 = 0; d0 < 4; ++d0) { float f_[8];
#pragma unroll
            for (int j = 0; j < 8; ++j) f_[j] = bf2f(qr[d0][j]);
            qr8[2 * d0] = (int)pg8::pk4_fp8(f_[0], f_[1], f_[2], f_[3]); qr8[2 * d0 + 1] = (int)pg8::pk4_fp8(f_[4], f_[5], f_[6], f_[7]); }
    }
    if constexpr (K8 || P8) asm volatile("" : "+v"(sc8));
    const int sk = tid >> 3, sc = tid & 7;
    const unsigned vsoff = (unsigned)(sk * u.ldv + sc * 8) * 2u, ksoff = K8 ? (unsigned)(sk * u.ldk8 + sc * 8) : (unsigned)(sk * u.ldk0 + sc * 8) * 2u;
    const int vst = (sc >> 2) * 4096 + sk * 64 + (sc & 3) * 16, kst = K8 ? sk * KST + sc * 8 : sk * KST + sc * 16;
    const int sk2 = (tid & 255) >> 2, sc2 = tid & 3;
    const unsigned k2soff = (DQK == 96) ? (unsigned)(sk2 * u.ldk1 + sc2 * 8) * 2u : 0u;
    const int k2st = sk2 * KST + (K8M ? 64 : 128) + sc2 * 16;
    const ALAS unsigned char* vb0 = V_lds + ((lane >> 4) & 1) * 32 + (lane & 3) * 8 + (4 * hi + ((lane & 15) >> 2)) * 64;
    typedef unsigned long long u64_; struct { bf16x8 v, k, k2; u64_ k8, v8; } sr_[2];
    const unsigned v8soff = (unsigned)(sk * 64 + sc * 8); const int v8st = sk * 80 + sc * 8;
#define ATT_SLOAD(i, k0) do { if constexpr (PV8) sr_[i].v8 = *(const u64_*)((const char*)(u.V8 + (size_t)(k0) * 64) + v8soff); else sr_[i].v = *(const bf16x8*)((const char*)(u.V + (size_t)(k0) * u.ldv) + vsoff); \
        if constexpr (K8) sr_[i].k8 = *(const u64_*)((const char*)(u.K8 + (size_t)(k0) * u.ldk8) + ksoff); else sr_[i].k = *(const bf16x8*)((const char*)(u.K0 + (size_t)(k0) * u.ldk0) + ksoff); \
        if constexpr (DQK == 96) sr_[i].k2 = *(const bf16x8*)((const char*)(u.K1 + (size_t)(k0) * u.ldk1) + k2soff); } while (0)
#define ATT_SWRITE(b, i) do { if constexpr (PV8) *(ALAS u64_*)(V_lds + vo_w + v8st) = sr_[i].v8; else *(ALAS bf16x8*)(V_lds + (b) * VBUF + vst) = sr_[i].v; \
        if constexpr (K8) *(ALAS u64_*)(K_lds + (b) * KBUF + kst) = sr_[i].k8; else *(ALAS bf16x8*)(K_lds + (b) * KBUF + kst) = sr_[i].k; \
        if constexpr (DQK == 96) *(ALAS bf16x8*)(K_lds + (b) * KBUF + k2st) = sr_[i].k2; } while (0)
#define ATT_SWAIT() do { if constexpr (SIDE::PLAIN) { if constexpr (DQK == 96) asm volatile("s_waitcnt vmcnt(3)" ::: "memory"); else asm volatile("s_waitcnt vmcnt(2)" ::: "memory"); } } while (0)
#define ATT_RESC(a) do { if constexpr (MODE != 0) { if (__any((a) < 1.f)) { if (hi == 0) al_l[r32] = (a); asm volatile("s_waitcnt lgkmcnt(0)" ::: "memory"); \
        if constexpr (PV8) asm volatile("s_nop 15\n\ts_nop 15\n\ts_nop 15\n\ts_nop 15\n\ts_nop 15\n\ts_nop 15\n\ts_nop 15\n\ts_nop 15\n\ts_nop 15\n\ts_nop 15\n\ts_nop 15\n\ts_nop 15" : "+v"(o[0]), "+v"(o[1]), "+v"(lacc) :: "memory");     \
        _Pragma("unroll") for (int r = 0; r < 16; ++r) { const float f_ = al_l[crow(r, hi)]; o[0][r] *= f_; o[1][r] *= f_; lacc[r] *= f_; } \
        if constexpr (PV8) asm volatile("s_nop 7" : "+v"(o[0]), "+v"(o[1]), "+v"(lacc) :: "memory"); } } } while (0)
#define ATT_SM(P0, P1, AL) do { if constexpr (MODE == 0) { fixedSM(P0); AL = 1.f; } else lazySM(P0, P1, m_reg, moved, AL); } while (0)
#define ATT_QKT8(P0, P1, KS) do { const ALAS unsigned char* kp_ = (KS) + r32 * 80 + hi * 32; \
        const i32x8 ka_ = __builtin_shufflevector(*(const ALAS i32x4*)kp_, *(const ALAS i32x4*)(kp_ + 16), 0, 1, 2, 3, 4, 5, 6, 7); \
        const i32x8 kb_ = __builtin_shufflevector(*(const ALAS i32x4*)(kp_ + 32 * 80), *(const ALAS i32x4*)(kp_ + 32 * 80 + 16), 0, 1, 2, 3, 4, 5, 6, 7); \
        asm volatile("v_mfma_scale_f32_32x32x64_f8f6f4 %0, %1, %2, 0, %3, %3 op_sel_hi:[0,0,0]" : "=&v"(P0) : "v"(ka_), "v"(qr8), "v"(sc8)); \
        asm volatile("v_mfma_scale_f32_32x32x64_f8f6f4 %0, %1, %2, 0, %3, %3 op_sel_hi:[0,0,0]" : "=&v"(P1) : "v"(kb_), "v"(qr8), "v"(sc8)); } while (0)
#define ATT_QKT8M(P0, P1, KS) do { const ALAS unsigned char* kp_ = (KS) + r32 * KST + hi * 32; \
        const i32x8 ka_ = __builtin_shufflevector(*(const ALAS i32x4*)kp_, *(const ALAS i32x4*)(kp_ + 16), 0, 1, 2, 3, 4, 5, 6, 7); \
        const i32x8 kb_ = __builtin_shufflevector(*(const ALAS i32x4*)(kp_ + 32 * KST), *(const ALAS i32x4*)(kp_ + 32 * KST + 16), 0, 1, 2, 3, 4, 5, 6, 7); \
        const ALAS unsigned char* rp_ = (KS) + r32 * KST + 64 + hi * 16; \
        const bf16x8 r00_ = *(const ALAS bf16x8*)rp_, r01_ = *(const ALAS bf16x8*)(rp_ + 32), r10_ = *(const ALAS bf16x8*)(rp_ + 32 * KST), r11_ = *(const ALAS bf16x8*)(rp_ + 32 * KST + 32); \
        f32x16 ci_; _Pragma("unroll") for (int r_ = 0; r_ < 16; ++r_) ci_[r_] = moved ? -m_reg : 0.f; \
        P0 = __builtin_amdgcn_mfma_f32_32x32x16_bf16(r00_, qr[4], ci_, 0, 0, 0); P1 = __builtin_amdgcn_mfma_f32_32x32x16_bf16(r10_, qr[4], ci_, 0, 0, 0); \
        P0 = __builtin_amdgcn_mfma_f32_32x32x16_bf16(r01_, qr[5], P0, 0, 0, 0); P1 = __builtin_amdgcn_mfma_f32_32x32x16_bf16(r11_, qr[5], P1, 0, 0, 0); \
          \
        asm volatile("s_nop 15\n\ts_nop 15\n\ts_nop 7\n\tv_mfma_scale_f32_32x32x64_f8f6f4 %0, %1, %2, %0, %3, %3 op_sel_hi:[0,0,0]" : "+v"(P0) : "v"(ka_), "v"(qr8), "v"(sc8), "v"(P1)); \
        asm volatile("v_mfma_scale_f32_32x32x64_f8f6f4 %0, %1, %2, %0, %3, %3 op_sel_hi:[0,0,0]" : "+v"(P1) : "v"(kb_), "v"(qr8), "v"(sc8)); } while (0)
#define ATT_QKT(P0, P1, KS) do { if constexpr (K8M) ATT_QKT8M(P0, P1, KS); else if constexpr (K8) ATT_QKT8(P0, P1, KS); else if (MODE != 0 && moved) { f32x16 ng_; _Pragma("unroll") for (int r_ = 0; r_ < 16; ++r_) ng_[r_] = -m_reg; qkt<DQK>(P0, P1, KS, qr, ng_, r32, hi); } \
        else { const f32x16 z_ = f32x16{}; qkt<DQK>(P0, P1, KS, qr, z_, r32, hi); } } while (0)
#define ATT_PV8(VOFF) do { const ALAS unsigned char* vp_ = V_lds + (VOFF) + r32 * 80 + hi * 32; \
        const i32x8 va_ = __builtin_shufflevector(*(const ALAS i32x4*)vp_, *(const ALAS i32x4*)(vp_ + 16), 0, 1, 2, 3, 4, 5, 6, 7); \
        const i32x8 vb_ = __builtin_shufflevector(*(const ALAS i32x4*)(vp_ + 32 * 80), *(const ALAS i32x4*)(vp_ + 32 * 80 + 16), 0, 1, 2, 3, 4, 5, 6, 7); \
        asm volatile("v_mfma_scale_f32_32x32x64_f8f6f4 %0, %1, %2, %0, %3, %3 op_sel_hi:[0,0,0] cbsz:1 blgp:1" : "+v"(o[0]) : "v"(p8), "v"(va_), "v"(sc8)); \
        asm volatile("v_mfma_scale_f32_32x32x64_f8f6f4 %0, %1, %2, %0, %3, %3 op_sel_hi:[0,0,0] cbsz:1 blgp:1" : "+v"(o[1]) : "v"(p8), "v"(vb_), "v"(sc8)); \
        asm volatile("v_mfma_scale_f32_32x32x64_f8f6f4 %0, %1, %2, %0, %3, %3 op_sel_hi:[0,0,0] cbsz:1 blgp:1" : "+v"(lacc) : "v"(p8), "v"(ones8), "v"(sc8)); } while (0)
#define ATT_PV(VB) do { if constexpr (PV8) ATT_PV8(vo_r); else pv_all(o[0], o[1], lacc, (VB), pa0, pa1, pa2, pa3); } while (0)
    constexpr int VB8 = 5120; int vo_r = 0, vo_c = VB8, vo_w = 0; (void)vo_c;
#define ATT_VROT() do { if constexpr (PV8) { const int t_ = vo_r; vo_r = vo_c; vo_c = vo_w; vo_w = t_; } } while (0)
#define ATT_BAR1() do { if constexpr (!PV8) __syncthreads(); } while (0)
#define ATT_FIN(P0, P1) do { if constexpr (PV8) { _Pragma("unroll") for (int r_ = 0; r_ < 16; ++r_) P1[r_] = __builtin_amdgcn_exp2f(P1[r_]); \
        _Pragma("unroll") for (int g_ = 0; g_ < 4; ++g_) { int w_ = __builtin_amdgcn_cvt_pk_bf8_f32(P0[4 * g_], P0[4 * g_ + 1], p8[g_], false); p8[g_] = __builtin_amdgcn_cvt_pk_bf8_f32(P0[4 * g_ + 2], P0[4 * g_ + 3], w_, true); \
            w_ = __builtin_amdgcn_cvt_pk_bf8_f32(P1[4 * g_], P1[4 * g_ + 1], p8[4 + g_], false); p8[4 + g_] = __builtin_amdgcn_cvt_pk_bf8_f32(P1[4 * g_ + 2], P1[4 * g_ + 3], w_, true); } }        \
        else finishSM(P0, P1, pa0, pa1, pa2, pa3); } while (0)
#define ATT_MASK(P0, P1, j) do { if constexpr (MODE == 2) na_mask(P0, P1, btab, u.kr0 + (j), grow, gcol, hi); } while (0)
    f32x16 pA0, pA1, pB0, pB1; float alA, alB; bf16x8 pa0, pa1, pa2, pa3; const int NT = u.nt;
    i32x8 p8 = {0, 0, 0, 0, 0, 0, 0, 0}; i32x8 ones8 = {0x3C3C3C3C, 0x3C3C3C3C, 0x3C3C3C3C, 0x3C3C3C3C, 0x3C3C3C3C, 0x3C3C3C3C, 0x3C3C3C3C, 0x3C3C3C3C};
    if constexpr (PV8) { int o1_ = 0x3C3C3C3C; asm volatile("" : "+v"(o1_)); ones8 = (i32x8){o1_, o1_, o1_, o1_, o1_, o1_, o1_, o1_}; asm volatile("" : "+v"(ones8)); }
    constexpr int SE = 0, SO = 1;
    ATT_SLOAD(SE, 0); asm volatile("s_waitcnt vmcnt(0)" ::: "memory"); ATT_SWRITE(0, SE); __syncthreads(); vo_w = VB8;
    if (ATT_OK(0)) ATT_QKT(pA0, pA1, K_lds); if constexpr (K8) asm volatile("s_nop 15\n\ts_nop 15\n\ts_nop 15\n\ts_nop 15\n\ts_nop 15\n\ts_nop 15\n\ts_nop 15\n\ts_nop 15\n\ts_nop 15\n\ts_nop 15" : "+v"(pA0), "+v"(pA1) :: "memory");
    if (ATT_OK(0)) ATT_MASK(pA0, pA1, 0);
    if constexpr (PV8 && MODE != 0) {
        float pm_ = pA0[0];
#pragma unroll
        for (int r = 1; r < 16; ++r) pm_ = fmaxf(pm_, pA0[r]);
#pragma unroll
        for (int r = 0; r < 16; ++r) pm_ = fmaxf(pm_, pA1[r]);
        { auto rr_ = __builtin_amdgcn_permlane32_swap(__float_as_uint(pm_), __float_as_uint(pm_), false, false); pm_ = fmaxf(__uint_as_float(rr_[0]), __uint_as_float(rr_[1])); }
        m_reg = pm_ - 8.0f; moved = true;
#pragma unroll
        for (int r = 0; r < 16; ++r) { pA0[r] -= m_reg; pA1[r] -= m_reg; }
    }
    if (ATT_OK(0)) ATT_SM(pA0, pA1, alA); else alA = 1.f;
    ATT_SLOAD(SO, KVBLK); if (2 < NT) ATT_SLOAD(SE, 2 * KVBLK);
    ATT_SWAIT(); ATT_SWRITE(1, SO); __syncthreads(); vo_w = 2 * VB8;
    if (wid >= 4) __builtin_amdgcn_s_setprio(1);
#define ASBAR2() do { if constexpr (!PV8) ASBAR(); } while (0)
#define ATT_BODY(ACT) { \
        if constexpr (!SIDE::PLAIN && (ACT)) side.template step<0>(); \
        ASBAR(); if (ATT_OK(j)) { ATT_QKT(pB0, pB1, K_lds + KBUF); ATT_MASK(pB0, pB1, j); } \
        if (ATT_OK(j - 1)) ATT_FIN(pA0, pA1); ASBAR2(); \
        ATT_SLOAD(SO, (j + 2) * KVBLK); if constexpr (!SIDE::PLAIN && (ACT)) side.template load<0>(); ASBAR2(); \
        if (ATT_OK(j - 1)) ATT_PV(vb0); if constexpr (K8) ASBAR();        \
        if (ATT_OK(j)) ATT_SM(pB0, pB1, alB); else alB = 1.f; \
        ATT_BAR1(); ATT_SWAIT(); ATT_SWRITE(0, SE); \
        ATT_RESC(alB); __syncthreads(); ATT_VROT(); \
        if constexpr (!SIDE::PLAIN && (ACT)) side.template step<1>(); \
        ASBAR(); if (ATT_OK(j + 1)) { ATT_QKT(pA0, pA1, K_lds); ATT_MASK(pA0, pA1, j + 1); } \
        if (ATT_OK(j)) ATT_FIN(pB0, pB1); ASBAR2(); \
        ATT_SLOAD(SE, (j + 3 < NT ? j + 3 : NT - 1) * KVBLK);        \
        if constexpr (!SIDE::PLAIN && (ACT)) side.template load<1>(); ASBAR2(); \
        if (ATT_OK(j)) ATT_PV(vb0 + VBUF); if constexpr (K8) ASBAR(); \
        if (ATT_OK(j + 1)) ATT_SM(pA0, pA1, alA); else alA = 1.f; \
        ATT_BAR1(); ATT_SWAIT(); ATT_SWRITE(1, SO); \
        ATT_RESC(alA); __syncthreads(); ATT_VROT(); }
    if constexpr (SIDE::PLAIN) { for (int j = 1; j + 1 < NT; j += 2) ATT_BODY(false) }
    else { int j = 1; const int ntrip = (NT - 1) / 2, ng = ntrip / 7, rem = ntrip - 7 * ng;
        for (int g = 0; g < ng; ++g) {
#pragma unroll
            for (int a_ = 0; a_ < 2; ++a_) { ATT_BODY(true) j += 2; }
#pragma nounroll
            for (int k_ = 0; k_ < 5; ++k_) { ATT_BODY(false) j += 2; } }
#pragma nounroll
        for (int k_ = 0; k_ < rem; ++k_) { ATT_BODY(false) j += 2; } }
#undef ATT_BODY
#undef ASBAR2
    ASBAR(); if (ATT_OK(NT - 1)) { ATT_QKT(pB0, pB1, K_lds + KBUF); ATT_MASK(pB0, pB1, NT - 1); }
    if (ATT_OK(NT - 2)) ATT_FIN(pA0, pA1); ASBAR();
    if (ATT_OK(NT - 2)) ATT_PV(vb0); if constexpr (K8) ASBAR();
    if (ATT_OK(NT - 1)) ATT_SM(pB0, pB1, alB); else alB = 1.f;
    __syncthreads(); ATT_RESC(alB);
    if (ATT_OK(NT - 1)) ATT_FIN(pB0, pB1); ASBAR(); ATT_VROT();
    if (ATT_OK(NT - 1)) ATT_PV(vb0 + VBUF);
    __builtin_amdgcn_s_setprio(0);
    if constexpr (PV8) asm volatile("s_nop 15\n\ts_nop 15\n\ts_nop 15\n\ts_nop 15\n\ts_nop 15\n\ts_nop 15\n\ts_nop 15\n\ts_nop 15\n\ts_nop 15\n\ts_nop 15\n\ts_nop 15\n\ts_nop 15\n\ts_nop 15\n\ts_nop 15" : "+v"(o[0]), "+v"(o[1]), "+v"(lacc) :: "memory");
#if MK_E8
    bf16_t* Ow = (bf16_t*)((unsigned char*)u.O + (size_t)(wid * QBLK) * u.ldo);
#else
    bf16_t* Ow = u.O + (size_t)(wid * QBLK) * u.ldo;
#endif
#pragma unroll
    for (int r = 0; r < 16; ++r) { const int orow = crow(r, hi); const float rl = __builtin_amdgcn_rcpf(lacc[r]);
#pragma unroll
        for (int d0 = 0; d0 < 2; ++d0) {
#if MK_E8
            ((unsigned char*)Ow)[(size_t)orow * u.ldo + d0 * 32 + r32] = (unsigned char)(pg8::pk4_fp8(o[d0][r] * rl * 64.0f, 0.f, 0.f, 0.f) & 0xffu);
#else
            Ow[(size_t)orow * u.ldo + d0 * 32 + r32] = (bf16_t)f2bf_s(o[d0][r] * rl);
#endif
        } }
    __syncthreads();
#undef ATT_OK
#undef ATT_SLOAD
#undef ATT_SWRITE
#undef ATT_SWAIT
#undef ATT_RESC
#undef ATT_SM
#undef ATT_QKT
#undef ATT_QKT8
#undef ATT_QKT8M
#undef ATT_PV8
#undef ATT_VROT
#undef ATT_BAR1
#undef ATT_FIN
#undef ATT_PV
#undef ATT_MASK
}
}


constexpr int NWAVES = 8;
#ifndef MK_DEBUG
#define MK_DEBUG 0
#endif
#ifndef MK_DBG_IGNORE
#define MK_DBG_IGNORE 0
#endif
#ifndef MK_ONE_LAUNCH
#define MK_ONE_LAUNCH 0
#endif
#ifndef REP_P
#define REP_P 1
#endif
#ifndef REP_A
#define REP_A 1
#endif
#ifndef REP_B
#define REP_B 1
#endif
#ifndef REP_C
#define REP_C 1
#endif
#ifndef REP_DG
#define REP_DG 1
#endif
#ifndef REP_DM
#define REP_DM 1
#endif
#ifndef REP_DN
#define REP_DN 1
#endif
#ifndef REP_E
#define REP_E 1
#endif
#ifndef REP_F
#define REP_F 1
#endif
#ifndef REP_H
#define REP_H 1
#endif
#ifndef REP_I
#define REP_I 1
#endif
#ifndef REP_J
#define REP_J 1
#endif
#ifndef REP_K
#define REP_K 1
#endif
#ifndef MK_FP8_LAST
#define MK_FP8_LAST 1
#endif
#ifndef MK_FP8_MOE_ALL
#define MK_FP8_MOE_ALL 1
#endif
#define F8MOE(l) (MK_FP8_LAST && ((l) == DEPTH - 1 || MK_FP8_MOE_ALL))
#ifndef MK_FP8_IN_ALL
#define MK_FP8_IN_ALL 1
#endif
#define F8IN(l) (MK_FP8_LAST && ((l) == DEPTH - 1 || MK_FP8_IN_ALL))
#ifndef MK_FP8_QK
#define MK_FP8_QK 1
#endif
#ifndef MK_FP8_PV
#define MK_FP8_PV 1
#endif
#ifndef MK_FP8_PVM
#define MK_FP8_PVM 1
#endif
#ifndef MK_FP8_QKM
#define MK_FP8_QKM 1
#endif
#ifndef MK_FP8_OUT
#define MK_FP8_OUT 1
#endif
constexpr int NB = 4, SEQ = 8192, T = NB * SEQ, D = 1024, DEPTH = 2, GW = 64;
constexpr int DIN = 5536, DINP = 5632;
constexpr int H_NAQ = 0, H_NAK = 384, H_NAV = 768, H_GQ = 1152, H_GK = 1536, H_GV = 1664, H_CQ = 1792, H_CKV = 2176, H_KR = 2432, H_GATE = 2464;
constexpr int NE = 32, TOPK = 4, FF = 1024, TK = T * TOPK;
constexpr int PSLOTS = TK + NE * 256;
constexpr int MAXTILES = PSLOTS / 256;
constexpr int LCAP = T;
constexpr float LN_EPS = 1e-5f, RMS_EPS = 1e-6f, DN_ALPHA = 1.4142135623730951f;
constexpr float LOG2E_F = 1.4426950408889634f;
constexpr int PPL = 10, NPH = 1 + DEPTH * PPL;

constexpr size_t MiB = 1u << 20;
constexpr size_t WS_CTL = 0, CTL_ZERO_BYTES = 1 * MiB;
constexpr size_t WB_IN = 0, WB_UQ = WB_IN + (size_t)DINP * 1024 * 2, WB_UKV = WB_UQ + (size_t)512 * 384 * 2, WB_BA = WB_UKV + (size_t)512 * 256 * 2,
                 WB_BB = WB_BA + (size_t)1024 * 384 * 2, WB_BC = WB_BB + (size_t)1024 * 384 * 2, WB_OUT = WB_BC + (size_t)1024 * 384 * 2,
                 WB_GU = WB_OUT + (size_t)1024 * 1024 * 2, WB_DN = WB_GU + (size_t)NE * 2048 * 1024 * 2, WB_LAYER = WB_DN + (size_t)NE * 1024 * 1024 * 2;
static_assert(WB_LAYER % 256 == 0, "weight block alignment");
constexpr size_t WS_W = 2 * MiB;
constexpr size_t WS_H = WS_W + 2 * WB_LAYER;
constexpr size_t SZ_H = (size_t)T * DINP * 2;
constexpr size_t WS_A2 = WS_H + SZ_H;
constexpr size_t A2_MIX = 0, A2_MIXED = A2_MIX + (size_t)T * 1024 * 4, A2_YA = A2_MIXED + (size_t)T * 1024 * 2, A2_YB = A2_YA + (size_t)T * 384 * 2,
                 A2_YC = A2_YB + (size_t)T * 384 * 2, A2_QC = A2_YC + (size_t)T * 384 * 2, A2_KVC = A2_QC + (size_t)T * 384 * 2, A2_KB = A2_KVC + (size_t)T * 512 * 2,
                 A2_CQN = A2_KB + (size_t)T * 128 * 2, A2_CKVN = A2_CQN + (size_t)T * 384 * 2, A2_KR = A2_CKVN + (size_t)T * 256 * 2, A2_K8 = A2_KR + (size_t)T * 32 * 2, A2_VT8 = A2_K8 + (size_t)T * 128, A2_VT8M = A2_VT8 + (size_t)T * 128, A2_K8M = A2_VT8M + (size_t)T * 256, SZ_A2 = A2_K8M + (size_t)T * 256;
static_assert(SZ_A2 >= (size_t)PSLOTS * 1024 * 2 && SZ_H >= (size_t)PSLOTS * 1024 * 2, "overlays fit");
constexpr size_t WS_X2 = WS_A2 + SZ_A2;
constexpr size_t WS_XB = WS_X2 + (size_t)T * D * 4;
constexpr size_t WS_X1 = WS_XB + (size_t)T * D * 2;
constexpr size_t WS_X1B = WS_X1 + (size_t)T * D * 4;
constexpr size_t WS_LT = WS_X1B + (size_t)T * D * 2;
constexpr size_t WS_LG = WS_LT + (size_t)NE * LCAP * 4;
constexpr size_t WS_TE = WS_LG + (size_t)NE * LCAP * 4;
constexpr size_t WS_TR = WS_TE + (size_t)T * 4 * 4;
constexpr size_t WS_SG = WS_TR + (size_t)T * 4 * 4;
constexpr size_t WS_END = WS_SG + (size_t)PSLOTS * 4;
constexpr int CW_BAR = 4096;
constexpr int CW_CNT = 16384;

constexpr int RING_BYTES = 131072, LDSCTL_OFF = 139264, MISC_OFF = LDSCTL_OFF + 64;
constexpr int TBL_OFF = LDSCTL_OFF + 256;
constexpr int TBL_START = TBL_OFF, TBL_TILEE = TBL_OFF + 512, TBL_RS = TBL_TILEE + 2304;
constexpr int LDS_BYTES = 155648;
static_assert(TBL_RS + 512 * 12 + 256 <= LDS_BYTES, "LDS map");

#define GAS __attribute__((address_space(1)))
#define LAS __attribute__((address_space(3)))
typedef unsigned short bf16;
typedef unsigned v4u __attribute__((ext_vector_type(4)));
typedef float f32x4 __attribute__((ext_vector_type(4)));
typedef GAS unsigned gu32;
#define RLX_AGENT __ATOMIC_RELAXED, __HIP_MEMORY_SCOPE_AGENT
#define LDS_WAIT() asm volatile("s_waitcnt lgkmcnt(0)" ::: "memory")
#define VM_WAIT() asm volatile("s_waitcnt vmcnt(0)" ::: "memory")
__device__ __forceinline__ unsigned f2bf(float f) { unsigned u = __builtin_bit_cast(unsigned, f); return (u + 0x7fffu + ((u >> 16) & 1u)) >> 16; }
__device__ __forceinline__ unsigned pk2(float lo, float hi) { unsigned r; asm("v_cvt_pk_bf16_f32 %0, %1, %2" : "=v"(r) : "v"(lo), "v"(hi)); return r; }
__device__ __forceinline__ float bflo(unsigned w) { return __uint_as_float(w << 16); }
__device__ __forceinline__ float bfhi(unsigned w) { return __uint_as_float(w & 0xffff0000u); }

template <int CTRL> __device__ __forceinline__ float dpp_mov(float v) { return __int_as_float(__builtin_amdgcn_update_dpp(0, __float_as_int(v), CTRL, 0xf, 0xf, false)); }
__device__ __forceinline__ float wave_allsum(float v) {
    v += dpp_mov<0xB1>(v); v += dpp_mov<0x4E>(v); v += dpp_mov<0x141>(v); v += dpp_mov<0x140>(v);
    { auto r = __builtin_amdgcn_permlane16_swap(__float_as_uint(v), __float_as_uint(v), false, false); v = __uint_as_float(r[0]) + __uint_as_float(r[1]); }
    { auto r = __builtin_amdgcn_permlane32_swap(__float_as_uint(v), __float_as_uint(v), false, false); v = __uint_as_float(r[0]) + __uint_as_float(r[1]); }
    return v;
}
__device__ __forceinline__ float wave_allmax(float v) {
    v = fmaxf(v, dpp_mov<0xB1>(v)); v = fmaxf(v, dpp_mov<0x4E>(v)); v = fmaxf(v, dpp_mov<0x141>(v)); v = fmaxf(v, dpp_mov<0x140>(v));
    { auto r = __builtin_amdgcn_permlane16_swap(__float_as_uint(v), __float_as_uint(v), false, false); v = fmaxf(__uint_as_float(r[0]), __uint_as_float(r[1])); }
    { auto r = __builtin_amdgcn_permlane32_swap(__float_as_uint(v), __float_as_uint(v), false, false); v = fmaxf(__uint_as_float(r[0]), __uint_as_float(r[1])); }
    return v;
}
template <int O> __device__ __forceinline__ int shxi(int v, int lane) { (void)lane;
    if constexpr (O == 1) return __builtin_amdgcn_update_dpp(0, v, 0xB1, 0xf, 0xf, false);
    else if constexpr (O == 2) return __builtin_amdgcn_update_dpp(0, v, 0x4E, 0xf, 0xf, false);
    else if constexpr (O == 4) { int r = __builtin_amdgcn_update_dpp(0, v, 0x104, 0xf, 0x5, false); return __builtin_amdgcn_update_dpp(r, v, 0x114, 0xf, 0xA, false); }
    else if constexpr (O == 8) return __builtin_amdgcn_update_dpp(0, v, 0x128, 0xf, 0xf, false);
    else if constexpr (O == 16) { auto r = __builtin_amdgcn_permlane16_swap((unsigned)v, (unsigned)v, false, false); int o; const unsigned long long m = 0xFFFF0000FFFF0000ull;
        asm("v_cndmask_b32_e64 %0, %1, %2, %3" : "=v"(o) : "v"(r[1]), "v"(r[0]), "s"(m)); return o; }
    else { static_assert(O == 32, "lane ^ O: O = 1, 2, 4, 8, 16, 32"); auto r = __builtin_amdgcn_permlane32_swap((unsigned)v, (unsigned)v, false, false); int o; const unsigned long long m = 0xFFFFFFFF00000000ull;
        asm("v_cndmask_b32_e64 %0, %1, %2, %3" : "=v"(o) : "v"(r[1]), "v"(r[0]), "s"(m)); return o; }
}
template <int O> __device__ __forceinline__ float shx(float v, int lane) { return __int_as_float(shxi<O>(__float_as_int(v), lane)); }

#define XB_TMO      128
#define XB_XCNT(j)  (256  + 64 * (j))
#define XB_XSUB(j)  (1280 + 64 * (j))
#define XB_XGEN(j)  (2304 + 64 * (j))
#define XB_TOP      3328
#define XB_TOPGEN   3392
#define XCD_BAR_WORDS 3456
#define XB_SPIN_CAP (1u << 18)

__device__ __forceinline__ unsigned xb_ld(unsigned* p)              { return __hip_atomic_load(p, __ATOMIC_RELAXED, __HIP_MEMORY_SCOPE_AGENT); }
__device__ __forceinline__ unsigned xb_add(unsigned* p, unsigned v) { return __hip_atomic_fetch_add(p, v, __ATOMIC_RELAXED, __HIP_MEMORY_SCOPE_AGENT); }
__device__ __forceinline__ unsigned xb_xcc_id() { return (unsigned)__builtin_amdgcn_s_getreg((3 << 11) | 20) & 0xFu; }
#define XB_SPIN(cond, bar) do { unsigned _sp = 0; while (cond) { __builtin_amdgcn_s_sleep(1); \
    if ((++_sp & 255u) == 0u) { if (xb_ld(&(bar)[XB_TMO])) break; if (_sp > XB_SPIN_CAP) { atomicAdd(&(bar)[XB_TMO], 1u); break; } } } } while (0)

struct XcdBarrier {
    unsigned* bar; unsigned x;
    volatile LAS unsigned* st;
};

__device__ __forceinline__ XcdBarrier xcd_barrier_post(unsigned* bar, volatile LAS unsigned* st) {
    XcdBarrier b; b.bar = bar; b.x = xb_xcc_id(); b.st = st;
    if (threadIdx.x == 0) (void)xb_add(&bar[XB_XCNT(b.x)], 1u);
    return b;
}
__device__ __forceinline__ void xcd_barrier_complete(unsigned* bar, unsigned x, unsigned& nloc, unsigned& nx) {
    const unsigned G = gridDim.x * gridDim.y * gridDim.z;
    unsigned sum, cnt, mine, sp = 0u;
    for (;;) {
        sum = 0u; cnt = 0u; mine = 0u;
#pragma unroll
        for (unsigned j = 0; j < 16; ++j) { const unsigned c = xb_ld(&bar[XB_XCNT(j)]); sum += c; cnt += (c > 0u) ? 1u : 0u; mine = (j == x) ? c : mine; }
        if (sum == G) break;
        __builtin_amdgcn_s_sleep(1);
        if ((++sp & 255u) == 0u) { if (xb_ld(&bar[XB_TMO])) break; if (sp > XB_SPIN_CAP) { atomicAdd(&bar[XB_TMO], 1u); break; } }
    }
    nloc = mine > 0u ? mine : 1u; nx = cnt > 0u ? cnt : 1u;
}

__device__ __forceinline__ void xcd_barrier(const XcdBarrier& b) {
    asm volatile("s_waitcnt vmcnt(0)" ::: "memory");
    __syncthreads();
    if (threadIdx.x == 0) {
        unsigned* bar = b.bar;
        __builtin_amdgcn_s_waitcnt(0);
        unsigned nloc = b.st[0], nx = b.st[1];
        if (nloc == 0u) { xcd_barrier_complete(bar, b.x, nloc, nx); b.st[0] = nloc; b.st[1] = nx; }
        const unsigned old = xb_add(&bar[XB_XSUB(b.x)], 1u);
        const unsigned gen = old / nloc;
        if (old + 1u == (gen + 1u) * nloc) {
            __builtin_amdgcn_fence(__ATOMIC_RELEASE, "agent");
            asm volatile("s_waitcnt vmcnt(0)" ::: "memory");
            const unsigned og = xb_add(&bar[XB_TOP], 1u);
            const unsigned tg = og / nx;
            if (og + 1u == (tg + 1u) * nx) xb_add(&bar[XB_TOPGEN], 1u);
            else XB_SPIN(xb_ld(&bar[XB_TOPGEN]) == tg, bar);
            __builtin_amdgcn_fence(__ATOMIC_ACQUIRE, "agent");
            xb_add(&bar[XB_XGEN(b.x)], 1u);
            asm volatile("s_waitcnt vmcnt(0)" ::: "memory");
        } else {
            XB_SPIN(xb_ld(&bar[XB_XGEN(b.x)]) == gen, bar);
            __builtin_amdgcn_fence(__ATOMIC_ACQUIRE, "agent");
            asm volatile("s_waitcnt vmcnt(0)" ::: "memory");
        }
    }
    __syncthreads();
}


struct Frame {
    LAS unsigned char* lds;
    gu32* ctl;
    int tid, lane, wave;
    int vcu, G, bx;
    unsigned char* ws;
    float* out;
};
__device__ __forceinline__ void stagger(const Frame& F, int grp, int ticks) {
    if (grp > 0 && F.tid == 0) { const unsigned long long t0 = __builtin_amdgcn_s_memrealtime(); const unsigned long long d = (unsigned long long)(grp * ticks);
        while (__builtin_amdgcn_s_memrealtime() - t0 < d) __builtin_amdgcn_s_sleep(4); }
    __syncthreads();
}
__device__ __forceinline__ const float* in_ptr(int i) {
    const void* base = (const void*)__builtin_amdgcn_kernarg_segment_ptr(); const GAS float* p;
    asm volatile("s_load_dwordx2 %0, %1, %2\n\ts_waitcnt lgkmcnt(0)" : "=s"(p) : "s"(base), "i"(i * 8) : "memory"); return (const float*)p;
}
#define INP(i) in_ptr(i)
template <int SITE> __device__ __forceinline__ Frame mkframe(LAS unsigned char* lds_in, unsigned char* ws_in, float* out_in, int wave_id, int bx0, int G0) {
    Frame F; int lane_;
    asm volatile("v_mbcnt_lo_u32_b32 %0, -1, 0\n\tv_mbcnt_hi_u32_b32 %0, -1, %0 ; site %1" : "=v"(lane_) : "n"(SITE));
    int bx = bx0, G = G0, wv = wave_id; asm volatile("; site %3" : "+s"(bx), "+s"(G), "+s"(wv) : "n"(SITE));
    GAS unsigned char* wsg = (GAS unsigned char*)ws_in; asm volatile("; site %1" : "+s"(wsg) : "n"(SITE)); unsigned char* ws = (unsigned char*)wsg;
    LAS unsigned char* l3 = lds_in; asm volatile("; site %1" : "+s"(l3) : "n"(SITE));
    const int tid = wv * 64 + lane_;
    F.lds = l3; F.tid = tid; F.lane = lane_; F.wave = wv;
    F.G = G; F.bx = bx; F.vcu = (G % 8 == 0) ? (bx % 8) * (G / 8) + bx / 8 : bx;
    F.ws = ws; F.ctl = (gu32*)(wsg + WS_CTL); F.out = out_in; return F;
}
__device__ __forceinline__ float wave_sum(float v, int lane) { (void)lane; return wave_allsum(v); }
template <bool F8> __device__ __forceinline__ void tr_item(const float* W, int ldw, int Kd, int k0, int src_n0, bf16* WT, int dst_n0, float scale, LAS float* scr, int lane) {
    float v[32];
#pragma unroll
    for (int i = 0; i < 32; ++i) v[i] = W[(size_t)(k0 + 2 * i + (lane >> 5)) * ldw + src_n0 + (lane & 31)];
#pragma unroll
    for (int i = 0; i < 32; ++i) scr[(2 * i + (lane >> 5)) * 33 + (lane & 31)] = v[i];
    LDS_WAIT(); asm volatile("" ::: "memory");
    const int c = lane & 7;
#pragma unroll
    for (int j = 0; j < 4; ++j) { const int n = (lane >> 3) + 8 * j; const LAS float* s = scr + (8 * c) * 33 + n;
        if constexpr (F8) { typedef unsigned u32x2 __attribute__((ext_vector_type(2)));
            *(GAS u32x2*)((unsigned char*)WT + (size_t)(dst_n0 + n) * Kd + k0 + 8 * c) = (u32x2){pg8::pk4_fp8(s[0 * 33] * scale, s[1 * 33] * scale, s[2 * 33] * scale, s[3 * 33] * scale), pg8::pk4_fp8(s[4 * 33] * scale, s[5 * 33] * scale, s[6 * 33] * scale, s[7 * 33] * scale)}; }
        else { v4u o; o.x = pk2(s[0 * 33] * scale, s[1 * 33] * scale); o.y = pk2(s[2 * 33] * scale, s[3 * 33] * scale); o.z = pk2(s[4 * 33] * scale, s[5 * 33] * scale); o.w = pk2(s[6 * 33] * scale, s[7 * 33] * scale);
            *(GAS v4u*)(WT + (size_t)(dst_n0 + n) * Kd + k0 + 8 * c) = o; } }
    LDS_WAIT(); asm volatile("" ::: "memory");
}
template <int KIND, bool F8 = false> __device__ __forceinline__ void conv_matrix(Frame& F, const float* W, int K, int N, bf16* WT, float s, int gw, int NGW, LAS float* scr, int Kd = 0) {
    if (Kd == 0) Kd = K;
    const int nnb = N / 32, nkb = K / 64, nit = nnb * nkb;
    for (int it = gw; it < nit; it += NGW) {
        const int kb = it / nnb, nb = it % nnb; const int dst_n0 = 32 * nb; int src_n0 = dst_n0; float sc = s;
        if (KIND == 1) sc = (dst_n0 < 384) ? s : 1.0f;
        if (F8) sc *= 32.0f;
        if (KIND == 2) { const int p = dst_n0 >> 8, j = dst_n0 & 255; src_n0 = (j < 128) ? (128 * p + j) : (1024 + 128 * p + (j - 128)); }
        tr_item<F8>(W, N, Kd, 64 * kb, src_n0, WT, dst_n0, sc, scr, F.lane);
    }
}
__device__ __forceinline__ void zero_rows(bf16* WT, int K, int n_lo, int n_hi, int gtid, int nthr) {
    const size_t n16 = (size_t)(n_hi - n_lo) * K / 8; GAS v4u* p = (GAS v4u*)(WT + (size_t)n_lo * K);
    for (size_t i = gtid; i < n16; i += nthr) p[i] = (v4u){0u, 0u, 0u, 0u};
}
__device__ __forceinline__ void p_prologue(Frame& F) {
    LAS float* scr = (LAS float*)(F.lds + F.wave * 16384);
    const int gw0 = F.vcu * NWAVES + F.wave, NGW = F.G * NWAVES, gtid = F.bx * (NWAVES * 64) + F.tid, nthr = F.G * NWAVES * 64;
    for (int l = 0; l < DEPTH; ++l) {
        unsigned char* wb = F.ws + WS_W + (size_t)l * WB_LAYER;
        int gw = gw0;
#define ROT(n) do { gw = (gw + NGW - ((n) % NGW)) % NGW; } while (0)
        if (F8IN(l)) { conv_matrix<1, true>(F, INP(1) + (size_t)l * 1024 * DIN, 1024, DIN, (bf16*)(wb + WB_IN), 0.125f * LOG2E_F, gw, NGW, scr); zero_rows((bf16*)(wb + WB_IN), 512, DIN, DINP, gtid, nthr); }
        else { conv_matrix<1>(F, INP(1) + (size_t)l * 1024 * DIN, 1024, DIN, (bf16*)(wb + WB_IN), 0.125f * LOG2E_F, gw, NGW, scr); zero_rows((bf16*)(wb + WB_IN), 1024, DIN, DINP, gtid, nthr); }
        ROT(16 * 173);
        conv_matrix<0>(F, INP(7) + (size_t)l * 384 * 384, 384, 384, (bf16*)(wb + WB_UQ), 0.10206207261596577f * LOG2E_F, gw, NGW, scr); ROT(72);
        zero_rows((bf16*)(wb + WB_UQ), 384, 384, 512, gtid, nthr);
        conv_matrix<0>(F, INP(8) + (size_t)l * 256 * 512, 256, 512, (bf16*)(wb + WB_UKV), 1.0f, gw, NGW, scr); ROT(64);
#if MK_E8
        conv_matrix<0, true>(F, INP(9) + (size_t)l * 384 * 1024, 384, 1024, (bf16*)(wb + WB_BA), 1.0f, gw, NGW, scr, 512); ROT(192);
        conv_matrix<0, true>(F, INP(10) + (size_t)l * 384 * 1024, 384, 1024, (bf16*)(wb + WB_BB), 1.0f, gw, NGW, scr, 512); ROT(192);
        conv_matrix<0, true>(F, INP(11) + (size_t)l * 256 * 1024, 256, 1024, (bf16*)(wb + WB_BC), 1.0f, gw, NGW, scr, 512); ROT(64);
        for (int i = gtid; i < 1024 * 8; i += nthr) { *((GAS v4u*)(wb + WB_BA + (size_t)(i >> 3) * 512 + 384) + (i & 7)) = (v4u){0u, 0u, 0u, 0u}; *((GAS v4u*)(wb + WB_BB + (size_t)(i >> 3) * 512 + 384) + (i & 7)) = (v4u){0u, 0u, 0u, 0u}; }
        for (int i = gtid; i < 1024 * 16; i += nthr) *((GAS v4u*)(wb + WB_BC + (size_t)(i >> 4) * 512 + 256) + (i & 15)) = (v4u){0u, 0u, 0u, 0u};
#else
        conv_matrix<0>(F, INP(9) + (size_t)l * 384 * 1024, 384, 1024, (bf16*)(wb + WB_BA), 1.0f, gw, NGW, scr); ROT(192);
        conv_matrix<0>(F, INP(10) + (size_t)l * 384 * 1024, 384, 1024, (bf16*)(wb + WB_BB), 1.0f, gw, NGW, scr); ROT(192);
        conv_matrix<0>(F, INP(11) + (size_t)l * 256 * 1024, 256, 1024, (bf16*)(wb + WB_BC), 1.0f, gw, NGW, scr, 384); ROT(64);
        for (int i = gtid; i < 1024 * 16; i += nthr) *((GAS v4u*)(wb + WB_BC) + (size_t)(i >> 4) * 48 + 32 + (i & 15)) = (v4u){0u, 0u, 0u, 0u};
#endif
        if (MK_FP8_OUT) conv_matrix<3, true>(F, INP(12) + (size_t)l * 1024 * 1024, 1024, 1024, (bf16*)(wb + WB_OUT), 2.0f, gw, NGW, scr); else conv_matrix<0>(F, INP(12) + (size_t)l * 1024 * 1024, 1024, 1024, (bf16*)(wb + WB_OUT), 1.0f, gw, NGW, scr);
        ROT(512);
#undef ROT
    }
    { const GAS f32x4* xs = (const GAS f32x4*)INP(0); GAS v4u* xd = (GAS v4u*)(F.ws + WS_XB);
      typedef unsigned u32x2 __attribute__((ext_vector_type(2))); GAS u32x2* x8 = (GAS u32x2*)(F.ws + WS_X2);
      static_assert(((size_t)T * D / 8) % ((size_t)256 * NWAVES * 64 * 4) == 0, "x conversion: four pieces per thread and trip on the 256-workgroup grid");
      for (size_t i0 = gtid; i0 < (size_t)T * D / 8; i0 += (size_t)4 * nthr) {
          f32x4 a[4], b[4];
#pragma unroll
          for (int q = 0; q < 4; ++q) { const size_t i = i0 + (size_t)q * nthr; if (i < (size_t)T * D / 8) { a[q] = xs[2 * i]; b[q] = xs[2 * i + 1]; } }
#pragma unroll
          for (int q = 0; q < 4; ++q) { const size_t i = i0 + (size_t)q * nthr; if (i < (size_t)T * D / 8) { xd[i] = (v4u){pk2(a[q].x, a[q].y), pk2(a[q].z, a[q].w), pk2(b[q].x, b[q].y), pk2(b[q].z, b[q].w)};
              if (F8IN(0)) x8[i] = (u32x2){pg8::pk4_fp8(a[q].x * 16.f, a[q].y * 16.f, a[q].z * 16.f, a[q].w * 16.f), pg8::pk4_fp8(b[q].x * 16.f, b[q].y * 16.f, b[q].z * 16.f, b[q].w * 16.f)}; } } } }
}

constexpr int CONV_ITEMS = NE * 1024 + NE * 512, CONV_LDS_OFF = 49152, CONV_PITCH = 36, CONV_LDS_WAVE = 2 * 16 * CONV_PITCH * 4;
struct MoeConv {
    static constexpr bool PLAIN = false;
    const float* Wgu; const float* Wdn; unsigned char* Tgu; unsigned char* Tdn; bool f8;
    LAS float* scr; int lane; int gw, ngw, nmini; int s;
    f32x4 cvA[2], cvB[2];
    struct Mini { const float* W; unsigned char* WT; int ldw, k0, src_n0, dst_n0; float sc; };
    __device__ __forceinline__ Mini decode(int m) const {
        m = m < 0 ? 0 : (m >= nmini ? nmini - 1 : m);
        const int g = gw + (m >> 2) * ngw, q = m & 3; const bool gu = g < NE * 1024; const int h = gu ? g : g - NE * 1024;
        const int e = gu ? (h >> 10) : (h >> 9), r = gu ? (h & 1023) : (h & 511), kb = gu ? (r >> 6) : (r >> 5), nb = gu ? (r & 63) : (r & 31);
        Mini x; x.dst_n0 = 32 * nb; const int p = x.dst_n0 >> 8, j = x.dst_n0 & 255;
        x.src_n0 = gu ? ((j < 128) ? (128 * p + j) : (1024 + 128 * p + (j - 128))) : x.dst_n0; x.k0 = 64 * kb + 16 * q; x.ldw = gu ? 2048 : 1024;
        x.W = gu ? Wgu + (size_t)e * 1024 * 2048 : Wdn + (size_t)e * 1024 * 1024; const size_t es = f8 ? 1 : 2; x.WT = gu ? Tgu + (size_t)e * 2048 * 1024 * es : Tdn + (size_t)e * 1024 * 1024 * es; x.sc = gu ? 64.0f : 128.0f; return x;
    }
    __device__ __forceinline__ bool done() const { return s >= nmini + 3; }
    template <int P> __device__ __forceinline__ void step() {
        {   const Mini x = decode(s - 3); const LAS float* b = scr + (1 - P) * (16 * CONV_PITCH); const int n = lane >> 1, kh = lane & 1; const LAS float* p = b + (8 * kh) * CONV_PITCH + n;
            const float q0 = p[0 * CONV_PITCH], q1 = p[1 * CONV_PITCH], q2 = p[2 * CONV_PITCH], q3 = p[3 * CONV_PITCH], q4 = p[4 * CONV_PITCH], q5 = p[5 * CONV_PITCH], q6 = p[6 * CONV_PITCH], q7 = p[7 * CONV_PITCH];
            const size_t eo = (size_t)(x.dst_n0 + n) * 1024 + x.k0 + 8 * kh;
            if (f8) { typedef unsigned u32x2 __attribute__((ext_vector_type(2)));
                *(GAS u32x2*)(x.WT + eo) = (u32x2){pg8::pk4_fp8(q0 * x.sc, q1 * x.sc, q2 * x.sc, q3 * x.sc), pg8::pk4_fp8(q4 * x.sc, q5 * x.sc, q6 * x.sc, q7 * x.sc)}; }
            else { v4u o; o.x = pk2(q0, q1); o.y = pk2(q2, q3); o.z = pk2(q4, q5); o.w = pk2(q6, q7); *(GAS v4u*)(x.WT + eo * 2) = o; } }
        {   LAS float* b = scr + P * (16 * CONV_PITCH);
#pragma unroll
            for (int i = 0; i < 2; ++i) *(LAS f32x4*)(b + (8 * i + (lane >> 3)) * CONV_PITCH + 4 * (lane & 7)) = P ? cvB[i] : cvA[i]; }
    }
    template <int P> __device__ __forceinline__ void load() {
        {   const Mini x = decode(s); const GAS f32x4* src = (const GAS f32x4*)((const GAS float*)x.W + (size_t)(x.k0 + (lane >> 3)) * x.ldw + x.src_n0 + 4 * (lane & 7));
#pragma unroll
            for (int i = 0; i < 2; ++i) { const f32x4 v = src[(size_t)(8 * i) * (x.ldw / 4)]; if (P) cvB[i] = v; else cvA[i] = v; } }
        ++s;
    }
};
__device__ __forceinline__ void p_prep(Frame& F, int l) {
    const bf16* hb = (const bf16*)(F.ws + WS_H); unsigned char* a2 = F.ws + WS_A2;
    unsigned char* k8 = a2 + A2_K8; unsigned char* vt8 = a2 + A2_VT8; bf16* kB = (bf16*)(a2 + A2_KB); bf16* cqn = (bf16*)(a2 + A2_CQN); bf16* ckvn = (bf16*)(a2 + A2_CKVN); bf16* kr = (bf16*)(a2 + A2_KR);
    LAS float* gl_ = (LAS float*)F.lds;
    {   const float* gk_ = INP(4) + l * 64; const float* gq_ = INP(5) + l * 384; const float* gkv_ = INP(6) + l * 256;
        for (int i = F.tid; i < 704; i += NWAVES * 64) gl_[i] = i < 64 ? gk_[i] : (i < 448 ? gq_[i - 64] : gkv_[i - 448]);
        __syncthreads(); }
    const LAS float* gk = gl_; const LAS float* gq = gl_ + 64; const LAS float* gkv = gl_ + 448;
    const int lane = F.lane, gw = F.vcu * NWAVES + F.wave, NGW = F.G * NWAVES;
    v4u nk = {0u, 0u, 0u, 0u}, nq = nk, nkv = nk, nr = nk;
    if (gw < T) { const bf16* h0 = hb + (size_t)gw * DINP; if (lane < 16) nk = *(const GAS v4u*)(h0 + H_GK + lane * 8); if (lane < 48) nq = *(const GAS v4u*)(h0 + H_CQ + lane * 8);
        if (lane < 32) nkv = *(const GAS v4u*)(h0 + H_CKV + lane * 8); if (lane < 4) nr = *(const GAS v4u*)(h0 + H_KR + lane * 8); }
    if (MK_FP8_QK) {
        for (int th = gw; th < NB * (SEQ / 64) * 2; th += NGW) { const int kvh = th & 1, tile = (th >> 1) & (SEQ / 64 - 1), bb = th >> 8;
            const GAS bf16* vcol = (const GAS bf16*)(hb + ((size_t)bb * SEQ + (size_t)tile * 64) * DINP + H_GV + kvh * 64 + lane);
            unsigned short vv[64];
#pragma unroll
            for (int kk = 0; kk < 64; ++kk) vv[kk] = vcol[(size_t)kk * DINP];
            __builtin_amdgcn_sched_barrier(0);
            unsigned w[16];
#pragma unroll
            for (int g4 = 0; g4 < 16; ++g4) { const int wi = 8 * (g4 & 1) + 4 * (g4 >> 3) + ((g4 >> 1) & 3);
                int d_ = __builtin_amdgcn_cvt_pk_bf8_f32(bflo((unsigned)vv[4 * g4]), bflo((unsigned)vv[4 * g4 + 1]), 0, false);
                d_ = __builtin_amdgcn_cvt_pk_bf8_f32(bflo((unsigned)vv[4 * g4 + 2]), bflo((unsigned)vv[4 * g4 + 3]), d_, true); w[wi] = (unsigned)d_; }
            GAS v4u* dst = (GAS v4u*)(vt8 + ((size_t)th * 64 + lane) * 64);
            dst = (GAS v4u*)(vt8 + ((((size_t)(bb * 2 + kvh) * (SEQ / 64) + tile) * 64 + lane) * 64));
#pragma unroll
            for (int q = 0; q < 4; ++q) dst[q] = (v4u){w[4 * q], w[4 * q + 1], w[4 * q + 2], w[4 * q + 3]}; }
    }
    for (int t = gw; t < T; t += NGW) {
        const v4u wk_ = nk, wq_ = nq, wkv_ = nkv, wr_ = nr;
        if (t + NGW < T) { const bf16* h1 = hb + (size_t)(t + NGW) * DINP; if (lane < 16) nk = *(const GAS v4u*)(h1 + H_GK + lane * 8); if (lane < 48) nq = *(const GAS v4u*)(h1 + H_CQ + lane * 8);
            if (lane < 32) nkv = *(const GAS v4u*)(h1 + H_CKV + lane * 8); if (lane < 4) nr = *(const GAS v4u*)(h1 + H_KR + lane * 8); }
        const int s = t & (SEQ - 1); const float prow = (float)(s >> 6), pcol = (float)(s & 63);
#if MK_E8
        if (lane < 32) { unsigned char* yz = a2 + (lane < 8 ? A2_YA : (lane < 16 ? A2_YB : A2_YC)) + (size_t)t * 512 + (lane < 16 ? 384 + (lane & 7) * 16 : 256 + (lane - 16) * 16);
            unsigned z_ = 0u; asm volatile("v_mov_b32 %0, 0" : "=v"(z_)); *(GAS v4u*)yz = (v4u){z_, z_, z_, z_}; }
#endif
        {   float x[8]; float ssq = 0.f; const int cc = lane & 7;
            if (lane < 16) { const v4u w = wk_; x[0] = bflo(w.x); x[1] = bfhi(w.x); x[2] = bflo(w.y); x[3] = bfhi(w.y); x[4] = bflo(w.z); x[5] = bfhi(w.z); x[6] = bflo(w.w); x[7] = bfhi(w.w); }
            else {
#pragma unroll
                for (int j = 0; j < 8; ++j) x[j] = 0.f; }
#pragma unroll
            for (int j = 0; j < 8; ++j) ssq += x[j] * x[j];
            ssq += shx<1>(ssq, lane); ssq += shx<2>(ssq, lane); ssq += shx<4>(ssq, lane);
            const float rstd = 1.0f / sqrtf(ssq * (1.0f / 64.0f) + RMS_EPS);
            float y[8], o[8];
#pragma unroll
            for (int j = 0; j < 8; ++j) y[j] = x[j] * rstd * gk[(cc * 8 + j) & 63];
#pragma unroll
            for (int j = 0; j < 8; ++j) { const float other = shx<4>(y[j], lane); const int i = 8 * (cc & 3) + j;
                const float inv = exp2f(-(float)(i & 15) * (att::LOG2_THETA / 16.0f)); const float ang = ((i < 16) ? prow : pcol) * inv * att::INV2PI;
                const float c = __builtin_amdgcn_cosf(ang), sn = __builtin_amdgcn_sinf(ang);
                o[j] = (cc < 4) ? (y[j] * c - other * sn) : (other * sn + y[j] * c); }
            if (lane < 16) { *(GAS v4u*)(kB + (size_t)t * 128 + lane * 8) = (v4u){pk2(o[0], o[1]), pk2(o[2], o[3]), pk2(o[4], o[5]), pk2(o[6], o[7])};
                typedef unsigned u32x2 __attribute__((ext_vector_type(2)));
                *(GAS u32x2*)(k8 + (size_t)t * 128 + (lane >> 3) * 64 + 32 * (cc & 1) + 8 * (cc >> 1)) = (u32x2){pg8::pk4_fp8(o[0], o[1], o[2], o[3]), pg8::pk4_fp8(o[4], o[5], o[6], o[7])}; }
        }
        {   float x[8]; float ssq = 0.f;
            if (lane < 48) { const v4u w = wq_; x[0] = bflo(w.x); x[1] = bfhi(w.x); x[2] = bflo(w.y); x[3] = bfhi(w.y); x[4] = bflo(w.z); x[5] = bfhi(w.z); x[6] = bflo(w.w); x[7] = bfhi(w.w); }
            else {
#pragma unroll
                for (int j = 0; j < 8; ++j) x[j] = 0.f; }
#pragma unroll
            for (int j = 0; j < 8; ++j) ssq += x[j] * x[j];
            ssq = wave_sum(ssq, lane); const float rstd = 1.0f / sqrtf(ssq * (1.0f / 384.0f) + RMS_EPS);
            if (lane < 48) { float y[8];
#pragma unroll
                for (int j = 0; j < 8; ++j) y[j] = x[j] * rstd * gq[lane * 8 + j];
                *(GAS v4u*)(cqn + (size_t)t * 384 + lane * 8) = (v4u){pk2(y[0], y[1]), pk2(y[2], y[3]), pk2(y[4], y[5]), pk2(y[6], y[7])}; }
        }
        {   float x[8]; float ssq = 0.f;
            if (lane < 32) { const v4u w = wkv_; x[0] = bflo(w.x); x[1] = bfhi(w.x); x[2] = bflo(w.y); x[3] = bfhi(w.y); x[4] = bflo(w.z); x[5] = bfhi(w.z); x[6] = bflo(w.w); x[7] = bfhi(w.w); }
            else {
#pragma unroll
                for (int j = 0; j < 8; ++j) x[j] = 0.f; }
#pragma unroll
            for (int j = 0; j < 8; ++j) ssq += x[j] * x[j];
            ssq = wave_sum(ssq, lane); const float rstd = 1.0f / sqrtf(ssq * (1.0f / 256.0f) + RMS_EPS);
            if (lane < 32) { float y[8];
#pragma unroll
                for (int j = 0; j < 8; ++j) y[j] = x[j] * rstd * gkv[lane * 8 + j];
                *(GAS v4u*)(ckvn + (size_t)t * 256 + lane * 8) = (v4u){pk2(y[0], y[1]), pk2(y[2], y[3]), pk2(y[4], y[5]), pk2(y[6], y[7])}; }
        }
        {   float x[8]; const int cc = lane & 3;
            if (lane < 4) { const v4u w = wr_; x[0] = bflo(w.x); x[1] = bfhi(w.x); x[2] = bflo(w.y); x[3] = bfhi(w.y); x[4] = bflo(w.z); x[5] = bfhi(w.z); x[6] = bflo(w.w); x[7] = bfhi(w.w); }
            else {
#pragma unroll
                for (int j = 0; j < 8; ++j) x[j] = 0.f; }
            float o[8];
#pragma unroll
            for (int j = 0; j < 8; ++j) { const float other = shx<2>(x[j], lane);
                const float inv = exp2f(-(float)j * (att::LOG2_THETA / 8.0f)); const float ang = (((cc & 1) == 0) ? prow : pcol) * inv * att::INV2PI;
                const float c = __builtin_amdgcn_cosf(ang), sn = __builtin_amdgcn_sinf(ang);
                o[j] = (cc < 2) ? (x[j] * c - other * sn) : (other * sn + x[j] * c); }
            if (lane < 4) *(GAS v4u*)(kr + (size_t)t * 32 + lane * 8) = (v4u){pk2(o[0], o[1]), pk2(o[2], o[3]), pk2(o[4], o[5]), pk2(o[6], o[7])};
        }
    }
}


__device__ __forceinline__ int build_tables(Frame& F, int l) {
    LAS int* st = (LAS int*)(F.lds + TBL_START); LAS int* cn = st + 33; LAS int* te = (LAS int*)(F.lds + TBL_TILEE);
    __syncthreads();
    if (F.tid < NE) cn[F.tid] = (int)__hip_atomic_load(F.ctl + CW_CNT + 64 * l + F.tid, RLX_AGENT);
    __syncthreads();
    if (F.tid == 0) { int s = 0; for (int e = 0; e < NE; ++e) { st[e] = s; s += ((cn[e] + 255) >> 8) << 8; } st[NE] = s; }
    __syncthreads();
    const int total = st[NE];
    for (int tile = F.tid; tile < (total >> 8); tile += NWAVES * 64) { int e = 0; for (int k = 1; k < NE; ++k) e += (tile * 256 >= st[k]) ? 1 : 0; te[tile] = e; }
    __syncthreads();
    return total;
}

template <bool XBF> __device__ __forceinline__ void p_ln1_router(Frame& F, int l, const void* xin) {
    const bool w8 = F8MOE(l); unsigned char* x1f8 = F.ws + WS_X2;
    const float* xcur = (const float*)xin; const bf16* xcb = (const bf16*)xin;
    const bf16* outb = (const bf16*)(F.ws + WS_X1); bf16* x1b = (bf16*)(F.ws + WS_X1B);
    int* list_t = (int*)(F.ws + WS_LT); float* list_g = (float*)(F.ws + WS_LG); int* tok_e = (int*)(F.ws + WS_TE); int* tok_r = (int*)(F.ws + WS_TR);
    const float* wr = INP(15) + (size_t)l * 1024 * NE; const float* br = INP(16) + l * NE;
    const int lane0 = F.lane, tid = F.tid;
    LAS unsigned char* wl = F.lds;
    LAS int* sel_e = (LAS int*)(F.lds + TBL_RS); LAS float* sel_g = (LAS float*)(sel_e + 512); LAS int* sel_r = sel_e + 1024; LAS int* hist = sel_e + 1536; LAS int* base = hist + 32;
    __syncthreads();
    {   f32x4 wv_[16];
#pragma unroll
        for (int q = 0; q < 16; ++q) { const int idx = tid + q * (NWAVES * 64), k = idx >> 3, c = idx & 7; wv_[q] = *(const GAS f32x4*)(wr + (size_t)k * NE + c * 4); }
#pragma unroll
        for (int q = 0; q < 16; ++q) { const int idx = tid + q * (NWAVES * 64), k = idx >> 3, c = idx & 7, kp = (k & 3) * 256 + (k >> 2), cp = c ^ ((kp >> 1) & 7);
            *(LAS f32x4*)(wl + (kp * 8 + cp) * 16) = wv_[q]; } }
    { const GAS f32x4* gsrc = (const GAS f32x4*)((tid < 256 ? INP(13) : INP(14)) + l * D) + (tid & 255); ((LAS f32x4*)(F.lds + RING_BYTES))[tid] = *gsrc; }
    __syncthreads();
    for (int tile = F.bx; tile < T / 128; tile += F.G) {
        if (tid < 32) hist[tid] = 0;
        __syncthreads();
        f32x4 px[4]; unsigned long long po[4], pxb[4]; constexpr bool O8 = (MK_OUT8 != 0) && (MK_FP8_OUT != 0); const unsigned char* out8 = F.ws + WS_X1;
        {   const int t0 = tile * 128 + F.wave * 16; const GAS f32x4* xr0 = (const GAS f32x4*)(xcur + (size_t)t0 * D) + lane0; const GAS unsigned long long* or0 = (const GAS unsigned long long*)(outb + (size_t)t0 * D) + lane0;
#pragma unroll
            for (int j = 0; j < 4; ++j) { if (XBF) pxb[j] = ((const GAS unsigned long long*)(xcb + (size_t)t0 * D) + lane0)[64 * j]; else px[j] = xr0[64 * j]; if (O8) po[j] = ((const GAS unsigned*)(out8 + (size_t)t0 * D) + lane0)[64 * j]; else po[j] = or0[64 * j]; } }
        for (int it = 0; it < 16; ++it) {
            int lane = lane0; asm volatile("" : "+v"(lane));
            const int sw = (lane >> 1) & 7; const float bias_e = br[(lane >> 1) & 31];
            const LAS f32x4* lgp = (const LAS f32x4*)(F.lds + RING_BYTES) + lane; const LAS f32x4* lbp = lgp + 256;
            const int tl = F.wave * 16 + it, t = tile * 128 + tl;
            f32x4 v[4]; float s = 0.f;
#pragma unroll
            for (int j = 0; j < 4; ++j) { const unsigned long long ow = po[j]; const unsigned olo = (unsigned)ow, ohi = (unsigned)(ow >> 32);
                f32x4 xv_; if (XBF) { const unsigned xlo = (unsigned)pxb[j], xhi = (unsigned)(pxb[j] >> 32); xv_ = (f32x4){bflo(xlo), bfhi(xlo), bflo(xhi), bfhi(xhi)}; } else xv_ = px[j];
                f32x4 ov_; if (O8) { const auto a0 = __builtin_amdgcn_cvt_pk_f32_fp8((int)olo, false), a1 = __builtin_amdgcn_cvt_pk_f32_fp8((int)olo, true); ov_ = (f32x4){a0[0], a0[1], a1[0], a1[1]} * (1.0f / 32.0f); } else ov_ = (f32x4){bflo(olo), bfhi(olo), bflo(ohi), bfhi(ohi)};
                v[j] = xv_ * DN_ALPHA + ov_; s += (v[j].x + v[j].y) + (v[j].z + v[j].w); }
            if (it + 1 < 16) { const GAS f32x4* xr = (const GAS f32x4*)(xcur + (size_t)(t + 1) * D) + lane; const GAS unsigned long long* orr = (const GAS unsigned long long*)(outb + (size_t)(t + 1) * D) + lane;
#pragma unroll
                for (int j = 0; j < 4; ++j) { if (XBF) pxb[j] = ((const GAS unsigned long long*)(xcb + (size_t)(t + 1) * D) + lane)[64 * j]; else px[j] = xr[64 * j]; if (O8) po[j] = ((const GAS unsigned*)(out8 + (size_t)(t + 1) * D) + lane)[64 * j]; else po[j] = orr[64 * j]; } }
            const float mean = wave_sum(s, lane) * (1.f / D); float s2 = 0.f;
#pragma unroll
            for (int j = 0; j < 4; ++j) { v[j] = v[j] - mean; s2 += (v[j].x * v[j].x + v[j].y * v[j].y) + (v[j].z * v[j].z + v[j].w * v[j].w); }
            const float rstd = 1.f / sqrtf(wave_sum(s2, lane) * (1.f / D) + LN_EPS);
            GAS unsigned long long* o8 = (GAS unsigned long long*)(x1b + (size_t)t * D) + lane;
#pragma unroll
            for (int j = 0; j < 4; ++j) { v[j] = v[j] * rstd * lgp[64 * j] + lbp[64 * j];
                o8[64 * j] = (unsigned long long)pk2(v[j].x, v[j].y) | ((unsigned long long)pk2(v[j].z, v[j].w) << 32);
                if (w8) ((GAS unsigned*)(x1f8 + (size_t)t * D))[64 * j + lane] = pg8::pk4_fp8(v[j].x * 16.0f, v[j].y * 16.0f, v[j].z * 16.0f, v[j].w * 16.0f); }
            float acc[32];
#pragma unroll
            for (int c = 0; c < 8; ++c) {
                int basec = lane * 128 + ((c ^ sw) << 4); asm volatile("" : "+v"(basec));
                const LAS unsigned char* wp = wl + basec; int basec2 = basec + 65536; asm volatile("" : "+v"(basec2)); const LAS unsigned char* wp2 = wl + basec2;
                typedef float f32x2p __attribute__((ext_vector_type(2)));
                f32x2p a01 = {0.f, 0.f}, a23 = {0.f, 0.f};
                f32x4 w[16];
#pragma unroll
                for (int i = 0; i < 4; ++i)
#pragma unroll
                    for (int j = 0; j < 4; ++j) w[i * 4 + j] = *(const LAS f32x4*)((i < 2 ? wp : wp2) + ((i & 1) * 256 + 64 * j) * 128);
                __builtin_amdgcn_sched_barrier(0);
#pragma unroll
                for (int i = 0; i < 4; ++i)
#pragma unroll
                    for (int j = 0; j < 4; ++j) { const float xv = v[j][i]; const f32x2p x2 = {xv, xv};
                        a01 = __builtin_elementwise_fma(x2, (f32x2p){w[i * 4 + j].x, w[i * 4 + j].y}, a01); a23 = __builtin_elementwise_fma(x2, (f32x2p){w[i * 4 + j].z, w[i * 4 + j].w}, a23); }
                __builtin_amdgcn_sched_barrier(0);
                acc[4 * c + 0] = a01.x; acc[4 * c + 1] = a01.y; acc[4 * c + 2] = a23.x; acc[4 * c + 3] = a23.y;
            }
            float a16[16], a8[8], a4[4], a2[2], a1;
#pragma unroll
            for (int i = 0; i < 16; ++i) { auto r_ = __builtin_amdgcn_permlane32_swap(__float_as_uint(acc[i]), __float_as_uint(acc[16 + i]), false, false); a16[i] = __uint_as_float(r_[0]) + __uint_as_float(r_[1]); }
#pragma unroll
            for (int i = 0; i < 8; ++i) { auto r_ = __builtin_amdgcn_permlane16_swap(__float_as_uint(a16[i]), __float_as_uint(a16[8 + i]), false, false); a8[i] = __uint_as_float(r_[0]) + __uint_as_float(r_[1]); }
            { const bool b = (lane & 8) != 0;
#pragma unroll
              for (int i = 0; i < 4; ++i) { const float send = b ? a8[i] : a8[4 + i]; const float keep = b ? a8[4 + i] : a8[i]; a4[i] = keep + shx<8>(send, lane); } }
            { const bool b = (lane & 4) != 0;
#pragma unroll
              for (int i = 0; i < 2; ++i) { const float send = b ? a4[i] : a4[2 + i]; const float keep = b ? a4[2 + i] : a4[i]; a2[i] = keep + shx<4>(send, lane); } }
            { const bool b = (lane & 2) != 0; const float send = b ? a2[0] : a2[1]; const float keep = b ? a2[1] : a2[0]; a1 = keep + shx<2>(send, lane); }
            a1 += shx<1>(a1, lane);
            float val = a1 + bias_e; const int my_e = (lane >> 1) & 31;
            float sv[4]; int se[4];
#pragma unroll
            for (int r = 0; r < 4; ++r) {
                const float bv = wave_allmax(val); const int be = ((int)__builtin_ctzll(__builtin_amdgcn_ballot_w64(val == bv)) >> 1) & 31;
                sv[r] = bv; se[r] = be; if (my_e == be) val = -INFINITY; }
            const float e1 = __expf(sv[1] - sv[0]), e2 = __expf(sv[2] - sv[0]), e3 = __expf(sv[3] - sv[0]); const float rs = 1.0f / (1.0f + e1 + e2 + e3);
            if (lane < 4) { const int ee = lane == 0 ? se[0] : lane == 1 ? se[1] : lane == 2 ? se[2] : se[3]; const float gg = (lane == 0 ? 1.0f : lane == 1 ? e1 : lane == 2 ? e2 : e3) * rs;
                const int a = tl * 4 + lane; sel_e[a] = ee; sel_g[a] = gg; sel_r[a] = __hip_atomic_fetch_add(&hist[ee], 1, __ATOMIC_RELAXED, __HIP_MEMORY_SCOPE_WORKGROUP); }
        }
        __syncthreads();
        if (tid < 32) base[tid] = (int)__hip_atomic_fetch_add(F.ctl + CW_CNT + 64 * l + tid, (unsigned)hist[tid], RLX_AGENT);
        __syncthreads();
        { const int a = tid, e = sel_e[a], rank = base[e] + sel_r[a], t = tile * 128 + (a >> 2);
          list_t[(size_t)e * LCAP + rank] = t; list_g[(size_t)e * LCAP + rank] = sel_g[a]; tok_e[t * 4 + (a & 3)] = e; tok_r[t * 4 + (a & 3)] = rank; }
        __syncthreads();
    }
}

__device__ __forceinline__ void p_gather(Frame& F, int l) {
    const int total = build_tables(F, l);
    LAS int* st = (LAS int*)(F.lds + TBL_START); LAS int* cn = st + 33;
    const bf16* x1b = (const bf16*)(F.ws + WS_X1B); bf16* xg = (bf16*)(F.ws + WS_H); float* sg = (float*)(F.ws + WS_SG);
    const int* list_t = (const int*)(F.ws + WS_LT); const float* list_g = (const float*)(F.ws + WS_LG);
    const int lane = F.lane, gw = F.vcu * NWAVES + F.wave, NGW = F.G * NWAVES;
    for (int s = gw; s < total; s += NGW) {
        const bool pr = (lane < NE) && (s >= st[lane & 31]);
        const int e = __popcll(__ballot(pr)) - 1; const int r = s - st[e];
        GAS v4u* dst = (GAS v4u*)(xg + (size_t)s * D);
        if (r < cn[e]) { const int t = list_t[(size_t)e * LCAP + r]; const GAS v4u* src = (const GAS v4u*)(x1b + (size_t)t * D);
            dst[lane] = src[lane]; dst[64 + lane] = src[64 + lane]; if (lane == 0) sg[s] = list_g[(size_t)e * LCAP + r]; }
        else { unsigned zz = 0u; asm volatile("" : "+v"(zz)); const v4u z4 = {zz, zz, zz, zz}; dst[lane] = z4; dst[64 + lane] = z4; if (lane == 0) sg[s] = 0.f; }
    }
}

__device__ __forceinline__ void p_ln2(Frame& F, int l, float* dst, bool write_f32, bool write_xb) {
    (void)build_tables(F, l);
    LAS int* st = (LAS int*)(F.lds + TBL_START);
    const bf16* x1b = (const bf16*)(F.ws + WS_X1B); const bf16* yb = (const bf16*)(F.ws + WS_H); bf16* xb = (bf16*)(F.ws + WS_XB);
    const int* tok_e = (const int*)(F.ws + WS_TE); const int* tok_r = (const int*)(F.ws + WS_TR);
    const int lane = F.lane, hl = lane & 31, half = lane >> 5, gw = F.vcu * NWAVES + F.wave, NGW = F.G * NWAVES;
    { const GAS f32x4* gsrc = (const GAS f32x4*)((F.tid < 256 ? INP(21) : INP(22)) + l * D) + (F.tid & 255); ((LAS f32x4*)F.lds)[F.tid] = *gsrc; __syncthreads(); }
    const LAS float* lgp = (const LAS float*)F.lds; const LAS float* lbp = lgp + D;
    float dmult = 1.0f;
#if MK_DEBUG
    if (l == DEPTH - 1) { const unsigned mask = __hip_atomic_load(F.ctl + 20000, RLX_AGENT) & ~(unsigned)(MK_DBG_IGNORE); if (mask) dmult = 1.0f + (float)(__ffs((int)mask) - 1); }
#endif
    static_assert(!MK_Y8 || (MK_FP8_LAST && MK_FP8_MOE_ALL), "MK_Y8: every layer's down-projection leaves fp8 rows");
    typedef unsigned u32x2y __attribute__((ext_vector_type(2))); constexpr bool y8 = true; v4u yw16[4][4]; (void)yw16;
    int t = 2 * gw + half; const int step = 2 * NGW, k4 = hl & 3;
    if (t < T) {
        const int niter = (T - 1 - t) / step + 1;
        v4u xn[4]; u32x2y yn[4][4];
        int eB = tok_e[t * 4 + k4], rB = tok_r[t * 4 + k4];
#define LN2_FETCH(tt) do { const int slot4_ = st[eB] + rB; int slot_[4]; _Pragma("unroll") for (int k = 0; k < 4; ++k) slot_[k] = __builtin_amdgcn_ds_bpermute((half * 32 + k) << 2, slot4_); \
            { const GAS v4u* xr_ = (const GAS v4u*)(x1b + (size_t)(tt) * D) + hl; _Pragma("unroll") for (int q = 0; q < 4; ++q) xn[q] = xr_[32 * q]; } \
            _Pragma("unroll") for (int k = 0; k < 4; ++k) { const GAS u32x2y* yr_ = (const GAS u32x2y*)((const unsigned char*)yb + (size_t)slot_[k] * D) + hl; _Pragma("unroll") for (int q = 0; q < 4; ++q) yn[k][q] = yr_[32 * q]; } } while (0)
        LN2_FETCH(t);
        { const int tb = t + step < T ? t + step : t; eB = tok_e[tb * 4 + k4]; rB = tok_r[tb * 4 + k4]; }
        auto ln2_token = [&](const int t, const v4u (&xw)[4], const u32x2y (&yw)[4][4]) __attribute__((always_inline)) {
        float v[4][8]; float s = 0.f;
#pragma unroll
        for (int q = 0; q < 4; ++q) {
            v[q][0] = bflo(xw[q].x) * DN_ALPHA; v[q][1] = bfhi(xw[q].x) * DN_ALPHA; v[q][2] = bflo(xw[q].y) * DN_ALPHA; v[q][3] = bfhi(xw[q].y) * DN_ALPHA;
            v[q][4] = bflo(xw[q].z) * DN_ALPHA; v[q][5] = bfhi(xw[q].z) * DN_ALPHA; v[q][6] = bflo(xw[q].w) * DN_ALPHA; v[q][7] = bfhi(xw[q].w) * DN_ALPHA;
#pragma unroll
#if MK_Y8
            for (int k = 0; k < 4; ++k) { if (y8) { const auto a0 = __builtin_amdgcn_cvt_pk_f32_fp8((int)yw[k][q].x, false), a1 = __builtin_amdgcn_cvt_pk_f32_fp8((int)yw[k][q].x, true), a2 = __builtin_amdgcn_cvt_pk_f32_fp8((int)yw[k][q].y, false), a3 = __builtin_amdgcn_cvt_pk_f32_fp8((int)yw[k][q].y, true);
                    v[q][0] += a0[0] * (1.f / 32.f); v[q][1] += a0[1] * (1.f / 32.f); v[q][2] += a1[0] * (1.f / 32.f); v[q][3] += a1[1] * (1.f / 32.f); v[q][4] += a2[0] * (1.f / 32.f); v[q][5] += a2[1] * (1.f / 32.f); v[q][6] += a3[0] * (1.f / 32.f); v[q][7] += a3[1] * (1.f / 32.f); }
                else { v[q][0] += bflo(yw16[k][q].x); v[q][1] += bfhi(yw16[k][q].x); v[q][2] += bflo(yw16[k][q].y); v[q][3] += bfhi(yw16[k][q].y);
                    v[q][4] += bflo(yw16[k][q].z); v[q][5] += bfhi(yw16[k][q].z); v[q][6] += bflo(yw16[k][q].w); v[q][7] += bfhi(yw16[k][q].w); } }
#else
            for (int k = 0; k < 4; ++k) { v[q][0] += bflo(yw[k][q].x); v[q][1] += bfhi(yw[k][q].x); v[q][2] += bflo(yw[k][q].y); v[q][3] += bfhi(yw[k][q].y);
                v[q][4] += bflo(yw[k][q].z); v[q][5] += bfhi(yw[k][q].z); v[q][6] += bflo(yw[k][q].w); v[q][7] += bfhi(yw[k][q].w); }
#endif
#pragma unroll
            for (int i = 0; i < 8; ++i) s += v[q][i]; }
        s += shx<1>(s, lane); s += shx<2>(s, lane); s += shx<4>(s, lane); s += shx<8>(s, lane); s += shx<16>(s, lane);
        const float mean = s * (1.f / D); float s2 = 0.f;
#pragma unroll
        for (int q = 0; q < 4; ++q)
#pragma unroll
            for (int i = 0; i < 8; ++i) { v[q][i] -= mean; s2 += v[q][i] * v[q][i]; }
        s2 += shx<1>(s2, lane); s2 += shx<2>(s2, lane); s2 += shx<4>(s2, lane); s2 += shx<8>(s2, lane); s2 += shx<16>(s2, lane);
        const float rstd = 1.f / sqrtf(s2 * (1.f / D) + LN_EPS);
        GAS f32x4* orow = (GAS f32x4*)(dst + (size_t)t * D) + 2 * hl; GAS v4u* o16 = (GAS v4u*)(xb + (size_t)t * D) + hl;
#pragma unroll
        for (int q = 0; q < 4; ++q) { const LAS f32x4* gq = (const LAS f32x4*)(lgp + 256 * q) + 2 * hl; const LAS f32x4* bq = (const LAS f32x4*)(lbp + 256 * q) + 2 * hl;
            const f32x4 g0 = gq[0], g1 = gq[1], b0 = bq[0], b1 = bq[1];
            f32x4 y0 = {v[q][0] * rstd, v[q][1] * rstd, v[q][2] * rstd, v[q][3] * rstd}, y1 = {v[q][4] * rstd, v[q][5] * rstd, v[q][6] * rstd, v[q][7] * rstd};
            y0 = y0 * g0 + b0; y1 = y1 * g1 + b1;
            if (write_f32) { orow[64 * q] = y0 * dmult; orow[64 * q + 1] = y1 * dmult; }
            if (write_xb) { o16[32 * q] = (v4u){pk2(y0.x, y0.y), pk2(y0.z, y0.w), pk2(y1.x, y1.y), pk2(y1.z, y1.w)};
                if (F8IN(l + 1)) { typedef unsigned u32x2 __attribute__((ext_vector_type(2)));
                    ((GAS u32x2*)(F.ws + WS_X2 + (size_t)t * D))[hl + 32 * q] = (u32x2){pg8::pk4_fp8(y0.x * 16.f, y0.y * 16.f, y0.z * 16.f, y0.w * 16.f), pg8::pk4_fp8(y1.x * 16.f, y1.y * 16.f, y1.z * 16.f, y1.w * 16.f)}; } } }
        };
        for (int it = 0; it + 1 < niter; ++it, t += step) {
            v4u xw[4]; u32x2y yw[4][4];
#pragma unroll
            for (int q = 0; q < 4; ++q) { xw[q] = xn[q];
#pragma unroll
                for (int k = 0; k < 4; ++k) yw[k][q] = yn[k][q]; }
            LN2_FETCH(t + step);
            { const int tc = t + 2 * step < T ? t + 2 * step : t + step; eB = tok_e[tc * 4 + k4]; rB = tok_r[tc * 4 + k4]; }
            ln2_token(t, xw, yw);
        }
        ln2_token(t, xn, yn);
#undef LN2_FETCH
    }
}

template <int WHICH> __device__ __forceinline__ void p_attention(Frame& F, int l) {
    const bf16* hb = (const bf16*)(F.ws + WS_H); unsigned char* a2 = F.ws + WS_A2;
    const bf16* kB = (const bf16*)(a2 + A2_KB); const bf16* kr = (const bf16*)(a2 + A2_KR); const bf16* qc = (const bf16*)(a2 + A2_QC); const bf16* kvc = (const bf16*)(a2 + A2_KVC);
    bf16* ya = (bf16*)(a2 + A2_YA); bf16* yb = (bf16*)(a2 + A2_YB); bf16* yc = (bf16*)(a2 + A2_YC);
    att::ALAS_PTR lds = (att::ALAS_PTR)F.lds;
    att::NoSide noside;
    __syncthreads();
    if (WHICH == 0) {
        float mq = fabsf((INP(3) + l * 64)[F.lane]), mk = fabsf((INP(4) + l * 64)[F.lane]);
#define MX_STEP(O) { mq = fmaxf(mq, shx<O>(mq, F.lane)); mk = fmaxf(mk, shx<O>(mk, F.lane)); }
        MX_STEP(1) MX_STEP(2) MX_STEP(4) MX_STEP(8) MX_STEP(16) MX_STEP(32)
#undef MX_STEP
        const float cref = __int_as_float(__builtin_amdgcn_readfirstlane(__float_as_int(8.0f * LOG2E_F * 1.03f * mq * mk)));
        const bool fixed_ok = cref < 60.0f;
        unsigned char* wbl = F.ws + WS_W + (size_t)l * WB_LAYER;
        MoeConv cv; cv.Wgu = INP(17) + (size_t)l * NE * 1024 * 2048; cv.Wdn = INP(19) + (size_t)l * NE * 1024 * 1024; cv.Tgu = wbl + WB_GU; cv.Tdn = wbl + WB_DN; cv.f8 = F8MOE(l);
        cv.scr = (LAS float*)(F.lds + CONV_LDS_OFF + F.wave * CONV_LDS_WAVE); cv.lane = F.lane; cv.ngw = F.G * NWAVES; cv.gw = F.vcu * NWAVES + F.wave; cv.s = 0;
        cv.nmini = 4 * ((CONV_ITEMS - cv.gw + cv.ngw - 1) / cv.ngw);
#pragma unroll
        for (int i_ = 0; i_ < 2; ++i_) { cv.cvA[i_] = (f32x4){0.f, 0.f, 0.f, 0.f}; cv.cvB[i_] = (f32x4){0.f, 0.f, 0.f, 0.f}; }
        for (int idx = F.vcu; idx < 768; idx += F.G) {
            const int qi = idx >> 8, rem = idx & 255, bk = rem >> 5, qb = rem & 31, b = bk >> 1, kvh = bk & 1, head = kvh * 3 + qi;
            att::UnitP u; const size_t tb = (size_t)b * SEQ, tq = tb + (size_t)qb * 256;
            u.Q = hb + tq * DINP + H_GQ + head * 64; u.ldq = DINP; u.K0 = kB + tb * 128 + kvh * 64; u.ldk0 = 128; u.K1 = nullptr; u.ldk1 = 0;
            u.V = hb + tb * DINP + H_GV + kvh * 64; u.ldv = DINP; u.O = MK_E8 ? (bf16*)((unsigned char*)yb + tq * 512 + head * 64) : yb + tq * 384 + head * 64; u.ldo = MK_E8 ? 512 : 384; u.nt = SEQ / 64; u.grow0 = qb * 4; u.gain = INP(3) + l * 64; u.kr0 = 0; u.cref = cref;
            u.K8 = a2 + A2_K8 + tb * 128 + kvh * 64; u.ldk8 = 128; u.V8 = a2 + A2_VT8 + (size_t)(b * 2 + kvh) * (SEQ / 64) * 4096;
            if (MK_FP8_QK && cref <= 15.0f) att::attn_unit<64, 0, MoeConv, true, (MK_FP8_PV != 0)>(u, lds, F.tid, cv);
            else if (!MK_FP8_QK && fixed_ok) att::attn_unit<64, 0, MoeConv, false>(u, lds, F.tid, cv);
            else att::attn_unit<64, 3, MoeConv>(u, lds, F.tid, cv);
        }
        while (!cv.done()) { cv.step<0>(); cv.load<0>(); cv.step<1>(); cv.load<1>(); }
    }
    if (WHICH == 1) for (int idx = F.vcu; idx < 512; idx += F.G) {
        const int rnd = idx >> 8, rem = idx & 255, p = (rem >> 5) * 2 + rnd, qb = rem & 31, b = p >> 2, h = p & 3;
        att::UnitP u; const size_t tb = (size_t)b * SEQ, tq = tb + (size_t)qb * 256;
        u.Q = qc + tq * 384 + h * 96; u.ldq = 384; u.K0 = kvc + tb * 512 + h * 128; u.ldk0 = 512; u.K1 = kr + tb * 32; u.ldk1 = 32;
        u.V = kvc + tb * 512 + h * 128 + 64; u.ldv = 512; u.O = MK_E8 ? (bf16*)((unsigned char*)yc + tq * 512 + h * 64) : yc + tq * 384 + h * 64; u.ldo = MK_E8 ? 512 : 384; u.nt = SEQ / 64; u.grow0 = qb * 4; u.gain = nullptr; u.kr0 = 0; u.cref = 0.f; u.K8 = a2 + A2_K8M + tb * 256 + h * 64; u.ldk8 = 256; u.V8 = a2 + A2_VT8M + (size_t)(b * 4 + h) * (SEQ / 64) * 4096;
        att::attn_unit<96, 1, att::NoSide, (MK_FP8_QKM != 0 && MK_FP8_PVM != 0), (MK_FP8_PVM != 0)>(u, lds, F.tid, noside);
    }
    if (WHICH == 2) for (int idx = F.vcu; idx < 768; idx += F.G) {
        const int b = idx / 192, rem = idx % 192, h = rem >> 5, rg = rem & 31, R0 = rg * 4;
        int r_lo = R0 - 4; r_lo = r_lo < 0 ? 0 : (r_lo > 120 ? 120 : r_lo);
        int r_hi = R0 - 1; r_hi = (r_hi < 0 ? 0 : (r_hi > 120 ? 120 : r_hi)) + 8;
        if ((r_hi - r_lo) & 1) { if (r_hi < 128) ++r_hi; else --r_lo; }
        {
            LAS float* bt = (LAS float*)(F.lds + att::OFF_BIAS); const float* rp = INP(2) + ((size_t)l * 6 + h) * 465;
            float bv_[4];
#pragma unroll
            for (int k = 0; k < 4; ++k) { const int e = F.tid + 512 * k, dr = e >> 7, x = (e & 127) - 48; const int drc = dr > 14 ? 14 : dr, xc = x < 0 ? 0 : (x > 30 ? 30 : x); bv_[k] = rp[drc * 31 + xc]; }
            __builtin_amdgcn_sched_barrier(0);
#pragma unroll
            for (int k = 0; k < 4; ++k) { const int e = F.tid + 512 * k, x = (e & 127) - 48;
                if (e < 15 * 128) bt[e] = (x >= 0 && x <= 30) ? bv_[k] * LOG2E_F : 0.f; } }
        att::UnitP u; const size_t tb = (size_t)b * SEQ, tq = tb + (size_t)R0 * 64, tk = tb + (size_t)r_lo * 64;
        u.Q = hb + tq * DINP + H_NAQ + h * 64; u.ldq = DINP; u.K0 = hb + tk * DINP + H_NAK + h * 64; u.ldk0 = DINP; u.K1 = nullptr; u.ldk1 = 0;
        u.V = hb + tk * DINP + H_NAV + h * 64; u.ldv = DINP; u.O = MK_E8 ? (bf16*)((unsigned char*)ya + tq * 512 + h * 64) : ya + tq * 384 + h * 64; u.ldo = MK_E8 ? 512 : 384; u.nt = r_hi - r_lo; u.grow0 = R0; u.gain = nullptr; u.kr0 = r_lo; u.cref = 0.f; u.K8 = nullptr; u.ldk8 = 0; u.V8 = nullptr;
        att::attn_unit<64, 2>(u, lds, F.tid, noside);
    }
}


#ifndef STAG_A
#define STAG_A 0
#endif
#ifndef NT_A
#define NT_A 1
#endif
#ifndef STAG_AG
#define STAG_AG 4
#endif
#ifndef STAG_J
#define STAG_J 0
#endif
#ifndef STAG_I
#define STAG_I 0
#endif
#ifndef PROBE_AM
#define PROBE_AM 0
#endif
#ifndef PROBE_I1
#define PROBE_I1 0
#endif
struct Args { const float* in[23]; float* out; unsigned char* ws; int ph_lo, ph_hi, use_bar, pad; };
__global__ void __launch_bounds__(NWAVES * 64, 2) mk_fwd(Args args) {
    extern __shared__ __attribute__((aligned(16))) unsigned char lds[];
    const int wave_id = __builtin_amdgcn_readfirstlane((int)threadIdx.x >> 6), bx0 = blockIdx.x, G0 = gridDim.x;
    {   LAS unsigned* z = (LAS unsigned*)((LAS unsigned char*)lds + LDSCTL_OFF); for (int u = threadIdx.x; u < (LDS_BYTES - LDSCTL_OFF) / 4; u += NWAVES * 64) z[u] = 0u; }
    __syncthreads();
    XcdBarrier bar; bar.bar = (unsigned*)(args.ws + WS_CTL) + CW_BAR; bar.x = 0; bar.st = nullptr;
    if (args.use_bar) bar = xcd_barrier_post((unsigned*)(args.ws + WS_CTL) + CW_BAR, (volatile LAS unsigned*)((LAS unsigned char*)lds + MISC_OFF));
    const int lo = args.ph_lo, hi = args.ph_hi;
#define IN(k) (lo <= (k) && (k) < hi)
#define REPEAT(n) for (int rep_ = 0; rep_ < (n); ++rep_)
#define RSEAM(n) do { if (rep_ + 1 < (n)) { XcdBarrier b_ = bar; { GAS unsigned* bb_ = (GAS unsigned*)b_.bar; asm volatile("; rseam %1" : "+s"(bb_) : "n"(__COUNTER__)); b_.bar = (unsigned*)bb_; } xcd_barrier(b_); } } while (0)
#define SEAM(k) do { if (IN(k) && IN((k) + 1)) { XcdBarrier b_ = bar; { GAS unsigned* bb_ = (GAS unsigned*)b_.bar; asm volatile("; seam %1" : "+s"(bb_) : "n"(__COUNTER__)); b_.bar = (unsigned*)bb_; } xcd_barrier(b_); } } while (0)
#define FRAME() Frame F = mkframe<__COUNTER__>((LAS unsigned char*)lds, args.ws, args.out, wave_id, bx0, G0); unsigned char* ws = F.ws; unsigned char* a2 = ws + WS_A2; unsigned char* wb = ws + WS_W + (size_t)l * WB_LAYER; (void)a2; (void)wb

    if (IN(0)) REPEAT(REP_P) { Frame F = mkframe<__COUNTER__>((LAS unsigned char*)lds, args.ws, args.out, wave_id, bx0, G0); p_prologue(F); RSEAM(REP_P); } SEAM(0);

    for (int l = 0; l < DEPTH; ++l) {
        const int pb = 1 + l * PPL;
        if (IN(pb + 0)) REPEAT(REP_A) { FRAME();
            pg8::StaticOrder S; S.init(T, DINP, F.G, F.bx);
            if (!F8IN(l)) {
                pg8::Gemm g{(const bf16*)(ws + WS_XB), (const bf16*)(wb + WB_IN), T, DINP, 1024, 0, 0, (const void*)ws};
                pg8::EpiStore E{(bf16*)(ws + WS_H), DINP, DINP, 1.0f};
                pg8::gemm_phase<pg8::EpiStore, pg8::StaticOrder, true, true>(F.lds, g, S, E, F.tid);
            } else {
                pg8::Gemm g{(const bf16*)(ws + WS_X2), (const bf16*)(wb + WB_IN), T, DINP, 1024, 0, 0, (const void*)ws};
#if MK_GATE_EXP
                pg8::EpiStoreGE E{(bf16*)(ws + WS_H), DINP, DINP, 1.0f / 512.0f, H_GATE};
                pg8::gemm_phase<pg8::EpiStoreGE, pg8::StaticOrder, true, true, false, pg8::NoGather, 1>(F.lds, g, S, E, F.tid);
#else
                pg8::EpiStore E{(bf16*)(ws + WS_H), DINP, DINP, 1.0f / 512.0f};
                pg8::gemm_phase<pg8::EpiStore, pg8::StaticOrder, true, true, false, pg8::NoGather, 1>(F.lds, g, S, E, F.tid);
#endif
            }
            RSEAM(REP_A);
        } SEAM(pb + 0);
        if (IN(pb + 1)) REPEAT(REP_B) { FRAME(); p_prep(F, l); RSEAM(REP_B); } SEAM(pb + 1);
        if (IN(pb + 2)) REPEAT(REP_C) {
            { FRAME(); pg8::Gemm g{(const bf16*)(a2 + A2_CQN), (const bf16*)(wb + WB_UQ), T, 512, 384, 0, 0, (const void*)ws}; pg8::StaticOrder S; S.init(T, 512, F.G, F.bx);
              pg8::EpiStore E{(bf16*)(a2 + A2_QC), 384, 384, 1.0f};
              pg8::gemm_phase<pg8::EpiStore, pg8::StaticOrder, true, true>(F.lds, g, S, E, F.tid); }
            { FRAME(); pg8::Gemm g{(const bf16*)(a2 + A2_CKVN), (const bf16*)(wb + WB_UKV), T, 512, 256, 0, 0, (const void*)ws}; pg8::StaticOrder S; S.init(T, 512, F.G, F.bx);
#if MK_FP8_PVM
              pg8::EpiStoreV8 E{(bf16*)(a2 + A2_KVC), a2 + A2_VT8M, a2 + A2_K8M};
              pg8::gemm_phase<pg8::EpiStoreV8, pg8::StaticOrder, true, true>(F.lds, g, S, E, F.tid); }
#else
              pg8::EpiStore E{(bf16*)(a2 + A2_KVC), 512, 512, 1.0f};
              pg8::gemm_phase<pg8::EpiStore, pg8::StaticOrder, true, true>(F.lds, g, S, E, F.tid); }
#endif
            RSEAM(REP_C);
        } SEAM(pb + 2);
        if (IN(pb + 3)) { REPEAT(REP_DG) { FRAME(); p_attention<0>(F, l); RSEAM(REP_DG); } REPEAT(REP_DM) { FRAME(); p_attention<1>(F, l); RSEAM(REP_DM); } REPEAT(REP_DN) { FRAME(); p_attention<2>(F, l); RSEAM(REP_DN); } } SEAM(pb + 3);
        if (IN(pb + 4)) REPEAT(REP_E) { FRAME();
            pg8::ChainOrder S; S.so.init(T, 1024, F.G, F.bx); S.nch = 3;
#if MK_E8
            pg8::Gemm g{(const bf16*)(a2 + A2_YA), (const bf16*)(wb + WB_BA), T, 1024, 512, (size_t)1024 * 384 * 2, (size_t)T * 384 * 2, (const void*)ws};
            pg8::EpiGateChain E{(const bf16*)(ws + WS_H) + H_GATE, DINP, (void*)(a2 + A2_MIXED), 256.0f / 2048.0f};
            pg8::gemm_phase<pg8::EpiGateChain, pg8::ChainOrder, true, true, false, pg8::NoGather, 1>(F.lds, g, S, E, F.tid);
#else
            pg8::Gemm g{(const bf16*)(a2 + A2_YA), (const bf16*)(wb + WB_BA), T, 1024, 384, (size_t)1024 * 384 * 2, (size_t)T * 384 * 2, (const void*)ws};
            pg8::EpiGateChain E{(const bf16*)(ws + WS_H) + H_GATE, DINP, (void*)(a2 + A2_MIXED), MK_FP8_OUT ? 256.0f : 0.0f};
            pg8::gemm_phase<pg8::EpiGateChain, pg8::ChainOrder, true, true>(F.lds, g, S, E, F.tid);
#endif
            RSEAM(REP_E);
        } SEAM(pb + 4);
        if (IN(pb + 5)) REPEAT(REP_F) { FRAME();
            pg8::StaticOrder S; S.init(T, 1024, F.G, F.bx);
            if (!MK_FP8_OUT) { pg8::Gemm g{(const bf16*)(a2 + A2_MIXED), (const bf16*)(wb + WB_OUT), T, 1024, 1024, 0, 0, (const void*)ws};
                pg8::EpiStore E{(bf16*)(ws + WS_X1), 1024, 1024, 1.0f};
                pg8::gemm_phase<pg8::EpiStore, pg8::StaticOrder, true, true>(F.lds, g, S, E, F.tid); }
            else { pg8::Gemm g{(const bf16*)(a2 + A2_MIXED), (const bf16*)(wb + WB_OUT), T, 1024, 1024, 0, 0, (const void*)ws};
#if MK_OUT8
                pg8::EpiStoreF8 E{ws + WS_X1, 1024, 32.0f / 16384.0f};
                pg8::gemm_phase<pg8::EpiStoreF8, pg8::StaticOrder, true, true, false, pg8::NoGather, 1>(F.lds, g, S, E, F.tid); }
#else
                pg8::EpiStore E{(bf16*)(ws + WS_X1), 1024, 1024, 1.0f / 16384.0f};
                pg8::gemm_phase<pg8::EpiStore, pg8::StaticOrder, true, true, false, pg8::NoGather, 1>(F.lds, g, S, E, F.tid); }
#endif
            RSEAM(REP_F);
        } SEAM(pb + 5);
        if (IN(pb + 6)) { FRAME(); p_ln1_router<true>(F, l, ws + WS_XB);   } SEAM(pb + 6);
        const bool f8l = F8MOE(l);
        if (IN(pb + 7)) REPEAT(REP_I) { FRAME();
            const int total = build_tables(F, l);
            pg8::MoeOrder S{8, (total >> 8) * 8, F.G, F.vcu, (const LAS int*)(F.lds + TBL_TILEE)};
            pg8::MoeGather gs{(const int*)(ws + WS_LT), (const LAS int*)(F.lds + TBL_START), (const LAS int*)(F.lds + TBL_START) + 33, LCAP};
            if (!f8l) {
                pg8::Gemm g{(const bf16*)(ws + WS_X1B), (const bf16*)(wb + WB_GU), total, 2048, 1024, (size_t)2048 * 1024 * 2, 0, nullptr};
                pg8::EpiSwigluT<false> E{(void*)(ws + WS_A2), INP(18) + (size_t)l * NE * 2048, 1.0f, 1.0f};
                pg8::gemm_phase<pg8::EpiSwigluT<false>, pg8::MoeOrder, true, true, true, pg8::MoeGather>(F.lds, g, S, E, F.tid, gs);
            } else {
                pg8::Gemm g{(const bf16*)(ws + WS_X2), (const bf16*)(wb + WB_GU), total, 2048, 1024, (size_t)2048 * 1024, 0, (const void*)ws, (rep_ + 1 < REP_I) ? PROBE_I1 : 0};
                pg8::EpiSwigluT<true> E{(void*)(ws + WS_A2), INP(18) + (size_t)l * NE * 2048, 1.0f / 1024.0f, 4.0f};
                if (STAG_I > 0) stagger(F, (F.vcu * 4) / F.G, STAG_I);
                pg8::gemm_phase<pg8::EpiSwigluT<true>, pg8::MoeOrder, true, true, true, pg8::MoeGather, 1>(F.lds, g, S, E, F.tid, gs);
            }
            RSEAM(REP_I);
        } SEAM(pb + 7);
        if (IN(pb + 8)) REPEAT(REP_J) { FRAME();
            const int total = build_tables(F, l);
            pg8::MoeOrder S{4, (total >> 8) * 4, F.G, F.vcu, (const LAS int*)(F.lds + TBL_TILEE)};
            if (!f8l) {
                pg8::Gemm g{(const bf16*)(ws + WS_A2), (const bf16*)(wb + WB_DN), total, 1024, 1024, (size_t)1024 * 1024 * 2, 0, nullptr};
                pg8::EpiDown E{(bf16*)(ws + WS_H), INP(20) + (size_t)l * NE * 1024, (const float*)(ws + WS_LG), (const LAS int*)(F.lds + TBL_START), (const LAS int*)(F.lds + TBL_START) + 33, LCAP, 1.0f};
                pg8::gemm_phase<pg8::EpiDown, pg8::MoeOrder, true, true>(F.lds, g, S, E, F.tid);
            } else {
                pg8::Gemm g{(const bf16*)(ws + WS_A2), (const bf16*)(wb + WB_DN), total, 1024, 1024, (size_t)1024 * 1024, 0, (const void*)ws};
                pg8::EpiDown E{(bf16*)(ws + WS_H), INP(20) + (size_t)l * NE * 1024, (const float*)(ws + WS_LG), (const LAS int*)(F.lds + TBL_START), (const LAS int*)(F.lds + TBL_START) + 33, LCAP, 1.0f / 512.0f};
                if (STAG_J > 0) stagger(F, (F.vcu * 4) / F.G, STAG_J);
                pg8::gemm_phase<pg8::EpiDown, pg8::MoeOrder, true, true, false, pg8::NoGather, 1>(F.lds, g, S, E, F.tid);
            }
            RSEAM(REP_J);
        } SEAM(pb + 8);
        if (IN(pb + 9)) REPEAT(REP_K) { FRAME(); RSEAM(REP_K); p_ln2(F, l, F.out, l == DEPTH - 1, l + 1 < DEPTH); }
        if (l + 1 < DEPTH) SEAM(pb + 9);
    }
#undef IN
#undef SEAM
}


#if MK_DEBUG
constexpr int CW_DBG = 20000;
__device__ __forceinline__ float bfr(float f) { return __uint_as_float(f2bf(f) << 16); }
__device__ __forceinline__ float bfv(const bf16* p) { return __uint_as_float(((unsigned)*p) << 16); }
__device__ __forceinline__ unsigned hsh(unsigned x) { x ^= x >> 16; x *= 0x7feb352du; x ^= x >> 15; x *= 0x846ca68bu; x ^= x >> 16; return x; }
__device__ __forceinline__ bool close_(float got, float ref, float rel, float abs_) { return fabsf(got - ref) <= rel * fabsf(ref) + abs_; }
__device__ __forceinline__ void ropecs(int i, int quarter, int s, float& c, float& sn) {
    const float pos = (i < quarter) ? (float)(s >> 6) : (float)(s & 63); const int m = (i < quarter) ? i : i - quarter;
    const float inv = exp2f(-(float)m / (float)quarter * 13.287712379549449f); const float ang = pos * inv * 0.15915494309189535f; c = __builtin_amdgcn_cosf(ang); sn = __builtin_amdgcn_sinf(ang);
}
#define DBG_FAIL(bit) atomicOr((unsigned*)(ws + WS_CTL) + CW_DBG, 1u << (bit))
template <int stage> __global__ void __launch_bounds__(256) dbg_kernel(Args args) {
    unsigned char* ws = args.ws; const int l = 0;
    const int gid = blockIdx.x * 256 + threadIdx.x;
    const bf16* hb = (const bf16*)(ws + WS_H); unsigned char* a2 = ws + WS_A2; unsigned char* wb = ws + WS_W + (size_t)l * WB_LAYER;
    const bf16* kB = (const bf16*)(a2 + A2_KB); const bf16* cqn = (const bf16*)(a2 + A2_CQN); const bf16* ckvn = (const bf16*)(a2 + A2_CKVN); const bf16* kr = (const bf16*)(a2 + A2_KR);
    const bf16* qc = (const bf16*)(a2 + A2_QC); const bf16* kvc = (const bf16*)(a2 + A2_KVC);
    const bf16* ya = (const bf16*)(a2 + A2_YA); const bf16* yb = (const bf16*)(a2 + A2_YB); const bf16* yc = (const bf16*)(a2 + A2_YC);
    const unsigned h1 = hsh(gid * 2654435761u + 12345u + stage * 977u), h2 = hsh(h1 + 0x9e3779b9u);
    const int t = h1 % T, s = t & (SEQ - 1), b = t / SEQ;
    if (stage == 0) {
        const int n = h2 % DIN; const float* x = args.in[0] + (size_t)t * D; const float* W = args.in[1];
        const float sc = (n < 384) ? 0.125f * LOG2E_F : 1.0f; float r = 0.f;
        for (int k = 0; k < 1024; ++k) r += bfr(x[k]) * bfr(W[(size_t)k * DIN + n] * sc);
        if (!close_(bfv(hb + (size_t)t * DINP + n), r, 0.02f, 0.02f)) DBG_FAIL(1);
    }
    if (stage == 1) {
        const bf16* hr = hb + (size_t)t * DINP;
        {   const int d = h2 % 128, head = d >> 6, dd = d & 63; float ssq = 0.f;
            for (int k = 0; k < 64; ++k) { const float v = bfv(hr + H_GK + head * 64 + k); ssq += v * v; }
            const float rstd = 1.0f / sqrtf(ssq / 64.0f + RMS_EPS); const float* g = args.in[4];
            const int i = dd & 31; const float y1 = bfv(hr + H_GK + head * 64 + i) * rstd * g[i], y2 = bfv(hr + H_GK + head * 64 + i + 32) * rstd * g[i + 32];
            float c, sn; ropecs(i, 16, s, c, sn); const float ref = (dd < 32) ? (y1 * c - y2 * sn) : (y1 * sn + y2 * c);
            if (!close_(bfv(kB + (size_t)t * 128 + d), ref, 0.02f, 0.01f)) DBG_FAIL(2); }
        {   const int d = h2 % 384; float ssq = 0.f; for (int k = 0; k < 384; ++k) { const float v = bfv(hr + H_CQ + k); ssq += v * v; }
            const float ref = bfv(hr + H_CQ + d) / sqrtf(ssq / 384.0f + RMS_EPS) * args.in[5][d];
            if (!close_(bfv(cqn + (size_t)t * 384 + d), ref, 0.02f, 0.01f)) DBG_FAIL(3); }
        {   const int d = h2 % 256; float ssq = 0.f; for (int k = 0; k < 256; ++k) { const float v = bfv(hr + H_CKV + k); ssq += v * v; }
            const float ref = bfv(hr + H_CKV + d) / sqrtf(ssq / 256.0f + RMS_EPS) * args.in[6][d];
            if (!close_(bfv(ckvn + (size_t)t * 256 + d), ref, 0.02f, 0.01f)) DBG_FAIL(4); }
        {   const int d = h2 % 32, i = d & 15; const float x1 = bfv(hr + H_KR + i), x2 = bfv(hr + H_KR + i + 16); float c, sn; ropecs(i, 8, s, c, sn);
            const float ref = (d < 16) ? (x1 * c - x2 * sn) : (x1 * sn + x2 * c);
            if (!close_(bfv(kr + (size_t)t * 32 + d), ref, 0.02f, 0.01f)) DBG_FAIL(5); }
    }
    if (stage == 2) {
        {   const int n = h2 % 384; float r = 0.f; const float sc = 0.10206207261596577f * LOG2E_F;
            for (int k = 0; k < 384; ++k) r += bfv(cqn + (size_t)t * 384 + k) * bfr(args.in[7][(size_t)k * 384 + n] * sc);
            if (!close_(bfv(qc + (size_t)t * 384 + n), r, 0.02f, 0.01f)) DBG_FAIL(6); }
        {   const int n = h2 % 512; float r = 0.f;
            for (int k = 0; k < 256; ++k) r += bfv(ckvn + (size_t)t * 256 + k) * bfr(args.in[8][(size_t)k * 512 + n]);
            if (!close_(bfv(kvc + (size_t)t * 512 + n), r, 0.02f, 0.02f)) DBG_FAIL(7); }
    }
    if (stage == 3) {
        const int gr = s >> 6, gc = s & 63;
        if (gid < 1024) {
            const int h = h2 % 6, dofs = ((h2 >> 8) & 1) * 32; float q[64], o[32];
            _Pragma("unroll") for (int d = 0; d < 64; ++d) { q[d] = bfv(hb + (size_t)t * DINP + H_NAQ + h * 64 + d); }
            _Pragma("unroll") for (int d = 0; d < 32; ++d) o[d] = 0.f;
            int r0 = gr - 4; r0 = r0 < 0 ? 0 : (r0 > 120 ? 120 : r0); int c0 = gc - 8; c0 = c0 < 0 ? 0 : (c0 > 48 ? 48 : c0);
            const float* rp = args.in[2] + (size_t)h * 465; float m = -1e30f, lsum = 0.f;
            for (int pass = 0; pass < 2; ++pass)
                for (int i = 0; i < 8; ++i) for (int j = 0; j < 16; ++j) { const int kr_ = r0 + i, kc = c0 + j; const size_t kt = (size_t)b * SEQ + kr_ * 64 + kc;
                    float sc = 0.f; _Pragma("unroll") for (int d = 0; d < 64; ++d) sc += q[d] * bfv(hb + kt * DINP + H_NAK + h * 64 + d);
                    sc += rp[(kr_ - gr + 7) * 31 + (kc - gc + 15)] * LOG2E_F;
                    if (pass == 0) m = fmaxf(m, sc); else { const float p = exp2f(sc - m); lsum += p; _Pragma("unroll") for (int d = 0; d < 32; ++d) o[d] += p * bfv(hb + kt * DINP + H_NAV + h * 64 + dofs + d); } }
            bool bad = false; _Pragma("unroll") for (int d = 0; d < 32; ++d) bad |= !close_(bfv(ya + (size_t)t * 384 + h * 64 + dofs + d), o[d] / lsum, 0.03f, 0.01f);
            if (bad) DBG_FAIL(8);
        } else if (gid < 1024 + 128) {
            const int head = h2 % 6, kvh = head / 3, dofs = ((h2 >> 8) & 1) * 32; float q[64], o[32]; float ssq = 0.f;
            _Pragma("unroll") for (int d = 0; d < 64; ++d) { q[d] = bfv(hb + (size_t)t * DINP + H_GQ + head * 64 + d); ssq += q[d] * q[d]; }
            _Pragma("unroll") for (int d = 0; d < 32; ++d) o[d] = 0.f;
            const float rstd = 1.0f / sqrtf(ssq / 64.0f + RMS_EPS);
            _Pragma("unroll") for (int d = 0; d < 64; ++d) q[d] = q[d] * rstd * args.in[3][d];
            _Pragma("unroll") for (int i = 0; i < 32; ++i) { float c, sn; ropecs(i, 16, s, c, sn); const float y1 = q[i], y2 = q[i + 32]; q[i] = y1 * c - y2 * sn; q[i + 32] = y1 * sn + y2 * c; }
            _Pragma("unroll") for (int d = 0; d < 64; ++d) q[d] = bfr(q[d] * 0.125f * LOG2E_F);
            float m = -1e30f, lsum = 0.f;
            for (int key = 0; key < SEQ; ++key) { const size_t kt = (size_t)b * SEQ + key; float sc = 0.f;
                _Pragma("unroll") for (int d = 0; d < 64; ++d) sc += q[d] * bfv(kB + kt * 128 + kvh * 64 + d);
                const float mn = fmaxf(m, sc), al = exp2f(m - mn), p = exp2f(sc - mn); m = mn; lsum = lsum * al + p;
                _Pragma("unroll") for (int d = 0; d < 32; ++d) o[d] = o[d] * al + p * bfv(hb + kt * DINP + H_GV + kvh * 64 + dofs + d); }
            bool bad = false; _Pragma("unroll") for (int d = 0; d < 32; ++d) bad |= !close_(bfv(yb + (size_t)t * 384 + head * 64 + dofs + d), o[d] / lsum, 0.03f, MK_FP8_QK ? 0.012f : 0.003f);
            if (bad) DBG_FAIL(9);
        } else if (gid < 1024 + 256) {
            const int h = h2 % 4, dofs = ((h2 >> 8) & 1) * 32; float q[96], o[32];
            _Pragma("unroll") for (int d = 0; d < 96; ++d) q[d] = bfv(qc + (size_t)t * 384 + h * 96 + d);
            _Pragma("unroll") for (int i = 0; i < 16; ++i) { float c, sn; ropecs(i, 8, s, c, sn); const float y1 = q[64 + i], y2 = q[80 + i]; q[64 + i] = bfr(y1 * c - y2 * sn); q[80 + i] = bfr(y1 * sn + y2 * c); }
            _Pragma("unroll") for (int d = 0; d < 32; ++d) o[d] = 0.f;
            float m = -1e30f, lsum = 0.f;
            for (int key = 0; key < SEQ; ++key) { const size_t kt = (size_t)b * SEQ + key; float sc = 0.f;
                _Pragma("unroll") for (int d = 0; d < 64; ++d) sc += q[d] * bfv(kvc + kt * 512 + h * 128 + d);
                _Pragma("unroll") for (int d = 0; d < 32; ++d) sc += q[64 + d] * bfv(kr + kt * 32 + d);
                const float mn = fmaxf(m, sc), al = exp2f(m - mn), p = exp2f(sc - mn); m = mn; lsum = lsum * al + p;
                _Pragma("unroll") for (int d = 0; d < 32; ++d) o[d] = o[d] * al + p * bfv(kvc + kt * 512 + h * 128 + 64 + dofs + d); }
            bool bad = false; _Pragma("unroll") for (int d = 0; d < 32; ++d) bad |= !close_(bfv(yc + (size_t)t * 384 + h * 64 + dofs + d), o[d] / lsum, 0.03f, 0.003f);
            if (bad) DBG_FAIL(10);
        }
    }
    if (stage == 4) {
        const int n = h2 % 1024; float r = 0.f;
        { float a = 0.f; for (int k = 0; k < 384; ++k) a += bfv(ya + (size_t)t * 384 + k) * bfr(args.in[9][(size_t)k * 1024 + n]); r += a / (1.0f + expf(-bfv(hb + (size_t)t * DINP + H_GATE + n))); }
        { float a = 0.f; for (int k = 0; k < 384; ++k) a += bfv(yb + (size_t)t * 384 + k) * bfr(args.in[10][(size_t)k * 1024 + n]); r += a / (1.0f + expf(-bfv(hb + (size_t)t * DINP + H_GATE + 1024 + n))); }
        { float a = 0.f; for (int k = 0; k < 256; ++k) a += bfv(yc + (size_t)t * 384 + k) * bfr(args.in[11][(size_t)k * 1024 + n]); r += a / (1.0f + expf(-bfv(hb + (size_t)t * DINP + H_GATE + 2048 + n))); }
        if (!close_(bfv((const bf16*)(a2 + A2_MIXED) + (size_t)t * 1024 + n), r, 0.02f, 0.003f)) DBG_FAIL(11);
    }
    if (stage == 5) {
        const int n = h2 % 1024; float r = 0.f; const bf16* mx = (const bf16*)(a2 + A2_MIXED) + (size_t)t * 1024;
        for (int k = 0; k < 1024; ++k) r += bfv(mx + k) * bfr(args.in[12][(size_t)k * 1024 + n]);
        if (!close_(bfv((const bf16*)(ws + WS_X1) + (size_t)t * D + n), r, 0.02f, 0.002f)) DBG_FAIL(12);
    }
    if (stage == 6) {
        const bf16* x1 = (const bf16*)(ws + WS_X1B) + (size_t)t * D; const int* tok_e = (const int*)(ws + WS_TE); const int* tok_r = (const int*)(ws + WS_TR);
        const int* list_t = (const int*)(ws + WS_LT); const float* list_g = (const float*)(ws + WS_LG);
        float lg[32]; _Pragma("unroll") for (int e = 0; e < 32; ++e) lg[e] = args.in[16][e];
        for (int k = 0; k < 1024; ++k) { const float xv = bfv(x1 + k); _Pragma("unroll") for (int e = 0; e < 32; ++e) lg[e] += xv * args.in[15][(size_t)k * 32 + e]; }
        int se[4]; float sv[4]; unsigned used = 0;
        _Pragma("unroll") for (int r = 0; r < 4; ++r) { int be = -1; float bv = -INFINITY; _Pragma("unroll") for (int e = 0; e < 32; ++e) if (!((used >> e) & 1) && lg[e] > bv) { bv = lg[e]; be = e; } se[r] = be; sv[r] = bv; used |= 1u << be; }
        float fifth = -INFINITY; _Pragma("unroll") for (int e = 0; e < 32; ++e) if (!((used >> e) & 1)) fifth = fmaxf(fifth, lg[e]);
        const bool neartie = (sv[3] - fifth) < 3e-2f || (sv[0] - sv[1]) < 3e-2f || (sv[1] - sv[2]) < 3e-2f || (sv[2] - sv[3]) < 3e-2f;
        float den = 0.f; _Pragma("unroll") for (int r = 0; r < 4; ++r) den += expf(sv[r] - sv[0]);
        bool bad = false, badg = false;
        if (!neartie) _Pragma("unroll") for (int r = 0; r < 4; ++r) { const int e = tok_e[t * 4 + r], rk = tok_r[t * 4 + r]; if (e != se[r]) { bad = true; continue; }
            if (rk < 0 || rk >= LCAP || list_t[(size_t)e * LCAP + rk] != t) badg = true; else if (!close_(list_g[(size_t)e * LCAP + rk], expf(sv[r] - sv[0]) / den, 0.03f, 1e-3f)) badg = true; }
        if (bad) DBG_FAIL(13); if (badg) DBG_FAIL(14);
        { float sm = 0.f, sq = 0.f; for (int k = 0; k < 1024; ++k) { const float z = (bfv(x1 + k) - args.in[14][k]) / args.in[13][k]; sm += z; sq += z * z; }
          if (fabsf(sm / 1024.f) > 4e-3f || fabsf(sq / 1024.f - 1.0f) > 2e-2f) DBG_FAIL(19); }
    }
    if (stage >= 7 && stage <= 9) {
        __shared__ int st[33], cn[32];
        if (threadIdx.x == 0) { int a = 0; for (int e2 = 0; e2 < 32; ++e2) { cn[e2] = (int)((const unsigned*)(ws + WS_CTL))[CW_CNT + 64 * l + e2]; st[e2] = a; a += ((cn[e2] + 255) >> 8) << 8; } st[32] = a; }
        __syncthreads();
        const int total = st[32]; const int sl = h1 % total; int e = 0; for (int k = 1; k < 32; ++k) if (sl >= st[k]) e = k; const int r = sl - st[e];
        const int* list_t = (const int*)(ws + WS_LT); const float* list_g = (const float*)(ws + WS_LG); const float* sg = (const float*)(ws + WS_SG);
        if (stage == 7) { int sum = 0; for (int k = 0; k < 32; ++k) sum += cn[k]; if (sum != TK) DBG_FAIL(15); }
        if (stage == 7 && r < cn[e]) {
            const bf16* xg = (const bf16*)(ws + WS_X1B) + (size_t)list_t[(size_t)e * LCAP + r] * D; const int f = h2 % 1024; const float* W = args.in[17] + (size_t)e * 1024 * 2048;
            float g = args.in[18][e * 2048 + f], u = args.in[18][e * 2048 + 1024 + f];
            for (int k = 0; k < 1024; ++k) { const float xv = bfv(xg + k); g += xv * bfr(W[(size_t)k * 2048 + f]); u += xv * bfr(W[(size_t)k * 2048 + 1024 + f]); }
            g = fminf(g, 7.0f); u = fminf(fmaxf(u, -7.0f), 7.0f); const float ref = g / (1.0f + expf(-1.702f * g)) * (u + 1.0f);
            if (!close_(bfv((const bf16*)(ws + WS_A2) + (size_t)sl * 1024 + f), ref, 0.03f, 0.02f)) DBG_FAIL(16);
        }
        if (stage == 8 && r < cn[e]) {
            const bf16* ab = (const bf16*)(ws + WS_A2) + (size_t)sl * 1024; const int n = h2 % 1024; const float* W = args.in[19] + (size_t)e * 1024 * 1024;
            float y = args.in[20][e * 1024 + n]; for (int k = 0; k < 1024; ++k) y += bfv(ab + k) * bfr(W[(size_t)k * 1024 + n]);
            y *= list_g[(size_t)e * LCAP + r];
            if (!close_(bfv((const bf16*)(ws + WS_H) + (size_t)sl * 1024 + n), y, 0.03f, 0.005f)) DBG_FAIL(17);
        }
        if (stage == 9) {
            const bf16* x1 = (const bf16*)(ws + WS_X1B) + (size_t)t * D; const int* tok_e = (const int*)(ws + WS_TE); const int* tok_r = (const int*)(ws + WS_TR);
            const bf16* ybf = (const bf16*)(ws + WS_H); float sm = 0.f, sq = 0.f; const int n = h2 % 1024; float vn = 0.f;
            for (int k = 0; k < 1024; ++k) { float v = DN_ALPHA * bfv(x1 + k); for (int q = 0; q < 4; ++q) v += bfv(ybf + (size_t)(st[tok_e[t * 4 + q]] + tok_r[t * 4 + q]) * D + k); sm += v; sq += v * v; if (k == n) vn = v; }
            const float mean = sm / 1024.f, var = sq / 1024.f - mean * mean; const float ref = (vn - mean) / sqrtf(var + LN_EPS) * args.in[21][n] + args.in[22][n];
            if (!close_(bfv((const bf16*)(ws + WS_XB) + (size_t)t * D + n), ref, 0.01f, 0.01f)) DBG_FAIL(18);
        }
    }
}
static void dbg_launch(int stage, const Args& a, hipStream_t stream) {
    switch (stage) {
#define DBGL(k) case k: hipLaunchKernelGGL(dbg_kernel<k>, dim3(8), dim3(256), 0, stream, a); break;
        DBGL(0) DBGL(1) DBGL(2) DBGL(3) DBGL(4) DBGL(5) DBGL(6) DBGL(7) DBGL(8) DBGL(9)
#undef DBGL
    }
}
#endif

extern "C" void kernel_launch(void* const* d_in, const int* in_sizes, int n_in, void* d_out, int out_size, void* d_ws, size_t ws_size, hipStream_t stream) {
    static int grid = 0;
    if (grid == 0) {
        if (n_in != 23 || in_sizes[0] != T * D || out_size != T * D || ws_size < WS_END) { fprintf(stderr, "kernel_launch: unexpected shapes / workspace (%d inputs, ws %zu, need %zu)\n", n_in, ws_size, (size_t)WS_END); grid = -1; return; }
        int dev = 0, cus = 0, per_cu = 0;
        if (hipGetDevice(&dev) != hipSuccess || hipDeviceGetAttribute(&cus, hipDeviceAttributeMultiprocessorCount, dev) != hipSuccess) { grid = -1; return; }
        if (hipFuncSetAttribute((const void*)mk_fwd, hipFuncAttributeMaxDynamicSharedMemorySize, LDS_BYTES) != hipSuccess) { fprintf(stderr, "kernel_launch: hipFuncSetAttribute failed\n"); grid = -1; return; }
        if (hipOccupancyMaxActiveBlocksPerMultiprocessor(&per_cu, (const void*)mk_fwd, NWAVES * 64, LDS_BYTES) != hipSuccess || per_cu < 1) { fprintf(stderr, "kernel_launch: occupancy query reports %d\n", per_cu); }
        (void)hipGetLastError();
        grid = cus;
    }
    if (grid < 0) return;
    if (hipMemsetAsync((char*)d_ws + WS_CTL, 0, CTL_ZERO_BYTES, stream) != hipSuccess) return;
    Args a{};
    for (int i = 0; i < 23; ++i) a.in[i] = (const float*)d_in[i];
    a.out = (float*)d_out; a.ws = (unsigned char*)d_ws; a.pad = 0;
#if MK_ONE_LAUNCH
    a.ph_lo = 0; a.ph_hi = NPH; a.use_bar = 1;
    hipLaunchKernelGGL(mk_fwd, dim3(grid), dim3(NWAVES * 64), LDS_BYTES, stream, a);
#else
    for (int p = 0; p < NPH; ++p) { a.ph_lo = p; a.ph_hi = p + 1; a.use_bar = 0; hipLaunchKernelGGL(mk_fwd, dim3(grid), dim3(NWAVES * 64), LDS_BYTES, stream, a);
#if MK_DEBUG
        if (p >= 1 && p <= PPL) dbg_launch(p - 1, a, stream);
#endif
    }
#endif
    const hipError_t le = hipPeekAtLastError();
    if (le != hipSuccess) fprintf(stderr, "kernel_launch: launch failed: %s\n", hipGetErrorName(le));
}
```
